# Optimizing an MI355X kernel written in HIP

```python
import jax
import jax.numpy as jnp
from jax import lax
import numpy as np


D_MODEL = 1024
BATCH = 8
SEQ = 4096
DEPTH = 2

GRID_W = 64
CTX_LEN = 256

N_HEADS = 16
HEAD_DIM = 64
ATT_W = N_HEADS * HEAD_DIM
WIN_R = 8
WIN_C = 16

FOURIER_GROUPS = 4
FOURIER_W = D_MODEL // 2
FOURIER_GROUP_W = FOURIER_W // FOURIER_GROUPS

POOL_WINDOWS = (2, 4, 8, 16)
POOL_W = D_MODEL // 2
POOL_GROUP_W = POOL_W // len(POOL_WINDOWS)
POOL_OUT_GROUP = D_MODEL // len(POOL_WINDOWS)

N_BRANCHES = 3
K_OFF = 0
V_OFF = K_OFF + ATT_W
Q_OFF = V_OFF + ATT_W
F_OFF = Q_OFF + ATT_W
P_OFF = F_OFF + FOURIER_W
G_OFF = P_OFF + POOL_W
IN_W = G_OFF + N_BRANCHES * D_MODEL

N_EXPERTS = 16
EC_CAPACITY_FACTOR = 2
EXPERT_FF = 2816

RMS_EPS = 1e-6

kernel_name = "hybrid_na_fourier_pool_ecmoe_dit"


def rmsnorm(x, g):
    x32 = x.astype(jnp.float32)
    y = x32 * lax.rsqrt(jnp.mean(x32 * x32, axis=-1, keepdims=True) + RMS_EPS)
    return y.astype(x.dtype) * g


def adaln_params(cond, ada_w, ada_b):
    mod = jax.nn.silu(cond) @ ada_w + ada_b
    return jnp.split(mod, 6, axis=-1)


def modulate(x, g, shift, scale):
    return rmsnorm(x, g) * (1 + scale) + shift


def split_heads(t):
    return t.reshape(t.shape[0], t.shape[1], N_HEADS, HEAD_DIM)


def neighbourhood_attention(q, k, v, k_ctx, v_ctx, rpb):
    batch, length, heads, hd = q.shape
    rows = length // GRID_W
    win_r = min(WIN_R, rows)
    win_c = min(WIN_C, GRID_W)
    n_win = win_r * win_c
    qg = q.reshape(batch, rows, GRID_W, heads, hd)
    kg = k.reshape(batch, rows, GRID_W, heads, hd)
    vg = v.reshape(batch, rows, GRID_W, heads, hd)
    col = jnp.arange(GRID_W)
    col_start = jnp.clip(col - win_c // 2, 0, GRID_W - win_c)
    cols_idx = col_start[:, None] + jnp.arange(win_c)[None, :]
    coff = cols_idx - col[:, None] + (WIN_C - 1)
    scale = hd ** -0.5

    def row_block(r):
        rs = jnp.clip(r - win_r // 2, 0, rows - win_r)
        q_r = lax.dynamic_index_in_dim(qg, r, axis=1, keepdims=False)
        k_win = lax.dynamic_slice_in_dim(kg, rs, win_r, axis=1)[:, :, cols_idx]
        v_win = lax.dynamic_slice_in_dim(vg, rs, win_r, axis=1)[:, :, cols_idx]
        roff = rs + jnp.arange(win_r) - r + (WIN_R - 1)
        bias = rpb[:, roff[None, :, None], coff[:, None, :]]
        s_win = jnp.einsum('bqhd,brqjhd->bhqrj', q_r, k_win) * scale + bias[None]
        s_ctx = jnp.einsum('bqhd,bkhd->bhqk', q_r, k_ctx) * scale
        s = jnp.concatenate([s_win.reshape(batch, heads, GRID_W, n_win), s_ctx], axis=-1)
        p = jax.nn.softmax(s.astype(jnp.float32), axis=-1).astype(q.dtype)
        p_win = p[..., :n_win].reshape(batch, heads, GRID_W, win_r, win_c)
        return (jnp.einsum('bhqrj,brqjhd->bqhd', p_win, v_win)
                + jnp.einsum('bhqk,bkhd->bqhd', p[..., n_win:], v_ctx))

    out = lax.map(row_block, jnp.arange(rows))
    return jnp.moveaxis(out, 0, 1).reshape(batch, length, heads * hd)


def context_attention(q, k, v):
    batch, length = q.shape[0], q.shape[1]
    s = jnp.einsum('bqhd,bkhd->bhqk', q, k) * (HEAD_DIM ** -0.5)
    p = jax.nn.softmax(s.astype(jnp.float32), axis=-1).astype(q.dtype)
    return jnp.einsum('bhqk,bkhd->bqhd', p, v).reshape(batch, length, ATT_W)


def fourier_mix(u):
    batch, length, _ = u.shape
    ug = u.reshape(batch, length, FOURIER_GROUPS, FOURIER_GROUP_W).astype(jnp.float32)
    f = jnp.fft.fft2(ug, axes=(1, 3), norm='ortho').real
    return f.reshape(batch, length, FOURIER_W).astype(u.dtype)


def pooling_mix(u, w_pool, pool_scale):
    batch, length, _ = u.shape
    ug = u.reshape(batch, length, len(POOL_WINDOWS), POOL_GROUP_W)
    t = jnp.arange(length)
    outs = []
    for gi, w in enumerate(POOL_WINDOWS):
        ui = ug[:, :, gi].astype(jnp.float32)
        cs = jnp.concatenate([jnp.zeros_like(ui[:, :1]), jnp.cumsum(ui, axis=1)], axis=1)
        lo = jnp.clip(t - w // 2, 0, length)
        hi = jnp.clip(t + w - w // 2, 0, length)
        mean = (cs[:, hi] - cs[:, lo]) / (hi - lo).astype(jnp.float32)[:, None]
        outs.append(mean - ui)
    pooled = jnp.stack(outs, axis=2).astype(u.dtype)
    y = jnp.einsum('blgc,gcf->blgf', pooled, w_pool).reshape(batch, length, D_MODEL)
    return y * pool_scale


def merge_branches(att, p, w_att_o, w_fourier, w_pool, pool_scale, w_out):
    y_att = att @ w_att_o
    y_four = fourier_mix(p[..., F_OFF:P_OFF]) @ w_fourier
    y_pool = pooling_mix(p[..., P_OFF:G_OFF], w_pool, pool_scale)
    g = jax.nn.sigmoid(p[..., G_OFF:IN_W])
    merged = (g[..., :D_MODEL] * y_att
              + g[..., D_MODEL:2 * D_MODEL] * y_four
              + g[..., 2 * D_MODEL:] * y_pool)
    return merged @ w_out


def expert_choice_ffn(h, w_router, w_gate, w_up, w_down):
    batch, length, _ = h.shape
    cap = EC_CAPACITY_FACTOR * length // N_EXPERTS
    affinity = jax.nn.softmax((h @ w_router).astype(jnp.float32), axis=-1)
    gates, idx = lax.top_k(jnp.swapaxes(affinity, 1, 2), cap)
    b_idx = jnp.arange(batch)[:, None, None]
    xg = h[b_idx, idx]
    a = jnp.einsum('becd,edf->becf', xg, w_gate)
    u = jnp.einsum('becd,edf->becf', xg, w_up)
    y = jnp.einsum('becf,efd->becd', jax.nn.silu(a) * u, w_down) * gates[..., None].astype(h.dtype)
    return jnp.zeros_like(h).at[b_idx, idx].add(y)


def trunk_layer(x, ctx, c, c_ctx, ada_w, ada_b, norm1_g, norm2_g, w_in, rpb, w_att_o, w_fourier,
                w_pool, pool_scale, w_out, w_router, w_gate, w_up, w_down, update_ctx):
    sh1, sc1, g1, sh2, sc2, g2 = [m[:, None, :] for m in adaln_params(c, ada_w, ada_b)]
    sh1c, sc1c, g1c, sh2c, sc2c, g2c = adaln_params(c_ctx, ada_w, ada_b)

    h = modulate(x, norm1_g, sh1, sc1)
    hc = modulate(ctx, norm1_g, sh1c, sc1c)
    p = h @ w_in
    pc = hc @ (w_in if update_ctx else w_in[:, :Q_OFF])
    k_ctx = split_heads(pc[..., K_OFF:V_OFF])
    v_ctx = split_heads(pc[..., V_OFF:Q_OFF])
    att = neighbourhood_attention(split_heads(p[..., Q_OFF:F_OFF]), split_heads(p[..., K_OFF:V_OFF]),
                                  split_heads(p[..., V_OFF:Q_OFF]), k_ctx, v_ctx, rpb)
    x = x + g1 * merge_branches(att, p, w_att_o, w_fourier, w_pool, pool_scale, w_out)

    h2 = modulate(x, norm2_g, sh2, sc2)
    x = x + g2 * expert_choice_ffn(h2, w_router, w_gate, w_up, w_down)

    if update_ctx:
        att_c = context_attention(split_heads(pc[..., Q_OFF:F_OFF]), k_ctx, v_ctx)
        ctx = ctx + g1c * merge_branches(att_c, pc, w_att_o, w_fourier, w_pool, pool_scale, w_out)
        hc2 = modulate(ctx, norm2_g, sh2c, sc2c)
        ctx = ctx + g2c * expert_choice_ffn(hc2, w_router, w_gate, w_up, w_down)
    return x, ctx


def _normal(k, shape, scale):
    return jax.random.normal(k, shape, jnp.float32) * scale


def setup_inputs(seed: int = 0) -> dict:
    key = jax.random.key(seed)
    ks = jax.random.split(key, 21)
    d = D_MODEL
    return {
        'x': _normal(ks[0], (BATCH, SEQ, d), 1.0),
        'c': _normal(ks[1], (BATCH, d), 1.0),
        'ctx': _normal(ks[2], (BATCH, CTX_LEN, d), 1.0),
        'c_ctx': _normal(ks[3], (d,), 1.0),
        'ada_w': _normal(ks[4], (DEPTH, d, 6 * d), 0.5 * d ** -0.5),
        'ada_b': _normal(ks[5], (DEPTH, 6 * d), 0.02),
        'norm1_g': 1.0 + _normal(ks[6], (DEPTH, d), 0.02),
        'norm2_g': 1.0 + _normal(ks[7], (DEPTH, d), 0.02),
        'w_in': _normal(ks[8], (DEPTH, d, IN_W), d ** -0.5),
        'rpb': _normal(ks[9], (DEPTH, N_HEADS, 2 * WIN_R - 1, 2 * WIN_C - 1), 0.1),
        'w_att_o': _normal(ks[10], (DEPTH, ATT_W, d), ATT_W ** -0.5),
        'w_fourier': _normal(ks[11], (DEPTH, FOURIER_W, d), FOURIER_W ** -0.5),
        'w_pool': _normal(ks[12], (DEPTH, len(POOL_WINDOWS), POOL_GROUP_W, POOL_OUT_GROUP), POOL_GROUP_W ** -0.5),
        'pool_scale': 1.0 + _normal(ks[13], (DEPTH, d), 0.02),
        'w_out': _normal(ks[14], (DEPTH, d, d), d ** -0.5),
        'w_router': _normal(ks[15], (DEPTH, d, N_EXPERTS), d ** -0.5),
        'w_exp_gate': _normal(ks[16], (DEPTH, N_EXPERTS, d, EXPERT_FF), d ** -0.5),
        'w_exp_up': _normal(ks[17], (DEPTH, N_EXPERTS, d, EXPERT_FF), d ** -0.5),
        'w_exp_down': _normal(ks[18], (DEPTH, N_EXPERTS, EXPERT_FF, d), EXPERT_FF ** -0.5),
        'final_norm_g': 1.0 + _normal(ks[19], (d,), 0.02),
    }


def reference(x, c, ctx, c_ctx, ada_w, ada_b, norm1_g, norm2_g, w_in, rpb, w_att_o, w_fourier,
              w_pool, pool_scale, w_out, w_router, w_exp_gate, w_exp_up, w_exp_down, final_norm_g):
    for i in range(DEPTH):
        x, ctx = trunk_layer(x, ctx, c, c_ctx, ada_w[i], ada_b[i], norm1_g[i], norm2_g[i], w_in[i], rpb[i],
                             w_att_o[i], w_fourier[i], w_pool[i], pool_scale[i], w_out[i], w_router[i],
                             w_exp_gate[i], w_exp_up[i], w_exp_down[i], update_ctx=(i < DEPTH - 1))
    return rmsnorm(x, final_norm_g)
```

```cpp
#include <hip/hip_runtime.h>
#include <cstdio>
#include <cstdint>

#ifndef N_LAUNCH_MODE
#define N_LAUNCH_MODE 1
#endif

#define GAS __attribute__((address_space(1)))
#define LAS __attribute__((address_space(3)))
typedef unsigned short bf16;
typedef short bf16x8 __attribute__((ext_vector_type(8)));
typedef float f32x4 __attribute__((ext_vector_type(4)));
typedef unsigned u32x4 __attribute__((ext_vector_type(4)));
typedef unsigned u32x2 __attribute__((ext_vector_type(2)));

constexpr int NB = 8, SEQ = 4096, DM = 1024, CTXL = 256, NH = 16, HD = 64, GRIDW = 64;
constexpr int RL = NB * SEQ, RC = NB * CTXL, RT = RL + RC;
constexpr int INW = 7168, NE = 16, FF = 2816, CAPL = 512, CAPC = 32;
constexpr int SLOT_E = 4352, NSLOT = NE * SLOT_E;
constexpr float RMS_EPS = 1e-6f;
constexpr int NWAVES = 8, NTHREADS = 512;

constexpr size_t al256(size_t x) { return (x + 255) & ~(size_t)255; }
constexpr size_t WS_CTL = 0, CTL_BYTES = 1u << 20;
constexpr size_t WS_MOD = WS_CTL + CTL_BYTES;
constexpr size_t WS_XC = al256(WS_MOD + (size_t)2 * 9 * 6144 * 4);
constexpr size_t WS_AFF = al256(WS_XC + (size_t)RC * DM * 4);
constexpr size_t WS_SROW = al256(WS_AFF + (size_t)RT * 16 * 4);
constexpr size_t WS_SGATE = al256(WS_SROW + (size_t)NSLOT * 4);
constexpr size_t WS_SEL = al256(WS_SGATE + (size_t)NSLOT * 4);
constexpr size_t WS_DFTM = al256(WS_SEL + (size_t)RT * 16 * 4);
constexpr size_t WS_DFTC = al256(WS_DFTM + (size_t)4096 * 8192 * 2);
constexpr size_t WS_WA = al256(WS_DFTC + (size_t)256 * 512 * 2);
constexpr size_t WS_WFV = al256(WS_WA + (size_t)5632 * 1024 * 2);
constexpr size_t WS_WAO = al256(WS_WFV + (size_t)2048 * 1024 * 2);
constexpr size_t WS_WFO = al256(WS_WAO + (size_t)1024 * 1024 * 2);
constexpr size_t WS_WPO = al256(WS_WFO + (size_t)1024 * 512 * 2);
constexpr size_t WS_WOUT = al256(WS_WPO + (size_t)1024 * 256 * 2);
constexpr size_t WS_WGU = al256(WS_WOUT + (size_t)1024 * 1024 * 2);
constexpr size_t WS_WD = al256(WS_WGU + (size_t)16 * 5632 * 1024 * 2);
constexpr size_t WS_H = al256(WS_WD + (size_t)16 * 1024 * 2816 * 2);
constexpr size_t WS_R = al256(WS_H + (size_t)RT * DM * 2);
constexpr size_t WS_KQ = WS_R;
constexpr size_t WS_MRG = WS_KQ;
constexpr size_t WS_PB = al256(WS_KQ + (size_t)RT * 2048 * 2);
constexpr size_t WS_GB = al256(WS_PB + (size_t)RT * 512 * 2);
constexpr size_t WS_YT = al256(WS_GB + (size_t)RT * 3072 * 2);
constexpr size_t WS_MRGB = WS_YT;
constexpr size_t WS_VT = al256(WS_YT + (size_t)RT * 1024 * 2);
constexpr size_t WS_FOUR = al256(WS_VT + (size_t)RT * 1024 * 2);
constexpr size_t WS_ATT = al256(WS_FOUR + (size_t)RT * 512 * 2);
constexpr size_t WS_POOL = al256(WS_ATT + (size_t)RT * 1024 * 2);
constexpr size_t WS_MIX_END = al256(WS_POOL + (size_t)RT * 512 * 2);
constexpr size_t WS_XG = WS_R;
constexpr size_t WS_HID = al256(WS_XG + (size_t)NSLOT * 1024 * 2);
constexpr size_t WS_Y = al256(WS_HID + (size_t)NSLOT * 2816 * 2);
constexpr size_t WS_MOE_END = al256(WS_Y + (size_t)NSLOT * 1024 * 2);
constexpr size_t WS_END = WS_MIX_END > WS_MOE_END ? WS_MIX_END : WS_MOE_END;
constexpr size_t YT_CTX_OFF = (size_t)8 * 1024 * 4096;

constexpr int CW_BAR = 4096;

constexpr int LDS_BYTES = 147456;
constexpr int LDS_MISC = 131072;

__device__ __forceinline__ unsigned f2bf(float f) { unsigned u = __float_as_uint(f); return (u + 0x7fffu + ((u >> 16) & 1u)) >> 16; }
__device__ __forceinline__ unsigned pk2(float lo, float hi) { return f2bf(lo) | (f2bf(hi) << 16); }
__device__ __forceinline__ float bf2f(unsigned b) { return __uint_as_float(b << 16); }
__device__ __forceinline__ float bflo(unsigned w) { return __uint_as_float(w << 16); }
__device__ __forceinline__ float bfhi(unsigned w) { return __uint_as_float(w & 0xffff0000u); }
__device__ __forceinline__ float wave_sum(float v) {
#pragma unroll
    for (int o = 1; o < 64; o <<= 1) v += __shfl_xor(v, o);
    return v;
}
__device__ __forceinline__ float wave_max(float v) {
#pragma unroll
    for (int o = 1; o < 64; o <<= 1) v = fmaxf(v, __shfl_xor(v, o));
    return v;
}
__device__ __forceinline__ float sigmoidf_(float x) { return 1.f / (1.f + __expf(-x)); }
#define LDS_WAIT() asm volatile("s_waitcnt lgkmcnt(0)" ::: "memory")

#define XB_TMO      128
#define XB_XCNT(j)  (256  + 64 * (j))
#define XB_XSUB(j)  (1280 + 64 * (j))
#define XB_XGEN(j)  (2304 + 64 * (j))
#define XB_TOP      3328
#define XB_TOPGEN   3392
#define XCD_BAR_WORDS 3456
#define XB_SPIN_CAP (1u << 22)

__device__ __forceinline__ unsigned xb_ld(unsigned* p)              { return __hip_atomic_load(p, __ATOMIC_RELAXED, __HIP_MEMORY_SCOPE_AGENT); }
__device__ __forceinline__ unsigned xb_add(unsigned* p, unsigned v) { return __hip_atomic_fetch_add(p, v, __ATOMIC_RELAXED, __HIP_MEMORY_SCOPE_AGENT); }
__device__ __forceinline__ unsigned xb_xcc_id() { return (unsigned)__builtin_amdgcn_s_getreg((3 << 11) | 20) & 0xFu; }
#define XB_SPIN(cond, bar) do { unsigned _sp = 0; while (cond) { __builtin_amdgcn_s_sleep(1); \
    if ((++_sp & 255u) == 0u) { if (xb_ld(&(bar)[XB_TMO])) break; if (_sp > XB_SPIN_CAP) { atomicAdd(&(bar)[XB_TMO], 1u); break; } } } } while (0)

struct XcdBarrier { unsigned* bar; unsigned x; volatile LAS unsigned* st; };

__device__ __forceinline__ XcdBarrier xcd_barrier_post(unsigned* bar, volatile LAS unsigned* st) {
    XcdBarrier b; b.bar = bar; b.x = xb_xcc_id(); b.st = st;
    if (threadIdx.x == 0) (void)xb_add(&bar[XB_XCNT(b.x)], 1u);
    return b;
}
__device__ __forceinline__ void xcd_barrier_complete(unsigned* bar, unsigned x, unsigned& nloc, unsigned& nx) {
    const unsigned G = gridDim.x * gridDim.y * gridDim.z;
    unsigned sum, cnt, mine, sp = 0u;
    for (;;) {
        sum = 0u; cnt = 0u; mine = 0u;
#pragma unroll
        for (unsigned j = 0; j < 16; ++j) { const unsigned c = xb_ld(&bar[XB_XCNT(j)]); sum += c; cnt += (c > 0u) ? 1u : 0u; mine = (j == x) ? c : mine; }
        if (sum == G) break;
        __builtin_amdgcn_s_sleep(1);
        if ((++sp & 255u) == 0u) { if (xb_ld(&bar[XB_TMO])) break; if (sp > XB_SPIN_CAP) { atomicAdd(&bar[XB_TMO], 1u); break; } }
    }
    nloc = mine > 0u ? mine : 1u; nx = cnt > 0u ? cnt : 1u;
}
__device__ __forceinline__ void xcd_barrier(const XcdBarrier& b) {
    asm volatile("s_waitcnt vmcnt(0)" ::: "memory");
    __syncthreads();
    if (threadIdx.x == 0) {
        unsigned* bar = b.bar;
        __builtin_amdgcn_s_waitcnt(0);
        unsigned nloc = b.st[0], nx = b.st[1];
        if (nloc == 0u) { xcd_barrier_complete(bar, b.x, nloc, nx); b.st[0] = nloc; b.st[1] = nx; }
        const unsigned old = xb_add(&bar[XB_XSUB(b.x)], 1u);
        const unsigned gen = old / nloc;
        if (old + 1u == (gen + 1u) * nloc) {
            __builtin_amdgcn_fence(__ATOMIC_RELEASE, "agent");
            asm volatile("s_waitcnt vmcnt(0)" ::: "memory");
            const unsigned og = xb_add(&bar[XB_TOP], 1u);
            const unsigned tg = og / nx;
            if (og + 1u == (tg + 1u) * nx) xb_add(&bar[XB_TOPGEN], 1u);
            else XB_SPIN(xb_ld(&bar[XB_TOPGEN]) == tg, bar);
            __builtin_amdgcn_fence(__ATOMIC_ACQUIRE, "agent");
            xb_add(&bar[XB_XGEN(b.x)], 1u);
            asm volatile("s_waitcnt vmcnt(0)" ::: "memory");
        } else {
            XB_SPIN(xb_ld(&bar[XB_XGEN(b.x)]) == gen, bar);
            __builtin_amdgcn_fence(__ATOMIC_ACQUIRE, "agent");
            asm volatile("s_waitcnt vmcnt(0)" ::: "memory");
        }
    }
    __syncthreads();
}

struct Params {
    const float *x, *c, *ctx, *c_ctx, *ada_w, *ada_b, *norm1_g, *norm2_g, *w_in, *rpb, *w_att_o, *w_fourier, *w_pool, *pool_scale, *w_out, *w_router, *w_eg, *w_eu, *w_ed, *final_g;
    float* out; unsigned char* ws; int l_lo, l_hi;
};
struct Frame {
    LAS unsigned char* lds;
    int tid, lane, wave, G, bid;
    unsigned char* ws;
};
#define WSP(T, off) ((T*)(F.ws + (off)))

struct Unit { int grp, pm, pn; };
struct GroupSched {
    int ng, nM, nN, G, c; int tM, tN, tpm0, tpn0;
    __device__ __forceinline__ void init(int ng_, int nM_, int nN_, int G_, int c_, int tM_ = 0, int tN_ = 0, int tpm0_ = 0, int tpn0_ = 0) { ng = ng_; nM = nM_; nN = nN_; G = G_; c = c_; tM = tM_; tN = tN_; tpm0 = tpm0_; tpn0 = tpn0_; }
    __device__ __forceinline__ bool next(int i, Unit& u) const {
        const int per = nM * nN; const int L = i * G + c;
        if (L < ng * per) {
            u.grp = L / per; int wgid = L - u.grp * per;
            { const int q = per / 8, r = per % 8, xcd = wgid % 8, off = wgid / 8; wgid = (xcd < r ? xcd * (q + 1) : r * (q + 1) + (xcd - r) * q) + off; }
            const int nig = 8 * nN, gid = wgid / nig, fm = gid * 8, gsz = (nM - fm) < 8 ? (nM - fm) : 8;
            u.pm = fm + ((wgid % nig) % gsz); u.pn = (wgid % nig) / gsz; return true;
        }
        const int w = L - ng * per;
        if (w < tM * tN) { u.grp = ng; u.pm = tpm0 + (w % tM); u.pn = tpn0 + (w / tM); return true; }
        return false;
    }
};
struct Operands { const bf16* A; const bf16* Bt; int lda, ldb; };

template <class Addr, class Epi>
__device__ __forceinline__ void gemm_simple(const GroupSched& S, const Addr& AD, const Epi& E, int K) {
    const int tid = threadIdx.x, wid = __builtin_amdgcn_readfirstlane(tid >> 6), lane = tid & 63, wr = wid >> 2, wc = wid & 3, fr = lane & 15, fq = lane >> 4;
    Unit u;
    for (int i = 0; S.next(i, u); ++i) {
        const Operands op = AD(u);
        f32x4 acc[2][2][4][2];
#pragma unroll
        for (int a = 0; a < 2; ++a)
#pragma unroll
            for (int b = 0; b < 2; ++b)
#pragma unroll
                for (int m = 0; m < 4; ++m)
#pragma unroll
                    for (int n = 0; n < 2; ++n) acc[a][b][m][n] = (f32x4){0.f, 0.f, 0.f, 0.f};
        const bf16* ap = op.A + (size_t)(wr * 64 + fr) * op.lda + fq * 8;
        const bf16* bp = op.Bt + (size_t)(wc * 32 + fr) * op.ldb + fq * 8;
#pragma unroll 1
        for (int k = 0; k < K; k += 32) {
            bf16x8 bfr[2][2];
#pragma unroll
            for (int b = 0; b < 2; ++b)
#pragma unroll
                for (int n = 0; n < 2; ++n) bfr[b][n] = *(const bf16x8*)(bp + (size_t)(b * 128 + n * 16) * op.ldb + k);
#pragma unroll
            for (int a = 0; a < 2; ++a) {
                bf16x8 af[4];
#pragma unroll
                for (int m = 0; m < 4; ++m) af[m] = *(const bf16x8*)(ap + (size_t)(a * 128 + m * 16) * op.lda + k);
#pragma unroll
                for (int b = 0; b < 2; ++b)
#pragma unroll
                    for (int m = 0; m < 4; ++m)
#pragma unroll
                        for (int n = 0; n < 2; ++n) acc[a][b][m][n] = __builtin_amdgcn_mfma_f32_16x16x32_bf16(bfr[b][n], af[m], acc[a][b][m][n], 0, 0, 0);
            }
        }
        E(acc, u, wr, wc, fr, fq);
    }
}
constexpr int HTB = 128 * 64 * 2;
__device__ __forceinline__ int lds_byte(int r, int c) { const int st = (r >> 4) * 2 + (c >> 5), rr = r & 15, cc = c & 31, ob = rr * 64 + cc * 2; return st * 1024 + (ob ^ (((ob >> 9) & 1) << 5)); }
__device__ __forceinline__ void stage_rc(int b, int& R, int& C) { const int st = b / 1024, sb = b % 1024, swz = sb ^ (((sb >> 9) & 1) << 5); R = (st >> 1) * 16 + swz / 64; C = (st & 1) * 32 + (swz % 64) / 2; }
template <class Addr, class Epi>
__device__ __forceinline__ void gemm_fast(LAS unsigned char* lds, const int tid, const GroupSched& S, const Addr& AD, const Epi& E, const int K, const int lda, const int ldb) {
    const int wid = __builtin_amdgcn_readfirstlane(tid >> 6), lane = tid & 63, wr = wid >> 2, wc = wid & 3, fr = lane & 15, fq = lane >> 4;
    const int nt = K / 64;
    unsigned voffA[2], voffB[2];
#pragma unroll
    for (int i = 0; i < 2; ++i) { int R, C; stage_rc(tid * 16 + i * 8192, R, C); voffA[i] = (unsigned)(R * lda + C) * 2u; voffB[i] = (unsigned)(R * ldb + C) * 2u; }
    const size_t kstep = 128;
    const size_t hstepA = (size_t)128 * lda * 2, hstepB = (size_t)128 * ldb * 2;
    const unsigned ldsw = (unsigned)wid * 1024u;
    const int aoff = lds_byte(wr * 64 + fr, fq * 8), boff = lds_byte(wc * 32 + fr, fq * 8);
#define PG8_SA(b, h) (((b) * 2 + (h)) * HTB)
#define PG8_SB(b, h) ((4 + (b) * 2 + (h)) * HTB)
#define PG8_STAGE(bufoff, gbase, voff) do { _Pragma("unroll") for (int _i = 0; _i < 2; ++_i) \
        __builtin_amdgcn_global_load_lds((const unsigned*)((const char*)(gbase) + (voff)[_i]), (LAS unsigned*)(lds + (bufoff) + ldsw + _i * 8192), 16, 0, 0); } while (0)
#define PG8_LDA(dst, b, h) do { _Pragma("unroll") for (int m = 0; m < 4; ++m) _Pragma("unroll") for (int k = 0; k < 2; ++k) dst[m][k] = *(const LAS bf16x8*)(lds + PG8_SA(b, h) + aoff + m * 2048 + k * 1024); } while (0)
#define PG8_LDB(dst, b, h) do { _Pragma("unroll") for (int n = 0; n < 2; ++n) _Pragma("unroll") for (int k = 0; k < 2; ++k) dst[n][k] = *(const LAS bf16x8*)(lds + PG8_SB(b, h) + boff + n * 2048 + k * 1024); } while (0)
#define PG8_MMA(ai, bj, At, Bt) do { __builtin_amdgcn_s_setprio(1); _Pragma("unroll") for (int m = 0; m < 4; ++m) _Pragma("unroll") for (int n = 0; n < 2; ++n) _Pragma("unroll") for (int k = 0; k < 2; ++k) \
        acc[ai][bj][m][n] = __builtin_amdgcn_mfma_f32_16x16x32_bf16(Bt[n][k], At[m][k], acc[ai][bj][m][n], 0, 0, 0); __builtin_amdgcn_s_setprio(0); } while (0)
#define PG8_WAIT_V(n) asm volatile("s_waitcnt vmcnt(" #n ")" ::: "memory")
#define PG8_WAIT_L(n) asm volatile("s_waitcnt lgkmcnt(" #n ")" ::: "memory")
#define PG8_BAR __builtin_amdgcn_s_barrier()
#define PG8_SCHED __builtin_amdgcn_sched_barrier(0)
    Unit cur, nxt; int ui = 0;
    if (!S.next(0, cur)) return;
    f32x4 acc[2][2][4][2];
#pragma unroll
    for (int a = 0; a < 2; ++a)
#pragma unroll
        for (int b = 0; b < 2; ++b)
#pragma unroll
            for (int m = 0; m < 4; ++m)
#pragma unroll
                for (int n = 0; n < 2; ++n) acc[a][b][m][n] = (f32x4){0.f, 0.f, 0.f, 0.f};
    bf16x8 At[4][2], B0[2][2], B1[2][2];
    const char* cA; const char* cB;
    { const Operands op = AD(cur); cA = (const char*)op.A; cB = (const char*)op.Bt; }
    PG8_STAGE(PG8_SB(0, 0), cB, voffB); PG8_STAGE(PG8_SB(0, 1), cB + hstepB, voffB); PG8_STAGE(PG8_SA(0, 0), cA, voffA); PG8_STAGE(PG8_SA(0, 1), cA + hstepA, voffA);
    if (wr == 1) PG8_BAR;
    PG8_WAIT_V(2); PG8_BAR;
    PG8_STAGE(PG8_SB(1, 0), cB + kstep, voffB); PG8_STAGE(PG8_SA(1, 0), cA + kstep, voffA); PG8_STAGE(PG8_SB(1, 1), cB + hstepB + kstep, voffB);
    PG8_WAIT_V(6); PG8_BAR;
    for (;;) {
        const bool has_next = S.next(ui + 1, nxt);
        const char* nA = cA; const char* nB = cB;
        if (has_next) { const Operands op = AD(nxt); nA = (const char*)op.A; nB = (const char*)op.Bt; }
#pragma unroll 1
        for (int t = 0; t < nt; t += 2) {
            const bool last = (t == nt - 2);
            const char* a1 = cA + (size_t)(t + 1) * kstep;
            const char* a2 = last ? nA : cA + (size_t)(t + 2) * kstep; const char* b2 = last ? nB : cB + (size_t)(t + 2) * kstep;
            const char* a3 = a2 + kstep; const char* b3 = b2 + kstep;
            PG8_LDB(B0, 0, 0); PG8_LDB(B1, 0, 1); PG8_SCHED; PG8_LDA(At, 0, 0); PG8_STAGE(PG8_SA(1, 1), a1 + hstepA, voffA);
            PG8_WAIT_V(8); PG8_WAIT_L(0); PG8_BAR; PG8_MMA(0, 0, At, B0); PG8_MMA(0, 1, At, B1); PG8_BAR; PG8_SCHED;
            PG8_LDA(At, 0, 1); PG8_STAGE(PG8_SB(0, 0), b2, voffB); PG8_STAGE(PG8_SB(0, 1), b2 + hstepB, voffB); PG8_STAGE(PG8_SA(0, 0), a2, voffA);
            PG8_WAIT_V(8); PG8_WAIT_L(0); PG8_BAR; PG8_MMA(1, 0, At, B0); PG8_MMA(1, 1, At, B1); PG8_BAR; PG8_SCHED;
            PG8_LDB(B0, 1, 0); PG8_LDB(B1, 1, 1); PG8_SCHED; PG8_LDA(At, 1, 0); PG8_STAGE(PG8_SA(0, 1), a2 + hstepA, voffA);
            PG8_WAIT_V(8); PG8_WAIT_L(0); PG8_BAR; PG8_MMA(0, 0, At, B0); PG8_MMA(0, 1, At, B1); PG8_BAR; PG8_SCHED;
            PG8_LDA(At, 1, 1); PG8_STAGE(PG8_SB(1, 0), b3, voffB); PG8_STAGE(PG8_SB(1, 1), b3 + hstepB, voffB); PG8_STAGE(PG8_SA(1, 0), a3, voffA);
            PG8_WAIT_V(8); PG8_WAIT_L(0); PG8_BAR; PG8_MMA(1, 0, At, B0); PG8_MMA(1, 1, At, B1); PG8_BAR; PG8_SCHED;
        }
        if (wr == 0) PG8_BAR;
        { int fr2 = fr, fq2 = fq; asm volatile("" : "+v"(fr2), "+v"(fq2));
          E(acc, cur, wr, wc, fr2, fq2); }
        if (!has_next) break;
#pragma unroll
        for (int a = 0; a < 2; ++a)
#pragma unroll
            for (int b = 0; b < 2; ++b)
#pragma unroll
                for (int m = 0; m < 4; ++m)
#pragma unroll
                    for (int n = 0; n < 2; ++n) acc[a][b][m][n] = (f32x4){0.f, 0.f, 0.f, 0.f};
        cur = nxt; cA = nA; cB = nB; ++ui;
        if (wr == 1) PG8_BAR;
    }
    PG8_WAIT_V(0);
    PG8_BAR;
#undef PG8_SA
#undef PG8_SB
#undef PG8_STAGE
#undef PG8_LDA
#undef PG8_LDB
#undef PG8_MMA
#undef PG8_WAIT_V
#undef PG8_WAIT_L
#undef PG8_BAR
#undef PG8_SCHED
}
#ifndef USE_FAST
#define USE_FAST 1
#endif
#if USE_FAST
#define GEMM(S, AD, E, K, lda, ldb) gemm_fast(F.lds, F.tid, S, AD, E, K, lda, ldb)
#else
#define GEMM(S, AD, E, K, lda, ldb) gemm_simple(S, AD, E, K)
#endif
#define EPI_ARGS const f32x4 (&acc)[2][2][4][2], const Unit& u, int wr, int wc, int fr, int fq
#define EPI_FOR(BODY) _Pragma("unroll") for (int ai = 0; ai < 2; ++ai) _Pragma("unroll") for (int m = 0; m < 4; ++m) { const int r = ai * 128 + wr * 64 + m * 16 + fr; \
    _Pragma("unroll") for (int bj = 0; bj < 2; ++bj) _Pragma("unroll") for (int n = 0; n < 2; ++n) { const int c = bj * 128 + wc * 32 + n * 16 + 4 * fq; const f32x4 v = acc[ai][bj][m][n]; BODY } }
__device__ __forceinline__ void st_bf4(bf16* p, f32x4 v) { u32x2 w; w.x = pk2(v[0], v[1]); w.y = pk2(v[2], v[3]); *(u32x2*)p = w; }

__device__ __forceinline__ void p_mod(const Params& P, Frame& F) {
    LAS float* sc = (LAS float*)F.lds;
    LAS float* red = (LAS float*)(F.lds + 9 * 1024 * 4);
    float* MOD = WSP(float, WS_MOD);
    bool have = false;
    for (int it = F.bid; it < 2 * 96; it += F.G) {
        if (!have) {
            for (int i = F.tid; i < 9 * 1024; i += NTHREADS) { const int r = i >> 10, k = i & 1023; const float v = r < 8 ? P.c[r * 1024 + k] : P.c_ctx[k]; sc[i] = v * sigmoidf_(v); }
            have = true;
        }
        __syncthreads();
        const int l = it / 96, j0 = (it % 96) * 64, jj = F.tid & 63, kc = F.tid >> 6;
        const float* W = P.ada_w + (size_t)l * 1024 * 6144 + j0 + jj;
        float a[9];
#pragma unroll
        for (int r = 0; r < 9; ++r) a[r] = 0.f;
        for (int k = kc * 128; k < kc * 128 + 128; ++k) { const float w = W[(size_t)k * 6144];
#pragma unroll
            for (int r = 0; r < 9; ++r) a[r] += sc[r * 1024 + k] * w; }
#pragma unroll
        for (int r = 0; r < 9; ++r) red[(kc * 9 + r) * 64 + jj] = a[r];
        __syncthreads();
        for (int o = F.tid; o < 9 * 64; o += NTHREADS) { const int r = o >> 6, j = o & 63; float s = 0.f;
#pragma unroll
            for (int q = 0; q < 8; ++q) s += red[(q * 9 + r) * 64 + j];
            MOD[((size_t)l * 9 + r) * 6144 + j0 + j] = s + P.ada_b[l * 6144 + j0 + j]; }
    }
    __syncthreads();
}
__device__ __forceinline__ void p_dftgen(Frame& F) {
    LAS float* tab = (LAS float*)F.lds;
    for (int j = F.tid; j < 4096; j += NTHREADS) tab[j] = cospif((float)j * (1.0f / 2048.0f));
    __syncthreads();
    bf16* DM_ = WSP(bf16, WS_DFTM); bf16* DC_ = WSP(bf16, WS_DFTC);
    const int nchunk = 4096 * 1024 + 256 * 64;
    for (int ch = F.bid * NTHREADS + F.tid; ch < nchunk; ch += F.G * NTHREADS) {
        float v[8]; bf16* dst;
        if (ch < 4096 * 1024) { const int kf = ch >> 10, col0 = (ch & 1023) * 8, cs = col0 >> 12, l0 = col0 & 4095;
#pragma unroll
            for (int i = 0; i < 8; ++i) { const int j = (kf * (l0 + i)) & 4095; v[i] = cs ? -tab[(j + 3072) & 4095] : tab[j]; }
            dst = DM_ + (size_t)kf * 8192 + col0; }
        else { const int c2 = ch - 4096 * 1024, kf = c2 >> 6, col0 = (c2 & 63) * 8, cs = col0 >> 8, l0 = col0 & 255;
#pragma unroll
            for (int i = 0; i < 8; ++i) { const int j = ((kf * (l0 + i)) & 255) * 16; v[i] = cs ? -tab[(j + 3072) & 4095] : tab[j]; }
            dst = DC_ + (size_t)kf * 512 + col0; }
        u32x4 o; o.x = pk2(v[0], v[1]); o.y = pk2(v[2], v[3]); o.z = pk2(v[4], v[5]); o.w = pk2(v[6], v[7]);
        *(u32x4*)dst = o;
    }
    __syncthreads();
}
__device__ __forceinline__ void transpose_item(const float* W, int ldw, int k0, int n0, bf16* WT, int ldt, int drow0, LAS float* scr, int lane) {
#pragma unroll 8
    for (int i = 0; i < 32; ++i) { const int kk = 2 * i + (lane >> 5); scr[kk * 33 + (lane & 31)] = W[(size_t)(k0 + kk) * ldw + n0 + (lane & 31)]; }
    LDS_WAIT(); asm volatile("" ::: "memory");
    const int c = lane & 7;
#pragma unroll
    for (int j = 0; j < 4; ++j) { const int n = (lane >> 3) + 8 * j; const LAS float* s = scr + (8 * c) * 33 + n;
        u32x4 o; o.x = pk2(s[0 * 33], s[1 * 33]); o.y = pk2(s[2 * 33], s[3 * 33]); o.z = pk2(s[4 * 33], s[5 * 33]); o.w = pk2(s[6 * 33], s[7 * 33]);
        *(u32x4*)(WT + (size_t)(drow0 + n) * ldt + k0 + 8 * c) = o; }
    LDS_WAIT(); asm volatile("" ::: "memory");
}
__device__ __forceinline__ void p_wconv(const Params& P, Frame& F, int l) {
    LAS float* scr = (LAS float*)(F.lds + F.wave * 16384);
    const int gw = F.bid * NWAVES + F.wave, NGW = F.G * NWAVES;
    const float* w_in = P.w_in + (size_t)l * 1024 * INW;
    bf16* WA = WSP(bf16, WS_WA); bf16* WFV = WSP(bf16, WS_WFV);
    constexpr int I_K = 16 * 32, I_Q = 16 * 32, I_P = 16 * 16, I_G = 16 * 96, I_V = 16 * 32, I_AO = 16 * 32, I_FO = 8 * 32, I_OUT = 16 * 32;
    constexpr int NSM = I_K + I_Q + I_P + I_G + I_V + I_AO + I_FO + I_OUT;
    for (int it = gw; it < NSM; it += NGW) {
        int r = it;
        if (r < I_K) { transpose_item(w_in, INW, (r / 32) * 64, 0 + (r % 32) * 32, WA, 1024, 0 + (r % 32) * 32, scr, F.lane); continue; } r -= I_K;
        if (r < I_Q) { transpose_item(w_in, INW, (r / 32) * 64, 2048 + (r % 32) * 32, WA, 1024, 1024 + (r % 32) * 32, scr, F.lane); continue; } r -= I_Q;
        if (r < I_P) { transpose_item(w_in, INW, (r / 16) * 64, 3584 + (r % 16) * 32, WA, 1024, 2048 + (r % 16) * 32, scr, F.lane); continue; } r -= I_P;
        if (r < I_G) { transpose_item(w_in, INW, (r / 96) * 64, 4096 + (r % 96) * 32, WA, 1024, 2560 + (r % 96) * 32, scr, F.lane); continue; } r -= I_G;
        if (r < I_V) { transpose_item(w_in, INW, (r / 32) * 64, 1024 + (r % 32) * 32, WFV, 1024, 1024 + (r % 32) * 32, scr, F.lane); continue; } r -= I_V;
        if (r < I_AO) { transpose_item(P.w_att_o + (size_t)l * 1024 * 1024, 1024, (r / 32) * 64, (r % 32) * 32, WSP(bf16, WS_WAO), 1024, (r % 32) * 32, scr, F.lane); continue; } r -= I_AO;
        if (r < I_FO) { transpose_item(P.w_fourier + (size_t)l * 512 * 1024, 1024, (r / 32) * 64, (r % 32) * 32, WSP(bf16, WS_WFO), 512, (r % 32) * 32, scr, F.lane); continue; } r -= I_FO;
        transpose_item(P.w_out + (size_t)l * 1024 * 1024, 1024, (r / 32) * 64, (r % 32) * 32, WSP(bf16, WS_WOUT), 1024, (r % 32) * 32, scr, F.lane);
    }
    constexpr int I_E = 16 * 88;
    bf16* WGU = WSP(bf16, WS_WGU); bf16* WD = WSP(bf16, WS_WD);
    for (int it = gw; it < 3 * 16 * I_E; it += NGW) {
        const int which = it / (16 * I_E), r0 = it % (16 * I_E), e = r0 / I_E, r = r0 % I_E;
        if (which < 2) { const int kb = r / 88, nb = r % 88, n0 = nb * 32;
            const float* src = (which == 0 ? P.w_eg : P.w_eu) + ((size_t)l * 16 + e) * 1024 * FF;
            transpose_item(src, FF, kb * 64, n0, WGU + (size_t)e * 5632 * 1024, 1024, (n0 >> 7) * 256 + (which ? 128 : 0) + (n0 & 127), scr, F.lane); }
        else { const int kb = r / 32, nb = r % 32;
            transpose_item(P.w_ed + ((size_t)l * 16 + e) * FF * 1024, 1024, kb * 64, nb * 32, WD + (size_t)e * 1024 * FF, FF, nb * 32, scr, F.lane); }
    }
    { bf16* WPO = WSP(bf16, WS_WPO); const float* wp = P.w_pool + (size_t)l * 4 * 128 * 256;
      for (int i = F.bid * NTHREADS + F.tid; i < 1024 * 256; i += F.G * NTHREADS) { const int n = i >> 8, kk = i & 255, g = n >> 8, f = n & 255;
          WPO[i] = (bf16)(((kk >> 7) == (g & 1)) ? f2bf(wp[((size_t)g * 128 + (kk & 127)) * 256 + f]) : 0u); } }
    { LAS float* t128 = (LAS float*)F.lds;
      __syncthreads();
      for (int j = F.tid; j < 128; j += NTHREADS) t128[j] = cospif((float)j * (1.0f / 64.0f));
      __syncthreads();
      for (int i = F.bid * NTHREADS + F.tid; i < 1024 * 1024; i += F.G * NTHREADS) { const int fc = i >> 10, k = i & 1023, cs = fc & 1, gm = fc >> 1, g = gm >> 7, m = gm & 127;
          const float* src = w_in + (size_t)k * INW + 3072 + g * 128; float s = 0.f; const int ph = cs ? 96 : 0;
          for (int c = 0; c < 128; ++c) s += src[c] * t128[(m * c + ph) & 127];
          WFV[i] = (bf16)f2bf(s); }
      __syncthreads(); }
}

struct RowMod { const float* g; const float* sh; const float* sc; };
__device__ __forceinline__ void row_load(const float* row, int lane, f32x4 (&v)[4]) {
#pragma unroll
    for (int j = 0; j < 4; ++j) v[j] = *(const f32x4*)(row + 4 * lane + 256 * j);
}
__device__ __forceinline__ float row_rstd(const f32x4 (&v)[4]) {
    float s = 0.f;
#pragma unroll
    for (int j = 0; j < 4; ++j) s += (v[j][0] * v[j][0] + v[j][1] * v[j][1]) + (v[j][2] * v[j][2] + v[j][3] * v[j][3]);
    return rsqrtf(wave_sum(s) * (1.0f / 1024.0f) + RMS_EPS);
}
__device__ __forceinline__ void row_modulate(const f32x4 (&v)[4], float rstd, const RowMod& M, int lane, f32x4 (&y)[4]) {
#pragma unroll
    for (int j = 0; j < 4; ++j) { const int k = 4 * lane + 256 * j; const f32x4 g = *(const f32x4*)(M.g + k), sh = *(const f32x4*)(M.sh + k), sc = *(const f32x4*)(M.sc + k);
        y[j] = v[j] * rstd * g * (sc + 1.0f) + sh; }
}
__device__ __forceinline__ void row_store_bf(bf16* row, int lane, const f32x4 (&y)[4]) {
#pragma unroll
    for (int j = 0; j < 4; ++j) st_bf4(row + 4 * lane + 256 * j, y[j]);
}
__device__ __forceinline__ const float* mod_ptr(Frame& F, int l, int row, int which) { const int mr = row < RL ? (row >> 12) : 8; return WSP(float, WS_MOD) + ((size_t)l * 9 + mr) * 6144 + which * 1024; }

__device__ __forceinline__ void p_rowpass_a0(const Params& P, Frame& F) {
    const int gw = F.bid * NWAVES + F.wave, NGW = F.G * NWAVES; bf16* H = WSP(bf16, WS_H);
    for (int row = gw; row < RT; row += NGW) {
        const float* src = row < RL ? P.x + (size_t)row * DM : P.ctx + (size_t)(row - RL) * DM;
        f32x4 v[4], y[4]; row_load(src, F.lane, v); const float rs = row_rstd(v);
        RowMod M{P.norm1_g, mod_ptr(F, 0, row, 0), mod_ptr(F, 0, row, 1)};
        row_modulate(v, rs, M, F.lane, y); row_store_bf(H + (size_t)row * DM, F.lane, y);
    }
}
__device__ __forceinline__ void p_rowpass_f(const Params& P, Frame& F, int l, int nrows) {
    const int gw = F.bid * NWAVES + F.wave, NGW = F.G * NWAVES; bf16* H = WSP(bf16, WS_H); float* AFF = WSP(float, WS_AFF);
    const float* wr = P.w_router + (size_t)l * 1024 * 16;
    for (int row = gw; row < nrows; row += NGW) {
        const float* src = row < RL ? P.out + (size_t)row * DM : WSP(float, WS_XC) + (size_t)(row - RL) * DM;
        f32x4 v[4], y[4]; row_load(src, F.lane, v); const float rs = row_rstd(v);
        RowMod M{P.norm2_g + l * 1024, mod_ptr(F, l, row, 3), mod_ptr(F, l, row, 4)};
        row_modulate(v, rs, M, F.lane, y); row_store_bf(H + (size_t)row * DM, F.lane, y);
        float lg[16];
#pragma unroll
        for (int e = 0; e < 16; ++e) lg[e] = 0.f;
#pragma unroll
        for (int j = 0; j < 4; ++j)
#pragma unroll
            for (int q = 0; q < 4; ++q) { const float* w = wr + (size_t)(4 * F.lane + 256 * j + q) * 16; const float hv = y[j][q];
#pragma unroll
                for (int e4 = 0; e4 < 4; ++e4) { const f32x4 ww = *(const f32x4*)(w + 4 * e4); lg[4 * e4 + 0] += hv * ww[0]; lg[4 * e4 + 1] += hv * ww[1]; lg[4 * e4 + 2] += hv * ww[2]; lg[4 * e4 + 3] += hv * ww[3]; } }
        float mx = -1e30f;
#pragma unroll
        for (int e = 0; e < 16; ++e) { lg[e] = wave_sum(lg[e]); mx = fmaxf(mx, lg[e]); }
        float den = 0.f;
#pragma unroll
        for (int e = 0; e < 16; ++e) { lg[e] = __expf(lg[e] - mx); den += lg[e]; }
        const float inv = 1.0f / den;
        if (F.lane < 16) { float mine = 0.f;
#pragma unroll
            for (int e = 0; e < 16; ++e) mine = (F.lane == e) ? lg[e] : mine;
            AFF[(size_t)row * 16 + F.lane] = mine * inv; }
    }
}
__device__ __forceinline__ void p_rowpass_k(const Params& P, Frame& F, int l, int nrows) {
    const int gw = F.bid * NWAVES + F.wave, NGW = F.G * NWAVES; bf16* H = WSP(bf16, WS_H);
    const int* SEL = WSP(int, WS_SEL); const bf16* Y = WSP(bf16, WS_Y);
    for (int row = gw; row < nrows; row += NGW) {
        float* xr = row < RL ? P.out + (size_t)row * DM : WSP(float, WS_XC) + (size_t)(row - RL) * DM;
        f32x4 v[4], a[4]; row_load(xr, F.lane, v);
#pragma unroll
        for (int j = 0; j < 4; ++j) a[j] = (f32x4){0.f, 0.f, 0.f, 0.f};
        for (int e = 0; e < 16; ++e) { const int s = SEL[(size_t)row * 16 + e];
            if (s >= 0) { const bf16* yr = Y + (size_t)s * DM;
#pragma unroll
                for (int j = 0; j < 4; ++j) { const u32x2 w = *(const u32x2*)(yr + 4 * F.lane + 256 * j); a[j][0] += bflo(w.x); a[j][1] += bfhi(w.x); a[j][2] += bflo(w.y); a[j][3] += bfhi(w.y); } } }
        const float* g2 = mod_ptr(F, l, row, 5);
#pragma unroll
        for (int j = 0; j < 4; ++j) { const f32x4 g = *(const f32x4*)(g2 + 4 * F.lane + 256 * j); v[j] = v[j] + g * a[j]; }
        const float rs = row_rstd(v);
        if (l == 0) {
#pragma unroll
            for (int j = 0; j < 4; ++j) *(f32x4*)(xr + 4 * F.lane + 256 * j) = v[j];
            f32x4 y[4]; RowMod M{P.norm1_g + 1024, mod_ptr(F, 1, row, 0), mod_ptr(F, 1, row, 1)};
            row_modulate(v, rs, M, F.lane, y); row_store_bf(H + (size_t)row * DM, F.lane, y);
        } else {
#pragma unroll
            for (int j = 0; j < 4; ++j) { const f32x4 g = *(const f32x4*)(P.final_g + 4 * F.lane + 256 * j); *(f32x4*)(xr + 4 * F.lane + 256 * j) = v[j] * rs * g; }
        }
    }
}

__device__ __forceinline__ float dot64(const bf16x8 (&q)[8], const bf16* kp) {
    float s = 0.f;
#pragma unroll
    for (int i = 0; i < 8; ++i) { const u32x4 kw = *(const u32x4*)(kp + 8 * i); const u32x4 qw = __builtin_bit_cast(u32x4, q[i]);
#pragma unroll
        for (int t = 0; t < 4; ++t) s += bflo(kw[t]) * bflo(qw[t]) + bfhi(kw[t]) * bfhi(qw[t]); }
    return s;
}
__device__ __forceinline__ void p_attn_naive(const Params& P, Frame& F, int l, bool with_ctx_queries) {
    const int gw = F.bid * NWAVES + F.wave, NGW = F.G * NWAVES;
    const bf16* KQ = WSP(bf16, WS_KQ); const bf16* VT = WSP(bf16, WS_VT); bf16* ATT = WSP(bf16, WS_ATT);
    LAS float* pw = (LAS float*)(F.lds + F.wave * 2048);
    const float* rpb = P.rpb + (size_t)l * 16 * 15 * 31;
    const int nlat = NB * 64 * NH * 64, nitems = nlat + (with_ctx_queries ? NB * NH * CTXL : 0);
    for (int it = gw; it < nitems; it += NGW) {
        const bool lat = it < nlat;
        int b, h, r = 0, qc = 0, rowq;
        if (lat) { qc = it & 63; h = (it >> 6) & 15; r = (it >> 10) & 63; b = it >> 16; rowq = b * SEQ + r * 64 + qc; }
        else { const int i2 = it - nlat; qc = i2 & 255; h = (i2 >> 8) & 15; b = i2 >> 12; rowq = RL + b * CTXL + qc; }
        bf16x8 q[8];
        { const bf16* qp = KQ + (size_t)rowq * 2048 + 1024 + h * 64;
#pragma unroll
          for (int i = 0; i < 8; ++i) q[i] = *(const bf16x8*)(qp + 8 * i); }
        const int rs = min(max(r - 4, 0), 56), cs = min(max(qc - 8, 0), 48);
        float s[6];
        if (lat) {
#pragma unroll
            for (int t = 0; t < 2; ++t) { const int w = F.lane + 64 * t, i = w >> 4, j = w & 15; const int tok = (rs + i) * 64 + cs + j;
                s[t] = dot64(q, KQ + (size_t)(b * SEQ + tok) * 2048 + h * 64) * 0.125f + rpb[(h * 15 + (rs + i - r + 7)) * 31 + (cs + j - qc + 15)]; }
        } else { s[0] = -1e30f; s[1] = -1e30f; }
#pragma unroll
        for (int t = 0; t < 4; ++t) { const int c = F.lane + 64 * t; s[2 + t] = dot64(q, KQ + (size_t)(RL + b * CTXL + c) * 2048 + h * 64) * 0.125f; }
        float mx = s[0];
#pragma unroll
        for (int t = 1; t < 6; ++t) mx = fmaxf(mx, s[t]);
        mx = wave_max(mx);
        float sum = 0.f;
#pragma unroll
        for (int t = 0; t < 6; ++t) { s[t] = (lat || t >= 2) ? __expf(s[t] - mx) : 0.f; sum += s[t]; }
        sum = wave_sum(sum);
        pw[F.lane] = s[0]; pw[F.lane + 64] = s[1];
#pragma unroll
        for (int t = 0; t < 4; ++t) pw[128 + F.lane + 64 * t] = s[2 + t];
        LDS_WAIT(); asm volatile("" ::: "memory");
        float o = 0.f;
        if (lat) { const bf16* vr = VT + ((size_t)b * 1024 + h * 64 + F.lane) * 4096;
#pragma unroll 2
            for (int w = 0; w < 128; ++w) { const int tok = (rs + (w >> 4)) * 64 + cs + (w & 15); o += pw[w] * bf2f(vr[tok]); } }
        { const bf16* vr = VT + YT_CTX_OFF + ((size_t)b * 1024 + h * 64 + F.lane) * 256;
#pragma unroll 2
          for (int c8 = 0; c8 < 32; ++c8) { const u32x4 vw = *(const u32x4*)(vr + 8 * c8); const LAS float* pp = pw + 128 + 8 * c8;
#pragma unroll
              for (int t = 0; t < 4; ++t) o += pp[2 * t] * bflo(vw[t]) + pp[2 * t + 1] * bfhi(vw[t]); } }
        ATT[(size_t)rowq * 1024 + h * 64 + F.lane] = (bf16)f2bf(o / sum);
        LDS_WAIT(); asm volatile("" ::: "memory");
    }
}

__device__ __forceinline__ void p_pool(Frame& F, int nrows) {
    const bf16* PB = WSP(bf16, WS_PB); bf16* POOL = WSP(bf16, WS_POOL);
    for (int i = F.bid * NTHREADS + F.tid; i < nrows * 64; i += F.G * NTHREADS) {
        const int row = i >> 6, ch = i & 63, g = ch >> 4, hw = 1 << g;
        int base, t, Lb; if (row < RL) { base = row & ~4095; t = row & 4095; Lb = SEQ; } else { const int rr = row - RL; base = RL + (rr & ~255); t = rr & 255; Lb = CTXL; }
        const int lo = max(t - hw, 0), hi = min(t + hw, Lb);
        float a[8];
#pragma unroll
        for (int q = 0; q < 8; ++q) a[q] = 0.f;
        for (int tt = lo; tt < hi; ++tt) { const u32x4 w = *(const u32x4*)(PB + (size_t)(base + tt) * 512 + ch * 8);
#pragma unroll
            for (int q = 0; q < 4; ++q) { a[2 * q] += bflo(w[q]); a[2 * q + 1] += bfhi(w[q]); } }
        const u32x4 me = *(const u32x4*)(PB + (size_t)row * 512 + ch * 8); const float inv = 1.0f / (float)(hi - lo);
        u32x4 o;
#pragma unroll
        for (int q = 0; q < 4; ++q) o[q] = pk2(a[2 * q] * inv - bflo(me[q]), a[2 * q + 1] * inv - bfhi(me[q]));
        *(u32x4*)(POOL + (size_t)row * 512 + ch * 8) = o;
    }
}

__device__ __forceinline__ int block_sum_i(int v, LAS int* sm, int tid) {
#pragma unroll
    for (int o = 1; o < 64; o <<= 1) v += __shfl_xor(v, o);
    __syncthreads();
    if ((tid & 63) == 0) sm[tid >> 6] = v;
    __syncthreads();
    int s = 0;
#pragma unroll
    for (int i = 0; i < 8; ++i) s += sm[i];
    return s;
}
__device__ __forceinline__ int block_excl_scan(int v, LAS int* sm, int tid, int& total) {
    const int lane = tid & 63, w = tid >> 6; int inc = v;
#pragma unroll
    for (int o = 1; o < 64; o <<= 1) { const int t = __shfl_up(inc, o); if (lane >= o) inc += t; }
    __syncthreads();
    if (lane == 63) sm[w] = inc;
    __syncthreads();
    int base = 0; total = 0;
#pragma unroll
    for (int i = 0; i < 8; ++i) { const int s = sm[i]; if (i < w) base += s; total += s; }
    return base + inc - v;
}
template <int NPT>
__device__ __forceinline__ void topk_pair(Frame& F, int row0, int n, int cap, int e, int slot0) {
    LAS int* sm = (LAS int*)F.lds;
    const float* AFF = WSP(float, WS_AFF); int* SROW = WSP(int, WS_SROW); float* SG = WSP(float, WS_SGATE); int* SEL = WSP(int, WS_SEL);
    unsigned key[NPT];
#pragma unroll
    for (int j = 0; j < NPT; ++j) { const int i = F.tid * NPT + j; key[j] = (i < n) ? __float_as_uint(AFF[(size_t)(row0 + i) * 16 + e]) : 0u; }
    unsigned T = 0u;
    for (int bit = 30; bit >= 0; --bit) { const unsigned cand = T | (1u << bit); int cnt = 0;
#pragma unroll
        for (int j = 0; j < NPT; ++j) cnt += (key[j] >= cand) ? 1 : 0;
        cnt = block_sum_i(cnt, sm, F.tid);
        if (cnt >= cap) T = cand; }
    int ngt = 0, neq = 0;
#pragma unroll
    for (int j = 0; j < NPT; ++j) { ngt += (key[j] > T) ? 1 : 0; neq += (key[j] == T) ? 1 : 0; }
    int tot_gt, tot_eq;
    (void)block_excl_scan(ngt, sm, F.tid, tot_gt);
    int eqr = block_excl_scan(neq, sm, F.tid, tot_eq);
    const int need_eq = cap - tot_gt;
    int nsel = 0; bool selj[NPT];
#pragma unroll
    for (int j = 0; j < NPT; ++j) { bool s = key[j] > T; if (key[j] == T && T != 0u) { s = eqr < need_eq; ++eqr; } selj[j] = s; nsel += s ? 1 : 0; }
    int tot_sel; int pos = block_excl_scan(nsel, sm, F.tid, tot_sel);
#pragma unroll
    for (int j = 0; j < NPT; ++j) { const int i = F.tid * NPT + j;
        if (i < n) { const int row = row0 + i;
            if (selj[j]) { const int slot = slot0 + pos; ++pos; SROW[slot] = row; SG[slot] = __uint_as_float(key[j]); SEL[(size_t)row * 16 + e] = slot; }
            else SEL[(size_t)row * 16 + e] = -1; } }
    __syncthreads();
}
__device__ __forceinline__ void p_topk(Frame& F, bool with_ctx) {
    const int npairs = 128 + (with_ctx ? 128 : 0);
    for (int pi = F.bid; pi < npairs; pi += F.G) {
        if (pi < 128) { const int b = pi >> 4, e = pi & 15; topk_pair<8>(F, b * SEQ, SEQ, CAPL, e, e * SLOT_E + b * CAPL); }
        else { const int p2 = pi - 128, b = p2 >> 4, e = p2 & 15; topk_pair<1>(F, RL + b * CTXL, CTXL, CAPC, e, e * SLOT_E + 4096 + b * CAPC); }
    }
}
__device__ __forceinline__ void p_gather(Frame& F, bool with_ctx) {
    const int gw = F.bid * NWAVES + F.wave, NGW = F.G * NWAVES; const bf16* H = WSP(bf16, WS_H); bf16* XG = WSP(bf16, WS_XG); const int* SROW = WSP(int, WS_SROW);
    for (int s = gw; s < NSLOT; s += NGW) { if (!with_ctx && (s % SLOT_E) >= 4096) continue;
        const int row = SROW[s]; const u32x4* src = (const u32x4*)(H + (size_t)row * DM); u32x4* dst = (u32x4*)(XG + (size_t)s * DM);
        dst[F.lane] = src[F.lane]; dst[F.lane + 64] = src[F.lane + 64]; }
}

template <int PH> __global__ void __launch_bounds__(NTHREADS, 2) fwd_kernel(Params P) {
    extern __shared__ __attribute__((aligned(16))) unsigned char lds_raw[];
    Frame F; F.lds = (LAS unsigned char*)lds_raw; F.tid = threadIdx.x; F.lane = F.tid & 63; F.wave = __builtin_amdgcn_readfirstlane(F.tid >> 6); F.G = gridDim.x; F.bid = blockIdx.x; F.ws = P.ws;
    volatile LAS unsigned* MISC = (volatile LAS unsigned*)(F.lds + LDS_MISC);
    if (F.tid < 64) MISC[F.tid] = 0u;
    __syncthreads();
    XcdBarrier bar; bar.bar = WSP(unsigned, WS_CTL) + CW_BAR; bar.x = 0; bar.st = MISC + 8;
    if constexpr (PH < 0) bar = xcd_barrier_post(WSP(unsigned, WS_CTL) + CW_BAR, MISC + 8);
#define IN(k) (PH < 0 || PH == (k))
#define REFRESH() do { int t_ = threadIdx.x; asm volatile("" : "+v"(t_)); F.tid = t_; F.lane = t_ & 63; } while (0)
#define SEAM(k) do { if constexpr (PH < 0) xcd_barrier(bar); } while (0)

    if (IN(0)) { p_mod(P, F); p_dftgen(F); p_wconv(P, F, 0); }
    SEAM(0);
    if (IN(1)) { p_rowpass_a0(P, F); }
    SEAM(1);
    for (int l = P.l_lo; l < P.l_hi; ++l) {
        constexpr int pb = 2; const bool L0 = (l == 0);
        bf16* H = WSP(bf16, WS_H);
        if (IN(pb + 0)) { REFRESH();
            { GroupSched S; S.init(1, 128, 22, F.G, F.bid, 8, L0 ? 22 : 4, 128, 0);
              const bf16* WA = WSP(bf16, WS_WA);
              auto AD = [=](const Unit& u) { return Operands{H + (size_t)u.pm * 256 * DM, WA + (size_t)u.pn * 256 * DM, DM, DM}; };
              bf16* KQ = WSP(bf16, WS_KQ); bf16* PBp = WSP(bf16, WS_PB); bf16* GB = WSP(bf16, WS_GB);
              auto E = [=](EPI_ARGS) { const int row0 = u.pm * 256;
                  if (u.pn < 8) { EPI_FOR( st_bf4(KQ + (size_t)(row0 + r) * 2048 + u.pn * 256 + c, v); ) }
                  else if (u.pn < 10) { EPI_FOR( st_bf4(PBp + (size_t)(row0 + r) * 512 + (u.pn - 8) * 256 + c, v); ) }
                  else { EPI_FOR( f32x4 s; s[0] = sigmoidf_(v[0]); s[1] = sigmoidf_(v[1]); s[2] = sigmoidf_(v[2]); s[3] = sigmoidf_(v[3]); st_bf4(GB + (size_t)(row0 + r) * 3072 + (u.pn - 10) * 256 + c, s); ) } };
              GEMM(S, AD, E, DM, DM, DM); }
            { GroupSched S; S.init(1, 8, 128, F.G, F.bid, L0 ? 8 : 4, 8, L0 ? 0 : 4, 128);
              const bf16* WFV = WSP(bf16, WS_WFV);
              auto AD = [=](const Unit& u) { return Operands{WFV + (size_t)u.pm * 256 * DM, H + (size_t)u.pn * 256 * DM, DM, DM}; };
              bf16* YT = WSP(bf16, WS_YT); bf16* VT = WSP(bf16, WS_VT);
              auto E = [=](EPI_ARGS) { bf16* T = (u.pm < 4) ? YT : VT; const int rr0 = (u.pm & 3) * 256;
                  if (u.pn < 128) { const int b = u.pn >> 4, l0 = (u.pn & 15) * 256; EPI_FOR( st_bf4(T + ((size_t)b * 1024 + rr0 + r) * 4096 + l0 + c, v); ) }
                  else { const int b = u.pn - 128; EPI_FOR( st_bf4(T + YT_CTX_OFF + ((size_t)b * 1024 + rr0 + r) * 256 + c, v); ) } };
              GEMM(S, AD, E, DM, DM, DM); }
        }
        SEAM(pb + 0);
        if (IN(pb + 1)) { REFRESH();
            p_attn_naive(P, F, l, L0);
            __syncthreads();
            { GroupSched S; S.init(1, 16, 16, F.G, F.bid);
              const bf16* DFTM = WSP(bf16, WS_DFTM); const bf16* YT = WSP(bf16, WS_YT); bf16* FOUR = WSP(bf16, WS_FOUR);
              auto AD = [=](const Unit& u) { return Operands{DFTM + (size_t)u.pm * 256 * 8192, YT + (size_t)u.pn * 256 * 8192, 8192, 8192}; };
              auto E = [=](EPI_ARGS) { const int b = u.pn >> 1, c0 = (u.pn & 1) * 256; const float sc = 0.0013810679320049757f;
                  EPI_FOR( st_bf4(FOUR + ((size_t)b * SEQ + u.pm * 256 + r) * 512 + c0 + c, v * sc); ) };
              GEMM(S, AD, E, 8192, 8192, 8192); }
            if (L0) { GroupSched S; S.init(1, 1, 16, F.G, F.bid);
              const bf16* DFTC = WSP(bf16, WS_DFTC); const bf16* YTC = WSP(bf16, WS_YT) + YT_CTX_OFF; bf16* FOUR = WSP(bf16, WS_FOUR);
              auto AD = [=](const Unit& u) { return Operands{DFTC, YTC + (size_t)u.pn * 256 * 512, 512, 512}; };
              auto E = [=](EPI_ARGS) { const int b = u.pn >> 1, c0 = (u.pn & 1) * 256; const float sc = 0.005524271728019903f;
                  EPI_FOR( st_bf4(FOUR + ((size_t)RL + b * CTXL + r) * 512 + c0 + c, v * sc); ) };
              GEMM(S, AD, E, 512, 512, 512); }
            p_pool(F, L0 ? RT : RL);
        }
        SEAM(pb + 1);
        if (IN(pb + 2)) { REFRESH();
            const int nM = L0 ? 136 : 128; float* MRG = WSP(float, WS_MRG); const bf16* GB = WSP(bf16, WS_GB);
            { GroupSched S; S.init(1, nM, 4, F.G, F.bid); const bf16* A = WSP(bf16, WS_ATT); const bf16* W = WSP(bf16, WS_WAO);
              auto AD = [=](const Unit& u) { return Operands{A + (size_t)u.pm * 256 * 1024, W + (size_t)u.pn * 256 * 1024, 1024, 1024}; };
              auto E = [=](EPI_ARGS) { EPI_FOR( const size_t row = (size_t)u.pm * 256 + r; const int col = u.pn * 256 + c; const u32x2 g = *(const u32x2*)(GB + row * 3072 + col);
                  f32x4 o; o[0] = bflo(g.x) * v[0]; o[1] = bfhi(g.x) * v[1]; o[2] = bflo(g.y) * v[2]; o[3] = bfhi(g.y) * v[3]; *(f32x4*)(MRG + row * 1024 + col) = o; ) };
              GEMM(S, AD, E, 1024, 1024, 1024); }
            { GroupSched S; S.init(1, nM, 4, F.G, F.bid); const bf16* A = WSP(bf16, WS_FOUR); const bf16* W = WSP(bf16, WS_WFO);
              auto AD = [=](const Unit& u) { return Operands{A + (size_t)u.pm * 256 * 512, W + (size_t)u.pn * 256 * 512, 512, 512}; };
              auto E = [=](EPI_ARGS) { EPI_FOR( const size_t row = (size_t)u.pm * 256 + r; const int col = u.pn * 256 + c; const u32x2 g = *(const u32x2*)(GB + row * 3072 + 1024 + col);
                  f32x4 o = *(const f32x4*)(MRG + row * 1024 + col); o[0] += bflo(g.x) * v[0]; o[1] += bfhi(g.x) * v[1]; o[2] += bflo(g.y) * v[2]; o[3] += bfhi(g.y) * v[3]; *(f32x4*)(MRG + row * 1024 + col) = o; ) };
              GEMM(S, AD, E, 512, 512, 512); }
            { GroupSched S; S.init(1, nM, 4, F.G, F.bid); const bf16* A = WSP(bf16, WS_POOL); const bf16* W = WSP(bf16, WS_WPO); bf16* MRGB = WSP(bf16, WS_MRGB);
              const float* ps = P.pool_scale + l * 1024;
              auto AD = [=](const Unit& u) { return Operands{A + (size_t)u.pm * 256 * 512 + (u.pn >> 1) * 256, W + (size_t)u.pn * 256 * 256, 512, 256}; };
              auto E = [=](EPI_ARGS) { EPI_FOR( const size_t row = (size_t)u.pm * 256 + r; const int col = u.pn * 256 + c; const u32x2 g = *(const u32x2*)(GB + row * 3072 + 2048 + col);
                  const f32x4 pv = *(const f32x4*)(ps + col); f32x4 o = *(const f32x4*)(MRG + row * 1024 + col);
                  o[0] += bflo(g.x) * pv[0] * v[0]; o[1] += bfhi(g.x) * pv[1] * v[1]; o[2] += bflo(g.y) * pv[2] * v[2]; o[3] += bfhi(g.y) * pv[3] * v[3]; st_bf4(MRGB + row * 1024 + col, o); ) };
              GEMM(S, AD, E, 256, 512, 256); }
        }
        SEAM(pb + 2);
        if (IN(pb + 3)) { REFRESH();
            GroupSched S; S.init(1, L0 ? 136 : 128, 4, F.G, F.bid); const bf16* A = WSP(bf16, WS_MRGB); const bf16* W = WSP(bf16, WS_WOUT);
            const float* xin = L0 ? P.x : P.out; const float* cin = L0 ? P.ctx : WSP(float, WS_XC); float* xo = P.out; float* co = WSP(float, WS_XC);
            const float* MOD = WSP(float, WS_MOD) + (size_t)l * 9 * 6144;
            auto AD = [=](const Unit& u) { return Operands{A + (size_t)u.pm * 256 * 1024, W + (size_t)u.pn * 256 * 1024, 1024, 1024}; };
            auto E = [=](EPI_ARGS) { EPI_FOR( const int row = u.pm * 256 + r; const int col = u.pn * 256 + c; const int mr = row < RL ? (row >> 12) : 8;
                const f32x4 g = *(const f32x4*)(MOD + (size_t)mr * 6144 + 2048 + col);
                const float* src = row < RL ? xin + (size_t)row * DM + col : cin + (size_t)(row - RL) * DM + col; float* dst = row < RL ? xo + (size_t)row * DM + col : co + (size_t)(row - RL) * DM + col;
                *(f32x4*)dst = *(const f32x4*)src + g * v; ) };
            GEMM(S, AD, E, 1024, 1024, 1024);
        }
        SEAM(pb + 3);
        if (IN(pb + 4)) { REFRESH(); p_rowpass_f(P, F, l, L0 ? RT : RL); }
        SEAM(pb + 4);
        if (IN(pb + 5)) { REFRESH(); p_topk(F, L0); }
        SEAM(pb + 5);
        if (IN(pb + 6)) { REFRESH(); p_gather(F, L0); }
        SEAM(pb + 6);
        if (IN(pb + 7)) { REFRESH();
            GroupSched S; S.init(16, L0 ? 17 : 16, 22, F.G, F.bid); const bf16* XG = WSP(bf16, WS_XG); const bf16* W = WSP(bf16, WS_WGU); bf16* HID = WSP(bf16, WS_HID);
            auto AD = [=](const Unit& u) { return Operands{XG + ((size_t)u.grp * SLOT_E + u.pm * 256) * DM, W + ((size_t)u.grp * 5632 + u.pn * 256) * DM, DM, DM}; };
            auto E = [=](EPI_ARGS) {
#pragma unroll
                for (int ai = 0; ai < 2; ++ai)
#pragma unroll
                    for (int m = 0; m < 4; ++m) { const size_t slot = (size_t)u.grp * SLOT_E + u.pm * 256 + ai * 128 + wr * 64 + m * 16 + fr;
#pragma unroll
                        for (int n = 0; n < 2; ++n) { const f32x4 a = acc[ai][0][m][n], up = acc[ai][1][m][n]; f32x4 o;
#pragma unroll
                            for (int j = 0; j < 4; ++j) o[j] = a[j] * sigmoidf_(a[j]) * up[j];
                            st_bf4(HID + slot * FF + u.pn * 128 + wc * 32 + n * 16 + 4 * fq, o); } } };
            GEMM(S, AD, E, DM, DM, DM);
        }
        SEAM(pb + 7);
        if (IN(pb + 8)) { REFRESH();
            GroupSched S; S.init(16, L0 ? 17 : 16, 4, F.G, F.bid); const bf16* HID = WSP(bf16, WS_HID); const bf16* W = WSP(bf16, WS_WD); bf16* Y = WSP(bf16, WS_Y); const float* SG = WSP(float, WS_SGATE);
            auto AD = [=](const Unit& u) { return Operands{HID + ((size_t)u.grp * SLOT_E + u.pm * 256) * FF, W + ((size_t)u.grp * 1024 + u.pn * 256) * FF, FF, FF}; };
            auto E = [=](EPI_ARGS) { EPI_FOR( const size_t slot = (size_t)u.grp * SLOT_E + u.pm * 256 + r; const float gt = SG[slot]; st_bf4(Y + slot * DM + u.pn * 256 + c, v * gt); ) };
            GEMM(S, AD, E, FF, FF, FF);
        }
        SEAM(pb + 8);
        if (IN(pb + 9)) { REFRESH(); p_rowpass_k(P, F, l, L0 ? RT : RL); if (L0) p_wconv(P, F, 1); }
        if (L0) SEAM(pb + 9);
    }
#undef IN
#undef SEAM
}
template <int PH> static void launch_ph(int grid, const Params& p, hipStream_t stream) { hipLaunchKernelGGL(fwd_kernel<PH>, dim3(grid), dim3(NTHREADS), LDS_BYTES, stream, p); }
template <int PH> static bool set_attr() { return hipFuncSetAttribute((const void*)fwd_kernel<PH>, hipFuncAttributeMaxDynamicSharedMemorySize, LDS_BYTES) == hipSuccess; }

extern "C" void kernel_launch(void* const* d_in, const int* in_sizes, int n_in, void* d_out, int out_size, void* d_ws, size_t ws_size, hipStream_t stream) {
    static int grid = 0;
    if (grid == 0) {
        if (n_in != 20 || out_size != RL * DM || ws_size < WS_END) { fprintf(stderr, "kernel_launch: unexpected shapes (n_in %d out %d ws %zu need %zu)\n", n_in, out_size, ws_size, (size_t)WS_END); grid = -1; return; }
        int dev = 0, cus = 0, per_cu = 0;
        if (hipGetDevice(&dev) != hipSuccess || hipDeviceGetAttribute(&cus, hipDeviceAttributeMultiprocessorCount, dev) != hipSuccess) { grid = -1; return; }
#if N_LAUNCH_MODE == 1
        if (!set_attr<-1>()) { fprintf(stderr, "kernel_launch: hipFuncSetAttribute failed\n"); grid = -1; return; }
        if (hipOccupancyMaxActiveBlocksPerMultiprocessor(&per_cu, (const void*)fwd_kernel<-1>, NTHREADS, LDS_BYTES) != hipSuccess || per_cu < 1) fprintf(stderr, "kernel_launch: occupancy query reports %d\n", per_cu);
#else
        if (!(set_attr<0>() && set_attr<1>() && set_attr<2>() && set_attr<3>() && set_attr<4>() && set_attr<5>() && set_attr<6>() && set_attr<7>() && set_attr<8>() && set_attr<9>() && set_attr<10>() && set_attr<11>())) { fprintf(stderr, "kernel_launch: hipFuncSetAttribute failed\n"); grid = -1; return; }
        (void)per_cu;
#endif
        (void)hipGetLastError();
        grid = cus;
    }
    if (grid < 0) return;
    if (hipMemsetAsync((char*)d_ws + WS_CTL, 0, CTL_BYTES, stream) != hipSuccess) return;
    Params p{};
    const float** pp = (const float**)&p;
    for (int i = 0; i < 20; ++i) pp[i] = (const float*)d_in[i];
    p.out = (float*)d_out; p.ws = (unsigned char*)d_ws;
#if N_LAUNCH_MODE == 1
    p.l_lo = 0; p.l_hi = 2;
    launch_ph<-1>(grid, p, stream);
#else
    p.l_lo = 0; p.l_hi = 0; launch_ph<0>(grid, p, stream); launch_ph<1>(grid, p, stream);
    for (int l = 0; l < 2; ++l) { p.l_lo = l; p.l_hi = l + 1;
        launch_ph<2>(grid, p, stream); launch_ph<3>(grid, p, stream); launch_ph<4>(grid, p, stream); launch_ph<5>(grid, p, stream); launch_ph<6>(grid, p, stream);
        launch_ph<7>(grid, p, stream); launch_ph<8>(grid, p, stream); launch_ph<9>(grid, p, stream); launch_ph<10>(grid, p, stream); launch_ph<11>(grid, p, stream); }
#endif
}
```

```cpp
#include <hip/hip_runtime.h>
#include <cstdio>
#include <cstdint>

#ifndef N_LAUNCH_MODE
#define N_LAUNCH_MODE 1
#endif

#define GAS __attribute__((address_space(1)))
#define LAS __attribute__((address_space(3)))
typedef unsigned short bf16;
typedef short bf16x8 __attribute__((ext_vector_type(8)));
typedef float f32x4 __attribute__((ext_vector_type(4)));
typedef unsigned u32x4 __attribute__((ext_vector_type(4)));
typedef unsigned u32x2 __attribute__((ext_vector_type(2)));

constexpr int NB = 8, SEQ = 4096, DM = 1024, CTXL = 256, NH = 16, HD = 64, GRIDW = 64;
constexpr int RL = NB * SEQ, RC = NB * CTXL, RT = RL + RC;
constexpr int INW = 7168, NE = 16, FF = 2816, CAPL = 512, CAPC = 32;
constexpr int SLOT_E = 4352, NSLOT = NE * SLOT_E;
constexpr float RMS_EPS = 1e-6f;
constexpr int NWAVES = 8, NTHREADS = 512;

constexpr size_t al256(size_t x) { return (x + 255) & ~(size_t)255; }
constexpr size_t WS_CTL = 0, CTL_BYTES = 1u << 20;
constexpr size_t WS_MOD = WS_CTL + CTL_BYTES;
constexpr size_t WS_XC = al256(WS_MOD + (size_t)2 * 9 * 6144 * 4);
constexpr size_t WS_AFF = al256(WS_XC + (size_t)RC * DM * 4);
constexpr size_t WS_SROW = al256(WS_AFF + (size_t)RT * 16 * 4);
constexpr size_t WS_SGATE = al256(WS_SROW + (size_t)NSLOT * 4);
constexpr size_t WS_SEL = al256(WS_SGATE + (size_t)NSLOT * 4);
constexpr size_t WS_DFTM = al256(WS_SEL + (size_t)RT * 16 * 4);
constexpr size_t WS_DFTC = al256(WS_DFTM + (size_t)4096 * 8192 * 2);
constexpr size_t WS_WA = al256(WS_DFTC + (size_t)256 * 512 * 2);
constexpr size_t WS_WFV = al256(WS_WA + (size_t)5632 * 1024 * 2);
constexpr size_t WS_WAO = al256(WS_WFV + (size_t)2048 * 1024 * 2);
constexpr size_t WS_WFO = al256(WS_WAO + (size_t)1024 * 1024 * 2);
constexpr size_t WS_WPO = al256(WS_WFO + (size_t)1024 * 512 * 2);
constexpr size_t WS_WOUT = al256(WS_WPO + (size_t)1024 * 256 * 2);
constexpr size_t WS_WGU = al256(WS_WOUT + (size_t)1024 * 1024 * 2);
constexpr size_t WS_WD = al256(WS_WGU + (size_t)16 * 5632 * 1024 * 2);
constexpr size_t WS_H = al256(WS_WD + (size_t)16 * 1024 * 2816 * 2);
constexpr size_t WS_R = al256(WS_H + (size_t)RT * DM * 2);
constexpr size_t WS_KQ = WS_R;
constexpr size_t WS_MRG = WS_KQ;
constexpr size_t WS_PB = al256(WS_KQ + (size_t)RT * 2048 * 2);
constexpr size_t WS_GB = al256(WS_PB + (size_t)RT * 512 * 2);
constexpr size_t WS_YT = al256(WS_GB + (size_t)RT * 3072 * 2);
constexpr size_t WS_MRGB = WS_YT;
constexpr size_t WS_VT = al256(WS_YT + (size_t)RT * 1024 * 2);
constexpr size_t WS_FOUR = al256(WS_VT + (size_t)RT * 1024 * 2);
constexpr size_t WS_ATT = al256(WS_FOUR + (size_t)RT * 512 * 2);
constexpr size_t WS_POOL = al256(WS_ATT + (size_t)RT * 1024 * 2);
constexpr size_t WS_MIX_END = al256(WS_POOL + (size_t)RT * 512 * 2);
constexpr size_t WS_XG = WS_R;
constexpr size_t WS_HID = al256(WS_XG + (size_t)NSLOT * 1024 * 2);
constexpr size_t WS_Y = al256(WS_HID + (size_t)NSLOT * 2816 * 2);
constexpr size_t WS_MOE_END = al256(WS_Y + (size_t)NSLOT * 1024 * 2);
constexpr size_t WS_END = WS_MIX_END > WS_MOE_END ? WS_MIX_END : WS_MOE_END;
constexpr size_t YT_CTX_OFF = (size_t)8 * 1024 * 4096;

constexpr int CW_BAR = 4096;

constexpr int LDS_BYTES = 147456;
constexpr int LDS_MISC = 131072;

__device__ __forceinline__ unsigned f2bf(float f) { unsigned u = __float_as_uint(f); return (u + 0x7fffu + ((u >> 16) & 1u)) >> 16; }
__device__ __forceinline__ unsigned pk2(float lo, float hi) { return f2bf(lo) | (f2bf(hi) << 16); }
__device__ __forceinline__ float bf2f(unsigned b) { return __uint_as_float(b << 16); }
__device__ __forceinline__ float bflo(unsigned w) { return __uint_as_float(w << 16); }
__device__ __forceinline__ float bfhi(unsigned w) { return __uint_as_float(w & 0xffff0000u); }
__device__ __forceinline__ float wave_sum(float v) {
#pragma unroll
    for (int o = 1; o < 64; o <<= 1) v += __shfl_xor(v, o);
    return v;
}
__device__ __forceinline__ float wave_max(float v) {
#pragma unroll
    for (int o = 1; o < 64; o <<= 1) v = fmaxf(v, __shfl_xor(v, o));
    return v;
}
__device__ __forceinline__ float sigmoidf_(float x) { return 1.f / (1.f + __expf(-x)); }
#define LDS_WAIT() asm volatile("s_waitcnt lgkmcnt(0)" ::: "memory")

#define XB_TMO      128
#define XB_XCNT(j)  (256  + 64 * (j))
#define XB_XSUB(j)  (1280 + 64 * (j))
#define XB_XGEN(j)  (2304 + 64 * (j))
#define XB_TOP      3328
#define XB_TOPGEN   3392
#define XCD_BAR_WORDS 3456
#define XB_SPIN_CAP (1u << 22)

__device__ __forceinline__ unsigned xb_ld(unsigned* p)              { return __hip_atomic_load(p, __ATOMIC_RELAXED, __HIP_MEMORY_SCOPE_AGENT); }
__device__ __forceinline__ unsigned xb_add(unsigned* p, unsigned v) { return __hip_atomic_fetch_add(p, v, __ATOMIC_RELAXED, __HIP_MEMORY_SCOPE_AGENT); }
__device__ __forceinline__ unsigned xb_xcc_id() { return (unsigned)__builtin_amdgcn_s_getreg((3 << 11) | 20) & 0xFu; }
#define XB_SPIN(cond, bar) do { unsigned _sp = 0; while (cond) { __builtin_amdgcn_s_sleep(1); \
    if ((++_sp & 255u) == 0u) { if (xb_ld(&(bar)[XB_TMO])) break; if (_sp > XB_SPIN_CAP) { atomicAdd(&(bar)[XB_TMO], 1u); break; } } } } while (0)

struct XcdBarrier { unsigned* bar; unsigned x; volatile LAS unsigned* st; };

__device__ __forceinline__ XcdBarrier xcd_barrier_post(unsigned* bar, volatile LAS unsigned* st) {
    XcdBarrier b; b.bar = bar; b.x = xb_xcc_id(); b.st = st;
    if (threadIdx.x == 0) (void)xb_add(&bar[XB_XCNT(b.x)], 1u);
    return b;
}
__device__ __forceinline__ void xcd_barrier_complete(unsigned* bar, unsigned x, unsigned& nloc, unsigned& nx) {
    const unsigned G = gridDim.x * gridDim.y * gridDim.z;
    unsigned sum, cnt, mine, sp = 0u;
    for (;;) {
        sum = 0u; cnt = 0u; mine = 0u;
#pragma unroll
        for (unsigned j = 0; j < 16; ++j) { const unsigned c = xb_ld(&bar[XB_XCNT(j)]); sum += c; cnt += (c > 0u) ? 1u : 0u; mine = (j == x) ? c : mine; }
        if (sum == G) break;
        __builtin_amdgcn_s_sleep(1);
        if ((++sp & 255u) == 0u) { if (xb_ld(&bar[XB_TMO])) break; if (sp > XB_SPIN_CAP) { atomicAdd(&bar[XB_TMO], 1u); break; } }
    }
    nloc = mine > 0u ? mine : 1u; nx = cnt > 0u ? cnt : 1u;
}
__device__ __forceinline__ void xcd_barrier(const XcdBarrier& b) {
    asm volatile("s_waitcnt vmcnt(0)" ::: "memory");
    __syncthreads();
    if (threadIdx.x == 0) {
        unsigned* bar = b.bar;
        __builtin_amdgcn_s_waitcnt(0);
        unsigned nloc = b.st[0], nx = b.st[1];
        if (nloc == 0u) { xcd_barrier_complete(bar, b.x, nloc, nx); b.st[0] = nloc; b.st[1] = nx; }
        const unsigned old = xb_add(&bar[XB_XSUB(b.x)], 1u);
        const unsigned gen = old / nloc;
        if (old + 1u == (gen + 1u) * nloc) {
            __builtin_amdgcn_fence(__ATOMIC_RELEASE, "agent");
            asm volatile("s_waitcnt vmcnt(0)" ::: "memory");
            const unsigned og = xb_add(&bar[XB_TOP], 1u);
            const unsigned tg = og / nx;
            if (og + 1u == (tg + 1u) * nx) xb_add(&bar[XB_TOPGEN], 1u);
            else XB_SPIN(xb_ld(&bar[XB_TOPGEN]) == tg, bar);
            __builtin_amdgcn_fence(__ATOMIC_ACQUIRE, "agent");
            xb_add(&bar[XB_XGEN(b.x)], 1u);
            asm volatile("s_waitcnt vmcnt(0)" ::: "memory");
        } else {
            XB_SPIN(xb_ld(&bar[XB_XGEN(b.x)]) == gen, bar);
            __builtin_amdgcn_fence(__ATOMIC_ACQUIRE, "agent");
            asm volatile("s_waitcnt vmcnt(0)" ::: "memory");
        }
    }
    __syncthreads();
}

struct Params {
    const float *x, *c, *ctx, *c_ctx, *ada_w, *ada_b, *norm1_g, *norm2_g, *w_in, *rpb, *w_att_o, *w_fourier, *w_pool, *pool_scale, *w_out, *w_router, *w_eg, *w_eu, *w_ed, *final_g;
    float* out; unsigned char* ws; int l_lo, l_hi;
};
struct Frame {
    LAS unsigned char* lds;
    int tid, lane, wave, G, bid;
    unsigned char* ws;
};
#define WSP(T, off) ((T*)(F.ws + (off)))

struct Unit { int grp, pm, pn; };
struct GroupSched {
    int ng, nM, nN, G, c; int tM, tN, tpm0, tpn0;
    __device__ __forceinline__ void init(int ng_, int nM_, int nN_, int G_, int c_, int tM_ = 0, int tN_ = 0, int tpm0_ = 0, int tpn0_ = 0) { ng = ng_; nM = nM_; nN = nN_; G = G_; c = c_; tM = tM_; tN = tN_; tpm0 = tpm0_; tpn0 = tpn0_; }
    __device__ __forceinline__ bool next(int i, Unit& u) const {
        const int per = nM * nN; const int L = i * G + c;
        if (L < ng * per) {
            u.grp = L / per; int wgid = L - u.grp * per;
            { const int q = per / 8, r = per % 8, xcd = wgid % 8, off = wgid / 8; wgid = (xcd < r ? xcd * (q + 1) : r * (q + 1) + (xcd - r) * q) + off; }
            const int nig = 8 * nN, gid = wgid / nig, fm = gid * 8, gsz = (nM - fm) < 8 ? (nM - fm) : 8;
            u.pm = fm + ((wgid % nig) % gsz); u.pn = (wgid % nig) / gsz; return true;
        }
        const int w = L - ng * per;
        if (w < tM * tN) { u.grp = ng; u.pm = tpm0 + (w % tM); u.pn = tpn0 + (w / tM); return true; }
        return false;
    }
};
struct Operands { const bf16* A; const bf16* Bt; int lda, ldb; };

template <class Addr, class Epi>
__device__ __forceinline__ void gemm_simple(const GroupSched& S, const Addr& AD, const Epi& E, int K) {
    const int tid = threadIdx.x, wid = __builtin_amdgcn_readfirstlane(tid >> 6), lane = tid & 63, wr = wid >> 2, wc = wid & 3, fr = lane & 15, fq = lane >> 4;
    Unit u;
    for (int i = 0; S.next(i, u); ++i) {
        const Operands op = AD(u);
        f32x4 acc[2][2][4][2];
#pragma unroll
        for (int a = 0; a < 2; ++a)
#pragma unroll
            for (int b = 0; b < 2; ++b)
#pragma unroll
                for (int m = 0; m < 4; ++m)
#pragma unroll
                    for (int n = 0; n < 2; ++n) acc[a][b][m][n] = (f32x4){0.f, 0.f, 0.f, 0.f};
        const bf16* ap = op.A + (size_t)(wr * 64 + fr) * op.lda + fq * 8;
        const bf16* bp = op.Bt + (size_t)(wc * 32 + fr) * op.ldb + fq * 8;
#pragma unroll 1
        for (int k = 0; k < K; k += 32) {
            bf16x8 bfr[2][2];
#pragma unroll
            for (int b = 0; b < 2; ++b)
#pragma unroll
                for (int n = 0; n < 2; ++n) bfr[b][n] = *(const bf16x8*)(bp + (size_t)(b * 128 + n * 16) * op.ldb + k);
#pragma unroll
            for (int a = 0; a < 2; ++a) {
                bf16x8 af[4];
#pragma unroll
                for (int m = 0; m < 4; ++m) af[m] = *(const bf16x8*)(ap + (size_t)(a * 128 + m * 16) * op.lda + k);
#pragma unroll
                for (int b = 0; b < 2; ++b)
#pragma unroll
                    for (int m = 0; m < 4; ++m)
#pragma unroll
                        for (int n = 0; n < 2; ++n) acc[a][b][m][n] = __builtin_amdgcn_mfma_f32_16x16x32_bf16(bfr[b][n], af[m], acc[a][b][m][n], 0, 0, 0);
            }
        }
        E(acc, u, wr, wc, fr, fq);
    }
}
constexpr int HTB = 128 * 64 * 2;
__device__ __forceinline__ int lds_byte(int r, int c) { const int st = (r >> 4) * 2 + (c >> 5), rr = r & 15, cc = c & 31, ob = rr * 64 + cc * 2; return st * 1024 + (ob ^ (((ob >> 9) & 1) << 5)); }
__device__ __forceinline__ void stage_rc(int b, int& R, int& C) { const int st = b / 1024, sb = b % 1024, swz = sb ^ (((sb >> 9) & 1) << 5); R = (st >> 1) * 16 + swz / 64; C = (st & 1) * 32 + (swz % 64) / 2; }
template <class Addr, class Epi>
__device__ __forceinline__ void gemm_fast(LAS unsigned char* lds, const int tid, const GroupSched& S, const Addr& AD, const Epi& E, const int K, const int lda, const int ldb) {
    const int wid = __builtin_amdgcn_readfirstlane(tid >> 6), lane = tid & 63, wr = wid >> 2, wc = wid & 3, fr = lane & 15, fq = lane >> 4;
    const int nt = K / 64;
    unsigned voffA[2], voffB[2];
#pragma unroll
    for (int i = 0; i < 2; ++i) { int R, C; stage_rc(tid * 16 + i * 8192, R, C); voffA[i] = (unsigned)(R * lda + C) * 2u; voffB[i] = (unsigned)(R * ldb + C) * 2u; }
    const size_t kstep = 128;
    const size_t hstepA = (size_t)128 * lda * 2, hstepB = (size_t)128 * ldb * 2;
    const unsigned ldsw = (unsigned)wid * 1024u;
    const int aoff = lds_byte(wr * 64 + fr, fq * 8), boff = lds_byte(wc * 32 + fr, fq * 8);
#define PG8_SA(b, h) (((b) * 2 + (h)) * HTB)
#define PG8_SB(b, h) ((4 + (b) * 2 + (h)) * HTB)
#define PG8_STAGE(bufoff, gbase, voff) do { _Pragma("unroll") for (int _i = 0; _i < 2; ++_i) \
        __builtin_amdgcn_global_load_lds((const unsigned*)((const char*)(gbase) + (voff)[_i]), (LAS unsigned*)(lds + (bufoff) + ldsw + _i * 8192), 16, 0, 0); } while (0)
#define PG8_LDA(dst, b, h) do { _Pragma("unroll") for (int m = 0; m < 4; ++m) _Pragma("unroll") for (int k = 0; k < 2; ++k) dst[m][k] = *(const LAS bf16x8*)(lds + PG8_SA(b, h) + aoff + m * 2048 + k * 1024); } while (0)
#define PG8_LDB(dst, b, h) do { _Pragma("unroll") for (int n = 0; n < 2; ++n) _Pragma("unroll") for (int k = 0; k < 2; ++k) dst[n][k] = *(const LAS bf16x8*)(lds + PG8_SB(b, h) + boff + n * 2048 + k * 1024); } while (0)
#define PG8_MMA(ai, bj, At, Bt) do { __builtin_amdgcn_s_setprio(1); _Pragma("unroll") for (int m = 0; m < 4; ++m) _Pragma("unroll") for (int n = 0; n < 2; ++n) _Pragma("unroll") for (int k = 0; k < 2; ++k) \
        acc[ai][bj][m][n] = __builtin_amdgcn_mfma_f32_16x16x32_bf16(Bt[n][k], At[m][k], acc[ai][bj][m][n], 0, 0, 0); __builtin_amdgcn_s_setprio(0); } while (0)
#define PG8_WAIT_V(n) asm volatile("s_waitcnt vmcnt(" #n ")" ::: "memory")
#define PG8_WAIT_L(n) asm volatile("s_waitcnt lgkmcnt(" #n ")" ::: "memory")
#define PG8_BAR __builtin_amdgcn_s_barrier()
#define PG8_SCHED __builtin_amdgcn_sched_barrier(0)
    Unit cur, nxt; int ui = 0;
    if (!S.next(0, cur)) return;
    f32x4 acc[2][2][4][2];
#pragma unroll
    for (int a = 0; a < 2; ++a)
#pragma unroll
        for (int b = 0; b < 2; ++b)
#pragma unroll
            for (int m = 0; m < 4; ++m)
#pragma unroll
                for (int n = 0; n < 2; ++n) acc[a][b][m][n] = (f32x4){0.f, 0.f, 0.f, 0.f};
    bf16x8 At[4][2], B0[2][2], B1[2][2];
    const char* cA; const char* cB;
    { const Operands op = AD(cur); cA = (const char*)op.A; cB = (const char*)op.Bt; }
    PG8_STAGE(PG8_SB(0, 0), cB, voffB); PG8_STAGE(PG8_SB(0, 1), cB + hstepB, voffB); PG8_STAGE(PG8_SA(0, 0), cA, voffA); PG8_STAGE(PG8_SA(0, 1), cA + hstepA, voffA);
    if (wr == 1) PG8_BAR;
    PG8_WAIT_V(2); PG8_BAR;
    PG8_STAGE(PG8_SB(1, 0), cB + kstep, voffB); PG8_STAGE(PG8_SA(1, 0), cA + kstep, voffA); PG8_STAGE(PG8_SB(1, 1), cB + hstepB + kstep, voffB);
    PG8_WAIT_V(6); PG8_BAR;
    for (;;) {
        const bool has_next = S.next(ui + 1, nxt);
        const char* nA = cA; const char* nB = cB;
        if (has_next) { const Operands op = AD(nxt); nA = (const char*)op.A; nB = (const char*)op.Bt; }
#pragma unroll 1
        for (int t = 0; t < nt; t += 2) {
            const bool last = (t == nt - 2);
            const char* a1 = cA + (size_t)(t + 1) * kstep;
            const char* a2 = last ? nA : cA + (size_t)(t + 2) * kstep; const char* b2 = last ? nB : cB + (size_t)(t + 2) * kstep;
            const char* a3 = a2 + kstep; const char* b3 = b2 + kstep;
            PG8_LDB(B0, 0, 0); PG8_LDB(B1, 0, 1); PG8_SCHED; PG8_LDA(At, 0, 0); PG8_STAGE(PG8_SA(1, 1), a1 + hstepA, voffA);
            PG8_WAIT_V(8); PG8_WAIT_L(0); PG8_BAR; PG8_MMA(0, 0, At, B0); PG8_MMA(0, 1, At, B1); PG8_BAR; PG8_SCHED;
            PG8_LDA(At, 0, 1); PG8_STAGE(PG8_SB(0, 0), b2, voffB); PG8_STAGE(PG8_SB(0, 1), b2 + hstepB, voffB); PG8_STAGE(PG8_SA(0, 0), a2, voffA);
            PG8_WAIT_V(8); PG8_WAIT_L(0); PG8_BAR; PG8_MMA(1, 0, At, B0); PG8_MMA(1, 1, At, B1); PG8_BAR; PG8_SCHED;
            PG8_LDB(B0, 1, 0); PG8_LDB(B1, 1, 1); PG8_SCHED; PG8_LDA(At, 1, 0); PG8_STAGE(PG8_SA(0, 1), a2 + hstepA, voffA);
            PG8_WAIT_V(8); PG8_WAIT_L(0); PG8_BAR; PG8_MMA(0, 0, At, B0); PG8_MMA(0, 1, At, B1); PG8_BAR; PG8_SCHED;
            PG8_LDA(At, 1, 1); PG8_STAGE(PG8_SB(1, 0), b3, voffB); PG8_STAGE(PG8_SB(1, 1), b3 + hstepB, voffB); PG8_STAGE(PG8_SA(1, 0), a3, voffA);
            PG8_WAIT_V(8); PG8_WAIT_L(0); PG8_BAR; PG8_MMA(1, 0, At, B0); PG8_MMA(1, 1, At, B1); PG8_BAR; PG8_SCHED;
        }
        if (wr == 0) PG8_BAR;
        { int fr2 = fr, fq2 = fq; asm volatile("" : "+v"(fr2), "+v"(fq2));
          E(acc, cur, wr, wc, fr2, fq2); }
        if (!has_next) break;
#pragma unroll
        for (int a = 0; a < 2; ++a)
#pragma unroll
            for (int b = 0; b < 2; ++b)
#pragma unroll
                for (int m = 0; m < 4; ++m)
#pragma unroll
                    for (int n = 0; n < 2; ++n) acc[a][b][m][n] = (f32x4){0.f, 0.f, 0.f, 0.f};
        cur = nxt; cA = nA; cB = nB; ++ui;
        if (wr == 1) PG8_BAR;
    }
    PG8_WAIT_V(0);
    PG8_BAR;
#undef PG8_SA
#undef PG8_SB
#undef PG8_STAGE
#undef PG8_LDA
#undef PG8_LDB
#undef PG8_MMA
#undef PG8_WAIT_V
#undef PG8_WAIT_L
#undef PG8_BAR
#undef PG8_SCHED
}
#ifndef USE_FAST
#define USE_FAST 1
#endif
#if USE_FAST
#define GEMM(S, AD, E, K, lda, ldb) gemm_fast(F.lds, F.tid, S, AD, E, K, lda, ldb)
#else
#define GEMM(S, AD, E, K, lda, ldb) gemm_simple(S, AD, E, K)
#endif
#define EPI_ARGS const f32x4 (&acc)[2][2][4][2], const Unit& u, int wr, int wc, int fr, int fq
#define EPI_FOR(BODY) _Pragma("unroll") for (int ai = 0; ai < 2; ++ai) _Pragma("unroll") for (int m = 0; m < 4; ++m) { const int r = ai * 128 + wr * 64 + m * 16 + fr; \
    _Pragma("unroll") for (int bj = 0; bj < 2; ++bj) _Pragma("unroll") for (int n = 0; n < 2; ++n) { const int c = bj * 128 + wc * 32 + n * 16 + 4 * fq; const f32x4 v = acc[ai][bj][m][n]; BODY } }
__device__ __forceinline__ void st_bf4(bf16* p, f32x4 v) { u32x2 w; w.x = pk2(v[0], v[1]); w.y = pk2(v[2], v[3]); *(u32x2*)p = w; }

__device__ __forceinline__ void p_mod(const Params& P, Frame& F) {
    LAS float* sc = (LAS float*)F.lds;
    LAS float* red = (LAS float*)(F.lds + 9 * 1024 * 4);
    float* MOD = WSP(float, WS_MOD);
    bool have = false;
    for (int it = F.bid; it < 2 * 96; it += F.G) {
        if (!have) {
            for (int i = F.tid; i < 9 * 1024; i += NTHREADS) { const int r = i >> 10, k = i & 1023; const float v = r < 8 ? P.c[r * 1024 + k] : P.c_ctx[k]; sc[i] = v * sigmoidf_(v); }
            have = true;
        }
        __syncthreads();
        const int l = it / 96, j0 = (it % 96) * 64, jj = F.tid & 63, kc = F.tid >> 6;
        const float* W = P.ada_w + (size_t)l * 1024 * 6144 + j0 + jj;
        float a[9];
#pragma unroll
        for (int r = 0; r < 9; ++r) a[r] = 0.f;
        for (int k = kc * 128; k < kc * 128 + 128; ++k) { const float w = W[(size_t)k * 6144];
#pragma unroll
            for (int r = 0; r < 9; ++r) a[r] += sc[r * 1024 + k] * w; }
#pragma unroll
        for (int r = 0; r < 9; ++r) red[(kc * 9 + r) * 64 + jj] = a[r];
        __syncthreads();
        for (int o = F.tid; o < 9 * 64; o += NTHREADS) { const int r = o >> 6, j = o & 63; float s = 0.f;
#pragma unroll
            for (int q = 0; q < 8; ++q) s += red[(q * 9 + r) * 64 + j];
            MOD[((size_t)l * 9 + r) * 6144 + j0 + j] = s + P.ada_b[l * 6144 + j0 + j]; }
    }
    __syncthreads();
}
__device__ __forceinline__ void p_dftgen(Frame& F) {
    LAS float* tab = (LAS float*)F.lds;
    for (int j = F.tid; j < 4096; j += NTHREADS) tab[j] = cospif((float)j * (1.0f / 2048.0f));
    __syncthreads();
    bf16* DM_ = WSP(bf16, WS_DFTM); bf16* DC_ = WSP(bf16, WS_DFTC);
    const int nchunk = 4096 * 1024 + 256 * 64;
    for (int ch = F.bid * NTHREADS + F.tid; ch < nchunk; ch += F.G * NTHREADS) {
        float v[8]; bf16* dst;
        if (ch < 4096 * 1024) { const int kf = ch >> 10, col0 = (ch & 1023) * 8, cs = col0 >> 12, l0 = col0 & 4095;
#pragma unroll
            for (int i = 0; i < 8; ++i) { const int j = (kf * (l0 + i)) & 4095; v[i] = cs ? -tab[(j + 3072) & 4095] : tab[j]; }
            dst = DM_ + (size_t)kf * 8192 + col0; }
        else { const int c2 = ch - 4096 * 1024, kf = c2 >> 6, col0 = (c2 & 63) * 8, cs = col0 >> 8, l0 = col0 & 255;
#pragma unroll
            for (int i = 0; i < 8; ++i) { const int j = ((kf * (l0 + i)) & 255) * 16; v[i] = cs ? -tab[(j + 3072) & 4095] : tab[j]; }
            dst = DC_ + (size_t)kf * 512 + col0; }
        u32x4 o; o.x = pk2(v[0], v[1]); o.y = pk2(v[2], v[3]); o.z = pk2(v[4], v[5]); o.w = pk2(v[6], v[7]);
        *(u32x4*)dst = o;
    }
    __syncthreads();
}
__device__ __forceinline__ void transpose_item(const float* W, int ldw, int k0, int n0, bf16* WT, int ldt, int drow0, LAS float* scr, int lane) {
#pragma unroll 8
    for (int i = 0; i < 32; ++i) { const int kk = 2 * i + (lane >> 5); scr[kk * 33 + (lane & 31)] = W[(size_t)(k0 + kk) * ldw + n0 + (lane & 31)]; }
    LDS_WAIT(); asm volatile("" ::: "memory");
    const int c = lane & 7;
#pragma unroll
    for (int j = 0; j < 4; ++j) { const int n = (lane >> 3) + 8 * j; const LAS float* s = scr + (8 * c) * 33 + n;
        u32x4 o; o.x = pk2(s[0 * 33], s[1 * 33]); o.y = pk2(s[2 * 33], s[3 * 33]); o.z = pk2(s[4 * 33], s[5 * 33]); o.w = pk2(s[6 * 33], s[7 * 33]);
        *(u32x4*)(WT + (size_t)(drow0 + n) * ldt + k0 + 8 * c) = o; }
    LDS_WAIT(); asm volatile("" ::: "memory");
}
__device__ __forceinline__ void p_wconv(const Params& P, Frame& F, int l) {
    LAS float* scr = (LAS float*)(F.lds + F.wave * 16384);
    const int gw = F.bid * NWAVES + F.wave, NGW = F.G * NWAVES;
    const float* w_in = P.w_in + (size_t)l * 1024 * INW;
    bf16* WA = WSP(bf16, WS_WA); bf16* WFV = WSP(bf16, WS_WFV);
    constexpr int I_K = 16 * 32, I_Q = 16 * 32, I_P = 16 * 16, I_G = 16 * 96, I_V = 16 * 32, I_AO = 16 * 32, I_FO = 8 * 32, I_OUT = 16 * 32;
    constexpr int NSM = I_K + I_Q + I_P + I_G + I_V + I_AO + I_FO + I_OUT;
    for (int it = gw; it < NSM; it += NGW) {
        int r = it;
        if (r < I_K) { transpose_item(w_in, INW, (r / 32) * 64, 0 + (r % 32) * 32, WA, 1024, 0 + (r % 32) * 32, scr, F.lane); continue; } r -= I_K;
        if (r < I_Q) { transpose_item(w_in, INW, (r / 32) * 64, 2048 + (r % 32) * 32, WA, 1024, 1024 + (r % 32) * 32, scr, F.lane); continue; } r -= I_Q;
        if (r < I_P) { transpose_item(w_in, INW, (r / 16) * 64, 3584 + (r % 16) * 32, WA, 1024, 2048 + (r % 16) * 32, scr, F.lane); continue; } r -= I_P;
        if (r < I_G) { transpose_item(w_in, INW, (r / 96) * 64, 4096 + (r % 96) * 32, WA, 1024, 2560 + (r % 96) * 32, scr, F.lane); continue; } r -= I_G;
        if (r < I_V) { transpose_item(w_in, INW, (r / 32) * 64, 1024 + (r % 32) * 32, WFV, 1024, 1024 + (r % 32) * 32, scr, F.lane); continue; } r -= I_V;
        if (r < I_AO) { transpose_item(P.w_att_o + (size_t)l * 1024 * 1024, 1024, (r / 32) * 64, (r % 32) * 32, WSP(bf16, WS_WAO), 1024, (r % 32) * 32, scr, F.lane); continue; } r -= I_AO;
        if (r < I_FO) { transpose_item(P.w_fourier + (size_t)l * 512 * 1024, 1024, (r / 32) * 64, (r % 32) * 32, WSP(bf16, WS_WFO), 512, (r % 32) * 32, scr, F.lane); continue; } r -= I_FO;
        transpose_item(P.w_out + (size_t)l * 1024 * 1024, 1024, (r / 32) * 64, (r % 32) * 32, WSP(bf16, WS_WOUT), 1024, (r % 32) * 32, scr, F.lane);
    }
    constexpr int I_E = 16 * 88;
    bf16* WGU = WSP(bf16, WS_WGU); bf16* WD = WSP(bf16, WS_WD);
    for (int it = gw; it < 3 * 16 * I_E; it += NGW) {
        const int which = it / (16 * I_E), r0 = it % (16 * I_E), e = r0 / I_E, r = r0 % I_E;
        if (which < 2) { const int kb = r / 88, nb = r % 88, n0 = nb * 32;
            const float* src = (which == 0 ? P.w_eg : P.w_eu) + ((size_t)l * 16 + e) * 1024 * FF;
            transpose_item(src, FF, kb * 64, n0, WGU + (size_t)e * 5632 * 1024, 1024, (n0 >> 7) * 256 + (which ? 128 : 0) + (n0 & 127), scr, F.lane); }
        else { const int kb = r / 32, nb = r % 32;
            transpose_item(P.w_ed + ((size_t)l * 16 + e) * FF * 1024, 1024, kb * 64, nb * 32, WD + (size_t)e * 1024 * FF, FF, nb * 32, scr, F.lane); }
    }
    { bf16* WPO = WSP(bf16, WS_WPO); const float* wp = P.w_pool + (size_t)l * 4 * 128 * 256;
      for (int i = F.bid * NTHREADS + F.tid; i < 1024 * 256; i += F.G * NTHREADS) { const int n = i >> 8, kk = i & 255, g = n >> 8, f = n & 255;
          WPO[i] = (bf16)(((kk >> 7) == (g & 1)) ? f2bf(wp[((size_t)g * 128 + (kk & 127)) * 256 + f]) : 0u); } }
    { LAS float* t128 = (LAS float*)F.lds;
      __syncthreads();
      for (int j = F.tid; j < 128; j += NTHREADS) t128[j] = cospif((float)j * (1.0f / 64.0f));
      __syncthreads();
      for (int i = F.bid * NTHREADS + F.tid; i < 1024 * 1024; i += F.G * NTHREADS) { const int fc = i >> 10, k = i & 1023, cs = fc & 1, gm = fc >> 1, g = gm >> 7, m = gm & 127;
          const float* src = w_in + (size_t)k * INW + 3072 + g * 128; float s = 0.f; const int ph = cs ? 96 : 0;
          for (int c = 0; c < 128; ++c) s += src[c] * t128[(m * c + ph) & 127];
          WFV[i] = (bf16)f2bf(s); }
      __syncthreads(); }
}

struct RowMod { const float* g; const float* sh; const float* sc; };
__device__ __forceinline__ void row_load(const float* row, int lane, f32x4 (&v)[4]) {
#pragma unroll
    for (int j = 0; j < 4; ++j) v[j] = *(const f32x4*)(row + 4 * lane + 256 * j);
}
__device__ __forceinline__ float row_rstd(const f32x4 (&v)[4]) {
    float s = 0.f;
#pragma unroll
    for (int j = 0; j < 4; ++j) s += (v[j][0] * v[j][0] + v[j][1] * v[j][1]) + (v[j][2] * v[j][2] + v[j][3] * v[j][3]);
    return rsqrtf(wave_sum(s) * (1.0f / 1024.0f) + RMS_EPS);
}
__device__ __forceinline__ void row_modulate(const f32x4 (&v)[4], float rstd, const RowMod& M, int lane, f32x4 (&y)[4]) {
#pragma unroll
    for (int j = 0; j < 4; ++j) { const int k = 4 * lane + 256 * j; const f32x4 g = *(const f32x4*)(M.g + k), sh = *(const f32x4*)(M.sh + k), sc = *(const f32x4*)(M.sc + k);
        y[j] = v[j] * rstd * g * (sc + 1.0f) + sh; }
}
__device__ __forceinline__ void row_store_bf(bf16* row, int lane, const f32x4 (&y)[4]) {
#pragma unroll
    for (int j = 0; j < 4; ++j) st_bf4(row + 4 * lane + 256 * j, y[j]);
}
__device__ __forceinline__ const float* mod_ptr(Frame& F, int l, int row, int which) { const int mr = row < RL ? (row >> 12) : 8; return WSP(float, WS_MOD) + ((size_t)l * 9 + mr) * 6144 + which * 1024; }

__device__ __forceinline__ void p_rowpass_a0(const Params& P, Frame& F) {
    const int gw = F.bid * NWAVES + F.wave, NGW = F.G * NWAVES; bf16* H = WSP(bf16, WS_H);
    for (int row = gw; row < RT; row += NGW) {
        const float* src = row < RL ? P.x + (size_t)row * DM : P.ctx + (size_t)(row - RL) * DM;
        f32x4 v[4], y[4]; row_load(src, F.lane, v); const float rs = row_rstd(v);
        RowMod M{P.norm1_g, mod_ptr(F, 0, row, 0), mod_ptr(F, 0, row, 1)};
        row_modulate(v, rs, M, F.lane, y); row_store_bf(H + (size_t)row * DM, F.lane, y);
    }
}
__device__ __forceinline__ void p_rowpass_f(const Params& P, Frame& F, int l, int nrows) {
    const int gw = F.bid * NWAVES + F.wave, NGW = F.G * NWAVES; bf16* H = WSP(bf16, WS_H); float* AFF = WSP(float, WS_AFF);
    const float* wr = P.w_router + (size_t)l * 1024 * 16;
    for (int row = gw; row < nrows; row += NGW) {
        const float* src = row < RL ? P.out + (size_t)row * DM : WSP(float, WS_XC) + (size_t)(row - RL) * DM;
        f32x4 v[4], y[4]; row_load(src, F.lane, v); const float rs = row_rstd(v);
        RowMod M{P.norm2_g + l * 1024, mod_ptr(F, l, row, 3), mod_ptr(F, l, row, 4)};
        row_modulate(v, rs, M, F.lane, y); row_store_bf(H + (size_t)row * DM, F.lane, y);
        float lg[16];
#pragma unroll
        for (int e = 0; e < 16; ++e) lg[e] = 0.f;
#pragma unroll
        for (int j = 0; j < 4; ++j)
#pragma unroll
            for (int q = 0; q < 4; ++q) { const float* w = wr + (size_t)(4 * F.lane + 256 * j + q) * 16; const float hv = y[j][q];
#pragma unroll
                for (int e4 = 0; e4 < 4; ++e4) { const f32x4 ww = *(const f32x4*)(w + 4 * e4); lg[4 * e4 + 0] += hv * ww[0]; lg[4 * e4 + 1] += hv * ww[1]; lg[4 * e4 + 2] += hv * ww[2]; lg[4 * e4 + 3] += hv * ww[3]; } }
        float mx = -1e30f;
#pragma unroll
        for (int e = 0; e < 16; ++e) { lg[e] = wave_sum(lg[e]); mx = fmaxf(mx, lg[e]); }
        float den = 0.f;
#pragma unroll
        for (int e = 0; e < 16; ++e) { lg[e] = __expf(lg[e] - mx); den += lg[e]; }
        const float inv = 1.0f / den;
        if (F.lane < 16) { float mine = 0.f;
#pragma unroll
            for (int e = 0; e < 16; ++e) mine = (F.lane == e) ? lg[e] : mine;
            AFF[(size_t)row * 16 + F.lane] = mine * inv; }
    }
}
__device__ __forceinline__ void p_rowpass_k(const Params& P, Frame& F, int l, int nrows) {
    const int gw = F.bid * NWAVES + F.wave, NGW = F.G * NWAVES; bf16* H = WSP(bf16, WS_H);
    const int* SEL = WSP(int, WS_SEL); const bf16* Y = WSP(bf16, WS_Y);
    for (int row = gw; row < nrows; row += NGW) {
        float* xr = row < RL ? P.out + (size_t)row * DM : WSP(float, WS_XC) + (size_t)(row - RL) * DM;
        f32x4 v[4], a[4]; row_load(xr, F.lane, v);
#pragma unroll
        for (int j = 0; j < 4; ++j) a[j] = (f32x4){0.f, 0.f, 0.f, 0.f};
        for (int e = 0; e < 16; ++e) { const int s = SEL[(size_t)row * 16 + e];
            if (s >= 0) { const bf16* yr = Y + (size_t)s * DM;
#pragma unroll
                for (int j = 0; j < 4; ++j) { const u32x2 w = *(const u32x2*)(yr + 4 * F.lane + 256 * j); a[j][0] += bflo(w.x); a[j][1] += bfhi(w.x); a[j][2] += bflo(w.y); a[j][3] += bfhi(w.y); } } }
        const float* g2 = mod_ptr(F, l, row, 5);
#pragma unroll
        for (int j = 0; j < 4; ++j) { const f32x4 g = *(const f32x4*)(g2 + 4 * F.lane + 256 * j); v[j] = v[j] + g * a[j]; }
        const float rs = row_rstd(v);
        if (l == 0) {
#pragma unroll
            for (int j = 0; j < 4; ++j) *(f32x4*)(xr + 4 * F.lane + 256 * j) = v[j];
            f32x4 y[4]; RowMod M{P.norm1_g + 1024, mod_ptr(F, 1, row, 0), mod_ptr(F, 1, row, 1)};
            row_modulate(v, rs, M, F.lane, y); row_store_bf(H + (size_t)row * DM, F.lane, y);
        } else {
#pragma unroll
            for (int j = 0; j < 4; ++j) { const f32x4 g = *(const f32x4*)(P.final_g + 4 * F.lane + 256 * j); *(f32x4*)(xr + 4 * F.lane + 256 * j) = v[j] * rs * g; }
        }
    }
}

__device__ __forceinline__ float dot64(const bf16x8 (&q)[8], const bf16* kp) {
    float s = 0.f;
#pragma unroll
    for (int i = 0; i < 8; ++i) { const u32x4 kw = *(const u32x4*)(kp + 8 * i); const u32x4 qw = __builtin_bit_cast(u32x4, q[i]);
#pragma unroll
        for (int t = 0; t < 4; ++t) s += bflo(kw[t]) * bflo(qw[t]) + bfhi(kw[t]) * bfhi(qw[t]); }
    return s;
}
__device__ __forceinline__ void p_attn_naive(const Params& P, Frame& F, int l, bool with_ctx_queries) {
    const int gw = F.bid * NWAVES + F.wave, NGW = F.G * NWAVES;
    const bf16* KQ = WSP(bf16, WS_KQ); const bf16* VT = WSP(bf16, WS_VT); bf16* ATT = WSP(bf16, WS_ATT);
    LAS float* pw = (LAS float*)(F.lds + F.wave * 2048);
    const float* rpb = P.rpb + (size_t)l * 16 * 15 * 31;
    const int nlat = NB * 64 * NH * 64, nitems = nlat + (with_ctx_queries ? NB * NH * CTXL : 0);
    for (int it = gw; it < nitems; it += NGW) {
        const bool lat = it < nlat;
        int b, h, r = 0, qc = 0, rowq;
        if (lat) { qc = it & 63; h = (it >> 6) & 15; r = (it >> 10) & 63; b = it >> 16; rowq = b * SEQ + r * 64 + qc; }
        else { const int i2 = it - nlat; qc = i2 & 255; h = (i2 >> 8) & 15; b = i2 >> 12; rowq = RL + b * CTXL + qc; }
        bf16x8 q[8];
        { const bf16* qp = KQ + (size_t)rowq * 2048 + 1024 + h * 64;
#pragma unroll
          for (int i = 0; i < 8; ++i) q[i] = *(const bf16x8*)(qp + 8 * i); }
        const int rs = min(max(r - 4, 0), 56), cs = min(max(qc - 8, 0), 48);
        float s[6];
        if (lat) {
#pragma unroll
            for (int t = 0; t < 2; ++t) { const int w = F.lane + 64 * t, i = w >> 4, j = w & 15; const int tok = (rs + i) * 64 + cs + j;
                s[t] = dot64(q, KQ + (size_t)(b * SEQ + tok) * 2048 + h * 64) * 0.125f + rpb[(h * 15 + (rs + i - r + 7)) * 31 + (cs + j - qc + 15)]; }
        } else { s[0] = -1e30f; s[1] = -1e30f; }
#pragma unroll
        for (int t = 0; t < 4; ++t) { const int c = F.lane + 64 * t; s[2 + t] = dot64(q, KQ + (size_t)(RL + b * CTXL + c) * 2048 + h * 64) * 0.125f; }
        float mx = s[0];
#pragma unroll
        for (int t = 1; t < 6; ++t) mx = fmaxf(mx, s[t]);
        mx = wave_max(mx);
        float sum = 0.f;
#pragma unroll
        for (int t = 0; t < 6; ++t) { s[t] = (lat || t >= 2) ? __expf(s[t] - mx) : 0.f; sum += s[t]; }
        sum = wave_sum(sum);
        pw[F.lane] = s[0]; pw[F.lane + 64] = s[1];
#pragma unroll
        for (int t = 0; t < 4; ++t) pw[128 + F.lane + 64 * t] = s[2 + t];
        LDS_WAIT(); asm volatile("" ::: "memory");
        float o = 0.f;
        if (lat) { const bf16* vr = VT + ((size_t)b * 1024 + h * 64 + F.lane) * 4096;
#pragma unroll 2
            for (int w = 0; w < 128; ++w) { const int tok = (rs + (w >> 4)) * 64 + cs + (w & 15); o += pw[w] * bf2f(vr[tok]); } }
        { const bf16* vr = VT + YT_CTX_OFF + ((size_t)b * 1024 + h * 64 + F.lane) * 256;
#pragma unroll 2
          for (int c8 = 0; c8 < 32; ++c8) { const u32x4 vw = *(const u32x4*)(vr + 8 * c8); const LAS float* pp = pw + 128 + 8 * c8;
#pragma unroll
              for (int t = 0; t < 4; ++t) o += pp[2 * t] * bflo(vw[t]) + pp[2 * t + 1] * bfhi(vw[t]); } }
        ATT[(size_t)rowq * 1024 + h * 64 + F.lane] = (bf16)f2bf(o / sum);
        LDS_WAIT(); asm volatile("" ::: "memory");
    }
}

__device__ __forceinline__ void attn_unit(const bf16* __restrict__ KQ, const bf16* __restrict__ VT, bf16* __restrict__ ATT, const float* __restrict__ rpbh,
                                          const int b, const int h, const int r, const int qt, const bool lat, const int lane) {
    const int l15 = lane & 15, g = lane >> 4;
    const int rowq0 = lat ? b * SEQ + r * 64 + 16 * qt : RL + b * CTXL + 16 * qt;
    bf16x8 qf[2];
    { const bf16* qp = KQ + (size_t)(rowq0 + l15) * 2048 + 1024 + h * 64 + 8 * g; qf[0] = *(const bf16x8*)qp; qf[1] = *(const bf16x8*)(qp + 32); }
    const int rs = min(max(r - 4, 0), 56), kc0 = min(max(16 * qt - 8, 0), 32);
    const f32x4 z = {0.f, 0.f, 0.f, 0.f};
    float m = -1e30f, sum = 0.f;
    f32x4 o[4];
#pragma unroll
    for (int dt = 0; dt < 4; ++dt) o[dt] = z;
#define ATT_CHUNK_TAIL() do { \
        cm = fmaxf(cm, __shfl_xor(cm, 16)); cm = fmaxf(cm, __shfl_xor(cm, 32)); \
        const float mn = fmaxf(m, cm), scl = __expf(m - mn); m = mn; float ps = 0.f; \
        _Pragma("unroll") for (int t = 0; t < 4; ++t) _Pragma("unroll") for (int j = 0; j < 4; ++j) { const float p = __expf(sc[t][j] - mn); sc[t][j] = p; ps += p; } \
        sum = sum * scl + ps; \
        _Pragma("unroll") for (int dt = 0; dt < 4; ++dt) o[dt] = o[dt] * scl; \
        _Pragma("unroll") for (int ks = 0; ks < 2; ++ks) { u32x4 pw; pw.x = pk2(sc[2 * ks][0], sc[2 * ks][1]); pw.y = pk2(sc[2 * ks][2], sc[2 * ks][3]); pw.z = pk2(sc[2 * ks + 1][0], sc[2 * ks + 1][1]); pw.w = pk2(sc[2 * ks + 1][2], sc[2 * ks + 1][3]); \
            const bf16x8 pf = __builtin_bit_cast(bf16x8, pw); \
            _Pragma("unroll") for (int dt = 0; dt < 4; ++dt) o[dt] = __builtin_amdgcn_mfma_f32_16x16x32_bf16(__builtin_bit_cast(bf16x8, vw[ks][dt]), pf, o[dt], 0, 0, 0); } } while (0)
    if (lat) {
        const bf16* kb = KQ + (size_t)(b * SEQ + rs * 64 + kc0 + l15) * 2048 + h * 64 + 8 * g;
        const bf16* vb = VT + (size_t)(b * 1024 + h * 64 + l15) * 4096 + rs * 64 + kc0 + 4 * g;
        const int q = 16 * qt + l15, csq = min(max(q - 8, 0), 48);
#pragma unroll 1
        for (int c = 0; c < 4; ++c) {
            bf16x8 kf[4][2]; u32x4 vw[2][4]; f32x4 sc[4];
#pragma unroll
            for (int t = 0; t < 4; ++t) { const bf16* kp = kb + (size_t)((2 * c + (t >> 1)) * 64 + (t & 1) * 16) * 2048; kf[t][0] = *(const bf16x8*)kp; kf[t][1] = *(const bf16x8*)(kp + 32); }
#pragma unroll
            for (int ks = 0; ks < 2; ++ks)
#pragma unroll
                for (int dt = 0; dt < 4; ++dt) { const bf16* vp = vb + (size_t)(16 * dt) * 4096 + (2 * c + ks) * 64; const u32x2 v0 = *(const u32x2*)vp, v1 = *(const u32x2*)(vp + 16); vw[ks][dt] = (u32x4){v0.x, v0.y, v1.x, v1.y}; }
#pragma unroll
            for (int t = 0; t < 4; ++t) { sc[t] = __builtin_amdgcn_mfma_f32_16x16x32_bf16(kf[t][0], qf[0], z, 0, 0, 0); sc[t] = __builtin_amdgcn_mfma_f32_16x16x32_bf16(kf[t][1], qf[1], sc[t], 0, 0, 0); }
            float cm = -1e30f;
#pragma unroll
            for (int t = 0; t < 4; ++t) { const float* bp = rpbh + (rs + 2 * c + (t >> 1) - r + 7) * 31;
#pragma unroll
                for (int j = 0; j < 4; ++j) { const int jc = kc0 + 16 * (t & 1) + 4 * g + j; const bool ok = (jc >= csq) && (jc < csq + 16); const int bi = min(max(jc - q + 15, 0), 30);
                    float v = sc[t][j] * 0.125f + bp[bi]; v = ok ? v : -1e30f; sc[t][j] = v; cm = fmaxf(cm, v); } }
            ATT_CHUNK_TAIL();
        }
    }
    { const bf16* kb = KQ + (size_t)(RL + b * CTXL + l15) * 2048 + h * 64 + 8 * g;
      const bf16* vb = VT + YT_CTX_OFF + (size_t)(b * 1024 + h * 64 + l15) * 256 + 4 * g;
#pragma unroll 1
      for (int c = 0; c < 4; ++c) {
          bf16x8 kf[4][2]; u32x4 vw[2][4]; f32x4 sc[4];
#pragma unroll
          for (int t = 0; t < 4; ++t) { const bf16* kp = kb + (size_t)(64 * c + 16 * t) * 2048; kf[t][0] = *(const bf16x8*)kp; kf[t][1] = *(const bf16x8*)(kp + 32); }
#pragma unroll
          for (int ks = 0; ks < 2; ++ks)
#pragma unroll
              for (int dt = 0; dt < 4; ++dt) { const bf16* vp = vb + (size_t)(16 * dt) * 256 + 64 * c + 32 * ks; const u32x2 v0 = *(const u32x2*)vp, v1 = *(const u32x2*)(vp + 16); vw[ks][dt] = (u32x4){v0.x, v0.y, v1.x, v1.y}; }
#pragma unroll
          for (int t = 0; t < 4; ++t) { sc[t] = __builtin_amdgcn_mfma_f32_16x16x32_bf16(kf[t][0], qf[0], z, 0, 0, 0); sc[t] = __builtin_amdgcn_mfma_f32_16x16x32_bf16(kf[t][1], qf[1], sc[t], 0, 0, 0); }
          float cm = -1e30f;
#pragma unroll
          for (int t = 0; t < 4; ++t)
#pragma unroll
              for (int j = 0; j < 4; ++j) { const float v = sc[t][j] * 0.125f; sc[t][j] = v; cm = fmaxf(cm, v); }
          ATT_CHUNK_TAIL();
      } }
#undef ATT_CHUNK_TAIL
    sum += __shfl_xor(sum, 16); sum += __shfl_xor(sum, 32);
    const float inv = 1.0f / sum;
#pragma unroll
    for (int dt = 0; dt < 4; ++dt) st_bf4(ATT + (size_t)(rowq0 + l15) * 1024 + h * 64 + 16 * dt + 4 * g, o[dt] * inv);
}
__device__ __forceinline__ void p_attn_mfma(const Params& P, Frame& F, int l, bool with_ctx_queries) {
    const bf16* KQ = WSP(bf16, WS_KQ); const bf16* VT = WSP(bf16, WS_VT); bf16* ATT = WSP(bf16, WS_ATT);
    const float* rpb = P.rpb + (size_t)l * 16 * 465;
    for (int hp = F.bid; hp < 256; hp += F.G) {
        const int p = hp & 127, half = hp >> 7, b = p >> 4, h = p & 15;
#pragma unroll 1
        for (int it = 0; it < 16; ++it) attn_unit(KQ, VT, ATT, rpb + h * 465, b, h, half * 32 + it * 2 + (F.wave >> 2), F.wave & 3, true, F.lane);
    }
    if (with_ctx_queries) { const int gw = F.bid * NWAVES + F.wave, NGW = F.G * NWAVES;
#pragma unroll 1
        for (int u = gw; u < NB * NH * 16; u += NGW) { const int b = u >> 8, h = (u >> 4) & 15; attn_unit(KQ, VT, ATT, rpb + h * 465, b, h, 0, u & 15, false, F.lane); } }
}

__device__ __forceinline__ void p_pool(Frame& F, int nrows) {
    const bf16* PB = WSP(bf16, WS_PB); bf16* POOL = WSP(bf16, WS_POOL);
    for (int i = F.bid * NTHREADS + F.tid; i < nrows * 64; i += F.G * NTHREADS) {
        const int row = i >> 6, ch = i & 63, g = ch >> 4, hw = 1 << g;
        int base, t, Lb; if (row < RL) { base = row & ~4095; t = row & 4095; Lb = SEQ; } else { const int rr = row - RL; base = RL + (rr & ~255); t = rr & 255; Lb = CTXL; }
        const int lo = max(t - hw, 0), hi = min(t + hw, Lb);
        float a[8];
#pragma unroll
        for (int q = 0; q < 8; ++q) a[q] = 0.f;
        for (int tt = lo; tt < hi; ++tt) { const u32x4 w = *(const u32x4*)(PB + (size_t)(base + tt) * 512 + ch * 8);
#pragma unroll
            for (int q = 0; q < 4; ++q) { a[2 * q] += bflo(w[q]); a[2 * q + 1] += bfhi(w[q]); } }
        const u32x4 me = *(const u32x4*)(PB + (size_t)row * 512 + ch * 8); const float inv = 1.0f / (float)(hi - lo);
        u32x4 o;
#pragma unroll
        for (int q = 0; q < 4; ++q) o[q] = pk2(a[2 * q] * inv - bflo(me[q]), a[2 * q + 1] * inv - bfhi(me[q]));
        *(u32x4*)(POOL + (size_t)row * 512 + ch * 8) = o;
    }
}

__device__ __forceinline__ int block_sum_i(int v, LAS int* sm, int tid) {
#pragma unroll
    for (int o = 1; o < 64; o <<= 1) v += __shfl_xor(v, o);
    __syncthreads();
    if ((tid & 63) == 0) sm[tid >> 6] = v;
    __syncthreads();
    int s = 0;
#pragma unroll
    for (int i = 0; i < 8; ++i) s += sm[i];
    return s;
}
__device__ __forceinline__ int block_excl_scan(int v, LAS int* sm, int tid, int& total) {
    const int lane = tid & 63, w = tid >> 6; int inc = v;
#pragma unroll
    for (int o = 1; o < 64; o <<= 1) { const int t = __shfl_up(inc, o); if (lane >= o) inc += t; }
    __syncthreads();
    if (lane == 63) sm[w] = inc;
    __syncthreads();
    int base = 0; total = 0;
#pragma unroll
    for (int i = 0; i < 8; ++i) { const int s = sm[i]; if (i < w) base += s; total += s; }
    return base + inc - v;
}
template <int NPT>
__device__ __forceinline__ void topk_pair(Frame& F, int row0, int n, int cap, int e, int slot0) {
    LAS int* sm = (LAS int*)F.lds;
    const float* AFF = WSP(float, WS_AFF); int* SROW = WSP(int, WS_SROW); float* SG = WSP(float, WS_SGATE); int* SEL = WSP(int, WS_SEL);
    unsigned key[NPT];
#pragma unroll
    for (int j = 0; j < NPT; ++j) { const int i = F.tid * NPT + j; key[j] = (i < n) ? __float_as_uint(AFF[(size_t)(row0 + i) * 16 + e]) : 0u; }
    unsigned T = 0u;
    for (int bit = 30; bit >= 0; --bit) { const unsigned cand = T | (1u << bit); int cnt = 0;
#pragma unroll
        for (int j = 0; j < NPT; ++j) cnt += (key[j] >= cand) ? 1 : 0;
        cnt = block_sum_i(cnt, sm, F.tid);
        if (cnt >= cap) T = cand; }
    int ngt = 0, neq = 0;
#pragma unroll
    for (int j = 0; j < NPT; ++j) { ngt += (key[j] > T) ? 1 : 0; neq += (key[j] == T) ? 1 : 0; }
    int tot_gt, tot_eq;
    (void)block_excl_scan(ngt, sm, F.tid, tot_gt);
    int eqr = block_excl_scan(neq, sm, F.tid, tot_eq);
    const int need_eq = cap - tot_gt;
    int nsel = 0; bool selj[NPT];
#pragma unroll
    for (int j = 0; j < NPT; ++j) { bool s = key[j] > T; if (key[j] == T && T != 0u) { s = eqr < need_eq; ++eqr; } selj[j] = s; nsel += s ? 1 : 0; }
    int tot_sel; int pos = block_excl_scan(nsel, sm, F.tid, tot_sel);
#pragma unroll
    for (int j = 0; j < NPT; ++j) { const int i = F.tid * NPT + j;
        if (i < n) { const int row = row0 + i;
            if (selj[j]) { const int slot = slot0 + pos; ++pos; SROW[slot] = row; SG[slot] = __uint_as_float(key[j]); SEL[(size_t)row * 16 + e] = slot; }
            else SEL[(size_t)row * 16 + e] = -1; } }
    __syncthreads();
}
__device__ __forceinline__ void p_topk(Frame& F, bool with_ctx) {
    const int npairs = 128 + (with_ctx ? 128 : 0);
    for (int pi = F.bid; pi < npairs; pi += F.G) {
        if (pi < 128) { const int b = pi >> 4, e = pi & 15; topk_pair<8>(F, b * SEQ, SEQ, CAPL, e, e * SLOT_E + b * CAPL); }
        else { const int p2 = pi - 128, b = p2 >> 4, e = p2 & 15; topk_pair<1>(F, RL + b * CTXL, CTXL, CAPC, e, e * SLOT_E + 4096 + b * CAPC); }
    }
}
__device__ __forceinline__ void p_gather(Frame& F, bool with_ctx) {
    const int gw = F.bid * NWAVES + F.wave, NGW = F.G * NWAVES; const bf16* H = WSP(bf16, WS_H); bf16* XG = WSP(bf16, WS_XG); const int* SROW = WSP(int, WS_SROW);
    for (int s = gw; s < NSLOT; s += NGW) { if (!with_ctx && (s % SLOT_E) >= 4096) continue;
        const int row = SROW[s]; const u32x4* src = (const u32x4*)(H + (size_t)row * DM); u32x4* dst = (u32x4*)(XG + (size_t)s * DM);
        dst[F.lane] = src[F.lane]; dst[F.lane + 64] = src[F.lane + 64]; }
}

template <int PH> __global__ void __launch_bounds__(NTHREADS, 2) fwd_kernel(Params P) {
    extern __shared__ __attribute__((aligned(16))) unsigned char lds_raw[];
    Frame F; F.lds = (LAS unsigned char*)lds_raw; F.tid = threadIdx.x; F.lane = F.tid & 63; F.wave = __builtin_amdgcn_readfirstlane(F.tid >> 6); F.G = gridDim.x; F.bid = blockIdx.x; F.ws = P.ws;
    volatile LAS unsigned* MISC = (volatile LAS unsigned*)(F.lds + LDS_MISC);
    if (F.tid < 64) MISC[F.tid] = 0u;
    __syncthreads();
    XcdBarrier bar; bar.bar = WSP(unsigned, WS_CTL) + CW_BAR; bar.x = 0; bar.st = MISC + 8;
    if constexpr (PH < 0) bar = xcd_barrier_post(WSP(unsigned, WS_CTL) + CW_BAR, MISC + 8);
#define IN(k) (PH < 0 || PH == (k))
#define REFRESH() do { int t_ = threadIdx.x; asm volatile("" : "+v"(t_)); F.tid = t_; F.lane = t_ & 63; F.wave = __builtin_amdgcn_readfirstlane(t_ >> 6); } while (0)
#define SEAM(k) do { if constexpr (PH < 0) xcd_barrier(bar); } while (0)

    if (IN(0)) { p_mod(P, F); p_dftgen(F); p_wconv(P, F, 0); }
    SEAM(0);
    if (IN(1)) { p_rowpass_a0(P, F); }
    SEAM(1);
    for (int l = P.l_lo; l < P.l_hi; ++l) {
        constexpr int pb = 2; const bool L0 = (l == 0);
        bf16* H = WSP(bf16, WS_H);
        if (IN(pb + 0)) { REFRESH();
            { GroupSched S; S.init(1, 128, 22, F.G, F.bid, 8, L0 ? 22 : 4, 128, 0);
              const bf16* WA = WSP(bf16, WS_WA);
              auto AD = [=](const Unit& u) { return Operands{H + (size_t)u.pm * 256 * DM, WA + (size_t)u.pn * 256 * DM, DM, DM}; };
              bf16* KQ = WSP(bf16, WS_KQ); bf16* PBp = WSP(bf16, WS_PB); bf16* GB = WSP(bf16, WS_GB);
              auto E = [=](EPI_ARGS) { const int row0 = u.pm * 256;
                  if (u.pn < 8) { EPI_FOR( st_bf4(KQ + (size_t)(row0 + r) * 2048 + u.pn * 256 + c, v); ) }
                  else if (u.pn < 10) { EPI_FOR( st_bf4(PBp + (size_t)(row0 + r) * 512 + (u.pn - 8) * 256 + c, v); ) }
                  else { EPI_FOR( f32x4 s; s[0] = sigmoidf_(v[0]); s[1] = sigmoidf_(v[1]); s[2] = sigmoidf_(v[2]); s[3] = sigmoidf_(v[3]); st_bf4(GB + (size_t)(row0 + r) * 3072 + (u.pn - 10) * 256 + c, s); ) } };
              GEMM(S, AD, E, DM, DM, DM); }
            { GroupSched S; S.init(1, 8, 128, F.G, F.bid, L0 ? 8 : 4, 8, L0 ? 0 : 4, 128);
              const bf16* WFV = WSP(bf16, WS_WFV);
              auto AD = [=](const Unit& u) { return Operands{WFV + (size_t)u.pm * 256 * DM, H + (size_t)u.pn * 256 * DM, DM, DM}; };
              bf16* YT = WSP(bf16, WS_YT); bf16* VT = WSP(bf16, WS_VT);
              auto E = [=](EPI_ARGS) { bf16* T = (u.pm < 4) ? YT : VT; const int rr0 = (u.pm & 3) * 256;
                  if (u.pn < 128) { const int b = u.pn >> 4, l0 = (u.pn & 15) * 256; EPI_FOR( st_bf4(T + ((size_t)b * 1024 + rr0 + r) * 4096 + l0 + c, v); ) }
                  else { const int b = u.pn - 128; EPI_FOR( st_bf4(T + YT_CTX_OFF + ((size_t)b * 1024 + rr0 + r) * 256 + c, v); ) } };
              GEMM(S, AD, E, DM, DM, DM); }
        }
        SEAM(pb + 0);
        if (IN(pb + 1)) { REFRESH();
            p_attn_mfma(P, F, l, L0);
            { GroupSched S; S.init(1, 16, 16, F.G, F.bid);
              const bf16* DFTM = WSP(bf16, WS_DFTM); const bf16* YT = WSP(bf16, WS_YT); bf16* FOUR = WSP(bf16, WS_FOUR);
              auto AD = [=](const Unit& u) { return Operands{DFTM + (size_t)u.pm * 256 * 8192, YT + (size_t)u.pn * 256 * 8192, 8192, 8192}; };
              auto E = [=](EPI_ARGS) { const int b = u.pn >> 1, c0 = (u.pn & 1) * 256; const float sc = 0.0013810679320049757f;
                  EPI_FOR( st_bf4(FOUR + ((size_t)b * SEQ + u.pm * 256 + r) * 512 + c0 + c, v * sc); ) };
              GEMM(S, AD, E, 8192, 8192, 8192); }
            if (L0) { GroupSched S; S.init(1, 1, 16, F.G, F.bid);
              const bf16* DFTC = WSP(bf16, WS_DFTC); const bf16* YTC = WSP(bf16, WS_YT) + YT_CTX_OFF; bf16* FOUR = WSP(bf16, WS_FOUR);
              auto AD = [=](const Unit& u) { return Operands{DFTC, YTC + (size_t)u.pn * 256 * 512, 512, 512}; };
              auto E = [=](EPI_ARGS) { const int b = u.pn >> 1, c0 = (u.pn & 1) * 256; const float sc = 0.005524271728019903f;
                  EPI_FOR( st_bf4(FOUR + ((size_t)RL + b * CTXL + r) * 512 + c0 + c, v * sc); ) };
              GEMM(S, AD, E, 512, 512, 512); }
            p_pool(F, L0 ? RT : RL);
        }
        SEAM(pb + 1);
        if (IN(pb + 2)) { REFRESH();
            const int nM = L0 ? 136 : 128; float* MRG = WSP(float, WS_MRG); const bf16* GB = WSP(bf16, WS_GB);
            { GroupSched S; S.init(1, nM, 4, F.G, F.bid); const bf16* A = WSP(bf16, WS_ATT); const bf16* W = WSP(bf16, WS_WAO);
              auto AD = [=](const Unit& u) { return Operands{A + (size_t)u.pm * 256 * 1024, W + (size_t)u.pn * 256 * 1024, 1024, 1024}; };
              auto E = [=](EPI_ARGS) { EPI_FOR( const size_t row = (size_t)u.pm * 256 + r; const int col = u.pn * 256 + c; const u32x2 g = *(const u32x2*)(GB + row * 3072 + col);
                  f32x4 o; o[0] = bflo(g.x) * v[0]; o[1] = bfhi(g.x) * v[1]; o[2] = bflo(g.y) * v[2]; o[3] = bfhi(g.y) * v[3]; *(f32x4*)(MRG + row * 1024 + col) = o; ) };
              GEMM(S, AD, E, 1024, 1024, 1024); }
            { GroupSched S; S.init(1, nM, 4, F.G, F.bid); const bf16* A = WSP(bf16, WS_FOUR); const bf16* W = WSP(bf16, WS_WFO);
              auto AD = [=](const Unit& u) { return Operands{A + (size_t)u.pm * 256 * 512, W + (size_t)u.pn * 256 * 512, 512, 512}; };
              auto E = [=](EPI_ARGS) { EPI_FOR( const size_t row = (size_t)u.pm * 256 + r; const int col = u.pn * 256 + c; const u32x2 g = *(const u32x2*)(GB + row * 3072 + 1024 + col);
                  f32x4 o = *(const f32x4*)(MRG + row * 1024 + col); o[0] += bflo(g.x) * v[0]; o[1] += bfhi(g.x) * v[1]; o[2] += bflo(g.y) * v[2]; o[3] += bfhi(g.y) * v[3]; *(f32x4*)(MRG + row * 1024 + col) = o; ) };
              GEMM(S, AD, E, 512, 512, 512); }
            { GroupSched S; S.init(1, nM, 4, F.G, F.bid); const bf16* A = WSP(bf16, WS_POOL); const bf16* W = WSP(bf16, WS_WPO); bf16* MRGB = WSP(bf16, WS_MRGB);
              const float* ps = P.pool_scale + l * 1024;
              auto AD = [=](const Unit& u) { return Operands{A + (size_t)u.pm * 256 * 512 + (u.pn >> 1) * 256, W + (size_t)u.pn * 256 * 256, 512, 256}; };
              auto E = [=](EPI_ARGS) { EPI_FOR( const size_t row = (size_t)u.pm * 256 + r; const int col = u.pn * 256 + c; const u32x2 g = *(const u32x2*)(GB + row * 3072 + 2048 + col);
                  const f32x4 pv = *(const f32x4*)(ps + col); f32x4 o = *(const f32x4*)(MRG + row * 1024 + col);
                  o[0] += bflo(g.x) * pv[0] * v[0]; o[1] += bfhi(g.x) * pv[1] * v[1]; o[2] += bflo(g.y) * pv[2] * v[2]; o[3] += bfhi(g.y) * pv[3] * v[3]; st_bf4(MRGB + row * 1024 + col, o); ) };
              GEMM(S, AD, E, 256, 512, 256); }
        }
        SEAM(pb + 2);
        if (IN(pb + 3)) { REFRESH();
            GroupSched S; S.init(1, L0 ? 136 : 128, 4, F.G, F.bid); const bf16* A = WSP(bf16, WS_MRGB); const bf16* W = WSP(bf16, WS_WOUT);
            const float* xin = L0 ? P.x : P.out; const float* cin = L0 ? P.ctx : WSP(float, WS_XC); float* xo = P.out; float* co = WSP(float, WS_XC);
            const float* MOD = WSP(float, WS_MOD) + (size_t)l * 9 * 6144;
            auto AD = [=](const Unit& u) { return Operands{A + (size_t)u.pm * 256 * 1024, W + (size_t)u.pn * 256 * 1024, 1024, 1024}; };
            auto E = [=](EPI_ARGS) { EPI_FOR( const int row = u.pm * 256 + r; const int col = u.pn * 256 + c; const int mr = row < RL ? (row >> 12) : 8;
                const f32x4 g = *(const f32x4*)(MOD + (size_t)mr * 6144 + 2048 + col);
                const float* src = row < RL ? xin + (size_t)row * DM + col : cin + (size_t)(row - RL) * DM + col; float* dst = row < RL ? xo + (size_t)row * DM + col : co + (size_t)(row - RL) * DM + col;
                *(f32x4*)dst = *(const f32x4*)src + g * v; ) };
            GEMM(S, AD, E, 1024, 1024, 1024);
        }
        SEAM(pb + 3);
        if (IN(pb + 4)) { REFRESH(); p_rowpass_f(P, F, l, L0 ? RT : RL); }
        SEAM(pb + 4);
        if (IN(pb + 5)) { REFRESH(); p_topk(F, L0); }
        SEAM(pb + 5);
        if (IN(pb + 6)) { REFRESH(); p_gather(F, L0); }
        SEAM(pb + 6);
        if (IN(pb + 7)) { REFRESH();
            GroupSched S; S.init(16, L0 ? 17 : 16, 22, F.G, F.bid); const bf16* XG = WSP(bf16, WS_XG); const bf16* W = WSP(bf16, WS_WGU); bf16* HID = WSP(bf16, WS_HID);
            auto AD = [=](const Unit& u) { return Operands{XG + ((size_t)u.grp * SLOT_E + u.pm * 256) * DM, W + ((size_t)u.grp * 5632 + u.pn * 256) * DM, DM, DM}; };
            auto E = [=](EPI_ARGS) {
#pragma unroll
                for (int ai = 0; ai < 2; ++ai)
#pragma unroll
                    for (int m = 0; m < 4; ++m) { const size_t slot = (size_t)u.grp * SLOT_E + u.pm * 256 + ai * 128 + wr * 64 + m * 16 + fr;
#pragma unroll
                        for (int n = 0; n < 2; ++n) { const f32x4 a = acc[ai][0][m][n], up = acc[ai][1][m][n]; f32x4 o;
#pragma unroll
                            for (int j = 0; j < 4; ++j) o[j] = a[j] * sigmoidf_(a[j]) * up[j];
                            st_bf4(HID + slot * FF + u.pn * 128 + wc * 32 + n * 16 + 4 * fq, o); } } };
            GEMM(S, AD, E, DM, DM, DM);
        }
        SEAM(pb + 7);
        if (IN(pb + 8)) { REFRESH();
            GroupSched S; S.init(16, L0 ? 17 : 16, 4, F.G, F.bid); const bf16* HID = WSP(bf16, WS_HID); const bf16* W = WSP(bf16, WS_WD); bf16* Y = WSP(bf16, WS_Y); const float* SG = WSP(float, WS_SGATE);
            auto AD = [=](const Unit& u) { return Operands{HID + ((size_t)u.grp * SLOT_E + u.pm * 256) * FF, W + ((size_t)u.grp * 1024 + u.pn * 256) * FF, FF, FF}; };
            auto E = [=](EPI_ARGS) { EPI_FOR( const size_t slot = (size_t)u.grp * SLOT_E + u.pm * 256 + r; const float gt = SG[slot]; st_bf4(Y + slot * DM + u.pn * 256 + c, v * gt); ) };
            GEMM(S, AD, E, FF, FF, FF);
        }
        SEAM(pb + 8);
        if (IN(pb + 9)) { REFRESH(); p_rowpass_k(P, F, l, L0 ? RT : RL); if (L0) p_wconv(P, F, 1); }
        if (L0) SEAM(pb + 9);
    }
#undef IN
#undef SEAM
}
template <int PH> static void launch_ph(int grid, const Params& p, hipStream_t stream) { hipLaunchKernelGGL(fwd_kernel<PH>, dim3(grid), dim3(NTHREADS), LDS_BYTES, stream, p); }
template <int PH> static bool set_attr() { return hipFuncSetAttribute((const void*)fwd_kernel<PH>, hipFuncAttributeMaxDynamicSharedMemorySize, LDS_BYTES) == hipSuccess; }

extern "C" void kernel_launch(void* const* d_in, const int* in_sizes, int n_in, void* d_out, int out_size, void* d_ws, size_t ws_size, hipStream_t stream) {
    static int grid = 0;
    if (grid == 0) {
        if (n_in != 20 || out_size != RL * DM || ws_size < WS_END) { fprintf(stderr, "kernel_launch: unexpected shapes (n_in %d out %d ws %zu need %zu)\n", n_in, out_size, ws_size, (size_t)WS_END); grid = -1; return; }
        int dev = 0, cus = 0, per_cu = 0;
        if (hipGetDevice(&dev) != hipSuccess || hipDeviceGetAttribute(&cus, hipDeviceAttributeMultiprocessorCount, dev) != hipSuccess) { grid = -1; return; }
#if N_LAUNCH_MODE == 1
        if (!set_attr<-1>()) { fprintf(stderr, "kernel_launch: hipFuncSetAttribute failed\n"); grid = -1; return; }
        if (hipOccupancyMaxActiveBlocksPerMultiprocessor(&per_cu, (const void*)fwd_kernel<-1>, NTHREADS, LDS_BYTES) != hipSuccess || per_cu < 1) fprintf(stderr, "kernel_launch: occupancy query reports %d\n", per_cu);
#else
        if (!(set_attr<0>() && set_attr<1>() && set_attr<2>() && set_attr<3>() && set_attr<4>() && set_attr<5>() && set_attr<6>() && set_attr<7>() && set_attr<8>() && set_attr<9>() && set_attr<10>() && set_attr<11>())) { fprintf(stderr, "kernel_launch: hipFuncSetAttribute failed\n"); grid = -1; return; }
        (void)per_cu;
#endif
        (void)hipGetLastError();
        grid = cus;
    }
    if (grid < 0) return;
    if (hipMemsetAsync((char*)d_ws + WS_CTL, 0, CTL_BYTES, stream) != hipSuccess) return;
    Params p{};
    const float** pp = (const float**)&p;
    for (int i = 0; i < 20; ++i) pp[i] = (const float*)d_in[i];
    p.out = (float*)d_out; p.ws = (unsigned char*)d_ws;
#if N_LAUNCH_MODE == 1
    p.l_lo = 0; p.l_hi = 2;
    launch_ph<-1>(grid, p, stream);
#else
    p.l_lo = 0; p.l_hi = 0; launch_ph<0>(grid, p, stream); launch_ph<1>(grid, p, stream);
    for (int l = 0; l < 2; ++l) { p.l_lo = l; p.l_hi = l + 1;
        launch_ph<2>(grid, p, stream); launch_ph<3>(grid, p, stream); launch_ph<4>(grid, p, stream); launch_ph<5>(grid, p, stream); launch_ph<6>(grid, p, stream);
        launch_ph<7>(grid, p, stream); launch_ph<8>(grid, p, stream); launch_ph<9>(grid, p, stream); launch_ph<10>(grid, p, stream); launch_ph<11>(grid, p, stream); }
#endif
}
```

```cpp
#include <hip/hip_runtime.h>
#include <cstdio>
#include <cstdint>

#ifndef N_LAUNCH_MODE
#define N_LAUNCH_MODE 1
#endif

#define GAS __attribute__((address_space(1)))
#define LAS __attribute__((address_space(3)))
typedef unsigned short bf16;
typedef short bf16x8 __attribute__((ext_vector_type(8)));
typedef float f32x4 __attribute__((ext_vector_type(4)));
typedef unsigned u32x4 __attribute__((ext_vector_type(4)));
typedef unsigned u32x2 __attribute__((ext_vector_type(2)));

constexpr int NB = 8, SEQ = 4096, DM = 1024, CTXL = 256, NH = 16, HD = 64, GRIDW = 64;
constexpr int RL = NB * SEQ, RC = NB * CTXL, RT = RL + RC;
constexpr int INW = 7168, NE = 16, FF = 2816, CAPL = 512, CAPC = 32;
constexpr int SLOT_E = 4352, NSLOT = NE * SLOT_E;
constexpr float RMS_EPS = 1e-6f;
constexpr int NWAVES = 8, NTHREADS = 512;

constexpr size_t al256(size_t x) { return (x + 255) & ~(size_t)255; }
constexpr size_t WS_CTL = 0, CTL_BYTES = 1u << 20;
constexpr size_t WS_MOD = WS_CTL + CTL_BYTES;
constexpr size_t WS_XC = al256(WS_MOD + (size_t)2 * 9 * 6144 * 4);
constexpr size_t WS_AFF = al256(WS_XC + (size_t)RC * DM * 4);
constexpr size_t WS_SROW = al256(WS_AFF + (size_t)RT * 16 * 4);
constexpr size_t WS_SGATE = al256(WS_SROW + (size_t)NSLOT * 4);
constexpr size_t WS_SEL = al256(WS_SGATE + (size_t)NSLOT * 4);
constexpr size_t WS_DFTM = al256(WS_SEL + (size_t)RT * 16 * 4);
constexpr size_t WS_DFTC = al256(WS_DFTM + (size_t)4096 * 8192 * 2);
constexpr size_t WS_WA = al256(WS_DFTC + (size_t)256 * 512 * 2);
constexpr size_t WS_WFV = al256(WS_WA + (size_t)5632 * 1024 * 2);
constexpr size_t WS_WAO = al256(WS_WFV + (size_t)2048 * 1024 * 2);
constexpr size_t WS_WFO = al256(WS_WAO + (size_t)1024 * 1024 * 2);
constexpr size_t WS_WPO = al256(WS_WFO + (size_t)1024 * 512 * 2);
constexpr size_t WS_WOUT = al256(WS_WPO + (size_t)1024 * 256 * 2);
constexpr size_t WS_WGU = al256(WS_WOUT + (size_t)1024 * 1024 * 2);
constexpr size_t WS_WD = al256(WS_WGU + (size_t)16 * 5632 * 1024 * 2);
constexpr size_t WS_H = al256(WS_WD + (size_t)16 * 1024 * 2816 * 2);
constexpr size_t WS_R = al256(WS_H + (size_t)RT * DM * 2);
constexpr size_t WS_KQ = WS_R;
constexpr size_t WS_MRG = WS_KQ;
constexpr size_t WS_PB = al256(WS_KQ + (size_t)RT * 2048 * 2);
constexpr size_t WS_GB = al256(WS_PB + (size_t)RT * 512 * 2);
constexpr size_t WS_YT = al256(WS_GB + (size_t)RT * 3072 * 2);
constexpr size_t WS_MRGB = WS_YT;
constexpr size_t WS_VT = al256(WS_YT + (size_t)RT * 1024 * 2);
constexpr size_t WS_FOUR = al256(WS_VT + (size_t)RT * 1024 * 2);
constexpr size_t WS_ATT = al256(WS_FOUR + (size_t)RT * 512 * 2);
constexpr size_t WS_POOL = al256(WS_ATT + (size_t)RT * 1024 * 2);
constexpr size_t WS_MIX_END = al256(WS_POOL + (size_t)RT * 512 * 2);
constexpr size_t WS_XG = WS_R;
constexpr size_t WS_HID = al256(WS_XG + (size_t)NSLOT * 1024 * 2);
constexpr size_t WS_Y = al256(WS_HID + (size_t)NSLOT * 2816 * 2);
constexpr size_t WS_MOE_END = al256(WS_Y + (size_t)NSLOT * 1024 * 2);
constexpr size_t WS_END = WS_MIX_END > WS_MOE_END ? WS_MIX_END : WS_MOE_END;
constexpr size_t YT_CTX_OFF = (size_t)8 * 1024 * 4096;

constexpr int CW_BAR = 4096;

constexpr int LDS_BYTES = 147456;
constexpr int LDS_MISC = 131072;

__device__ __forceinline__ unsigned f2bf(float f) { unsigned u = __float_as_uint(f); return (u + 0x7fffu + ((u >> 16) & 1u)) >> 16; }
__device__ __forceinline__ unsigned pk2(float lo, float hi) { return f2bf(lo) | (f2bf(hi) << 16); }
__device__ __forceinline__ float bf2f(unsigned b) { return __uint_as_float(b << 16); }
__device__ __forceinline__ float bflo(unsigned w) { return __uint_as_float(w << 16); }
__device__ __forceinline__ float bfhi(unsigned w) { return __uint_as_float(w & 0xffff0000u); }
__device__ __forceinline__ float wave_sum(float v) {
#pragma unroll
    for (int o = 1; o < 64; o <<= 1) v += __shfl_xor(v, o);
    return v;
}
__device__ __forceinline__ float wave_max(float v) {
#pragma unroll
    for (int o = 1; o < 64; o <<= 1) v = fmaxf(v, __shfl_xor(v, o));
    return v;
}
__device__ __forceinline__ float sigmoidf_(float x) { return 1.f / (1.f + __expf(-x)); }
#define LDS_WAIT() asm volatile("s_waitcnt lgkmcnt(0)" ::: "memory")

#define XB_TMO      128
#define XB_XCNT(j)  (256  + 64 * (j))
#define XB_XSUB(j)  (1280 + 64 * (j))
#define XB_XGEN(j)  (2304 + 64 * (j))
#define XB_TOP      3328
#define XB_TOPGEN   3392
#define XCD_BAR_WORDS 3456
#define XB_SPIN_CAP (1u << 22)

__device__ __forceinline__ unsigned xb_ld(unsigned* p)              { return __hip_atomic_load(p, __ATOMIC_RELAXED, __HIP_MEMORY_SCOPE_AGENT); }
__device__ __forceinline__ unsigned xb_add(unsigned* p, unsigned v) { return __hip_atomic_fetch_add(p, v, __ATOMIC_RELAXED, __HIP_MEMORY_SCOPE_AGENT); }
__device__ __forceinline__ unsigned xb_xcc_id() { return (unsigned)__builtin_amdgcn_s_getreg((3 << 11) | 20) & 0xFu; }
#define XB_SPIN(cond, bar) do { unsigned _sp = 0; while (cond) { __builtin_amdgcn_s_sleep(1); \
    if ((++_sp & 255u) == 0u) { if (xb_ld(&(bar)[XB_TMO])) break; if (_sp > XB_SPIN_CAP) { atomicAdd(&(bar)[XB_TMO], 1u); break; } } } } while (0)

struct XcdBarrier { unsigned* bar; unsigned x; volatile LAS unsigned* st; };

__device__ __forceinline__ XcdBarrier xcd_barrier_post(unsigned* bar, volatile LAS unsigned* st) {
    XcdBarrier b; b.bar = bar; b.x = xb_xcc_id(); b.st = st;
    if (threadIdx.x == 0) (void)xb_add(&bar[XB_XCNT(b.x)], 1u);
    return b;
}
__device__ __forceinline__ void xcd_barrier_complete(unsigned* bar, unsigned x, unsigned& nloc, unsigned& nx) {
    const unsigned G = gridDim.x * gridDim.y * gridDim.z;
    unsigned sum, cnt, mine, sp = 0u;
    for (;;) {
        sum = 0u; cnt = 0u; mine = 0u;
#pragma unroll
        for (unsigned j = 0; j < 16; ++j) { const unsigned c = xb_ld(&bar[XB_XCNT(j)]); sum += c; cnt += (c > 0u) ? 1u : 0u; mine = (j == x) ? c : mine; }
        if (sum == G) break;
        __builtin_amdgcn_s_sleep(1);
        if ((++sp & 255u) == 0u) { if (xb_ld(&bar[XB_TMO])) break; if (sp > XB_SPIN_CAP) { atomicAdd(&bar[XB_TMO], 1u); break; } }
    }
    nloc = mine > 0u ? mine : 1u; nx = cnt > 0u ? cnt : 1u;
}
__device__ __forceinline__ void xcd_barrier(const XcdBarrier& b) {
    asm volatile("s_waitcnt vmcnt(0)" ::: "memory");
    __syncthreads();
    if (threadIdx.x == 0) {
        unsigned* bar = b.bar;
        __builtin_amdgcn_s_waitcnt(0);
        unsigned nloc = b.st[0], nx = b.st[1];
        if (nloc == 0u) { xcd_barrier_complete(bar, b.x, nloc, nx); b.st[0] = nloc; b.st[1] = nx; }
        const unsigned old = xb_add(&bar[XB_XSUB(b.x)], 1u);
        const unsigned gen = old / nloc;
        if (old + 1u == (gen + 1u) * nloc) {
            __builtin_amdgcn_fence(__ATOMIC_RELEASE, "agent");
            asm volatile("s_waitcnt vmcnt(0)" ::: "memory");
            const unsigned og = xb_add(&bar[XB_TOP], 1u);
            const unsigned tg = og / nx;
            if (og + 1u == (tg + 1u) * nx) xb_add(&bar[XB_TOPGEN], 1u);
            else XB_SPIN(xb_ld(&bar[XB_TOPGEN]) == tg, bar);
            __builtin_amdgcn_fence(__ATOMIC_ACQUIRE, "agent");
            xb_add(&bar[XB_XGEN(b.x)], 1u);
            asm volatile("s_waitcnt vmcnt(0)" ::: "memory");
        } else {
            XB_SPIN(xb_ld(&bar[XB_XGEN(b.x)]) == gen, bar);
            __builtin_amdgcn_fence(__ATOMIC_ACQUIRE, "agent");
            asm volatile("s_waitcnt vmcnt(0)" ::: "memory");
        }
    }
    __syncthreads();
}

struct Params {
    const float *x, *c, *ctx, *c_ctx, *ada_w, *ada_b, *norm1_g, *norm2_g, *w_in, *rpb, *w_att_o, *w_fourier, *w_pool, *pool_scale, *w_out, *w_router, *w_eg, *w_eu, *w_ed, *final_g;
    float* out; unsigned char* ws; int l_lo, l_hi;
};
struct Frame {
    LAS unsigned char* lds;
    int tid, lane, wave, G, bid;
    unsigned char* ws;
};
#define WSP(T, off) ((T*)(F.ws + (off)))

struct Unit { int grp, pm, pn; };
struct GroupSched {
    int ng, nM, nN, G, c; int tM, tN, tpm0, tpn0;
    __device__ __forceinline__ void init(int ng_, int nM_, int nN_, int G_, int c_, int tM_ = 0, int tN_ = 0, int tpm0_ = 0, int tpn0_ = 0) { ng = ng_; nM = nM_; nN = nN_; G = G_; c = c_; tM = tM_; tN = tN_; tpm0 = tpm0_; tpn0 = tpn0_; }
    __device__ __forceinline__ bool next(int i, Unit& u) const {
        const int per = nM * nN; const int L = i * G + c;
        if (L < ng * per) {
            u.grp = L / per; int wgid = L - u.grp * per;
            { const int q = per / 8, r = per % 8, xcd = wgid % 8, off = wgid / 8; wgid = (xcd < r ? xcd * (q + 1) : r * (q + 1) + (xcd - r) * q) + off; }
            const int nig = 8 * nN, gid = wgid / nig, fm = gid * 8, gsz = (nM - fm) < 8 ? (nM - fm) : 8;
            u.pm = fm + ((wgid % nig) % gsz); u.pn = (wgid % nig) / gsz; return true;
        }
        const int w = L - ng * per;
        if (w < tM * tN) { u.grp = ng; u.pm = tpm0 + (w % tM); u.pn = tpn0 + (w / tM); return true; }
        return false;
    }
};
struct Operands { const bf16* A; const bf16* Bt; int lda, ldb; };

template <class Addr, class Epi>
__device__ __forceinline__ void gemm_simple(const GroupSched& S, const Addr& AD, const Epi& E, int K) {
    const int tid = threadIdx.x, wid = __builtin_amdgcn_readfirstlane(tid >> 6), lane = tid & 63, wr = wid >> 2, wc = wid & 3, fr = lane & 15, fq = lane >> 4;
    Unit u;
    for (int i = 0; S.next(i, u); ++i) {
        const Operands op = AD(u);
        f32x4 acc[2][2][4][2];
#pragma unroll
        for (int a = 0; a < 2; ++a)
#pragma unroll
            for (int b = 0; b < 2; ++b)
#pragma unroll
                for (int m = 0; m < 4; ++m)
#pragma unroll
                    for (int n = 0; n < 2; ++n) acc[a][b][m][n] = (f32x4){0.f, 0.f, 0.f, 0.f};
        const bf16* ap = op.A + (size_t)(wr * 64 + fr) * op.lda + fq * 8;
        const bf16* bp = op.Bt + (size_t)(wc * 32 + fr) * op.ldb + fq * 8;
#pragma unroll 1
        for (int k = 0; k < K; k += 32) {
            bf16x8 bfr[2][2];
#pragma unroll
            for (int b = 0; b < 2; ++b)
#pragma unroll
                for (int n = 0; n < 2; ++n) bfr[b][n] = *(const bf16x8*)(bp + (size_t)(b * 128 + n * 16) * op.ldb + k);
#pragma unroll
            for (int a = 0; a < 2; ++a) {
                bf16x8 af[4];
#pragma unroll
                for (int m = 0; m < 4; ++m) af[m] = *(const bf16x8*)(ap + (size_t)(a * 128 + m * 16) * op.lda + k);
#pragma unroll
                for (int b = 0; b < 2; ++b)
#pragma unroll
                    for (int m = 0; m < 4; ++m)
#pragma unroll
                        for (int n = 0; n < 2; ++n) acc[a][b][m][n] = __builtin_amdgcn_mfma_f32_16x16x32_bf16(bfr[b][n], af[m], acc[a][b][m][n], 0, 0, 0);
            }
        }
        E(acc, u, wr, wc, fr, fq);
    }
}
constexpr int HTB = 128 * 64 * 2;
__device__ __forceinline__ int lds_byte(int r, int c) { const int st = (r >> 4) * 2 + (c >> 5), rr = r & 15, cc = c & 31, ob = rr * 64 + cc * 2; return st * 1024 + (ob ^ (((ob >> 9) & 1) << 5)); }
__device__ __forceinline__ void stage_rc(int b, int& R, int& C) { const int st = b / 1024, sb = b % 1024, swz = sb ^ (((sb >> 9) & 1) << 5); R = (st >> 1) * 16 + swz / 64; C = (st & 1) * 32 + (swz % 64) / 2; }
template <class Addr, class Epi>
__device__ __forceinline__ void gemm_fast(LAS unsigned char* lds, const int tid, const GroupSched& S, const Addr& AD, const Epi& E, const int K, const int lda, const int ldb) {
    const int wid = __builtin_amdgcn_readfirstlane(tid >> 6), lane = tid & 63, wr = wid >> 2, wc = wid & 3, fr = lane & 15, fq = lane >> 4;
    const int nt = K / 64;
    unsigned voffA[2], voffB[2];
#pragma unroll
    for (int i = 0; i < 2; ++i) { int R, C; stage_rc(tid * 16 + i * 8192, R, C); voffA[i] = (unsigned)(R * lda + C) * 2u; voffB[i] = (unsigned)(R * ldb + C) * 2u; }
    const size_t kstep = 128;
    const size_t hstepA = (size_t)128 * lda * 2, hstepB = (size_t)128 * ldb * 2;
    const unsigned ldsw = (unsigned)wid * 1024u;
    const int aoff = lds_byte(wr * 64 + fr, fq * 8), boff = lds_byte(wc * 32 + fr, fq * 8);
#define PG8_SA(b, h) (((b) * 2 + (h)) * HTB)
#define PG8_SB(b, h) ((4 + (b) * 2 + (h)) * HTB)
#define PG8_STAGE(bufoff, gbase, voff) do { _Pragma("unroll") for (int _i = 0; _i < 2; ++_i) \
        __builtin_amdgcn_global_load_lds((const unsigned*)((const char*)(gbase) + (voff)[_i]), (LAS unsigned*)(lds + (bufoff) + ldsw + _i * 8192), 16, 0, 0); } while (0)
#define PG8_LDA(dst, b, h) do { _Pragma("unroll") for (int m = 0; m < 4; ++m) _Pragma("unroll") for (int k = 0; k < 2; ++k) dst[m][k] = *(const LAS bf16x8*)(lds + PG8_SA(b, h) + aoff + m * 2048 + k * 1024); } while (0)
#define PG8_LDB(dst, b, h) do { _Pragma("unroll") for (int n = 0; n < 2; ++n) _Pragma("unroll") for (int k = 0; k < 2; ++k) dst[n][k] = *(const LAS bf16x8*)(lds + PG8_SB(b, h) + boff + n * 2048 + k * 1024); } while (0)
#define PG8_MMA(ai, bj, At, Bt) do { __builtin_amdgcn_s_setprio(1); _Pragma("unroll") for (int m = 0; m < 4; ++m) _Pragma("unroll") for (int n = 0; n < 2; ++n) _Pragma("unroll") for (int k = 0; k < 2; ++k) \
        acc[ai][bj][m][n] = __builtin_amdgcn_mfma_f32_16x16x32_bf16(Bt[n][k], At[m][k], acc[ai][bj][m][n], 0, 0, 0); __builtin_amdgcn_s_setprio(0); } while (0)
#define PG8_WAIT_V(n) asm volatile("s_waitcnt vmcnt(" #n ")" ::: "memory")
#define PG8_WAIT_L(n) asm volatile("s_waitcnt lgkmcnt(" #n ")" ::: "memory")
#define PG8_BAR __builtin_amdgcn_s_barrier()
#define PG8_SCHED __builtin_amdgcn_sched_barrier(0)
    Unit cur, nxt; int ui = 0;
    if (!S.next(0, cur)) return;
    f32x4 acc[2][2][4][2];
#pragma unroll
    for (int a = 0; a < 2; ++a)
#pragma unroll
        for (int b = 0; b < 2; ++b)
#pragma unroll
            for (int m = 0; m < 4; ++m)
#pragma unroll
                for (int n = 0; n < 2; ++n) acc[a][b][m][n] = (f32x4){0.f, 0.f, 0.f, 0.f};
    bf16x8 At[4][2], B0[2][2], B1[2][2];
    const char* cA; const char* cB;
    { const Operands op = AD(cur); cA = (const char*)op.A; cB = (const char*)op.Bt; }
    PG8_STAGE(PG8_SB(0, 0), cB, voffB); PG8_STAGE(PG8_SB(0, 1), cB + hstepB, voffB); PG8_STAGE(PG8_SA(0, 0), cA, voffA); PG8_STAGE(PG8_SA(0, 1), cA + hstepA, voffA);
    if (wr == 1) PG8_BAR;
    PG8_WAIT_V(2); PG8_BAR;
    PG8_STAGE(PG8_SB(1, 0), cB + kstep, voffB); PG8_STAGE(PG8_SA(1, 0), cA + kstep, voffA); PG8_STAGE(PG8_SB(1, 1), cB + hstepB + kstep, voffB);
    PG8_WAIT_V(6); PG8_BAR;
    for (;;) {
        const bool has_next = S.next(ui + 1, nxt);
        const char* nA = cA; const char* nB = cB;
        if (has_next) { const Operands op = AD(nxt); nA = (const char*)op.A; nB = (const char*)op.Bt; }
#pragma unroll 1
        for (int t = 0; t < nt; t += 2) {
            const bool last = (t == nt - 2);
            const char* a1 = cA + (size_t)(t + 1) * kstep;
            const char* a2 = last ? nA : cA + (size_t)(t + 2) * kstep; const char* b2 = last ? nB : cB + (size_t)(t + 2) * kstep;
            const char* a3 = a2 + kstep; const char* b3 = b2 + kstep;
            PG8_LDB(B0, 0, 0); PG8_LDB(B1, 0, 1); PG8_SCHED; PG8_LDA(At, 0, 0); PG8_STAGE(PG8_SA(1, 1), a1 + hstepA, voffA);
            PG8_WAIT_V(8); PG8_WAIT_L(0); PG8_BAR; PG8_MMA(0, 0, At, B0); PG8_MMA(0, 1, At, B1); PG8_BAR; PG8_SCHED;
            PG8_LDA(At, 0, 1); PG8_STAGE(PG8_SB(0, 0), b2, voffB); PG8_STAGE(PG8_SB(0, 1), b2 + hstepB, voffB); PG8_STAGE(PG8_SA(0, 0), a2, voffA);
            PG8_WAIT_V(8); PG8_WAIT_L(0); PG8_BAR; PG8_MMA(1, 0, At, B0); PG8_MMA(1, 1, At, B1); PG8_BAR; PG8_SCHED;
            PG8_LDB(B0, 1, 0); PG8_LDB(B1, 1, 1); PG8_SCHED; PG8_LDA(At, 1, 0); PG8_STAGE(PG8_SA(0, 1), a2 + hstepA, voffA);
            PG8_WAIT_V(8); PG8_WAIT_L(0); PG8_BAR; PG8_MMA(0, 0, At, B0); PG8_MMA(0, 1, At, B1); PG8_BAR; PG8_SCHED;
            PG8_LDA(At, 1, 1); PG8_STAGE(PG8_SB(1, 0), b3, voffB); PG8_STAGE(PG8_SB(1, 1), b3 + hstepB, voffB); PG8_STAGE(PG8_SA(1, 0), a3, voffA);
            PG8_WAIT_V(8); PG8_WAIT_L(0); PG8_BAR; PG8_MMA(1, 0, At, B0); PG8_MMA(1, 1, At, B1); PG8_BAR; PG8_SCHED;
        }
        if (wr == 0) PG8_BAR;
        { int fr2 = fr, fq2 = fq; asm volatile("" : "+v"(fr2), "+v"(fq2));
          E(acc, cur, wr, wc, fr2, fq2); }
        if (!has_next) break;
#pragma unroll
        for (int a = 0; a < 2; ++a)
#pragma unroll
            for (int b = 0; b < 2; ++b)
#pragma unroll
                for (int m = 0; m < 4; ++m)
#pragma unroll
                    for (int n = 0; n < 2; ++n) acc[a][b][m][n] = (f32x4){0.f, 0.f, 0.f, 0.f};
        cur = nxt; cA = nA; cB = nB; ++ui;
        if (wr == 1) PG8_BAR;
    }
    PG8_WAIT_V(0);
    PG8_BAR;
#undef PG8_SA
#undef PG8_SB
#undef PG8_STAGE
#undef PG8_LDA
#undef PG8_LDB
#undef PG8_MMA
#undef PG8_WAIT_V
#undef PG8_WAIT_L
#undef PG8_BAR
#undef PG8_SCHED
}
#ifndef DUP_PH
#define DUP_PH -1
#endif
#define REP_BEGIN(k) _Pragma("unroll 1") for (int rep_ = 0; rep_ < ((DUP_PH == (k)) ? 2 : 1); ++rep_) { if (rep_) { if constexpr (PH < 0) xcd_barrier(bar); }
#define REP_END }
#ifndef USE_FAST
#define USE_FAST 1
#endif
#if USE_FAST
#define GEMM(S, AD, E, K, lda, ldb) gemm_fast(F.lds, F.tid, S, AD, E, K, lda, ldb)
#else
#define GEMM(S, AD, E, K, lda, ldb) gemm_simple(S, AD, E, K)
#endif
#define EPI_ARGS const f32x4 (&acc)[2][2][4][2], const Unit& u, int wr, int wc, int fr, int fq
#define EPI_FOR(BODY) _Pragma("unroll") for (int ai = 0; ai < 2; ++ai) _Pragma("unroll") for (int m = 0; m < 4; ++m) { const int r = ai * 128 + wr * 64 + m * 16 + fr; \
    _Pragma("unroll") for (int bj = 0; bj < 2; ++bj) _Pragma("unroll") for (int n = 0; n < 2; ++n) { const int c = bj * 128 + wc * 32 + n * 16 + 4 * fq; const f32x4 v = acc[ai][bj][m][n]; BODY } }
__device__ __forceinline__ void st_bf4(bf16* p, f32x4 v) { u32x2 w; w.x = pk2(v[0], v[1]); w.y = pk2(v[2], v[3]); *(u32x2*)p = w; }

__device__ __forceinline__ void p_mod(const Params& P, Frame& F) {
    LAS float* sc = (LAS float*)F.lds;
    LAS float* red = (LAS float*)(F.lds + 9 * 1024 * 4);
    float* MOD = WSP(float, WS_MOD);
    bool have = false;
    for (int it = F.bid; it < 2 * 96; it += F.G) {
        if (!have) {
            for (int i = F.tid; i < 9 * 1024; i += NTHREADS) { const int r = i >> 10, k = i & 1023; const float v = r < 8 ? P.c[r * 1024 + k] : P.c_ctx[k]; sc[i] = v * sigmoidf_(v); }
            have = true;
        }
        __syncthreads();
        const int l = it / 96, j0 = (it % 96) * 64, jj = F.tid & 63, kc = F.tid >> 6;
        const float* W = P.ada_w + (size_t)l * 1024 * 6144 + j0 + jj;
        float a[9];
#pragma unroll
        for (int r = 0; r < 9; ++r) a[r] = 0.f;
        for (int k = kc * 128; k < kc * 128 + 128; ++k) { const float w = W[(size_t)k * 6144];
#pragma unroll
            for (int r = 0; r < 9; ++r) a[r] += sc[r * 1024 + k] * w; }
#pragma unroll
        for (int r = 0; r < 9; ++r) red[(kc * 9 + r) * 64 + jj] = a[r];
        __syncthreads();
        for (int o = F.tid; o < 9 * 64; o += NTHREADS) { const int r = o >> 6, j = o & 63; float s = 0.f;
#pragma unroll
            for (int q = 0; q < 8; ++q) s += red[(q * 9 + r) * 64 + j];
            MOD[((size_t)l * 9 + r) * 6144 + j0 + j] = s + P.ada_b[l * 6144 + j0 + j]; }
    }
    __syncthreads();
}
__device__ __forceinline__ void p_dftgen(Frame& F) {
    LAS float* tab = (LAS float*)F.lds;
    for (int j = F.tid; j < 4096; j += NTHREADS) tab[j] = cospif((float)j * (1.0f / 2048.0f));
    __syncthreads();
    bf16* DM_ = WSP(bf16, WS_DFTM); bf16* DC_ = WSP(bf16, WS_DFTC);
    const int nchunk = 4096 * 1024 + 256 * 64;
    for (int ch = F.bid * NTHREADS + F.tid; ch < nchunk; ch += F.G * NTHREADS) {
        float v[8]; bf16* dst;
        if (ch < 4096 * 1024) { const int kf = ch >> 10, col0 = (ch & 1023) * 8, cs = col0 >> 12, l0 = col0 & 4095;
#pragma unroll
            for (int i = 0; i < 8; ++i) { const int j = (kf * (l0 + i)) & 4095; v[i] = cs ? -tab[(j + 3072) & 4095] : tab[j]; }
            dst = DM_ + (size_t)kf * 8192 + col0; }
        else { const int c2 = ch - 4096 * 1024, kf = c2 >> 6, col0 = (c2 & 63) * 8, cs = col0 >> 8, l0 = col0 & 255;
#pragma unroll
            for (int i = 0; i < 8; ++i) { const int j = ((kf * (l0 + i)) & 255) * 16; v[i] = cs ? -tab[(j + 3072) & 4095] : tab[j]; }
            dst = DC_ + (size_t)kf * 512 + col0; }
        u32x4 o; o.x = pk2(v[0], v[1]); o.y = pk2(v[2], v[3]); o.z = pk2(v[4], v[5]); o.w = pk2(v[6], v[7]);
        *(u32x4*)dst = o;
    }
    __syncthreads();
}
__device__ __forceinline__ void transpose_item(const float* W, int ldw, int k0, int n0, bf16* WT, int ldt, int drow0, LAS float* scr, int lane) {
#pragma unroll 8
    for (int i = 0; i < 32; ++i) { const int kk = 2 * i + (lane >> 5); scr[kk * 33 + (lane & 31)] = W[(size_t)(k0 + kk) * ldw + n0 + (lane & 31)]; }
    LDS_WAIT(); asm volatile("" ::: "memory");
    const int c = lane & 7;
#pragma unroll
    for (int j = 0; j < 4; ++j) { const int n = (lane >> 3) + 8 * j; const LAS float* s = scr + (8 * c) * 33 + n;
        u32x4 o; o.x = pk2(s[0 * 33], s[1 * 33]); o.y = pk2(s[2 * 33], s[3 * 33]); o.z = pk2(s[4 * 33], s[5 * 33]); o.w = pk2(s[6 * 33], s[7 * 33]);
        *(u32x4*)(WT + (size_t)(drow0 + n) * ldt + k0 + 8 * c) = o; }
    LDS_WAIT(); asm volatile("" ::: "memory");
}
__device__ __forceinline__ void p_wconv(const Params& P, Frame& F, int l) {
    LAS float* scr = (LAS float*)(F.lds + F.wave * 16384);
    const int gw = F.bid * NWAVES + F.wave, NGW = F.G * NWAVES;
    const float* w_in = P.w_in + (size_t)l * 1024 * INW;
    bf16* WA = WSP(bf16, WS_WA); bf16* WFV = WSP(bf16, WS_WFV);
    constexpr int I_K = 16 * 32, I_Q = 16 * 32, I_P = 16 * 16, I_G = 16 * 96, I_V = 16 * 32, I_AO = 16 * 32, I_FO = 8 * 32, I_OUT = 16 * 32;
    constexpr int NSM = I_K + I_Q + I_P + I_G + I_V + I_AO + I_FO + I_OUT;
    for (int it = gw; it < NSM; it += NGW) {
        int r = it;
        if (r < I_K) { transpose_item(w_in, INW, (r / 32) * 64, 0 + (r % 32) * 32, WA, 1024, 0 + (r % 32) * 32, scr, F.lane); continue; } r -= I_K;
        if (r < I_Q) { transpose_item(w_in, INW, (r / 32) * 64, 2048 + (r % 32) * 32, WA, 1024, 1024 + (r % 32) * 32, scr, F.lane); continue; } r -= I_Q;
        if (r < I_P) { transpose_item(w_in, INW, (r / 16) * 64, 3584 + (r % 16) * 32, WA, 1024, 2048 + (r % 16) * 32, scr, F.lane); continue; } r -= I_P;
        if (r < I_G) { transpose_item(w_in, INW, (r / 96) * 64, 4096 + (r % 96) * 32, WA, 1024, 2560 + (r % 96) * 32, scr, F.lane); continue; } r -= I_G;
        if (r < I_V) { transpose_item(w_in, INW, (r / 32) * 64, 1024 + (r % 32) * 32, WFV, 1024, 1024 + (r % 32) * 32, scr, F.lane); continue; } r -= I_V;
        if (r < I_AO) { transpose_item(P.w_att_o + (size_t)l * 1024 * 1024, 1024, (r / 32) * 64, (r % 32) * 32, WSP(bf16, WS_WAO), 1024, (r % 32) * 32, scr, F.lane); continue; } r -= I_AO;
        if (r < I_FO) { transpose_item(P.w_fourier + (size_t)l * 512 * 1024, 1024, (r / 32) * 64, (r % 32) * 32, WSP(bf16, WS_WFO), 512, (r % 32) * 32, scr, F.lane); continue; } r -= I_FO;
        transpose_item(P.w_out + (size_t)l * 1024 * 1024, 1024, (r / 32) * 64, (r % 32) * 32, WSP(bf16, WS_WOUT), 1024, (r % 32) * 32, scr, F.lane);
    }
    constexpr int I_E = 16 * 88;
    bf16* WGU = WSP(bf16, WS_WGU); bf16* WD = WSP(bf16, WS_WD);
    for (int it = gw; it < 3 * 16 * I_E; it += NGW) {
        const int which = it / (16 * I_E), r0 = it % (16 * I_E), e = r0 / I_E, r = r0 % I_E;
        if (which < 2) { const int kb = r / 88, nb = r % 88, n0 = nb * 32;
            const float* src = (which == 0 ? P.w_eg : P.w_eu) + ((size_t)l * 16 + e) * 1024 * FF;
            transpose_item(src, FF, kb * 64, n0, WGU + (size_t)e * 5632 * 1024, 1024, (n0 >> 7) * 256 + (which ? 128 : 0) + (n0 & 127), scr, F.lane); }
        else { const int kb = r / 32, nb = r % 32;
            transpose_item(P.w_ed + ((size_t)l * 16 + e) * FF * 1024, 1024, kb * 64, nb * 32, WD + (size_t)e * 1024 * FF, FF, nb * 32, scr, F.lane); }
    }
    { bf16* WPO = WSP(bf16, WS_WPO); const float* wp = P.w_pool + (size_t)l * 4 * 128 * 256;
      for (int i = F.bid * NTHREADS + F.tid; i < 1024 * 256; i += F.G * NTHREADS) { const int n = i >> 8, kk = i & 255, g = n >> 8, f = n & 255;
          WPO[i] = (bf16)(((kk >> 7) == (g & 1)) ? f2bf(wp[((size_t)g * 128 + (kk & 127)) * 256 + f]) : 0u); } }
    { LAS float* t128 = (LAS float*)F.lds;
      __syncthreads();
      for (int j = F.tid; j < 128; j += NTHREADS) t128[j] = cospif((float)j * (1.0f / 64.0f));
      __syncthreads();
      for (int i = F.bid * NTHREADS + F.tid; i < 1024 * 1024; i += F.G * NTHREADS) { const int fc = i >> 10, k = i & 1023, cs = fc & 1, gm = fc >> 1, g = gm >> 7, m = gm & 127;
          const float* src = w_in + (size_t)k * INW + 3072 + g * 128; float s = 0.f; const int ph = cs ? 96 : 0;
          for (int c = 0; c < 128; ++c) s += src[c] * t128[(m * c + ph) & 127];
          WFV[i] = (bf16)f2bf(s); }
      __syncthreads(); }
}

struct RowMod { const float* g; const float* sh; const float* sc; };
__device__ __forceinline__ void row_load(const float* row, int lane, f32x4 (&v)[4]) {
#pragma unroll
    for (int j = 0; j < 4; ++j) v[j] = *(const f32x4*)(row + 4 * lane + 256 * j);
}
__device__ __forceinline__ float row_rstd(const f32x4 (&v)[4]) {
    float s = 0.f;
#pragma unroll
    for (int j = 0; j < 4; ++j) s += (v[j][0] * v[j][0] + v[j][1] * v[j][1]) + (v[j][2] * v[j][2] + v[j][3] * v[j][3]);
    return rsqrtf(wave_sum(s) * (1.0f / 1024.0f) + RMS_EPS);
}
__device__ __forceinline__ void row_modulate(const f32x4 (&v)[4], float rstd, const RowMod& M, int lane, f32x4 (&y)[4]) {
#pragma unroll
    for (int j = 0; j < 4; ++j) { const int k = 4 * lane + 256 * j; const f32x4 g = *(const f32x4*)(M.g + k), sh = *(const f32x4*)(M.sh + k), sc = *(const f32x4*)(M.sc + k);
        y[j] = v[j] * rstd * g * (sc + 1.0f) + sh; }
}
__device__ __forceinline__ void row_store_bf(bf16* row, int lane, const f32x4 (&y)[4]) {
#pragma unroll
    for (int j = 0; j < 4; ++j) st_bf4(row + 4 * lane + 256 * j, y[j]);
}
__device__ __forceinline__ const float* mod_ptr(Frame& F, int l, int row, int which) { const int mr = row < RL ? (row >> 12) : 8; return WSP(float, WS_MOD) + ((size_t)l * 9 + mr) * 6144 + which * 1024; }

__device__ __forceinline__ void p_rowpass_a0(const Params& P, Frame& F) {
    const int gw = F.bid * NWAVES + F.wave, NGW = F.G * NWAVES; bf16* H = WSP(bf16, WS_H);
    for (int row = gw; row < RT; row += NGW) {
        const float* src = row < RL ? P.x + (size_t)row * DM : P.ctx + (size_t)(row - RL) * DM;
        f32x4 v[4], y[4]; row_load(src, F.lane, v); const float rs = row_rstd(v);
        RowMod M{P.norm1_g, mod_ptr(F, 0, row, 0), mod_ptr(F, 0, row, 1)};
        row_modulate(v, rs, M, F.lane, y); row_store_bf(H + (size_t)row * DM, F.lane, y);
    }
}
__device__ __forceinline__ void p_rowpass_f(const Params& P, Frame& F, int l, int nrows) {
    const int gw = F.bid * NWAVES + F.wave, NGW = F.G * NWAVES; bf16* H = WSP(bf16, WS_H); float* AFF = WSP(float, WS_AFF);
    const float* wr = P.w_router + (size_t)l * 1024 * 16;
    LAS float* wl = (LAS float*)F.lds;
    __syncthreads();
    for (int i = F.tid; i < 16384; i += NTHREADS) wl[(i & 15) * 1024 + (i >> 4)] = wr[i];
    __syncthreads();
    for (int row = gw; row < nrows; row += NGW) {
        const float* src = row < RL ? P.out + (size_t)row * DM : WSP(float, WS_XC) + (size_t)(row - RL) * DM;
        f32x4 v[4], y[4]; row_load(src, F.lane, v); const float rs = row_rstd(v);
        RowMod M{P.norm2_g + l * 1024, mod_ptr(F, l, row, 3), mod_ptr(F, l, row, 4)};
        row_modulate(v, rs, M, F.lane, y); row_store_bf(H + (size_t)row * DM, F.lane, y);
        float lg[16];
        int wo = 4 * F.lane; asm volatile("" : "+v"(wo));
#pragma unroll
        for (int e = 0; e < 16; ++e) { float a = 0.f;
#pragma unroll
            for (int j = 0; j < 4; ++j) { const f32x4 w = *(const LAS f32x4*)(wl + e * 1024 + wo + 256 * j); a += (y[j][0] * w[0] + y[j][1] * w[1]) + (y[j][2] * w[2] + y[j][3] * w[3]); }
            lg[e] = a; }
        float mx = -1e30f;
#pragma unroll
        for (int e = 0; e < 16; ++e) { lg[e] = wave_sum(lg[e]); mx = fmaxf(mx, lg[e]); }
        float den = 0.f;
#pragma unroll
        for (int e = 0; e < 16; ++e) { lg[e] = __expf(lg[e] - mx); den += lg[e]; }
        const float inv = 1.0f / den;
        if (F.lane < 16) { float mine = 0.f;
#pragma unroll
            for (int e = 0; e < 16; ++e) mine = (F.lane == e) ? lg[e] : mine;
            AFF[(size_t)row * 16 + F.lane] = mine * inv; }
    }
    __syncthreads();
}
__device__ __forceinline__ void p_rowpass_k(const Params& P, Frame& F, int l, int nrows) {
    const int gw = F.bid * NWAVES + F.wave, NGW = F.G * NWAVES; bf16* H = WSP(bf16, WS_H);
    const int* SEL = WSP(int, WS_SEL); const bf16* Y = WSP(bf16, WS_Y);
    for (int row = gw; row < nrows; row += NGW) {
        float* xr = row < RL ? P.out + (size_t)row * DM : WSP(float, WS_XC) + (size_t)(row - RL) * DM;
        f32x4 v[4], a[4]; row_load(xr, F.lane, v);
#pragma unroll
        for (int j = 0; j < 4; ++j) a[j] = (f32x4){0.f, 0.f, 0.f, 0.f};
        for (int e = 0; e < 16; ++e) { const int s = SEL[(size_t)row * 16 + e];
            if (s >= 0) { const bf16* yr = Y + (size_t)s * DM;
#pragma unroll
                for (int j = 0; j < 4; ++j) { const u32x2 w = *(const u32x2*)(yr + 4 * F.lane + 256 * j); a[j][0] += bflo(w.x); a[j][1] += bfhi(w.x); a[j][2] += bflo(w.y); a[j][3] += bfhi(w.y); } } }
        const float* g2 = mod_ptr(F, l, row, 5);
#pragma unroll
        for (int j = 0; j < 4; ++j) { const f32x4 g = *(const f32x4*)(g2 + 4 * F.lane + 256 * j); v[j] = v[j] + g * a[j]; }
        const float rs = row_rstd(v);
        if (l == 0) {
#pragma unroll
            for (int j = 0; j < 4; ++j) *(f32x4*)(xr + 4 * F.lane + 256 * j) = v[j];
            f32x4 y[4]; RowMod M{P.norm1_g + 1024, mod_ptr(F, 1, row, 0), mod_ptr(F, 1, row, 1)};
            row_modulate(v, rs, M, F.lane, y); row_store_bf(H + (size_t)row * DM, F.lane, y);
        } else {
#pragma unroll
            for (int j = 0; j < 4; ++j) { const f32x4 g = *(const f32x4*)(P.final_g + 4 * F.lane + 256 * j); *(f32x4*)(xr + 4 * F.lane + 256 * j) = v[j] * rs * g; }
        }
    }
}

__device__ __forceinline__ float dot64(const bf16x8 (&q)[8], const bf16* kp) {
    float s = 0.f;
#pragma unroll
    for (int i = 0; i < 8; ++i) { const u32x4 kw = *(const u32x4*)(kp + 8 * i); const u32x4 qw = __builtin_bit_cast(u32x4, q[i]);
#pragma unroll
        for (int t = 0; t < 4; ++t) s += bflo(kw[t]) * bflo(qw[t]) + bfhi(kw[t]) * bfhi(qw[t]); }
    return s;
}
__device__ __forceinline__ void p_attn_naive(const Params& P, Frame& F, int l, bool with_ctx_queries) {
    const int gw = F.bid * NWAVES + F.wave, NGW = F.G * NWAVES;
    const bf16* KQ = WSP(bf16, WS_KQ); const bf16* VT = WSP(bf16, WS_VT); bf16* ATT = WSP(bf16, WS_ATT);
    LAS float* pw = (LAS float*)(F.lds + F.wave * 2048);
    const float* rpb = P.rpb + (size_t)l * 16 * 15 * 31;
    const int nlat = NB * 64 * NH * 64, nitems = nlat + (with_ctx_queries ? NB * NH * CTXL : 0);
    for (int it = gw; it < nitems; it += NGW) {
        const bool lat = it < nlat;
        int b, h, r = 0, qc = 0, rowq;
        if (lat) { qc = it & 63; h = (it >> 6) & 15; r = (it >> 10) & 63; b = it >> 16; rowq = b * SEQ + r * 64 + qc; }
        else { const int i2 = it - nlat; qc = i2 & 255; h = (i2 >> 8) & 15; b = i2 >> 12; rowq = RL + b * CTXL + qc; }
        bf16x8 q[8];
        { const bf16* qp = KQ + (size_t)rowq * 2048 + 1024 + h * 64;
#pragma unroll
          for (int i = 0; i < 8; ++i) q[i] = *(const bf16x8*)(qp + 8 * i); }
        const int rs = min(max(r - 4, 0), 56), cs = min(max(qc - 8, 0), 48);
        float s[6];
        if (lat) {
#pragma unroll
            for (int t = 0; t < 2; ++t) { const int w = F.lane + 64 * t, i = w >> 4, j = w & 15; const int tok = (rs + i) * 64 + cs + j;
                s[t] = dot64(q, KQ + (size_t)(b * SEQ + tok) * 2048 + h * 64) * 0.125f + rpb[(h * 15 + (rs + i - r + 7)) * 31 + (cs + j - qc + 15)]; }
        } else { s[0] = -1e30f; s[1] = -1e30f; }
#pragma unroll
        for (int t = 0; t < 4; ++t) { const int c = F.lane + 64 * t; s[2 + t] = dot64(q, KQ + (size_t)(RL + b * CTXL + c) * 2048 + h * 64) * 0.125f; }
        float mx = s[0];
#pragma unroll
        for (int t = 1; t < 6; ++t) mx = fmaxf(mx, s[t]);
        mx = wave_max(mx);
        float sum = 0.f;
#pragma unroll
        for (int t = 0; t < 6; ++t) { s[t] = (lat || t >= 2) ? __expf(s[t] - mx) : 0.f; sum += s[t]; }
        sum = wave_sum(sum);
        pw[F.lane] = s[0]; pw[F.lane + 64] = s[1];
#pragma unroll
        for (int t = 0; t < 4; ++t) pw[128 + F.lane + 64 * t] = s[2 + t];
        LDS_WAIT(); asm volatile("" ::: "memory");
        float o = 0.f;
        if (lat) { const bf16* vr = VT + ((size_t)b * 1024 + h * 64 + F.lane) * 4096;
#pragma unroll 2
            for (int w = 0; w < 128; ++w) { const int tok = (rs + (w >> 4)) * 64 + cs + (w & 15); o += pw[w] * bf2f(vr[tok]); } }
        { const bf16* vr = VT + YT_CTX_OFF + ((size_t)b * 1024 + h * 64 + F.lane) * 256;
#pragma unroll 2
          for (int c8 = 0; c8 < 32; ++c8) { const u32x4 vw = *(const u32x4*)(vr + 8 * c8); const LAS float* pp = pw + 128 + 8 * c8;
#pragma unroll
              for (int t = 0; t < 4; ++t) o += pp[2 * t] * bflo(vw[t]) + pp[2 * t + 1] * bfhi(vw[t]); } }
        ATT[(size_t)rowq * 1024 + h * 64 + F.lane] = (bf16)f2bf(o / sum);
        LDS_WAIT(); asm volatile("" ::: "memory");
    }
}

__device__ __forceinline__ void attn_unit(const bf16* __restrict__ KQ, const bf16* __restrict__ VT, bf16* __restrict__ ATT, const float* __restrict__ rpbh,
                                          const int b, const int h, const int r, const int qt, const bool lat, const int lane) {
    const int l15 = lane & 15, g = lane >> 4;
    const int rowq0 = lat ? b * SEQ + r * 64 + 16 * qt : RL + b * CTXL + 16 * qt;
    bf16x8 qf[2];
    { const bf16* qp = KQ + (size_t)(rowq0 + l15) * 2048 + 1024 + h * 64 + 8 * g; qf[0] = *(const bf16x8*)qp; qf[1] = *(const bf16x8*)(qp + 32); }
    const int rs = min(max(r - 4, 0), 56), kc0 = min(max(16 * qt - 8, 0), 32);
    const f32x4 z = {0.f, 0.f, 0.f, 0.f};
    float m = -1e30f, sum = 0.f;
    f32x4 o[4];
#pragma unroll
    for (int dt = 0; dt < 4; ++dt) o[dt] = z;
#define ATT_CHUNK_TAIL() do { \
        cm = fmaxf(cm, __shfl_xor(cm, 16)); cm = fmaxf(cm, __shfl_xor(cm, 32)); \
        const float mn = fmaxf(m, cm), scl = __expf(m - mn); m = mn; float ps = 0.f; \
        _Pragma("unroll") for (int t = 0; t < 4; ++t) _Pragma("unroll") for (int j = 0; j < 4; ++j) { const float p = __expf(sc[t][j] - mn); sc[t][j] = p; ps += p; } \
        sum = sum * scl + ps; \
        _Pragma("unroll") for (int dt = 0; dt < 4; ++dt) o[dt] = o[dt] * scl; \
        _Pragma("unroll") for (int ks = 0; ks < 2; ++ks) { u32x4 pw; pw.x = pk2(sc[2 * ks][0], sc[2 * ks][1]); pw.y = pk2(sc[2 * ks][2], sc[2 * ks][3]); pw.z = pk2(sc[2 * ks + 1][0], sc[2 * ks + 1][1]); pw.w = pk2(sc[2 * ks + 1][2], sc[2 * ks + 1][3]); \
            const bf16x8 pf = __builtin_bit_cast(bf16x8, pw); \
            _Pragma("unroll") for (int dt = 0; dt < 4; ++dt) o[dt] = __builtin_amdgcn_mfma_f32_16x16x32_bf16(__builtin_bit_cast(bf16x8, vw[ks][dt]), pf, o[dt], 0, 0, 0); } } while (0)
    if (lat) {
        const bf16* kb = KQ + (size_t)(b * SEQ + rs * 64 + kc0 + l15) * 2048 + h * 64 + 8 * g;
        const bf16* vb = VT + (size_t)(b * 1024 + h * 64 + l15) * 4096 + rs * 64 + kc0 + 4 * g;
        const int q = 16 * qt + l15, csq = min(max(q - 8, 0), 48);
#pragma unroll 1
        for (int c = 0; c < 4; ++c) {
            bf16x8 kf[4][2]; u32x4 vw[2][4]; f32x4 sc[4];
#pragma unroll
            for (int t = 0; t < 4; ++t) { const bf16* kp = kb + (size_t)((2 * c + (t >> 1)) * 64 + (t & 1) * 16) * 2048; kf[t][0] = *(const bf16x8*)kp; kf[t][1] = *(const bf16x8*)(kp + 32); }
#pragma unroll
            for (int ks = 0; ks < 2; ++ks)
#pragma unroll
                for (int dt = 0; dt < 4; ++dt) { const bf16* vp = vb + (size_t)(16 * dt) * 4096 + (2 * c + ks) * 64; const u32x2 v0 = *(const u32x2*)vp, v1 = *(const u32x2*)(vp + 16); vw[ks][dt] = (u32x4){v0.x, v0.y, v1.x, v1.y}; }
#pragma unroll
            for (int t = 0; t < 4; ++t) { sc[t] = __builtin_amdgcn_mfma_f32_16x16x32_bf16(kf[t][0], qf[0], z, 0, 0, 0); sc[t] = __builtin_amdgcn_mfma_f32_16x16x32_bf16(kf[t][1], qf[1], sc[t], 0, 0, 0); }
            float cm = -1e30f;
#pragma unroll
            for (int t = 0; t < 4; ++t) { const float* bp = rpbh + (rs + 2 * c + (t >> 1) - r + 7) * 31;
#pragma unroll
                for (int j = 0; j < 4; ++j) { const int jc = kc0 + 16 * (t & 1) + 4 * g + j; const bool ok = (jc >= csq) && (jc < csq + 16); const int bi = min(max(jc - q + 15, 0), 30);
                    float v = sc[t][j] * 0.125f + bp[bi]; v = ok ? v : -1e30f; sc[t][j] = v; cm = fmaxf(cm, v); } }
            ATT_CHUNK_TAIL();
        }
    }
    { const bf16* kb = KQ + (size_t)(RL + b * CTXL + l15) * 2048 + h * 64 + 8 * g;
      const bf16* vb = VT + YT_CTX_OFF + (size_t)(b * 1024 + h * 64 + l15) * 256 + 4 * g;
#pragma unroll 1
      for (int c = 0; c < 4; ++c) {
          bf16x8 kf[4][2]; u32x4 vw[2][4]; f32x4 sc[4];
#pragma unroll
          for (int t = 0; t < 4; ++t) { const bf16* kp = kb + (size_t)(64 * c + 16 * t) * 2048; kf[t][0] = *(const bf16x8*)kp; kf[t][1] = *(const bf16x8*)(kp + 32); }
#pragma unroll
          for (int ks = 0; ks < 2; ++ks)
#pragma unroll
              for (int dt = 0; dt < 4; ++dt) { const bf16* vp = vb + (size_t)(16 * dt) * 256 + 64 * c + 32 * ks; const u32x2 v0 = *(const u32x2*)vp, v1 = *(const u32x2*)(vp + 16); vw[ks][dt] = (u32x4){v0.x, v0.y, v1.x, v1.y}; }
#pragma unroll
          for (int t = 0; t < 4; ++t) { sc[t] = __builtin_amdgcn_mfma_f32_16x16x32_bf16(kf[t][0], qf[0], z, 0, 0, 0); sc[t] = __builtin_amdgcn_mfma_f32_16x16x32_bf16(kf[t][1], qf[1], sc[t], 0, 0, 0); }
          float cm = -1e30f;
#pragma unroll
          for (int t = 0; t < 4; ++t)
#pragma unroll
              for (int j = 0; j < 4; ++j) { const float v = sc[t][j] * 0.125f; sc[t][j] = v; cm = fmaxf(cm, v); }
          ATT_CHUNK_TAIL();
      } }
#undef ATT_CHUNK_TAIL
    sum += __shfl_xor(sum, 16); sum += __shfl_xor(sum, 32);
    const float inv = 1.0f / sum;
#pragma unroll
    for (int dt = 0; dt < 4; ++dt) st_bf4(ATT + (size_t)(rowq0 + l15) * 1024 + h * 64 + 16 * dt + 4 * g, o[dt] * inv);
}
__device__ __forceinline__ void p_attn_mfma(const Params& P, Frame& F, int l, bool with_ctx_queries) {
    const bf16* KQ = WSP(bf16, WS_KQ); const bf16* VT = WSP(bf16, WS_VT); bf16* ATT = WSP(bf16, WS_ATT);
    const float* rpb = P.rpb + (size_t)l * 16 * 465;
    for (int hp = F.bid; hp < 256; hp += F.G) {
        const int p = hp & 127, half = hp >> 7, b = p >> 4, h = p & 15;
#pragma unroll 1
        for (int it = 0; it < 16; ++it) attn_unit(KQ, VT, ATT, rpb + h * 465, b, h, half * 32 + it * 2 + (F.wave >> 2), F.wave & 3, true, F.lane);
    }
    if (with_ctx_queries) { const int gw = F.bid * NWAVES + F.wave, NGW = F.G * NWAVES;
#pragma unroll 1
        for (int u = gw; u < NB * NH * 16; u += NGW) { const int b = u >> 8, h = (u >> 4) & 15; attn_unit(KQ, VT, ATT, rpb + h * 465, b, h, 0, u & 15, false, F.lane); } }
}

__device__ __forceinline__ void p_pool(Frame& F, int nrows) {
    const bf16* PB = WSP(bf16, WS_PB); bf16* POOL = WSP(bf16, WS_POOL);
    for (int i = F.bid * NTHREADS + F.tid; i < nrows * 64; i += F.G * NTHREADS) {
        const int row = i >> 6, ch = i & 63, g = ch >> 4, hw = 1 << g;
        int base, t, Lb; if (row < RL) { base = row & ~4095; t = row & 4095; Lb = SEQ; } else { const int rr = row - RL; base = RL + (rr & ~255); t = rr & 255; Lb = CTXL; }
        const int lo = max(t - hw, 0), hi = min(t + hw, Lb);
        float a[8];
#pragma unroll
        for (int q = 0; q < 8; ++q) a[q] = 0.f;
        for (int tt = lo; tt < hi; ++tt) { const u32x4 w = *(const u32x4*)(PB + (size_t)(base + tt) * 512 + ch * 8);
#pragma unroll
            for (int q = 0; q < 4; ++q) { a[2 * q] += bflo(w[q]); a[2 * q + 1] += bfhi(w[q]); } }
        const u32x4 me = *(const u32x4*)(PB + (size_t)row * 512 + ch * 8); const float inv = 1.0f / (float)(hi - lo);
        u32x4 o;
#pragma unroll
        for (int q = 0; q < 4; ++q) o[q] = pk2(a[2 * q] * inv - bflo(me[q]), a[2 * q + 1] * inv - bfhi(me[q]));
        *(u32x4*)(POOL + (size_t)row * 512 + ch * 8) = o;
    }
}

__device__ __forceinline__ int block_sum_i(int v, LAS int* sm, int tid) {
#pragma unroll
    for (int o = 1; o < 64; o <<= 1) v += __shfl_xor(v, o);
    __syncthreads();
    if ((tid & 63) == 0) sm[tid >> 6] = v;
    __syncthreads();
    int s = 0;
#pragma unroll
    for (int i = 0; i < 8; ++i) s += sm[i];
    return s;
}
__device__ __forceinline__ int block_excl_scan(int v, LAS int* sm, int tid, int& total) {
    const int lane = tid & 63, w = tid >> 6; int inc = v;
#pragma unroll
    for (int o = 1; o < 64; o <<= 1) { const int t = __shfl_up(inc, o); if (lane >= o) inc += t; }
    __syncthreads();
    if (lane == 63) sm[w] = inc;
    __syncthreads();
    int base = 0; total = 0;
#pragma unroll
    for (int i = 0; i < 8; ++i) { const int s = sm[i]; if (i < w) base += s; total += s; }
    return base + inc - v;
}
template <int NPT>
__device__ __forceinline__ void topk_pair(Frame& F, int row0, int n, int cap, int e, int slot0) {
    LAS int* sm = (LAS int*)F.lds;
    const float* AFF = WSP(float, WS_AFF); int* SROW = WSP(int, WS_SROW); float* SG = WSP(float, WS_SGATE); int* SEL = WSP(int, WS_SEL);
    unsigned key[NPT];
#pragma unroll
    for (int j = 0; j < NPT; ++j) { const int i = F.tid * NPT + j; key[j] = (i < n) ? __float_as_uint(AFF[(size_t)(row0 + i) * 16 + e]) : 0u; }
    unsigned T = 0u;
    for (int bit = 30; bit >= 0; --bit) { const unsigned cand = T | (1u << bit); int cnt = 0;
#pragma unroll
        for (int j = 0; j < NPT; ++j) cnt += (key[j] >= cand) ? 1 : 0;
        cnt = block_sum_i(cnt, sm, F.tid);
        if (cnt >= cap) T = cand; }
    int ngt = 0, neq = 0;
#pragma unroll
    for (int j = 0; j < NPT; ++j) { ngt += (key[j] > T) ? 1 : 0; neq += (key[j] == T) ? 1 : 0; }
    int tot_gt, tot_eq;
    (void)block_excl_scan(ngt, sm, F.tid, tot_gt);
    int eqr = block_excl_scan(neq, sm, F.tid, tot_eq);
    const int need_eq = cap - tot_gt;
    int nsel = 0; bool selj[NPT];
#pragma unroll
    for (int j = 0; j < NPT; ++j) { bool s = key[j] > T; if (key[j] == T && T != 0u) { s = eqr < need_eq; ++eqr; } selj[j] = s; nsel += s ? 1 : 0; }
    int tot_sel; int pos = block_excl_scan(nsel, sm, F.tid, tot_sel);
#pragma unroll
    for (int j = 0; j < NPT; ++j) { const int i = F.tid * NPT + j;
        if (i < n) { const int row = row0 + i;
            if (selj[j]) { const int slot = slot0 + pos; ++pos; SROW[slot] = row; SG[slot] = __uint_as_float(key[j]); SEL[(size_t)row * 16 + e] = slot; }
            else SEL[(size_t)row * 16 + e] = -1; } }
    __syncthreads();
}
__device__ __forceinline__ void p_topk(Frame& F, bool with_ctx) {
    const int npairs = 128 + (with_ctx ? 128 : 0);
    for (int pi = F.bid; pi < npairs; pi += F.G) {
        if (pi < 128) { const int b = pi >> 4, e = pi & 15; topk_pair<8>(F, b * SEQ, SEQ, CAPL, e, e * SLOT_E + b * CAPL); }
        else { const int p2 = pi - 128, b = p2 >> 4, e = p2 & 15; topk_pair<1>(F, RL + b * CTXL, CTXL, CAPC, e, e * SLOT_E + 4096 + b * CAPC); }
    }
}
__device__ __forceinline__ void p_gather(Frame& F, bool with_ctx) {
    const int gw = F.bid * NWAVES + F.wave, NGW = F.G * NWAVES; const bf16* H = WSP(bf16, WS_H); bf16* XG = WSP(bf16, WS_XG); const int* SROW = WSP(int, WS_SROW);
    for (int s = gw; s < NSLOT; s += NGW) { if (!with_ctx && (s % SLOT_E) >= 4096) continue;
        const int row = SROW[s]; const u32x4* src = (const u32x4*)(H + (size_t)row * DM); u32x4* dst = (u32x4*)(XG + (size_t)s * DM);
        dst[F.lane] = src[F.lane]; dst[F.lane + 64] = src[F.lane + 64]; }
}

template <int PH> __global__ void __launch_bounds__(NTHREADS, 2) fwd_kernel(Params P) {
    extern __shared__ __attribute__((aligned(16))) unsigned char lds_raw[];
    Frame F; F.lds = (LAS unsigned char*)lds_raw; F.tid = threadIdx.x; F.lane = F.tid & 63; F.wave = __builtin_amdgcn_readfirstlane(F.tid >> 6); F.G = gridDim.x; F.bid = blockIdx.x; F.ws = P.ws;
    volatile LAS unsigned* MISC = (volatile LAS unsigned*)(F.lds + LDS_MISC);
    if (F.tid < 64) MISC[F.tid] = 0u;
    __syncthreads();
    XcdBarrier bar; bar.bar = WSP(unsigned, WS_CTL) + CW_BAR; bar.x = 0; bar.st = MISC + 8;
    if constexpr (PH < 0) bar = xcd_barrier_post(WSP(unsigned, WS_CTL) + CW_BAR, MISC + 8);
#define IN(k) (PH < 0 || PH == (k))
#define REFRESH() do { int t_ = threadIdx.x; asm volatile("" : "+v"(t_)); F.tid = t_; F.lane = t_ & 63; F.wave = __builtin_amdgcn_readfirstlane(t_ >> 6); } while (0)
#define SEAM(k) do { if constexpr (PH < 0) xcd_barrier(bar); } while (0)

    if (IN(0)) { REP_BEGIN(100) p_mod(P, F); p_dftgen(F); REP_END REP_BEGIN(101) p_wconv(P, F, 0); REP_END }
    SEAM(0);
    if (IN(1)) { p_rowpass_a0(P, F); }
    SEAM(1);
    for (int l = P.l_lo; l < P.l_hi; ++l) {
        constexpr int pb = 2; const bool L0 = (l == 0);
        bf16* H = WSP(bf16, WS_H);
        if (IN(pb + 0)) { REFRESH(); REP_BEGIN(2)
            { GroupSched S; S.init(1, 128, 22, F.G, F.bid, 8, L0 ? 22 : 4, 128, 0);
              const bf16* WA = WSP(bf16, WS_WA);
              auto AD = [=](const Unit& u) { return Operands{H + (size_t)u.pm * 256 * DM, WA + (size_t)u.pn * 256 * DM, DM, DM}; };
              bf16* KQ = WSP(bf16, WS_KQ); bf16* PBp = WSP(bf16, WS_PB); bf16* GB = WSP(bf16, WS_GB);
              auto E = [=](EPI_ARGS) { const int row0 = u.pm * 256;
                  if (u.pn < 8) { EPI_FOR( st_bf4(KQ + (size_t)(row0 + r) * 2048 + u.pn * 256 + c, v); ) }
                  else if (u.pn < 10) { EPI_FOR( st_bf4(PBp + (size_t)(row0 + r) * 512 + (u.pn - 8) * 256 + c, v); ) }
                  else { EPI_FOR( f32x4 s; s[0] = sigmoidf_(v[0]); s[1] = sigmoidf_(v[1]); s[2] = sigmoidf_(v[2]); s[3] = sigmoidf_(v[3]); st_bf4(GB + (size_t)(row0 + r) * 3072 + (u.pn - 10) * 256 + c, s); ) } };
              GEMM(S, AD, E, DM, DM, DM); }
            { GroupSched S; S.init(1, 8, 128, F.G, F.bid, L0 ? 8 : 4, 8, L0 ? 0 : 4, 128);
              const bf16* WFV = WSP(bf16, WS_WFV);
              auto AD = [=](const Unit& u) { return Operands{WFV + (size_t)u.pm * 256 * DM, H + (size_t)u.pn * 256 * DM, DM, DM}; };
              bf16* YT = WSP(bf16, WS_YT); bf16* VT = WSP(bf16, WS_VT);
              auto E = [=](EPI_ARGS) { bf16* T = (u.pm < 4) ? YT : VT; const int rr0 = (u.pm & 3) * 256;
                  if (u.pn < 128) { const int b = u.pn >> 4, l0 = (u.pn & 15) * 256; EPI_FOR( st_bf4(T + ((size_t)b * 1024 + rr0 + r) * 4096 + l0 + c, v); ) }
                  else { const int b = u.pn - 128; EPI_FOR( st_bf4(T + YT_CTX_OFF + ((size_t)b * 1024 + rr0 + r) * 256 + c, v); ) } };
              GEMM(S, AD, E, DM, DM, DM); }
        REP_END }
        SEAM(pb + 0);
        if (IN(pb + 1)) { REFRESH();
            REP_BEGIN(31) p_attn_mfma(P, F, l, L0); REP_END
            REP_BEGIN(32)
            { GroupSched S; S.init(1, 16, 16, F.G, F.bid);
              const bf16* DFTM = WSP(bf16, WS_DFTM); const bf16* YT = WSP(bf16, WS_YT); bf16* FOUR = WSP(bf16, WS_FOUR);
              auto AD = [=](const Unit& u) { return Operands{DFTM + (size_t)u.pm * 256 * 8192, YT + (size_t)u.pn * 256 * 8192, 8192, 8192}; };
              auto E = [=](EPI_ARGS) { const int b = u.pn >> 1, c0 = (u.pn & 1) * 256; const float sc = 0.0013810679320049757f;
                  EPI_FOR( st_bf4(FOUR + ((size_t)b * SEQ + u.pm * 256 + r) * 512 + c0 + c, v * sc); ) };
              GEMM(S, AD, E, 8192, 8192, 8192); }
            if (L0) { GroupSched S; S.init(1, 1, 16, F.G, F.bid);
              const bf16* DFTC = WSP(bf16, WS_DFTC); const bf16* YTC = WSP(bf16, WS_YT) + YT_CTX_OFF; bf16* FOUR = WSP(bf16, WS_FOUR);
              auto AD = [=](const Unit& u) { return Operands{DFTC, YTC + (size_t)u.pn * 256 * 512, 512, 512}; };
              auto E = [=](EPI_ARGS) { const int b = u.pn >> 1, c0 = (u.pn & 1) * 256; const float sc = 0.005524271728019903f;
                  EPI_FOR( st_bf4(FOUR + ((size_t)RL + b * CTXL + r) * 512 + c0 + c, v * sc); ) };
              GEMM(S, AD, E, 512, 512, 512); }
            REP_END
            REP_BEGIN(33) p_pool(F, L0 ? RT : RL); REP_END
        }
        SEAM(pb + 1);
        if (IN(pb + 2)) { REFRESH(); REP_BEGIN(4)
            const int nM = L0 ? 136 : 128; float* MRG = WSP(float, WS_MRG); const bf16* GB = WSP(bf16, WS_GB);
            { GroupSched S; S.init(1, nM, 4, F.G, F.bid); const bf16* A = WSP(bf16, WS_ATT); const bf16* W = WSP(bf16, WS_WAO);
              auto AD = [=](const Unit& u) { return Operands{A + (size_t)u.pm * 256 * 1024, W + (size_t)u.pn * 256 * 1024, 1024, 1024}; };
              auto E = [=](EPI_ARGS) { EPI_FOR( const size_t row = (size_t)u.pm * 256 + r; const int col = u.pn * 256 + c; const u32x2 g = *(const u32x2*)(GB + row * 3072 + col);
                  f32x4 o; o[0] = bflo(g.x) * v[0]; o[1] = bfhi(g.x) * v[1]; o[2] = bflo(g.y) * v[2]; o[3] = bfhi(g.y) * v[3]; *(f32x4*)(MRG + row * 1024 + col) = o; ) };
              GEMM(S, AD, E, 1024, 1024, 1024); }
            { GroupSched S; S.init(1, nM, 4, F.G, F.bid); const bf16* A = WSP(bf16, WS_FOUR); const bf16* W = WSP(bf16, WS_WFO);
              auto AD = [=](const Unit& u) { return Operands{A + (size_t)u.pm * 256 * 512, W + (size_t)u.pn * 256 * 512, 512, 512}; };
              auto E = [=](EPI_ARGS) { EPI_FOR( const size_t row = (size_t)u.pm * 256 + r; const int col = u.pn * 256 + c; const u32x2 g = *(const u32x2*)(GB + row * 3072 + 1024 + col);
                  f32x4 o = *(const f32x4*)(MRG + row * 1024 + col); o[0] += bflo(g.x) * v[0]; o[1] += bfhi(g.x) * v[1]; o[2] += bflo(g.y) * v[2]; o[3] += bfhi(g.y) * v[3]; *(f32x4*)(MRG + row * 1024 + col) = o; ) };
              GEMM(S, AD, E, 512, 512, 512); }
            { GroupSched S; S.init(1, nM, 4, F.G, F.bid); const bf16* A = WSP(bf16, WS_POOL); const bf16* W = WSP(bf16, WS_WPO); bf16* MRGB = WSP(bf16, WS_MRGB);
              const float* ps = P.pool_scale + l * 1024;
              auto AD = [=](const Unit& u) { return Operands{A + (size_t)u.pm * 256 * 512 + (u.pn >> 1) * 256, W + (size_t)u.pn * 256 * 256, 512, 256}; };
              auto E = [=](EPI_ARGS) { EPI_FOR( const size_t row = (size_t)u.pm * 256 + r; const int col = u.pn * 256 + c; const u32x2 g = *(const u32x2*)(GB + row * 3072 + 2048 + col);
                  const f32x4 pv = *(const f32x4*)(ps + col); f32x4 o = *(const f32x4*)(MRG + row * 1024 + col);
                  o[0] += bflo(g.x) * pv[0] * v[0]; o[1] += bfhi(g.x) * pv[1] * v[1]; o[2] += bflo(g.y) * pv[2] * v[2]; o[3] += bfhi(g.y) * pv[3] * v[3]; st_bf4(MRGB + row * 1024 + col, o); ) };
              GEMM(S, AD, E, 256, 512, 256); }
        REP_END }
        SEAM(pb + 2);
        if (IN(pb + 3)) { REFRESH();
            GroupSched S; S.init(1, L0 ? 136 : 128, 4, F.G, F.bid); const bf16* A = WSP(bf16, WS_MRGB); const bf16* W = WSP(bf16, WS_WOUT);
            const float* xin = L0 ? P.x : P.out; const float* cin = L0 ? P.ctx : WSP(float, WS_XC); float* xo = P.out; float* co = WSP(float, WS_XC);
            const float* MOD = WSP(float, WS_MOD) + (size_t)l * 9 * 6144;
            auto AD = [=](const Unit& u) { return Operands{A + (size_t)u.pm * 256 * 1024, W + (size_t)u.pn * 256 * 1024, 1024, 1024}; };
            auto E = [=](EPI_ARGS) { EPI_FOR( const int row = u.pm * 256 + r; const int col = u.pn * 256 + c; const int mr = row < RL ? (row >> 12) : 8;
                const f32x4 g = *(const f32x4*)(MOD + (size_t)mr * 6144 + 2048 + col);
                const float* src = row < RL ? xin + (size_t)row * DM + col : cin + (size_t)(row - RL) * DM + col; float* dst = row < RL ? xo + (size_t)row * DM + col : co + (size_t)(row - RL) * DM + col;
                *(f32x4*)dst = *(const f32x4*)src + g * v; ) };
            GEMM(S, AD, E, 1024, 1024, 1024);
        }
        SEAM(pb + 3);
        if (IN(pb + 4)) { REFRESH(); REP_BEGIN(6) p_rowpass_f(P, F, l, L0 ? RT : RL); REP_END }
        SEAM(pb + 4);
        if (IN(pb + 5)) { REFRESH(); REP_BEGIN(7) p_topk(F, L0); REP_END }
        SEAM(pb + 5);
        if (IN(pb + 6)) { REFRESH(); REP_BEGIN(8) p_gather(F, L0); REP_END }
        SEAM(pb + 6);
        if (IN(pb + 7)) { REFRESH(); REP_BEGIN(9)
            GroupSched S; S.init(16, L0 ? 17 : 16, 22, F.G, F.bid); const bf16* XG = WSP(bf16, WS_XG); const bf16* W = WSP(bf16, WS_WGU); bf16* HID = WSP(bf16, WS_HID);
            auto AD = [=](const Unit& u) { return Operands{XG + ((size_t)u.grp * SLOT_E + u.pm * 256) * DM, W + ((size_t)u.grp * 5632 + u.pn * 256) * DM, DM, DM}; };
            auto E = [=](EPI_ARGS) {
#pragma unroll
                for (int ai = 0; ai < 2; ++ai)
#pragma unroll
                    for (int m = 0; m < 4; ++m) { const size_t slot = (size_t)u.grp * SLOT_E + u.pm * 256 + ai * 128 + wr * 64 + m * 16 + fr;
#pragma unroll
                        for (int n = 0; n < 2; ++n) { const f32x4 a = acc[ai][0][m][n], up = acc[ai][1][m][n]; f32x4 o;
#pragma unroll
                            for (int j = 0; j < 4; ++j) o[j] = a[j] * sigmoidf_(a[j]) * up[j];
                            st_bf4(HID + slot * FF + u.pn * 128 + wc * 32 + n * 16 + 4 * fq, o); } } };
            GEMM(S, AD, E, DM, DM, DM);
        REP_END }
        SEAM(pb + 7);
        if (IN(pb + 8)) { REFRESH(); REP_BEGIN(10)
            GroupSched S; S.init(16, L0 ? 17 : 16, 4, F.G, F.bid); const bf16* HID = WSP(bf16, WS_HID); const bf16* W = WSP(bf16, WS_WD); bf16* Y = WSP(bf16, WS_Y); const float* SG = WSP(float, WS_SGATE);
            auto AD = [=](const Unit& u) { return Operands{HID + ((size_t)u.grp * SLOT_E + u.pm * 256) * FF, W + ((size_t)u.grp * 1024 + u.pn * 256) * FF, FF, FF}; };
            auto E = [=](EPI_ARGS) { EPI_FOR( const size_t slot = (size_t)u.grp * SLOT_E + u.pm * 256 + r; const float gt = SG[slot]; st_bf4(Y + slot * DM + u.pn * 256 + c, v * gt); ) };
            GEMM(S, AD, E, FF, FF, FF);
        REP_END }
        SEAM(pb + 8);
        if (IN(pb + 9)) { REFRESH(); p_rowpass_k(P, F, l, L0 ? RT : RL); if (L0) p_wconv(P, F, 1); }
        if (L0) SEAM(pb + 9);
    }
#undef IN
#undef SEAM
}
template <int PH> static void launch_ph(int grid, const Params& p, hipStream_t stream) { hipLaunchKernelGGL(fwd_kernel<PH>, dim3(grid), dim3(NTHREADS), LDS_BYTES, stream, p); }
template <int PH> static bool set_attr() { return hipFuncSetAttribute((const void*)fwd_kernel<PH>, hipFuncAttributeMaxDynamicSharedMemorySize, LDS_BYTES) == hipSuccess; }

extern "C" void kernel_launch(void* const* d_in, const int* in_sizes, int n_in, void* d_out, int out_size, void* d_ws, size_t ws_size, hipStream_t stream) {
    static int grid = 0;
    if (grid == 0) {
        if (n_in != 20 || out_size != RL * DM || ws_size < WS_END) { fprintf(stderr, "kernel_launch: unexpected shapes (n_in %d out %d ws %zu need %zu)\n", n_in, out_size, ws_size, (size_t)WS_END); grid = -1; return; }
        int dev = 0, cus = 0, per_cu = 0;
        if (hipGetDevice(&dev) != hipSuccess || hipDeviceGetAttribute(&cus, hipDeviceAttributeMultiprocessorCount, dev) != hipSuccess) { grid = -1; return; }
#if N_LAUNCH_MODE == 1
        if (!set_attr<-1>()) { fprintf(stderr, "kernel_launch: hipFuncSetAttribute failed\n"); grid = -1; return; }
        if (hipOccupancyMaxActiveBlocksPerMultiprocessor(&per_cu, (const void*)fwd_kernel<-1>, NTHREADS, LDS_BYTES) != hipSuccess || per_cu < 1) fprintf(stderr, "kernel_launch: occupancy query reports %d\n", per_cu);
#else
        if (!(set_attr<0>() && set_attr<1>() && set_attr<2>() && set_attr<3>() && set_attr<4>() && set_attr<5>() && set_attr<6>() && set_attr<7>() && set_attr<8>() && set_attr<9>() && set_attr<10>() && set_attr<11>())) { fprintf(stderr, "kernel_launch: hipFuncSetAttribute failed\n"); grid = -1; return; }
        (void)per_cu;
#endif
        (void)hipGetLastError();
        grid = cus;
    }
    if (grid < 0) return;
    if (hipMemsetAsync((char*)d_ws + WS_CTL, 0, CTL_BYTES, stream) != hipSuccess) return;
    Params p{};
    const float** pp = (const float**)&p;
    for (int i = 0; i < 20; ++i) pp[i] = (const float*)d_in[i];
    p.out = (float*)d_out; p.ws = (unsigned char*)d_ws;
#if N_LAUNCH_MODE == 1
    p.l_lo = 0; p.l_hi = 2;
    launch_ph<-1>(grid, p, stream);
#else
    p.l_lo = 0; p.l_hi = 0; launch_ph<0>(grid, p, stream); launch_ph<1>(grid, p, stream);
    for (int l = 0; l < 2; ++l) { p.l_lo = l; p.l_hi = l + 1;
        launch_ph<2>(grid, p, stream); launch_ph<3>(grid, p, stream); launch_ph<4>(grid, p, stream); launch_ph<5>(grid, p, stream); launch_ph<6>(grid, p, stream);
        launch_ph<7>(grid, p, stream); launch_ph<8>(grid, p, stream); launch_ph<9>(grid, p, stream); launch_ph<10>(grid, p, stream); launch_ph<11>(grid, p, stream); }
#endif
}
```

```cpp
#include <hip/hip_runtime.h>
#include <cstdio>
#include <cstdint>

#ifndef N_LAUNCH_MODE
#define N_LAUNCH_MODE 1
#endif

#define GAS __attribute__((address_space(1)))
#define LAS __attribute__((address_space(3)))
typedef unsigned short bf16;
typedef short bf16x8 __attribute__((ext_vector_type(8)));
typedef float f32x4 __attribute__((ext_vector_type(4)));
typedef unsigned u32x4 __attribute__((ext_vector_type(4)));
typedef unsigned u32x2 __attribute__((ext_vector_type(2)));

constexpr int NB = 8, SEQ = 4096, DM = 1024, CTXL = 256, NH = 16, HD = 64, GRIDW = 64;
constexpr int RL = NB * SEQ, RC = NB * CTXL, RT = RL + RC;
constexpr int INW = 7168, NE = 16, FF = 2816, CAPL = 512, CAPC = 32;
constexpr int SLOT_E = 4352, NSLOT = NE * SLOT_E;
constexpr float RMS_EPS = 1e-6f;
constexpr int NWAVES = 8, NTHREADS = 512;

constexpr size_t al256(size_t x) { return (x + 255) & ~(size_t)255; }
constexpr size_t WS_CTL = 0, CTL_BYTES = 1u << 20;
constexpr size_t WS_MOD = WS_CTL + CTL_BYTES;
constexpr size_t WS_XC = al256(WS_MOD + (size_t)2 * 9 * 6144 * 4);
constexpr size_t WS_AFF = al256(WS_XC + (size_t)RC * DM * 4);
constexpr size_t WS_SROW = al256(WS_AFF + (size_t)RT * 16 * 4);
constexpr size_t WS_SGATE = al256(WS_SROW + (size_t)NSLOT * 4);
constexpr size_t WS_SEL = al256(WS_SGATE + (size_t)NSLOT * 4);
constexpr size_t WS_DFTM = al256(WS_SEL + (size_t)RT * 16 * 4);
constexpr size_t WS_DFTC = al256(WS_DFTM + (size_t)4096 * 8192 * 2);
constexpr size_t WS_WA = al256(WS_DFTC + (size_t)256 * 512 * 2);
constexpr size_t WS_WFV = al256(WS_WA + (size_t)5632 * 1024 * 2);
constexpr size_t WS_WAO = al256(WS_WFV + (size_t)2048 * 1024 * 2);
constexpr size_t WS_WFO = al256(WS_WAO + (size_t)1024 * 1024 * 2);
constexpr size_t WS_WPO = al256(WS_WFO + (size_t)1024 * 512 * 2);
constexpr size_t WS_WOUT = al256(WS_WPO + (size_t)1024 * 256 * 2);
constexpr size_t WS_WGU = al256(WS_WOUT + (size_t)1024 * 1024 * 2);
constexpr size_t WS_WD = al256(WS_WGU + (size_t)16 * 5632 * 1024 * 2);
constexpr size_t WS_H = al256(WS_WD + (size_t)16 * 1024 * 2816 * 2);
constexpr size_t WS_R = al256(WS_H + (size_t)RT * DM * 2);
constexpr size_t WS_KQ = WS_R;
constexpr size_t WS_MRG = WS_KQ;
constexpr size_t WS_PB = al256(WS_KQ + (size_t)RT * 2048 * 2);
constexpr size_t WS_GB = al256(WS_PB + (size_t)RT * 512 * 2);
constexpr size_t WS_YT = al256(WS_GB + (size_t)RT * 3072 * 2);
constexpr size_t WS_MRGB = WS_YT;
constexpr size_t WS_VT = al256(WS_YT + (size_t)RT * 1024 * 2);
constexpr size_t WS_FOUR = al256(WS_VT + (size_t)RT * 1024 * 2);
constexpr size_t WS_ATT = al256(WS_FOUR + (size_t)RT * 512 * 2);
constexpr size_t WS_POOL = al256(WS_ATT + (size_t)RT * 1024 * 2);
constexpr size_t WS_MIX_END = al256(WS_POOL + (size_t)RT * 512 * 2);
constexpr size_t WS_XG = WS_R;
constexpr size_t WS_HID = al256(WS_XG + (size_t)NSLOT * 1024 * 2);
constexpr size_t WS_Y = al256(WS_HID + (size_t)NSLOT * 2816 * 2);
constexpr size_t WS_MOE_END = al256(WS_Y + (size_t)NSLOT * 1024 * 2);
constexpr size_t WS_END = WS_MIX_END > WS_MOE_END ? WS_MIX_END : WS_MOE_END;
constexpr size_t YT_CTX_OFF = (size_t)8 * 1024 * 4096;

constexpr int CW_BAR = 4096;

constexpr int LDS_BYTES = 147456;
constexpr int LDS_MISC = 131072;

__device__ __forceinline__ unsigned f2bf(float f) { unsigned u = __float_as_uint(f); return (u + 0x7fffu + ((u >> 16) & 1u)) >> 16; }
__device__ __forceinline__ unsigned pk2(float lo, float hi) { return f2bf(lo) | (f2bf(hi) << 16); }
__device__ __forceinline__ float bf2f(unsigned b) { return __uint_as_float(b << 16); }
__device__ __forceinline__ float bflo(unsigned w) { return __uint_as_float(w << 16); }
__device__ __forceinline__ float bfhi(unsigned w) { return __uint_as_float(w & 0xffff0000u); }
__device__ __forceinline__ float wave_sum(float v) {
#pragma unroll
    for (int o = 1; o < 64; o <<= 1) v += __shfl_xor(v, o);
    return v;
}
__device__ __forceinline__ float wave_max(float v) {
#pragma unroll
    for (int o = 1; o < 64; o <<= 1) v = fmaxf(v, __shfl_xor(v, o));
    return v;
}
__device__ __forceinline__ float sigmoidf_(float x) { return 1.f / (1.f + __expf(-x)); }
#define LDS_WAIT() asm volatile("s_waitcnt lgkmcnt(0)" ::: "memory")

#define XB_TMO      128
#define XB_XCNT(j)  (256  + 64 * (j))
#define XB_XSUB(j)  (1280 + 64 * (j))
#define XB_XGEN(j)  (2304 + 64 * (j))
#define XB_TOP      3328
#define XB_TOPGEN   3392
#define XCD_BAR_WORDS 3456
#define XB_SPIN_CAP (1u << 22)

__device__ __forceinline__ unsigned xb_ld(unsigned* p)              { return __hip_atomic_load(p, __ATOMIC_RELAXED, __HIP_MEMORY_SCOPE_AGENT); }
__device__ __forceinline__ unsigned xb_add(unsigned* p, unsigned v) { return __hip_atomic_fetch_add(p, v, __ATOMIC_RELAXED, __HIP_MEMORY_SCOPE_AGENT); }
__device__ __forceinline__ unsigned xb_xcc_id() { return (unsigned)__builtin_amdgcn_s_getreg((3 << 11) | 20) & 0xFu; }
#define XB_SPIN(cond, bar) do { unsigned _sp = 0; while (cond) { __builtin_amdgcn_s_sleep(1); \
    if ((++_sp & 255u) == 0u) { if (xb_ld(&(bar)[XB_TMO])) break; if (_sp > XB_SPIN_CAP) { atomicAdd(&(bar)[XB_TMO], 1u); break; } } } } while (0)

struct XcdBarrier { unsigned* bar; unsigned x; volatile LAS unsigned* st; };

__device__ __forceinline__ XcdBarrier xcd_barrier_post(unsigned* bar, volatile LAS unsigned* st) {
    XcdBarrier b; b.bar = bar; b.x = xb_xcc_id(); b.st = st;
    if (threadIdx.x == 0) (void)xb_add(&bar[XB_XCNT(b.x)], 1u);
    return b;
}
__device__ __forceinline__ void xcd_barrier_complete(unsigned* bar, unsigned x, unsigned& nloc, unsigned& nx) {
    const unsigned G = gridDim.x * gridDim.y * gridDim.z;
    unsigned sum, cnt, mine, sp = 0u;
    for (;;) {
        sum = 0u; cnt = 0u; mine = 0u;
#pragma unroll
        for (unsigned j = 0; j < 16; ++j) { const unsigned c = xb_ld(&bar[XB_XCNT(j)]); sum += c; cnt += (c > 0u) ? 1u : 0u; mine = (j == x) ? c : mine; }
        if (sum == G) break;
        __builtin_amdgcn_s_sleep(1);
        if ((++sp & 255u) == 0u) { if (xb_ld(&bar[XB_TMO])) break; if (sp > XB_SPIN_CAP) { atomicAdd(&bar[XB_TMO], 1u); break; } }
    }
    nloc = mine > 0u ? mine : 1u; nx = cnt > 0u ? cnt : 1u;
}
__device__ __forceinline__ void xcd_barrier(const XcdBarrier& b) {
    asm volatile("s_waitcnt vmcnt(0)" ::: "memory");
    __syncthreads();
    if (threadIdx.x == 0) {
        unsigned* bar = b.bar;
        __builtin_amdgcn_s_waitcnt(0);
        unsigned nloc = b.st[0], nx = b.st[1];
        if (nloc == 0u) { xcd_barrier_complete(bar, b.x, nloc, nx); b.st[0] = nloc; b.st[1] = nx; }
        const unsigned old = xb_add(&bar[XB_XSUB(b.x)], 1u);
        const unsigned gen = old / nloc;
        if (old + 1u == (gen + 1u) * nloc) {
            __builtin_amdgcn_fence(__ATOMIC_RELEASE, "agent");
            asm volatile("s_waitcnt vmcnt(0)" ::: "memory");
            const unsigned og = xb_add(&bar[XB_TOP], 1u);
            const unsigned tg = og / nx;
            if (og + 1u == (tg + 1u) * nx) xb_add(&bar[XB_TOPGEN], 1u);
            else XB_SPIN(xb_ld(&bar[XB_TOPGEN]) == tg, bar);
            __builtin_amdgcn_fence(__ATOMIC_ACQUIRE, "agent");
            xb_add(&bar[XB_XGEN(b.x)], 1u);
            asm volatile("s_waitcnt vmcnt(0)" ::: "memory");
        } else {
            XB_SPIN(xb_ld(&bar[XB_XGEN(b.x)]) == gen, bar);
            __builtin_amdgcn_fence(__ATOMIC_ACQUIRE, "agent");
            asm volatile("s_waitcnt vmcnt(0)" ::: "memory");
        }
    }
    __syncthreads();
}

struct Params {
    const float *x, *c, *ctx, *c_ctx, *ada_w, *ada_b, *norm1_g, *norm2_g, *w_in, *rpb, *w_att_o, *w_fourier, *w_pool, *pool_scale, *w_out, *w_router, *w_eg, *w_eu, *w_ed, *final_g;
    float* out; unsigned char* ws; int l_lo, l_hi;
};
struct Frame {
    LAS unsigned char* lds;
    int tid, lane, wave, G, bid;
    unsigned char* ws;
};
#define WSP(T, off) ((T*)(F.ws + (off)))

struct Unit { int grp, pm, pn; };
struct GroupSched {
    int ng, nM, nN, G, c; int tM, tN, tpm0, tpn0;
    __device__ __forceinline__ void init(int ng_, int nM_, int nN_, int G_, int c_, int tM_ = 0, int tN_ = 0, int tpm0_ = 0, int tpn0_ = 0) { ng = ng_; nM = nM_; nN = nN_; G = G_; c = c_; tM = tM_; tN = tN_; tpm0 = tpm0_; tpn0 = tpn0_; }
    __device__ __forceinline__ bool next(int i, Unit& u) const {
        const int per = nM * nN; const int L = i * G + c;
        if (L < ng * per) {
            u.grp = L / per; int wgid = L - u.grp * per;
            { const int q = per / 8, r = per % 8, xcd = wgid % 8, off = wgid / 8; wgid = (xcd < r ? xcd * (q + 1) : r * (q + 1) + (xcd - r) * q) + off; }
            const int nig = 8 * nN, gid = wgid / nig, fm = gid * 8, gsz = (nM - fm) < 8 ? (nM - fm) : 8;
            u.pm = fm + ((wgid % nig) % gsz); u.pn = (wgid % nig) / gsz; return true;
        }
        const int w = L - ng * per;
        if (w < tM * tN) { u.grp = ng; u.pm = tpm0 + (w % tM); u.pn = tpn0 + (w / tM); return true; }
        return false;
    }
};
struct Operands { const bf16* A; const bf16* Bt; int lda, ldb; };

template <class Addr, class Epi>
__device__ __forceinline__ void gemm_simple(const GroupSched& S, const Addr& AD, const Epi& E, int K) {
    const int tid = threadIdx.x, wid = __builtin_amdgcn_readfirstlane(tid >> 6), lane = tid & 63, wr = wid >> 2, wc = wid & 3, fr = lane & 15, fq = lane >> 4;
    Unit u;
    for (int i = 0; S.next(i, u); ++i) {
        const Operands op = AD(u);
        f32x4 acc[2][2][4][2];
#pragma unroll
        for (int a = 0; a < 2; ++a)
#pragma unroll
            for (int b = 0; b < 2; ++b)
#pragma unroll
                for (int m = 0; m < 4; ++m)
#pragma unroll
                    for (int n = 0; n < 2; ++n) acc[a][b][m][n] = (f32x4){0.f, 0.f, 0.f, 0.f};
        const bf16* ap = op.A + (size_t)(wr * 64 + fr) * op.lda + fq * 8;
        const bf16* bp = op.Bt + (size_t)(wc * 32 + fr) * op.ldb + fq * 8;
#pragma unroll 1
        for (int k = 0; k < K; k += 32) {
            bf16x8 bfr[2][2];
#pragma unroll
            for (int b = 0; b < 2; ++b)
#pragma unroll
                for (int n = 0; n < 2; ++n) bfr[b][n] = *(const bf16x8*)(bp + (size_t)(b * 128 + n * 16) * op.ldb + k);
#pragma unroll
            for (int a = 0; a < 2; ++a) {
                bf16x8 af[4];
#pragma unroll
                for (int m = 0; m < 4; ++m) af[m] = *(const bf16x8*)(ap + (size_t)(a * 128 + m * 16) * op.lda + k);
#pragma unroll
                for (int b = 0; b < 2; ++b)
#pragma unroll
                    for (int m = 0; m < 4; ++m)
#pragma unroll
                        for (int n = 0; n < 2; ++n) acc[a][b][m][n] = __builtin_amdgcn_mfma_f32_16x16x32_bf16(bfr[b][n], af[m], acc[a][b][m][n], 0, 0, 0);
            }
        }
        E(acc, u, wr, wc, fr, fq);
    }
}
constexpr int HTB = 128 * 64 * 2;
__device__ __forceinline__ int lds_byte(int r, int c) { const int st = (r >> 4) * 2 + (c >> 5), rr = r & 15, cc = c & 31, ob = rr * 64 + cc * 2; return st * 1024 + (ob ^ (((ob >> 9) & 1) << 5)); }
__device__ __forceinline__ void stage_rc(int b, int& R, int& C) { const int st = b / 1024, sb = b % 1024, swz = sb ^ (((sb >> 9) & 1) << 5); R = (st >> 1) * 16 + swz / 64; C = (st & 1) * 32 + (swz % 64) / 2; }
template <class Addr, class Epi>
__device__ __forceinline__ void gemm_fast(LAS unsigned char* lds, const int tid, const GroupSched& S, const Addr& AD, const Epi& E, const int K, const int lda, const int ldb) {
    const int wid = __builtin_amdgcn_readfirstlane(tid >> 6), lane = tid & 63, wr = wid >> 2, wc = wid & 3, fr = lane & 15, fq = lane >> 4;
    const int nt = K / 64;
    unsigned voffA[2], voffB[2];
#pragma unroll
    for (int i = 0; i < 2; ++i) { int R, C; stage_rc(tid * 16 + i * 8192, R, C); voffA[i] = (unsigned)(R * lda + C) * 2u; voffB[i] = (unsigned)(R * ldb + C) * 2u; }
    const size_t kstep = 128;
    const size_t hstepA = (size_t)128 * lda * 2, hstepB = (size_t)128 * ldb * 2;
    const unsigned ldsw = (unsigned)wid * 1024u;
    const int aoff = lds_byte(wr * 64 + fr, fq * 8), boff = lds_byte(wc * 32 + fr, fq * 8);
#define PG8_SA(b, h) (((b) * 2 + (h)) * HTB)
#define PG8_SB(b, h) ((4 + (b) * 2 + (h)) * HTB)
#define PG8_STAGE(bufoff, gbase, voff) do { _Pragma("unroll") for (int _i = 0; _i < 2; ++_i) \
        __builtin_amdgcn_global_load_lds((const unsigned*)((const char*)(gbase) + (voff)[_i]), (LAS unsigned*)(lds + (bufoff) + ldsw + _i * 8192), 16, 0, 0); } while (0)
#define PG8_LDA(dst, b, h) do { _Pragma("unroll") for (int m = 0; m < 4; ++m) _Pragma("unroll") for (int k = 0; k < 2; ++k) dst[m][k] = *(const LAS bf16x8*)(lds + PG8_SA(b, h) + aoff + m * 2048 + k * 1024); } while (0)
#define PG8_LDB(dst, b, h) do { _Pragma("unroll") for (int n = 0; n < 2; ++n) _Pragma("unroll") for (int k = 0; k < 2; ++k) dst[n][k] = *(const LAS bf16x8*)(lds + PG8_SB(b, h) + boff + n * 2048 + k * 1024); } while (0)
#define PG8_MMA(ai, bj, At, Bt) do { __builtin_amdgcn_s_setprio(1); _Pragma("unroll") for (int m = 0; m < 4; ++m) _Pragma("unroll") for (int n = 0; n < 2; ++n) _Pragma("unroll") for (int k = 0; k < 2; ++k) \
        acc[ai][bj][m][n] = __builtin_amdgcn_mfma_f32_16x16x32_bf16(Bt[n][k], At[m][k], acc[ai][bj][m][n], 0, 0, 0); __builtin_amdgcn_s_setprio(0); } while (0)
#define PG8_WAIT_V(n) asm volatile("s_waitcnt vmcnt(" #n ")" ::: "memory")
#define PG8_WAIT_L(n) asm volatile("s_waitcnt lgkmcnt(" #n ")" ::: "memory")
#define PG8_BAR __builtin_amdgcn_s_barrier()
#define PG8_SCHED __builtin_amdgcn_sched_barrier(0)
    Unit cur, nxt; int ui = 0;
    if (!S.next(0, cur)) return;
    f32x4 acc[2][2][4][2];
#pragma unroll
    for (int a = 0; a < 2; ++a)
#pragma unroll
        for (int b = 0; b < 2; ++b)
#pragma unroll
            for (int m = 0; m < 4; ++m)
#pragma unroll
                for (int n = 0; n < 2; ++n) acc[a][b][m][n] = (f32x4){0.f, 0.f, 0.f, 0.f};
    bf16x8 At[4][2], B0[2][2], B1[2][2];
    const char* cA; const char* cB;
    { const Operands op = AD(cur); cA = (const char*)op.A; cB = (const char*)op.Bt; }
    PG8_STAGE(PG8_SB(0, 0), cB, voffB); PG8_STAGE(PG8_SB(0, 1), cB + hstepB, voffB); PG8_STAGE(PG8_SA(0, 0), cA, voffA); PG8_STAGE(PG8_SA(0, 1), cA + hstepA, voffA);
    if (wr == 1) PG8_BAR;
    PG8_WAIT_V(2); PG8_BAR;
    PG8_STAGE(PG8_SB(1, 0), cB + kstep, voffB); PG8_STAGE(PG8_SA(1, 0), cA + kstep, voffA); PG8_STAGE(PG8_SB(1, 1), cB + hstepB + kstep, voffB);
    PG8_WAIT_V(6); PG8_BAR;
    for (;;) {
        const bool has_next = S.next(ui + 1, nxt);
        const char* nA = cA; const char* nB = cB;
        if (has_next) { const Operands op = AD(nxt); nA = (const char*)op.A; nB = (const char*)op.Bt; }
#pragma unroll 1
        for (int t = 0; t < nt; t += 2) {
            const bool last = (t == nt - 2);
            const char* a1 = cA + (size_t)(t + 1) * kstep;
            const char* a2 = last ? nA : cA + (size_t)(t + 2) * kstep; const char* b2 = last ? nB : cB + (size_t)(t + 2) * kstep;
            const char* a3 = a2 + kstep; const char* b3 = b2 + kstep;
            PG8_LDB(B0, 0, 0); PG8_LDB(B1, 0, 1); PG8_SCHED; PG8_LDA(At, 0, 0); PG8_STAGE(PG8_SA(1, 1), a1 + hstepA, voffA);
            PG8_WAIT_V(8); PG8_WAIT_L(0); PG8_BAR; PG8_MMA(0, 0, At, B0); PG8_MMA(0, 1, At, B1); PG8_BAR; PG8_SCHED;
            PG8_LDA(At, 0, 1); PG8_STAGE(PG8_SB(0, 0), b2, voffB); PG8_STAGE(PG8_SB(0, 1), b2 + hstepB, voffB); PG8_STAGE(PG8_SA(0, 0), a2, voffA);
            PG8_WAIT_V(8); PG8_WAIT_L(0); PG8_BAR; PG8_MMA(1, 0, At, B0); PG8_MMA(1, 1, At, B1); PG8_BAR; PG8_SCHED;
            PG8_LDB(B0, 1, 0); PG8_LDB(B1, 1, 1); PG8_SCHED; PG8_LDA(At, 1, 0); PG8_STAGE(PG8_SA(0, 1), a2 + hstepA, voffA);
            PG8_WAIT_V(8); PG8_WAIT_L(0); PG8_BAR; PG8_MMA(0, 0, At, B0); PG8_MMA(0, 1, At, B1); PG8_BAR; PG8_SCHED;
            PG8_LDA(At, 1, 1); PG8_STAGE(PG8_SB(1, 0), b3, voffB); PG8_STAGE(PG8_SB(1, 1), b3 + hstepB, voffB); PG8_STAGE(PG8_SA(1, 0), a3, voffA);
            PG8_WAIT_V(8); PG8_WAIT_L(0); PG8_BAR; PG8_MMA(1, 0, At, B0); PG8_MMA(1, 1, At, B1); PG8_BAR; PG8_SCHED;
        }
        if (wr == 0) PG8_BAR;
        { int fr2 = fr, fq2 = fq; asm volatile("" : "+v"(fr2), "+v"(fq2));
          E(acc, cur, wr, wc, fr2, fq2); }
        if (!has_next) break;
#pragma unroll
        for (int a = 0; a < 2; ++a)
#pragma unroll
            for (int b = 0; b < 2; ++b)
#pragma unroll
                for (int m = 0; m < 4; ++m)
#pragma unroll
                    for (int n = 0; n < 2; ++n) acc[a][b][m][n] = (f32x4){0.f, 0.f, 0.f, 0.f};
        cur = nxt; cA = nA; cB = nB; ++ui;
        if (wr == 1) PG8_BAR;
    }
    PG8_WAIT_V(0);
    PG8_BAR;
#undef PG8_SA
#undef PG8_SB
#undef PG8_STAGE
#undef PG8_LDA
#undef PG8_LDB
#undef PG8_MMA
#undef PG8_WAIT_V
#undef PG8_WAIT_L
#undef PG8_BAR
#undef PG8_SCHED
}
#ifndef DUP_PH
#define DUP_PH -1
#endif
#define REP_BEGIN(k) _Pragma("unroll 1") for (int rep_ = 0; rep_ < ((DUP_PH == (k)) ? 2 : 1); ++rep_) { if (rep_) { if constexpr (PH < 0) xcd_barrier(bar); }
#define REP_END }
#ifndef USE_FAST
#define USE_FAST 1
#endif
#if USE_FAST
#define GEMM(S, AD, E, K, lda, ldb) gemm_fast(F.lds, F.tid, S, AD, E, K, lda, ldb)
#else
#define GEMM(S, AD, E, K, lda, ldb) gemm_simple(S, AD, E, K)
#endif
#define EPI_ARGS const f32x4 (&acc)[2][2][4][2], const Unit& u, int wr, int wc, int fr, int fq
#define EPI_FOR(BODY) _Pragma("unroll") for (int ai = 0; ai < 2; ++ai) _Pragma("unroll") for (int m = 0; m < 4; ++m) { const int r = ai * 128 + wr * 64 + m * 16 + fr; \
    _Pragma("unroll") for (int bj = 0; bj < 2; ++bj) _Pragma("unroll") for (int n = 0; n < 2; ++n) { const int c = bj * 128 + wc * 32 + n * 16 + 4 * fq; const f32x4 v = acc[ai][bj][m][n]; BODY } }
__device__ __forceinline__ void st_bf4(bf16* p, f32x4 v) { u32x2 w; w.x = pk2(v[0], v[1]); w.y = pk2(v[2], v[3]); *(u32x2*)p = w; }

__device__ __forceinline__ void p_mod(const Params& P, Frame& F) {
    LAS float* sc = (LAS float*)F.lds;
    LAS float* red = (LAS float*)(F.lds + 9 * 1024 * 4);
    float* MOD = WSP(float, WS_MOD);
    bool have = false;
    for (int it = F.bid; it < 2 * 96; it += F.G) {
        if (!have) {
            for (int i = F.tid; i < 9 * 1024; i += NTHREADS) { const int r = i >> 10, k = i & 1023; const float v = r < 8 ? P.c[r * 1024 + k] : P.c_ctx[k]; sc[i] = v * sigmoidf_(v); }
            have = true;
        }
        __syncthreads();
        const int l = it / 96, j0 = (it % 96) * 64, jj = F.tid & 63, kc = F.tid >> 6;
        const float* W = P.ada_w + (size_t)l * 1024 * 6144 + j0 + jj;
        float a[9];
#pragma unroll
        for (int r = 0; r < 9; ++r) a[r] = 0.f;
        for (int k = kc * 128; k < kc * 128 + 128; ++k) { const float w = W[(size_t)k * 6144];
#pragma unroll
            for (int r = 0; r < 9; ++r) a[r] += sc[r * 1024 + k] * w; }
#pragma unroll
        for (int r = 0; r < 9; ++r) red[(kc * 9 + r) * 64 + jj] = a[r];
        __syncthreads();
        for (int o = F.tid; o < 9 * 64; o += NTHREADS) { const int r = o >> 6, j = o & 63; float s = 0.f;
#pragma unroll
            for (int q = 0; q < 8; ++q) s += red[(q * 9 + r) * 64 + j];
            MOD[((size_t)l * 9 + r) * 6144 + j0 + j] = s + P.ada_b[l * 6144 + j0 + j]; }
    }
    __syncthreads();
}
__device__ __forceinline__ void p_dftgen(Frame& F) {
    LAS float* tab = (LAS float*)F.lds;
    for (int j = F.tid; j < 4096; j += NTHREADS) tab[j] = cospif((float)j * (1.0f / 2048.0f));
    __syncthreads();
    bf16* DM_ = WSP(bf16, WS_DFTM); bf16* DC_ = WSP(bf16, WS_DFTC);
    const int nchunk = 4096 * 1024 + 256 * 64;
    for (int ch = F.bid * NTHREADS + F.tid; ch < nchunk; ch += F.G * NTHREADS) {
        float v[8]; bf16* dst;
        if (ch < 4096 * 1024) { const int kf = ch >> 10, col0 = (ch & 1023) * 8, cs = col0 >> 12, l0 = col0 & 4095;
#pragma unroll
            for (int i = 0; i < 8; ++i) { const int j = (kf * (l0 + i)) & 4095; v[i] = cs ? -tab[(j + 3072) & 4095] : tab[j]; }
            dst = DM_ + (size_t)kf * 8192 + col0; }
        else { const int c2 = ch - 4096 * 1024, kf = c2 >> 6, col0 = (c2 & 63) * 8, cs = col0 >> 8, l0 = col0 & 255;
#pragma unroll
            for (int i = 0; i < 8; ++i) { const int j = ((kf * (l0 + i)) & 255) * 16; v[i] = cs ? -tab[(j + 3072) & 4095] : tab[j]; }
            dst = DC_ + (size_t)kf * 512 + col0; }
        u32x4 o; o.x = pk2(v[0], v[1]); o.y = pk2(v[2], v[3]); o.z = pk2(v[4], v[5]); o.w = pk2(v[6], v[7]);
        *(u32x4*)dst = o;
    }
    __syncthreads();
}
__device__ __forceinline__ void transpose_item(const float* W, int ldw, int k0, int n0, bf16* WT, int ldt, int drow0, LAS float* scr, int lane) {
#pragma unroll 8
    for (int i = 0; i < 32; ++i) { const int kk = 2 * i + (lane >> 5); scr[kk * 33 + (lane & 31)] = W[(size_t)(k0 + kk) * ldw + n0 + (lane & 31)]; }
    LDS_WAIT(); asm volatile("" ::: "memory");
    const int c = lane & 7;
#pragma unroll
    for (int j = 0; j < 4; ++j) { const int n = (lane >> 3) + 8 * j; const LAS float* s = scr + (8 * c) * 33 + n;
        u32x4 o; o.x = pk2(s[0 * 33], s[1 * 33]); o.y = pk2(s[2 * 33], s[3 * 33]); o.z = pk2(s[4 * 33], s[5 * 33]); o.w = pk2(s[6 * 33], s[7 * 33]);
        *(u32x4*)(WT + (size_t)(drow0 + n) * ldt + k0 + 8 * c) = o; }
    LDS_WAIT(); asm volatile("" ::: "memory");
}
__device__ __forceinline__ void p_wconv(const Params& P, Frame& F, int l) {
    LAS float* scr = (LAS float*)(F.lds + F.wave * 16384);
    const int gw = F.bid * NWAVES + F.wave, NGW = F.G * NWAVES;
    const float* w_in = P.w_in + (size_t)l * 1024 * INW;
    bf16* WA = WSP(bf16, WS_WA); bf16* WFV = WSP(bf16, WS_WFV);
    constexpr int I_K = 16 * 32, I_Q = 16 * 32, I_P = 16 * 16, I_G = 16 * 96, I_V = 16 * 32, I_AO = 16 * 32, I_FO = 8 * 32, I_OUT = 16 * 32;
    constexpr int NSM = I_K + I_Q + I_P + I_G + I_V + I_AO + I_FO + I_OUT;
    for (int it = gw; it < NSM; it += NGW) {
        int r = it;
        if (r < I_K) { transpose_item(w_in, INW, (r / 32) * 64, 0 + (r % 32) * 32, WA, 1024, 0 + (r % 32) * 32, scr, F.lane); continue; } r -= I_K;
        if (r < I_Q) { transpose_item(w_in, INW, (r / 32) * 64, 2048 + (r % 32) * 32, WA, 1024, 1024 + (r % 32) * 32, scr, F.lane); continue; } r -= I_Q;
        if (r < I_P) { transpose_item(w_in, INW, (r / 16) * 64, 3584 + (r % 16) * 32, WA, 1024, 2048 + (r % 16) * 32, scr, F.lane); continue; } r -= I_P;
        if (r < I_G) { transpose_item(w_in, INW, (r / 96) * 64, 4096 + (r % 96) * 32, WA, 1024, 2560 + (r % 96) * 32, scr, F.lane); continue; } r -= I_G;
        if (r < I_V) { transpose_item(w_in, INW, (r / 32) * 64, 1024 + (r % 32) * 32, WFV, 1024, 1024 + (r % 32) * 32, scr, F.lane); continue; } r -= I_V;
        if (r < I_AO) { transpose_item(P.w_att_o + (size_t)l * 1024 * 1024, 1024, (r / 32) * 64, (r % 32) * 32, WSP(bf16, WS_WAO), 1024, (r % 32) * 32, scr, F.lane); continue; } r -= I_AO;
        if (r < I_FO) { transpose_item(P.w_fourier + (size_t)l * 512 * 1024, 1024, (r / 32) * 64, (r % 32) * 32, WSP(bf16, WS_WFO), 512, (r % 32) * 32, scr, F.lane); continue; } r -= I_FO;
        transpose_item(P.w_out + (size_t)l * 1024 * 1024, 1024, (r / 32) * 64, (r % 32) * 32, WSP(bf16, WS_WOUT), 1024, (r % 32) * 32, scr, F.lane);
    }
    constexpr int I_E = 16 * 88;
    bf16* WGU = WSP(bf16, WS_WGU); bf16* WD = WSP(bf16, WS_WD);
    for (int it = gw; it < 3 * 16 * I_E; it += NGW) {
        const int which = it / (16 * I_E), r0 = it % (16 * I_E), e = r0 / I_E, r = r0 % I_E;
        if (which < 2) { const int kb = r / 88, nb = r % 88, n0 = nb * 32;
            const float* src = (which == 0 ? P.w_eg : P.w_eu) + ((size_t)l * 16 + e) * 1024 * FF;
            transpose_item(src, FF, kb * 64, n0, WGU + (size_t)e * 5632 * 1024, 1024, (n0 >> 7) * 256 + (which ? 128 : 0) + (n0 & 127), scr, F.lane); }
        else { const int kb = r / 32, nb = r % 32;
            transpose_item(P.w_ed + ((size_t)l * 16 + e) * FF * 1024, 1024, kb * 64, nb * 32, WD + (size_t)e * 1024 * FF, FF, nb * 32, scr, F.lane); }
    }
    { bf16* WPO = WSP(bf16, WS_WPO); const float* wp = P.w_pool + (size_t)l * 4 * 128 * 256;
      for (int i = F.bid * NTHREADS + F.tid; i < 1024 * 256; i += F.G * NTHREADS) { const int n = i >> 8, kk = i & 255, g = n >> 8, f = n & 255;
          WPO[i] = (bf16)(((kk >> 7) == (g & 1)) ? f2bf(wp[((size_t)g * 128 + (kk & 127)) * 256 + f]) : 0u); } }
    { LAS float* t128 = (LAS float*)F.lds;
      __syncthreads();
      for (int j = F.tid; j < 128; j += NTHREADS) t128[j] = cospif((float)j * (1.0f / 64.0f));
      __syncthreads();
      for (int i = F.bid * NTHREADS + F.tid; i < 1024 * 1024; i += F.G * NTHREADS) { const int fc = i >> 10, k = i & 1023, cs = fc & 1, gm = fc >> 1, g = gm >> 7, m = gm & 127;
          const float* src = w_in + (size_t)k * INW + 3072 + g * 128; float s = 0.f; const int ph = cs ? 96 : 0;
          for (int c = 0; c < 128; ++c) s += src[c] * t128[(m * c + ph) & 127];
          WFV[i] = (bf16)f2bf(s); }
      __syncthreads(); }
}

struct RowMod { const float* g; const float* sh; const float* sc; };
__device__ __forceinline__ void row_load(const float* row, int lane, f32x4 (&v)[4]) {
#pragma unroll
    for (int j = 0; j < 4; ++j) v[j] = *(const f32x4*)(row + 4 * lane + 256 * j);
}
__device__ __forceinline__ float row_rstd(const f32x4 (&v)[4]) {
    float s = 0.f;
#pragma unroll
    for (int j = 0; j < 4; ++j) s += (v[j][0] * v[j][0] + v[j][1] * v[j][1]) + (v[j][2] * v[j][2] + v[j][3] * v[j][3]);
    return rsqrtf(wave_sum(s) * (1.0f / 1024.0f) + RMS_EPS);
}
__device__ __forceinline__ void row_modulate(const f32x4 (&v)[4], float rstd, const RowMod& M, int lane, f32x4 (&y)[4]) {
#pragma unroll
    for (int j = 0; j < 4; ++j) { const int k = 4 * lane + 256 * j; const f32x4 g = *(const f32x4*)(M.g + k), sh = *(const f32x4*)(M.sh + k), sc = *(const f32x4*)(M.sc + k);
        y[j] = v[j] * rstd * g * (sc + 1.0f) + sh; }
}
__device__ __forceinline__ void row_store_bf(bf16* row, int lane, const f32x4 (&y)[4]) {
#pragma unroll
    for (int j = 0; j < 4; ++j) st_bf4(row + 4 * lane + 256 * j, y[j]);
}
__device__ __forceinline__ const float* mod_ptr(Frame& F, int l, int row, int which) { const int mr = row < RL ? (row >> 12) : 8; return WSP(float, WS_MOD) + ((size_t)l * 9 + mr) * 6144 + which * 1024; }

__device__ __forceinline__ void p_rowpass_a0(const Params& P, Frame& F) {
    const int gw = F.bid * NWAVES + F.wave, NGW = F.G * NWAVES; bf16* H = WSP(bf16, WS_H);
    for (int row = gw; row < RT; row += NGW) {
        const float* src = row < RL ? P.x + (size_t)row * DM : P.ctx + (size_t)(row - RL) * DM;
        f32x4 v[4], y[4]; row_load(src, F.lane, v); const float rs = row_rstd(v);
        RowMod M{P.norm1_g, mod_ptr(F, 0, row, 0), mod_ptr(F, 0, row, 1)};
        row_modulate(v, rs, M, F.lane, y); row_store_bf(H + (size_t)row * DM, F.lane, y);
    }
}
__device__ __forceinline__ void p_rowpass_f(const Params& P, Frame& F, int l, int nrows) {
    const int gw = F.bid * NWAVES + F.wave, NGW = F.G * NWAVES; bf16* H = WSP(bf16, WS_H); float* AFF = WSP(float, WS_AFF);
    const float* wr = P.w_router + (size_t)l * 1024 * 16;
    LAS float* wl = (LAS float*)F.lds;
    __syncthreads();
    for (int i = F.tid; i < 16384; i += NTHREADS) wl[(i & 15) * 1024 + (i >> 4)] = wr[i];
    __syncthreads();
    for (int row = gw; row < nrows; row += NGW) {
        const float* src = row < RL ? P.out + (size_t)row * DM : WSP(float, WS_XC) + (size_t)(row - RL) * DM;
        f32x4 v[4], y[4]; row_load(src, F.lane, v); const float rs = row_rstd(v);
        RowMod M{P.norm2_g + l * 1024, mod_ptr(F, l, row, 3), mod_ptr(F, l, row, 4)};
        row_modulate(v, rs, M, F.lane, y); row_store_bf(H + (size_t)row * DM, F.lane, y);
        float lg[16];
        int wo = 4 * F.lane; asm volatile("" : "+v"(wo));
#pragma unroll
        for (int e = 0; e < 16; ++e) { float a = 0.f;
#pragma unroll
            for (int j = 0; j < 4; ++j) { const f32x4 w = *(const LAS f32x4*)(wl + e * 1024 + wo + 256 * j); a += (y[j][0] * w[0] + y[j][1] * w[1]) + (y[j][2] * w[2] + y[j][3] * w[3]); }
            lg[e] = a; }
        float mx = -1e30f;
#pragma unroll
        for (int e = 0; e < 16; ++e) { lg[e] = wave_sum(lg[e]); mx = fmaxf(mx, lg[e]); }
        float den = 0.f;
#pragma unroll
        for (int e = 0; e < 16; ++e) { lg[e] = __expf(lg[e] - mx); den += lg[e]; }
        const float inv = 1.0f / den;
        if (F.lane < 16) { float mine = 0.f;
#pragma unroll
            for (int e = 0; e < 16; ++e) mine = (F.lane == e) ? lg[e] : mine;
            AFF[(size_t)row * 16 + F.lane] = mine * inv; }
    }
    __syncthreads();
}
__device__ __forceinline__ void p_rowpass_k(const Params& P, Frame& F, int l, int nrows) {
    const int gw = F.bid * NWAVES + F.wave, NGW = F.G * NWAVES; bf16* H = WSP(bf16, WS_H);
    const int* SEL = WSP(int, WS_SEL); const bf16* Y = WSP(bf16, WS_Y);
    for (int row = gw; row < nrows; row += NGW) {
        float* xr = row < RL ? P.out + (size_t)row * DM : WSP(float, WS_XC) + (size_t)(row - RL) * DM;
        f32x4 v[4], a[4]; row_load(xr, F.lane, v);
#pragma unroll
        for (int j = 0; j < 4; ++j) a[j] = (f32x4){0.f, 0.f, 0.f, 0.f};
        for (int e = 0; e < 16; ++e) { const int s = SEL[(size_t)row * 16 + e];
            if (s >= 0) { const bf16* yr = Y + (size_t)s * DM;
#pragma unroll
                for (int j = 0; j < 4; ++j) { const u32x2 w = *(const u32x2*)(yr + 4 * F.lane + 256 * j); a[j][0] += bflo(w.x); a[j][1] += bfhi(w.x); a[j][2] += bflo(w.y); a[j][3] += bfhi(w.y); } } }
        const float* g2 = mod_ptr(F, l, row, 5);
#pragma unroll
        for (int j = 0; j < 4; ++j) { const f32x4 g = *(const f32x4*)(g2 + 4 * F.lane + 256 * j); v[j] = v[j] + g * a[j]; }
        const float rs = row_rstd(v);
        if (l == 0) {
#pragma unroll
            for (int j = 0; j < 4; ++j) *(f32x4*)(xr + 4 * F.lane + 256 * j) = v[j];
            f32x4 y[4]; RowMod M{P.norm1_g + 1024, mod_ptr(F, 1, row, 0), mod_ptr(F, 1, row, 1)};
            row_modulate(v, rs, M, F.lane, y); row_store_bf(H + (size_t)row * DM, F.lane, y);
        } else {
#pragma unroll
            for (int j = 0; j < 4; ++j) { const f32x4 g = *(const f32x4*)(P.final_g + 4 * F.lane + 256 * j); *(f32x4*)(xr + 4 * F.lane + 256 * j) = v[j] * rs * g; }
        }
    }
}

__device__ __forceinline__ float dot64(const bf16x8 (&q)[8], const bf16* kp) {
    float s = 0.f;
#pragma unroll
    for (int i = 0; i < 8; ++i) { const u32x4 kw = *(const u32x4*)(kp + 8 * i); const u32x4 qw = __builtin_bit_cast(u32x4, q[i]);
#pragma unroll
        for (int t = 0; t < 4; ++t) s += bflo(kw[t]) * bflo(qw[t]) + bfhi(kw[t]) * bfhi(qw[t]); }
    return s;
}
__device__ __forceinline__ void p_attn_naive(const Params& P, Frame& F, int l, bool with_ctx_queries) {
    const int gw = F.bid * NWAVES + F.wave, NGW = F.G * NWAVES;
    const bf16* KQ = WSP(bf16, WS_KQ); const bf16* VT = WSP(bf16, WS_VT); bf16* ATT = WSP(bf16, WS_ATT);
    LAS float* pw = (LAS float*)(F.lds + F.wave * 2048);
    const float* rpb = P.rpb + (size_t)l * 16 * 15 * 31;
    const int nlat = NB * 64 * NH * 64, nitems = nlat + (with_ctx_queries ? NB * NH * CTXL : 0);
    for (int it = gw; it < nitems; it += NGW) {
        const bool lat = it < nlat;
        int b, h, r = 0, qc = 0, rowq;
        if (lat) { qc = it & 63; h = (it >> 6) & 15; r = (it >> 10) & 63; b = it >> 16; rowq = b * SEQ + r * 64 + qc; }
        else { const int i2 = it - nlat; qc = i2 & 255; h = (i2 >> 8) & 15; b = i2 >> 12; rowq = RL + b * CTXL + qc; }
        bf16x8 q[8];
        { const bf16* qp = KQ + (size_t)rowq * 2048 + 1024 + h * 64;
#pragma unroll
          for (int i = 0; i < 8; ++i) q[i] = *(const bf16x8*)(qp + 8 * i); }
        const int rs = min(max(r - 4, 0), 56), cs = min(max(qc - 8, 0), 48);
        float s[6];
        if (lat) {
#pragma unroll
            for (int t = 0; t < 2; ++t) { const int w = F.lane + 64 * t, i = w >> 4, j = w & 15; const int tok = (rs + i) * 64 + cs + j;
                s[t] = dot64(q, KQ + (size_t)(b * SEQ + tok) * 2048 + h * 64) * 0.125f + rpb[(h * 15 + (rs + i - r + 7)) * 31 + (cs + j - qc + 15)]; }
        } else { s[0] = -1e30f; s[1] = -1e30f; }
#pragma unroll
        for (int t = 0; t < 4; ++t) { const int c = F.lane + 64 * t; s[2 + t] = dot64(q, KQ + (size_t)(RL + b * CTXL + c) * 2048 + h * 64) * 0.125f; }
        float mx = s[0];
#pragma unroll
        for (int t = 1; t < 6; ++t) mx = fmaxf(mx, s[t]);
        mx = wave_max(mx);
        float sum = 0.f;
#pragma unroll
        for (int t = 0; t < 6; ++t) { s[t] = (lat || t >= 2) ? __expf(s[t] - mx) : 0.f; sum += s[t]; }
        sum = wave_sum(sum);
        pw[F.lane] = s[0]; pw[F.lane + 64] = s[1];
#pragma unroll
        for (int t = 0; t < 4; ++t) pw[128 + F.lane + 64 * t] = s[2 + t];
        LDS_WAIT(); asm volatile("" ::: "memory");
        float o = 0.f;
        if (lat) { const bf16* vr = VT + ((size_t)b * 1024 + h * 64 + F.lane) * 4096;
#pragma unroll 2
            for (int w = 0; w < 128; ++w) { const int tok = (rs + (w >> 4)) * 64 + cs + (w & 15); o += pw[w] * bf2f(vr[tok]); } }
        { const bf16* vr = VT + YT_CTX_OFF + ((size_t)b * 1024 + h * 64 + F.lane) * 256;
#pragma unroll 2
          for (int c8 = 0; c8 < 32; ++c8) { const u32x4 vw = *(const u32x4*)(vr + 8 * c8); const LAS float* pp = pw + 128 + 8 * c8;
#pragma unroll
              for (int t = 0; t < 4; ++t) o += pp[2 * t] * bflo(vw[t]) + pp[2 * t + 1] * bfhi(vw[t]); } }
        ATT[(size_t)rowq * 1024 + h * 64 + F.lane] = (bf16)f2bf(o / sum);
        LDS_WAIT(); asm volatile("" ::: "memory");
    }
}

constexpr int ACK_STRIDE = 72, ACV_STRIDE = 264;
constexpr int ALDS_CK = 0, ALDS_CV = 256 * ACK_STRIDE * 2, ALDS_RP = ALDS_CV + 64 * ACV_STRIDE * 2;
struct AttnState { float m, sum; f32x4 o[4]; };
#define MFMA16(a, b, c) __builtin_amdgcn_mfma_f32_16x16x32_bf16((a), (b), (c), 0, 0, 0)
template <int NT>
__device__ __forceinline__ void attn_tail(AttnState& S, f32x4 (&sc)[NT], const u32x4 (&vw)[NT / 2][4]) {
    float cm = -1e30f;
#pragma unroll
    for (int t = 0; t < NT; ++t)
#pragma unroll
        for (int j = 0; j < 4; ++j) cm = fmaxf(cm, sc[t][j]);
    cm = fmaxf(cm, __shfl_xor(cm, 16)); cm = fmaxf(cm, __shfl_xor(cm, 32));
    const float mn = fmaxf(S.m, cm), scl = __expf(S.m - mn); S.m = mn; float ps = 0.f;
#pragma unroll
    for (int t = 0; t < NT; ++t)
#pragma unroll
        for (int j = 0; j < 4; ++j) { const float p = __expf(sc[t][j] - mn); sc[t][j] = p; ps += p; }
    S.sum = S.sum * scl + ps;
#pragma unroll
    for (int dt = 0; dt < 4; ++dt) S.o[dt] = S.o[dt] * scl;
#pragma unroll
    for (int ks = 0; ks < NT / 2; ++ks) { u32x4 pw; pw.x = pk2(sc[2 * ks][0], sc[2 * ks][1]); pw.y = pk2(sc[2 * ks][2], sc[2 * ks][3]); pw.z = pk2(sc[2 * ks + 1][0], sc[2 * ks + 1][1]); pw.w = pk2(sc[2 * ks + 1][2], sc[2 * ks + 1][3]);
        const bf16x8 pf = __builtin_bit_cast(bf16x8, pw);
#pragma unroll
        for (int dt = 0; dt < 4; ++dt) S.o[dt] = MFMA16(__builtin_bit_cast(bf16x8, vw[ks][dt]), pf, S.o[dt]); }
}
__device__ __forceinline__ void attn_unit2(const bf16* __restrict__ KQ, const bf16* __restrict__ VT, bf16* __restrict__ ATT, LAS unsigned char* lds,
                                           const int b, const int h, const int rowqA, const int rowqB, const bool win, const int r, const int qt, const int lane) {
    const int l15 = lane & 15, g = lane >> 4;
    const f32x4 z = {0.f, 0.f, 0.f, 0.f};
    bf16x8 qA[2], qB[2];
    { const bf16* qp = KQ + (size_t)(rowqA + l15) * 2048 + 1024 + h * 64 + 8 * g; qA[0] = *(const bf16x8*)qp; qA[1] = *(const bf16x8*)(qp + 32); }
    { const bf16* qp = KQ + (size_t)(rowqB + l15) * 2048 + 1024 + h * 64 + 8 * g; qB[0] = *(const bf16x8*)qp; qB[1] = *(const bf16x8*)(qp + 32); }
    AttnState SA, SB; SA.m = -1e30f; SA.sum = 0.f; SB.m = -1e30f; SB.sum = 0.f;
#pragma unroll
    for (int dt = 0; dt < 4; ++dt) { SA.o[dt] = z; SB.o[dt] = z; }
    if (win) {
        const int rsA = min(max(r - 4, 0), 56), dB = min(max(r - 3, 0), 56) - rsA, kc0 = min(max(16 * qt - 8, 0), 32);
        const int q = 16 * qt + l15, csq = min(max(q - 8, 0), 48);
        const bf16* kb = KQ + (size_t)(b * SEQ + kc0 + l15) * 2048 + h * 64 + 8 * g;
        const bf16* vb = VT + (size_t)(b * 1024 + h * 64 + l15) * 4096 + kc0 + 4 * g;
        const LAS float* rp = (const LAS float*)(lds + ALDS_RP);
        bool okc[2][4]; int bic[2][4];
#pragma unroll
        for (int t = 0; t < 2; ++t)
#pragma unroll
            for (int j = 0; j < 4; ++j) { const int jc = kc0 + 16 * t + 4 * g + j; okc[t][j] = (jc >= csq) && (jc < csq + 16); bic[t][j] = min(max(jc - q + 15, 0), 30); }
        bf16x8 K0[2][2], K1[2][2]; u32x4 V0[1][4], V1[1][4];
#define ATT_LOADW(KB, VB, i) do { const int gr_ = min(rsA + (i), 63); const bf16* kp_ = kb + (size_t)(gr_ * 64) * 2048; const bf16* vp_ = vb + gr_ * 64; \
        _Pragma("unroll") for (int t = 0; t < 2; ++t) { KB[t][0] = *(const bf16x8*)(kp_ + (size_t)(16 * t) * 2048); KB[t][1] = *(const bf16x8*)(kp_ + (size_t)(16 * t) * 2048 + 32); } \
        _Pragma("unroll") for (int dt = 0; dt < 4; ++dt) { const u32x2 a_ = *(const u32x2*)(vp_ + (size_t)(16 * dt) * 4096), b_ = *(const u32x2*)(vp_ + (size_t)(16 * dt) * 4096 + 16); VB[0][dt] = (u32x4){a_.x, a_.y, b_.x, b_.y}; } } while (0)
#define ATT_ONE(ST, QF, KB, VB, roff) do { f32x4 sc[2]; \
        _Pragma("unroll") for (int t = 0; t < 2; ++t) { sc[t] = MFMA16(KB[t][0], QF[0], z); sc[t] = MFMA16(KB[t][1], QF[1], sc[t]); } \
        const LAS float* bp_ = rp + (roff) * 31; \
        _Pragma("unroll") for (int t = 0; t < 2; ++t) _Pragma("unroll") for (int j = 0; j < 4; ++j) { const float v_ = sc[t][j] * 0.125f + bp_[bic[t][j]]; sc[t][j] = okc[t][j] ? v_ : -1e30f; } \
        attn_tail<2>(ST, sc, VB); } while (0)
#define ATT_COMPUTE(KB, VB, i) do { const int roffA_ = rsA + (i) - r + 7; \
        if ((i) <= 7) ATT_ONE(SA, qA, KB, VB, roffA_); \
        if ((i) >= dB && (i) <= 7 + dB) ATT_ONE(SB, qB, KB, VB, roffA_ - 1); } while (0)
        ATT_LOADW(K0, V0, 0);
#pragma unroll 1
        for (int i = 0; i < 8; i += 2) { ATT_LOADW(K1, V1, i + 1); ATT_COMPUTE(K0, V0, i); ATT_LOADW(K0, V0, i + 2); ATT_COMPUTE(K1, V1, i + 1); }
        ATT_COMPUTE(K0, V0, 8);
#undef ATT_LOADW
#undef ATT_ONE
#undef ATT_COMPUTE
    }
    { const LAS bf16* ck = (const LAS bf16*)(lds + ALDS_CK) + l15 * ACK_STRIDE + 8 * g;
      const LAS bf16* cv = (const LAS bf16*)(lds + ALDS_CV) + l15 * ACV_STRIDE + 4 * g;
#pragma unroll 1
      for (int c = 0; c < 4; ++c) {
          bf16x8 kf[4][2]; u32x4 vw[2][4];
#pragma unroll
          for (int t = 0; t < 4; ++t) { const LAS bf16* kp = ck + (64 * c + 16 * t) * ACK_STRIDE; kf[t][0] = *(const LAS bf16x8*)kp; kf[t][1] = *(const LAS bf16x8*)(kp + 32); }
#pragma unroll
          for (int ks = 0; ks < 2; ++ks)
#pragma unroll
              for (int dt = 0; dt < 4; ++dt) { const LAS bf16* vp = cv + (16 * dt) * ACV_STRIDE + 64 * c + 32 * ks; const u32x2 v0 = *(const LAS u32x2*)vp, v1 = *(const LAS u32x2*)(vp + 16); vw[ks][dt] = (u32x4){v0.x, v0.y, v1.x, v1.y}; }
          { f32x4 sc[4];
#pragma unroll
            for (int t = 0; t < 4; ++t) { sc[t] = MFMA16(kf[t][0], qA[0], z); sc[t] = MFMA16(kf[t][1], qA[1], sc[t]); sc[t] = sc[t] * 0.125f; }
            attn_tail<4>(SA, sc, vw); }
          { f32x4 sc[4];
#pragma unroll
            for (int t = 0; t < 4; ++t) { sc[t] = MFMA16(kf[t][0], qB[0], z); sc[t] = MFMA16(kf[t][1], qB[1], sc[t]); sc[t] = sc[t] * 0.125f; }
            attn_tail<4>(SB, sc, vw); }
      } }
    { float sum = SA.sum; sum += __shfl_xor(sum, 16); sum += __shfl_xor(sum, 32); const float inv = 1.0f / sum;
#pragma unroll
      for (int dt = 0; dt < 4; ++dt) st_bf4(ATT + (size_t)(rowqA + l15) * 1024 + h * 64 + 16 * dt + 4 * g, SA.o[dt] * inv); }
    { float sum = SB.sum; sum += __shfl_xor(sum, 16); sum += __shfl_xor(sum, 32); const float inv = 1.0f / sum;
#pragma unroll
      for (int dt = 0; dt < 4; ++dt) st_bf4(ATT + (size_t)(rowqB + l15) * 1024 + h * 64 + 16 * dt + 4 * g, SB.o[dt] * inv); }
}
__device__ __forceinline__ void p_attn_mfma(const Params& P, Frame& F, int l, bool with_ctx_queries) {
    const bf16* KQ = WSP(bf16, WS_KQ); const bf16* VT = WSP(bf16, WS_VT); bf16* ATT = WSP(bf16, WS_ATT);
    const float* rpb = P.rpb + (size_t)l * 16 * 465;
    for (int hp = F.bid; hp < 256; hp += F.G) {
        const int p = hp & 127, half = hp >> 7, b = p >> 4, h = p & 15;
        __syncthreads();
        { LAS bf16* ck = (LAS bf16*)(F.lds + ALDS_CK); LAS bf16* cv = (LAS bf16*)(F.lds + ALDS_CV); LAS float* rp = (LAS float*)(F.lds + ALDS_RP);
          { const int key = F.tid >> 1, hf = F.tid & 1; const u32x4* src = (const u32x4*)(KQ + (size_t)(RL + b * CTXL + key) * 2048 + h * 64 + hf * 32); LAS u32x4* dst = (LAS u32x4*)(ck + key * ACK_STRIDE + hf * 32);
#pragma unroll
            for (int i = 0; i < 4; ++i) dst[i] = src[i]; }
          { const int d = F.tid >> 3, sg = F.tid & 7; const u32x4* src = (const u32x4*)(VT + YT_CTX_OFF + (size_t)(b * 1024 + h * 64 + d) * 256 + sg * 32); LAS u32x4* dst = (LAS u32x4*)(cv + d * ACV_STRIDE + sg * 32);
#pragma unroll
            for (int i = 0; i < 4; ++i) dst[i] = src[i]; }
          if (F.tid < 465) rp[F.tid] = rpb[h * 465 + F.tid]; }
        __syncthreads();
        const int qt = F.wave & 3, rpi = F.wave >> 2;
#pragma unroll 1
        for (int st = 0; st < 8; ++st) { const int r = half * 32 + st * 4 + rpi * 2; const int rowqA = b * SEQ + r * 64 + 16 * qt;
            attn_unit2(KQ, VT, ATT, F.lds, b, h, rowqA, rowqA + 64, true, r, qt, F.lane); }
        if (with_ctx_queries && half == 0) { const int rowqA = RL + b * CTXL + 32 * F.wave; attn_unit2(KQ, VT, ATT, F.lds, b, h, rowqA, rowqA + 16, false, 0, 0, F.lane); }
    }
    __syncthreads();
}

__device__ __forceinline__ void p_pool(Frame& F, int nrows) {
    const bf16* PB = WSP(bf16, WS_PB); bf16* POOL = WSP(bf16, WS_POOL);
    for (int i = F.bid * NTHREADS + F.tid; i < nrows * 64; i += F.G * NTHREADS) {
        const int row = i >> 6, ch = i & 63, g = ch >> 4, hw = 1 << g;
        int base, t, Lb; if (row < RL) { base = row & ~4095; t = row & 4095; Lb = SEQ; } else { const int rr = row - RL; base = RL + (rr & ~255); t = rr & 255; Lb = CTXL; }
        const int lo = max(t - hw, 0), hi = min(t + hw, Lb);
        float a[8];
#pragma unroll
        for (int q = 0; q < 8; ++q) a[q] = 0.f;
        for (int tt = lo; tt < hi; ++tt) { const u32x4 w = *(const u32x4*)(PB + (size_t)(base + tt) * 512 + ch * 8);
#pragma unroll
            for (int q = 0; q < 4; ++q) { a[2 * q] += bflo(w[q]); a[2 * q + 1] += bfhi(w[q]); } }
        const u32x4 me = *(const u32x4*)(PB + (size_t)row * 512 + ch * 8); const float inv = 1.0f / (float)(hi - lo);
        u32x4 o;
#pragma unroll
        for (int q = 0; q < 4; ++q) o[q] = pk2(a[2 * q] * inv - bflo(me[q]), a[2 * q + 1] * inv - bfhi(me[q]));
        *(u32x4*)(POOL + (size_t)row * 512 + ch * 8) = o;
    }
}

__device__ __forceinline__ int block_sum_i(int v, LAS int* sm, int tid) {
#pragma unroll
    for (int o = 1; o < 64; o <<= 1) v += __shfl_xor(v, o);
    __syncthreads();
    if ((tid & 63) == 0) sm[tid >> 6] = v;
    __syncthreads();
    int s = 0;
#pragma unroll
    for (int i = 0; i < 8; ++i) s += sm[i];
    return s;
}
__device__ __forceinline__ int block_excl_scan(int v, LAS int* sm, int tid, int& total) {
    const int lane = tid & 63, w = tid >> 6; int inc = v;
#pragma unroll
    for (int o = 1; o < 64; o <<= 1) { const int t = __shfl_up(inc, o); if (lane >= o) inc += t; }
    __syncthreads();
    if (lane == 63) sm[w] = inc;
    __syncthreads();
    int base = 0; total = 0;
#pragma unroll
    for (int i = 0; i < 8; ++i) { const int s = sm[i]; if (i < w) base += s; total += s; }
    return base + inc - v;
}
template <int NPT>
__device__ __forceinline__ void topk_pair(Frame& F, int row0, int n, int cap, int e, int slot0) {
    LAS int* sm = (LAS int*)F.lds;
    const float* AFF = WSP(float, WS_AFF); int* SROW = WSP(int, WS_SROW); float* SG = WSP(float, WS_SGATE); int* SEL = WSP(int, WS_SEL);
    unsigned key[NPT];
#pragma unroll
    for (int j = 0; j < NPT; ++j) { const int i = F.tid * NPT + j; key[j] = (i < n) ? __float_as_uint(AFF[(size_t)(row0 + i) * 16 + e]) : 0u; }
    unsigned T = 0u;
    for (int bit = 30; bit >= 0; --bit) { const unsigned cand = T | (1u << bit); int cnt = 0;
#pragma unroll
        for (int j = 0; j < NPT; ++j) cnt += (key[j] >= cand) ? 1 : 0;
        cnt = block_sum_i(cnt, sm, F.tid);
        if (cnt >= cap) T = cand; }
    int ngt = 0, neq = 0;
#pragma unroll
    for (int j = 0; j < NPT; ++j) { ngt += (key[j] > T) ? 1 : 0; neq += (key[j] == T) ? 1 : 0; }
    int tot_gt, tot_eq;
    (void)block_excl_scan(ngt, sm, F.tid, tot_gt);
    int eqr = block_excl_scan(neq, sm, F.tid, tot_eq);
    const int need_eq = cap - tot_gt;
    int nsel = 0; bool selj[NPT];
#pragma unroll
    for (int j = 0; j < NPT; ++j) { bool s = key[j] > T; if (key[j] == T && T != 0u) { s = eqr < need_eq; ++eqr; } selj[j] = s; nsel += s ? 1 : 0; }
    int tot_sel; int pos = block_excl_scan(nsel, sm, F.tid, tot_sel);
#pragma unroll
    for (int j = 0; j < NPT; ++j) { const int i = F.tid * NPT + j;
        if (i < n) { const int row = row0 + i;
            if (selj[j]) { const int slot = slot0 + pos; ++pos; SROW[slot] = row; SG[slot] = __uint_as_float(key[j]); SEL[(size_t)row * 16 + e] = slot; }
            else SEL[(size_t)row * 16 + e] = -1; } }
    __syncthreads();
}
__device__ __forceinline__ void p_topk(Frame& F, bool with_ctx) {
    const int npairs = 128 + (with_ctx ? 128 : 0);
    for (int pi = F.bid; pi < npairs; pi += F.G) {
        if (pi < 128) { const int b = pi >> 4, e = pi & 15; topk_pair<8>(F, b * SEQ, SEQ, CAPL, e, e * SLOT_E + b * CAPL); }
        else { const int p2 = pi - 128, b = p2 >> 4, e = p2 & 15; topk_pair<1>(F, RL + b * CTXL, CTXL, CAPC, e, e * SLOT_E + 4096 + b * CAPC); }
    }
}
__device__ __forceinline__ void p_gather(Frame& F, bool with_ctx) {
    const int gw = F.bid * NWAVES + F.wave, NGW = F.G * NWAVES; const bf16* H = WSP(bf16, WS_H); bf16* XG = WSP(bf16, WS_XG); const int* SROW = WSP(int, WS_SROW);
    for (int s = gw; s < NSLOT; s += NGW) { if (!with_ctx && (s % SLOT_E) >= 4096) continue;
        const int row = SROW[s]; const u32x4* src = (const u32x4*)(H + (size_t)row * DM); u32x4* dst = (u32x4*)(XG + (size_t)s * DM);
        dst[F.lane] = src[F.lane]; dst[F.lane + 64] = src[F.lane + 64]; }
}

template <int PH> __global__ void __launch_bounds__(NTHREADS, 2) fwd_kernel(Params P) {
    extern __shared__ __attribute__((aligned(16))) unsigned char lds_raw[];
    Frame F; F.lds = (LAS unsigned char*)lds_raw; F.tid = threadIdx.x; F.lane = F.tid & 63; F.wave = __builtin_amdgcn_readfirstlane(F.tid >> 6); F.G = gridDim.x; F.bid = blockIdx.x; F.ws = P.ws;
    volatile LAS unsigned* MISC = (volatile LAS unsigned*)(F.lds + LDS_MISC);
    if (F.tid < 64) MISC[F.tid] = 0u;
    __syncthreads();
    XcdBarrier bar; bar.bar = WSP(unsigned, WS_CTL) + CW_BAR; bar.x = 0; bar.st = MISC + 8;
    if constexpr (PH < 0) bar = xcd_barrier_post(WSP(unsigned, WS_CTL) + CW_BAR, MISC + 8);
#define IN(k) (PH < 0 || PH == (k))
#define REFRESH() do { int t_ = threadIdx.x; asm volatile("" : "+v"(t_)); F.tid = t_; F.lane = t_ & 63; F.wave = __builtin_amdgcn_readfirstlane(t_ >> 6); } while (0)
#define SEAM(k) do { if constexpr (PH < 0) xcd_barrier(bar); } while (0)

    if (IN(0)) { REP_BEGIN(100) p_mod(P, F); p_dftgen(F); REP_END REP_BEGIN(101) p_wconv(P, F, 0); REP_END }
    SEAM(0);
    if (IN(1)) { p_rowpass_a0(P, F); }
    SEAM(1);
    for (int l = P.l_lo; l < P.l_hi; ++l) {
        constexpr int pb = 2; const bool L0 = (l == 0);
        bf16* H = WSP(bf16, WS_H);
        if (IN(pb + 0)) { REFRESH(); REP_BEGIN(2)
            { GroupSched S; S.init(1, 128, 22, F.G, F.bid, 8, L0 ? 22 : 4, 128, 0);
              const bf16* WA = WSP(bf16, WS_WA);
              auto AD = [=](const Unit& u) { return Operands{H + (size_t)u.pm * 256 * DM, WA + (size_t)u.pn * 256 * DM, DM, DM}; };
              bf16* KQ = WSP(bf16, WS_KQ); bf16* PBp = WSP(bf16, WS_PB); bf16* GB = WSP(bf16, WS_GB);
              auto E = [=](EPI_ARGS) { const int row0 = u.pm * 256;
                  if (u.pn < 8) { EPI_FOR( st_bf4(KQ + (size_t)(row0 + r) * 2048 + u.pn * 256 + c, v); ) }
                  else if (u.pn < 10) { EPI_FOR( st_bf4(PBp + (size_t)(row0 + r) * 512 + (u.pn - 8) * 256 + c, v); ) }
                  else { EPI_FOR( f32x4 s; s[0] = sigmoidf_(v[0]); s[1] = sigmoidf_(v[1]); s[2] = sigmoidf_(v[2]); s[3] = sigmoidf_(v[3]); st_bf4(GB + (size_t)(row0 + r) * 3072 + (u.pn - 10) * 256 + c, s); ) } };
              GEMM(S, AD, E, DM, DM, DM); }
            { GroupSched S; S.init(1, 8, 128, F.G, F.bid, L0 ? 8 : 4, 8, L0 ? 0 : 4, 128);
              const bf16* WFV = WSP(bf16, WS_WFV);
              auto AD = [=](const Unit& u) { return Operands{WFV + (size_t)u.pm * 256 * DM, H + (size_t)u.pn * 256 * DM, DM, DM}; };
              bf16* YT = WSP(bf16, WS_YT); bf16* VT = WSP(bf16, WS_VT);
              auto E = [=](EPI_ARGS) { bf16* T = (u.pm < 4) ? YT : VT; const int rr0 = (u.pm & 3) * 256;
                  if (u.pn < 128) { const int b = u.pn >> 4, l0 = (u.pn & 15) * 256; EPI_FOR( st_bf4(T + ((size_t)b * 1024 + rr0 + r) * 4096 + l0 + c, v); ) }
                  else { const int b = u.pn - 128; EPI_FOR( st_bf4(T + YT_CTX_OFF + ((size_t)b * 1024 + rr0 + r) * 256 + c, v); ) } };
              GEMM(S, AD, E, DM, DM, DM); }
        REP_END }
        SEAM(pb + 0);
        if (IN(pb + 1)) { REFRESH();
            REP_BEGIN(31) p_attn_mfma(P, F, l, L0); REP_END
            REP_BEGIN(32)
            { GroupSched S; S.init(1, 16, 16, F.G, F.bid);
              const bf16* DFTM = WSP(bf16, WS_DFTM); const bf16* YT = WSP(bf16, WS_YT); bf16* FOUR = WSP(bf16, WS_FOUR);
              auto AD = [=](const Unit& u) { return Operands{DFTM + (size_t)u.pm * 256 * 8192, YT + (size_t)u.pn * 256 * 8192, 8192, 8192}; };
              auto E = [=](EPI_ARGS) { const int b = u.pn >> 1, c0 = (u.pn & 1) * 256; const float sc = 0.0013810679320049757f;
                  EPI_FOR( st_bf4(FOUR + ((size_t)b * SEQ + u.pm * 256 + r) * 512 + c0 + c, v * sc); ) };
              GEMM(S, AD, E, 8192, 8192, 8192); }
            if (L0) { GroupSched S; S.init(1, 1, 16, F.G, F.bid);
              const bf16* DFTC = WSP(bf16, WS_DFTC); const bf16* YTC = WSP(bf16, WS_YT) + YT_CTX_OFF; bf16* FOUR = WSP(bf16, WS_FOUR);
              auto AD = [=](const Unit& u) { return Operands{DFTC, YTC + (size_t)u.pn * 256 * 512, 512, 512}; };
              auto E = [=](EPI_ARGS) { const int b = u.pn >> 1, c0 = (u.pn & 1) * 256; const float sc = 0.005524271728019903f;
                  EPI_FOR( st_bf4(FOUR + ((size_t)RL + b * CTXL + r) * 512 + c0 + c, v * sc); ) };
              GEMM(S, AD, E, 512, 512, 512); }
            REP_END
            REP_BEGIN(33) p_pool(F, L0 ? RT : RL); REP_END
        }
        SEAM(pb + 1);
        if (IN(pb + 2)) { REFRESH(); REP_BEGIN(4)
            const int nM = L0 ? 136 : 128; float* MRG = WSP(float, WS_MRG); const bf16* GB = WSP(bf16, WS_GB);
            { GroupSched S; S.init(1, nM, 4, F.G, F.bid); const bf16* A = WSP(bf16, WS_ATT); const bf16* W = WSP(bf16, WS_WAO);
              auto AD = [=](const Unit& u) { return Operands{A + (size_t)u.pm * 256 * 1024, W + (size_t)u.pn * 256 * 1024, 1024, 1024}; };
              auto E = [=](EPI_ARGS) { EPI_FOR( const size_t row = (size_t)u.pm * 256 + r; const int col = u.pn * 256 + c; const u32x2 g = *(const u32x2*)(GB + row * 3072 + col);
                  f32x4 o; o[0] = bflo(g.x) * v[0]; o[1] = bfhi(g.x) * v[1]; o[2] = bflo(g.y) * v[2]; o[3] = bfhi(g.y) * v[3]; *(f32x4*)(MRG + row * 1024 + col) = o; ) };
              GEMM(S, AD, E, 1024, 1024, 1024); }
            { GroupSched S; S.init(1, nM, 4, F.G, F.bid); const bf16* A = WSP(bf16, WS_FOUR); const bf16* W = WSP(bf16, WS_WFO);
              auto AD = [=](const Unit& u) { return Operands{A + (size_t)u.pm * 256 * 512, W + (size_t)u.pn * 256 * 512, 512, 512}; };
              auto E = [=](EPI_ARGS) { EPI_FOR( const size_t row = (size_t)u.pm * 256 + r; const int col = u.pn * 256 + c; const u32x2 g = *(const u32x2*)(GB + row * 3072 + 1024 + col);
                  f32x4 o = *(const f32x4*)(MRG + row * 1024 + col); o[0] += bflo(g.x) * v[0]; o[1] += bfhi(g.x) * v[1]; o[2] += bflo(g.y) * v[2]; o[3] += bfhi(g.y) * v[3]; *(f32x4*)(MRG + row * 1024 + col) = o; ) };
              GEMM(S, AD, E, 512, 512, 512); }
            { GroupSched S; S.init(1, nM, 4, F.G, F.bid); const bf16* A = WSP(bf16, WS_POOL); const bf16* W = WSP(bf16, WS_WPO); bf16* MRGB = WSP(bf16, WS_MRGB);
              const float* ps = P.pool_scale + l * 1024;
              auto AD = [=](const Unit& u) { return Operands{A + (size_t)u.pm * 256 * 512 + (u.pn >> 1) * 256, W + (size_t)u.pn * 256 * 256, 512, 256}; };
              auto E = [=](EPI_ARGS) { EPI_FOR( const size_t row = (size_t)u.pm * 256 + r; const int col = u.pn * 256 + c; const u32x2 g = *(const u32x2*)(GB + row * 3072 + 2048 + col);
                  const f32x4 pv = *(const f32x4*)(ps + col); f32x4 o = *(const f32x4*)(MRG + row * 1024 + col);
                  o[0] += bflo(g.x) * pv[0] * v[0]; o[1] += bfhi(g.x) * pv[1] * v[1]; o[2] += bflo(g.y) * pv[2] * v[2]; o[3] += bfhi(g.y) * pv[3] * v[3]; st_bf4(MRGB + row * 1024 + col, o); ) };
              GEMM(S, AD, E, 256, 512, 256); }
        REP_END }
        SEAM(pb + 2);
        if (IN(pb + 3)) { REFRESH();
            GroupSched S; S.init(1, L0 ? 136 : 128, 4, F.G, F.bid); const bf16* A = WSP(bf16, WS_MRGB); const bf16* W = WSP(bf16, WS_WOUT);
            const float* xin = L0 ? P.x : P.out; const float* cin = L0 ? P.ctx : WSP(float, WS_XC); float* xo = P.out; float* co = WSP(float, WS_XC);
            const float* MOD = WSP(float, WS_MOD) + (size_t)l * 9 * 6144;
            auto AD = [=](const Unit& u) { return Operands{A + (size_t)u.pm * 256 * 1024, W + (size_t)u.pn * 256 * 1024, 1024, 1024}; };
            auto E = [=](EPI_ARGS) { EPI_FOR( const int row = u.pm * 256 + r; const int col = u.pn * 256 + c; const int mr = row < RL ? (row >> 12) : 8;
                const f32x4 g = *(const f32x4*)(MOD + (size_t)mr * 6144 + 2048 + col);
                const float* src = row < RL ? xin + (size_t)row * DM + col : cin + (size_t)(row - RL) * DM + col; float* dst = row < RL ? xo + (size_t)row * DM + col : co + (size_t)(row - RL) * DM + col;
                *(f32x4*)dst = *(const f32x4*)src + g * v; ) };
            GEMM(S, AD, E, 1024, 1024, 1024);
        }
        SEAM(pb + 3);
        if (IN(pb + 4)) { REFRESH(); REP_BEGIN(6) p_rowpass_f(P, F, l, L0 ? RT : RL); REP_END }
        SEAM(pb + 4);
        if (IN(pb + 5)) { REFRESH(); REP_BEGIN(7) p_topk(F, L0); REP_END }
        SEAM(pb + 5);
        if (IN(pb + 6)) { REFRESH(); REP_BEGIN(8) p_gather(F, L0); REP_END }
        SEAM(pb + 6);
        if (IN(pb + 7)) { REFRESH(); REP_BEGIN(9)
            GroupSched S; S.init(16, L0 ? 17 : 16, 22, F.G, F.bid); const bf16* XG = WSP(bf16, WS_XG); const bf16* W = WSP(bf16, WS_WGU); bf16* HID = WSP(bf16, WS_HID);
            auto AD = [=](const Unit& u) { return Operands{XG + ((size_t)u.grp * SLOT_E + u.pm * 256) * DM, W + ((size_t)u.grp * 5632 + u.pn * 256) * DM, DM, DM}; };
            auto E = [=](EPI_ARGS) {
#pragma unroll
                for (int ai = 0; ai < 2; ++ai)
#pragma unroll
                    for (int m = 0; m < 4; ++m) { const size_t slot = (size_t)u.grp * SLOT_E + u.pm * 256 + ai * 128 + wr * 64 + m * 16 + fr;
#pragma unroll
                        for (int n = 0; n < 2; ++n) { const f32x4 a = acc[ai][0][m][n], up = acc[ai][1][m][n]; f32x4 o;
#pragma unroll
                            for (int j = 0; j < 4; ++j) o[j] = a[j] * sigmoidf_(a[j]) * up[j];
                            st_bf4(HID + slot * FF + u.pn * 128 + wc * 32 + n * 16 + 4 * fq, o); } } };
            GEMM(S, AD, E, DM, DM, DM);
        REP_END }
        SEAM(pb + 7);
        if (IN(pb + 8)) { REFRESH(); REP_BEGIN(10)
            GroupSched S; S.init(16, L0 ? 17 : 16, 4, F.G, F.bid); const bf16* HID = WSP(bf16, WS_HID); const bf16* W = WSP(bf16, WS_WD); bf16* Y = WSP(bf16, WS_Y); const float* SG = WSP(float, WS_SGATE);
            auto AD = [=](const Unit& u) { return Operands{HID + ((size_t)u.grp * SLOT_E + u.pm * 256) * FF, W + ((size_t)u.grp * 1024 + u.pn * 256) * FF, FF, FF}; };
            auto E = [=](EPI_ARGS) { EPI_FOR( const size_t slot = (size_t)u.grp * SLOT_E + u.pm * 256 + r; const float gt = SG[slot]; st_bf4(Y + slot * DM + u.pn * 256 + c, v * gt); ) };
            GEMM(S, AD, E, FF, FF, FF);
        REP_END }
        SEAM(pb + 8);
        if (IN(pb + 9)) { REFRESH(); p_rowpass_k(P, F, l, L0 ? RT : RL); if (L0) p_wconv(P, F, 1); }
        if (L0) SEAM(pb + 9);
    }
#undef IN
#undef SEAM
}
template <int PH> static void launch_ph(int grid, const Params& p, hipStream_t stream) { hipLaunchKernelGGL(fwd_kernel<PH>, dim3(grid), dim3(NTHREADS), LDS_BYTES, stream, p); }
template <int PH> static bool set_attr() { return hipFuncSetAttribute((const void*)fwd_kernel<PH>, hipFuncAttributeMaxDynamicSharedMemorySize, LDS_BYTES) == hipSuccess; }

extern "C" void kernel_launch(void* const* d_in, const int* in_sizes, int n_in, void* d_out, int out_size, void* d_ws, size_t ws_size, hipStream_t stream) {
    static int grid = 0;
    if (grid == 0) {
        if (n_in != 20 || out_size != RL * DM || ws_size < WS_END) { fprintf(stderr, "kernel_launch: unexpected shapes (n_in %d out %d ws %zu need %zu)\n", n_in, out_size, ws_size, (size_t)WS_END); grid = -1; return; }
        int dev = 0, cus = 0, per_cu = 0;
        if (hipGetDevice(&dev) != hipSuccess || hipDeviceGetAttribute(&cus, hipDeviceAttributeMultiprocessorCount, dev) != hipSuccess) { grid = -1; return; }
#if N_LAUNCH_MODE == 1
        if (!set_attr<-1>()) { fprintf(stderr, "kernel_launch: hipFuncSetAttribute failed\n"); grid = -1; return; }
        if (hipOccupancyMaxActiveBlocksPerMultiprocessor(&per_cu, (const void*)fwd_kernel<-1>, NTHREADS, LDS_BYTES) != hipSuccess || per_cu < 1) fprintf(stderr, "kernel_launch: occupancy query reports %d\n", per_cu);
#else
        if (!(set_attr<0>() && set_attr<1>() && set_attr<2>() && set_attr<3>() && set_attr<4>() && set_attr<5>() && set_attr<6>() && set_attr<7>() && set_attr<8>() && set_attr<9>() && set_attr<10>() && set_attr<11>())) { fprintf(stderr, "kernel_launch: hipFuncSetAttribute failed\n"); grid = -1; return; }
        (void)per_cu;
#endif
        (void)hipGetLastError();
        grid = cus;
    }
    if (grid < 0) return;
    if (hipMemsetAsync((char*)d_ws + WS_CTL, 0, CTL_BYTES, stream) != hipSuccess) return;
    Params p{};
    const float** pp = (const float**)&p;
    for (int i = 0; i < 20; ++i) pp[i] = (const float*)d_in[i];
    p.out = (float*)d_out; p.ws = (unsigned char*)d_ws;
#if N_LAUNCH_MODE == 1
    p.l_lo = 0; p.l_hi = 2;
    launch_ph<-1>(grid, p, stream);
#else
    p.l_lo = 0; p.l_hi = 0; launch_ph<0>(grid, p, stream); launch_ph<1>(grid, p, stream);
    for (int l = 0; l < 2; ++l) { p.l_lo = l; p.l_hi = l + 1;
        launch_ph<2>(grid, p, stream); launch_ph<3>(grid, p, stream); launch_ph<4>(grid, p, stream); launch_ph<5>(grid, p, stream); launch_ph<6>(grid, p, stream);
        launch_ph<7>(grid, p, stream); launch_ph<8>(grid, p, stream); launch_ph<9>(grid, p, stream); launch_ph<10>(grid, p, stream); launch_ph<11>(grid, p, stream); }
#endif
}
```

```cpp
#include <hip/hip_runtime.h>
#include <cstdio>
#include <cstdint>

#ifndef N_LAUNCH_MODE
#define N_LAUNCH_MODE 1
#endif

#define GAS __attribute__((address_space(1)))
#define LAS __attribute__((address_space(3)))
typedef unsigned short bf16;
typedef short bf16x8 __attribute__((ext_vector_type(8)));
typedef float f32x4 __attribute__((ext_vector_type(4)));
typedef unsigned u32x4 __attribute__((ext_vector_type(4)));
typedef unsigned u32x2 __attribute__((ext_vector_type(2)));

constexpr int NB = 8, SEQ = 4096, DM = 1024, CTXL = 256, NH = 16, HD = 64, GRIDW = 64;
constexpr int RL = NB * SEQ, RC = NB * CTXL, RT = RL + RC;
constexpr int INW = 7168, NE = 16, FF = 2816, CAPL = 512, CAPC = 32;
constexpr int SLOT_E = 4352, NSLOT = NE * SLOT_E;
constexpr float RMS_EPS = 1e-6f;
constexpr float LOG2E = 1.4426950408889634f, QSCALE = 0.125f * LOG2E;
constexpr int NWAVES = 8, NTHREADS = 512;

constexpr size_t al256(size_t x) { return (x + 255) & ~(size_t)255; }
constexpr size_t WS_CTL = 0, CTL_BYTES = 1u << 20;
constexpr size_t WS_MOD = WS_CTL + CTL_BYTES;
constexpr size_t WS_XC = al256(WS_MOD + (size_t)2 * 9 * 6144 * 4);
constexpr size_t WS_AFF = al256(WS_XC + (size_t)RC * DM * 4);
constexpr size_t WS_SROW = al256(WS_AFF + (size_t)RT * 16 * 4);
constexpr size_t WS_SGATE = al256(WS_SROW + (size_t)NSLOT * 4);
constexpr size_t WS_SEL = al256(WS_SGATE + (size_t)NSLOT * 4);
constexpr size_t WS_DFTM = al256(WS_SEL + (size_t)RT * 16 * 4);
constexpr size_t WS_DFTC = al256(WS_DFTM + (size_t)4096 * 8192 * 2);
constexpr size_t WS_WA = al256(WS_DFTC + (size_t)256 * 512 * 2);
constexpr size_t WS_WFV = al256(WS_WA + (size_t)5632 * 1024 * 2);
constexpr size_t WS_WAO = al256(WS_WFV + (size_t)2048 * 1024 * 2);
constexpr size_t WS_WFO = al256(WS_WAO + (size_t)1024 * 1024 * 2);
constexpr size_t WS_WPO = al256(WS_WFO + (size_t)1024 * 512 * 2);
constexpr size_t WS_WOUT = al256(WS_WPO + (size_t)1024 * 256 * 2);
constexpr size_t WS_WGU = al256(WS_WOUT + (size_t)1024 * 1024 * 2);
constexpr size_t WS_WD = al256(WS_WGU + (size_t)16 * 5632 * 1024 * 2);
constexpr size_t WS_H = al256(WS_WD + (size_t)16 * 1024 * 2816 * 2);
constexpr size_t WS_R = al256(WS_H + (size_t)RT * DM * 2);
constexpr size_t WS_KQ = WS_R;
constexpr size_t WS_MRG = WS_KQ;
constexpr size_t WS_PB = al256(WS_KQ + (size_t)RT * 2048 * 2);
constexpr size_t WS_GB = al256(WS_PB + (size_t)RT * 512 * 2);
constexpr size_t WS_YT = al256(WS_GB + (size_t)RT * 3072 * 2);
constexpr size_t WS_MRGB = WS_YT;
constexpr size_t WS_VT = al256(WS_YT + (size_t)RT * 1024 * 2);
constexpr size_t WS_FOUR = al256(WS_VT + (size_t)RT * 1024 * 2);
constexpr size_t WS_ATT = al256(WS_FOUR + (size_t)RT * 512 * 2);
constexpr size_t WS_POOL = al256(WS_ATT + (size_t)RT * 1024 * 2);
constexpr size_t WS_MIX_END = al256(WS_POOL + (size_t)RT * 512 * 2);
constexpr size_t WS_XG = WS_R;
constexpr size_t WS_HID = al256(WS_XG + (size_t)NSLOT * 1024 * 2);
constexpr size_t WS_Y = al256(WS_HID + (size_t)NSLOT * 2816 * 2);
constexpr size_t WS_MOE_END = al256(WS_Y + (size_t)NSLOT * 1024 * 2);
constexpr size_t WS_END = WS_MIX_END > WS_MOE_END ? WS_MIX_END : WS_MOE_END;
constexpr size_t YT_CTX_OFF = (size_t)8 * 1024 * 4096;

constexpr int CW_BAR = 4096;

constexpr int LDS_BYTES = 147456;
constexpr int LDS_MISC = 131072;

__device__ __forceinline__ unsigned f2bf(float f) { unsigned u = __float_as_uint(f); return (u + 0x7fffu + ((u >> 16) & 1u)) >> 16; }
typedef __bf16 hbf16x2 __attribute__((ext_vector_type(2)));
typedef float f32x2 __attribute__((ext_vector_type(2)));
__device__ __forceinline__ unsigned pk2(float lo, float hi) { const f32x2 v = {lo, hi}; return __builtin_bit_cast(unsigned, __builtin_convertvector(v, hbf16x2)); }
__device__ __forceinline__ float bf2f(unsigned b) { return __uint_as_float(b << 16); }
__device__ __forceinline__ float bflo(unsigned w) { return __uint_as_float(w << 16); }
__device__ __forceinline__ float bfhi(unsigned w) { return __uint_as_float(w & 0xffff0000u); }
__device__ __forceinline__ float wave_sum(float v) {
#pragma unroll
    for (int o = 1; o < 64; o <<= 1) v += __shfl_xor(v, o);
    return v;
}
__device__ __forceinline__ float wave_max(float v) {
#pragma unroll
    for (int o = 1; o < 64; o <<= 1) v = fmaxf(v, __shfl_xor(v, o));
    return v;
}
__device__ __forceinline__ float sigmoidf_(float x) { return 1.f / (1.f + __expf(-x)); }
#define LDS_WAIT() asm volatile("s_waitcnt lgkmcnt(0)" ::: "memory")

#define XB_TMO      128
#define XB_XCNT(j)  (256  + 64 * (j))
#define XB_XSUB(j)  (1280 + 64 * (j))
#define XB_XGEN(j)  (2304 + 64 * (j))
#define XB_TOP      3328
#define XB_TOPGEN   3392
#define XCD_BAR_WORDS 3456
#define XB_SPIN_CAP (1u << 22)

__device__ __forceinline__ unsigned xb_ld(unsigned* p)              { return __hip_atomic_load(p, __ATOMIC_RELAXED, __HIP_MEMORY_SCOPE_AGENT); }
__device__ __forceinline__ unsigned xb_add(unsigned* p, unsigned v) { return __hip_atomic_fetch_add(p, v, __ATOMIC_RELAXED, __HIP_MEMORY_SCOPE_AGENT); }
__device__ __forceinline__ unsigned xb_xcc_id() { return (unsigned)__builtin_amdgcn_s_getreg((3 << 11) | 20) & 0xFu; }
#define XB_SPIN(cond, bar) do { unsigned _sp = 0; while (cond) { __builtin_amdgcn_s_sleep(1); \
    if ((++_sp & 255u) == 0u) { if (xb_ld(&(bar)[XB_TMO])) break; if (_sp > XB_SPIN_CAP) { atomicAdd(&(bar)[XB_TMO], 1u); break; } } } } while (0)

struct XcdBarrier { unsigned* bar; unsigned x; volatile LAS unsigned* st; };

__device__ __forceinline__ XcdBarrier xcd_barrier_post(unsigned* bar, volatile LAS unsigned* st) {
    XcdBarrier b; b.bar = bar; b.x = xb_xcc_id(); b.st = st;
    if (threadIdx.x == 0) (void)xb_add(&bar[XB_XCNT(b.x)], 1u);
    return b;
}
__device__ __forceinline__ void xcd_barrier_complete(unsigned* bar, unsigned x, unsigned& nloc, unsigned& nx) {
    const unsigned G = gridDim.x * gridDim.y * gridDim.z;
    unsigned sum, cnt, mine, sp = 0u;
    for (;;) {
        sum = 0u; cnt = 0u; mine = 0u;
#pragma unroll
        for (unsigned j = 0; j < 16; ++j) { const unsigned c = xb_ld(&bar[XB_XCNT(j)]); sum += c; cnt += (c > 0u) ? 1u : 0u; mine = (j == x) ? c : mine; }
        if (sum == G) break;
        __builtin_amdgcn_s_sleep(1);
        if ((++sp & 255u) == 0u) { if (xb_ld(&bar[XB_TMO])) break; if (sp > XB_SPIN_CAP) { atomicAdd(&bar[XB_TMO], 1u); break; } }
    }
    nloc = mine > 0u ? mine : 1u; nx = cnt > 0u ? cnt : 1u;
}
__device__ __forceinline__ void xcd_barrier(const XcdBarrier& b) {
    asm volatile("s_waitcnt vmcnt(0)" ::: "memory");
    __syncthreads();
    if (threadIdx.x == 0) {
        unsigned* bar = b.bar;
        __builtin_amdgcn_s_waitcnt(0);
        unsigned nloc = b.st[0], nx = b.st[1];
        if (nloc == 0u) { xcd_barrier_complete(bar, b.x, nloc, nx); b.st[0] = nloc; b.st[1] = nx; }
        const unsigned old = xb_add(&bar[XB_XSUB(b.x)], 1u);
        const unsigned gen = old / nloc;
        if (old + 1u == (gen + 1u) * nloc) {
            __builtin_amdgcn_fence(__ATOMIC_RELEASE, "agent");
            asm volatile("s_waitcnt vmcnt(0)" ::: "memory");
            const unsigned og = xb_add(&bar[XB_TOP], 1u);
            const unsigned tg = og / nx;
            if (og + 1u == (tg + 1u) * nx) xb_add(&bar[XB_TOPGEN], 1u);
            else XB_SPIN(xb_ld(&bar[XB_TOPGEN]) == tg, bar);
            __builtin_amdgcn_fence(__ATOMIC_ACQUIRE, "agent");
            xb_add(&bar[XB_XGEN(b.x)], 1u);
            asm volatile("s_waitcnt vmcnt(0)" ::: "memory");
        } else {
            XB_SPIN(xb_ld(&bar[XB_XGEN(b.x)]) == gen, bar);
            __builtin_amdgcn_fence(__ATOMIC_ACQUIRE, "agent");
            asm volatile("s_waitcnt vmcnt(0)" ::: "memory");
        }
    }
    __syncthreads();
}

struct Params {
    const float *x, *c, *ctx, *c_ctx, *ada_w, *ada_b, *norm1_g, *norm2_g, *w_in, *rpb, *w_att_o, *w_fourier, *w_pool, *pool_scale, *w_out, *w_router, *w_eg, *w_eu, *w_ed, *final_g;
    float* out; unsigned char* ws; int l_lo, l_hi;
};
struct Frame {
    LAS unsigned char* lds;
    int tid, lane, wave, G, bid;
    unsigned char* ws;
};
#define WSP(T, off) ((T*)(F.ws + (off)))

struct Unit { int grp, pm, pn; };
struct GroupSched {
    int ng, nM, nN, G, c; int tM, tN, tpm0, tpn0;
    __device__ __forceinline__ void init(int ng_, int nM_, int nN_, int G_, int c_, int tM_ = 0, int tN_ = 0, int tpm0_ = 0, int tpn0_ = 0) { ng = ng_; nM = nM_; nN = nN_; G = G_; c = c_; tM = tM_; tN = tN_; tpm0 = tpm0_; tpn0 = tpn0_; }
    __device__ __forceinline__ bool next(int i, Unit& u) const {
        const int per = nM * nN; const int L = i * G + c;
        if (L < ng * per) {
            u.grp = L / per; int wgid = L - u.grp * per;
            { const int q = per / 8, r = per % 8, xcd = wgid % 8, off = wgid / 8; wgid = (xcd < r ? xcd * (q + 1) : r * (q + 1) + (xcd - r) * q) + off; }
            const int nig = 8 * nN, gid = wgid / nig, fm = gid * 8, gsz = (nM - fm) < 8 ? (nM - fm) : 8;
            u.pm = fm + ((wgid % nig) % gsz); u.pn = (wgid % nig) / gsz; return true;
        }
        const int w = L - ng * per;
        if (w < tM * tN) { u.grp = ng; u.pm = tpm0 + (w % tM); u.pn = tpn0 + (w / tM); return true; }
        return false;
    }
};
struct Operands { const bf16* A; const bf16* Bt; int lda, ldb; };

template <class Addr, class Epi>
__device__ __forceinline__ void gemm_simple(const GroupSched& S, const Addr& AD, const Epi& E, int K) {
    const int tid = threadIdx.x, wid = __builtin_amdgcn_readfirstlane(tid >> 6), lane = tid & 63, wr = wid >> 2, wc = wid & 3, fr = lane & 15, fq = lane >> 4;
    Unit u;
    for (int i = 0; S.next(i, u); ++i) {
        const Operands op = AD(u);
        f32x4 acc[2][2][4][2];
#pragma unroll
        for (int a = 0; a < 2; ++a)
#pragma unroll
            for (int b = 0; b < 2; ++b)
#pragma unroll
                for (int m = 0; m < 4; ++m)
#pragma unroll
                    for (int n = 0; n < 2; ++n) acc[a][b][m][n] = (f32x4){0.f, 0.f, 0.f, 0.f};
        const bf16* ap = op.A + (size_t)(wr * 64 + fr) * op.lda + fq * 8;
        const bf16* bp = op.Bt + (size_t)(wc * 32 + fr) * op.ldb + fq * 8;
#pragma unroll 1
        for (int k = 0; k < K; k += 32) {
            bf16x8 bfr[2][2];
#pragma unroll
            for (int b = 0; b < 2; ++b)
#pragma unroll
                for (int n = 0; n < 2; ++n) bfr[b][n] = *(const bf16x8*)(bp + (size_t)(b * 128 + n * 16) * op.ldb + k);
#pragma unroll
            for (int a = 0; a < 2; ++a) {
                bf16x8 af[4];
#pragma unroll
                for (int m = 0; m < 4; ++m) af[m] = *(const bf16x8*)(ap + (size_t)(a * 128 + m * 16) * op.lda + k);
#pragma unroll
                for (int b = 0; b < 2; ++b)
#pragma unroll
                    for (int m = 0; m < 4; ++m)
#pragma unroll
                        for (int n = 0; n < 2; ++n) acc[a][b][m][n] = __builtin_amdgcn_mfma_f32_16x16x32_bf16(bfr[b][n], af[m], acc[a][b][m][n], 0, 0, 0);
            }
        }
        E(acc, u, wr, wc, fr, fq);
    }
}
constexpr int HTB = 128 * 64 * 2;
__device__ __forceinline__ int lds_byte(int r, int c) { const int st = (r >> 4) * 2 + (c >> 5), rr = r & 15, cc = c & 31, ob = rr * 64 + cc * 2; return st * 1024 + (ob ^ (((ob >> 9) & 1) << 5)); }
__device__ __forceinline__ void stage_rc(int b, int& R, int& C) { const int st = b / 1024, sb = b % 1024, swz = sb ^ (((sb >> 9) & 1) << 5); R = (st >> 1) * 16 + swz / 64; C = (st & 1) * 32 + (swz % 64) / 2; }
template <class Addr, class Epi>
__device__ __forceinline__ void gemm_fast(LAS unsigned char* lds, const int tid, const GroupSched& S, const Addr& AD, const Epi& E, const int K, const int lda, const int ldb) {
    const int wid = __builtin_amdgcn_readfirstlane(tid >> 6), lane = tid & 63, wr = wid >> 2, wc = wid & 3, fr = lane & 15, fq = lane >> 4;
    const int nt = K / 64;
    unsigned voffA[2], voffB[2];
#pragma unroll
    for (int i = 0; i < 2; ++i) { int R, C; stage_rc(tid * 16 + i * 8192, R, C); voffA[i] = (unsigned)(R * lda + C) * 2u; voffB[i] = (unsigned)(R * ldb + C) * 2u; }
    const size_t kstep = 128;
    const size_t hstepA = (size_t)128 * lda * 2, hstepB = (size_t)128 * ldb * 2;
    const unsigned ldsw = (unsigned)wid * 1024u;
    const int aoff = lds_byte(wr * 64 + fr, fq * 8), boff = lds_byte(wc * 32 + fr, fq * 8);
#define PG8_SA(b, h) (((b) * 2 + (h)) * HTB)
#define PG8_SB(b, h) ((4 + (b) * 2 + (h)) * HTB)
#define PG8_STAGE(bufoff, gbase, voff) do { _Pragma("unroll") for (int _i = 0; _i < 2; ++_i) \
        __builtin_amdgcn_global_load_lds((const unsigned*)((const char*)(gbase) + (voff)[_i]), (LAS unsigned*)(lds + (bufoff) + ldsw + _i * 8192), 16, 0, 0); } while (0)
#define PG8_LDA(dst, b, h) do { _Pragma("unroll") for (int m = 0; m < 4; ++m) _Pragma("unroll") for (int k = 0; k < 2; ++k) dst[m][k] = *(const LAS bf16x8*)(lds + PG8_SA(b, h) + aoff + m * 2048 + k * 1024); } while (0)
#define PG8_LDB(dst, b, h) do { _Pragma("unroll") for (int n = 0; n < 2; ++n) _Pragma("unroll") for (int k = 0; k < 2; ++k) dst[n][k] = *(const LAS bf16x8*)(lds + PG8_SB(b, h) + boff + n * 2048 + k * 1024); } while (0)
#define PG8_MMA(ai, bj, At, Bt) do { __builtin_amdgcn_s_setprio(1); _Pragma("unroll") for (int m = 0; m < 4; ++m) _Pragma("unroll") for (int n = 0; n < 2; ++n) _Pragma("unroll") for (int k = 0; k < 2; ++k) \
        acc[ai][bj][m][n] = __builtin_amdgcn_mfma_f32_16x16x32_bf16(Bt[n][k], At[m][k], acc[ai][bj][m][n], 0, 0, 0); __builtin_amdgcn_s_setprio(0); } while (0)
#define PG8_WAIT_V(n) asm volatile("s_waitcnt vmcnt(" #n ")" ::: "memory")
#define PG8_WAIT_L(n) asm volatile("s_waitcnt lgkmcnt(" #n ")" ::: "memory")
#define PG8_BAR __builtin_amdgcn_s_barrier()
#define PG8_SCHED __builtin_amdgcn_sched_barrier(0)
    Unit cur, nxt; int ui = 0;
    if (!S.next(0, cur)) return;
    f32x4 acc[2][2][4][2];
#pragma unroll
    for (int a = 0; a < 2; ++a)
#pragma unroll
        for (int b = 0; b < 2; ++b)
#pragma unroll
            for (int m = 0; m < 4; ++m)
#pragma unroll
                for (int n = 0; n < 2; ++n) acc[a][b][m][n] = (f32x4){0.f, 0.f, 0.f, 0.f};
    bf16x8 At[4][2], B0[2][2], B1[2][2];
    const char* cA; const char* cB;
    { const Operands op = AD(cur); cA = (const char*)op.A; cB = (const char*)op.Bt; }
    PG8_STAGE(PG8_SB(0, 0), cB, voffB); PG8_STAGE(PG8_SB(0, 1), cB + hstepB, voffB); PG8_STAGE(PG8_SA(0, 0), cA, voffA); PG8_STAGE(PG8_SA(0, 1), cA + hstepA, voffA);
    if (wr == 1) PG8_BAR;
    PG8_WAIT_V(2); PG8_BAR;
    PG8_STAGE(PG8_SB(1, 0), cB + kstep, voffB); PG8_STAGE(PG8_SA(1, 0), cA + kstep, voffA); PG8_STAGE(PG8_SB(1, 1), cB + hstepB + kstep, voffB);
    PG8_WAIT_V(6); PG8_BAR;
    for (;;) {
        const bool has_next = S.next(ui + 1, nxt);
        const char* nA = cA; const char* nB = cB;
        if (has_next) { const Operands op = AD(nxt); nA = (const char*)op.A; nB = (const char*)op.Bt; }
#pragma unroll 1
        for (int t = 0; t < nt; t += 2) {
            const bool last = (t == nt - 2);
            const char* a1 = cA + (size_t)(t + 1) * kstep;
            const char* a2 = last ? nA : cA + (size_t)(t + 2) * kstep; const char* b2 = last ? nB : cB + (size_t)(t + 2) * kstep;
            const char* a3 = a2 + kstep; const char* b3 = b2 + kstep;
            PG8_LDB(B0, 0, 0); PG8_LDB(B1, 0, 1); PG8_SCHED; PG8_LDA(At, 0, 0); PG8_STAGE(PG8_SA(1, 1), a1 + hstepA, voffA);
            PG8_WAIT_V(8); PG8_WAIT_L(0); PG8_BAR; PG8_MMA(0, 0, At, B0); PG8_MMA(0, 1, At, B1); PG8_BAR; PG8_SCHED;
            PG8_LDA(At, 0, 1); PG8_STAGE(PG8_SB(0, 0), b2, voffB); PG8_STAGE(PG8_SB(0, 1), b2 + hstepB, voffB); PG8_STAGE(PG8_SA(0, 0), a2, voffA);
            PG8_WAIT_V(8); PG8_WAIT_L(0); PG8_BAR; PG8_MMA(1, 0, At, B0); PG8_MMA(1, 1, At, B1); PG8_BAR; PG8_SCHED;
            PG8_LDB(B0, 1, 0); PG8_LDB(B1, 1, 1); PG8_SCHED; PG8_LDA(At, 1, 0); PG8_STAGE(PG8_SA(0, 1), a2 + hstepA, voffA);
            PG8_WAIT_V(8); PG8_WAIT_L(0); PG8_BAR; PG8_MMA(0, 0, At, B0); PG8_MMA(0, 1, At, B1); PG8_BAR; PG8_SCHED;
            PG8_LDA(At, 1, 1); PG8_STAGE(PG8_SB(1, 0), b3, voffB); PG8_STAGE(PG8_SB(1, 1), b3 + hstepB, voffB); PG8_STAGE(PG8_SA(1, 0), a3, voffA);
            PG8_WAIT_V(8); PG8_WAIT_L(0); PG8_BAR; PG8_MMA(1, 0, At, B0); PG8_MMA(1, 1, At, B1); PG8_BAR; PG8_SCHED;
        }
        if (wr == 0) PG8_BAR;
        { int fr2 = fr, fq2 = fq; asm volatile("" : "+v"(fr2), "+v"(fq2));
          E(acc, cur, wr, wc, fr2, fq2); }
        if (!has_next) break;
#pragma unroll
        for (int a = 0; a < 2; ++a)
#pragma unroll
            for (int b = 0; b < 2; ++b)
#pragma unroll
                for (int m = 0; m < 4; ++m)
#pragma unroll
                    for (int n = 0; n < 2; ++n) acc[a][b][m][n] = (f32x4){0.f, 0.f, 0.f, 0.f};
        cur = nxt; cA = nA; cB = nB; ++ui;
        if (wr == 1) PG8_BAR;
    }
    PG8_WAIT_V(0);
    PG8_BAR;
#undef PG8_SA
#undef PG8_SB
#undef PG8_STAGE
#undef PG8_LDA
#undef PG8_LDB
#undef PG8_MMA
#undef PG8_WAIT_V
#undef PG8_WAIT_L
#undef PG8_BAR
#undef PG8_SCHED
}
#ifndef DUP_PH
#define DUP_PH -1
#endif
#define REP_BEGIN(k) _Pragma("unroll 1") for (int rep_ = 0; rep_ < ((DUP_PH == (k)) ? 2 : 1); ++rep_) { if (rep_) { if constexpr (PH < 0) xcd_barrier(bar); }
#define REP_END }
#ifndef USE_FAST
#define USE_FAST 1
#endif
#if USE_FAST
#define GEMM(S, AD, E, K, lda, ldb) gemm_fast(F.lds, F.tid, S, AD, E, K, lda, ldb)
#else
#define GEMM(S, AD, E, K, lda, ldb) gemm_simple(S, AD, E, K)
#endif
#define EPI_ARGS const f32x4 (&acc)[2][2][4][2], const Unit& u, int wr, int wc, int fr, int fq
#define EPI_FOR(BODY) _Pragma("unroll") for (int ai = 0; ai < 2; ++ai) _Pragma("unroll") for (int m = 0; m < 4; ++m) { const int r = ai * 128 + wr * 64 + m * 16 + fr; \
    _Pragma("unroll") for (int bj = 0; bj < 2; ++bj) _Pragma("unroll") for (int n = 0; n < 2; ++n) { const int c = bj * 128 + wc * 32 + n * 16 + 4 * fq; const f32x4 v = acc[ai][bj][m][n]; BODY } }
__device__ __forceinline__ void st_bf4(bf16* p, f32x4 v) { u32x2 w; w.x = pk2(v[0], v[1]); w.y = pk2(v[2], v[3]); *(u32x2*)p = w; }

__device__ __forceinline__ void p_mod(const Params& P, Frame& F) {
    LAS float* sc = (LAS float*)F.lds;
    LAS float* red = (LAS float*)(F.lds + 9 * 1024 * 4);
    float* MOD = WSP(float, WS_MOD);
    bool have = false;
    for (int it = F.bid; it < 2 * 96; it += F.G) {
        if (!have) {
            for (int i = F.tid; i < 9 * 1024; i += NTHREADS) { const int r = i >> 10, k = i & 1023; const float v = r < 8 ? P.c[r * 1024 + k] : P.c_ctx[k]; sc[i] = v * sigmoidf_(v); }
            have = true;
        }
        __syncthreads();
        const int l = it / 96, j0 = (it % 96) * 64, jj = F.tid & 63, kc = F.tid >> 6;
        const float* W = P.ada_w + (size_t)l * 1024 * 6144 + j0 + jj;
        float a[9];
#pragma unroll
        for (int r = 0; r < 9; ++r) a[r] = 0.f;
        for (int k = kc * 128; k < kc * 128 + 128; ++k) { const float w = W[(size_t)k * 6144];
#pragma unroll
            for (int r = 0; r < 9; ++r) a[r] += sc[r * 1024 + k] * w; }
#pragma unroll
        for (int r = 0; r < 9; ++r) red[(kc * 9 + r) * 64 + jj] = a[r];
        __syncthreads();
        for (int o = F.tid; o < 9 * 64; o += NTHREADS) { const int r = o >> 6, j = o & 63; float s = 0.f;
#pragma unroll
            for (int q = 0; q < 8; ++q) s += red[(q * 9 + r) * 64 + j];
            MOD[((size_t)l * 9 + r) * 6144 + j0 + j] = s + P.ada_b[l * 6144 + j0 + j]; }
    }
    __syncthreads();
}
__device__ __forceinline__ void p_dftgen(Frame& F) {
    LAS float* tab = (LAS float*)F.lds;
    for (int j = F.tid; j < 4096; j += NTHREADS) tab[j] = cospif((float)j * (1.0f / 2048.0f));
    __syncthreads();
    bf16* DM_ = WSP(bf16, WS_DFTM); bf16* DC_ = WSP(bf16, WS_DFTC);
    const int nchunk = 4096 * 1024 + 256 * 64;
    for (int ch = F.bid * NTHREADS + F.tid; ch < nchunk; ch += F.G * NTHREADS) {
        float v[8]; bf16* dst;
        if (ch < 4096 * 1024) { const int kf = ch >> 10, col0 = (ch & 1023) * 8, cs = col0 >> 12, l0 = col0 & 4095;
#pragma unroll
            for (int i = 0; i < 8; ++i) { const int j = (kf * (l0 + i)) & 4095; v[i] = cs ? -tab[(j + 3072) & 4095] : tab[j]; }
            dst = DM_ + (size_t)kf * 8192 + col0; }
        else { const int c2 = ch - 4096 * 1024, kf = c2 >> 6, col0 = (c2 & 63) * 8, cs = col0 >> 8, l0 = col0 & 255;
#pragma unroll
            for (int i = 0; i < 8; ++i) { const int j = ((kf * (l0 + i)) & 255) * 16; v[i] = cs ? -tab[(j + 3072) & 4095] : tab[j]; }
            dst = DC_ + (size_t)kf * 512 + col0; }
        u32x4 o; o.x = pk2(v[0], v[1]); o.y = pk2(v[2], v[3]); o.z = pk2(v[4], v[5]); o.w = pk2(v[6], v[7]);
        *(u32x4*)dst = o;
    }
    __syncthreads();
}
__device__ __forceinline__ void transpose_item(const float* W, int ldw, int k0, int n0, bf16* WT, int ldt, int drow0, LAS float* scr, int lane) {
#pragma unroll 8
    for (int i = 0; i < 32; ++i) { const int kk = 2 * i + (lane >> 5); scr[kk * 33 + (lane & 31)] = W[(size_t)(k0 + kk) * ldw + n0 + (lane & 31)]; }
    LDS_WAIT(); asm volatile("" ::: "memory");
    const int c = lane & 7;
#pragma unroll
    for (int j = 0; j < 4; ++j) { const int n = (lane >> 3) + 8 * j; const LAS float* s = scr + (8 * c) * 33 + n;
        u32x4 o; o.x = pk2(s[0 * 33], s[1 * 33]); o.y = pk2(s[2 * 33], s[3 * 33]); o.z = pk2(s[4 * 33], s[5 * 33]); o.w = pk2(s[6 * 33], s[7 * 33]);
        *(u32x4*)(WT + (size_t)(drow0 + n) * ldt + k0 + 8 * c) = o; }
    LDS_WAIT(); asm volatile("" ::: "memory");
}
__device__ __forceinline__ void p_wconv(const Params& P, Frame& F, int l) {
    LAS float* scr = (LAS float*)(F.lds + F.wave * 16384);
    const int gw = F.bid * NWAVES + F.wave, NGW = F.G * NWAVES;
    const float* w_in = P.w_in + (size_t)l * 1024 * INW;
    bf16* WA = WSP(bf16, WS_WA); bf16* WFV = WSP(bf16, WS_WFV);
    constexpr int I_K = 16 * 32, I_Q = 16 * 32, I_P = 16 * 16, I_G = 16 * 96, I_V = 16 * 32, I_AO = 16 * 32, I_FO = 8 * 32, I_OUT = 16 * 32;
    constexpr int NSM = I_K + I_Q + I_P + I_G + I_V + I_AO + I_FO + I_OUT;
    for (int it = gw; it < NSM; it += NGW) {
        int r = it;
        if (r < I_K) { transpose_item(w_in, INW, (r / 32) * 64, 0 + (r % 32) * 32, WA, 1024, 0 + (r % 32) * 32, scr, F.lane); continue; } r -= I_K;
        if (r < I_Q) { transpose_item(w_in, INW, (r / 32) * 64, 2048 + (r % 32) * 32, WA, 1024, 1024 + (r % 32) * 32, scr, F.lane); continue; } r -= I_Q;
        if (r < I_P) { transpose_item(w_in, INW, (r / 16) * 64, 3584 + (r % 16) * 32, WA, 1024, 2048 + (r % 16) * 32, scr, F.lane); continue; } r -= I_P;
        if (r < I_G) { transpose_item(w_in, INW, (r / 96) * 64, 4096 + (r % 96) * 32, WA, 1024, 2560 + (r % 96) * 32, scr, F.lane); continue; } r -= I_G;
        if (r < I_V) { transpose_item(w_in, INW, (r / 32) * 64, 1024 + (r % 32) * 32, WFV, 1024, 1024 + (r % 32) * 32, scr, F.lane); continue; } r -= I_V;
        if (r < I_AO) { transpose_item(P.w_att_o + (size_t)l * 1024 * 1024, 1024, (r / 32) * 64, (r % 32) * 32, WSP(bf16, WS_WAO), 1024, (r % 32) * 32, scr, F.lane); continue; } r -= I_AO;
        if (r < I_FO) { transpose_item(P.w_fourier + (size_t)l * 512 * 1024, 1024, (r / 32) * 64, (r % 32) * 32, WSP(bf16, WS_WFO), 512, (r % 32) * 32, scr, F.lane); continue; } r -= I_FO;
        transpose_item(P.w_out + (size_t)l * 1024 * 1024, 1024, (r / 32) * 64, (r % 32) * 32, WSP(bf16, WS_WOUT), 1024, (r % 32) * 32, scr, F.lane);
    }
    constexpr int I_E = 16 * 88;
    bf16* WGU = WSP(bf16, WS_WGU); bf16* WD = WSP(bf16, WS_WD);
    for (int it = gw; it < 3 * 16 * I_E; it += NGW) {
        const int which = it / (16 * I_E), r0 = it % (16 * I_E), e = r0 / I_E, r = r0 % I_E;
        if (which < 2) { const int kb = r / 88, nb = r % 88, n0 = nb * 32;
            const float* src = (which == 0 ? P.w_eg : P.w_eu) + ((size_t)l * 16 + e) * 1024 * FF;
            transpose_item(src, FF, kb * 64, n0, WGU + (size_t)e * 5632 * 1024, 1024, (n0 >> 7) * 256 + (which ? 128 : 0) + (n0 & 127), scr, F.lane); }
        else { const int kb = r / 32, nb = r % 32;
            transpose_item(P.w_ed + ((size_t)l * 16 + e) * FF * 1024, 1024, kb * 64, nb * 32, WD + (size_t)e * 1024 * FF, FF, nb * 32, scr, F.lane); }
    }
    { bf16* WPO = WSP(bf16, WS_WPO); const float* wp = P.w_pool + (size_t)l * 4 * 128 * 256;
      for (int i = F.bid * NTHREADS + F.tid; i < 1024 * 256; i += F.G * NTHREADS) { const int n = i >> 8, kk = i & 255, g = n >> 8, f = n & 255;
          WPO[i] = (bf16)(((kk >> 7) == (g & 1)) ? f2bf(wp[((size_t)g * 128 + (kk & 127)) * 256 + f]) : 0u); } }
    { LAS float* t128 = (LAS float*)F.lds;
      __syncthreads();
      for (int j = F.tid; j < 128; j += NTHREADS) t128[j] = cospif((float)j * (1.0f / 64.0f));
      __syncthreads();
      for (int i = F.bid * NTHREADS + F.tid; i < 1024 * 1024; i += F.G * NTHREADS) { const int fc = i >> 10, k = i & 1023, cs = fc & 1, gm = fc >> 1, g = gm >> 7, m = gm & 127;
          const float* src = w_in + (size_t)k * INW + 3072 + g * 128; float s = 0.f; const int ph = cs ? 96 : 0;
          for (int c = 0; c < 128; ++c) s += src[c] * t128[(m * c + ph) & 127];
          WFV[i] = (bf16)f2bf(s); }
      __syncthreads(); }
}

struct RowMod { const float* g; const float* sh; const float* sc; };
__device__ __forceinline__ void row_load(const float* row, int lane, f32x4 (&v)[4]) {
#pragma unroll
    for (int j = 0; j < 4; ++j) v[j] = *(const f32x4*)(row + 4 * lane + 256 * j);
}
__device__ __forceinline__ float row_rstd(const f32x4 (&v)[4]) {
    float s = 0.f;
#pragma unroll
    for (int j = 0; j < 4; ++j) s += (v[j][0] * v[j][0] + v[j][1] * v[j][1]) + (v[j][2] * v[j][2] + v[j][3] * v[j][3]);
    return rsqrtf(wave_sum(s) * (1.0f / 1024.0f) + RMS_EPS);
}
__device__ __forceinline__ void row_modulate(const f32x4 (&v)[4], float rstd, const RowMod& M, int lane, f32x4 (&y)[4]) {
#pragma unroll
    for (int j = 0; j < 4; ++j) { const int k = 4 * lane + 256 * j; const f32x4 g = *(const f32x4*)(M.g + k), sh = *(const f32x4*)(M.sh + k), sc = *(const f32x4*)(M.sc + k);
        y[j] = v[j] * rstd * g * (sc + 1.0f) + sh; }
}
__device__ __forceinline__ void row_store_bf(bf16* row, int lane, const f32x4 (&y)[4]) {
#pragma unroll
    for (int j = 0; j < 4; ++j) st_bf4(row + 4 * lane + 256 * j, y[j]);
}
__device__ __forceinline__ const float* mod_ptr(Frame& F, int l, int row, int which) { const int mr = row < RL ? (row >> 12) : 8; return WSP(float, WS_MOD) + ((size_t)l * 9 + mr) * 6144 + which * 1024; }

__device__ __forceinline__ void p_rowpass_a0(const Params& P, Frame& F) {
    const int gw = F.bid * NWAVES + F.wave, NGW = F.G * NWAVES; bf16* H = WSP(bf16, WS_H);
    for (int row = gw; row < RT; row += NGW) {
        const float* src = row < RL ? P.x + (size_t)row * DM : P.ctx + (size_t)(row - RL) * DM;
        f32x4 v[4], y[4]; row_load(src, F.lane, v); const float rs = row_rstd(v);
        RowMod M{P.norm1_g, mod_ptr(F, 0, row, 0), mod_ptr(F, 0, row, 1)};
        row_modulate(v, rs, M, F.lane, y); row_store_bf(H + (size_t)row * DM, F.lane, y);
    }
}
__device__ __forceinline__ void p_rowpass_f(const Params& P, Frame& F, int l, int nrows) {
    const int gw = F.bid * NWAVES + F.wave, NGW = F.G * NWAVES; bf16* H = WSP(bf16, WS_H); float* AFF = WSP(float, WS_AFF);
    const float* wr = P.w_router + (size_t)l * 1024 * 16;
    LAS float* wl = (LAS float*)F.lds;
    __syncthreads();
    for (int i = F.tid; i < 16384; i += NTHREADS) wl[(i & 15) * 1024 + (i >> 4)] = wr[i];
    __syncthreads();
    for (int row = gw; row < nrows; row += NGW) {
        const float* src = row < RL ? P.out + (size_t)row * DM : WSP(float, WS_XC) + (size_t)(row - RL) * DM;
        f32x4 v[4], y[4]; row_load(src, F.lane, v); const float rs = row_rstd(v);
        RowMod M{P.norm2_g + l * 1024, mod_ptr(F, l, row, 3), mod_ptr(F, l, row, 4)};
        row_modulate(v, rs, M, F.lane, y); row_store_bf(H + (size_t)row * DM, F.lane, y);
        float lg[16];
        int wo = 4 * F.lane; asm volatile("" : "+v"(wo));
#pragma unroll
        for (int e = 0; e < 16; ++e) { float a = 0.f;
#pragma unroll
            for (int j = 0; j < 4; ++j) { const f32x4 w = *(const LAS f32x4*)(wl + e * 1024 + wo + 256 * j); a += (y[j][0] * w[0] + y[j][1] * w[1]) + (y[j][2] * w[2] + y[j][3] * w[3]); }
            lg[e] = a; }
        float mx = -1e30f;
#pragma unroll
        for (int e = 0; e < 16; ++e) { lg[e] = wave_sum(lg[e]); mx = fmaxf(mx, lg[e]); }
        float den = 0.f;
#pragma unroll
        for (int e = 0; e < 16; ++e) { lg[e] = __expf(lg[e] - mx); den += lg[e]; }
        const float inv = 1.0f / den;
        if (F.lane < 16) { float mine = 0.f;
#pragma unroll
            for (int e = 0; e < 16; ++e) mine = (F.lane == e) ? lg[e] : mine;
            AFF[(size_t)row * 16 + F.lane] = mine * inv; }
    }
    __syncthreads();
}
__device__ __forceinline__ void p_rowpass_k(const Params& P, Frame& F, int l, int nrows) {
    const int gw = F.bid * NWAVES + F.wave, NGW = F.G * NWAVES; bf16* H = WSP(bf16, WS_H);
    const int* SEL = WSP(int, WS_SEL); const bf16* Y = WSP(bf16, WS_Y);
    for (int row = gw; row < nrows; row += NGW) {
        float* xr = row < RL ? P.out + (size_t)row * DM : WSP(float, WS_XC) + (size_t)(row - RL) * DM;
        f32x4 v[4], a[4]; row_load(xr, F.lane, v);
#pragma unroll
        for (int j = 0; j < 4; ++j) a[j] = (f32x4){0.f, 0.f, 0.f, 0.f};
        for (int e = 0; e < 16; ++e) { const int s = SEL[(size_t)row * 16 + e];
            if (s >= 0) { const bf16* yr = Y + (size_t)s * DM;
#pragma unroll
                for (int j = 0; j < 4; ++j) { const u32x2 w = *(const u32x2*)(yr + 4 * F.lane + 256 * j); a[j][0] += bflo(w.x); a[j][1] += bfhi(w.x); a[j][2] += bflo(w.y); a[j][3] += bfhi(w.y); } } }
        const float* g2 = mod_ptr(F, l, row, 5);
#pragma unroll
        for (int j = 0; j < 4; ++j) { const f32x4 g = *(const f32x4*)(g2 + 4 * F.lane + 256 * j); v[j] = v[j] + g * a[j]; }
        const float rs = row_rstd(v);
        if (l == 0) {
#pragma unroll
            for (int j = 0; j < 4; ++j) *(f32x4*)(xr + 4 * F.lane + 256 * j) = v[j];
            f32x4 y[4]; RowMod M{P.norm1_g + 1024, mod_ptr(F, 1, row, 0), mod_ptr(F, 1, row, 1)};
            row_modulate(v, rs, M, F.lane, y); row_store_bf(H + (size_t)row * DM, F.lane, y);
        } else {
#pragma unroll
            for (int j = 0; j < 4; ++j) { const f32x4 g = *(const f32x4*)(P.final_g + 4 * F.lane + 256 * j); *(f32x4*)(xr + 4 * F.lane + 256 * j) = v[j] * rs * g; }
        }
    }
}

__device__ __forceinline__ float dot64(const bf16x8 (&q)[8], const bf16* kp) {
    float s = 0.f;
#pragma unroll
    for (int i = 0; i < 8; ++i) { const u32x4 kw = *(const u32x4*)(kp + 8 * i); const u32x4 qw = __builtin_bit_cast(u32x4, q[i]);
#pragma unroll
        for (int t = 0; t < 4; ++t) s += bflo(kw[t]) * bflo(qw[t]) + bfhi(kw[t]) * bfhi(qw[t]); }
    return s;
}
__device__ __forceinline__ void p_attn_naive(const Params& P, Frame& F, int l, bool with_ctx_queries) {
    const int gw = F.bid * NWAVES + F.wave, NGW = F.G * NWAVES;
    const bf16* KQ = WSP(bf16, WS_KQ); const bf16* VT = WSP(bf16, WS_VT); bf16* ATT = WSP(bf16, WS_ATT);
    LAS float* pw = (LAS float*)(F.lds + F.wave * 2048);
    const float* rpb = P.rpb + (size_t)l * 16 * 15 * 31;
    const int nlat = NB * 64 * NH * 64, nitems = nlat + (with_ctx_queries ? NB * NH * CTXL : 0);
    for (int it = gw; it < nitems; it += NGW) {
        const bool lat = it < nlat;
        int b, h, r = 0, qc = 0, rowq;
        if (lat) { qc = it & 63; h = (it >> 6) & 15; r = (it >> 10) & 63; b = it >> 16; rowq = b * SEQ + r * 64 + qc; }
        else { const int i2 = it - nlat; qc = i2 & 255; h = (i2 >> 8) & 15; b = i2 >> 12; rowq = RL + b * CTXL + qc; }
        bf16x8 q[8];
        { const bf16* qp = KQ + (size_t)rowq * 2048 + 1024 + h * 64;
#pragma unroll
          for (int i = 0; i < 8; ++i) q[i] = *(const bf16x8*)(qp + 8 * i); }
        const int rs = min(max(r - 4, 0), 56), cs = min(max(qc - 8, 0), 48);
        float s[6];
        if (lat) {
#pragma unroll
            for (int t = 0; t < 2; ++t) { const int w = F.lane + 64 * t, i = w >> 4, j = w & 15; const int tok = (rs + i) * 64 + cs + j;
                s[t] = dot64(q, KQ + (size_t)(b * SEQ + tok) * 2048 + h * 64) * 0.125f + rpb[(h * 15 + (rs + i - r + 7)) * 31 + (cs + j - qc + 15)]; }
        } else { s[0] = -1e30f; s[1] = -1e30f; }
#pragma unroll
        for (int t = 0; t < 4; ++t) { const int c = F.lane + 64 * t; s[2 + t] = dot64(q, KQ + (size_t)(RL + b * CTXL + c) * 2048 + h * 64) * 0.125f; }
        float mx = s[0];
#pragma unroll
        for (int t = 1; t < 6; ++t) mx = fmaxf(mx, s[t]);
        mx = wave_max(mx);
        float sum = 0.f;
#pragma unroll
        for (int t = 0; t < 6; ++t) { s[t] = (lat || t >= 2) ? __expf(s[t] - mx) : 0.f; sum += s[t]; }
        sum = wave_sum(sum);
        pw[F.lane] = s[0]; pw[F.lane + 64] = s[1];
#pragma unroll
        for (int t = 0; t < 4; ++t) pw[128 + F.lane + 64 * t] = s[2 + t];
        LDS_WAIT(); asm volatile("" ::: "memory");
        float o = 0.f;
        if (lat) { const bf16* vr = VT + ((size_t)b * 1024 + h * 64 + F.lane) * 4096;
#pragma unroll 2
            for (int w = 0; w < 128; ++w) { const int tok = (rs + (w >> 4)) * 64 + cs + (w & 15); o += pw[w] * bf2f(vr[tok]); } }
        { const bf16* vr = VT + YT_CTX_OFF + ((size_t)b * 1024 + h * 64 + F.lane) * 256;
#pragma unroll 2
          for (int c8 = 0; c8 < 32; ++c8) { const u32x4 vw = *(const u32x4*)(vr + 8 * c8); const LAS float* pp = pw + 128 + 8 * c8;
#pragma unroll
              for (int t = 0; t < 4; ++t) o += pp[2 * t] * bflo(vw[t]) + pp[2 * t + 1] * bfhi(vw[t]); } }
        ATT[(size_t)rowq * 1024 + h * 64 + F.lane] = (bf16)f2bf(o / sum);
        LDS_WAIT(); asm volatile("" ::: "memory");
    }
}

constexpr int ACK_STRIDE = 72, ACV_STRIDE = 264;
constexpr int ALDS_CK = 0, ALDS_CV = 256 * ACK_STRIDE * 2, ALDS_RP = ALDS_CV + 64 * ACV_STRIDE * 2;
struct AttnState { float m, sum; f32x4 o[4]; };
__device__ __forceinline__ float xrow16_max(float x) {
    auto s = __builtin_amdgcn_permlane16_swap(__float_as_uint(x), __float_as_uint(x), false, false);
    x = fmaxf(__uint_as_float(s[0]), __uint_as_float(s[1]));
    auto t = __builtin_amdgcn_permlane32_swap(__float_as_uint(x), __float_as_uint(x), false, false);
    return fmaxf(__uint_as_float(t[0]), __uint_as_float(t[1]));
}
__device__ __forceinline__ float xrow16_sum(float x) {
    auto s = __builtin_amdgcn_permlane16_swap(__float_as_uint(x), __float_as_uint(x), false, false);
    x = __uint_as_float(s[0]) + __uint_as_float(s[1]);
    auto t = __builtin_amdgcn_permlane32_swap(__float_as_uint(x), __float_as_uint(x), false, false);
    return __uint_as_float(t[0]) + __uint_as_float(t[1]);
}
#define MFMA16(a, b, c) __builtin_amdgcn_mfma_f32_16x16x32_bf16((a), (b), (c), 0, 0, 0)
template <int NT>
__device__ __forceinline__ void attn_tail(AttnState& S, f32x4 (&sc)[NT], const u32x4 (&vw)[NT / 2][4]) {
    float cm = -1e30f;
#pragma unroll
    for (int t = 0; t < NT; ++t)
#pragma unroll
        for (int j = 0; j < 4; ++j) cm = fmaxf(cm, sc[t][j]);
    cm = xrow16_max(cm);
    const float mn = fmaxf(S.m, cm), scl = __builtin_amdgcn_exp2f(S.m - mn); S.m = mn; float ps = 0.f;
#pragma unroll
    for (int t = 0; t < NT; ++t)
#pragma unroll
        for (int j = 0; j < 4; ++j) { const float p = __builtin_amdgcn_exp2f(sc[t][j] - mn); sc[t][j] = p; ps += p; }
    S.sum = S.sum * scl + ps;
#pragma unroll
    for (int dt = 0; dt < 4; ++dt) S.o[dt] = S.o[dt] * scl;
#pragma unroll
    for (int ks = 0; ks < NT / 2; ++ks) { u32x4 pw; pw.x = pk2(sc[2 * ks][0], sc[2 * ks][1]); pw.y = pk2(sc[2 * ks][2], sc[2 * ks][3]); pw.z = pk2(sc[2 * ks + 1][0], sc[2 * ks + 1][1]); pw.w = pk2(sc[2 * ks + 1][2], sc[2 * ks + 1][3]);
        const bf16x8 pf = __builtin_bit_cast(bf16x8, pw);
#pragma unroll
        for (int dt = 0; dt < 4; ++dt) S.o[dt] = MFMA16(__builtin_bit_cast(bf16x8, vw[ks][dt]), pf, S.o[dt]); }
}
__device__ __forceinline__ void attn_unit2(const bf16* __restrict__ KQ, const bf16* __restrict__ VT, bf16* __restrict__ ATT, LAS unsigned char* lds,
                                           const int b, const int h, const int rowqA, const int rowqB, const bool win, const int r, const int qt, const int lane) {
    const int l15 = lane & 15, g = lane >> 4;
    const f32x4 z = {0.f, 0.f, 0.f, 0.f};
    bf16x8 qA[2], qB[2];
    { const bf16* qp = KQ + (size_t)(rowqA + l15) * 2048 + 1024 + h * 64 + 8 * g; qA[0] = *(const bf16x8*)qp; qA[1] = *(const bf16x8*)(qp + 32); }
    { const bf16* qp = KQ + (size_t)(rowqB + l15) * 2048 + 1024 + h * 64 + 8 * g; qB[0] = *(const bf16x8*)qp; qB[1] = *(const bf16x8*)(qp + 32); }
    AttnState SA, SB; SA.m = -1e30f; SA.sum = 0.f; SB.m = -1e30f; SB.sum = 0.f;
#pragma unroll
    for (int dt = 0; dt < 4; ++dt) { SA.o[dt] = z; SB.o[dt] = z; }
    if (win) {
        const int rsA = min(max(r - 4, 0), 56), dB = min(max(r - 3, 0), 56) - rsA, kc0 = min(max(16 * qt - 8, 0), 32);
        const int q = 16 * qt + l15, csq = min(max(q - 8, 0), 48);
        const int krow0 = 8 * (l15 >> 2) + (l15 & 3);
        const bf16* kb = KQ + (size_t)(b * SEQ + kc0 + krow0) * 2048 + h * 64 + 8 * g;
        const bf16* vb = VT + (size_t)(b * 1024 + h * 64 + l15) * 4096 + kc0 + 8 * g;
        const LAS float* rp = (const LAS float*)(lds + ALDS_RP);
        const int jb = kc0 + 8 * g;
        const int okb = jb - csq;
        const LAS float* rpl = rp + 16 + (jb - q + 15);
        float madd[2][4];
#pragma unroll
        for (int t = 0; t < 2; ++t)
#pragma unroll
            for (int j = 0; j < 4; ++j) madd[t][j] = ((unsigned)(okb + 4 * t + j) < 16u) ? 0.f : -__builtin_inff();
        bf16x8 K0[2][2], K1[2][2]; u32x4 V0[1][4], V1[1][4];
#define ATT_LOADW(KB, VB, i) do { const int gr_ = min(rsA + (i), 63); const bf16* kp_ = kb + (size_t)(gr_ * 64) * 2048; const bf16* vp_ = vb + gr_ * 64; \
        _Pragma("unroll") for (int t = 0; t < 2; ++t) { KB[t][0] = *(const bf16x8*)(kp_ + (size_t)(4 * t) * 2048); KB[t][1] = *(const bf16x8*)(kp_ + (size_t)(4 * t) * 2048 + 32); } \
        _Pragma("unroll") for (int dt = 0; dt < 4; ++dt) VB[0][dt] = *(const u32x4*)(vp_ + (size_t)(16 * dt) * 4096); } while (0)
#define ATT_ONE(ST, QF, KB, VB, roff, rowok) do { f32x4 sc[2]; \
        _Pragma("unroll") for (int t = 0; t < 2; ++t) { sc[t] = MFMA16(KB[t][0], QF[0], z); sc[t] = MFMA16(KB[t][1], QF[1], sc[t]); } \
        const LAS float* bp_ = rpl + ((rowok) ? (roff) : 15) * 64; \
        _Pragma("unroll") for (int t = 0; t < 2; ++t) _Pragma("unroll") for (int j = 0; j < 4; ++j) sc[t][j] = (sc[t][j] + bp_[4 * t + j]) + madd[t][j]; \
        attn_tail<2>(ST, sc, VB); } while (0)
#define ATT_COMPUTE(KB, VB, i) do { const int roffA_ = min(rsA + (i) - r + 7, 14); \
        ATT_ONE(SA, qA, KB, VB, roffA_, (i) <= 7); \
        ATT_ONE(SB, qB, KB, VB, max(roffA_ - 1, 0), (i) >= dB && (i) <= 7 + dB); } while (0)
        ATT_LOADW(K0, V0, 0);
#pragma unroll 1
        for (int i = 0; i < 8; i += 2) { ATT_LOADW(K1, V1, i + 1); ATT_COMPUTE(K0, V0, i); ATT_LOADW(K0, V0, i + 2); ATT_COMPUTE(K1, V1, i + 1); }
        ATT_COMPUTE(K0, V0, 8);
#undef ATT_LOADW
#undef ATT_ONE
#undef ATT_COMPUTE
    }
    { const LAS bf16* ck = (const LAS bf16*)(lds + ALDS_CK) + l15 * ACK_STRIDE + 8 * g;
      const LAS bf16* cv = (const LAS bf16*)(lds + ALDS_CV) + l15 * ACV_STRIDE + 8 * g;
#pragma unroll 1
      for (int c = 0; c < 4; ++c) {
          bf16x8 kf[4][2]; u32x4 vw[2][4];
#pragma unroll
          for (int t = 0; t < 4; ++t) { const LAS bf16* kp = ck + (64 * c + 16 * t) * ACK_STRIDE; kf[t][0] = *(const LAS bf16x8*)kp; kf[t][1] = *(const LAS bf16x8*)(kp + 32); }
#pragma unroll
          for (int ks = 0; ks < 2; ++ks)
#pragma unroll
              for (int dt = 0; dt < 4; ++dt) vw[ks][dt] = *(const LAS u32x4*)(cv + (16 * dt) * ACV_STRIDE + 64 * c + 32 * ks);
          { f32x4 sc[4];
#pragma unroll
            for (int t = 0; t < 4; ++t) { sc[t] = MFMA16(kf[t][0], qA[0], z); sc[t] = MFMA16(kf[t][1], qA[1], sc[t]); }
            attn_tail<4>(SA, sc, vw); }
          { f32x4 sc[4];
#pragma unroll
            for (int t = 0; t < 4; ++t) { sc[t] = MFMA16(kf[t][0], qB[0], z); sc[t] = MFMA16(kf[t][1], qB[1], sc[t]); }
            attn_tail<4>(SB, sc, vw); }
      } }
    { const float inv = 1.0f / xrow16_sum(SA.sum);
#pragma unroll
      for (int dt = 0; dt < 4; ++dt) st_bf4(ATT + (size_t)(rowqA + l15) * 1024 + h * 64 + 16 * dt + 4 * g, SA.o[dt] * inv); }
    { const float inv = 1.0f / xrow16_sum(SB.sum);
#pragma unroll
      for (int dt = 0; dt < 4; ++dt) st_bf4(ATT + (size_t)(rowqB + l15) * 1024 + h * 64 + 16 * dt + 4 * g, SB.o[dt] * inv); }
}
__device__ __forceinline__ void p_attn_mfma(const Params& P, Frame& F, int l, bool with_ctx_queries) {
    const bf16* KQ = WSP(bf16, WS_KQ); const bf16* VT = WSP(bf16, WS_VT); bf16* ATT = WSP(bf16, WS_ATT);
    const float* rpb = P.rpb + (size_t)l * 16 * 465;
    for (int hp = F.bid; hp < 256; hp += F.G) {
        const int p = hp & 127, half = hp >> 7, b = p >> 4, h = p & 15;
        __syncthreads();
        { LAS bf16* ck = (LAS bf16*)(F.lds + ALDS_CK); LAS bf16* cv = (LAS bf16*)(F.lds + ALDS_CV); LAS float* rp = (LAS float*)(F.lds + ALDS_RP);
          { const int key = F.tid >> 1, hf = F.tid & 1; const int k32 = key & 31, pos = (key & ~31) + ((k32 >> 2) & 1) * 16 + 4 * (k32 >> 3) + (k32 & 3);
            const u32x4* src = (const u32x4*)(KQ + (size_t)(RL + b * CTXL + key) * 2048 + h * 64 + hf * 32); LAS u32x4* dst = (LAS u32x4*)(ck + pos * ACK_STRIDE + hf * 32);
#pragma unroll
            for (int i = 0; i < 4; ++i) dst[i] = src[i]; }
          { const int d = F.tid >> 3, sg = F.tid & 7; const u32x4* src = (const u32x4*)(VT + YT_CTX_OFF + (size_t)(b * 1024 + h * 64 + d) * 256 + sg * 32); LAS u32x4* dst = (LAS u32x4*)(cv + d * ACV_STRIDE + sg * 32);
#pragma unroll
            for (int i = 0; i < 4; ++i) dst[i] = src[i]; }
          for (int i = F.tid; i < 16 * 64; i += NTHREADS) { const int rr = i >> 6, cc = (i & 63) - 16; rp[i] = rr == 15 ? -__builtin_inff() : ((cc >= 0 && cc < 31) ? rpb[h * 465 + rr * 31 + cc] * LOG2E : 0.f); } }
        __syncthreads();
        const int qt = F.wave & 3, rpi = F.wave >> 2;
#pragma unroll 1
        for (int st = 0; st < 8; ++st) { const int r = half * 32 + st * 4 + rpi * 2; const int rowqA = b * SEQ + r * 64 + 16 * qt;
            attn_unit2(KQ, VT, ATT, F.lds, b, h, rowqA, rowqA + 64, true, r, qt, F.lane); }
        if (with_ctx_queries && half == 0) { const int rowqA = RL + b * CTXL + 32 * F.wave; attn_unit2(KQ, VT, ATT, F.lds, b, h, rowqA, rowqA + 16, false, 0, 0, F.lane); }
    }
    __syncthreads();
}

__device__ __forceinline__ void p_pool(Frame& F, int nrows) {
    const bf16* PB = WSP(bf16, WS_PB); bf16* POOL = WSP(bf16, WS_POOL);
    for (int i = F.bid * NTHREADS + F.tid; i < nrows * 64; i += F.G * NTHREADS) {
        const int row = i >> 6, ch = i & 63, g = ch >> 4, hw = 1 << g;
        int base, t, Lb; if (row < RL) { base = row & ~4095; t = row & 4095; Lb = SEQ; } else { const int rr = row - RL; base = RL + (rr & ~255); t = rr & 255; Lb = CTXL; }
        const int lo = max(t - hw, 0), hi = min(t + hw, Lb);
        float a[8];
#pragma unroll
        for (int q = 0; q < 8; ++q) a[q] = 0.f;
        for (int tt = lo; tt < hi; ++tt) { const u32x4 w = *(const u32x4*)(PB + (size_t)(base + tt) * 512 + ch * 8);
#pragma unroll
            for (int q = 0; q < 4; ++q) { a[2 * q] += bflo(w[q]); a[2 * q + 1] += bfhi(w[q]); } }
        const u32x4 me = *(const u32x4*)(PB + (size_t)row * 512 + ch * 8); const float inv = 1.0f / (float)(hi - lo);
        u32x4 o;
#pragma unroll
        for (int q = 0; q < 4; ++q) o[q] = pk2(a[2 * q] * inv - bflo(me[q]), a[2 * q + 1] * inv - bfhi(me[q]));
        *(u32x4*)(POOL + (size_t)row * 512 + ch * 8) = o;
    }
}

__device__ __forceinline__ int block_sum_i(int v, LAS int* sm, int tid) {
#pragma unroll
    for (int o = 1; o < 64; o <<= 1) v += __shfl_xor(v, o);
    __syncthreads();
    if ((tid & 63) == 0) sm[tid >> 6] = v;
    __syncthreads();
    int s = 0;
#pragma unroll
    for (int i = 0; i < 8; ++i) s += sm[i];
    return s;
}
__device__ __forceinline__ int block_excl_scan(int v, LAS int* sm, int tid, int& total) {
    const int lane = tid & 63, w = tid >> 6; int inc = v;
#pragma unroll
    for (int o = 1; o < 64; o <<= 1) { const int t = __shfl_up(inc, o); if (lane >= o) inc += t; }
    __syncthreads();
    if (lane == 63) sm[w] = inc;
    __syncthreads();
    int base = 0; total = 0;
#pragma unroll
    for (int i = 0; i < 8; ++i) { const int s = sm[i]; if (i < w) base += s; total += s; }
    return base + inc - v;
}
template <int NPT>
__device__ __forceinline__ void topk_pair(Frame& F, int row0, int n, int cap, int e, int slot0) {
    LAS int* sm = (LAS int*)F.lds;
    const float* AFF = WSP(float, WS_AFF); int* SROW = WSP(int, WS_SROW); float* SG = WSP(float, WS_SGATE); int* SEL = WSP(int, WS_SEL);
    unsigned key[NPT];
#pragma unroll
    for (int j = 0; j < NPT; ++j) { const int i = F.tid * NPT + j; key[j] = (i < n) ? __float_as_uint(AFF[(size_t)(row0 + i) * 16 + e]) : 0u; }
    unsigned T = 0u;
    for (int bit = 30; bit >= 0; --bit) { const unsigned cand = T | (1u << bit); int cnt = 0;
#pragma unroll
        for (int j = 0; j < NPT; ++j) cnt += (key[j] >= cand) ? 1 : 0;
        cnt = block_sum_i(cnt, sm, F.tid);
        if (cnt >= cap) T = cand; }
    int ngt = 0, neq = 0;
#pragma unroll
    for (int j = 0; j < NPT; ++j) { ngt += (key[j] > T) ? 1 : 0; neq += (key[j] == T) ? 1 : 0; }
    int tot_gt, tot_eq;
    (void)block_excl_scan(ngt, sm, F.tid, tot_gt);
    int eqr = block_excl_scan(neq, sm, F.tid, tot_eq);
    const int need_eq = cap - tot_gt;
    int nsel = 0; bool selj[NPT];
#pragma unroll
    for (int j = 0; j < NPT; ++j) { bool s = key[j] > T; if (key[j] == T && T != 0u) { s = eqr < need_eq; ++eqr; } selj[j] = s; nsel += s ? 1 : 0; }
    int tot_sel; int pos = block_excl_scan(nsel, sm, F.tid, tot_sel);
#pragma unroll
    for (int j = 0; j < NPT; ++j) { const int i = F.tid * NPT + j;
        if (i < n) { const int row = row0 + i;
            if (selj[j]) { const int slot = slot0 + pos; ++pos; SROW[slot] = row; SG[slot] = __uint_as_float(key[j]); SEL[(size_t)row * 16 + e] = slot; }
            else SEL[(size_t)row * 16 + e] = -1; } }
    __syncthreads();
}
__device__ __forceinline__ void p_topk(Frame& F, bool with_ctx) {
    const int npairs = 128 + (with_ctx ? 128 : 0);
    for (int pi = F.bid; pi < npairs; pi += F.G) {
        if (pi < 128) { const int b = pi >> 4, e = pi & 15; topk_pair<8>(F, b * SEQ, SEQ, CAPL, e, e * SLOT_E + b * CAPL); }
        else { const int p2 = pi - 128, b = p2 >> 4, e = p2 & 15; topk_pair<1>(F, RL + b * CTXL, CTXL, CAPC, e, e * SLOT_E + 4096 + b * CAPC); }
    }
}
__device__ __forceinline__ void p_gather(Frame& F, bool with_ctx) {
    const int gw = F.bid * NWAVES + F.wave, NGW = F.G * NWAVES; const bf16* H = WSP(bf16, WS_H); bf16* XG = WSP(bf16, WS_XG); const int* SROW = WSP(int, WS_SROW);
    for (int s = gw; s < NSLOT; s += NGW) { if (!with_ctx && (s % SLOT_E) >= 4096) continue;
        const int row = SROW[s]; const u32x4* src = (const u32x4*)(H + (size_t)row * DM); u32x4* dst = (u32x4*)(XG + (size_t)s * DM);
        dst[F.lane] = src[F.lane]; dst[F.lane + 64] = src[F.lane + 64]; }
}

template <int PH> __global__ void __launch_bounds__(NTHREADS, 2) fwd_kernel(Params P) {
    extern __shared__ __attribute__((aligned(16))) unsigned char lds_raw[];
    Frame F; F.lds = (LAS unsigned char*)lds_raw; F.tid = threadIdx.x; F.lane = F.tid & 63; F.wave = __builtin_amdgcn_readfirstlane(F.tid >> 6); F.G = gridDim.x; F.bid = blockIdx.x; F.ws = P.ws;
    volatile LAS unsigned* MISC = (volatile LAS unsigned*)(F.lds + LDS_MISC);
    if (F.tid < 64) MISC[F.tid] = 0u;
    __syncthreads();
    XcdBarrier bar; bar.bar = WSP(unsigned, WS_CTL) + CW_BAR; bar.x = 0; bar.st = MISC + 8;
    if constexpr (PH < 0) bar = xcd_barrier_post(WSP(unsigned, WS_CTL) + CW_BAR, MISC + 8);
#define IN(k) (PH < 0 || PH == (k))
#define REFRESH() do { int t_ = threadIdx.x; asm volatile("" : "+v"(t_)); F.tid = t_; F.lane = t_ & 63; F.wave = __builtin_amdgcn_readfirstlane(t_ >> 6); } while (0)
#define SEAM(k) do { if constexpr (PH < 0) xcd_barrier(bar); } while (0)

    if (IN(0)) { REP_BEGIN(100) p_mod(P, F); p_dftgen(F); REP_END REP_BEGIN(101) p_wconv(P, F, 0); REP_END }
    SEAM(0);
    if (IN(1)) { p_rowpass_a0(P, F); }
    SEAM(1);
    for (int l = P.l_lo; l < P.l_hi; ++l) {
        constexpr int pb = 2; const bool L0 = (l == 0);
        bf16* H = WSP(bf16, WS_H);
        if (IN(pb + 0)) { REFRESH(); REP_BEGIN(2)
            { GroupSched S; S.init(1, 128, 22, F.G, F.bid, 8, L0 ? 22 : 4, 128, 0);
              const bf16* WA = WSP(bf16, WS_WA);
              auto AD = [=](const Unit& u) { return Operands{H + (size_t)u.pm * 256 * DM, WA + (size_t)u.pn * 256 * DM, DM, DM}; };
              bf16* KQ = WSP(bf16, WS_KQ); bf16* PBp = WSP(bf16, WS_PB); bf16* GB = WSP(bf16, WS_GB);
              auto E = [=](EPI_ARGS) { const int row0 = u.pm * 256;
                  if (u.pn < 8) { const float qs = (u.pn >= 4) ? QSCALE : 1.0f; EPI_FOR( st_bf4(KQ + (size_t)(row0 + r) * 2048 + u.pn * 256 + c, v * qs); ) }
                  else if (u.pn < 10) { EPI_FOR( st_bf4(PBp + (size_t)(row0 + r) * 512 + (u.pn - 8) * 256 + c, v); ) }
                  else { EPI_FOR( f32x4 s; s[0] = sigmoidf_(v[0]); s[1] = sigmoidf_(v[1]); s[2] = sigmoidf_(v[2]); s[3] = sigmoidf_(v[3]); st_bf4(GB + (size_t)(row0 + r) * 3072 + (u.pn - 10) * 256 + c, s); ) } };
              GEMM(S, AD, E, DM, DM, DM); }
            { GroupSched S; S.init(1, 8, 128, F.G, F.bid, L0 ? 8 : 4, 8, L0 ? 0 : 4, 128);
              const bf16* WFV = WSP(bf16, WS_WFV);
              auto AD = [=](const Unit& u) { return Operands{WFV + (size_t)u.pm * 256 * DM, H + (size_t)u.pn * 256 * DM, DM, DM}; };
              bf16* YT = WSP(bf16, WS_YT); bf16* VT = WSP(bf16, WS_VT);
              auto E = [=](EPI_ARGS) { bf16* T = (u.pm < 4) ? YT : VT; const int rr0 = (u.pm & 3) * 256;
                  if (u.pn < 128) { const int b = u.pn >> 4, l0 = (u.pn & 15) * 256; EPI_FOR( st_bf4(T + ((size_t)b * 1024 + rr0 + r) * 4096 + l0 + c, v); ) }
                  else { const int b = u.pn - 128; EPI_FOR( st_bf4(T + YT_CTX_OFF + ((size_t)b * 1024 + rr0 + r) * 256 + c, v); ) } };
              GEMM(S, AD, E, DM, DM, DM); }
        REP_END }
        SEAM(pb + 0);
        if (IN(pb + 1)) { REFRESH();
            REP_BEGIN(31) p_attn_mfma(P, F, l, L0); REP_END
            REP_BEGIN(32)
            { GroupSched S; S.init(1, 16, 16, F.G, F.bid);
              const bf16* DFTM = WSP(bf16, WS_DFTM); const bf16* YT = WSP(bf16, WS_YT); bf16* FOUR = WSP(bf16, WS_FOUR);
              auto AD = [=](const Unit& u) { return Operands{DFTM + (size_t)u.pm * 256 * 8192, YT + (size_t)u.pn * 256 * 8192, 8192, 8192}; };
              auto E = [=](EPI_ARGS) { const int b = u.pn >> 1, c0 = (u.pn & 1) * 256; const float sc = 0.0013810679320049757f;
                  EPI_FOR( st_bf4(FOUR + ((size_t)b * SEQ + u.pm * 256 + r) * 512 + c0 + c, v * sc); ) };
              GEMM(S, AD, E, 8192, 8192, 8192); }
            if (L0) { GroupSched S; S.init(1, 1, 16, F.G, F.bid);
              const bf16* DFTC = WSP(bf16, WS_DFTC); const bf16* YTC = WSP(bf16, WS_YT) + YT_CTX_OFF; bf16* FOUR = WSP(bf16, WS_FOUR);
              auto AD = [=](const Unit& u) { return Operands{DFTC, YTC + (size_t)u.pn * 256 * 512, 512, 512}; };
              auto E = [=](EPI_ARGS) { const int b = u.pn >> 1, c0 = (u.pn & 1) * 256; const float sc = 0.005524271728019903f;
                  EPI_FOR( st_bf4(FOUR + ((size_t)RL + b * CTXL + r) * 512 + c0 + c, v * sc); ) };
              GEMM(S, AD, E, 512, 512, 512); }
            REP_END
            REP_BEGIN(33) p_pool(F, L0 ? RT : RL); REP_END
        }
        SEAM(pb + 1);
        if (IN(pb + 2)) { REFRESH(); REP_BEGIN(4)
            const int nM = L0 ? 136 : 128; float* MRG = WSP(float, WS_MRG); const bf16* GB = WSP(bf16, WS_GB);
            { GroupSched S; S.init(1, nM, 4, F.G, F.bid); const bf16* A = WSP(bf16, WS_ATT); const bf16* W = WSP(bf16, WS_WAO);
              auto AD = [=](const Unit& u) { return Operands{A + (size_t)u.pm * 256 * 1024, W + (size_t)u.pn * 256 * 1024, 1024, 1024}; };
              auto E = [=](EPI_ARGS) { EPI_FOR( const size_t row = (size_t)u.pm * 256 + r; const int col = u.pn * 256 + c; const u32x2 g = *(const u32x2*)(GB + row * 3072 + col);
                  f32x4 o; o[0] = bflo(g.x) * v[0]; o[1] = bfhi(g.x) * v[1]; o[2] = bflo(g.y) * v[2]; o[3] = bfhi(g.y) * v[3]; *(f32x4*)(MRG + row * 1024 + col) = o; ) };
              GEMM(S, AD, E, 1024, 1024, 1024); }
            { GroupSched S; S.init(1, nM, 4, F.G, F.bid); const bf16* A = WSP(bf16, WS_FOUR); const bf16* W = WSP(bf16, WS_WFO);
              auto AD = [=](const Unit& u) { return Operands{A + (size_t)u.pm * 256 * 512, W + (size_t)u.pn * 256 * 512, 512, 512}; };
              auto E = [=](EPI_ARGS) { EPI_FOR( const size_t row = (size_t)u.pm * 256 + r; const int col = u.pn * 256 + c; const u32x2 g = *(const u32x2*)(GB + row * 3072 + 1024 + col);
                  f32x4 o = *(const f32x4*)(MRG + row * 1024 + col); o[0] += bflo(g.x) * v[0]; o[1] += bfhi(g.x) * v[1]; o[2] += bflo(g.y) * v[2]; o[3] += bfhi(g.y) * v[3]; *(f32x4*)(MRG + row * 1024 + col) = o; ) };
              GEMM(S, AD, E, 512, 512, 512); }
            { GroupSched S; S.init(1, nM, 4, F.G, F.bid); const bf16* A = WSP(bf16, WS_POOL); const bf16* W = WSP(bf16, WS_WPO); bf16* MRGB = WSP(bf16, WS_MRGB);
              const float* ps = P.pool_scale + l * 1024;
              auto AD = [=](const Unit& u) { return Operands{A + (size_t)u.pm * 256 * 512 + (u.pn >> 1) * 256, W + (size_t)u.pn * 256 * 256, 512, 256}; };
              auto E = [=](EPI_ARGS) { EPI_FOR( const size_t row = (size_t)u.pm * 256 + r; const int col = u.pn * 256 + c; const u32x2 g = *(const u32x2*)(GB + row * 3072 + 2048 + col);
                  const f32x4 pv = *(const f32x4*)(ps + col); f32x4 o = *(const f32x4*)(MRG + row * 1024 + col);
                  o[0] += bflo(g.x) * pv[0] * v[0]; o[1] += bfhi(g.x) * pv[1] * v[1]; o[2] += bflo(g.y) * pv[2] * v[2]; o[3] += bfhi(g.y) * pv[3] * v[3]; st_bf4(MRGB + row * 1024 + col, o); ) };
              GEMM(S, AD, E, 256, 512, 256); }
        REP_END }
        SEAM(pb + 2);
        if (IN(pb + 3)) { REFRESH();
            GroupSched S; S.init(1, L0 ? 136 : 128, 4, F.G, F.bid); const bf16* A = WSP(bf16, WS_MRGB); const bf16* W = WSP(bf16, WS_WOUT);
            const float* xin = L0 ? P.x : P.out; const float* cin = L0 ? P.ctx : WSP(float, WS_XC); float* xo = P.out; float* co = WSP(float, WS_XC);
            const float* MOD = WSP(float, WS_MOD) + (size_t)l * 9 * 6144;
            auto AD = [=](const Unit& u) { return Operands{A + (size_t)u.pm * 256 * 1024, W + (size_t)u.pn * 256 * 1024, 1024, 1024}; };
            auto E = [=](EPI_ARGS) { EPI_FOR( const int row = u.pm * 256 + r; const int col = u.pn * 256 + c; const int mr = row < RL ? (row >> 12) : 8;
                const f32x4 g = *(const f32x4*)(MOD + (size_t)mr * 6144 + 2048 + col);
                const float* src = row < RL ? xin + (size_t)row * DM + col : cin + (size_t)(row - RL) * DM + col; float* dst = row < RL ? xo + (size_t)row * DM + col : co + (size_t)(row - RL) * DM + col;
                *(f32x4*)dst = *(const f32x4*)src + g * v; ) };
            GEMM(S, AD, E, 1024, 1024, 1024);
        }
        SEAM(pb + 3);
        if (IN(pb + 4)) { REFRESH(); REP_BEGIN(6) p_rowpass_f(P, F, l, L0 ? RT : RL); REP_END }
        SEAM(pb + 4);
        if (IN(pb + 5)) { REFRESH(); REP_BEGIN(7) p_topk(F, L0); REP_END }
        SEAM(pb + 5);
        if (IN(pb + 6)) { REFRESH(); REP_BEGIN(8) p_gather(F, L0); REP_END }
        SEAM(pb + 6);
        if (IN(pb + 7)) { REFRESH(); REP_BEGIN(9)
            GroupSched S; S.init(16, L0 ? 17 : 16, 22, F.G, F.bid); const bf16* XG = WSP(bf16, WS_XG); const bf16* W = WSP(bf16, WS_WGU); bf16* HID = WSP(bf16, WS_HID);
            auto AD = [=](const Unit& u) { return Operands{XG + ((size_t)u.grp * SLOT_E + u.pm * 256) * DM, W + ((size_t)u.grp * 5632 + u.pn * 256) * DM, DM, DM}; };
            auto E = [=](EPI_ARGS) {
#pragma unroll
                for (int ai = 0; ai < 2; ++ai)
#pragma unroll
                    for (int m = 0; m < 4; ++m) { const size_t slot = (size_t)u.grp * SLOT_E + u.pm * 256 + ai * 128 + wr * 64 + m * 16 + fr;
#pragma unroll
                        for (int n = 0; n < 2; ++n) { const f32x4 a = acc[ai][0][m][n], up = acc[ai][1][m][n]; f32x4 o;
#pragma unroll
                            for (int j = 0; j < 4; ++j) o[j] = a[j] * sigmoidf_(a[j]) * up[j];
                            st_bf4(HID + slot * FF + u.pn * 128 + wc * 32 + n * 16 + 4 * fq, o); } } };
            GEMM(S, AD, E, DM, DM, DM);
        REP_END }
        SEAM(pb + 7);
        if (IN(pb + 8)) { REFRESH(); REP_BEGIN(10)
            GroupSched S; S.init(16, L0 ? 17 : 16, 4, F.G, F.bid); const bf16* HID = WSP(bf16, WS_HID); const bf16* W = WSP(bf16, WS_WD); bf16* Y = WSP(bf16, WS_Y); const float* SG = WSP(float, WS_SGATE);
            auto AD = [=](const Unit& u) { return Operands{HID + ((size_t)u.grp * SLOT_E + u.pm * 256) * FF, W + ((size_t)u.grp * 1024 + u.pn * 256) * FF, FF, FF}; };
            auto E = [=](EPI_ARGS) { EPI_FOR( const size_t slot = (size_t)u.grp * SLOT_E + u.pm * 256 + r; const float gt = SG[slot]; st_bf4(Y + slot * DM + u.pn * 256 + c, v * gt); ) };
            GEMM(S, AD, E, FF, FF, FF);
        REP_END }
        SEAM(pb + 8);
        if (IN(pb + 9)) { REFRESH(); p_rowpass_k(P, F, l, L0 ? RT : RL); if (L0) p_wconv(P, F, 1); }
        if (L0) SEAM(pb + 9);
    }
#undef IN
#undef SEAM
}
template <int PH> static void launch_ph(int grid, const Params& p, hipStream_t stream) { hipLaunchKernelGGL(fwd_kernel<PH>, dim3(grid), dim3(NTHREADS), LDS_BYTES, stream, p); }
template <int PH> static bool set_attr() { return hipFuncSetAttribute((const void*)fwd_kernel<PH>, hipFuncAttributeMaxDynamicSharedMemorySize, LDS_BYTES) == hipSuccess; }

extern "C" void kernel_launch(void* const* d_in, const int* in_sizes, int n_in, void* d_out, int out_size, void* d_ws, size_t ws_size, hipStream_t stream) {
    static int grid = 0;
    if (grid == 0) {
        if (n_in != 20 || out_size != RL * DM || ws_size < WS_END) { fprintf(stderr, "kernel_launch: unexpected shapes (n_in %d out %d ws %zu need %zu)\n", n_in, out_size, ws_size, (size_t)WS_END); grid = -1; return; }
        int dev = 0, cus = 0, per_cu = 0;
        if (hipGetDevice(&dev) != hipSuccess || hipDeviceGetAttribute(&cus, hipDeviceAttributeMultiprocessorCount, dev) != hipSuccess) { grid = -1; return; }
#if N_LAUNCH_MODE == 1
        if (!set_attr<-1>()) { fprintf(stderr, "kernel_launch: hipFuncSetAttribute failed\n"); grid = -1; return; }
        if (hipOccupancyMaxActiveBlocksPerMultiprocessor(&per_cu, (const void*)fwd_kernel<-1>, NTHREADS, LDS_BYTES) != hipSuccess || per_cu < 1) fprintf(stderr, "kernel_launch: occupancy query reports %d\n", per_cu);
#else
        if (!(set_attr<0>() && set_attr<1>() && set_attr<2>() && set_attr<3>() && set_attr<4>() && set_attr<5>() && set_attr<6>() && set_attr<7>() && set_attr<8>() && set_attr<9>() && set_attr<10>() && set_attr<11>())) { fprintf(stderr, "kernel_launch: hipFuncSetAttribute failed\n"); grid = -1; return; }
        (void)per_cu;
#endif
        (void)hipGetLastError();
        grid = cus;
    }
    if (grid < 0) return;
    if (hipMemsetAsync((char*)d_ws + WS_CTL, 0, CTL_BYTES, stream) != hipSuccess) return;
    Params p{};
    const float** pp = (const float**)&p;
    for (int i = 0; i < 20; ++i) pp[i] = (const float*)d_in[i];
    p.out = (float*)d_out; p.ws = (unsigned char*)d_ws;
#if N_LAUNCH_MODE == 1
    p.l_lo = 0; p.l_hi = 2;
    launch_ph<-1>(grid, p, stream);
#else
    p.l_lo = 0; p.l_hi = 0; launch_ph<0>(grid, p, stream); launch_ph<1>(grid, p, stream);
    for (int l = 0; l < 2; ++l) { p.l_lo = l; p.l_hi = l + 1;
        launch_ph<2>(grid, p, stream); launch_ph<3>(grid, p, stream); launch_ph<4>(grid, p, stream); launch_ph<5>(grid, p, stream); launch_ph<6>(grid, p, stream);
        launch_ph<7>(grid, p, stream); launch_ph<8>(grid, p, stream); launch_ph<9>(grid, p, stream); launch_ph<10>(grid, p, stream); launch_ph<11>(grid, p, stream); }
#endif
}
```

```cpp
#include <hip/hip_runtime.h>
#include <cstdio>
#include <cstdint>

#ifndef N_LAUNCH_MODE
#define N_LAUNCH_MODE 1
#endif

#define GAS __attribute__((address_space(1)))
#define LAS __attribute__((address_space(3)))
typedef unsigned short bf16;
typedef short bf16x8 __attribute__((ext_vector_type(8)));
typedef float f32x4 __attribute__((ext_vector_type(4)));
typedef unsigned u32x4 __attribute__((ext_vector_type(4)));
typedef unsigned u32x2 __attribute__((ext_vector_type(2)));

constexpr int NB = 8, SEQ = 4096, DM = 1024, CTXL = 256, NH = 16, HD = 64, GRIDW = 64;
constexpr int RL = NB * SEQ, RC = NB * CTXL, RT = RL + RC;
constexpr int INW = 7168, NE = 16, FF = 2816, CAPL = 512, CAPC = 32;
constexpr int SLOT_E = 4352, NSLOT = NE * SLOT_E;
constexpr float RMS_EPS = 1e-6f;
constexpr float LOG2E = 1.4426950408889634f, QSCALE = 0.125f * LOG2E;
constexpr int NWAVES = 8, NTHREADS = 512;

constexpr size_t al256(size_t x) { return (x + 255) & ~(size_t)255; }
constexpr size_t WS_CTL = 0, CTL_BYTES = 1u << 20;
constexpr size_t WS_MOD = WS_CTL + CTL_BYTES;
constexpr size_t WS_XC = al256(WS_MOD + (size_t)2 * 9 * 6144 * 4);
constexpr size_t WS_AFF = al256(WS_XC + (size_t)RC * DM * 4);
constexpr size_t WS_SROW = al256(WS_AFF + (size_t)RT * 16 * 4);
constexpr size_t WS_SGATE = al256(WS_SROW + (size_t)NSLOT * 4);
constexpr size_t WS_SEL = al256(WS_SGATE + (size_t)NSLOT * 4);
constexpr size_t WS_DFTM = al256(WS_SEL + (size_t)RT * 16 * 4);
constexpr size_t WS_DFTC = al256(WS_DFTM + (size_t)4096 * 8192 * 2);
constexpr size_t WS_WA = al256(WS_DFTC + (size_t)256 * 512 * 2);
constexpr size_t WS_WFV = al256(WS_WA + (size_t)5632 * 1024 * 2);
constexpr size_t WS_WAO = al256(WS_WFV + (size_t)2048 * 1024 * 2);
constexpr size_t WS_WFO = al256(WS_WAO + (size_t)1024 * 1024 * 2);
constexpr size_t WS_WPO = al256(WS_WFO + (size_t)1024 * 512 * 2);
constexpr size_t WS_WOUT = al256(WS_WPO + (size_t)1024 * 256 * 2);
constexpr size_t WS_WGU = al256(WS_WOUT + (size_t)1024 * 1024 * 2);
constexpr size_t WS_WD = al256(WS_WGU + (size_t)16 * 5632 * 1024 * 2);
constexpr size_t WS_H = al256(WS_WD + (size_t)16 * 1024 * 2816 * 2);
constexpr size_t WS_R = al256(WS_H + (size_t)RT * DM * 2);
constexpr size_t WS_KQ = WS_R;
constexpr size_t WS_MRG = WS_KQ;
constexpr size_t WS_PB = al256(WS_KQ + (size_t)RT * 2048 * 2);
constexpr size_t WS_GB = al256(WS_PB + (size_t)RT * 512 * 2);
constexpr size_t WS_YT = al256(WS_GB + (size_t)RT * 3072 * 2);
constexpr size_t WS_MRGB = WS_YT;
constexpr size_t WS_VT = al256(WS_YT + (size_t)RT * 1024 * 2);
constexpr size_t WS_FOUR = al256(WS_VT + (size_t)RT * 1024 * 2);
constexpr size_t WS_ATT = al256(WS_FOUR + (size_t)RT * 512 * 2);
constexpr size_t WS_POOL = al256(WS_ATT + (size_t)RT * 1024 * 2);
constexpr size_t WS_MIX_END = al256(WS_POOL + (size_t)RT * 512 * 2);
constexpr size_t WS_XG = WS_R;
constexpr size_t WS_HID = al256(WS_XG + (size_t)NSLOT * 1024 * 2);
constexpr size_t WS_Y = al256(WS_HID + (size_t)NSLOT * 2816 * 2);
constexpr size_t WS_MOE_END = al256(WS_Y + (size_t)NSLOT * 1024 * 2);
constexpr size_t WS_END = WS_MIX_END > WS_MOE_END ? WS_MIX_END : WS_MOE_END;
constexpr size_t YT_CTX_OFF = (size_t)8 * 1024 * 4096;

constexpr int CW_BAR = 4096;

constexpr int LDS_BYTES = 147456;
constexpr int LDS_MISC = 131072;

__device__ __forceinline__ unsigned f2bf(float f) { unsigned u = __float_as_uint(f); return (u + 0x7fffu + ((u >> 16) & 1u)) >> 16; }
typedef __bf16 hbf16x2 __attribute__((ext_vector_type(2)));
typedef float f32x2 __attribute__((ext_vector_type(2)));
__device__ __forceinline__ unsigned pk2(float lo, float hi) { const f32x2 v = {lo, hi}; return __builtin_bit_cast(unsigned, __builtin_convertvector(v, hbf16x2)); }
__device__ __forceinline__ float bf2f(unsigned b) { return __uint_as_float(b << 16); }
__device__ __forceinline__ float bflo(unsigned w) { return __uint_as_float(w << 16); }
__device__ __forceinline__ float bfhi(unsigned w) { return __uint_as_float(w & 0xffff0000u); }
__device__ __forceinline__ float wave_sum(float v) {
#pragma unroll
    for (int o = 1; o < 64; o <<= 1) v += __shfl_xor(v, o);
    return v;
}
__device__ __forceinline__ float wave_max(float v) {
#pragma unroll
    for (int o = 1; o < 64; o <<= 1) v = fmaxf(v, __shfl_xor(v, o));
    return v;
}
__device__ __forceinline__ float sigmoidf_(float x) { return 1.f / (1.f + __expf(-x)); }
#define LDS_WAIT() asm volatile("s_waitcnt lgkmcnt(0)" ::: "memory")

#define XB_TMO      128
#define XB_XCNT(j)  (256  + 64 * (j))
#define XB_XSUB(j)  (1280 + 64 * (j))
#define XB_XGEN(j)  (2304 + 64 * (j))
#define XB_TOP      3328
#define XB_TOPGEN   3392
#define XCD_BAR_WORDS 3456
#define XB_SPIN_CAP (1u << 22)

__device__ __forceinline__ unsigned xb_ld(unsigned* p)              { return __hip_atomic_load(p, __ATOMIC_RELAXED, __HIP_MEMORY_SCOPE_AGENT); }
__device__ __forceinline__ unsigned xb_add(unsigned* p, unsigned v) { return __hip_atomic_fetch_add(p, v, __ATOMIC_RELAXED, __HIP_MEMORY_SCOPE_AGENT); }
__device__ __forceinline__ unsigned xb_xcc_id() { return (unsigned)__builtin_amdgcn_s_getreg((3 << 11) | 20) & 0xFu; }
#define XB_SPIN(cond, bar) do { unsigned _sp = 0; while (cond) { __builtin_amdgcn_s_sleep(1); \
    if ((++_sp & 255u) == 0u) { if (xb_ld(&(bar)[XB_TMO])) break; if (_sp > XB_SPIN_CAP) { atomicAdd(&(bar)[XB_TMO], 1u); break; } } } } while (0)

struct XcdBarrier { unsigned* bar; unsigned x; volatile LAS unsigned* st; };

__device__ __forceinline__ XcdBarrier xcd_barrier_post(unsigned* bar, volatile LAS unsigned* st) {
    XcdBarrier b; b.bar = bar; b.x = xb_xcc_id(); b.st = st;
    if (threadIdx.x == 0) (void)xb_add(&bar[XB_XCNT(b.x)], 1u);
    return b;
}
__device__ __forceinline__ void xcd_barrier_complete(unsigned* bar, unsigned x, unsigned& nloc, unsigned& nx) {
    const unsigned G = gridDim.x * gridDim.y * gridDim.z;
    unsigned sum, cnt, mine, sp = 0u;
    for (;;) {
        sum = 0u; cnt = 0u; mine = 0u;
#pragma unroll
        for (unsigned j = 0; j < 16; ++j) { const unsigned c = xb_ld(&bar[XB_XCNT(j)]); sum += c; cnt += (c > 0u) ? 1u : 0u; mine = (j == x) ? c : mine; }
        if (sum == G) break;
        __builtin_amdgcn_s_sleep(1);
        if ((++sp & 255u) == 0u) { if (xb_ld(&bar[XB_TMO])) break; if (sp > XB_SPIN_CAP) { atomicAdd(&bar[XB_TMO], 1u); break; } }
    }
    nloc = mine > 0u ? mine : 1u; nx = cnt > 0u ? cnt : 1u;
}
__device__ __forceinline__ void xcd_barrier(const XcdBarrier& b) {
    asm volatile("s_waitcnt vmcnt(0)" ::: "memory");
    __syncthreads();
    if (threadIdx.x == 0) {
        unsigned* bar = b.bar;
        __builtin_amdgcn_s_waitcnt(0);
        unsigned nloc = b.st[0], nx = b.st[1];
        if (nloc == 0u) { xcd_barrier_complete(bar, b.x, nloc, nx); b.st[0] = nloc; b.st[1] = nx; }
        const unsigned old = xb_add(&bar[XB_XSUB(b.x)], 1u);
        const unsigned gen = old / nloc;
        if (old + 1u == (gen + 1u) * nloc) {
            __builtin_amdgcn_fence(__ATOMIC_RELEASE, "agent");
            asm volatile("s_waitcnt vmcnt(0)" ::: "memory");
            const unsigned og = xb_add(&bar[XB_TOP], 1u);
            const unsigned tg = og / nx;
            if (og + 1u == (tg + 1u) * nx) xb_add(&bar[XB_TOPGEN], 1u);
            else XB_SPIN(xb_ld(&bar[XB_TOPGEN]) == tg, bar);
            __builtin_amdgcn_fence(__ATOMIC_ACQUIRE, "agent");
            xb_add(&bar[XB_XGEN(b.x)], 1u);
            asm volatile("s_waitcnt vmcnt(0)" ::: "memory");
        } else {
            XB_SPIN(xb_ld(&bar[XB_XGEN(b.x)]) == gen, bar);
            __builtin_amdgcn_fence(__ATOMIC_ACQUIRE, "agent");
            asm volatile("s_waitcnt vmcnt(0)" ::: "memory");
        }
    }
    __syncthreads();
}

struct Params {
    const float *x, *c, *ctx, *c_ctx, *ada_w, *ada_b, *norm1_g, *norm2_g, *w_in, *rpb, *w_att_o, *w_fourier, *w_pool, *pool_scale, *w_out, *w_router, *w_eg, *w_eu, *w_ed, *final_g;
    float* out; unsigned char* ws; int l_lo, l_hi;
};
struct Frame {
    LAS unsigned char* lds;
    int tid, lane, wave, G, bid;
    unsigned char* ws;
};
#define WSP(T, off) ((T*)(F.ws + (off)))

struct Unit { int grp, pm, pn; };
struct GroupSched {
    int ng, nM, nN, G, c; int tM, tN, tpm0, tpn0;
    __device__ __forceinline__ void init(int ng_, int nM_, int nN_, int G_, int c_, int tM_ = 0, int tN_ = 0, int tpm0_ = 0, int tpn0_ = 0) { ng = ng_; nM = nM_; nN = nN_; G = G_; c = c_; tM = tM_; tN = tN_; tpm0 = tpm0_; tpn0 = tpn0_; }
    __device__ __forceinline__ bool next(int i, Unit& u) const {
        const int per = nM * nN; const int L = i * G + c;
        if (L < ng * per) {
            u.grp = L / per; int wgid = L - u.grp * per;
            { const int q = per / 8, r = per % 8, xcd = wgid % 8, off = wgid / 8; wgid = (xcd < r ? xcd * (q + 1) : r * (q + 1) + (xcd - r) * q) + off; }
            const int nig = 8 * nN, gid = wgid / nig, fm = gid * 8, gsz = (nM - fm) < 8 ? (nM - fm) : 8;
            u.pm = fm + ((wgid % nig) % gsz); u.pn = (wgid % nig) / gsz; return true;
        }
        const int w = L - ng * per;
        if (w < tM * tN) { u.grp = ng; u.pm = tpm0 + (w % tM); u.pn = tpn0 + (w / tM); return true; }
        return false;
    }
};
struct Operands { const bf16* A; const bf16* Bt; int lda, ldb; };

template <class Addr, class Epi>
__device__ __forceinline__ void gemm_simple(const GroupSched& S, const Addr& AD, const Epi& E, int K) {
    const int tid = threadIdx.x, wid = __builtin_amdgcn_readfirstlane(tid >> 6), lane = tid & 63, wr = wid >> 2, wc = wid & 3, fr = lane & 15, fq = lane >> 4;
    Unit u;
    for (int i = 0; S.next(i, u); ++i) {
        const Operands op = AD(u);
        f32x4 acc[2][2][4][2];
#pragma unroll
        for (int a = 0; a < 2; ++a)
#pragma unroll
            for (int b = 0; b < 2; ++b)
#pragma unroll
                for (int m = 0; m < 4; ++m)
#pragma unroll
                    for (int n = 0; n < 2; ++n) acc[a][b][m][n] = (f32x4){0.f, 0.f, 0.f, 0.f};
        const bf16* ap = op.A + (size_t)(wr * 64 + fr) * op.lda + fq * 8;
        const bf16* bp = op.Bt + (size_t)(wc * 32 + fr) * op.ldb + fq * 8;
#pragma unroll 1
        for (int k = 0; k < K; k += 32) {
            bf16x8 bfr[2][2];
#pragma unroll
            for (int b = 0; b < 2; ++b)
#pragma unroll
                for (int n = 0; n < 2; ++n) bfr[b][n] = *(const bf16x8*)(bp + (size_t)(b * 128 + n * 16) * op.ldb + k);
#pragma unroll
            for (int a = 0; a < 2; ++a) {
                bf16x8 af[4];
#pragma unroll
                for (int m = 0; m < 4; ++m) af[m] = *(const bf16x8*)(ap + (size_t)(a * 128 + m * 16) * op.lda + k);
#pragma unroll
                for (int b = 0; b < 2; ++b)
#pragma unroll
                    for (int m = 0; m < 4; ++m)
#pragma unroll
                        for (int n = 0; n < 2; ++n) acc[a][b][m][n] = __builtin_amdgcn_mfma_f32_16x16x32_bf16(bfr[b][n], af[m], acc[a][b][m][n], 0, 0, 0);
            }
        }
        E(acc, u, wr, wc, fr, fq);
    }
}
constexpr int HTB = 128 * 64 * 2;
__device__ __forceinline__ int lds_byte(int r, int c) { const int st = (r >> 4) * 2 + (c >> 5), rr = r & 15, cc = c & 31, ob = rr * 64 + cc * 2; return st * 1024 + (ob ^ (((ob >> 9) & 1) << 5)); }
__device__ __forceinline__ void stage_rc(int b, int& R, int& C) { const int st = b / 1024, sb = b % 1024, swz = sb ^ (((sb >> 9) & 1) << 5); R = (st >> 1) * 16 + swz / 64; C = (st & 1) * 32 + (swz % 64) / 2; }
template <class Addr, class Epi>
__device__ __forceinline__ void gemm_fast(LAS unsigned char* lds, const int tid, const GroupSched& S, const Addr& AD, const Epi& E, const int K, const int lda, const int ldb) {
    const int wid = __builtin_amdgcn_readfirstlane(tid >> 6), lane = tid & 63, wr = wid >> 2, wc = wid & 3, fr = lane & 15, fq = lane >> 4;
    const int nt = K / 64;
    unsigned voffA[2], voffB[2];
#pragma unroll
    for (int i = 0; i < 2; ++i) { int R, C; stage_rc(tid * 16 + i * 8192, R, C); voffA[i] = (unsigned)(R * lda + C) * 2u; voffB[i] = (unsigned)(R * ldb + C) * 2u; }
    const size_t kstep = 128;
    const size_t hstepA = (size_t)128 * lda * 2, hstepB = (size_t)128 * ldb * 2;
    const unsigned ldsw = (unsigned)wid * 1024u;
    const int aoff = lds_byte(wr * 64 + fr, fq * 8), boff = lds_byte(wc * 32 + fr, fq * 8);
#define PG8_SA(b, h) (((b) * 2 + (h)) * HTB)
#define PG8_SB(b, h) ((4 + (b) * 2 + (h)) * HTB)
#define PG8_STAGE(bufoff, gbase, voff) do { _Pragma("unroll") for (int _i = 0; _i < 2; ++_i) \
        __builtin_amdgcn_global_load_lds((const unsigned*)((const char*)(gbase) + (voff)[_i]), (LAS unsigned*)(lds + (bufoff) + ldsw + _i * 8192), 16, 0, 0); } while (0)
#define PG8_LDA(dst, b, h) do { _Pragma("unroll") for (int m = 0; m < 4; ++m) _Pragma("unroll") for (int k = 0; k < 2; ++k) dst[m][k] = *(const LAS bf16x8*)(lds + PG8_SA(b, h) + aoff + m * 2048 + k * 1024); } while (0)
#define PG8_LDB(dst, b, h) do { _Pragma("unroll") for (int n = 0; n < 2; ++n) _Pragma("unroll") for (int k = 0; k < 2; ++k) dst[n][k] = *(const LAS bf16x8*)(lds + PG8_SB(b, h) + boff + n * 2048 + k * 1024); } while (0)
#define PG8_MMA(ai, bj, At, Bt) do { __builtin_amdgcn_s_setprio(1); _Pragma("unroll") for (int m = 0; m < 4; ++m) _Pragma("unroll") for (int n = 0; n < 2; ++n) _Pragma("unroll") for (int k = 0; k < 2; ++k) \
        acc[ai][bj][m][n] = __builtin_amdgcn_mfma_f32_16x16x32_bf16(Bt[n][k], At[m][k], acc[ai][bj][m][n], 0, 0, 0); __builtin_amdgcn_s_setprio(0); } while (0)
#define PG8_WAIT_V(n) asm volatile("s_waitcnt vmcnt(" #n ")" ::: "memory")
#define PG8_WAIT_L(n) asm volatile("s_waitcnt lgkmcnt(" #n ")" ::: "memory")
#define PG8_BAR __builtin_amdgcn_s_barrier()
#define PG8_SCHED __builtin_amdgcn_sched_barrier(0)
    Unit cur, nxt; int ui = 0;
    if (!S.next(0, cur)) return;
    f32x4 acc[2][2][4][2];
#pragma unroll
    for (int a = 0; a < 2; ++a)
#pragma unroll
        for (int b = 0; b < 2; ++b)
#pragma unroll
            for (int m = 0; m < 4; ++m)
#pragma unroll
                for (int n = 0; n < 2; ++n) acc[a][b][m][n] = (f32x4){0.f, 0.f, 0.f, 0.f};
    bf16x8 At[4][2], B0[2][2], B1[2][2];
    const char* cA; const char* cB;
    { const Operands op = AD(cur); cA = (const char*)op.A; cB = (const char*)op.Bt; }
    PG8_STAGE(PG8_SB(0, 0), cB, voffB); PG8_STAGE(PG8_SB(0, 1), cB + hstepB, voffB); PG8_STAGE(PG8_SA(0, 0), cA, voffA); PG8_STAGE(PG8_SA(0, 1), cA + hstepA, voffA);
    if (wr == 1) PG8_BAR;
    PG8_WAIT_V(2); PG8_BAR;
    PG8_STAGE(PG8_SB(1, 0), cB + kstep, voffB); PG8_STAGE(PG8_SA(1, 0), cA + kstep, voffA); PG8_STAGE(PG8_SB(1, 1), cB + hstepB + kstep, voffB);
    PG8_WAIT_V(6); PG8_BAR;
    for (;;) {
        const bool has_next = S.next(ui + 1, nxt);
        const char* nA = cA; const char* nB = cB;
        if (has_next) { const Operands op = AD(nxt); nA = (const char*)op.A; nB = (const char*)op.Bt; }
#pragma unroll 1
        for (int t = 0; t < nt; t += 2) {
            const bool last = (t == nt - 2);
            const char* a1 = cA + (size_t)(t + 1) * kstep;
            const char* a2 = last ? nA : cA + (size_t)(t + 2) * kstep; const char* b2 = last ? nB : cB + (size_t)(t + 2) * kstep;
            const char* a3 = a2 + kstep; const char* b3 = b2 + kstep;
            PG8_LDB(B0, 0, 0); PG8_LDB(B1, 0, 1); PG8_SCHED; PG8_LDA(At, 0, 0); PG8_STAGE(PG8_SA(1, 1), a1 + hstepA, voffA);
            PG8_WAIT_V(8); PG8_WAIT_L(0); PG8_BAR; PG8_MMA(0, 0, At, B0); PG8_MMA(0, 1, At, B1); PG8_BAR; PG8_SCHED;
            PG8_LDA(At, 0, 1); PG8_STAGE(PG8_SB(0, 0), b2, voffB); PG8_STAGE(PG8_SB(0, 1), b2 + hstepB, voffB); PG8_STAGE(PG8_SA(0, 0), a2, voffA);
            PG8_WAIT_V(8); PG8_WAIT_L(0); PG8_BAR; PG8_MMA(1, 0, At, B0); PG8_MMA(1, 1, At, B1); PG8_BAR; PG8_SCHED;
            PG8_LDB(B0, 1, 0); PG8_LDB(B1, 1, 1); PG8_SCHED; PG8_LDA(At, 1, 0); PG8_STAGE(PG8_SA(0, 1), a2 + hstepA, voffA);
            PG8_WAIT_V(8); PG8_WAIT_L(0); PG8_BAR; PG8_MMA(0, 0, At, B0); PG8_MMA(0, 1, At, B1); PG8_BAR; PG8_SCHED;
            PG8_LDA(At, 1, 1); PG8_STAGE(PG8_SB(1, 0), b3, voffB); PG8_STAGE(PG8_SB(1, 1), b3 + hstepB, voffB); PG8_STAGE(PG8_SA(1, 0), a3, voffA);
            PG8_WAIT_V(8); PG8_WAIT_L(0); PG8_BAR; PG8_MMA(1, 0, At, B0); PG8_MMA(1, 1, At, B1); PG8_BAR; PG8_SCHED;
        }
        if (wr == 0) PG8_BAR;
        { int fr2 = fr, fq2 = fq; asm volatile("" : "+v"(fr2), "+v"(fq2));
          E(acc, cur, wr, wc, fr2, fq2); }
        if (!has_next) break;
#pragma unroll
        for (int a = 0; a < 2; ++a)
#pragma unroll
            for (int b = 0; b < 2; ++b)
#pragma unroll
                for (int m = 0; m < 4; ++m)
#pragma unroll
                    for (int n = 0; n < 2; ++n) acc[a][b][m][n] = (f32x4){0.f, 0.f, 0.f, 0.f};
        cur = nxt; cA = nA; cB = nB; ++ui;
        if (wr == 1) PG8_BAR;
    }
    PG8_WAIT_V(0);
    PG8_BAR;
#undef PG8_SA
#undef PG8_SB
#undef PG8_STAGE
#undef PG8_LDA
#undef PG8_LDB
#undef PG8_MMA
#undef PG8_WAIT_V
#undef PG8_WAIT_L
#undef PG8_BAR
#undef PG8_SCHED
}
#ifndef DUP_PH
#define DUP_PH -1
#endif
#define REP_BEGIN(k) _Pragma("unroll 1") for (int rep_ = 0; rep_ < ((DUP_PH == (k)) ? 2 : 1); ++rep_) { if (rep_) { if constexpr (PH < 0) xcd_barrier(bar); }
#define REP_END }
#ifndef USE_FAST
#define USE_FAST 1
#endif
#if USE_FAST
#define GEMM(S, AD, E, K, lda, ldb) gemm_fast(F.lds, F.tid, S, AD, E, K, lda, ldb)
#else
#define GEMM(S, AD, E, K, lda, ldb) gemm_simple(S, AD, E, K)
#endif
#define EPI_ARGS const f32x4 (&acc)[2][2][4][2], const Unit& u, int wr, int wc, int fr, int fq
#define EPI_FOR(BODY) _Pragma("unroll") for (int ai = 0; ai < 2; ++ai) _Pragma("unroll") for (int m = 0; m < 4; ++m) { const int r = ai * 128 + wr * 64 + m * 16 + fr; \
    _Pragma("unroll") for (int bj = 0; bj < 2; ++bj) _Pragma("unroll") for (int n = 0; n < 2; ++n) { const int c = bj * 128 + wc * 32 + n * 16 + 4 * fq; const f32x4 v = acc[ai][bj][m][n]; BODY } }
__device__ __forceinline__ void st_bf4(bf16* p, f32x4 v) { u32x2 w; w.x = pk2(v[0], v[1]); w.y = pk2(v[2], v[3]); *(u32x2*)p = w; }

__device__ __forceinline__ void p_mod(const Params& P, Frame& F) {
    LAS float* sc = (LAS float*)F.lds;
    LAS float* red = (LAS float*)(F.lds + 9 * 1024 * 4);
    float* MOD = WSP(float, WS_MOD);
    bool have = false;
    for (int it = F.bid; it < 2 * 96; it += F.G) {
        if (!have) {
            for (int i = F.tid; i < 9 * 1024; i += NTHREADS) { const int r = i >> 10, k = i & 1023; const float v = r < 8 ? P.c[r * 1024 + k] : P.c_ctx[k]; sc[i] = v * sigmoidf_(v); }
            have = true;
        }
        __syncthreads();
        const int l = it / 96, j0 = (it % 96) * 64, jj = F.tid & 63, kc = F.tid >> 6;
        const float* W = P.ada_w + (size_t)l * 1024 * 6144 + j0 + jj;
        float a[9];
#pragma unroll
        for (int r = 0; r < 9; ++r) a[r] = 0.f;
        for (int k = kc * 128; k < kc * 128 + 128; ++k) { const float w = W[(size_t)k * 6144];
#pragma unroll
            for (int r = 0; r < 9; ++r) a[r] += sc[r * 1024 + k] * w; }
#pragma unroll
        for (int r = 0; r < 9; ++r) red[(kc * 9 + r) * 64 + jj] = a[r];
        __syncthreads();
        for (int o = F.tid; o < 9 * 64; o += NTHREADS) { const int r = o >> 6, j = o & 63; float s = 0.f;
#pragma unroll
            for (int q = 0; q < 8; ++q) s += red[(q * 9 + r) * 64 + j];
            MOD[((size_t)l * 9 + r) * 6144 + j0 + j] = s + P.ada_b[l * 6144 + j0 + j]; }
    }
    __syncthreads();
}
__device__ __forceinline__ void p_dftgen(Frame& F) {
    LAS float* tab = (LAS float*)F.lds;
    for (int j = F.tid; j < 4096; j += NTHREADS) tab[j] = cospif((float)j * (1.0f / 2048.0f));
    __syncthreads();
    bf16* DM_ = WSP(bf16, WS_DFTM); bf16* DC_ = WSP(bf16, WS_DFTC);
    const int nchunk = 4096 * 1024 + 256 * 64;
    for (int ch = F.bid * NTHREADS + F.tid; ch < nchunk; ch += F.G * NTHREADS) {
        float v[8]; bf16* dst;
        if (ch < 4096 * 1024) { const int kf = ch >> 10, col0 = (ch & 1023) * 8, cs = col0 >> 12, l0 = col0 & 4095;
#pragma unroll
            for (int i = 0; i < 8; ++i) { const int j = (kf * (l0 + i)) & 4095; v[i] = cs ? -tab[(j + 3072) & 4095] : tab[j]; }
            dst = DM_ + (size_t)kf * 8192 + col0; }
        else { const int c2 = ch - 4096 * 1024, kf = c2 >> 6, col0 = (c2 & 63) * 8, cs = col0 >> 8, l0 = col0 & 255;
#pragma unroll
            for (int i = 0; i < 8; ++i) { const int j = ((kf * (l0 + i)) & 255) * 16; v[i] = cs ? -tab[(j + 3072) & 4095] : tab[j]; }
            dst = DC_ + (size_t)kf * 512 + col0; }
        u32x4 o; o.x = pk2(v[0], v[1]); o.y = pk2(v[2], v[3]); o.z = pk2(v[4], v[5]); o.w = pk2(v[6], v[7]);
        *(u32x4*)dst = o;
    }
    __syncthreads();
}
__device__ __forceinline__ void transpose_item(const float* W, int ldw, int k0, int n0, bf16* WT, int ldt, int drow0, LAS float* scr, int lane) {
    f32x4 ld[8];
#pragma unroll
    for (int i = 0; i < 8; ++i) ld[i] = *(const f32x4*)(W + (size_t)(k0 + 8 * i + (lane >> 3)) * ldw + n0 + 4 * (lane & 7));
#pragma unroll
    for (int i = 0; i < 8; ++i) { LAS float* d = scr + (8 * i + (lane >> 3)) * 33 + 4 * (lane & 7); d[0] = ld[i][0]; d[1] = ld[i][1]; d[2] = ld[i][2]; d[3] = ld[i][3]; }
    LDS_WAIT(); asm volatile("" ::: "memory");
    const int c = lane & 7;
#pragma unroll
    for (int j = 0; j < 4; ++j) { const int n = (lane >> 3) + 8 * j; const LAS float* s = scr + (8 * c) * 33 + n;
        u32x4 o; o.x = pk2(s[0 * 33], s[1 * 33]); o.y = pk2(s[2 * 33], s[3 * 33]); o.z = pk2(s[4 * 33], s[5 * 33]); o.w = pk2(s[6 * 33], s[7 * 33]);
        *(u32x4*)(WT + (size_t)(drow0 + n) * ldt + k0 + 8 * c) = o; }
    LDS_WAIT(); asm volatile("" ::: "memory");
}
__device__ __forceinline__ void p_wconv(const Params& P, Frame& F, int l) {
    LAS float* scr = (LAS float*)(F.lds + F.wave * 16384);
    const int gw = F.bid * NWAVES + F.wave, NGW = F.G * NWAVES;
    const float* w_in = P.w_in + (size_t)l * 1024 * INW;
    bf16* WA = WSP(bf16, WS_WA); bf16* WFV = WSP(bf16, WS_WFV);
    constexpr int I_K = 16 * 32, I_Q = 16 * 32, I_P = 16 * 16, I_G = 16 * 96, I_V = 16 * 32, I_AO = 16 * 32, I_FO = 8 * 32, I_OUT = 16 * 32;
    constexpr int NSM = I_K + I_Q + I_P + I_G + I_V + I_AO + I_FO + I_OUT;
    for (int it = gw; it < NSM; it += NGW) {
        int r = it;
        if (r < I_K) { transpose_item(w_in, INW, (r / 32) * 64, 0 + (r % 32) * 32, WA, 1024, 0 + (r % 32) * 32, scr, F.lane); continue; } r -= I_K;
        if (r < I_Q) { transpose_item(w_in, INW, (r / 32) * 64, 2048 + (r % 32) * 32, WA, 1024, 1024 + (r % 32) * 32, scr, F.lane); continue; } r -= I_Q;
        if (r < I_P) { transpose_item(w_in, INW, (r / 16) * 64, 3584 + (r % 16) * 32, WA, 1024, 2048 + (r % 16) * 32, scr, F.lane); continue; } r -= I_P;
        if (r < I_G) { transpose_item(w_in, INW, (r / 96) * 64, 4096 + (r % 96) * 32, WA, 1024, 2560 + (r % 96) * 32, scr, F.lane); continue; } r -= I_G;
        if (r < I_V) { transpose_item(w_in, INW, (r / 32) * 64, 1024 + (r % 32) * 32, WFV, 1024, 1024 + (r % 32) * 32, scr, F.lane); continue; } r -= I_V;
        if (r < I_AO) { transpose_item(P.w_att_o + (size_t)l * 1024 * 1024, 1024, (r / 32) * 64, (r % 32) * 32, WSP(bf16, WS_WAO), 1024, (r % 32) * 32, scr, F.lane); continue; } r -= I_AO;
        if (r < I_FO) { transpose_item(P.w_fourier + (size_t)l * 512 * 1024, 1024, (r / 32) * 64, (r % 32) * 32, WSP(bf16, WS_WFO), 512, (r % 32) * 32, scr, F.lane); continue; } r -= I_FO;
        transpose_item(P.w_out + (size_t)l * 1024 * 1024, 1024, (r / 32) * 64, (r % 32) * 32, WSP(bf16, WS_WOUT), 1024, (r % 32) * 32, scr, F.lane);
    }
    constexpr int I_E = 16 * 88;
    bf16* WGU = WSP(bf16, WS_WGU); bf16* WD = WSP(bf16, WS_WD);
    for (int it = gw; it < 3 * 16 * I_E; it += NGW) {
        const int which = it / (16 * I_E), r0 = it % (16 * I_E), e = r0 / I_E, r = r0 % I_E;
        if (which < 2) { const int kb = r / 88, nb = r % 88, n0 = nb * 32;
            const float* src = (which == 0 ? P.w_eg : P.w_eu) + ((size_t)l * 16 + e) * 1024 * FF;
            transpose_item(src, FF, kb * 64, n0, WGU + (size_t)e * 5632 * 1024, 1024, (n0 >> 7) * 256 + (which ? 128 : 0) + (n0 & 127), scr, F.lane); }
        else { const int kb = r / 32, nb = r % 32;
            transpose_item(P.w_ed + ((size_t)l * 16 + e) * FF * 1024, 1024, kb * 64, nb * 32, WD + (size_t)e * 1024 * FF, FF, nb * 32, scr, F.lane); }
    }
    { bf16* WPO = WSP(bf16, WS_WPO); const float* wp = P.w_pool + (size_t)l * 4 * 128 * 256;
      for (int i = F.bid * NTHREADS + F.tid; i < 1024 * 256; i += F.G * NTHREADS) { const int n = i >> 8, kk = i & 255, g = n >> 8, f = n & 255;
          WPO[i] = (bf16)(((kk >> 7) == (g & 1)) ? f2bf(wp[((size_t)g * 128 + (kk & 127)) * 256 + f]) : 0u); } }
    { LAS float* t128 = (LAS float*)F.lds;
      __syncthreads();
      for (int j = F.tid; j < 128; j += NTHREADS) t128[j] = cospif((float)j * (1.0f / 64.0f));
      __syncthreads();
      for (int i = F.bid * NTHREADS + F.tid; i < 1024 * 1024; i += F.G * NTHREADS) { const int fc = i >> 10, k = i & 1023, cs = fc & 1, gm = fc >> 1, g = gm >> 7, m = gm & 127;
          const float* src = w_in + (size_t)k * INW + 3072 + g * 128; float s = 0.f; const int ph = cs ? 96 : 0;
          for (int c = 0; c < 128; ++c) s += src[c] * t128[(m * c + ph) & 127];
          WFV[i] = (bf16)f2bf(s); }
      __syncthreads(); }
}

struct RowMod { const float* g; const float* sh; const float* sc; };
__device__ __forceinline__ void row_load(const float* row, int lane, f32x4 (&v)[4]) {
#pragma unroll
    for (int j = 0; j < 4; ++j) v[j] = *(const f32x4*)(row + 4 * lane + 256 * j);
}
__device__ __forceinline__ float row_rstd(const f32x4 (&v)[4]) {
    float s = 0.f;
#pragma unroll
    for (int j = 0; j < 4; ++j) s += (v[j][0] * v[j][0] + v[j][1] * v[j][1]) + (v[j][2] * v[j][2] + v[j][3] * v[j][3]);
    return rsqrtf(wave_sum(s) * (1.0f / 1024.0f) + RMS_EPS);
}
__device__ __forceinline__ void row_modulate(const f32x4 (&v)[4], float rstd, const RowMod& M, int lane, f32x4 (&y)[4]) {
#pragma unroll
    for (int j = 0; j < 4; ++j) { const int k = 4 * lane + 256 * j; const f32x4 g = *(const f32x4*)(M.g + k), sh = *(const f32x4*)(M.sh + k), sc = *(const f32x4*)(M.sc + k);
        y[j] = v[j] * rstd * g * (sc + 1.0f) + sh; }
}
__device__ __forceinline__ void row_store_bf(bf16* row, int lane, const f32x4 (&y)[4]) {
#pragma unroll
    for (int j = 0; j < 4; ++j) st_bf4(row + 4 * lane + 256 * j, y[j]);
}
__device__ __forceinline__ const float* mod_ptr(Frame& F, int l, int row, int which) { const int mr = row < RL ? (row >> 12) : 8; return WSP(float, WS_MOD) + ((size_t)l * 9 + mr) * 6144 + which * 1024; }

__device__ __forceinline__ void p_rowpass_a0(const Params& P, Frame& F) {
    const int gw = F.bid * NWAVES + F.wave, NGW = F.G * NWAVES; bf16* H = WSP(bf16, WS_H);
    for (int row = gw; row < RT; row += NGW) {
        const float* src = row < RL ? P.x + (size_t)row * DM : P.ctx + (size_t)(row - RL) * DM;
        f32x4 v[4], y[4]; row_load(src, F.lane, v); const float rs = row_rstd(v);
        RowMod M{P.norm1_g, mod_ptr(F, 0, row, 0), mod_ptr(F, 0, row, 1)};
        row_modulate(v, rs, M, F.lane, y); row_store_bf(H + (size_t)row * DM, F.lane, y);
    }
}
__device__ __forceinline__ void p_rowpass_f(const Params& P, Frame& F, int l, int nrows) {
    const int gw = F.bid * NWAVES + F.wave, NGW = F.G * NWAVES; bf16* H = WSP(bf16, WS_H); float* AFF = WSP(float, WS_AFF);
    const float* wr = P.w_router + (size_t)l * 1024 * 16;
    LAS float* wl = (LAS float*)F.lds;
    __syncthreads();
    for (int i = F.tid; i < 16384; i += NTHREADS) wl[(i & 15) * 1024 + (i >> 4)] = wr[i];
    __syncthreads();
    for (int row = gw; row < nrows; row += NGW) {
        const float* src = row < RL ? P.out + (size_t)row * DM : WSP(float, WS_XC) + (size_t)(row - RL) * DM;
        f32x4 v[4], y[4]; row_load(src, F.lane, v); const float rs = row_rstd(v);
        RowMod M{P.norm2_g + l * 1024, mod_ptr(F, l, row, 3), mod_ptr(F, l, row, 4)};
        row_modulate(v, rs, M, F.lane, y); row_store_bf(H + (size_t)row * DM, F.lane, y);
        float lg[16];
        int wo = 4 * F.lane; asm volatile("" : "+v"(wo));
#pragma unroll
        for (int e = 0; e < 16; ++e) { float a = 0.f;
#pragma unroll
            for (int j = 0; j < 4; ++j) { const f32x4 w = *(const LAS f32x4*)(wl + e * 1024 + wo + 256 * j); a += (y[j][0] * w[0] + y[j][1] * w[1]) + (y[j][2] * w[2] + y[j][3] * w[3]); }
            lg[e] = a; }
        float mx = -1e30f;
#pragma unroll
        for (int e = 0; e < 16; ++e) { lg[e] = wave_sum(lg[e]); mx = fmaxf(mx, lg[e]); }
        float den = 0.f;
#pragma unroll
        for (int e = 0; e < 16; ++e) { lg[e] = __expf(lg[e] - mx); den += lg[e]; }
        const float inv = 1.0f / den;
        if (F.lane < 16) { float mine = 0.f;
#pragma unroll
            for (int e = 0; e < 16; ++e) mine = (F.lane == e) ? lg[e] : mine;
            AFF[(size_t)row * 16 + F.lane] = mine * inv; }
    }
    __syncthreads();
}
__device__ __forceinline__ void p_rowpass_k(const Params& P, Frame& F, int l, int nrows) {
    const int gw = F.bid * NWAVES + F.wave, NGW = F.G * NWAVES; bf16* H = WSP(bf16, WS_H);
    const int* SEL = WSP(int, WS_SEL); const bf16* Y = WSP(bf16, WS_Y);
    for (int row = gw; row < nrows; row += NGW) {
        float* xr = row < RL ? P.out + (size_t)row * DM : WSP(float, WS_XC) + (size_t)(row - RL) * DM;
        f32x4 v[4], a[4]; row_load(xr, F.lane, v);
#pragma unroll
        for (int j = 0; j < 4; ++j) a[j] = (f32x4){0.f, 0.f, 0.f, 0.f};
        for (int e = 0; e < 16; ++e) { const int s = SEL[(size_t)row * 16 + e];
            if (s >= 0) { const bf16* yr = Y + (size_t)s * DM;
#pragma unroll
                for (int j = 0; j < 4; ++j) { const u32x2 w = *(const u32x2*)(yr + 4 * F.lane + 256 * j); a[j][0] += bflo(w.x); a[j][1] += bfhi(w.x); a[j][2] += bflo(w.y); a[j][3] += bfhi(w.y); } } }
        const float* g2 = mod_ptr(F, l, row, 5);
#pragma unroll
        for (int j = 0; j < 4; ++j) { const f32x4 g = *(const f32x4*)(g2 + 4 * F.lane + 256 * j); v[j] = v[j] + g * a[j]; }
        const float rs = row_rstd(v);
        if (l == 0) {
#pragma unroll
            for (int j = 0; j < 4; ++j) *(f32x4*)(xr + 4 * F.lane + 256 * j) = v[j];
            f32x4 y[4]; RowMod M{P.norm1_g + 1024, mod_ptr(F, 1, row, 0), mod_ptr(F, 1, row, 1)};
            row_modulate(v, rs, M, F.lane, y); row_store_bf(H + (size_t)row * DM, F.lane, y);
        } else {
#pragma unroll
            for (int j = 0; j < 4; ++j) { const f32x4 g = *(const f32x4*)(P.final_g + 4 * F.lane + 256 * j); *(f32x4*)(xr + 4 * F.lane + 256 * j) = v[j] * rs * g; }
        }
    }
}

__device__ __forceinline__ float dot64(const bf16x8 (&q)[8], const bf16* kp) {
    float s = 0.f;
#pragma unroll
    for (int i = 0; i < 8; ++i) { const u32x4 kw = *(const u32x4*)(kp + 8 * i); const u32x4 qw = __builtin_bit_cast(u32x4, q[i]);
#pragma unroll
        for (int t = 0; t < 4; ++t) s += bflo(kw[t]) * bflo(qw[t]) + bfhi(kw[t]) * bfhi(qw[t]); }
    return s;
}
__device__ __forceinline__ void p_attn_naive(const Params& P, Frame& F, int l, bool with_ctx_queries) {
    const int gw = F.bid * NWAVES + F.wave, NGW = F.G * NWAVES;
    const bf16* KQ = WSP(bf16, WS_KQ); const bf16* VT = WSP(bf16, WS_VT); bf16* ATT = WSP(bf16, WS_ATT);
    LAS float* pw = (LAS float*)(F.lds + F.wave * 2048);
    const float* rpb = P.rpb + (size_t)l * 16 * 15 * 31;
    const int nlat = NB * 64 * NH * 64, nitems = nlat + (with_ctx_queries ? NB * NH * CTXL : 0);
    for (int it = gw; it < nitems; it += NGW) {
        const bool lat = it < nlat;
        int b, h, r = 0, qc = 0, rowq;
        if (lat) { qc = it & 63; h = (it >> 6) & 15; r = (it >> 10) & 63; b = it >> 16; rowq = b * SEQ + r * 64 + qc; }
        else { const int i2 = it - nlat; qc = i2 & 255; h = (i2 >> 8) & 15; b = i2 >> 12; rowq = RL + b * CTXL + qc; }
        bf16x8 q[8];
        { const bf16* qp = KQ + (size_t)rowq * 2048 + 1024 + h * 64;
#pragma unroll
          for (int i = 0; i < 8; ++i) q[i] = *(const bf16x8*)(qp + 8 * i); }
        const int rs = min(max(r - 4, 0), 56), cs = min(max(qc - 8, 0), 48);
        float s[6];
        if (lat) {
#pragma unroll
            for (int t = 0; t < 2; ++t) { const int w = F.lane + 64 * t, i = w >> 4, j = w & 15; const int tok = (rs + i) * 64 + cs + j;
                s[t] = dot64(q, KQ + (size_t)(b * SEQ + tok) * 2048 + h * 64) * 0.125f + rpb[(h * 15 + (rs + i - r + 7)) * 31 + (cs + j - qc + 15)]; }
        } else { s[0] = -1e30f; s[1] = -1e30f; }
#pragma unroll
        for (int t = 0; t < 4; ++t) { const int c = F.lane + 64 * t; s[2 + t] = dot64(q, KQ + (size_t)(RL + b * CTXL + c) * 2048 + h * 64) * 0.125f; }
        float mx = s[0];
#pragma unroll
        for (int t = 1; t < 6; ++t) mx = fmaxf(mx, s[t]);
        mx = wave_max(mx);
        float sum = 0.f;
#pragma unroll
        for (int t = 0; t < 6; ++t) { s[t] = (lat || t >= 2) ? __expf(s[t] - mx) : 0.f; sum += s[t]; }
        sum = wave_sum(sum);
        pw[F.lane] = s[0]; pw[F.lane + 64] = s[1];
#pragma unroll
        for (int t = 0; t < 4; ++t) pw[128 + F.lane + 64 * t] = s[2 + t];
        LDS_WAIT(); asm volatile("" ::: "memory");
        float o = 0.f;
        if (lat) { const bf16* vr = VT + ((size_t)b * 1024 + h * 64 + F.lane) * 4096;
#pragma unroll 2
            for (int w = 0; w < 128; ++w) { const int tok = (rs + (w >> 4)) * 64 + cs + (w & 15); o += pw[w] * bf2f(vr[tok]); } }
        { const bf16* vr = VT + YT_CTX_OFF + ((size_t)b * 1024 + h * 64 + F.lane) * 256;
#pragma unroll 2
          for (int c8 = 0; c8 < 32; ++c8) { const u32x4 vw = *(const u32x4*)(vr + 8 * c8); const LAS float* pp = pw + 128 + 8 * c8;
#pragma unroll
              for (int t = 0; t < 4; ++t) o += pp[2 * t] * bflo(vw[t]) + pp[2 * t + 1] * bfhi(vw[t]); } }
        ATT[(size_t)rowq * 1024 + h * 64 + F.lane] = (bf16)f2bf(o / sum);
        LDS_WAIT(); asm volatile("" ::: "memory");
    }
}

constexpr int ACK_STRIDE = 72, ACV_STRIDE = 264;
constexpr int ALDS_CK = 0, ALDS_CV = 256 * ACK_STRIDE * 2, ALDS_RP = ALDS_CV + 64 * ACV_STRIDE * 2;
struct AttnState { float m, sum; f32x4 o[4]; };
__device__ __forceinline__ float xrow16_max(float x) {
    auto s = __builtin_amdgcn_permlane16_swap(__float_as_uint(x), __float_as_uint(x), false, false);
    x = fmaxf(__uint_as_float(s[0]), __uint_as_float(s[1]));
    auto t = __builtin_amdgcn_permlane32_swap(__float_as_uint(x), __float_as_uint(x), false, false);
    return fmaxf(__uint_as_float(t[0]), __uint_as_float(t[1]));
}
__device__ __forceinline__ float xrow16_sum(float x) {
    auto s = __builtin_amdgcn_permlane16_swap(__float_as_uint(x), __float_as_uint(x), false, false);
    x = __uint_as_float(s[0]) + __uint_as_float(s[1]);
    auto t = __builtin_amdgcn_permlane32_swap(__float_as_uint(x), __float_as_uint(x), false, false);
    return __uint_as_float(t[0]) + __uint_as_float(t[1]);
}
#define MFMA16(a, b, c) __builtin_amdgcn_mfma_f32_16x16x32_bf16((a), (b), (c), 0, 0, 0)
template <int NT>
__device__ __forceinline__ void attn_tail(AttnState& S, f32x4 (&sc)[NT], const u32x4 (&vw)[NT / 2][4]) {
    float cm = -1e30f;
#pragma unroll
    for (int t = 0; t < NT; ++t)
#pragma unroll
        for (int j = 0; j < 4; ++j) cm = fmaxf(cm, sc[t][j]);
    cm = xrow16_max(cm);
    const float mn = fmaxf(S.m, cm), scl = __builtin_amdgcn_exp2f(S.m - mn); S.m = mn; float ps = 0.f;
#pragma unroll
    for (int t = 0; t < NT; ++t)
#pragma unroll
        for (int j = 0; j < 4; ++j) { const float p = __builtin_amdgcn_exp2f(sc[t][j] - mn); sc[t][j] = p; ps += p; }
    S.sum = S.sum * scl + ps;
#pragma unroll
    for (int dt = 0; dt < 4; ++dt) S.o[dt] = S.o[dt] * scl;
#pragma unroll
    for (int ks = 0; ks < NT / 2; ++ks) { u32x4 pw; pw.x = pk2(sc[2 * ks][0], sc[2 * ks][1]); pw.y = pk2(sc[2 * ks][2], sc[2 * ks][3]); pw.z = pk2(sc[2 * ks + 1][0], sc[2 * ks + 1][1]); pw.w = pk2(sc[2 * ks + 1][2], sc[2 * ks + 1][3]);
        const bf16x8 pf = __builtin_bit_cast(bf16x8, pw);
#pragma unroll
        for (int dt = 0; dt < 4; ++dt) S.o[dt] = MFMA16(__builtin_bit_cast(bf16x8, vw[ks][dt]), pf, S.o[dt]); }
}
__device__ __forceinline__ void attn_unit2(const bf16* __restrict__ KQ, const bf16* __restrict__ VT, bf16* __restrict__ ATT, LAS unsigned char* lds,
                                           const int b, const int h, const int rowqA, const int rowqB, const bool win, const int r, const int qt, const int lane) {
    const int l15 = lane & 15, g = lane >> 4;
    const f32x4 z = {0.f, 0.f, 0.f, 0.f};
    bf16x8 qA[2], qB[2];
    { const bf16* qp = KQ + (size_t)(rowqA + l15) * 2048 + 1024 + h * 64 + 8 * g; qA[0] = *(const bf16x8*)qp; qA[1] = *(const bf16x8*)(qp + 32); }
    { const bf16* qp = KQ + (size_t)(rowqB + l15) * 2048 + 1024 + h * 64 + 8 * g; qB[0] = *(const bf16x8*)qp; qB[1] = *(const bf16x8*)(qp + 32); }
    AttnState SA, SB; SA.m = -1e30f; SA.sum = 0.f; SB.m = -1e30f; SB.sum = 0.f;
#pragma unroll
    for (int dt = 0; dt < 4; ++dt) { SA.o[dt] = z; SB.o[dt] = z; }
    if (win) {
        const int rsA = min(max(r - 4, 0), 56), dB = min(max(r - 3, 0), 56) - rsA, kc0 = min(max(16 * qt - 8, 0), 32);
        const int q = 16 * qt + l15, csq = min(max(q - 8, 0), 48);
        const int krow0 = 8 * (l15 >> 2) + (l15 & 3);
        const bf16* kb = KQ + (size_t)(b * SEQ + kc0 + krow0) * 2048 + h * 64 + 8 * g;
        const bf16* vb = VT + (size_t)(b * 1024 + h * 64 + l15) * 4096 + kc0 + 8 * g;
        const LAS float* rp = (const LAS float*)(lds + ALDS_RP);
        const int jb = kc0 + 8 * g;
        const int okb = jb - csq;
        const LAS float* rpl = rp + 16 + (jb - q + 15);
        float madd[2][4];
#pragma unroll
        for (int t = 0; t < 2; ++t)
#pragma unroll
            for (int j = 0; j < 4; ++j) madd[t][j] = ((unsigned)(okb + 4 * t + j) < 16u) ? 0.f : -__builtin_inff();
        bf16x8 K0[2][2], K1[2][2]; u32x4 V0[1][4], V1[1][4];
#define ATT_LOADW(KB, VB, i) do { const int gr_ = min(rsA + (i), 63); const bf16* kp_ = kb + (size_t)(gr_ * 64) * 2048; const bf16* vp_ = vb + gr_ * 64; \
        _Pragma("unroll") for (int t = 0; t < 2; ++t) { KB[t][0] = *(const bf16x8*)(kp_ + (size_t)(4 * t) * 2048); KB[t][1] = *(const bf16x8*)(kp_ + (size_t)(4 * t) * 2048 + 32); } \
        _Pragma("unroll") for (int dt = 0; dt < 4; ++dt) VB[0][dt] = *(const u32x4*)(vp_ + (size_t)(16 * dt) * 4096); } while (0)
#define ATT_ONE(ST, QF, KB, VB, roff, rowok) do { f32x4 sc[2]; \
        _Pragma("unroll") for (int t = 0; t < 2; ++t) { sc[t] = MFMA16(KB[t][0], QF[0], z); sc[t] = MFMA16(KB[t][1], QF[1], sc[t]); } \
        const LAS float* bp_ = rpl + ((rowok) ? (roff) : 15) * 64; \
        _Pragma("unroll") for (int t = 0; t < 2; ++t) _Pragma("unroll") for (int j = 0; j < 4; ++j) sc[t][j] = (sc[t][j] + bp_[4 * t + j]) + madd[t][j]; \
        attn_tail<2>(ST, sc, VB); } while (0)
#define ATT_COMPUTE(KB, VB, i) do { const int roffA_ = min(rsA + (i) - r + 7, 14); \
        ATT_ONE(SA, qA, KB, VB, roffA_, (i) <= 7); \
        ATT_ONE(SB, qB, KB, VB, max(roffA_ - 1, 0), (i) >= dB && (i) <= 7 + dB); } while (0)
        ATT_LOADW(K0, V0, 0);
#pragma unroll 1
        for (int i = 0; i < 8; i += 2) { ATT_LOADW(K1, V1, i + 1); ATT_COMPUTE(K0, V0, i); ATT_LOADW(K0, V0, i + 2); ATT_COMPUTE(K1, V1, i + 1); }
        ATT_COMPUTE(K0, V0, 8);
#undef ATT_LOADW
#undef ATT_ONE
#undef ATT_COMPUTE
    }
    { const LAS bf16* ck = (const LAS bf16*)(lds + ALDS_CK) + l15 * ACK_STRIDE + 8 * g;
      const LAS bf16* cv = (const LAS bf16*)(lds + ALDS_CV) + l15 * ACV_STRIDE + 8 * g;
#pragma unroll 1
      for (int c = 0; c < 4; ++c) {
          bf16x8 kf[4][2]; u32x4 vw[2][4];
#pragma unroll
          for (int t = 0; t < 4; ++t) { const LAS bf16* kp = ck + (64 * c + 16 * t) * ACK_STRIDE; kf[t][0] = *(const LAS bf16x8*)kp; kf[t][1] = *(const LAS bf16x8*)(kp + 32); }
#pragma unroll
          for (int ks = 0; ks < 2; ++ks)
#pragma unroll
              for (int dt = 0; dt < 4; ++dt) vw[ks][dt] = *(const LAS u32x4*)(cv + (16 * dt) * ACV_STRIDE + 64 * c + 32 * ks);
          { f32x4 sc[4];
#pragma unroll
            for (int t = 0; t < 4; ++t) { sc[t] = MFMA16(kf[t][0], qA[0], z); sc[t] = MFMA16(kf[t][1], qA[1], sc[t]); }
            attn_tail<4>(SA, sc, vw); }
          { f32x4 sc[4];
#pragma unroll
            for (int t = 0; t < 4; ++t) { sc[t] = MFMA16(kf[t][0], qB[0], z); sc[t] = MFMA16(kf[t][1], qB[1], sc[t]); }
            attn_tail<4>(SB, sc, vw); }
      } }
    { const float inv = 1.0f / xrow16_sum(SA.sum);
#pragma unroll
      for (int dt = 0; dt < 4; ++dt) st_bf4(ATT + (size_t)(rowqA + l15) * 1024 + h * 64 + 16 * dt + 4 * g, SA.o[dt] * inv); }
    { const float inv = 1.0f / xrow16_sum(SB.sum);
#pragma unroll
      for (int dt = 0; dt < 4; ++dt) st_bf4(ATT + (size_t)(rowqB + l15) * 1024 + h * 64 + 16 * dt + 4 * g, SB.o[dt] * inv); }
}
__device__ __forceinline__ void p_attn_mfma(const Params& P, Frame& F, int l, bool with_ctx_queries) {
    const bf16* KQ = WSP(bf16, WS_KQ); const bf16* VT = WSP(bf16, WS_VT); bf16* ATT = WSP(bf16, WS_ATT);
    const float* rpb = P.rpb + (size_t)l * 16 * 465;
    for (int hp = F.bid; hp < 256; hp += F.G) {
        const int p = hp & 127, half = hp >> 7, b = p >> 4, h = p & 15;
        __syncthreads();
        { LAS bf16* ck = (LAS bf16*)(F.lds + ALDS_CK); LAS bf16* cv = (LAS bf16*)(F.lds + ALDS_CV); LAS float* rp = (LAS float*)(F.lds + ALDS_RP);
          { const int key = F.tid >> 1, hf = F.tid & 1; const int k32 = key & 31, pos = (key & ~31) + ((k32 >> 2) & 1) * 16 + 4 * (k32 >> 3) + (k32 & 3);
            const u32x4* src = (const u32x4*)(KQ + (size_t)(RL + b * CTXL + key) * 2048 + h * 64 + hf * 32); LAS u32x4* dst = (LAS u32x4*)(ck + pos * ACK_STRIDE + hf * 32);
#pragma unroll
            for (int i = 0; i < 4; ++i) dst[i] = src[i]; }
          { const int d = F.tid >> 3, sg = F.tid & 7; const u32x4* src = (const u32x4*)(VT + YT_CTX_OFF + (size_t)(b * 1024 + h * 64 + d) * 256 + sg * 32); LAS u32x4* dst = (LAS u32x4*)(cv + d * ACV_STRIDE + sg * 32);
#pragma unroll
            for (int i = 0; i < 4; ++i) dst[i] = src[i]; }
          for (int i = F.tid; i < 16 * 64; i += NTHREADS) { const int rr = i >> 6, cc = (i & 63) - 16; rp[i] = rr == 15 ? -__builtin_inff() : ((cc >= 0 && cc < 31) ? rpb[h * 465 + rr * 31 + cc] * LOG2E : 0.f); } }
        __syncthreads();
        const int qt = F.wave & 3, rpi = F.wave >> 2;
#pragma unroll 1
        for (int st = 0; st < 8; ++st) { const int r = half * 32 + st * 4 + rpi * 2; const int rowqA = b * SEQ + r * 64 + 16 * qt;
            attn_unit2(KQ, VT, ATT, F.lds, b, h, rowqA, rowqA + 64, true, r, qt, F.lane); }
        if (with_ctx_queries && half == 0) { const int rowqA = RL + b * CTXL + 32 * F.wave; attn_unit2(KQ, VT, ATT, F.lds, b, h, rowqA, rowqA + 16, false, 0, 0, F.lane); }
    }
    __syncthreads();
}

__device__ __forceinline__ void p_pool(Frame& F, int nrows) {
    const bf16* PB = WSP(bf16, WS_PB); bf16* POOL = WSP(bf16, WS_POOL);
    for (int i = F.bid * NTHREADS + F.tid; i < nrows * 64; i += F.G * NTHREADS) {
        const int row = i >> 6, ch = i & 63, g = ch >> 4, hw = 1 << g;
        int base, t, Lb; if (row < RL) { base = row & ~4095; t = row & 4095; Lb = SEQ; } else { const int rr = row - RL; base = RL + (rr & ~255); t = rr & 255; Lb = CTXL; }
        const int lo = max(t - hw, 0), hi = min(t + hw, Lb);
        float a[8];
#pragma unroll
        for (int q = 0; q < 8; ++q) a[q] = 0.f;
        for (int tt = lo; tt < hi; ++tt) { const u32x4 w = *(const u32x4*)(PB + (size_t)(base + tt) * 512 + ch * 8);
#pragma unroll
            for (int q = 0; q < 4; ++q) { a[2 * q] += bflo(w[q]); a[2 * q + 1] += bfhi(w[q]); } }
        const u32x4 me = *(const u32x4*)(PB + (size_t)row * 512 + ch * 8); const float inv = 1.0f / (float)(hi - lo);
        u32x4 o;
#pragma unroll
        for (int q = 0; q < 4; ++q) o[q] = pk2(a[2 * q] * inv - bflo(me[q]), a[2 * q + 1] * inv - bfhi(me[q]));
        *(u32x4*)(POOL + (size_t)row * 512 + ch * 8) = o;
    }
}

__device__ __forceinline__ int block_sum_i(int v, LAS int* sm, int tid) {
#pragma unroll
    for (int o = 1; o < 64; o <<= 1) v += __shfl_xor(v, o);
    __syncthreads();
    if ((tid & 63) == 0) sm[tid >> 6] = v;
    __syncthreads();
    int s = 0;
#pragma unroll
    for (int i = 0; i < 8; ++i) s += sm[i];
    return s;
}
__device__ __forceinline__ int block_excl_scan(int v, LAS int* sm, int tid, int& total) {
    const int lane = tid & 63, w = tid >> 6; int inc = v;
#pragma unroll
    for (int o = 1; o < 64; o <<= 1) { const int t = __shfl_up(inc, o); if (lane >= o) inc += t; }
    __syncthreads();
    if (lane == 63) sm[w] = inc;
    __syncthreads();
    int base = 0; total = 0;
#pragma unroll
    for (int i = 0; i < 8; ++i) { const int s = sm[i]; if (i < w) base += s; total += s; }
    return base + inc - v;
}
template <int NPT>
__device__ __forceinline__ void topk_pair(Frame& F, int row0, int n, int cap, int e, int slot0) {
    LAS int* sm = (LAS int*)F.lds;
    const float* AFF = WSP(float, WS_AFF); int* SROW = WSP(int, WS_SROW); float* SG = WSP(float, WS_SGATE); int* SEL = WSP(int, WS_SEL);
    unsigned key[NPT];
#pragma unroll
    for (int j = 0; j < NPT; ++j) { const int i = F.tid * NPT + j; key[j] = (i < n) ? __float_as_uint(AFF[(size_t)(row0 + i) * 16 + e]) : 0u; }
    unsigned T = 0u;
    for (int bit = 30; bit >= 0; --bit) { const unsigned cand = T | (1u << bit); int cnt = 0;
#pragma unroll
        for (int j = 0; j < NPT; ++j) cnt += (key[j] >= cand) ? 1 : 0;
        cnt = block_sum_i(cnt, sm, F.tid);
        if (cnt >= cap) T = cand; }
    int ngt = 0, neq = 0;
#pragma unroll
    for (int j = 0; j < NPT; ++j) { ngt += (key[j] > T) ? 1 : 0; neq += (key[j] == T) ? 1 : 0; }
    int tot_gt, tot_eq;
    (void)block_excl_scan(ngt, sm, F.tid, tot_gt);
    int eqr = block_excl_scan(neq, sm, F.tid, tot_eq);
    const int need_eq = cap - tot_gt;
    int nsel = 0; bool selj[NPT];
#pragma unroll
    for (int j = 0; j < NPT; ++j) { bool s = key[j] > T; if (key[j] == T && T != 0u) { s = eqr < need_eq; ++eqr; } selj[j] = s; nsel += s ? 1 : 0; }
    int tot_sel; int pos = block_excl_scan(nsel, sm, F.tid, tot_sel);
#pragma unroll
    for (int j = 0; j < NPT; ++j) { const int i = F.tid * NPT + j;
        if (i < n) { const int row = row0 + i;
            if (selj[j]) { const int slot = slot0 + pos; ++pos; SROW[slot] = row; SG[slot] = __uint_as_float(key[j]); SEL[(size_t)row * 16 + e] = slot; }
            else SEL[(size_t)row * 16 + e] = -1; } }
    __syncthreads();
}
__device__ __forceinline__ void p_topk(Frame& F, bool with_ctx) {
    const int npairs = 128 + (with_ctx ? 128 : 0);
    for (int pi = F.bid; pi < npairs; pi += F.G) {
        if (pi < 128) { const int b = pi >> 4, e = pi & 15; topk_pair<8>(F, b * SEQ, SEQ, CAPL, e, e * SLOT_E + b * CAPL); }
        else { const int p2 = pi - 128, b = p2 >> 4, e = p2 & 15; topk_pair<1>(F, RL + b * CTXL, CTXL, CAPC, e, e * SLOT_E + 4096 + b * CAPC); }
    }
}
__device__ __forceinline__ void p_gather(Frame& F, bool with_ctx) {
    const int gw = F.bid * NWAVES + F.wave, NGW = F.G * NWAVES; const bf16* H = WSP(bf16, WS_H); bf16* XG = WSP(bf16, WS_XG); const int* SROW = WSP(int, WS_SROW);
    for (int s = gw; s < NSLOT; s += NGW) { if (!with_ctx && (s % SLOT_E) >= 4096) continue;
        const int row = SROW[s]; const u32x4* src = (const u32x4*)(H + (size_t)row * DM); u32x4* dst = (u32x4*)(XG + (size_t)s * DM);
        dst[F.lane] = src[F.lane]; dst[F.lane + 64] = src[F.lane + 64]; }
}

template <int PH> __global__ void __launch_bounds__(NTHREADS, 2) fwd_kernel(Params P) {
    extern __shared__ __attribute__((aligned(16))) unsigned char lds_raw[];
    Frame F; F.lds = (LAS unsigned char*)lds_raw; F.tid = threadIdx.x; F.lane = F.tid & 63; F.wave = __builtin_amdgcn_readfirstlane(F.tid >> 6); F.G = gridDim.x; F.bid = blockIdx.x; F.ws = P.ws;
    volatile LAS unsigned* MISC = (volatile LAS unsigned*)(F.lds + LDS_MISC);
    if (F.tid < 64) MISC[F.tid] = 0u;
    __syncthreads();
    XcdBarrier bar; bar.bar = WSP(unsigned, WS_CTL) + CW_BAR; bar.x = 0; bar.st = MISC + 8;
    if constexpr (PH < 0) bar = xcd_barrier_post(WSP(unsigned, WS_CTL) + CW_BAR, MISC + 8);
#define IN(k) (PH < 0 || PH == (k))
#define REFRESH() do { int t_ = threadIdx.x; asm volatile("" : "+v"(t_)); F.tid = t_; F.lane = t_ & 63; F.wave = __builtin_amdgcn_readfirstlane(t_ >> 6); } while (0)
#define SEAM(k) do { if constexpr (PH < 0) xcd_barrier(bar); } while (0)

    if (IN(0)) { REP_BEGIN(100) p_mod(P, F); p_dftgen(F); REP_END REP_BEGIN(101) p_wconv(P, F, 0); REP_END }
    SEAM(0);
    if (IN(1)) { p_rowpass_a0(P, F); }
    SEAM(1);
    for (int l = P.l_lo; l < P.l_hi; ++l) {
        constexpr int pb = 2; const bool L0 = (l == 0);
        bf16* H = WSP(bf16, WS_H);
        if (IN(pb + 0)) { REFRESH(); REP_BEGIN(2)
            { GroupSched S; S.init(1, 128, 22, F.G, F.bid, 8, L0 ? 22 : 4, 128, 0);
              const bf16* WA = WSP(bf16, WS_WA);
              auto AD = [=](const Unit& u) { return Operands{H + (size_t)u.pm * 256 * DM, WA + (size_t)u.pn * 256 * DM, DM, DM}; };
              bf16* KQ = WSP(bf16, WS_KQ); bf16* PBp = WSP(bf16, WS_PB); bf16* GB = WSP(bf16, WS_GB);
              auto E = [=](EPI_ARGS) { const int row0 = u.pm * 256;
                  if (u.pn < 8) { const float qs = (u.pn >= 4) ? QSCALE : 1.0f; EPI_FOR( st_bf4(KQ + (size_t)(row0 + r) * 2048 + u.pn * 256 + c, v * qs); ) }
                  else if (u.pn < 10) { EPI_FOR( st_bf4(PBp + (size_t)(row0 + r) * 512 + (u.pn - 8) * 256 + c, v); ) }
                  else { EPI_FOR( f32x4 s; s[0] = sigmoidf_(v[0]); s[1] = sigmoidf_(v[1]); s[2] = sigmoidf_(v[2]); s[3] = sigmoidf_(v[3]); st_bf4(GB + (size_t)(row0 + r) * 3072 + (u.pn - 10) * 256 + c, s); ) } };
              GEMM(S, AD, E, DM, DM, DM); }
            { GroupSched S; S.init(1, 8, 128, F.G, F.bid, L0 ? 8 : 4, 8, L0 ? 0 : 4, 128);
              const bf16* WFV = WSP(bf16, WS_WFV);
              auto AD = [=](const Unit& u) { return Operands{WFV + (size_t)u.pm * 256 * DM, H + (size_t)u.pn * 256 * DM, DM, DM}; };
              bf16* YT = WSP(bf16, WS_YT); bf16* VT = WSP(bf16, WS_VT);
              auto E = [=](EPI_ARGS) { bf16* T = (u.pm < 4) ? YT : VT; const int rr0 = (u.pm & 3) * 256;
                  if (u.pn < 128) { const int b = u.pn >> 4, l0 = (u.pn & 15) * 256; EPI_FOR( st_bf4(T + ((size_t)b * 1024 + rr0 + r) * 4096 + l0 + c, v); ) }
                  else { const int b = u.pn - 128; EPI_FOR( st_bf4(T + YT_CTX_OFF + ((size_t)b * 1024 + rr0 + r) * 256 + c, v); ) } };
              GEMM(S, AD, E, DM, DM, DM); }
        REP_END }
        SEAM(pb + 0);
        if (IN(pb + 1)) { REFRESH();
            REP_BEGIN(31) p_attn_mfma(P, F, l, L0); REP_END
            REP_BEGIN(32)
            { GroupSched S; S.init(1, 16, 16, F.G, F.bid);
              const bf16* DFTM = WSP(bf16, WS_DFTM); const bf16* YT = WSP(bf16, WS_YT); bf16* FOUR = WSP(bf16, WS_FOUR);
              auto AD = [=](const Unit& u) { return Operands{DFTM + (size_t)u.pm * 256 * 8192, YT + (size_t)u.pn * 256 * 8192, 8192, 8192}; };
              auto E = [=](EPI_ARGS) { const int b = u.pn >> 1, c0 = (u.pn & 1) * 256; const float sc = 0.0013810679320049757f;
                  EPI_FOR( st_bf4(FOUR + ((size_t)b * SEQ + u.pm * 256 + r) * 512 + c0 + c, v * sc); ) };
              GEMM(S, AD, E, 8192, 8192, 8192); }
            if (L0) { GroupSched S; S.init(1, 1, 16, F.G, F.bid);
              const bf16* DFTC = WSP(bf16, WS_DFTC); const bf16* YTC = WSP(bf16, WS_YT) + YT_CTX_OFF; bf16* FOUR = WSP(bf16, WS_FOUR);
              auto AD = [=](const Unit& u) { return Operands{DFTC, YTC + (size_t)u.pn * 256 * 512, 512, 512}; };
              auto E = [=](EPI_ARGS) { const int b = u.pn >> 1, c0 = (u.pn & 1) * 256; const float sc = 0.005524271728019903f;
                  EPI_FOR( st_bf4(FOUR + ((size_t)RL + b * CTXL + r) * 512 + c0 + c, v * sc); ) };
              GEMM(S, AD, E, 512, 512, 512); }
            REP_END
            REP_BEGIN(33) p_pool(F, L0 ? RT : RL); REP_END
        }
        SEAM(pb + 1);
        if (IN(pb + 2)) { REFRESH(); REP_BEGIN(4)
            const int nM = L0 ? 136 : 128; float* MRG = WSP(float, WS_MRG); const bf16* GB = WSP(bf16, WS_GB);
            { GroupSched S; S.init(1, nM, 4, F.G, F.bid); const bf16* A = WSP(bf16, WS_ATT); const bf16* W = WSP(bf16, WS_WAO);
              auto AD = [=](const Unit& u) { return Operands{A + (size_t)u.pm * 256 * 1024, W + (size_t)u.pn * 256 * 1024, 1024, 1024}; };
              auto E = [=](EPI_ARGS) { EPI_FOR( const size_t row = (size_t)u.pm * 256 + r; const int col = u.pn * 256 + c; const u32x2 g = *(const u32x2*)(GB + row * 3072 + col);
                  f32x4 o; o[0] = bflo(g.x) * v[0]; o[1] = bfhi(g.x) * v[1]; o[2] = bflo(g.y) * v[2]; o[3] = bfhi(g.y) * v[3]; *(f32x4*)(MRG + row * 1024 + col) = o; ) };
              GEMM(S, AD, E, 1024, 1024, 1024); }
            { GroupSched S; S.init(1, nM, 4, F.G, F.bid); const bf16* A = WSP(bf16, WS_FOUR); const bf16* W = WSP(bf16, WS_WFO);
              auto AD = [=](const Unit& u) { return Operands{A + (size_t)u.pm * 256 * 512, W + (size_t)u.pn * 256 * 512, 512, 512}; };
              auto E = [=](EPI_ARGS) { EPI_FOR( const size_t row = (size_t)u.pm * 256 + r; const int col = u.pn * 256 + c; const u32x2 g = *(const u32x2*)(GB + row * 3072 + 1024 + col);
                  f32x4 o = *(const f32x4*)(MRG + row * 1024 + col); o[0] += bflo(g.x) * v[0]; o[1] += bfhi(g.x) * v[1]; o[2] += bflo(g.y) * v[2]; o[3] += bfhi(g.y) * v[3]; *(f32x4*)(MRG + row * 1024 + col) = o; ) };
              GEMM(S, AD, E, 512, 512, 512); }
            { GroupSched S; S.init(1, nM, 4, F.G, F.bid); const bf16* A = WSP(bf16, WS_POOL); const bf16* W = WSP(bf16, WS_WPO); bf16* MRGB = WSP(bf16, WS_MRGB);
              const float* ps = P.pool_scale + l * 1024;
              auto AD = [=](const Unit& u) { return Operands{A + (size_t)u.pm * 256 * 512 + (u.pn >> 1) * 256, W + (size_t)u.pn * 256 * 256, 512, 256}; };
              auto E = [=](EPI_ARGS) { EPI_FOR( const size_t row = (size_t)u.pm * 256 + r; const int col = u.pn * 256 + c; const u32x2 g = *(const u32x2*)(GB + row * 3072 + 2048 + col);
                  const f32x4 pv = *(const f32x4*)(ps + col); f32x4 o = *(const f32x4*)(MRG + row * 1024 + col);
                  o[0] += bflo(g.x) * pv[0] * v[0]; o[1] += bfhi(g.x) * pv[1] * v[1]; o[2] += bflo(g.y) * pv[2] * v[2]; o[3] += bfhi(g.y) * pv[3] * v[3]; st_bf4(MRGB + row * 1024 + col, o); ) };
              GEMM(S, AD, E, 256, 512, 256); }
        REP_END }
        SEAM(pb + 2);
        if (IN(pb + 3)) { REFRESH();
            GroupSched S; S.init(1, L0 ? 136 : 128, 4, F.G, F.bid); const bf16* A = WSP(bf16, WS_MRGB); const bf16* W = WSP(bf16, WS_WOUT);
            const float* xin = L0 ? P.x : P.out; const float* cin = L0 ? P.ctx : WSP(float, WS_XC); float* xo = P.out; float* co = WSP(float, WS_XC);
            const float* MOD = WSP(float, WS_MOD) + (size_t)l * 9 * 6144;
            auto AD = [=](const Unit& u) { return Operands{A + (size_t)u.pm * 256 * 1024, W + (size_t)u.pn * 256 * 1024, 1024, 1024}; };
            auto E = [=](EPI_ARGS) { EPI_FOR( const int row = u.pm * 256 + r; const int col = u.pn * 256 + c; const int mr = row < RL ? (row >> 12) : 8;
                const f32x4 g = *(const f32x4*)(MOD + (size_t)mr * 6144 + 2048 + col);
                const float* src = row < RL ? xin + (size_t)row * DM + col : cin + (size_t)(row - RL) * DM + col; float* dst = row < RL ? xo + (size_t)row * DM + col : co + (size_t)(row - RL) * DM + col;
                *(f32x4*)dst = *(const f32x4*)src + g * v; ) };
            GEMM(S, AD, E, 1024, 1024, 1024);
        }
        SEAM(pb + 3);
        if (IN(pb + 4)) { REFRESH(); REP_BEGIN(6) p_rowpass_f(P, F, l, L0 ? RT : RL); REP_END }
        SEAM(pb + 4);
        if (IN(pb + 5)) { REFRESH(); REP_BEGIN(7) p_topk(F, L0); REP_END }
        SEAM(pb + 5);
        if (IN(pb + 6)) { REFRESH(); REP_BEGIN(8) p_gather(F, L0); REP_END }
        SEAM(pb + 6);
        if (IN(pb + 7)) { REFRESH(); REP_BEGIN(9)
            GroupSched S; S.init(16, L0 ? 17 : 16, 22, F.G, F.bid); const bf16* XG = WSP(bf16, WS_XG); const bf16* W = WSP(bf16, WS_WGU); bf16* HID = WSP(bf16, WS_HID);
            auto AD = [=](const Unit& u) { return Operands{XG + ((size_t)u.grp * SLOT_E + u.pm * 256) * DM, W + ((size_t)u.grp * 5632 + u.pn * 256) * DM, DM, DM}; };
            auto E = [=](EPI_ARGS) {
#pragma unroll
                for (int ai = 0; ai < 2; ++ai)
#pragma unroll
                    for (int m = 0; m < 4; ++m) { const size_t slot = (size_t)u.grp * SLOT_E + u.pm * 256 + ai * 128 + wr * 64 + m * 16 + fr;
#pragma unroll
                        for (int n = 0; n < 2; ++n) { const f32x4 a = acc[ai][0][m][n], up = acc[ai][1][m][n]; f32x4 o;
#pragma unroll
                            for (int j = 0; j < 4; ++j) o[j] = a[j] * sigmoidf_(a[j]) * up[j];
                            st_bf4(HID + slot * FF + u.pn * 128 + wc * 32 + n * 16 + 4 * fq, o); } } };
            GEMM(S, AD, E, DM, DM, DM);
        REP_END }
        SEAM(pb + 7);
        if (IN(pb + 8)) { REFRESH(); REP_BEGIN(10)
            GroupSched S; S.init(16, L0 ? 17 : 16, 4, F.G, F.bid); const bf16* HID = WSP(bf16, WS_HID); const bf16* W = WSP(bf16, WS_WD); bf16* Y = WSP(bf16, WS_Y); const float* SG = WSP(float, WS_SGATE);
            auto AD = [=](const Unit& u) { return Operands{HID + ((size_t)u.grp * SLOT_E + u.pm * 256) * FF, W + ((size_t)u.grp * 1024 + u.pn * 256) * FF, FF, FF}; };
            auto E = [=](EPI_ARGS) { EPI_FOR( const size_t slot = (size_t)u.grp * SLOT_E + u.pm * 256 + r; const float gt = SG[slot]; st_bf4(Y + slot * DM + u.pn * 256 + c, v * gt); ) };
            GEMM(S, AD, E, FF, FF, FF);
        REP_END }
        SEAM(pb + 8);
        if (IN(pb + 9)) { REFRESH(); p_rowpass_k(P, F, l, L0 ? RT : RL); if (L0) p_wconv(P, F, 1); }
        if (L0) SEAM(pb + 9);
    }
#undef IN
#undef SEAM
}
template <int PH> static void launch_ph(int grid, const Params& p, hipStream_t stream) { hipLaunchKernelGGL(fwd_kernel<PH>, dim3(grid), dim3(NTHREADS), LDS_BYTES, stream, p); }
template <int PH> static bool set_attr() { return hipFuncSetAttribute((const void*)fwd_kernel<PH>, hipFuncAttributeMaxDynamicSharedMemorySize, LDS_BYTES) == hipSuccess; }

extern "C" void kernel_launch(void* const* d_in, const int* in_sizes, int n_in, void* d_out, int out_size, void* d_ws, size_t ws_size, hipStream_t stream) {
    static int grid = 0;
    if (grid == 0) {
        if (n_in != 20 || out_size != RL * DM || ws_size < WS_END) { fprintf(stderr, "kernel_launch: unexpected shapes (n_in %d out %d ws %zu need %zu)\n", n_in, out_size, ws_size, (size_t)WS_END); grid = -1; return; }
        int dev = 0, cus = 0, per_cu = 0;
        if (hipGetDevice(&dev) != hipSuccess || hipDeviceGetAttribute(&cus, hipDeviceAttributeMultiprocessorCount, dev) != hipSuccess) { grid = -1; return; }
#if N_LAUNCH_MODE == 1
        if (!set_attr<-1>()) { fprintf(stderr, "kernel_launch: hipFuncSetAttribute failed\n"); grid = -1; return; }
        if (hipOccupancyMaxActiveBlocksPerMultiprocessor(&per_cu, (const void*)fwd_kernel<-1>, NTHREADS, LDS_BYTES) != hipSuccess || per_cu < 1) fprintf(stderr, "kernel_launch: occupancy query reports %d\n", per_cu);
#else
        if (!(set_attr<0>() && set_attr<1>() && set_attr<2>() && set_attr<3>() && set_attr<4>() && set_attr<5>() && set_attr<6>() && set_attr<7>() && set_attr<8>() && set_attr<9>() && set_attr<10>() && set_attr<11>())) { fprintf(stderr, "kernel_launch: hipFuncSetAttribute failed\n"); grid = -1; return; }
        (void)per_cu;
#endif
        (void)hipGetLastError();
        grid = cus;
    }
    if (grid < 0) return;
    if (hipMemsetAsync((char*)d_ws + WS_CTL, 0, CTL_BYTES, stream) != hipSuccess) return;
    Params p{};
    const float** pp = (const float**)&p;
    for (int i = 0; i < 20; ++i) pp[i] = (const float*)d_in[i];
    p.out = (float*)d_out; p.ws = (unsigned char*)d_ws;
#if N_LAUNCH_MODE == 1
    p.l_lo = 0; p.l_hi = 2;
    launch_ph<-1>(grid, p, stream);
#else
    p.l_lo = 0; p.l_hi = 0; launch_ph<0>(grid, p, stream); launch_ph<1>(grid, p, stream);
    for (int l = 0; l < 2; ++l) { p.l_lo = l; p.l_hi = l + 1;
        launch_ph<2>(grid, p, stream); launch_ph<3>(grid, p, stream); launch_ph<4>(grid, p, stream); launch_ph<5>(grid, p, stream); launch_ph<6>(grid, p, stream);
        launch_ph<7>(grid, p, stream); launch_ph<8>(grid, p, stream); launch_ph<9>(grid, p, stream); launch_ph<10>(grid, p, stream); launch_ph<11>(grid, p, stream); }
#endif
}
```

```cpp
#include <hip/hip_runtime.h>
#include <cstdio>
#include <cstdint>

#ifndef N_LAUNCH_MODE
#define N_LAUNCH_MODE 1
#endif

#define GAS __attribute__((address_space(1)))
#define LAS __attribute__((address_space(3)))
typedef unsigned short bf16;
typedef short bf16x8 __attribute__((ext_vector_type(8)));
typedef float f32x4 __attribute__((ext_vector_type(4)));
typedef unsigned u32x4 __attribute__((ext_vector_type(4)));
typedef unsigned u32x2 __attribute__((ext_vector_type(2)));

constexpr int NB = 8, SEQ = 4096, DM = 1024, CTXL = 256, NH = 16, HD = 64, GRIDW = 64;
constexpr int RL = NB * SEQ, RC = NB * CTXL, RT = RL + RC;
constexpr int INW = 7168, NE = 16, FF = 2816, CAPL = 512, CAPC = 32;
constexpr int SLOT_E = 4352, NSLOT = NE * SLOT_E;
constexpr float RMS_EPS = 1e-6f;
constexpr float LOG2E = 1.4426950408889634f, QSCALE = 0.125f * LOG2E;
constexpr int NWAVES = 8, NTHREADS = 512;

constexpr size_t al256(size_t x) { return (x + 255) & ~(size_t)255; }
constexpr size_t WS_CTL = 0, CTL_BYTES = 1u << 20;
constexpr size_t WS_MOD = WS_CTL + CTL_BYTES;
constexpr size_t WS_XC = al256(WS_MOD + (size_t)2 * 9 * 6144 * 4);
constexpr size_t WS_AFF = al256(WS_XC + (size_t)RC * DM * 4);
constexpr size_t WS_SROW = al256(WS_AFF + (size_t)RT * 16 * 4);
constexpr size_t WS_SGATE = al256(WS_SROW + (size_t)NSLOT * 4);
constexpr size_t WS_SEL = al256(WS_SGATE + (size_t)NSLOT * 4);
constexpr size_t WS_DFTM = al256(WS_SEL + (size_t)RT * 16 * 4);
constexpr size_t WS_DFTC = al256(WS_DFTM + (size_t)4096 * 8192 * 2);
constexpr size_t WS_WA = al256(WS_DFTC + (size_t)256 * 512 * 2);
constexpr size_t WS_WFV = al256(WS_WA + (size_t)5632 * 1024 * 2);
constexpr size_t WS_WAO = al256(WS_WFV + (size_t)2048 * 1024 * 2);
constexpr size_t WS_WFO = al256(WS_WAO + (size_t)1024 * 1024 * 2);
constexpr size_t WS_WPO = al256(WS_WFO + (size_t)1024 * 512 * 2);
constexpr size_t WS_WOUT = al256(WS_WPO + (size_t)1024 * 256 * 2);
constexpr size_t WS_WGU = al256(WS_WOUT + (size_t)1024 * 1024 * 2);
constexpr size_t WS_WD = al256(WS_WGU + (size_t)16 * 5632 * 1024 * 2);
constexpr size_t WS_H = al256(WS_WD + (size_t)16 * 1024 * 2816 * 2);
constexpr size_t WS_R = al256(WS_H + (size_t)RT * DM * 2);
constexpr size_t WS_KQ = WS_R;
constexpr size_t WS_MRG = WS_KQ;
constexpr size_t WS_PB = al256(WS_KQ + (size_t)RT * 2048 * 2);
constexpr size_t WS_GB = al256(WS_PB + (size_t)RT * 512 * 2);
constexpr size_t WS_YT = al256(WS_GB + (size_t)RT * 3072 * 2);
constexpr size_t WS_MRGB = WS_YT;
constexpr size_t WS_VT = al256(WS_YT + (size_t)RT * 1024 * 2);
constexpr size_t WS_FOUR = al256(WS_VT + (size_t)RT * 1024 * 2);
constexpr size_t WS_ATT = al256(WS_FOUR + (size_t)RT * 512 * 2);
constexpr size_t WS_POOL = al256(WS_ATT + (size_t)RT * 1024 * 2);
constexpr size_t WS_MIX_END = al256(WS_POOL + (size_t)RT * 512 * 2);
constexpr size_t WS_XG = WS_R;
constexpr size_t WS_HID = al256(WS_XG + (size_t)NSLOT * 1024 * 2);
constexpr size_t WS_Y = al256(WS_HID + (size_t)NSLOT * 2816 * 2);
constexpr size_t WS_MOE_END = al256(WS_Y + (size_t)NSLOT * 1024 * 2);
constexpr size_t WS_END = WS_MIX_END > WS_MOE_END ? WS_MIX_END : WS_MOE_END;
constexpr size_t YT_CTX_OFF = (size_t)8 * 1024 * 4096;

constexpr int CW_BAR = 4096;

constexpr int LDS_BYTES = 147456;
constexpr int LDS_MISC = 131072;

__device__ __forceinline__ unsigned f2bf(float f) { unsigned u = __float_as_uint(f); return (u + 0x7fffu + ((u >> 16) & 1u)) >> 16; }
typedef __bf16 hbf16x2 __attribute__((ext_vector_type(2)));
typedef float f32x2 __attribute__((ext_vector_type(2)));
__device__ __forceinline__ unsigned pk2(float lo, float hi) { const f32x2 v = {lo, hi}; return __builtin_bit_cast(unsigned, __builtin_convertvector(v, hbf16x2)); }
__device__ __forceinline__ float bf2f(unsigned b) { return __uint_as_float(b << 16); }
__device__ __forceinline__ float bflo(unsigned w) { return __uint_as_float(w << 16); }
__device__ __forceinline__ float bfhi(unsigned w) { return __uint_as_float(w & 0xffff0000u); }
__device__ __forceinline__ float wave_sum(float v) {
#pragma unroll
    for (int o = 1; o < 64; o <<= 1) v += __shfl_xor(v, o);
    return v;
}
__device__ __forceinline__ float wave_max(float v) {
#pragma unroll
    for (int o = 1; o < 64; o <<= 1) v = fmaxf(v, __shfl_xor(v, o));
    return v;
}
__device__ __forceinline__ float sigmoidf_(float x) { return 1.f / (1.f + __expf(-x)); }
#define LDS_WAIT() asm volatile("s_waitcnt lgkmcnt(0)" ::: "memory")

#define XB_TMO      128
#define XB_XCNT(j)  (256  + 64 * (j))
#define XB_XSUB(j)  (1280 + 64 * (j))
#define XB_XGEN(j)  (2304 + 64 * (j))
#define XB_TOP      3328
#define XB_TOPGEN   3392
#define XCD_BAR_WORDS 3456
#define XB_SPIN_CAP (1u << 22)

__device__ __forceinline__ unsigned xb_ld(unsigned* p)              { return __hip_atomic_load(p, __ATOMIC_RELAXED, __HIP_MEMORY_SCOPE_AGENT); }
__device__ __forceinline__ unsigned xb_add(unsigned* p, unsigned v) { return __hip_atomic_fetch_add(p, v, __ATOMIC_RELAXED, __HIP_MEMORY_SCOPE_AGENT); }
__device__ __forceinline__ unsigned xb_xcc_id() { return (unsigned)__builtin_amdgcn_s_getreg((3 << 11) | 20) & 0xFu; }
#define XB_SPIN(cond, bar) do { unsigned _sp = 0; while (cond) { __builtin_amdgcn_s_sleep(1); \
    if ((++_sp & 255u) == 0u) { if (xb_ld(&(bar)[XB_TMO])) break; if (_sp > XB_SPIN_CAP) { atomicAdd(&(bar)[XB_TMO], 1u); break; } } } } while (0)

struct XcdBarrier { unsigned* bar; unsigned x; volatile LAS unsigned* st; };

__device__ __forceinline__ XcdBarrier xcd_barrier_post(unsigned* bar, volatile LAS unsigned* st) {
    XcdBarrier b; b.bar = bar; b.x = xb_xcc_id(); b.st = st;
    if (threadIdx.x == 0) (void)xb_add(&bar[XB_XCNT(b.x)], 1u);
    return b;
}
__device__ __forceinline__ void xcd_barrier_complete(unsigned* bar, unsigned x, unsigned& nloc, unsigned& nx) {
    const unsigned G = gridDim.x * gridDim.y * gridDim.z;
    unsigned sum, cnt, mine, sp = 0u;
    for (;;) {
        sum = 0u; cnt = 0u; mine = 0u;
#pragma unroll
        for (unsigned j = 0; j < 16; ++j) { const unsigned c = xb_ld(&bar[XB_XCNT(j)]); sum += c; cnt += (c > 0u) ? 1u : 0u; mine = (j == x) ? c : mine; }
        if (sum == G) break;
        __builtin_amdgcn_s_sleep(1);
        if ((++sp & 255u) == 0u) { if (xb_ld(&bar[XB_TMO])) break; if (sp > XB_SPIN_CAP) { atomicAdd(&bar[XB_TMO], 1u); break; } }
    }
    nloc = mine > 0u ? mine : 1u; nx = cnt > 0u ? cnt : 1u;
}
__device__ __forceinline__ void xcd_barrier(const XcdBarrier& b) {
    asm volatile("s_waitcnt vmcnt(0)" ::: "memory");
    __syncthreads();
    if (threadIdx.x == 0) {
        unsigned* bar = b.bar;
        __builtin_amdgcn_s_waitcnt(0);
        unsigned nloc = b.st[0], nx = b.st[1];
        if (nloc == 0u) { xcd_barrier_complete(bar, b.x, nloc, nx); b.st[0] = nloc; b.st[1] = nx; }
        const unsigned old = xb_add(&bar[XB_XSUB(b.x)], 1u);
        const unsigned gen = old / nloc;
        if (old + 1u == (gen + 1u) * nloc) {
            __builtin_amdgcn_fence(__ATOMIC_RELEASE, "agent");
            asm volatile("s_waitcnt vmcnt(0)" ::: "memory");
            const unsigned og = xb_add(&bar[XB_TOP], 1u);
            const unsigned tg = og / nx;
            if (og + 1u == (tg + 1u) * nx) xb_add(&bar[XB_TOPGEN], 1u);
            else XB_SPIN(xb_ld(&bar[XB_TOPGEN]) == tg, bar);
            __builtin_amdgcn_fence(__ATOMIC_ACQUIRE, "agent");
            xb_add(&bar[XB_XGEN(b.x)], 1u);
            asm volatile("s_waitcnt vmcnt(0)" ::: "memory");
        } else {
            XB_SPIN(xb_ld(&bar[XB_XGEN(b.x)]) == gen, bar);
            __builtin_amdgcn_fence(__ATOMIC_ACQUIRE, "agent");
            asm volatile("s_waitcnt vmcnt(0)" ::: "memory");
        }
    }
    __syncthreads();
}

struct Params {
    const float *x, *c, *ctx, *c_ctx, *ada_w, *ada_b, *norm1_g, *norm2_g, *w_in, *rpb, *w_att_o, *w_fourier, *w_pool, *pool_scale, *w_out, *w_router, *w_eg, *w_eu, *w_ed, *final_g;
    float* out; unsigned char* ws; int l_lo, l_hi;
};
struct Frame {
    LAS unsigned char* lds;
    int tid, lane, wave, G, bid;
    unsigned char* ws;
};
#define WSP(T, off) ((T*)(F.ws + (off)))

struct Unit { int grp, pm, pn; };
struct GroupSched {
    int ng, nM, nN, G, c; int tM, tN, tpm0, tpn0;
    __device__ __forceinline__ void init(int ng_, int nM_, int nN_, int G_, int c_, int tM_ = 0, int tN_ = 0, int tpm0_ = 0, int tpn0_ = 0) { ng = ng_; nM = nM_; nN = nN_; G = G_; c = c_; tM = tM_; tN = tN_; tpm0 = tpm0_; tpn0 = tpn0_; }
    __device__ __forceinline__ bool next(int i, Unit& u) const {
        const int per = nM * nN; const int L = i * G + c;
        if (L < ng * per) {
            u.grp = L / per; int wgid = L - u.grp * per;
            { const int q = per / 8, r = per % 8, xcd = wgid % 8, off = wgid / 8; wgid = (xcd < r ? xcd * (q + 1) : r * (q + 1) + (xcd - r) * q) + off; }
            const int nig = 8 * nN, gid = wgid / nig, fm = gid * 8, gsz = (nM - fm) < 8 ? (nM - fm) : 8;
            u.pm = fm + ((wgid % nig) % gsz); u.pn = (wgid % nig) / gsz; return true;
        }
        const int w = L - ng * per;
        if (w < tM * tN) { u.grp = ng; u.pm = tpm0 + (w % tM); u.pn = tpn0 + (w / tM); return true; }
        return false;
    }
};
struct Operands { const bf16* A; const bf16* Bt; int lda, ldb; int slot0; };

template <class Addr, class Epi>
__device__ __forceinline__ void gemm_simple(const GroupSched& S, const Addr& AD, const Epi& E, int K) {
    const int tid = threadIdx.x, wid = __builtin_amdgcn_readfirstlane(tid >> 6), lane = tid & 63, wr = wid >> 2, wc = wid & 3, fr = lane & 15, fq = lane >> 4;
    Unit u;
    for (int i = 0; S.next(i, u); ++i) {
        const Operands op = AD(u);
        f32x4 acc[2][2][4][2];
#pragma unroll
        for (int a = 0; a < 2; ++a)
#pragma unroll
            for (int b = 0; b < 2; ++b)
#pragma unroll
                for (int m = 0; m < 4; ++m)
#pragma unroll
                    for (int n = 0; n < 2; ++n) acc[a][b][m][n] = (f32x4){0.f, 0.f, 0.f, 0.f};
        const bf16* ap = op.A + (size_t)(wr * 64 + fr) * op.lda + fq * 8;
        const bf16* bp = op.Bt + (size_t)(wc * 32 + fr) * op.ldb + fq * 8;
#pragma unroll 1
        for (int k = 0; k < K; k += 32) {
            bf16x8 bfr[2][2];
#pragma unroll
            for (int b = 0; b < 2; ++b)
#pragma unroll
                for (int n = 0; n < 2; ++n) bfr[b][n] = *(const bf16x8*)(bp + (size_t)(b * 128 + n * 16) * op.ldb + k);
#pragma unroll
            for (int a = 0; a < 2; ++a) {
                bf16x8 af[4];
#pragma unroll
                for (int m = 0; m < 4; ++m) af[m] = *(const bf16x8*)(ap + (size_t)(a * 128 + m * 16) * op.lda + k);
#pragma unroll
                for (int b = 0; b < 2; ++b)
#pragma unroll
                    for (int m = 0; m < 4; ++m)
#pragma unroll
                        for (int n = 0; n < 2; ++n) acc[a][b][m][n] = __builtin_amdgcn_mfma_f32_16x16x32_bf16(bfr[b][n], af[m], acc[a][b][m][n], 0, 0, 0);
            }
        }
        E(acc, u, wr, wc, fr, fq);
    }
}
constexpr int HTB = 128 * 64 * 2;
__device__ __forceinline__ int lds_byte(int r, int c) { const int st = (r >> 4) * 2 + (c >> 5), rr = r & 15, cc = c & 31, ob = rr * 64 + cc * 2; return st * 1024 + (ob ^ (((ob >> 9) & 1) << 5)); }
__device__ __forceinline__ void stage_rc(int b, int& R, int& C) { const int st = b / 1024, sb = b % 1024, swz = sb ^ (((sb >> 9) & 1) << 5); R = (st >> 1) * 16 + swz / 64; C = (st & 1) * 32 + (swz % 64) / 2; }
template <bool GATHER, class Addr, class Epi>
__device__ __forceinline__ void gemm_fast(LAS unsigned char* lds, const int tid, const GroupSched& S, const Addr& AD, const Epi& E, const int K, const int lda, const int ldb, const int* __restrict__ grows) {
    const int wid = __builtin_amdgcn_readfirstlane(tid >> 6), lane = tid & 63, wr = wid >> 2, wc = wid & 3, fr = lane & 15, fq = lane >> 4;
    const int nt = K / 64;
    unsigned voffB[2]; int sR[2]; unsigned sC[2];
    unsigned cvg[2][2], nvg[2][2];
#pragma unroll
    for (int i = 0; i < 2; ++i) { int R, C; stage_rc(tid * 16 + i * 8192, R, C); sR[i] = R; sC[i] = (unsigned)C * 2u; voffB[i] = (unsigned)(R * ldb + C) * 2u;
        if constexpr (!GATHER) { cvg[0][i] = (unsigned)(R * lda + C) * 2u; cvg[1][i] = (unsigned)((R + 128) * lda + C) * 2u; nvg[0][i] = cvg[0][i]; nvg[1][i] = cvg[1][i]; } }
    const size_t kstep = 128;
    const size_t hstepB = (size_t)128 * ldb * 2;
    const unsigned ldsw = (unsigned)wid * 1024u;
    const int aoff = lds_byte(wr * 64 + fr, fq * 8), boff = lds_byte(wc * 32 + fr, fq * 8);
#define PG8_SA(b, h) (((b) * 2 + (h)) * HTB)
#define PG8_SB(b, h) ((4 + (b) * 2 + (h)) * HTB)
#define PG8_STAGE(bufoff, gbase, voff) do { _Pragma("unroll") for (int _i = 0; _i < 2; ++_i) \
        __builtin_amdgcn_global_load_lds((const unsigned*)((const char*)(gbase) + (voff)[_i]), (LAS unsigned*)(lds + (bufoff) + ldsw + _i * 8192), 16, 0, 0); } while (0)
#define PG8_LDA(dst, b, h) do { _Pragma("unroll") for (int m = 0; m < 4; ++m) _Pragma("unroll") for (int k = 0; k < 2; ++k) dst[m][k] = *(const LAS bf16x8*)(lds + PG8_SA(b, h) + aoff + m * 2048 + k * 1024); } while (0)
#define PG8_LDB(dst, b, h) do { _Pragma("unroll") for (int n = 0; n < 2; ++n) _Pragma("unroll") for (int k = 0; k < 2; ++k) dst[n][k] = *(const LAS bf16x8*)(lds + PG8_SB(b, h) + boff + n * 2048 + k * 1024); } while (0)
#define PG8_MMA(ai, bj, At, Bt) do { __builtin_amdgcn_s_setprio(1); _Pragma("unroll") for (int m = 0; m < 4; ++m) _Pragma("unroll") for (int n = 0; n < 2; ++n) _Pragma("unroll") for (int k = 0; k < 2; ++k) \
        acc[ai][bj][m][n] = __builtin_amdgcn_mfma_f32_16x16x32_bf16(Bt[n][k], At[m][k], acc[ai][bj][m][n], 0, 0, 0); __builtin_amdgcn_s_setprio(0); } while (0)
#define PG8_WAIT_V(n) asm volatile("s_waitcnt vmcnt(" #n ")" ::: "memory")
#define PG8_WAIT_L(n) asm volatile("s_waitcnt lgkmcnt(" #n ")" ::: "memory")
#define PG8_BAR __builtin_amdgcn_s_barrier()
#define PG8_SCHED __builtin_amdgcn_sched_barrier(0)
#define PG8_GIDX(dst, slot0) do { _Pragma("unroll") for (int h_ = 0; h_ < 2; ++h_) _Pragma("unroll") for (int i_ = 0; i_ < 2; ++i_) dst[h_][i_] = (unsigned)grows[(slot0) + h_ * 128 + sR[i_]] * (unsigned)(lda * 2) + sC[i_]; } while (0)
    Unit cur, nxt; int ui = 0;
    if (!S.next(0, cur)) return;
    f32x4 acc[2][2][4][2];
#pragma unroll
    for (int a = 0; a < 2; ++a)
#pragma unroll
        for (int b = 0; b < 2; ++b)
#pragma unroll
            for (int m = 0; m < 4; ++m)
#pragma unroll
                for (int n = 0; n < 2; ++n) acc[a][b][m][n] = (f32x4){0.f, 0.f, 0.f, 0.f};
    bf16x8 At[4][2], B0[2][2], B1[2][2];
    const char* cA; const char* cB;
    { const Operands op = AD(cur); cA = (const char*)op.A; cB = (const char*)op.Bt;
      if constexpr (GATHER) { PG8_GIDX(cvg, op.slot0); Unit u1; if (S.next(1, u1)) { const Operands o1 = AD(u1); PG8_GIDX(nvg, o1.slot0); } else { PG8_GIDX(nvg, op.slot0); } PG8_WAIT_V(0); } }
    PG8_STAGE(PG8_SB(0, 0), cB, voffB); PG8_STAGE(PG8_SB(0, 1), cB + hstepB, voffB); PG8_STAGE(PG8_SA(0, 0), cA, cvg[0]); PG8_STAGE(PG8_SA(0, 1), cA, cvg[1]);
    if (wr == 1) PG8_BAR;
    PG8_WAIT_V(2); PG8_BAR;
    PG8_STAGE(PG8_SB(1, 0), cB + kstep, voffB); PG8_STAGE(PG8_SA(1, 0), cA + kstep, cvg[0]); PG8_STAGE(PG8_SB(1, 1), cB + hstepB + kstep, voffB);
    PG8_WAIT_V(6); PG8_BAR;
    for (;;) {
        const bool has_next = S.next(ui + 1, nxt);
        const char* nA = cA; const char* nB = cB;
        if (has_next) { const Operands op = AD(nxt); nA = (const char*)op.A; nB = (const char*)op.Bt; }
#pragma unroll 1
        for (int t = 0; t < nt; t += 2) {
            const bool last = (t == nt - 2);
            const char* a1 = cA + (size_t)(t + 1) * kstep;
            const char* a2 = last ? nA : cA + (size_t)(t + 2) * kstep; const char* b2 = last ? nB : cB + (size_t)(t + 2) * kstep;
            const char* a3 = a2 + kstep; const char* b3 = b2 + kstep;
            unsigned v2[2][2];
#pragma unroll
            for (int h_ = 0; h_ < 2; ++h_)
#pragma unroll
                for (int i_ = 0; i_ < 2; ++i_) v2[h_][i_] = (GATHER && last) ? nvg[h_][i_] : cvg[h_][i_];
            PG8_LDB(B0, 0, 0); PG8_LDB(B1, 0, 1); PG8_SCHED; PG8_LDA(At, 0, 0); PG8_STAGE(PG8_SA(1, 1), a1, cvg[1]);
            PG8_WAIT_V(8); PG8_WAIT_L(0); PG8_BAR; PG8_MMA(0, 0, At, B0); PG8_MMA(0, 1, At, B1); PG8_BAR; PG8_SCHED;
            PG8_LDA(At, 0, 1); PG8_STAGE(PG8_SB(0, 0), b2, voffB); PG8_STAGE(PG8_SB(0, 1), b2 + hstepB, voffB); PG8_STAGE(PG8_SA(0, 0), a2, v2[0]);
            PG8_WAIT_V(8); PG8_WAIT_L(0); PG8_BAR; PG8_MMA(1, 0, At, B0); PG8_MMA(1, 1, At, B1); PG8_BAR; PG8_SCHED;
            PG8_LDB(B0, 1, 0); PG8_LDB(B1, 1, 1); PG8_SCHED; PG8_LDA(At, 1, 0); PG8_STAGE(PG8_SA(0, 1), a2, v2[1]);
            PG8_WAIT_V(8); PG8_WAIT_L(0); PG8_BAR; PG8_MMA(0, 0, At, B0); PG8_MMA(0, 1, At, B1); PG8_BAR; PG8_SCHED;
            PG8_LDA(At, 1, 1); PG8_STAGE(PG8_SB(1, 0), b3, voffB); PG8_STAGE(PG8_SB(1, 1), b3 + hstepB, voffB); PG8_STAGE(PG8_SA(1, 0), a3, v2[0]);
            PG8_WAIT_V(8); PG8_WAIT_L(0); PG8_BAR; PG8_MMA(1, 0, At, B0); PG8_MMA(1, 1, At, B1); PG8_BAR; PG8_SCHED;
        }
        if (wr == 0) PG8_BAR;
        unsigned fvg[2][2];
        if constexpr (GATHER) { Unit u2; if (S.next(ui + 2, u2)) { const Operands o2 = AD(u2); PG8_GIDX(fvg, o2.slot0); } else { _Pragma("unroll") for (int h_ = 0; h_ < 2; ++h_) _Pragma("unroll") for (int i_ = 0; i_ < 2; ++i_) fvg[h_][i_] = nvg[h_][i_]; } }
        { int fr2 = fr, fq2 = fq; asm volatile("" : "+v"(fr2), "+v"(fq2));
          E(acc, cur, wr, wc, fr2, fq2); }
        if (!has_next) break;
        if constexpr (GATHER) { PG8_WAIT_V(0);
#pragma unroll
            for (int h_ = 0; h_ < 2; ++h_)
#pragma unroll
                for (int i_ = 0; i_ < 2; ++i_) { cvg[h_][i_] = nvg[h_][i_]; nvg[h_][i_] = fvg[h_][i_]; } }
#pragma unroll
        for (int a = 0; a < 2; ++a)
#pragma unroll
            for (int b = 0; b < 2; ++b)
#pragma unroll
                for (int m = 0; m < 4; ++m)
#pragma unroll
                    for (int n = 0; n < 2; ++n) acc[a][b][m][n] = (f32x4){0.f, 0.f, 0.f, 0.f};
        cur = nxt; cA = nA; cB = nB; ++ui;
        if (wr == 1) PG8_BAR;
    }
    PG8_WAIT_V(0);
    PG8_BAR;
#undef PG8_SA
#undef PG8_SB
#undef PG8_STAGE
#undef PG8_LDA
#undef PG8_LDB
#undef PG8_MMA
#undef PG8_WAIT_V
#undef PG8_WAIT_L
#undef PG8_BAR
#undef PG8_SCHED
#undef PG8_GIDX
}
#ifndef DUP_PH
#define DUP_PH -1
#endif
#define REP_BEGIN(k) _Pragma("unroll 1") for (int rep_ = 0; rep_ < ((DUP_PH == (k)) ? 2 : 1); ++rep_) { if (rep_) { if constexpr (PH < 0) xcd_barrier(bar); }
#define REP_END }
#ifndef USE_FAST
#define USE_FAST 1
#endif
#if USE_FAST
#define GEMM(S, AD, E, K, lda, ldb) gemm_fast<false>(F.lds, F.tid, S, AD, E, K, lda, ldb, nullptr)
#define GEMM_GATHER(S, AD, E, K, lda, ldb, rows) gemm_fast<true>(F.lds, F.tid, S, AD, E, K, lda, ldb, rows)
#else
#define GEMM(S, AD, E, K, lda, ldb) gemm_simple(S, AD, E, K)
#endif
#define EPI_ARGS const f32x4 (&acc)[2][2][4][2], const Unit& u, int wr, int wc, int fr, int fq
#define EPI_FOR(BODY) _Pragma("unroll") for (int ai = 0; ai < 2; ++ai) _Pragma("unroll") for (int m = 0; m < 4; ++m) { const int r = ai * 128 + wr * 64 + m * 16 + fr; \
    _Pragma("unroll") for (int bj = 0; bj < 2; ++bj) _Pragma("unroll") for (int n = 0; n < 2; ++n) { const int c = bj * 128 + wc * 32 + n * 16 + 4 * fq; const f32x4 v = acc[ai][bj][m][n]; BODY } }
__device__ __forceinline__ void st_bf4(bf16* p, f32x4 v) { u32x2 w; w.x = pk2(v[0], v[1]); w.y = pk2(v[2], v[3]); *(u32x2*)p = w; }

__device__ __forceinline__ void p_mod(const Params& P, Frame& F) {
    LAS float* sc = (LAS float*)F.lds;
    LAS float* red = (LAS float*)(F.lds + 9 * 1024 * 4);
    float* MOD = WSP(float, WS_MOD);
    bool have = false;
    for (int it = F.bid; it < 2 * 96; it += F.G) {
        if (!have) {
            for (int i = F.tid; i < 9 * 1024; i += NTHREADS) { const int r = i >> 10, k = i & 1023; const float v = r < 8 ? P.c[r * 1024 + k] : P.c_ctx[k]; sc[i] = v * sigmoidf_(v); }
            have = true;
        }
        __syncthreads();
        const int l = it / 96, j0 = (it % 96) * 64, jj = F.tid & 63, kc = F.tid >> 6;
        const float* W = P.ada_w + (size_t)l * 1024 * 6144 + j0 + jj;
        float a[9];
#pragma unroll
        for (int r = 0; r < 9; ++r) a[r] = 0.f;
        for (int k = kc * 128; k < kc * 128 + 128; ++k) { const float w = W[(size_t)k * 6144];
#pragma unroll
            for (int r = 0; r < 9; ++r) a[r] += sc[r * 1024 + k] * w; }
#pragma unroll
        for (int r = 0; r < 9; ++r) red[(kc * 9 + r) * 64 + jj] = a[r];
        __syncthreads();
        for (int o = F.tid; o < 9 * 64; o += NTHREADS) { const int r = o >> 6, j = o & 63; float s = 0.f;
#pragma unroll
            for (int q = 0; q < 8; ++q) s += red[(q * 9 + r) * 64 + j];
            MOD[((size_t)l * 9 + r) * 6144 + j0 + j] = s + P.ada_b[l * 6144 + j0 + j]; }
    }
    __syncthreads();
}
__device__ __forceinline__ void p_dftgen(Frame& F) {
    LAS float* tab = (LAS float*)F.lds;
    for (int j = F.tid; j < 4096; j += NTHREADS) tab[j] = cospif((float)j * (1.0f / 2048.0f));
    __syncthreads();
    bf16* DM_ = WSP(bf16, WS_DFTM); bf16* DC_ = WSP(bf16, WS_DFTC);
    const int nchunk = 4096 * 1024 + 256 * 64;
    for (int ch = F.bid * NTHREADS + F.tid; ch < nchunk; ch += F.G * NTHREADS) {
        float v[8]; bf16* dst;
        if (ch < 4096 * 1024) { const int kf = ch >> 10, col0 = (ch & 1023) * 8, cs = col0 >> 12, l0 = col0 & 4095;
#pragma unroll
            for (int i = 0; i < 8; ++i) { const int j = (kf * (l0 + i)) & 4095; v[i] = cs ? -tab[(j + 3072) & 4095] : tab[j]; }
            dst = DM_ + (size_t)kf * 8192 + col0; }
        else { const int c2 = ch - 4096 * 1024, kf = c2 >> 6, col0 = (c2 & 63) * 8, cs = col0 >> 8, l0 = col0 & 255;
#pragma unroll
            for (int i = 0; i < 8; ++i) { const int j = ((kf * (l0 + i)) & 255) * 16; v[i] = cs ? -tab[(j + 3072) & 4095] : tab[j]; }
            dst = DC_ + (size_t)kf * 512 + col0; }
        u32x4 o; o.x = pk2(v[0], v[1]); o.y = pk2(v[2], v[3]); o.z = pk2(v[4], v[5]); o.w = pk2(v[6], v[7]);
        *(u32x4*)dst = o;
    }
    __syncthreads();
}
__device__ __forceinline__ void transpose_item(const float* W, int ldw, int k0, int n0, bf16* WT, int ldt, int drow0, LAS float* scr, int lane) {
    f32x4 ld[8];
#pragma unroll
    for (int i = 0; i < 8; ++i) ld[i] = *(const f32x4*)(W + (size_t)(k0 + 8 * i + (lane >> 3)) * ldw + n0 + 4 * (lane & 7));
#pragma unroll
    for (int i = 0; i < 8; ++i) { LAS float* d = scr + (8 * i + (lane >> 3)) * 33 + 4 * (lane & 7); d[0] = ld[i][0]; d[1] = ld[i][1]; d[2] = ld[i][2]; d[3] = ld[i][3]; }
    LDS_WAIT(); asm volatile("" ::: "memory");
    const int c = lane & 7;
#pragma unroll
    for (int j = 0; j < 4; ++j) { const int n = (lane >> 3) + 8 * j; const LAS float* s = scr + (8 * c) * 33 + n;
        u32x4 o; o.x = pk2(s[0 * 33], s[1 * 33]); o.y = pk2(s[2 * 33], s[3 * 33]); o.z = pk2(s[4 * 33], s[5 * 33]); o.w = pk2(s[6 * 33], s[7 * 33]);
        *(u32x4*)(WT + (size_t)(drow0 + n) * ldt + k0 + 8 * c) = o; }
    LDS_WAIT(); asm volatile("" ::: "memory");
}
__device__ __forceinline__ void p_wconv(const Params& P, Frame& F, int l) {
    LAS float* scr = (LAS float*)(F.lds + F.wave * 16384);
    const int gw = F.bid * NWAVES + F.wave, NGW = F.G * NWAVES;
    const float* w_in = P.w_in + (size_t)l * 1024 * INW;
    bf16* WA = WSP(bf16, WS_WA); bf16* WFV = WSP(bf16, WS_WFV);
    constexpr int I_K = 16 * 32, I_Q = 16 * 32, I_P = 16 * 16, I_G = 16 * 96, I_V = 16 * 32, I_AO = 16 * 32, I_FO = 8 * 32, I_OUT = 16 * 32;
    constexpr int NSM = I_K + I_Q + I_P + I_G + I_V + I_AO + I_FO + I_OUT;
    for (int it = gw; it < NSM; it += NGW) {
        int r = it;
        if (r < I_K) { transpose_item(w_in, INW, (r / 32) * 64, 0 + (r % 32) * 32, WA, 1024, 0 + (r % 32) * 32, scr, F.lane); continue; } r -= I_K;
        if (r < I_Q) { transpose_item(w_in, INW, (r / 32) * 64, 2048 + (r % 32) * 32, WA, 1024, 1024 + (r % 32) * 32, scr, F.lane); continue; } r -= I_Q;
        if (r < I_P) { transpose_item(w_in, INW, (r / 16) * 64, 3584 + (r % 16) * 32, WA, 1024, 2048 + (r % 16) * 32, scr, F.lane); continue; } r -= I_P;
        if (r < I_G) { transpose_item(w_in, INW, (r / 96) * 64, 4096 + (r % 96) * 32, WA, 1024, 2560 + (r % 96) * 32, scr, F.lane); continue; } r -= I_G;
        if (r < I_V) { transpose_item(w_in, INW, (r / 32) * 64, 1024 + (r % 32) * 32, WFV, 1024, 1024 + (r % 32) * 32, scr, F.lane); continue; } r -= I_V;
        if (r < I_AO) { transpose_item(P.w_att_o + (size_t)l * 1024 * 1024, 1024, (r / 32) * 64, (r % 32) * 32, WSP(bf16, WS_WAO), 1024, (r % 32) * 32, scr, F.lane); continue; } r -= I_AO;
        if (r < I_FO) { transpose_item(P.w_fourier + (size_t)l * 512 * 1024, 1024, (r / 32) * 64, (r % 32) * 32, WSP(bf16, WS_WFO), 512, (r % 32) * 32, scr, F.lane); continue; } r -= I_FO;
        transpose_item(P.w_out + (size_t)l * 1024 * 1024, 1024, (r / 32) * 64, (r % 32) * 32, WSP(bf16, WS_WOUT), 1024, (r % 32) * 32, scr, F.lane);
    }
    constexpr int I_E = 16 * 88;
    bf16* WGU = WSP(bf16, WS_WGU); bf16* WD = WSP(bf16, WS_WD);
    for (int it = gw; it < 3 * 16 * I_E; it += NGW) {
        const int which = it / (16 * I_E), r0 = it % (16 * I_E), e = r0 / I_E, r = r0 % I_E;
        if (which < 2) { const int kb = r / 88, nb = r % 88, n0 = nb * 32;
            const float* src = (which == 0 ? P.w_eg : P.w_eu) + ((size_t)l * 16 + e) * 1024 * FF;
            transpose_item(src, FF, kb * 64, n0, WGU + (size_t)e * 5632 * 1024, 1024, (n0 >> 7) * 256 + (which ? 128 : 0) + (n0 & 127), scr, F.lane); }
        else { const int kb = r / 32, nb = r % 32;
            transpose_item(P.w_ed + ((size_t)l * 16 + e) * FF * 1024, 1024, kb * 64, nb * 32, WD + (size_t)e * 1024 * FF, FF, nb * 32, scr, F.lane); }
    }
    { bf16* WPO = WSP(bf16, WS_WPO); const float* wp = P.w_pool + (size_t)l * 4 * 128 * 256;
      for (int i = F.bid * NTHREADS + F.tid; i < 1024 * 256; i += F.G * NTHREADS) { const int n = i >> 8, kk = i & 255, g = n >> 8, f = n & 255;
          WPO[i] = (bf16)(((kk >> 7) == (g & 1)) ? f2bf(wp[((size_t)g * 128 + (kk & 127)) * 256 + f]) : 0u); } }
    { LAS float* t128 = (LAS float*)F.lds;
      __syncthreads();
      for (int j = F.tid; j < 128; j += NTHREADS) t128[j] = cospif((float)j * (1.0f / 64.0f));
      __syncthreads();
      for (int i = F.bid * NTHREADS + F.tid; i < 1024 * 1024; i += F.G * NTHREADS) { const int fc = i >> 10, k = i & 1023, cs = fc & 1, gm = fc >> 1, g = gm >> 7, m = gm & 127;
          const float* src = w_in + (size_t)k * INW + 3072 + g * 128; float s = 0.f; const int ph = cs ? 96 : 0;
          for (int c = 0; c < 128; ++c) s += src[c] * t128[(m * c + ph) & 127];
          WFV[i] = (bf16)f2bf(s); }
      __syncthreads(); }
}

struct RowMod { const float* g; const float* sh; const float* sc; };
__device__ __forceinline__ void row_load(const float* row, int lane, f32x4 (&v)[4]) {
#pragma unroll
    for (int j = 0; j < 4; ++j) v[j] = *(const f32x4*)(row + 4 * lane + 256 * j);
}
__device__ __forceinline__ float row_rstd(const f32x4 (&v)[4]) {
    float s = 0.f;
#pragma unroll
    for (int j = 0; j < 4; ++j) s += (v[j][0] * v[j][0] + v[j][1] * v[j][1]) + (v[j][2] * v[j][2] + v[j][3] * v[j][3]);
    return rsqrtf(wave_sum(s) * (1.0f / 1024.0f) + RMS_EPS);
}
__device__ __forceinline__ void row_modulate(const f32x4 (&v)[4], float rstd, const RowMod& M, int lane, f32x4 (&y)[4]) {
#pragma unroll
    for (int j = 0; j < 4; ++j) { const int k = 4 * lane + 256 * j; const f32x4 g = *(const f32x4*)(M.g + k), sh = *(const f32x4*)(M.sh + k), sc = *(const f32x4*)(M.sc + k);
        y[j] = v[j] * rstd * g * (sc + 1.0f) + sh; }
}
__device__ __forceinline__ void row_store_bf(bf16* row, int lane, const f32x4 (&y)[4]) {
#pragma unroll
    for (int j = 0; j < 4; ++j) st_bf4(row + 4 * lane + 256 * j, y[j]);
}
__device__ __forceinline__ const float* mod_ptr(Frame& F, int l, int row, int which) { const int mr = row < RL ? (row >> 12) : 8; return WSP(float, WS_MOD) + ((size_t)l * 9 + mr) * 6144 + which * 1024; }

__device__ __forceinline__ void p_rowpass_a0(const Params& P, Frame& F) {
    const int gw = F.bid * NWAVES + F.wave, NGW = F.G * NWAVES; bf16* H = WSP(bf16, WS_H);
    for (int row = gw; row < RT; row += NGW) {
        const float* src = row < RL ? P.x + (size_t)row * DM : P.ctx + (size_t)(row - RL) * DM;
        f32x4 v[4], y[4]; row_load(src, F.lane, v); const float rs = row_rstd(v);
        RowMod M{P.norm1_g, mod_ptr(F, 0, row, 0), mod_ptr(F, 0, row, 1)};
        row_modulate(v, rs, M, F.lane, y); row_store_bf(H + (size_t)row * DM, F.lane, y);
    }
}
__device__ __forceinline__ void p_rowpass_f(const Params& P, Frame& F, int l, int nrows) {
    const int gw = F.bid * NWAVES + F.wave, NGW = F.G * NWAVES; bf16* H = WSP(bf16, WS_H); float* AFF = WSP(float, WS_AFF);
    const float* wr = P.w_router + (size_t)l * 1024 * 16;
    LAS float* wl = (LAS float*)F.lds;
    __syncthreads();
    for (int i = F.tid; i < 16384; i += NTHREADS) wl[(i & 15) * 1024 + (i >> 4)] = wr[i];
    __syncthreads();
    for (int row = gw; row < nrows; row += NGW) {
        const float* src = row < RL ? P.out + (size_t)row * DM : WSP(float, WS_XC) + (size_t)(row - RL) * DM;
        f32x4 v[4], y[4]; row_load(src, F.lane, v); const float rs = row_rstd(v);
        RowMod M{P.norm2_g + l * 1024, mod_ptr(F, l, row, 3), mod_ptr(F, l, row, 4)};
        row_modulate(v, rs, M, F.lane, y); row_store_bf(H + (size_t)row * DM, F.lane, y);
        float lg[16];
        int wo = 4 * F.lane; asm volatile("" : "+v"(wo));
#pragma unroll
        for (int e = 0; e < 16; ++e) { float a = 0.f;
#pragma unroll
            for (int j = 0; j < 4; ++j) { const f32x4 w = *(const LAS f32x4*)(wl + e * 1024 + wo + 256 * j); a += (y[j][0] * w[0] + y[j][1] * w[1]) + (y[j][2] * w[2] + y[j][3] * w[3]); }
            lg[e] = a; }
        float mx = -1e30f;
#pragma unroll
        for (int e = 0; e < 16; ++e) { lg[e] = wave_sum(lg[e]); mx = fmaxf(mx, lg[e]); }
        float den = 0.f;
#pragma unroll
        for (int e = 0; e < 16; ++e) { lg[e] = __expf(lg[e] - mx); den += lg[e]; }
        const float inv = 1.0f / den;
        if (F.lane < 16) { float mine = 0.f;
#pragma unroll
            for (int e = 0; e < 16; ++e) mine = (F.lane == e) ? lg[e] : mine;
            AFF[(size_t)row * 16 + F.lane] = mine * inv; }
    }
    __syncthreads();
}
__device__ __forceinline__ void p_rowpass_k(const Params& P, Frame& F, int l, int nrows) {
    const int gw = F.bid * NWAVES + F.wave, NGW = F.G * NWAVES; bf16* H = WSP(bf16, WS_H);
    const int* SEL = WSP(int, WS_SEL); const bf16* Y = WSP(bf16, WS_Y);
    for (int row = gw; row < nrows; row += NGW) {
        float* xr = row < RL ? P.out + (size_t)row * DM : WSP(float, WS_XC) + (size_t)(row - RL) * DM;
        f32x4 v[4], a[4]; row_load(xr, F.lane, v);
#pragma unroll
        for (int j = 0; j < 4; ++j) a[j] = (f32x4){0.f, 0.f, 0.f, 0.f};
        for (int e = 0; e < 16; ++e) { const int s = SEL[(size_t)row * 16 + e];
            if (s >= 0) { const bf16* yr = Y + (size_t)s * DM;
#pragma unroll
                for (int j = 0; j < 4; ++j) { const u32x2 w = *(const u32x2*)(yr + 4 * F.lane + 256 * j); a[j][0] += bflo(w.x); a[j][1] += bfhi(w.x); a[j][2] += bflo(w.y); a[j][3] += bfhi(w.y); } } }
        const float* g2 = mod_ptr(F, l, row, 5);
#pragma unroll
        for (int j = 0; j < 4; ++j) { const f32x4 g = *(const f32x4*)(g2 + 4 * F.lane + 256 * j); v[j] = v[j] + g * a[j]; }
        const float rs = row_rstd(v);
        if (l == 0) {
#pragma unroll
            for (int j = 0; j < 4; ++j) *(f32x4*)(xr + 4 * F.lane + 256 * j) = v[j];
            f32x4 y[4]; RowMod M{P.norm1_g + 1024, mod_ptr(F, 1, row, 0), mod_ptr(F, 1, row, 1)};
            row_modulate(v, rs, M, F.lane, y); row_store_bf(H + (size_t)row * DM, F.lane, y);
        } else {
#pragma unroll
            for (int j = 0; j < 4; ++j) { const f32x4 g = *(const f32x4*)(P.final_g + 4 * F.lane + 256 * j); *(f32x4*)(xr + 4 * F.lane + 256 * j) = v[j] * rs * g; }
        }
    }
}

__device__ __forceinline__ float dot64(const bf16x8 (&q)[8], const bf16* kp) {
    float s = 0.f;
#pragma unroll
    for (int i = 0; i < 8; ++i) { const u32x4 kw = *(const u32x4*)(kp + 8 * i); const u32x4 qw = __builtin_bit_cast(u32x4, q[i]);
#pragma unroll
        for (int t = 0; t < 4; ++t) s += bflo(kw[t]) * bflo(qw[t]) + bfhi(kw[t]) * bfhi(qw[t]); }
    return s;
}
__device__ __forceinline__ void p_attn_naive(const Params& P, Frame& F, int l, bool with_ctx_queries) {
    const int gw = F.bid * NWAVES + F.wave, NGW = F.G * NWAVES;
    const bf16* KQ = WSP(bf16, WS_KQ); const bf16* VT = WSP(bf16, WS_VT); bf16* ATT = WSP(bf16, WS_ATT);
    LAS float* pw = (LAS float*)(F.lds + F.wave * 2048);
    const float* rpb = P.rpb + (size_t)l * 16 * 15 * 31;
    const int nlat = NB * 64 * NH * 64, nitems = nlat + (with_ctx_queries ? NB * NH * CTXL : 0);
    for (int it = gw; it < nitems; it += NGW) {
        const bool lat = it < nlat;
        int b, h, r = 0, qc = 0, rowq;
        if (lat) { qc = it & 63; h = (it >> 6) & 15; r = (it >> 10) & 63; b = it >> 16; rowq = b * SEQ + r * 64 + qc; }
        else { const int i2 = it - nlat; qc = i2 & 255; h = (i2 >> 8) & 15; b = i2 >> 12; rowq = RL + b * CTXL + qc; }
        bf16x8 q[8];
        { const bf16* qp = KQ + (size_t)rowq * 2048 + 1024 + h * 64;
#pragma unroll
          for (int i = 0; i < 8; ++i) q[i] = *(const bf16x8*)(qp + 8 * i); }
        const int rs = min(max(r - 4, 0), 56), cs = min(max(qc - 8, 0), 48);
        float s[6];
        if (lat) {
#pragma unroll
            for (int t = 0; t < 2; ++t) { const int w = F.lane + 64 * t, i = w >> 4, j = w & 15; const int tok = (rs + i) * 64 + cs + j;
                s[t] = dot64(q, KQ + (size_t)(b * SEQ + tok) * 2048 + h * 64) * 0.125f + rpb[(h * 15 + (rs + i - r + 7)) * 31 + (cs + j - qc + 15)]; }
        } else { s[0] = -1e30f; s[1] = -1e30f; }
#pragma unroll
        for (int t = 0; t < 4; ++t) { const int c = F.lane + 64 * t; s[2 + t] = dot64(q, KQ + (size_t)(RL + b * CTXL + c) * 2048 + h * 64) * 0.125f; }
        float mx = s[0];
#pragma unroll
        for (int t = 1; t < 6; ++t) mx = fmaxf(mx, s[t]);
        mx = wave_max(mx);
        float sum = 0.f;
#pragma unroll
        for (int t = 0; t < 6; ++t) { s[t] = (lat || t >= 2) ? __expf(s[t] - mx) : 0.f; sum += s[t]; }
        sum = wave_sum(sum);
        pw[F.lane] = s[0]; pw[F.lane + 64] = s[1];
#pragma unroll
        for (int t = 0; t < 4; ++t) pw[128 + F.lane + 64 * t] = s[2 + t];
        LDS_WAIT(); asm volatile("" ::: "memory");
        float o = 0.f;
        if (lat) { const bf16* vr = VT + ((size_t)b * 1024 + h * 64 + F.lane) * 4096;
#pragma unroll 2
            for (int w = 0; w < 128; ++w) { const int tok = (rs + (w >> 4)) * 64 + cs + (w & 15); o += pw[w] * bf2f(vr[tok]); } }
        { const bf16* vr = VT + YT_CTX_OFF + ((size_t)b * 1024 + h * 64 + F.lane) * 256;
#pragma unroll 2
          for (int c8 = 0; c8 < 32; ++c8) { const u32x4 vw = *(const u32x4*)(vr + 8 * c8); const LAS float* pp = pw + 128 + 8 * c8;
#pragma unroll
              for (int t = 0; t < 4; ++t) o += pp[2 * t] * bflo(vw[t]) + pp[2 * t + 1] * bfhi(vw[t]); } }
        ATT[(size_t)rowq * 1024 + h * 64 + F.lane] = (bf16)f2bf(o / sum);
        LDS_WAIT(); asm volatile("" ::: "memory");
    }
}

constexpr int ACK_STRIDE = 72, ACV_STRIDE = 264;
constexpr int ALDS_CK = 0, ALDS_CV = 256 * ACK_STRIDE * 2, ALDS_RP = ALDS_CV + 64 * ACV_STRIDE * 2;
struct AttnState { float m, sum; f32x4 o[4]; };
__device__ __forceinline__ float xrow16_max(float x) {
    auto s = __builtin_amdgcn_permlane16_swap(__float_as_uint(x), __float_as_uint(x), false, false);
    x = fmaxf(__uint_as_float(s[0]), __uint_as_float(s[1]));
    auto t = __builtin_amdgcn_permlane32_swap(__float_as_uint(x), __float_as_uint(x), false, false);
    return fmaxf(__uint_as_float(t[0]), __uint_as_float(t[1]));
}
__device__ __forceinline__ float xrow16_sum(float x) {
    auto s = __builtin_amdgcn_permlane16_swap(__float_as_uint(x), __float_as_uint(x), false, false);
    x = __uint_as_float(s[0]) + __uint_as_float(s[1]);
    auto t = __builtin_amdgcn_permlane32_swap(__float_as_uint(x), __float_as_uint(x), false, false);
    return __uint_as_float(t[0]) + __uint_as_float(t[1]);
}
#define MFMA16(a, b, c) __builtin_amdgcn_mfma_f32_16x16x32_bf16((a), (b), (c), 0, 0, 0)
template <int NT>
__device__ __forceinline__ void attn_tail(AttnState& S, f32x4 (&sc)[NT], const u32x4 (&vw)[NT / 2][4]) {
    float cm = -1e30f;
#pragma unroll
    for (int t = 0; t < NT; ++t)
#pragma unroll
        for (int j = 0; j < 4; ++j) cm = fmaxf(cm, sc[t][j]);
    cm = xrow16_max(cm);
    const float mn = fmaxf(S.m, cm), scl = __builtin_amdgcn_exp2f(S.m - mn); S.m = mn; float ps = 0.f;
#pragma unroll
    for (int t = 0; t < NT; ++t)
#pragma unroll
        for (int j = 0; j < 4; ++j) { const float p = __builtin_amdgcn_exp2f(sc[t][j] - mn); sc[t][j] = p; ps += p; }
    S.sum = S.sum * scl + ps;
#pragma unroll
    for (int dt = 0; dt < 4; ++dt) S.o[dt] = S.o[dt] * scl;
#pragma unroll
    for (int ks = 0; ks < NT / 2; ++ks) { u32x4 pw; pw.x = pk2(sc[2 * ks][0], sc[2 * ks][1]); pw.y = pk2(sc[2 * ks][2], sc[2 * ks][3]); pw.z = pk2(sc[2 * ks + 1][0], sc[2 * ks + 1][1]); pw.w = pk2(sc[2 * ks + 1][2], sc[2 * ks + 1][3]);
        const bf16x8 pf = __builtin_bit_cast(bf16x8, pw);
#pragma unroll
        for (int dt = 0; dt < 4; ++dt) S.o[dt] = MFMA16(__builtin_bit_cast(bf16x8, vw[ks][dt]), pf, S.o[dt]); }
}
__device__ __forceinline__ void attn_unit2(const bf16* __restrict__ KQ, const bf16* __restrict__ VT, bf16* __restrict__ ATT, LAS unsigned char* lds,
                                           const int b, const int h, const int rowqA, const int rowqB, const bool win, const int r, const int qt, const int lane) {
    const int l15 = lane & 15, g = lane >> 4;
    const f32x4 z = {0.f, 0.f, 0.f, 0.f};
    bf16x8 qA[2], qB[2];
    { const bf16* qp = KQ + (size_t)(rowqA + l15) * 2048 + 1024 + h * 64 + 8 * g; qA[0] = *(const bf16x8*)qp; qA[1] = *(const bf16x8*)(qp + 32); }
    { const bf16* qp = KQ + (size_t)(rowqB + l15) * 2048 + 1024 + h * 64 + 8 * g; qB[0] = *(const bf16x8*)qp; qB[1] = *(const bf16x8*)(qp + 32); }
    AttnState SA, SB; SA.m = -1e30f; SA.sum = 0.f; SB.m = -1e30f; SB.sum = 0.f;
#pragma unroll
    for (int dt = 0; dt < 4; ++dt) { SA.o[dt] = z; SB.o[dt] = z; }
    if (win) {
        const int rsA = min(max(r - 4, 0), 56), dB = min(max(r - 3, 0), 56) - rsA, kc0 = min(max(16 * qt - 8, 0), 32);
        const int q = 16 * qt + l15, csq = min(max(q - 8, 0), 48);
        const int krow0 = 8 * (l15 >> 2) + (l15 & 3);
        const bf16* kb = KQ + (size_t)(b * SEQ + kc0 + krow0) * 2048 + h * 64 + 8 * g;
        const bf16* vb = VT + (size_t)(b * 1024 + h * 64 + l15) * 4096 + kc0 + 8 * g;
        const LAS float* rp = (const LAS float*)(lds + ALDS_RP);
        const int jb = kc0 + 8 * g;
        const int okb = jb - csq;
        const LAS float* rpl = rp + 16 + (jb - q + 15);
        float madd[2][4];
#pragma unroll
        for (int t = 0; t < 2; ++t)
#pragma unroll
            for (int j = 0; j < 4; ++j) madd[t][j] = ((unsigned)(okb + 4 * t + j) < 16u) ? 0.f : -__builtin_inff();
        bf16x8 K0[2][2], K1[2][2]; u32x4 V0[1][4], V1[1][4];
#define ATT_LOADW(KB, VB, i) do { const int gr_ = min(rsA + (i), 63); const bf16* kp_ = kb + (size_t)(gr_ * 64) * 2048; const bf16* vp_ = vb + gr_ * 64; \
        _Pragma("unroll") for (int t = 0; t < 2; ++t) { KB[t][0] = *(const bf16x8*)(kp_ + (size_t)(4 * t) * 2048); KB[t][1] = *(const bf16x8*)(kp_ + (size_t)(4 * t) * 2048 + 32); } \
        _Pragma("unroll") for (int dt = 0; dt < 4; ++dt) VB[0][dt] = *(const u32x4*)(vp_ + (size_t)(16 * dt) * 4096); } while (0)
#define ATT_ONE(ST, QF, KB, VB, roff, rowok) do { f32x4 sc[2]; \
        _Pragma("unroll") for (int t = 0; t < 2; ++t) { sc[t] = MFMA16(KB[t][0], QF[0], z); sc[t] = MFMA16(KB[t][1], QF[1], sc[t]); } \
        const LAS float* bp_ = rpl + ((rowok) ? (roff) : 15) * 64; \
        _Pragma("unroll") for (int t = 0; t < 2; ++t) _Pragma("unroll") for (int j = 0; j < 4; ++j) sc[t][j] = (sc[t][j] + bp_[4 * t + j]) + madd[t][j]; \
        attn_tail<2>(ST, sc, VB); } while (0)
#define ATT_COMPUTE(KB, VB, i) do { const int roffA_ = min(rsA + (i) - r + 7, 14); \
        ATT_ONE(SA, qA, KB, VB, roffA_, (i) <= 7); \
        ATT_ONE(SB, qB, KB, VB, max(roffA_ - 1, 0), (i) >= dB && (i) <= 7 + dB); } while (0)
        ATT_LOADW(K0, V0, 0);
#pragma unroll 1
        for (int i = 0; i < 8; i += 2) { ATT_LOADW(K1, V1, i + 1); ATT_COMPUTE(K0, V0, i); ATT_LOADW(K0, V0, i + 2); ATT_COMPUTE(K1, V1, i + 1); }
        ATT_COMPUTE(K0, V0, 8);
#undef ATT_LOADW
#undef ATT_ONE
#undef ATT_COMPUTE
    }
    { const LAS bf16* ck = (const LAS bf16*)(lds + ALDS_CK) + l15 * ACK_STRIDE + 8 * g;
      const LAS bf16* cv = (const LAS bf16*)(lds + ALDS_CV) + l15 * ACV_STRIDE + 8 * g;
#pragma unroll 1
      for (int c = 0; c < 4; ++c) {
          bf16x8 kf[4][2]; u32x4 vw[2][4];
#pragma unroll
          for (int t = 0; t < 4; ++t) { const LAS bf16* kp = ck + (64 * c + 16 * t) * ACK_STRIDE; kf[t][0] = *(const LAS bf16x8*)kp; kf[t][1] = *(const LAS bf16x8*)(kp + 32); }
#pragma unroll
          for (int ks = 0; ks < 2; ++ks)
#pragma unroll
              for (int dt = 0; dt < 4; ++dt) vw[ks][dt] = *(const LAS u32x4*)(cv + (16 * dt) * ACV_STRIDE + 64 * c + 32 * ks);
          { f32x4 sc[4];
#pragma unroll
            for (int t = 0; t < 4; ++t) { sc[t] = MFMA16(kf[t][0], qA[0], z); sc[t] = MFMA16(kf[t][1], qA[1], sc[t]); }
            attn_tail<4>(SA, sc, vw); }
          { f32x4 sc[4];
#pragma unroll
            for (int t = 0; t < 4; ++t) { sc[t] = MFMA16(kf[t][0], qB[0], z); sc[t] = MFMA16(kf[t][1], qB[1], sc[t]); }
            attn_tail<4>(SB, sc, vw); }
      } }
    { const float inv = 1.0f / xrow16_sum(SA.sum);
#pragma unroll
      for (int dt = 0; dt < 4; ++dt) st_bf4(ATT + (size_t)(rowqA + l15) * 1024 + h * 64 + 16 * dt + 4 * g, SA.o[dt] * inv); }
    { const float inv = 1.0f / xrow16_sum(SB.sum);
#pragma unroll
      for (int dt = 0; dt < 4; ++dt) st_bf4(ATT + (size_t)(rowqB + l15) * 1024 + h * 64 + 16 * dt + 4 * g, SB.o[dt] * inv); }
}
__device__ __forceinline__ void p_attn_mfma(const Params& P, Frame& F, int l, bool with_ctx_queries) {
    const bf16* KQ = WSP(bf16, WS_KQ); const bf16* VT = WSP(bf16, WS_VT); bf16* ATT = WSP(bf16, WS_ATT);
    const float* rpb = P.rpb + (size_t)l * 16 * 465;
    for (int hp = F.bid; hp < 256; hp += F.G) {
        const int p = hp & 127, half = hp >> 7, b = p >> 4, h = p & 15;
        __syncthreads();
        { LAS bf16* ck = (LAS bf16*)(F.lds + ALDS_CK); LAS bf16* cv = (LAS bf16*)(F.lds + ALDS_CV); LAS float* rp = (LAS float*)(F.lds + ALDS_RP);
          { const int key = F.tid >> 1, hf = F.tid & 1; const int k32 = key & 31, pos = (key & ~31) + ((k32 >> 2) & 1) * 16 + 4 * (k32 >> 3) + (k32 & 3);
            const u32x4* src = (const u32x4*)(KQ + (size_t)(RL + b * CTXL + key) * 2048 + h * 64 + hf * 32); LAS u32x4* dst = (LAS u32x4*)(ck + pos * ACK_STRIDE + hf * 32);
#pragma unroll
            for (int i = 0; i < 4; ++i) dst[i] = src[i]; }
          { const int d = F.tid >> 3, sg = F.tid & 7; const u32x4* src = (const u32x4*)(VT + YT_CTX_OFF + (size_t)(b * 1024 + h * 64 + d) * 256 + sg * 32); LAS u32x4* dst = (LAS u32x4*)(cv + d * ACV_STRIDE + sg * 32);
#pragma unroll
            for (int i = 0; i < 4; ++i) dst[i] = src[i]; }
          for (int i = F.tid; i < 16 * 64; i += NTHREADS) { const int rr = i >> 6, cc = (i & 63) - 16; rp[i] = rr == 15 ? -__builtin_inff() : ((cc >= 0 && cc < 31) ? rpb[h * 465 + rr * 31 + cc] * LOG2E : 0.f); } }
        __syncthreads();
        const int qt = F.wave & 3, rpi = F.wave >> 2;
#pragma unroll 1
        for (int st = 0; st < 8; ++st) { const int r = half * 32 + st * 4 + rpi * 2; const int rowqA = b * SEQ + r * 64 + 16 * qt;
            attn_unit2(KQ, VT, ATT, F.lds, b, h, rowqA, rowqA + 64, true, r, qt, F.lane); }
        if (with_ctx_queries && half == 0) { const int rowqA = RL + b * CTXL + 32 * F.wave; attn_unit2(KQ, VT, ATT, F.lds, b, h, rowqA, rowqA + 16, false, 0, 0, F.lane); }
    }
    __syncthreads();
}

__device__ __forceinline__ void p_pool(Frame& F, int nrows) {
    const bf16* PB = WSP(bf16, WS_PB); bf16* POOL = WSP(bf16, WS_POOL);
    for (int i = F.bid * NTHREADS + F.tid; i < nrows * 64; i += F.G * NTHREADS) {
        const int row = i >> 6, ch = i & 63, g = ch >> 4, hw = 1 << g;
        int base, t, Lb; if (row < RL) { base = row & ~4095; t = row & 4095; Lb = SEQ; } else { const int rr = row - RL; base = RL + (rr & ~255); t = rr & 255; Lb = CTXL; }
        const int lo = max(t - hw, 0), hi = min(t + hw, Lb);
        float a[8];
#pragma unroll
        for (int q = 0; q < 8; ++q) a[q] = 0.f;
        for (int tt = lo; tt < hi; ++tt) { const u32x4 w = *(const u32x4*)(PB + (size_t)(base + tt) * 512 + ch * 8);
#pragma unroll
            for (int q = 0; q < 4; ++q) { a[2 * q] += bflo(w[q]); a[2 * q + 1] += bfhi(w[q]); } }
        const u32x4 me = *(const u32x4*)(PB + (size_t)row * 512 + ch * 8); const float inv = 1.0f / (float)(hi - lo);
        u32x4 o;
#pragma unroll
        for (int q = 0; q < 4; ++q) o[q] = pk2(a[2 * q] * inv - bflo(me[q]), a[2 * q + 1] * inv - bfhi(me[q]));
        *(u32x4*)(POOL + (size_t)row * 512 + ch * 8) = o;
    }
}

__device__ __forceinline__ int block_sum_i(int v, LAS int* sm, int tid) {
#pragma unroll
    for (int o = 1; o < 64; o <<= 1) v += __shfl_xor(v, o);
    __syncthreads();
    if ((tid & 63) == 0) sm[tid >> 6] = v;
    __syncthreads();
    int s = 0;
#pragma unroll
    for (int i = 0; i < 8; ++i) s += sm[i];
    return s;
}
__device__ __forceinline__ int block_excl_scan(int v, LAS int* sm, int tid, int& total) {
    const int lane = tid & 63, w = tid >> 6; int inc = v;
#pragma unroll
    for (int o = 1; o < 64; o <<= 1) { const int t = __shfl_up(inc, o); if (lane >= o) inc += t; }
    __syncthreads();
    if (lane == 63) sm[w] = inc;
    __syncthreads();
    int base = 0; total = 0;
#pragma unroll
    for (int i = 0; i < 8; ++i) { const int s = sm[i]; if (i < w) base += s; total += s; }
    return base + inc - v;
}
template <int NPT>
__device__ __forceinline__ void topk_pair(Frame& F, int row0, int n, int cap, int e, int slot0) {
    LAS int* sm = (LAS int*)F.lds;
    const float* AFF = WSP(float, WS_AFF); int* SROW = WSP(int, WS_SROW); float* SG = WSP(float, WS_SGATE); int* SEL = WSP(int, WS_SEL);
    unsigned key[NPT];
#pragma unroll
    for (int j = 0; j < NPT; ++j) { const int i = F.tid * NPT + j; key[j] = (i < n) ? __float_as_uint(AFF[(size_t)(row0 + i) * 16 + e]) : 0u; }
    unsigned T = 0u;
    for (int bit = 30; bit >= 0; --bit) { const unsigned cand = T | (1u << bit); int cnt = 0;
#pragma unroll
        for (int j = 0; j < NPT; ++j) cnt += (key[j] >= cand) ? 1 : 0;
        cnt = block_sum_i(cnt, sm, F.tid);
        if (cnt >= cap) T = cand; }
    int ngt = 0, neq = 0;
#pragma unroll
    for (int j = 0; j < NPT; ++j) { ngt += (key[j] > T) ? 1 : 0; neq += (key[j] == T) ? 1 : 0; }
    int tot_gt, tot_eq;
    (void)block_excl_scan(ngt, sm, F.tid, tot_gt);
    int eqr = block_excl_scan(neq, sm, F.tid, tot_eq);
    const int need_eq = cap - tot_gt;
    int nsel = 0; bool selj[NPT];
#pragma unroll
    for (int j = 0; j < NPT; ++j) { bool s = key[j] > T; if (key[j] == T && T != 0u) { s = eqr < need_eq; ++eqr; } selj[j] = s; nsel += s ? 1 : 0; }
    int tot_sel; int pos = block_excl_scan(nsel, sm, F.tid, tot_sel);
#pragma unroll
    for (int j = 0; j < NPT; ++j) { const int i = F.tid * NPT + j;
        if (i < n) { const int row = row0 + i;
            if (selj[j]) { const int slot = slot0 + pos; ++pos; SROW[slot] = row; SG[slot] = __uint_as_float(key[j]); SEL[(size_t)row * 16 + e] = slot; }
            else SEL[(size_t)row * 16 + e] = -1; } }
    __syncthreads();
}
__device__ __forceinline__ void p_topk(Frame& F, bool with_ctx) {
    const int npairs = 128 + (with_ctx ? 128 : 0);
    for (int pi = F.bid; pi < npairs; pi += F.G) {
        if (pi < 128) { const int b = pi >> 4, e = pi & 15; topk_pair<8>(F, b * SEQ, SEQ, CAPL, e, e * SLOT_E + b * CAPL); }
        else { const int p2 = pi - 128, b = p2 >> 4, e = p2 & 15; topk_pair<1>(F, RL + b * CTXL, CTXL, CAPC, e, e * SLOT_E + 4096 + b * CAPC); }
    }
}
__device__ __forceinline__ void p_gather(Frame& F, bool with_ctx) {
    const int gw = F.bid * NWAVES + F.wave, NGW = F.G * NWAVES; const bf16* H = WSP(bf16, WS_H); bf16* XG = WSP(bf16, WS_XG); const int* SROW = WSP(int, WS_SROW);
    for (int s = gw; s < NSLOT; s += NGW) { if (!with_ctx && (s % SLOT_E) >= 4096) continue;
        const int row = SROW[s]; const u32x4* src = (const u32x4*)(H + (size_t)row * DM); u32x4* dst = (u32x4*)(XG + (size_t)s * DM);
        dst[F.lane] = src[F.lane]; dst[F.lane + 64] = src[F.lane + 64]; }
}

template <int PH> __global__ void __launch_bounds__(NTHREADS, 2) fwd_kernel(Params P) {
    extern __shared__ __attribute__((aligned(16))) unsigned char lds_raw[];
    Frame F; F.lds = (LAS unsigned char*)lds_raw; F.tid = threadIdx.x; F.lane = F.tid & 63; F.wave = __builtin_amdgcn_readfirstlane(F.tid >> 6); F.G = gridDim.x; F.bid = blockIdx.x; F.ws = P.ws;
    volatile LAS unsigned* MISC = (volatile LAS unsigned*)(F.lds + LDS_MISC);
    if (F.tid < 64) MISC[F.tid] = 0u;
    __syncthreads();
    XcdBarrier bar; bar.bar = WSP(unsigned, WS_CTL) + CW_BAR; bar.x = 0; bar.st = MISC + 8;
    if constexpr (PH < 0) bar = xcd_barrier_post(WSP(unsigned, WS_CTL) + CW_BAR, MISC + 8);
#define IN(k) (PH < 0 || PH == (k))
#define REFRESH() do { int t_ = threadIdx.x; asm volatile("" : "+v"(t_)); F.tid = t_; F.lane = t_ & 63; F.wave = __builtin_amdgcn_readfirstlane(t_ >> 6); } while (0)
#define SEAM(k) do { if constexpr (PH < 0) xcd_barrier(bar); } while (0)

    if (IN(0)) { REP_BEGIN(100) p_mod(P, F); p_dftgen(F); REP_END REP_BEGIN(101) p_wconv(P, F, 0); REP_END }
    SEAM(0);
    if (IN(1)) { p_rowpass_a0(P, F); }
    SEAM(1);
    for (int l = P.l_lo; l < P.l_hi; ++l) {
        constexpr int pb = 2; const bool L0 = (l == 0);
        bf16* H = WSP(bf16, WS_H);
        if (IN(pb + 0)) { REFRESH(); REP_BEGIN(2)
            { GroupSched S; S.init(1, 128, 22, F.G, F.bid, 8, L0 ? 22 : 4, 128, 0);
              const bf16* WA = WSP(bf16, WS_WA);
              auto AD = [=](const Unit& u) { return Operands{H + (size_t)u.pm * 256 * DM, WA + (size_t)u.pn * 256 * DM, DM, DM, 0}; };
              bf16* KQ = WSP(bf16, WS_KQ); bf16* PBp = WSP(bf16, WS_PB); bf16* GB = WSP(bf16, WS_GB);
              auto E = [=](EPI_ARGS) { const int row0 = u.pm * 256;
                  if (u.pn < 8) { const float qs = (u.pn >= 4) ? QSCALE : 1.0f; EPI_FOR( st_bf4(KQ + (size_t)(row0 + r) * 2048 + u.pn * 256 + c, v * qs); ) }
                  else if (u.pn < 10) { EPI_FOR( st_bf4(PBp + (size_t)(row0 + r) * 512 + (u.pn - 8) * 256 + c, v); ) }
                  else { EPI_FOR( f32x4 s; s[0] = sigmoidf_(v[0]); s[1] = sigmoidf_(v[1]); s[2] = sigmoidf_(v[2]); s[3] = sigmoidf_(v[3]); st_bf4(GB + (size_t)(row0 + r) * 3072 + (u.pn - 10) * 256 + c, s); ) } };
              GEMM(S, AD, E, DM, DM, DM); }
            { GroupSched S; S.init(1, 8, 128, F.G, F.bid, L0 ? 8 : 4, 8, L0 ? 0 : 4, 128);
              const bf16* WFV = WSP(bf16, WS_WFV);
              auto AD = [=](const Unit& u) { return Operands{WFV + (size_t)u.pm * 256 * DM, H + (size_t)u.pn * 256 * DM, DM, DM, 0}; };
              bf16* YT = WSP(bf16, WS_YT); bf16* VT = WSP(bf16, WS_VT);
              auto E = [=](EPI_ARGS) { bf16* T = (u.pm < 4) ? YT : VT; const int rr0 = (u.pm & 3) * 256;
                  if (u.pn < 128) { const int b = u.pn >> 4, l0 = (u.pn & 15) * 256; EPI_FOR( st_bf4(T + ((size_t)b * 1024 + rr0 + r) * 4096 + l0 + c, v); ) }
                  else { const int b = u.pn - 128; EPI_FOR( st_bf4(T + YT_CTX_OFF + ((size_t)b * 1024 + rr0 + r) * 256 + c, v); ) } };
              GEMM(S, AD, E, DM, DM, DM); }
        REP_END }
        SEAM(pb + 0);
        if (IN(pb + 1)) { REFRESH();
            REP_BEGIN(31) p_attn_mfma(P, F, l, L0); REP_END
            REP_BEGIN(32)
            { GroupSched S; S.init(1, 16, 16, F.G, F.bid);
              const bf16* DFTM = WSP(bf16, WS_DFTM); const bf16* YT = WSP(bf16, WS_YT); bf16* FOUR = WSP(bf16, WS_FOUR);
              auto AD = [=](const Unit& u) { return Operands{DFTM + (size_t)u.pm * 256 * 8192, YT + (size_t)u.pn * 256 * 8192, 8192, 8192, 0}; };
              auto E = [=](EPI_ARGS) { const int b = u.pn >> 1, c0 = (u.pn & 1) * 256; const float sc = 0.0013810679320049757f;
                  EPI_FOR( st_bf4(FOUR + ((size_t)b * SEQ + u.pm * 256 + r) * 512 + c0 + c, v * sc); ) };
              GEMM(S, AD, E, 8192, 8192, 8192); }
            if (L0) { GroupSched S; S.init(1, 1, 16, F.G, F.bid);
              const bf16* DFTC = WSP(bf16, WS_DFTC); const bf16* YTC = WSP(bf16, WS_YT) + YT_CTX_OFF; bf16* FOUR = WSP(bf16, WS_FOUR);
              auto AD = [=](const Unit& u) { return Operands{DFTC, YTC + (size_t)u.pn * 256 * 512, 512, 512, 0}; };
              auto E = [=](EPI_ARGS) { const int b = u.pn >> 1, c0 = (u.pn & 1) * 256; const float sc = 0.005524271728019903f;
                  EPI_FOR( st_bf4(FOUR + ((size_t)RL + b * CTXL + r) * 512 + c0 + c, v * sc); ) };
              GEMM(S, AD, E, 512, 512, 512); }
            REP_END
            REP_BEGIN(33) p_pool(F, L0 ? RT : RL); REP_END
        }
        SEAM(pb + 1);
        if (IN(pb + 2)) { REFRESH(); REP_BEGIN(4)
            const int nM = L0 ? 136 : 128; float* MRG = WSP(float, WS_MRG); const bf16* GB = WSP(bf16, WS_GB);
            { GroupSched S; S.init(1, nM, 4, F.G, F.bid); const bf16* A = WSP(bf16, WS_ATT); const bf16* W = WSP(bf16, WS_WAO);
              auto AD = [=](const Unit& u) { return Operands{A + (size_t)u.pm * 256 * 1024, W + (size_t)u.pn * 256 * 1024, 1024, 1024, 0}; };
              auto E = [=](EPI_ARGS) { EPI_FOR( const size_t row = (size_t)u.pm * 256 + r; const int col = u.pn * 256 + c; const u32x2 g = *(const u32x2*)(GB + row * 3072 + col);
                  f32x4 o; o[0] = bflo(g.x) * v[0]; o[1] = bfhi(g.x) * v[1]; o[2] = bflo(g.y) * v[2]; o[3] = bfhi(g.y) * v[3]; *(f32x4*)(MRG + row * 1024 + col) = o; ) };
              GEMM(S, AD, E, 1024, 1024, 1024); }
            { GroupSched S; S.init(1, nM, 4, F.G, F.bid); const bf16* A = WSP(bf16, WS_FOUR); const bf16* W = WSP(bf16, WS_WFO);
              auto AD = [=](const Unit& u) { return Operands{A + (size_t)u.pm * 256 * 512, W + (size_t)u.pn * 256 * 512, 512, 512, 0}; };
              auto E = [=](EPI_ARGS) { EPI_FOR( const size_t row = (size_t)u.pm * 256 + r; const int col = u.pn * 256 + c; const u32x2 g = *(const u32x2*)(GB + row * 3072 + 1024 + col);
                  f32x4 o = *(const f32x4*)(MRG + row * 1024 + col); o[0] += bflo(g.x) * v[0]; o[1] += bfhi(g.x) * v[1]; o[2] += bflo(g.y) * v[2]; o[3] += bfhi(g.y) * v[3]; *(f32x4*)(MRG + row * 1024 + col) = o; ) };
              GEMM(S, AD, E, 512, 512, 512); }
            { GroupSched S; S.init(1, nM, 4, F.G, F.bid); const bf16* A = WSP(bf16, WS_POOL); const bf16* W = WSP(bf16, WS_WPO); bf16* MRGB = WSP(bf16, WS_MRGB);
              const float* ps = P.pool_scale + l * 1024;
              auto AD = [=](const Unit& u) { return Operands{A + (size_t)u.pm * 256 * 512 + (u.pn >> 1) * 256, W + (size_t)u.pn * 256 * 256, 512, 256, 0}; };
              auto E = [=](EPI_ARGS) { EPI_FOR( const size_t row = (size_t)u.pm * 256 + r; const int col = u.pn * 256 + c; const u32x2 g = *(const u32x2*)(GB + row * 3072 + 2048 + col);
                  const f32x4 pv = *(const f32x4*)(ps + col); f32x4 o = *(const f32x4*)(MRG + row * 1024 + col);
                  o[0] += bflo(g.x) * pv[0] * v[0]; o[1] += bfhi(g.x) * pv[1] * v[1]; o[2] += bflo(g.y) * pv[2] * v[2]; o[3] += bfhi(g.y) * pv[3] * v[3]; st_bf4(MRGB + row * 1024 + col, o); ) };
              GEMM(S, AD, E, 256, 512, 256); }
        REP_END }
        SEAM(pb + 2);
        if (IN(pb + 3)) { REFRESH();
            GroupSched S; S.init(1, L0 ? 136 : 128, 4, F.G, F.bid); const bf16* A = WSP(bf16, WS_MRGB); const bf16* W = WSP(bf16, WS_WOUT);
            const float* xin = L0 ? P.x : P.out; const float* cin = L0 ? P.ctx : WSP(float, WS_XC); float* xo = P.out; float* co = WSP(float, WS_XC);
            const float* MOD = WSP(float, WS_MOD) + (size_t)l * 9 * 6144;
            auto AD = [=](const Unit& u) { return Operands{A + (size_t)u.pm * 256 * 1024, W + (size_t)u.pn * 256 * 1024, 1024, 1024, 0}; };
            auto E = [=](EPI_ARGS) { EPI_FOR( const int row = u.pm * 256 + r; const int col = u.pn * 256 + c; const int mr = row < RL ? (row >> 12) : 8;
                const f32x4 g = *(const f32x4*)(MOD + (size_t)mr * 6144 + 2048 + col);
                const float* src = row < RL ? xin + (size_t)row * DM + col : cin + (size_t)(row - RL) * DM + col; float* dst = row < RL ? xo + (size_t)row * DM + col : co + (size_t)(row - RL) * DM + col;
                *(f32x4*)dst = *(const f32x4*)src + g * v; ) };
            GEMM(S, AD, E, 1024, 1024, 1024);
        }
        SEAM(pb + 3);
        if (IN(pb + 4)) { REFRESH(); REP_BEGIN(6) p_rowpass_f(P, F, l, L0 ? RT : RL); REP_END }
        SEAM(pb + 4);
        if (IN(pb + 5)) { REFRESH(); REP_BEGIN(7) p_topk(F, L0); REP_END }
        SEAM(pb + 5);
        if (IN(pb + 7)) { REFRESH(); REP_BEGIN(9)
            GroupSched S; S.init(16, L0 ? 17 : 16, 22, F.G, F.bid); const bf16* W = WSP(bf16, WS_WGU); bf16* HID = WSP(bf16, WS_HID); const int* SROW = WSP(int, WS_SROW);
            auto AD = [=](const Unit& u) { return Operands{H, W + ((size_t)u.grp * 5632 + u.pn * 256) * DM, DM, DM, u.grp * SLOT_E + u.pm * 256}; };
            auto E = [=](EPI_ARGS) {
#pragma unroll
                for (int ai = 0; ai < 2; ++ai)
#pragma unroll
                    for (int m = 0; m < 4; ++m) { const size_t slot = (size_t)u.grp * SLOT_E + u.pm * 256 + ai * 128 + wr * 64 + m * 16 + fr;
#pragma unroll
                        for (int n = 0; n < 2; ++n) { const f32x4 a = acc[ai][0][m][n], up = acc[ai][1][m][n]; f32x4 o;
#pragma unroll
                            for (int j = 0; j < 4; ++j) o[j] = a[j] * sigmoidf_(a[j]) * up[j];
                            st_bf4(HID + slot * FF + u.pn * 128 + wc * 32 + n * 16 + 4 * fq, o); } } };
            GEMM_GATHER(S, AD, E, DM, DM, DM, SROW);
        REP_END }
        SEAM(pb + 7);
        if (IN(pb + 8)) { REFRESH(); REP_BEGIN(10)
            GroupSched S; S.init(16, L0 ? 17 : 16, 4, F.G, F.bid); const bf16* HID = WSP(bf16, WS_HID); const bf16* W = WSP(bf16, WS_WD); bf16* Y = WSP(bf16, WS_Y); const float* SG = WSP(float, WS_SGATE);
            auto AD = [=](const Unit& u) { return Operands{HID + ((size_t)u.grp * SLOT_E + u.pm * 256) * FF, W + ((size_t)u.grp * 1024 + u.pn * 256) * FF, FF, FF, 0}; };
            auto E = [=](EPI_ARGS) { EPI_FOR( const size_t slot = (size_t)u.grp * SLOT_E + u.pm * 256 + r; const float gt = SG[slot]; st_bf4(Y + slot * DM + u.pn * 256 + c, v * gt); ) };
            GEMM(S, AD, E, FF, FF, FF);
        REP_END }
        SEAM(pb + 8);
        if (IN(pb + 9)) { REFRESH(); p_rowpass_k(P, F, l, L0 ? RT : RL); if (L0) p_wconv(P, F, 1); }
        if (L0) SEAM(pb + 9);
    }
#undef IN
#undef SEAM
}
template <int PH> static void launch_ph(int grid, const Params& p, hipStream_t stream) { hipLaunchKernelGGL(fwd_kernel<PH>, dim3(grid), dim3(NTHREADS), LDS_BYTES, stream, p); }
template <int PH> static bool set_attr() { return hipFuncSetAttribute((const void*)fwd_kernel<PH>, hipFuncAttributeMaxDynamicSharedMemorySize, LDS_BYTES) == hipSuccess; }

extern "C" void kernel_launch(void* const* d_in, const int* in_sizes, int n_in, void* d_out, int out_size, void* d_ws, size_t ws_size, hipStream_t stream) {
    static int grid = 0;
    if (grid == 0) {
        if (n_in != 20 || out_size != RL * DM || ws_size < WS_END) { fprintf(stderr, "kernel_launch: unexpected shapes (n_in %d out %d ws %zu need %zu)\n", n_in, out_size, ws_size, (size_t)WS_END); grid = -1; return; }
        int dev = 0, cus = 0, per_cu = 0;
        if (hipGetDevice(&dev) != hipSuccess || hipDeviceGetAttribute(&cus, hipDeviceAttributeMultiprocessorCount, dev) != hipSuccess) { grid = -1; return; }
#if N_LAUNCH_MODE == 1
        if (!set_attr<-1>()) { fprintf(stderr, "kernel_launch: hipFuncSetAttribute failed\n"); grid = -1; return; }
        if (hipOccupancyMaxActiveBlocksPerMultiprocessor(&per_cu, (const void*)fwd_kernel<-1>, NTHREADS, LDS_BYTES) != hipSuccess || per_cu < 1) fprintf(stderr, "kernel_launch: occupancy query reports %d\n", per_cu);
#else
        if (!(set_attr<0>() && set_attr<1>() && set_attr<2>() && set_attr<3>() && set_attr<4>() && set_attr<5>() && set_attr<6>() && set_attr<7>() && set_attr<8>() && set_attr<9>() && set_attr<10>() && set_attr<11>())) { fprintf(stderr, "kernel_launch: hipFuncSetAttribute failed\n"); grid = -1; return; }
        (void)per_cu;
#endif
        (void)hipGetLastError();
        grid = cus;
    }
    if (grid < 0) return;
    if (hipMemsetAsync((char*)d_ws + WS_CTL, 0, CTL_BYTES, stream) != hipSuccess) return;
    Params p{};
    const float** pp = (const float**)&p;
    for (int i = 0; i < 20; ++i) pp[i] = (const float*)d_in[i];
    p.out = (float*)d_out; p.ws = (unsigned char*)d_ws;
#if N_LAUNCH_MODE == 1
    p.l_lo = 0; p.l_hi = 2;
    launch_ph<-1>(grid, p, stream);
#else
    p.l_lo = 0; p.l_hi = 0; launch_ph<0>(grid, p, stream); launch_ph<1>(grid, p, stream);
    for (int l = 0; l < 2; ++l) { p.l_lo = l; p.l_hi = l + 1;
        launch_ph<2>(grid, p, stream); launch_ph<3>(grid, p, stream); launch_ph<4>(grid, p, stream); launch_ph<5>(grid, p, stream); launch_ph<6>(grid, p, stream);
        launch_ph<7>(grid, p, stream); launch_ph<8>(grid, p, stream); launch_ph<9>(grid, p, stream); launch_ph<10>(grid, p, stream); launch_ph<11>(grid, p, stream); }
#endif
}
```

```cpp
#include <hip/hip_runtime.h>
#include <cstdio>
#include <cstdint>

#ifndef N_LAUNCH_MODE
#define N_LAUNCH_MODE 1
#endif

#define GAS __attribute__((address_space(1)))
#define LAS __attribute__((address_space(3)))
typedef unsigned short bf16;
typedef short bf16x8 __attribute__((ext_vector_type(8)));
typedef float f32x4 __attribute__((ext_vector_type(4)));
typedef unsigned u32x4 __attribute__((ext_vector_type(4)));
typedef unsigned u32x2 __attribute__((ext_vector_type(2)));

constexpr int NB = 8, SEQ = 4096, DM = 1024, CTXL = 256, NH = 16, HD = 64, GRIDW = 64;
constexpr int RL = NB * SEQ, RC = NB * CTXL, RT = RL + RC;
constexpr int INW = 7168, NE = 16, FF = 2816, CAPL = 512, CAPC = 32;
constexpr int SLOT_E = 4352, NSLOT = NE * SLOT_E;
constexpr float RMS_EPS = 1e-6f;
constexpr float LOG2E = 1.4426950408889634f, QSCALE = 0.125f * LOG2E;
constexpr int NWAVES = 8, NTHREADS = 512;

constexpr size_t al256(size_t x) { return (x + 255) & ~(size_t)255; }
constexpr size_t WS_CTL = 0, CTL_BYTES = 1u << 20;
constexpr size_t WS_MOD = WS_CTL + CTL_BYTES;
constexpr size_t WS_XC = al256(WS_MOD + (size_t)2 * 9 * 6144 * 4);
constexpr size_t WS_AFF = al256(WS_XC + (size_t)RC * DM * 4);
constexpr size_t WS_SROW = al256(WS_AFF + (size_t)RT * 16 * 4);
constexpr size_t WS_SGATE = al256(WS_SROW + (size_t)NSLOT * 4);
constexpr size_t WS_SEL = al256(WS_SGATE + (size_t)NSLOT * 4);
constexpr size_t WS_DFTM = al256(WS_SEL + (size_t)RT * 16 * 4);
constexpr size_t WS_DFTC = al256(WS_DFTM + (size_t)4096 * 8192 * 2);
constexpr size_t WS_WA = al256(WS_DFTC + (size_t)256 * 512 * 2);
constexpr size_t WS_WFV = al256(WS_WA + (size_t)5632 * 1024 * 2);
constexpr size_t WS_WAO = al256(WS_WFV + (size_t)2048 * 1024 * 2);
constexpr size_t WS_WFO = al256(WS_WAO + (size_t)1024 * 1024 * 2);
constexpr size_t WS_WPO = al256(WS_WFO + (size_t)1024 * 512 * 2);
constexpr size_t WS_WOUT = al256(WS_WPO + (size_t)1024 * 256 * 2);
constexpr size_t WS_WGU = al256(WS_WOUT + (size_t)1024 * 1024 * 2);
constexpr size_t WS_WD = al256(WS_WGU + (size_t)16 * 5632 * 1024 * 2);
constexpr size_t WS_H = al256(WS_WD + (size_t)16 * 1024 * 2816 * 2);
constexpr size_t WS_R = al256(WS_H + (size_t)RT * DM * 2);
constexpr size_t WS_KQ = WS_R;
constexpr size_t WS_MRG = WS_KQ;
constexpr size_t WS_PB = al256(WS_KQ + (size_t)RT * 2048 * 2);
constexpr size_t WS_GB = al256(WS_PB + (size_t)RT * 512 * 2);
constexpr size_t WS_YT = al256(WS_GB + (size_t)RT * 3072 * 2);
constexpr size_t WS_MRGB = WS_YT;
constexpr size_t WS_VT = al256(WS_YT + (size_t)RT * 1024 * 2);
constexpr size_t WS_FOUR = al256(WS_VT + (size_t)RT * 1024 * 2);
constexpr size_t WS_ATT = al256(WS_FOUR + (size_t)RT * 512 * 2);
constexpr size_t WS_POOL = al256(WS_ATT + (size_t)RT * 1024 * 2);
constexpr size_t WS_MIX_END = al256(WS_POOL + (size_t)RT * 512 * 2);
constexpr size_t WS_XG = WS_R;
constexpr size_t WS_HID = al256(WS_XG + (size_t)NSLOT * 1024 * 2);
constexpr size_t WS_Y = al256(WS_HID + (size_t)NSLOT * 2816 * 2);
constexpr size_t WS_MOE_END = al256(WS_Y + (size_t)NSLOT * 1024 * 2);
constexpr size_t WS_END = WS_MIX_END > WS_MOE_END ? WS_MIX_END : WS_MOE_END;
constexpr size_t YT_CTX_OFF = (size_t)8 * 1024 * 4096;

constexpr int CW_BAR = 4096;

constexpr int LDS_BYTES = 147456;
constexpr int LDS_MISC = 131072;

__device__ __forceinline__ unsigned f2bf(float f) { unsigned u = __float_as_uint(f); return (u + 0x7fffu + ((u >> 16) & 1u)) >> 16; }
typedef __bf16 hbf16x2 __attribute__((ext_vector_type(2)));
typedef float f32x2 __attribute__((ext_vector_type(2)));
__device__ __forceinline__ unsigned pk2(float lo, float hi) { const f32x2 v = {lo, hi}; return __builtin_bit_cast(unsigned, __builtin_convertvector(v, hbf16x2)); }
__device__ __forceinline__ float bf2f(unsigned b) { return __uint_as_float(b << 16); }
__device__ __forceinline__ float bflo(unsigned w) { return __uint_as_float(w << 16); }
__device__ __forceinline__ float bfhi(unsigned w) { return __uint_as_float(w & 0xffff0000u); }
__device__ __forceinline__ float wave_sum(float v) {
#pragma unroll
    for (int o = 1; o < 64; o <<= 1) v += __shfl_xor(v, o);
    return v;
}
__device__ __forceinline__ float wave_max(float v) {
#pragma unroll
    for (int o = 1; o < 64; o <<= 1) v = fmaxf(v, __shfl_xor(v, o));
    return v;
}
__device__ __forceinline__ float sigmoidf_(float x) { return 1.f / (1.f + __expf(-x)); }
#define LDS_WAIT() asm volatile("s_waitcnt lgkmcnt(0)" ::: "memory")

#define XB_TMO      128
#define XB_XCNT(j)  (256  + 64 * (j))
#define XB_XSUB(j)  (1280 + 64 * (j))
#define XB_XGEN(j)  (2304 + 64 * (j))
#define XB_TOP      3328
#define XB_TOPGEN   3392
#define XCD_BAR_WORDS 3456
#define XB_SPIN_CAP (1u << 22)

__device__ __forceinline__ unsigned xb_ld(unsigned* p)              { return __hip_atomic_load(p, __ATOMIC_RELAXED, __HIP_MEMORY_SCOPE_AGENT); }
__device__ __forceinline__ unsigned xb_add(unsigned* p, unsigned v) { return __hip_atomic_fetch_add(p, v, __ATOMIC_RELAXED, __HIP_MEMORY_SCOPE_AGENT); }
__device__ __forceinline__ unsigned xb_xcc_id() { return (unsigned)__builtin_amdgcn_s_getreg((3 << 11) | 20) & 0xFu; }
#define XB_SPIN(cond, bar) do { unsigned _sp = 0; while (cond) { __builtin_amdgcn_s_sleep(1); \
    if ((++_sp & 255u) == 0u) { if (xb_ld(&(bar)[XB_TMO])) break; if (_sp > XB_SPIN_CAP) { atomicAdd(&(bar)[XB_TMO], 1u); break; } } } } while (0)

struct XcdBarrier { unsigned* bar; unsigned x; volatile LAS unsigned* st; };

__device__ __forceinline__ XcdBarrier xcd_barrier_post(unsigned* bar, volatile LAS unsigned* st) {
    XcdBarrier b; b.bar = bar; b.x = xb_xcc_id(); b.st = st;
    if (threadIdx.x == 0) (void)xb_add(&bar[XB_XCNT(b.x)], 1u);
    return b;
}
__device__ __forceinline__ void xcd_barrier_complete(unsigned* bar, unsigned x, unsigned& nloc, unsigned& nx) {
    const unsigned G = gridDim.x * gridDim.y * gridDim.z;
    unsigned sum, cnt, mine, sp = 0u;
    for (;;) {
        sum = 0u; cnt = 0u; mine = 0u;
#pragma unroll
        for (unsigned j = 0; j < 16; ++j) { const unsigned c = xb_ld(&bar[XB_XCNT(j)]); sum += c; cnt += (c > 0u) ? 1u : 0u; mine = (j == x) ? c : mine; }
        if (sum == G) break;
        __builtin_amdgcn_s_sleep(1);
        if ((++sp & 255u) == 0u) { if (xb_ld(&bar[XB_TMO])) break; if (sp > XB_SPIN_CAP) { atomicAdd(&bar[XB_TMO], 1u); break; } }
    }
    nloc = mine > 0u ? mine : 1u; nx = cnt > 0u ? cnt : 1u;
}
__device__ __forceinline__ void xcd_barrier(const XcdBarrier& b) {
    asm volatile("s_waitcnt vmcnt(0)" ::: "memory");
    __syncthreads();
    if (threadIdx.x == 0) {
        unsigned* bar = b.bar;
        __builtin_amdgcn_s_waitcnt(0);
        unsigned nloc = b.st[0], nx = b.st[1];
        if (nloc == 0u) { xcd_barrier_complete(bar, b.x, nloc, nx); b.st[0] = nloc; b.st[1] = nx; }
        const unsigned old = xb_add(&bar[XB_XSUB(b.x)], 1u);
        const unsigned gen = old / nloc;
        if (old + 1u == (gen + 1u) * nloc) {
            __builtin_amdgcn_fence(__ATOMIC_RELEASE, "agent");
            asm volatile("s_waitcnt vmcnt(0)" ::: "memory");
            const unsigned og = xb_add(&bar[XB_TOP], 1u);
            const unsigned tg = og / nx;
            if (og + 1u == (tg + 1u) * nx) xb_add(&bar[XB_TOPGEN], 1u);
            else XB_SPIN(xb_ld(&bar[XB_TOPGEN]) == tg, bar);
            __builtin_amdgcn_fence(__ATOMIC_ACQUIRE, "agent");
            xb_add(&bar[XB_XGEN(b.x)], 1u);
            asm volatile("s_waitcnt vmcnt(0)" ::: "memory");
        } else {
            XB_SPIN(xb_ld(&bar[XB_XGEN(b.x)]) == gen, bar);
            __builtin_amdgcn_fence(__ATOMIC_ACQUIRE, "agent");
            asm volatile("s_waitcnt vmcnt(0)" ::: "memory");
        }
    }
    __syncthreads();
}

struct Params {
    const float *x, *c, *ctx, *c_ctx, *ada_w, *ada_b, *norm1_g, *norm2_g, *w_in, *rpb, *w_att_o, *w_fourier, *w_pool, *pool_scale, *w_out, *w_router, *w_eg, *w_eu, *w_ed, *final_g;
    float* out; unsigned char* ws; int l_lo, l_hi;
};
struct Frame {
    LAS unsigned char* lds;
    int tid, lane, wave, G, bid;
    unsigned char* ws;
};
#define WSP(T, off) ((T*)(F.ws + (off)))

struct Unit { int grp, pm, pn, seg; };
struct GroupSched {
    int ng, nM, nN, G, c; int tM, tN, tpm0, tpn0;
    __device__ __forceinline__ void init(int ng_, int nM_, int nN_, int G_, int c_, int tM_ = 0, int tN_ = 0, int tpm0_ = 0, int tpn0_ = 0) { ng = ng_; nM = nM_; nN = nN_; G = G_; c = c_; tM = tM_; tN = tN_; tpm0 = tpm0_; tpn0 = tpn0_; }
    __device__ __forceinline__ bool next(int i, Unit& u) const {
        const int per = nM * nN; const int L = i * G + c;
        if (L < ng * per) {
            u.grp = L / per; int wgid = L - u.grp * per;
            { const int q = per / 8, r = per % 8, xcd = wgid % 8, off = wgid / 8; wgid = (xcd < r ? xcd * (q + 1) : r * (q + 1) + (xcd - r) * q) + off; }
            const int nig = 8 * nN, gid = wgid / nig, fm = gid * 8, gsz = (nM - fm) < 8 ? (nM - fm) : 8;
            u.pm = fm + ((wgid % nig) % gsz); u.pn = (wgid % nig) / gsz; u.seg = 0; return true;
        }
        const int w = L - ng * per;
        if (w < tM * tN) { u.grp = ng; u.pm = tpm0 + (w % tM); u.pn = tpn0 + (w / tM); u.seg = 0; return true; }
        return false;
    }
};
struct Operands { const bf16* A; const bf16* Bt; int lda, ldb, slot0, K; };

template <class Addr, class Epi>
__device__ __forceinline__ void gemm_simple(const GroupSched& S, const Addr& AD, const Epi& E, int K) {
    const int tid = threadIdx.x, wid = __builtin_amdgcn_readfirstlane(tid >> 6), lane = tid & 63, wr = wid >> 2, wc = wid & 3, fr = lane & 15, fq = lane >> 4;
    Unit u;
    for (int i = 0; S.next(i, u); ++i) {
        const Operands op = AD(u);
        f32x4 acc[2][2][4][2];
#pragma unroll
        for (int a = 0; a < 2; ++a)
#pragma unroll
            for (int b = 0; b < 2; ++b)
#pragma unroll
                for (int m = 0; m < 4; ++m)
#pragma unroll
                    for (int n = 0; n < 2; ++n) acc[a][b][m][n] = (f32x4){0.f, 0.f, 0.f, 0.f};
        const bf16* ap = op.A + (size_t)(wr * 64 + fr) * op.lda + fq * 8;
        const bf16* bp = op.Bt + (size_t)(wc * 32 + fr) * op.ldb + fq * 8;
#pragma unroll 1
        for (int k = 0; k < K; k += 32) {
            bf16x8 bfr[2][2];
#pragma unroll
            for (int b = 0; b < 2; ++b)
#pragma unroll
                for (int n = 0; n < 2; ++n) bfr[b][n] = *(const bf16x8*)(bp + (size_t)(b * 128 + n * 16) * op.ldb + k);
#pragma unroll
            for (int a = 0; a < 2; ++a) {
                bf16x8 af[4];
#pragma unroll
                for (int m = 0; m < 4; ++m) af[m] = *(const bf16x8*)(ap + (size_t)(a * 128 + m * 16) * op.lda + k);
#pragma unroll
                for (int b = 0; b < 2; ++b)
#pragma unroll
                    for (int m = 0; m < 4; ++m)
#pragma unroll
                        for (int n = 0; n < 2; ++n) acc[a][b][m][n] = __builtin_amdgcn_mfma_f32_16x16x32_bf16(bfr[b][n], af[m], acc[a][b][m][n], 0, 0, 0);
            }
        }
        E(acc, u, wr, wc, fr, fq);
    }
}
constexpr int HTB = 128 * 64 * 2;
__device__ __forceinline__ int lds_byte(int r, int c) { const int st = (r >> 4) * 2 + (c >> 5), rr = r & 15, cc = c & 31, ob = rr * 64 + cc * 2; return st * 1024 + (ob ^ (((ob >> 9) & 1) << 5)); }
__device__ __forceinline__ void stage_rc(int b, int& R, int& C) { const int st = b / 1024, sb = b % 1024, swz = sb ^ (((sb >> 9) & 1) << 5); R = (st >> 1) * 16 + swz / 64; C = (st & 1) * 32 + (swz % 64) / 2; }
template <bool GATHER, class Sched, class Addr, class Epi>
__device__ __forceinline__ void gemm_fast(LAS unsigned char* lds, const int tid, const Sched& S, const Addr& AD, const Epi& E, const int* __restrict__ grows) {
    const int wid = __builtin_amdgcn_readfirstlane(tid >> 6), lane = tid & 63, wr = wid >> 2, wc = wid & 3, fr = lane & 15, fq = lane >> 4;
    int sR[2]; unsigned sC[2];
    unsigned cvg[2][2], nvg[2][2], cvb[2][2], nvb[2][2];
#pragma unroll
    for (int i = 0; i < 2; ++i) { int R, C; stage_rc(tid * 16 + i * 8192, R, C); sR[i] = R; sC[i] = (unsigned)C * 2u; }
    const size_t kstep = 128;
    const unsigned ldsw = (unsigned)wid * 1024u;
    const int aoff = lds_byte(wr * 64 + fr, fq * 8), boff = lds_byte(wc * 32 + fr, fq * 8);
#define PG8_SA(b, h) (((b) * 2 + (h)) * HTB)
#define PG8_SB(b, h) ((4 + (b) * 2 + (h)) * HTB)
#define PG8_STAGE(bufoff, gbase, voff) do { _Pragma("unroll") for (int _i = 0; _i < 2; ++_i) \
        __builtin_amdgcn_global_load_lds((const unsigned*)((const char*)(gbase) + (voff)[_i]), (LAS unsigned*)(lds + (bufoff) + ldsw + _i * 8192), 16, 0, 0); } while (0)
#define PG8_LDA(dst, b, h) do { _Pragma("unroll") for (int m = 0; m < 4; ++m) _Pragma("unroll") for (int k = 0; k < 2; ++k) dst[m][k] = *(const LAS bf16x8*)(lds + PG8_SA(b, h) + aoff + m * 2048 + k * 1024); } while (0)
#define PG8_LDB(dst, b, h) do { _Pragma("unroll") for (int n = 0; n < 2; ++n) _Pragma("unroll") for (int k = 0; k < 2; ++k) dst[n][k] = *(const LAS bf16x8*)(lds + PG8_SB(b, h) + boff + n * 2048 + k * 1024); } while (0)
#define PG8_MMA(ai, bj, At, Bt) do { __builtin_amdgcn_s_setprio(1); _Pragma("unroll") for (int m = 0; m < 4; ++m) _Pragma("unroll") for (int n = 0; n < 2; ++n) _Pragma("unroll") for (int k = 0; k < 2; ++k) \
        acc[ai][bj][m][n] = __builtin_amdgcn_mfma_f32_16x16x32_bf16(Bt[n][k], At[m][k], acc[ai][bj][m][n], 0, 0, 0); __builtin_amdgcn_s_setprio(0); } while (0)
#define PG8_WAIT_V(n) asm volatile("s_waitcnt vmcnt(" #n ")" ::: "memory")
#define PG8_WAIT_L(n) asm volatile("s_waitcnt lgkmcnt(" #n ")" ::: "memory")
#define PG8_BAR __builtin_amdgcn_s_barrier()
#define PG8_SCHED __builtin_amdgcn_sched_barrier(0)
#define PG8_GIDX(dst, op_) do { _Pragma("unroll") for (int h_ = 0; h_ < 2; ++h_) _Pragma("unroll") for (int i_ = 0; i_ < 2; ++i_) dst[h_][i_] = (unsigned)grows[(op_).slot0 + h_ * 128 + sR[i_]] * (unsigned)((op_).lda * 2) + sC[i_]; } while (0)
#define PG8_AOFF(dst, op_) do { _Pragma("unroll") for (int h_ = 0; h_ < 2; ++h_) _Pragma("unroll") for (int i_ = 0; i_ < 2; ++i_) dst[h_][i_] = (unsigned)((sR[i_] + 128 * h_) * (op_).lda) * 2u + sC[i_]; } while (0)
#define PG8_BOFF(dst, op_) do { _Pragma("unroll") for (int h_ = 0; h_ < 2; ++h_) _Pragma("unroll") for (int i_ = 0; i_ < 2; ++i_) dst[h_][i_] = (unsigned)((sR[i_] + 128 * h_) * (op_).ldb) * 2u + sC[i_]; } while (0)
#define PG8_COPY(dst, src) do { _Pragma("unroll") for (int h_ = 0; h_ < 2; ++h_) _Pragma("unroll") for (int i_ = 0; i_ < 2; ++i_) dst[h_][i_] = src[h_][i_]; } while (0)
    Unit cur, nxt; int ui = 0;
    if (!S.next(0, cur)) return;
    f32x4 acc[2][2][4][2];
#pragma unroll
    for (int a = 0; a < 2; ++a)
#pragma unroll
        for (int b = 0; b < 2; ++b)
#pragma unroll
            for (int m = 0; m < 4; ++m)
#pragma unroll
                for (int n = 0; n < 2; ++n) acc[a][b][m][n] = (f32x4){0.f, 0.f, 0.f, 0.f};
    bf16x8 At[4][2], B0[2][2], B1[2][2];
    const char* cA; const char* cB; int nt;
    { const Operands op = AD(cur); cA = (const char*)op.A; cB = (const char*)op.Bt; nt = op.K / 64; PG8_BOFF(cvb, op);
      Unit u1; const bool h1 = S.next(1, u1); const Operands o1 = h1 ? AD(u1) : op; PG8_BOFF(nvb, o1);
      if constexpr (GATHER) { PG8_GIDX(cvg, op); PG8_GIDX(nvg, o1); PG8_WAIT_V(0); } else { PG8_AOFF(cvg, op); PG8_AOFF(nvg, o1); } }
    PG8_STAGE(PG8_SB(0, 0), cB, cvb[0]); PG8_STAGE(PG8_SB(0, 1), cB, cvb[1]); PG8_STAGE(PG8_SA(0, 0), cA, cvg[0]); PG8_STAGE(PG8_SA(0, 1), cA, cvg[1]);
    if (wr == 1) PG8_BAR;
    PG8_WAIT_V(2); PG8_BAR;
    PG8_STAGE(PG8_SB(1, 0), cB + kstep, cvb[0]); PG8_STAGE(PG8_SA(1, 0), cA + kstep, cvg[0]); PG8_STAGE(PG8_SB(1, 1), cB + kstep, cvb[1]);
    PG8_WAIT_V(6); PG8_BAR;
    for (;;) {
        const bool has_next = S.next(ui + 1, nxt);
        const char* nA = cA; const char* nB = cB; int nnt = nt;
        if (has_next) { const Operands op = AD(nxt); nA = (const char*)op.A; nB = (const char*)op.Bt; nnt = op.K / 64; }
#pragma unroll 1
        for (int t = 0; t < nt; t += 2) {
            const bool last = (t == nt - 2);
            const char* a1 = cA + (size_t)(t + 1) * kstep;
            const char* a2 = last ? nA : cA + (size_t)(t + 2) * kstep; const char* b2 = last ? nB : cB + (size_t)(t + 2) * kstep;
            const char* a3 = a2 + kstep; const char* b3 = b2 + kstep;
            unsigned v2[2][2], w2[2][2];
#pragma unroll
            for (int h_ = 0; h_ < 2; ++h_)
#pragma unroll
                for (int i_ = 0; i_ < 2; ++i_) { v2[h_][i_] = last ? nvg[h_][i_] : cvg[h_][i_]; w2[h_][i_] = last ? nvb[h_][i_] : cvb[h_][i_]; }
            PG8_LDB(B0, 0, 0); PG8_LDB(B1, 0, 1); PG8_SCHED; PG8_LDA(At, 0, 0); PG8_STAGE(PG8_SA(1, 1), a1, cvg[1]);
            PG8_WAIT_V(8); PG8_WAIT_L(0); PG8_BAR; PG8_MMA(0, 0, At, B0); PG8_MMA(0, 1, At, B1); PG8_BAR; PG8_SCHED;
            PG8_LDA(At, 0, 1); PG8_STAGE(PG8_SB(0, 0), b2, w2[0]); PG8_STAGE(PG8_SB(0, 1), b2, w2[1]); PG8_STAGE(PG8_SA(0, 0), a2, v2[0]);
            PG8_WAIT_V(8); PG8_WAIT_L(0); PG8_BAR; PG8_MMA(1, 0, At, B0); PG8_MMA(1, 1, At, B1); PG8_BAR; PG8_SCHED;
            PG8_LDB(B0, 1, 0); PG8_LDB(B1, 1, 1); PG8_SCHED; PG8_LDA(At, 1, 0); PG8_STAGE(PG8_SA(0, 1), a2, v2[1]);
            PG8_WAIT_V(8); PG8_WAIT_L(0); PG8_BAR; PG8_MMA(0, 0, At, B0); PG8_MMA(0, 1, At, B1); PG8_BAR; PG8_SCHED;
            PG8_LDA(At, 1, 1); PG8_STAGE(PG8_SB(1, 0), b3, w2[0]); PG8_STAGE(PG8_SB(1, 1), b3, w2[1]); PG8_STAGE(PG8_SA(1, 0), a3, v2[0]);
            PG8_WAIT_V(8); PG8_WAIT_L(0); PG8_BAR; PG8_MMA(1, 0, At, B0); PG8_MMA(1, 1, At, B1); PG8_BAR; PG8_SCHED;
        }
        if (wr == 0) PG8_BAR;
        unsigned fvg[2][2], fvb[2][2];
        { Unit u2; const bool h2 = S.next(ui + 2, u2);
          if (h2) { const Operands o2 = AD(u2); PG8_BOFF(fvb, o2); if constexpr (GATHER) PG8_GIDX(fvg, o2); else PG8_AOFF(fvg, o2); }
          else { PG8_COPY(fvb, nvb); PG8_COPY(fvg, nvg); } }
        { int fr2 = fr, fq2 = fq; asm volatile("" : "+v"(fr2), "+v"(fq2));
          E(acc, cur, wr, wc, fr2, fq2); }
        if (!has_next) break;
        if constexpr (GATHER) PG8_WAIT_V(0);
        PG8_COPY(cvg, nvg); PG8_COPY(nvg, fvg); PG8_COPY(cvb, nvb); PG8_COPY(nvb, fvb);
        if (E.reset(cur)) {
#pragma unroll
        for (int a = 0; a < 2; ++a)
#pragma unroll
            for (int b = 0; b < 2; ++b)
#pragma unroll
                for (int m = 0; m < 4; ++m)
#pragma unroll
                    for (int n = 0; n < 2; ++n) acc[a][b][m][n] = (f32x4){0.f, 0.f, 0.f, 0.f};
        }
        cur = nxt; cA = nA; cB = nB; nt = nnt; ++ui;
        if (wr == 1) PG8_BAR;
    }
    PG8_WAIT_V(0);
    PG8_BAR;
#undef PG8_SA
#undef PG8_SB
#undef PG8_STAGE
#undef PG8_LDA
#undef PG8_LDB
#undef PG8_MMA
#undef PG8_WAIT_V
#undef PG8_WAIT_L
#undef PG8_BAR
#undef PG8_SCHED
#undef PG8_GIDX
#undef PG8_AOFF
#undef PG8_BOFF
#undef PG8_COPY
}
template <class F> struct EpiFn { F f; __device__ __forceinline__ void operator()(f32x4 (&acc)[2][2][4][2], const Unit& u, int wr, int wc, int fr, int fq) const { f(acc, u, wr, wc, fr, fq); } __device__ __forceinline__ bool reset(const Unit&) const { return true; } };
template <class F> __device__ __forceinline__ EpiFn<F> mk_epi(F f) { return EpiFn<F>{f}; }
template <class F> struct EpiSeg { F f; int last; __device__ __forceinline__ void operator()(f32x4 (&acc)[2][2][4][2], const Unit& u, int wr, int wc, int fr, int fq) const { f(acc, u, wr, wc, fr, fq); } __device__ __forceinline__ bool reset(const Unit& u) const { return u.seg == last; } };
template <class F> __device__ __forceinline__ EpiSeg<F> mk_epi_seg(F f, int last) { return EpiSeg<F>{f, last}; }
template <int NSEG> struct SegSched { GroupSched base; __device__ __forceinline__ bool next(int j, Unit& u) const { if (!base.next(j / NSEG, u)) return false; u.seg = j % NSEG; return true; } };
#ifndef DUP_PH
#define DUP_PH -1
#endif
#define REP_BEGIN(k) _Pragma("unroll 1") for (int rep_ = 0; rep_ < ((DUP_PH == (k)) ? 2 : 1); ++rep_) { if (rep_) { if constexpr (PH < 0) xcd_barrier(bar); }
#define REP_END }
#ifndef USE_FAST
#define USE_FAST 1
#endif
#if USE_FAST
#define GEMM(S, AD, E, K, lda, ldb) gemm_fast<false>(F.lds, F.tid, S, AD, mk_epi(E), nullptr)
#define GEMM_GATHER(S, AD, E, K, lda, ldb, rows) gemm_fast<true>(F.lds, F.tid, S, AD, mk_epi(E), rows)
#else
#define GEMM(S, AD, E, K, lda, ldb) gemm_simple(S, AD, E, K)
#endif
#define EPI_ARGS f32x4 (&acc)[2][2][4][2], const Unit& u, int wr, int wc, int fr, int fq
#define EPI_FOR(...) _Pragma("unroll") for (int ai = 0; ai < 2; ++ai) _Pragma("unroll") for (int m = 0; m < 4; ++m) { const int r = ai * 128 + wr * 64 + m * 16 + fr; \
    _Pragma("unroll") for (int bj = 0; bj < 2; ++bj) _Pragma("unroll") for (int n = 0; n < 2; ++n) { const int c = bj * 128 + wc * 32 + n * 16 + 4 * fq; const f32x4 v = acc[ai][bj][m][n]; __VA_ARGS__ } }
__device__ __forceinline__ void st_bf4(bf16* p, f32x4 v) { u32x2 w; w.x = pk2(v[0], v[1]); w.y = pk2(v[2], v[3]); *(u32x2*)p = w; }

__device__ __forceinline__ void p_mod(const Params& P, Frame& F) {
    LAS float* sc = (LAS float*)F.lds;
    LAS float* red = (LAS float*)(F.lds + 9 * 1024 * 4);
    float* MOD = WSP(float, WS_MOD);
    bool have = false;
    for (int it = F.bid; it < 2 * 96; it += F.G) {
        if (!have) {
            for (int i = F.tid; i < 9 * 1024; i += NTHREADS) { const int r = i >> 10, k = i & 1023; const float v = r < 8 ? P.c[r * 1024 + k] : P.c_ctx[k]; sc[i] = v * sigmoidf_(v); }
            have = true;
        }
        __syncthreads();
        const int l = it / 96, j0 = (it % 96) * 64, jj = F.tid & 63, kc = F.tid >> 6;
        const float* W = P.ada_w + (size_t)l * 1024 * 6144 + j0 + jj;
        float a[9];
#pragma unroll
        for (int r = 0; r < 9; ++r) a[r] = 0.f;
        for (int k = kc * 128; k < kc * 128 + 128; ++k) { const float w = W[(size_t)k * 6144];
#pragma unroll
            for (int r = 0; r < 9; ++r) a[r] += sc[r * 1024 + k] * w; }
#pragma unroll
        for (int r = 0; r < 9; ++r) red[(kc * 9 + r) * 64 + jj] = a[r];
        __syncthreads();
        for (int o = F.tid; o < 9 * 64; o += NTHREADS) { const int r = o >> 6, j = o & 63; float s = 0.f;
#pragma unroll
            for (int q = 0; q < 8; ++q) s += red[(q * 9 + r) * 64 + j];
            MOD[((size_t)l * 9 + r) * 6144 + j0 + j] = s + P.ada_b[l * 6144 + j0 + j]; }
    }
    __syncthreads();
}
__device__ __forceinline__ void p_dftgen(Frame& F) {
    LAS float* tab = (LAS float*)F.lds;
    for (int j = F.tid; j < 4096; j += NTHREADS) tab[j] = cospif((float)j * (1.0f / 2048.0f));
    __syncthreads();
    bf16* DM_ = WSP(bf16, WS_DFTM); bf16* DC_ = WSP(bf16, WS_DFTC);
    const int nchunk = 4096 * 1024 + 256 * 64;
    for (int ch = F.bid * NTHREADS + F.tid; ch < nchunk; ch += F.G * NTHREADS) {
        float v[8]; bf16* dst;
        if (ch < 4096 * 1024) { const int kf = ch >> 10, col0 = (ch & 1023) * 8, cs = col0 >> 12, l0 = col0 & 4095;
#pragma unroll
            for (int i = 0; i < 8; ++i) { const int j = (kf * (l0 + i)) & 4095; v[i] = cs ? -tab[(j + 3072) & 4095] : tab[j]; }
            dst = DM_ + (size_t)kf * 8192 + col0; }
        else { const int c2 = ch - 4096 * 1024, kf = c2 >> 6, col0 = (c2 & 63) * 8, cs = col0 >> 8, l0 = col0 & 255;
#pragma unroll
            for (int i = 0; i < 8; ++i) { const int j = ((kf * (l0 + i)) & 255) * 16; v[i] = cs ? -tab[(j + 3072) & 4095] : tab[j]; }
            dst = DC_ + (size_t)kf * 512 + col0; }
        u32x4 o; o.x = pk2(v[0], v[1]); o.y = pk2(v[2], v[3]); o.z = pk2(v[4], v[5]); o.w = pk2(v[6], v[7]);
        *(u32x4*)dst = o;
    }
    __syncthreads();
}
__device__ __forceinline__ void transpose_item(const float* W, int ldw, int k0, int n0, bf16* WT, int ldt, int drow0, LAS float* scr, int lane) {
    f32x4 ld[8];
#pragma unroll
    for (int i = 0; i < 8; ++i) ld[i] = *(const f32x4*)(W + (size_t)(k0 + 8 * i + (lane >> 3)) * ldw + n0 + 4 * (lane & 7));
#pragma unroll
    for (int i = 0; i < 8; ++i) { LAS float* d = scr + (8 * i + (lane >> 3)) * 33 + 4 * (lane & 7); d[0] = ld[i][0]; d[1] = ld[i][1]; d[2] = ld[i][2]; d[3] = ld[i][3]; }
    LDS_WAIT(); asm volatile("" ::: "memory");
    const int c = lane & 7;
#pragma unroll
    for (int j = 0; j < 4; ++j) { const int n = (lane >> 3) + 8 * j; const LAS float* s = scr + (8 * c) * 33 + n;
        u32x4 o; o.x = pk2(s[0 * 33], s[1 * 33]); o.y = pk2(s[2 * 33], s[3 * 33]); o.z = pk2(s[4 * 33], s[5 * 33]); o.w = pk2(s[6 * 33], s[7 * 33]);
        *(u32x4*)(WT + (size_t)(drow0 + n) * ldt + k0 + 8 * c) = o; }
    LDS_WAIT(); asm volatile("" ::: "memory");
}
__device__ __forceinline__ void p_wconv(const Params& P, Frame& F, int l) {
    LAS float* scr = (LAS float*)(F.lds + F.wave * 16384);
    const int gw = F.bid * NWAVES + F.wave, NGW = F.G * NWAVES;
    const float* w_in = P.w_in + (size_t)l * 1024 * INW;
    bf16* WA = WSP(bf16, WS_WA); bf16* WFV = WSP(bf16, WS_WFV);
    constexpr int I_K = 16 * 32, I_Q = 16 * 32, I_P = 16 * 16, I_G = 16 * 96, I_V = 16 * 32, I_AO = 16 * 32, I_FO = 8 * 32, I_OUT = 16 * 32;
    constexpr int NSM = I_K + I_Q + I_P + I_G + I_V + I_AO + I_FO + I_OUT;
    for (int it = gw; it < NSM; it += NGW) {
        int r = it;
        if (r < I_K) { transpose_item(w_in, INW, (r / 32) * 64, 0 + (r % 32) * 32, WA, 1024, 0 + (r % 32) * 32, scr, F.lane); continue; } r -= I_K;
        if (r < I_Q) { transpose_item(w_in, INW, (r / 32) * 64, 2048 + (r % 32) * 32, WA, 1024, 1024 + (r % 32) * 32, scr, F.lane); continue; } r -= I_Q;
        if (r < I_P) { transpose_item(w_in, INW, (r / 16) * 64, 3584 + (r % 16) * 32, WA, 1024, 2048 + (r % 16) * 32, scr, F.lane); continue; } r -= I_P;
        if (r < I_G) { transpose_item(w_in, INW, (r / 96) * 64, 4096 + (r % 96) * 32, WA, 1024, 2560 + (r % 96) * 32, scr, F.lane); continue; } r -= I_G;
        if (r < I_V) { transpose_item(w_in, INW, (r / 32) * 64, 1024 + (r % 32) * 32, WFV, 1024, 1024 + (r % 32) * 32, scr, F.lane); continue; } r -= I_V;
        if (r < I_AO) { transpose_item(P.w_att_o + (size_t)l * 1024 * 1024, 1024, (r / 32) * 64, (r % 32) * 32, WSP(bf16, WS_WAO), 1024, (r % 32) * 32, scr, F.lane); continue; } r -= I_AO;
        if (r < I_FO) { transpose_item(P.w_fourier + (size_t)l * 512 * 1024, 1024, (r / 32) * 64, (r % 32) * 32, WSP(bf16, WS_WFO), 512, (r % 32) * 32, scr, F.lane); continue; } r -= I_FO;
        transpose_item(P.w_out + (size_t)l * 1024 * 1024, 1024, (r / 32) * 64, (r % 32) * 32, WSP(bf16, WS_WOUT), 1024, (r % 32) * 32, scr, F.lane);
    }
    constexpr int I_E = 16 * 88;
    bf16* WGU = WSP(bf16, WS_WGU); bf16* WD = WSP(bf16, WS_WD);
    for (int it = gw; it < 3 * 16 * I_E; it += NGW) {
        const int which = it / (16 * I_E), r0 = it % (16 * I_E), e = r0 / I_E, r = r0 % I_E;
        if (which < 2) { const int kb = r / 88, nb = r % 88, n0 = nb * 32;
            const float* src = (which == 0 ? P.w_eg : P.w_eu) + ((size_t)l * 16 + e) * 1024 * FF;
            transpose_item(src, FF, kb * 64, n0, WGU + (size_t)e * 5632 * 1024, 1024, (n0 >> 7) * 256 + (which ? 128 : 0) + (n0 & 127), scr, F.lane); }
        else { const int kb = r / 32, nb = r % 32;
            transpose_item(P.w_ed + ((size_t)l * 16 + e) * FF * 1024, 1024, kb * 64, nb * 32, WD + (size_t)e * 1024 * FF, FF, nb * 32, scr, F.lane); }
    }
    { bf16* WPO = WSP(bf16, WS_WPO); const float* wp = P.w_pool + (size_t)l * 4 * 128 * 256;
      for (int i = F.bid * NTHREADS + F.tid; i < 1024 * 256; i += F.G * NTHREADS) { const int n = i >> 8, kk = i & 255, g = n >> 8, f = n & 255;
          WPO[i] = (bf16)(((kk >> 7) == (g & 1)) ? f2bf(wp[((size_t)g * 128 + (kk & 127)) * 256 + f]) : 0u); } }
    { LAS float* t128 = (LAS float*)F.lds;
      __syncthreads();
      for (int j = F.tid; j < 128; j += NTHREADS) t128[j] = cospif((float)j * (1.0f / 64.0f));
      __syncthreads();
      for (int i = F.bid * NTHREADS + F.tid; i < 1024 * 1024; i += F.G * NTHREADS) { const int fc = i >> 10, k = i & 1023, cs = fc & 1, gm = fc >> 1, g = gm >> 7, m = gm & 127;
          const float* src = w_in + (size_t)k * INW + 3072 + g * 128; float s = 0.f; const int ph = cs ? 96 : 0;
          for (int c = 0; c < 128; ++c) s += src[c] * t128[(m * c + ph) & 127];
          WFV[i] = (bf16)f2bf(s); }
      __syncthreads(); }
}

struct RowMod { const float* g; const float* sh; const float* sc; };
__device__ __forceinline__ void row_load(const float* row, int lane, f32x4 (&v)[4]) {
#pragma unroll
    for (int j = 0; j < 4; ++j) v[j] = *(const f32x4*)(row + 4 * lane + 256 * j);
}
__device__ __forceinline__ float row_rstd(const f32x4 (&v)[4]) {
    float s = 0.f;
#pragma unroll
    for (int j = 0; j < 4; ++j) s += (v[j][0] * v[j][0] + v[j][1] * v[j][1]) + (v[j][2] * v[j][2] + v[j][3] * v[j][3]);
    return rsqrtf(wave_sum(s) * (1.0f / 1024.0f) + RMS_EPS);
}
__device__ __forceinline__ void row_modulate(const f32x4 (&v)[4], float rstd, const RowMod& M, int lane, f32x4 (&y)[4]) {
#pragma unroll
    for (int j = 0; j < 4; ++j) { const int k = 4 * lane + 256 * j; const f32x4 g = *(const f32x4*)(M.g + k), sh = *(const f32x4*)(M.sh + k), sc = *(const f32x4*)(M.sc + k);
        y[j] = v[j] * rstd * g * (sc + 1.0f) + sh; }
}
__device__ __forceinline__ void row_store_bf(bf16* row, int lane, const f32x4 (&y)[4]) {
#pragma unroll
    for (int j = 0; j < 4; ++j) st_bf4(row + 4 * lane + 256 * j, y[j]);
}
__device__ __forceinline__ const float* mod_ptr(Frame& F, int l, int row, int which) { const int mr = row < RL ? (row >> 12) : 8; return WSP(float, WS_MOD) + ((size_t)l * 9 + mr) * 6144 + which * 1024; }

__device__ __forceinline__ void p_rowpass_a0(const Params& P, Frame& F) {
    const int gw = F.bid * NWAVES + F.wave, NGW = F.G * NWAVES; bf16* H = WSP(bf16, WS_H);
    for (int row = gw; row < RT; row += NGW) {
        const float* src = row < RL ? P.x + (size_t)row * DM : P.ctx + (size_t)(row - RL) * DM;
        f32x4 v[4], y[4]; row_load(src, F.lane, v); const float rs = row_rstd(v);
        RowMod M{P.norm1_g, mod_ptr(F, 0, row, 0), mod_ptr(F, 0, row, 1)};
        row_modulate(v, rs, M, F.lane, y); row_store_bf(H + (size_t)row * DM, F.lane, y);
    }
}
__device__ __forceinline__ void p_rowpass_f(const Params& P, Frame& F, int l, int nrows) {
    const int gw = F.bid * NWAVES + F.wave, NGW = F.G * NWAVES; bf16* H = WSP(bf16, WS_H); float* AFF = WSP(float, WS_AFF);
    const float* wr = P.w_router + (size_t)l * 1024 * 16;
    LAS float* wl = (LAS float*)F.lds;
    __syncthreads();
    for (int i = F.tid; i < 16384; i += NTHREADS) wl[(i & 15) * 1024 + (i >> 4)] = wr[i];
    __syncthreads();
    for (int row = gw; row < nrows; row += NGW) {
        const float* src = row < RL ? P.out + (size_t)row * DM : WSP(float, WS_XC) + (size_t)(row - RL) * DM;
        f32x4 v[4], y[4]; row_load(src, F.lane, v); const float rs = row_rstd(v);
        RowMod M{P.norm2_g + l * 1024, mod_ptr(F, l, row, 3), mod_ptr(F, l, row, 4)};
        row_modulate(v, rs, M, F.lane, y); row_store_bf(H + (size_t)row * DM, F.lane, y);
        float lg[16];
        int wo = 4 * F.lane; asm volatile("" : "+v"(wo));
#pragma unroll
        for (int e = 0; e < 16; ++e) { float a = 0.f;
#pragma unroll
            for (int j = 0; j < 4; ++j) { const f32x4 w = *(const LAS f32x4*)(wl + e * 1024 + wo + 256 * j); a += (y[j][0] * w[0] + y[j][1] * w[1]) + (y[j][2] * w[2] + y[j][3] * w[3]); }
            lg[e] = a; }
        float mx = -1e30f;
#pragma unroll
        for (int e = 0; e < 16; ++e) { lg[e] = wave_sum(lg[e]); mx = fmaxf(mx, lg[e]); }
        float den = 0.f;
#pragma unroll
        for (int e = 0; e < 16; ++e) { lg[e] = __expf(lg[e] - mx); den += lg[e]; }
        const float inv = 1.0f / den;
        if (F.lane < 16) { float mine = 0.f;
#pragma unroll
            for (int e = 0; e < 16; ++e) mine = (F.lane == e) ? lg[e] : mine;
            AFF[(size_t)row * 16 + F.lane] = mine * inv; }
    }
    __syncthreads();
}
__device__ __forceinline__ void p_rowpass_k(const Params& P, Frame& F, int l, int nrows) {
    const int gw = F.bid * NWAVES + F.wave, NGW = F.G * NWAVES; bf16* H = WSP(bf16, WS_H);
    const int* SEL = WSP(int, WS_SEL); const bf16* Y = WSP(bf16, WS_Y);
    for (int row = gw; row < nrows; row += NGW) {
        float* xr = row < RL ? P.out + (size_t)row * DM : WSP(float, WS_XC) + (size_t)(row - RL) * DM;
        f32x4 v[4], a[4]; row_load(xr, F.lane, v);
#pragma unroll
        for (int j = 0; j < 4; ++j) a[j] = (f32x4){0.f, 0.f, 0.f, 0.f};
        for (int e = 0; e < 16; ++e) { const int s = SEL[(size_t)row * 16 + e];
            if (s >= 0) { const bf16* yr = Y + (size_t)s * DM;
#pragma unroll
                for (int j = 0; j < 4; ++j) { const u32x2 w = *(const u32x2*)(yr + 4 * F.lane + 256 * j); a[j][0] += bflo(w.x); a[j][1] += bfhi(w.x); a[j][2] += bflo(w.y); a[j][3] += bfhi(w.y); } } }
        const float* g2 = mod_ptr(F, l, row, 5);
#pragma unroll
        for (int j = 0; j < 4; ++j) { const f32x4 g = *(const f32x4*)(g2 + 4 * F.lane + 256 * j); v[j] = v[j] + g * a[j]; }
        const float rs = row_rstd(v);
        if (l == 0) {
#pragma unroll
            for (int j = 0; j < 4; ++j) *(f32x4*)(xr + 4 * F.lane + 256 * j) = v[j];
            f32x4 y[4]; RowMod M{P.norm1_g + 1024, mod_ptr(F, 1, row, 0), mod_ptr(F, 1, row, 1)};
            row_modulate(v, rs, M, F.lane, y); row_store_bf(H + (size_t)row * DM, F.lane, y);
        } else {
#pragma unroll
            for (int j = 0; j < 4; ++j) { const f32x4 g = *(const f32x4*)(P.final_g + 4 * F.lane + 256 * j); *(f32x4*)(xr + 4 * F.lane + 256 * j) = v[j] * rs * g; }
        }
    }
}

__device__ __forceinline__ float dot64(const bf16x8 (&q)[8], const bf16* kp) {
    float s = 0.f;
#pragma unroll
    for (int i = 0; i < 8; ++i) { const u32x4 kw = *(const u32x4*)(kp + 8 * i); const u32x4 qw = __builtin_bit_cast(u32x4, q[i]);
#pragma unroll
        for (int t = 0; t < 4; ++t) s += bflo(kw[t]) * bflo(qw[t]) + bfhi(kw[t]) * bfhi(qw[t]); }
    return s;
}
__device__ __forceinline__ void p_attn_naive(const Params& P, Frame& F, int l, bool with_ctx_queries) {
    const int gw = F.bid * NWAVES + F.wave, NGW = F.G * NWAVES;
    const bf16* KQ = WSP(bf16, WS_KQ); const bf16* VT = WSP(bf16, WS_VT); bf16* ATT = WSP(bf16, WS_ATT);
    LAS float* pw = (LAS float*)(F.lds + F.wave * 2048);
    const float* rpb = P.rpb + (size_t)l * 16 * 15 * 31;
    const int nlat = NB * 64 * NH * 64, nitems = nlat + (with_ctx_queries ? NB * NH * CTXL : 0);
    for (int it = gw; it < nitems; it += NGW) {
        const bool lat = it < nlat;
        int b, h, r = 0, qc = 0, rowq;
        if (lat) { qc = it & 63; h = (it >> 6) & 15; r = (it >> 10) & 63; b = it >> 16; rowq = b * SEQ + r * 64 + qc; }
        else { const int i2 = it - nlat; qc = i2 & 255; h = (i2 >> 8) & 15; b = i2 >> 12; rowq = RL + b * CTXL + qc; }
        bf16x8 q[8];
        { const bf16* qp = KQ + (size_t)rowq * 2048 + 1024 + h * 64;
#pragma unroll
          for (int i = 0; i < 8; ++i) q[i] = *(const bf16x8*)(qp + 8 * i); }
        const int rs = min(max(r - 4, 0), 56), cs = min(max(qc - 8, 0), 48);
        float s[6];
        if (lat) {
#pragma unroll
            for (int t = 0; t < 2; ++t) { const int w = F.lane + 64 * t, i = w >> 4, j = w & 15; const int tok = (rs + i) * 64 + cs + j;
                s[t] = dot64(q, KQ + (size_t)(b * SEQ + tok) * 2048 + h * 64) * 0.125f + rpb[(h * 15 + (rs + i - r + 7)) * 31 + (cs + j - qc + 15)]; }
        } else { s[0] = -1e30f; s[1] = -1e30f; }
#pragma unroll
        for (int t = 0; t < 4; ++t) { const int c = F.lane + 64 * t; s[2 + t] = dot64(q, KQ + (size_t)(RL + b * CTXL + c) * 2048 + h * 64) * 0.125f; }
        float mx = s[0];
#pragma unroll
        for (int t = 1; t < 6; ++t) mx = fmaxf(mx, s[t]);
        mx = wave_max(mx);
        float sum = 0.f;
#pragma unroll
        for (int t = 0; t < 6; ++t) { s[t] = (lat || t >= 2) ? __expf(s[t] - mx) : 0.f; sum += s[t]; }
        sum = wave_sum(sum);
        pw[F.lane] = s[0]; pw[F.lane + 64] = s[1];
#pragma unroll
        for (int t = 0; t < 4; ++t) pw[128 + F.lane + 64 * t] = s[2 + t];
        LDS_WAIT(); asm volatile("" ::: "memory");
        float o = 0.f;
        if (lat) { const bf16* vr = VT + ((size_t)b * 1024 + h * 64 + F.lane) * 4096;
#pragma unroll 2
            for (int w = 0; w < 128; ++w) { const int tok = (rs + (w >> 4)) * 64 + cs + (w & 15); o += pw[w] * bf2f(vr[tok]); } }
        { const bf16* vr = VT + YT_CTX_OFF + ((size_t)b * 1024 + h * 64 + F.lane) * 256;
#pragma unroll 2
          for (int c8 = 0; c8 < 32; ++c8) { const u32x4 vw = *(const u32x4*)(vr + 8 * c8); const LAS float* pp = pw + 128 + 8 * c8;
#pragma unroll
              for (int t = 0; t < 4; ++t) o += pp[2 * t] * bflo(vw[t]) + pp[2 * t + 1] * bfhi(vw[t]); } }
        ATT[(size_t)rowq * 1024 + h * 64 + F.lane] = (bf16)f2bf(o / sum);
        LDS_WAIT(); asm volatile("" ::: "memory");
    }
}

constexpr int ACK_STRIDE = 72, ACV_STRIDE = 264;
constexpr int ALDS_CK = 0, ALDS_CV = 256 * ACK_STRIDE * 2, ALDS_RP = ALDS_CV + 64 * ACV_STRIDE * 2;
struct AttnState { float m, sum; f32x4 o[4]; };
__device__ __forceinline__ float xrow16_max(float x) {
    auto s = __builtin_amdgcn_permlane16_swap(__float_as_uint(x), __float_as_uint(x), false, false);
    x = fmaxf(__uint_as_float(s[0]), __uint_as_float(s[1]));
    auto t = __builtin_amdgcn_permlane32_swap(__float_as_uint(x), __float_as_uint(x), false, false);
    return fmaxf(__uint_as_float(t[0]), __uint_as_float(t[1]));
}
__device__ __forceinline__ float xrow16_sum(float x) {
    auto s = __builtin_amdgcn_permlane16_swap(__float_as_uint(x), __float_as_uint(x), false, false);
    x = __uint_as_float(s[0]) + __uint_as_float(s[1]);
    auto t = __builtin_amdgcn_permlane32_swap(__float_as_uint(x), __float_as_uint(x), false, false);
    return __uint_as_float(t[0]) + __uint_as_float(t[1]);
}
#define MFMA16(a, b, c) __builtin_amdgcn_mfma_f32_16x16x32_bf16((a), (b), (c), 0, 0, 0)
template <int NT>
__device__ __forceinline__ void attn_tail(AttnState& S, f32x4 (&sc)[NT], const u32x4 (&vw)[NT / 2][4]) {
    float cm = -1e30f;
#pragma unroll
    for (int t = 0; t < NT; ++t)
#pragma unroll
        for (int j = 0; j < 4; ++j) cm = fmaxf(cm, sc[t][j]);
    cm = xrow16_max(cm);
    const float mn = fmaxf(S.m, cm), scl = __builtin_amdgcn_exp2f(S.m - mn); S.m = mn; float ps = 0.f;
#pragma unroll
    for (int t = 0; t < NT; ++t)
#pragma unroll
        for (int j = 0; j < 4; ++j) { const float p = __builtin_amdgcn_exp2f(sc[t][j] - mn); sc[t][j] = p; ps += p; }
    S.sum = S.sum * scl + ps;
#pragma unroll
    for (int dt = 0; dt < 4; ++dt) S.o[dt] = S.o[dt] * scl;
#pragma unroll
    for (int ks = 0; ks < NT / 2; ++ks) { u32x4 pw; pw.x = pk2(sc[2 * ks][0], sc[2 * ks][1]); pw.y = pk2(sc[2 * ks][2], sc[2 * ks][3]); pw.z = pk2(sc[2 * ks + 1][0], sc[2 * ks + 1][1]); pw.w = pk2(sc[2 * ks + 1][2], sc[2 * ks + 1][3]);
        const bf16x8 pf = __builtin_bit_cast(bf16x8, pw);
#pragma unroll
        for (int dt = 0; dt < 4; ++dt) S.o[dt] = MFMA16(__builtin_bit_cast(bf16x8, vw[ks][dt]), pf, S.o[dt]); }
}
__device__ __forceinline__ void attn_unit2(const bf16* __restrict__ KQ, const bf16* __restrict__ VT, bf16* __restrict__ ATT, LAS unsigned char* lds,
                                           const int b, const int h, const int rowqA, const int rowqB, const bool win, const int r, const int qt, const int lane) {
    const int l15 = lane & 15, g = lane >> 4;
    const f32x4 z = {0.f, 0.f, 0.f, 0.f};
    bf16x8 qA[2], qB[2];
    { const bf16* qp = KQ + (size_t)(rowqA + l15) * 2048 + 1024 + h * 64 + 8 * g; qA[0] = *(const bf16x8*)qp; qA[1] = *(const bf16x8*)(qp + 32); }
    { const bf16* qp = KQ + (size_t)(rowqB + l15) * 2048 + 1024 + h * 64 + 8 * g; qB[0] = *(const bf16x8*)qp; qB[1] = *(const bf16x8*)(qp + 32); }
    AttnState SA, SB; SA.m = -1e30f; SA.sum = 0.f; SB.m = -1e30f; SB.sum = 0.f;
#pragma unroll
    for (int dt = 0; dt < 4; ++dt) { SA.o[dt] = z; SB.o[dt] = z; }
    if (win) {
        const int rsA = min(max(r - 4, 0), 56), dB = min(max(r - 3, 0), 56) - rsA, kc0 = min(max(16 * qt - 8, 0), 32);
        const int q = 16 * qt + l15, csq = min(max(q - 8, 0), 48);
        const int krow0 = 8 * (l15 >> 2) + (l15 & 3);
        const bf16* kb = KQ + (size_t)(b * SEQ + kc0 + krow0) * 2048 + h * 64 + 8 * g;
        const bf16* vb = VT + (size_t)(b * 1024 + h * 64 + l15) * 4096 + kc0 + 8 * g;
        const LAS float* rp = (const LAS float*)(lds + ALDS_RP);
        const int jb = kc0 + 8 * g;
        const int okb = jb - csq;
        const LAS float* rpl = rp + 16 + (jb - q + 15);
        float madd[2][4];
#pragma unroll
        for (int t = 0; t < 2; ++t)
#pragma unroll
            for (int j = 0; j < 4; ++j) madd[t][j] = ((unsigned)(okb + 4 * t + j) < 16u) ? 0.f : -__builtin_inff();
        bf16x8 K0[2][2], K1[2][2]; u32x4 V0[1][4], V1[1][4];
#define ATT_LOADW(KB, VB, i) do { const int gr_ = min(rsA + (i), 63); const bf16* kp_ = kb + (size_t)(gr_ * 64) * 2048; const bf16* vp_ = vb + gr_ * 64; \
        _Pragma("unroll") for (int t = 0; t < 2; ++t) { KB[t][0] = *(const bf16x8*)(kp_ + (size_t)(4 * t) * 2048); KB[t][1] = *(const bf16x8*)(kp_ + (size_t)(4 * t) * 2048 + 32); } \
        _Pragma("unroll") for (int dt = 0; dt < 4; ++dt) VB[0][dt] = *(const u32x4*)(vp_ + (size_t)(16 * dt) * 4096); } while (0)
#define ATT_ONE(ST, QF, KB, VB, roff, rowok) do { f32x4 sc[2]; \
        _Pragma("unroll") for (int t = 0; t < 2; ++t) { sc[t] = MFMA16(KB[t][0], QF[0], z); sc[t] = MFMA16(KB[t][1], QF[1], sc[t]); } \
        const LAS float* bp_ = rpl + ((rowok) ? (roff) : 15) * 64; \
        _Pragma("unroll") for (int t = 0; t < 2; ++t) _Pragma("unroll") for (int j = 0; j < 4; ++j) sc[t][j] = (sc[t][j] + bp_[4 * t + j]) + madd[t][j]; \
        attn_tail<2>(ST, sc, VB); } while (0)
#define ATT_COMPUTE(KB, VB, i) do { const int roffA_ = min(rsA + (i) - r + 7, 14); \
        ATT_ONE(SA, qA, KB, VB, roffA_, (i) <= 7); \
        ATT_ONE(SB, qB, KB, VB, max(roffA_ - 1, 0), (i) >= dB && (i) <= 7 + dB); } while (0)
        ATT_LOADW(K0, V0, 0);
#pragma unroll 1
        for (int i = 0; i < 8; i += 2) { ATT_LOADW(K1, V1, i + 1); ATT_COMPUTE(K0, V0, i); ATT_LOADW(K0, V0, i + 2); ATT_COMPUTE(K1, V1, i + 1); }
        ATT_COMPUTE(K0, V0, 8);
#undef ATT_LOADW
#undef ATT_ONE
#undef ATT_COMPUTE
    }
    { const LAS bf16* ck = (const LAS bf16*)(lds + ALDS_CK) + l15 * ACK_STRIDE + 8 * g;
      const LAS bf16* cv = (const LAS bf16*)(lds + ALDS_CV) + l15 * ACV_STRIDE + 8 * g;
#pragma unroll 1
      for (int c = 0; c < 4; ++c) {
          bf16x8 kf[4][2]; u32x4 vw[2][4];
#pragma unroll
          for (int t = 0; t < 4; ++t) { const LAS bf16* kp = ck + (64 * c + 16 * t) * ACK_STRIDE; kf[t][0] = *(const LAS bf16x8*)kp; kf[t][1] = *(const LAS bf16x8*)(kp + 32); }
#pragma unroll
          for (int ks = 0; ks < 2; ++ks)
#pragma unroll
              for (int dt = 0; dt < 4; ++dt) vw[ks][dt] = *(const LAS u32x4*)(cv + (16 * dt) * ACV_STRIDE + 64 * c + 32 * ks);
          { f32x4 sc[4];
#pragma unroll
            for (int t = 0; t < 4; ++t) { sc[t] = MFMA16(kf[t][0], qA[0], z); sc[t] = MFMA16(kf[t][1], qA[1], sc[t]); }
            attn_tail<4>(SA, sc, vw); }
          { f32x4 sc[4];
#pragma unroll
            for (int t = 0; t < 4; ++t) { sc[t] = MFMA16(kf[t][0], qB[0], z); sc[t] = MFMA16(kf[t][1], qB[1], sc[t]); }
            attn_tail<4>(SB, sc, vw); }
      } }
    { const float inv = 1.0f / xrow16_sum(SA.sum);
#pragma unroll
      for (int dt = 0; dt < 4; ++dt) st_bf4(ATT + (size_t)(rowqA + l15) * 1024 + h * 64 + 16 * dt + 4 * g, SA.o[dt] * inv); }
    { const float inv = 1.0f / xrow16_sum(SB.sum);
#pragma unroll
      for (int dt = 0; dt < 4; ++dt) st_bf4(ATT + (size_t)(rowqB + l15) * 1024 + h * 64 + 16 * dt + 4 * g, SB.o[dt] * inv); }
}
__device__ __forceinline__ void p_attn_mfma(const Params& P, Frame& F, int l, bool with_ctx_queries) {
    const bf16* KQ = WSP(bf16, WS_KQ); const bf16* VT = WSP(bf16, WS_VT); bf16* ATT = WSP(bf16, WS_ATT);
    const float* rpb = P.rpb + (size_t)l * 16 * 465;
    for (int hp = F.bid; hp < 256; hp += F.G) {
        const int p = hp & 127, half = hp >> 7, b = p >> 4, h = p & 15;
        __syncthreads();
        { LAS bf16* ck = (LAS bf16*)(F.lds + ALDS_CK); LAS bf16* cv = (LAS bf16*)(F.lds + ALDS_CV); LAS float* rp = (LAS float*)(F.lds + ALDS_RP);
          { const int key = F.tid >> 1, hf = F.tid & 1; const int k32 = key & 31, pos = (key & ~31) + ((k32 >> 2) & 1) * 16 + 4 * (k32 >> 3) + (k32 & 3);
            const u32x4* src = (const u32x4*)(KQ + (size_t)(RL + b * CTXL + key) * 2048 + h * 64 + hf * 32); LAS u32x4* dst = (LAS u32x4*)(ck + pos * ACK_STRIDE + hf * 32);
#pragma unroll
            for (int i = 0; i < 4; ++i) dst[i] = src[i]; }
          { const int d = F.tid >> 3, sg = F.tid & 7; const u32x4* src = (const u32x4*)(VT + YT_CTX_OFF + (size_t)(b * 1024 + h * 64 + d) * 256 + sg * 32); LAS u32x4* dst = (LAS u32x4*)(cv + d * ACV_STRIDE + sg * 32);
#pragma unroll
            for (int i = 0; i < 4; ++i) dst[i] = src[i]; }
          for (int i = F.tid; i < 16 * 64; i += NTHREADS) { const int rr = i >> 6, cc = (i & 63) - 16; rp[i] = rr == 15 ? -__builtin_inff() : ((cc >= 0 && cc < 31) ? rpb[h * 465 + rr * 31 + cc] * LOG2E : 0.f); } }
        __syncthreads();
        const int qt = F.wave & 3, rpi = F.wave >> 2;
#pragma unroll 1
        for (int st = 0; st < 8; ++st) { const int r = half * 32 + st * 4 + rpi * 2; const int rowqA = b * SEQ + r * 64 + 16 * qt;
            attn_unit2(KQ, VT, ATT, F.lds, b, h, rowqA, rowqA + 64, true, r, qt, F.lane); }
        if (with_ctx_queries && half == 0) { const int rowqA = RL + b * CTXL + 32 * F.wave; attn_unit2(KQ, VT, ATT, F.lds, b, h, rowqA, rowqA + 16, false, 0, 0, F.lane); }
    }
    __syncthreads();
}

__device__ __forceinline__ void p_pool(Frame& F, int nrows) {
    const bf16* PB = WSP(bf16, WS_PB); bf16* POOL = WSP(bf16, WS_POOL);
    for (int i = F.bid * NTHREADS + F.tid; i < nrows * 64; i += F.G * NTHREADS) {
        const int row = i >> 6, ch = i & 63, g = ch >> 4, hw = 1 << g;
        int base, t, Lb; if (row < RL) { base = row & ~4095; t = row & 4095; Lb = SEQ; } else { const int rr = row - RL; base = RL + (rr & ~255); t = rr & 255; Lb = CTXL; }
        const int lo = max(t - hw, 0), hi = min(t + hw, Lb);
        float a[8];
#pragma unroll
        for (int q = 0; q < 8; ++q) a[q] = 0.f;
        for (int tt = lo; tt < hi; ++tt) { const u32x4 w = *(const u32x4*)(PB + (size_t)(base + tt) * 512 + ch * 8);
#pragma unroll
            for (int q = 0; q < 4; ++q) { a[2 * q] += bflo(w[q]); a[2 * q + 1] += bfhi(w[q]); } }
        const u32x4 me = *(const u32x4*)(PB + (size_t)row * 512 + ch * 8); const float inv = 1.0f / (float)(hi - lo);
        u32x4 o;
#pragma unroll
        for (int q = 0; q < 4; ++q) o[q] = pk2(a[2 * q] * inv - bflo(me[q]), a[2 * q + 1] * inv - bfhi(me[q]));
        *(u32x4*)(POOL + (size_t)row * 512 + ch * 8) = o;
    }
}

__device__ __forceinline__ int block_sum_i(int v, LAS int* sm, int tid) {
#pragma unroll
    for (int o = 1; o < 64; o <<= 1) v += __shfl_xor(v, o);
    __syncthreads();
    if ((tid & 63) == 0) sm[tid >> 6] = v;
    __syncthreads();
    int s = 0;
#pragma unroll
    for (int i = 0; i < 8; ++i) s += sm[i];
    return s;
}
__device__ __forceinline__ int block_excl_scan(int v, LAS int* sm, int tid, int& total) {
    const int lane = tid & 63, w = tid >> 6; int inc = v;
#pragma unroll
    for (int o = 1; o < 64; o <<= 1) { const int t = __shfl_up(inc, o); if (lane >= o) inc += t; }
    __syncthreads();
    if (lane == 63) sm[w] = inc;
    __syncthreads();
    int base = 0; total = 0;
#pragma unroll
    for (int i = 0; i < 8; ++i) { const int s = sm[i]; if (i < w) base += s; total += s; }
    return base + inc - v;
}
template <int NPT>
__device__ __forceinline__ void topk_pair(Frame& F, int row0, int n, int cap, int e, int slot0) {
    LAS int* sm = (LAS int*)F.lds;
    const float* AFF = WSP(float, WS_AFF); int* SROW = WSP(int, WS_SROW); float* SG = WSP(float, WS_SGATE); int* SEL = WSP(int, WS_SEL);
    unsigned key[NPT];
#pragma unroll
    for (int j = 0; j < NPT; ++j) { const int i = F.tid * NPT + j; key[j] = (i < n) ? __float_as_uint(AFF[(size_t)(row0 + i) * 16 + e]) : 0u; }
    unsigned T = 0u;
    for (int bit = 30; bit >= 0; --bit) { const unsigned cand = T | (1u << bit); int cnt = 0;
#pragma unroll
        for (int j = 0; j < NPT; ++j) cnt += (key[j] >= cand) ? 1 : 0;
        cnt = block_sum_i(cnt, sm, F.tid);
        if (cnt >= cap) T = cand; }
    int ngt = 0, neq = 0;
#pragma unroll
    for (int j = 0; j < NPT; ++j) { ngt += (key[j] > T) ? 1 : 0; neq += (key[j] == T) ? 1 : 0; }
    int tot_gt, tot_eq;
    (void)block_excl_scan(ngt, sm, F.tid, tot_gt);
    int eqr = block_excl_scan(neq, sm, F.tid, tot_eq);
    const int need_eq = cap - tot_gt;
    int nsel = 0; bool selj[NPT];
#pragma unroll
    for (int j = 0; j < NPT; ++j) { bool s = key[j] > T; if (key[j] == T && T != 0u) { s = eqr < need_eq; ++eqr; } selj[j] = s; nsel += s ? 1 : 0; }
    int tot_sel; int pos = block_excl_scan(nsel, sm, F.tid, tot_sel);
#pragma unroll
    for (int j = 0; j < NPT; ++j) { const int i = F.tid * NPT + j;
        if (i < n) { const int row = row0 + i;
            if (selj[j]) { const int slot = slot0 + pos; ++pos; SROW[slot] = row; SG[slot] = __uint_as_float(key[j]); SEL[(size_t)row * 16 + e] = slot; }
            else SEL[(size_t)row * 16 + e] = -1; } }
    __syncthreads();
}
__device__ __forceinline__ void p_topk(Frame& F, bool with_ctx) {
    const int npairs = 128 + (with_ctx ? 128 : 0);
    for (int pi = F.bid; pi < npairs; pi += F.G) {
        if (pi < 128) { const int b = pi >> 4, e = pi & 15; topk_pair<8>(F, b * SEQ, SEQ, CAPL, e, e * SLOT_E + b * CAPL); }
        else { const int p2 = pi - 128, b = p2 >> 4, e = p2 & 15; topk_pair<1>(F, RL + b * CTXL, CTXL, CAPC, e, e * SLOT_E + 4096 + b * CAPC); }
    }
}
__device__ __forceinline__ void p_gather(Frame& F, bool with_ctx) {
    const int gw = F.bid * NWAVES + F.wave, NGW = F.G * NWAVES; const bf16* H = WSP(bf16, WS_H); bf16* XG = WSP(bf16, WS_XG); const int* SROW = WSP(int, WS_SROW);
    for (int s = gw; s < NSLOT; s += NGW) { if (!with_ctx && (s % SLOT_E) >= 4096) continue;
        const int row = SROW[s]; const u32x4* src = (const u32x4*)(H + (size_t)row * DM); u32x4* dst = (u32x4*)(XG + (size_t)s * DM);
        dst[F.lane] = src[F.lane]; dst[F.lane + 64] = src[F.lane + 64]; }
}

template <int PH> __global__ void __launch_bounds__(NTHREADS, 2) fwd_kernel(Params P) {
    extern __shared__ __attribute__((aligned(16))) unsigned char lds_raw[];
    Frame F; F.lds = (LAS unsigned char*)lds_raw; F.tid = threadIdx.x; F.lane = F.tid & 63; F.wave = __builtin_amdgcn_readfirstlane(F.tid >> 6); F.G = gridDim.x; F.bid = blockIdx.x; F.ws = P.ws;
    volatile LAS unsigned* MISC = (volatile LAS unsigned*)(F.lds + LDS_MISC);
    if (F.tid < 64) MISC[F.tid] = 0u;
    __syncthreads();
    XcdBarrier bar; bar.bar = WSP(unsigned, WS_CTL) + CW_BAR; bar.x = 0; bar.st = MISC + 8;
    if constexpr (PH < 0) bar = xcd_barrier_post(WSP(unsigned, WS_CTL) + CW_BAR, MISC + 8);
#define IN(k) (PH < 0 || PH == (k))
#define REFRESH() do { int t_ = threadIdx.x; asm volatile("" : "+v"(t_)); F.tid = t_; F.lane = t_ & 63; F.wave = __builtin_amdgcn_readfirstlane(t_ >> 6); } while (0)
#define SEAM(k) do { if constexpr (PH < 0) xcd_barrier(bar); } while (0)

    if (IN(0)) { REP_BEGIN(100) p_mod(P, F); p_dftgen(F); REP_END REP_BEGIN(101) p_wconv(P, F, 0); REP_END }
    SEAM(0);
    if (IN(1)) { p_rowpass_a0(P, F); }
    SEAM(1);
    for (int l = P.l_lo; l < P.l_hi; ++l) {
        constexpr int pb = 2; const bool L0 = (l == 0);
        bf16* H = WSP(bf16, WS_H);
        if (IN(pb + 0)) { REFRESH(); REP_BEGIN(2)
            { GroupSched S; S.init(1, 128, 22, F.G, F.bid, 8, L0 ? 22 : 4, 128, 0);
              const bf16* WA = WSP(bf16, WS_WA);
              auto AD = [=](const Unit& u) { return Operands{H + (size_t)u.pm * 256 * DM, WA + (size_t)u.pn * 256 * DM, DM, DM, 0, DM}; };
              bf16* KQ = WSP(bf16, WS_KQ); bf16* PBp = WSP(bf16, WS_PB); bf16* GB = WSP(bf16, WS_GB);
              auto E = [=](EPI_ARGS) { const int row0 = u.pm * 256;
                  if (u.pn < 8) { const float qs = (u.pn >= 4) ? QSCALE : 1.0f; EPI_FOR( st_bf4(KQ + (size_t)(row0 + r) * 2048 + u.pn * 256 + c, v * qs); ) }
                  else if (u.pn < 10) { EPI_FOR( st_bf4(PBp + (size_t)(row0 + r) * 512 + (u.pn - 8) * 256 + c, v); ) }
                  else { EPI_FOR( f32x4 s; s[0] = sigmoidf_(v[0]); s[1] = sigmoidf_(v[1]); s[2] = sigmoidf_(v[2]); s[3] = sigmoidf_(v[3]); st_bf4(GB + (size_t)(row0 + r) * 3072 + (u.pn - 10) * 256 + c, s); ) } };
              GEMM(S, AD, E, DM, DM, DM); }
            { GroupSched S; S.init(1, 8, 128, F.G, F.bid, L0 ? 8 : 4, 8, L0 ? 0 : 4, 128);
              const bf16* WFV = WSP(bf16, WS_WFV);
              auto AD = [=](const Unit& u) { return Operands{WFV + (size_t)u.pm * 256 * DM, H + (size_t)u.pn * 256 * DM, DM, DM, 0, DM}; };
              bf16* YT = WSP(bf16, WS_YT); bf16* VT = WSP(bf16, WS_VT);
              auto E = [=](EPI_ARGS) { bf16* T = (u.pm < 4) ? YT : VT; const int rr0 = (u.pm & 3) * 256;
                  if (u.pn < 128) { const int b = u.pn >> 4, l0 = (u.pn & 15) * 256; EPI_FOR( st_bf4(T + ((size_t)b * 1024 + rr0 + r) * 4096 + l0 + c, v); ) }
                  else { const int b = u.pn - 128; EPI_FOR( st_bf4(T + YT_CTX_OFF + ((size_t)b * 1024 + rr0 + r) * 256 + c, v); ) } };
              GEMM(S, AD, E, DM, DM, DM); }
        REP_END }
        SEAM(pb + 0);
        if (IN(pb + 1)) { REFRESH();
            REP_BEGIN(31) p_attn_mfma(P, F, l, L0); REP_END
            REP_BEGIN(32)
            { GroupSched S; S.init(1, 16, 16, F.G, F.bid);
              const bf16* DFTM = WSP(bf16, WS_DFTM); const bf16* YT = WSP(bf16, WS_YT); bf16* FOUR = WSP(bf16, WS_FOUR);
              auto AD = [=](const Unit& u) { return Operands{DFTM + (size_t)u.pm * 256 * 8192, YT + (size_t)u.pn * 256 * 8192, 8192, 8192, 0, 8192}; };
              auto E = [=](EPI_ARGS) { const int b = u.pn >> 1, c0 = (u.pn & 1) * 256; const float sc = 0.0013810679320049757f;
                  EPI_FOR( st_bf4(FOUR + ((size_t)b * SEQ + u.pm * 256 + r) * 512 + c0 + c, v * sc); ) };
              GEMM(S, AD, E, 8192, 8192, 8192); }
            if (L0) { GroupSched S; S.init(1, 1, 16, F.G, F.bid);
              const bf16* DFTC = WSP(bf16, WS_DFTC); const bf16* YTC = WSP(bf16, WS_YT) + YT_CTX_OFF; bf16* FOUR = WSP(bf16, WS_FOUR);
              auto AD = [=](const Unit& u) { return Operands{DFTC, YTC + (size_t)u.pn * 256 * 512, 512, 512, 0, 512}; };
              auto E = [=](EPI_ARGS) { const int b = u.pn >> 1, c0 = (u.pn & 1) * 256; const float sc = 0.005524271728019903f;
                  EPI_FOR( st_bf4(FOUR + ((size_t)RL + b * CTXL + r) * 512 + c0 + c, v * sc); ) };
              GEMM(S, AD, E, 512, 512, 512); }
            REP_END
            REP_BEGIN(33) p_pool(F, L0 ? RT : RL); REP_END
        }
        SEAM(pb + 1);
        if (IN(pb + 2)) { REFRESH();
            SegSched<3> S; S.base.init(1, L0 ? 136 : 128, 4, F.G, F.bid);
            const bf16* ATT = WSP(bf16, WS_ATT); const bf16* FOUR = WSP(bf16, WS_FOUR); const bf16* POOL = WSP(bf16, WS_POOL);
            const bf16* WAO = WSP(bf16, WS_WAO); const bf16* WFO = WSP(bf16, WS_WFO); const bf16* WPO = WSP(bf16, WS_WPO);
            const bf16* GB = WSP(bf16, WS_GB); bf16* MRGB = WSP(bf16, WS_MRGB); const float* ps = P.pool_scale + l * 1024;
            auto AD = [=](const Unit& u) {
                if (u.seg == 0) return Operands{ATT + (size_t)u.pm * 256 * 1024, WAO + (size_t)u.pn * 256 * 1024, 1024, 1024, 0, 1024};
                if (u.seg == 1) return Operands{FOUR + (size_t)u.pm * 256 * 512, WFO + (size_t)u.pn * 256 * 512, 512, 512, 0, 512};
                return Operands{POOL + (size_t)u.pm * 256 * 512 + (u.pn >> 1) * 256, WPO + (size_t)u.pn * 256 * 256, 512, 256, 0, 256}; };
            auto E = [=](EPI_ARGS) {
                const int kd = u.seg < 2 ? u.seg + 1 : 2; const bool fin = (u.seg == 2);
                f32x4 psv[2][2];
#pragma unroll
                for (int bj = 0; bj < 2; ++bj)
#pragma unroll
                    for (int n = 0; n < 2; ++n) psv[bj][n] = *(const f32x4*)(ps + u.pn * 256 + bj * 128 + wc * 32 + n * 16 + 4 * fq);
#pragma unroll
                for (int ai = 0; ai < 2; ++ai)
#pragma unroll
                    for (int m = 0; m < 4; ++m) { const size_t row = (size_t)u.pm * 256 + ai * 128 + wr * 64 + m * 16 + fr; const bf16* gr = GB + row * 3072 + u.pn * 256 + wc * 32 + 4 * fq;
                        u32x2 nr[2][2], dr[2][2];
#pragma unroll
                        for (int bj = 0; bj < 2; ++bj)
#pragma unroll
                            for (int n = 0; n < 2; ++n) { nr[bj][n] = *(const u32x2*)(gr + u.seg * 1024 + bj * 128 + n * 16); dr[bj][n] = *(const u32x2*)(gr + kd * 1024 + bj * 128 + n * 16); }
#pragma unroll
                        for (int bj = 0; bj < 2; ++bj)
#pragma unroll
                            for (int n = 0; n < 2; ++n) { f32x4 nu = {bflo(nr[bj][n].x), bfhi(nr[bj][n].x), bflo(nr[bj][n].y), bfhi(nr[bj][n].y)}, de = {bflo(dr[bj][n].x), bfhi(dr[bj][n].x), bflo(dr[bj][n].y), bfhi(dr[bj][n].y)};
                                if (u.seg == 2) nu = nu * psv[bj][n];
                                de = de * psv[bj][n];
                                f32x4 o;
#pragma unroll
                                for (int j = 0; j < 4; ++j) { const float nj = (fabsf(nu[j]) < 1e-30f) ? copysignf(1e-30f, nu[j]) : nu[j]; const float dj = (fabsf(de[j]) < 1e-30f) ? copysignf(1e-30f, de[j]) : de[j];
                                    o[j] = acc[ai][bj][m][n][j] * nj * (fin ? 1.0f : __builtin_amdgcn_rcpf(dj)); }
                                acc[ai][bj][m][n] = o; if (fin) st_bf4(MRGB + row * 1024 + u.pn * 256 + bj * 128 + wc * 32 + n * 16 + 4 * fq, o); } } };
            gemm_fast<false>(F.lds, F.tid, S, AD, mk_epi_seg(E, 2), nullptr);
        }
        SEAM(pb + 2);
        if (IN(pb + 3)) { REFRESH();
            GroupSched S; S.init(1, L0 ? 136 : 128, 4, F.G, F.bid); const bf16* A = WSP(bf16, WS_MRGB); const bf16* W = WSP(bf16, WS_WOUT);
            const float* xin = L0 ? P.x : P.out; const float* cin = L0 ? P.ctx : WSP(float, WS_XC); float* xo = P.out; float* co = WSP(float, WS_XC);
            const float* MOD = WSP(float, WS_MOD) + (size_t)l * 9 * 6144;
            auto AD = [=](const Unit& u) { return Operands{A + (size_t)u.pm * 256 * 1024, W + (size_t)u.pn * 256 * 1024, 1024, 1024, 0, 1024}; };
            auto E = [=](EPI_ARGS) {
                const int row0 = u.pm * 256, mr = row0 < RL ? (row0 >> 12) : 8, colb = u.pn * 256 + wc * 32 + 4 * fq;
                const float* src0 = row0 < RL ? xin + (size_t)row0 * DM : cin + (size_t)(row0 - RL) * DM; float* dst0 = row0 < RL ? xo + (size_t)row0 * DM : co + (size_t)(row0 - RL) * DM;
                f32x4 gv[2][2];
#pragma unroll
                for (int bj = 0; bj < 2; ++bj)
#pragma unroll
                    for (int n = 0; n < 2; ++n) gv[bj][n] = *(const f32x4*)(MOD + (size_t)mr * 6144 + 2048 + colb + bj * 128 + n * 16);
#pragma unroll
                for (int ai = 0; ai < 2; ++ai)
#pragma unroll
                    for (int m = 0; m < 4; ++m) { const size_t ro = (size_t)(ai * 128 + wr * 64 + m * 16 + fr) * DM + colb; f32x4 xv[2][2];
#pragma unroll
                        for (int bj = 0; bj < 2; ++bj)
#pragma unroll
                            for (int n = 0; n < 2; ++n) xv[bj][n] = *(const f32x4*)(src0 + ro + bj * 128 + n * 16);
#pragma unroll
                        for (int bj = 0; bj < 2; ++bj)
#pragma unroll
                            for (int n = 0; n < 2; ++n) *(f32x4*)(dst0 + ro + bj * 128 + n * 16) = xv[bj][n] + gv[bj][n] * acc[ai][bj][m][n]; } };
            GEMM(S, AD, E, 1024, 1024, 1024);
        }
        SEAM(pb + 3);
        if (IN(pb + 4)) { REFRESH(); REP_BEGIN(6) p_rowpass_f(P, F, l, L0 ? RT : RL); REP_END }
        SEAM(pb + 4);
        if (IN(pb + 5)) { REFRESH(); REP_BEGIN(7) p_topk(F, L0); REP_END }
        SEAM(pb + 5);
        if (IN(pb + 7)) { REFRESH(); REP_BEGIN(9)
            GroupSched S; S.init(16, L0 ? 17 : 16, 22, F.G, F.bid); const bf16* W = WSP(bf16, WS_WGU); bf16* HID = WSP(bf16, WS_HID); const int* SROW = WSP(int, WS_SROW);
            auto AD = [=](const Unit& u) { return Operands{H, W + ((size_t)u.grp * 5632 + u.pn * 256) * DM, DM, DM, u.grp * SLOT_E + u.pm * 256, DM}; };
            auto E = [=](EPI_ARGS) {
#pragma unroll
                for (int ai = 0; ai < 2; ++ai)
#pragma unroll
                    for (int m = 0; m < 4; ++m) { const size_t slot = (size_t)u.grp * SLOT_E + u.pm * 256 + ai * 128 + wr * 64 + m * 16 + fr;
#pragma unroll
                        for (int n = 0; n < 2; ++n) { const f32x4 a = acc[ai][0][m][n], up = acc[ai][1][m][n]; f32x4 o;
#pragma unroll
                            for (int j = 0; j < 4; ++j) o[j] = a[j] * sigmoidf_(a[j]) * up[j];
                            st_bf4(HID + slot * FF + u.pn * 128 + wc * 32 + n * 16 + 4 * fq, o); } } };
            GEMM_GATHER(S, AD, E, DM, DM, DM, SROW);
        REP_END }
        SEAM(pb + 7);
        if (IN(pb + 8)) { REFRESH(); REP_BEGIN(10)
            GroupSched S; S.init(16, L0 ? 17 : 16, 4, F.G, F.bid); const bf16* HID = WSP(bf16, WS_HID); const bf16* W = WSP(bf16, WS_WD); bf16* Y = WSP(bf16, WS_Y); const float* SG = WSP(float, WS_SGATE);
            auto AD = [=](const Unit& u) { return Operands{HID + ((size_t)u.grp * SLOT_E + u.pm * 256) * FF, W + ((size_t)u.grp * 1024 + u.pn * 256) * FF, FF, FF, 0, FF}; };
            auto E = [=](EPI_ARGS) { const size_t slot0 = (size_t)u.grp * SLOT_E + u.pm * 256 + wr * 64 + fr; float gt[2][4];
#pragma unroll
                for (int ai = 0; ai < 2; ++ai)
#pragma unroll
                    for (int m = 0; m < 4; ++m) gt[ai][m] = SG[slot0 + ai * 128 + m * 16];
#pragma unroll
                for (int ai = 0; ai < 2; ++ai)
#pragma unroll
                    for (int m = 0; m < 4; ++m)
#pragma unroll
                        for (int bj = 0; bj < 2; ++bj)
#pragma unroll
                            for (int n = 0; n < 2; ++n) st_bf4(Y + (slot0 + ai * 128 + m * 16) * DM + u.pn * 256 + bj * 128 + wc * 32 + n * 16 + 4 * fq, acc[ai][bj][m][n] * gt[ai][m]); };
            GEMM(S, AD, E, FF, FF, FF);
        REP_END }
        SEAM(pb + 8);
        if (IN(pb + 9)) { REFRESH(); p_rowpass_k(P, F, l, L0 ? RT : RL); if (L0) p_wconv(P, F, 1); }
        if (L0) SEAM(pb + 9);
    }
#undef IN
#undef SEAM
}
template <int PH> static void launch_ph(int grid, const Params& p, hipStream_t stream) { hipLaunchKernelGGL(fwd_kernel<PH>, dim3(grid), dim3(NTHREADS), LDS_BYTES, stream, p); }
template <int PH> static bool set_attr() { return hipFuncSetAttribute((const void*)fwd_kernel<PH>, hipFuncAttributeMaxDynamicSharedMemorySize, LDS_BYTES) == hipSuccess; }

extern "C" void kernel_launch(void* const* d_in, const int* in_sizes, int n_in, void* d_out, int out_size, void* d_ws, size_t ws_size, hipStream_t stream) {
    static int grid = 0;
    if (grid == 0) {
        if (n_in != 20 || out_size != RL * DM || ws_size < WS_END) { fprintf(stderr, "kernel_launch: unexpected shapes (n_in %d out %d ws %zu need %zu)\n", n_in, out_size, ws_size, (size_t)WS_END); grid = -1; return; }
        int dev = 0, cus = 0, per_cu = 0;
        if (hipGetDevice(&dev) != hipSuccess || hipDeviceGetAttribute(&cus, hipDeviceAttributeMultiprocessorCount, dev) != hipSuccess) { grid = -1; return; }
#if N_LAUNCH_MODE == 1
        if (!set_attr<-1>()) { fprintf(stderr, "kernel_launch: hipFuncSetAttribute failed\n"); grid = -1; return; }
        if (hipOccupancyMaxActiveBlocksPerMultiprocessor(&per_cu, (const void*)fwd_kernel<-1>, NTHREADS, LDS_BYTES) != hipSuccess || per_cu < 1) fprintf(stderr, "kernel_launch: occupancy query reports %d\n", per_cu);
#else
        if (!(set_attr<0>() && set_attr<1>() && set_attr<2>() && set_attr<3>() && set_attr<4>() && set_attr<5>() && set_attr<6>() && set_attr<7>() && set_attr<9>() && set_attr<10>() && set_attr<11>())) { fprintf(stderr, "kernel_launch: hipFuncSetAttribute failed\n"); grid = -1; return; }
        (void)per_cu;
#endif
        (void)hipGetLastError();
        grid = cus;
    }
    if (grid < 0) return;
    if (hipMemsetAsync((char*)d_ws + WS_CTL, 0, CTL_BYTES, stream) != hipSuccess) return;
    Params p{};
    const float** pp = (const float**)&p;
    for (int i = 0; i < 20; ++i) pp[i] = (const float*)d_in[i];
    p.out = (float*)d_out; p.ws = (unsigned char*)d_ws;
#if N_LAUNCH_MODE == 1
    p.l_lo = 0; p.l_hi = 2;
    launch_ph<-1>(grid, p, stream);
#else
    p.l_lo = 0; p.l_hi = 0; launch_ph<0>(grid, p, stream); launch_ph<1>(grid, p, stream);
#ifndef DUP_LAUNCH
#define DUP_LAUNCH -1
#endif
#define LP(k) do { launch_ph<k>(grid, p, stream); if (DUP_LAUNCH == (k) && l == 0) launch_ph<k>(grid, p, stream); } while (0)
    for (int l = 0; l < 2; ++l) { p.l_lo = l; p.l_hi = l + 1;
        LP(2); LP(3); LP(4); LP(5); LP(6); LP(7); LP(9); LP(10); LP(11); }
#endif
}
```

```cpp
#include <hip/hip_runtime.h>
#include <cstdio>
#include <cstdint>

#ifndef N_LAUNCH_MODE
#define N_LAUNCH_MODE 1
#endif

#define GAS __attribute__((address_space(1)))
#define LAS __attribute__((address_space(3)))
typedef unsigned short bf16;
typedef short bf16x8 __attribute__((ext_vector_type(8)));
typedef float f32x4 __attribute__((ext_vector_type(4)));
typedef unsigned u32x4 __attribute__((ext_vector_type(4)));
typedef unsigned u32x2 __attribute__((ext_vector_type(2)));

constexpr int NB = 8, SEQ = 4096, DM = 1024, CTXL = 256, NH = 16, HD = 64, GRIDW = 64;
constexpr int RL = NB * SEQ, RC = NB * CTXL, RT = RL + RC;
constexpr int INW = 7168, NE = 16, FF = 2816, CAPL = 512, CAPC = 32;
constexpr int SLOT_E = 4352, NSLOT = NE * SLOT_E;
constexpr float RMS_EPS = 1e-6f;
constexpr float LOG2E = 1.4426950408889634f, QSCALE = 0.125f * LOG2E;
constexpr int NWAVES = 8, NTHREADS = 512;

constexpr size_t al256(size_t x) { return (x + 255) & ~(size_t)255; }
constexpr size_t WS_CTL = 0, CTL_BYTES = 1u << 20;
constexpr size_t WS_MOD = WS_CTL + CTL_BYTES;
constexpr size_t WS_XC = al256(WS_MOD + (size_t)2 * 9 * 6144 * 4);
constexpr size_t WS_AFF = al256(WS_XC + (size_t)RC * DM * 4);
constexpr size_t WS_SROW = al256(WS_AFF + (size_t)RT * 16 * 4);
constexpr size_t WS_SGATE = al256(WS_SROW + (size_t)NSLOT * 4);
constexpr size_t WS_SEL = al256(WS_SGATE + (size_t)NSLOT * 4);
constexpr size_t WS_DFTM = al256(WS_SEL + (size_t)RT * 16 * 4);
constexpr size_t WS_DFTC = al256(WS_DFTM + (size_t)4096 * 8192 * 2);
constexpr size_t WS_WA = al256(WS_DFTC + (size_t)256 * 512 * 2);
constexpr size_t WS_WFV = al256(WS_WA + (size_t)5632 * 1024 * 2);
constexpr size_t WS_WAO = al256(WS_WFV + (size_t)2048 * 1024 * 2);
constexpr size_t WS_WFO = al256(WS_WAO + (size_t)1024 * 1024 * 2);
constexpr size_t WS_WPO = al256(WS_WFO + (size_t)1024 * 512 * 2);
constexpr size_t WS_WOUT = al256(WS_WPO + (size_t)1024 * 256 * 2);
constexpr size_t WS_WGU = al256(WS_WOUT + (size_t)1024 * 1024 * 2);
constexpr size_t WS_WD = al256(WS_WGU + (size_t)16 * 5632 * 1024 * 2);
constexpr size_t WS_H = al256(WS_WD + (size_t)16 * 1024 * 2816 * 2);
constexpr size_t WS_R = al256(WS_H + (size_t)RT * DM * 2);
constexpr size_t WS_KQ = WS_R;
constexpr size_t WS_MRG = WS_KQ;
constexpr size_t WS_PB = al256(WS_KQ + (size_t)RT * 2048 * 2);
constexpr size_t WS_GB = al256(WS_PB + (size_t)RT * 512 * 2);
constexpr size_t WS_YT = al256(WS_GB + (size_t)RT * 3072 * 2);
constexpr size_t WS_MRGB = WS_YT;
constexpr size_t WS_VT = al256(WS_YT + (size_t)RT * 1024 * 2);
constexpr size_t WS_FOUR = al256(WS_VT + (size_t)RT * 1024 * 2);
constexpr size_t WS_ATT = al256(WS_FOUR + (size_t)RT * 512 * 2);
constexpr size_t WS_POOL = al256(WS_ATT + (size_t)RT * 1024 * 2);
constexpr size_t WS_MIX_END = al256(WS_POOL + (size_t)RT * 512 * 2);
constexpr size_t WS_XG = WS_R;
constexpr size_t WS_HID = al256(WS_XG + (size_t)NSLOT * 1024 * 2);
constexpr size_t WS_Y = al256(WS_HID + (size_t)NSLOT * 2816 * 2);
constexpr size_t WS_MOE_END = al256(WS_Y + (size_t)NSLOT * 1024 * 2);
constexpr size_t WS_END = WS_MIX_END > WS_MOE_END ? WS_MIX_END : WS_MOE_END;
constexpr size_t YT_CTX_OFF = (size_t)8 * 1024 * 4096;

constexpr int CW_BAR = 4096;

constexpr int LDS_BYTES = 147456;
constexpr int LDS_MISC = 131072;

__device__ __forceinline__ unsigned f2bf(float f) { unsigned u = __float_as_uint(f); return (u + 0x7fffu + ((u >> 16) & 1u)) >> 16; }
typedef __bf16 hbf16x2 __attribute__((ext_vector_type(2)));
typedef float f32x2 __attribute__((ext_vector_type(2)));
__device__ __forceinline__ unsigned pk2(float lo, float hi) { const f32x2 v = {lo, hi}; return __builtin_bit_cast(unsigned, __builtin_convertvector(v, hbf16x2)); }
__device__ __forceinline__ float bf2f(unsigned b) { return __uint_as_float(b << 16); }
__device__ __forceinline__ float bflo(unsigned w) { return __uint_as_float(w << 16); }
__device__ __forceinline__ float bfhi(unsigned w) { return __uint_as_float(w & 0xffff0000u); }
__device__ __forceinline__ float wave_sum(float v) {
#pragma unroll
    for (int o = 1; o < 64; o <<= 1) v += __shfl_xor(v, o);
    return v;
}
__device__ __forceinline__ float wave_max(float v) {
#pragma unroll
    for (int o = 1; o < 64; o <<= 1) v = fmaxf(v, __shfl_xor(v, o));
    return v;
}
__device__ __forceinline__ float sigmoidf_(float x) { return 1.f / (1.f + __expf(-x)); }
#define LDS_WAIT() asm volatile("s_waitcnt lgkmcnt(0)" ::: "memory")

#define XB_TMO      128
#define XB_XCNT(j)  (256  + 64 * (j))
#define XB_XSUB(j)  (1280 + 64 * (j))
#define XB_XGEN(j)  (2304 + 64 * (j))
#define XB_TOP      3328
#define XB_TOPGEN   3392
#define XCD_BAR_WORDS 3456
#define XB_SPIN_CAP (1u << 22)

__device__ __forceinline__ unsigned xb_ld(unsigned* p)              { return __hip_atomic_load(p, __ATOMIC_RELAXED, __HIP_MEMORY_SCOPE_AGENT); }
__device__ __forceinline__ unsigned xb_add(unsigned* p, unsigned v) { return __hip_atomic_fetch_add(p, v, __ATOMIC_RELAXED, __HIP_MEMORY_SCOPE_AGENT); }
__device__ __forceinline__ unsigned xb_xcc_id() { return (unsigned)__builtin_amdgcn_s_getreg((3 << 11) | 20) & 0xFu; }
#define XB_SPIN(cond, bar) do { unsigned _sp = 0; while (cond) { __builtin_amdgcn_s_sleep(1); \
    if ((++_sp & 255u) == 0u) { if (xb_ld(&(bar)[XB_TMO])) break; if (_sp > XB_SPIN_CAP) { atomicAdd(&(bar)[XB_TMO], 1u); break; } } } } while (0)

struct XcdBarrier { unsigned* bar; unsigned x; volatile LAS unsigned* st; };

__device__ __forceinline__ XcdBarrier xcd_barrier_post(unsigned* bar, volatile LAS unsigned* st) {
    XcdBarrier b; b.bar = bar; b.x = xb_xcc_id(); b.st = st;
    if (threadIdx.x == 0) (void)xb_add(&bar[XB_XCNT(b.x)], 1u);
    return b;
}
__device__ __forceinline__ void xcd_barrier_complete(unsigned* bar, unsigned x, unsigned& nloc, unsigned& nx) {
    const unsigned G = gridDim.x * gridDim.y * gridDim.z;
    unsigned sum, cnt, mine, sp = 0u;
    for (;;) {
        sum = 0u; cnt = 0u; mine = 0u;
#pragma unroll
        for (unsigned j = 0; j < 16; ++j) { const unsigned c = xb_ld(&bar[XB_XCNT(j)]); sum += c; cnt += (c > 0u) ? 1u : 0u; mine = (j == x) ? c : mine; }
        if (sum == G) break;
        __builtin_amdgcn_s_sleep(1);
        if ((++sp & 255u) == 0u) { if (xb_ld(&bar[XB_TMO])) break; if (sp > XB_SPIN_CAP) { atomicAdd(&bar[XB_TMO], 1u); break; } }
    }
    nloc = mine > 0u ? mine : 1u; nx = cnt > 0u ? cnt : 1u;
}
__device__ __forceinline__ void xcd_barrier(const XcdBarrier& b) {
    asm volatile("s_waitcnt vmcnt(0)" ::: "memory");
    __syncthreads();
    if (threadIdx.x == 0) {
        unsigned* bar = b.bar;
        __builtin_amdgcn_s_waitcnt(0);
        unsigned nloc = b.st[0], nx = b.st[1];
        if (nloc == 0u) { xcd_barrier_complete(bar, b.x, nloc, nx); b.st[0] = nloc; b.st[1] = nx; }
        const unsigned old = xb_add(&bar[XB_XSUB(b.x)], 1u);
        const unsigned gen = old / nloc;
        if (old + 1u == (gen + 1u) * nloc) {
            __builtin_amdgcn_fence(__ATOMIC_RELEASE, "agent");
            asm volatile("s_waitcnt vmcnt(0)" ::: "memory");
            const unsigned og = xb_add(&bar[XB_TOP], 1u);
            const unsigned tg = og / nx;
            if (og + 1u == (tg + 1u) * nx) xb_add(&bar[XB_TOPGEN], 1u);
            else XB_SPIN(xb_ld(&bar[XB_TOPGEN]) == tg, bar);
            __builtin_amdgcn_fence(__ATOMIC_ACQUIRE, "agent");
            xb_add(&bar[XB_XGEN(b.x)], 1u);
            asm volatile("s_waitcnt vmcnt(0)" ::: "memory");
        } else {
            XB_SPIN(xb_ld(&bar[XB_XGEN(b.x)]) == gen, bar);
            __builtin_amdgcn_fence(__ATOMIC_ACQUIRE, "agent");
            asm volatile("s_waitcnt vmcnt(0)" ::: "memory");
        }
    }
    __syncthreads();
}

struct Params {
    const float *x, *c, *ctx, *c_ctx, *ada_w, *ada_b, *norm1_g, *norm2_g, *w_in, *rpb, *w_att_o, *w_fourier, *w_pool, *pool_scale, *w_out, *w_router, *w_eg, *w_eu, *w_ed, *final_g;
    float* out; unsigned char* ws; int l_lo, l_hi;
};
struct Frame {
    LAS unsigned char* lds;
    int tid, lane, wave, G, bid;
    unsigned char* ws;
};
#define WSP(T, off) ((T*)(F.ws + (off)))

struct Unit { int grp, pm, pn, seg; };
struct GroupSched {
    int ng, nM, nN, G, c; int tM, tN, tpm0, tpn0;
    __device__ __forceinline__ void init(int ng_, int nM_, int nN_, int G_, int c_, int tM_ = 0, int tN_ = 0, int tpm0_ = 0, int tpn0_ = 0) { ng = ng_; nM = nM_; nN = nN_; G = G_; c = c_; tM = tM_; tN = tN_; tpm0 = tpm0_; tpn0 = tpn0_; }
    __device__ __forceinline__ bool next(int i, Unit& u) const {
        const int per = nM * nN; const int L = i * G + c;
        if (L < ng * per) {
            u.grp = L / per; int wgid = L - u.grp * per;
            { const int q = per / 8, r = per % 8, xcd = wgid % 8, off = wgid / 8; wgid = (xcd < r ? xcd * (q + 1) : r * (q + 1) + (xcd - r) * q) + off; }
            const int nig = 8 * nN, gid = wgid / nig, fm = gid * 8, gsz = (nM - fm) < 8 ? (nM - fm) : 8;
            u.pm = fm + ((wgid % nig) % gsz); u.pn = (wgid % nig) / gsz; u.seg = 0; return true;
        }
        const int w = L - ng * per;
        if (w < tM * tN) { u.grp = ng; u.pm = tpm0 + (w % tM); u.pn = tpn0 + (w / tM); u.seg = 0; return true; }
        return false;
    }
};
struct Operands { const bf16* A; const bf16* Bt; int lda, ldb, slot0, K; };

template <class Addr, class Epi>
__device__ __forceinline__ void gemm_simple(const GroupSched& S, const Addr& AD, const Epi& E, int K) {
    const int tid = threadIdx.x, wid = __builtin_amdgcn_readfirstlane(tid >> 6), lane = tid & 63, wr = wid >> 2, wc = wid & 3, fr = lane & 15, fq = lane >> 4;
    Unit u;
    for (int i = 0; S.next(i, u); ++i) {
        const Operands op = AD(u);
        f32x4 acc[2][2][4][2];
#pragma unroll
        for (int a = 0; a < 2; ++a)
#pragma unroll
            for (int b = 0; b < 2; ++b)
#pragma unroll
                for (int m = 0; m < 4; ++m)
#pragma unroll
                    for (int n = 0; n < 2; ++n) acc[a][b][m][n] = (f32x4){0.f, 0.f, 0.f, 0.f};
        const bf16* ap = op.A + (size_t)(wr * 64 + fr) * op.lda + fq * 8;
        const bf16* bp = op.Bt + (size_t)(wc * 32 + fr) * op.ldb + fq * 8;
#pragma unroll 1
        for (int k = 0; k < K; k += 32) {
            bf16x8 bfr[2][2];
#pragma unroll
            for (int b = 0; b < 2; ++b)
#pragma unroll
                for (int n = 0; n < 2; ++n) bfr[b][n] = *(const bf16x8*)(bp + (size_t)(b * 128 + n * 16) * op.ldb + k);
#pragma unroll
            for (int a = 0; a < 2; ++a) {
                bf16x8 af[4];
#pragma unroll
                for (int m = 0; m < 4; ++m) af[m] = *(const bf16x8*)(ap + (size_t)(a * 128 + m * 16) * op.lda + k);
#pragma unroll
                for (int b = 0; b < 2; ++b)
#pragma unroll
                    for (int m = 0; m < 4; ++m)
#pragma unroll
                        for (int n = 0; n < 2; ++n) acc[a][b][m][n] = __builtin_amdgcn_mfma_f32_16x16x32_bf16(bfr[b][n], af[m], acc[a][b][m][n], 0, 0, 0);
            }
        }
        E(acc, u, wr, wc, fr, fq);
    }
}
constexpr int HTB = 128 * 64 * 2;
__device__ __forceinline__ int lds_byte(int r, int c) { const int st = (r >> 4) * 2 + (c >> 5), rr = r & 15, cc = c & 31, ob = rr * 64 + cc * 2; return st * 1024 + (ob ^ (((ob >> 9) & 1) << 5)); }
__device__ __forceinline__ void stage_rc(int b, int& R, int& C) { const int st = b / 1024, sb = b % 1024, swz = sb ^ (((sb >> 9) & 1) << 5); R = (st >> 1) * 16 + swz / 64; C = (st & 1) * 32 + (swz % 64) / 2; }
template <bool GATHER, class Sched, class Addr, class Epi>
__device__ __forceinline__ void gemm_fast(LAS unsigned char* lds, const int tid, const Sched& S, const Addr& AD, const Epi& E, const int* __restrict__ grows) {
    const int wid = __builtin_amdgcn_readfirstlane(tid >> 6), lane = tid & 63, wr = wid >> 2, wc = wid & 3, fr = lane & 15, fq = lane >> 4;
    int sR[2]; unsigned sC[2];
    unsigned cvg[2][2], nvg[2][2], cvb[2][2], nvb[2][2];
#pragma unroll
    for (int i = 0; i < 2; ++i) { int R, C; stage_rc(tid * 16 + i * 8192, R, C); sR[i] = R; sC[i] = (unsigned)C * 2u; }
    const size_t kstep = 128;
    const unsigned ldsw = (unsigned)wid * 1024u;
    const int aoff = lds_byte(wr * 64 + fr, fq * 8), boff = lds_byte(wc * 32 + fr, fq * 8);
#define PG8_SA(b, h) (((b) * 2 + (h)) * HTB)
#define PG8_SB(b, h) ((4 + (b) * 2 + (h)) * HTB)
#define PG8_STAGE(bufoff, gbase, voff) do { _Pragma("unroll") for (int _i = 0; _i < 2; ++_i) \
        __builtin_amdgcn_global_load_lds((const unsigned*)((const char*)(gbase) + (voff)[_i]), (LAS unsigned*)(lds + (bufoff) + ldsw + _i * 8192), 16, 0, 0); } while (0)
#define PG8_LDA(dst, b, h) do { _Pragma("unroll") for (int m = 0; m < 4; ++m) _Pragma("unroll") for (int k = 0; k < 2; ++k) dst[m][k] = *(const LAS bf16x8*)(lds + PG8_SA(b, h) + aoff + m * 2048 + k * 1024); } while (0)
#define PG8_LDB(dst, b, h) do { _Pragma("unroll") for (int n = 0; n < 2; ++n) _Pragma("unroll") for (int k = 0; k < 2; ++k) dst[n][k] = *(const LAS bf16x8*)(lds + PG8_SB(b, h) + boff + n * 2048 + k * 1024); } while (0)
#define PG8_MMA(ai, bj, At, Bt) do { __builtin_amdgcn_s_setprio(1); _Pragma("unroll") for (int m = 0; m < 4; ++m) _Pragma("unroll") for (int n = 0; n < 2; ++n) _Pragma("unroll") for (int k = 0; k < 2; ++k) \
        acc[ai][bj][m][n] = __builtin_amdgcn_mfma_f32_16x16x32_bf16(Bt[n][k], At[m][k], acc[ai][bj][m][n], 0, 0, 0); __builtin_amdgcn_s_setprio(0); } while (0)
#define PG8_WAIT_V(n) asm volatile("s_waitcnt vmcnt(" #n ")" ::: "memory")
#define PG8_WAIT_L(n) asm volatile("s_waitcnt lgkmcnt(" #n ")" ::: "memory")
#define PG8_BAR __builtin_amdgcn_s_barrier()
#define PG8_SCHED __builtin_amdgcn_sched_barrier(0)
#define PG8_GIDX(dst, op_) do { _Pragma("unroll") for (int h_ = 0; h_ < 2; ++h_) _Pragma("unroll") for (int i_ = 0; i_ < 2; ++i_) dst[h_][i_] = (unsigned)grows[(op_).slot0 + h_ * 128 + sR[i_]] * (unsigned)((op_).lda * 2) + sC[i_]; } while (0)
#define PG8_AOFF(dst, op_) do { _Pragma("unroll") for (int h_ = 0; h_ < 2; ++h_) _Pragma("unroll") for (int i_ = 0; i_ < 2; ++i_) dst[h_][i_] = (unsigned)((sR[i_] + 128 * h_) * (op_).lda) * 2u + sC[i_]; } while (0)
#define PG8_BOFF(dst, op_) do { _Pragma("unroll") for (int h_ = 0; h_ < 2; ++h_) _Pragma("unroll") for (int i_ = 0; i_ < 2; ++i_) dst[h_][i_] = (unsigned)((sR[i_] + 128 * h_) * (op_).ldb) * 2u + sC[i_]; } while (0)
#define PG8_COPY(dst, src) do { _Pragma("unroll") for (int h_ = 0; h_ < 2; ++h_) _Pragma("unroll") for (int i_ = 0; i_ < 2; ++i_) dst[h_][i_] = src[h_][i_]; } while (0)
    Unit cur, nxt; int ui = 0;
    if (!S.next(0, cur)) return;
    f32x4 acc[2][2][4][2];
#pragma unroll
    for (int a = 0; a < 2; ++a)
#pragma unroll
        for (int b = 0; b < 2; ++b)
#pragma unroll
            for (int m = 0; m < 4; ++m)
#pragma unroll
                for (int n = 0; n < 2; ++n) acc[a][b][m][n] = (f32x4){0.f, 0.f, 0.f, 0.f};
    bf16x8 At[4][2], B0[2][2], B1[2][2];
    const char* cA; const char* cB; int nt;
    { const Operands op = AD(cur); cA = (const char*)op.A; cB = (const char*)op.Bt; nt = op.K / 64; PG8_BOFF(cvb, op);
      Unit u1; const bool h1 = S.next(1, u1); const Operands o1 = h1 ? AD(u1) : op; PG8_BOFF(nvb, o1);
      if constexpr (GATHER) { PG8_GIDX(cvg, op); PG8_GIDX(nvg, o1); PG8_WAIT_V(0); } else { PG8_AOFF(cvg, op); PG8_AOFF(nvg, o1); } }
    PG8_STAGE(PG8_SB(0, 0), cB, cvb[0]); PG8_STAGE(PG8_SB(0, 1), cB, cvb[1]); PG8_STAGE(PG8_SA(0, 0), cA, cvg[0]); PG8_STAGE(PG8_SA(0, 1), cA, cvg[1]);
    if (wr == 1) PG8_BAR;
    PG8_WAIT_V(2); PG8_BAR;
    PG8_STAGE(PG8_SB(1, 0), cB + kstep, cvb[0]); PG8_STAGE(PG8_SA(1, 0), cA + kstep, cvg[0]); PG8_STAGE(PG8_SB(1, 1), cB + kstep, cvb[1]);
    PG8_WAIT_V(6); PG8_BAR;
    for (;;) {
        const bool has_next = S.next(ui + 1, nxt);
        const char* nA = cA; const char* nB = cB; int nnt = nt;
        if (has_next) { const Operands op = AD(nxt); nA = (const char*)op.A; nB = (const char*)op.Bt; nnt = op.K / 64; }
#pragma unroll 1
        for (int t = 0; t < nt; t += 2) {
            const bool last = (t == nt - 2);
            const char* a1 = cA + (size_t)(t + 1) * kstep;
            const char* a2 = last ? nA : cA + (size_t)(t + 2) * kstep; const char* b2 = last ? nB : cB + (size_t)(t + 2) * kstep;
            const char* a3 = a2 + kstep; const char* b3 = b2 + kstep;
            unsigned v2[2][2], w2[2][2];
#pragma unroll
            for (int h_ = 0; h_ < 2; ++h_)
#pragma unroll
                for (int i_ = 0; i_ < 2; ++i_) { v2[h_][i_] = last ? nvg[h_][i_] : cvg[h_][i_]; w2[h_][i_] = last ? nvb[h_][i_] : cvb[h_][i_]; }
            PG8_LDB(B0, 0, 0); PG8_LDB(B1, 0, 1); PG8_SCHED; PG8_LDA(At, 0, 0); PG8_STAGE(PG8_SA(1, 1), a1, cvg[1]);
            PG8_WAIT_V(8); PG8_WAIT_L(0); PG8_BAR; PG8_MMA(0, 0, At, B0); PG8_MMA(0, 1, At, B1); PG8_BAR; PG8_SCHED;
            PG8_LDA(At, 0, 1); PG8_STAGE(PG8_SB(0, 0), b2, w2[0]); PG8_STAGE(PG8_SB(0, 1), b2, w2[1]); PG8_STAGE(PG8_SA(0, 0), a2, v2[0]);
            PG8_WAIT_V(8); PG8_WAIT_L(0); PG8_BAR; PG8_MMA(1, 0, At, B0); PG8_MMA(1, 1, At, B1); PG8_BAR; PG8_SCHED;
            PG8_LDB(B0, 1, 0); PG8_LDB(B1, 1, 1); PG8_SCHED; PG8_LDA(At, 1, 0); PG8_STAGE(PG8_SA(0, 1), a2, v2[1]);
            PG8_WAIT_V(8); PG8_WAIT_L(0); PG8_BAR; PG8_MMA(0, 0, At, B0); PG8_MMA(0, 1, At, B1); PG8_BAR; PG8_SCHED;
            PG8_LDA(At, 1, 1); PG8_STAGE(PG8_SB(1, 0), b3, w2[0]); PG8_STAGE(PG8_SB(1, 1), b3, w2[1]); PG8_STAGE(PG8_SA(1, 0), a3, v2[0]);
            PG8_WAIT_V(8); PG8_WAIT_L(0); PG8_BAR; PG8_MMA(1, 0, At, B0); PG8_MMA(1, 1, At, B1); PG8_BAR; PG8_SCHED;
        }
        if (wr == 0) PG8_BAR;
        unsigned fvg[2][2], fvb[2][2];
        { Unit u2; const bool h2 = S.next(ui + 2, u2);
          if (h2) { const Operands o2 = AD(u2); PG8_BOFF(fvb, o2); if constexpr (GATHER) PG8_GIDX(fvg, o2); else PG8_AOFF(fvg, o2); }
          else { PG8_COPY(fvb, nvb); PG8_COPY(fvg, nvg); } }
        { int fr2 = fr, fq2 = fq; asm volatile("" : "+v"(fr2), "+v"(fq2));
          E(acc, cur, wr, wc, fr2, fq2); }
        if (!has_next) break;
        if constexpr (GATHER) PG8_WAIT_V(0);
        PG8_COPY(cvg, nvg); PG8_COPY(nvg, fvg); PG8_COPY(cvb, nvb); PG8_COPY(nvb, fvb);
        if (E.reset(cur)) {
#pragma unroll
        for (int a = 0; a < 2; ++a)
#pragma unroll
            for (int b = 0; b < 2; ++b)
#pragma unroll
                for (int m = 0; m < 4; ++m)
#pragma unroll
                    for (int n = 0; n < 2; ++n) acc[a][b][m][n] = (f32x4){0.f, 0.f, 0.f, 0.f};
        }
        cur = nxt; cA = nA; cB = nB; nt = nnt; ++ui;
        if (wr == 1) PG8_BAR;
    }
    PG8_WAIT_V(0);
    PG8_BAR;
#undef PG8_SA
#undef PG8_SB
#undef PG8_STAGE
#undef PG8_LDA
#undef PG8_LDB
#undef PG8_MMA
#undef PG8_WAIT_V
#undef PG8_WAIT_L
#undef PG8_BAR
#undef PG8_SCHED
#undef PG8_GIDX
#undef PG8_AOFF
#undef PG8_BOFF
#undef PG8_COPY
}
template <class F> struct EpiFn { F f; __device__ __forceinline__ void operator()(f32x4 (&acc)[2][2][4][2], const Unit& u, int wr, int wc, int fr, int fq) const { f(acc, u, wr, wc, fr, fq); } __device__ __forceinline__ bool reset(const Unit&) const { return true; } };
template <class F> __device__ __forceinline__ EpiFn<F> mk_epi(F f) { return EpiFn<F>{f}; }
template <class F> struct EpiSeg { F f; int last; __device__ __forceinline__ void operator()(f32x4 (&acc)[2][2][4][2], const Unit& u, int wr, int wc, int fr, int fq) const { f(acc, u, wr, wc, fr, fq); } __device__ __forceinline__ bool reset(const Unit& u) const { return u.seg == last; } };
template <class F> __device__ __forceinline__ EpiSeg<F> mk_epi_seg(F f, int last) { return EpiSeg<F>{f, last}; }
template <int NSEG> struct SegSched { GroupSched base; __device__ __forceinline__ bool next(int j, Unit& u) const { if (!base.next(j / NSEG, u)) return false; u.seg = j % NSEG; return true; } };
#ifndef DUP_PH
#define DUP_PH -1
#endif
#define REP_BEGIN(k) _Pragma("unroll 1") for (int rep_ = 0; rep_ < ((DUP_PH == (k)) ? 2 : 1); ++rep_) { if (rep_) { if constexpr (PH < 0) xcd_barrier(bar); }
#define REP_END }
#ifndef USE_FAST
#define USE_FAST 1
#endif
#if USE_FAST
#define GEMM(S, AD, E, K, lda, ldb) gemm_fast<false>(F.lds, F.tid, S, AD, mk_epi(E), nullptr)
#define GEMM_GATHER(S, AD, E, K, lda, ldb, rows) gemm_fast<true>(F.lds, F.tid, S, AD, mk_epi(E), rows)
#else
#define GEMM(S, AD, E, K, lda, ldb) gemm_simple(S, AD, E, K)
#endif
#define EPI_ARGS f32x4 (&acc)[2][2][4][2], const Unit& u, int wr, int wc, int fr, int fq
#define EPI_FOR(...) _Pragma("unroll") for (int ai = 0; ai < 2; ++ai) _Pragma("unroll") for (int m = 0; m < 4; ++m) { const int r = ai * 128 + wr * 64 + m * 16 + fr; \
    _Pragma("unroll") for (int bj = 0; bj < 2; ++bj) _Pragma("unroll") for (int n = 0; n < 2; ++n) { const int c = bj * 128 + wc * 32 + n * 16 + 4 * fq; const f32x4 v = acc[ai][bj][m][n]; __VA_ARGS__ } }
__device__ __forceinline__ void st_bf4(bf16* p, f32x4 v) { u32x2 w; w.x = pk2(v[0], v[1]); w.y = pk2(v[2], v[3]); *(u32x2*)p = w; }

__device__ __forceinline__ void p_mod(const Params& P, Frame& F) {
    LAS float* sc = (LAS float*)F.lds;
    LAS float* red = (LAS float*)(F.lds + 9 * 1024 * 4);
    float* MOD = WSP(float, WS_MOD);
    bool have = false;
    for (int it = F.bid; it < 2 * 96; it += F.G) {
        if (!have) {
            for (int i = F.tid; i < 9 * 1024; i += NTHREADS) { const int r = i >> 10, k = i & 1023; const float v = r < 8 ? P.c[r * 1024 + k] : P.c_ctx[k]; sc[i] = v * sigmoidf_(v); }
            have = true;
        }
        __syncthreads();
        const int l = it / 96, j0 = (it % 96) * 64, jj = F.tid & 63, kc = F.tid >> 6;
        const float* W = P.ada_w + (size_t)l * 1024 * 6144 + j0 + jj;
        float a[9];
#pragma unroll
        for (int r = 0; r < 9; ++r) a[r] = 0.f;
        for (int k = kc * 128; k < kc * 128 + 128; ++k) { const float w = W[(size_t)k * 6144];
#pragma unroll
            for (int r = 0; r < 9; ++r) a[r] += sc[r * 1024 + k] * w; }
#pragma unroll
        for (int r = 0; r < 9; ++r) red[(kc * 9 + r) * 64 + jj] = a[r];
        __syncthreads();
        for (int o = F.tid; o < 9 * 64; o += NTHREADS) { const int r = o >> 6, j = o & 63; float s = 0.f;
#pragma unroll
            for (int q = 0; q < 8; ++q) s += red[(q * 9 + r) * 64 + j];
            MOD[((size_t)l * 9 + r) * 6144 + j0 + j] = s + P.ada_b[l * 6144 + j0 + j]; }
    }
    __syncthreads();
}
__device__ __forceinline__ void p_dftgen(Frame& F) {
    LAS float* tab = (LAS float*)F.lds;
    for (int j = F.tid; j < 4096; j += NTHREADS) tab[j] = cospif((float)j * (1.0f / 2048.0f));
    __syncthreads();
    bf16* DM_ = WSP(bf16, WS_DFTM); bf16* DC_ = WSP(bf16, WS_DFTC);
    const int nchunk = 4096 * 1024 + 256 * 64;
    for (int ch = F.bid * NTHREADS + F.tid; ch < nchunk; ch += F.G * NTHREADS) {
        float v[8]; bf16* dst;
        if (ch < 4096 * 1024) { const int kf = ch >> 10, col0 = (ch & 1023) * 8, cs = col0 >> 12, l0 = col0 & 4095;
#pragma unroll
            for (int i = 0; i < 8; ++i) { const int j = (kf * (l0 + i)) & 4095; v[i] = cs ? -tab[(j + 3072) & 4095] : tab[j]; }
            dst = DM_ + (size_t)kf * 8192 + col0; }
        else { const int c2 = ch - 4096 * 1024, kf = c2 >> 6, col0 = (c2 & 63) * 8, cs = col0 >> 8, l0 = col0 & 255;
#pragma unroll
            for (int i = 0; i < 8; ++i) { const int j = ((kf * (l0 + i)) & 255) * 16; v[i] = cs ? -tab[(j + 3072) & 4095] : tab[j]; }
            dst = DC_ + (size_t)kf * 512 + col0; }
        u32x4 o; o.x = pk2(v[0], v[1]); o.y = pk2(v[2], v[3]); o.z = pk2(v[4], v[5]); o.w = pk2(v[6], v[7]);
        *(u32x4*)dst = o;
    }
    __syncthreads();
}
__device__ __forceinline__ void transpose_item(const float* W, int ldw, int k0, int n0, bf16* WT, int ldt, int drow0, LAS float* scr, int lane) {
    f32x4 ld[8];
#pragma unroll
    for (int i = 0; i < 8; ++i) ld[i] = *(const f32x4*)(W + (size_t)(k0 + 8 * i + (lane >> 3)) * ldw + n0 + 4 * (lane & 7));
#pragma unroll
    for (int i = 0; i < 8; ++i) { LAS float* d = scr + (8 * i + (lane >> 3)) * 33 + 4 * (lane & 7); d[0] = ld[i][0]; d[1] = ld[i][1]; d[2] = ld[i][2]; d[3] = ld[i][3]; }
    LDS_WAIT(); asm volatile("" ::: "memory");
    const int c = lane & 7;
#pragma unroll
    for (int j = 0; j < 4; ++j) { const int n = (lane >> 3) + 8 * j; const LAS float* s = scr + (8 * c) * 33 + n;
        u32x4 o; o.x = pk2(s[0 * 33], s[1 * 33]); o.y = pk2(s[2 * 33], s[3 * 33]); o.z = pk2(s[4 * 33], s[5 * 33]); o.w = pk2(s[6 * 33], s[7 * 33]);
        *(u32x4*)(WT + (size_t)(drow0 + n) * ldt + k0 + 8 * c) = o; }
    LDS_WAIT(); asm volatile("" ::: "memory");
}
__device__ __forceinline__ void p_wconv(const Params& P, Frame& F, int l) {
    LAS float* scr = (LAS float*)(F.lds + F.wave * 16384);
    const int gw = F.bid * NWAVES + F.wave, NGW = F.G * NWAVES;
    const float* w_in = P.w_in + (size_t)l * 1024 * INW;
    bf16* WA = WSP(bf16, WS_WA); bf16* WFV = WSP(bf16, WS_WFV);
    constexpr int I_K = 16 * 32, I_Q = 16 * 32, I_P = 16 * 16, I_G = 16 * 96, I_V = 16 * 32, I_AO = 16 * 32, I_FO = 8 * 32, I_OUT = 16 * 32;
    constexpr int NSM = I_K + I_Q + I_P + I_G + I_V + I_AO + I_FO + I_OUT;
    for (int it = gw; it < NSM; it += NGW) {
        int r = it;
        if (r < I_K) { transpose_item(w_in, INW, (r / 32) * 64, 0 + (r % 32) * 32, WA, 1024, 0 + (r % 32) * 32, scr, F.lane); continue; } r -= I_K;
        if (r < I_Q) { transpose_item(w_in, INW, (r / 32) * 64, 2048 + (r % 32) * 32, WA, 1024, 1024 + (r % 32) * 32, scr, F.lane); continue; } r -= I_Q;
        if (r < I_P) { transpose_item(w_in, INW, (r / 16) * 64, 3584 + (r % 16) * 32, WA, 1024, 2048 + (r % 16) * 32, scr, F.lane); continue; } r -= I_P;
        if (r < I_G) { transpose_item(w_in, INW, (r / 96) * 64, 4096 + (r % 96) * 32, WA, 1024, 2560 + (r % 96) * 32, scr, F.lane); continue; } r -= I_G;
        if (r < I_V) { transpose_item(w_in, INW, (r / 32) * 64, 1024 + (r % 32) * 32, WFV, 1024, 1024 + (r % 32) * 32, scr, F.lane); continue; } r -= I_V;
        if (r < I_AO) { transpose_item(P.w_att_o + (size_t)l * 1024 * 1024, 1024, (r / 32) * 64, (r % 32) * 32, WSP(bf16, WS_WAO), 1024, (r % 32) * 32, scr, F.lane); continue; } r -= I_AO;
        if (r < I_FO) { transpose_item(P.w_fourier + (size_t)l * 512 * 1024, 1024, (r / 32) * 64, (r % 32) * 32, WSP(bf16, WS_WFO), 512, (r % 32) * 32, scr, F.lane); continue; } r -= I_FO;
        transpose_item(P.w_out + (size_t)l * 1024 * 1024, 1024, (r / 32) * 64, (r % 32) * 32, WSP(bf16, WS_WOUT), 1024, (r % 32) * 32, scr, F.lane);
    }
    constexpr int I_E = 16 * 88;
    bf16* WGU = WSP(bf16, WS_WGU); bf16* WD = WSP(bf16, WS_WD);
    for (int it = gw; it < 3 * 16 * I_E; it += NGW) {
        const int which = it / (16 * I_E), r0 = it % (16 * I_E), e = r0 / I_E, r = r0 % I_E;
        if (which < 2) { const int kb = r / 88, nb = r % 88, n0 = nb * 32;
            const float* src = (which == 0 ? P.w_eg : P.w_eu) + ((size_t)l * 16 + e) * 1024 * FF;
            transpose_item(src, FF, kb * 64, n0, WGU + (size_t)e * 5632 * 1024, 1024, (n0 >> 7) * 256 + (which ? 128 : 0) + (n0 & 127), scr, F.lane); }
        else { const int kb = r / 32, nb = r % 32;
            transpose_item(P.w_ed + ((size_t)l * 16 + e) * FF * 1024, 1024, kb * 64, nb * 32, WD + (size_t)e * 1024 * FF, FF, nb * 32, scr, F.lane); }
    }
    { bf16* WPO = WSP(bf16, WS_WPO); const float* wp = P.w_pool + (size_t)l * 4 * 128 * 256;
      for (int i = F.bid * NTHREADS + F.tid; i < 1024 * 256; i += F.G * NTHREADS) { const int n = i >> 8, kk = i & 255, g = n >> 8, f = n & 255;
          WPO[i] = (bf16)(((kk >> 7) == (g & 1)) ? f2bf(wp[((size_t)g * 128 + (kk & 127)) * 256 + f]) : 0u); } }
    { LAS float* t128 = (LAS float*)F.lds;
      __syncthreads();
      for (int j = F.tid; j < 128; j += NTHREADS) t128[j] = cospif((float)j * (1.0f / 64.0f));
      __syncthreads();
      for (int i = F.bid * NTHREADS + F.tid; i < 1024 * 1024; i += F.G * NTHREADS) { const int fc = i >> 10, k = i & 1023, cs = fc & 1, gm = fc >> 1, g = gm >> 7, m = gm & 127;
          const float* src = w_in + (size_t)k * INW + 3072 + g * 128; float s = 0.f; const int ph = cs ? 96 : 0;
          for (int c = 0; c < 128; ++c) s += src[c] * t128[(m * c + ph) & 127];
          WFV[i] = (bf16)f2bf(s); }
      __syncthreads(); }
}

struct RowMod { const float* g; const float* sh; const float* sc; };
__device__ __forceinline__ void row_load(const float* row, int lane, f32x4 (&v)[4]) {
#pragma unroll
    for (int j = 0; j < 4; ++j) v[j] = *(const f32x4*)(row + 4 * lane + 256 * j);
}
__device__ __forceinline__ float row_rstd(const f32x4 (&v)[4]) {
    float s = 0.f;
#pragma unroll
    for (int j = 0; j < 4; ++j) s += (v[j][0] * v[j][0] + v[j][1] * v[j][1]) + (v[j][2] * v[j][2] + v[j][3] * v[j][3]);
    return rsqrtf(wave_sum(s) * (1.0f / 1024.0f) + RMS_EPS);
}
__device__ __forceinline__ void row_modulate(const f32x4 (&v)[4], float rstd, const RowMod& M, int lane, f32x4 (&y)[4]) {
#pragma unroll
    for (int j = 0; j < 4; ++j) { const int k = 4 * lane + 256 * j; const f32x4 g = *(const f32x4*)(M.g + k), sh = *(const f32x4*)(M.sh + k), sc = *(const f32x4*)(M.sc + k);
        y[j] = v[j] * rstd * g * (sc + 1.0f) + sh; }
}
__device__ __forceinline__ void row_store_bf(bf16* row, int lane, const f32x4 (&y)[4]) {
#pragma unroll
    for (int j = 0; j < 4; ++j) st_bf4(row + 4 * lane + 256 * j, y[j]);
}
__device__ __forceinline__ const float* mod_ptr(Frame& F, int l, int row, int which) { const int mr = row < RL ? (row >> 12) : 8; return WSP(float, WS_MOD) + ((size_t)l * 9 + mr) * 6144 + which * 1024; }

__device__ __forceinline__ void p_rowpass_a0(const Params& P, Frame& F) {
    const int gw = F.bid * NWAVES + F.wave, NGW = F.G * NWAVES; bf16* H = WSP(bf16, WS_H);
    for (int row = gw; row < RT; row += NGW) {
        const float* src = row < RL ? P.x + (size_t)row * DM : P.ctx + (size_t)(row - RL) * DM;
        f32x4 v[4], y[4]; row_load(src, F.lane, v); const float rs = row_rstd(v);
        RowMod M{P.norm1_g, mod_ptr(F, 0, row, 0), mod_ptr(F, 0, row, 1)};
        row_modulate(v, rs, M, F.lane, y); row_store_bf(H + (size_t)row * DM, F.lane, y);
    }
}
__device__ __forceinline__ void p_rowpass_f(const Params& P, Frame& F, int l, int nrows) {
    const int gw = F.bid * NWAVES + F.wave, NGW = F.G * NWAVES; bf16* H = WSP(bf16, WS_H); float* AFF = WSP(float, WS_AFF);
    const float* wr = P.w_router + (size_t)l * 1024 * 16;
    LAS float* wl = (LAS float*)F.lds;
    __syncthreads();
    for (int i = F.tid; i < 16384; i += NTHREADS) wl[(i & 15) * 1024 + (i >> 4)] = wr[i];
    __syncthreads();
    for (int row = gw; row < nrows; row += NGW) {
        const float* src = row < RL ? P.out + (size_t)row * DM : WSP(float, WS_XC) + (size_t)(row - RL) * DM;
        f32x4 v[4], y[4]; row_load(src, F.lane, v); const float rs = row_rstd(v);
        RowMod M{P.norm2_g + l * 1024, mod_ptr(F, l, row, 3), mod_ptr(F, l, row, 4)};
        row_modulate(v, rs, M, F.lane, y); row_store_bf(H + (size_t)row * DM, F.lane, y);
        float lg[16];
        int wo = 4 * F.lane; asm volatile("" : "+v"(wo));
#pragma unroll
        for (int e = 0; e < 16; ++e) { float a = 0.f;
#pragma unroll
            for (int j = 0; j < 4; ++j) { const f32x4 w = *(const LAS f32x4*)(wl + e * 1024 + wo + 256 * j); a += (y[j][0] * w[0] + y[j][1] * w[1]) + (y[j][2] * w[2] + y[j][3] * w[3]); }
            lg[e] = a; }
        float mx = -1e30f;
#pragma unroll
        for (int e = 0; e < 16; ++e) { lg[e] = wave_sum(lg[e]); mx = fmaxf(mx, lg[e]); }
        float den = 0.f;
#pragma unroll
        for (int e = 0; e < 16; ++e) { lg[e] = __expf(lg[e] - mx); den += lg[e]; }
        const float inv = 1.0f / den;
        if (F.lane < 16) { float mine = 0.f;
#pragma unroll
            for (int e = 0; e < 16; ++e) mine = (F.lane == e) ? lg[e] : mine;
            AFF[(size_t)row * 16 + F.lane] = mine * inv; }
    }
    __syncthreads();
}
__device__ __forceinline__ void p_rowpass_k(const Params& P, Frame& F, int l, int nrows) {
    const int gw = F.bid * NWAVES + F.wave, NGW = F.G * NWAVES; bf16* H = WSP(bf16, WS_H);
    const int* SEL = WSP(int, WS_SEL); const bf16* Y = WSP(bf16, WS_Y);
    for (int row = gw; row < nrows; row += NGW) {
        float* xr = row < RL ? P.out + (size_t)row * DM : WSP(float, WS_XC) + (size_t)(row - RL) * DM;
        f32x4 v[4], a[4]; row_load(xr, F.lane, v);
#pragma unroll
        for (int j = 0; j < 4; ++j) a[j] = (f32x4){0.f, 0.f, 0.f, 0.f};
        for (int e = 0; e < 16; ++e) { const int s = SEL[(size_t)row * 16 + e];
            if (s >= 0) { const bf16* yr = Y + (size_t)s * DM;
#pragma unroll
                for (int j = 0; j < 4; ++j) { const u32x2 w = *(const u32x2*)(yr + 4 * F.lane + 256 * j); a[j][0] += bflo(w.x); a[j][1] += bfhi(w.x); a[j][2] += bflo(w.y); a[j][3] += bfhi(w.y); } } }
        const float* g2 = mod_ptr(F, l, row, 5);
#pragma unroll
        for (int j = 0; j < 4; ++j) { const f32x4 g = *(const f32x4*)(g2 + 4 * F.lane + 256 * j); v[j] = v[j] + g * a[j]; }
        const float rs = row_rstd(v);
        if (l == 0) {
#pragma unroll
            for (int j = 0; j < 4; ++j) *(f32x4*)(xr + 4 * F.lane + 256 * j) = v[j];
            f32x4 y[4]; RowMod M{P.norm1_g + 1024, mod_ptr(F, 1, row, 0), mod_ptr(F, 1, row, 1)};
            row_modulate(v, rs, M, F.lane, y); row_store_bf(H + (size_t)row * DM, F.lane, y);
        } else {
#pragma unroll
            for (int j = 0; j < 4; ++j) { const f32x4 g = *(const f32x4*)(P.final_g + 4 * F.lane + 256 * j); *(f32x4*)(xr + 4 * F.lane + 256 * j) = v[j] * rs * g; }
        }
    }
}

__device__ __forceinline__ float dot64(const bf16x8 (&q)[8], const bf16* kp) {
    float s = 0.f;
#pragma unroll
    for (int i = 0; i < 8; ++i) { const u32x4 kw = *(const u32x4*)(kp + 8 * i); const u32x4 qw = __builtin_bit_cast(u32x4, q[i]);
#pragma unroll
        for (int t = 0; t < 4; ++t) s += bflo(kw[t]) * bflo(qw[t]) + bfhi(kw[t]) * bfhi(qw[t]); }
    return s;
}
__device__ __forceinline__ void p_attn_naive(const Params& P, Frame& F, int l, bool with_ctx_queries) {
    const int gw = F.bid * NWAVES + F.wave, NGW = F.G * NWAVES;
    const bf16* KQ = WSP(bf16, WS_KQ); const bf16* VT = WSP(bf16, WS_VT); bf16* ATT = WSP(bf16, WS_ATT);
    LAS float* pw = (LAS float*)(F.lds + F.wave * 2048);
    const float* rpb = P.rpb + (size_t)l * 16 * 15 * 31;
    const int nlat = NB * 64 * NH * 64, nitems = nlat + (with_ctx_queries ? NB * NH * CTXL : 0);
    for (int it = gw; it < nitems; it += NGW) {
        const bool lat = it < nlat;
        int b, h, r = 0, qc = 0, rowq;
        if (lat) { qc = it & 63; h = (it >> 6) & 15; r = (it >> 10) & 63; b = it >> 16; rowq = b * SEQ + r * 64 + qc; }
        else { const int i2 = it - nlat; qc = i2 & 255; h = (i2 >> 8) & 15; b = i2 >> 12; rowq = RL + b * CTXL + qc; }
        bf16x8 q[8];
        { const bf16* qp = KQ + (size_t)rowq * 2048 + 1024 + h * 64;
#pragma unroll
          for (int i = 0; i < 8; ++i) q[i] = *(const bf16x8*)(qp + 8 * i); }
        const int rs = min(max(r - 4, 0), 56), cs = min(max(qc - 8, 0), 48);
        float s[6];
        if (lat) {
#pragma unroll
            for (int t = 0; t < 2; ++t) { const int w = F.lane + 64 * t, i = w >> 4, j = w & 15; const int tok = (rs + i) * 64 + cs + j;
                s[t] = dot64(q, KQ + (size_t)(b * SEQ + tok) * 2048 + h * 64) * 0.125f + rpb[(h * 15 + (rs + i - r + 7)) * 31 + (cs + j - qc + 15)]; }
        } else { s[0] = -1e30f; s[1] = -1e30f; }
#pragma unroll
        for (int t = 0; t < 4; ++t) { const int c = F.lane + 64 * t; s[2 + t] = dot64(q, KQ + (size_t)(RL + b * CTXL + c) * 2048 + h * 64) * 0.125f; }
        float mx = s[0];
#pragma unroll
        for (int t = 1; t < 6; ++t) mx = fmaxf(mx, s[t]);
        mx = wave_max(mx);
        float sum = 0.f;
#pragma unroll
        for (int t = 0; t < 6; ++t) { s[t] = (lat || t >= 2) ? __expf(s[t] - mx) : 0.f; sum += s[t]; }
        sum = wave_sum(sum);
        pw[F.lane] = s[0]; pw[F.lane + 64] = s[1];
#pragma unroll
        for (int t = 0; t < 4; ++t) pw[128 + F.lane + 64 * t] = s[2 + t];
        LDS_WAIT(); asm volatile("" ::: "memory");
        float o = 0.f;
        if (lat) { const bf16* vr = VT + ((size_t)b * 1024 + h * 64 + F.lane) * 4096;
#pragma unroll 2
            for (int w = 0; w < 128; ++w) { const int tok = (rs + (w >> 4)) * 64 + cs + (w & 15); o += pw[w] * bf2f(vr[tok]); } }
        { const bf16* vr = VT + YT_CTX_OFF + ((size_t)b * 1024 + h * 64 + F.lane) * 256;
#pragma unroll 2
          for (int c8 = 0; c8 < 32; ++c8) { const u32x4 vw = *(const u32x4*)(vr + 8 * c8); const LAS float* pp = pw + 128 + 8 * c8;
#pragma unroll
              for (int t = 0; t < 4; ++t) o += pp[2 * t] * bflo(vw[t]) + pp[2 * t + 1] * bfhi(vw[t]); } }
        ATT[(size_t)rowq * 1024 + h * 64 + F.lane] = (bf16)f2bf(o / sum);
        LDS_WAIT(); asm volatile("" ::: "memory");
    }
}

constexpr int ACK_STRIDE = 72, ACV_STRIDE = 264;
constexpr int ALDS_CK = 0, ALDS_CV = 256 * ACK_STRIDE * 2, ALDS_RP = ALDS_CV + 64 * ACV_STRIDE * 2;
struct AttnState { float m, sum; f32x4 o[4]; };
__device__ __forceinline__ float xrow16_max(float x) {
    auto s = __builtin_amdgcn_permlane16_swap(__float_as_uint(x), __float_as_uint(x), false, false);
    x = fmaxf(__uint_as_float(s[0]), __uint_as_float(s[1]));
    auto t = __builtin_amdgcn_permlane32_swap(__float_as_uint(x), __float_as_uint(x), false, false);
    return fmaxf(__uint_as_float(t[0]), __uint_as_float(t[1]));
}
__device__ __forceinline__ float xrow16_sum(float x) {
    auto s = __builtin_amdgcn_permlane16_swap(__float_as_uint(x), __float_as_uint(x), false, false);
    x = __uint_as_float(s[0]) + __uint_as_float(s[1]);
    auto t = __builtin_amdgcn_permlane32_swap(__float_as_uint(x), __float_as_uint(x), false, false);
    return __uint_as_float(t[0]) + __uint_as_float(t[1]);
}
#define MFMA16(a, b, c) __builtin_amdgcn_mfma_f32_16x16x32_bf16((a), (b), (c), 0, 0, 0)
template <int NT>
__device__ __forceinline__ void attn_tail(AttnState& S, f32x4 (&sc)[NT], const u32x4 (&vw)[NT / 2][4]) {
    float cm = -1e30f;
#pragma unroll
    for (int t = 0; t < NT; ++t)
#pragma unroll
        for (int j = 0; j < 4; ++j) cm = fmaxf(cm, sc[t][j]);
    cm = xrow16_max(cm);
    const float mn = fmaxf(S.m, cm), scl = __builtin_amdgcn_exp2f(S.m - mn); S.m = mn; float ps = 0.f;
#pragma unroll
    for (int t = 0; t < NT; ++t)
#pragma unroll
        for (int j = 0; j < 4; ++j) { const float p = __builtin_amdgcn_exp2f(sc[t][j] - mn); sc[t][j] = p; ps += p; }
    S.sum = S.sum * scl + ps;
#pragma unroll
    for (int dt = 0; dt < 4; ++dt) S.o[dt] = S.o[dt] * scl;
#pragma unroll
    for (int ks = 0; ks < NT / 2; ++ks) { u32x4 pw; pw.x = pk2(sc[2 * ks][0], sc[2 * ks][1]); pw.y = pk2(sc[2 * ks][2], sc[2 * ks][3]); pw.z = pk2(sc[2 * ks + 1][0], sc[2 * ks + 1][1]); pw.w = pk2(sc[2 * ks + 1][2], sc[2 * ks + 1][3]);
        const bf16x8 pf = __builtin_bit_cast(bf16x8, pw);
#pragma unroll
        for (int dt = 0; dt < 4; ++dt) S.o[dt] = MFMA16(__builtin_bit_cast(bf16x8, vw[ks][dt]), pf, S.o[dt]); }
}
__device__ __forceinline__ void attn_unit2(const bf16* __restrict__ KQ, const bf16* __restrict__ VT, bf16* __restrict__ ATT, LAS unsigned char* lds,
                                           const int b, const int h, const int rowqA, const int rowqB, const bool win, const int r, const int qt, const int lane) {
    const int l15 = lane & 15, g = lane >> 4;
    const f32x4 z = {0.f, 0.f, 0.f, 0.f};
    bf16x8 qA[2], qB[2];
    { const bf16* qp = KQ + (size_t)(rowqA + l15) * 2048 + 1024 + h * 64 + 8 * g; qA[0] = *(const bf16x8*)qp; qA[1] = *(const bf16x8*)(qp + 32); }
    { const bf16* qp = KQ + (size_t)(rowqB + l15) * 2048 + 1024 + h * 64 + 8 * g; qB[0] = *(const bf16x8*)qp; qB[1] = *(const bf16x8*)(qp + 32); }
    AttnState SA, SB; SA.m = -1e30f; SA.sum = 0.f; SB.m = -1e30f; SB.sum = 0.f;
#pragma unroll
    for (int dt = 0; dt < 4; ++dt) { SA.o[dt] = z; SB.o[dt] = z; }
    if (win) {
        const int rsA = min(max(r - 4, 0), 56), dB = min(max(r - 3, 0), 56) - rsA, kc0 = min(max(16 * qt - 8, 0), 32);
        const int q = 16 * qt + l15, csq = min(max(q - 8, 0), 48);
        const int krow0 = 8 * (l15 >> 2) + (l15 & 3);
        const bf16* kb = KQ + (size_t)(b * SEQ + kc0 + krow0) * 2048 + h * 64 + 8 * g;
        const bf16* vb = VT + (size_t)(b * 1024 + h * 64 + l15) * 4096 + kc0 + 8 * g;
        const LAS float* rp = (const LAS float*)(lds + ALDS_RP);
        const int jb = kc0 + 8 * g;
        const int okb = jb - csq;
        const LAS float* rpl = rp + 16 + (jb - q + 15);
        float madd[2][4];
#pragma unroll
        for (int t = 0; t < 2; ++t)
#pragma unroll
            for (int j = 0; j < 4; ++j) madd[t][j] = ((unsigned)(okb + 4 * t + j) < 16u) ? 0.f : -__builtin_inff();
        bf16x8 K0[2][2], K1[2][2]; u32x4 V0[1][4], V1[1][4];
#define ATT_LOADW(KB, VB, i) do { const int gr_ = min(rsA + (i), 63); const bf16* kp_ = kb + (size_t)(gr_ * 64) * 2048; const bf16* vp_ = vb + gr_ * 64; \
        _Pragma("unroll") for (int t = 0; t < 2; ++t) { KB[t][0] = *(const bf16x8*)(kp_ + (size_t)(4 * t) * 2048); KB[t][1] = *(const bf16x8*)(kp_ + (size_t)(4 * t) * 2048 + 32); } \
        _Pragma("unroll") for (int dt = 0; dt < 4; ++dt) VB[0][dt] = *(const u32x4*)(vp_ + (size_t)(16 * dt) * 4096); } while (0)
#define ATT_ONE(ST, QF, KB, VB, roff, rowok) do { f32x4 sc[2]; \
        _Pragma("unroll") for (int t = 0; t < 2; ++t) { sc[t] = MFMA16(KB[t][0], QF[0], z); sc[t] = MFMA16(KB[t][1], QF[1], sc[t]); } \
        const LAS float* bp_ = rpl + ((rowok) ? (roff) : 15) * 64; \
        _Pragma("unroll") for (int t = 0; t < 2; ++t) _Pragma("unroll") for (int j = 0; j < 4; ++j) sc[t][j] = (sc[t][j] + bp_[4 * t + j]) + madd[t][j]; \
        attn_tail<2>(ST, sc, VB); } while (0)
#define ATT_COMPUTE(KB, VB, i) do { const int roffA_ = min(rsA + (i) - r + 7, 14); \
        ATT_ONE(SA, qA, KB, VB, roffA_, (i) <= 7); \
        ATT_ONE(SB, qB, KB, VB, max(roffA_ - 1, 0), (i) >= dB && (i) <= 7 + dB); } while (0)
        ATT_LOADW(K0, V0, 0);
#pragma unroll 1
        for (int i = 0; i < 8; i += 2) { ATT_LOADW(K1, V1, i + 1); ATT_COMPUTE(K0, V0, i); ATT_LOADW(K0, V0, i + 2); ATT_COMPUTE(K1, V1, i + 1); }
        ATT_COMPUTE(K0, V0, 8);
#undef ATT_LOADW
#undef ATT_ONE
#undef ATT_COMPUTE
    }
    { const LAS bf16* ck = (const LAS bf16*)(lds + ALDS_CK) + l15 * ACK_STRIDE + 8 * g;
      const LAS bf16* cv = (const LAS bf16*)(lds + ALDS_CV) + l15 * ACV_STRIDE + 8 * g;
#pragma unroll 1
      for (int c = 0; c < 4; ++c) {
          bf16x8 kf[4][2]; u32x4 vw[2][4];
#pragma unroll
          for (int t = 0; t < 4; ++t) { const LAS bf16* kp = ck + (64 * c + 16 * t) * ACK_STRIDE; kf[t][0] = *(const LAS bf16x8*)kp; kf[t][1] = *(const LAS bf16x8*)(kp + 32); }
#pragma unroll
          for (int ks = 0; ks < 2; ++ks)
#pragma unroll
              for (int dt = 0; dt < 4; ++dt) vw[ks][dt] = *(const LAS u32x4*)(cv + (16 * dt) * ACV_STRIDE + 64 * c + 32 * ks);
          { f32x4 sc[4];
#pragma unroll
            for (int t = 0; t < 4; ++t) { sc[t] = MFMA16(kf[t][0], qA[0], z); sc[t] = MFMA16(kf[t][1], qA[1], sc[t]); }
            attn_tail<4>(SA, sc, vw); }
          { f32x4 sc[4];
#pragma unroll
            for (int t = 0; t < 4; ++t) { sc[t] = MFMA16(kf[t][0], qB[0], z); sc[t] = MFMA16(kf[t][1], qB[1], sc[t]); }
            attn_tail<4>(SB, sc, vw); }
      } }
    { const float inv = 1.0f / xrow16_sum(SA.sum);
#pragma unroll
      for (int dt = 0; dt < 4; ++dt) st_bf4(ATT + (size_t)(rowqA + l15) * 1024 + h * 64 + 16 * dt + 4 * g, SA.o[dt] * inv); }
    { const float inv = 1.0f / xrow16_sum(SB.sum);
#pragma unroll
      for (int dt = 0; dt < 4; ++dt) st_bf4(ATT + (size_t)(rowqB + l15) * 1024 + h * 64 + 16 * dt + 4 * g, SB.o[dt] * inv); }
}
__device__ __forceinline__ void p_attn_mfma(const Params& P, Frame& F, int l, bool with_ctx_queries) {
    const bf16* KQ = WSP(bf16, WS_KQ); const bf16* VT = WSP(bf16, WS_VT); bf16* ATT = WSP(bf16, WS_ATT);
    const float* rpb = P.rpb + (size_t)l * 16 * 465;
    for (int hp = F.bid; hp < 256; hp += F.G) {
        const int p = hp & 127, half = hp >> 7, b = p >> 4, h = p & 15;
        __syncthreads();
        { LAS bf16* ck = (LAS bf16*)(F.lds + ALDS_CK); LAS bf16* cv = (LAS bf16*)(F.lds + ALDS_CV); LAS float* rp = (LAS float*)(F.lds + ALDS_RP);
          { const int key = F.tid >> 1, hf = F.tid & 1; const int k32 = key & 31, pos = (key & ~31) + ((k32 >> 2) & 1) * 16 + 4 * (k32 >> 3) + (k32 & 3);
            const u32x4* src = (const u32x4*)(KQ + (size_t)(RL + b * CTXL + key) * 2048 + h * 64 + hf * 32); LAS u32x4* dst = (LAS u32x4*)(ck + pos * ACK_STRIDE + hf * 32);
#pragma unroll
            for (int i = 0; i < 4; ++i) dst[i] = src[i]; }
          { const int d = F.tid >> 3, sg = F.tid & 7; const u32x4* src = (const u32x4*)(VT + YT_CTX_OFF + (size_t)(b * 1024 + h * 64 + d) * 256 + sg * 32); LAS u32x4* dst = (LAS u32x4*)(cv + d * ACV_STRIDE + sg * 32);
#pragma unroll
            for (int i = 0; i < 4; ++i) dst[i] = src[i]; }
          for (int i = F.tid; i < 16 * 64; i += NTHREADS) { const int rr = i >> 6, cc = (i & 63) - 16; rp[i] = rr == 15 ? -__builtin_inff() : ((cc >= 0 && cc < 31) ? rpb[h * 465 + rr * 31 + cc] * LOG2E : 0.f); } }
        __syncthreads();
        const int qt = F.wave & 3, rpi = F.wave >> 2;
#pragma unroll 1
        for (int st = 0; st < 8; ++st) { const int r = half * 32 + st * 4 + rpi * 2; const int rowqA = b * SEQ + r * 64 + 16 * qt;
            attn_unit2(KQ, VT, ATT, F.lds, b, h, rowqA, rowqA + 64, true, r, qt, F.lane); }
        if (with_ctx_queries && half == 0) { const int rowqA = RL + b * CTXL + 32 * F.wave; attn_unit2(KQ, VT, ATT, F.lds, b, h, rowqA, rowqA + 16, false, 0, 0, F.lane); }
    }
    __syncthreads();
}

__device__ __forceinline__ void p_pool(Frame& F, int nrows) {
    const bf16* PB = WSP(bf16, WS_PB); bf16* POOL = WSP(bf16, WS_POOL);
    for (int i = F.bid * NTHREADS + F.tid; i < nrows * 64; i += F.G * NTHREADS) {
        const int row = i >> 6, ch = i & 63, g = ch >> 4, hw = 1 << g;
        int base, t, Lb; if (row < RL) { base = row & ~4095; t = row & 4095; Lb = SEQ; } else { const int rr = row - RL; base = RL + (rr & ~255); t = rr & 255; Lb = CTXL; }
        const int lo = max(t - hw, 0), hi = min(t + hw, Lb);
        float a[8];
#pragma unroll
        for (int q = 0; q < 8; ++q) a[q] = 0.f;
        for (int tt = lo; tt < hi; ++tt) { const u32x4 w = *(const u32x4*)(PB + (size_t)(base + tt) * 512 + ch * 8);
#pragma unroll
            for (int q = 0; q < 4; ++q) { a[2 * q] += bflo(w[q]); a[2 * q + 1] += bfhi(w[q]); } }
        const u32x4 me = *(const u32x4*)(PB + (size_t)row * 512 + ch * 8); const float inv = 1.0f / (float)(hi - lo);
        u32x4 o;
#pragma unroll
        for (int q = 0; q < 4; ++q) o[q] = pk2(a[2 * q] * inv - bflo(me[q]), a[2 * q + 1] * inv - bfhi(me[q]));
        *(u32x4*)(POOL + (size_t)row * 512 + ch * 8) = o;
    }
}

__device__ __forceinline__ int block_sum_i(int v, LAS int* sm, int tid) {
#pragma unroll
    for (int o = 1; o < 64; o <<= 1) v += __shfl_xor(v, o);
    __syncthreads();
    if ((tid & 63) == 0) sm[tid >> 6] = v;
    __syncthreads();
    int s = 0;
#pragma unroll
    for (int i = 0; i < 8; ++i) s += sm[i];
    return s;
}
__device__ __forceinline__ int block_excl_scan(int v, LAS int* sm, int tid, int& total) {
    const int lane = tid & 63, w = tid >> 6; int inc = v;
#pragma unroll
    for (int o = 1; o < 64; o <<= 1) { const int t = __shfl_up(inc, o); if (lane >= o) inc += t; }
    __syncthreads();
    if (lane == 63) sm[w] = inc;
    __syncthreads();
    int base = 0; total = 0;
#pragma unroll
    for (int i = 0; i < 8; ++i) { const int s = sm[i]; if (i < w) base += s; total += s; }
    return base + inc - v;
}
template <int NPT>
__device__ __forceinline__ void topk_pair(Frame& F, int row0, int n, int cap, int e, int slot0) {
    LAS int* sm = (LAS int*)F.lds;
    const float* AFF = WSP(float, WS_AFF); int* SROW = WSP(int, WS_SROW); float* SG = WSP(float, WS_SGATE); int* SEL = WSP(int, WS_SEL);
    unsigned key[NPT];
#pragma unroll
    for (int j = 0; j < NPT; ++j) { const int i = F.tid * NPT + j; key[j] = (i < n) ? __float_as_uint(AFF[(size_t)(row0 + i) * 16 + e]) : 0u; }
    unsigned T = 0u;
    for (int bit = 30; bit >= 0; --bit) { const unsigned cand = T | (1u << bit); int cnt = 0;
#pragma unroll
        for (int j = 0; j < NPT; ++j) cnt += (key[j] >= cand) ? 1 : 0;
        cnt = block_sum_i(cnt, sm, F.tid);
        if (cnt >= cap) T = cand; }
    int ngt = 0, neq = 0;
#pragma unroll
    for (int j = 0; j < NPT; ++j) { ngt += (key[j] > T) ? 1 : 0; neq += (key[j] == T) ? 1 : 0; }
    int tot_gt, tot_eq;
    (void)block_excl_scan(ngt, sm, F.tid, tot_gt);
    int eqr = block_excl_scan(neq, sm, F.tid, tot_eq);
    const int need_eq = cap - tot_gt;
    int nsel = 0; bool selj[NPT];
#pragma unroll
    for (int j = 0; j < NPT; ++j) { bool s = key[j] > T; if (key[j] == T && T != 0u) { s = eqr < need_eq; ++eqr; } selj[j] = s; nsel += s ? 1 : 0; }
    int tot_sel; int pos = block_excl_scan(nsel, sm, F.tid, tot_sel);
#pragma unroll
    for (int j = 0; j < NPT; ++j) { const int i = F.tid * NPT + j;
        if (i < n) { const int row = row0 + i;
            if (selj[j]) { const int slot = slot0 + pos; ++pos; SROW[slot] = row; SG[slot] = __uint_as_float(key[j]); SEL[(size_t)row * 16 + e] = slot; }
            else SEL[(size_t)row * 16 + e] = -1; } }
    __syncthreads();
}
__device__ __forceinline__ void p_topk(Frame& F, bool with_ctx) {
    const int npairs = 128 + (with_ctx ? 128 : 0);
    for (int pi = F.bid; pi < npairs; pi += F.G) {
        if (pi < 128) { const int b = pi >> 4, e = pi & 15; topk_pair<8>(F, b * SEQ, SEQ, CAPL, e, e * SLOT_E + b * CAPL); }
        else { const int p2 = pi - 128, b = p2 >> 4, e = p2 & 15; topk_pair<1>(F, RL + b * CTXL, CTXL, CAPC, e, e * SLOT_E + 4096 + b * CAPC); }
    }
}
__device__ __forceinline__ void p_gather(Frame& F, bool with_ctx) {
    const int gw = F.bid * NWAVES + F.wave, NGW = F.G * NWAVES; const bf16* H = WSP(bf16, WS_H); bf16* XG = WSP(bf16, WS_XG); const int* SROW = WSP(int, WS_SROW);
    for (int s = gw; s < NSLOT; s += NGW) { if (!with_ctx && (s % SLOT_E) >= 4096) continue;
        const int row = SROW[s]; const u32x4* src = (const u32x4*)(H + (size_t)row * DM); u32x4* dst = (u32x4*)(XG + (size_t)s * DM);
        dst[F.lane] = src[F.lane]; dst[F.lane + 64] = src[F.lane + 64]; }
}

template <int PH> __global__ void __launch_bounds__(NTHREADS, 2) fwd_kernel(Params P) {
    extern __shared__ __attribute__((aligned(16))) unsigned char lds_raw[];
    Frame F; F.lds = (LAS unsigned char*)lds_raw; F.tid = threadIdx.x; F.lane = F.tid & 63; F.wave = __builtin_amdgcn_readfirstlane(F.tid >> 6); F.G = gridDim.x; F.bid = blockIdx.x; F.ws = P.ws;
    volatile LAS unsigned* MISC = (volatile LAS unsigned*)(F.lds + LDS_MISC);
    if (F.tid < 64) MISC[F.tid] = 0u;
    __syncthreads();
    XcdBarrier bar; bar.bar = WSP(unsigned, WS_CTL) + CW_BAR; bar.x = 0; bar.st = MISC + 8;
    if constexpr (PH < 0) bar = xcd_barrier_post(WSP(unsigned, WS_CTL) + CW_BAR, MISC + 8);
#define IN(k) (PH < 0 || PH == (k))
#define REFRESH() do { int t_ = threadIdx.x; asm volatile("" : "+v"(t_)); F.tid = t_; F.lane = t_ & 63; F.wave = __builtin_amdgcn_readfirstlane(t_ >> 6); } while (0)
#define SEAM(k) do { if constexpr (PH < 0) xcd_barrier(bar); } while (0)

    if (IN(0)) { REP_BEGIN(100) p_mod(P, F); p_dftgen(F); REP_END REP_BEGIN(101) p_wconv(P, F, 0); REP_END }
    SEAM(0);
    if (IN(1)) { p_rowpass_a0(P, F); }
    SEAM(1);
    for (int l = P.l_lo; l < P.l_hi; ++l) {
        constexpr int pb = 2; const bool L0 = (l == 0);
        bf16* H = WSP(bf16, WS_H);
        if (IN(pb + 0)) { REFRESH(); REP_BEGIN(2)
            { GroupSched S; S.init(1, 128, 22, F.G, F.bid, 8, L0 ? 22 : 4, 128, 0);
              const bf16* WA = WSP(bf16, WS_WA);
              auto AD = [=](const Unit& u) { return Operands{H + (size_t)u.pm * 256 * DM, WA + (size_t)u.pn * 256 * DM, DM, DM, 0, DM}; };
              bf16* KQ = WSP(bf16, WS_KQ); bf16* PBp = WSP(bf16, WS_PB); bf16* GB = WSP(bf16, WS_GB);
              auto E = [=](EPI_ARGS) { const int row0 = u.pm * 256;
                  if (u.pn < 8) { const float qs = (u.pn >= 4) ? QSCALE : 1.0f; EPI_FOR( st_bf4(KQ + (size_t)(row0 + r) * 2048 + u.pn * 256 + c, v * qs); ) }
                  else if (u.pn < 10) { EPI_FOR( st_bf4(PBp + (size_t)(row0 + r) * 512 + (u.pn - 8) * 256 + c, v); ) }
                  else { EPI_FOR( f32x4 s; s[0] = sigmoidf_(v[0]); s[1] = sigmoidf_(v[1]); s[2] = sigmoidf_(v[2]); s[3] = sigmoidf_(v[3]); st_bf4(GB + (size_t)(row0 + r) * 3072 + (u.pn - 10) * 256 + c, s); ) } };
              GEMM(S, AD, E, DM, DM, DM); }
            { GroupSched S; S.init(1, 8, 128, F.G, F.bid, L0 ? 8 : 4, 8, L0 ? 0 : 4, 128);
              const bf16* WFV = WSP(bf16, WS_WFV);
              auto AD = [=](const Unit& u) { return Operands{WFV + (size_t)u.pm * 256 * DM, H + (size_t)u.pn * 256 * DM, DM, DM, 0, DM}; };
              bf16* YT = WSP(bf16, WS_YT); bf16* VT = WSP(bf16, WS_VT);
              auto E = [=](EPI_ARGS) { bf16* T = (u.pm < 4) ? YT : VT; const int rr0 = (u.pm & 3) * 256;
                  if (u.pn < 128) { const int b = u.pn >> 4, l0 = (u.pn & 15) * 256; EPI_FOR( st_bf4(T + ((size_t)b * 1024 + rr0 + r) * 4096 + l0 + c, v); ) }
                  else { const int b = u.pn - 128; EPI_FOR( st_bf4(T + YT_CTX_OFF + ((size_t)b * 1024 + rr0 + r) * 256 + c, v); ) } };
              GEMM(S, AD, E, DM, DM, DM); }
        REP_END }
        SEAM(pb + 0);
        if (IN(pb + 1)) { REFRESH();
            REP_BEGIN(31) p_attn_mfma(P, F, l, L0); REP_END
            REP_BEGIN(32)
            { GroupSched S; S.init(1, 16, 16, F.G, F.bid);
              const bf16* DFTM = WSP(bf16, WS_DFTM); const bf16* YT = WSP(bf16, WS_YT); bf16* FOUR = WSP(bf16, WS_FOUR);
              auto AD = [=](const Unit& u) { return Operands{DFTM + (size_t)u.pm * 256 * 8192, YT + (size_t)u.pn * 256 * 8192, 8192, 8192, 0, 8192}; };
              auto E = [=](EPI_ARGS) { const int b = u.pn >> 1, c0 = (u.pn & 1) * 256; const float sc = 0.0013810679320049757f;
                  EPI_FOR( st_bf4(FOUR + ((size_t)b * SEQ + u.pm * 256 + r) * 512 + c0 + c, v * sc); ) };
              GEMM(S, AD, E, 8192, 8192, 8192); }
            if (L0) { GroupSched S; S.init(1, 1, 16, F.G, F.bid);
              const bf16* DFTC = WSP(bf16, WS_DFTC); const bf16* YTC = WSP(bf16, WS_YT) + YT_CTX_OFF; bf16* FOUR = WSP(bf16, WS_FOUR);
              auto AD = [=](const Unit& u) { return Operands{DFTC, YTC + (size_t)u.pn * 256 * 512, 512, 512, 0, 512}; };
              auto E = [=](EPI_ARGS) { const int b = u.pn >> 1, c0 = (u.pn & 1) * 256; const float sc = 0.005524271728019903f;
                  EPI_FOR( st_bf4(FOUR + ((size_t)RL + b * CTXL + r) * 512 + c0 + c, v * sc); ) };
              GEMM(S, AD, E, 512, 512, 512); }
            REP_END
            REP_BEGIN(33) p_pool(F, L0 ? RT : RL); REP_END
        }
        SEAM(pb + 1);
        if (IN(pb + 2)) { REFRESH();
            SegSched<3> S; S.base.init(1, L0 ? 136 : 128, 4, F.G, F.bid);
            const bf16* ATT = WSP(bf16, WS_ATT); const bf16* FOUR = WSP(bf16, WS_FOUR); const bf16* POOL = WSP(bf16, WS_POOL);
            const bf16* WAO = WSP(bf16, WS_WAO); const bf16* WFO = WSP(bf16, WS_WFO); const bf16* WPO = WSP(bf16, WS_WPO);
            const bf16* GB = WSP(bf16, WS_GB); bf16* MRGB = WSP(bf16, WS_MRGB); const float* ps = P.pool_scale + l * 1024;
            auto AD = [=](const Unit& u) {
                if (u.seg == 0) return Operands{ATT + (size_t)u.pm * 256 * 1024, WAO + (size_t)u.pn * 256 * 1024, 1024, 1024, 0, 1024};
                if (u.seg == 1) return Operands{FOUR + (size_t)u.pm * 256 * 512, WFO + (size_t)u.pn * 256 * 512, 512, 512, 0, 512};
                return Operands{POOL + (size_t)u.pm * 256 * 512 + (u.pn >> 1) * 256, WPO + (size_t)u.pn * 256 * 256, 512, 256, 0, 256}; };
            auto E = [=](EPI_ARGS) {
                const int kd = u.seg < 2 ? u.seg + 1 : 2; const bool fin = (u.seg == 2);
                f32x4 psv[2][2];
#pragma unroll
                for (int bj = 0; bj < 2; ++bj)
#pragma unroll
                    for (int n = 0; n < 2; ++n) psv[bj][n] = *(const f32x4*)(ps + u.pn * 256 + bj * 128 + wc * 32 + n * 16 + 4 * fq);
#pragma unroll
                for (int ai = 0; ai < 2; ++ai)
#pragma unroll
                    for (int m = 0; m < 4; ++m) { const size_t row = (size_t)u.pm * 256 + ai * 128 + wr * 64 + m * 16 + fr; const bf16* gr = GB + row * 3072 + u.pn * 256 + wc * 32 + 4 * fq;
                        u32x2 nr[2][2], dr[2][2];
#pragma unroll
                        for (int bj = 0; bj < 2; ++bj)
#pragma unroll
                            for (int n = 0; n < 2; ++n) { nr[bj][n] = *(const u32x2*)(gr + u.seg * 1024 + bj * 128 + n * 16); dr[bj][n] = *(const u32x2*)(gr + kd * 1024 + bj * 128 + n * 16); }
#pragma unroll
                        for (int bj = 0; bj < 2; ++bj)
#pragma unroll
                            for (int n = 0; n < 2; ++n) { f32x4 nu = {bflo(nr[bj][n].x), bfhi(nr[bj][n].x), bflo(nr[bj][n].y), bfhi(nr[bj][n].y)}, de = {bflo(dr[bj][n].x), bfhi(dr[bj][n].x), bflo(dr[bj][n].y), bfhi(dr[bj][n].y)};
                                if (u.seg == 2) nu = nu * psv[bj][n];
                                de = de * psv[bj][n];
                                f32x4 o;
#pragma unroll
                                for (int j = 0; j < 4; ++j) { const float nj = (fabsf(nu[j]) < 1e-30f) ? copysignf(1e-30f, nu[j]) : nu[j]; const float dj = (fabsf(de[j]) < 1e-30f) ? copysignf(1e-30f, de[j]) : de[j];
                                    o[j] = acc[ai][bj][m][n][j] * nj * (fin ? 1.0f : __builtin_amdgcn_rcpf(dj)); }
                                acc[ai][bj][m][n] = o; if (fin) st_bf4(MRGB + row * 1024 + u.pn * 256 + bj * 128 + wc * 32 + n * 16 + 4 * fq, o); } } };
            gemm_fast<false>(F.lds, F.tid, S, AD, mk_epi_seg(E, 2), nullptr);
        }
        SEAM(pb + 2);
        if (IN(pb + 3)) { REFRESH();
            GroupSched S; S.init(1, L0 ? 136 : 128, 4, F.G, F.bid); const bf16* A = WSP(bf16, WS_MRGB); const bf16* W = WSP(bf16, WS_WOUT);
            const float* xin = L0 ? P.x : P.out; const float* cin = L0 ? P.ctx : WSP(float, WS_XC); float* xo = P.out; float* co = WSP(float, WS_XC);
            const float* MOD = WSP(float, WS_MOD) + (size_t)l * 9 * 6144;
            auto AD = [=](const Unit& u) { return Operands{A + (size_t)u.pm * 256 * 1024, W + (size_t)u.pn * 256 * 1024, 1024, 1024, 0, 1024}; };
            auto E = [=](EPI_ARGS) {
                const int row0 = u.pm * 256, mr = row0 < RL ? (row0 >> 12) : 8, colb = u.pn * 256 + wc * 32 + 4 * fq;
                const float* src0 = row0 < RL ? xin + (size_t)row0 * DM : cin + (size_t)(row0 - RL) * DM; float* dst0 = row0 < RL ? xo + (size_t)row0 * DM : co + (size_t)(row0 - RL) * DM;
                f32x4 gv[2][2];
#pragma unroll
                for (int bj = 0; bj < 2; ++bj)
#pragma unroll
                    for (int n = 0; n < 2; ++n) gv[bj][n] = *(const f32x4*)(MOD + (size_t)mr * 6144 + 2048 + colb + bj * 128 + n * 16);
#pragma unroll
                for (int ai = 0; ai < 2; ++ai)
#pragma unroll
                    for (int m = 0; m < 4; ++m) { const size_t ro = (size_t)(ai * 128 + wr * 64 + m * 16 + fr) * DM + colb; f32x4 xv[2][2];
#pragma unroll
                        for (int bj = 0; bj < 2; ++bj)
#pragma unroll
                            for (int n = 0; n < 2; ++n) xv[bj][n] = *(const f32x4*)(src0 + ro + bj * 128 + n * 16);
#pragma unroll
                        for (int bj = 0; bj < 2; ++bj)
#pragma unroll
                            for (int n = 0; n < 2; ++n) *(f32x4*)(dst0 + ro + bj * 128 + n * 16) = xv[bj][n] + gv[bj][n] * acc[ai][bj][m][n]; } };
            GEMM(S, AD, E, 1024, 1024, 1024);
        }
        SEAM(pb + 3);
        if (IN(pb + 4)) { REFRESH(); REP_BEGIN(6) p_rowpass_f(P, F, l, L0 ? RT : RL); REP_END }
        SEAM(pb + 4);
        if (IN(pb + 5)) { REFRESH(); REP_BEGIN(7) p_topk(F, L0); REP_END }
        SEAM(pb + 5);
        if (IN(pb + 7)) { REFRESH(); REP_BEGIN(9)
            GroupSched S; S.init(16, L0 ? 17 : 16, 22, F.G, F.bid); const bf16* W = WSP(bf16, WS_WGU); bf16* HID = WSP(bf16, WS_HID); const int* SROW = WSP(int, WS_SROW);
            auto AD = [=](const Unit& u) { return Operands{H, W + ((size_t)u.grp * 5632 + u.pn * 256) * DM, DM, DM, u.grp * SLOT_E + u.pm * 256, DM}; };
            auto E = [=](EPI_ARGS) {
#pragma unroll
                for (int ai = 0; ai < 2; ++ai)
#pragma unroll
                    for (int m = 0; m < 4; ++m) { const size_t slot = (size_t)u.grp * SLOT_E + u.pm * 256 + ai * 128 + wr * 64 + m * 16 + fr;
#pragma unroll
                        for (int n = 0; n < 2; ++n) { const f32x4 a = acc[ai][0][m][n], up = acc[ai][1][m][n]; f32x4 o;
#pragma unroll
                            for (int j = 0; j < 4; ++j) o[j] = a[j] * sigmoidf_(a[j]) * up[j];
                            st_bf4(HID + slot * FF + u.pn * 128 + wc * 32 + n * 16 + 4 * fq, o); } } };
            GEMM_GATHER(S, AD, E, DM, DM, DM, SROW);
        REP_END }
        SEAM(pb + 7);
        if (IN(pb + 8)) { REFRESH(); REP_BEGIN(10)
            const int tpe = L0 ? 17 : 16;
            GroupSched S; S.init(1, 16 * tpe, 4, F.G, F.bid); const bf16* HID = WSP(bf16, WS_HID); const bf16* W = WSP(bf16, WS_WD); bf16* Y = WSP(bf16, WS_Y); const float* SG = WSP(float, WS_SGATE);
            auto AD = [=](const Unit& u) { const int e = u.pm / tpe, st = e * 17 + (u.pm - e * tpe); return Operands{HID + (size_t)st * 256 * FF, W + ((size_t)e * 1024 + u.pn * 256) * FF, FF, FF, 0, FF}; };
            auto E = [=](EPI_ARGS) { const int e = u.pm / tpe; const size_t slot0 = (size_t)(e * 17 + (u.pm - e * tpe)) * 256 + wr * 64 + fr; float gt[2][4];
#pragma unroll
                for (int ai = 0; ai < 2; ++ai)
#pragma unroll
                    for (int m = 0; m < 4; ++m) gt[ai][m] = SG[slot0 + ai * 128 + m * 16];
#pragma unroll
                for (int ai = 0; ai < 2; ++ai)
#pragma unroll
                    for (int m = 0; m < 4; ++m)
#pragma unroll
                        for (int bj = 0; bj < 2; ++bj)
#pragma unroll
                            for (int n = 0; n < 2; ++n) st_bf4(Y + (slot0 + ai * 128 + m * 16) * DM + u.pn * 256 + bj * 128 + wc * 32 + n * 16 + 4 * fq, acc[ai][bj][m][n] * gt[ai][m]); };
            GEMM(S, AD, E, FF, FF, FF);
        REP_END }
        SEAM(pb + 8);
        if (IN(pb + 9)) { REFRESH(); p_rowpass_k(P, F, l, L0 ? RT : RL); if (L0) p_wconv(P, F, 1); }
        if (L0) SEAM(pb + 9);
    }
#undef IN
#undef SEAM
}
template <int PH> static void launch_ph(int grid, const Params& p, hipStream_t stream) { hipLaunchKernelGGL(fwd_kernel<PH>, dim3(grid), dim3(NTHREADS), LDS_BYTES, stream, p); }
template <int PH> static bool set_attr() { return hipFuncSetAttribute((const void*)fwd_kernel<PH>, hipFuncAttributeMaxDynamicSharedMemorySize, LDS_BYTES) == hipSuccess; }

extern "C" void kernel_launch(void* const* d_in, const int* in_sizes, int n_in, void* d_out, int out_size, void* d_ws, size_t ws_size, hipStream_t stream) {
    static int grid = 0;
    if (grid == 0) {
        if (n_in != 20 || out_size != RL * DM || ws_size < WS_END) { fprintf(stderr, "kernel_launch: unexpected shapes (n_in %d out %d ws %zu need %zu)\n", n_in, out_size, ws_size, (size_t)WS_END); grid = -1; return; }
        int dev = 0, cus = 0, per_cu = 0;
        if (hipGetDevice(&dev) != hipSuccess || hipDeviceGetAttribute(&cus, hipDeviceAttributeMultiprocessorCount, dev) != hipSuccess) { grid = -1; return; }
#if N_LAUNCH_MODE == 1
        if (!set_attr<-1>()) { fprintf(stderr, "kernel_launch: hipFuncSetAttribute failed\n"); grid = -1; return; }
        if (hipOccupancyMaxActiveBlocksPerMultiprocessor(&per_cu, (const void*)fwd_kernel<-1>, NTHREADS, LDS_BYTES) != hipSuccess || per_cu < 1) fprintf(stderr, "kernel_launch: occupancy query reports %d\n", per_cu);
#else
        if (!(set_attr<0>() && set_attr<1>() && set_attr<2>() && set_attr<3>() && set_attr<4>() && set_attr<5>() && set_attr<6>() && set_attr<7>() && set_attr<9>() && set_attr<10>() && set_attr<11>())) { fprintf(stderr, "kernel_launch: hipFuncSetAttribute failed\n"); grid = -1; return; }
        (void)per_cu;
#endif
        (void)hipGetLastError();
        grid = cus;
    }
    if (grid < 0) return;
    if (hipMemsetAsync((char*)d_ws + WS_CTL, 0, CTL_BYTES, stream) != hipSuccess) return;
    Params p{};
    const float** pp = (const float**)&p;
    for (int i = 0; i < 20; ++i) pp[i] = (const float*)d_in[i];
    p.out = (float*)d_out; p.ws = (unsigned char*)d_ws;
#if N_LAUNCH_MODE == 1
    p.l_lo = 0; p.l_hi = 2;
    launch_ph<-1>(grid, p, stream);
#else
    p.l_lo = 0; p.l_hi = 0; launch_ph<0>(grid, p, stream); launch_ph<1>(grid, p, stream);
#ifndef DUP_LAUNCH
#define DUP_LAUNCH -1
#endif
#define LP(k) do { launch_ph<k>(grid, p, stream); if (DUP_LAUNCH == (k) && l == 0) launch_ph<k>(grid, p, stream); } while (0)
    for (int l = 0; l < 2; ++l) { p.l_lo = l; p.l_hi = l + 1;
        LP(2); LP(3); LP(4); LP(5); LP(6); LP(7); LP(9); LP(10); LP(11); }
#endif
}
```

```cpp
#include <hip/hip_runtime.h>
#include <cstdio>
#include <cstdint>

#ifndef N_LAUNCH_MODE
#define N_LAUNCH_MODE 1
#endif

#define GAS __attribute__((address_space(1)))
#define LAS __attribute__((address_space(3)))
typedef unsigned short bf16;
typedef short bf16x8 __attribute__((ext_vector_type(8)));
typedef float f32x4 __attribute__((ext_vector_type(4)));
typedef unsigned u32x4 __attribute__((ext_vector_type(4)));
typedef unsigned u32x2 __attribute__((ext_vector_type(2)));

constexpr int NB = 8, SEQ = 4096, DM = 1024, CTXL = 256, NH = 16, HD = 64, GRIDW = 64;
constexpr int RL = NB * SEQ, RC = NB * CTXL, RT = RL + RC;
constexpr int INW = 7168, NE = 16, FF = 2816, CAPL = 512, CAPC = 32;
constexpr int SLOT_E = 4352, NSLOT = NE * SLOT_E;
constexpr float RMS_EPS = 1e-6f;
constexpr float LOG2E = 1.4426950408889634f, QSCALE = 0.125f * LOG2E;
constexpr int NWAVES = 8, NTHREADS = 512;

constexpr size_t al256(size_t x) { return (x + 255) & ~(size_t)255; }
constexpr size_t WS_CTL = 0, CTL_BYTES = 1u << 20;
constexpr size_t WS_MOD = WS_CTL + CTL_BYTES;
constexpr size_t WS_XC = al256(WS_MOD + (size_t)2 * 9 * 6144 * 4);
constexpr size_t WS_AFF = al256(WS_XC + (size_t)RC * DM * 4);
constexpr size_t WS_SROW = al256(WS_AFF + (size_t)RT * 16 * 4);
constexpr size_t WS_SGATE = al256(WS_SROW + (size_t)NSLOT * 4);
constexpr size_t WS_SEL = al256(WS_SGATE + (size_t)NSLOT * 4);
constexpr size_t WS_DFTM = al256(WS_SEL + (size_t)RT * 16 * 4);
constexpr size_t WS_DFTC = al256(WS_DFTM + (size_t)4096 * 8192 * 2);
constexpr size_t WS_WA = al256(WS_DFTC + (size_t)256 * 512 * 2);
constexpr size_t WS_WFV = al256(WS_WA + (size_t)5632 * 1024 * 2);
constexpr size_t WS_WAO = al256(WS_WFV + (size_t)2048 * 1024 * 2);
constexpr size_t WS_WFO = al256(WS_WAO + (size_t)1024 * 1024 * 2);
constexpr size_t WS_WPO = al256(WS_WFO + (size_t)1024 * 512 * 2);
constexpr size_t WS_WOUT = al256(WS_WPO + (size_t)1024 * 256 * 2);
constexpr size_t WS_WGU = al256(WS_WOUT + (size_t)1024 * 1024 * 2);
constexpr size_t WS_WD = al256(WS_WGU + (size_t)16 * 5632 * 1024 * 2);
constexpr size_t WS_H = al256(WS_WD + (size_t)16 * 1024 * 2816 * 2);
constexpr size_t WS_R = al256(WS_H + (size_t)RT * DM * 2);
constexpr size_t WS_KQ = WS_R;
constexpr size_t WS_MRG = WS_KQ;
constexpr size_t WS_PB = al256(WS_KQ + (size_t)RT * 2048 * 2);
constexpr size_t WS_GB = al256(WS_PB + (size_t)RT * 512 * 2);
constexpr size_t WS_YT = al256(WS_GB + (size_t)RT * 3072 * 2);
constexpr size_t WS_MRGB = WS_YT;
constexpr size_t WS_VT = al256(WS_YT + (size_t)RT * 1024 * 2);
constexpr size_t WS_FOUR = al256(WS_VT + (size_t)RT * 1024 * 2);
constexpr size_t WS_ATT = al256(WS_FOUR + (size_t)RT * 512 * 2);
constexpr size_t WS_POOL = al256(WS_ATT + (size_t)RT * 1024 * 2);
constexpr size_t WS_MIX_END = al256(WS_POOL + (size_t)RT * 512 * 2);
constexpr size_t WS_XG = WS_R;
constexpr size_t WS_HID = al256(WS_XG + (size_t)NSLOT * 1024 * 2);
constexpr size_t WS_Y = al256(WS_HID + (size_t)NSLOT * 2816 * 2);
constexpr size_t WS_MOE_END = al256(WS_Y + (size_t)NSLOT * 1024 * 2);
constexpr size_t WS_END = WS_MIX_END > WS_MOE_END ? WS_MIX_END : WS_MOE_END;
constexpr size_t YT_CTX_OFF = (size_t)8 * 1024 * 4096;

constexpr int CW_BAR = 4096;

constexpr int LDS_BYTES = 147456;
constexpr int LDS_MISC = 131072;

__device__ __forceinline__ unsigned f2bf(float f) { unsigned u = __float_as_uint(f); return (u + 0x7fffu + ((u >> 16) & 1u)) >> 16; }
typedef __bf16 hbf16x2 __attribute__((ext_vector_type(2)));
typedef float f32x2 __attribute__((ext_vector_type(2)));
__device__ __forceinline__ unsigned pk2(float lo, float hi) { const f32x2 v = {lo, hi}; return __builtin_bit_cast(unsigned, __builtin_convertvector(v, hbf16x2)); }
__device__ __forceinline__ float bf2f(unsigned b) { return __uint_as_float(b << 16); }
__device__ __forceinline__ float bflo(unsigned w) { return __uint_as_float(w << 16); }
__device__ __forceinline__ float bfhi(unsigned w) { return __uint_as_float(w & 0xffff0000u); }
template <int CTRL> __device__ __forceinline__ float dppf(float x) { return __builtin_bit_cast(float, __builtin_amdgcn_mov_dpp(__builtin_bit_cast(int, x), CTRL, 0xf, 0xf, true)); }
template <int CTRL> __device__ __forceinline__ int dppi(int x) { return __builtin_amdgcn_mov_dpp(x, CTRL, 0xf, 0xf, true); }
constexpr int DPP_XOR1 = 0xB1, DPP_XOR2 = 0x4E, DPP_ROR4 = 0x124, DPP_ROR8 = 0x128;
__device__ __forceinline__ float wave_sum(float v) {
    v += dppf<DPP_XOR1>(v); v += dppf<DPP_XOR2>(v); v += dppf<DPP_ROR4>(v); v += dppf<DPP_ROR8>(v);
    auto s = __builtin_amdgcn_permlane16_swap(__float_as_uint(v), __float_as_uint(v), false, false); v = __uint_as_float(s[0]) + __uint_as_float(s[1]);
    auto t = __builtin_amdgcn_permlane32_swap(__float_as_uint(v), __float_as_uint(v), false, false); return __uint_as_float(t[0]) + __uint_as_float(t[1]);
}
__device__ __forceinline__ float wave_max(float v) {
    v = fmaxf(v, dppf<DPP_XOR1>(v)); v = fmaxf(v, dppf<DPP_XOR2>(v)); v = fmaxf(v, dppf<DPP_ROR4>(v)); v = fmaxf(v, dppf<DPP_ROR8>(v));
    auto s = __builtin_amdgcn_permlane16_swap(__float_as_uint(v), __float_as_uint(v), false, false); v = fmaxf(__uint_as_float(s[0]), __uint_as_float(s[1]));
    auto t = __builtin_amdgcn_permlane32_swap(__float_as_uint(v), __float_as_uint(v), false, false); return fmaxf(__uint_as_float(t[0]), __uint_as_float(t[1]));
}
__device__ __forceinline__ int wave_sum_i(int v) {
    v += dppi<DPP_XOR1>(v); v += dppi<DPP_XOR2>(v); v += dppi<DPP_ROR4>(v); v += dppi<DPP_ROR8>(v);
    auto s = __builtin_amdgcn_permlane16_swap((unsigned)v, (unsigned)v, false, false); v = (int)(s[0] + s[1]);
    auto t = __builtin_amdgcn_permlane32_swap((unsigned)v, (unsigned)v, false, false); return (int)(t[0] + t[1]);
}
__device__ __forceinline__ float sigmoidf_(float x) { return 1.f / (1.f + __expf(-x)); }
#define LDS_WAIT() asm volatile("s_waitcnt lgkmcnt(0)" ::: "memory")

#define XB_TMO      128
#define XB_XCNT(j)  (256  + 64 * (j))
#define XB_XSUB(j)  (1280 + 64 * (j))
#define XB_XGEN(j)  (2304 + 64 * (j))
#define XB_TOP      3328
#define XB_TOPGEN   3392
#define XCD_BAR_WORDS 3456
#define XB_SPIN_CAP (1u << 22)

__device__ __forceinline__ unsigned xb_ld(unsigned* p)              { return __hip_atomic_load(p, __ATOMIC_RELAXED, __HIP_MEMORY_SCOPE_AGENT); }
__device__ __forceinline__ unsigned xb_add(unsigned* p, unsigned v) { return __hip_atomic_fetch_add(p, v, __ATOMIC_RELAXED, __HIP_MEMORY_SCOPE_AGENT); }
__device__ __forceinline__ unsigned xb_xcc_id() { return (unsigned)__builtin_amdgcn_s_getreg((3 << 11) | 20) & 0xFu; }
#define XB_SPIN(cond, bar) do { unsigned _sp = 0; while (cond) { __builtin_amdgcn_s_sleep(1); \
    if ((++_sp & 255u) == 0u) { if (xb_ld(&(bar)[XB_TMO])) break; if (_sp > XB_SPIN_CAP) { atomicAdd(&(bar)[XB_TMO], 1u); break; } } } } while (0)

struct XcdBarrier { unsigned* bar; unsigned x; volatile LAS unsigned* st; };

__device__ __forceinline__ XcdBarrier xcd_barrier_post(unsigned* bar, volatile LAS unsigned* st) {
    XcdBarrier b; b.bar = bar; b.x = xb_xcc_id(); b.st = st;
    if (threadIdx.x == 0) (void)xb_add(&bar[XB_XCNT(b.x)], 1u);
    return b;
}
__device__ __forceinline__ void xcd_barrier_complete(unsigned* bar, unsigned x, unsigned& nloc, unsigned& nx) {
    const unsigned G = gridDim.x * gridDim.y * gridDim.z;
    unsigned sum, cnt, mine, sp = 0u;
    for (;;) {
        sum = 0u; cnt = 0u; mine = 0u;
#pragma unroll
        for (unsigned j = 0; j < 16; ++j) { const unsigned c = xb_ld(&bar[XB_XCNT(j)]); sum += c; cnt += (c > 0u) ? 1u : 0u; mine = (j == x) ? c : mine; }
        if (sum == G) break;
        __builtin_amdgcn_s_sleep(1);
        if ((++sp & 255u) == 0u) { if (xb_ld(&bar[XB_TMO])) break; if (sp > XB_SPIN_CAP) { atomicAdd(&bar[XB_TMO], 1u); break; } }
    }
    nloc = mine > 0u ? mine : 1u; nx = cnt > 0u ? cnt : 1u;
}
__device__ __forceinline__ void xcd_barrier(const XcdBarrier& b) {
    asm volatile("s_waitcnt vmcnt(0)" ::: "memory");
    __syncthreads();
    if (threadIdx.x == 0) {
        unsigned* bar = b.bar;
        __builtin_amdgcn_s_waitcnt(0);
        unsigned nloc = b.st[0], nx = b.st[1];
        if (nloc == 0u) { xcd_barrier_complete(bar, b.x, nloc, nx); b.st[0] = nloc; b.st[1] = nx; }
        const unsigned old = xb_add(&bar[XB_XSUB(b.x)], 1u);
        const unsigned gen = old / nloc;
        if (old + 1u == (gen + 1u) * nloc) {
            __builtin_amdgcn_fence(__ATOMIC_RELEASE, "agent");
            asm volatile("s_waitcnt vmcnt(0)" ::: "memory");
            const unsigned og = xb_add(&bar[XB_TOP], 1u);
            const unsigned tg = og / nx;
            if (og + 1u == (tg + 1u) * nx) xb_add(&bar[XB_TOPGEN], 1u);
            else XB_SPIN(xb_ld(&bar[XB_TOPGEN]) == tg, bar);
            __builtin_amdgcn_fence(__ATOMIC_ACQUIRE, "agent");
            xb_add(&bar[XB_XGEN(b.x)], 1u);
            asm volatile("s_waitcnt vmcnt(0)" ::: "memory");
        } else {
            XB_SPIN(xb_ld(&bar[XB_XGEN(b.x)]) == gen, bar);
            __builtin_amdgcn_fence(__ATOMIC_ACQUIRE, "agent");
            asm volatile("s_waitcnt vmcnt(0)" ::: "memory");
        }
    }
    __syncthreads();
}

struct Params {
    const float *x, *c, *ctx, *c_ctx, *ada_w, *ada_b, *norm1_g, *norm2_g, *w_in, *rpb, *w_att_o, *w_fourier, *w_pool, *pool_scale, *w_out, *w_router, *w_eg, *w_eu, *w_ed, *final_g;
    float* out; unsigned char* ws; int l_lo, l_hi;
};
struct Frame {
    LAS unsigned char* lds;
    int tid, lane, wave, G, bid;
    unsigned char* ws;
};
#define WSP(T, off) ((T*)(F.ws + (off)))

struct Unit { int grp, pm, pn, seg; };
struct GroupSched {
    int ng, nM, nN, G, c; int tM, tN, tpm0, tpn0;
    __device__ __forceinline__ void init(int ng_, int nM_, int nN_, int G_, int c_, int tM_ = 0, int tN_ = 0, int tpm0_ = 0, int tpn0_ = 0) { ng = ng_; nM = nM_; nN = nN_; G = G_; c = c_; tM = tM_; tN = tN_; tpm0 = tpm0_; tpn0 = tpn0_; }
    __device__ __forceinline__ bool next(int i, Unit& u) const {
        const int per = nM * nN; const int L = i * G + c;
        if (L < ng * per) {
            u.grp = L / per; int wgid = L - u.grp * per;
            { const int q = per / 8, r = per % 8, xcd = wgid % 8, off = wgid / 8; wgid = (xcd < r ? xcd * (q + 1) : r * (q + 1) + (xcd - r) * q) + off; }
            const int nig = 8 * nN, gid = wgid / nig, fm = gid * 8, gsz = (nM - fm) < 8 ? (nM - fm) : 8;
            u.pm = fm + ((wgid % nig) % gsz); u.pn = (wgid % nig) / gsz; u.seg = 0; return true;
        }
        const int w = L - ng * per;
        if (w < tM * tN) { u.grp = ng; u.pm = tpm0 + (w % tM); u.pn = tpn0 + (w / tM); u.seg = 0; return true; }
        return false;
    }
};
struct Operands { const bf16* A; const bf16* Bt; int lda, ldb, slot0, K; };

template <class Addr, class Epi>
__device__ __forceinline__ void gemm_simple(const GroupSched& S, const Addr& AD, const Epi& E, int K) {
    const int tid = threadIdx.x, wid = __builtin_amdgcn_readfirstlane(tid >> 6), lane = tid & 63, wr = wid >> 2, wc = wid & 3, fr = lane & 15, fq = lane >> 4;
    Unit u;
    for (int i = 0; S.next(i, u); ++i) {
        const Operands op = AD(u);
        f32x4 acc[2][2][4][2];
#pragma unroll
        for (int a = 0; a < 2; ++a)
#pragma unroll
            for (int b = 0; b < 2; ++b)
#pragma unroll
                for (int m = 0; m < 4; ++m)
#pragma unroll
                    for (int n = 0; n < 2; ++n) acc[a][b][m][n] = (f32x4){0.f, 0.f, 0.f, 0.f};
        const bf16* ap = op.A + (size_t)(wr * 64 + fr) * op.lda + fq * 8;
        const bf16* bp = op.Bt + (size_t)(wc * 32 + fr) * op.ldb + fq * 8;
#pragma unroll 1
        for (int k = 0; k < K; k += 32) {
            bf16x8 bfr[2][2];
#pragma unroll
            for (int b = 0; b < 2; ++b)
#pragma unroll
                for (int n = 0; n < 2; ++n) bfr[b][n] = *(const bf16x8*)(bp + (size_t)(b * 128 + n * 16) * op.ldb + k);
#pragma unroll
            for (int a = 0; a < 2; ++a) {
                bf16x8 af[4];
#pragma unroll
                for (int m = 0; m < 4; ++m) af[m] = *(const bf16x8*)(ap + (size_t)(a * 128 + m * 16) * op.lda + k);
#pragma unroll
                for (int b = 0; b < 2; ++b)
#pragma unroll
                    for (int m = 0; m < 4; ++m)
#pragma unroll
                        for (int n = 0; n < 2; ++n) acc[a][b][m][n] = __builtin_amdgcn_mfma_f32_16x16x32_bf16(bfr[b][n], af[m], acc[a][b][m][n], 0, 0, 0);
            }
        }
        E(acc, u, wr, wc, fr, fq);
    }
}
constexpr int HTB = 128 * 64 * 2;
__device__ __forceinline__ int lds_byte(int r, int c) { const int st = (r >> 4) * 2 + (c >> 5), rr = r & 15, cc = c & 31, ob = rr * 64 + cc * 2; return st * 1024 + (ob ^ (((ob >> 9) & 1) << 5)); }
__device__ __forceinline__ int perm32(int rho) { const int n = rho >> 4, i = rho & 15; return 8 * (i >> 2) + 4 * n + (i & 3); }
__device__ __forceinline__ void stage_rc(int b, int& R, int& C) { const int st = b / 1024, sb = b % 1024, swz = sb ^ (((sb >> 9) & 1) << 5); R = (st >> 1) * 16 + swz / 64; C = (st & 1) * 32 + (swz % 64) / 2; }
template <bool GATHER, bool PERM, class Sched, class Addr, class Epi>
__device__ __forceinline__ void gemm_fast(LAS unsigned char* lds, const int tid, const Sched& S, const Addr& AD, const Epi& E, const int* __restrict__ grows) {
    const int wid = __builtin_amdgcn_readfirstlane(tid >> 6), lane = tid & 63, wr = wid >> 2, wc = wid & 3, fr = lane & 15, fq = lane >> 4;
    int sR[2], sRb[2]; unsigned sC[2];
    unsigned cvg[2][2], nvg[2][2], cvb[2][2], nvb[2][2];
#pragma unroll
    for (int i = 0; i < 2; ++i) { int R, C; stage_rc(tid * 16 + i * 8192, R, C); sR[i] = R; sC[i] = (unsigned)C * 2u; sRb[i] = PERM ? ((R & ~31) + perm32(R & 31)) : R; }
    const size_t kstep = 128;
    const unsigned ldsw = (unsigned)wid * 1024u;
    const int aoff = lds_byte(wr * 64 + fr, fq * 8), boff = lds_byte(wc * 32 + fr, fq * 8);
#define PG8_SA(b, h) (((b) * 2 + (h)) * HTB)
#define PG8_SB(b, h) ((4 + (b) * 2 + (h)) * HTB)
#define PG8_STAGE(bufoff, gbase, voff) do { _Pragma("unroll") for (int _i = 0; _i < 2; ++_i) \
        __builtin_amdgcn_global_load_lds((const unsigned*)((const char*)(gbase) + (voff)[_i]), (LAS unsigned*)(lds + (bufoff) + ldsw + _i * 8192), 16, 0, 0); } while (0)
#define PG8_LDA(dst, b, h) do { _Pragma("unroll") for (int m = 0; m < 4; ++m) _Pragma("unroll") for (int k = 0; k < 2; ++k) dst[m][k] = *(const LAS bf16x8*)(lds + PG8_SA(b, h) + aoff + m * 2048 + k * 1024); } while (0)
#define PG8_LDB(dst, b, h) do { _Pragma("unroll") for (int n = 0; n < 2; ++n) _Pragma("unroll") for (int k = 0; k < 2; ++k) dst[n][k] = *(const LAS bf16x8*)(lds + PG8_SB(b, h) + boff + n * 2048 + k * 1024); } while (0)
#define PG8_MMA(ai, bj, At, Bt) do { __builtin_amdgcn_s_setprio(1); _Pragma("unroll") for (int m = 0; m < 4; ++m) _Pragma("unroll") for (int n = 0; n < 2; ++n) _Pragma("unroll") for (int k = 0; k < 2; ++k) \
        acc[ai][bj][m][n] = __builtin_amdgcn_mfma_f32_16x16x32_bf16(Bt[n][k], At[m][k], acc[ai][bj][m][n], 0, 0, 0); __builtin_amdgcn_s_setprio(0); } while (0)
#define PG8_WAIT_V(n) asm volatile("s_waitcnt vmcnt(" #n ")" ::: "memory")
#define PG8_WAIT_L(n) asm volatile("s_waitcnt lgkmcnt(" #n ")" ::: "memory")
#define PG8_BAR __builtin_amdgcn_s_barrier()
#define PG8_SCHED __builtin_amdgcn_sched_barrier(0)
#define PG8_GIDX(dst, op_) do { _Pragma("unroll") for (int h_ = 0; h_ < 2; ++h_) _Pragma("unroll") for (int i_ = 0; i_ < 2; ++i_) dst[h_][i_] = (unsigned)grows[(op_).slot0 + h_ * 128 + sR[i_]] * (unsigned)((op_).lda * 2) + sC[i_]; } while (0)
#define PG8_AOFF(dst, op_) do { _Pragma("unroll") for (int h_ = 0; h_ < 2; ++h_) _Pragma("unroll") for (int i_ = 0; i_ < 2; ++i_) dst[h_][i_] = (unsigned)((sR[i_] + 128 * h_) * (op_).lda) * 2u + sC[i_]; } while (0)
#define PG8_BOFF(dst, op_) do { _Pragma("unroll") for (int h_ = 0; h_ < 2; ++h_) _Pragma("unroll") for (int i_ = 0; i_ < 2; ++i_) dst[h_][i_] = (unsigned)((sRb[i_] + 128 * h_) * (op_).ldb) * 2u + sC[i_]; } while (0)
#define PG8_COPY(dst, src) do { _Pragma("unroll") for (int h_ = 0; h_ < 2; ++h_) _Pragma("unroll") for (int i_ = 0; i_ < 2; ++i_) dst[h_][i_] = src[h_][i_]; } while (0)
    Unit cur, nxt; int ui = 0;
    if (!S.next(0, cur)) return;
    f32x4 acc[2][2][4][2];
#pragma unroll
    for (int a = 0; a < 2; ++a)
#pragma unroll
        for (int b = 0; b < 2; ++b)
#pragma unroll
            for (int m = 0; m < 4; ++m)
#pragma unroll
                for (int n = 0; n < 2; ++n) acc[a][b][m][n] = (f32x4){0.f, 0.f, 0.f, 0.f};
    bf16x8 At[4][2], B0[2][2], B1[2][2];
    const char* cA; const char* cB; int nt;
    { const Operands op = AD(cur); cA = (const char*)op.A; cB = (const char*)op.Bt; nt = op.K / 64; PG8_BOFF(cvb, op);
      Unit u1; const bool h1 = S.next(1, u1); const Operands o1 = h1 ? AD(u1) : op; PG8_BOFF(nvb, o1);
      if constexpr (GATHER) { PG8_GIDX(cvg, op); PG8_GIDX(nvg, o1); PG8_WAIT_V(0); } else { PG8_AOFF(cvg, op); PG8_AOFF(nvg, o1); } }
    PG8_STAGE(PG8_SB(0, 0), cB, cvb[0]); PG8_STAGE(PG8_SB(0, 1), cB, cvb[1]); PG8_STAGE(PG8_SA(0, 0), cA, cvg[0]); PG8_STAGE(PG8_SA(0, 1), cA, cvg[1]);
    if (wr == 1) PG8_BAR;
    PG8_WAIT_V(2); PG8_BAR;
    PG8_STAGE(PG8_SB(1, 0), cB + kstep, cvb[0]); PG8_STAGE(PG8_SA(1, 0), cA + kstep, cvg[0]); PG8_STAGE(PG8_SB(1, 1), cB + kstep, cvb[1]);
    PG8_WAIT_V(6); PG8_BAR;
    for (;;) {
        const bool has_next = S.next(ui + 1, nxt);
        const char* nA = cA; const char* nB = cB; int nnt = nt;
        if (has_next) { const Operands op = AD(nxt); nA = (const char*)op.A; nB = (const char*)op.Bt; nnt = op.K / 64; }
#pragma unroll 1
        for (int t = 0; t < nt; t += 2) {
            const bool last = (t == nt - 2);
            const char* a1 = cA + (size_t)(t + 1) * kstep;
            const char* a2 = last ? nA : cA + (size_t)(t + 2) * kstep; const char* b2 = last ? nB : cB + (size_t)(t + 2) * kstep;
            const char* a3 = a2 + kstep; const char* b3 = b2 + kstep;
            unsigned v2[2][2], w2[2][2];
#pragma unroll
            for (int h_ = 0; h_ < 2; ++h_)
#pragma unroll
                for (int i_ = 0; i_ < 2; ++i_) { v2[h_][i_] = last ? nvg[h_][i_] : cvg[h_][i_]; w2[h_][i_] = last ? nvb[h_][i_] : cvb[h_][i_]; }
            PG8_LDB(B0, 0, 0); PG8_LDB(B1, 0, 1); PG8_SCHED; PG8_LDA(At, 0, 0); PG8_STAGE(PG8_SA(1, 1), a1, cvg[1]);
            PG8_WAIT_V(8); PG8_WAIT_L(0); PG8_BAR; PG8_MMA(0, 0, At, B0); PG8_MMA(0, 1, At, B1); PG8_BAR; PG8_SCHED;
            PG8_LDA(At, 0, 1); PG8_STAGE(PG8_SB(0, 0), b2, w2[0]); PG8_STAGE(PG8_SB(0, 1), b2, w2[1]); PG8_STAGE(PG8_SA(0, 0), a2, v2[0]);
            PG8_WAIT_V(8); PG8_WAIT_L(0); PG8_BAR; PG8_MMA(1, 0, At, B0); PG8_MMA(1, 1, At, B1); PG8_BAR; PG8_SCHED;
            PG8_LDB(B0, 1, 0); PG8_LDB(B1, 1, 1); PG8_SCHED; PG8_LDA(At, 1, 0); PG8_STAGE(PG8_SA(0, 1), a2, v2[1]);
            PG8_WAIT_V(8); PG8_WAIT_L(0); PG8_BAR; PG8_MMA(0, 0, At, B0); PG8_MMA(0, 1, At, B1); PG8_BAR; PG8_SCHED;
            PG8_LDA(At, 1, 1); PG8_STAGE(PG8_SB(1, 0), b3, w2[0]); PG8_STAGE(PG8_SB(1, 1), b3, w2[1]); PG8_STAGE(PG8_SA(1, 0), a3, v2[0]);
            PG8_WAIT_V(8); PG8_WAIT_L(0); PG8_BAR; PG8_MMA(1, 0, At, B0); PG8_MMA(1, 1, At, B1); PG8_BAR; PG8_SCHED;
        }
        if (wr == 0) PG8_BAR;
        unsigned fvg[2][2], fvb[2][2];
        { Unit u2; const bool h2 = S.next(ui + 2, u2);
          if (h2) { const Operands o2 = AD(u2); PG8_BOFF(fvb, o2); if constexpr (GATHER) PG8_GIDX(fvg, o2); else PG8_AOFF(fvg, o2); }
          else { PG8_COPY(fvb, nvb); PG8_COPY(fvg, nvg); } }
        { int fr2 = fr, fq2 = fq; asm volatile("" : "+v"(fr2), "+v"(fq2));
          E(acc, cur, wr, wc, fr2, fq2); }
        if (!has_next) break;
        if constexpr (GATHER) PG8_WAIT_V(0);
        PG8_COPY(cvg, nvg); PG8_COPY(nvg, fvg); PG8_COPY(cvb, nvb); PG8_COPY(nvb, fvb);
        if (E.reset(cur)) {
#pragma unroll
        for (int a = 0; a < 2; ++a)
#pragma unroll
            for (int b = 0; b < 2; ++b)
#pragma unroll
                for (int m = 0; m < 4; ++m)
#pragma unroll
                    for (int n = 0; n < 2; ++n) acc[a][b][m][n] = (f32x4){0.f, 0.f, 0.f, 0.f};
        }
        cur = nxt; cA = nA; cB = nB; nt = nnt; ++ui;
        if (wr == 1) PG8_BAR;
    }
    PG8_WAIT_V(0);
    PG8_BAR;
#undef PG8_SA
#undef PG8_SB
#undef PG8_STAGE
#undef PG8_LDA
#undef PG8_LDB
#undef PG8_MMA
#undef PG8_WAIT_V
#undef PG8_WAIT_L
#undef PG8_BAR
#undef PG8_SCHED
#undef PG8_GIDX
#undef PG8_AOFF
#undef PG8_BOFF
#undef PG8_COPY
}
template <class F> struct EpiFn { F f; __device__ __forceinline__ void operator()(f32x4 (&acc)[2][2][4][2], const Unit& u, int wr, int wc, int fr, int fq) const { f(acc, u, wr, wc, fr, fq); } __device__ __forceinline__ bool reset(const Unit&) const { return true; } };
template <class F> __device__ __forceinline__ EpiFn<F> mk_epi(F f) { return EpiFn<F>{f}; }
template <class F> struct EpiSeg { F f; int last; __device__ __forceinline__ void operator()(f32x4 (&acc)[2][2][4][2], const Unit& u, int wr, int wc, int fr, int fq) const { f(acc, u, wr, wc, fr, fq); } __device__ __forceinline__ bool reset(const Unit& u) const { return u.seg == last; } };
template <class F> __device__ __forceinline__ EpiSeg<F> mk_epi_seg(F f, int last) { return EpiSeg<F>{f, last}; }
template <int NSEG> struct SegSched { GroupSched base; __device__ __forceinline__ bool next(int j, Unit& u) const { if (!base.next(j / NSEG, u)) return false; u.seg = j % NSEG; return true; } };
#ifndef DUP_PH
#define DUP_PH -1
#endif
#define REP_BEGIN(k) _Pragma("unroll 1") for (int rep_ = 0; rep_ < ((DUP_PH == (k)) ? 2 : 1); ++rep_) { if (rep_) { if constexpr (PH < 0) xcd_barrier(bar); }
#define REP_END }
#ifndef USE_FAST
#define USE_FAST 1
#endif
#if USE_FAST
#define GEMM(S, AD, E, K, lda, ldb) gemm_fast<false, false>(F.lds, F.tid, S, AD, mk_epi(E), nullptr)
#define GEMM_P(S, AD, E) gemm_fast<false, true>(F.lds, F.tid, S, AD, mk_epi(E), nullptr)
#define GEMM_GATHER(S, AD, E, K, lda, ldb, rows) gemm_fast<true, true>(F.lds, F.tid, S, AD, mk_epi(E), rows)
#else
#define GEMM(S, AD, E, K, lda, ldb) gemm_simple(S, AD, E, K)
#endif
#define EPI_ARGS f32x4 (&acc)[2][2][4][2], const Unit& u, int wr, int wc, int fr, int fq
#define EPI_FOR(...) _Pragma("unroll") for (int ai = 0; ai < 2; ++ai) _Pragma("unroll") for (int m = 0; m < 4; ++m) { const int r = ai * 128 + wr * 64 + m * 16 + fr; \
    _Pragma("unroll") for (int bj = 0; bj < 2; ++bj) _Pragma("unroll") for (int n = 0; n < 2; ++n) { const int c = bj * 128 + wc * 32 + n * 16 + 4 * fq; const f32x4 v = acc[ai][bj][m][n]; __VA_ARGS__ } }
#define EPI_FOR8(...) _Pragma("unroll") for (int ai = 0; ai < 2; ++ai) _Pragma("unroll") for (int m = 0; m < 4; ++m) { const int r = ai * 128 + wr * 64 + m * 16 + fr; \
    _Pragma("unroll") for (int bj = 0; bj < 2; ++bj) { const int c = bj * 128 + wc * 32 + 8 * fq; const f32x4 v0 = acc[ai][bj][m][0], v1 = acc[ai][bj][m][1]; __VA_ARGS__ } }
__device__ __forceinline__ void st_bf8(bf16* p, f32x4 a, f32x4 b) { u32x4 w; w.x = pk2(a[0], a[1]); w.y = pk2(a[2], a[3]); w.z = pk2(b[0], b[1]); w.w = pk2(b[2], b[3]); *(u32x4*)p = w; }
__device__ __forceinline__ void st_bf4(bf16* p, f32x4 v) { u32x2 w; w.x = pk2(v[0], v[1]); w.y = pk2(v[2], v[3]); *(u32x2*)p = w; }

__device__ __forceinline__ void p_mod(const Params& P, Frame& F) {
    LAS float* sc = (LAS float*)F.lds;
    LAS float* red = (LAS float*)(F.lds + 9 * 1024 * 4);
    float* MOD = WSP(float, WS_MOD);
    bool have = false;
    for (int it = F.bid; it < 2 * 96; it += F.G) {
        if (!have) {
            for (int i = F.tid; i < 9 * 1024; i += NTHREADS) { const int r = i >> 10, k = i & 1023; const float v = r < 8 ? P.c[r * 1024 + k] : P.c_ctx[k]; sc[i] = v * sigmoidf_(v); }
            have = true;
        }
        __syncthreads();
        const int l = it / 96, j0 = (it % 96) * 64, jj = F.tid & 63, kc = F.tid >> 6;
        const float* W = P.ada_w + (size_t)l * 1024 * 6144 + j0 + jj;
        float a[9];
#pragma unroll
        for (int r = 0; r < 9; ++r) a[r] = 0.f;
        for (int k = kc * 128; k < kc * 128 + 128; ++k) { const float w = W[(size_t)k * 6144];
#pragma unroll
            for (int r = 0; r < 9; ++r) a[r] += sc[r * 1024 + k] * w; }
#pragma unroll
        for (int r = 0; r < 9; ++r) red[(kc * 9 + r) * 64 + jj] = a[r];
        __syncthreads();
        for (int o = F.tid; o < 9 * 64; o += NTHREADS) { const int r = o >> 6, j = o & 63; float s = 0.f;
#pragma unroll
            for (int q = 0; q < 8; ++q) s += red[(q * 9 + r) * 64 + j];
            MOD[((size_t)l * 9 + r) * 6144 + j0 + j] = s + P.ada_b[l * 6144 + j0 + j]; }
    }
    __syncthreads();
}
__device__ __forceinline__ void p_dftgen(Frame& F) {
    LAS float* tab = (LAS float*)F.lds;
    for (int j = F.tid; j < 4096; j += NTHREADS) tab[j] = cospif((float)j * (1.0f / 2048.0f));
    __syncthreads();
    bf16* DM_ = WSP(bf16, WS_DFTM); bf16* DC_ = WSP(bf16, WS_DFTC);
    const int nchunk = 4096 * 1024 + 256 * 64;
    for (int ch = F.bid * NTHREADS + F.tid; ch < nchunk; ch += F.G * NTHREADS) {
        float v[8]; bf16* dst;
        if (ch < 4096 * 1024) { const int kf = ch >> 10, col0 = (ch & 1023) * 8, cs = col0 >> 12, l0 = col0 & 4095;
#pragma unroll
            for (int i = 0; i < 8; ++i) { const int j = (kf * (l0 + i)) & 4095; v[i] = cs ? -tab[(j + 3072) & 4095] : tab[j]; }
            dst = DM_ + (size_t)kf * 8192 + col0; }
        else { const int c2 = ch - 4096 * 1024, kf = c2 >> 6, col0 = (c2 & 63) * 8, cs = col0 >> 8, l0 = col0 & 255;
#pragma unroll
            for (int i = 0; i < 8; ++i) { const int j = ((kf * (l0 + i)) & 255) * 16; v[i] = cs ? -tab[(j + 3072) & 4095] : tab[j]; }
            dst = DC_ + (size_t)kf * 512 + col0; }
        u32x4 o; o.x = pk2(v[0], v[1]); o.y = pk2(v[2], v[3]); o.z = pk2(v[4], v[5]); o.w = pk2(v[6], v[7]);
        *(u32x4*)dst = o;
    }
    __syncthreads();
}
__device__ __forceinline__ void transpose_item(const float* W, int ldw, int k0, int n0, bf16* WT, int ldt, int drow0, LAS float* scr, int lane) {
    f32x4 ld[8];
#pragma unroll
    for (int i = 0; i < 8; ++i) ld[i] = *(const f32x4*)(W + (size_t)(k0 + 8 * i + (lane >> 3)) * ldw + n0 + 4 * (lane & 7));
#pragma unroll
    for (int i = 0; i < 8; ++i) { LAS float* d = scr + (8 * i + (lane >> 3)) * 33 + 4 * (lane & 7); d[0] = ld[i][0]; d[1] = ld[i][1]; d[2] = ld[i][2]; d[3] = ld[i][3]; }
    LDS_WAIT(); asm volatile("" ::: "memory");
    const int c = lane & 7;
#pragma unroll
    for (int j = 0; j < 4; ++j) { const int n = (lane >> 3) + 8 * j; const LAS float* s = scr + (8 * c) * 33 + n;
        u32x4 o; o.x = pk2(s[0 * 33], s[1 * 33]); o.y = pk2(s[2 * 33], s[3 * 33]); o.z = pk2(s[4 * 33], s[5 * 33]); o.w = pk2(s[6 * 33], s[7 * 33]);
        *(u32x4*)(WT + (size_t)(drow0 + n) * ldt + k0 + 8 * c) = o; }
    LDS_WAIT(); asm volatile("" ::: "memory");
}
__device__ __forceinline__ void p_wconv(const Params& P, Frame& F, int l) {
    LAS float* scr = (LAS float*)(F.lds + F.wave * 16384);
    const int gw = F.bid * NWAVES + F.wave, NGW = F.G * NWAVES;
    const float* w_in = P.w_in + (size_t)l * 1024 * INW;
    bf16* WA = WSP(bf16, WS_WA); bf16* WFV = WSP(bf16, WS_WFV);
    constexpr int I_K = 16 * 32, I_Q = 16 * 32, I_P = 16 * 16, I_G = 16 * 96, I_V = 16 * 32, I_AO = 16 * 32, I_FO = 8 * 32, I_OUT = 16 * 32;
    constexpr int NSM = I_K + I_Q + I_P + I_G + I_V + I_AO + I_FO + I_OUT;
    for (int it = gw; it < NSM; it += NGW) {
        int r = it;
        if (r < I_K) { transpose_item(w_in, INW, (r / 32) * 64, 0 + (r % 32) * 32, WA, 1024, 0 + (r % 32) * 32, scr, F.lane); continue; } r -= I_K;
        if (r < I_Q) { transpose_item(w_in, INW, (r / 32) * 64, 2048 + (r % 32) * 32, WA, 1024, 1024 + (r % 32) * 32, scr, F.lane); continue; } r -= I_Q;
        if (r < I_P) { transpose_item(w_in, INW, (r / 16) * 64, 3584 + (r % 16) * 32, WA, 1024, 2048 + (r % 16) * 32, scr, F.lane); continue; } r -= I_P;
        if (r < I_G) { transpose_item(w_in, INW, (r / 96) * 64, 4096 + (r % 96) * 32, WA, 1024, 2560 + (r % 96) * 32, scr, F.lane); continue; } r -= I_G;
        if (r < I_V) { transpose_item(w_in, INW, (r / 32) * 64, 1024 + (r % 32) * 32, WFV, 1024, 1024 + (r % 32) * 32, scr, F.lane); continue; } r -= I_V;
        if (r < I_AO) { transpose_item(P.w_att_o + (size_t)l * 1024 * 1024, 1024, (r / 32) * 64, (r % 32) * 32, WSP(bf16, WS_WAO), 1024, (r % 32) * 32, scr, F.lane); continue; } r -= I_AO;
        if (r < I_FO) { transpose_item(P.w_fourier + (size_t)l * 512 * 1024, 1024, (r / 32) * 64, (r % 32) * 32, WSP(bf16, WS_WFO), 512, (r % 32) * 32, scr, F.lane); continue; } r -= I_FO;
        transpose_item(P.w_out + (size_t)l * 1024 * 1024, 1024, (r / 32) * 64, (r % 32) * 32, WSP(bf16, WS_WOUT), 1024, (r % 32) * 32, scr, F.lane);
    }
    constexpr int I_E = 16 * 88;
    bf16* WGU = WSP(bf16, WS_WGU); bf16* WD = WSP(bf16, WS_WD);
    for (int it = gw; it < 3 * 16 * I_E; it += NGW) {
        const int which = it / (16 * I_E), r0 = it % (16 * I_E), e = r0 / I_E, r = r0 % I_E;
        if (which < 2) { const int kb = r / 88, nb = r % 88, n0 = nb * 32;
            const float* src = (which == 0 ? P.w_eg : P.w_eu) + ((size_t)l * 16 + e) * 1024 * FF;
            transpose_item(src, FF, kb * 64, n0, WGU + (size_t)e * 5632 * 1024, 1024, (n0 >> 7) * 256 + (which ? 128 : 0) + (n0 & 127), scr, F.lane); }
        else { const int kb = r / 32, nb = r % 32;
            transpose_item(P.w_ed + ((size_t)l * 16 + e) * FF * 1024, 1024, kb * 64, nb * 32, WD + (size_t)e * 1024 * FF, FF, nb * 32, scr, F.lane); }
    }
    { bf16* WPO = WSP(bf16, WS_WPO); const float* wp = P.w_pool + (size_t)l * 4 * 128 * 256;
      for (int i = F.bid * NTHREADS + F.tid; i < 1024 * 256; i += F.G * NTHREADS) { const int n = i >> 8, kk = i & 255, g = n >> 8, f = n & 255;
          WPO[i] = (bf16)(((kk >> 7) == (g & 1)) ? f2bf(wp[((size_t)g * 128 + (kk & 127)) * 256 + f]) : 0u); } }
    { LAS float* t128 = (LAS float*)F.lds;
      __syncthreads();
      for (int j = F.tid; j < 128; j += NTHREADS) t128[j] = cospif((float)j * (1.0f / 64.0f));
      __syncthreads();
      for (int i = F.bid * NTHREADS + F.tid; i < 1024 * 1024; i += F.G * NTHREADS) { const int fc = i >> 10, k = i & 1023, cs = fc & 1, gm = fc >> 1, g = gm >> 7, m = gm & 127;
          const float* src = w_in + (size_t)k * INW + 3072 + g * 128; float s = 0.f; const int ph = cs ? 96 : 0;
          for (int c = 0; c < 128; ++c) s += src[c] * t128[(m * c + ph) & 127];
          WFV[i] = (bf16)f2bf(s); }
      __syncthreads(); }
}

struct RowMod { const float* g; const float* sh; const float* sc; };
__device__ __forceinline__ void row_load(const float* row, int lane, f32x4 (&v)[4]) {
#pragma unroll
    for (int j = 0; j < 4; ++j) v[j] = *(const f32x4*)(row + 4 * lane + 256 * j);
}
__device__ __forceinline__ float row_rstd(const f32x4 (&v)[4]) {
    float s = 0.f;
#pragma unroll
    for (int j = 0; j < 4; ++j) s += (v[j][0] * v[j][0] + v[j][1] * v[j][1]) + (v[j][2] * v[j][2] + v[j][3] * v[j][3]);
    return rsqrtf(wave_sum(s) * (1.0f / 1024.0f) + RMS_EPS);
}
__device__ __forceinline__ void row_modulate(const f32x4 (&v)[4], float rstd, const RowMod& M, int lane, f32x4 (&y)[4]) {
#pragma unroll
    for (int j = 0; j < 4; ++j) { const int k = 4 * lane + 256 * j; const f32x4 g = *(const f32x4*)(M.g + k), sh = *(const f32x4*)(M.sh + k), sc = *(const f32x4*)(M.sc + k);
        y[j] = v[j] * rstd * g * (sc + 1.0f) + sh; }
}
__device__ __forceinline__ void row_store_bf(bf16* row, int lane, const f32x4 (&y)[4]) {
#pragma unroll
    for (int j = 0; j < 4; ++j) st_bf4(row + 4 * lane + 256 * j, y[j]);
}
__device__ __forceinline__ const float* mod_ptr(Frame& F, int l, int row, int which) { const int mr = row < RL ? (row >> 12) : 8; return WSP(float, WS_MOD) + ((size_t)l * 9 + mr) * 6144 + which * 1024; }

__device__ __forceinline__ void p_rowpass_a0(const Params& P, Frame& F) {
    const int gw = F.bid * NWAVES + F.wave, NGW = F.G * NWAVES; bf16* H = WSP(bf16, WS_H);
    for (int row = gw; row < RT; row += NGW) {
        const float* src = row < RL ? P.x + (size_t)row * DM : P.ctx + (size_t)(row - RL) * DM;
        f32x4 v[4], y[4]; row_load(src, F.lane, v); const float rs = row_rstd(v);
        RowMod M{P.norm1_g, mod_ptr(F, 0, row, 0), mod_ptr(F, 0, row, 1)};
        row_modulate(v, rs, M, F.lane, y); row_store_bf(H + (size_t)row * DM, F.lane, y);
    }
}
__device__ __forceinline__ void p_rowpass_f(const Params& P, Frame& F, int l, int nrows) {
    const int gw = F.bid * NWAVES + F.wave, NGW = F.G * NWAVES; bf16* H = WSP(bf16, WS_H); float* AFF = WSP(float, WS_AFF);
    const float* wr = P.w_router + (size_t)l * 1024 * 16;
    LAS float* wl = (LAS float*)F.lds;
    __syncthreads();
    for (int i = F.tid; i < 16384; i += NTHREADS) wl[(i & 15) * 1024 + (i >> 4)] = wr[i];
    __syncthreads();
    for (int row = gw; row < nrows; row += NGW) {
        const float* src = row < RL ? P.out + (size_t)row * DM : WSP(float, WS_XC) + (size_t)(row - RL) * DM;
        f32x4 v[4], y[4]; row_load(src, F.lane, v); const float rs = row_rstd(v);
        RowMod M{P.norm2_g + l * 1024, mod_ptr(F, l, row, 3), mod_ptr(F, l, row, 4)};
        row_modulate(v, rs, M, F.lane, y); row_store_bf(H + (size_t)row * DM, F.lane, y);
        float lg[16];
        int wo = 4 * F.lane; asm volatile("" : "+v"(wo));
#pragma unroll
        for (int e = 0; e < 16; ++e) { float a = 0.f;
#pragma unroll
            for (int j = 0; j < 4; ++j) { const f32x4 w = *(const LAS f32x4*)(wl + e * 1024 + wo + 256 * j); a += (y[j][0] * w[0] + y[j][1] * w[1]) + (y[j][2] * w[2] + y[j][3] * w[3]); }
            lg[e] = a; }
        float mx = -1e30f;
#pragma unroll
        for (int e = 0; e < 16; ++e) { lg[e] = wave_sum(lg[e]); mx = fmaxf(mx, lg[e]); }
        float den = 0.f;
#pragma unroll
        for (int e = 0; e < 16; ++e) { lg[e] = __expf(lg[e] - mx); den += lg[e]; }
        const float inv = 1.0f / den;
        if (F.lane < 16) { float mine = 0.f;
#pragma unroll
            for (int e = 0; e < 16; ++e) mine = (F.lane == e) ? lg[e] : mine;
            AFF[(size_t)row * 16 + F.lane] = mine * inv; }
    }
    __syncthreads();
}
__device__ __forceinline__ void p_rowpass_k(const Params& P, Frame& F, int l, int nrows) {
    const int gw = F.bid * NWAVES + F.wave, NGW = F.G * NWAVES; bf16* H = WSP(bf16, WS_H);
    const int* SEL = WSP(int, WS_SEL); const bf16* Y = WSP(bf16, WS_Y);
    for (int row = gw; row < nrows; row += NGW) {
        float* xr = row < RL ? P.out + (size_t)row * DM : WSP(float, WS_XC) + (size_t)(row - RL) * DM;
        f32x4 v[4], a[4]; row_load(xr, F.lane, v);
#pragma unroll
        for (int j = 0; j < 4; ++j) a[j] = (f32x4){0.f, 0.f, 0.f, 0.f};
        for (int e = 0; e < 16; ++e) { const int s = SEL[(size_t)row * 16 + e];
            if (s >= 0) { const bf16* yr = Y + (size_t)s * DM;
#pragma unroll
                for (int j = 0; j < 4; ++j) { const u32x2 w = *(const u32x2*)(yr + 4 * F.lane + 256 * j); a[j][0] += bflo(w.x); a[j][1] += bfhi(w.x); a[j][2] += bflo(w.y); a[j][3] += bfhi(w.y); } } }
        const float* g2 = mod_ptr(F, l, row, 5);
#pragma unroll
        for (int j = 0; j < 4; ++j) { const f32x4 g = *(const f32x4*)(g2 + 4 * F.lane + 256 * j); v[j] = v[j] + g * a[j]; }
        const float rs = row_rstd(v);
        if (l == 0) {
#pragma unroll
            for (int j = 0; j < 4; ++j) *(f32x4*)(xr + 4 * F.lane + 256 * j) = v[j];
            f32x4 y[4]; RowMod M{P.norm1_g + 1024, mod_ptr(F, 1, row, 0), mod_ptr(F, 1, row, 1)};
            row_modulate(v, rs, M, F.lane, y); row_store_bf(H + (size_t)row * DM, F.lane, y);
        } else {
#pragma unroll
            for (int j = 0; j < 4; ++j) { const f32x4 g = *(const f32x4*)(P.final_g + 4 * F.lane + 256 * j); *(f32x4*)(xr + 4 * F.lane + 256 * j) = v[j] * rs * g; }
        }
    }
}

__device__ __forceinline__ float dot64(const bf16x8 (&q)[8], const bf16* kp) {
    float s = 0.f;
#pragma unroll
    for (int i = 0; i < 8; ++i) { const u32x4 kw = *(const u32x4*)(kp + 8 * i); const u32x4 qw = __builtin_bit_cast(u32x4, q[i]);
#pragma unroll
        for (int t = 0; t < 4; ++t) s += bflo(kw[t]) * bflo(qw[t]) + bfhi(kw[t]) * bfhi(qw[t]); }
    return s;
}
__device__ __forceinline__ void p_attn_naive(const Params& P, Frame& F, int l, bool with_ctx_queries) {
    const int gw = F.bid * NWAVES + F.wave, NGW = F.G * NWAVES;
    const bf16* KQ = WSP(bf16, WS_KQ); const bf16* VT = WSP(bf16, WS_VT); bf16* ATT = WSP(bf16, WS_ATT);
    LAS float* pw = (LAS float*)(F.lds + F.wave * 2048);
    const float* rpb = P.rpb + (size_t)l * 16 * 15 * 31;
    const int nlat = NB * 64 * NH * 64, nitems = nlat + (with_ctx_queries ? NB * NH * CTXL : 0);
    for (int it = gw; it < nitems; it += NGW) {
        const bool lat = it < nlat;
        int b, h, r = 0, qc = 0, rowq;
        if (lat) { qc = it & 63; h = (it >> 6) & 15; r = (it >> 10) & 63; b = it >> 16; rowq = b * SEQ + r * 64 + qc; }
        else { const int i2 = it - nlat; qc = i2 & 255; h = (i2 >> 8) & 15; b = i2 >> 12; rowq = RL + b * CTXL + qc; }
        bf16x8 q[8];
        { const bf16* qp = KQ + (size_t)rowq * 2048 + 1024 + h * 64;
#pragma unroll
          for (int i = 0; i < 8; ++i) q[i] = *(const bf16x8*)(qp + 8 * i); }
        const int rs = min(max(r - 4, 0), 56), cs = min(max(qc - 8, 0), 48);
        float s[6];
        if (lat) {
#pragma unroll
            for (int t = 0; t < 2; ++t) { const int w = F.lane + 64 * t, i = w >> 4, j = w & 15; const int tok = (rs + i) * 64 + cs + j;
                s[t] = dot64(q, KQ + (size_t)(b * SEQ + tok) * 2048 + h * 64) * 0.125f + rpb[(h * 15 + (rs + i - r + 7)) * 31 + (cs + j - qc + 15)]; }
        } else { s[0] = -1e30f; s[1] = -1e30f; }
#pragma unroll
        for (int t = 0; t < 4; ++t) { const int c = F.lane + 64 * t; s[2 + t] = dot64(q, KQ + (size_t)(RL + b * CTXL + c) * 2048 + h * 64) * 0.125f; }
        float mx = s[0];
#pragma unroll
        for (int t = 1; t < 6; ++t) mx = fmaxf(mx, s[t]);
        mx = wave_max(mx);
        float sum = 0.f;
#pragma unroll
        for (int t = 0; t < 6; ++t) { s[t] = (lat || t >= 2) ? __expf(s[t] - mx) : 0.f; sum += s[t]; }
        sum = wave_sum(sum);
        pw[F.lane] = s[0]; pw[F.lane + 64] = s[1];
#pragma unroll
        for (int t = 0; t < 4; ++t) pw[128 + F.lane + 64 * t] = s[2 + t];
        LDS_WAIT(); asm volatile("" ::: "memory");
        float o = 0.f;
        if (lat) { const bf16* vr = VT + ((size_t)b * 1024 + h * 64 + F.lane) * 4096;
#pragma unroll 2
            for (int w = 0; w < 128; ++w) { const int tok = (rs + (w >> 4)) * 64 + cs + (w & 15); o += pw[w] * bf2f(vr[tok]); } }
        { const bf16* vr = VT + YT_CTX_OFF + ((size_t)b * 1024 + h * 64 + F.lane) * 256;
#pragma unroll 2
          for (int c8 = 0; c8 < 32; ++c8) { const u32x4 vw = *(const u32x4*)(vr + 8 * c8); const LAS float* pp = pw + 128 + 8 * c8;
#pragma unroll
              for (int t = 0; t < 4; ++t) o += pp[2 * t] * bflo(vw[t]) + pp[2 * t + 1] * bfhi(vw[t]); } }
        ATT[(size_t)rowq * 1024 + h * 64 + F.lane] = (bf16)f2bf(o / sum);
        LDS_WAIT(); asm volatile("" ::: "memory");
    }
}

constexpr int ACK_STRIDE = 72, ACV_STRIDE = 264;
constexpr int ALDS_CK = 0, ALDS_CV = 256 * ACK_STRIDE * 2, ALDS_RP = ALDS_CV + 64 * ACV_STRIDE * 2;
struct AttnState { float m, sum; f32x4 o[4]; };
__device__ __forceinline__ float xrow16_max(float x) {
    auto s = __builtin_amdgcn_permlane16_swap(__float_as_uint(x), __float_as_uint(x), false, false);
    x = fmaxf(__uint_as_float(s[0]), __uint_as_float(s[1]));
    auto t = __builtin_amdgcn_permlane32_swap(__float_as_uint(x), __float_as_uint(x), false, false);
    return fmaxf(__uint_as_float(t[0]), __uint_as_float(t[1]));
}
__device__ __forceinline__ float xrow16_sum(float x) {
    auto s = __builtin_amdgcn_permlane16_swap(__float_as_uint(x), __float_as_uint(x), false, false);
    x = __uint_as_float(s[0]) + __uint_as_float(s[1]);
    auto t = __builtin_amdgcn_permlane32_swap(__float_as_uint(x), __float_as_uint(x), false, false);
    return __uint_as_float(t[0]) + __uint_as_float(t[1]);
}
#define MFMA16(a, b, c) __builtin_amdgcn_mfma_f32_16x16x32_bf16((a), (b), (c), 0, 0, 0)
template <int NT>
__device__ __forceinline__ void attn_tail(AttnState& S, f32x4 (&sc)[NT], const u32x4 (&vw)[NT / 2][4]) {
    float cm = -1e30f;
#pragma unroll
    for (int t = 0; t < NT; ++t)
#pragma unroll
        for (int j = 0; j < 4; ++j) cm = fmaxf(cm, sc[t][j]);
    cm = xrow16_max(cm);
    const float mn = fmaxf(S.m, cm), scl = __builtin_amdgcn_exp2f(S.m - mn); S.m = mn; float ps = 0.f;
#pragma unroll
    for (int t = 0; t < NT; ++t)
#pragma unroll
        for (int j = 0; j < 4; ++j) { const float p = __builtin_amdgcn_exp2f(sc[t][j] - mn); sc[t][j] = p; ps += p; }
    S.sum = S.sum * scl + ps;
#pragma unroll
    for (int dt = 0; dt < 4; ++dt) S.o[dt] = S.o[dt] * scl;
#pragma unroll
    for (int ks = 0; ks < NT / 2; ++ks) { u32x4 pw; pw.x = pk2(sc[2 * ks][0], sc[2 * ks][1]); pw.y = pk2(sc[2 * ks][2], sc[2 * ks][3]); pw.z = pk2(sc[2 * ks + 1][0], sc[2 * ks + 1][1]); pw.w = pk2(sc[2 * ks + 1][2], sc[2 * ks + 1][3]);
        const bf16x8 pf = __builtin_bit_cast(bf16x8, pw);
#pragma unroll
        for (int dt = 0; dt < 4; ++dt) S.o[dt] = MFMA16(__builtin_bit_cast(bf16x8, vw[ks][dt]), pf, S.o[dt]); }
}
__device__ __forceinline__ void attn_unit2(const bf16* __restrict__ KQ, const bf16* __restrict__ VT, bf16* __restrict__ ATT, LAS unsigned char* lds,
                                           const int b, const int h, const int rowqA, const int rowqB, const bool win, const int r, const int qt, const int lane) {
    const int l15 = lane & 15, g = lane >> 4;
    const f32x4 z = {0.f, 0.f, 0.f, 0.f};
    bf16x8 qA[2], qB[2];
    { const bf16* qp = KQ + (size_t)(rowqA + l15) * 2048 + 1024 + h * 64 + 8 * g; qA[0] = *(const bf16x8*)qp; qA[1] = *(const bf16x8*)(qp + 32); }
    { const bf16* qp = KQ + (size_t)(rowqB + l15) * 2048 + 1024 + h * 64 + 8 * g; qB[0] = *(const bf16x8*)qp; qB[1] = *(const bf16x8*)(qp + 32); }
    AttnState SA, SB; SA.m = -1e30f; SA.sum = 0.f; SB.m = -1e30f; SB.sum = 0.f;
#pragma unroll
    for (int dt = 0; dt < 4; ++dt) { SA.o[dt] = z; SB.o[dt] = z; }
    if (win) {
        const int rsA = min(max(r - 4, 0), 56), dB = min(max(r - 3, 0), 56) - rsA, kc0 = min(max(16 * qt - 8, 0), 32);
        const int q = 16 * qt + l15, csq = min(max(q - 8, 0), 48);
        const int krow0 = 8 * (l15 >> 2) + (l15 & 3);
        const bf16* kb = KQ + (size_t)(b * SEQ + kc0 + krow0) * 2048 + h * 64 + 8 * g;
        const bf16* vb = VT + (size_t)(b * 1024 + h * 64 + l15) * 4096 + kc0 + 8 * g;
        const LAS float* rp = (const LAS float*)(lds + ALDS_RP);
        const int jb = kc0 + 8 * g;
        const int okb = jb - csq;
        const LAS float* rpl = rp + 16 + (jb - q + 15);
        float madd[2][4];
#pragma unroll
        for (int t = 0; t < 2; ++t)
#pragma unroll
            for (int j = 0; j < 4; ++j) madd[t][j] = ((unsigned)(okb + 4 * t + j) < 16u) ? 0.f : -__builtin_inff();
        bf16x8 K0[2][2], K1[2][2]; u32x4 V0[1][4], V1[1][4];
#define ATT_LOADW(KB, VB, i) do { const int gr_ = min(rsA + (i), 63); const bf16* kp_ = kb + (size_t)(gr_ * 64) * 2048; const bf16* vp_ = vb + gr_ * 64; \
        _Pragma("unroll") for (int t = 0; t < 2; ++t) { KB[t][0] = *(const bf16x8*)(kp_ + (size_t)(4 * t) * 2048); KB[t][1] = *(const bf16x8*)(kp_ + (size_t)(4 * t) * 2048 + 32); } \
        _Pragma("unroll") for (int dt = 0; dt < 4; ++dt) VB[0][dt] = *(const u32x4*)(vp_ + (size_t)(16 * dt) * 4096); } while (0)
#define ATT_ONE(ST, QF, KB, VB, roff, rowok) do { f32x4 sc[2]; \
        _Pragma("unroll") for (int t = 0; t < 2; ++t) { sc[t] = MFMA16(KB[t][0], QF[0], z); sc[t] = MFMA16(KB[t][1], QF[1], sc[t]); } \
        const LAS float* bp_ = rpl + ((rowok) ? (roff) : 15) * 64; \
        _Pragma("unroll") for (int t = 0; t < 2; ++t) _Pragma("unroll") for (int j = 0; j < 4; ++j) sc[t][j] = (sc[t][j] + bp_[4 * t + j]) + madd[t][j]; \
        attn_tail<2>(ST, sc, VB); } while (0)
#define ATT_COMPUTE(KB, VB, i) do { const int roffA_ = min(rsA + (i) - r + 7, 14); \
        ATT_ONE(SA, qA, KB, VB, roffA_, (i) <= 7); \
        ATT_ONE(SB, qB, KB, VB, max(roffA_ - 1, 0), (i) >= dB && (i) <= 7 + dB); } while (0)
        ATT_LOADW(K0, V0, 0);
#pragma unroll 1
        for (int i = 0; i < 8; i += 2) { ATT_LOADW(K1, V1, i + 1); ATT_COMPUTE(K0, V0, i); ATT_LOADW(K0, V0, i + 2); ATT_COMPUTE(K1, V1, i + 1); }
        ATT_COMPUTE(K0, V0, 8);
#undef ATT_LOADW
#undef ATT_ONE
#undef ATT_COMPUTE
    }
    { const LAS bf16* ck = (const LAS bf16*)(lds + ALDS_CK) + l15 * ACK_STRIDE + 8 * g;
      const LAS bf16* cv = (const LAS bf16*)(lds + ALDS_CV) + l15 * ACV_STRIDE + 8 * g;
#pragma unroll 1
      for (int c = 0; c < 4; ++c) {
          bf16x8 kf[4][2]; u32x4 vw[2][4];
#pragma unroll
          for (int t = 0; t < 4; ++t) { const LAS bf16* kp = ck + (64 * c + 16 * t) * ACK_STRIDE; kf[t][0] = *(const LAS bf16x8*)kp; kf[t][1] = *(const LAS bf16x8*)(kp + 32); }
#pragma unroll
          for (int ks = 0; ks < 2; ++ks)
#pragma unroll
              for (int dt = 0; dt < 4; ++dt) vw[ks][dt] = *(const LAS u32x4*)(cv + (16 * dt) * ACV_STRIDE + 64 * c + 32 * ks);
          { f32x4 sc[4];
#pragma unroll
            for (int t = 0; t < 4; ++t) { sc[t] = MFMA16(kf[t][0], qA[0], z); sc[t] = MFMA16(kf[t][1], qA[1], sc[t]); }
            attn_tail<4>(SA, sc, vw); }
          { f32x4 sc[4];
#pragma unroll
            for (int t = 0; t < 4; ++t) { sc[t] = MFMA16(kf[t][0], qB[0], z); sc[t] = MFMA16(kf[t][1], qB[1], sc[t]); }
            attn_tail<4>(SB, sc, vw); }
      } }
    { const float inv = 1.0f / xrow16_sum(SA.sum);
#pragma unroll
      for (int dt = 0; dt < 4; ++dt) st_bf4(ATT + (size_t)(rowqA + l15) * 1024 + h * 64 + 16 * dt + 4 * g, SA.o[dt] * inv); }
    { const float inv = 1.0f / xrow16_sum(SB.sum);
#pragma unroll
      for (int dt = 0; dt < 4; ++dt) st_bf4(ATT + (size_t)(rowqB + l15) * 1024 + h * 64 + 16 * dt + 4 * g, SB.o[dt] * inv); }
}
__device__ __forceinline__ void p_attn_mfma(const Params& P, Frame& F, int l, bool with_ctx_queries) {
    const bf16* KQ = WSP(bf16, WS_KQ); const bf16* VT = WSP(bf16, WS_VT); bf16* ATT = WSP(bf16, WS_ATT);
    const float* rpb = P.rpb + (size_t)l * 16 * 465;
    for (int hp = F.bid; hp < 256; hp += F.G) {
        const int p = hp & 127, half = hp >> 7, b = p >> 4, h = p & 15;
        __syncthreads();
        { LAS bf16* ck = (LAS bf16*)(F.lds + ALDS_CK); LAS bf16* cv = (LAS bf16*)(F.lds + ALDS_CV); LAS float* rp = (LAS float*)(F.lds + ALDS_RP);
          { const int key = F.tid >> 1, hf = F.tid & 1; const int k32 = key & 31, pos = (key & ~31) + ((k32 >> 2) & 1) * 16 + 4 * (k32 >> 3) + (k32 & 3);
            const u32x4* src = (const u32x4*)(KQ + (size_t)(RL + b * CTXL + key) * 2048 + h * 64 + hf * 32); LAS u32x4* dst = (LAS u32x4*)(ck + pos * ACK_STRIDE + hf * 32);
#pragma unroll
            for (int i = 0; i < 4; ++i) dst[i] = src[i]; }
          { const int d = F.tid >> 3, sg = F.tid & 7; const u32x4* src = (const u32x4*)(VT + YT_CTX_OFF + (size_t)(b * 1024 + h * 64 + d) * 256 + sg * 32); LAS u32x4* dst = (LAS u32x4*)(cv + d * ACV_STRIDE + sg * 32);
#pragma unroll
            for (int i = 0; i < 4; ++i) dst[i] = src[i]; }
          for (int i = F.tid; i < 16 * 64; i += NTHREADS) { const int rr = i >> 6, cc = (i & 63) - 16; rp[i] = rr == 15 ? -__builtin_inff() : ((cc >= 0 && cc < 31) ? rpb[h * 465 + rr * 31 + cc] * LOG2E : 0.f); } }
        __syncthreads();
        const int qt = F.wave & 3, rpi = F.wave >> 2;
#pragma unroll 1
        for (int st = 0; st < 8; ++st) { const int r = half * 32 + st * 4 + rpi * 2; const int rowqA = b * SEQ + r * 64 + 16 * qt;
            attn_unit2(KQ, VT, ATT, F.lds, b, h, rowqA, rowqA + 64, true, r, qt, F.lane); }
        if (with_ctx_queries && half == 0) { const int rowqA = RL + b * CTXL + 32 * F.wave; attn_unit2(KQ, VT, ATT, F.lds, b, h, rowqA, rowqA + 16, false, 0, 0, F.lane); }
    }
    __syncthreads();
}

__device__ __forceinline__ void p_pool(Frame& F, int nrows) {
    const bf16* PB = WSP(bf16, WS_PB); bf16* POOL = WSP(bf16, WS_POOL);
    for (int i = F.bid * NTHREADS + F.tid; i < nrows * 64; i += F.G * NTHREADS) {
        const int row = i >> 6, ch = i & 63, g = ch >> 4, hw = 1 << g;
        int base, t, Lb; if (row < RL) { base = row & ~4095; t = row & 4095; Lb = SEQ; } else { const int rr = row - RL; base = RL + (rr & ~255); t = rr & 255; Lb = CTXL; }
        const int lo = max(t - hw, 0), hi = min(t + hw, Lb);
        float a[8];
#pragma unroll
        for (int q = 0; q < 8; ++q) a[q] = 0.f;
        for (int tt = lo; tt < hi; ++tt) { const u32x4 w = *(const u32x4*)(PB + (size_t)(base + tt) * 512 + ch * 8);
#pragma unroll
            for (int q = 0; q < 4; ++q) { a[2 * q] += bflo(w[q]); a[2 * q + 1] += bfhi(w[q]); } }
        const u32x4 me = *(const u32x4*)(PB + (size_t)row * 512 + ch * 8); const float inv = 1.0f / (float)(hi - lo);
        u32x4 o;
#pragma unroll
        for (int q = 0; q < 4; ++q) o[q] = pk2(a[2 * q] * inv - bflo(me[q]), a[2 * q + 1] * inv - bfhi(me[q]));
        *(u32x4*)(POOL + (size_t)row * 512 + ch * 8) = o;
    }
}

__device__ __forceinline__ int block_sum_i(int v, LAS int* sm, int tid) {
    v = wave_sum_i(v);
    __syncthreads();
    if ((tid & 63) == 0) sm[tid >> 6] = v;
    __syncthreads();
    int s = 0;
#pragma unroll
    for (int i = 0; i < 8; ++i) s += sm[i];
    return s;
}
__device__ __forceinline__ int block_excl_scan(int v, LAS int* sm, int tid, int& total) {
    const int lane = tid & 63, w = tid >> 6; int inc = v;
#pragma unroll
    for (int o = 1; o < 64; o <<= 1) { const int t = __builtin_amdgcn_ds_bpermute(((lane - o) & 63) << 2, inc); if (lane >= o) inc += t; }
    __syncthreads();
    if (lane == 63) sm[w] = inc;
    __syncthreads();
    int base = 0; total = 0;
#pragma unroll
    for (int i = 0; i < 8; ++i) { const int s = sm[i]; if (i < w) base += s; total += s; }
    return base + inc - v;
}
template <int NPT>
__device__ __forceinline__ void topk_pair(Frame& F, int row0, int n, int cap, int e, int slot0) {
    LAS int* sm = (LAS int*)F.lds;
    const float* AFF = WSP(float, WS_AFF); int* SROW = WSP(int, WS_SROW); float* SG = WSP(float, WS_SGATE); int* SEL = WSP(int, WS_SEL);
    unsigned key[NPT];
#pragma unroll
    for (int j = 0; j < NPT; ++j) { const int i = F.tid * NPT + j; key[j] = (i < n) ? __float_as_uint(AFF[(size_t)(row0 + i) * 16 + e]) : 0u; }
    unsigned T = 0u;
    for (int bit = 30; bit >= 0; --bit) { const unsigned cand = T | (1u << bit); int cnt = 0;
#pragma unroll
        for (int j = 0; j < NPT; ++j) cnt += (key[j] >= cand) ? 1 : 0;
        cnt = block_sum_i(cnt, sm, F.tid);
        if (cnt >= cap) T = cand; }
    int ngt = 0, neq = 0;
#pragma unroll
    for (int j = 0; j < NPT; ++j) { ngt += (key[j] > T) ? 1 : 0; neq += (key[j] == T) ? 1 : 0; }
    int tot_gt, tot_eq;
    (void)block_excl_scan(ngt, sm, F.tid, tot_gt);
    int eqr = block_excl_scan(neq, sm, F.tid, tot_eq);
    const int need_eq = cap - tot_gt;
    int nsel = 0; bool selj[NPT];
#pragma unroll
    for (int j = 0; j < NPT; ++j) { bool s = key[j] > T; if (key[j] == T && T != 0u) { s = eqr < need_eq; ++eqr; } selj[j] = s; nsel += s ? 1 : 0; }
    int tot_sel; int pos = block_excl_scan(nsel, sm, F.tid, tot_sel);
#pragma unroll
    for (int j = 0; j < NPT; ++j) { const int i = F.tid * NPT + j;
        if (i < n) { const int row = row0 + i;
            if (selj[j]) { const int slot = slot0 + pos; ++pos; SROW[slot] = row; SG[slot] = __uint_as_float(key[j]); SEL[(size_t)row * 16 + e] = slot; }
            else SEL[(size_t)row * 16 + e] = -1; } }
    __syncthreads();
}
__device__ __forceinline__ void p_topk(Frame& F, bool with_ctx) {
    const int npairs = 128 + (with_ctx ? 128 : 0);
    for (int pi = F.bid; pi < npairs; pi += F.G) {
        if (pi < 128) { const int b = pi >> 4, e = pi & 15; topk_pair<8>(F, b * SEQ, SEQ, CAPL, e, e * SLOT_E + b * CAPL); }
        else { const int p2 = pi - 128, b = p2 >> 4, e = p2 & 15; topk_pair<1>(F, RL + b * CTXL, CTXL, CAPC, e, e * SLOT_E + 4096 + b * CAPC); }
    }
}
__device__ __forceinline__ void p_gather(Frame& F, bool with_ctx) {
    const int gw = F.bid * NWAVES + F.wave, NGW = F.G * NWAVES; const bf16* H = WSP(bf16, WS_H); bf16* XG = WSP(bf16, WS_XG); const int* SROW = WSP(int, WS_SROW);
    for (int s = gw; s < NSLOT; s += NGW) { if (!with_ctx && (s % SLOT_E) >= 4096) continue;
        const int row = SROW[s]; const u32x4* src = (const u32x4*)(H + (size_t)row * DM); u32x4* dst = (u32x4*)(XG + (size_t)s * DM);
        dst[F.lane] = src[F.lane]; dst[F.lane + 64] = src[F.lane + 64]; }
}

template <int PH> __global__ void __launch_bounds__(NTHREADS, 2) fwd_kernel(Params P) {
    extern __shared__ __attribute__((aligned(16))) unsigned char lds_raw[];
    Frame F; F.lds = (LAS unsigned char*)lds_raw; F.tid = threadIdx.x; F.lane = F.tid & 63; F.wave = __builtin_amdgcn_readfirstlane(F.tid >> 6); F.G = gridDim.x; F.bid = blockIdx.x; F.ws = P.ws;
    const int wave0 = __builtin_amdgcn_readfirstlane((int)threadIdx.x >> 6);
    volatile LAS unsigned* MISC = (volatile LAS unsigned*)(F.lds + LDS_MISC);
    if (F.tid < 64) MISC[F.tid] = 0u;
    __syncthreads();
    XcdBarrier bar; bar.bar = WSP(unsigned, WS_CTL) + CW_BAR; bar.x = 0; bar.st = MISC + 8;
    if constexpr (PH < 0) bar = xcd_barrier_post(WSP(unsigned, WS_CTL) + CW_BAR, MISC + 8);
#define IN(k) (PH < 0 || PH == (k))
#define REFRESH() do { unsigned on_ = ~0u; asm volatile("" : "+s"(on_)); int t_ = wave0 * 64 + (int)__builtin_amdgcn_mbcnt_hi(on_, __builtin_amdgcn_mbcnt_lo(on_, 0u)); asm volatile("" : "+v"(t_)); F.tid = t_; F.lane = t_ & 63; F.wave = __builtin_amdgcn_readfirstlane(t_ >> 6); } while (0)
#define SEAM(k) do { if constexpr (PH < 0) xcd_barrier(bar); } while (0)

    if (IN(0)) { REP_BEGIN(100) p_mod(P, F); p_dftgen(F); REP_END REP_BEGIN(101) p_wconv(P, F, 0); REP_END }
    SEAM(0);
    if (IN(1)) { p_rowpass_a0(P, F); }
    SEAM(1);
    for (int l = P.l_lo; l < P.l_hi; ++l) {
        constexpr int pb = 2; const bool L0 = (l == 0);
        bf16* H = WSP(bf16, WS_H);
        if (IN(pb + 0)) { REFRESH(); REP_BEGIN(2)
            { GroupSched S; S.init(1, 128, 22, F.G, F.bid, 8, L0 ? 22 : 4, 128, 0);
              const bf16* WA = WSP(bf16, WS_WA);
              auto AD = [=](const Unit& u) { return Operands{H + (size_t)u.pm * 256 * DM, WA + (size_t)u.pn * 256 * DM, DM, DM, 0, DM}; };
              bf16* KQ = WSP(bf16, WS_KQ); bf16* PBp = WSP(bf16, WS_PB); bf16* GB = WSP(bf16, WS_GB);
              auto E = [=](EPI_ARGS) { const int row0 = u.pm * 256;
                  if (u.pn < 8) { const float qs = (u.pn >= 4) ? QSCALE : 1.0f; EPI_FOR8( st_bf8(KQ + (size_t)(row0 + r) * 2048 + u.pn * 256 + c, v0 * qs, v1 * qs); ) }
                  else if (u.pn < 10) { EPI_FOR8( st_bf8(PBp + (size_t)(row0 + r) * 512 + (u.pn - 8) * 256 + c, v0, v1); ) }
                  else { EPI_FOR8( f32x4 s0; f32x4 s1; _Pragma("unroll") for (int j = 0; j < 4; ++j) { s0[j] = sigmoidf_(v0[j]); s1[j] = sigmoidf_(v1[j]); } st_bf8(GB + (size_t)(row0 + r) * 3072 + (u.pn - 10) * 256 + c, s0, s1); ) } };
              GEMM_P(S, AD, E); }
            REFRESH();
            { GroupSched S; S.init(1, 8, 128, F.G, F.bid, L0 ? 8 : 4, 8, L0 ? 0 : 4, 128);
              const bf16* WFV = WSP(bf16, WS_WFV);
              auto AD = [=](const Unit& u) { return Operands{WFV + (size_t)u.pm * 256 * DM, H + (size_t)u.pn * 256 * DM, DM, DM, 0, DM}; };
              bf16* YT = WSP(bf16, WS_YT); bf16* VT = WSP(bf16, WS_VT);
              auto E = [=](EPI_ARGS) { bf16* T = (u.pm < 4) ? YT : VT; const int rr0 = (u.pm & 3) * 256;
                  if (u.pn < 128) { const int b = u.pn >> 4, l0 = (u.pn & 15) * 256; EPI_FOR8( st_bf8(T + ((size_t)b * 1024 + rr0 + r) * 4096 + l0 + c, v0, v1); ) }
                  else { const int b = u.pn - 128; EPI_FOR8( st_bf8(T + YT_CTX_OFF + ((size_t)b * 1024 + rr0 + r) * 256 + c, v0, v1); ) } };
              GEMM_P(S, AD, E); }
        REP_END }
        SEAM(pb + 0);
        if (IN(pb + 1)) { REFRESH();
            REP_BEGIN(31) p_attn_mfma(P, F, l, L0); REP_END
            REFRESH();
            REP_BEGIN(32)
            { GroupSched S; S.init(1, 16, 16, F.G, F.bid);
              const bf16* DFTM = WSP(bf16, WS_DFTM); const bf16* YT = WSP(bf16, WS_YT); bf16* FOUR = WSP(bf16, WS_FOUR);
              auto AD = [=](const Unit& u) { return Operands{DFTM + (size_t)u.pm * 256 * 8192, YT + (size_t)u.pn * 256 * 8192, 8192, 8192, 0, 8192}; };
              auto E = [=](EPI_ARGS) { const int b = u.pn >> 1, c0 = (u.pn & 1) * 256; const float sc = 0.0013810679320049757f;
                  EPI_FOR8( st_bf8(FOUR + ((size_t)b * SEQ + u.pm * 256 + r) * 512 + c0 + c, v0 * sc, v1 * sc); ) };
              GEMM_P(S, AD, E); }
            REFRESH();
            if (L0) { GroupSched S; S.init(1, 1, 16, F.G, F.bid);
              const bf16* DFTC = WSP(bf16, WS_DFTC); const bf16* YTC = WSP(bf16, WS_YT) + YT_CTX_OFF; bf16* FOUR = WSP(bf16, WS_FOUR);
              auto AD = [=](const Unit& u) { return Operands{DFTC, YTC + (size_t)u.pn * 256 * 512, 512, 512, 0, 512}; };
              auto E = [=](EPI_ARGS) { const int b = u.pn >> 1, c0 = (u.pn & 1) * 256; const float sc = 0.005524271728019903f;
                  EPI_FOR8( st_bf8(FOUR + ((size_t)RL + b * CTXL + r) * 512 + c0 + c, v0 * sc, v1 * sc); ) };
              GEMM_P(S, AD, E); }
            REP_END
            REFRESH();
            REP_BEGIN(33) p_pool(F, L0 ? RT : RL); REP_END
        }
        SEAM(pb + 1);
        if (IN(pb + 2)) { REFRESH();
            SegSched<3> S; S.base.init(1, L0 ? 136 : 128, 4, F.G, F.bid);
            const bf16* ATT = WSP(bf16, WS_ATT); const bf16* FOUR = WSP(bf16, WS_FOUR); const bf16* POOL = WSP(bf16, WS_POOL);
            const bf16* WAO = WSP(bf16, WS_WAO); const bf16* WFO = WSP(bf16, WS_WFO); const bf16* WPO = WSP(bf16, WS_WPO);
            const bf16* GB = WSP(bf16, WS_GB); bf16* MRGB = WSP(bf16, WS_MRGB); const float* ps = P.pool_scale + l * 1024;
            auto AD = [=](const Unit& u) {
                if (u.seg == 0) return Operands{ATT + (size_t)u.pm * 256 * 1024, WAO + (size_t)u.pn * 256 * 1024, 1024, 1024, 0, 1024};
                if (u.seg == 1) return Operands{FOUR + (size_t)u.pm * 256 * 512, WFO + (size_t)u.pn * 256 * 512, 512, 512, 0, 512};
                return Operands{POOL + (size_t)u.pm * 256 * 512 + (u.pn >> 1) * 256, WPO + (size_t)u.pn * 256 * 256, 512, 256, 0, 256}; };
            auto E = [=](EPI_ARGS) {
                const int kd = u.seg < 2 ? u.seg + 1 : 2; const bool fin = (u.seg == 2); const int colb = u.pn * 256 + wc * 32 + 8 * fq;
#pragma unroll
                for (int ai = 0; ai < 2; ++ai)
#pragma unroll
                    for (int m = 0; m < 4; ++m) { const size_t row = (size_t)u.pm * 256 + ai * 128 + wr * 64 + m * 16 + fr; const bf16* gr = GB + row * 3072 + colb;
                        u32x4 nr[2], dr[2]; f32x4 psv[2][2];
#pragma unroll
                        for (int bj = 0; bj < 2; ++bj) { nr[bj] = *(const u32x4*)(gr + u.seg * 1024 + bj * 128); dr[bj] = *(const u32x4*)(gr + kd * 1024 + bj * 128);
                            psv[bj][0] = *(const f32x4*)(ps + colb + bj * 128); psv[bj][1] = *(const f32x4*)(ps + colb + bj * 128 + 4); }
#pragma unroll
                        for (int bj = 0; bj < 2; ++bj) { f32x4 o[2];
#pragma unroll
                            for (int n = 0; n < 2; ++n) { f32x4 nu = {bflo(nr[bj][2 * n]), bfhi(nr[bj][2 * n]), bflo(nr[bj][2 * n + 1]), bfhi(nr[bj][2 * n + 1])}, de = {bflo(dr[bj][2 * n]), bfhi(dr[bj][2 * n]), bflo(dr[bj][2 * n + 1]), bfhi(dr[bj][2 * n + 1])};
                                if (u.seg == 2) nu = nu * psv[bj][n];
                                de = de * psv[bj][n];
#pragma unroll
                                for (int j = 0; j < 4; ++j) { const float nj = (fabsf(nu[j]) < 1e-30f) ? copysignf(1e-30f, nu[j]) : nu[j]; const float dj = (fabsf(de[j]) < 1e-30f) ? copysignf(1e-30f, de[j]) : de[j];
                                    o[n][j] = acc[ai][bj][m][n][j] * nj * (fin ? 1.0f : __builtin_amdgcn_rcpf(dj)); }
                                acc[ai][bj][m][n] = o[n]; }
                            if (fin) st_bf8(MRGB + row * 1024 + colb + bj * 128, o[0], o[1]); } } };
            gemm_fast<false, true>(F.lds, F.tid, S, AD, mk_epi_seg(E, 2), nullptr);
        }
        SEAM(pb + 2);
        if (IN(pb + 3)) { REFRESH();
            GroupSched S; S.init(1, L0 ? 136 : 128, 4, F.G, F.bid); const bf16* A = WSP(bf16, WS_MRGB); const bf16* W = WSP(bf16, WS_WOUT);
            const float* xin = L0 ? P.x : P.out; const float* cin = L0 ? P.ctx : WSP(float, WS_XC); float* xo = P.out; float* co = WSP(float, WS_XC);
            const float* MOD = WSP(float, WS_MOD) + (size_t)l * 9 * 6144;
            auto AD = [=](const Unit& u) { return Operands{A + (size_t)u.pm * 256 * 1024, W + (size_t)u.pn * 256 * 1024, 1024, 1024, 0, 1024}; };
            auto E = [=](EPI_ARGS) {
                const int row0 = u.pm * 256, mr = row0 < RL ? (row0 >> 12) : 8, colb = u.pn * 256 + wc * 32 + 4 * fq;
                const float* src0 = row0 < RL ? xin + (size_t)row0 * DM : cin + (size_t)(row0 - RL) * DM; float* dst0 = row0 < RL ? xo + (size_t)row0 * DM : co + (size_t)(row0 - RL) * DM;
                f32x4 gv[2][2];
#pragma unroll
                for (int bj = 0; bj < 2; ++bj)
#pragma unroll
                    for (int n = 0; n < 2; ++n) gv[bj][n] = *(const f32x4*)(MOD + (size_t)mr * 6144 + 2048 + colb + bj * 128 + n * 16);
#pragma unroll
                for (int ai = 0; ai < 2; ++ai)
#pragma unroll
                    for (int m = 0; m < 4; ++m) { const size_t ro = (size_t)(ai * 128 + wr * 64 + m * 16 + fr) * DM + colb; f32x4 xv[2][2];
#pragma unroll
                        for (int bj = 0; bj < 2; ++bj)
#pragma unroll
                            for (int n = 0; n < 2; ++n) xv[bj][n] = *(const f32x4*)(src0 + ro + bj * 128 + n * 16);
#pragma unroll
                        for (int bj = 0; bj < 2; ++bj)
#pragma unroll
                            for (int n = 0; n < 2; ++n) *(f32x4*)(dst0 + ro + bj * 128 + n * 16) = xv[bj][n] + gv[bj][n] * acc[ai][bj][m][n]; } };
            GEMM(S, AD, E, 1024, 1024, 1024);
        }
        SEAM(pb + 3);
        if (IN(pb + 4)) { REFRESH(); REP_BEGIN(6) p_rowpass_f(P, F, l, L0 ? RT : RL); REP_END }
        SEAM(pb + 4);
        if (IN(pb + 5)) { REFRESH(); REP_BEGIN(7) p_topk(F, L0); REP_END }
        SEAM(pb + 5);
        if (IN(pb + 7)) { REFRESH(); REP_BEGIN(9)
            GroupSched S; S.init(16, L0 ? 17 : 16, 22, F.G, F.bid); const bf16* W = WSP(bf16, WS_WGU); bf16* HID = WSP(bf16, WS_HID); const int* SROW = WSP(int, WS_SROW);
            auto AD = [=](const Unit& u) { return Operands{H, W + ((size_t)u.grp * 5632 + u.pn * 256) * DM, DM, DM, u.grp * SLOT_E + u.pm * 256, DM}; };
            auto E = [=](EPI_ARGS) {
#pragma unroll
                for (int ai = 0; ai < 2; ++ai)
#pragma unroll
                    for (int m = 0; m < 4; ++m) { const size_t slot = (size_t)u.grp * SLOT_E + u.pm * 256 + ai * 128 + wr * 64 + m * 16 + fr; f32x4 o[2];
#pragma unroll
                        for (int n = 0; n < 2; ++n) { const f32x4 a = acc[ai][0][m][n], up = acc[ai][1][m][n];
#pragma unroll
                            for (int j = 0; j < 4; ++j) o[n][j] = a[j] * sigmoidf_(a[j]) * up[j]; }
                        st_bf8(HID + slot * FF + u.pn * 128 + wc * 32 + 8 * fq, o[0], o[1]); } };
            GEMM_GATHER(S, AD, E, DM, DM, DM, SROW);
        REP_END }
        SEAM(pb + 7);
        if (IN(pb + 8)) { REFRESH(); REP_BEGIN(10)
            const int tpe = L0 ? 17 : 16;
            GroupSched S; S.init(1, 16 * tpe, 4, F.G, F.bid); const bf16* HID = WSP(bf16, WS_HID); const bf16* W = WSP(bf16, WS_WD); bf16* Y = WSP(bf16, WS_Y); const float* SG = WSP(float, WS_SGATE);
            auto AD = [=](const Unit& u) { const int e = u.pm / tpe, st = e * 17 + (u.pm - e * tpe); return Operands{HID + (size_t)st * 256 * FF, W + ((size_t)e * 1024 + u.pn * 256) * FF, FF, FF, 0, FF}; };
            auto E = [=](EPI_ARGS) { const int e = u.pm / tpe; const size_t slot0 = (size_t)(e * 17 + (u.pm - e * tpe)) * 256 + wr * 64 + fr; float gt[2][4];
#pragma unroll
                for (int ai = 0; ai < 2; ++ai)
#pragma unroll
                    for (int m = 0; m < 4; ++m) gt[ai][m] = SG[slot0 + ai * 128 + m * 16];
#pragma unroll
                for (int ai = 0; ai < 2; ++ai)
#pragma unroll
                    for (int m = 0; m < 4; ++m)
#pragma unroll
                        for (int bj = 0; bj < 2; ++bj) st_bf8(Y + (slot0 + ai * 128 + m * 16) * DM + u.pn * 256 + bj * 128 + wc * 32 + 8 * fq, acc[ai][bj][m][0] * gt[ai][m], acc[ai][bj][m][1] * gt[ai][m]); };
            GEMM_P(S, AD, E);
        REP_END }
        SEAM(pb + 8);
        if (IN(pb + 9)) { REFRESH(); p_rowpass_k(P, F, l, L0 ? RT : RL); if (L0) p_wconv(P, F, 1); }
        if (L0) SEAM(pb + 9);
    }
#undef IN
#undef SEAM
}
template <int PH> static void launch_ph(int grid, const Params& p, hipStream_t stream) { hipLaunchKernelGGL(fwd_kernel<PH>, dim3(grid), dim3(NTHREADS), LDS_BYTES, stream, p); }
template <int PH> static bool set_attr() { return hipFuncSetAttribute((const void*)fwd_kernel<PH>, hipFuncAttributeMaxDynamicSharedMemorySize, LDS_BYTES) == hipSuccess; }

#ifndef DUP_LAUNCH
#define DUP_LAUNCH -1
#endif
extern "C" void kernel_launch(void* const* d_in, const int* in_sizes, int n_in, void* d_out, int out_size, void* d_ws, size_t ws_size, hipStream_t stream) {
    static int grid = 0;
    if (grid == 0) {
        if (n_in != 20 || out_size != RL * DM || ws_size < WS_END) { fprintf(stderr, "kernel_launch: unexpected shapes (n_in %d out %d ws %zu need %zu)\n", n_in, out_size, ws_size, (size_t)WS_END); grid = -1; return; }
        int dev = 0, cus = 0, per_cu = 0;
        if (hipGetDevice(&dev) != hipSuccess || hipDeviceGetAttribute(&cus, hipDeviceAttributeMultiprocessorCount, dev) != hipSuccess) { grid = -1; return; }
#if N_LAUNCH_MODE == 1
        if (!set_attr<-1>()) { fprintf(stderr, "kernel_launch: hipFuncSetAttribute failed\n"); grid = -1; return; }
        if (hipOccupancyMaxActiveBlocksPerMultiprocessor(&per_cu, (const void*)fwd_kernel<-1>, NTHREADS, LDS_BYTES) != hipSuccess || per_cu < 1) fprintf(stderr, "kernel_launch: occupancy query reports %d\n", per_cu);
#else
        if (!(set_attr<0>() && set_attr<1>() && set_attr<2>() && set_attr<3>() && set_attr<4>() && set_attr<5>() && set_attr<6>() && set_attr<7>() && set_attr<9>() && set_attr<10>() && set_attr<11>())) { fprintf(stderr, "kernel_launch: hipFuncSetAttribute failed\n"); grid = -1; return; }
        (void)per_cu;
#endif
        (void)hipGetLastError();
        grid = cus;
    }
    if (grid < 0) return;
    if (hipMemsetAsync((char*)d_ws + WS_CTL, 0, CTL_BYTES, stream) != hipSuccess) return;
    Params p{};
    const float** pp = (const float**)&p;
    for (int i = 0; i < 20; ++i) pp[i] = (const float*)d_in[i];
    p.out = (float*)d_out; p.ws = (unsigned char*)d_ws;
#if N_LAUNCH_MODE == 1
    p.l_lo = 0; p.l_hi = 2;
    launch_ph<-1>(grid, p, stream);
#else
    p.l_lo = 0; p.l_hi = 0; launch_ph<0>(grid, p, stream); if (DUP_LAUNCH == 0) launch_ph<0>(grid, p, stream); launch_ph<1>(grid, p, stream); if (DUP_LAUNCH == 1) launch_ph<1>(grid, p, stream);
#define LP(k) do { launch_ph<k>(grid, p, stream); if (DUP_LAUNCH == (k) && l == 0) launch_ph<k>(grid, p, stream); } while (0)
    for (int l = 0; l < 2; ++l) { p.l_lo = l; p.l_hi = l + 1;
        LP(2); LP(3); LP(4); LP(5); LP(6); LP(7); LP(9); LP(10); LP(11); }
#endif
}
```

```cpp
#include <hip/hip_runtime.h>
#include <cstdio>
#include <cstdint>

#ifndef N_LAUNCH_MODE
#define N_LAUNCH_MODE 1
#endif

#define GAS __attribute__((address_space(1)))
#define LAS __attribute__((address_space(3)))
typedef unsigned short bf16;
typedef short bf16x8 __attribute__((ext_vector_type(8)));
typedef float f32x4 __attribute__((ext_vector_type(4)));
typedef unsigned u32x4 __attribute__((ext_vector_type(4)));
typedef unsigned u32x2 __attribute__((ext_vector_type(2)));

constexpr int NB = 8, SEQ = 4096, DM = 1024, CTXL = 256, NH = 16, HD = 64, GRIDW = 64;
constexpr int RL = NB * SEQ, RC = NB * CTXL, RT = RL + RC;
constexpr int INW = 7168, NE = 16, FF = 2816, CAPL = 512, CAPC = 32;
constexpr int SLOT_E = 4352, NSLOT = NE * SLOT_E;
constexpr float RMS_EPS = 1e-6f;
constexpr float LOG2E = 1.4426950408889634f, QSCALE = 0.125f * LOG2E;
constexpr int NWAVES = 8, NTHREADS = 512;

constexpr size_t al256(size_t x) { return (x + 255) & ~(size_t)255; }
constexpr size_t WS_CTL = 0, CTL_BYTES = 1u << 20;
constexpr size_t WS_MOD = WS_CTL + CTL_BYTES;
constexpr size_t WS_XC = al256(WS_MOD + (size_t)2 * 9 * 6144 * 4);
constexpr size_t WS_AFF = al256(WS_XC + (size_t)RC * DM * 4);
constexpr size_t WS_SROW = al256(WS_AFF + (size_t)RT * 16 * 4);
constexpr size_t WS_SGATE = al256(WS_SROW + (size_t)NSLOT * 4);
constexpr size_t WS_SEL = al256(WS_SGATE + (size_t)NSLOT * 4);
constexpr size_t WS_DFTM = al256(WS_SEL + (size_t)RT * 16 * 4);
constexpr size_t WS_DFTC = al256(WS_DFTM + (size_t)4096 * 8192 * 2);
constexpr size_t WS_WA = al256(WS_DFTC + (size_t)256 * 512 * 2);
constexpr size_t WS_WFV = al256(WS_WA + (size_t)5632 * 1024 * 2);
constexpr size_t WS_WAO = al256(WS_WFV + (size_t)2048 * 1024 * 2);
constexpr size_t WS_WFO = al256(WS_WAO + (size_t)1024 * 1024 * 2);
constexpr size_t WS_WPO = al256(WS_WFO + (size_t)1024 * 512 * 2);
constexpr size_t WS_WOUT = al256(WS_WPO + (size_t)1024 * 256 * 2);
constexpr size_t WS_WGU = al256(WS_WOUT + (size_t)1024 * 1024 * 2);
constexpr size_t WS_WD = al256(WS_WGU + (size_t)16 * 5632 * 1024 * 2);
constexpr size_t WS_H = al256(WS_WD + (size_t)16 * 1024 * 2816 * 2);
constexpr size_t WS_R = al256(WS_H + (size_t)RT * DM * 2);
constexpr size_t WS_KQ = WS_R;
constexpr size_t WS_MRG = WS_KQ;
constexpr size_t WS_PB = al256(WS_KQ + (size_t)RT * 2048 * 2);
constexpr size_t WS_GB = al256(WS_PB + (size_t)RT * 512 * 2);
constexpr size_t WS_YT = al256(WS_GB + (size_t)RT * 3072 * 2);
constexpr size_t WS_MRGB = WS_YT;
constexpr size_t WS_VT = al256(WS_YT + (size_t)RT * 1024 * 2);
constexpr size_t WS_FOUR = al256(WS_VT + (size_t)RT * 1024 * 2);
constexpr size_t WS_ATT = al256(WS_FOUR + (size_t)RT * 512 * 2);
constexpr size_t WS_POOL = al256(WS_ATT + (size_t)RT * 1024 * 2);
constexpr size_t WS_MIX_END = al256(WS_POOL + (size_t)RT * 512 * 2);
constexpr size_t WS_XG = WS_R;
constexpr size_t WS_HID = al256(WS_XG + (size_t)NSLOT * 1024 * 2);
constexpr size_t WS_Y = al256(WS_HID + (size_t)NSLOT * 2816 * 2);
constexpr size_t WS_MOE_END = al256(WS_Y + (size_t)NSLOT * 1024 * 2);
constexpr size_t WS_END = WS_MIX_END > WS_MOE_END ? WS_MIX_END : WS_MOE_END;
constexpr size_t YT_CTX_OFF = (size_t)8 * 1024 * 4096;

constexpr int CW_BAR = 4096;

constexpr int LDS_BYTES = 147456;
constexpr int LDS_MISC = 131072;

__device__ __forceinline__ unsigned f2bf(float f) { unsigned u = __float_as_uint(f); return (u + 0x7fffu + ((u >> 16) & 1u)) >> 16; }
typedef __bf16 hbf16x2 __attribute__((ext_vector_type(2)));
typedef float f32x2 __attribute__((ext_vector_type(2)));
__device__ __forceinline__ unsigned pk2(float lo, float hi) { const f32x2 v = {lo, hi}; return __builtin_bit_cast(unsigned, __builtin_convertvector(v, hbf16x2)); }
__device__ __forceinline__ float bf2f(unsigned b) { return __uint_as_float(b << 16); }
__device__ __forceinline__ float bflo(unsigned w) { return __uint_as_float(w << 16); }
__device__ __forceinline__ float bfhi(unsigned w) { return __uint_as_float(w & 0xffff0000u); }
template <int CTRL> __device__ __forceinline__ float dppf(float x) { return __builtin_bit_cast(float, __builtin_amdgcn_mov_dpp(__builtin_bit_cast(int, x), CTRL, 0xf, 0xf, true)); }
template <int CTRL> __device__ __forceinline__ int dppi(int x) { return __builtin_amdgcn_mov_dpp(x, CTRL, 0xf, 0xf, true); }
constexpr int DPP_XOR1 = 0xB1, DPP_XOR2 = 0x4E, DPP_ROR4 = 0x124, DPP_ROR8 = 0x128;
__device__ __forceinline__ float wave_sum(float v) {
    v += dppf<DPP_XOR1>(v); v += dppf<DPP_XOR2>(v); v += dppf<DPP_ROR4>(v); v += dppf<DPP_ROR8>(v);
    auto s = __builtin_amdgcn_permlane16_swap(__float_as_uint(v), __float_as_uint(v), false, false); v = __uint_as_float(s[0]) + __uint_as_float(s[1]);
    auto t = __builtin_amdgcn_permlane32_swap(__float_as_uint(v), __float_as_uint(v), false, false); return __uint_as_float(t[0]) + __uint_as_float(t[1]);
}
__device__ __forceinline__ float wave_max(float v) {
    v = fmaxf(v, dppf<DPP_XOR1>(v)); v = fmaxf(v, dppf<DPP_XOR2>(v)); v = fmaxf(v, dppf<DPP_ROR4>(v)); v = fmaxf(v, dppf<DPP_ROR8>(v));
    auto s = __builtin_amdgcn_permlane16_swap(__float_as_uint(v), __float_as_uint(v), false, false); v = fmaxf(__uint_as_float(s[0]), __uint_as_float(s[1]));
    auto t = __builtin_amdgcn_permlane32_swap(__float_as_uint(v), __float_as_uint(v), false, false); return fmaxf(__uint_as_float(t[0]), __uint_as_float(t[1]));
}
__device__ __forceinline__ int wave_sum_i(int v) {
    v += dppi<DPP_XOR1>(v); v += dppi<DPP_XOR2>(v); v += dppi<DPP_ROR4>(v); v += dppi<DPP_ROR8>(v);
    auto s = __builtin_amdgcn_permlane16_swap((unsigned)v, (unsigned)v, false, false); v = (int)(s[0] + s[1]);
    auto t = __builtin_amdgcn_permlane32_swap((unsigned)v, (unsigned)v, false, false); return (int)(t[0] + t[1]);
}
__device__ __forceinline__ float sigmoidf_(float x) { return 1.f / (1.f + __expf(-x)); }
#define LDS_WAIT() asm volatile("s_waitcnt lgkmcnt(0)" ::: "memory")

#define XB_TMO      128
#define XB_XCNT(j)  (256  + 64 * (j))
#define XB_XSUB(j)  (1280 + 64 * (j))
#define XB_XGEN(j)  (2304 + 64 * (j))
#define XB_TOP      3328
#define XB_TOPGEN   3392
#define XCD_BAR_WORDS 3456
#define XB_SPIN_CAP (1u << 22)

__device__ __forceinline__ unsigned xb_ld(unsigned* p)              { return __hip_atomic_load(p, __ATOMIC_RELAXED, __HIP_MEMORY_SCOPE_AGENT); }
__device__ __forceinline__ unsigned xb_add(unsigned* p, unsigned v) { return __hip_atomic_fetch_add(p, v, __ATOMIC_RELAXED, __HIP_MEMORY_SCOPE_AGENT); }
__device__ __forceinline__ unsigned xb_xcc_id() { return (unsigned)__builtin_amdgcn_s_getreg((3 << 11) | 20) & 0xFu; }
#define XB_SPIN(cond, bar) do { unsigned _sp = 0; while (cond) { __builtin_amdgcn_s_sleep(1); \
    if ((++_sp & 255u) == 0u) { if (xb_ld(&(bar)[XB_TMO])) break; if (_sp > XB_SPIN_CAP) { atomicAdd(&(bar)[XB_TMO], 1u); break; } } } } while (0)

struct XcdBarrier { unsigned* bar; unsigned x; volatile LAS unsigned* st; };

__device__ __forceinline__ XcdBarrier xcd_barrier_post(unsigned* bar, volatile LAS unsigned* st) {
    XcdBarrier b; b.bar = bar; b.x = xb_xcc_id(); b.st = st;
    if (threadIdx.x == 0) (void)xb_add(&bar[XB_XCNT(b.x)], 1u);
    return b;
}
__device__ __forceinline__ void xcd_barrier_complete(unsigned* bar, unsigned x, unsigned& nloc, unsigned& nx) {
    const unsigned G = gridDim.x * gridDim.y * gridDim.z;
    unsigned sum, cnt, mine, sp = 0u;
    for (;;) {
        sum = 0u; cnt = 0u; mine = 0u;
#pragma unroll
        for (unsigned j = 0; j < 16; ++j) { const unsigned c = xb_ld(&bar[XB_XCNT(j)]); sum += c; cnt += (c > 0u) ? 1u : 0u; mine = (j == x) ? c : mine; }
        if (sum == G) break;
        __builtin_amdgcn_s_sleep(1);
        if ((++sp & 255u) == 0u) { if (xb_ld(&bar[XB_TMO])) break; if (sp > XB_SPIN_CAP) { atomicAdd(&bar[XB_TMO], 1u); break; } }
    }
    nloc = mine > 0u ? mine : 1u; nx = cnt > 0u ? cnt : 1u;
}
__device__ __forceinline__ void xcd_barrier(const XcdBarrier& b) {
    asm volatile("s_waitcnt vmcnt(0)" ::: "memory");
    __syncthreads();
    if (threadIdx.x == 0) {
        unsigned* bar = b.bar;
        __builtin_amdgcn_s_waitcnt(0);
        unsigned nloc = b.st[0], nx = b.st[1];
        if (nloc == 0u) { xcd_barrier_complete(bar, b.x, nloc, nx); b.st[0] = nloc; b.st[1] = nx; }
        const unsigned old = xb_add(&bar[XB_XSUB(b.x)], 1u);
        const unsigned gen = old / nloc;
        if (old + 1u == (gen + 1u) * nloc) {
            __builtin_amdgcn_fence(__ATOMIC_RELEASE, "agent");
            asm volatile("s_waitcnt vmcnt(0)" ::: "memory");
            const unsigned og = xb_add(&bar[XB_TOP], 1u);
            const unsigned tg = og / nx;
            if (og + 1u == (tg + 1u) * nx) xb_add(&bar[XB_TOPGEN], 1u);
            else XB_SPIN(xb_ld(&bar[XB_TOPGEN]) == tg, bar);
            __builtin_amdgcn_fence(__ATOMIC_ACQUIRE, "agent");
            xb_add(&bar[XB_XGEN(b.x)], 1u);
            asm volatile("s_waitcnt vmcnt(0)" ::: "memory");
        } else {
            XB_SPIN(xb_ld(&bar[XB_XGEN(b.x)]) == gen, bar);
            __builtin_amdgcn_fence(__ATOMIC_ACQUIRE, "agent");
            asm volatile("s_waitcnt vmcnt(0)" ::: "memory");
        }
    }
    __syncthreads();
}

struct Params {
    const float *x, *c, *ctx, *c_ctx, *ada_w, *ada_b, *norm1_g, *norm2_g, *w_in, *rpb, *w_att_o, *w_fourier, *w_pool, *pool_scale, *w_out, *w_router, *w_eg, *w_eu, *w_ed, *final_g;
    float* out; unsigned char* ws; int l_lo, l_hi;
};
struct Frame {
    LAS unsigned char* lds;
    int tid, lane, wave, G, bid;
    unsigned char* ws;
};
#define WSP(T, off) ((T*)(F.ws + (off)))

struct Unit { int grp, pm, pn, seg; };
struct GroupSched {
    int ng, nM, nN, G, c; int tM, tN, tpm0, tpn0;
    __device__ __forceinline__ void init(int ng_, int nM_, int nN_, int G_, int c_, int tM_ = 0, int tN_ = 0, int tpm0_ = 0, int tpn0_ = 0) { ng = ng_; nM = nM_; nN = nN_; G = G_; c = c_; tM = tM_; tN = tN_; tpm0 = tpm0_; tpn0 = tpn0_; }
    __device__ __forceinline__ bool next(int i, Unit& u) const {
        const int per = nM * nN; const int L = i * G + c;
        if (L < ng * per) {
            u.grp = L / per; int wgid = L - u.grp * per;
            { const int q = per / 8, r = per % 8, xcd = wgid % 8, off = wgid / 8; wgid = (xcd < r ? xcd * (q + 1) : r * (q + 1) + (xcd - r) * q) + off; }
            const int nig = 8 * nN, gid = wgid / nig, fm = gid * 8, gsz = (nM - fm) < 8 ? (nM - fm) : 8;
            u.pm = fm + ((wgid % nig) % gsz); u.pn = (wgid % nig) / gsz; u.seg = 0; return true;
        }
        const int w = L - ng * per;
        if (w < tM * tN) { u.grp = ng; u.pm = tpm0 + (w % tM); u.pn = tpn0 + (w / tM); u.seg = 0; return true; }
        return false;
    }
};
struct Operands { const bf16* A; const bf16* Bt; int lda, ldb, slot0, K; };

template <class Addr, class Epi>
__device__ __forceinline__ void gemm_simple(const GroupSched& S, const Addr& AD, const Epi& E, int K) {
    const int tid = threadIdx.x, wid = __builtin_amdgcn_readfirstlane(tid >> 6), lane = tid & 63, wr = wid >> 2, wc = wid & 3, fr = lane & 15, fq = lane >> 4;
    Unit u;
    for (int i = 0; S.next(i, u); ++i) {
        const Operands op = AD(u);
        f32x4 acc[2][2][4][2];
#pragma unroll
        for (int a = 0; a < 2; ++a)
#pragma unroll
            for (int b = 0; b < 2; ++b)
#pragma unroll
                for (int m = 0; m < 4; ++m)
#pragma unroll
                    for (int n = 0; n < 2; ++n) acc[a][b][m][n] = (f32x4){0.f, 0.f, 0.f, 0.f};
        const bf16* ap = op.A + (size_t)(wr * 64 + fr) * op.lda + fq * 8;
        const bf16* bp = op.Bt + (size_t)(wc * 32 + fr) * op.ldb + fq * 8;
#pragma unroll 1
        for (int k = 0; k < K; k += 32) {
            bf16x8 bfr[2][2];
#pragma unroll
            for (int b = 0; b < 2; ++b)
#pragma unroll
                for (int n = 0; n < 2; ++n) bfr[b][n] = *(const bf16x8*)(bp + (size_t)(b * 128 + n * 16) * op.ldb + k);
#pragma unroll
            for (int a = 0; a < 2; ++a) {
                bf16x8 af[4];
#pragma unroll
                for (int m = 0; m < 4; ++m) af[m] = *(const bf16x8*)(ap + (size_t)(a * 128 + m * 16) * op.lda + k);
#pragma unroll
                for (int b = 0; b < 2; ++b)
#pragma unroll
                    for (int m = 0; m < 4; ++m)
#pragma unroll
                        for (int n = 0; n < 2; ++n) acc[a][b][m][n] = __builtin_amdgcn_mfma_f32_16x16x32_bf16(bfr[b][n], af[m], acc[a][b][m][n], 0, 0, 0);
            }
        }
        E(acc, u, wr, wc, fr, fq);
    }
}
constexpr int HTB = 128 * 64 * 2;
__device__ __forceinline__ int lds_byte(int r, int c) { const int st = (r >> 4) * 2 + (c >> 5), rr = r & 15, cc = c & 31, ob = rr * 64 + cc * 2; return st * 1024 + (ob ^ (((ob >> 9) & 1) << 5)); }
__device__ __forceinline__ int perm32(int rho) { const int n = rho >> 4, i = rho & 15; return 8 * (i >> 2) + 4 * n + (i & 3); }
__device__ __forceinline__ void stage_rc(int b, int& R, int& C) { const int st = b / 1024, sb = b % 1024, swz = sb ^ (((sb >> 9) & 1) << 5); R = (st >> 1) * 16 + swz / 64; C = (st & 1) * 32 + (swz % 64) / 2; }
template <bool GATHER, bool PERM, class Sched, class Addr, class Epi>
__device__ __forceinline__ void gemm_fast(LAS unsigned char* lds, const int tid, const Sched& S, const Addr& AD, const Epi& E, const int* __restrict__ grows) {
    const int wid = __builtin_amdgcn_readfirstlane(tid >> 6), lane = tid & 63, wr = wid >> 2, wc = wid & 3, fr = lane & 15, fq = lane >> 4;
    int sR[2], sRb[2]; unsigned sC[2];
    unsigned cvg[2][2], nvg[2][2], cvb[2][2], nvb[2][2];
#pragma unroll
    for (int i = 0; i < 2; ++i) { int R, C; stage_rc(tid * 16 + i * 8192, R, C); sR[i] = R; sC[i] = (unsigned)C * 2u; sRb[i] = PERM ? ((R & ~31) + perm32(R & 31)) : R; }
    const size_t kstep = 128;
    const unsigned ldsw = (unsigned)wid * 1024u;
    const int aoff = lds_byte(wr * 64 + fr, fq * 8), boff = lds_byte(wc * 32 + fr, fq * 8);
#define PG8_SA(b, h) (((b) * 2 + (h)) * HTB)
#define PG8_SB(b, h) ((4 + (b) * 2 + (h)) * HTB)
#define PG8_STAGE(bufoff, gbase, voff) do { _Pragma("unroll") for (int _i = 0; _i < 2; ++_i) \
        __builtin_amdgcn_global_load_lds((const unsigned*)((const char*)(gbase) + (voff)[_i]), (LAS unsigned*)(lds + (bufoff) + ldsw + _i * 8192), 16, 0, 0); } while (0)
#define PG8_LDA(dst, b, h) do { _Pragma("unroll") for (int m = 0; m < 4; ++m) _Pragma("unroll") for (int k = 0; k < 2; ++k) dst[m][k] = *(const LAS bf16x8*)(lds + PG8_SA(b, h) + aoff + m * 2048 + k * 1024); } while (0)
#define PG8_LDB(dst, b, h) do { _Pragma("unroll") for (int n = 0; n < 2; ++n) _Pragma("unroll") for (int k = 0; k < 2; ++k) dst[n][k] = *(const LAS bf16x8*)(lds + PG8_SB(b, h) + boff + n * 2048 + k * 1024); } while (0)
#define PG8_MMA(ai, bj, At, Bt) do { __builtin_amdgcn_s_setprio(1); _Pragma("unroll") for (int m = 0; m < 4; ++m) _Pragma("unroll") for (int n = 0; n < 2; ++n) _Pragma("unroll") for (int k = 0; k < 2; ++k) \
        acc[ai][bj][m][n] = __builtin_amdgcn_mfma_f32_16x16x32_bf16(Bt[n][k], At[m][k], acc[ai][bj][m][n], 0, 0, 0); __builtin_amdgcn_s_setprio(0); } while (0)
#define PG8_WAIT_V(n) asm volatile("s_waitcnt vmcnt(" #n ")" ::: "memory")
#define PG8_WAIT_L(n) asm volatile("s_waitcnt lgkmcnt(" #n ")" ::: "memory")
#define PG8_BAR __builtin_amdgcn_s_barrier()
#define PG8_SCHED __builtin_amdgcn_sched_barrier(0)
#define PG8_GIDX(dst, op_) do { _Pragma("unroll") for (int h_ = 0; h_ < 2; ++h_) _Pragma("unroll") for (int i_ = 0; i_ < 2; ++i_) dst[h_][i_] = (unsigned)grows[(op_).slot0 + h_ * 128 + sR[i_]] * (unsigned)((op_).lda * 2) + sC[i_]; } while (0)
#define PG8_AOFF(dst, op_) do { _Pragma("unroll") for (int h_ = 0; h_ < 2; ++h_) _Pragma("unroll") for (int i_ = 0; i_ < 2; ++i_) dst[h_][i_] = (unsigned)((sR[i_] + 128 * h_) * (op_).lda) * 2u + sC[i_]; } while (0)
#define PG8_BOFF(dst, op_) do { _Pragma("unroll") for (int h_ = 0; h_ < 2; ++h_) _Pragma("unroll") for (int i_ = 0; i_ < 2; ++i_) dst[h_][i_] = (unsigned)((sRb[i_] + 128 * h_) * (op_).ldb) * 2u + sC[i_]; } while (0)
#define PG8_COPY(dst, src) do { _Pragma("unroll") for (int h_ = 0; h_ < 2; ++h_) _Pragma("unroll") for (int i_ = 0; i_ < 2; ++i_) dst[h_][i_] = src[h_][i_]; } while (0)
    Unit cur, nxt; int ui = 0;
    if (!S.next(0, cur)) return;
    f32x4 acc[2][2][4][2];
#pragma unroll
    for (int a = 0; a < 2; ++a)
#pragma unroll
        for (int b = 0; b < 2; ++b)
#pragma unroll
            for (int m = 0; m < 4; ++m)
#pragma unroll
                for (int n = 0; n < 2; ++n) acc[a][b][m][n] = (f32x4){0.f, 0.f, 0.f, 0.f};
    bf16x8 At[4][2], B0[2][2], B1[2][2];
    const char* cA; const char* cB; int nt;
    { const Operands op = AD(cur); cA = (const char*)op.A; cB = (const char*)op.Bt; nt = op.K / 64; PG8_BOFF(cvb, op);
      Unit u1; const bool h1 = S.next(1, u1); const Operands o1 = h1 ? AD(u1) : op; PG8_BOFF(nvb, o1);
      if constexpr (GATHER) { PG8_GIDX(cvg, op); PG8_GIDX(nvg, o1); PG8_WAIT_V(0); } else { PG8_AOFF(cvg, op); PG8_AOFF(nvg, o1); } }
    PG8_STAGE(PG8_SB(0, 0), cB, cvb[0]); PG8_STAGE(PG8_SB(0, 1), cB, cvb[1]); PG8_STAGE(PG8_SA(0, 0), cA, cvg[0]); PG8_STAGE(PG8_SA(0, 1), cA, cvg[1]);
    if (wr == 1) PG8_BAR;
    PG8_WAIT_V(2); PG8_BAR;
    PG8_STAGE(PG8_SB(1, 0), cB + kstep, cvb[0]); PG8_STAGE(PG8_SA(1, 0), cA + kstep, cvg[0]); PG8_STAGE(PG8_SB(1, 1), cB + kstep, cvb[1]);
    PG8_WAIT_V(6); PG8_BAR;
    for (;;) {
        const bool has_next = S.next(ui + 1, nxt);
        const char* nA = cA; const char* nB = cB; int nnt = nt;
        if (has_next) { const Operands op = AD(nxt); nA = (const char*)op.A; nB = (const char*)op.Bt; nnt = op.K / 64; }
#pragma unroll 1
        for (int t = 0; t < nt; t += 2) {
            const bool last = (t == nt - 2);
            const char* a1 = cA + (size_t)(t + 1) * kstep;
            const char* a2 = last ? nA : cA + (size_t)(t + 2) * kstep; const char* b2 = last ? nB : cB + (size_t)(t + 2) * kstep;
            const char* a3 = a2 + kstep; const char* b3 = b2 + kstep;
            unsigned v2[2][2], w2[2][2];
#pragma unroll
            for (int h_ = 0; h_ < 2; ++h_)
#pragma unroll
                for (int i_ = 0; i_ < 2; ++i_) { v2[h_][i_] = last ? nvg[h_][i_] : cvg[h_][i_]; w2[h_][i_] = last ? nvb[h_][i_] : cvb[h_][i_]; }
            PG8_LDB(B0, 0, 0); PG8_LDB(B1, 0, 1); PG8_SCHED; PG8_LDA(At, 0, 0); PG8_STAGE(PG8_SA(1, 1), a1, cvg[1]);
            PG8_WAIT_V(8); PG8_WAIT_L(0); PG8_BAR; PG8_MMA(0, 0, At, B0); PG8_MMA(0, 1, At, B1); PG8_BAR; PG8_SCHED;
            PG8_LDA(At, 0, 1); PG8_STAGE(PG8_SB(0, 0), b2, w2[0]); PG8_STAGE(PG8_SB(0, 1), b2, w2[1]); PG8_STAGE(PG8_SA(0, 0), a2, v2[0]);
            PG8_WAIT_V(8); PG8_WAIT_L(0); PG8_BAR; PG8_MMA(1, 0, At, B0); PG8_MMA(1, 1, At, B1); PG8_BAR; PG8_SCHED;
            PG8_LDB(B0, 1, 0); PG8_LDB(B1, 1, 1); PG8_SCHED; PG8_LDA(At, 1, 0); PG8_STAGE(PG8_SA(0, 1), a2, v2[1]);
            PG8_WAIT_V(8); PG8_WAIT_L(0); PG8_BAR; PG8_MMA(0, 0, At, B0); PG8_MMA(0, 1, At, B1); PG8_BAR; PG8_SCHED;
            PG8_LDA(At, 1, 1); PG8_STAGE(PG8_SB(1, 0), b3, w2[0]); PG8_STAGE(PG8_SB(1, 1), b3, w2[1]); PG8_STAGE(PG8_SA(1, 0), a3, v2[0]);
            PG8_WAIT_V(8); PG8_WAIT_L(0); PG8_BAR; PG8_MMA(1, 0, At, B0); PG8_MMA(1, 1, At, B1); PG8_BAR; PG8_SCHED;
        }
        if (wr == 0) PG8_BAR;
        unsigned fvg[2][2], fvb[2][2];
        { Unit u2; const bool h2 = S.next(ui + 2, u2);
          if (h2) { const Operands o2 = AD(u2); PG8_BOFF(fvb, o2); if constexpr (GATHER) PG8_GIDX(fvg, o2); else PG8_AOFF(fvg, o2); }
          else { PG8_COPY(fvb, nvb); PG8_COPY(fvg, nvg); } }
        { int fr2 = fr, fq2 = fq; asm volatile("" : "+v"(fr2), "+v"(fq2));
          E(acc, cur, wr, wc, fr2, fq2); }
        if (!has_next) break;
        if constexpr (GATHER) PG8_WAIT_V(0);
        PG8_COPY(cvg, nvg); PG8_COPY(nvg, fvg); PG8_COPY(cvb, nvb); PG8_COPY(nvb, fvb);
        if (E.reset(cur)) {
#pragma unroll
        for (int a = 0; a < 2; ++a)
#pragma unroll
            for (int b = 0; b < 2; ++b)
#pragma unroll
                for (int m = 0; m < 4; ++m)
#pragma unroll
                    for (int n = 0; n < 2; ++n) acc[a][b][m][n] = (f32x4){0.f, 0.f, 0.f, 0.f};
        }
        cur = nxt; cA = nA; cB = nB; nt = nnt; ++ui;
        if (wr == 1) PG8_BAR;
    }
    PG8_WAIT_V(0);
    PG8_BAR;
#undef PG8_SA
#undef PG8_SB
#undef PG8_STAGE
#undef PG8_LDA
#undef PG8_LDB
#undef PG8_MMA
#undef PG8_WAIT_V
#undef PG8_WAIT_L
#undef PG8_BAR
#undef PG8_SCHED
#undef PG8_GIDX
#undef PG8_AOFF
#undef PG8_BOFF
#undef PG8_COPY
}
template <class F> struct EpiFn { F f; __device__ __forceinline__ void operator()(f32x4 (&acc)[2][2][4][2], const Unit& u, int wr, int wc, int fr, int fq) const { f(acc, u, wr, wc, fr, fq); } __device__ __forceinline__ bool reset(const Unit&) const { return true; } };
template <class F> __device__ __forceinline__ EpiFn<F> mk_epi(F f) { return EpiFn<F>{f}; }
template <class F> struct EpiSeg { F f; int last; __device__ __forceinline__ void operator()(f32x4 (&acc)[2][2][4][2], const Unit& u, int wr, int wc, int fr, int fq) const { f(acc, u, wr, wc, fr, fq); } __device__ __forceinline__ bool reset(const Unit& u) const { return u.seg == last; } };
template <class F> __device__ __forceinline__ EpiSeg<F> mk_epi_seg(F f, int last) { return EpiSeg<F>{f, last}; }
template <int NSEG> struct SegSched { GroupSched base; __device__ __forceinline__ bool next(int j, Unit& u) const { if (!base.next(j / NSEG, u)) return false; u.seg = j % NSEG; return true; } };
#ifndef DUP_PH
#define DUP_PH -1
#endif
#define REP_BEGIN(k) _Pragma("unroll 1") for (int rep_ = 0; rep_ < ((DUP_PH == (k)) ? 2 : 1); ++rep_) { if (rep_) { if constexpr (PH < 0) xcd_barrier(bar); }
#define REP_END }
#ifndef USE_FAST
#define USE_FAST 1
#endif
#if USE_FAST
#define GEMM(S, AD, E, K, lda, ldb) gemm_fast<false, false>(F.lds, F.tid, S, AD, mk_epi(E), nullptr)
#define GEMM_P(S, AD, E) gemm_fast<false, true>(F.lds, F.tid, S, AD, mk_epi(E), nullptr)
#define GEMM_GATHER(S, AD, E, K, lda, ldb, rows) gemm_fast<true, true>(F.lds, F.tid, S, AD, mk_epi(E), rows)
#else
#define GEMM(S, AD, E, K, lda, ldb) gemm_simple(S, AD, E, K)
#endif
#define EPI_ARGS f32x4 (&acc)[2][2][4][2], const Unit& u, int wr, int wc, int fr, int fq
#define EPI_FOR(...) _Pragma("unroll") for (int ai = 0; ai < 2; ++ai) _Pragma("unroll") for (int m = 0; m < 4; ++m) { const int r = ai * 128 + wr * 64 + m * 16 + fr; \
    _Pragma("unroll") for (int bj = 0; bj < 2; ++bj) _Pragma("unroll") for (int n = 0; n < 2; ++n) { const int c = bj * 128 + wc * 32 + n * 16 + 4 * fq; const f32x4 v = acc[ai][bj][m][n]; __VA_ARGS__ } }
#define EPI_FOR8(...) _Pragma("unroll") for (int ai = 0; ai < 2; ++ai) _Pragma("unroll") for (int m = 0; m < 4; ++m) { const int r = ai * 128 + wr * 64 + m * 16 + fr; \
    _Pragma("unroll") for (int bj = 0; bj < 2; ++bj) { const int c = bj * 128 + wc * 32 + 8 * fq; const f32x4 v0 = acc[ai][bj][m][0], v1 = acc[ai][bj][m][1]; __VA_ARGS__ } }
__device__ __forceinline__ void st_bf8(bf16* p, f32x4 a, f32x4 b) { u32x4 w; w.x = pk2(a[0], a[1]); w.y = pk2(a[2], a[3]); w.z = pk2(b[0], b[1]); w.w = pk2(b[2], b[3]); *(u32x4*)p = w; }
__device__ __forceinline__ void st_bf4(bf16* p, f32x4 v) { u32x2 w; w.x = pk2(v[0], v[1]); w.y = pk2(v[2], v[3]); *(u32x2*)p = w; }

__device__ __forceinline__ void p_mod(const Params& P, Frame& F) {
    LAS float* sc = (LAS float*)F.lds;
    LAS float* red = (LAS float*)(F.lds + 9 * 1024 * 4);
    float* MOD = WSP(float, WS_MOD);
    bool have = false;
    for (int it = F.bid; it < 2 * 96; it += F.G) {
        if (!have) {
            for (int i = F.tid; i < 9 * 1024; i += NTHREADS) { const int r = i >> 10, k = i & 1023; const float v = r < 8 ? P.c[r * 1024 + k] : P.c_ctx[k]; sc[i] = v * sigmoidf_(v); }
            have = true;
        }
        __syncthreads();
        const int l = it / 96, j0 = (it % 96) * 64, jj = F.tid & 63, kc = F.tid >> 6;
        const float* W = P.ada_w + (size_t)l * 1024 * 6144 + j0 + jj;
        float a[9];
#pragma unroll
        for (int r = 0; r < 9; ++r) a[r] = 0.f;
#pragma unroll 8
        for (int k = kc * 128; k < kc * 128 + 128; ++k) { const float w = W[(size_t)k * 6144];
#pragma unroll
            for (int r = 0; r < 9; ++r) a[r] += sc[r * 1024 + k] * w; }
#pragma unroll
        for (int r = 0; r < 9; ++r) red[(kc * 9 + r) * 64 + jj] = a[r];
        __syncthreads();
        for (int o = F.tid; o < 9 * 64; o += NTHREADS) { const int r = o >> 6, j = o & 63; float s = 0.f;
#pragma unroll
            for (int q = 0; q < 8; ++q) s += red[(q * 9 + r) * 64 + j];
            MOD[((size_t)l * 9 + r) * 6144 + j0 + j] = s + P.ada_b[l * 6144 + j0 + j]; }
    }
    __syncthreads();
}
__device__ __forceinline__ void p_dftgen(Frame& F) {
    LAS float* tab = (LAS float*)F.lds;
    for (int j = F.tid; j < 4096; j += NTHREADS) tab[j] = cospif((float)j * (1.0f / 2048.0f));
    __syncthreads();
    bf16* DM_ = WSP(bf16, WS_DFTM); bf16* DC_ = WSP(bf16, WS_DFTC);
    const int nchunk = 4096 * 1024 + 256 * 64;
    for (int ch = F.bid * NTHREADS + F.tid; ch < nchunk; ch += F.G * NTHREADS) {
        float v[8]; bf16* dst;
        if (ch < 4096 * 1024) { const int kf = ch >> 10, col0 = (ch & 1023) * 8, cs = col0 >> 12, l0 = col0 & 4095;
#pragma unroll
            for (int i = 0; i < 8; ++i) { const int j = (kf * (l0 + i)) & 4095; v[i] = cs ? -tab[(j + 3072) & 4095] : tab[j]; }
            dst = DM_ + (size_t)kf * 8192 + col0; }
        else { const int c2 = ch - 4096 * 1024, kf = c2 >> 6, col0 = (c2 & 63) * 8, cs = col0 >> 8, l0 = col0 & 255;
#pragma unroll
            for (int i = 0; i < 8; ++i) { const int j = ((kf * (l0 + i)) & 255) * 16; v[i] = cs ? -tab[(j + 3072) & 4095] : tab[j]; }
            dst = DC_ + (size_t)kf * 512 + col0; }
        u32x4 o; o.x = pk2(v[0], v[1]); o.y = pk2(v[2], v[3]); o.z = pk2(v[4], v[5]); o.w = pk2(v[6], v[7]);
        *(u32x4*)dst = o;
    }
    __syncthreads();
}
__device__ __forceinline__ void transpose_item(const float* W, int ldw, int k0, int n0, bf16* WT, int ldt, int drow0, LAS float* scr, int lane) {
    f32x4 ld[8];
#pragma unroll
    for (int i = 0; i < 8; ++i) ld[i] = *(const f32x4*)(W + (size_t)(k0 + 8 * i + (lane >> 3)) * ldw + n0 + 4 * (lane & 7));
#pragma unroll
    for (int i = 0; i < 8; ++i) { LAS float* d = scr + (8 * i + (lane >> 3)) * 33 + 4 * (lane & 7); d[0] = ld[i][0]; d[1] = ld[i][1]; d[2] = ld[i][2]; d[3] = ld[i][3]; }
    LDS_WAIT(); asm volatile("" ::: "memory");
    const int c = lane & 7;
#pragma unroll
    for (int j = 0; j < 4; ++j) { const int n = (lane >> 3) + 8 * j; const LAS float* s = scr + (8 * c) * 33 + n;
        u32x4 o; o.x = pk2(s[0 * 33], s[1 * 33]); o.y = pk2(s[2 * 33], s[3 * 33]); o.z = pk2(s[4 * 33], s[5 * 33]); o.w = pk2(s[6 * 33], s[7 * 33]);
        *(u32x4*)(WT + (size_t)(drow0 + n) * ldt + k0 + 8 * c) = o; }
    LDS_WAIT(); asm volatile("" ::: "memory");
}
__device__ __forceinline__ void p_wconv(const Params& P, Frame& F, int l) {
    LAS float* scr = (LAS float*)(F.lds + F.wave * 16384);
    const int gw = F.bid * NWAVES + F.wave, NGW = F.G * NWAVES;
    const float* w_in = P.w_in + (size_t)l * 1024 * INW;
    bf16* WA = WSP(bf16, WS_WA); bf16* WFV = WSP(bf16, WS_WFV);
    constexpr int I_K = 16 * 32, I_Q = 16 * 32, I_P = 16 * 16, I_G = 16 * 96, I_V = 16 * 32, I_AO = 16 * 32, I_FO = 8 * 32, I_OUT = 16 * 32;
    constexpr int NSM = I_K + I_Q + I_P + I_G + I_V + I_AO + I_FO + I_OUT;
    for (int it = gw; it < NSM; it += NGW) {
        int r = it;
        if (r < I_K) { transpose_item(w_in, INW, (r / 32) * 64, 0 + (r % 32) * 32, WA, 1024, 0 + (r % 32) * 32, scr, F.lane); continue; } r -= I_K;
        if (r < I_Q) { transpose_item(w_in, INW, (r / 32) * 64, 2048 + (r % 32) * 32, WA, 1024, 1024 + (r % 32) * 32, scr, F.lane); continue; } r -= I_Q;
        if (r < I_P) { transpose_item(w_in, INW, (r / 16) * 64, 3584 + (r % 16) * 32, WA, 1024, 2048 + (r % 16) * 32, scr, F.lane); continue; } r -= I_P;
        if (r < I_G) { transpose_item(w_in, INW, (r / 96) * 64, 4096 + (r % 96) * 32, WA, 1024, 2560 + (r % 96) * 32, scr, F.lane); continue; } r -= I_G;
        if (r < I_V) { transpose_item(w_in, INW, (r / 32) * 64, 1024 + (r % 32) * 32, WFV, 1024, 1024 + (r % 32) * 32, scr, F.lane); continue; } r -= I_V;
        if (r < I_AO) { transpose_item(P.w_att_o + (size_t)l * 1024 * 1024, 1024, (r / 32) * 64, (r % 32) * 32, WSP(bf16, WS_WAO), 1024, (r % 32) * 32, scr, F.lane); continue; } r -= I_AO;
        if (r < I_FO) { transpose_item(P.w_fourier + (size_t)l * 512 * 1024, 1024, (r / 32) * 64, (r % 32) * 32, WSP(bf16, WS_WFO), 512, (r % 32) * 32, scr, F.lane); continue; } r -= I_FO;
        transpose_item(P.w_out + (size_t)l * 1024 * 1024, 1024, (r / 32) * 64, (r % 32) * 32, WSP(bf16, WS_WOUT), 1024, (r % 32) * 32, scr, F.lane);
    }
    constexpr int I_E = 16 * 88;
    bf16* WGU = WSP(bf16, WS_WGU); bf16* WD = WSP(bf16, WS_WD);
    for (int it = gw; it < 3 * 16 * I_E; it += NGW) {
        const int which = it / (16 * I_E), r0 = it % (16 * I_E), e = r0 / I_E, r = r0 % I_E;
        if (which < 2) { const int kb = r / 88, nb = r % 88, n0 = nb * 32;
            const float* src = (which == 0 ? P.w_eg : P.w_eu) + ((size_t)l * 16 + e) * 1024 * FF;
            transpose_item(src, FF, kb * 64, n0, WGU + (size_t)e * 5632 * 1024, 1024, (n0 >> 7) * 256 + (which ? 128 : 0) + (n0 & 127), scr, F.lane); }
        else { const int kb = r / 32, nb = r % 32;
            transpose_item(P.w_ed + ((size_t)l * 16 + e) * FF * 1024, 1024, kb * 64, nb * 32, WD + (size_t)e * 1024 * FF, FF, nb * 32, scr, F.lane); }
    }
    { bf16* WPO = WSP(bf16, WS_WPO); const float* wp = P.w_pool + (size_t)l * 4 * 128 * 256;
      for (int i = F.bid * NTHREADS + F.tid; i < 1024 * 256; i += F.G * NTHREADS) { const int n = i >> 8, kk = i & 255, g = n >> 8, f = n & 255;
          WPO[i] = (bf16)(((kk >> 7) == (g & 1)) ? f2bf(wp[((size_t)g * 128 + (kk & 127)) * 256 + f]) : 0u); } }
    { LAS float* t128 = (LAS float*)F.lds;
      __syncthreads();
      for (int j = F.tid; j < 128; j += NTHREADS) t128[j] = cospif((float)j * (1.0f / 64.0f));
      __syncthreads();
      for (int i = F.bid * NTHREADS + F.tid; i < 1024 * 1024; i += F.G * NTHREADS) { const int fc = i >> 10, k = i & 1023, cs = fc & 1, gm = fc >> 1, g = gm >> 7, m = gm & 127;
          const float* src = w_in + (size_t)k * INW + 3072 + g * 128; float s = 0.f; const int ph = cs ? 96 : 0;
          for (int c = 0; c < 128; ++c) s += src[c] * t128[(m * c + ph) & 127];
          WFV[i] = (bf16)f2bf(s); }
      __syncthreads(); }
}

struct RowMod { const float* g; const float* sh; const float* sc; };
__device__ __forceinline__ void row_load(const float* row, int lane, f32x4 (&v)[4]) {
#pragma unroll
    for (int j = 0; j < 4; ++j) v[j] = *(const f32x4*)(row + 4 * lane + 256 * j);
}
__device__ __forceinline__ float row_rstd(const f32x4 (&v)[4]) {
    float s = 0.f;
#pragma unroll
    for (int j = 0; j < 4; ++j) s += (v[j][0] * v[j][0] + v[j][1] * v[j][1]) + (v[j][2] * v[j][2] + v[j][3] * v[j][3]);
    return rsqrtf(wave_sum(s) * (1.0f / 1024.0f) + RMS_EPS);
}
__device__ __forceinline__ void row_modulate(const f32x4 (&v)[4], float rstd, const RowMod& M, int lane, f32x4 (&y)[4]) {
#pragma unroll
    for (int j = 0; j < 4; ++j) { const int k = 4 * lane + 256 * j; const f32x4 g = *(const f32x4*)(M.g + k), sh = *(const f32x4*)(M.sh + k), sc = *(const f32x4*)(M.sc + k);
        y[j] = v[j] * rstd * g * (sc + 1.0f) + sh; }
}
__device__ __forceinline__ void row_store_bf(bf16* row, int lane, const f32x4 (&y)[4]) {
#pragma unroll
    for (int j = 0; j < 4; ++j) st_bf4(row + 4 * lane + 256 * j, y[j]);
}
__device__ __forceinline__ const float* mod_ptr(Frame& F, int l, int row, int which) { const int mr = row < RL ? (row >> 12) : 8; return WSP(float, WS_MOD) + ((size_t)l * 9 + mr) * 6144 + which * 1024; }

__device__ __forceinline__ void p_rowpass_a0(const Params& P, Frame& F) {
    const int gw = F.bid * NWAVES + F.wave, NGW = F.G * NWAVES; bf16* H = WSP(bf16, WS_H);
    for (int row = gw; row < RT; row += NGW) {
        const float* src = row < RL ? P.x + (size_t)row * DM : P.ctx + (size_t)(row - RL) * DM;
        f32x4 v[4], y[4]; row_load(src, F.lane, v); const float rs = row_rstd(v);
        RowMod M{P.norm1_g, mod_ptr(F, 0, row, 0), mod_ptr(F, 0, row, 1)};
        row_modulate(v, rs, M, F.lane, y); row_store_bf(H + (size_t)row * DM, F.lane, y);
    }
}
__device__ __forceinline__ void p_rowpass_f(const Params& P, Frame& F, int l, int nrows) {
    const int gw = F.bid * NWAVES + F.wave, NGW = F.G * NWAVES; bf16* H = WSP(bf16, WS_H); float* AFF = WSP(float, WS_AFF);
    const float* wr = P.w_router + (size_t)l * 1024 * 16;
    LAS float* wl = (LAS float*)F.lds;
    __syncthreads();
    for (int i = F.tid; i < 16384; i += NTHREADS) wl[(i & 15) * 1024 + (i >> 4)] = wr[i];
    __syncthreads();
    for (int row = gw; row < nrows; row += NGW) {
        const float* src = row < RL ? P.out + (size_t)row * DM : WSP(float, WS_XC) + (size_t)(row - RL) * DM;
        f32x4 v[4], y[4]; row_load(src, F.lane, v); const float rs = row_rstd(v);
        RowMod M{P.norm2_g + l * 1024, mod_ptr(F, l, row, 3), mod_ptr(F, l, row, 4)};
        row_modulate(v, rs, M, F.lane, y); row_store_bf(H + (size_t)row * DM, F.lane, y);
        float lg[16];
        int wo = 4 * F.lane; asm volatile("" : "+v"(wo));
#pragma unroll
        for (int e = 0; e < 16; ++e) { float a = 0.f;
#pragma unroll
            for (int j = 0; j < 4; ++j) { const f32x4 w = *(const LAS f32x4*)(wl + e * 1024 + wo + 256 * j); a += (y[j][0] * w[0] + y[j][1] * w[1]) + (y[j][2] * w[2] + y[j][3] * w[3]); }
            lg[e] = a; }
        float mx = -1e30f;
#pragma unroll
        for (int e = 0; e < 16; ++e) { lg[e] = wave_sum(lg[e]); mx = fmaxf(mx, lg[e]); }
        float den = 0.f;
#pragma unroll
        for (int e = 0; e < 16; ++e) { lg[e] = __expf(lg[e] - mx); den += lg[e]; }
        const float inv = 1.0f / den;
        if (F.lane < 16) { float mine = 0.f;
#pragma unroll
            for (int e = 0; e < 16; ++e) mine = (F.lane == e) ? lg[e] : mine;
            AFF[(size_t)row * 16 + F.lane] = mine * inv; }
    }
    __syncthreads();
}
__device__ __forceinline__ void p_rowpass_k(const Params& P, Frame& F, int l, int nrows) {
    const int gw = F.bid * NWAVES + F.wave, NGW = F.G * NWAVES; bf16* H = WSP(bf16, WS_H);
    const int* SEL = WSP(int, WS_SEL); const bf16* Y = WSP(bf16, WS_Y);
    for (int row = gw; row < nrows; row += NGW) {
        float* xr = row < RL ? P.out + (size_t)row * DM : WSP(float, WS_XC) + (size_t)(row - RL) * DM;
        f32x4 v[4], a[4]; row_load(xr, F.lane, v);
#pragma unroll
        for (int j = 0; j < 4; ++j) a[j] = (f32x4){0.f, 0.f, 0.f, 0.f};
        for (int e = 0; e < 16; ++e) { const int s = SEL[(size_t)row * 16 + e];
            if (s >= 0) { const bf16* yr = Y + (size_t)s * DM;
#pragma unroll
                for (int j = 0; j < 4; ++j) { const u32x2 w = *(const u32x2*)(yr + 4 * F.lane + 256 * j); a[j][0] += bflo(w.x); a[j][1] += bfhi(w.x); a[j][2] += bflo(w.y); a[j][3] += bfhi(w.y); } } }
        const float* g2 = mod_ptr(F, l, row, 5);
#pragma unroll
        for (int j = 0; j < 4; ++j) { const f32x4 g = *(const f32x4*)(g2 + 4 * F.lane + 256 * j); v[j] = v[j] + g * a[j]; }
        const float rs = row_rstd(v);
        if (l == 0) {
#pragma unroll
            for (int j = 0; j < 4; ++j) *(f32x4*)(xr + 4 * F.lane + 256 * j) = v[j];
            f32x4 y[4]; RowMod M{P.norm1_g + 1024, mod_ptr(F, 1, row, 0), mod_ptr(F, 1, row, 1)};
            row_modulate(v, rs, M, F.lane, y); row_store_bf(H + (size_t)row * DM, F.lane, y);
        } else {
#pragma unroll
            for (int j = 0; j < 4; ++j) { const f32x4 g = *(const f32x4*)(P.final_g + 4 * F.lane + 256 * j); *(f32x4*)(xr + 4 * F.lane + 256 * j) = v[j] * rs * g; }
        }
    }
}

__device__ __forceinline__ float dot64(const bf16x8 (&q)[8], const bf16* kp) {
    float s = 0.f;
#pragma unroll
    for (int i = 0; i < 8; ++i) { const u32x4 kw = *(const u32x4*)(kp + 8 * i); const u32x4 qw = __builtin_bit_cast(u32x4, q[i]);
#pragma unroll
        for (int t = 0; t < 4; ++t) s += bflo(kw[t]) * bflo(qw[t]) + bfhi(kw[t]) * bfhi(qw[t]); }
    return s;
}
__device__ __forceinline__ void p_attn_naive(const Params& P, Frame& F, int l, bool with_ctx_queries) {
    const int gw = F.bid * NWAVES + F.wave, NGW = F.G * NWAVES;
    const bf16* KQ = WSP(bf16, WS_KQ); const bf16* VT = WSP(bf16, WS_VT); bf16* ATT = WSP(bf16, WS_ATT);
    LAS float* pw = (LAS float*)(F.lds + F.wave * 2048);
    const float* rpb = P.rpb + (size_t)l * 16 * 15 * 31;
    const int nlat = NB * 64 * NH * 64, nitems = nlat + (with_ctx_queries ? NB * NH * CTXL : 0);
    for (int it = gw; it < nitems; it += NGW) {
        const bool lat = it < nlat;
        int b, h, r = 0, qc = 0, rowq;
        if (lat) { qc = it & 63; h = (it >> 6) & 15; r = (it >> 10) & 63; b = it >> 16; rowq = b * SEQ + r * 64 + qc; }
        else { const int i2 = it - nlat; qc = i2 & 255; h = (i2 >> 8) & 15; b = i2 >> 12; rowq = RL + b * CTXL + qc; }
        bf16x8 q[8];
        { const bf16* qp = KQ + (size_t)rowq * 2048 + 1024 + h * 64;
#pragma unroll
          for (int i = 0; i < 8; ++i) q[i] = *(const bf16x8*)(qp + 8 * i); }
        const int rs = min(max(r - 4, 0), 56), cs = min(max(qc - 8, 0), 48);
        float s[6];
        if (lat) {
#pragma unroll
            for (int t = 0; t < 2; ++t) { const int w = F.lane + 64 * t, i = w >> 4, j = w & 15; const int tok = (rs + i) * 64 + cs + j;
                s[t] = dot64(q, KQ + (size_t)(b * SEQ + tok) * 2048 + h * 64) * 0.125f + rpb[(h * 15 + (rs + i - r + 7)) * 31 + (cs + j - qc + 15)]; }
        } else { s[0] = -1e30f; s[1] = -1e30f; }
#pragma unroll
        for (int t = 0; t < 4; ++t) { const int c = F.lane + 64 * t; s[2 + t] = dot64(q, KQ + (size_t)(RL + b * CTXL + c) * 2048 + h * 64) * 0.125f; }
        float mx = s[0];
#pragma unroll
        for (int t = 1; t < 6; ++t) mx = fmaxf(mx, s[t]);
        mx = wave_max(mx);
        float sum = 0.f;
#pragma unroll
        for (int t = 0; t < 6; ++t) { s[t] = (lat || t >= 2) ? __expf(s[t] - mx) : 0.f; sum += s[t]; }
        sum = wave_sum(sum);
        pw[F.lane] = s[0]; pw[F.lane + 64] = s[1];
#pragma unroll
        for (int t = 0; t < 4; ++t) pw[128 + F.lane + 64 * t] = s[2 + t];
        LDS_WAIT(); asm volatile("" ::: "memory");
        float o = 0.f;
        if (lat) { const bf16* vr = VT + ((size_t)b * 1024 + h * 64 + F.lane) * 4096;
#pragma unroll 2
            for (int w = 0; w < 128; ++w) { const int tok = (rs + (w >> 4)) * 64 + cs + (w & 15); o += pw[w] * bf2f(vr[tok]); } }
        { const bf16* vr = VT + YT_CTX_OFF + ((size_t)b * 1024 + h * 64 + F.lane) * 256;
#pragma unroll 2
          for (int c8 = 0; c8 < 32; ++c8) { const u32x4 vw = *(const u32x4*)(vr + 8 * c8); const LAS float* pp = pw + 128 + 8 * c8;
#pragma unroll
              for (int t = 0; t < 4; ++t) o += pp[2 * t] * bflo(vw[t]) + pp[2 * t + 1] * bfhi(vw[t]); } }
        ATT[(size_t)rowq * 1024 + h * 64 + F.lane] = (bf16)f2bf(o / sum);
        LDS_WAIT(); asm volatile("" ::: "memory");
    }
}

constexpr int ACK_STRIDE = 72, ACV_STRIDE = 264;
constexpr int ALDS_CK = 0, ALDS_CV = 256 * ACK_STRIDE * 2, ALDS_RP = ALDS_CV + 64 * ACV_STRIDE * 2;
struct AttnState { float m, sum; f32x4 o[4]; };
__device__ __forceinline__ float xrow16_max(float x) {
    auto s = __builtin_amdgcn_permlane16_swap(__float_as_uint(x), __float_as_uint(x), false, false);
    x = fmaxf(__uint_as_float(s[0]), __uint_as_float(s[1]));
    auto t = __builtin_amdgcn_permlane32_swap(__float_as_uint(x), __float_as_uint(x), false, false);
    return fmaxf(__uint_as_float(t[0]), __uint_as_float(t[1]));
}
__device__ __forceinline__ float xrow16_sum(float x) {
    auto s = __builtin_amdgcn_permlane16_swap(__float_as_uint(x), __float_as_uint(x), false, false);
    x = __uint_as_float(s[0]) + __uint_as_float(s[1]);
    auto t = __builtin_amdgcn_permlane32_swap(__float_as_uint(x), __float_as_uint(x), false, false);
    return __uint_as_float(t[0]) + __uint_as_float(t[1]);
}
#define MFMA16(a, b, c) __builtin_amdgcn_mfma_f32_16x16x32_bf16((a), (b), (c), 0, 0, 0)
template <int NT>
__device__ __forceinline__ void attn_tail(AttnState& S, f32x4 (&sc)[NT], const u32x4 (&vw)[NT / 2][4]) {
    float cm = -1e30f;
#pragma unroll
    for (int t = 0; t < NT; ++t)
#pragma unroll
        for (int j = 0; j < 4; ++j) cm = fmaxf(cm, sc[t][j]);
    cm = xrow16_max(cm);
    const float mn = fmaxf(S.m, cm), scl = __builtin_amdgcn_exp2f(S.m - mn); S.m = mn; float ps = 0.f;
#pragma unroll
    for (int t = 0; t < NT; ++t)
#pragma unroll
        for (int j = 0; j < 4; ++j) { const float p = __builtin_amdgcn_exp2f(sc[t][j] - mn); sc[t][j] = p; ps += p; }
    S.sum = S.sum * scl + ps;
#pragma unroll
    for (int dt = 0; dt < 4; ++dt) S.o[dt] = S.o[dt] * scl;
#pragma unroll
    for (int ks = 0; ks < NT / 2; ++ks) { u32x4 pw; pw.x = pk2(sc[2 * ks][0], sc[2 * ks][1]); pw.y = pk2(sc[2 * ks][2], sc[2 * ks][3]); pw.z = pk2(sc[2 * ks + 1][0], sc[2 * ks + 1][1]); pw.w = pk2(sc[2 * ks + 1][2], sc[2 * ks + 1][3]);
        const bf16x8 pf = __builtin_bit_cast(bf16x8, pw);
#pragma unroll
        for (int dt = 0; dt < 4; ++dt) S.o[dt] = MFMA16(__builtin_bit_cast(bf16x8, vw[ks][dt]), pf, S.o[dt]); }
}
__device__ __forceinline__ void attn_unit2(const bf16* __restrict__ KQ, const bf16* __restrict__ VT, bf16* __restrict__ ATT, LAS unsigned char* lds,
                                           const int b, const int h, const int rowqA, const int rowqB, const bool win, const int r, const int qt, const int lane) {
    const int l15 = lane & 15, g = lane >> 4;
    const f32x4 z = {0.f, 0.f, 0.f, 0.f};
    bf16x8 qA[2], qB[2];
    { const bf16* qp = KQ + (size_t)(rowqA + l15) * 2048 + 1024 + h * 64 + 8 * g; qA[0] = *(const bf16x8*)qp; qA[1] = *(const bf16x8*)(qp + 32); }
    { const bf16* qp = KQ + (size_t)(rowqB + l15) * 2048 + 1024 + h * 64 + 8 * g; qB[0] = *(const bf16x8*)qp; qB[1] = *(const bf16x8*)(qp + 32); }
    AttnState SA, SB; SA.m = -1e30f; SA.sum = 0.f; SB.m = -1e30f; SB.sum = 0.f;
#pragma unroll
    for (int dt = 0; dt < 4; ++dt) { SA.o[dt] = z; SB.o[dt] = z; }
    if (win) {
        const int rsA = min(max(r - 4, 0), 56), dB = min(max(r - 3, 0), 56) - rsA, kc0 = min(max(16 * qt - 8, 0), 32);
        const int q = 16 * qt + l15, csq = min(max(q - 8, 0), 48);
        const int krow0 = 8 * (l15 >> 2) + (l15 & 3);
        const bf16* kb = KQ + (size_t)(b * SEQ + kc0 + krow0) * 2048 + h * 64 + 8 * g;
        const bf16* vb = VT + (size_t)(b * 1024 + h * 64 + l15) * 4096 + kc0 + 8 * g;
        const LAS float* rp = (const LAS float*)(lds + ALDS_RP);
        const int jb = kc0 + 8 * g;
        const int okb = jb - csq;
        const LAS float* rpl = rp + 16 + (jb - q + 15);
        float madd[2][4];
#pragma unroll
        for (int t = 0; t < 2; ++t)
#pragma unroll
            for (int j = 0; j < 4; ++j) madd[t][j] = ((unsigned)(okb + 4 * t + j) < 16u) ? 0.f : -__builtin_inff();
        bf16x8 K0[2][2], K1[2][2]; u32x4 V0[1][4], V1[1][4];
#define ATT_LOADW(KB, VB, i) do { const int gr_ = min(rsA + (i), 63); const bf16* kp_ = kb + (size_t)(gr_ * 64) * 2048; const bf16* vp_ = vb + gr_ * 64; \
        _Pragma("unroll") for (int t = 0; t < 2; ++t) { KB[t][0] = *(const bf16x8*)(kp_ + (size_t)(4 * t) * 2048); KB[t][1] = *(const bf16x8*)(kp_ + (size_t)(4 * t) * 2048 + 32); } \
        _Pragma("unroll") for (int dt = 0; dt < 4; ++dt) VB[0][dt] = *(const u32x4*)(vp_ + (size_t)(16 * dt) * 4096); } while (0)
#define ATT_ONE(ST, QF, KB, VB, roff, rowok) do { f32x4 sc[2]; \
        _Pragma("unroll") for (int t = 0; t < 2; ++t) { sc[t] = MFMA16(KB[t][0], QF[0], z); sc[t] = MFMA16(KB[t][1], QF[1], sc[t]); } \
        const LAS float* bp_ = rpl + ((rowok) ? (roff) : 15) * 64; \
        _Pragma("unroll") for (int t = 0; t < 2; ++t) _Pragma("unroll") for (int j = 0; j < 4; ++j) sc[t][j] = (sc[t][j] + bp_[4 * t + j]) + madd[t][j]; \
        attn_tail<2>(ST, sc, VB); } while (0)
#define ATT_COMPUTE(KB, VB, i) do { const int roffA_ = min(rsA + (i) - r + 7, 14); \
        ATT_ONE(SA, qA, KB, VB, roffA_, (i) <= 7); \
        ATT_ONE(SB, qB, KB, VB, max(roffA_ - 1, 0), (i) >= dB && (i) <= 7 + dB); } while (0)
        ATT_LOADW(K0, V0, 0);
#pragma unroll 1
        for (int i = 0; i < 8; i += 2) { ATT_LOADW(K1, V1, i + 1); ATT_COMPUTE(K0, V0, i); ATT_LOADW(K0, V0, i + 2); ATT_COMPUTE(K1, V1, i + 1); }
        ATT_COMPUTE(K0, V0, 8);
#undef ATT_LOADW
#undef ATT_ONE
#undef ATT_COMPUTE
    }
    { const LAS bf16* ck = (const LAS bf16*)(lds + ALDS_CK) + l15 * ACK_STRIDE + 8 * g;
      const LAS bf16* cv = (const LAS bf16*)(lds + ALDS_CV) + l15 * ACV_STRIDE + 8 * g;
#pragma unroll 1
      for (int c = 0; c < 4; ++c) {
          bf16x8 kf[4][2]; u32x4 vw[2][4];
#pragma unroll
          for (int t = 0; t < 4; ++t) { const LAS bf16* kp = ck + (64 * c + 16 * t) * ACK_STRIDE; kf[t][0] = *(const LAS bf16x8*)kp; kf[t][1] = *(const LAS bf16x8*)(kp + 32); }
#pragma unroll
          for (int ks = 0; ks < 2; ++ks)
#pragma unroll
              for (int dt = 0; dt < 4; ++dt) vw[ks][dt] = *(const LAS u32x4*)(cv + (16 * dt) * ACV_STRIDE + 64 * c + 32 * ks);
          { f32x4 sc[4];
#pragma unroll
            for (int t = 0; t < 4; ++t) { sc[t] = MFMA16(kf[t][0], qA[0], z); sc[t] = MFMA16(kf[t][1], qA[1], sc[t]); }
            attn_tail<4>(SA, sc, vw); }
          { f32x4 sc[4];
#pragma unroll
            for (int t = 0; t < 4; ++t) { sc[t] = MFMA16(kf[t][0], qB[0], z); sc[t] = MFMA16(kf[t][1], qB[1], sc[t]); }
            attn_tail<4>(SB, sc, vw); }
      } }
    { const float inv = 1.0f / xrow16_sum(SA.sum);
#pragma unroll
      for (int dt = 0; dt < 4; ++dt) st_bf4(ATT + (size_t)(rowqA + l15) * 1024 + h * 64 + 16 * dt + 4 * g, SA.o[dt] * inv); }
    { const float inv = 1.0f / xrow16_sum(SB.sum);
#pragma unroll
      for (int dt = 0; dt < 4; ++dt) st_bf4(ATT + (size_t)(rowqB + l15) * 1024 + h * 64 + 16 * dt + 4 * g, SB.o[dt] * inv); }
}
__device__ __forceinline__ void p_attn_mfma(const Params& P, Frame& F, int l, bool with_ctx_queries) {
    const bf16* KQ = WSP(bf16, WS_KQ); const bf16* VT = WSP(bf16, WS_VT); bf16* ATT = WSP(bf16, WS_ATT);
    const float* rpb = P.rpb + (size_t)l * 16 * 465;
    for (int hp = F.bid; hp < 256; hp += F.G) {
        const int p = hp & 127, half = hp >> 7, b = p >> 4, h = p & 15;
        __syncthreads();
        { LAS bf16* ck = (LAS bf16*)(F.lds + ALDS_CK); LAS bf16* cv = (LAS bf16*)(F.lds + ALDS_CV); LAS float* rp = (LAS float*)(F.lds + ALDS_RP);
          { const int key = F.tid >> 1, hf = F.tid & 1; const int k32 = key & 31, pos = (key & ~31) + ((k32 >> 2) & 1) * 16 + 4 * (k32 >> 3) + (k32 & 3);
            const u32x4* src = (const u32x4*)(KQ + (size_t)(RL + b * CTXL + key) * 2048 + h * 64 + hf * 32); LAS u32x4* dst = (LAS u32x4*)(ck + pos * ACK_STRIDE + hf * 32);
#pragma unroll
            for (int i = 0; i < 4; ++i) dst[i] = src[i]; }
          { const int d = F.tid >> 3, sg = F.tid & 7; const u32x4* src = (const u32x4*)(VT + YT_CTX_OFF + (size_t)(b * 1024 + h * 64 + d) * 256 + sg * 32); LAS u32x4* dst = (LAS u32x4*)(cv + d * ACV_STRIDE + sg * 32);
#pragma unroll
            for (int i = 0; i < 4; ++i) dst[i] = src[i]; }
          for (int i = F.tid; i < 16 * 64; i += NTHREADS) { const int rr = i >> 6, cc = (i & 63) - 16; rp[i] = rr == 15 ? -__builtin_inff() : ((cc >= 0 && cc < 31) ? rpb[h * 465 + rr * 31 + cc] * LOG2E : 0.f); } }
        __syncthreads();
        const int qt = F.wave & 3, rpi = F.wave >> 2;
#pragma unroll 1
        for (int st = 0; st < 8; ++st) { const int r = half * 32 + st * 4 + rpi * 2; const int rowqA = b * SEQ + r * 64 + 16 * qt;
            attn_unit2(KQ, VT, ATT, F.lds, b, h, rowqA, rowqA + 64, true, r, qt, F.lane); }
        if (with_ctx_queries && half == 0) { const int rowqA = RL + b * CTXL + 32 * F.wave; attn_unit2(KQ, VT, ATT, F.lds, b, h, rowqA, rowqA + 16, false, 0, 0, F.lane); }
    }
    __syncthreads();
}

__device__ __forceinline__ void ld8(const bf16* p, float (&x)[8]) { const u32x4 w = *(const u32x4*)p;
#pragma unroll
    for (int q = 0; q < 4; ++q) { x[2 * q] = bflo(w[q]); x[2 * q + 1] = bfhi(w[q]); } }
__device__ __forceinline__ void p_pool(Frame& F, int nrows) {
    const bf16* PB = WSP(bf16, WS_PB); bf16* POOL = WSP(bf16, WS_POOL);
    for (int i = F.bid * NTHREADS + F.tid; i < (nrows >> 4) * 64; i += F.G * NTHREADS) {
        const int row0 = (i >> 6) << 4, ch = i & 63, g = ch >> 4, hw = 1 << g;
        int base, t0, Lb; if (row0 < RL) { base = row0 & ~4095; t0 = row0 & 4095; Lb = SEQ; } else { const int rr = row0 - RL; base = RL + (rr & ~255); t0 = rr & 255; Lb = CTXL; }
        const bf16* src = PB + (size_t)base * 512 + ch * 8;
        float S[8];
#pragma unroll
        for (int q = 0; q < 8; ++q) S[q] = 0.f;
#pragma unroll 4
        for (int d = -8; d < 8; ++d) { const int tt = t0 + d; if (d >= -hw && d < hw && tt >= 0 && tt < Lb) { float x[8]; ld8(src + (size_t)tt * 512, x);
#pragma unroll
                for (int q = 0; q < 8; ++q) S[q] += x[q]; } }
#pragma unroll 2
        for (int j = 0; j < 16; ++j) { const int t = t0 + j; const int lo = max(t - hw, 0), hi = min(t + hw, Lb); const float inv = 1.0f / (float)(hi - lo);
            float me[8]; ld8(src + (size_t)t * 512, me);
            u32x4 o;
#pragma unroll
            for (int q = 0; q < 4; ++q) o[q] = pk2(S[2 * q] * inv - me[2 * q], S[2 * q + 1] * inv - me[2 * q + 1]);
            *(u32x4*)(POOL + (size_t)(base + t) * 512 + ch * 8) = o;
            if (t + hw < Lb) { float x[8]; ld8(src + (size_t)(t + hw) * 512, x);
#pragma unroll
                for (int q = 0; q < 8; ++q) S[q] += x[q]; }
            if (t - hw >= 0) { float x[8]; ld8(src + (size_t)(t - hw) * 512, x);
#pragma unroll
                for (int q = 0; q < 8; ++q) S[q] -= x[q]; } }
    }
}

__device__ __forceinline__ int block_sum_i(int v, LAS int* sm, int tid) {
    v = wave_sum_i(v);
    __syncthreads();
    if ((tid & 63) == 0) sm[tid >> 6] = v;
    __syncthreads();
    int s = 0;
#pragma unroll
    for (int i = 0; i < 8; ++i) s += sm[i];
    return s;
}
__device__ __forceinline__ int block_excl_scan(int v, LAS int* sm, int tid, int& total) {
    const int lane = tid & 63, w = tid >> 6; int inc = v;
#pragma unroll
    for (int o = 1; o < 64; o <<= 1) { const int t = __builtin_amdgcn_ds_bpermute(((lane - o) & 63) << 2, inc); if (lane >= o) inc += t; }
    __syncthreads();
    if (lane == 63) sm[w] = inc;
    __syncthreads();
    int base = 0; total = 0;
#pragma unroll
    for (int i = 0; i < 8; ++i) { const int s = sm[i]; if (i < w) base += s; total += s; }
    return base + inc - v;
}
template <int NPT>
__device__ __forceinline__ void topk_pair(Frame& F, int row0, int n, int cap, int e, int slot0) {
    LAS int* sm = (LAS int*)F.lds;
    const float* AFF = WSP(float, WS_AFF); int* SROW = WSP(int, WS_SROW); float* SG = WSP(float, WS_SGATE); int* SEL = WSP(int, WS_SEL);
    unsigned key[NPT];
#pragma unroll
    for (int j = 0; j < NPT; ++j) { const int i = F.tid * NPT + j; key[j] = (i < n) ? __float_as_uint(AFF[(size_t)(row0 + i) * 16 + e]) : 0u; }
    unsigned T = 0u;
    for (int bit = 30; bit >= 0; --bit) { const unsigned cand = T | (1u << bit); int cnt = 0;
#pragma unroll
        for (int j = 0; j < NPT; ++j) cnt += (key[j] >= cand) ? 1 : 0;
        cnt = block_sum_i(cnt, sm, F.tid);
        if (cnt >= cap) T = cand; }
    int ngt = 0, neq = 0;
#pragma unroll
    for (int j = 0; j < NPT; ++j) { ngt += (key[j] > T) ? 1 : 0; neq += (key[j] == T) ? 1 : 0; }
    int tot_gt, tot_eq;
    (void)block_excl_scan(ngt, sm, F.tid, tot_gt);
    int eqr = block_excl_scan(neq, sm, F.tid, tot_eq);
    const int need_eq = cap - tot_gt;
    int nsel = 0; bool selj[NPT];
#pragma unroll
    for (int j = 0; j < NPT; ++j) { bool s = key[j] > T; if (key[j] == T && T != 0u) { s = eqr < need_eq; ++eqr; } selj[j] = s; nsel += s ? 1 : 0; }
    int tot_sel; int pos = block_excl_scan(nsel, sm, F.tid, tot_sel);
#pragma unroll
    for (int j = 0; j < NPT; ++j) { const int i = F.tid * NPT + j;
        if (i < n) { const int row = row0 + i;
            if (selj[j]) { const int slot = slot0 + pos; ++pos; SROW[slot] = row; SG[slot] = __uint_as_float(key[j]); SEL[(size_t)row * 16 + e] = slot; }
            else SEL[(size_t)row * 16 + e] = -1; } }
    __syncthreads();
}
__device__ __forceinline__ void p_topk(Frame& F, bool with_ctx) {
    const int npairs = 128 + (with_ctx ? 128 : 0);
    for (int pi = F.bid; pi < npairs; pi += F.G) {
        if (pi < 128) { const int b = pi >> 4, e = pi & 15; topk_pair<8>(F, b * SEQ, SEQ, CAPL, e, e * SLOT_E + b * CAPL); }
        else { const int p2 = pi - 128, b = p2 >> 4, e = p2 & 15; topk_pair<1>(F, RL + b * CTXL, CTXL, CAPC, e, e * SLOT_E + 4096 + b * CAPC); }
    }
}
__device__ __forceinline__ void p_gather(Frame& F, bool with_ctx) {
    const int gw = F.bid * NWAVES + F.wave, NGW = F.G * NWAVES; const bf16* H = WSP(bf16, WS_H); bf16* XG = WSP(bf16, WS_XG); const int* SROW = WSP(int, WS_SROW);
    for (int s = gw; s < NSLOT; s += NGW) { if (!with_ctx && (s % SLOT_E) >= 4096) continue;
        const int row = SROW[s]; const u32x4* src = (const u32x4*)(H + (size_t)row * DM); u32x4* dst = (u32x4*)(XG + (size_t)s * DM);
        dst[F.lane] = src[F.lane]; dst[F.lane + 64] = src[F.lane + 64]; }
}

template <int PH> __global__ void __launch_bounds__(NTHREADS, 2) fwd_kernel(Params P) {
    extern __shared__ __attribute__((aligned(16))) unsigned char lds_raw[];
    Frame F; F.lds = (LAS unsigned char*)lds_raw; F.tid = threadIdx.x; F.lane = F.tid & 63; F.wave = __builtin_amdgcn_readfirstlane(F.tid >> 6); F.G = gridDim.x; F.bid = blockIdx.x; F.ws = P.ws;
    const int wave0 = __builtin_amdgcn_readfirstlane((int)threadIdx.x >> 6);
    volatile LAS unsigned* MISC = (volatile LAS unsigned*)(F.lds + LDS_MISC);
    if (F.tid < 64) MISC[F.tid] = 0u;
    __syncthreads();
    XcdBarrier bar; bar.bar = WSP(unsigned, WS_CTL) + CW_BAR; bar.x = 0; bar.st = MISC + 8;
    if constexpr (PH < 0) bar = xcd_barrier_post(WSP(unsigned, WS_CTL) + CW_BAR, MISC + 8);
#define IN(k) (PH < 0 || PH == (k))
#define REFRESH() do { unsigned on_ = ~0u; asm volatile("" : "+s"(on_)); int t_ = wave0 * 64 + (int)__builtin_amdgcn_mbcnt_hi(on_, __builtin_amdgcn_mbcnt_lo(on_, 0u)); asm volatile("" : "+v"(t_)); F.tid = t_; F.lane = t_ & 63; F.wave = __builtin_amdgcn_readfirstlane(t_ >> 6); } while (0)
#define SEAM(k) do { if constexpr (PH < 0) xcd_barrier(bar); } while (0)

    if (IN(0)) { REP_BEGIN(100) p_mod(P, F); p_dftgen(F); REP_END REP_BEGIN(101) p_wconv(P, F, 0); REP_END }
    SEAM(0);
    if (IN(1)) { p_rowpass_a0(P, F); }
    SEAM(1);
    for (int l = P.l_lo; l < P.l_hi; ++l) {
        constexpr int pb = 2; const bool L0 = (l == 0);
        bf16* H = WSP(bf16, WS_H);
        if (IN(pb + 0)) { REFRESH(); REP_BEGIN(2)
            { GroupSched S; S.init(1, 128, 22, F.G, F.bid, 8, L0 ? 22 : 4, 128, 0);
              const bf16* WA = WSP(bf16, WS_WA);
              auto AD = [=](const Unit& u) { return Operands{H + (size_t)u.pm * 256 * DM, WA + (size_t)u.pn * 256 * DM, DM, DM, 0, DM}; };
              bf16* KQ = WSP(bf16, WS_KQ); bf16* PBp = WSP(bf16, WS_PB); bf16* GB = WSP(bf16, WS_GB);
              auto E = [=](EPI_ARGS) { const int row0 = u.pm * 256;
                  if (u.pn < 8) { const float qs = (u.pn >= 4) ? QSCALE : 1.0f; EPI_FOR8( st_bf8(KQ + (size_t)(row0 + r) * 2048 + u.pn * 256 + c, v0 * qs, v1 * qs); ) }
                  else if (u.pn < 10) { EPI_FOR8( st_bf8(PBp + (size_t)(row0 + r) * 512 + (u.pn - 8) * 256 + c, v0, v1); ) }
                  else { EPI_FOR8( f32x4 s0; f32x4 s1; _Pragma("unroll") for (int j = 0; j < 4; ++j) { s0[j] = sigmoidf_(v0[j]); s1[j] = sigmoidf_(v1[j]); } st_bf8(GB + (size_t)(row0 + r) * 3072 + (u.pn - 10) * 256 + c, s0, s1); ) } };
              GEMM_P(S, AD, E); }
            REFRESH();
            { GroupSched S; const int g1a_units = 128 * 22 + 8 * (L0 ? 22 : 4);
              S.init(1, 8, 128, F.G, (F.bid + F.G - ((g1a_units % F.G) & ~7)) % F.G, L0 ? 8 : 4, 8, L0 ? 0 : 4, 128);
              const bf16* WFV = WSP(bf16, WS_WFV);
              auto AD = [=](const Unit& u) { return Operands{WFV + (size_t)u.pm * 256 * DM, H + (size_t)u.pn * 256 * DM, DM, DM, 0, DM}; };
              bf16* YT = WSP(bf16, WS_YT); bf16* VT = WSP(bf16, WS_VT);
              auto E = [=](EPI_ARGS) { bf16* T = (u.pm < 4) ? YT : VT; const int rr0 = (u.pm & 3) * 256;
                  if (u.pn < 128) { const int b = u.pn >> 4, l0 = (u.pn & 15) * 256; EPI_FOR8( st_bf8(T + ((size_t)b * 1024 + rr0 + r) * 4096 + l0 + c, v0, v1); ) }
                  else { const int b = u.pn - 128; EPI_FOR8( st_bf8(T + YT_CTX_OFF + ((size_t)b * 1024 + rr0 + r) * 256 + c, v0, v1); ) } };
              GEMM_P(S, AD, E); }
        REP_END }
        SEAM(pb + 0);
        if (IN(pb + 1)) { REFRESH();
            REP_BEGIN(31) p_attn_mfma(P, F, l, L0); REP_END
            REFRESH();
            REP_BEGIN(32)
            { GroupSched S; S.init(1, 16, 16, F.G, F.bid);
              const bf16* DFTM = WSP(bf16, WS_DFTM); const bf16* YT = WSP(bf16, WS_YT); bf16* FOUR = WSP(bf16, WS_FOUR);
              auto AD = [=](const Unit& u) { return Operands{DFTM + (size_t)u.pm * 256 * 8192, YT + (size_t)u.pn * 256 * 8192, 8192, 8192, 0, 8192}; };
              auto E = [=](EPI_ARGS) { const int b = u.pn >> 1, c0 = (u.pn & 1) * 256; const float sc = 0.0013810679320049757f;
                  EPI_FOR8( st_bf8(FOUR + ((size_t)b * SEQ + u.pm * 256 + r) * 512 + c0 + c, v0 * sc, v1 * sc); ) };
              GEMM_P(S, AD, E); }
            REFRESH();
            if (L0) { GroupSched S; S.init(1, 1, 16, F.G, (F.bid + F.G - 128 % F.G) % F.G);
              const bf16* DFTC = WSP(bf16, WS_DFTC); const bf16* YTC = WSP(bf16, WS_YT) + YT_CTX_OFF; bf16* FOUR = WSP(bf16, WS_FOUR);
              auto AD = [=](const Unit& u) { return Operands{DFTC, YTC + (size_t)u.pn * 256 * 512, 512, 512, 0, 512}; };
              auto E = [=](EPI_ARGS) { const int b = u.pn >> 1, c0 = (u.pn & 1) * 256; const float sc = 0.005524271728019903f;
                  EPI_FOR8( st_bf8(FOUR + ((size_t)RL + b * CTXL + r) * 512 + c0 + c, v0 * sc, v1 * sc); ) };
              GEMM_P(S, AD, E); }
            REP_END
            REFRESH();
            REP_BEGIN(33) p_pool(F, L0 ? RT : RL); REP_END
        }
        SEAM(pb + 1);
        if (IN(pb + 2)) { REFRESH();
            SegSched<3> S; S.base.init(1, L0 ? 136 : 128, 4, F.G, F.bid);
            const bf16* ATT = WSP(bf16, WS_ATT); const bf16* FOUR = WSP(bf16, WS_FOUR); const bf16* POOL = WSP(bf16, WS_POOL);
            const bf16* WAO = WSP(bf16, WS_WAO); const bf16* WFO = WSP(bf16, WS_WFO); const bf16* WPO = WSP(bf16, WS_WPO);
            const bf16* GB = WSP(bf16, WS_GB); bf16* MRGB = WSP(bf16, WS_MRGB); const float* ps = P.pool_scale + l * 1024;
            auto AD = [=](const Unit& u) {
                if (u.seg == 0) return Operands{ATT + (size_t)u.pm * 256 * 1024, WAO + (size_t)u.pn * 256 * 1024, 1024, 1024, 0, 1024};
                if (u.seg == 1) return Operands{FOUR + (size_t)u.pm * 256 * 512, WFO + (size_t)u.pn * 256 * 512, 512, 512, 0, 512};
                return Operands{POOL + (size_t)u.pm * 256 * 512 + (u.pn >> 1) * 256, WPO + (size_t)u.pn * 256 * 256, 512, 256, 0, 256}; };
            auto E = [=](EPI_ARGS) {
                const int kd = u.seg < 2 ? u.seg + 1 : 2; const bool fin = (u.seg == 2); const int colb = u.pn * 256 + wc * 32 + 8 * fq;
#pragma unroll
                for (int ai = 0; ai < 2; ++ai)
#pragma unroll
                    for (int m = 0; m < 4; ++m) { const size_t row = (size_t)u.pm * 256 + ai * 128 + wr * 64 + m * 16 + fr; const bf16* gr = GB + row * 3072 + colb;
                        u32x4 nr[2], dr[2]; f32x4 psv[2][2];
#pragma unroll
                        for (int bj = 0; bj < 2; ++bj) { nr[bj] = *(const u32x4*)(gr + u.seg * 1024 + bj * 128); dr[bj] = *(const u32x4*)(gr + kd * 1024 + bj * 128);
                            psv[bj][0] = *(const f32x4*)(ps + colb + bj * 128); psv[bj][1] = *(const f32x4*)(ps + colb + bj * 128 + 4); }
#pragma unroll
                        for (int bj = 0; bj < 2; ++bj) { f32x4 o[2];
#pragma unroll
                            for (int n = 0; n < 2; ++n) { f32x4 nu = {bflo(nr[bj][2 * n]), bfhi(nr[bj][2 * n]), bflo(nr[bj][2 * n + 1]), bfhi(nr[bj][2 * n + 1])}, de = {bflo(dr[bj][2 * n]), bfhi(dr[bj][2 * n]), bflo(dr[bj][2 * n + 1]), bfhi(dr[bj][2 * n + 1])};
                                if (u.seg == 2) nu = nu * psv[bj][n];
                                de = de * psv[bj][n];
#pragma unroll
                                for (int j = 0; j < 4; ++j) { const float nj = (fabsf(nu[j]) < 1e-30f) ? copysignf(1e-30f, nu[j]) : nu[j]; const float dj = (fabsf(de[j]) < 1e-30f) ? copysignf(1e-30f, de[j]) : de[j];
                                    o[n][j] = acc[ai][bj][m][n][j] * nj * (fin ? 1.0f : __builtin_amdgcn_rcpf(dj)); }
                                acc[ai][bj][m][n] = o[n]; }
                            if (fin) st_bf8(MRGB + row * 1024 + colb + bj * 128, o[0], o[1]); } } };
            gemm_fast<false, true>(F.lds, F.tid, S, AD, mk_epi_seg(E, 2), nullptr);
        }
        SEAM(pb + 2);
        if (IN(pb + 3)) { REFRESH();
            GroupSched S; S.init(1, L0 ? 136 : 128, 4, F.G, F.bid); const bf16* A = WSP(bf16, WS_MRGB); const bf16* W = WSP(bf16, WS_WOUT);
            const float* xin = L0 ? P.x : P.out; const float* cin = L0 ? P.ctx : WSP(float, WS_XC); float* xo = P.out; float* co = WSP(float, WS_XC);
            const float* MOD = WSP(float, WS_MOD) + (size_t)l * 9 * 6144;
            auto AD = [=](const Unit& u) { return Operands{A + (size_t)u.pm * 256 * 1024, W + (size_t)u.pn * 256 * 1024, 1024, 1024, 0, 1024}; };
            auto E = [=](EPI_ARGS) {
                const int row0 = u.pm * 256, mr = row0 < RL ? (row0 >> 12) : 8, colb = u.pn * 256 + wc * 32 + 4 * fq;
                const float* src0 = row0 < RL ? xin + (size_t)row0 * DM : cin + (size_t)(row0 - RL) * DM; float* dst0 = row0 < RL ? xo + (size_t)row0 * DM : co + (size_t)(row0 - RL) * DM;
                f32x4 gv[2][2];
#pragma unroll
                for (int bj = 0; bj < 2; ++bj)
#pragma unroll
                    for (int n = 0; n < 2; ++n) gv[bj][n] = *(const f32x4*)(MOD + (size_t)mr * 6144 + 2048 + colb + bj * 128 + n * 16);
#pragma unroll
                for (int ai = 0; ai < 2; ++ai)
#pragma unroll
                    for (int m = 0; m < 4; ++m) { const size_t ro = (size_t)(ai * 128 + wr * 64 + m * 16 + fr) * DM + colb; f32x4 xv[2][2];
#pragma unroll
                        for (int bj = 0; bj < 2; ++bj)
#pragma unroll
                            for (int n = 0; n < 2; ++n) xv[bj][n] = *(const f32x4*)(src0 + ro + bj * 128 + n * 16);
#pragma unroll
                        for (int bj = 0; bj < 2; ++bj)
#pragma unroll
                            for (int n = 0; n < 2; ++n) *(f32x4*)(dst0 + ro + bj * 128 + n * 16) = xv[bj][n] + gv[bj][n] * acc[ai][bj][m][n]; } };
            GEMM(S, AD, E, 1024, 1024, 1024);
        }
        SEAM(pb + 3);
        if (IN(pb + 4)) { REFRESH(); REP_BEGIN(6) p_rowpass_f(P, F, l, L0 ? RT : RL); REP_END }
        SEAM(pb + 4);
        if (IN(pb + 5)) { REFRESH(); REP_BEGIN(7) p_topk(F, L0); REP_END }
        SEAM(pb + 5);
        if (IN(pb + 7)) { REFRESH(); REP_BEGIN(9)
            GroupSched S; S.init(16, L0 ? 17 : 16, 22, F.G, F.bid); const bf16* W = WSP(bf16, WS_WGU); bf16* HID = WSP(bf16, WS_HID); const int* SROW = WSP(int, WS_SROW);
            auto AD = [=](const Unit& u) { return Operands{H, W + ((size_t)u.grp * 5632 + u.pn * 256) * DM, DM, DM, u.grp * SLOT_E + u.pm * 256, DM}; };
            auto E = [=](EPI_ARGS) {
#pragma unroll
                for (int ai = 0; ai < 2; ++ai)
#pragma unroll
                    for (int m = 0; m < 4; ++m) { const size_t slot = (size_t)u.grp * SLOT_E + u.pm * 256 + ai * 128 + wr * 64 + m * 16 + fr; f32x4 o[2];
#pragma unroll
                        for (int n = 0; n < 2; ++n) { const f32x4 a = acc[ai][0][m][n], up = acc[ai][1][m][n];
#pragma unroll
                            for (int j = 0; j < 4; ++j) o[n][j] = a[j] * sigmoidf_(a[j]) * up[j]; }
                        st_bf8(HID + slot * FF + u.pn * 128 + wc * 32 + 8 * fq, o[0], o[1]); } };
            GEMM_GATHER(S, AD, E, DM, DM, DM, SROW);
        REP_END }
        SEAM(pb + 7);
        if (IN(pb + 8)) { REFRESH(); REP_BEGIN(10)
            const int tpe = L0 ? 17 : 16;
            GroupSched S; S.init(1, 16 * tpe, 4, F.G, F.bid); const bf16* HID = WSP(bf16, WS_HID); const bf16* W = WSP(bf16, WS_WD); bf16* Y = WSP(bf16, WS_Y); const float* SG = WSP(float, WS_SGATE);
            auto AD = [=](const Unit& u) { const int e = u.pm / tpe, st = e * 17 + (u.pm - e * tpe); return Operands{HID + (size_t)st * 256 * FF, W + ((size_t)e * 1024 + u.pn * 256) * FF, FF, FF, 0, FF}; };
            auto E = [=](EPI_ARGS) { const int e = u.pm / tpe; const size_t slot0 = (size_t)(e * 17 + (u.pm - e * tpe)) * 256 + wr * 64 + fr; float gt[2][4];
#pragma unroll
                for (int ai = 0; ai < 2; ++ai)
#pragma unroll
                    for (int m = 0; m < 4; ++m) gt[ai][m] = SG[slot0 + ai * 128 + m * 16];
#pragma unroll
                for (int ai = 0; ai < 2; ++ai)
#pragma unroll
                    for (int m = 0; m < 4; ++m)
#pragma unroll
                        for (int bj = 0; bj < 2; ++bj) st_bf8(Y + (slot0 + ai * 128 + m * 16) * DM + u.pn * 256 + bj * 128 + wc * 32 + 8 * fq, acc[ai][bj][m][0] * gt[ai][m], acc[ai][bj][m][1] * gt[ai][m]); };
            GEMM_P(S, AD, E);
        REP_END }
        SEAM(pb + 8);
        if (IN(pb + 9)) { REFRESH(); p_rowpass_k(P, F, l, L0 ? RT : RL); if (L0) p_wconv(P, F, 1); }
        if (L0) SEAM(pb + 9);
    }
#undef IN
#undef SEAM
}
template <int PH> static void launch_ph(int grid, const Params& p, hipStream_t stream) { hipLaunchKernelGGL(fwd_kernel<PH>, dim3(grid), dim3(NTHREADS), LDS_BYTES, stream, p); }
template <int PH> static bool set_attr() { return hipFuncSetAttribute((const void*)fwd_kernel<PH>, hipFuncAttributeMaxDynamicSharedMemorySize, LDS_BYTES) == hipSuccess; }

#ifndef DUP_LAUNCH
#define DUP_LAUNCH -1
#endif
extern "C" void kernel_launch(void* const* d_in, const int* in_sizes, int n_in, void* d_out, int out_size, void* d_ws, size_t ws_size, hipStream_t stream) {
    static int grid = 0;
    if (grid == 0) {
        if (n_in != 20 || out_size != RL * DM || ws_size < WS_END) { fprintf(stderr, "kernel_launch: unexpected shapes (n_in %d out %d ws %zu need %zu)\n", n_in, out_size, ws_size, (size_t)WS_END); grid = -1; return; }
        int dev = 0, cus = 0, per_cu = 0;
        if (hipGetDevice(&dev) != hipSuccess || hipDeviceGetAttribute(&cus, hipDeviceAttributeMultiprocessorCount, dev) != hipSuccess) { grid = -1; return; }
#if N_LAUNCH_MODE == 1
        if (!set_attr<-1>()) { fprintf(stderr, "kernel_launch: hipFuncSetAttribute failed\n"); grid = -1; return; }
        if (hipOccupancyMaxActiveBlocksPerMultiprocessor(&per_cu, (const void*)fwd_kernel<-1>, NTHREADS, LDS_BYTES) != hipSuccess || per_cu < 1) fprintf(stderr, "kernel_launch: occupancy query reports %d\n", per_cu);
#else
        if (!(set_attr<0>() && set_attr<1>() && set_attr<2>() && set_attr<3>() && set_attr<4>() && set_attr<5>() && set_attr<6>() && set_attr<7>() && set_attr<9>() && set_attr<10>() && set_attr<11>())) { fprintf(stderr, "kernel_launch: hipFuncSetAttribute failed\n"); grid = -1; return; }
        (void)per_cu;
#endif
        (void)hipGetLastError();
        grid = cus;
    }
    if (grid < 0) return;
    if (hipMemsetAsync((char*)d_ws + WS_CTL, 0, CTL_BYTES, stream) != hipSuccess) return;
    Params p{};
    const float** pp = (const float**)&p;
    for (int i = 0; i < 20; ++i) pp[i] = (const float*)d_in[i];
    p.out = (float*)d_out; p.ws = (unsigned char*)d_ws;
#if N_LAUNCH_MODE == 1
    p.l_lo = 0; p.l_hi = 2;
    launch_ph<-1>(grid, p, stream);
#else
    p.l_lo = 0; p.l_hi = 0; launch_ph<0>(grid, p, stream); if (DUP_LAUNCH == 0) launch_ph<0>(grid, p, stream); launch_ph<1>(grid, p, stream); if (DUP_LAUNCH == 1) launch_ph<1>(grid, p, stream);
#define LP(k) do { launch_ph<k>(grid, p, stream); if (DUP_LAUNCH == (k) && l == 0) launch_ph<k>(grid, p, stream); } while (0)
    for (int l = 0; l < 2; ++l) { p.l_lo = l; p.l_hi = l + 1;
        LP(2); LP(3); LP(4); LP(5); LP(6); LP(7); LP(9); LP(10); LP(11); }
#endif
}
```

```cpp
#include <hip/hip_runtime.h>
#include <cstdio>
#include <cstdint>

#ifndef N_LAUNCH_MODE
#define N_LAUNCH_MODE 1
#endif

#define GAS __attribute__((address_space(1)))
#define LAS __attribute__((address_space(3)))
typedef unsigned short bf16;
typedef short bf16x8 __attribute__((ext_vector_type(8)));
typedef float f32x4 __attribute__((ext_vector_type(4)));
typedef unsigned u32x4 __attribute__((ext_vector_type(4)));
typedef unsigned u32x2 __attribute__((ext_vector_type(2)));

constexpr int NB = 8, SEQ = 4096, DM = 1024, CTXL = 256, NH = 16, HD = 64, GRIDW = 64;
constexpr int RL = NB * SEQ, RC = NB * CTXL, RT = RL + RC;
constexpr int INW = 7168, NE = 16, FF = 2816, CAPL = 512, CAPC = 32;
constexpr int SLOT_E = 4352, NSLOT = NE * SLOT_E;
constexpr float RMS_EPS = 1e-6f;
constexpr float LOG2E = 1.4426950408889634f, QSCALE = 0.125f * LOG2E;
constexpr int NWAVES = 8, NTHREADS = 512;

constexpr size_t al256(size_t x) { return (x + 255) & ~(size_t)255; }
constexpr size_t WS_CTL = 0, CTL_BYTES = 1u << 20;
constexpr size_t WS_MOD = WS_CTL + CTL_BYTES;
constexpr size_t WS_XC = al256(WS_MOD + (size_t)2 * 9 * 6144 * 4);
constexpr size_t WS_AFF = al256(WS_XC + (size_t)RC * DM * 4);
constexpr size_t WS_SROW = al256(WS_AFF + (size_t)RT * 16 * 4);
constexpr size_t WS_SGATE = al256(WS_SROW + (size_t)NSLOT * 4);
constexpr size_t WS_SEL = al256(WS_SGATE + (size_t)NSLOT * 4);
constexpr size_t WS_DFTM = al256(WS_SEL + (size_t)RT * 16 * 4);
constexpr size_t WS_DFTC = al256(WS_DFTM + (size_t)4096 * 8192 * 2);
constexpr size_t WS_WA = al256(WS_DFTC + (size_t)256 * 512 * 2);
constexpr size_t WS_WFV = al256(WS_WA + (size_t)5632 * 1024 * 2);
constexpr size_t WS_WAO = al256(WS_WFV + (size_t)2048 * 1024 * 2);
constexpr size_t WS_WFO = al256(WS_WAO + (size_t)1024 * 1024 * 2);
constexpr size_t WS_WPO = al256(WS_WFO + (size_t)1024 * 512 * 2);
constexpr size_t WS_WOUT = al256(WS_WPO + (size_t)1024 * 256 * 2);
constexpr size_t WS_WGU = al256(WS_WOUT + (size_t)1024 * 1024 * 2);
constexpr size_t WS_WD = al256(WS_WGU + (size_t)16 * 5632 * 1024 * 2);
constexpr size_t WS_H = al256(WS_WD + (size_t)16 * 1024 * 2816 * 2);
constexpr size_t WS_R = al256(WS_H + (size_t)RT * DM * 2);
constexpr size_t WS_KQ = WS_R;
constexpr size_t WS_MRG = WS_KQ;
constexpr size_t WS_PB = al256(WS_KQ + (size_t)RT * 2048 * 2);
constexpr size_t WS_GB = al256(WS_PB + (size_t)RT * 512 * 2);
constexpr size_t WS_YT = al256(WS_GB + (size_t)RT * 3072 * 2);
constexpr size_t WS_MRGB = WS_YT;
constexpr size_t WS_VT = al256(WS_YT + (size_t)RT * 1024 * 2);
constexpr size_t WS_FOUR = al256(WS_VT + (size_t)RT * 1024 * 2);
constexpr size_t WS_ATT = al256(WS_FOUR + (size_t)RT * 512 * 2);
constexpr size_t WS_POOL = al256(WS_ATT + (size_t)RT * 1024 * 2);
constexpr size_t WS_MIX_END = al256(WS_POOL + (size_t)RT * 512 * 2);
constexpr size_t WS_XG = WS_R;
constexpr size_t WS_HID = al256(WS_XG + (size_t)NSLOT * 1024 * 2);
constexpr size_t WS_Y = al256(WS_HID + (size_t)NSLOT * 2816 * 2);
constexpr size_t WS_MOE_END = al256(WS_Y + (size_t)NSLOT * 1024 * 2);
constexpr size_t WS_END0 = WS_MIX_END > WS_MOE_END ? WS_MIX_END : WS_MOE_END;
constexpr size_t WS_ZP = WS_END0;
constexpr size_t WS_M1T = al256(WS_ZP + ((size_t)8 * 64 * 512 * 128 + 1024) * 2);
constexpr size_t WS_M2T = al256(WS_M1T + (size_t)256 * 256 * 2);
constexpr size_t WS_END = al256(WS_M2T + (size_t)256 * 256 * 2);
constexpr size_t YT_CTX_OFF = (size_t)8 * 1024 * 4096;

constexpr int CW_BAR = 4096;

constexpr int LDS_BYTES = 155648;
constexpr int LDS_TW = 132096;
constexpr int LDS_MISC = 131072;

__device__ __forceinline__ unsigned f2bf(float f) { unsigned u = __float_as_uint(f); return (u + 0x7fffu + ((u >> 16) & 1u)) >> 16; }
typedef __bf16 hbf16x2 __attribute__((ext_vector_type(2)));
typedef float f32x2 __attribute__((ext_vector_type(2)));
__device__ __forceinline__ unsigned pk2(float lo, float hi) { const f32x2 v = {lo, hi}; return __builtin_bit_cast(unsigned, __builtin_convertvector(v, hbf16x2)); }
__device__ __forceinline__ float bf2f(unsigned b) { return __uint_as_float(b << 16); }
__device__ __forceinline__ float bflo(unsigned w) { return __uint_as_float(w << 16); }
__device__ __forceinline__ float bfhi(unsigned w) { return __uint_as_float(w & 0xffff0000u); }
template <int CTRL> __device__ __forceinline__ float dppf(float x) { return __builtin_bit_cast(float, __builtin_amdgcn_mov_dpp(__builtin_bit_cast(int, x), CTRL, 0xf, 0xf, true)); }
template <int CTRL> __device__ __forceinline__ int dppi(int x) { return __builtin_amdgcn_mov_dpp(x, CTRL, 0xf, 0xf, true); }
constexpr int DPP_XOR1 = 0xB1, DPP_XOR2 = 0x4E, DPP_ROR4 = 0x124, DPP_ROR8 = 0x128;
__device__ __forceinline__ float wave_sum(float v) {
    v += dppf<DPP_XOR1>(v); v += dppf<DPP_XOR2>(v); v += dppf<DPP_ROR4>(v); v += dppf<DPP_ROR8>(v);
    auto s = __builtin_amdgcn_permlane16_swap(__float_as_uint(v), __float_as_uint(v), false, false); v = __uint_as_float(s[0]) + __uint_as_float(s[1]);
    auto t = __builtin_amdgcn_permlane32_swap(__float_as_uint(v), __float_as_uint(v), false, false); return __uint_as_float(t[0]) + __uint_as_float(t[1]);
}
__device__ __forceinline__ float wave_max(float v) {
    v = fmaxf(v, dppf<DPP_XOR1>(v)); v = fmaxf(v, dppf<DPP_XOR2>(v)); v = fmaxf(v, dppf<DPP_ROR4>(v)); v = fmaxf(v, dppf<DPP_ROR8>(v));
    auto s = __builtin_amdgcn_permlane16_swap(__float_as_uint(v), __float_as_uint(v), false, false); v = fmaxf(__uint_as_float(s[0]), __uint_as_float(s[1]));
    auto t = __builtin_amdgcn_permlane32_swap(__float_as_uint(v), __float_as_uint(v), false, false); return fmaxf(__uint_as_float(t[0]), __uint_as_float(t[1]));
}
__device__ __forceinline__ int wave_sum_i(int v) {
    v += dppi<DPP_XOR1>(v); v += dppi<DPP_XOR2>(v); v += dppi<DPP_ROR4>(v); v += dppi<DPP_ROR8>(v);
    auto s = __builtin_amdgcn_permlane16_swap((unsigned)v, (unsigned)v, false, false); v = (int)(s[0] + s[1]);
    auto t = __builtin_amdgcn_permlane32_swap((unsigned)v, (unsigned)v, false, false); return (int)(t[0] + t[1]);
}
__device__ __forceinline__ float sigmoidf_(float x) { return 1.f / (1.f + __expf(-x)); }
#define LDS_WAIT() asm volatile("s_waitcnt lgkmcnt(0)" ::: "memory")

#define XB_TMO      128
#define XB_XCNT(j)  (256  + 64 * (j))
#define XB_XSUB(j)  (1280 + 64 * (j))
#define XB_XGEN(j)  (2304 + 64 * (j))
#define XB_TOP      3328
#define XB_TOPGEN   3392
#define XCD_BAR_WORDS 3456
#define XB_SPIN_CAP (1u << 22)

__device__ __forceinline__ unsigned xb_ld(unsigned* p)              { return __hip_atomic_load(p, __ATOMIC_RELAXED, __HIP_MEMORY_SCOPE_AGENT); }
__device__ __forceinline__ unsigned xb_add(unsigned* p, unsigned v) { return __hip_atomic_fetch_add(p, v, __ATOMIC_RELAXED, __HIP_MEMORY_SCOPE_AGENT); }
__device__ __forceinline__ unsigned xb_xcc_id() { return (unsigned)__builtin_amdgcn_s_getreg((3 << 11) | 20) & 0xFu; }
#define XB_SPIN(cond, bar) do { unsigned _sp = 0; while (cond) { __builtin_amdgcn_s_sleep(1); \
    if ((++_sp & 255u) == 0u) { if (xb_ld(&(bar)[XB_TMO])) break; if (_sp > XB_SPIN_CAP) { atomicAdd(&(bar)[XB_TMO], 1u); break; } } } } while (0)

struct XcdBarrier { unsigned* bar; unsigned x; volatile LAS unsigned* st; };

__device__ __forceinline__ XcdBarrier xcd_barrier_post(unsigned* bar, volatile LAS unsigned* st) {
    XcdBarrier b; b.bar = bar; b.x = xb_xcc_id(); b.st = st;
    if (threadIdx.x == 0) (void)xb_add(&bar[XB_XCNT(b.x)], 1u);
    return b;
}
__device__ __forceinline__ void xcd_barrier_complete(unsigned* bar, unsigned x, unsigned& nloc, unsigned& nx) {
    const unsigned G = gridDim.x * gridDim.y * gridDim.z;
    unsigned sum, cnt, mine, sp = 0u;
    for (;;) {
        sum = 0u; cnt = 0u; mine = 0u;
#pragma unroll
        for (unsigned j = 0; j < 16; ++j) { const unsigned c = xb_ld(&bar[XB_XCNT(j)]); sum += c; cnt += (c > 0u) ? 1u : 0u; mine = (j == x) ? c : mine; }
        if (sum == G) break;
        __builtin_amdgcn_s_sleep(1);
        if ((++sp & 255u) == 0u) { if (xb_ld(&bar[XB_TMO])) break; if (sp > XB_SPIN_CAP) { atomicAdd(&bar[XB_TMO], 1u); break; } }
    }
    nloc = mine > 0u ? mine : 1u; nx = cnt > 0u ? cnt : 1u;
}
__device__ __forceinline__ void xcd_barrier(const XcdBarrier& b) {
    asm volatile("s_waitcnt vmcnt(0)" ::: "memory");
    __syncthreads();
    if (threadIdx.x == 0) {
        unsigned* bar = b.bar;
        __builtin_amdgcn_s_waitcnt(0);
        unsigned nloc = b.st[0], nx = b.st[1];
        if (nloc == 0u) { xcd_barrier_complete(bar, b.x, nloc, nx); b.st[0] = nloc; b.st[1] = nx; }
        const unsigned old = xb_add(&bar[XB_XSUB(b.x)], 1u);
        const unsigned gen = old / nloc;
        if (old + 1u == (gen + 1u) * nloc) {
            __builtin_amdgcn_fence(__ATOMIC_RELEASE, "agent");
            asm volatile("s_waitcnt vmcnt(0)" ::: "memory");
            const unsigned og = xb_add(&bar[XB_TOP], 1u);
            const unsigned tg = og / nx;
            if (og + 1u == (tg + 1u) * nx) xb_add(&bar[XB_TOPGEN], 1u);
            else XB_SPIN(xb_ld(&bar[XB_TOPGEN]) == tg, bar);
            __builtin_amdgcn_fence(__ATOMIC_ACQUIRE, "agent");
            xb_add(&bar[XB_XGEN(b.x)], 1u);
            asm volatile("s_waitcnt vmcnt(0)" ::: "memory");
        } else {
            XB_SPIN(xb_ld(&bar[XB_XGEN(b.x)]) == gen, bar);
            __builtin_amdgcn_fence(__ATOMIC_ACQUIRE, "agent");
            asm volatile("s_waitcnt vmcnt(0)" ::: "memory");
        }
    }
    __syncthreads();
}

struct Params {
    const float *x, *c, *ctx, *c_ctx, *ada_w, *ada_b, *norm1_g, *norm2_g, *w_in, *rpb, *w_att_o, *w_fourier, *w_pool, *pool_scale, *w_out, *w_router, *w_eg, *w_eu, *w_ed, *final_g;
    float* out; unsigned char* ws; int l_lo, l_hi;
};
struct Frame {
    LAS unsigned char* lds;
    int tid, lane, wave, G, bid;
    unsigned char* ws;
};
#define WSP(T, off) ((T*)(F.ws + (off)))

struct Unit { int grp, pm, pn, seg; };
struct GroupSched {
    int ng, nM, nN, G, c; int tM, tN, tpm0, tpn0;
    __device__ __forceinline__ void init(int ng_, int nM_, int nN_, int G_, int c_, int tM_ = 0, int tN_ = 0, int tpm0_ = 0, int tpn0_ = 0) { ng = ng_; nM = nM_; nN = nN_; G = G_; c = c_; tM = tM_; tN = tN_; tpm0 = tpm0_; tpn0 = tpn0_; }
    __device__ __forceinline__ bool next(int i, Unit& u) const {
        const int per = nM * nN; const int L = i * G + c;
        if (L < ng * per) {
            u.grp = L / per; int wgid = L - u.grp * per;
            { const int q = per / 8, r = per % 8, xcd = wgid % 8, off = wgid / 8; wgid = (xcd < r ? xcd * (q + 1) : r * (q + 1) + (xcd - r) * q) + off; }
            const int nig = 8 * nN, gid = wgid / nig, fm = gid * 8, gsz = (nM - fm) < 8 ? (nM - fm) : 8;
            u.pm = fm + ((wgid % nig) % gsz); u.pn = (wgid % nig) / gsz; u.seg = 0; return true;
        }
        const int w = L - ng * per;
        if (w < tM * tN) { u.grp = ng; u.pm = tpm0 + (w % tM); u.pn = tpn0 + (w / tM); u.seg = 0; return true; }
        return false;
    }
};
struct Operands { const bf16* A; const bf16* Bt; int lda, ldb, slot0, K; int bmap; };

template <class Addr, class Epi>
__device__ __forceinline__ void gemm_simple(const GroupSched& S, const Addr& AD, const Epi& E, int K) {
    const int tid = threadIdx.x, wid = __builtin_amdgcn_readfirstlane(tid >> 6), lane = tid & 63, wr = wid >> 2, wc = wid & 3, fr = lane & 15, fq = lane >> 4;
    Unit u;
    for (int i = 0; S.next(i, u); ++i) {
        const Operands op = AD(u);
        f32x4 acc[2][2][4][2];
#pragma unroll
        for (int a = 0; a < 2; ++a)
#pragma unroll
            for (int b = 0; b < 2; ++b)
#pragma unroll
                for (int m = 0; m < 4; ++m)
#pragma unroll
                    for (int n = 0; n < 2; ++n) acc[a][b][m][n] = (f32x4){0.f, 0.f, 0.f, 0.f};
        const bf16* ap = op.A + (size_t)(wr * 64 + fr) * op.lda + fq * 8;
        const bf16* bp = op.Bt + (size_t)(wc * 32 + fr) * op.ldb + fq * 8;
#pragma unroll 1
        for (int k = 0; k < K; k += 32) {
            bf16x8 bfr[2][2];
#pragma unroll
            for (int b = 0; b < 2; ++b)
#pragma unroll
                for (int n = 0; n < 2; ++n) bfr[b][n] = *(const bf16x8*)(bp + (size_t)(b * 128 + n * 16) * op.ldb + k);
#pragma unroll
            for (int a = 0; a < 2; ++a) {
                bf16x8 af[4];
#pragma unroll
                for (int m = 0; m < 4; ++m) af[m] = *(const bf16x8*)(ap + (size_t)(a * 128 + m * 16) * op.lda + k);
#pragma unroll
                for (int b = 0; b < 2; ++b)
#pragma unroll
                    for (int m = 0; m < 4; ++m)
#pragma unroll
                        for (int n = 0; n < 2; ++n) acc[a][b][m][n] = __builtin_amdgcn_mfma_f32_16x16x32_bf16(bfr[b][n], af[m], acc[a][b][m][n], 0, 0, 0);
            }
        }
        E(acc, u, wr, wc, fr, fq);
    }
}
constexpr int HTB = 128 * 64 * 2;
__device__ __forceinline__ int lds_byte(int r, int c) { const int st = (r >> 4) * 2 + (c >> 5), rr = r & 15, cc = c & 31, ob = rr * 64 + cc * 2; return st * 1024 + (ob ^ (((ob >> 9) & 1) << 5)); }
__device__ __forceinline__ int perm32(int rho) { const int n = rho >> 4, i = rho & 15; return 8 * (i >> 2) + 4 * n + (i & 3); }
__device__ __forceinline__ void stage_rc(int b, int& R, int& C) { const int st = b / 1024, sb = b % 1024, swz = sb ^ (((sb >> 9) & 1) << 5); R = (st >> 1) * 16 + swz / 64; C = (st & 1) * 32 + (swz % 64) / 2; }
template <bool GATHER, bool PERM, class Sched, class Addr, class Epi>
__device__ __forceinline__ void gemm_fast(LAS unsigned char* lds, const int tid, const Sched& S, const Addr& AD, const Epi& E, const int* __restrict__ grows) {
    const int wid = __builtin_amdgcn_readfirstlane(tid >> 6), lane = tid & 63, wr = wid >> 2, wc = wid & 3, fr = lane & 15, fq = lane >> 4;
    int sR[2], sRb[2]; unsigned sC[2];
    unsigned cvg[2][2], nvg[2][2], cvb[2][2], nvb[2][2];
#pragma unroll
    for (int i = 0; i < 2; ++i) { int R, C; stage_rc(tid * 16 + i * 8192, R, C); sR[i] = R; sC[i] = (unsigned)C * 2u; sRb[i] = PERM ? ((R & ~31) + perm32(R & 31)) : R; }
    const size_t kstep = 128;
    const unsigned ldsw = (unsigned)wid * 1024u;
    const int aoff = lds_byte(wr * 64 + fr, fq * 8), boff = lds_byte(wc * 32 + fr, fq * 8);
#define PG8_SA(b, h) (((b) * 2 + (h)) * HTB)
#define PG8_SB(b, h) ((4 + (b) * 2 + (h)) * HTB)
#define PG8_STAGE(bufoff, gbase, voff) do { _Pragma("unroll") for (int _i = 0; _i < 2; ++_i) \
        __builtin_amdgcn_global_load_lds((const unsigned*)((const char*)(gbase) + (voff)[_i]), (LAS unsigned*)(lds + (bufoff) + ldsw + _i * 8192), 16, 0, 0); } while (0)
#define PG8_LDA(dst, b, h) do { _Pragma("unroll") for (int m = 0; m < 4; ++m) _Pragma("unroll") for (int k = 0; k < 2; ++k) dst[m][k] = *(const LAS bf16x8*)(lds + PG8_SA(b, h) + aoff + m * 2048 + k * 1024); } while (0)
#define PG8_LDB(dst, b, h) do { _Pragma("unroll") for (int n = 0; n < 2; ++n) _Pragma("unroll") for (int k = 0; k < 2; ++k) dst[n][k] = *(const LAS bf16x8*)(lds + PG8_SB(b, h) + boff + n * 2048 + k * 1024); } while (0)
#define PG8_MMA(ai, bj, At, Bt) do { __builtin_amdgcn_s_setprio(1); _Pragma("unroll") for (int m = 0; m < 4; ++m) _Pragma("unroll") for (int n = 0; n < 2; ++n) _Pragma("unroll") for (int k = 0; k < 2; ++k) \
        acc[ai][bj][m][n] = __builtin_amdgcn_mfma_f32_16x16x32_bf16(Bt[n][k], At[m][k], acc[ai][bj][m][n], 0, 0, 0); __builtin_amdgcn_s_setprio(0); } while (0)
#define PG8_WAIT_V(n) asm volatile("s_waitcnt vmcnt(" #n ")" ::: "memory")
#define PG8_WAIT_L(n) asm volatile("s_waitcnt lgkmcnt(" #n ")" ::: "memory")
#define PG8_BAR __builtin_amdgcn_s_barrier()
#define PG8_SCHED __builtin_amdgcn_sched_barrier(0)
#define PG8_GIDX(dst, op_) do { _Pragma("unroll") for (int h_ = 0; h_ < 2; ++h_) _Pragma("unroll") for (int i_ = 0; i_ < 2; ++i_) dst[h_][i_] = (unsigned)grows[(op_).slot0 + h_ * 128 + sR[i_]] * (unsigned)((op_).lda * 2) + sC[i_]; } while (0)
#define PG8_AOFF(dst, op_) do { _Pragma("unroll") for (int h_ = 0; h_ < 2; ++h_) _Pragma("unroll") for (int i_ = 0; i_ < 2; ++i_) dst[h_][i_] = (unsigned)((sR[i_] + 128 * h_) * (op_).lda) * 2u + sC[i_]; } while (0)
#define PG8_BOFF(dst, op_) do { _Pragma("unroll") for (int h_ = 0; h_ < 2; ++h_) _Pragma("unroll") for (int i_ = 0; i_ < 2; ++i_) { const int c_ = sRb[i_] + 128 * h_; \
        dst[h_][i_] = (unsigned)(((op_).bmap ? (64 * (c_ & 7) + (c_ >> 3)) : c_) * (op_).ldb) * 2u + sC[i_]; } } while (0)
#define PG8_COPY(dst, src) do { _Pragma("unroll") for (int h_ = 0; h_ < 2; ++h_) _Pragma("unroll") for (int i_ = 0; i_ < 2; ++i_) dst[h_][i_] = src[h_][i_]; } while (0)
    Unit cur, nxt; int ui = 0;
    if (!S.next(0, cur)) return;
    f32x4 acc[2][2][4][2];
#pragma unroll
    for (int a = 0; a < 2; ++a)
#pragma unroll
        for (int b = 0; b < 2; ++b)
#pragma unroll
            for (int m = 0; m < 4; ++m)
#pragma unroll
                for (int n = 0; n < 2; ++n) acc[a][b][m][n] = (f32x4){0.f, 0.f, 0.f, 0.f};
    bf16x8 At[4][2], B0[2][2], B1[2][2];
    const char* cA; const char* cB; int nt;
    { const Operands op = AD(cur); cA = (const char*)op.A; cB = (const char*)op.Bt; nt = op.K / 64; PG8_BOFF(cvb, op);
      Unit u1; const bool h1 = S.next(1, u1); const Operands o1 = h1 ? AD(u1) : op; PG8_BOFF(nvb, o1);
      if constexpr (GATHER) { PG8_GIDX(cvg, op); PG8_GIDX(nvg, o1); PG8_WAIT_V(0); } else { PG8_AOFF(cvg, op); PG8_AOFF(nvg, o1); } }
    PG8_STAGE(PG8_SB(0, 0), cB, cvb[0]); PG8_STAGE(PG8_SB(0, 1), cB, cvb[1]); PG8_STAGE(PG8_SA(0, 0), cA, cvg[0]); PG8_STAGE(PG8_SA(0, 1), cA, cvg[1]);
    if (wr == 1) PG8_BAR;
    PG8_WAIT_V(2); PG8_BAR;
    PG8_STAGE(PG8_SB(1, 0), cB + kstep, cvb[0]); PG8_STAGE(PG8_SA(1, 0), cA + kstep, cvg[0]); PG8_STAGE(PG8_SB(1, 1), cB + kstep, cvb[1]);
    PG8_WAIT_V(6); PG8_BAR;
    for (;;) {
        const bool has_next = S.next(ui + 1, nxt);
        const char* nA = cA; const char* nB = cB; int nnt = nt;
        if (has_next) { const Operands op = AD(nxt); nA = (const char*)op.A; nB = (const char*)op.Bt; nnt = op.K / 64; }
#pragma unroll 1
        for (int t = 0; t < nt; t += 2) {
            const bool last = (t == nt - 2);
            const char* a1 = cA + (size_t)(t + 1) * kstep;
            const char* a2 = last ? nA : cA + (size_t)(t + 2) * kstep; const char* b2 = last ? nB : cB + (size_t)(t + 2) * kstep;
            const char* a3 = a2 + kstep; const char* b3 = b2 + kstep;
            unsigned v2[2][2], w2[2][2];
#pragma unroll
            for (int h_ = 0; h_ < 2; ++h_)
#pragma unroll
                for (int i_ = 0; i_ < 2; ++i_) { v2[h_][i_] = last ? nvg[h_][i_] : cvg[h_][i_]; w2[h_][i_] = last ? nvb[h_][i_] : cvb[h_][i_]; }
            PG8_LDB(B0, 0, 0); PG8_LDB(B1, 0, 1); PG8_SCHED; PG8_LDA(At, 0, 0); PG8_STAGE(PG8_SA(1, 1), a1, cvg[1]);
            PG8_WAIT_V(8); PG8_WAIT_L(0); PG8_BAR; PG8_MMA(0, 0, At, B0); PG8_MMA(0, 1, At, B1); PG8_BAR; PG8_SCHED;
            PG8_LDA(At, 0, 1); PG8_STAGE(PG8_SB(0, 0), b2, w2[0]); PG8_STAGE(PG8_SB(0, 1), b2, w2[1]); PG8_STAGE(PG8_SA(0, 0), a2, v2[0]);
            PG8_WAIT_V(8); PG8_WAIT_L(0); PG8_BAR; PG8_MMA(1, 0, At, B0); PG8_MMA(1, 1, At, B1); PG8_BAR; PG8_SCHED;
            PG8_LDB(B0, 1, 0); PG8_LDB(B1, 1, 1); PG8_SCHED; PG8_LDA(At, 1, 0); PG8_STAGE(PG8_SA(0, 1), a2, v2[1]);
            PG8_WAIT_V(8); PG8_WAIT_L(0); PG8_BAR; PG8_MMA(0, 0, At, B0); PG8_MMA(0, 1, At, B1); PG8_BAR; PG8_SCHED;
            PG8_LDA(At, 1, 1); PG8_STAGE(PG8_SB(1, 0), b3, w2[0]); PG8_STAGE(PG8_SB(1, 1), b3, w2[1]); PG8_STAGE(PG8_SA(1, 0), a3, v2[0]);
            PG8_WAIT_V(8); PG8_WAIT_L(0); PG8_BAR; PG8_MMA(1, 0, At, B0); PG8_MMA(1, 1, At, B1); PG8_BAR; PG8_SCHED;
        }
        if (wr == 0) PG8_BAR;
        unsigned fvg[2][2], fvb[2][2];
        { Unit u2; const bool h2 = S.next(ui + 2, u2);
          if (h2) { const Operands o2 = AD(u2); PG8_BOFF(fvb, o2); if constexpr (GATHER) PG8_GIDX(fvg, o2); else PG8_AOFF(fvg, o2); }
          else { PG8_COPY(fvb, nvb); PG8_COPY(fvg, nvg); } }
        { int fr2 = fr, fq2 = fq; asm volatile("" : "+v"(fr2), "+v"(fq2));
          E(acc, cur, wr, wc, fr2, fq2); }
        if (!has_next) break;
        if constexpr (GATHER) PG8_WAIT_V(0);
        PG8_COPY(cvg, nvg); PG8_COPY(nvg, fvg); PG8_COPY(cvb, nvb); PG8_COPY(nvb, fvb);
        if (E.reset(cur)) {
#pragma unroll
        for (int a = 0; a < 2; ++a)
#pragma unroll
            for (int b = 0; b < 2; ++b)
#pragma unroll
                for (int m = 0; m < 4; ++m)
#pragma unroll
                    for (int n = 0; n < 2; ++n) acc[a][b][m][n] = (f32x4){0.f, 0.f, 0.f, 0.f};
        }
        cur = nxt; cA = nA; cB = nB; nt = nnt; ++ui;
        if (wr == 1) PG8_BAR;
    }
    PG8_WAIT_V(0);
    PG8_BAR;
#undef PG8_SA
#undef PG8_SB
#undef PG8_STAGE
#undef PG8_LDA
#undef PG8_LDB
#undef PG8_MMA
#undef PG8_WAIT_V
#undef PG8_WAIT_L
#undef PG8_BAR
#undef PG8_SCHED
#undef PG8_GIDX
#undef PG8_AOFF
#undef PG8_BOFF
#undef PG8_COPY
}
template <class F> struct EpiFn { F f; __device__ __forceinline__ void operator()(f32x4 (&acc)[2][2][4][2], const Unit& u, int wr, int wc, int fr, int fq) const { f(acc, u, wr, wc, fr, fq); } __device__ __forceinline__ bool reset(const Unit&) const { return true; } };
template <class F> __device__ __forceinline__ EpiFn<F> mk_epi(F f) { return EpiFn<F>{f}; }
template <class F> struct EpiSeg { F f; int last; __device__ __forceinline__ void operator()(f32x4 (&acc)[2][2][4][2], const Unit& u, int wr, int wc, int fr, int fq) const { f(acc, u, wr, wc, fr, fq); } __device__ __forceinline__ bool reset(const Unit& u) const { return u.seg == last; } };
template <class F> __device__ __forceinline__ EpiSeg<F> mk_epi_seg(F f, int last) { return EpiSeg<F>{f, last}; }
template <int NSEG> struct SegSched { GroupSched base; __device__ __forceinline__ bool next(int j, Unit& u) const { if (!base.next(j / NSEG, u)) return false; u.seg = j % NSEG; return true; } };
#ifndef DUP_PH
#define DUP_PH -1
#endif
#define REP_BEGIN(k) _Pragma("unroll 1") for (int rep_ = 0; rep_ < ((DUP_PH == (k)) ? 2 : 1); ++rep_) { if (rep_) { if constexpr (PH < 0) xcd_barrier(bar); }
#define REP_END }
#ifndef USE_FAST
#define USE_FAST 1
#endif
#if USE_FAST
#define GEMM(S, AD, E, K, lda, ldb) gemm_fast<false, false>(F.lds, F.tid, S, AD, mk_epi(E), nullptr)
#define GEMM_P(S, AD, E) gemm_fast<false, true>(F.lds, F.tid, S, AD, mk_epi(E), nullptr)
#define GEMM_GATHER(S, AD, E, K, lda, ldb, rows) gemm_fast<true, true>(F.lds, F.tid, S, AD, mk_epi(E), rows)
#else
#define GEMM(S, AD, E, K, lda, ldb) gemm_simple(S, AD, E, K)
#endif
#define EPI_ARGS f32x4 (&acc)[2][2][4][2], const Unit& u, int wr, int wc, int fr, int fq
#define EPI_FOR(...) _Pragma("unroll") for (int ai = 0; ai < 2; ++ai) _Pragma("unroll") for (int m = 0; m < 4; ++m) { const int r = ai * 128 + wr * 64 + m * 16 + fr; \
    _Pragma("unroll") for (int bj = 0; bj < 2; ++bj) _Pragma("unroll") for (int n = 0; n < 2; ++n) { const int c = bj * 128 + wc * 32 + n * 16 + 4 * fq; const f32x4 v = acc[ai][bj][m][n]; __VA_ARGS__ } }
#define EPI_FOR8(...) _Pragma("unroll") for (int ai = 0; ai < 2; ++ai) _Pragma("unroll") for (int m = 0; m < 4; ++m) { const int r = ai * 128 + wr * 64 + m * 16 + fr; \
    _Pragma("unroll") for (int bj = 0; bj < 2; ++bj) { const int c = bj * 128 + wc * 32 + 8 * fq; const f32x4 v0 = acc[ai][bj][m][0], v1 = acc[ai][bj][m][1]; __VA_ARGS__ } }
__device__ __forceinline__ void st_bf8(bf16* p, f32x4 a, f32x4 b) { u32x4 w; w.x = pk2(a[0], a[1]); w.y = pk2(a[2], a[3]); w.z = pk2(b[0], b[1]); w.w = pk2(b[2], b[3]); *(u32x4*)p = w; }
__device__ __forceinline__ void st_bf4(bf16* p, f32x4 v) { u32x2 w; w.x = pk2(v[0], v[1]); w.y = pk2(v[2], v[3]); *(u32x2*)p = w; }

__device__ __forceinline__ void p_mod(const Params& P, Frame& F) {
    LAS float* sc = (LAS float*)F.lds;
    LAS float* red = (LAS float*)(F.lds + 9 * 1024 * 4);
    float* MOD = WSP(float, WS_MOD);
    bool have = false;
    for (int it = F.bid; it < 2 * 96; it += F.G) {
        if (!have) {
            for (int i = F.tid; i < 9 * 1024; i += NTHREADS) { const int r = i >> 10, k = i & 1023; const float v = r < 8 ? P.c[r * 1024 + k] : P.c_ctx[k]; sc[i] = v * sigmoidf_(v); }
            have = true;
        }
        __syncthreads();
        const int l = it / 96, j0 = (it % 96) * 64, jj = F.tid & 63, kc = F.tid >> 6;
        const float* W = P.ada_w + (size_t)l * 1024 * 6144 + j0 + jj;
        float a[9];
#pragma unroll
        for (int r = 0; r < 9; ++r) a[r] = 0.f;
#pragma unroll 8
        for (int k = kc * 128; k < kc * 128 + 128; ++k) { const float w = W[(size_t)k * 6144];
#pragma unroll
            for (int r = 0; r < 9; ++r) a[r] += sc[r * 1024 + k] * w; }
#pragma unroll
        for (int r = 0; r < 9; ++r) red[(kc * 9 + r) * 64 + jj] = a[r];
        __syncthreads();
        for (int o = F.tid; o < 9 * 64; o += NTHREADS) { const int r = o >> 6, j = o & 63; float s = 0.f;
#pragma unroll
            for (int q = 0; q < 8; ++q) s += red[(q * 9 + r) * 64 + j];
            MOD[((size_t)l * 9 + r) * 6144 + j0 + j] = s + P.ada_b[l * 6144 + j0 + j]; }
    }
    __syncthreads();
}
__device__ __forceinline__ void p_dftgen(Frame& F) {
    LAS float* tab = (LAS float*)F.lds;
    for (int j = F.tid; j < 4096; j += NTHREADS) tab[j] = cospif((float)j * (1.0f / 2048.0f));
    __syncthreads();
    bf16* DC_ = WSP(bf16, WS_DFTC); bf16* M1 = WSP(bf16, WS_M1T); bf16* M2 = WSP(bf16, WS_M2T);
    const int nchunk = 256 * 64 + 2 * 256 * 32;
    for (int ch = F.bid * NTHREADS + F.tid; ch < nchunk; ch += F.G * NTHREADS) {
        float v[8]; bf16* dst;
        if (ch < 256 * 64) { const int kf = ch >> 6, col0 = (ch & 63) * 8, cs = col0 >> 8, l0 = col0 & 255;
#pragma unroll
            for (int i = 0; i < 8; ++i) { const int j = ((kf * (l0 + i)) & 255) * 16; v[i] = cs ? -tab[(j + 3072) & 4095] : tab[j]; }
            dst = DC_ + (size_t)kf * 512 + col0; }
        else if (ch < 256 * 64 + 256 * 32) { const int c2 = ch - 256 * 64, row = c2 >> 5, col0 = (c2 & 31) * 8, ri = row >> 7, k1 = row & 127, cs = (col0 >> 6) & 1, l10 = col0 & 63;
#pragma unroll
            for (int i = 0; i < 8; ++i) { const int j = ((k1 * (l10 + i)) & 63) * 64; const float c = tab[j], sn = tab[(j + 3072) & 4095];
                v[i] = (k1 >= 64 || col0 >= 128) ? 0.f : (ri == 0 ? (cs == 0 ? c : -sn) : (cs == 0 ? sn : c)); }
            dst = M1 + (size_t)row * 256 + col0; }
        else { const int c2 = ch - 256 * 64 - 256 * 32, row = c2 >> 5, col0 = (c2 & 31) * 8, ri = (col0 >> 6) & 1, l20 = col0 & 63;
#pragma unroll
            for (int i = 0; i < 8; ++i) { const int j = ((row * (l20 + i)) & 63) * 64; const float c = tab[j], sn = tab[(j + 3072) & 4095];
                v[i] = (row >= 64 || col0 >= 128) ? 0.f : (ri == 0 ? c : -sn); }
            dst = M2 + (size_t)row * 256 + col0; }
        u32x4 o; o.x = pk2(v[0], v[1]); o.y = pk2(v[2], v[3]); o.z = pk2(v[4], v[5]); o.w = pk2(v[6], v[7]);
        *(u32x4*)dst = o;
    }
    __syncthreads();
}
__device__ __forceinline__ void transpose_item(const float* W, int ldw, int k0, int n0, bf16* WT, int ldt, int drow0, LAS float* scr, int lane) {
    f32x4 ld[8];
#pragma unroll
    for (int i = 0; i < 8; ++i) ld[i] = *(const f32x4*)(W + (size_t)(k0 + 8 * i + (lane >> 3)) * ldw + n0 + 4 * (lane & 7));
#pragma unroll
    for (int i = 0; i < 8; ++i) { LAS float* d = scr + (8 * i + (lane >> 3)) * 33 + 4 * (lane & 7); d[0] = ld[i][0]; d[1] = ld[i][1]; d[2] = ld[i][2]; d[3] = ld[i][3]; }
    LDS_WAIT(); asm volatile("" ::: "memory");
    const int c = lane & 7;
#pragma unroll
    for (int j = 0; j < 4; ++j) { const int n = (lane >> 3) + 8 * j; const LAS float* s = scr + (8 * c) * 33 + n;
        u32x4 o; o.x = pk2(s[0 * 33], s[1 * 33]); o.y = pk2(s[2 * 33], s[3 * 33]); o.z = pk2(s[4 * 33], s[5 * 33]); o.w = pk2(s[6 * 33], s[7 * 33]);
        *(u32x4*)(WT + (size_t)(drow0 + n) * ldt + k0 + 8 * c) = o; }
    LDS_WAIT(); asm volatile("" ::: "memory");
}
__device__ __forceinline__ void p_wconv(const Params& P, Frame& F, int l) {
    LAS float* scr = (LAS float*)(F.lds + F.wave * 16384);
    const int gw = F.bid * NWAVES + F.wave, NGW = F.G * NWAVES;
    const float* w_in = P.w_in + (size_t)l * 1024 * INW;
    bf16* WA = WSP(bf16, WS_WA); bf16* WFV = WSP(bf16, WS_WFV);
    constexpr int I_K = 16 * 32, I_Q = 16 * 32, I_P = 16 * 16, I_G = 16 * 96, I_V = 16 * 32, I_AO = 16 * 32, I_FO = 8 * 32, I_OUT = 16 * 32;
    constexpr int NSM = I_K + I_Q + I_P + I_G + I_V + I_AO + I_FO + I_OUT;
    for (int it = gw; it < NSM; it += NGW) {
        int r = it;
        if (r < I_K) { transpose_item(w_in, INW, (r / 32) * 64, 0 + (r % 32) * 32, WA, 1024, 0 + (r % 32) * 32, scr, F.lane); continue; } r -= I_K;
        if (r < I_Q) { transpose_item(w_in, INW, (r / 32) * 64, 2048 + (r % 32) * 32, WA, 1024, 1024 + (r % 32) * 32, scr, F.lane); continue; } r -= I_Q;
        if (r < I_P) { transpose_item(w_in, INW, (r / 16) * 64, 3584 + (r % 16) * 32, WA, 1024, 2048 + (r % 16) * 32, scr, F.lane); continue; } r -= I_P;
        if (r < I_G) { transpose_item(w_in, INW, (r / 96) * 64, 4096 + (r % 96) * 32, WA, 1024, 2560 + (r % 96) * 32, scr, F.lane); continue; } r -= I_G;
        if (r < I_V) { transpose_item(w_in, INW, (r / 32) * 64, 1024 + (r % 32) * 32, WFV, 1024, 1024 + (r % 32) * 32, scr, F.lane); continue; } r -= I_V;
        if (r < I_AO) { transpose_item(P.w_att_o + (size_t)l * 1024 * 1024, 1024, (r / 32) * 64, (r % 32) * 32, WSP(bf16, WS_WAO), 1024, (r % 32) * 32, scr, F.lane); continue; } r -= I_AO;
        if (r < I_FO) { transpose_item(P.w_fourier + (size_t)l * 512 * 1024, 1024, (r / 32) * 64, (r % 32) * 32, WSP(bf16, WS_WFO), 512, (r % 32) * 32, scr, F.lane); continue; } r -= I_FO;
        transpose_item(P.w_out + (size_t)l * 1024 * 1024, 1024, (r / 32) * 64, (r % 32) * 32, WSP(bf16, WS_WOUT), 1024, (r % 32) * 32, scr, F.lane);
    }
    constexpr int I_E = 16 * 88;
    bf16* WGU = WSP(bf16, WS_WGU); bf16* WD = WSP(bf16, WS_WD);
    for (int it = gw; it < 3 * 16 * I_E; it += NGW) {
        const int which = it / (16 * I_E), r0 = it % (16 * I_E), e = r0 / I_E, r = r0 % I_E;
        if (which < 2) { const int kb = r / 88, nb = r % 88, n0 = nb * 32;
            const float* src = (which == 0 ? P.w_eg : P.w_eu) + ((size_t)l * 16 + e) * 1024 * FF;
            transpose_item(src, FF, kb * 64, n0, WGU + (size_t)e * 5632 * 1024, 1024, (n0 >> 7) * 256 + (which ? 128 : 0) + (n0 & 127), scr, F.lane); }
        else { const int kb = r / 32, nb = r % 32;
            transpose_item(P.w_ed + ((size_t)l * 16 + e) * FF * 1024, 1024, kb * 64, nb * 32, WD + (size_t)e * 1024 * FF, FF, nb * 32, scr, F.lane); }
    }
    { bf16* WPO = WSP(bf16, WS_WPO); const float* wp = P.w_pool + (size_t)l * 4 * 128 * 256;
      for (int i = F.bid * NTHREADS + F.tid; i < 1024 * 256; i += F.G * NTHREADS) { const int n = i >> 8, kk = i & 255, g = n >> 8, f = n & 255;
          WPO[i] = (bf16)(((kk >> 7) == (g & 1)) ? f2bf(wp[((size_t)g * 128 + (kk & 127)) * 256 + f]) : 0u); } }
    { LAS float* t128 = (LAS float*)F.lds;
      __syncthreads();
      for (int j = F.tid; j < 128; j += NTHREADS) t128[j] = cospif((float)j * (1.0f / 64.0f));
      __syncthreads();
      for (int i = F.bid * NTHREADS + F.tid; i < 1024 * 1024; i += F.G * NTHREADS) { const int fc = i >> 10, k = i & 1023, cs = fc & 1, gm = fc >> 1, g = gm >> 7, m = gm & 127;
          const float* src = w_in + (size_t)k * INW + 3072 + g * 128; float s = 0.f; const int ph = cs ? 96 : 0;
          for (int c = 0; c < 128; ++c) s += src[c] * t128[(m * c + ph) & 127];
          WFV[i] = (bf16)f2bf(s); }
      __syncthreads(); }
}

struct RowMod { const float* g; const float* sh; const float* sc; };
__device__ __forceinline__ void row_load(const float* row, int lane, f32x4 (&v)[4]) {
#pragma unroll
    for (int j = 0; j < 4; ++j) v[j] = *(const f32x4*)(row + 4 * lane + 256 * j);
}
__device__ __forceinline__ float row_rstd(const f32x4 (&v)[4]) {
    float s = 0.f;
#pragma unroll
    for (int j = 0; j < 4; ++j) s += (v[j][0] * v[j][0] + v[j][1] * v[j][1]) + (v[j][2] * v[j][2] + v[j][3] * v[j][3]);
    return rsqrtf(wave_sum(s) * (1.0f / 1024.0f) + RMS_EPS);
}
__device__ __forceinline__ void row_modulate(const f32x4 (&v)[4], float rstd, const RowMod& M, int lane, f32x4 (&y)[4]) {
#pragma unroll
    for (int j = 0; j < 4; ++j) { const int k = 4 * lane + 256 * j; const f32x4 g = *(const f32x4*)(M.g + k), sh = *(const f32x4*)(M.sh + k), sc = *(const f32x4*)(M.sc + k);
        y[j] = v[j] * rstd * g * (sc + 1.0f) + sh; }
}
__device__ __forceinline__ void row_store_bf(bf16* row, int lane, const f32x4 (&y)[4]) {
#pragma unroll
    for (int j = 0; j < 4; ++j) st_bf4(row + 4 * lane + 256 * j, y[j]);
}
__device__ __forceinline__ const float* mod_ptr(Frame& F, int l, int row, int which) { const int mr = row < RL ? (row >> 12) : 8; return WSP(float, WS_MOD) + ((size_t)l * 9 + mr) * 6144 + which * 1024; }

__device__ __forceinline__ void p_rowpass_a0(const Params& P, Frame& F) {
    const int gw = F.bid * NWAVES + F.wave, NGW = F.G * NWAVES; bf16* H = WSP(bf16, WS_H);
    for (int row = gw; row < RT; row += NGW) {
        const float* src = row < RL ? P.x + (size_t)row * DM : P.ctx + (size_t)(row - RL) * DM;
        f32x4 v[4], y[4]; row_load(src, F.lane, v); const float rs = row_rstd(v);
        RowMod M{P.norm1_g, mod_ptr(F, 0, row, 0), mod_ptr(F, 0, row, 1)};
        row_modulate(v, rs, M, F.lane, y); row_store_bf(H + (size_t)row * DM, F.lane, y);
    }
}
__device__ __forceinline__ void p_rowpass_f(const Params& P, Frame& F, int l, int nrows) {
    const int gw = F.bid * NWAVES + F.wave, NGW = F.G * NWAVES; bf16* H = WSP(bf16, WS_H); float* AFF = WSP(float, WS_AFF);
    const float* wr = P.w_router + (size_t)l * 1024 * 16;
    LAS float* wl = (LAS float*)F.lds;
    __syncthreads();
    for (int i = F.tid; i < 16384; i += NTHREADS) wl[(i & 15) * 1024 + (i >> 4)] = wr[i];
    __syncthreads();
    for (int row = gw; row < nrows; row += NGW) {
        const float* src = row < RL ? P.out + (size_t)row * DM : WSP(float, WS_XC) + (size_t)(row - RL) * DM;
        f32x4 v[4], y[4]; row_load(src, F.lane, v); const float rs = row_rstd(v);
        RowMod M{P.norm2_g + l * 1024, mod_ptr(F, l, row, 3), mod_ptr(F, l, row, 4)};
        row_modulate(v, rs, M, F.lane, y); row_store_bf(H + (size_t)row * DM, F.lane, y);
        float lg[16];
        int wo = 4 * F.lane; asm volatile("" : "+v"(wo));
#pragma unroll
        for (int e = 0; e < 16; ++e) { float a = 0.f;
#pragma unroll
            for (int j = 0; j < 4; ++j) { const f32x4 w = *(const LAS f32x4*)(wl + e * 1024 + wo + 256 * j); a += (y[j][0] * w[0] + y[j][1] * w[1]) + (y[j][2] * w[2] + y[j][3] * w[3]); }
            lg[e] = a; }
        float mx = -1e30f;
#pragma unroll
        for (int e = 0; e < 16; ++e) { lg[e] = wave_sum(lg[e]); mx = fmaxf(mx, lg[e]); }
        float den = 0.f;
#pragma unroll
        for (int e = 0; e < 16; ++e) { lg[e] = __expf(lg[e] - mx); den += lg[e]; }
        const float inv = 1.0f / den;
        if (F.lane < 16) { float mine = 0.f;
#pragma unroll
            for (int e = 0; e < 16; ++e) mine = (F.lane == e) ? lg[e] : mine;
            AFF[(size_t)row * 16 + F.lane] = mine * inv; }
    }
    __syncthreads();
}
__device__ __forceinline__ void p_rowpass_k(const Params& P, Frame& F, int l, int nrows) {
    const int gw = F.bid * NWAVES + F.wave, NGW = F.G * NWAVES; bf16* H = WSP(bf16, WS_H);
    const int* SEL = WSP(int, WS_SEL); const bf16* Y = WSP(bf16, WS_Y);
    for (int row = gw; row < nrows; row += NGW) {
        float* xr = row < RL ? P.out + (size_t)row * DM : WSP(float, WS_XC) + (size_t)(row - RL) * DM;
        f32x4 v[4], a[4]; row_load(xr, F.lane, v);
#pragma unroll
        for (int j = 0; j < 4; ++j) a[j] = (f32x4){0.f, 0.f, 0.f, 0.f};
        for (int e = 0; e < 16; ++e) { const int s = SEL[(size_t)row * 16 + e];
            if (s >= 0) { const bf16* yr = Y + (size_t)s * DM;
#pragma unroll
                for (int j = 0; j < 4; ++j) { const u32x2 w = *(const u32x2*)(yr + 4 * F.lane + 256 * j); a[j][0] += bflo(w.x); a[j][1] += bfhi(w.x); a[j][2] += bflo(w.y); a[j][3] += bfhi(w.y); } } }
        const float* g2 = mod_ptr(F, l, row, 5);
#pragma unroll
        for (int j = 0; j < 4; ++j) { const f32x4 g = *(const f32x4*)(g2 + 4 * F.lane + 256 * j); v[j] = v[j] + g * a[j]; }
        const float rs = row_rstd(v);
        if (l == 0) {
#pragma unroll
            for (int j = 0; j < 4; ++j) *(f32x4*)(xr + 4 * F.lane + 256 * j) = v[j];
            f32x4 y[4]; RowMod M{P.norm1_g + 1024, mod_ptr(F, 1, row, 0), mod_ptr(F, 1, row, 1)};
            row_modulate(v, rs, M, F.lane, y); row_store_bf(H + (size_t)row * DM, F.lane, y);
        } else {
#pragma unroll
            for (int j = 0; j < 4; ++j) { const f32x4 g = *(const f32x4*)(P.final_g + 4 * F.lane + 256 * j); *(f32x4*)(xr + 4 * F.lane + 256 * j) = v[j] * rs * g; }
        }
    }
}

__device__ __forceinline__ float dot64(const bf16x8 (&q)[8], const bf16* kp) {
    float s = 0.f;
#pragma unroll
    for (int i = 0; i < 8; ++i) { const u32x4 kw = *(const u32x4*)(kp + 8 * i); const u32x4 qw = __builtin_bit_cast(u32x4, q[i]);
#pragma unroll
        for (int t = 0; t < 4; ++t) s += bflo(kw[t]) * bflo(qw[t]) + bfhi(kw[t]) * bfhi(qw[t]); }
    return s;
}
__device__ __forceinline__ void p_attn_naive(const Params& P, Frame& F, int l, bool with_ctx_queries) {
    const int gw = F.bid * NWAVES + F.wave, NGW = F.G * NWAVES;
    const bf16* KQ = WSP(bf16, WS_KQ); const bf16* VT = WSP(bf16, WS_VT); bf16* ATT = WSP(bf16, WS_ATT);
    LAS float* pw = (LAS float*)(F.lds + F.wave * 2048);
    const float* rpb = P.rpb + (size_t)l * 16 * 15 * 31;
    const int nlat = NB * 64 * NH * 64, nitems = nlat + (with_ctx_queries ? NB * NH * CTXL : 0);
    for (int it = gw; it < nitems; it += NGW) {
        const bool lat = it < nlat;
        int b, h, r = 0, qc = 0, rowq;
        if (lat) { qc = it & 63; h = (it >> 6) & 15; r = (it >> 10) & 63; b = it >> 16; rowq = b * SEQ + r * 64 + qc; }
        else { const int i2 = it - nlat; qc = i2 & 255; h = (i2 >> 8) & 15; b = i2 >> 12; rowq = RL + b * CTXL + qc; }
        bf16x8 q[8];
        { const bf16* qp = KQ + (size_t)rowq * 2048 + 1024 + h * 64;
#pragma unroll
          for (int i = 0; i < 8; ++i) q[i] = *(const bf16x8*)(qp + 8 * i); }
        const int rs = min(max(r - 4, 0), 56), cs = min(max(qc - 8, 0), 48);
        float s[6];
        if (lat) {
#pragma unroll
            for (int t = 0; t < 2; ++t) { const int w = F.lane + 64 * t, i = w >> 4, j = w & 15; const int tok = (rs + i) * 64 + cs + j;
                s[t] = dot64(q, KQ + (size_t)(b * SEQ + tok) * 2048 + h * 64) * 0.125f + rpb[(h * 15 + (rs + i - r + 7)) * 31 + (cs + j - qc + 15)]; }
        } else { s[0] = -1e30f; s[1] = -1e30f; }
#pragma unroll
        for (int t = 0; t < 4; ++t) { const int c = F.lane + 64 * t; s[2 + t] = dot64(q, KQ + (size_t)(RL + b * CTXL + c) * 2048 + h * 64) * 0.125f; }
        float mx = s[0];
#pragma unroll
        for (int t = 1; t < 6; ++t) mx = fmaxf(mx, s[t]);
        mx = wave_max(mx);
        float sum = 0.f;
#pragma unroll
        for (int t = 0; t < 6; ++t) { s[t] = (lat || t >= 2) ? __expf(s[t] - mx) : 0.f; sum += s[t]; }
        sum = wave_sum(sum);
        pw[F.lane] = s[0]; pw[F.lane + 64] = s[1];
#pragma unroll
        for (int t = 0; t < 4; ++t) pw[128 + F.lane + 64 * t] = s[2 + t];
        LDS_WAIT(); asm volatile("" ::: "memory");
        float o = 0.f;
        if (lat) { const bf16* vr = VT + ((size_t)b * 1024 + h * 64 + F.lane) * 4096;
#pragma unroll 2
            for (int w = 0; w < 128; ++w) { const int tok = (rs + (w >> 4)) * 64 + cs + (w & 15); o += pw[w] * bf2f(vr[tok]); } }
        { const bf16* vr = VT + YT_CTX_OFF + ((size_t)b * 1024 + h * 64 + F.lane) * 256;
#pragma unroll 2
          for (int c8 = 0; c8 < 32; ++c8) { const u32x4 vw = *(const u32x4*)(vr + 8 * c8); const LAS float* pp = pw + 128 + 8 * c8;
#pragma unroll
              for (int t = 0; t < 4; ++t) o += pp[2 * t] * bflo(vw[t]) + pp[2 * t + 1] * bfhi(vw[t]); } }
        ATT[(size_t)rowq * 1024 + h * 64 + F.lane] = (bf16)f2bf(o / sum);
        LDS_WAIT(); asm volatile("" ::: "memory");
    }
}

constexpr int ACK_STRIDE = 72, ACV_STRIDE = 264;
constexpr int ALDS_CK = 0, ALDS_CV = 256 * ACK_STRIDE * 2, ALDS_RP = ALDS_CV + 64 * ACV_STRIDE * 2;
struct AttnState { float m, sum; f32x4 o[4]; };
__device__ __forceinline__ float xrow16_max(float x) {
    auto s = __builtin_amdgcn_permlane16_swap(__float_as_uint(x), __float_as_uint(x), false, false);
    x = fmaxf(__uint_as_float(s[0]), __uint_as_float(s[1]));
    auto t = __builtin_amdgcn_permlane32_swap(__float_as_uint(x), __float_as_uint(x), false, false);
    return fmaxf(__uint_as_float(t[0]), __uint_as_float(t[1]));
}
__device__ __forceinline__ float xrow16_sum(float x) {
    auto s = __builtin_amdgcn_permlane16_swap(__float_as_uint(x), __float_as_uint(x), false, false);
    x = __uint_as_float(s[0]) + __uint_as_float(s[1]);
    auto t = __builtin_amdgcn_permlane32_swap(__float_as_uint(x), __float_as_uint(x), false, false);
    return __uint_as_float(t[0]) + __uint_as_float(t[1]);
}
#define MFMA16(a, b, c) __builtin_amdgcn_mfma_f32_16x16x32_bf16((a), (b), (c), 0, 0, 0)
template <int NT>
__device__ __forceinline__ void attn_tail(AttnState& S, f32x4 (&sc)[NT], const u32x4 (&vw)[NT / 2][4]) {
    float cm = -1e30f;
#pragma unroll
    for (int t = 0; t < NT; ++t)
#pragma unroll
        for (int j = 0; j < 4; ++j) cm = fmaxf(cm, sc[t][j]);
    cm = xrow16_max(cm);
    const float mn = fmaxf(S.m, cm), scl = __builtin_amdgcn_exp2f(S.m - mn); S.m = mn; float ps = 0.f;
#pragma unroll
    for (int t = 0; t < NT; ++t)
#pragma unroll
        for (int j = 0; j < 4; ++j) { const float p = __builtin_amdgcn_exp2f(sc[t][j] - mn); sc[t][j] = p; ps += p; }
    S.sum = S.sum * scl + ps;
#pragma unroll
    for (int dt = 0; dt < 4; ++dt) S.o[dt] = S.o[dt] * scl;
#pragma unroll
    for (int ks = 0; ks < NT / 2; ++ks) { u32x4 pw; pw.x = pk2(sc[2 * ks][0], sc[2 * ks][1]); pw.y = pk2(sc[2 * ks][2], sc[2 * ks][3]); pw.z = pk2(sc[2 * ks + 1][0], sc[2 * ks + 1][1]); pw.w = pk2(sc[2 * ks + 1][2], sc[2 * ks + 1][3]);
        const bf16x8 pf = __builtin_bit_cast(bf16x8, pw);
#pragma unroll
        for (int dt = 0; dt < 4; ++dt) S.o[dt] = MFMA16(__builtin_bit_cast(bf16x8, vw[ks][dt]), pf, S.o[dt]); }
}
__device__ __forceinline__ void attn_unit2(const bf16* __restrict__ KQ, const bf16* __restrict__ VT, bf16* __restrict__ ATT, LAS unsigned char* lds,
                                           const int b, const int h, const int rowqA, const int rowqB, const bool win, const int r, const int qt, const int lane) {
    const int l15 = lane & 15, g = lane >> 4;
    const f32x4 z = {0.f, 0.f, 0.f, 0.f};
    bf16x8 qA[2], qB[2];
    { const bf16* qp = KQ + (size_t)(rowqA + l15) * 2048 + 1024 + h * 64 + 8 * g; qA[0] = *(const bf16x8*)qp; qA[1] = *(const bf16x8*)(qp + 32); }
    { const bf16* qp = KQ + (size_t)(rowqB + l15) * 2048 + 1024 + h * 64 + 8 * g; qB[0] = *(const bf16x8*)qp; qB[1] = *(const bf16x8*)(qp + 32); }
    AttnState SA, SB; SA.m = -1e30f; SA.sum = 0.f; SB.m = -1e30f; SB.sum = 0.f;
#pragma unroll
    for (int dt = 0; dt < 4; ++dt) { SA.o[dt] = z; SB.o[dt] = z; }
    if (win) {
        const int rsA = min(max(r - 4, 0), 56), dB = min(max(r - 3, 0), 56) - rsA, kc0 = min(max(16 * qt - 8, 0), 32);
        const int q = 16 * qt + l15, csq = min(max(q - 8, 0), 48);
        const int krow0 = 8 * (l15 >> 2) + (l15 & 3);
        const bf16* kb = KQ + (size_t)(b * SEQ + kc0 + krow0) * 2048 + h * 64 + 8 * g;
        const bf16* vb = VT + (size_t)(b * 1024 + h * 64 + l15) * 4096 + kc0 + 8 * g;
        const LAS float* rp = (const LAS float*)(lds + ALDS_RP);
        const int jb = kc0 + 8 * g;
        const int okb = jb - csq;
        const LAS float* rpl = rp + 16 + (jb - q + 15);
        float madd[2][4];
#pragma unroll
        for (int t = 0; t < 2; ++t)
#pragma unroll
            for (int j = 0; j < 4; ++j) madd[t][j] = ((unsigned)(okb + 4 * t + j) < 16u) ? 0.f : -__builtin_inff();
        bf16x8 K0[2][2], K1[2][2]; u32x4 V0[1][4], V1[1][4];
#define ATT_LOADW(KB, VB, i) do { const int gr_ = min(rsA + (i), 63); const bf16* kp_ = kb + (size_t)(gr_ * 64) * 2048; const bf16* vp_ = vb + gr_ * 64; \
        _Pragma("unroll") for (int t = 0; t < 2; ++t) { KB[t][0] = *(const bf16x8*)(kp_ + (size_t)(4 * t) * 2048); KB[t][1] = *(const bf16x8*)(kp_ + (size_t)(4 * t) * 2048 + 32); } \
        _Pragma("unroll") for (int dt = 0; dt < 4; ++dt) VB[0][dt] = *(const u32x4*)(vp_ + (size_t)(16 * dt) * 4096); } while (0)
#define ATT_ONE(ST, QF, KB, VB, roff, rowok) do { f32x4 sc[2]; \
        _Pragma("unroll") for (int t = 0; t < 2; ++t) { sc[t] = MFMA16(KB[t][0], QF[0], z); sc[t] = MFMA16(KB[t][1], QF[1], sc[t]); } \
        const LAS float* bp_ = rpl + ((rowok) ? (roff) : 15) * 64; \
        _Pragma("unroll") for (int t = 0; t < 2; ++t) _Pragma("unroll") for (int j = 0; j < 4; ++j) sc[t][j] = (sc[t][j] + bp_[4 * t + j]) + madd[t][j]; \
        attn_tail<2>(ST, sc, VB); } while (0)
#define ATT_COMPUTE(KB, VB, i) do { const int roffA_ = min(rsA + (i) - r + 7, 14); \
        ATT_ONE(SA, qA, KB, VB, roffA_, (i) <= 7); \
        ATT_ONE(SB, qB, KB, VB, max(roffA_ - 1, 0), (i) >= dB && (i) <= 7 + dB); } while (0)
        ATT_LOADW(K0, V0, 0);
#pragma unroll 1
        for (int i = 0; i < 8; i += 2) { ATT_LOADW(K1, V1, i + 1); ATT_COMPUTE(K0, V0, i); ATT_LOADW(K0, V0, i + 2); ATT_COMPUTE(K1, V1, i + 1); }
        ATT_COMPUTE(K0, V0, 8);
#undef ATT_LOADW
#undef ATT_ONE
#undef ATT_COMPUTE
    }
    { const LAS bf16* ck = (const LAS bf16*)(lds + ALDS_CK) + l15 * ACK_STRIDE + 8 * g;
      const LAS bf16* cv = (const LAS bf16*)(lds + ALDS_CV) + l15 * ACV_STRIDE + 8 * g;
#pragma unroll 1
      for (int c = 0; c < 4; ++c) {
          bf16x8 kf[4][2]; u32x4 vw[2][4];
#pragma unroll
          for (int t = 0; t < 4; ++t) { const LAS bf16* kp = ck + (64 * c + 16 * t) * ACK_STRIDE; kf[t][0] = *(const LAS bf16x8*)kp; kf[t][1] = *(const LAS bf16x8*)(kp + 32); }
#pragma unroll
          for (int ks = 0; ks < 2; ++ks)
#pragma unroll
              for (int dt = 0; dt < 4; ++dt) vw[ks][dt] = *(const LAS u32x4*)(cv + (16 * dt) * ACV_STRIDE + 64 * c + 32 * ks);
          { f32x4 sc[4];
#pragma unroll
            for (int t = 0; t < 4; ++t) { sc[t] = MFMA16(kf[t][0], qA[0], z); sc[t] = MFMA16(kf[t][1], qA[1], sc[t]); }
            attn_tail<4>(SA, sc, vw); }
          { f32x4 sc[4];
#pragma unroll
            for (int t = 0; t < 4; ++t) { sc[t] = MFMA16(kf[t][0], qB[0], z); sc[t] = MFMA16(kf[t][1], qB[1], sc[t]); }
            attn_tail<4>(SB, sc, vw); }
      } }
    { const float inv = 1.0f / xrow16_sum(SA.sum);
#pragma unroll
      for (int dt = 0; dt < 4; ++dt) st_bf4(ATT + (size_t)(rowqA + l15) * 1024 + h * 64 + 16 * dt + 4 * g, SA.o[dt] * inv); }
    { const float inv = 1.0f / xrow16_sum(SB.sum);
#pragma unroll
      for (int dt = 0; dt < 4; ++dt) st_bf4(ATT + (size_t)(rowqB + l15) * 1024 + h * 64 + 16 * dt + 4 * g, SB.o[dt] * inv); }
}
__device__ __forceinline__ void p_attn_mfma(const Params& P, Frame& F, int l, bool with_ctx_queries) {
    const bf16* KQ = WSP(bf16, WS_KQ); const bf16* VT = WSP(bf16, WS_VT); bf16* ATT = WSP(bf16, WS_ATT);
    const float* rpb = P.rpb + (size_t)l * 16 * 465;
    for (int hp = F.bid; hp < 256; hp += F.G) {
        const int p = hp & 127, half = hp >> 7, b = p >> 4, h = p & 15;
        __syncthreads();
        { LAS bf16* ck = (LAS bf16*)(F.lds + ALDS_CK); LAS bf16* cv = (LAS bf16*)(F.lds + ALDS_CV); LAS float* rp = (LAS float*)(F.lds + ALDS_RP);
          { const int key = F.tid >> 1, hf = F.tid & 1; const int k32 = key & 31, pos = (key & ~31) + ((k32 >> 2) & 1) * 16 + 4 * (k32 >> 3) + (k32 & 3);
            const u32x4* src = (const u32x4*)(KQ + (size_t)(RL + b * CTXL + key) * 2048 + h * 64 + hf * 32); LAS u32x4* dst = (LAS u32x4*)(ck + pos * ACK_STRIDE + hf * 32);
#pragma unroll
            for (int i = 0; i < 4; ++i) dst[i] = src[i]; }
          { const int d = F.tid >> 3, sg = F.tid & 7; const u32x4* src = (const u32x4*)(VT + YT_CTX_OFF + (size_t)(b * 1024 + h * 64 + d) * 256 + sg * 32); LAS u32x4* dst = (LAS u32x4*)(cv + d * ACV_STRIDE + sg * 32);
#pragma unroll
            for (int i = 0; i < 4; ++i) dst[i] = src[i]; }
          for (int i = F.tid; i < 16 * 64; i += NTHREADS) { const int rr = i >> 6, cc = (i & 63) - 16; rp[i] = rr == 15 ? -__builtin_inff() : ((cc >= 0 && cc < 31) ? rpb[h * 465 + rr * 31 + cc] * LOG2E : 0.f); } }
        __syncthreads();
        const int qt = F.wave & 3, rpi = F.wave >> 2;
#pragma unroll 1
        for (int st = 0; st < 8; ++st) { const int r = half * 32 + st * 4 + rpi * 2; const int rowqA = b * SEQ + r * 64 + 16 * qt;
            attn_unit2(KQ, VT, ATT, F.lds, b, h, rowqA, rowqA + 64, true, r, qt, F.lane); }
        if (with_ctx_queries && half == 0) { const int rowqA = RL + b * CTXL + 32 * F.wave; attn_unit2(KQ, VT, ATT, F.lds, b, h, rowqA, rowqA + 16, false, 0, 0, F.lane); }
    }
    __syncthreads();
}

__device__ __forceinline__ void ld8(const bf16* p, float (&x)[8]) { const u32x4 w = *(const u32x4*)p;
#pragma unroll
    for (int q = 0; q < 4; ++q) { x[2 * q] = bflo(w[q]); x[2 * q + 1] = bfhi(w[q]); } }
__device__ __forceinline__ void p_pool(Frame& F, int nrows) {
    const bf16* PB = WSP(bf16, WS_PB); bf16* POOL = WSP(bf16, WS_POOL);
    for (int i = F.bid * NTHREADS + F.tid; i < (nrows >> 4) * 64; i += F.G * NTHREADS) {
        const int row0 = (i >> 6) << 4, ch = i & 63, g = ch >> 4, hw = 1 << g;
        int base, t0, Lb; if (row0 < RL) { base = row0 & ~4095; t0 = row0 & 4095; Lb = SEQ; } else { const int rr = row0 - RL; base = RL + (rr & ~255); t0 = rr & 255; Lb = CTXL; }
        const bf16* src = PB + (size_t)base * 512 + ch * 8;
        float S[8];
#pragma unroll
        for (int q = 0; q < 8; ++q) S[q] = 0.f;
#pragma unroll 4
        for (int d = -8; d < 8; ++d) { const int tt = t0 + d; if (d >= -hw && d < hw && tt >= 0 && tt < Lb) { float x[8]; ld8(src + (size_t)tt * 512, x);
#pragma unroll
                for (int q = 0; q < 8; ++q) S[q] += x[q]; } }
#pragma unroll 2
        for (int j = 0; j < 16; ++j) { const int t = t0 + j; const int lo = max(t - hw, 0), hi = min(t + hw, Lb); const float inv = 1.0f / (float)(hi - lo);
            float me[8]; ld8(src + (size_t)t * 512, me);
            u32x4 o;
#pragma unroll
            for (int q = 0; q < 4; ++q) o[q] = pk2(S[2 * q] * inv - me[2 * q], S[2 * q + 1] * inv - me[2 * q + 1]);
            *(u32x4*)(POOL + (size_t)(base + t) * 512 + ch * 8) = o;
            if (t + hw < Lb) { float x[8]; ld8(src + (size_t)(t + hw) * 512, x);
#pragma unroll
                for (int q = 0; q < 8; ++q) S[q] += x[q]; }
            if (t - hw >= 0) { float x[8]; ld8(src + (size_t)(t - hw) * 512, x);
#pragma unroll
                for (int q = 0; q < 8; ++q) S[q] -= x[q]; } }
    }
}

__device__ __forceinline__ int block_sum_i(int v, LAS int* sm, int tid) {
    v = wave_sum_i(v);
    __syncthreads();
    if ((tid & 63) == 0) sm[tid >> 6] = v;
    __syncthreads();
    int s = 0;
#pragma unroll
    for (int i = 0; i < 8; ++i) s += sm[i];
    return s;
}
__device__ __forceinline__ int block_excl_scan(int v, LAS int* sm, int tid, int& total) {
    const int lane = tid & 63, w = tid >> 6; int inc = v;
#pragma unroll
    for (int o = 1; o < 64; o <<= 1) { const int t = __builtin_amdgcn_ds_bpermute(((lane - o) & 63) << 2, inc); if (lane >= o) inc += t; }
    __syncthreads();
    if (lane == 63) sm[w] = inc;
    __syncthreads();
    int base = 0; total = 0;
#pragma unroll
    for (int i = 0; i < 8; ++i) { const int s = sm[i]; if (i < w) base += s; total += s; }
    return base + inc - v;
}
template <int NPT>
__device__ __forceinline__ void topk_pair(Frame& F, int row0, int n, int cap, int e, int slot0) {
    LAS int* sm = (LAS int*)F.lds;
    const float* AFF = WSP(float, WS_AFF); int* SROW = WSP(int, WS_SROW); float* SG = WSP(float, WS_SGATE); int* SEL = WSP(int, WS_SEL);
    unsigned key[NPT];
#pragma unroll
    for (int j = 0; j < NPT; ++j) { const int i = F.tid * NPT + j; key[j] = (i < n) ? __float_as_uint(AFF[(size_t)(row0 + i) * 16 + e]) : 0u; }
    unsigned T = 0u;
    for (int bit = 30; bit >= 0; --bit) { const unsigned cand = T | (1u << bit); int cnt = 0;
#pragma unroll
        for (int j = 0; j < NPT; ++j) cnt += (key[j] >= cand) ? 1 : 0;
        cnt = block_sum_i(cnt, sm, F.tid);
        if (cnt >= cap) T = cand; }
    int ngt = 0, neq = 0;
#pragma unroll
    for (int j = 0; j < NPT; ++j) { ngt += (key[j] > T) ? 1 : 0; neq += (key[j] == T) ? 1 : 0; }
    int tot_gt, tot_eq;
    (void)block_excl_scan(ngt, sm, F.tid, tot_gt);
    int eqr = block_excl_scan(neq, sm, F.tid, tot_eq);
    const int need_eq = cap - tot_gt;
    int nsel = 0; bool selj[NPT];
#pragma unroll
    for (int j = 0; j < NPT; ++j) { bool s = key[j] > T; if (key[j] == T && T != 0u) { s = eqr < need_eq; ++eqr; } selj[j] = s; nsel += s ? 1 : 0; }
    int tot_sel; int pos = block_excl_scan(nsel, sm, F.tid, tot_sel);
#pragma unroll
    for (int j = 0; j < NPT; ++j) { const int i = F.tid * NPT + j;
        if (i < n) { const int row = row0 + i;
            if (selj[j]) { const int slot = slot0 + pos; ++pos; SROW[slot] = row; SG[slot] = __uint_as_float(key[j]); SEL[(size_t)row * 16 + e] = slot; }
            else SEL[(size_t)row * 16 + e] = -1; } }
    __syncthreads();
}
__device__ __forceinline__ void p_topk(Frame& F, bool with_ctx) {
    const int npairs = 128 + (with_ctx ? 128 : 0);
    for (int pi = F.bid; pi < npairs; pi += F.G) {
        if (pi < 128) { const int b = pi >> 4, e = pi & 15; topk_pair<8>(F, b * SEQ, SEQ, CAPL, e, e * SLOT_E + b * CAPL); }
        else { const int p2 = pi - 128, b = p2 >> 4, e = p2 & 15; topk_pair<1>(F, RL + b * CTXL, CTXL, CAPC, e, e * SLOT_E + 4096 + b * CAPC); }
    }
}
__device__ __forceinline__ void p_gather(Frame& F, bool with_ctx) {
    const int gw = F.bid * NWAVES + F.wave, NGW = F.G * NWAVES; const bf16* H = WSP(bf16, WS_H); bf16* XG = WSP(bf16, WS_XG); const int* SROW = WSP(int, WS_SROW);
    for (int s = gw; s < NSLOT; s += NGW) { if (!with_ctx && (s % SLOT_E) >= 4096) continue;
        const int row = SROW[s]; const u32x4* src = (const u32x4*)(H + (size_t)row * DM); u32x4* dst = (u32x4*)(XG + (size_t)s * DM);
        dst[F.lane] = src[F.lane]; dst[F.lane + 64] = src[F.lane + 64]; }
}

template <int PH> __global__ void __launch_bounds__(NTHREADS, 2) fwd_kernel(Params P) {
    extern __shared__ __attribute__((aligned(16))) unsigned char lds_raw[];
    Frame F; F.lds = (LAS unsigned char*)lds_raw; F.tid = threadIdx.x; F.lane = F.tid & 63; F.wave = __builtin_amdgcn_readfirstlane(F.tid >> 6); F.G = gridDim.x; F.bid = blockIdx.x; F.ws = P.ws;
    const int wave0 = __builtin_amdgcn_readfirstlane((int)threadIdx.x >> 6);
    volatile LAS unsigned* MISC = (volatile LAS unsigned*)(F.lds + LDS_MISC);
    if (F.tid < 64) MISC[F.tid] = 0u;
    __syncthreads();
    XcdBarrier bar; bar.bar = WSP(unsigned, WS_CTL) + CW_BAR; bar.x = 0; bar.st = MISC + 8;
    if constexpr (PH < 0) bar = xcd_barrier_post(WSP(unsigned, WS_CTL) + CW_BAR, MISC + 8);
#define IN(k) (PH < 0 || PH == (k))
#define REFRESH() do { unsigned on_ = ~0u; asm volatile("" : "+s"(on_)); int t_ = wave0 * 64 + (int)__builtin_amdgcn_mbcnt_hi(on_, __builtin_amdgcn_mbcnt_lo(on_, 0u)); asm volatile("" : "+v"(t_)); F.tid = t_; F.lane = t_ & 63; F.wave = __builtin_amdgcn_readfirstlane(t_ >> 6); } while (0)
#define SEAM(k) do { if constexpr (PH < 0) xcd_barrier(bar); } while (0)

    if (IN(0)) { REP_BEGIN(100) p_mod(P, F); p_dftgen(F); REP_END REP_BEGIN(101) p_wconv(P, F, 0); REP_END }
    SEAM(0);
    if (IN(1)) { p_rowpass_a0(P, F); }
    SEAM(1);
    for (int l = P.l_lo; l < P.l_hi; ++l) {
        constexpr int pb = 2; const bool L0 = (l == 0);
        bf16* H = WSP(bf16, WS_H);
        if (IN(pb + 0)) { REFRESH(); REP_BEGIN(2)
            { GroupSched S; S.init(1, 128, 22, F.G, F.bid, 8, L0 ? 22 : 4, 128, 0);
              const bf16* WA = WSP(bf16, WS_WA);
              auto AD = [=](const Unit& u) { return Operands{H + (size_t)u.pm * 256 * DM, WA + (size_t)u.pn * 256 * DM, DM, DM, 0, DM}; };
              bf16* KQ = WSP(bf16, WS_KQ); bf16* PBp = WSP(bf16, WS_PB); bf16* GB = WSP(bf16, WS_GB);
              auto E = [=](EPI_ARGS) { const int row0 = u.pm * 256;
                  if (u.pn < 8) { const float qs = (u.pn >= 4) ? QSCALE : 1.0f; EPI_FOR8( st_bf8(KQ + (size_t)(row0 + r) * 2048 + u.pn * 256 + c, v0 * qs, v1 * qs); ) }
                  else if (u.pn < 10) { EPI_FOR8( st_bf8(PBp + (size_t)(row0 + r) * 512 + (u.pn - 8) * 256 + c, v0, v1); ) }
                  else { EPI_FOR8( f32x4 s0; f32x4 s1; _Pragma("unroll") for (int j = 0; j < 4; ++j) { s0[j] = sigmoidf_(v0[j]); s1[j] = sigmoidf_(v1[j]); } st_bf8(GB + (size_t)(row0 + r) * 3072 + (u.pn - 10) * 256 + c, s0, s1); ) } };
              GEMM_P(S, AD, E); }
            REFRESH();
            { GroupSched S; const int g1a_units = 128 * 22 + 8 * (L0 ? 22 : 4);
              S.init(1, 8, 128, F.G, (F.bid + F.G - ((g1a_units % F.G) & ~7)) % F.G, L0 ? 8 : 4, 8, L0 ? 0 : 4, 128);
              const bf16* WFV = WSP(bf16, WS_WFV);
              auto AD = [=](const Unit& u) { const bool fmap = (u.pm < 4) && (u.pn < 128); const int t16 = u.pn & 15;
                  const size_t tok0 = fmap ? (size_t)(u.pn >> 4) * SEQ + 64 * ((t16 >> 1) * 8) + (t16 & 1) * 32 : (size_t)u.pn * 256;
                  return Operands{WFV + (size_t)u.pm * 256 * DM, H + tok0 * DM, DM, DM, 0, DM, fmap ? 1 : 0}; };
              bf16* YT = WSP(bf16, WS_YT); bf16* VT = WSP(bf16, WS_VT);
              auto E = [=](EPI_ARGS) { bf16* T = (u.pm < 4) ? YT : VT; const int rr0 = (u.pm & 3) * 256;
                  if (u.pn < 128) { const int b = u.pn >> 4;
                      if (u.pm < 4) { const int t16 = u.pn & 15, l10 = (t16 >> 1) * 8, l20 = (t16 & 1) * 32;
                          EPI_FOR8( const int fc = rr0 + r; st_bf8(T + ((((size_t)b * 512 + (fc >> 1)) * 64 + l20 + (c >> 3)) * 2 + (fc & 1)) * 64 + l10, v0, v1); ) }
                      else { const int l0 = (u.pn & 15) * 256; EPI_FOR8( st_bf8(T + ((size_t)b * 1024 + rr0 + r) * 4096 + l0 + c, v0, v1); ) } }
                  else { const int b = u.pn - 128; EPI_FOR8( st_bf8(T + YT_CTX_OFF + ((size_t)b * 1024 + rr0 + r) * 256 + c, v0, v1); ) } };
              GEMM_P(S, AD, E); }
        REP_END }
        SEAM(pb + 0);
        if (IN(pb + 1)) { REFRESH();
            REP_BEGIN(31) p_attn_mfma(P, F, l, L0); REP_END
            REFRESH();
            REP_BEGIN(32)
            { LAS float* tw = (LAS float*)(F.lds + LDS_TW);
              for (int j = F.tid; j < 4096; j += NTHREADS) tw[j] = cospif((float)j * (1.0f / 2048.0f));
              __syncthreads();
              GroupSched S; S.init(1, 1, 1024, F.G, F.bid);
              const bf16* M1 = WSP(bf16, WS_M1T); const bf16* YF = WSP(bf16, WS_YT); bf16* ZP = WSP(bf16, WS_ZP);
              auto AD = [=](const Unit& u) { return Operands{M1, YF + (size_t)u.pn * 256 * 128, 256, 128, 0, 256}; };
              auto E = [=](EPI_ARGS) {
                  if (wr != 0) return;
                  const int b = u.pn >> 7, gm0 = (u.pn & 127) * 4;
#pragma unroll
                  for (int m = 0; m < 4; ++m) { const int k1 = 16 * m + fr;
#pragma unroll
                      for (int bj = 0; bj < 2; ++bj) { const int l20 = 32 * (wc & 1) + 8 * fq, gm = gm0 + 2 * bj + (wc >> 1);
                          f32x4 zr[2], zi[2];
#pragma unroll
                          for (int n = 0; n < 2; ++n)
#pragma unroll
                              for (int j = 0; j < 4; ++j) { const int ix = k1 * (l20 + 4 * n + j); const float tc = tw[ix], ts = tw[(ix + 3072) & 4095];
                                  const float ur = acc[0][bj][m][n][j], ui = acc[1][bj][m][n][j]; zr[n][j] = ur * tc - ui * ts; zi[n][j] = ur * ts + ui * tc; }
                          bf16* dst = ZP + ((((size_t)b * 64 + k1) * 512 + gm) * 2) * 64 + l20;
                          st_bf8(dst, zr[0], zr[1]); st_bf8(dst + 64, zi[0], zi[1]); } } };
              GEMM_P(S, AD, E); }
            REP_END
        }
        SEAM(pb + 1);
        if (IN(pb + 10)) { REFRESH();
            { GroupSched S; S.init(1, 1, 1024, F.G, F.bid);
              const bf16* M2 = WSP(bf16, WS_M2T); const bf16* ZP = WSP(bf16, WS_ZP); bf16* FOUR = WSP(bf16, WS_FOUR);
              auto AD = [=](const Unit& u) { return Operands{M2, ZP + (size_t)u.pn * 256 * 128, 256, 128, 0, 256}; };
              auto E = [=](EPI_ARGS) {
                  if (wr != 0) return;
                  const int b = u.pn >> 7, k1 = (u.pn >> 1) & 63, gmb = (u.pn & 1) * 256 + wc * 32 + 8 * fq; const float sc = 0.0013810679320049757f;
#pragma unroll
                  for (int m = 0; m < 4; ++m) { const int k2 = 16 * m + fr; bf16* dst = FOUR + ((size_t)b * SEQ + k1 + 64 * k2) * 512 + gmb;
#pragma unroll
                      for (int bj = 0; bj < 2; ++bj) st_bf8(dst + bj * 128, acc[0][bj][m][0] * sc, acc[0][bj][m][1] * sc); } };
              GEMM_P(S, AD, E); }
            REFRESH();
            if (L0) { GroupSched S; S.init(1, 1, 16, F.G, (F.bid + F.G - 128 % F.G) % F.G);
              const bf16* DFTC = WSP(bf16, WS_DFTC); const bf16* YTC = WSP(bf16, WS_YT) + YT_CTX_OFF; bf16* FOUR = WSP(bf16, WS_FOUR);
              auto AD = [=](const Unit& u) { return Operands{DFTC, YTC + (size_t)u.pn * 256 * 512, 512, 512, 0, 512}; };
              auto E = [=](EPI_ARGS) { const int b = u.pn >> 1, c0 = (u.pn & 1) * 256; const float sc = 0.005524271728019903f;
                  EPI_FOR8( st_bf8(FOUR + ((size_t)RL + b * CTXL + r) * 512 + c0 + c, v0 * sc, v1 * sc); ) };
              GEMM_P(S, AD, E); }
            REFRESH();
            REP_BEGIN(33) p_pool(F, L0 ? RT : RL); REP_END
        }
        SEAM(pb + 10);
        if (IN(pb + 2)) { REFRESH();
            SegSched<3> S; S.base.init(1, L0 ? 136 : 128, 4, F.G, F.bid);
            const bf16* ATT = WSP(bf16, WS_ATT); const bf16* FOUR = WSP(bf16, WS_FOUR); const bf16* POOL = WSP(bf16, WS_POOL);
            const bf16* WAO = WSP(bf16, WS_WAO); const bf16* WFO = WSP(bf16, WS_WFO); const bf16* WPO = WSP(bf16, WS_WPO);
            const bf16* GB = WSP(bf16, WS_GB); bf16* MRGB = WSP(bf16, WS_MRGB); const float* ps = P.pool_scale + l * 1024;
            auto AD = [=](const Unit& u) {
                if (u.seg == 0) return Operands{ATT + (size_t)u.pm * 256 * 1024, WAO + (size_t)u.pn * 256 * 1024, 1024, 1024, 0, 1024};
                if (u.seg == 1) return Operands{FOUR + (size_t)u.pm * 256 * 512, WFO + (size_t)u.pn * 256 * 512, 512, 512, 0, 512};
                return Operands{POOL + (size_t)u.pm * 256 * 512 + (u.pn >> 1) * 256, WPO + (size_t)u.pn * 256 * 256, 512, 256, 0, 256}; };
            auto E = [=](EPI_ARGS) {
                const int kd = u.seg < 2 ? u.seg + 1 : 2; const bool fin = (u.seg == 2); const int colb = u.pn * 256 + wc * 32 + 8 * fq;
#pragma unroll
                for (int ai = 0; ai < 2; ++ai)
#pragma unroll
                    for (int m = 0; m < 4; ++m) { const size_t row = (size_t)u.pm * 256 + ai * 128 + wr * 64 + m * 16 + fr; const bf16* gr = GB + row * 3072 + colb;
                        u32x4 nr[2], dr[2]; f32x4 psv[2][2];
#pragma unroll
                        for (int bj = 0; bj < 2; ++bj) { nr[bj] = *(const u32x4*)(gr + u.seg * 1024 + bj * 128); dr[bj] = *(const u32x4*)(gr + kd * 1024 + bj * 128);
                            psv[bj][0] = *(const f32x4*)(ps + colb + bj * 128); psv[bj][1] = *(const f32x4*)(ps + colb + bj * 128 + 4); }
#pragma unroll
                        for (int bj = 0; bj < 2; ++bj) { f32x4 o[2];
#pragma unroll
                            for (int n = 0; n < 2; ++n) { f32x4 nu = {bflo(nr[bj][2 * n]), bfhi(nr[bj][2 * n]), bflo(nr[bj][2 * n + 1]), bfhi(nr[bj][2 * n + 1])}, de = {bflo(dr[bj][2 * n]), bfhi(dr[bj][2 * n]), bflo(dr[bj][2 * n + 1]), bfhi(dr[bj][2 * n + 1])};
                                if (u.seg == 2) nu = nu * psv[bj][n];
                                de = de * psv[bj][n];
#pragma unroll
                                for (int j = 0; j < 4; ++j) { const float nj = (fabsf(nu[j]) < 1e-30f) ? copysignf(1e-30f, nu[j]) : nu[j]; const float dj = (fabsf(de[j]) < 1e-30f) ? copysignf(1e-30f, de[j]) : de[j];
                                    o[n][j] = acc[ai][bj][m][n][j] * nj * (fin ? 1.0f : __builtin_amdgcn_rcpf(dj)); }
                                acc[ai][bj][m][n] = o[n]; }
                            if (fin) st_bf8(MRGB + row * 1024 + colb + bj * 128, o[0], o[1]); } } };
            gemm_fast<false, true>(F.lds, F.tid, S, AD, mk_epi_seg(E, 2), nullptr);
        }
        SEAM(pb + 2);
        if (IN(pb + 3)) { REFRESH();
            GroupSched S; S.init(1, L0 ? 136 : 128, 4, F.G, F.bid); const bf16* A = WSP(bf16, WS_MRGB); const bf16* W = WSP(bf16, WS_WOUT);
            const float* xin = L0 ? P.x : P.out; const float* cin = L0 ? P.ctx : WSP(float, WS_XC); float* xo = P.out; float* co = WSP(float, WS_XC);
            const float* MOD = WSP(float, WS_MOD) + (size_t)l * 9 * 6144;
            auto AD = [=](const Unit& u) { return Operands{A + (size_t)u.pm * 256 * 1024, W + (size_t)u.pn * 256 * 1024, 1024, 1024, 0, 1024}; };
            auto E = [=](EPI_ARGS) {
                const int row0 = u.pm * 256, mr = row0 < RL ? (row0 >> 12) : 8, colb = u.pn * 256 + wc * 32 + 4 * fq;
                const float* src0 = row0 < RL ? xin + (size_t)row0 * DM : cin + (size_t)(row0 - RL) * DM; float* dst0 = row0 < RL ? xo + (size_t)row0 * DM : co + (size_t)(row0 - RL) * DM;
                f32x4 gv[2][2];
#pragma unroll
                for (int bj = 0; bj < 2; ++bj)
#pragma unroll
                    for (int n = 0; n < 2; ++n) gv[bj][n] = *(const f32x4*)(MOD + (size_t)mr * 6144 + 2048 + colb + bj * 128 + n * 16);
#pragma unroll
                for (int ai = 0; ai < 2; ++ai)
#pragma unroll
                    for (int m = 0; m < 4; ++m) { const size_t ro = (size_t)(ai * 128 + wr * 64 + m * 16 + fr) * DM + colb; f32x4 xv[2][2];
#pragma unroll
                        for (int bj = 0; bj < 2; ++bj)
#pragma unroll
                            for (int n = 0; n < 2; ++n) xv[bj][n] = *(const f32x4*)(src0 + ro + bj * 128 + n * 16);
#pragma unroll
                        for (int bj = 0; bj < 2; ++bj)
#pragma unroll
                            for (int n = 0; n < 2; ++n) *(f32x4*)(dst0 + ro + bj * 128 + n * 16) = xv[bj][n] + gv[bj][n] * acc[ai][bj][m][n]; } };
            GEMM(S, AD, E, 1024, 1024, 1024);
        }
        SEAM(pb + 3);
        if (IN(pb + 4)) { REFRESH(); REP_BEGIN(6) p_rowpass_f(P, F, l, L0 ? RT : RL); REP_END }
        SEAM(pb + 4);
        if (IN(pb + 5)) { REFRESH(); REP_BEGIN(7) p_topk(F, L0); REP_END }
        SEAM(pb + 5);
        if (IN(pb + 7)) { REFRESH(); REP_BEGIN(9)
            GroupSched S; S.init(16, L0 ? 17 : 16, 22, F.G, F.bid); const bf16* W = WSP(bf16, WS_WGU); bf16* HID = WSP(bf16, WS_HID); const int* SROW = WSP(int, WS_SROW);
            auto AD = [=](const Unit& u) { return Operands{H, W + ((size_t)u.grp * 5632 + u.pn * 256) * DM, DM, DM, u.grp * SLOT_E + u.pm * 256, DM}; };
            auto E = [=](EPI_ARGS) {
#pragma unroll
                for (int ai = 0; ai < 2; ++ai)
#pragma unroll
                    for (int m = 0; m < 4; ++m) { const size_t slot = (size_t)u.grp * SLOT_E + u.pm * 256 + ai * 128 + wr * 64 + m * 16 + fr; f32x4 o[2];
#pragma unroll
                        for (int n = 0; n < 2; ++n) { const f32x4 a = acc[ai][0][m][n], up = acc[ai][1][m][n];
#pragma unroll
                            for (int j = 0; j < 4; ++j) o[n][j] = a[j] * sigmoidf_(a[j]) * up[j]; }
                        st_bf8(HID + slot * FF + u.pn * 128 + wc * 32 + 8 * fq, o[0], o[1]); } };
            GEMM_GATHER(S, AD, E, DM, DM, DM, SROW);
        REP_END }
        SEAM(pb + 7);
        if (IN(pb + 8)) { REFRESH(); REP_BEGIN(10)
            const int tpe = L0 ? 17 : 16;
            GroupSched S; S.init(1, 16 * tpe, 4, F.G, F.bid); const bf16* HID = WSP(bf16, WS_HID); const bf16* W = WSP(bf16, WS_WD); bf16* Y = WSP(bf16, WS_Y); const float* SG = WSP(float, WS_SGATE);
            auto AD = [=](const Unit& u) { const int e = u.pm / tpe, st = e * 17 + (u.pm - e * tpe); return Operands{HID + (size_t)st * 256 * FF, W + ((size_t)e * 1024 + u.pn * 256) * FF, FF, FF, 0, FF}; };
            auto E = [=](EPI_ARGS) { const int e = u.pm / tpe; const size_t slot0 = (size_t)(e * 17 + (u.pm - e * tpe)) * 256 + wr * 64 + fr; float gt[2][4];
#pragma unroll
                for (int ai = 0; ai < 2; ++ai)
#pragma unroll
                    for (int m = 0; m < 4; ++m) gt[ai][m] = SG[slot0 + ai * 128 + m * 16];
#pragma unroll
                for (int ai = 0; ai < 2; ++ai)
#pragma unroll
                    for (int m = 0; m < 4; ++m)
#pragma unroll
                        for (int bj = 0; bj < 2; ++bj) st_bf8(Y + (slot0 + ai * 128 + m * 16) * DM + u.pn * 256 + bj * 128 + wc * 32 + 8 * fq, acc[ai][bj][m][0] * gt[ai][m], acc[ai][bj][m][1] * gt[ai][m]); };
            GEMM_P(S, AD, E);
        REP_END }
        SEAM(pb + 8);
        if (IN(pb + 9)) { REFRESH(); p_rowpass_k(P, F, l, L0 ? RT : RL); if (L0) p_wconv(P, F, 1); }
        if (L0) SEAM(pb + 9);
    }
#undef IN
#undef SEAM
}
template <int PH> static void launch_ph(int grid, const Params& p, hipStream_t stream) { hipLaunchKernelGGL(fwd_kernel<PH>, dim3(grid), dim3(NTHREADS), LDS_BYTES, stream, p); }
template <int PH> static bool set_attr() { return hipFuncSetAttribute((const void*)fwd_kernel<PH>, hipFuncAttributeMaxDynamicSharedMemorySize, LDS_BYTES) == hipSuccess; }

#ifndef DUP_LAUNCH
#define DUP_LAUNCH -1
#endif
extern "C" void kernel_launch(void* const* d_in, const int* in_sizes, int n_in, void* d_out, int out_size, void* d_ws, size_t ws_size, hipStream_t stream) {
    static int grid = 0;
    if (grid == 0) {
        if (n_in != 20 || out_size != RL * DM || ws_size < WS_END) { fprintf(stderr, "kernel_launch: unexpected shapes (n_in %d out %d ws %zu need %zu)\n", n_in, out_size, ws_size, (size_t)WS_END); grid = -1; return; }
        int dev = 0, cus = 0, per_cu = 0;
        if (hipGetDevice(&dev) != hipSuccess || hipDeviceGetAttribute(&cus, hipDeviceAttributeMultiprocessorCount, dev) != hipSuccess) { grid = -1; return; }
#if N_LAUNCH_MODE == 1
        if (!set_attr<-1>()) { fprintf(stderr, "kernel_launch: hipFuncSetAttribute failed\n"); grid = -1; return; }
        if (hipOccupancyMaxActiveBlocksPerMultiprocessor(&per_cu, (const void*)fwd_kernel<-1>, NTHREADS, LDS_BYTES) != hipSuccess || per_cu < 1) fprintf(stderr, "kernel_launch: occupancy query reports %d\n", per_cu);
#else
        if (!(set_attr<0>() && set_attr<1>() && set_attr<2>() && set_attr<3>() && set_attr<12>() && set_attr<4>() && set_attr<5>() && set_attr<6>() && set_attr<7>() && set_attr<9>() && set_attr<10>() && set_attr<11>())) { fprintf(stderr, "kernel_launch: hipFuncSetAttribute failed\n"); grid = -1; return; }
        (void)per_cu;
#endif
        (void)hipGetLastError();
        grid = cus;
    }
    if (grid < 0) return;
    if (hipMemsetAsync((char*)d_ws + WS_CTL, 0, CTL_BYTES, stream) != hipSuccess) return;
    Params p{};
    const float** pp = (const float**)&p;
    for (int i = 0; i < 20; ++i) pp[i] = (const float*)d_in[i];
    p.out = (float*)d_out; p.ws = (unsigned char*)d_ws;
#if N_LAUNCH_MODE == 1
    p.l_lo = 0; p.l_hi = 2;
    launch_ph<-1>(grid, p, stream);
#else
    p.l_lo = 0; p.l_hi = 0; launch_ph<0>(grid, p, stream); if (DUP_LAUNCH == 0) launch_ph<0>(grid, p, stream); launch_ph<1>(grid, p, stream); if (DUP_LAUNCH == 1) launch_ph<1>(grid, p, stream);
#define LP(k) do { launch_ph<k>(grid, p, stream); if (DUP_LAUNCH == (k) && l == 0) launch_ph<k>(grid, p, stream); } while (0)
    for (int l = 0; l < 2; ++l) { p.l_lo = l; p.l_hi = l + 1;
        LP(2); LP(3); LP(12); LP(4); LP(5); LP(6); LP(7); LP(9); LP(10); LP(11); }
#endif
}
```

```cpp
#include <hip/hip_runtime.h>
#include <cstdio>
#include <cstdint>

#ifndef N_LAUNCH_MODE
#define N_LAUNCH_MODE 1
#endif

#define GAS __attribute__((address_space(1)))
#define LAS __attribute__((address_space(3)))
typedef unsigned short bf16;
typedef short bf16x8 __attribute__((ext_vector_type(8)));
typedef float f32x4 __attribute__((ext_vector_type(4)));
typedef unsigned u32x4 __attribute__((ext_vector_type(4)));
typedef unsigned u32x2 __attribute__((ext_vector_type(2)));

constexpr int NB = 8, SEQ = 4096, DM = 1024, CTXL = 256, NH = 16, HD = 64, GRIDW = 64;
constexpr int RL = NB * SEQ, RC = NB * CTXL, RT = RL + RC;
constexpr int INW = 7168, NE = 16, FF = 2816, CAPL = 512, CAPC = 32;
constexpr int SLOT_E = 4352, NSLOT = NE * SLOT_E;
constexpr float RMS_EPS = 1e-6f;
constexpr float LOG2E = 1.4426950408889634f, QSCALE = 0.125f * LOG2E;
constexpr int NWAVES = 8, NTHREADS = 512;

constexpr size_t al256(size_t x) { return (x + 255) & ~(size_t)255; }
constexpr size_t WS_CTL = 0, CTL_BYTES = 1u << 20;
constexpr size_t WS_MOD = WS_CTL + CTL_BYTES;
constexpr size_t WS_XC = al256(WS_MOD + (size_t)2 * 9 * 6144 * 4);
constexpr size_t WS_AFF = al256(WS_XC + (size_t)RC * DM * 4);
constexpr size_t WS_SROW = al256(WS_AFF + (size_t)RT * 16 * 4);
constexpr size_t WS_SGATE = al256(WS_SROW + (size_t)NSLOT * 4);
constexpr size_t WS_SEL = al256(WS_SGATE + (size_t)NSLOT * 4);
constexpr size_t WS_DFTM = al256(WS_SEL + (size_t)RT * 16 * 4);
constexpr size_t WS_DFTC = al256(WS_DFTM + (size_t)4096 * 8192 * 2);
constexpr size_t WS_WA = al256(WS_DFTC + (size_t)256 * 512 * 2);
constexpr size_t WS_WFV = al256(WS_WA + (size_t)5632 * 1024 * 2);
constexpr size_t WS_WAO = al256(WS_WFV + (size_t)2048 * 1024 * 2);
constexpr size_t WS_WFO = al256(WS_WAO + (size_t)1024 * 1024 * 2);
constexpr size_t WS_WPO = al256(WS_WFO + (size_t)1024 * 512 * 2);
constexpr size_t WS_WOUT = al256(WS_WPO + (size_t)1024 * 256 * 2);
constexpr size_t WS_WGU = al256(WS_WOUT + (size_t)1024 * 1024 * 2);
constexpr size_t WS_WD = al256(WS_WGU + (size_t)16 * 5632 * 1024 * 2);
constexpr size_t WS_H = al256(WS_WD + (size_t)16 * 1024 * 2816 * 2);
constexpr size_t WS_R = al256(WS_H + (size_t)RT * DM * 2);
constexpr size_t WS_KQ = WS_R;
constexpr size_t WS_MRG = WS_KQ;
constexpr size_t WS_PB = al256(WS_KQ + (size_t)RT * 2048 * 2);
constexpr size_t WS_GB = al256(WS_PB + (size_t)RT * 512 * 2);
constexpr size_t WS_YT = al256(WS_GB + (size_t)RT * 3072 * 2);
constexpr size_t WS_MRGB = WS_YT;
constexpr size_t WS_VT = al256(WS_YT + (size_t)RT * 1024 * 2);
constexpr size_t WS_FOUR = al256(WS_VT + (size_t)RT * 1024 * 2);
constexpr size_t WS_ATT = al256(WS_FOUR + (size_t)RT * 512 * 2);
constexpr size_t WS_POOL = al256(WS_ATT + (size_t)RT * 1024 * 2);
constexpr size_t WS_MIX_END = al256(WS_POOL + (size_t)RT * 512 * 2);
constexpr size_t WS_XG = WS_R;
constexpr size_t WS_HID = al256(WS_XG + (size_t)NSLOT * 1024 * 2);
constexpr size_t WS_Y = al256(WS_HID + (size_t)NSLOT * 2816 * 2);
constexpr size_t WS_MOE_END = al256(WS_Y + (size_t)NSLOT * 1024 * 2);
constexpr size_t WS_END0 = WS_MIX_END > WS_MOE_END ? WS_MIX_END : WS_MOE_END;
constexpr size_t WS_ZP = WS_END0;
constexpr size_t WS_M1T = al256(WS_ZP + ((size_t)8 * 64 * 512 * 128 + 1024) * 2);
constexpr size_t WS_M2T = al256(WS_M1T + (size_t)256 * 256 * 2);
constexpr size_t WS_END = al256(WS_M2T + (size_t)256 * 256 * 2);
constexpr size_t YT_CTX_OFF = (size_t)8 * 1024 * 4096;

constexpr int CW_BAR = 4096;

constexpr int LDS_BYTES = 155648;
constexpr int LDS_TW = 132096;
constexpr int LDS_MISC = 131072;

__device__ __forceinline__ unsigned f2bf(float f) { unsigned u = __float_as_uint(f); return (u + 0x7fffu + ((u >> 16) & 1u)) >> 16; }
typedef __bf16 hbf16x2 __attribute__((ext_vector_type(2)));
typedef float f32x2 __attribute__((ext_vector_type(2)));
__device__ __forceinline__ unsigned pk2(float lo, float hi) { const f32x2 v = {lo, hi}; return __builtin_bit_cast(unsigned, __builtin_convertvector(v, hbf16x2)); }
__device__ __forceinline__ float bf2f(unsigned b) { return __uint_as_float(b << 16); }
__device__ __forceinline__ float bflo(unsigned w) { return __uint_as_float(w << 16); }
__device__ __forceinline__ float bfhi(unsigned w) { return __uint_as_float(w & 0xffff0000u); }
template <int CTRL> __device__ __forceinline__ float dppf(float x) { return __builtin_bit_cast(float, __builtin_amdgcn_mov_dpp(__builtin_bit_cast(int, x), CTRL, 0xf, 0xf, true)); }
template <int CTRL> __device__ __forceinline__ int dppi(int x) { return __builtin_amdgcn_mov_dpp(x, CTRL, 0xf, 0xf, true); }
constexpr int DPP_XOR1 = 0xB1, DPP_XOR2 = 0x4E, DPP_ROR4 = 0x124, DPP_ROR8 = 0x128;
__device__ __forceinline__ float wave_sum(float v) {
    v += dppf<DPP_XOR1>(v); v += dppf<DPP_XOR2>(v); v += dppf<DPP_ROR4>(v); v += dppf<DPP_ROR8>(v);
    auto s = __builtin_amdgcn_permlane16_swap(__float_as_uint(v), __float_as_uint(v), false, false); v = __uint_as_float(s[0]) + __uint_as_float(s[1]);
    auto t = __builtin_amdgcn_permlane32_swap(__float_as_uint(v), __float_as_uint(v), false, false); return __uint_as_float(t[0]) + __uint_as_float(t[1]);
}
__device__ __forceinline__ float wave_max(float v) {
    v = fmaxf(v, dppf<DPP_XOR1>(v)); v = fmaxf(v, dppf<DPP_XOR2>(v)); v = fmaxf(v, dppf<DPP_ROR4>(v)); v = fmaxf(v, dppf<DPP_ROR8>(v));
    auto s = __builtin_amdgcn_permlane16_swap(__float_as_uint(v), __float_as_uint(v), false, false); v = fmaxf(__uint_as_float(s[0]), __uint_as_float(s[1]));
    auto t = __builtin_amdgcn_permlane32_swap(__float_as_uint(v), __float_as_uint(v), false, false); return fmaxf(__uint_as_float(t[0]), __uint_as_float(t[1]));
}
__device__ __forceinline__ int wave_sum_i(int v) {
    v += dppi<DPP_XOR1>(v); v += dppi<DPP_XOR2>(v); v += dppi<DPP_ROR4>(v); v += dppi<DPP_ROR8>(v);
    auto s = __builtin_amdgcn_permlane16_swap((unsigned)v, (unsigned)v, false, false); v = (int)(s[0] + s[1]);
    auto t = __builtin_amdgcn_permlane32_swap((unsigned)v, (unsigned)v, false, false); return (int)(t[0] + t[1]);
}
__device__ __forceinline__ float sigmoidf_(float x) { return __builtin_amdgcn_rcpf(1.f + __builtin_amdgcn_exp2f(x * -1.4426950408889634f)); }
#define LDS_WAIT() asm volatile("s_waitcnt lgkmcnt(0)" ::: "memory")

#define XB_TMO      128
#define XB_XCNT(j)  (256  + 64 * (j))
#define XB_XSUB(j)  (1280 + 64 * (j))
#define XB_XGEN(j)  (2304 + 64 * (j))
#define XB_TOP      3328
#define XB_TOPGEN   3392
#define XCD_BAR_WORDS 3456
#define XB_SPIN_CAP (1u << 22)

__device__ __forceinline__ unsigned xb_ld(unsigned* p)              { return __hip_atomic_load(p, __ATOMIC_RELAXED, __HIP_MEMORY_SCOPE_AGENT); }
__device__ __forceinline__ unsigned xb_add(unsigned* p, unsigned v) { return __hip_atomic_fetch_add(p, v, __ATOMIC_RELAXED, __HIP_MEMORY_SCOPE_AGENT); }
__device__ __forceinline__ unsigned xb_xcc_id() { return (unsigned)__builtin_amdgcn_s_getreg((3 << 11) | 20) & 0xFu; }
#define XB_SPIN(cond, bar) do { unsigned _sp = 0; while (cond) { __builtin_amdgcn_s_sleep(1); \
    if ((++_sp & 255u) == 0u) { if (xb_ld(&(bar)[XB_TMO])) break; if (_sp > XB_SPIN_CAP) { atomicAdd(&(bar)[XB_TMO], 1u); break; } } } } while (0)

struct XcdBarrier { unsigned* bar; unsigned x; volatile LAS unsigned* st; };

__device__ __forceinline__ XcdBarrier xcd_barrier_post(unsigned* bar, volatile LAS unsigned* st) {
    XcdBarrier b; b.bar = bar; b.x = xb_xcc_id(); b.st = st;
    if (threadIdx.x == 0) (void)xb_add(&bar[XB_XCNT(b.x)], 1u);
    return b;
}
__device__ __forceinline__ void xcd_barrier_complete(unsigned* bar, unsigned x, unsigned& nloc, unsigned& nx) {
    const unsigned G = gridDim.x * gridDim.y * gridDim.z;
    unsigned sum, cnt, mine, sp = 0u;
    for (;;) {
        sum = 0u; cnt = 0u; mine = 0u;
#pragma unroll
        for (unsigned j = 0; j < 16; ++j) { const unsigned c = xb_ld(&bar[XB_XCNT(j)]); sum += c; cnt += (c > 0u) ? 1u : 0u; mine = (j == x) ? c : mine; }
        if (sum == G) break;
        __builtin_amdgcn_s_sleep(1);
        if ((++sp & 255u) == 0u) { if (xb_ld(&bar[XB_TMO])) break; if (sp > XB_SPIN_CAP) { atomicAdd(&bar[XB_TMO], 1u); break; } }
    }
    nloc = mine > 0u ? mine : 1u; nx = cnt > 0u ? cnt : 1u;
}
__device__ __forceinline__ void xcd_barrier(const XcdBarrier& b) {
    asm volatile("s_waitcnt vmcnt(0)" ::: "memory");
    __syncthreads();
    if (threadIdx.x == 0) {
        unsigned* bar = b.bar;
        __builtin_amdgcn_s_waitcnt(0);
        unsigned nloc = b.st[0], nx = b.st[1];
        if (nloc == 0u) { xcd_barrier_complete(bar, b.x, nloc, nx); b.st[0] = nloc; b.st[1] = nx; }
        const unsigned old = xb_add(&bar[XB_XSUB(b.x)], 1u);
        const unsigned gen = old / nloc;
        if (old + 1u == (gen + 1u) * nloc) {
            __builtin_amdgcn_fence(__ATOMIC_RELEASE, "agent");
            asm volatile("s_waitcnt vmcnt(0)" ::: "memory");
            const unsigned og = xb_add(&bar[XB_TOP], 1u);
            const unsigned tg = og / nx;
            if (og + 1u == (tg + 1u) * nx) xb_add(&bar[XB_TOPGEN], 1u);
            else XB_SPIN(xb_ld(&bar[XB_TOPGEN]) == tg, bar);
            __builtin_amdgcn_fence(__ATOMIC_ACQUIRE, "agent");
            xb_add(&bar[XB_XGEN(b.x)], 1u);
            asm volatile("s_waitcnt vmcnt(0)" ::: "memory");
        } else {
            XB_SPIN(xb_ld(&bar[XB_XGEN(b.x)]) == gen, bar);
            __builtin_amdgcn_fence(__ATOMIC_ACQUIRE, "agent");
            asm volatile("s_waitcnt vmcnt(0)" ::: "memory");
        }
    }
    __syncthreads();
}

struct Params {
    const float *x, *c, *ctx, *c_ctx, *ada_w, *ada_b, *norm1_g, *norm2_g, *w_in, *rpb, *w_att_o, *w_fourier, *w_pool, *pool_scale, *w_out, *w_router, *w_eg, *w_eu, *w_ed, *final_g;
    float* out; unsigned char* ws; int l_lo, l_hi;
};
struct Frame {
    LAS unsigned char* lds;
    int tid, lane, wave, G, bid;
    unsigned char* ws;
};
#define WSP(T, off) ((T*)(F.ws + (off)))

struct Unit { int grp, pm, pn, seg; };
struct GroupSched {
    int ng, nM, nN, G, c; int tM, tN, tpm0, tpn0;
    __device__ __forceinline__ void init(int ng_, int nM_, int nN_, int G_, int c_, int tM_ = 0, int tN_ = 0, int tpm0_ = 0, int tpn0_ = 0) { ng = ng_; nM = nM_; nN = nN_; G = G_; c = c_; tM = tM_; tN = tN_; tpm0 = tpm0_; tpn0 = tpn0_; }
    __device__ __forceinline__ bool next(int i, Unit& u) const {
        const int per = nM * nN; const int L = i * G + c;
        if (L < ng * per) {
            u.grp = L / per; int wgid = L - u.grp * per;
            { const int q = per / 8, r = per % 8, xcd = wgid % 8, off = wgid / 8; wgid = (xcd < r ? xcd * (q + 1) : r * (q + 1) + (xcd - r) * q) + off; }
            const int nig = 8 * nN, gid = wgid / nig, fm = gid * 8, gsz = (nM - fm) < 8 ? (nM - fm) : 8;
            u.pm = fm + ((wgid % nig) % gsz); u.pn = (wgid % nig) / gsz; u.seg = 0; return true;
        }
        const int w = L - ng * per;
        if (w < tM * tN) { u.grp = ng; u.pm = tpm0 + (w % tM); u.pn = tpn0 + (w / tM); u.seg = 0; return true; }
        return false;
    }
};
struct Operands { const bf16* A; const bf16* Bt; int lda, ldb, slot0, K; int bmap; };

template <class Addr, class Epi>
__device__ __forceinline__ void gemm_simple(const GroupSched& S, const Addr& AD, const Epi& E, int K) {
    const int tid = threadIdx.x, wid = __builtin_amdgcn_readfirstlane(tid >> 6), lane = tid & 63, wr = wid >> 2, wc = wid & 3, fr = lane & 15, fq = lane >> 4;
    Unit u;
    for (int i = 0; S.next(i, u); ++i) {
        const Operands op = AD(u);
        f32x4 acc[2][2][4][2];
#pragma unroll
        for (int a = 0; a < 2; ++a)
#pragma unroll
            for (int b = 0; b < 2; ++b)
#pragma unroll
                for (int m = 0; m < 4; ++m)
#pragma unroll
                    for (int n = 0; n < 2; ++n) acc[a][b][m][n] = (f32x4){0.f, 0.f, 0.f, 0.f};
        const bf16* ap = op.A + (size_t)(wr * 64 + fr) * op.lda + fq * 8;
        const bf16* bp = op.Bt + (size_t)(wc * 32 + fr) * op.ldb + fq * 8;
#pragma unroll 1
        for (int k = 0; k < K; k += 32) {
            bf16x8 bfr[2][2];
#pragma unroll
            for (int b = 0; b < 2; ++b)
#pragma unroll
                for (int n = 0; n < 2; ++n) bfr[b][n] = *(const bf16x8*)(bp + (size_t)(b * 128 + n * 16) * op.ldb + k);
#pragma unroll
            for (int a = 0; a < 2; ++a) {
                bf16x8 af[4];
#pragma unroll
                for (int m = 0; m < 4; ++m) af[m] = *(const bf16x8*)(ap + (size_t)(a * 128 + m * 16) * op.lda + k);
#pragma unroll
                for (int b = 0; b < 2; ++b)
#pragma unroll
                    for (int m = 0; m < 4; ++m)
#pragma unroll
                        for (int n = 0; n < 2; ++n) acc[a][b][m][n] = __builtin_amdgcn_mfma_f32_16x16x32_bf16(bfr[b][n], af[m], acc[a][b][m][n], 0, 0, 0);
            }
        }
        E(acc, u, wr, wc, fr, fq);
    }
}
constexpr int HTB = 128 * 64 * 2;
__device__ __forceinline__ int lds_byte(int r, int c) { const int st = (r >> 4) * 2 + (c >> 5), rr = r & 15, cc = c & 31, ob = rr * 64 + cc * 2; return st * 1024 + (ob ^ (((ob >> 9) & 1) << 5)); }
__device__ __forceinline__ int perm32(int rho) { const int n = rho >> 4, i = rho & 15; return 8 * (i >> 2) + 4 * n + (i & 3); }
__device__ __forceinline__ void stage_rc(int b, int& R, int& C) { const int st = b / 1024, sb = b % 1024, swz = sb ^ (((sb >> 9) & 1) << 5); R = (st >> 1) * 16 + swz / 64; C = (st & 1) * 32 + (swz % 64) / 2; }
template <bool GATHER, bool PERM, class Sched, class Addr, class Epi>
__device__ __forceinline__ void gemm_fast(LAS unsigned char* lds, const int tid, const Sched& S, const Addr& AD, const Epi& E, const int* __restrict__ grows) {
    const int wid = __builtin_amdgcn_readfirstlane(tid >> 6), lane = tid & 63, wr = wid >> 2, wc = wid & 3, fr = lane & 15, fq = lane >> 4;
    int sR[2], sRb[2]; unsigned sC[2];
    unsigned cvg[2][2], nvg[2][2], cvb[2][2], nvb[2][2];
#pragma unroll
    for (int i = 0; i < 2; ++i) { int R, C; stage_rc(tid * 16 + i * 8192, R, C); sR[i] = R; sC[i] = (unsigned)C * 2u; sRb[i] = PERM ? ((R & ~31) + perm32(R & 31)) : R; }
    const size_t kstep = 128;
    const unsigned ldsw = (unsigned)wid * 1024u;
    const int aoff = lds_byte(wr * 64 + fr, fq * 8), boff = lds_byte(wc * 32 + fr, fq * 8);
#define PG8_SA(b, h) (((b) * 2 + (h)) * HTB)
#define PG8_SB(b, h) ((4 + (b) * 2 + (h)) * HTB)
#define PG8_STAGE(bufoff, gbase, voff) do { _Pragma("unroll") for (int _i = 0; _i < 2; ++_i) \
        __builtin_amdgcn_global_load_lds((const unsigned*)((const char*)(gbase) + (voff)[_i]), (LAS unsigned*)(lds + (bufoff) + ldsw + _i * 8192), 16, 0, 0); } while (0)
#define PG8_LDA(dst, b, h) do { _Pragma("unroll") for (int m = 0; m < 4; ++m) _Pragma("unroll") for (int k = 0; k < 2; ++k) dst[m][k] = *(const LAS bf16x8*)(lds + PG8_SA(b, h) + aoff + m * 2048 + k * 1024); } while (0)
#define PG8_LDB(dst, b, h) do { _Pragma("unroll") for (int n = 0; n < 2; ++n) _Pragma("unroll") for (int k = 0; k < 2; ++k) dst[n][k] = *(const LAS bf16x8*)(lds + PG8_SB(b, h) + boff + n * 2048 + k * 1024); } while (0)
#define PG8_MMA(ai, bj, At, Bt) do { __builtin_amdgcn_s_setprio(1); _Pragma("unroll") for (int m = 0; m < 4; ++m) _Pragma("unroll") for (int n = 0; n < 2; ++n) _Pragma("unroll") for (int k = 0; k < 2; ++k) \
        acc[ai][bj][m][n] = __builtin_amdgcn_mfma_f32_16x16x32_bf16(Bt[n][k], At[m][k], acc[ai][bj][m][n], 0, 0, 0); __builtin_amdgcn_s_setprio(0); } while (0)
#define PG8_WAIT_V(n) asm volatile("s_waitcnt vmcnt(" #n ")" ::: "memory")
#define PG8_WAIT_L(n) asm volatile("s_waitcnt lgkmcnt(" #n ")" ::: "memory")
#define PG8_BAR __builtin_amdgcn_s_barrier()
#define PG8_SCHED __builtin_amdgcn_sched_barrier(0)
#define PG8_GIDX(dst, op_) do { _Pragma("unroll") for (int h_ = 0; h_ < 2; ++h_) _Pragma("unroll") for (int i_ = 0; i_ < 2; ++i_) dst[h_][i_] = (unsigned)grows[(op_).slot0 + h_ * 128 + sR[i_]] * (unsigned)((op_).lda * 2) + sC[i_]; } while (0)
#define PG8_AOFF(dst, op_) do { _Pragma("unroll") for (int h_ = 0; h_ < 2; ++h_) _Pragma("unroll") for (int i_ = 0; i_ < 2; ++i_) dst[h_][i_] = (unsigned)((sR[i_] + 128 * h_) * (op_).lda) * 2u + sC[i_]; } while (0)
#define PG8_BOFF(dst, op_) do { _Pragma("unroll") for (int h_ = 0; h_ < 2; ++h_) _Pragma("unroll") for (int i_ = 0; i_ < 2; ++i_) { const int c_ = sRb[i_] + 128 * h_; \
        dst[h_][i_] = (unsigned)(((op_).bmap ? (64 * (c_ & 7) + (c_ >> 3)) : c_) * (op_).ldb) * 2u + sC[i_]; } } while (0)
#define PG8_COPY(dst, src) do { _Pragma("unroll") for (int h_ = 0; h_ < 2; ++h_) _Pragma("unroll") for (int i_ = 0; i_ < 2; ++i_) dst[h_][i_] = src[h_][i_]; } while (0)
    Unit cur, nxt; int ui = 0;
    if (!S.next(0, cur)) return;
    f32x4 acc[2][2][4][2];
#pragma unroll
    for (int a = 0; a < 2; ++a)
#pragma unroll
        for (int b = 0; b < 2; ++b)
#pragma unroll
            for (int m = 0; m < 4; ++m)
#pragma unroll
                for (int n = 0; n < 2; ++n) acc[a][b][m][n] = (f32x4){0.f, 0.f, 0.f, 0.f};
    bf16x8 At[4][2], B0[2][2], B1[2][2];
    const char* cA; const char* cB; int nt;
    { const Operands op = AD(cur); cA = (const char*)op.A; cB = (const char*)op.Bt; nt = op.K / 64; PG8_BOFF(cvb, op);
      Unit u1; const bool h1 = S.next(1, u1); const Operands o1 = h1 ? AD(u1) : op; PG8_BOFF(nvb, o1);
      if constexpr (GATHER) { PG8_GIDX(cvg, op); PG8_GIDX(nvg, o1); PG8_WAIT_V(0); } else { PG8_AOFF(cvg, op); PG8_AOFF(nvg, o1); } }
    PG8_STAGE(PG8_SB(0, 0), cB, cvb[0]); PG8_STAGE(PG8_SB(0, 1), cB, cvb[1]); PG8_STAGE(PG8_SA(0, 0), cA, cvg[0]); PG8_STAGE(PG8_SA(0, 1), cA, cvg[1]);
    if (wr == 1) PG8_BAR;
    PG8_WAIT_V(2); PG8_BAR;
    PG8_STAGE(PG8_SB(1, 0), cB + kstep, cvb[0]); PG8_STAGE(PG8_SA(1, 0), cA + kstep, cvg[0]); PG8_STAGE(PG8_SB(1, 1), cB + kstep, cvb[1]);
    PG8_WAIT_V(6); PG8_BAR;
    for (;;) {
        const bool has_next = S.next(ui + 1, nxt);
        const char* nA = cA; const char* nB = cB; int nnt = nt;
        if (has_next) { const Operands op = AD(nxt); nA = (const char*)op.A; nB = (const char*)op.Bt; nnt = op.K / 64; }
#pragma unroll 1
        for (int t = 0; t < nt; t += 2) {
            const bool last = (t == nt - 2);
            const char* a1 = cA + (size_t)(t + 1) * kstep;
            const char* a2 = last ? nA : cA + (size_t)(t + 2) * kstep; const char* b2 = last ? nB : cB + (size_t)(t + 2) * kstep;
            const char* a3 = a2 + kstep; const char* b3 = b2 + kstep;
            unsigned v2[2][2], w2[2][2];
#pragma unroll
            for (int h_ = 0; h_ < 2; ++h_)
#pragma unroll
                for (int i_ = 0; i_ < 2; ++i_) { v2[h_][i_] = last ? nvg[h_][i_] : cvg[h_][i_]; w2[h_][i_] = last ? nvb[h_][i_] : cvb[h_][i_]; }
            PG8_LDB(B0, 0, 0); PG8_LDB(B1, 0, 1); PG8_SCHED; PG8_LDA(At, 0, 0); PG8_STAGE(PG8_SA(1, 1), a1, cvg[1]);
            PG8_WAIT_V(8); PG8_WAIT_L(0); PG8_BAR; PG8_MMA(0, 0, At, B0); PG8_MMA(0, 1, At, B1); PG8_BAR; PG8_SCHED;
            PG8_LDA(At, 0, 1); PG8_STAGE(PG8_SB(0, 0), b2, w2[0]); PG8_STAGE(PG8_SB(0, 1), b2, w2[1]); PG8_STAGE(PG8_SA(0, 0), a2, v2[0]);
            PG8_WAIT_V(8); PG8_WAIT_L(0); PG8_BAR; PG8_MMA(1, 0, At, B0); PG8_MMA(1, 1, At, B1); PG8_BAR; PG8_SCHED;
            PG8_LDB(B0, 1, 0); PG8_LDB(B1, 1, 1); PG8_SCHED; PG8_LDA(At, 1, 0); PG8_STAGE(PG8_SA(0, 1), a2, v2[1]);
            PG8_WAIT_V(8); PG8_WAIT_L(0); PG8_BAR; PG8_MMA(0, 0, At, B0); PG8_MMA(0, 1, At, B1); PG8_BAR; PG8_SCHED;
            PG8_LDA(At, 1, 1); PG8_STAGE(PG8_SB(1, 0), b3, w2[0]); PG8_STAGE(PG8_SB(1, 1), b3, w2[1]); PG8_STAGE(PG8_SA(1, 0), a3, v2[0]);
            PG8_WAIT_V(8); PG8_WAIT_L(0); PG8_BAR; PG8_MMA(1, 0, At, B0); PG8_MMA(1, 1, At, B1); PG8_BAR; PG8_SCHED;
        }
        if (wr == 0) PG8_BAR;
        unsigned fvg[2][2], fvb[2][2];
        { Unit u2; const bool h2 = S.next(ui + 2, u2);
          if (h2) { const Operands o2 = AD(u2); PG8_BOFF(fvb, o2); if constexpr (GATHER) PG8_GIDX(fvg, o2); else PG8_AOFF(fvg, o2); }
          else { PG8_COPY(fvb, nvb); PG8_COPY(fvg, nvg); } }
        { int fr2 = fr, fq2 = fq; asm volatile("" : "+v"(fr2), "+v"(fq2));
          E(acc, cur, wr, wc, fr2, fq2); }
        if (!has_next) break;
        if constexpr (GATHER) PG8_WAIT_V(0);
        PG8_COPY(cvg, nvg); PG8_COPY(nvg, fvg); PG8_COPY(cvb, nvb); PG8_COPY(nvb, fvb);
        if (E.reset(cur)) {
#pragma unroll
        for (int a = 0; a < 2; ++a)
#pragma unroll
            for (int b = 0; b < 2; ++b)
#pragma unroll
                for (int m = 0; m < 4; ++m)
#pragma unroll
                    for (int n = 0; n < 2; ++n) acc[a][b][m][n] = (f32x4){0.f, 0.f, 0.f, 0.f};
        }
        cur = nxt; cA = nA; cB = nB; nt = nnt; ++ui;
        if (wr == 1) PG8_BAR;
    }
    PG8_WAIT_V(0);
    PG8_BAR;
#undef PG8_SA
#undef PG8_SB
#undef PG8_STAGE
#undef PG8_LDA
#undef PG8_LDB
#undef PG8_MMA
#undef PG8_WAIT_V
#undef PG8_WAIT_L
#undef PG8_BAR
#undef PG8_SCHED
#undef PG8_GIDX
#undef PG8_AOFF
#undef PG8_BOFF
#undef PG8_COPY
}
template <class F> struct EpiFn { F f; __device__ __forceinline__ void operator()(f32x4 (&acc)[2][2][4][2], const Unit& u, int wr, int wc, int fr, int fq) const { f(acc, u, wr, wc, fr, fq); } __device__ __forceinline__ bool reset(const Unit&) const { return true; } };
template <class F> __device__ __forceinline__ EpiFn<F> mk_epi(F f) { return EpiFn<F>{f}; }
template <class F> struct EpiSeg { F f; int last; __device__ __forceinline__ void operator()(f32x4 (&acc)[2][2][4][2], const Unit& u, int wr, int wc, int fr, int fq) const { f(acc, u, wr, wc, fr, fq); } __device__ __forceinline__ bool reset(const Unit& u) const { return u.seg == last; } };
template <class F> __device__ __forceinline__ EpiSeg<F> mk_epi_seg(F f, int last) { return EpiSeg<F>{f, last}; }
template <int NSEG> struct SegSched { GroupSched base; __device__ __forceinline__ bool next(int j, Unit& u) const { if (!base.next(j / NSEG, u)) return false; u.seg = j % NSEG; return true; } };
#ifndef DUP_PH
#define DUP_PH -1
#endif
#define REP_BEGIN(k) _Pragma("unroll 1") for (int rep_ = 0; rep_ < ((DUP_PH == (k)) ? 2 : 1); ++rep_) { if (rep_) { if constexpr (PH < 0) xcd_barrier(bar); }
#define REP_END }
#ifndef USE_FAST
#define USE_FAST 1
#endif
#if USE_FAST
#define GEMM(S, AD, E, K, lda, ldb) gemm_fast<false, false>(F.lds, F.tid, S, AD, mk_epi(E), nullptr)
#define GEMM_P(S, AD, E) gemm_fast<false, true>(F.lds, F.tid, S, AD, mk_epi(E), nullptr)
#define GEMM_GATHER(S, AD, E, K, lda, ldb, rows) gemm_fast<true, true>(F.lds, F.tid, S, AD, mk_epi(E), rows)
#else
#define GEMM(S, AD, E, K, lda, ldb) gemm_simple(S, AD, E, K)
#endif
#define EPI_ARGS f32x4 (&acc)[2][2][4][2], const Unit& u, int wr, int wc, int fr, int fq
#define EPI_FOR(...) _Pragma("unroll") for (int ai = 0; ai < 2; ++ai) _Pragma("unroll") for (int m = 0; m < 4; ++m) { const int r = ai * 128 + wr * 64 + m * 16 + fr; \
    _Pragma("unroll") for (int bj = 0; bj < 2; ++bj) _Pragma("unroll") for (int n = 0; n < 2; ++n) { const int c = bj * 128 + wc * 32 + n * 16 + 4 * fq; const f32x4 v = acc[ai][bj][m][n]; __VA_ARGS__ } }
#define EPI_FOR8(...) _Pragma("unroll") for (int ai = 0; ai < 2; ++ai) _Pragma("unroll") for (int m = 0; m < 4; ++m) { const int r = ai * 128 + wr * 64 + m * 16 + fr; \
    _Pragma("unroll") for (int bj = 0; bj < 2; ++bj) { const int c = bj * 128 + wc * 32 + 8 * fq; const f32x4 v0 = acc[ai][bj][m][0], v1 = acc[ai][bj][m][1]; __VA_ARGS__ } }
__device__ __forceinline__ void st_bf8(bf16* p, f32x4 a, f32x4 b) { u32x4 w; w.x = pk2(a[0], a[1]); w.y = pk2(a[2], a[3]); w.z = pk2(b[0], b[1]); w.w = pk2(b[2], b[3]); *(u32x4*)p = w; }
__device__ __forceinline__ void st_bf4(bf16* p, f32x4 v) { u32x2 w; w.x = pk2(v[0], v[1]); w.y = pk2(v[2], v[3]); *(u32x2*)p = w; }

__device__ __forceinline__ void p_mod(const Params& P, Frame& F) {
    LAS float* sc = (LAS float*)F.lds;
    LAS float* red = (LAS float*)(F.lds + 9 * 1024 * 4);
    float* MOD = WSP(float, WS_MOD);
    bool have = false;
    for (int it = F.bid; it < 2 * 96; it += F.G) {
        if (!have) {
            for (int i = F.tid; i < 9 * 1024; i += NTHREADS) { const int r = i >> 10, k = i & 1023; const float v = r < 8 ? P.c[r * 1024 + k] : P.c_ctx[k]; sc[i] = v * sigmoidf_(v); }
            have = true;
        }
        __syncthreads();
        const int l = it / 96, j0 = (it % 96) * 64, jj = F.tid & 63, kc = F.tid >> 6;
        const float* W = P.ada_w + (size_t)l * 1024 * 6144 + j0 + jj;
        float a[9];
#pragma unroll
        for (int r = 0; r < 9; ++r) a[r] = 0.f;
#pragma unroll 8
        for (int k = kc * 128; k < kc * 128 + 128; ++k) { const float w = W[(size_t)k * 6144];
#pragma unroll
            for (int r = 0; r < 9; ++r) a[r] += sc[r * 1024 + k] * w; }
#pragma unroll
        for (int r = 0; r < 9; ++r) red[(kc * 9 + r) * 64 + jj] = a[r];
        __syncthreads();
        for (int o = F.tid; o < 9 * 64; o += NTHREADS) { const int r = o >> 6, j = o & 63; float s = 0.f;
#pragma unroll
            for (int q = 0; q < 8; ++q) s += red[(q * 9 + r) * 64 + j];
            MOD[((size_t)l * 9 + r) * 6144 + j0 + j] = s + P.ada_b[l * 6144 + j0 + j]; }
    }
    __syncthreads();
}
__device__ __forceinline__ void p_dftgen(Frame& F) {
    LAS float* tab = (LAS float*)F.lds;
    for (int j = F.tid; j < 4096; j += NTHREADS) tab[j] = cospif((float)j * (1.0f / 2048.0f));
    __syncthreads();
    bf16* DC_ = WSP(bf16, WS_DFTC); bf16* M1 = WSP(bf16, WS_M1T); bf16* M2 = WSP(bf16, WS_M2T);
    const int nchunk = 256 * 64 + 2 * 256 * 32;
    for (int ch = F.bid * NTHREADS + F.tid; ch < nchunk; ch += F.G * NTHREADS) {
        float v[8]; bf16* dst;
        if (ch < 256 * 64) { const int kf = ch >> 6, col0 = (ch & 63) * 8, cs = col0 >> 8, l0 = col0 & 255;
#pragma unroll
            for (int i = 0; i < 8; ++i) { const int j = ((kf * (l0 + i)) & 255) * 16; v[i] = cs ? -tab[(j + 3072) & 4095] : tab[j]; }
            dst = DC_ + (size_t)kf * 512 + col0; }
        else if (ch < 256 * 64 + 256 * 32) { const int c2 = ch - 256 * 64, row = c2 >> 5, col0 = (c2 & 31) * 8, ri = row >> 7, k1 = row & 127, cs = (col0 >> 6) & 1, l10 = col0 & 63;
#pragma unroll
            for (int i = 0; i < 8; ++i) { const int j = ((k1 * (l10 + i)) & 63) * 64; const float c = tab[j], sn = tab[(j + 3072) & 4095];
                v[i] = (k1 >= 64 || col0 >= 128) ? 0.f : (ri == 0 ? (cs == 0 ? c : -sn) : (cs == 0 ? sn : c)); }
            dst = M1 + (size_t)row * 256 + col0; }
        else { const int c2 = ch - 256 * 64 - 256 * 32, row = c2 >> 5, col0 = (c2 & 31) * 8, ri = (col0 >> 6) & 1, l20 = col0 & 63;
#pragma unroll
            for (int i = 0; i < 8; ++i) { const int j = ((row * (l20 + i)) & 63) * 64; const float c = tab[j], sn = tab[(j + 3072) & 4095];
                v[i] = (row >= 64 || col0 >= 128) ? 0.f : (ri == 0 ? c : -sn); }
            dst = M2 + (size_t)row * 256 + col0; }
        u32x4 o; o.x = pk2(v[0], v[1]); o.y = pk2(v[2], v[3]); o.z = pk2(v[4], v[5]); o.w = pk2(v[6], v[7]);
        *(u32x4*)dst = o;
    }
    __syncthreads();
}
__device__ __forceinline__ void transpose_item(const float* W, int ldw, int k0, int n0, bf16* WT, int ldt, int drow0, LAS float* scr, int lane) {
    f32x4 ld[8];
#pragma unroll
    for (int i = 0; i < 8; ++i) ld[i] = *(const f32x4*)(W + (size_t)(k0 + 8 * i + (lane >> 3)) * ldw + n0 + 4 * (lane & 7));
#pragma unroll
    for (int i = 0; i < 8; ++i) { LAS float* d = scr + (8 * i + (lane >> 3)) * 33 + 4 * (lane & 7); d[0] = ld[i][0]; d[1] = ld[i][1]; d[2] = ld[i][2]; d[3] = ld[i][3]; }
    LDS_WAIT(); asm volatile("" ::: "memory");
    const int c = lane & 7;
#pragma unroll
    for (int j = 0; j < 4; ++j) { const int n = (lane >> 3) + 8 * j; const LAS float* s = scr + (8 * c) * 33 + n;
        u32x4 o; o.x = pk2(s[0 * 33], s[1 * 33]); o.y = pk2(s[2 * 33], s[3 * 33]); o.z = pk2(s[4 * 33], s[5 * 33]); o.w = pk2(s[6 * 33], s[7 * 33]);
        *(u32x4*)(WT + (size_t)(drow0 + n) * ldt + k0 + 8 * c) = o; }
    LDS_WAIT(); asm volatile("" ::: "memory");
}
__device__ __forceinline__ void p_wconv(const Params& P, Frame& F, int l) {
    LAS float* scr = (LAS float*)(F.lds + F.wave * 16384);
    const int gw = F.bid * NWAVES + F.wave, NGW = F.G * NWAVES;
    const float* w_in = P.w_in + (size_t)l * 1024 * INW;
    bf16* WA = WSP(bf16, WS_WA); bf16* WFV = WSP(bf16, WS_WFV);
    constexpr int I_K = 16 * 32, I_Q = 16 * 32, I_P = 16 * 16, I_G = 16 * 96, I_V = 16 * 32, I_AO = 16 * 32, I_FO = 8 * 32, I_OUT = 16 * 32;
    constexpr int NSM = I_K + I_Q + I_P + I_G + I_V + I_AO + I_FO + I_OUT;
    for (int it = gw; it < NSM; it += NGW) {
        int r = it;
        if (r < I_K) { transpose_item(w_in, INW, (r / 32) * 64, 0 + (r % 32) * 32, WA, 1024, 0 + (r % 32) * 32, scr, F.lane); continue; } r -= I_K;
        if (r < I_Q) { transpose_item(w_in, INW, (r / 32) * 64, 2048 + (r % 32) * 32, WA, 1024, 1024 + (r % 32) * 32, scr, F.lane); continue; } r -= I_Q;
        if (r < I_P) { transpose_item(w_in, INW, (r / 16) * 64, 3584 + (r % 16) * 32, WA, 1024, 2048 + (r % 16) * 32, scr, F.lane); continue; } r -= I_P;
        if (r < I_G) { transpose_item(w_in, INW, (r / 96) * 64, 4096 + (r % 96) * 32, WA, 1024, 2560 + (r % 96) * 32, scr, F.lane); continue; } r -= I_G;
        if (r < I_V) { transpose_item(w_in, INW, (r / 32) * 64, 1024 + (r % 32) * 32, WFV, 1024, 1024 + (r % 32) * 32, scr, F.lane); continue; } r -= I_V;
        if (r < I_AO) { transpose_item(P.w_att_o + (size_t)l * 1024 * 1024, 1024, (r / 32) * 64, (r % 32) * 32, WSP(bf16, WS_WAO), 1024, (r % 32) * 32, scr, F.lane); continue; } r -= I_AO;
        if (r < I_FO) { transpose_item(P.w_fourier + (size_t)l * 512 * 1024, 1024, (r / 32) * 64, (r % 32) * 32, WSP(bf16, WS_WFO), 512, (r % 32) * 32, scr, F.lane); continue; } r -= I_FO;
        transpose_item(P.w_out + (size_t)l * 1024 * 1024, 1024, (r / 32) * 64, (r % 32) * 32, WSP(bf16, WS_WOUT), 1024, (r % 32) * 32, scr, F.lane);
    }
    constexpr int I_E = 16 * 88;
    bf16* WGU = WSP(bf16, WS_WGU); bf16* WD = WSP(bf16, WS_WD);
    for (int it = gw; it < 3 * 16 * I_E; it += NGW) {
        const int which = it / (16 * I_E), r0 = it % (16 * I_E), e = r0 / I_E, r = r0 % I_E;
        if (which < 2) { const int kb = r / 88, nb = r % 88, n0 = nb * 32;
            const float* src = (which == 0 ? P.w_eg : P.w_eu) + ((size_t)l * 16 + e) * 1024 * FF;
            transpose_item(src, FF, kb * 64, n0, WGU + (size_t)e * 5632 * 1024, 1024, (n0 >> 7) * 256 + (which ? 128 : 0) + (n0 & 127), scr, F.lane); }
        else { const int kb = r / 32, nb = r % 32;
            transpose_item(P.w_ed + ((size_t)l * 16 + e) * FF * 1024, 1024, kb * 64, nb * 32, WD + (size_t)e * 1024 * FF, FF, nb * 32, scr, F.lane); }
    }
    { bf16* WPO = WSP(bf16, WS_WPO); const float* wp = P.w_pool + (size_t)l * 4 * 128 * 256;
      for (int i = F.bid * NTHREADS + F.tid; i < 1024 * 256; i += F.G * NTHREADS) { const int n = i >> 8, kk = i & 255, g = n >> 8, f = n & 255;
          WPO[i] = (bf16)(((kk >> 7) == (g & 1)) ? f2bf(wp[((size_t)g * 128 + (kk & 127)) * 256 + f]) : 0u); } }
    { LAS float* t128 = (LAS float*)F.lds;
      __syncthreads();
      for (int j = F.tid; j < 128; j += NTHREADS) t128[j] = cospif((float)j * (1.0f / 64.0f));
      __syncthreads();
      for (int i = F.bid * NTHREADS + F.tid; i < 1024 * 1024; i += F.G * NTHREADS) { const int fc = i >> 10, k = i & 1023, cs = fc & 1, gm = fc >> 1, g = gm >> 7, m = gm & 127;
          const float* src = w_in + (size_t)k * INW + 3072 + g * 128; float s = 0.f; const int ph = cs ? 96 : 0;
          for (int c = 0; c < 128; ++c) s += src[c] * t128[(m * c + ph) & 127];
          WFV[i] = (bf16)f2bf(s); }
      __syncthreads(); }
}

struct RowMod { const float* g; const float* sh; const float* sc; };
__device__ __forceinline__ void row_load(const float* row, int lane, f32x4 (&v)[4]) {
#pragma unroll
    for (int j = 0; j < 4; ++j) v[j] = *(const f32x4*)(row + 4 * lane + 256 * j);
}
__device__ __forceinline__ float row_rstd(const f32x4 (&v)[4]) {
    float s = 0.f;
#pragma unroll
    for (int j = 0; j < 4; ++j) s += (v[j][0] * v[j][0] + v[j][1] * v[j][1]) + (v[j][2] * v[j][2] + v[j][3] * v[j][3]);
    return rsqrtf(wave_sum(s) * (1.0f / 1024.0f) + RMS_EPS);
}
__device__ __forceinline__ void row_modulate(const f32x4 (&v)[4], float rstd, const RowMod& M, int lane, f32x4 (&y)[4]) {
#pragma unroll
    for (int j = 0; j < 4; ++j) { const int k = 4 * lane + 256 * j; const f32x4 g = *(const f32x4*)(M.g + k), sh = *(const f32x4*)(M.sh + k), sc = *(const f32x4*)(M.sc + k);
        y[j] = v[j] * rstd * g * (sc + 1.0f) + sh; }
}
__device__ __forceinline__ void row_store_bf(bf16* row, int lane, const f32x4 (&y)[4]) {
#pragma unroll
    for (int j = 0; j < 4; ++j) st_bf4(row + 4 * lane + 256 * j, y[j]);
}
__device__ __forceinline__ const float* mod_ptr(Frame& F, int l, int row, int which) { const int mr = row < RL ? (row >> 12) : 8; return WSP(float, WS_MOD) + ((size_t)l * 9 + mr) * 6144 + which * 1024; }

__device__ __forceinline__ void p_rowpass_a0(const Params& P, Frame& F) {
    const int gw = F.bid * NWAVES + F.wave, NGW = F.G * NWAVES; bf16* H = WSP(bf16, WS_H);
    for (int row = gw; row < RT; row += NGW) {
        const float* src = row < RL ? P.x + (size_t)row * DM : P.ctx + (size_t)(row - RL) * DM;
        f32x4 v[4], y[4]; row_load(src, F.lane, v); const float rs = row_rstd(v);
        RowMod M{P.norm1_g, mod_ptr(F, 0, row, 0), mod_ptr(F, 0, row, 1)};
        row_modulate(v, rs, M, F.lane, y); row_store_bf(H + (size_t)row * DM, F.lane, y);
    }
}
__device__ __forceinline__ void p_rowpass_f(const Params& P, Frame& F, int l, int nrows) {
    const int gw = F.bid * NWAVES + F.wave, NGW = F.G * NWAVES; bf16* H = WSP(bf16, WS_H); float* AFF = WSP(float, WS_AFF);
    const float* wr = P.w_router + (size_t)l * 1024 * 16;
    LAS float* wl = (LAS float*)F.lds;
    __syncthreads();
    for (int i = F.tid; i < 16384; i += NTHREADS) wl[(i & 15) * 1024 + (i >> 4)] = wr[i];
    __syncthreads();
    for (int row = gw; row < nrows; row += NGW) {
        const float* src = row < RL ? P.out + (size_t)row * DM : WSP(float, WS_XC) + (size_t)(row - RL) * DM;
        f32x4 v[4], y[4]; row_load(src, F.lane, v); const float rs = row_rstd(v);
        RowMod M{P.norm2_g + l * 1024, mod_ptr(F, l, row, 3), mod_ptr(F, l, row, 4)};
        row_modulate(v, rs, M, F.lane, y); row_store_bf(H + (size_t)row * DM, F.lane, y);
        float lg[16];
        int wo = 4 * F.lane; asm volatile("" : "+v"(wo));
#pragma unroll
        for (int e = 0; e < 16; ++e) { float a = 0.f;
#pragma unroll
            for (int j = 0; j < 4; ++j) { const f32x4 w = *(const LAS f32x4*)(wl + e * 1024 + wo + 256 * j); a += (y[j][0] * w[0] + y[j][1] * w[1]) + (y[j][2] * w[2] + y[j][3] * w[3]); }
            lg[e] = a; }
        float mx = -1e30f;
#pragma unroll
        for (int e = 0; e < 16; ++e) { lg[e] = wave_sum(lg[e]); mx = fmaxf(mx, lg[e]); }
        float den = 0.f;
#pragma unroll
        for (int e = 0; e < 16; ++e) { lg[e] = __expf(lg[e] - mx); den += lg[e]; }
        const float inv = 1.0f / den;
        if (F.lane < 16) { float mine = 0.f;
#pragma unroll
            for (int e = 0; e < 16; ++e) mine = (F.lane == e) ? lg[e] : mine;
            AFF[(size_t)row * 16 + F.lane] = mine * inv; }
    }
    __syncthreads();
}
__device__ __forceinline__ void p_rowpass_k(const Params& P, Frame& F, int l, int nrows) {
    const int gw = F.bid * NWAVES + F.wave, NGW = F.G * NWAVES; bf16* H = WSP(bf16, WS_H);
    const int* SEL = WSP(int, WS_SEL); const bf16* Y = WSP(bf16, WS_Y);
    for (int row = gw; row < nrows; row += NGW) {
        float* xr = row < RL ? P.out + (size_t)row * DM : WSP(float, WS_XC) + (size_t)(row - RL) * DM;
        f32x4 v[4], a[4]; row_load(xr, F.lane, v);
#pragma unroll
        for (int j = 0; j < 4; ++j) a[j] = (f32x4){0.f, 0.f, 0.f, 0.f};
        for (int e = 0; e < 16; ++e) { const int s = SEL[(size_t)row * 16 + e];
            if (s >= 0) { const bf16* yr = Y + (size_t)s * DM;
#pragma unroll
                for (int j = 0; j < 4; ++j) { const u32x2 w = *(const u32x2*)(yr + 4 * F.lane + 256 * j); a[j][0] += bflo(w.x); a[j][1] += bfhi(w.x); a[j][2] += bflo(w.y); a[j][3] += bfhi(w.y); } } }
        const float* g2 = mod_ptr(F, l, row, 5);
#pragma unroll
        for (int j = 0; j < 4; ++j) { const f32x4 g = *(const f32x4*)(g2 + 4 * F.lane + 256 * j); v[j] = v[j] + g * a[j]; }
        const float rs = row_rstd(v);
        if (l == 0) {
#pragma unroll
            for (int j = 0; j < 4; ++j) *(f32x4*)(xr + 4 * F.lane + 256 * j) = v[j];
            f32x4 y[4]; RowMod M{P.norm1_g + 1024, mod_ptr(F, 1, row, 0), mod_ptr(F, 1, row, 1)};
            row_modulate(v, rs, M, F.lane, y); row_store_bf(H + (size_t)row * DM, F.lane, y);
        } else {
#pragma unroll
            for (int j = 0; j < 4; ++j) { const f32x4 g = *(const f32x4*)(P.final_g + 4 * F.lane + 256 * j); *(f32x4*)(xr + 4 * F.lane + 256 * j) = v[j] * rs * g; }
        }
    }
}

__device__ __forceinline__ float dot64(const bf16x8 (&q)[8], const bf16* kp) {
    float s = 0.f;
#pragma unroll
    for (int i = 0; i < 8; ++i) { const u32x4 kw = *(const u32x4*)(kp + 8 * i); const u32x4 qw = __builtin_bit_cast(u32x4, q[i]);
#pragma unroll
        for (int t = 0; t < 4; ++t) s += bflo(kw[t]) * bflo(qw[t]) + bfhi(kw[t]) * bfhi(qw[t]); }
    return s;
}
__device__ __forceinline__ void p_attn_naive(const Params& P, Frame& F, int l, bool with_ctx_queries) {
    const int gw = F.bid * NWAVES + F.wave, NGW = F.G * NWAVES;
    const bf16* KQ = WSP(bf16, WS_KQ); const bf16* VT = WSP(bf16, WS_VT); bf16* ATT = WSP(bf16, WS_ATT);
    LAS float* pw = (LAS float*)(F.lds + F.wave * 2048);
    const float* rpb = P.rpb + (size_t)l * 16 * 15 * 31;
    const int nlat = NB * 64 * NH * 64, nitems = nlat + (with_ctx_queries ? NB * NH * CTXL : 0);
    for (int it = gw; it < nitems; it += NGW) {
        const bool lat = it < nlat;
        int b, h, r = 0, qc = 0, rowq;
        if (lat) { qc = it & 63; h = (it >> 6) & 15; r = (it >> 10) & 63; b = it >> 16; rowq = b * SEQ + r * 64 + qc; }
        else { const int i2 = it - nlat; qc = i2 & 255; h = (i2 >> 8) & 15; b = i2 >> 12; rowq = RL + b * CTXL + qc; }
        bf16x8 q[8];
        { const bf16* qp = KQ + (size_t)rowq * 2048 + 1024 + h * 64;
#pragma unroll
          for (int i = 0; i < 8; ++i) q[i] = *(const bf16x8*)(qp + 8 * i); }
        const int rs = min(max(r - 4, 0), 56), cs = min(max(qc - 8, 0), 48);
        float s[6];
        if (lat) {
#pragma unroll
            for (int t = 0; t < 2; ++t) { const int w = F.lane + 64 * t, i = w >> 4, j = w & 15; const int tok = (rs + i) * 64 + cs + j;
                s[t] = dot64(q, KQ + (size_t)(b * SEQ + tok) * 2048 + h * 64) * 0.125f + rpb[(h * 15 + (rs + i - r + 7)) * 31 + (cs + j - qc + 15)]; }
        } else { s[0] = -1e30f; s[1] = -1e30f; }
#pragma unroll
        for (int t = 0; t < 4; ++t) { const int c = F.lane + 64 * t; s[2 + t] = dot64(q, KQ + (size_t)(RL + b * CTXL + c) * 2048 + h * 64) * 0.125f; }
        float mx = s[0];
#pragma unroll
        for (int t = 1; t < 6; ++t) mx = fmaxf(mx, s[t]);
        mx = wave_max(mx);
        float sum = 0.f;
#pragma unroll
        for (int t = 0; t < 6; ++t) { s[t] = (lat || t >= 2) ? __expf(s[t] - mx) : 0.f; sum += s[t]; }
        sum = wave_sum(sum);
        pw[F.lane] = s[0]; pw[F.lane + 64] = s[1];
#pragma unroll
        for (int t = 0; t < 4; ++t) pw[128 + F.lane + 64 * t] = s[2 + t];
        LDS_WAIT(); asm volatile("" ::: "memory");
        float o = 0.f;
        if (lat) { const bf16* vr = VT + ((size_t)b * 1024 + h * 64 + F.lane) * 4096;
#pragma unroll 2
            for (int w = 0; w < 128; ++w) { const int tok = (rs + (w >> 4)) * 64 + cs + (w & 15); o += pw[w] * bf2f(vr[tok]); } }
        { const bf16* vr = VT + YT_CTX_OFF + ((size_t)b * 1024 + h * 64 + F.lane) * 256;
#pragma unroll 2
          for (int c8 = 0; c8 < 32; ++c8) { const u32x4 vw = *(const u32x4*)(vr + 8 * c8); const LAS float* pp = pw + 128 + 8 * c8;
#pragma unroll
              for (int t = 0; t < 4; ++t) o += pp[2 * t] * bflo(vw[t]) + pp[2 * t + 1] * bfhi(vw[t]); } }
        ATT[(size_t)rowq * 1024 + h * 64 + F.lane] = (bf16)f2bf(o / sum);
        LDS_WAIT(); asm volatile("" ::: "memory");
    }
}

constexpr int ACK_STRIDE = 72, ACV_STRIDE = 264;
constexpr int ALDS_CK = 0, ALDS_CV = 256 * ACK_STRIDE * 2, ALDS_RP = ALDS_CV + 64 * ACV_STRIDE * 2;
struct AttnState { float m, sum; f32x4 o[4]; };
__device__ __forceinline__ float xrow16_max(float x) {
    auto s = __builtin_amdgcn_permlane16_swap(__float_as_uint(x), __float_as_uint(x), false, false);
    x = fmaxf(__uint_as_float(s[0]), __uint_as_float(s[1]));
    auto t = __builtin_amdgcn_permlane32_swap(__float_as_uint(x), __float_as_uint(x), false, false);
    return fmaxf(__uint_as_float(t[0]), __uint_as_float(t[1]));
}
__device__ __forceinline__ float xrow16_sum(float x) {
    auto s = __builtin_amdgcn_permlane16_swap(__float_as_uint(x), __float_as_uint(x), false, false);
    x = __uint_as_float(s[0]) + __uint_as_float(s[1]);
    auto t = __builtin_amdgcn_permlane32_swap(__float_as_uint(x), __float_as_uint(x), false, false);
    return __uint_as_float(t[0]) + __uint_as_float(t[1]);
}
#define MFMA16(a, b, c) __builtin_amdgcn_mfma_f32_16x16x32_bf16((a), (b), (c), 0, 0, 0)
template <int NT>
__device__ __forceinline__ void attn_tail(AttnState& S, f32x4 (&sc)[NT], const u32x4 (&vw)[NT / 2][4]) {
    float cm = -1e30f;
#pragma unroll
    for (int t = 0; t < NT; ++t)
#pragma unroll
        for (int j = 0; j < 4; ++j) cm = fmaxf(cm, sc[t][j]);
    cm = xrow16_max(cm);
    const float mn = fmaxf(S.m, cm), scl = __builtin_amdgcn_exp2f(S.m - mn); S.m = mn; float ps = 0.f;
#pragma unroll
    for (int t = 0; t < NT; ++t)
#pragma unroll
        for (int j = 0; j < 4; ++j) { const float p = __builtin_amdgcn_exp2f(sc[t][j] - mn); sc[t][j] = p; ps += p; }
    S.sum = S.sum * scl + ps;
#pragma unroll
    for (int dt = 0; dt < 4; ++dt) S.o[dt] = S.o[dt] * scl;
#pragma unroll
    for (int ks = 0; ks < NT / 2; ++ks) { u32x4 pw; pw.x = pk2(sc[2 * ks][0], sc[2 * ks][1]); pw.y = pk2(sc[2 * ks][2], sc[2 * ks][3]); pw.z = pk2(sc[2 * ks + 1][0], sc[2 * ks + 1][1]); pw.w = pk2(sc[2 * ks + 1][2], sc[2 * ks + 1][3]);
        const bf16x8 pf = __builtin_bit_cast(bf16x8, pw);
#pragma unroll
        for (int dt = 0; dt < 4; ++dt) S.o[dt] = MFMA16(__builtin_bit_cast(bf16x8, vw[ks][dt]), pf, S.o[dt]); }
}
__device__ __forceinline__ void attn_unit2(const bf16* __restrict__ KQ, const bf16* __restrict__ VT, bf16* __restrict__ ATT, LAS unsigned char* lds,
                                           const int b, const int h, const int rowqA, const int rowqB, const bool win, const int r, const int qt, const int lane) {
    const int l15 = lane & 15, g = lane >> 4;
    const f32x4 z = {0.f, 0.f, 0.f, 0.f};
    bf16x8 qA[2], qB[2];
    { const bf16* qp = KQ + (size_t)(rowqA + l15) * 2048 + 1024 + h * 64 + 8 * g; qA[0] = *(const bf16x8*)qp; qA[1] = *(const bf16x8*)(qp + 32); }
    { const bf16* qp = KQ + (size_t)(rowqB + l15) * 2048 + 1024 + h * 64 + 8 * g; qB[0] = *(const bf16x8*)qp; qB[1] = *(const bf16x8*)(qp + 32); }
    AttnState SA, SB; SA.m = -1e30f; SA.sum = 0.f; SB.m = -1e30f; SB.sum = 0.f;
#pragma unroll
    for (int dt = 0; dt < 4; ++dt) { SA.o[dt] = z; SB.o[dt] = z; }
    if (win) {
        const int rsA = min(max(r - 4, 0), 56), dB = min(max(r - 3, 0), 56) - rsA, kc0 = min(max(16 * qt - 8, 0), 32);
        const int q = 16 * qt + l15, csq = min(max(q - 8, 0), 48);
        const int krow0 = 8 * (l15 >> 2) + (l15 & 3);
        const bf16* kb = KQ + (size_t)(b * SEQ + kc0 + krow0) * 2048 + h * 64 + 8 * g;
        const bf16* vb = VT + (size_t)(b * 1024 + h * 64 + l15) * 4096 + kc0 + 8 * g;
        const LAS float* rp = (const LAS float*)(lds + ALDS_RP);
        const int jb = kc0 + 8 * g;
        const int okb = jb - csq;
        const LAS float* rpl = rp + 16 + (jb - q + 15);
        float madd[2][4];
#pragma unroll
        for (int t = 0; t < 2; ++t)
#pragma unroll
            for (int j = 0; j < 4; ++j) madd[t][j] = ((unsigned)(okb + 4 * t + j) < 16u) ? 0.f : -__builtin_inff();
        bf16x8 K0[2][2], K1[2][2]; u32x4 V0[1][4], V1[1][4];
#define ATT_LOADW(KB, VB, i) do { const int gr_ = min(rsA + (i), 63); const bf16* kp_ = kb + (size_t)(gr_ * 64) * 2048; const bf16* vp_ = vb + gr_ * 64; \
        _Pragma("unroll") for (int t = 0; t < 2; ++t) { KB[t][0] = *(const bf16x8*)(kp_ + (size_t)(4 * t) * 2048); KB[t][1] = *(const bf16x8*)(kp_ + (size_t)(4 * t) * 2048 + 32); } \
        _Pragma("unroll") for (int dt = 0; dt < 4; ++dt) VB[0][dt] = *(const u32x4*)(vp_ + (size_t)(16 * dt) * 4096); } while (0)
#define ATT_ONE(ST, QF, KB, VB, roff, rowok) do { f32x4 sc[2]; \
        _Pragma("unroll") for (int t = 0; t < 2; ++t) { sc[t] = MFMA16(KB[t][0], QF[0], z); sc[t] = MFMA16(KB[t][1], QF[1], sc[t]); } \
        const LAS float* bp_ = rpl + ((rowok) ? (roff) : 15) * 64; \
        _Pragma("unroll") for (int t = 0; t < 2; ++t) _Pragma("unroll") for (int j = 0; j < 4; ++j) sc[t][j] = (sc[t][j] + bp_[4 * t + j]) + madd[t][j]; \
        attn_tail<2>(ST, sc, VB); } while (0)
#define ATT_COMPUTE(KB, VB, i) do { const int roffA_ = min(rsA + (i) - r + 7, 14); \
        ATT_ONE(SA, qA, KB, VB, roffA_, (i) <= 7); \
        ATT_ONE(SB, qB, KB, VB, max(roffA_ - 1, 0), (i) >= dB && (i) <= 7 + dB); } while (0)
        ATT_LOADW(K0, V0, 0);
#pragma unroll 1
        for (int i = 0; i < 8; i += 2) { ATT_LOADW(K1, V1, i + 1); ATT_COMPUTE(K0, V0, i); ATT_LOADW(K0, V0, i + 2); ATT_COMPUTE(K1, V1, i + 1); }
        ATT_COMPUTE(K0, V0, 8);
#undef ATT_LOADW
#undef ATT_ONE
#undef ATT_COMPUTE
    }
    { const LAS bf16* ck = (const LAS bf16*)(lds + ALDS_CK) + l15 * ACK_STRIDE + 8 * g;
      const LAS bf16* cv = (const LAS bf16*)(lds + ALDS_CV) + l15 * ACV_STRIDE + 8 * g;
#pragma unroll 1
      for (int c = 0; c < 4; ++c) {
          bf16x8 kf[4][2]; u32x4 vw[2][4];
#pragma unroll
          for (int t = 0; t < 4; ++t) { const LAS bf16* kp = ck + (64 * c + 16 * t) * ACK_STRIDE; kf[t][0] = *(const LAS bf16x8*)kp; kf[t][1] = *(const LAS bf16x8*)(kp + 32); }
#pragma unroll
          for (int ks = 0; ks < 2; ++ks)
#pragma unroll
              for (int dt = 0; dt < 4; ++dt) vw[ks][dt] = *(const LAS u32x4*)(cv + (16 * dt) * ACV_STRIDE + 64 * c + 32 * ks);
          { f32x4 sc[4];
#pragma unroll
            for (int t = 0; t < 4; ++t) { sc[t] = MFMA16(kf[t][0], qA[0], z); sc[t] = MFMA16(kf[t][1], qA[1], sc[t]); }
            attn_tail<4>(SA, sc, vw); }
          { f32x4 sc[4];
#pragma unroll
            for (int t = 0; t < 4; ++t) { sc[t] = MFMA16(kf[t][0], qB[0], z); sc[t] = MFMA16(kf[t][1], qB[1], sc[t]); }
            attn_tail<4>(SB, sc, vw); }
      } }
    { const float inv = 1.0f / xrow16_sum(SA.sum);
#pragma unroll
      for (int dt = 0; dt < 4; ++dt) st_bf4(ATT + (size_t)(rowqA + l15) * 1024 + h * 64 + 16 * dt + 4 * g, SA.o[dt] * inv); }
    { const float inv = 1.0f / xrow16_sum(SB.sum);
#pragma unroll
      for (int dt = 0; dt < 4; ++dt) st_bf4(ATT + (size_t)(rowqB + l15) * 1024 + h * 64 + 16 * dt + 4 * g, SB.o[dt] * inv); }
}
__device__ __forceinline__ void p_attn_mfma(const Params& P, Frame& F, int l, bool with_ctx_queries) {
    const bf16* KQ = WSP(bf16, WS_KQ); const bf16* VT = WSP(bf16, WS_VT); bf16* ATT = WSP(bf16, WS_ATT);
    const float* rpb = P.rpb + (size_t)l * 16 * 465;
    for (int hp = F.bid; hp < 256; hp += F.G) {
        const int p = hp & 127, half = hp >> 7, b = p >> 4, h = p & 15;
        __syncthreads();
        { LAS bf16* ck = (LAS bf16*)(F.lds + ALDS_CK); LAS bf16* cv = (LAS bf16*)(F.lds + ALDS_CV); LAS float* rp = (LAS float*)(F.lds + ALDS_RP);
          { const int key = F.tid >> 1, hf = F.tid & 1; const int k32 = key & 31, pos = (key & ~31) + ((k32 >> 2) & 1) * 16 + 4 * (k32 >> 3) + (k32 & 3);
            const u32x4* src = (const u32x4*)(KQ + (size_t)(RL + b * CTXL + key) * 2048 + h * 64 + hf * 32); LAS u32x4* dst = (LAS u32x4*)(ck + pos * ACK_STRIDE + hf * 32);
#pragma unroll
            for (int i = 0; i < 4; ++i) dst[i] = src[i]; }
          { const int d = F.tid >> 3, sg = F.tid & 7; const u32x4* src = (const u32x4*)(VT + YT_CTX_OFF + (size_t)(b * 1024 + h * 64 + d) * 256 + sg * 32); LAS u32x4* dst = (LAS u32x4*)(cv + d * ACV_STRIDE + sg * 32);
#pragma unroll
            for (int i = 0; i < 4; ++i) dst[i] = src[i]; }
          for (int i = F.tid; i < 16 * 64; i += NTHREADS) { const int rr = i >> 6, cc = (i & 63) - 16; rp[i] = rr == 15 ? -__builtin_inff() : ((cc >= 0 && cc < 31) ? rpb[h * 465 + rr * 31 + cc] * LOG2E : 0.f); } }
        __syncthreads();
        const int qt = F.wave & 3, rpi = F.wave >> 2;
#pragma unroll 1
        for (int st = 0; st < 8; ++st) { const int r = half * 32 + st * 4 + rpi * 2; const int rowqA = b * SEQ + r * 64 + 16 * qt;
            attn_unit2(KQ, VT, ATT, F.lds, b, h, rowqA, rowqA + 64, true, r, qt, F.lane); }
        if (with_ctx_queries && half == 0) { const int rowqA = RL + b * CTXL + 32 * F.wave; attn_unit2(KQ, VT, ATT, F.lds, b, h, rowqA, rowqA + 16, false, 0, 0, F.lane); }
    }
    __syncthreads();
}

__device__ __forceinline__ void ld8(const bf16* p, float (&x)[8]) { const u32x4 w = *(const u32x4*)p;
#pragma unroll
    for (int q = 0; q < 4; ++q) { x[2 * q] = bflo(w[q]); x[2 * q + 1] = bfhi(w[q]); } }
__device__ __forceinline__ void p_pool(Frame& F, int nrows) {
    const bf16* PB = WSP(bf16, WS_PB); bf16* POOL = WSP(bf16, WS_POOL);
    for (int i = F.bid * NTHREADS + F.tid; i < (nrows >> 4) * 64; i += F.G * NTHREADS) {
        const int row0 = (i >> 6) << 4, ch = i & 63, g = ch >> 4, hw = 1 << g;
        int base, t0, Lb; if (row0 < RL) { base = row0 & ~4095; t0 = row0 & 4095; Lb = SEQ; } else { const int rr = row0 - RL; base = RL + (rr & ~255); t0 = rr & 255; Lb = CTXL; }
        const bf16* src = PB + (size_t)base * 512 + ch * 8;
        float S[8];
#pragma unroll
        for (int q = 0; q < 8; ++q) S[q] = 0.f;
#pragma unroll 4
        for (int d = -8; d < 8; ++d) { const int tt = t0 + d; if (d >= -hw && d < hw && tt >= 0 && tt < Lb) { float x[8]; ld8(src + (size_t)tt * 512, x);
#pragma unroll
                for (int q = 0; q < 8; ++q) S[q] += x[q]; } }
#pragma unroll 2
        for (int j = 0; j < 16; ++j) { const int t = t0 + j; const int lo = max(t - hw, 0), hi = min(t + hw, Lb); const float inv = 1.0f / (float)(hi - lo);
            float me[8]; ld8(src + (size_t)t * 512, me);
            u32x4 o;
#pragma unroll
            for (int q = 0; q < 4; ++q) o[q] = pk2(S[2 * q] * inv - me[2 * q], S[2 * q + 1] * inv - me[2 * q + 1]);
            *(u32x4*)(POOL + (size_t)(base + t) * 512 + ch * 8) = o;
            if (t + hw < Lb) { float x[8]; ld8(src + (size_t)(t + hw) * 512, x);
#pragma unroll
                for (int q = 0; q < 8; ++q) S[q] += x[q]; }
            if (t - hw >= 0) { float x[8]; ld8(src + (size_t)(t - hw) * 512, x);
#pragma unroll
                for (int q = 0; q < 8; ++q) S[q] -= x[q]; } }
    }
}

__device__ __forceinline__ int block_sum_i(int v, LAS int* sm, int tid) {
    v = wave_sum_i(v);
    __syncthreads();
    if ((tid & 63) == 0) sm[tid >> 6] = v;
    __syncthreads();
    int s = 0;
#pragma unroll
    for (int i = 0; i < 8; ++i) s += sm[i];
    return s;
}
__device__ __forceinline__ int block_excl_scan(int v, LAS int* sm, int tid, int& total) {
    const int lane = tid & 63, w = tid >> 6; int inc = v;
#pragma unroll
    for (int o = 1; o < 64; o <<= 1) { const int t = __builtin_amdgcn_ds_bpermute(((lane - o) & 63) << 2, inc); if (lane >= o) inc += t; }
    __syncthreads();
    if (lane == 63) sm[w] = inc;
    __syncthreads();
    int base = 0; total = 0;
#pragma unroll
    for (int i = 0; i < 8; ++i) { const int s = sm[i]; if (i < w) base += s; total += s; }
    return base + inc - v;
}
template <int NPT>
__device__ __forceinline__ void topk_pair(Frame& F, int row0, int n, int cap, int e, int slot0) {
    LAS int* sm = (LAS int*)F.lds;
    const float* AFF = WSP(float, WS_AFF); int* SROW = WSP(int, WS_SROW); float* SG = WSP(float, WS_SGATE); int* SEL = WSP(int, WS_SEL);
    unsigned key[NPT];
#pragma unroll
    for (int j = 0; j < NPT; ++j) { const int i = F.tid * NPT + j; key[j] = (i < n) ? __float_as_uint(AFF[(size_t)(row0 + i) * 16 + e]) : 0u; }
    unsigned T = 0u;
    for (int bit = 30; bit >= 0; --bit) { const unsigned cand = T | (1u << bit); int cnt = 0;
#pragma unroll
        for (int j = 0; j < NPT; ++j) cnt += (key[j] >= cand) ? 1 : 0;
        cnt = block_sum_i(cnt, sm, F.tid);
        if (cnt >= cap) T = cand; }
    int ngt = 0, neq = 0;
#pragma unroll
    for (int j = 0; j < NPT; ++j) { ngt += (key[j] > T) ? 1 : 0; neq += (key[j] == T) ? 1 : 0; }
    int tot_gt, tot_eq;
    (void)block_excl_scan(ngt, sm, F.tid, tot_gt);
    int eqr = block_excl_scan(neq, sm, F.tid, tot_eq);
    const int need_eq = cap - tot_gt;
    int nsel = 0; bool selj[NPT];
#pragma unroll
    for (int j = 0; j < NPT; ++j) { bool s = key[j] > T; if (key[j] == T && T != 0u) { s = eqr < need_eq; ++eqr; } selj[j] = s; nsel += s ? 1 : 0; }
    int tot_sel; int pos = block_excl_scan(nsel, sm, F.tid, tot_sel);
#pragma unroll
    for (int j = 0; j < NPT; ++j) { const int i = F.tid * NPT + j;
        if (i < n) { const int row = row0 + i;
            if (selj[j]) { const int slot = slot0 + pos; ++pos; SROW[slot] = row; SG[slot] = __uint_as_float(key[j]); SEL[(size_t)row * 16 + e] = slot; }
            else SEL[(size_t)row * 16 + e] = -1; } }
    __syncthreads();
}
__device__ __forceinline__ void p_topk(Frame& F, bool with_ctx) {
    const int npairs = 128 + (with_ctx ? 128 : 0);
    for (int pi = F.bid; pi < npairs; pi += F.G) {
        if (pi < 128) { const int b = pi >> 4, e = pi & 15; topk_pair<8>(F, b * SEQ, SEQ, CAPL, e, e * SLOT_E + b * CAPL); }
        else { const int p2 = pi - 128, b = p2 >> 4, e = p2 & 15; topk_pair<1>(F, RL + b * CTXL, CTXL, CAPC, e, e * SLOT_E + 4096 + b * CAPC); }
    }
}
__device__ __forceinline__ void p_gather(Frame& F, bool with_ctx) {
    const int gw = F.bid * NWAVES + F.wave, NGW = F.G * NWAVES; const bf16* H = WSP(bf16, WS_H); bf16* XG = WSP(bf16, WS_XG); const int* SROW = WSP(int, WS_SROW);
    for (int s = gw; s < NSLOT; s += NGW) { if (!with_ctx && (s % SLOT_E) >= 4096) continue;
        const int row = SROW[s]; const u32x4* src = (const u32x4*)(H + (size_t)row * DM); u32x4* dst = (u32x4*)(XG + (size_t)s * DM);
        dst[F.lane] = src[F.lane]; dst[F.lane + 64] = src[F.lane + 64]; }
}

template <int PH> __global__ void __launch_bounds__(NTHREADS, 2) fwd_kernel(Params P) {
    extern __shared__ __attribute__((aligned(16))) unsigned char lds_raw[];
    Frame F; F.lds = (LAS unsigned char*)lds_raw; F.tid = threadIdx.x; F.lane = F.tid & 63; F.wave = __builtin_amdgcn_readfirstlane(F.tid >> 6); F.G = gridDim.x; F.bid = blockIdx.x; F.ws = P.ws;
    const int wave0 = __builtin_amdgcn_readfirstlane((int)threadIdx.x >> 6);
    volatile LAS unsigned* MISC = (volatile LAS unsigned*)(F.lds + LDS_MISC);
    if (F.tid < 64) MISC[F.tid] = 0u;
    __syncthreads();
    XcdBarrier bar; bar.bar = WSP(unsigned, WS_CTL) + CW_BAR; bar.x = 0; bar.st = MISC + 8;
    if constexpr (PH < 0) bar = xcd_barrier_post(WSP(unsigned, WS_CTL) + CW_BAR, MISC + 8);
#define IN(k) (PH < 0 || PH == (k))
#define REFRESH() do { unsigned on_ = ~0u; asm volatile("" : "+s"(on_)); int t_ = wave0 * 64 + (int)__builtin_amdgcn_mbcnt_hi(on_, __builtin_amdgcn_mbcnt_lo(on_, 0u)); asm volatile("" : "+v"(t_)); F.tid = t_; F.lane = t_ & 63; F.wave = __builtin_amdgcn_readfirstlane(t_ >> 6); } while (0)
#define SEAM(k) do { if constexpr (PH < 0) xcd_barrier(bar); } while (0)

    if (IN(0)) { REP_BEGIN(100) p_mod(P, F); p_dftgen(F); REP_END REP_BEGIN(101) p_wconv(P, F, 0); REP_END }
    SEAM(0);
    if (IN(1)) { p_rowpass_a0(P, F); }
    SEAM(1);
    for (int l = P.l_lo; l < P.l_hi; ++l) {
        constexpr int pb = 2; const bool L0 = (l == 0);
        bf16* H = WSP(bf16, WS_H);
        if (IN(pb + 0)) { REFRESH(); REP_BEGIN(2)
            { GroupSched S; S.init(1, 128, 22, F.G, F.bid, 8, L0 ? 22 : 4, 128, 0);
              const bf16* WA = WSP(bf16, WS_WA);
              auto AD = [=](const Unit& u) { return Operands{H + (size_t)u.pm * 256 * DM, WA + (size_t)u.pn * 256 * DM, DM, DM, 0, DM}; };
              bf16* KQ = WSP(bf16, WS_KQ); bf16* PBp = WSP(bf16, WS_PB); bf16* GB = WSP(bf16, WS_GB);
              auto E = [=](EPI_ARGS) { const int row0 = u.pm * 256;
                  if (u.pn < 8) { const float qs = (u.pn >= 4) ? QSCALE : 1.0f; EPI_FOR8( st_bf8(KQ + (size_t)(row0 + r) * 2048 + u.pn * 256 + c, v0 * qs, v1 * qs); ) }
                  else if (u.pn < 10) { EPI_FOR8( st_bf8(PBp + (size_t)(row0 + r) * 512 + (u.pn - 8) * 256 + c, v0, v1); ) }
                  else { EPI_FOR8( f32x4 s0; f32x4 s1; _Pragma("unroll") for (int j = 0; j < 4; ++j) { s0[j] = sigmoidf_(v0[j]); s1[j] = sigmoidf_(v1[j]); } st_bf8(GB + (size_t)(row0 + r) * 3072 + (u.pn - 10) * 256 + c, s0, s1); ) } };
              GEMM_P(S, AD, E); }
            REFRESH();
            { GroupSched S; const int g1a_units = 128 * 22 + 8 * (L0 ? 22 : 4);
              S.init(1, 8, 128, F.G, (F.bid + F.G - ((g1a_units % F.G) & ~7)) % F.G, L0 ? 8 : 4, 8, L0 ? 0 : 4, 128);
              const bf16* WFV = WSP(bf16, WS_WFV);
              auto AD = [=](const Unit& u) { const bool fmap = (u.pm < 4) && (u.pn < 128); const int t16 = u.pn & 15;
                  const size_t tok0 = fmap ? (size_t)(u.pn >> 4) * SEQ + 64 * ((t16 >> 1) * 8) + (t16 & 1) * 32 : (size_t)u.pn * 256;
                  return Operands{WFV + (size_t)u.pm * 256 * DM, H + tok0 * DM, DM, DM, 0, DM, fmap ? 1 : 0}; };
              bf16* YT = WSP(bf16, WS_YT); bf16* VT = WSP(bf16, WS_VT);
              auto E = [=](EPI_ARGS) { bf16* T = (u.pm < 4) ? YT : VT; const int rr0 = (u.pm & 3) * 256;
                  if (u.pn < 128) { const int b = u.pn >> 4;
                      if (u.pm < 4) { const int t16 = u.pn & 15, l10 = (t16 >> 1) * 8, l20 = (t16 & 1) * 32;
                          EPI_FOR8( const int fc = rr0 + r; st_bf8(T + ((((size_t)b * 512 + (fc >> 1)) * 64 + l20 + (c >> 3)) * 2 + (fc & 1)) * 64 + l10, v0, v1); ) }
                      else { const int l0 = (u.pn & 15) * 256; EPI_FOR8( st_bf8(T + ((size_t)b * 1024 + rr0 + r) * 4096 + l0 + c, v0, v1); ) } }
                  else { const int b = u.pn - 128; EPI_FOR8( st_bf8(T + YT_CTX_OFF + ((size_t)b * 1024 + rr0 + r) * 256 + c, v0, v1); ) } };
              GEMM_P(S, AD, E); }
        REP_END }
        SEAM(pb + 0);
        if (IN(pb + 1)) { REFRESH();
            REP_BEGIN(31) p_attn_mfma(P, F, l, L0); REP_END
            REFRESH();
            REP_BEGIN(32)
            { LAS float* tw = (LAS float*)(F.lds + LDS_TW);
              for (int j = F.tid; j < 4096; j += NTHREADS) tw[j] = cospif((float)j * (1.0f / 2048.0f));
              __syncthreads();
              GroupSched S; S.init(1, 1, 1024, F.G, F.bid);
              const bf16* M1 = WSP(bf16, WS_M1T); const bf16* YF = WSP(bf16, WS_YT); bf16* ZP = WSP(bf16, WS_ZP);
              auto AD = [=](const Unit& u) { return Operands{M1, YF + (size_t)u.pn * 256 * 128, 256, 128, 0, 256}; };
              auto E = [=](EPI_ARGS) {
                  if (wr != 0) return;
                  const int b = u.pn >> 7, gm0 = (u.pn & 127) * 4;
#pragma unroll
                  for (int m = 0; m < 4; ++m) { const int k1 = 16 * m + fr;
#pragma unroll
                      for (int bj = 0; bj < 2; ++bj) { const int l20 = 32 * (wc & 1) + 8 * fq, gm = gm0 + 2 * bj + (wc >> 1);
                          f32x4 zr[2], zi[2];
#pragma unroll
                          for (int n = 0; n < 2; ++n)
#pragma unroll
                              for (int j = 0; j < 4; ++j) { const int ix = k1 * (l20 + 4 * n + j); const float tc = tw[ix], ts = tw[(ix + 3072) & 4095];
                                  const float ur = acc[0][bj][m][n][j], ui = acc[1][bj][m][n][j]; zr[n][j] = ur * tc - ui * ts; zi[n][j] = ur * ts + ui * tc; }
                          bf16* dst = ZP + ((((size_t)b * 64 + k1) * 512 + gm) * 2) * 64 + l20;
                          st_bf8(dst, zr[0], zr[1]); st_bf8(dst + 64, zi[0], zi[1]); } } };
              GEMM_P(S, AD, E); }
            REP_END
        }
        SEAM(pb + 1);
        if (IN(pb + 10)) { REFRESH();
            { GroupSched S; S.init(1, 1, 1024, F.G, F.bid);
              const bf16* M2 = WSP(bf16, WS_M2T); const bf16* ZP = WSP(bf16, WS_ZP); bf16* FOUR = WSP(bf16, WS_FOUR);
              auto AD = [=](const Unit& u) { return Operands{M2, ZP + (size_t)u.pn * 256 * 128, 256, 128, 0, 256}; };
              auto E = [=](EPI_ARGS) {
                  if (wr != 0) return;
                  const int b = u.pn >> 7, k1 = (u.pn >> 1) & 63, gmb = (u.pn & 1) * 256 + wc * 32 + 8 * fq; const float sc = 0.0013810679320049757f;
#pragma unroll
                  for (int m = 0; m < 4; ++m) { const int k2 = 16 * m + fr; bf16* dst = FOUR + ((size_t)b * SEQ + k1 + 64 * k2) * 512 + gmb;
#pragma unroll
                      for (int bj = 0; bj < 2; ++bj) st_bf8(dst + bj * 128, acc[0][bj][m][0] * sc, acc[0][bj][m][1] * sc); } };
              GEMM_P(S, AD, E); }
            REFRESH();
            if (L0) { GroupSched S; S.init(1, 1, 16, F.G, (F.bid + F.G - 128 % F.G) % F.G);
              const bf16* DFTC = WSP(bf16, WS_DFTC); const bf16* YTC = WSP(bf16, WS_YT) + YT_CTX_OFF; bf16* FOUR = WSP(bf16, WS_FOUR);
              auto AD = [=](const Unit& u) { return Operands{DFTC, YTC + (size_t)u.pn * 256 * 512, 512, 512, 0, 512}; };
              auto E = [=](EPI_ARGS) { const int b = u.pn >> 1, c0 = (u.pn & 1) * 256; const float sc = 0.005524271728019903f;
                  EPI_FOR8( st_bf8(FOUR + ((size_t)RL + b * CTXL + r) * 512 + c0 + c, v0 * sc, v1 * sc); ) };
              GEMM_P(S, AD, E); }
            REFRESH();
            REP_BEGIN(33) p_pool(F, L0 ? RT : RL); REP_END
        }
        SEAM(pb + 10);
        if (IN(pb + 2)) { REFRESH();
            SegSched<3> S; S.base.init(1, L0 ? 136 : 128, 4, F.G, F.bid);
            const bf16* ATT = WSP(bf16, WS_ATT); const bf16* FOUR = WSP(bf16, WS_FOUR); const bf16* POOL = WSP(bf16, WS_POOL);
            const bf16* WAO = WSP(bf16, WS_WAO); const bf16* WFO = WSP(bf16, WS_WFO); const bf16* WPO = WSP(bf16, WS_WPO);
            const bf16* GB = WSP(bf16, WS_GB); bf16* MRGB = WSP(bf16, WS_MRGB); const float* ps = P.pool_scale + l * 1024;
            auto AD = [=](const Unit& u) {
                if (u.seg == 0) return Operands{ATT + (size_t)u.pm * 256 * 1024, WAO + (size_t)u.pn * 256 * 1024, 1024, 1024, 0, 1024};
                if (u.seg == 1) return Operands{FOUR + (size_t)u.pm * 256 * 512, WFO + (size_t)u.pn * 256 * 512, 512, 512, 0, 512};
                return Operands{POOL + (size_t)u.pm * 256 * 512 + (u.pn >> 1) * 256, WPO + (size_t)u.pn * 256 * 256, 512, 256, 0, 256}; };
            auto E = [=](EPI_ARGS) {
                const int kd = u.seg < 2 ? u.seg + 1 : 2; const bool fin = (u.seg == 2); const int colb = u.pn * 256 + wc * 32 + 8 * fq;
#pragma unroll
                for (int ai = 0; ai < 2; ++ai)
#pragma unroll
                    for (int m = 0; m < 4; ++m) { const size_t row = (size_t)u.pm * 256 + ai * 128 + wr * 64 + m * 16 + fr; const bf16* gr = GB + row * 3072 + colb;
                        u32x4 nr[2], dr[2]; f32x4 psv[2][2];
#pragma unroll
                        for (int bj = 0; bj < 2; ++bj) { nr[bj] = *(const u32x4*)(gr + u.seg * 1024 + bj * 128); dr[bj] = *(const u32x4*)(gr + kd * 1024 + bj * 128);
                            psv[bj][0] = *(const f32x4*)(ps + colb + bj * 128); psv[bj][1] = *(const f32x4*)(ps + colb + bj * 128 + 4); }
#pragma unroll
                        for (int bj = 0; bj < 2; ++bj) { f32x4 o[2];
#pragma unroll
                            for (int n = 0; n < 2; ++n) { f32x4 nu = {bflo(nr[bj][2 * n]), bfhi(nr[bj][2 * n]), bflo(nr[bj][2 * n + 1]), bfhi(nr[bj][2 * n + 1])}, de = {bflo(dr[bj][2 * n]), bfhi(dr[bj][2 * n]), bflo(dr[bj][2 * n + 1]), bfhi(dr[bj][2 * n + 1])};
                                if (u.seg == 2) nu = nu * psv[bj][n];
                                de = de * psv[bj][n];
#pragma unroll
                                for (int j = 0; j < 4; ++j) { const float nj = (fabsf(nu[j]) < 1e-30f) ? copysignf(1e-30f, nu[j]) : nu[j]; const float dj = (fabsf(de[j]) < 1e-30f) ? copysignf(1e-30f, de[j]) : de[j];
                                    o[n][j] = acc[ai][bj][m][n][j] * nj * (fin ? 1.0f : __builtin_amdgcn_rcpf(dj)); }
                                acc[ai][bj][m][n] = o[n]; }
                            if (fin) st_bf8(MRGB + row * 1024 + colb + bj * 128, o[0], o[1]); } } };
            gemm_fast<false, true>(F.lds, F.tid, S, AD, mk_epi_seg(E, 2), nullptr);
        }
        SEAM(pb + 2);
        if (IN(pb + 3)) { REFRESH();
            GroupSched S; S.init(1, L0 ? 136 : 128, 4, F.G, F.bid); const bf16* A = WSP(bf16, WS_MRGB); const bf16* W = WSP(bf16, WS_WOUT);
            const float* xin = L0 ? P.x : P.out; const float* cin = L0 ? P.ctx : WSP(float, WS_XC); float* xo = P.out; float* co = WSP(float, WS_XC);
            const float* MOD = WSP(float, WS_MOD) + (size_t)l * 9 * 6144;
            auto AD = [=](const Unit& u) { return Operands{A + (size_t)u.pm * 256 * 1024, W + (size_t)u.pn * 256 * 1024, 1024, 1024, 0, 1024}; };
            auto E = [=](EPI_ARGS) {
                const int row0 = u.pm * 256, mr = row0 < RL ? (row0 >> 12) : 8, colb = u.pn * 256 + wc * 32 + 4 * fq;
                const float* src0 = row0 < RL ? xin + (size_t)row0 * DM : cin + (size_t)(row0 - RL) * DM; float* dst0 = row0 < RL ? xo + (size_t)row0 * DM : co + (size_t)(row0 - RL) * DM;
                f32x4 gv[2][2];
#pragma unroll
                for (int bj = 0; bj < 2; ++bj)
#pragma unroll
                    for (int n = 0; n < 2; ++n) gv[bj][n] = *(const f32x4*)(MOD + (size_t)mr * 6144 + 2048 + colb + bj * 128 + n * 16);
#pragma unroll
                for (int ai = 0; ai < 2; ++ai) { f32x4 xv[4][2][2];
#pragma unroll
                    for (int m = 0; m < 4; ++m) { const size_t ro = (size_t)(ai * 128 + wr * 64 + m * 16 + fr) * DM + colb;
#pragma unroll
                        for (int bj = 0; bj < 2; ++bj)
#pragma unroll
                            for (int n = 0; n < 2; ++n) xv[m][bj][n] = *(const f32x4*)(src0 + ro + bj * 128 + n * 16); }
#pragma unroll
                    for (int m = 0; m < 4; ++m) { const size_t ro = (size_t)(ai * 128 + wr * 64 + m * 16 + fr) * DM + colb;
#pragma unroll
                        for (int bj = 0; bj < 2; ++bj)
#pragma unroll
                            for (int n = 0; n < 2; ++n) *(f32x4*)(dst0 + ro + bj * 128 + n * 16) = xv[m][bj][n] + gv[bj][n] * acc[ai][bj][m][n]; } } };
            GEMM(S, AD, E, 1024, 1024, 1024);
        }
        SEAM(pb + 3);
        if (IN(pb + 4)) { REFRESH(); REP_BEGIN(6) p_rowpass_f(P, F, l, L0 ? RT : RL); REP_END }
        SEAM(pb + 4);
        if (IN(pb + 5)) { REFRESH(); REP_BEGIN(7) p_topk(F, L0); REP_END }
        SEAM(pb + 5);
        if (IN(pb + 7)) { REFRESH(); REP_BEGIN(9)
            GroupSched S; S.init(16, L0 ? 17 : 16, 22, F.G, F.bid); const bf16* W = WSP(bf16, WS_WGU); bf16* HID = WSP(bf16, WS_HID); const int* SROW = WSP(int, WS_SROW);
            auto AD = [=](const Unit& u) { return Operands{H, W + ((size_t)u.grp * 5632 + u.pn * 256) * DM, DM, DM, u.grp * SLOT_E + u.pm * 256, DM}; };
            auto E = [=](EPI_ARGS) {
#pragma unroll
                for (int ai = 0; ai < 2; ++ai)
#pragma unroll
                    for (int m = 0; m < 4; ++m) { const size_t slot = (size_t)u.grp * SLOT_E + u.pm * 256 + ai * 128 + wr * 64 + m * 16 + fr; f32x4 o[2];
#pragma unroll
                        for (int n = 0; n < 2; ++n) { const f32x4 a = acc[ai][0][m][n], up = acc[ai][1][m][n];
#pragma unroll
                            for (int j = 0; j < 4; ++j) o[n][j] = a[j] * sigmoidf_(a[j]) * up[j]; }
                        st_bf8(HID + slot * FF + u.pn * 128 + wc * 32 + 8 * fq, o[0], o[1]); } };
            GEMM_GATHER(S, AD, E, DM, DM, DM, SROW);
        REP_END }
        SEAM(pb + 7);
        if (IN(pb + 8)) { REFRESH(); REP_BEGIN(10)
            const int tpe = L0 ? 17 : 16;
            GroupSched S; S.init(1, 16 * tpe, 4, F.G, F.bid); const bf16* HID = WSP(bf16, WS_HID); const bf16* W = WSP(bf16, WS_WD); bf16* Y = WSP(bf16, WS_Y); const float* SG = WSP(float, WS_SGATE);
            auto AD = [=](const Unit& u) { const int e = u.pm / tpe, st = e * 17 + (u.pm - e * tpe); return Operands{HID + (size_t)st * 256 * FF, W + ((size_t)e * 1024 + u.pn * 256) * FF, FF, FF, 0, FF}; };
            auto E = [=](EPI_ARGS) { const int e = u.pm / tpe; const size_t slot0 = (size_t)(e * 17 + (u.pm - e * tpe)) * 256 + wr * 64 + fr; float gt[2][4];
#pragma unroll
                for (int ai = 0; ai < 2; ++ai)
#pragma unroll
                    for (int m = 0; m < 4; ++m) gt[ai][m] = SG[slot0 + ai * 128 + m * 16];
#pragma unroll
                for (int ai = 0; ai < 2; ++ai)
#pragma unroll
                    for (int m = 0; m < 4; ++m)
#pragma unroll
                        for (int bj = 0; bj < 2; ++bj) st_bf8(Y + (slot0 + ai * 128 + m * 16) * DM + u.pn * 256 + bj * 128 + wc * 32 + 8 * fq, acc[ai][bj][m][0] * gt[ai][m], acc[ai][bj][m][1] * gt[ai][m]); };
            GEMM_P(S, AD, E);
        REP_END }
        SEAM(pb + 8);
        if (IN(pb + 9)) { REFRESH(); p_rowpass_k(P, F, l, L0 ? RT : RL); if (L0) p_wconv(P, F, 1); }
        if (L0) SEAM(pb + 9);
    }
#undef IN
#undef SEAM
}
template <int PH> static void launch_ph(int grid, const Params& p, hipStream_t stream) { hipLaunchKernelGGL(fwd_kernel<PH>, dim3(grid), dim3(NTHREADS), LDS_BYTES, stream, p); }
template <int PH> static bool set_attr() { return hipFuncSetAttribute((const void*)fwd_kernel<PH>, hipFuncAttributeMaxDynamicSharedMemorySize, LDS_BYTES) == hipSuccess; }

#ifndef DUP_LAUNCH
#define DUP_LAUNCH -1
#endif
extern "C" void kernel_launch(void* const* d_in, const int* in_sizes, int n_in, void* d_out, int out_size, void* d_ws, size_t ws_size, hipStream_t stream) {
    static int grid = 0;
    if (grid == 0) {
        if (n_in != 20 || out_size != RL * DM || ws_size < WS_END) { fprintf(stderr, "kernel_launch: unexpected shapes (n_in %d out %d ws %zu need %zu)\n", n_in, out_size, ws_size, (size_t)WS_END); grid = -1; return; }
        int dev = 0, cus = 0, per_cu = 0;
        if (hipGetDevice(&dev) != hipSuccess || hipDeviceGetAttribute(&cus, hipDeviceAttributeMultiprocessorCount, dev) != hipSuccess) { grid = -1; return; }
#if N_LAUNCH_MODE == 1
        if (!set_attr<-1>()) { fprintf(stderr, "kernel_launch: hipFuncSetAttribute failed\n"); grid = -1; return; }
        if (hipOccupancyMaxActiveBlocksPerMultiprocessor(&per_cu, (const void*)fwd_kernel<-1>, NTHREADS, LDS_BYTES) != hipSuccess || per_cu < 1) fprintf(stderr, "kernel_launch: occupancy query reports %d\n", per_cu);
#else
        if (!(set_attr<0>() && set_attr<1>() && set_attr<2>() && set_attr<3>() && set_attr<12>() && set_attr<4>() && set_attr<5>() && set_attr<6>() && set_attr<7>() && set_attr<9>() && set_attr<10>() && set_attr<11>())) { fprintf(stderr, "kernel_launch: hipFuncSetAttribute failed\n"); grid = -1; return; }
        (void)per_cu;
#endif
        (void)hipGetLastError();
        grid = cus;
    }
    if (grid < 0) return;
    if (hipMemsetAsync((char*)d_ws + WS_CTL, 0, CTL_BYTES, stream) != hipSuccess) return;
    Params p{};
    const float** pp = (const float**)&p;
    for (int i = 0; i < 20; ++i) pp[i] = (const float*)d_in[i];
    p.out = (float*)d_out; p.ws = (unsigned char*)d_ws;
#if N_LAUNCH_MODE == 1
    p.l_lo = 0; p.l_hi = 2;
    launch_ph<-1>(grid, p, stream);
#else
    p.l_lo = 0; p.l_hi = 0; launch_ph<0>(grid, p, stream); if (DUP_LAUNCH == 0) launch_ph<0>(grid, p, stream); launch_ph<1>(grid, p, stream); if (DUP_LAUNCH == 1) launch_ph<1>(grid, p, stream);
#define LP(k) do { launch_ph<k>(grid, p, stream); if (DUP_LAUNCH == (k) && l == 0) launch_ph<k>(grid, p, stream); } while (0)
    for (int l = 0; l < 2; ++l) { p.l_lo = l; p.l_hi = l + 1;
        LP(2); LP(3); LP(12); LP(4); LP(5); LP(6); LP(7); LP(9); LP(10); LP(11); }
#endif
}
```

```cpp
#include <hip/hip_runtime.h>
#include <cstdio>
#include <cstdint>

#ifndef N_LAUNCH_MODE
#define N_LAUNCH_MODE 1
#endif

#define GAS __attribute__((address_space(1)))
#define LAS __attribute__((address_space(3)))
typedef unsigned short bf16;
typedef short bf16x8 __attribute__((ext_vector_type(8)));
typedef float f32x4 __attribute__((ext_vector_type(4)));
typedef unsigned u32x4 __attribute__((ext_vector_type(4)));
typedef unsigned u32x2 __attribute__((ext_vector_type(2)));

constexpr int NB = 8, SEQ = 4096, DM = 1024, CTXL = 256, NH = 16, HD = 64, GRIDW = 64;
constexpr int RL = NB * SEQ, RC = NB * CTXL, RT = RL + RC;
constexpr int INW = 7168, NE = 16, FF = 2816, CAPL = 512, CAPC = 32;
constexpr int SLOT_E = 4352, NSLOT = NE * SLOT_E;
constexpr float RMS_EPS = 1e-6f;
constexpr float LOG2E = 1.4426950408889634f, QSCALE = 0.125f * LOG2E;
constexpr int NWAVES = 8, NTHREADS = 512;

constexpr size_t al256(size_t x) { return (x + 255) & ~(size_t)255; }
constexpr size_t WS_CTL = 0, CTL_BYTES = 1u << 20;
constexpr size_t WS_MOD = WS_CTL + CTL_BYTES;
constexpr size_t WS_XC = al256(WS_MOD + (size_t)2 * 9 * 6144 * 4);
constexpr size_t WS_AFF = al256(WS_XC + (size_t)RC * DM * 4);
constexpr size_t WS_SROW = al256(WS_AFF + (size_t)RT * 16 * 4);
constexpr size_t WS_SGATE = al256(WS_SROW + (size_t)NSLOT * 4);
constexpr size_t WS_SEL = al256(WS_SGATE + (size_t)NSLOT * 4);
constexpr size_t WS_DFTM = al256(WS_SEL + (size_t)RT * 16 * 4);
constexpr size_t WS_DFTC = al256(WS_DFTM + (size_t)4096 * 8192 * 2);
constexpr size_t WS_WA = al256(WS_DFTC + (size_t)256 * 512 * 2);
constexpr size_t WS_WFV = al256(WS_WA + (size_t)5632 * 1024 * 2);
constexpr size_t WS_WAO = al256(WS_WFV + (size_t)2048 * 1024 * 2);
constexpr size_t WS_WFO = al256(WS_WAO + (size_t)1024 * 1024 * 2);
constexpr size_t WS_WPO = al256(WS_WFO + (size_t)1024 * 512 * 2);
constexpr size_t WS_WOUT = al256(WS_WPO + (size_t)1024 * 256 * 2);
constexpr size_t WS_WGU = al256(WS_WOUT + (size_t)1024 * 1024 * 2);
constexpr size_t WS_WD = al256(WS_WGU + (size_t)16 * 5632 * 1024 * 2);
constexpr size_t WS_H = al256(WS_WD + (size_t)16 * 1024 * 2816 * 2);
constexpr size_t WS_R = al256(WS_H + (size_t)RT * DM * 2);
constexpr size_t WS_KQ = WS_R;
constexpr size_t WS_MRG = WS_KQ;
constexpr size_t WS_PB = al256(WS_KQ + (size_t)RT * 2048 * 2);
constexpr size_t WS_GB = al256(WS_PB + (size_t)RT * 512 * 2);
constexpr size_t WS_YT = al256(WS_GB + (size_t)RT * 3072 * 2);
constexpr size_t WS_MRGB = WS_YT;
constexpr size_t WS_VT = al256(WS_YT + (size_t)RT * 1024 * 2);
constexpr size_t WS_FOUR = al256(WS_VT + (size_t)RT * 1024 * 2);
constexpr size_t WS_ATT = al256(WS_FOUR + (size_t)RT * 512 * 2);
constexpr size_t WS_POOL = al256(WS_ATT + (size_t)RT * 1024 * 2);
constexpr size_t WS_MIX_END = al256(WS_POOL + (size_t)RT * 512 * 2);
constexpr size_t WS_XG = WS_R;
constexpr size_t WS_HID = al256(WS_XG + (size_t)NSLOT * 1024 * 2);
constexpr size_t WS_Y = al256(WS_HID + (size_t)NSLOT * 2816 * 2);
constexpr size_t WS_MOE_END = al256(WS_Y + (size_t)NSLOT * 1024 * 2);
constexpr size_t WS_END0 = WS_MIX_END > WS_MOE_END ? WS_MIX_END : WS_MOE_END;
constexpr size_t WS_ZP = WS_END0;
constexpr size_t WS_M1T = al256(WS_ZP + ((size_t)8 * 64 * 512 * 128 + 1024) * 2);
constexpr size_t WS_M2T = al256(WS_M1T + (size_t)256 * 256 * 2);
constexpr size_t WS_END = al256(WS_M2T + (size_t)256 * 512 * 2);
constexpr size_t YT_CTX_OFF = (size_t)8 * 1024 * 4096;

constexpr int CW_BAR = 4096;

constexpr int LDS_BYTES = 155648;
constexpr int LDS_TW = 132096;
constexpr int LDS_MISC = 131072;

__device__ __forceinline__ unsigned f2bf(float f) { unsigned u = __float_as_uint(f); return (u + 0x7fffu + ((u >> 16) & 1u)) >> 16; }
typedef __bf16 hbf16x2 __attribute__((ext_vector_type(2)));
typedef float f32x2 __attribute__((ext_vector_type(2)));
__device__ __forceinline__ unsigned pk2(float lo, float hi) { const f32x2 v = {lo, hi}; return __builtin_bit_cast(unsigned, __builtin_convertvector(v, hbf16x2)); }
__device__ __forceinline__ float bf2f(unsigned b) { return __uint_as_float(b << 16); }
__device__ __forceinline__ float bflo(unsigned w) { return __uint_as_float(w << 16); }
__device__ __forceinline__ float bfhi(unsigned w) { return __uint_as_float(w & 0xffff0000u); }
template <int CTRL> __device__ __forceinline__ float dppf(float x) { return __builtin_bit_cast(float, __builtin_amdgcn_mov_dpp(__builtin_bit_cast(int, x), CTRL, 0xf, 0xf, true)); }
template <int CTRL> __device__ __forceinline__ int dppi(int x) { return __builtin_amdgcn_mov_dpp(x, CTRL, 0xf, 0xf, true); }
constexpr int DPP_XOR1 = 0xB1, DPP_XOR2 = 0x4E, DPP_ROR4 = 0x124, DPP_ROR8 = 0x128;
__device__ __forceinline__ float wave_sum(float v) {
    v += dppf<DPP_XOR1>(v); v += dppf<DPP_XOR2>(v); v += dppf<DPP_ROR4>(v); v += dppf<DPP_ROR8>(v);
    auto s = __builtin_amdgcn_permlane16_swap(__float_as_uint(v), __float_as_uint(v), false, false); v = __uint_as_float(s[0]) + __uint_as_float(s[1]);
    auto t = __builtin_amdgcn_permlane32_swap(__float_as_uint(v), __float_as_uint(v), false, false); return __uint_as_float(t[0]) + __uint_as_float(t[1]);
}
__device__ __forceinline__ float wave_max(float v) {
    v = fmaxf(v, dppf<DPP_XOR1>(v)); v = fmaxf(v, dppf<DPP_XOR2>(v)); v = fmaxf(v, dppf<DPP_ROR4>(v)); v = fmaxf(v, dppf<DPP_ROR8>(v));
    auto s = __builtin_amdgcn_permlane16_swap(__float_as_uint(v), __float_as_uint(v), false, false); v = fmaxf(__uint_as_float(s[0]), __uint_as_float(s[1]));
    auto t = __builtin_amdgcn_permlane32_swap(__float_as_uint(v), __float_as_uint(v), false, false); return fmaxf(__uint_as_float(t[0]), __uint_as_float(t[1]));
}
__device__ __forceinline__ int wave_sum_i(int v) {
    v += dppi<DPP_XOR1>(v); v += dppi<DPP_XOR2>(v); v += dppi<DPP_ROR4>(v); v += dppi<DPP_ROR8>(v);
    auto s = __builtin_amdgcn_permlane16_swap((unsigned)v, (unsigned)v, false, false); v = (int)(s[0] + s[1]);
    auto t = __builtin_amdgcn_permlane32_swap((unsigned)v, (unsigned)v, false, false); return (int)(t[0] + t[1]);
}
__device__ __forceinline__ float sigmoidf_(float x) { return __builtin_amdgcn_rcpf(1.f + __builtin_amdgcn_exp2f(x * -1.4426950408889634f)); }
#define LDS_WAIT() asm volatile("s_waitcnt lgkmcnt(0)" ::: "memory")

#define XB_TMO      128
#define XB_XCNT(j)  (256  + 64 * (j))
#define XB_XSUB(j)  (1280 + 64 * (j))
#define XB_XGEN(j)  (2304 + 64 * (j))
#define XB_TOP      3328
#define XB_TOPGEN   3392
#define XCD_BAR_WORDS 3456
#define XB_SPIN_CAP (1u << 22)

__device__ __forceinline__ unsigned xb_ld(unsigned* p)              { return __hip_atomic_load(p, __ATOMIC_RELAXED, __HIP_MEMORY_SCOPE_AGENT); }
__device__ __forceinline__ unsigned xb_add(unsigned* p, unsigned v) { return __hip_atomic_fetch_add(p, v, __ATOMIC_RELAXED, __HIP_MEMORY_SCOPE_AGENT); }
__device__ __forceinline__ unsigned xb_xcc_id() { return (unsigned)__builtin_amdgcn_s_getreg((3 << 11) | 20) & 0xFu; }
#define XB_SPIN(cond, bar) do { unsigned _sp = 0; while (cond) { __builtin_amdgcn_s_sleep(1); \
    if ((++_sp & 255u) == 0u) { if (xb_ld(&(bar)[XB_TMO])) break; if (_sp > XB_SPIN_CAP) { atomicAdd(&(bar)[XB_TMO], 1u); break; } } } } while (0)

struct XcdBarrier { unsigned* bar; unsigned x; volatile LAS unsigned* st; };

__device__ __forceinline__ XcdBarrier xcd_barrier_post(unsigned* bar, volatile LAS unsigned* st) {
    XcdBarrier b; b.bar = bar; b.x = xb_xcc_id(); b.st = st;
    if (threadIdx.x == 0) (void)xb_add(&bar[XB_XCNT(b.x)], 1u);
    return b;
}
__device__ __forceinline__ void xcd_barrier_complete(unsigned* bar, unsigned x, unsigned& nloc, unsigned& nx) {
    const unsigned G = gridDim.x * gridDim.y * gridDim.z;
    unsigned sum, cnt, mine, sp = 0u;
    for (;;) {
        sum = 0u; cnt = 0u; mine = 0u;
#pragma unroll
        for (unsigned j = 0; j < 16; ++j) { const unsigned c = xb_ld(&bar[XB_XCNT(j)]); sum += c; cnt += (c > 0u) ? 1u : 0u; mine = (j == x) ? c : mine; }
        if (sum == G) break;
        __builtin_amdgcn_s_sleep(1);
        if ((++sp & 255u) == 0u) { if (xb_ld(&bar[XB_TMO])) break; if (sp > XB_SPIN_CAP) { atomicAdd(&bar[XB_TMO], 1u); break; } }
    }
    nloc = mine > 0u ? mine : 1u; nx = cnt > 0u ? cnt : 1u;
}
__device__ __forceinline__ void xcd_barrier(const XcdBarrier& b) {
    asm volatile("s_waitcnt vmcnt(0)" ::: "memory");
    __syncthreads();
    if (threadIdx.x == 0) {
        unsigned* bar = b.bar;
        __builtin_amdgcn_s_waitcnt(0);
        unsigned nloc = b.st[0], nx = b.st[1];
        if (nloc == 0u) { xcd_barrier_complete(bar, b.x, nloc, nx); b.st[0] = nloc; b.st[1] = nx; }
        const unsigned old = xb_add(&bar[XB_XSUB(b.x)], 1u);
        const unsigned gen = old / nloc;
        if (old + 1u == (gen + 1u) * nloc) {
            __builtin_amdgcn_fence(__ATOMIC_RELEASE, "agent");
            asm volatile("s_waitcnt vmcnt(0)" ::: "memory");
            const unsigned og = xb_add(&bar[XB_TOP], 1u);
            const unsigned tg = og / nx;
            if (og + 1u == (tg + 1u) * nx) xb_add(&bar[XB_TOPGEN], 1u);
            else XB_SPIN(xb_ld(&bar[XB_TOPGEN]) == tg, bar);
            __builtin_amdgcn_fence(__ATOMIC_ACQUIRE, "agent");
            xb_add(&bar[XB_XGEN(b.x)], 1u);
            asm volatile("s_waitcnt vmcnt(0)" ::: "memory");
        } else {
            XB_SPIN(xb_ld(&bar[XB_XGEN(b.x)]) == gen, bar);
            __builtin_amdgcn_fence(__ATOMIC_ACQUIRE, "agent");
            asm volatile("s_waitcnt vmcnt(0)" ::: "memory");
        }
    }
    __syncthreads();
}

struct Params {
    const float *x, *c, *ctx, *c_ctx, *ada_w, *ada_b, *norm1_g, *norm2_g, *w_in, *rpb, *w_att_o, *w_fourier, *w_pool, *pool_scale, *w_out, *w_router, *w_eg, *w_eu, *w_ed, *final_g;
    float* out; unsigned char* ws; int l_lo, l_hi;
};
struct Frame {
    LAS unsigned char* lds;
    int tid, lane, wave, G, bid;
    unsigned char* ws;
};
#define WSP(T, off) ((T*)(F.ws + (off)))

struct Unit { int grp, pm, pn, seg; };
struct GroupSched {
    int ng, nM, nN, G, c; int tM, tN, tpm0, tpn0;
    __device__ __forceinline__ void init(int ng_, int nM_, int nN_, int G_, int c_, int tM_ = 0, int tN_ = 0, int tpm0_ = 0, int tpn0_ = 0) { ng = ng_; nM = nM_; nN = nN_; G = G_; c = c_; tM = tM_; tN = tN_; tpm0 = tpm0_; tpn0 = tpn0_; }
    __device__ __forceinline__ bool next(int i, Unit& u) const {
        const int per = nM * nN; const int L = i * G + c;
        if (L < ng * per) {
            u.grp = L / per; int wgid = L - u.grp * per;
            { const int q = per / 8, r = per % 8, xcd = wgid % 8, off = wgid / 8; wgid = (xcd < r ? xcd * (q + 1) : r * (q + 1) + (xcd - r) * q) + off; }
            const int nig = 8 * nN, gid = wgid / nig, fm = gid * 8, gsz = (nM - fm) < 8 ? (nM - fm) : 8;
            u.pm = fm + ((wgid % nig) % gsz); u.pn = (wgid % nig) / gsz; u.seg = 0; return true;
        }
        const int w = L - ng * per;
        if (w < tM * tN) { u.grp = ng; u.pm = tpm0 + (w % tM); u.pn = tpn0 + (w / tM); u.seg = 0; return true; }
        return false;
    }
};
struct Operands { const bf16* A; const bf16* Bt; int lda, ldb, slot0, K; int bmap; };

template <class Addr, class Epi>
__device__ __forceinline__ void gemm_simple(const GroupSched& S, const Addr& AD, const Epi& E, int K) {
    const int tid = threadIdx.x, wid = __builtin_amdgcn_readfirstlane(tid >> 6), lane = tid & 63, wr = wid >> 2, wc = wid & 3, fr = lane & 15, fq = lane >> 4;
    Unit u;
    for (int i = 0; S.next(i, u); ++i) {
        const Operands op = AD(u);
        f32x4 acc[2][2][4][2];
#pragma unroll
        for (int a = 0; a < 2; ++a)
#pragma unroll
            for (int b = 0; b < 2; ++b)
#pragma unroll
                for (int m = 0; m < 4; ++m)
#pragma unroll
                    for (int n = 0; n < 2; ++n) acc[a][b][m][n] = (f32x4){0.f, 0.f, 0.f, 0.f};
        const bf16* ap = op.A + (size_t)(wr * 64 + fr) * op.lda + fq * 8;
        const bf16* bp = op.Bt + (size_t)(wc * 32 + fr) * op.ldb + fq * 8;
#pragma unroll 1
        for (int k = 0; k < K; k += 32) {
            bf16x8 bfr[2][2];
#pragma unroll
            for (int b = 0; b < 2; ++b)
#pragma unroll
                for (int n = 0; n < 2; ++n) bfr[b][n] = *(const bf16x8*)(bp + (size_t)(b * 128 + n * 16) * op.ldb + k);
#pragma unroll
            for (int a = 0; a < 2; ++a) {
                bf16x8 af[4];
#pragma unroll
                for (int m = 0; m < 4; ++m) af[m] = *(const bf16x8*)(ap + (size_t)(a * 128 + m * 16) * op.lda + k);
#pragma unroll
                for (int b = 0; b < 2; ++b)
#pragma unroll
                    for (int m = 0; m < 4; ++m)
#pragma unroll
                        for (int n = 0; n < 2; ++n) acc[a][b][m][n] = __builtin_amdgcn_mfma_f32_16x16x32_bf16(bfr[b][n], af[m], acc[a][b][m][n], 0, 0, 0);
            }
        }
        E(acc, u, wr, wc, fr, fq);
    }
}
constexpr int HTB = 128 * 64 * 2;
__device__ __forceinline__ int lds_byte(int r, int c) { const int st = (r >> 4) * 2 + (c >> 5), rr = r & 15, cc = c & 31, ob = rr * 64 + cc * 2; return st * 1024 + (ob ^ (((ob >> 9) & 1) << 5)); }
__device__ __forceinline__ int perm32(int rho) { const int n = rho >> 4, i = rho & 15; return 8 * (i >> 2) + 4 * n + (i & 3); }
__device__ __forceinline__ void stage_rc(int b, int& R, int& C) { const int st = b / 1024, sb = b % 1024, swz = sb ^ (((sb >> 9) & 1) << 5); R = (st >> 1) * 16 + swz / 64; C = (st & 1) * 32 + (swz % 64) / 2; }
template <bool GATHER, bool PERM, class Sched, class Addr, class Epi>
__device__ __forceinline__ void gemm_fast(LAS unsigned char* lds, const int tid, const Sched& S, const Addr& AD, const Epi& E, const int* __restrict__ grows) {
    const int wid = __builtin_amdgcn_readfirstlane(tid >> 6), lane = tid & 63, wr = wid >> 2, wc = wid & 3, fr = lane & 15, fq = lane >> 4;
    int sR[2], sRb[2]; unsigned sC[2];
    unsigned cvg[2][2], nvg[2][2], cvb[2][2], nvb[2][2];
#pragma unroll
    for (int i = 0; i < 2; ++i) { int R, C; stage_rc(tid * 16 + i * 8192, R, C); sR[i] = R; sC[i] = (unsigned)C * 2u; sRb[i] = PERM ? ((R & ~31) + perm32(R & 31)) : R; }
    const size_t kstep = 128;
    const unsigned ldsw = (unsigned)wid * 1024u;
    const int aoff = lds_byte(wr * 64 + fr, fq * 8), boff = lds_byte(wc * 32 + fr, fq * 8);
#define PG8_SA(b, h) (((b) * 2 + (h)) * HTB)
#define PG8_SB(b, h) ((4 + (b) * 2 + (h)) * HTB)
#define PG8_STAGE(bufoff, gbase, voff) do { _Pragma("unroll") for (int _i = 0; _i < 2; ++_i) \
        __builtin_amdgcn_global_load_lds((const unsigned*)((const char*)(gbase) + (voff)[_i]), (LAS unsigned*)(lds + (bufoff) + ldsw + _i * 8192), 16, 0, 0); } while (0)
#define PG8_LDA(dst, b, h) do { _Pragma("unroll") for (int m = 0; m < 4; ++m) _Pragma("unroll") for (int k = 0; k < 2; ++k) dst[m][k] = *(const LAS bf16x8*)(lds + PG8_SA(b, h) + aoff + m * 2048 + k * 1024); } while (0)
#define PG8_LDB(dst, b, h) do { _Pragma("unroll") for (int n = 0; n < 2; ++n) _Pragma("unroll") for (int k = 0; k < 2; ++k) dst[n][k] = *(const LAS bf16x8*)(lds + PG8_SB(b, h) + boff + n * 2048 + k * 1024); } while (0)
#define PG8_MMA(ai, bj, At, Bt) do { __builtin_amdgcn_s_setprio(1); _Pragma("unroll") for (int m = 0; m < 4; ++m) _Pragma("unroll") for (int n = 0; n < 2; ++n) _Pragma("unroll") for (int k = 0; k < 2; ++k) \
        acc[ai][bj][m][n] = __builtin_amdgcn_mfma_f32_16x16x32_bf16(Bt[n][k], At[m][k], acc[ai][bj][m][n], 0, 0, 0); __builtin_amdgcn_s_setprio(0); } while (0)
#define PG8_WAIT_V(n) asm volatile("s_waitcnt vmcnt(" #n ")" ::: "memory")
#define PG8_WAIT_L(n) asm volatile("s_waitcnt lgkmcnt(" #n ")" ::: "memory")
#define PG8_BAR __builtin_amdgcn_s_barrier()
#define PG8_SCHED __builtin_amdgcn_sched_barrier(0)
#define PG8_GIDX(dst, op_) do { _Pragma("unroll") for (int h_ = 0; h_ < 2; ++h_) _Pragma("unroll") for (int i_ = 0; i_ < 2; ++i_) dst[h_][i_] = (unsigned)grows[(op_).slot0 + h_ * 128 + sR[i_]] * (unsigned)((op_).lda * 2) + sC[i_]; } while (0)
#define PG8_AOFF(dst, op_) do { _Pragma("unroll") for (int h_ = 0; h_ < 2; ++h_) _Pragma("unroll") for (int i_ = 0; i_ < 2; ++i_) dst[h_][i_] = (unsigned)((sR[i_] + 128 * h_) * (op_).lda) * 2u + sC[i_]; } while (0)
#define PG8_BOFF(dst, op_) do { _Pragma("unroll") for (int h_ = 0; h_ < 2; ++h_) _Pragma("unroll") for (int i_ = 0; i_ < 2; ++i_) { const int c_ = sRb[i_] + 128 * h_; \
        dst[h_][i_] = (unsigned)(((op_).bmap ? (64 * (c_ & 7) + (c_ >> 3)) : c_) * (op_).ldb) * 2u + sC[i_]; } } while (0)
#define PG8_COPY(dst, src) do { _Pragma("unroll") for (int h_ = 0; h_ < 2; ++h_) _Pragma("unroll") for (int i_ = 0; i_ < 2; ++i_) dst[h_][i_] = src[h_][i_]; } while (0)
    Unit cur, nxt; int ui = 0;
    if (!S.next(0, cur)) return;
    f32x4 acc[2][2][4][2];
#pragma unroll
    for (int a = 0; a < 2; ++a)
#pragma unroll
        for (int b = 0; b < 2; ++b)
#pragma unroll
            for (int m = 0; m < 4; ++m)
#pragma unroll
                for (int n = 0; n < 2; ++n) acc[a][b][m][n] = (f32x4){0.f, 0.f, 0.f, 0.f};
    bf16x8 At[4][2], B0[2][2], B1[2][2];
    const char* cA; const char* cB; int nt;
    { const Operands op = AD(cur); cA = (const char*)op.A; cB = (const char*)op.Bt; nt = op.K / 64; PG8_BOFF(cvb, op);
      Unit u1; const bool h1 = S.next(1, u1); const Operands o1 = h1 ? AD(u1) : op; PG8_BOFF(nvb, o1);
      if constexpr (GATHER) { PG8_GIDX(cvg, op); PG8_GIDX(nvg, o1); PG8_WAIT_V(0); } else { PG8_AOFF(cvg, op); PG8_AOFF(nvg, o1); } }
    PG8_STAGE(PG8_SB(0, 0), cB, cvb[0]); PG8_STAGE(PG8_SB(0, 1), cB, cvb[1]); PG8_STAGE(PG8_SA(0, 0), cA, cvg[0]); PG8_STAGE(PG8_SA(0, 1), cA, cvg[1]);
    if (wr == 1) PG8_BAR;
    PG8_WAIT_V(2); PG8_BAR;
    PG8_STAGE(PG8_SB(1, 0), cB + kstep, cvb[0]); PG8_STAGE(PG8_SA(1, 0), cA + kstep, cvg[0]); PG8_STAGE(PG8_SB(1, 1), cB + kstep, cvb[1]);
    PG8_WAIT_V(6); PG8_BAR;
    for (;;) {
        const bool has_next = S.next(ui + 1, nxt);
        const char* nA = cA; const char* nB = cB; int nnt = nt;
        if (has_next) { const Operands op = AD(nxt); nA = (const char*)op.A; nB = (const char*)op.Bt; nnt = op.K / 64; }
#pragma unroll 1
        for (int t = 0; t < nt; t += 2) {
            const bool last = (t == nt - 2);
            const char* a1 = cA + (size_t)(t + 1) * kstep;
            const char* a2 = last ? nA : cA + (size_t)(t + 2) * kstep; const char* b2 = last ? nB : cB + (size_t)(t + 2) * kstep;
            const char* a3 = a2 + kstep; const char* b3 = b2 + kstep;
            unsigned v2[2][2], w2[2][2];
#pragma unroll
            for (int h_ = 0; h_ < 2; ++h_)
#pragma unroll
                for (int i_ = 0; i_ < 2; ++i_) { v2[h_][i_] = last ? nvg[h_][i_] : cvg[h_][i_]; w2[h_][i_] = last ? nvb[h_][i_] : cvb[h_][i_]; }
            PG8_LDB(B0, 0, 0); PG8_LDB(B1, 0, 1); PG8_SCHED; PG8_LDA(At, 0, 0); PG8_STAGE(PG8_SA(1, 1), a1, cvg[1]);
            PG8_WAIT_V(8); PG8_WAIT_L(0); PG8_BAR; PG8_MMA(0, 0, At, B0); PG8_MMA(0, 1, At, B1); PG8_BAR; PG8_SCHED;
            PG8_LDA(At, 0, 1); PG8_STAGE(PG8_SB(0, 0), b2, w2[0]); PG8_STAGE(PG8_SB(0, 1), b2, w2[1]); PG8_STAGE(PG8_SA(0, 0), a2, v2[0]);
            PG8_WAIT_V(8); PG8_WAIT_L(0); PG8_BAR; PG8_MMA(1, 0, At, B0); PG8_MMA(1, 1, At, B1); PG8_BAR; PG8_SCHED;
            PG8_LDB(B0, 1, 0); PG8_LDB(B1, 1, 1); PG8_SCHED; PG8_LDA(At, 1, 0); PG8_STAGE(PG8_SA(0, 1), a2, v2[1]);
            PG8_WAIT_V(8); PG8_WAIT_L(0); PG8_BAR; PG8_MMA(0, 0, At, B0); PG8_MMA(0, 1, At, B1); PG8_BAR; PG8_SCHED;
            PG8_LDA(At, 1, 1); PG8_STAGE(PG8_SB(1, 0), b3, w2[0]); PG8_STAGE(PG8_SB(1, 1), b3, w2[1]); PG8_STAGE(PG8_SA(1, 0), a3, v2[0]);
            PG8_WAIT_V(8); PG8_WAIT_L(0); PG8_BAR; PG8_MMA(1, 0, At, B0); PG8_MMA(1, 1, At, B1); PG8_BAR; PG8_SCHED;
        }
        if (wr == 0) PG8_BAR;
        unsigned fvg[2][2], fvb[2][2];
        { Unit u2; const bool h2 = S.next(ui + 2, u2);
          if (h2) { const Operands o2 = AD(u2); PG8_BOFF(fvb, o2); if constexpr (GATHER) PG8_GIDX(fvg, o2); else PG8_AOFF(fvg, o2); }
          else { PG8_COPY(fvb, nvb); PG8_COPY(fvg, nvg); } }
        { int fr2 = fr, fq2 = fq; asm volatile("" : "+v"(fr2), "+v"(fq2));
          E(acc, cur, wr, wc, fr2, fq2); }
        if (!has_next) break;
        if constexpr (GATHER) PG8_WAIT_V(0);
        PG8_COPY(cvg, nvg); PG8_COPY(nvg, fvg); PG8_COPY(cvb, nvb); PG8_COPY(nvb, fvb);
        if (E.reset(cur)) {
#pragma unroll
        for (int a = 0; a < 2; ++a)
#pragma unroll
            for (int b = 0; b < 2; ++b)
#pragma unroll
                for (int m = 0; m < 4; ++m)
#pragma unroll
                    for (int n = 0; n < 2; ++n) acc[a][b][m][n] = (f32x4){0.f, 0.f, 0.f, 0.f};
        }
        cur = nxt; cA = nA; cB = nB; nt = nnt; ++ui;
        if (wr == 1) PG8_BAR;
    }
    PG8_WAIT_V(0);
    PG8_BAR;
#undef PG8_SA
#undef PG8_SB
#undef PG8_STAGE
#undef PG8_LDA
#undef PG8_LDB
#undef PG8_MMA
#undef PG8_WAIT_V
#undef PG8_WAIT_L
#undef PG8_BAR
#undef PG8_SCHED
#undef PG8_GIDX
#undef PG8_AOFF
#undef PG8_BOFF
#undef PG8_COPY
}
template <class F> struct EpiFn { F f; __device__ __forceinline__ void operator()(f32x4 (&acc)[2][2][4][2], const Unit& u, int wr, int wc, int fr, int fq) const { f(acc, u, wr, wc, fr, fq); } __device__ __forceinline__ bool reset(const Unit&) const { return true; } };
template <class F> __device__ __forceinline__ EpiFn<F> mk_epi(F f) { return EpiFn<F>{f}; }
template <class F> struct EpiSeg { F f; int last; __device__ __forceinline__ void operator()(f32x4 (&acc)[2][2][4][2], const Unit& u, int wr, int wc, int fr, int fq) const { f(acc, u, wr, wc, fr, fq); } __device__ __forceinline__ bool reset(const Unit& u) const { return u.seg == last; } };
template <class F> __device__ __forceinline__ EpiSeg<F> mk_epi_seg(F f, int last) { return EpiSeg<F>{f, last}; }
template <int NSEG> struct SegSched { GroupSched base; __device__ __forceinline__ bool next(int j, Unit& u) const { if (!base.next(j / NSEG, u)) return false; u.seg = j % NSEG; return true; } };
#ifndef DUP_PH
#define DUP_PH -1
#endif
#define REP_BEGIN(k) _Pragma("unroll 1") for (int rep_ = 0; rep_ < ((DUP_PH == (k)) ? 2 : 1); ++rep_) { if (rep_) { if constexpr (PH < 0) xcd_barrier(bar); }
#define REP_END }
#ifndef USE_FAST
#define USE_FAST 1
#endif
#if USE_FAST
#define GEMM(S, AD, E, K, lda, ldb) gemm_fast<false, false>(F.lds, F.tid, S, AD, mk_epi(E), nullptr)
#define GEMM_P(S, AD, E) gemm_fast<false, true>(F.lds, F.tid, S, AD, mk_epi(E), nullptr)
#define GEMM_GATHER(S, AD, E, K, lda, ldb, rows) gemm_fast<true, true>(F.lds, F.tid, S, AD, mk_epi(E), rows)
#else
#define GEMM(S, AD, E, K, lda, ldb) gemm_simple(S, AD, E, K)
#endif
#define EPI_ARGS f32x4 (&acc)[2][2][4][2], const Unit& u, int wr, int wc, int fr, int fq
#define EPI_FOR(...) _Pragma("unroll") for (int ai = 0; ai < 2; ++ai) _Pragma("unroll") for (int m = 0; m < 4; ++m) { const int r = ai * 128 + wr * 64 + m * 16 + fr; \
    _Pragma("unroll") for (int bj = 0; bj < 2; ++bj) _Pragma("unroll") for (int n = 0; n < 2; ++n) { const int c = bj * 128 + wc * 32 + n * 16 + 4 * fq; const f32x4 v = acc[ai][bj][m][n]; __VA_ARGS__ } }
#define EPI_FOR8(...) _Pragma("unroll") for (int ai = 0; ai < 2; ++ai) _Pragma("unroll") for (int m = 0; m < 4; ++m) { const int r = ai * 128 + wr * 64 + m * 16 + fr; \
    _Pragma("unroll") for (int bj = 0; bj < 2; ++bj) { const int c = bj * 128 + wc * 32 + 8 * fq; const f32x4 v0 = acc[ai][bj][m][0], v1 = acc[ai][bj][m][1]; __VA_ARGS__ } }
__device__ __forceinline__ void st_bf8(bf16* p, f32x4 a, f32x4 b) { u32x4 w; w.x = pk2(a[0], a[1]); w.y = pk2(a[2], a[3]); w.z = pk2(b[0], b[1]); w.w = pk2(b[2], b[3]); *(u32x4*)p = w; }
__device__ __forceinline__ void st_bf4(bf16* p, f32x4 v) { u32x2 w; w.x = pk2(v[0], v[1]); w.y = pk2(v[2], v[3]); *(u32x2*)p = w; }

__device__ __forceinline__ void p_mod(const Params& P, Frame& F) {
    LAS float* sc = (LAS float*)F.lds;
    LAS float* red = (LAS float*)(F.lds + 9 * 1024 * 4);
    float* MOD = WSP(float, WS_MOD);
    bool have = false;
    for (int it = F.bid; it < 2 * 96; it += F.G) {
        if (!have) {
            for (int i = F.tid; i < 9 * 1024; i += NTHREADS) { const int r = i >> 10, k = i & 1023; const float v = r < 8 ? P.c[r * 1024 + k] : P.c_ctx[k]; sc[i] = v * sigmoidf_(v); }
            have = true;
        }
        __syncthreads();
        const int l = it / 96, j0 = (it % 96) * 64, jj = F.tid & 63, kc = F.tid >> 6;
        const float* W = P.ada_w + (size_t)l * 1024 * 6144 + j0 + jj;
        float a[9];
#pragma unroll
        for (int r = 0; r < 9; ++r) a[r] = 0.f;
#pragma unroll 8
        for (int k = kc * 128; k < kc * 128 + 128; ++k) { const float w = W[(size_t)k * 6144];
#pragma unroll
            for (int r = 0; r < 9; ++r) a[r] += sc[r * 1024 + k] * w; }
#pragma unroll
        for (int r = 0; r < 9; ++r) red[(kc * 9 + r) * 64 + jj] = a[r];
        __syncthreads();
        for (int o = F.tid; o < 9 * 64; o += NTHREADS) { const int r = o >> 6, j = o & 63; float s = 0.f;
#pragma unroll
            for (int q = 0; q < 8; ++q) s += red[(q * 9 + r) * 64 + j];
            MOD[((size_t)l * 9 + r) * 6144 + j0 + j] = s + P.ada_b[l * 6144 + j0 + j]; }
    }
    __syncthreads();
}
__device__ __forceinline__ void p_dftgen(Frame& F) {
    LAS float* tab = (LAS float*)F.lds;
    for (int j = F.tid; j < 4096; j += NTHREADS) tab[j] = cospif((float)j * (1.0f / 2048.0f));
    __syncthreads();
    bf16* DC_ = WSP(bf16, WS_DFTC); bf16* M1 = WSP(bf16, WS_M1T); bf16* M2 = WSP(bf16, WS_M2T);
    const int nchunk = 256 * 64 + 256 * 32 + 256 * 64;
    for (int ch = F.bid * NTHREADS + F.tid; ch < nchunk; ch += F.G * NTHREADS) {
        float v[8]; bf16* dst;
        if (ch < 256 * 64) { const int kf = ch >> 6, col0 = (ch & 63) * 8, cs = col0 >> 8, l0 = col0 & 255;
#pragma unroll
            for (int i = 0; i < 8; ++i) { const int j = ((kf * (l0 + i)) & 255) * 16; v[i] = cs ? -tab[(j + 3072) & 4095] : tab[j]; }
            dst = DC_ + (size_t)kf * 512 + col0; }
        else if (ch < 256 * 64 + 256 * 32) { const int c2 = ch - 256 * 64, row = c2 >> 5, col0 = (c2 & 31) * 8, ri = row >> 7, h = (row >> 6) & 1, k1 = row & 63, h2 = col0 >> 7, cs = (col0 >> 6) & 1, l10 = col0 & 63;
#pragma unroll
            for (int i = 0; i < 8; ++i) { const int j = ((k1 * (l10 + i)) & 63) * 64; const float c = tab[j], sn = tab[(j + 3072) & 4095];
                v[i] = (h != h2) ? 0.f : (ri == 0 ? (cs == 0 ? c : -sn) : (cs == 0 ? sn : c)); }
            dst = M1 + (size_t)row * 256 + col0; }
        else { const int c2 = ch - 256 * 64 - 256 * 32, row = c2 >> 6, col0 = (c2 & 63) * 8, q = row >> 6, k2 = row & 63, q2 = col0 >> 7, ri = (col0 >> 6) & 1, l20 = col0 & 63;
#pragma unroll
            for (int i = 0; i < 8; ++i) { const int j = ((k2 * (l20 + i)) & 63) * 64; const float c = tab[j], sn = tab[(j + 3072) & 4095];
                v[i] = (q != q2) ? 0.f : (ri == 0 ? c : -sn); }
            dst = M2 + (size_t)row * 512 + col0; }
        u32x4 o; o.x = pk2(v[0], v[1]); o.y = pk2(v[2], v[3]); o.z = pk2(v[4], v[5]); o.w = pk2(v[6], v[7]);
        *(u32x4*)dst = o;
    }
    __syncthreads();
}
__device__ __forceinline__ void transpose_item(const float* W, int ldw, int k0, int n0, bf16* WT, int ldt, int drow0, LAS float* scr, int lane) {
    f32x4 ld[8];
#pragma unroll
    for (int i = 0; i < 8; ++i) ld[i] = *(const f32x4*)(W + (size_t)(k0 + 8 * i + (lane >> 3)) * ldw + n0 + 4 * (lane & 7));
#pragma unroll
    for (int i = 0; i < 8; ++i) { LAS float* d = scr + (8 * i + (lane >> 3)) * 33 + 4 * (lane & 7); d[0] = ld[i][0]; d[1] = ld[i][1]; d[2] = ld[i][2]; d[3] = ld[i][3]; }
    LDS_WAIT(); asm volatile("" ::: "memory");
    const int c = lane & 7;
#pragma unroll
    for (int j = 0; j < 4; ++j) { const int n = (lane >> 3) + 8 * j; const LAS float* s = scr + (8 * c) * 33 + n;
        u32x4 o; o.x = pk2(s[0 * 33], s[1 * 33]); o.y = pk2(s[2 * 33], s[3 * 33]); o.z = pk2(s[4 * 33], s[5 * 33]); o.w = pk2(s[6 * 33], s[7 * 33]);
        *(u32x4*)(WT + (size_t)(drow0 + n) * ldt + k0 + 8 * c) = o; }
    LDS_WAIT(); asm volatile("" ::: "memory");
}
__device__ __forceinline__ void p_wconv(const Params& P, Frame& F, int l) {
    LAS float* scr = (LAS float*)(F.lds + F.wave * 16384);
    const int gw = F.bid * NWAVES + F.wave, NGW = F.G * NWAVES;
    const float* w_in = P.w_in + (size_t)l * 1024 * INW;
    bf16* WA = WSP(bf16, WS_WA); bf16* WFV = WSP(bf16, WS_WFV);
    constexpr int I_K = 16 * 32, I_Q = 16 * 32, I_P = 16 * 16, I_G = 16 * 96, I_V = 16 * 32, I_AO = 16 * 32, I_FO = 8 * 32, I_OUT = 16 * 32;
    constexpr int NSM = I_K + I_Q + I_P + I_G + I_V + I_AO + I_FO + I_OUT;
    for (int it = gw; it < NSM; it += NGW) {
        int r = it;
        if (r < I_K) { transpose_item(w_in, INW, (r / 32) * 64, 0 + (r % 32) * 32, WA, 1024, 0 + (r % 32) * 32, scr, F.lane); continue; } r -= I_K;
        if (r < I_Q) { transpose_item(w_in, INW, (r / 32) * 64, 2048 + (r % 32) * 32, WA, 1024, 1024 + (r % 32) * 32, scr, F.lane); continue; } r -= I_Q;
        if (r < I_P) { transpose_item(w_in, INW, (r / 16) * 64, 3584 + (r % 16) * 32, WA, 1024, 2048 + (r % 16) * 32, scr, F.lane); continue; } r -= I_P;
        if (r < I_G) { transpose_item(w_in, INW, (r / 96) * 64, 4096 + (r % 96) * 32, WA, 1024, 2560 + (r % 96) * 32, scr, F.lane); continue; } r -= I_G;
        if (r < I_V) { transpose_item(w_in, INW, (r / 32) * 64, 1024 + (r % 32) * 32, WFV, 1024, 1024 + (r % 32) * 32, scr, F.lane); continue; } r -= I_V;
        if (r < I_AO) { transpose_item(P.w_att_o + (size_t)l * 1024 * 1024, 1024, (r / 32) * 64, (r % 32) * 32, WSP(bf16, WS_WAO), 1024, (r % 32) * 32, scr, F.lane); continue; } r -= I_AO;
        if (r < I_FO) { transpose_item(P.w_fourier + (size_t)l * 512 * 1024, 1024, (r / 32) * 64, (r % 32) * 32, WSP(bf16, WS_WFO), 512, (r % 32) * 32, scr, F.lane); continue; } r -= I_FO;
        transpose_item(P.w_out + (size_t)l * 1024 * 1024, 1024, (r / 32) * 64, (r % 32) * 32, WSP(bf16, WS_WOUT), 1024, (r % 32) * 32, scr, F.lane);
    }
    constexpr int I_E = 16 * 88;
    bf16* WGU = WSP(bf16, WS_WGU); bf16* WD = WSP(bf16, WS_WD);
    for (int it = gw; it < 3 * 16 * I_E; it += NGW) {
        const int which = it / (16 * I_E), r0 = it % (16 * I_E), e = r0 / I_E, r = r0 % I_E;
        if (which < 2) { const int kb = r / 88, nb = r % 88, n0 = nb * 32;
            const float* src = (which == 0 ? P.w_eg : P.w_eu) + ((size_t)l * 16 + e) * 1024 * FF;
            transpose_item(src, FF, kb * 64, n0, WGU + (size_t)e * 5632 * 1024, 1024, (n0 >> 7) * 256 + (which ? 128 : 0) + (n0 & 127), scr, F.lane); }
        else { const int kb = r / 32, nb = r % 32;
            transpose_item(P.w_ed + ((size_t)l * 16 + e) * FF * 1024, 1024, kb * 64, nb * 32, WD + (size_t)e * 1024 * FF, FF, nb * 32, scr, F.lane); }
    }
    { bf16* WPO = WSP(bf16, WS_WPO); const float* wp = P.w_pool + (size_t)l * 4 * 128 * 256;
      for (int i = F.bid * NTHREADS + F.tid; i < 1024 * 256; i += F.G * NTHREADS) { const int n = i >> 8, kk = i & 255, g = n >> 8, f = n & 255;
          WPO[i] = (bf16)(((kk >> 7) == (g & 1)) ? f2bf(wp[((size_t)g * 128 + (kk & 127)) * 256 + f]) : 0u); } }
    { LAS float* t128 = (LAS float*)F.lds;
      __syncthreads();
      for (int j = F.tid; j < 128; j += NTHREADS) t128[j] = cospif((float)j * (1.0f / 64.0f));
      __syncthreads();
      for (int i = F.bid * NTHREADS + F.tid; i < 1024 * 1024; i += F.G * NTHREADS) { const int fc = i >> 10, k = i & 1023, cs = fc & 1, gm = fc >> 1, g = gm >> 7, m = gm & 127;
          const float* src = w_in + (size_t)k * INW + 3072 + g * 128; float s = 0.f; const int ph = cs ? 96 : 0;
          for (int c = 0; c < 128; ++c) s += src[c] * t128[(m * c + ph) & 127];
          WFV[i] = (bf16)f2bf(s); }
      __syncthreads(); }
}

struct RowMod { const float* g; const float* sh; const float* sc; };
__device__ __forceinline__ void row_load(const float* row, int lane, f32x4 (&v)[4]) {
#pragma unroll
    for (int j = 0; j < 4; ++j) v[j] = *(const f32x4*)(row + 4 * lane + 256 * j);
}
__device__ __forceinline__ float row_rstd(const f32x4 (&v)[4]) {
    float s = 0.f;
#pragma unroll
    for (int j = 0; j < 4; ++j) s += (v[j][0] * v[j][0] + v[j][1] * v[j][1]) + (v[j][2] * v[j][2] + v[j][3] * v[j][3]);
    return rsqrtf(wave_sum(s) * (1.0f / 1024.0f) + RMS_EPS);
}
__device__ __forceinline__ void row_modulate(const f32x4 (&v)[4], float rstd, const RowMod& M, int lane, f32x4 (&y)[4]) {
#pragma unroll
    for (int j = 0; j < 4; ++j) { const int k = 4 * lane + 256 * j; const f32x4 g = *(const f32x4*)(M.g + k), sh = *(const f32x4*)(M.sh + k), sc = *(const f32x4*)(M.sc + k);
        y[j] = v[j] * rstd * g * (sc + 1.0f) + sh; }
}
__device__ __forceinline__ void row_store_bf(bf16* row, int lane, const f32x4 (&y)[4]) {
#pragma unroll
    for (int j = 0; j < 4; ++j) st_bf4(row + 4 * lane + 256 * j, y[j]);
}
__device__ __forceinline__ const float* mod_ptr(Frame& F, int l, int row, int which) { const int mr = row < RL ? (row >> 12) : 8; return WSP(float, WS_MOD) + ((size_t)l * 9 + mr) * 6144 + which * 1024; }

__device__ __forceinline__ void p_rowpass_a0(const Params& P, Frame& F) {
    const int gw = F.bid * NWAVES + F.wave, NGW = F.G * NWAVES; bf16* H = WSP(bf16, WS_H);
    for (int row = gw; row < RT; row += NGW) {
        const float* src = row < RL ? P.x + (size_t)row * DM : P.ctx + (size_t)(row - RL) * DM;
        f32x4 v[4], y[4]; row_load(src, F.lane, v); const float rs = row_rstd(v);
        RowMod M{P.norm1_g, mod_ptr(F, 0, row, 0), mod_ptr(F, 0, row, 1)};
        row_modulate(v, rs, M, F.lane, y); row_store_bf(H + (size_t)row * DM, F.lane, y);
    }
}
__device__ __forceinline__ void p_rowpass_f(const Params& P, Frame& F, int l, int nrows) {
    const int gw = F.bid * NWAVES + F.wave, NGW = F.G * NWAVES; bf16* H = WSP(bf16, WS_H); float* AFF = WSP(float, WS_AFF);
    const float* wr = P.w_router + (size_t)l * 1024 * 16;
    LAS float* wl = (LAS float*)F.lds;
    __syncthreads();
    for (int i = F.tid; i < 16384; i += NTHREADS) wl[(i & 15) * 1024 + (i >> 4)] = wr[i];
    __syncthreads();
    for (int row = gw; row < nrows; row += NGW) {
        const float* src = row < RL ? P.out + (size_t)row * DM : WSP(float, WS_XC) + (size_t)(row - RL) * DM;
        f32x4 v[4], y[4]; row_load(src, F.lane, v); const float rs = row_rstd(v);
        RowMod M{P.norm2_g + l * 1024, mod_ptr(F, l, row, 3), mod_ptr(F, l, row, 4)};
        row_modulate(v, rs, M, F.lane, y); row_store_bf(H + (size_t)row * DM, F.lane, y);
        float lg[16];
        int wo = 4 * F.lane; asm volatile("" : "+v"(wo));
#pragma unroll
        for (int e = 0; e < 16; ++e) { float a = 0.f;
#pragma unroll
            for (int j = 0; j < 4; ++j) { const f32x4 w = *(const LAS f32x4*)(wl + e * 1024 + wo + 256 * j); a += (y[j][0] * w[0] + y[j][1] * w[1]) + (y[j][2] * w[2] + y[j][3] * w[3]); }
            lg[e] = a; }
        float mx = -1e30f;
#pragma unroll
        for (int e = 0; e < 16; ++e) { lg[e] = wave_sum(lg[e]); mx = fmaxf(mx, lg[e]); }
        float den = 0.f;
#pragma unroll
        for (int e = 0; e < 16; ++e) { lg[e] = __expf(lg[e] - mx); den += lg[e]; }
        const float inv = 1.0f / den;
        if (F.lane < 16) { float mine = 0.f;
#pragma unroll
            for (int e = 0; e < 16; ++e) mine = (F.lane == e) ? lg[e] : mine;
            AFF[(size_t)row * 16 + F.lane] = mine * inv; }
    }
    __syncthreads();
}
__device__ __forceinline__ void p_rowpass_k(const Params& P, Frame& F, int l, int nrows) {
    const int gw = F.bid * NWAVES + F.wave, NGW = F.G * NWAVES; bf16* H = WSP(bf16, WS_H);
    const int* SEL = WSP(int, WS_SEL); const bf16* Y = WSP(bf16, WS_Y);
    for (int row = gw; row < nrows; row += NGW) {
        float* xr = row < RL ? P.out + (size_t)row * DM : WSP(float, WS_XC) + (size_t)(row - RL) * DM;
        f32x4 v[4], a[4]; row_load(xr, F.lane, v);
#pragma unroll
        for (int j = 0; j < 4; ++j) a[j] = (f32x4){0.f, 0.f, 0.f, 0.f};
        for (int e = 0; e < 16; ++e) { const int s = SEL[(size_t)row * 16 + e];
            if (s >= 0) { const bf16* yr = Y + (size_t)s * DM;
#pragma unroll
                for (int j = 0; j < 4; ++j) { const u32x2 w = *(const u32x2*)(yr + 4 * F.lane + 256 * j); a[j][0] += bflo(w.x); a[j][1] += bfhi(w.x); a[j][2] += bflo(w.y); a[j][3] += bfhi(w.y); } } }
        const float* g2 = mod_ptr(F, l, row, 5);
#pragma unroll
        for (int j = 0; j < 4; ++j) { const f32x4 g = *(const f32x4*)(g2 + 4 * F.lane + 256 * j); v[j] = v[j] + g * a[j]; }
        const float rs = row_rstd(v);
        if (l == 0) {
#pragma unroll
            for (int j = 0; j < 4; ++j) *(f32x4*)(xr + 4 * F.lane + 256 * j) = v[j];
            f32x4 y[4]; RowMod M{P.norm1_g + 1024, mod_ptr(F, 1, row, 0), mod_ptr(F, 1, row, 1)};
            row_modulate(v, rs, M, F.lane, y); row_store_bf(H + (size_t)row * DM, F.lane, y);
        } else {
#pragma unroll
            for (int j = 0; j < 4; ++j) { const f32x4 g = *(const f32x4*)(P.final_g + 4 * F.lane + 256 * j); *(f32x4*)(xr + 4 * F.lane + 256 * j) = v[j] * rs * g; }
        }
    }
}

__device__ __forceinline__ float dot64(const bf16x8 (&q)[8], const bf16* kp) {
    float s = 0.f;
#pragma unroll
    for (int i = 0; i < 8; ++i) { const u32x4 kw = *(const u32x4*)(kp + 8 * i); const u32x4 qw = __builtin_bit_cast(u32x4, q[i]);
#pragma unroll
        for (int t = 0; t < 4; ++t) s += bflo(kw[t]) * bflo(qw[t]) + bfhi(kw[t]) * bfhi(qw[t]); }
    return s;
}
__device__ __forceinline__ void p_attn_naive(const Params& P, Frame& F, int l, bool with_ctx_queries) {
    const int gw = F.bid * NWAVES + F.wave, NGW = F.G * NWAVES;
    const bf16* KQ = WSP(bf16, WS_KQ); const bf16* VT = WSP(bf16, WS_VT); bf16* ATT = WSP(bf16, WS_ATT);
    LAS float* pw = (LAS float*)(F.lds + F.wave * 2048);
    const float* rpb = P.rpb + (size_t)l * 16 * 15 * 31;
    const int nlat = NB * 64 * NH * 64, nitems = nlat + (with_ctx_queries ? NB * NH * CTXL : 0);
    for (int it = gw; it < nitems; it += NGW) {
        const bool lat = it < nlat;
        int b, h, r = 0, qc = 0, rowq;
        if (lat) { qc = it & 63; h = (it >> 6) & 15; r = (it >> 10) & 63; b = it >> 16; rowq = b * SEQ + r * 64 + qc; }
        else { const int i2 = it - nlat; qc = i2 & 255; h = (i2 >> 8) & 15; b = i2 >> 12; rowq = RL + b * CTXL + qc; }
        bf16x8 q[8];
        { const bf16* qp = KQ + (size_t)rowq * 2048 + 1024 + h * 64;
#pragma unroll
          for (int i = 0; i < 8; ++i) q[i] = *(const bf16x8*)(qp + 8 * i); }
        const int rs = min(max(r - 4, 0), 56), cs = min(max(qc - 8, 0), 48);
        float s[6];
        if (lat) {
#pragma unroll
            for (int t = 0; t < 2; ++t) { const int w = F.lane + 64 * t, i = w >> 4, j = w & 15; const int tok = (rs + i) * 64 + cs + j;
                s[t] = dot64(q, KQ + (size_t)(b * SEQ + tok) * 2048 + h * 64) * 0.125f + rpb[(h * 15 + (rs + i - r + 7)) * 31 + (cs + j - qc + 15)]; }
        } else { s[0] = -1e30f; s[1] = -1e30f; }
#pragma unroll
        for (int t = 0; t < 4; ++t) { const int c = F.lane + 64 * t; s[2 + t] = dot64(q, KQ + (size_t)(RL + b * CTXL + c) * 2048 + h * 64) * 0.125f; }
        float mx = s[0];
#pragma unroll
        for (int t = 1; t < 6; ++t) mx = fmaxf(mx, s[t]);
        mx = wave_max(mx);
        float sum = 0.f;
#pragma unroll
        for (int t = 0; t < 6; ++t) { s[t] = (lat || t >= 2) ? __expf(s[t] - mx) : 0.f; sum += s[t]; }
        sum = wave_sum(sum);
        pw[F.lane] = s[0]; pw[F.lane + 64] = s[1];
#pragma unroll
        for (int t = 0; t < 4; ++t) pw[128 + F.lane + 64 * t] = s[2 + t];
        LDS_WAIT(); asm volatile("" ::: "memory");
        float o = 0.f;
        if (lat) { const bf16* vr = VT + ((size_t)b * 1024 + h * 64 + F.lane) * 4096;
#pragma unroll 2
            for (int w = 0; w < 128; ++w) { const int tok = (rs + (w >> 4)) * 64 + cs + (w & 15); o += pw[w] * bf2f(vr[tok]); } }
        { const bf16* vr = VT + YT_CTX_OFF + ((size_t)b * 1024 + h * 64 + F.lane) * 256;
#pragma unroll 2
          for (int c8 = 0; c8 < 32; ++c8) { const u32x4 vw = *(const u32x4*)(vr + 8 * c8); const LAS float* pp = pw + 128 + 8 * c8;
#pragma unroll
              for (int t = 0; t < 4; ++t) o += pp[2 * t] * bflo(vw[t]) + pp[2 * t + 1] * bfhi(vw[t]); } }
        ATT[(size_t)rowq * 1024 + h * 64 + F.lane] = (bf16)f2bf(o / sum);
        LDS_WAIT(); asm volatile("" ::: "memory");
    }
}

constexpr int ACK_STRIDE = 72, ACV_STRIDE = 264;
constexpr int ALDS_CK = 0, ALDS_CV = 256 * ACK_STRIDE * 2, ALDS_RP = ALDS_CV + 64 * ACV_STRIDE * 2;
struct AttnState { float m, sum; f32x4 o[4]; };
__device__ __forceinline__ float xrow16_max(float x) {
    auto s = __builtin_amdgcn_permlane16_swap(__float_as_uint(x), __float_as_uint(x), false, false);
    x = fmaxf(__uint_as_float(s[0]), __uint_as_float(s[1]));
    auto t = __builtin_amdgcn_permlane32_swap(__float_as_uint(x), __float_as_uint(x), false, false);
    return fmaxf(__uint_as_float(t[0]), __uint_as_float(t[1]));
}
__device__ __forceinline__ float xrow16_sum(float x) {
    auto s = __builtin_amdgcn_permlane16_swap(__float_as_uint(x), __float_as_uint(x), false, false);
    x = __uint_as_float(s[0]) + __uint_as_float(s[1]);
    auto t = __builtin_amdgcn_permlane32_swap(__float_as_uint(x), __float_as_uint(x), false, false);
    return __uint_as_float(t[0]) + __uint_as_float(t[1]);
}
#define MFMA16(a, b, c) __builtin_amdgcn_mfma_f32_16x16x32_bf16((a), (b), (c), 0, 0, 0)
template <int NT>
__device__ __forceinline__ void attn_tail(AttnState& S, f32x4 (&sc)[NT], const u32x4 (&vw)[NT / 2][4]) {
    float cm = -1e30f;
#pragma unroll
    for (int t = 0; t < NT; ++t)
#pragma unroll
        for (int j = 0; j < 4; ++j) cm = fmaxf(cm, sc[t][j]);
    cm = xrow16_max(cm);
    const float mn = fmaxf(S.m, cm), scl = __builtin_amdgcn_exp2f(S.m - mn); S.m = mn; float ps = 0.f;
#pragma unroll
    for (int t = 0; t < NT; ++t)
#pragma unroll
        for (int j = 0; j < 4; ++j) { const float p = __builtin_amdgcn_exp2f(sc[t][j] - mn); sc[t][j] = p; ps += p; }
    S.sum = S.sum * scl + ps;
#pragma unroll
    for (int dt = 0; dt < 4; ++dt) S.o[dt] = S.o[dt] * scl;
#pragma unroll
    for (int ks = 0; ks < NT / 2; ++ks) { u32x4 pw; pw.x = pk2(sc[2 * ks][0], sc[2 * ks][1]); pw.y = pk2(sc[2 * ks][2], sc[2 * ks][3]); pw.z = pk2(sc[2 * ks + 1][0], sc[2 * ks + 1][1]); pw.w = pk2(sc[2 * ks + 1][2], sc[2 * ks + 1][3]);
        const bf16x8 pf = __builtin_bit_cast(bf16x8, pw);
#pragma unroll
        for (int dt = 0; dt < 4; ++dt) S.o[dt] = MFMA16(__builtin_bit_cast(bf16x8, vw[ks][dt]), pf, S.o[dt]); }
}
__device__ __forceinline__ void attn_unit2(const bf16* __restrict__ KQ, const bf16* __restrict__ VT, bf16* __restrict__ ATT, LAS unsigned char* lds,
                                           const int b, const int h, const int rowqA, const int rowqB, const bool win, const int r, const int qt, const int lane) {
    const int l15 = lane & 15, g = lane >> 4;
    const f32x4 z = {0.f, 0.f, 0.f, 0.f};
    bf16x8 qA[2], qB[2];
    { const bf16* qp = KQ + (size_t)(rowqA + l15) * 2048 + 1024 + h * 64 + 8 * g; qA[0] = *(const bf16x8*)qp; qA[1] = *(const bf16x8*)(qp + 32); }
    { const bf16* qp = KQ + (size_t)(rowqB + l15) * 2048 + 1024 + h * 64 + 8 * g; qB[0] = *(const bf16x8*)qp; qB[1] = *(const bf16x8*)(qp + 32); }
    AttnState SA, SB; SA.m = -1e30f; SA.sum = 0.f; SB.m = -1e30f; SB.sum = 0.f;
#pragma unroll
    for (int dt = 0; dt < 4; ++dt) { SA.o[dt] = z; SB.o[dt] = z; }
    if (win) {
        const int rsA = min(max(r - 4, 0), 56), dB = min(max(r - 3, 0), 56) - rsA, kc0 = min(max(16 * qt - 8, 0), 32);
        const int q = 16 * qt + l15, csq = min(max(q - 8, 0), 48);
        const int krow0 = 8 * (l15 >> 2) + (l15 & 3);
        const bf16* kb = KQ + (size_t)(b * SEQ + kc0 + krow0) * 2048 + h * 64 + 8 * g;
        const bf16* vb = VT + (size_t)(b * 1024 + h * 64 + l15) * 4096 + kc0 + 8 * g;
        const LAS float* rp = (const LAS float*)(lds + ALDS_RP);
        const int jb = kc0 + 8 * g;
        const int okb = jb - csq;
        const LAS float* rpl = rp + 16 + (jb - q + 15);
        float madd[2][4];
#pragma unroll
        for (int t = 0; t < 2; ++t)
#pragma unroll
            for (int j = 0; j < 4; ++j) madd[t][j] = ((unsigned)(okb + 4 * t + j) < 16u) ? 0.f : -__builtin_inff();
        bf16x8 K0[2][2], K1[2][2]; u32x4 V0[1][4], V1[1][4];
#define ATT_LOADW(KB, VB, i) do { const int gr_ = min(rsA + (i), 63); const bf16* kp_ = kb + (size_t)(gr_ * 64) * 2048; const bf16* vp_ = vb + gr_ * 64; \
        _Pragma("unroll") for (int t = 0; t < 2; ++t) { KB[t][0] = *(const bf16x8*)(kp_ + (size_t)(4 * t) * 2048); KB[t][1] = *(const bf16x8*)(kp_ + (size_t)(4 * t) * 2048 + 32); } \
        _Pragma("unroll") for (int dt = 0; dt < 4; ++dt) VB[0][dt] = *(const u32x4*)(vp_ + (size_t)(16 * dt) * 4096); } while (0)
#define ATT_ONE(ST, QF, KB, VB, roff, rowok) do { f32x4 sc[2]; \
        _Pragma("unroll") for (int t = 0; t < 2; ++t) { sc[t] = MFMA16(KB[t][0], QF[0], z); sc[t] = MFMA16(KB[t][1], QF[1], sc[t]); } \
        const LAS float* bp_ = rpl + ((rowok) ? (roff) : 15) * 64; \
        _Pragma("unroll") for (int t = 0; t < 2; ++t) _Pragma("unroll") for (int j = 0; j < 4; ++j) sc[t][j] = (sc[t][j] + bp_[4 * t + j]) + madd[t][j]; \
        attn_tail<2>(ST, sc, VB); } while (0)
#define ATT_COMPUTE(KB, VB, i) do { const int roffA_ = min(rsA + (i) - r + 7, 14); \
        ATT_ONE(SA, qA, KB, VB, roffA_, (i) <= 7); \
        ATT_ONE(SB, qB, KB, VB, max(roffA_ - 1, 0), (i) >= dB && (i) <= 7 + dB); } while (0)
        ATT_LOADW(K0, V0, 0);
#pragma unroll 1
        for (int i = 0; i < 8; i += 2) { ATT_LOADW(K1, V1, i + 1); ATT_COMPUTE(K0, V0, i); ATT_LOADW(K0, V0, i + 2); ATT_COMPUTE(K1, V1, i + 1); }
        ATT_COMPUTE(K0, V0, 8);
#undef ATT_LOADW
#undef ATT_ONE
#undef ATT_COMPUTE
    }
    { const LAS bf16* ck = (const LAS bf16*)(lds + ALDS_CK) + l15 * ACK_STRIDE + 8 * g;
      const LAS bf16* cv = (const LAS bf16*)(lds + ALDS_CV) + l15 * ACV_STRIDE + 8 * g;
#pragma unroll 1
      for (int c = 0; c < 4; ++c) {
          bf16x8 kf[4][2]; u32x4 vw[2][4];
#pragma unroll
          for (int t = 0; t < 4; ++t) { const LAS bf16* kp = ck + (64 * c + 16 * t) * ACK_STRIDE; kf[t][0] = *(const LAS bf16x8*)kp; kf[t][1] = *(const LAS bf16x8*)(kp + 32); }
#pragma unroll
          for (int ks = 0; ks < 2; ++ks)
#pragma unroll
              for (int dt = 0; dt < 4; ++dt) vw[ks][dt] = *(const LAS u32x4*)(cv + (16 * dt) * ACV_STRIDE + 64 * c + 32 * ks);
          { f32x4 sc[4];
#pragma unroll
            for (int t = 0; t < 4; ++t) { sc[t] = MFMA16(kf[t][0], qA[0], z); sc[t] = MFMA16(kf[t][1], qA[1], sc[t]); }
            attn_tail<4>(SA, sc, vw); }
          { f32x4 sc[4];
#pragma unroll
            for (int t = 0; t < 4; ++t) { sc[t] = MFMA16(kf[t][0], qB[0], z); sc[t] = MFMA16(kf[t][1], qB[1], sc[t]); }
            attn_tail<4>(SB, sc, vw); }
      } }
    { const float inv = 1.0f / xrow16_sum(SA.sum);
#pragma unroll
      for (int dt = 0; dt < 4; ++dt) st_bf4(ATT + (size_t)(rowqA + l15) * 1024 + h * 64 + 16 * dt + 4 * g, SA.o[dt] * inv); }
    { const float inv = 1.0f / xrow16_sum(SB.sum);
#pragma unroll
      for (int dt = 0; dt < 4; ++dt) st_bf4(ATT + (size_t)(rowqB + l15) * 1024 + h * 64 + 16 * dt + 4 * g, SB.o[dt] * inv); }
}
__device__ __forceinline__ void p_attn_mfma(const Params& P, Frame& F, int l, bool with_ctx_queries) {
    const bf16* KQ = WSP(bf16, WS_KQ); const bf16* VT = WSP(bf16, WS_VT); bf16* ATT = WSP(bf16, WS_ATT);
    const float* rpb = P.rpb + (size_t)l * 16 * 465;
    for (int hp = F.bid; hp < 256; hp += F.G) {
        const int p = hp & 127, half = hp >> 7, b = p >> 4, h = p & 15;
        __syncthreads();
        { LAS bf16* ck = (LAS bf16*)(F.lds + ALDS_CK); LAS bf16* cv = (LAS bf16*)(F.lds + ALDS_CV); LAS float* rp = (LAS float*)(F.lds + ALDS_RP);
          { const int key = F.tid >> 1, hf = F.tid & 1; const int k32 = key & 31, pos = (key & ~31) + ((k32 >> 2) & 1) * 16 + 4 * (k32 >> 3) + (k32 & 3);
            const u32x4* src = (const u32x4*)(KQ + (size_t)(RL + b * CTXL + key) * 2048 + h * 64 + hf * 32); LAS u32x4* dst = (LAS u32x4*)(ck + pos * ACK_STRIDE + hf * 32);
#pragma unroll
            for (int i = 0; i < 4; ++i) dst[i] = src[i]; }
          { const int d = F.tid >> 3, sg = F.tid & 7; const u32x4* src = (const u32x4*)(VT + YT_CTX_OFF + (size_t)(b * 1024 + h * 64 + d) * 256 + sg * 32); LAS u32x4* dst = (LAS u32x4*)(cv + d * ACV_STRIDE + sg * 32);
#pragma unroll
            for (int i = 0; i < 4; ++i) dst[i] = src[i]; }
          for (int i = F.tid; i < 16 * 64; i += NTHREADS) { const int rr = i >> 6, cc = (i & 63) - 16; rp[i] = rr == 15 ? -__builtin_inff() : ((cc >= 0 && cc < 31) ? rpb[h * 465 + rr * 31 + cc] * LOG2E : 0.f); } }
        __syncthreads();
        const int qt = F.wave & 3, rpi = F.wave >> 2;
#pragma unroll 1
        for (int st = 0; st < 8; ++st) { const int r = half * 32 + st * 4 + rpi * 2; const int rowqA = b * SEQ + r * 64 + 16 * qt;
            attn_unit2(KQ, VT, ATT, F.lds, b, h, rowqA, rowqA + 64, true, r, qt, F.lane); }
        if (with_ctx_queries && half == 0) { const int rowqA = RL + b * CTXL + 32 * F.wave; attn_unit2(KQ, VT, ATT, F.lds, b, h, rowqA, rowqA + 16, false, 0, 0, F.lane); }
    }
    __syncthreads();
}

__device__ __forceinline__ void ld8(const bf16* p, float (&x)[8]) { const u32x4 w = *(const u32x4*)p;
#pragma unroll
    for (int q = 0; q < 4; ++q) { x[2 * q] = bflo(w[q]); x[2 * q + 1] = bfhi(w[q]); } }
__device__ __forceinline__ void p_pool(Frame& F, int nrows) {
    const bf16* PB = WSP(bf16, WS_PB); bf16* POOL = WSP(bf16, WS_POOL);
    for (int i = F.bid * NTHREADS + F.tid; i < (nrows >> 4) * 64; i += F.G * NTHREADS) {
        const int row0 = (i >> 6) << 4, ch = i & 63, g = ch >> 4, hw = 1 << g;
        int base, t0, Lb; if (row0 < RL) { base = row0 & ~4095; t0 = row0 & 4095; Lb = SEQ; } else { const int rr = row0 - RL; base = RL + (rr & ~255); t0 = rr & 255; Lb = CTXL; }
        const bf16* src = PB + (size_t)base * 512 + ch * 8;
        float S[8];
#pragma unroll
        for (int q = 0; q < 8; ++q) S[q] = 0.f;
#pragma unroll 4
        for (int d = -8; d < 8; ++d) { const int tt = t0 + d; if (d >= -hw && d < hw && tt >= 0 && tt < Lb) { float x[8]; ld8(src + (size_t)tt * 512, x);
#pragma unroll
                for (int q = 0; q < 8; ++q) S[q] += x[q]; } }
#pragma unroll 2
        for (int j = 0; j < 16; ++j) { const int t = t0 + j; const int lo = max(t - hw, 0), hi = min(t + hw, Lb); const float inv = 1.0f / (float)(hi - lo);
            float me[8]; ld8(src + (size_t)t * 512, me);
            u32x4 o;
#pragma unroll
            for (int q = 0; q < 4; ++q) o[q] = pk2(S[2 * q] * inv - me[2 * q], S[2 * q + 1] * inv - me[2 * q + 1]);
            *(u32x4*)(POOL + (size_t)(base + t) * 512 + ch * 8) = o;
            if (t + hw < Lb) { float x[8]; ld8(src + (size_t)(t + hw) * 512, x);
#pragma unroll
                for (int q = 0; q < 8; ++q) S[q] += x[q]; }
            if (t - hw >= 0) { float x[8]; ld8(src + (size_t)(t - hw) * 512, x);
#pragma unroll
                for (int q = 0; q < 8; ++q) S[q] -= x[q]; } }
    }
}

__device__ __forceinline__ int block_sum_i(int v, LAS int* sm, int tid) {
    v = wave_sum_i(v);
    __syncthreads();
    if ((tid & 63) == 0) sm[tid >> 6] = v;
    __syncthreads();
    int s = 0;
#pragma unroll
    for (int i = 0; i < 8; ++i) s += sm[i];
    return s;
}
__device__ __forceinline__ int block_excl_scan(int v, LAS int* sm, int tid, int& total) {
    const int lane = tid & 63, w = tid >> 6; int inc = v;
#pragma unroll
    for (int o = 1; o < 64; o <<= 1) { const int t = __builtin_amdgcn_ds_bpermute(((lane - o) & 63) << 2, inc); if (lane >= o) inc += t; }
    __syncthreads();
    if (lane == 63) sm[w] = inc;
    __syncthreads();
    int base = 0; total = 0;
#pragma unroll
    for (int i = 0; i < 8; ++i) { const int s = sm[i]; if (i < w) base += s; total += s; }
    return base + inc - v;
}
template <int NPT>
__device__ __forceinline__ void topk_pair(Frame& F, int row0, int n, int cap, int e, int slot0) {
    LAS int* sm = (LAS int*)F.lds;
    const float* AFF = WSP(float, WS_AFF); int* SROW = WSP(int, WS_SROW); float* SG = WSP(float, WS_SGATE); int* SEL = WSP(int, WS_SEL);
    unsigned key[NPT];
#pragma unroll
    for (int j = 0; j < NPT; ++j) { const int i = F.tid * NPT + j; key[j] = (i < n) ? __float_as_uint(AFF[(size_t)(row0 + i) * 16 + e]) : 0u; }
    unsigned T = 0u;
    for (int bit = 30; bit >= 0; --bit) { const unsigned cand = T | (1u << bit); int cnt = 0;
#pragma unroll
        for (int j = 0; j < NPT; ++j) cnt += (key[j] >= cand) ? 1 : 0;
        cnt = block_sum_i(cnt, sm, F.tid);
        if (cnt >= cap) T = cand; }
    int ngt = 0, neq = 0;
#pragma unroll
    for (int j = 0; j < NPT; ++j) { ngt += (key[j] > T) ? 1 : 0; neq += (key[j] == T) ? 1 : 0; }
    int tot_gt, tot_eq;
    (void)block_excl_scan(ngt, sm, F.tid, tot_gt);
    int eqr = block_excl_scan(neq, sm, F.tid, tot_eq);
    const int need_eq = cap - tot_gt;
    int nsel = 0; bool selj[NPT];
#pragma unroll
    for (int j = 0; j < NPT; ++j) { bool s = key[j] > T; if (key[j] == T && T != 0u) { s = eqr < need_eq; ++eqr; } selj[j] = s; nsel += s ? 1 : 0; }
    int tot_sel; int pos = block_excl_scan(nsel, sm, F.tid, tot_sel);
#pragma unroll
    for (int j = 0; j < NPT; ++j) { const int i = F.tid * NPT + j;
        if (i < n) { const int row = row0 + i;
            if (selj[j]) { const int slot = slot0 + pos; ++pos; SROW[slot] = row; SG[slot] = __uint_as_float(key[j]); SEL[(size_t)row * 16 + e] = slot; }
            else SEL[(size_t)row * 16 + e] = -1; } }
    __syncthreads();
}
__device__ __forceinline__ void p_topk(Frame& F, bool with_ctx) {
    const int npairs = 128 + (with_ctx ? 128 : 0);
    for (int pi = F.bid; pi < npairs; pi += F.G) {
        if (pi < 128) { const int b = pi >> 4, e = pi & 15; topk_pair<8>(F, b * SEQ, SEQ, CAPL, e, e * SLOT_E + b * CAPL); }
        else { const int p2 = pi - 128, b = p2 >> 4, e = p2 & 15; topk_pair<1>(F, RL + b * CTXL, CTXL, CAPC, e, e * SLOT_E + 4096 + b * CAPC); }
    }
}
__device__ __forceinline__ void p_gather(Frame& F, bool with_ctx) {
    const int gw = F.bid * NWAVES + F.wave, NGW = F.G * NWAVES; const bf16* H = WSP(bf16, WS_H); bf16* XG = WSP(bf16, WS_XG); const int* SROW = WSP(int, WS_SROW);
    for (int s = gw; s < NSLOT; s += NGW) { if (!with_ctx && (s % SLOT_E) >= 4096) continue;
        const int row = SROW[s]; const u32x4* src = (const u32x4*)(H + (size_t)row * DM); u32x4* dst = (u32x4*)(XG + (size_t)s * DM);
        dst[F.lane] = src[F.lane]; dst[F.lane + 64] = src[F.lane + 64]; }
}

template <int PH> __global__ void __launch_bounds__(NTHREADS, 2) fwd_kernel(Params P) {
    extern __shared__ __attribute__((aligned(16))) unsigned char lds_raw[];
    Frame F; F.lds = (LAS unsigned char*)lds_raw; F.tid = threadIdx.x; F.lane = F.tid & 63; F.wave = __builtin_amdgcn_readfirstlane(F.tid >> 6); F.G = gridDim.x; F.bid = blockIdx.x; F.ws = P.ws;
    const int wave0 = __builtin_amdgcn_readfirstlane((int)threadIdx.x >> 6);
    volatile LAS unsigned* MISC = (volatile LAS unsigned*)(F.lds + LDS_MISC);
    if (F.tid < 64) MISC[F.tid] = 0u;
    __syncthreads();
    XcdBarrier bar; bar.bar = WSP(unsigned, WS_CTL) + CW_BAR; bar.x = 0; bar.st = MISC + 8;
    if constexpr (PH < 0) bar = xcd_barrier_post(WSP(unsigned, WS_CTL) + CW_BAR, MISC + 8);
#define IN(k) (PH < 0 || PH == (k))
#define REFRESH() do { unsigned on_ = ~0u; asm volatile("" : "+s"(on_)); int t_ = wave0 * 64 + (int)__builtin_amdgcn_mbcnt_hi(on_, __builtin_amdgcn_mbcnt_lo(on_, 0u)); asm volatile("" : "+v"(t_)); F.tid = t_; F.lane = t_ & 63; F.wave = __builtin_amdgcn_readfirstlane(t_ >> 6); } while (0)
#define SEAM(k) do { if constexpr (PH < 0) xcd_barrier(bar); } while (0)

    if (IN(0)) { REP_BEGIN(100) p_mod(P, F); p_dftgen(F); REP_END REP_BEGIN(101) p_wconv(P, F, 0); REP_END }
    SEAM(0);
    if (IN(1)) { p_rowpass_a0(P, F); }
    SEAM(1);
    for (int l = P.l_lo; l < P.l_hi; ++l) {
        constexpr int pb = 2; const bool L0 = (l == 0);
        bf16* H = WSP(bf16, WS_H);
        if (IN(pb + 0)) { REFRESH(); REP_BEGIN(2)
            { GroupSched S; S.init(1, 128, 22, F.G, F.bid, 8, L0 ? 22 : 4, 128, 0);
              const bf16* WA = WSP(bf16, WS_WA);
              auto AD = [=](const Unit& u) { return Operands{H + (size_t)u.pm * 256 * DM, WA + (size_t)u.pn * 256 * DM, DM, DM, 0, DM}; };
              bf16* KQ = WSP(bf16, WS_KQ); bf16* PBp = WSP(bf16, WS_PB); bf16* GB = WSP(bf16, WS_GB);
              auto E = [=](EPI_ARGS) { const int row0 = u.pm * 256;
                  if (u.pn < 8) { const float qs = (u.pn >= 4) ? QSCALE : 1.0f; EPI_FOR8( st_bf8(KQ + (size_t)(row0 + r) * 2048 + u.pn * 256 + c, v0 * qs, v1 * qs); ) }
                  else if (u.pn < 10) { EPI_FOR8( st_bf8(PBp + (size_t)(row0 + r) * 512 + (u.pn - 8) * 256 + c, v0, v1); ) }
                  else { EPI_FOR8( f32x4 s0; f32x4 s1; _Pragma("unroll") for (int j = 0; j < 4; ++j) { s0[j] = sigmoidf_(v0[j]); s1[j] = sigmoidf_(v1[j]); } st_bf8(GB + (size_t)(row0 + r) * 3072 + (u.pn - 10) * 256 + c, s0, s1); ) } };
              GEMM_P(S, AD, E); }
            REFRESH();
            { GroupSched S; const int g1a_units = 128 * 22 + 8 * (L0 ? 22 : 4);
              S.init(1, 8, 128, F.G, (F.bid + F.G - ((g1a_units % F.G) & ~7)) % F.G, L0 ? 8 : 4, 8, L0 ? 0 : 4, 128);
              const bf16* WFV = WSP(bf16, WS_WFV);
              auto AD = [=](const Unit& u) { const bool fmap = (u.pm < 4) && (u.pn < 128); const int t16 = u.pn & 15;
                  const size_t tok0 = fmap ? (size_t)(u.pn >> 4) * SEQ + 64 * ((t16 >> 1) * 8) + (t16 & 1) * 32 : (size_t)u.pn * 256;
                  return Operands{WFV + (size_t)u.pm * 256 * DM, H + tok0 * DM, DM, DM, 0, DM, fmap ? 1 : 0}; };
              bf16* YT = WSP(bf16, WS_YT); bf16* VT = WSP(bf16, WS_VT);
              auto E = [=](EPI_ARGS) { bf16* T = (u.pm < 4) ? YT : VT; const int rr0 = (u.pm & 3) * 256;
                  if (u.pn < 128) { const int b = u.pn >> 4;
                      if (u.pm < 4) { const int t16 = u.pn & 15, l10 = (t16 >> 1) * 8, l20 = (t16 & 1) * 32;
                          EPI_FOR8( const int fc = rr0 + r; st_bf8(T + (((((size_t)b * 512 + (fc >> 1)) * 32 + (c >> 3)) * 2 + (l20 >> 5)) * 2 + (fc & 1)) * 64 + l10, v0, v1); ) }
                      else { const int l0 = (u.pn & 15) * 256; EPI_FOR8( st_bf8(T + ((size_t)b * 1024 + rr0 + r) * 4096 + l0 + c, v0, v1); ) } }
                  else { const int b = u.pn - 128; EPI_FOR8( st_bf8(T + YT_CTX_OFF + ((size_t)b * 1024 + rr0 + r) * 256 + c, v0, v1); ) } };
              GEMM_P(S, AD, E); }
        REP_END }
        SEAM(pb + 0);
        if (IN(pb + 1)) { REFRESH();
            REP_BEGIN(31) p_attn_mfma(P, F, l, L0); REP_END
            REFRESH();
            REP_BEGIN(32)
            { LAS float* tw = (LAS float*)(F.lds + LDS_TW);
              for (int j = F.tid; j < 4096; j += NTHREADS) tw[j] = cospif((float)j * (1.0f / 2048.0f));
              __syncthreads();
              GroupSched S; S.init(1, 1, 512, F.G, F.bid);
              const bf16* M1 = WSP(bf16, WS_M1T); const bf16* YF = WSP(bf16, WS_YT); bf16* ZP = WSP(bf16, WS_ZP);
              auto AD = [=](const Unit& u) { return Operands{M1, YF + (size_t)u.pn * 256 * 256, 256, 256, 0, 256}; };
              auto E = [=](EPI_ARGS) {
                  const int b = u.pn >> 6, gm0 = (u.pn & 63) * 8 + wc, l20 = 32 * wr + 8 * fq;
#pragma unroll
                  for (int m = 0; m < 4; ++m) { const int k1 = 16 * m + fr;
#pragma unroll
                      for (int bj = 0; bj < 2; ++bj) { const int gm = gm0 + 4 * bj;
                          f32x4 zr[2], zi[2];
#pragma unroll
                          for (int n = 0; n < 2; ++n)
#pragma unroll
                              for (int j = 0; j < 4; ++j) { const int ix = k1 * (l20 + 4 * n + j); const float tc = tw[ix], ts = tw[(ix + 3072) & 4095];
                                  const float ur = acc[0][bj][m][n][j], ui = acc[1][bj][m][n][j]; zr[n][j] = ur * tc - ui * ts; zi[n][j] = ur * ts + ui * tc; }
                          bf16* dst = ZP + (((((size_t)b * 64 + k1) * 128 + (gm & 127)) * 4 + (gm >> 7)) * 2) * 64 + l20;
                          st_bf8(dst, zr[0], zr[1]); st_bf8(dst + 64, zi[0], zi[1]); } } };
              GEMM_P(S, AD, E); }
            REP_END
        }
        SEAM(pb + 1);
        if (IN(pb + 10)) { REFRESH();
            { GroupSched S; S.init(1, 1, 256, F.G, F.bid);
              const bf16* M2 = WSP(bf16, WS_M2T); const bf16* ZP = WSP(bf16, WS_ZP); bf16* FOUR = WSP(bf16, WS_FOUR);
              auto AD = [=](const Unit& u) { return Operands{M2, ZP + (size_t)u.pn * 256 * 512, 512, 512, 0, 512}; };
              auto E = [=](EPI_ARGS) { const float sc = 0.0013810679320049757f;
#pragma unroll
                  for (int ai = 0; ai < 2; ++ai)
#pragma unroll
                      for (int m = 0; m < 4; ++m) { const int q = 2 * ai + wr, k2 = 16 * m + fr;
#pragma unroll
                          for (int bj = 0; bj < 2; ++bj) { const int bk = u.pn * 2 + bj, b = bk >> 6, k1 = bk & 63;
                              st_bf8(FOUR + ((size_t)b * SEQ + k1 + 64 * k2) * 512 + q * 128 + wc * 32 + 8 * fq, acc[ai][bj][m][0] * sc, acc[ai][bj][m][1] * sc); } } };
              GEMM_P(S, AD, E); }
            REFRESH();
            if (L0) { GroupSched S; S.init(1, 1, 16, F.G, (F.bid + F.G - 128 % F.G) % F.G);
              const bf16* DFTC = WSP(bf16, WS_DFTC); const bf16* YTC = WSP(bf16, WS_YT) + YT_CTX_OFF; bf16* FOUR = WSP(bf16, WS_FOUR);
              auto AD = [=](const Unit& u) { return Operands{DFTC, YTC + (size_t)u.pn * 256 * 512, 512, 512, 0, 512}; };
              auto E = [=](EPI_ARGS) { const int b = u.pn >> 1, c0 = (u.pn & 1) * 256; const float sc = 0.005524271728019903f;
                  EPI_FOR8( st_bf8(FOUR + ((size_t)RL + b * CTXL + r) * 512 + c0 + c, v0 * sc, v1 * sc); ) };
              GEMM_P(S, AD, E); }
            REFRESH();
            REP_BEGIN(33) p_pool(F, L0 ? RT : RL); REP_END
        }
        SEAM(pb + 10);
        if (IN(pb + 2)) { REFRESH();
            SegSched<3> S; S.base.init(1, L0 ? 136 : 128, 4, F.G, F.bid);
            const bf16* ATT = WSP(bf16, WS_ATT); const bf16* FOUR = WSP(bf16, WS_FOUR); const bf16* POOL = WSP(bf16, WS_POOL);
            const bf16* WAO = WSP(bf16, WS_WAO); const bf16* WFO = WSP(bf16, WS_WFO); const bf16* WPO = WSP(bf16, WS_WPO);
            const bf16* GB = WSP(bf16, WS_GB); bf16* MRGB = WSP(bf16, WS_MRGB); const float* ps = P.pool_scale + l * 1024;
            auto AD = [=](const Unit& u) {
                if (u.seg == 0) return Operands{ATT + (size_t)u.pm * 256 * 1024, WAO + (size_t)u.pn * 256 * 1024, 1024, 1024, 0, 1024};
                if (u.seg == 1) return Operands{FOUR + (size_t)u.pm * 256 * 512, WFO + (size_t)u.pn * 256 * 512, 512, 512, 0, 512};
                return Operands{POOL + (size_t)u.pm * 256 * 512 + (u.pn >> 1) * 256, WPO + (size_t)u.pn * 256 * 256, 512, 256, 0, 256}; };
            auto E = [=](EPI_ARGS) {
                const int kd = u.seg < 2 ? u.seg + 1 : 2; const bool fin = (u.seg == 2); const int colb = u.pn * 256 + wc * 32 + 8 * fq;
#pragma unroll
                for (int ai = 0; ai < 2; ++ai)
#pragma unroll
                    for (int m = 0; m < 4; ++m) { const size_t row = (size_t)u.pm * 256 + ai * 128 + wr * 64 + m * 16 + fr; const bf16* gr = GB + row * 3072 + colb;
                        u32x4 nr[2], dr[2]; f32x4 psv[2][2];
#pragma unroll
                        for (int bj = 0; bj < 2; ++bj) { nr[bj] = *(const u32x4*)(gr + u.seg * 1024 + bj * 128); dr[bj] = *(const u32x4*)(gr + kd * 1024 + bj * 128);
                            psv[bj][0] = *(const f32x4*)(ps + colb + bj * 128); psv[bj][1] = *(const f32x4*)(ps + colb + bj * 128 + 4); }
#pragma unroll
                        for (int bj = 0; bj < 2; ++bj) { f32x4 o[2];
#pragma unroll
                            for (int n = 0; n < 2; ++n) { f32x4 nu = {bflo(nr[bj][2 * n]), bfhi(nr[bj][2 * n]), bflo(nr[bj][2 * n + 1]), bfhi(nr[bj][2 * n + 1])}, de = {bflo(dr[bj][2 * n]), bfhi(dr[bj][2 * n]), bflo(dr[bj][2 * n + 1]), bfhi(dr[bj][2 * n + 1])};
                                if (u.seg == 2) nu = nu * psv[bj][n];
                                de = de * psv[bj][n];
#pragma unroll
                                for (int j = 0; j < 4; ++j) { const float nj = (fabsf(nu[j]) < 1e-30f) ? copysignf(1e-30f, nu[j]) : nu[j]; const float dj = (fabsf(de[j]) < 1e-30f) ? copysignf(1e-30f, de[j]) : de[j];
                                    o[n][j] = acc[ai][bj][m][n][j] * nj * (fin ? 1.0f : __builtin_amdgcn_rcpf(dj)); }
                                acc[ai][bj][m][n] = o[n]; }
                            if (fin) st_bf8(MRGB + row * 1024 + colb + bj * 128, o[0], o[1]); } } };
            gemm_fast<false, true>(F.lds, F.tid, S, AD, mk_epi_seg(E, 2), nullptr);
        }
        SEAM(pb + 2);
        if (IN(pb + 3)) { REFRESH();
            GroupSched S; S.init(1, L0 ? 136 : 128, 4, F.G, F.bid); const bf16* A = WSP(bf16, WS_MRGB); const bf16* W = WSP(bf16, WS_WOUT);
            const float* xin = L0 ? P.x : P.out; const float* cin = L0 ? P.ctx : WSP(float, WS_XC); float* xo = P.out; float* co = WSP(float, WS_XC);
            const float* MOD = WSP(float, WS_MOD) + (size_t)l * 9 * 6144;
            auto AD = [=](const Unit& u) { return Operands{A + (size_t)u.pm * 256 * 1024, W + (size_t)u.pn * 256 * 1024, 1024, 1024, 0, 1024}; };
            auto E = [=](EPI_ARGS) {
                const int row0 = u.pm * 256, mr = row0 < RL ? (row0 >> 12) : 8, colb = u.pn * 256 + wc * 32 + 4 * fq;
                const float* src0 = row0 < RL ? xin + (size_t)row0 * DM : cin + (size_t)(row0 - RL) * DM; float* dst0 = row0 < RL ? xo + (size_t)row0 * DM : co + (size_t)(row0 - RL) * DM;
                f32x4 gv[2][2];
#pragma unroll
                for (int bj = 0; bj < 2; ++bj)
#pragma unroll
                    for (int n = 0; n < 2; ++n) gv[bj][n] = *(const f32x4*)(MOD + (size_t)mr * 6144 + 2048 + colb + bj * 128 + n * 16);
#pragma unroll
                for (int ai = 0; ai < 2; ++ai) { f32x4 xv[4][2][2];
#pragma unroll
                    for (int m = 0; m < 4; ++m) { const size_t ro = (size_t)(ai * 128 + wr * 64 + m * 16 + fr) * DM + colb;
#pragma unroll
                        for (int bj = 0; bj < 2; ++bj)
#pragma unroll
                            for (int n = 0; n < 2; ++n) xv[m][bj][n] = *(const f32x4*)(src0 + ro + bj * 128 + n * 16); }
#pragma unroll
                    for (int m = 0; m < 4; ++m) { const size_t ro = (size_t)(ai * 128 + wr * 64 + m * 16 + fr) * DM + colb;
#pragma unroll
                        for (int bj = 0; bj < 2; ++bj)
#pragma unroll
                            for (int n = 0; n < 2; ++n) *(f32x4*)(dst0 + ro + bj * 128 + n * 16) = xv[m][bj][n] + gv[bj][n] * acc[ai][bj][m][n]; } } };
            GEMM(S, AD, E, 1024, 1024, 1024);
        }
        SEAM(pb + 3);
        if (IN(pb + 4)) { REFRESH(); REP_BEGIN(6) p_rowpass_f(P, F, l, L0 ? RT : RL); REP_END }
        SEAM(pb + 4);
        if (IN(pb + 5)) { REFRESH(); REP_BEGIN(7) p_topk(F, L0); REP_END }
        SEAM(pb + 5);
        if (IN(pb + 7)) { REFRESH(); REP_BEGIN(9)
            GroupSched S; S.init(16, L0 ? 17 : 16, 22, F.G, F.bid); const bf16* W = WSP(bf16, WS_WGU); bf16* HID = WSP(bf16, WS_HID); const int* SROW = WSP(int, WS_SROW);
            auto AD = [=](const Unit& u) { return Operands{H, W + ((size_t)u.grp * 5632 + u.pn * 256) * DM, DM, DM, u.grp * SLOT_E + u.pm * 256, DM}; };
            auto E = [=](EPI_ARGS) {
#pragma unroll
                for (int ai = 0; ai < 2; ++ai)
#pragma unroll
                    for (int m = 0; m < 4; ++m) { const size_t slot = (size_t)u.grp * SLOT_E + u.pm * 256 + ai * 128 + wr * 64 + m * 16 + fr; f32x4 o[2];
#pragma unroll
                        for (int n = 0; n < 2; ++n) { const f32x4 a = acc[ai][0][m][n], up = acc[ai][1][m][n];
#pragma unroll
                            for (int j = 0; j < 4; ++j) o[n][j] = a[j] * sigmoidf_(a[j]) * up[j]; }
                        st_bf8(HID + slot * FF + u.pn * 128 + wc * 32 + 8 * fq, o[0], o[1]); } };
            GEMM_GATHER(S, AD, E, DM, DM, DM, SROW);
        REP_END }
        SEAM(pb + 7);
        if (IN(pb + 8)) { REFRESH(); REP_BEGIN(10)
            const int tpe = L0 ? 17 : 16;
            GroupSched S; S.init(1, 16 * tpe, 4, F.G, F.bid); const bf16* HID = WSP(bf16, WS_HID); const bf16* W = WSP(bf16, WS_WD); bf16* Y = WSP(bf16, WS_Y); const float* SG = WSP(float, WS_SGATE);
            auto AD = [=](const Unit& u) { const int e = u.pm / tpe, st = e * 17 + (u.pm - e * tpe); return Operands{HID + (size_t)st * 256 * FF, W + ((size_t)e * 1024 + u.pn * 256) * FF, FF, FF, 0, FF}; };
            auto E = [=](EPI_ARGS) { const int e = u.pm / tpe; const size_t slot0 = (size_t)(e * 17 + (u.pm - e * tpe)) * 256 + wr * 64 + fr; float gt[2][4];
#pragma unroll
                for (int ai = 0; ai < 2; ++ai)
#pragma unroll
                    for (int m = 0; m < 4; ++m) gt[ai][m] = SG[slot0 + ai * 128 + m * 16];
#pragma unroll
                for (int ai = 0; ai < 2; ++ai)
#pragma unroll
                    for (int m = 0; m < 4; ++m)
#pragma unroll
                        for (int bj = 0; bj < 2; ++bj) st_bf8(Y + (slot0 + ai * 128 + m * 16) * DM + u.pn * 256 + bj * 128 + wc * 32 + 8 * fq, acc[ai][bj][m][0] * gt[ai][m], acc[ai][bj][m][1] * gt[ai][m]); };
            GEMM_P(S, AD, E);
        REP_END }
        SEAM(pb + 8);
        if (IN(pb + 9)) { REFRESH(); p_rowpass_k(P, F, l, L0 ? RT : RL); if (L0) p_wconv(P, F, 1); }
        if (L0) SEAM(pb + 9);
    }
#undef IN
#undef SEAM
}
template <int PH> static void launch_ph(int grid, const Params& p, hipStream_t stream) { hipLaunchKernelGGL(fwd_kernel<PH>, dim3(grid), dim3(NTHREADS), LDS_BYTES, stream, p); }
template <int PH> static bool set_attr() { return hipFuncSetAttribute((const void*)fwd_kernel<PH>, hipFuncAttributeMaxDynamicSharedMemorySize, LDS_BYTES) == hipSuccess; }

#ifndef DUP_LAUNCH
#define DUP_LAUNCH -1
#endif
extern "C" void kernel_launch(void* const* d_in, const int* in_sizes, int n_in, void* d_out, int out_size, void* d_ws, size_t ws_size, hipStream_t stream) {
    static int grid = 0;
    if (grid == 0) {
        if (n_in != 20 || out_size != RL * DM || ws_size < WS_END) { fprintf(stderr, "kernel_launch: unexpected shapes (n_in %d out %d ws %zu need %zu)\n", n_in, out_size, ws_size, (size_t)WS_END); grid = -1; return; }
        int dev = 0, cus = 0, per_cu = 0;
        if (hipGetDevice(&dev) != hipSuccess || hipDeviceGetAttribute(&cus, hipDeviceAttributeMultiprocessorCount, dev) != hipSuccess) { grid = -1; return; }
#if N_LAUNCH_MODE == 1
        if (!set_attr<-1>()) { fprintf(stderr, "kernel_launch: hipFuncSetAttribute failed\n"); grid = -1; return; }
        if (hipOccupancyMaxActiveBlocksPerMultiprocessor(&per_cu, (const void*)fwd_kernel<-1>, NTHREADS, LDS_BYTES) != hipSuccess || per_cu < 1) fprintf(stderr, "kernel_launch: occupancy query reports %d\n", per_cu);
#else
        if (!(set_attr<0>() && set_attr<1>() && set_attr<2>() && set_attr<3>() && set_attr<12>() && set_attr<4>() && set_attr<5>() && set_attr<6>() && set_attr<7>() && set_attr<9>() && set_attr<10>() && set_attr<11>())) { fprintf(stderr, "kernel_launch: hipFuncSetAttribute failed\n"); grid = -1; return; }
        (void)per_cu;
#endif
        (void)hipGetLastError();
        grid = cus;
    }
    if (grid < 0) return;
    if (hipMemsetAsync((char*)d_ws + WS_CTL, 0, CTL_BYTES, stream) != hipSuccess) return;
    Params p{};
    const float** pp = (const float**)&p;
    for (int i = 0; i < 20; ++i) pp[i] = (const float*)d_in[i];
    p.out = (float*)d_out; p.ws = (unsigned char*)d_ws;
#if N_LAUNCH_MODE == 1
    p.l_lo = 0; p.l_hi = 2;
    launch_ph<-1>(grid, p, stream);
#else
    p.l_lo = 0; p.l_hi = 0; launch_ph<0>(grid, p, stream); if (DUP_LAUNCH == 0) launch_ph<0>(grid, p, stream); launch_ph<1>(grid, p, stream); if (DUP_LAUNCH == 1) launch_ph<1>(grid, p, stream);
#define LP(k) do { launch_ph<k>(grid, p, stream); if (DUP_LAUNCH == (k) && l == 0) launch_ph<k>(grid, p, stream); } while (0)
    for (int l = 0; l < 2; ++l) { p.l_lo = l; p.l_hi = l + 1;
        LP(2); LP(3); LP(12); LP(4); LP(5); LP(6); LP(7); LP(9); LP(10); LP(11); }
#endif
}
```

```cpp
#include <hip/hip_runtime.h>
#include <cstdio>
#include <cstdint>

#ifndef N_LAUNCH_MODE
#define N_LAUNCH_MODE 1
#endif

#define GAS __attribute__((address_space(1)))
#define LAS __attribute__((address_space(3)))
typedef unsigned short bf16;
typedef short bf16x8 __attribute__((ext_vector_type(8)));
typedef float f32x4 __attribute__((ext_vector_type(4)));
typedef unsigned u32x4 __attribute__((ext_vector_type(4)));
typedef unsigned u32x2 __attribute__((ext_vector_type(2)));

constexpr int NB = 8, SEQ = 4096, DM = 1024, CTXL = 256, NH = 16, HD = 64, GRIDW = 64;
constexpr int RL = NB * SEQ, RC = NB * CTXL, RT = RL + RC;
constexpr int INW = 7168, NE = 16, FF = 2816, CAPL = 512, CAPC = 32;
constexpr int SLOT_E = 4352, NSLOT = NE * SLOT_E;
constexpr float RMS_EPS = 1e-6f;
constexpr float LOG2E = 1.4426950408889634f, QSCALE = 0.125f * LOG2E;
constexpr int NWAVES = 8, NTHREADS = 512;

constexpr size_t al256(size_t x) { return (x + 255) & ~(size_t)255; }
constexpr size_t WS_CTL = 0, CTL_BYTES = 1u << 20;
constexpr size_t WS_MOD = WS_CTL + CTL_BYTES;
constexpr size_t WS_XC = al256(WS_MOD + (size_t)2 * 9 * 6144 * 4);
constexpr size_t WS_AFF = al256(WS_XC + (size_t)RC * DM * 4);
constexpr size_t WS_SROW = al256(WS_AFF + (size_t)RT * 16 * 4);
constexpr size_t WS_SGATE = al256(WS_SROW + (size_t)NSLOT * 4);
constexpr size_t WS_SEL = al256(WS_SGATE + (size_t)NSLOT * 4);
constexpr size_t WS_DFTM = al256(WS_SEL + (size_t)RT * 16 * 4);
constexpr size_t WS_DFTC = al256(WS_DFTM + (size_t)4096 * 8192 * 2);
constexpr size_t WS_WA = al256(WS_DFTC + (size_t)256 * 512 * 2);
constexpr size_t WS_WFV = al256(WS_WA + (size_t)5632 * 1024 * 2);
constexpr size_t WS_WAO = al256(WS_WFV + (size_t)2048 * 1024 * 2);
constexpr size_t WS_WFO = al256(WS_WAO + (size_t)1024 * 1024 * 2);
constexpr size_t WS_WPO = al256(WS_WFO + (size_t)1024 * 512 * 2);
constexpr size_t WS_WOUT = al256(WS_WPO + (size_t)1024 * 256 * 2);
constexpr size_t WS_WGU = al256(WS_WOUT + (size_t)1024 * 1024 * 2);
constexpr size_t WS_WD = al256(WS_WGU + (size_t)16 * 5632 * 1024 * 2);
constexpr size_t WS_H = al256(WS_WD + (size_t)16 * 1024 * 2816 * 2);
constexpr size_t WS_R = al256(WS_H + (size_t)RT * DM * 2);
constexpr size_t WS_KQ = WS_R;
constexpr size_t WS_MRG = WS_KQ;
constexpr size_t WS_PB = al256(WS_KQ + (size_t)RT * 2048 * 2);
constexpr size_t WS_GB = al256(WS_PB + (size_t)RT * 512 * 2);
constexpr size_t WS_YT = al256(WS_GB + (size_t)RT * 3072 * 2);
constexpr size_t WS_MRGB = WS_YT;
constexpr size_t WS_VT = al256(WS_YT + (size_t)RT * 1024 * 2);
constexpr size_t WS_FOUR = al256(WS_VT + (size_t)RT * 1024 * 2);
constexpr size_t WS_ATT = al256(WS_FOUR + (size_t)RT * 512 * 2);
constexpr size_t WS_POOL = al256(WS_ATT + (size_t)RT * 1024 * 2);
constexpr size_t WS_MIX_END = al256(WS_POOL + (size_t)RT * 512 * 2);
constexpr size_t WS_XG = WS_R;
constexpr size_t WS_HID = al256(WS_XG + (size_t)NSLOT * 1024 * 2);
constexpr size_t WS_Y = al256(WS_HID + (size_t)NSLOT * 2816 * 2);
constexpr size_t WS_MOE_END = al256(WS_Y + (size_t)NSLOT * 1024 * 2);
constexpr size_t WS_END0 = WS_MIX_END > WS_MOE_END ? WS_MIX_END : WS_MOE_END;
constexpr size_t WS_ZP = WS_END0;
constexpr size_t WS_M1T = al256(WS_ZP + ((size_t)8 * 64 * 512 * 128 + 1024) * 2);
constexpr size_t WS_M2T = al256(WS_M1T + (size_t)256 * 256 * 2);
constexpr size_t WS_END = al256(WS_M2T + (size_t)256 * 512 * 2);
constexpr size_t YT_CTX_OFF = (size_t)8 * 1024 * 4096;

constexpr int CW_BAR = 4096;

constexpr int LDS_BYTES = 155648;
constexpr int LDS_TW = 132096;
constexpr int LDS_MISC = 131072;

__device__ __forceinline__ unsigned f2bf(float f) { unsigned u = __float_as_uint(f); return (u + 0x7fffu + ((u >> 16) & 1u)) >> 16; }
typedef __bf16 hbf16x2 __attribute__((ext_vector_type(2)));
typedef float f32x2 __attribute__((ext_vector_type(2)));
__device__ __forceinline__ unsigned pk2(float lo, float hi) { const f32x2 v = {lo, hi}; return __builtin_bit_cast(unsigned, __builtin_convertvector(v, hbf16x2)); }
__device__ __forceinline__ float bf2f(unsigned b) { return __uint_as_float(b << 16); }
__device__ __forceinline__ float bflo(unsigned w) { return __uint_as_float(w << 16); }
__device__ __forceinline__ float bfhi(unsigned w) { return __uint_as_float(w & 0xffff0000u); }
template <int CTRL> __device__ __forceinline__ float dppf(float x) { return __builtin_bit_cast(float, __builtin_amdgcn_mov_dpp(__builtin_bit_cast(int, x), CTRL, 0xf, 0xf, true)); }
template <int CTRL> __device__ __forceinline__ int dppi(int x) { return __builtin_amdgcn_mov_dpp(x, CTRL, 0xf, 0xf, true); }
constexpr int DPP_XOR1 = 0xB1, DPP_XOR2 = 0x4E, DPP_ROR4 = 0x124, DPP_ROR8 = 0x128;
__device__ __forceinline__ float wave_sum(float v) {
    v += dppf<DPP_XOR1>(v); v += dppf<DPP_XOR2>(v); v += dppf<DPP_ROR4>(v); v += dppf<DPP_ROR8>(v);
    auto s = __builtin_amdgcn_permlane16_swap(__float_as_uint(v), __float_as_uint(v), false, false); v = __uint_as_float(s[0]) + __uint_as_float(s[1]);
    auto t = __builtin_amdgcn_permlane32_swap(__float_as_uint(v), __float_as_uint(v), false, false); return __uint_as_float(t[0]) + __uint_as_float(t[1]);
}
__device__ __forceinline__ float wave_max(float v) {
    v = fmaxf(v, dppf<DPP_XOR1>(v)); v = fmaxf(v, dppf<DPP_XOR2>(v)); v = fmaxf(v, dppf<DPP_ROR4>(v)); v = fmaxf(v, dppf<DPP_ROR8>(v));
    auto s = __builtin_amdgcn_permlane16_swap(__float_as_uint(v), __float_as_uint(v), false, false); v = fmaxf(__uint_as_float(s[0]), __uint_as_float(s[1]));
    auto t = __builtin_amdgcn_permlane32_swap(__float_as_uint(v), __float_as_uint(v), false, false); return fmaxf(__uint_as_float(t[0]), __uint_as_float(t[1]));
}
__device__ __forceinline__ int wave_sum_i(int v) {
    v += dppi<DPP_XOR1>(v); v += dppi<DPP_XOR2>(v); v += dppi<DPP_ROR4>(v); v += dppi<DPP_ROR8>(v);
    auto s = __builtin_amdgcn_permlane16_swap((unsigned)v, (unsigned)v, false, false); v = (int)(s[0] + s[1]);
    auto t = __builtin_amdgcn_permlane32_swap((unsigned)v, (unsigned)v, false, false); return (int)(t[0] + t[1]);
}
__device__ __forceinline__ float sigmoidf_(float x) { return __builtin_amdgcn_rcpf(1.f + __builtin_amdgcn_exp2f(x * -1.4426950408889634f)); }
#define LDS_WAIT() asm volatile("s_waitcnt lgkmcnt(0)" ::: "memory")

#define XB_TMO      128
#define XB_XCNT(j)  (256  + 64 * (j))
#define XB_XSUB(j)  (1280 + 64 * (j))
#define XB_XGEN(j)  (2304 + 64 * (j))
#define XB_TOP      3328
#define XB_TOPGEN   3392
#define XCD_BAR_WORDS 3456
#define XB_SPIN_CAP (1u << 22)

__device__ __forceinline__ unsigned xb_ld(unsigned* p)              { return __hip_atomic_load(p, __ATOMIC_RELAXED, __HIP_MEMORY_SCOPE_AGENT); }
__device__ __forceinline__ unsigned xb_add(unsigned* p, unsigned v) { return __hip_atomic_fetch_add(p, v, __ATOMIC_RELAXED, __HIP_MEMORY_SCOPE_AGENT); }
__device__ __forceinline__ unsigned xb_xcc_id() { return (unsigned)__builtin_amdgcn_s_getreg((3 << 11) | 20) & 0xFu; }
#define XB_SPIN(cond, bar) do { unsigned _sp = 0; while (cond) { __builtin_amdgcn_s_sleep(1); \
    if ((++_sp & 255u) == 0u) { if (xb_ld(&(bar)[XB_TMO])) break; if (_sp > XB_SPIN_CAP) { atomicAdd(&(bar)[XB_TMO], 1u); break; } } } } while (0)

struct XcdBarrier { unsigned* bar; unsigned x; volatile LAS unsigned* st; };

__device__ __forceinline__ XcdBarrier xcd_barrier_post(unsigned* bar, volatile LAS unsigned* st) {
    XcdBarrier b; b.bar = bar; b.x = xb_xcc_id(); b.st = st;
    if (threadIdx.x == 0) (void)xb_add(&bar[XB_XCNT(b.x)], 1u);
    return b;
}
__device__ __forceinline__ void xcd_barrier_complete(unsigned* bar, unsigned x, unsigned& nloc, unsigned& nx) {
    const unsigned G = gridDim.x * gridDim.y * gridDim.z;
    unsigned sum, cnt, mine, sp = 0u;
    for (;;) {
        sum = 0u; cnt = 0u; mine = 0u;
#pragma unroll
        for (unsigned j = 0; j < 16; ++j) { const unsigned c = xb_ld(&bar[XB_XCNT(j)]); sum += c; cnt += (c > 0u) ? 1u : 0u; mine = (j == x) ? c : mine; }
        if (sum == G) break;
        __builtin_amdgcn_s_sleep(1);
        if ((++sp & 255u) == 0u) { if (xb_ld(&bar[XB_TMO])) break; if (sp > XB_SPIN_CAP) { atomicAdd(&bar[XB_TMO], 1u); break; } }
    }
    nloc = mine > 0u ? mine : 1u; nx = cnt > 0u ? cnt : 1u;
}
__device__ __forceinline__ void xcd_barrier(const XcdBarrier& b) {
    asm volatile("s_waitcnt vmcnt(0)" ::: "memory");
    __syncthreads();
    if (threadIdx.x == 0) {
        unsigned* bar = b.bar;
        __builtin_amdgcn_s_waitcnt(0);
        unsigned nloc = b.st[0], nx = b.st[1];
        if (nloc == 0u) { xcd_barrier_complete(bar, b.x, nloc, nx); b.st[0] = nloc; b.st[1] = nx; }
        const unsigned old = xb_add(&bar[XB_XSUB(b.x)], 1u);
        const unsigned gen = old / nloc;
        if (old + 1u == (gen + 1u) * nloc) {
            __builtin_amdgcn_fence(__ATOMIC_RELEASE, "agent");
            asm volatile("s_waitcnt vmcnt(0)" ::: "memory");
            const unsigned og = xb_add(&bar[XB_TOP], 1u);
            const unsigned tg = og / nx;
            if (og + 1u == (tg + 1u) * nx) xb_add(&bar[XB_TOPGEN], 1u);
            else XB_SPIN(xb_ld(&bar[XB_TOPGEN]) == tg, bar);
            __builtin_amdgcn_fence(__ATOMIC_ACQUIRE, "agent");
            xb_add(&bar[XB_XGEN(b.x)], 1u);
            asm volatile("s_waitcnt vmcnt(0)" ::: "memory");
        } else {
            XB_SPIN(xb_ld(&bar[XB_XGEN(b.x)]) == gen, bar);
            __builtin_amdgcn_fence(__ATOMIC_ACQUIRE, "agent");
            asm volatile("s_waitcnt vmcnt(0)" ::: "memory");
        }
    }
    __syncthreads();
}

struct Params {
    const float *x, *c, *ctx, *c_ctx, *ada_w, *ada_b, *norm1_g, *norm2_g, *w_in, *rpb, *w_att_o, *w_fourier, *w_pool, *pool_scale, *w_out, *w_router, *w_eg, *w_eu, *w_ed, *final_g;
    float* out; unsigned char* ws; int l_lo, l_hi;
};
struct Frame {
    LAS unsigned char* lds;
    int tid, lane, wave, G, bid;
    unsigned char* ws;
};
#define WSP(T, off) ((T*)(F.ws + (off)))

struct Unit { int grp, pm, pn, seg; };
struct GroupSched {
    int ng, nM, nN, G, c; int tM, tN, tpm0, tpn0;
    __device__ __forceinline__ void init(int ng_, int nM_, int nN_, int G_, int c_, int tM_ = 0, int tN_ = 0, int tpm0_ = 0, int tpn0_ = 0) { ng = ng_; nM = nM_; nN = nN_; G = G_; c = c_; tM = tM_; tN = tN_; tpm0 = tpm0_; tpn0 = tpn0_; }
    __device__ __forceinline__ bool next(int i, Unit& u) const {
        const int per = nM * nN; const int L = i * G + c;
        if (L < ng * per) {
            u.grp = L / per; int wgid = L - u.grp * per;
            { const int q = per / 8, r = per % 8, xcd = wgid % 8, off = wgid / 8; wgid = (xcd < r ? xcd * (q + 1) : r * (q + 1) + (xcd - r) * q) + off; }
            const int nig = 8 * nN, gid = wgid / nig, fm = gid * 8, gsz = (nM - fm) < 8 ? (nM - fm) : 8;
            u.pm = fm + ((wgid % nig) % gsz); u.pn = (wgid % nig) / gsz; u.seg = 0; return true;
        }
        const int w = L - ng * per;
        if (w < tM * tN) { u.grp = ng; u.pm = tpm0 + (w % tM); u.pn = tpn0 + (w / tM); u.seg = 0; return true; }
        return false;
    }
};
struct Operands { const bf16* A; const bf16* Bt; int lda, ldb, slot0, K; int bmap; };

template <class Addr, class Epi>
__device__ __forceinline__ void gemm_simple(const GroupSched& S, const Addr& AD, const Epi& E, int K) {
    const int tid = threadIdx.x, wid = __builtin_amdgcn_readfirstlane(tid >> 6), lane = tid & 63, wr = wid >> 2, wc = wid & 3, fr = lane & 15, fq = lane >> 4;
    Unit u;
    for (int i = 0; S.next(i, u); ++i) {
        const Operands op = AD(u);
        f32x4 acc[2][2][4][2];
#pragma unroll
        for (int a = 0; a < 2; ++a)
#pragma unroll
            for (int b = 0; b < 2; ++b)
#pragma unroll
                for (int m = 0; m < 4; ++m)
#pragma unroll
                    for (int n = 0; n < 2; ++n) acc[a][b][m][n] = (f32x4){0.f, 0.f, 0.f, 0.f};
        const bf16* ap = op.A + (size_t)(wr * 64 + fr) * op.lda + fq * 8;
        const bf16* bp = op.Bt + (size_t)(wc * 32 + fr) * op.ldb + fq * 8;
#pragma unroll 1
        for (int k = 0; k < K; k += 32) {
            bf16x8 bfr[2][2];
#pragma unroll
            for (int b = 0; b < 2; ++b)
#pragma unroll
                for (int n = 0; n < 2; ++n) bfr[b][n] = *(const bf16x8*)(bp + (size_t)(b * 128 + n * 16) * op.ldb + k);
#pragma unroll
            for (int a = 0; a < 2; ++a) {
                bf16x8 af[4];
#pragma unroll
                for (int m = 0; m < 4; ++m) af[m] = *(const bf16x8*)(ap + (size_t)(a * 128 + m * 16) * op.lda + k);
#pragma unroll
                for (int b = 0; b < 2; ++b)
#pragma unroll
                    for (int m = 0; m < 4; ++m)
#pragma unroll
                        for (int n = 0; n < 2; ++n) acc[a][b][m][n] = __builtin_amdgcn_mfma_f32_16x16x32_bf16(bfr[b][n], af[m], acc[a][b][m][n], 0, 0, 0);
            }
        }
        E(acc, u, wr, wc, fr, fq);
    }
}
constexpr int HTB = 128 * 64 * 2;
__device__ __forceinline__ int lds_byte(int r, int c) { const int st = (r >> 4) * 2 + (c >> 5), rr = r & 15, cc = c & 31, ob = rr * 64 + cc * 2; return st * 1024 + (ob ^ (((ob >> 9) & 1) << 5)); }
__device__ __forceinline__ int perm32(int rho) { const int n = rho >> 4, i = rho & 15; return 8 * (i >> 2) + 4 * n + (i & 3); }
__device__ __forceinline__ void stage_rc(int b, int& R, int& C) { const int st = b / 1024, sb = b % 1024, swz = sb ^ (((sb >> 9) & 1) << 5); R = (st >> 1) * 16 + swz / 64; C = (st & 1) * 32 + (swz % 64) / 2; }
template <bool GATHER, bool PERM, class Sched, class Addr, class Epi>
__device__ __forceinline__ void gemm_fast(LAS unsigned char* lds, const int tid, const Sched& S, const Addr& AD, const Epi& E, const int* __restrict__ grows) {
    const int wid = __builtin_amdgcn_readfirstlane(tid >> 6), lane = tid & 63, wr = wid >> 2, wc = wid & 3, fr = lane & 15, fq = lane >> 4;
    int sR[2], sRb[2]; unsigned sC[2];
    unsigned cvg[2][2], nvg[2][2], cvb[2][2], nvb[2][2];
#pragma unroll
    for (int i = 0; i < 2; ++i) { int R, C; stage_rc(tid * 16 + i * 8192, R, C); sR[i] = R; sC[i] = (unsigned)C * 2u; sRb[i] = PERM ? ((R & ~31) + perm32(R & 31)) : R; }
    const size_t kstep = 128;
    const unsigned ldsw = (unsigned)wid * 1024u;
    const int aoff = lds_byte(wr * 64 + fr, fq * 8), boff = lds_byte(wc * 32 + fr, fq * 8);
#define PG8_SA(b, h) (((b) * 2 + (h)) * HTB)
#define PG8_SB(b, h) ((4 + (b) * 2 + (h)) * HTB)
#define PG8_STAGE(bufoff, gbase, voff) do { _Pragma("unroll") for (int _i = 0; _i < 2; ++_i) \
        __builtin_amdgcn_global_load_lds((const unsigned*)((const char*)(gbase) + (voff)[_i]), (LAS unsigned*)(lds + (bufoff) + ldsw + _i * 8192), 16, 0, 0); } while (0)
#define PG8_LDA(dst, b, h) do { _Pragma("unroll") for (int m = 0; m < 4; ++m) _Pragma("unroll") for (int k = 0; k < 2; ++k) dst[m][k] = *(const LAS bf16x8*)(lds + PG8_SA(b, h) + aoff + m * 2048 + k * 1024); } while (0)
#define PG8_LDB(dst, b, h) do { _Pragma("unroll") for (int n = 0; n < 2; ++n) _Pragma("unroll") for (int k = 0; k < 2; ++k) dst[n][k] = *(const LAS bf16x8*)(lds + PG8_SB(b, h) + boff + n * 2048 + k * 1024); } while (0)
#define PG8_MMA(ai, bj, At, Bt) do { __builtin_amdgcn_s_setprio(1); _Pragma("unroll") for (int m = 0; m < 4; ++m) _Pragma("unroll") for (int n = 0; n < 2; ++n) _Pragma("unroll") for (int k = 0; k < 2; ++k) \
        acc[ai][bj][m][n] = __builtin_amdgcn_mfma_f32_16x16x32_bf16(Bt[n][k], At[m][k], acc[ai][bj][m][n], 0, 0, 0); __builtin_amdgcn_s_setprio(0); } while (0)
#define PG8_WAIT_V(n) asm volatile("s_waitcnt vmcnt(" #n ")" ::: "memory")
#define PG8_WAIT_L(n) asm volatile("s_waitcnt lgkmcnt(" #n ")" ::: "memory")
#define PG8_BAR __builtin_amdgcn_s_barrier()
#define PG8_SCHED __builtin_amdgcn_sched_barrier(0)
#define PG8_GIDX(dst, op_) do { _Pragma("unroll") for (int h_ = 0; h_ < 2; ++h_) _Pragma("unroll") for (int i_ = 0; i_ < 2; ++i_) dst[h_][i_] = (unsigned)grows[(op_).slot0 + h_ * 128 + sR[i_]] * (unsigned)((op_).lda * 2) + sC[i_]; } while (0)
#define PG8_AOFF(dst, op_) do { _Pragma("unroll") for (int h_ = 0; h_ < 2; ++h_) _Pragma("unroll") for (int i_ = 0; i_ < 2; ++i_) dst[h_][i_] = (unsigned)((sR[i_] + 128 * h_) * (op_).lda) * 2u + sC[i_]; } while (0)
#define PG8_BOFF(dst, op_) do { _Pragma("unroll") for (int h_ = 0; h_ < 2; ++h_) _Pragma("unroll") for (int i_ = 0; i_ < 2; ++i_) { const int c_ = sRb[i_] + 128 * h_; \
        dst[h_][i_] = (unsigned)(((op_).bmap ? (64 * (c_ & 7) + (c_ >> 3)) : c_) * (op_).ldb) * 2u + sC[i_]; } } while (0)
#define PG8_COPY(dst, src) do { _Pragma("unroll") for (int h_ = 0; h_ < 2; ++h_) _Pragma("unroll") for (int i_ = 0; i_ < 2; ++i_) dst[h_][i_] = src[h_][i_]; } while (0)
    Unit cur, nxt; int ui = 0;
    if (!S.next(0, cur)) return;
    f32x4 acc[2][2][4][2];
#pragma unroll
    for (int a = 0; a < 2; ++a)
#pragma unroll
        for (int b = 0; b < 2; ++b)
#pragma unroll
            for (int m = 0; m < 4; ++m)
#pragma unroll
                for (int n = 0; n < 2; ++n) acc[a][b][m][n] = (f32x4){0.f, 0.f, 0.f, 0.f};
    bf16x8 At[4][2], B0[2][2], B1[2][2];
    const char* cA; const char* cB; int nt;
    { const Operands op = AD(cur); cA = (const char*)op.A; cB = (const char*)op.Bt; nt = op.K / 64; PG8_BOFF(cvb, op);
      Unit u1; const bool h1 = S.next(1, u1); const Operands o1 = h1 ? AD(u1) : op; PG8_BOFF(nvb, o1);
      if constexpr (GATHER) { PG8_GIDX(cvg, op); PG8_GIDX(nvg, o1); PG8_WAIT_V(0); } else { PG8_AOFF(cvg, op); PG8_AOFF(nvg, o1); } }
    PG8_STAGE(PG8_SB(0, 0), cB, cvb[0]); PG8_STAGE(PG8_SB(0, 1), cB, cvb[1]); PG8_STAGE(PG8_SA(0, 0), cA, cvg[0]); PG8_STAGE(PG8_SA(0, 1), cA, cvg[1]);
    if (wr == 1) PG8_BAR;
    PG8_WAIT_V(2); PG8_BAR;
    PG8_STAGE(PG8_SB(1, 0), cB + kstep, cvb[0]); PG8_STAGE(PG8_SA(1, 0), cA + kstep, cvg[0]); PG8_STAGE(PG8_SB(1, 1), cB + kstep, cvb[1]);
    PG8_WAIT_V(6); PG8_BAR;
    for (;;) {
        const bool has_next = S.next(ui + 1, nxt);
        const char* nA = cA; const char* nB = cB; int nnt = nt;
        if (has_next) { const Operands op = AD(nxt); nA = (const char*)op.A; nB = (const char*)op.Bt; nnt = op.K / 64; }
#pragma unroll 1
        for (int t = 0; t < nt; t += 2) {
            const bool last = (t == nt - 2);
            const char* a1 = cA + (size_t)(t + 1) * kstep;
            const char* a2 = last ? nA : cA + (size_t)(t + 2) * kstep; const char* b2 = last ? nB : cB + (size_t)(t + 2) * kstep;
            const char* a3 = a2 + kstep; const char* b3 = b2 + kstep;
            unsigned v2[2][2], w2[2][2];
#pragma unroll
            for (int h_ = 0; h_ < 2; ++h_)
#pragma unroll
                for (int i_ = 0; i_ < 2; ++i_) { v2[h_][i_] = last ? nvg[h_][i_] : cvg[h_][i_]; w2[h_][i_] = last ? nvb[h_][i_] : cvb[h_][i_]; }
            PG8_LDB(B0, 0, 0); PG8_LDB(B1, 0, 1); PG8_SCHED; PG8_LDA(At, 0, 0); PG8_STAGE(PG8_SA(1, 1), a1, cvg[1]);
            PG8_WAIT_V(8); PG8_WAIT_L(0); PG8_BAR; PG8_MMA(0, 0, At, B0); PG8_MMA(0, 1, At, B1); PG8_BAR; PG8_SCHED;
            PG8_LDA(At, 0, 1); PG8_STAGE(PG8_SB(0, 0), b2, w2[0]); PG8_STAGE(PG8_SB(0, 1), b2, w2[1]); PG8_STAGE(PG8_SA(0, 0), a2, v2[0]);
            PG8_WAIT_V(8); PG8_WAIT_L(0); PG8_BAR; PG8_MMA(1, 0, At, B0); PG8_MMA(1, 1, At, B1); PG8_BAR; PG8_SCHED;
            PG8_LDB(B0, 1, 0); PG8_LDB(B1, 1, 1); PG8_SCHED; PG8_LDA(At, 1, 0); PG8_STAGE(PG8_SA(0, 1), a2, v2[1]);
            PG8_WAIT_V(8); PG8_WAIT_L(0); PG8_BAR; PG8_MMA(0, 0, At, B0); PG8_MMA(0, 1, At, B1); PG8_BAR; PG8_SCHED;
            PG8_LDA(At, 1, 1); PG8_STAGE(PG8_SB(1, 0), b3, w2[0]); PG8_STAGE(PG8_SB(1, 1), b3, w2[1]); PG8_STAGE(PG8_SA(1, 0), a3, v2[0]);
            PG8_WAIT_V(8); PG8_WAIT_L(0); PG8_BAR; PG8_MMA(1, 0, At, B0); PG8_MMA(1, 1, At, B1); PG8_BAR; PG8_SCHED;
        }
        if (wr == 0) PG8_BAR;
        unsigned fvg[2][2], fvb[2][2];
        { Unit u2; const bool h2 = S.next(ui + 2, u2);
          if (h2) { const Operands o2 = AD(u2); PG8_BOFF(fvb, o2); if constexpr (GATHER) PG8_GIDX(fvg, o2); else PG8_AOFF(fvg, o2); }
          else { PG8_COPY(fvb, nvb); PG8_COPY(fvg, nvg); } }
        { int fr2 = fr, fq2 = fq; asm volatile("" : "+v"(fr2), "+v"(fq2));
          E(acc, cur, wr, wc, fr2, fq2); }
        if (!has_next) break;
        if constexpr (GATHER) PG8_WAIT_V(0);
        PG8_COPY(cvg, nvg); PG8_COPY(nvg, fvg); PG8_COPY(cvb, nvb); PG8_COPY(nvb, fvb);
        if (E.reset(cur)) {
#pragma unroll
        for (int a = 0; a < 2; ++a)
#pragma unroll
            for (int b = 0; b < 2; ++b)
#pragma unroll
                for (int m = 0; m < 4; ++m)
#pragma unroll
                    for (int n = 0; n < 2; ++n) acc[a][b][m][n] = (f32x4){0.f, 0.f, 0.f, 0.f};
        }
        cur = nxt; cA = nA; cB = nB; nt = nnt; ++ui;
        if (wr == 1) PG8_BAR;
    }
    PG8_WAIT_V(0);
    PG8_BAR;
#undef PG8_SA
#undef PG8_SB
#undef PG8_STAGE
#undef PG8_LDA
#undef PG8_LDB
#undef PG8_MMA
#undef PG8_WAIT_V
#undef PG8_WAIT_L
#undef PG8_BAR
#undef PG8_SCHED
#undef PG8_GIDX
#undef PG8_AOFF
#undef PG8_BOFF
#undef PG8_COPY
}
template <class F> struct EpiFn { F f; __device__ __forceinline__ void operator()(f32x4 (&acc)[2][2][4][2], const Unit& u, int wr, int wc, int fr, int fq) const { f(acc, u, wr, wc, fr, fq); } __device__ __forceinline__ bool reset(const Unit&) const { return true; } };
template <class F> __device__ __forceinline__ EpiFn<F> mk_epi(F f) { return EpiFn<F>{f}; }
template <class F> struct EpiSeg { F f; int last; __device__ __forceinline__ void operator()(f32x4 (&acc)[2][2][4][2], const Unit& u, int wr, int wc, int fr, int fq) const { f(acc, u, wr, wc, fr, fq); } __device__ __forceinline__ bool reset(const Unit& u) const { return u.seg == last; } };
template <class F> __device__ __forceinline__ EpiSeg<F> mk_epi_seg(F f, int last) { return EpiSeg<F>{f, last}; }
template <int NSEG> struct SegSched { GroupSched base; __device__ __forceinline__ bool next(int j, Unit& u) const { if (!base.next(j / NSEG, u)) return false; u.seg = j % NSEG; return true; } };
#ifndef DUP_PH
#define DUP_PH -1
#endif
#define REP_BEGIN(k) _Pragma("unroll 1") for (int rep_ = 0; rep_ < ((DUP_PH == (k)) ? 2 : 1); ++rep_) { if (rep_) { if constexpr (PH < 0) xcd_barrier(bar); }
#define REP_END }
#ifndef USE_FAST
#define USE_FAST 1
#endif
#if USE_FAST
#define GEMM(S, AD, E, K, lda, ldb) gemm_fast<false, false>(F.lds, F.tid, S, AD, mk_epi(E), nullptr)
#define GEMM_P(S, AD, E) gemm_fast<false, true>(F.lds, F.tid, S, AD, mk_epi(E), nullptr)
#define GEMM_GATHER(S, AD, E, K, lda, ldb, rows) gemm_fast<true, true>(F.lds, F.tid, S, AD, mk_epi(E), rows)
#else
#define GEMM(S, AD, E, K, lda, ldb) gemm_simple(S, AD, E, K)
#endif
#define EPI_ARGS f32x4 (&acc)[2][2][4][2], const Unit& u, int wr, int wc, int fr, int fq
#define EPI_FOR(...) _Pragma("unroll") for (int ai = 0; ai < 2; ++ai) _Pragma("unroll") for (int m = 0; m < 4; ++m) { const int r = ai * 128 + wr * 64 + m * 16 + fr; \
    _Pragma("unroll") for (int bj = 0; bj < 2; ++bj) _Pragma("unroll") for (int n = 0; n < 2; ++n) { const int c = bj * 128 + wc * 32 + n * 16 + 4 * fq; const f32x4 v = acc[ai][bj][m][n]; __VA_ARGS__ } }
#define EPI_FOR8(...) _Pragma("unroll") for (int ai = 0; ai < 2; ++ai) _Pragma("unroll") for (int m = 0; m < 4; ++m) { const int r = ai * 128 + wr * 64 + m * 16 + fr; \
    _Pragma("unroll") for (int bj = 0; bj < 2; ++bj) { const int c = bj * 128 + wc * 32 + 8 * fq; const f32x4 v0 = acc[ai][bj][m][0], v1 = acc[ai][bj][m][1]; __VA_ARGS__ } }
__device__ __forceinline__ void st_bf8(bf16* p, f32x4 a, f32x4 b) { u32x4 w; w.x = pk2(a[0], a[1]); w.y = pk2(a[2], a[3]); w.z = pk2(b[0], b[1]); w.w = pk2(b[2], b[3]); *(u32x4*)p = w; }
__device__ __forceinline__ void st_bf4(bf16* p, f32x4 v) { u32x2 w; w.x = pk2(v[0], v[1]); w.y = pk2(v[2], v[3]); *(u32x2*)p = w; }

__device__ __forceinline__ void p_mod(const Params& P, Frame& F) {
    LAS float* sc = (LAS float*)F.lds;
    LAS float* red = (LAS float*)(F.lds + 9 * 1024 * 4);
    float* MOD = WSP(float, WS_MOD);
    bool have = false;
    for (int it = F.bid; it < 2 * 96; it += F.G) {
        if (!have) {
            for (int i = F.tid; i < 9 * 1024; i += NTHREADS) { const int r = i >> 10, k = i & 1023; const float v = r < 8 ? P.c[r * 1024 + k] : P.c_ctx[k]; sc[i] = v * sigmoidf_(v); }
            have = true;
        }
        __syncthreads();
        const int l = it / 96, j0 = (it % 96) * 64, jj = F.tid & 63, kc = F.tid >> 6;
        const float* W = P.ada_w + (size_t)l * 1024 * 6144 + j0 + jj;
        float a[9];
#pragma unroll
        for (int r = 0; r < 9; ++r) a[r] = 0.f;
#pragma unroll 8
        for (int k = kc * 128; k < kc * 128 + 128; ++k) { const float w = W[(size_t)k * 6144];
#pragma unroll
            for (int r = 0; r < 9; ++r) a[r] += sc[r * 1024 + k] * w; }
#pragma unroll
        for (int r = 0; r < 9; ++r) red[(kc * 9 + r) * 64 + jj] = a[r];
        __syncthreads();
        for (int o = F.tid; o < 9 * 64; o += NTHREADS) { const int r = o >> 6, j = o & 63; float s = 0.f;
#pragma unroll
            for (int q = 0; q < 8; ++q) s += red[(q * 9 + r) * 64 + j];
            MOD[((size_t)l * 9 + r) * 6144 + j0 + j] = s + P.ada_b[l * 6144 + j0 + j]; }
    }
    __syncthreads();
}
__device__ __forceinline__ void p_dftgen(Frame& F) {
    LAS float* tab = (LAS float*)F.lds;
    for (int j = F.tid; j < 4096; j += NTHREADS) tab[j] = cospif((float)j * (1.0f / 2048.0f));
    __syncthreads();
    bf16* DC_ = WSP(bf16, WS_DFTC); bf16* M1 = WSP(bf16, WS_M1T); bf16* M2 = WSP(bf16, WS_M2T);
    const int nchunk = 256 * 64 + 256 * 32 + 256 * 64;
    for (int ch = F.bid * NTHREADS + F.tid; ch < nchunk; ch += F.G * NTHREADS) {
        float v[8]; bf16* dst;
        if (ch < 256 * 64) { const int kf = ch >> 6, col0 = (ch & 63) * 8, cs = col0 >> 8, l0 = col0 & 255;
#pragma unroll
            for (int i = 0; i < 8; ++i) { const int j = ((kf * (l0 + i)) & 255) * 16; v[i] = cs ? -tab[(j + 3072) & 4095] : tab[j]; }
            dst = DC_ + (size_t)kf * 512 + col0; }
        else if (ch < 256 * 64 + 256 * 32) { const int c2 = ch - 256 * 64, row = c2 >> 5, col0 = (c2 & 31) * 8, ri = row >> 7, h = (row >> 6) & 1, k1 = row & 63, h2 = col0 >> 7, cs = (col0 >> 6) & 1, l10 = col0 & 63;
#pragma unroll
            for (int i = 0; i < 8; ++i) { const int j = ((k1 * (l10 + i)) & 63) * 64; const float c = tab[j], sn = tab[(j + 3072) & 4095];
                v[i] = (h != h2) ? 0.f : (ri == 0 ? (cs == 0 ? c : -sn) : (cs == 0 ? sn : c)); }
            dst = M1 + (size_t)row * 256 + col0; }
        else { const int c2 = ch - 256 * 64 - 256 * 32, row = c2 >> 6, col0 = (c2 & 63) * 8, q = row >> 6, k2 = row & 63, q2 = col0 >> 7, ri = (col0 >> 6) & 1, l20 = col0 & 63;
#pragma unroll
            for (int i = 0; i < 8; ++i) { const int j = ((k2 * (l20 + i)) & 63) * 64; const float c = tab[j], sn = tab[(j + 3072) & 4095];
                v[i] = (q != q2) ? 0.f : (ri == 0 ? c : -sn); }
            dst = M2 + (size_t)row * 512 + col0; }
        u32x4 o; o.x = pk2(v[0], v[1]); o.y = pk2(v[2], v[3]); o.z = pk2(v[4], v[5]); o.w = pk2(v[6], v[7]);
        *(u32x4*)dst = o;
    }
    __syncthreads();
}
__device__ __forceinline__ void transpose_item(const float* W, int ldw, int k0, int n0, bf16* WT, int ldt, int drow0, LAS float* scr, int lane) {
    f32x4 ld[8];
#pragma unroll
    for (int i = 0; i < 8; ++i) ld[i] = *(const f32x4*)(W + (size_t)(k0 + 8 * i + (lane >> 3)) * ldw + n0 + 4 * (lane & 7));
#pragma unroll
    for (int i = 0; i < 8; ++i) { LAS float* d = scr + (8 * i + (lane >> 3)) * 33 + 4 * (lane & 7); d[0] = ld[i][0]; d[1] = ld[i][1]; d[2] = ld[i][2]; d[3] = ld[i][3]; }
    LDS_WAIT(); asm volatile("" ::: "memory");
    const int c = lane & 7;
#pragma unroll
    for (int j = 0; j < 4; ++j) { const int n = (lane >> 3) + 8 * j; const LAS float* s = scr + (8 * c) * 33 + n;
        u32x4 o; o.x = pk2(s[0 * 33], s[1 * 33]); o.y = pk2(s[2 * 33], s[3 * 33]); o.z = pk2(s[4 * 33], s[5 * 33]); o.w = pk2(s[6 * 33], s[7 * 33]);
        *(u32x4*)(WT + (size_t)(drow0 + n) * ldt + k0 + 8 * c) = o; }
    LDS_WAIT(); asm volatile("" ::: "memory");
}
__device__ __forceinline__ void p_wconv(const Params& P, Frame& F, int l) {
    LAS float* scr = (LAS float*)(F.lds + F.wave * 16384);
    const int gw = F.bid * NWAVES + F.wave, NGW = F.G * NWAVES;
    const float* w_in = P.w_in + (size_t)l * 1024 * INW;
    bf16* WA = WSP(bf16, WS_WA); bf16* WFV = WSP(bf16, WS_WFV);
    constexpr int I_K = 16 * 32, I_Q = 16 * 32, I_P = 16 * 16, I_G = 16 * 96, I_V = 16 * 32, I_AO = 16 * 32, I_FO = 8 * 32, I_OUT = 16 * 32;
    constexpr int NSM = I_K + I_Q + I_P + I_G + I_V + I_AO + I_FO + I_OUT;
    for (int it = gw; it < NSM; it += NGW) {
        int r = it;
        if (r < I_K) { transpose_item(w_in, INW, (r / 32) * 64, 0 + (r % 32) * 32, WA, 1024, 0 + (r % 32) * 32, scr, F.lane); continue; } r -= I_K;
        if (r < I_Q) { transpose_item(w_in, INW, (r / 32) * 64, 2048 + (r % 32) * 32, WA, 1024, 1024 + (r % 32) * 32, scr, F.lane); continue; } r -= I_Q;
        if (r < I_P) { transpose_item(w_in, INW, (r / 16) * 64, 3584 + (r % 16) * 32, WA, 1024, 2048 + (r % 16) * 32, scr, F.lane); continue; } r -= I_P;
        if (r < I_G) { transpose_item(w_in, INW, (r / 96) * 64, 4096 + (r % 96) * 32, WA, 1024, 2560 + (r % 96) * 32, scr, F.lane); continue; } r -= I_G;
        if (r < I_V) { transpose_item(w_in, INW, (r / 32) * 64, 1024 + (r % 32) * 32, WFV, 1024, 1024 + (r % 32) * 32, scr, F.lane); continue; } r -= I_V;
        if (r < I_AO) { transpose_item(P.w_att_o + (size_t)l * 1024 * 1024, 1024, (r / 32) * 64, (r % 32) * 32, WSP(bf16, WS_WAO), 1024, (r % 32) * 32, scr, F.lane); continue; } r -= I_AO;
        if (r < I_FO) { transpose_item(P.w_fourier + (size_t)l * 512 * 1024, 1024, (r / 32) * 64, (r % 32) * 32, WSP(bf16, WS_WFO), 512, (r % 32) * 32, scr, F.lane); continue; } r -= I_FO;
        transpose_item(P.w_out + (size_t)l * 1024 * 1024, 1024, (r / 32) * 64, (r % 32) * 32, WSP(bf16, WS_WOUT), 1024, (r % 32) * 32, scr, F.lane);
    }
    constexpr int I_E = 16 * 88;
    bf16* WGU = WSP(bf16, WS_WGU); bf16* WD = WSP(bf16, WS_WD);
    for (int it = gw; it < 3 * 16 * I_E; it += NGW) {
        const int which = it / (16 * I_E), r0 = it % (16 * I_E), e = r0 / I_E, r = r0 % I_E;
        if (which < 2) { const int kb = r / 88, nb = r % 88, n0 = nb * 32;
            const float* src = (which == 0 ? P.w_eg : P.w_eu) + ((size_t)l * 16 + e) * 1024 * FF;
            transpose_item(src, FF, kb * 64, n0, WGU + (size_t)e * 5632 * 1024, 1024, (n0 >> 7) * 256 + (which ? 128 : 0) + (n0 & 127), scr, F.lane); }
        else { const int kb = r / 32, nb = r % 32;
            transpose_item(P.w_ed + ((size_t)l * 16 + e) * FF * 1024, 1024, kb * 64, nb * 32, WD + (size_t)e * 1024 * FF, FF, nb * 32, scr, F.lane); }
    }
    { bf16* WPO = WSP(bf16, WS_WPO); const float* wp = P.w_pool + (size_t)l * 4 * 128 * 256;
      for (int i = F.bid * NTHREADS + F.tid; i < 1024 * 256; i += F.G * NTHREADS) { const int n = i >> 8, kk = i & 255, g = n >> 8, f = n & 255;
          WPO[i] = (bf16)(((kk >> 7) == (g & 1)) ? f2bf(wp[((size_t)g * 128 + (kk & 127)) * 256 + f]) : 0u); } }
    { LAS float* t128 = (LAS float*)F.lds;
      __syncthreads();
      for (int j = F.tid; j < 128; j += NTHREADS) t128[j] = cospif((float)j * (1.0f / 64.0f));
      __syncthreads();
      for (int i = F.bid * NTHREADS + F.tid; i < 1024 * 1024; i += F.G * NTHREADS) { const int fc = i >> 10, k = i & 1023, cs = fc & 1, gm = fc >> 1, g = gm >> 7, m = gm & 127;
          const float* src = w_in + (size_t)k * INW + 3072 + g * 128; float s = 0.f; const int ph = cs ? 96 : 0;
          for (int c = 0; c < 128; ++c) s += src[c] * t128[(m * c + ph) & 127];
          WFV[i] = (bf16)f2bf(s); }
      __syncthreads(); }
}

struct RowMod { const float* g; const float* sh; const float* sc; };
__device__ __forceinline__ void row_load(const float* row, int lane, f32x4 (&v)[4]) {
#pragma unroll
    for (int j = 0; j < 4; ++j) v[j] = *(const f32x4*)(row + 4 * lane + 256 * j);
}
__device__ __forceinline__ float row_rstd(const f32x4 (&v)[4]) {
    float s = 0.f;
#pragma unroll
    for (int j = 0; j < 4; ++j) s += (v[j][0] * v[j][0] + v[j][1] * v[j][1]) + (v[j][2] * v[j][2] + v[j][3] * v[j][3]);
    return rsqrtf(wave_sum(s) * (1.0f / 1024.0f) + RMS_EPS);
}
__device__ __forceinline__ void row_modulate(const f32x4 (&v)[4], float rstd, const RowMod& M, int lane, f32x4 (&y)[4]) {
#pragma unroll
    for (int j = 0; j < 4; ++j) { const int k = 4 * lane + 256 * j; const f32x4 g = *(const f32x4*)(M.g + k), sh = *(const f32x4*)(M.sh + k), sc = *(const f32x4*)(M.sc + k);
        y[j] = v[j] * rstd * g * (sc + 1.0f) + sh; }
}
__device__ __forceinline__ void row_store_bf(bf16* row, int lane, const f32x4 (&y)[4]) {
#pragma unroll
    for (int j = 0; j < 4; ++j) st_bf4(row + 4 * lane + 256 * j, y[j]);
}
__device__ __forceinline__ const float* mod_ptr(Frame& F, int l, int row, int which) { const int mr = row < RL ? (row >> 12) : 8; return WSP(float, WS_MOD) + ((size_t)l * 9 + mr) * 6144 + which * 1024; }

__device__ __forceinline__ void p_rowpass_a0(const Params& P, Frame& F) {
    const int gw = F.bid * NWAVES + F.wave, NGW = F.G * NWAVES; bf16* H = WSP(bf16, WS_H);
    f32x4 vn[4]; int row = gw;
    if (row < RT) row_load(row < RL ? P.x + (size_t)row * DM : P.ctx + (size_t)(row - RL) * DM, F.lane, vn);
    for (; row < RT; row += NGW) {
        f32x4 v[4], y[4];
#pragma unroll
        for (int j = 0; j < 4; ++j) v[j] = vn[j];
        { const int nr = row + NGW; if (nr < RT) row_load(nr < RL ? P.x + (size_t)nr * DM : P.ctx + (size_t)(nr - RL) * DM, F.lane, vn); }
        const float rs = row_rstd(v);
        RowMod M{P.norm1_g, mod_ptr(F, 0, row, 0), mod_ptr(F, 0, row, 1)};
        row_modulate(v, rs, M, F.lane, y); row_store_bf(H + (size_t)row * DM, F.lane, y);
    }
}
__device__ __forceinline__ void p_rowpass_f(const Params& P, Frame& F, int l, int nrows) {
    const int gw = F.bid * NWAVES + F.wave, NGW = F.G * NWAVES; bf16* H = WSP(bf16, WS_H); float* AFF = WSP(float, WS_AFF);
    const float* wr = P.w_router + (size_t)l * 1024 * 16;
    LAS float* wl = (LAS float*)F.lds;
    __syncthreads();
    for (int i = F.tid; i < 16384; i += NTHREADS) wl[(i & 15) * 1024 + (i >> 4)] = wr[i];
    __syncthreads();
    f32x4 vn[4]; int row = gw;
    if (row < nrows) row_load(row < RL ? P.out + (size_t)row * DM : WSP(float, WS_XC) + (size_t)(row - RL) * DM, F.lane, vn);
    for (; row < nrows; row += NGW) {
        f32x4 v[4], y[4];
#pragma unroll
        for (int j = 0; j < 4; ++j) v[j] = vn[j];
        { const int nr = row + NGW; if (nr < nrows) row_load(nr < RL ? P.out + (size_t)nr * DM : WSP(float, WS_XC) + (size_t)(nr - RL) * DM, F.lane, vn); }
        const float rs = row_rstd(v);
        RowMod M{P.norm2_g + l * 1024, mod_ptr(F, l, row, 3), mod_ptr(F, l, row, 4)};
        row_modulate(v, rs, M, F.lane, y); row_store_bf(H + (size_t)row * DM, F.lane, y);
        float lg[16];
        int wo = 4 * F.lane; asm volatile("" : "+v"(wo));
#pragma unroll
        for (int e = 0; e < 16; ++e) { float a = 0.f;
#pragma unroll
            for (int j = 0; j < 4; ++j) { const f32x4 w = *(const LAS f32x4*)(wl + e * 1024 + wo + 256 * j); a += (y[j][0] * w[0] + y[j][1] * w[1]) + (y[j][2] * w[2] + y[j][3] * w[3]); }
            lg[e] = a; }
        float mx = -1e30f;
#pragma unroll
        for (int e = 0; e < 16; ++e) { lg[e] = wave_sum(lg[e]); mx = fmaxf(mx, lg[e]); }
        float den = 0.f;
#pragma unroll
        for (int e = 0; e < 16; ++e) { lg[e] = __expf(lg[e] - mx); den += lg[e]; }
        const float inv = 1.0f / den;
        if (F.lane < 16) { float mine = 0.f;
#pragma unroll
            for (int e = 0; e < 16; ++e) mine = (F.lane == e) ? lg[e] : mine;
            AFF[(size_t)row * 16 + F.lane] = mine * inv; }
    }
    __syncthreads();
}
__device__ __forceinline__ void p_rowpass_k(const Params& P, Frame& F, int l, int nrows) {
    const int gw = F.bid * NWAVES + F.wave, NGW = F.G * NWAVES; bf16* H = WSP(bf16, WS_H);
    const int* SEL = WSP(int, WS_SEL); const bf16* Y = WSP(bf16, WS_Y);
    f32x4 vn[4]; int seln = -1; int row = gw;
    if (row < nrows) { row_load(row < RL ? P.out + (size_t)row * DM : WSP(float, WS_XC) + (size_t)(row - RL) * DM, F.lane, vn); seln = F.lane < 16 ? SEL[(size_t)row * 16 + F.lane] : -1; }
    for (; row < nrows; row += NGW) {
        float* xr = row < RL ? P.out + (size_t)row * DM : WSP(float, WS_XC) + (size_t)(row - RL) * DM;
        f32x4 v[4], a[4]; const int sel = seln;
#pragma unroll
        for (int j = 0; j < 4; ++j) { v[j] = vn[j]; a[j] = (f32x4){0.f, 0.f, 0.f, 0.f}; }
        { const int nr = row + NGW; if (nr < nrows) { row_load(nr < RL ? P.out + (size_t)nr * DM : WSP(float, WS_XC) + (size_t)(nr - RL) * DM, F.lane, vn); seln = F.lane < 16 ? SEL[(size_t)nr * 16 + F.lane] : -1; } }
        unsigned em = (unsigned)__ballot(sel >= 0) & 0xffffu;
        while (em) { const int e = __builtin_ctz(em); em &= em - 1; const int s = __builtin_amdgcn_readlane(sel, e); const bf16* yr = Y + (size_t)s * DM;
#pragma unroll
            for (int j = 0; j < 4; ++j) { const u32x2 w = *(const u32x2*)(yr + 4 * F.lane + 256 * j); a[j][0] += bflo(w.x); a[j][1] += bfhi(w.x); a[j][2] += bflo(w.y); a[j][3] += bfhi(w.y); } }
        const float* g2 = mod_ptr(F, l, row, 5);
#pragma unroll
        for (int j = 0; j < 4; ++j) { const f32x4 g = *(const f32x4*)(g2 + 4 * F.lane + 256 * j); v[j] = v[j] + g * a[j]; }
        const float rs = row_rstd(v);
        if (l == 0) {
#pragma unroll
            for (int j = 0; j < 4; ++j) *(f32x4*)(xr + 4 * F.lane + 256 * j) = v[j];
            f32x4 y[4]; RowMod M{P.norm1_g + 1024, mod_ptr(F, 1, row, 0), mod_ptr(F, 1, row, 1)};
            row_modulate(v, rs, M, F.lane, y); row_store_bf(H + (size_t)row * DM, F.lane, y);
        } else {
#pragma unroll
            for (int j = 0; j < 4; ++j) { const f32x4 g = *(const f32x4*)(P.final_g + 4 * F.lane + 256 * j); *(f32x4*)(xr + 4 * F.lane + 256 * j) = v[j] * rs * g; }
        }
    }
}

__device__ __forceinline__ float dot64(const bf16x8 (&q)[8], const bf16* kp) {
    float s = 0.f;
#pragma unroll
    for (int i = 0; i < 8; ++i) { const u32x4 kw = *(const u32x4*)(kp + 8 * i); const u32x4 qw = __builtin_bit_cast(u32x4, q[i]);
#pragma unroll
        for (int t = 0; t < 4; ++t) s += bflo(kw[t]) * bflo(qw[t]) + bfhi(kw[t]) * bfhi(qw[t]); }
    return s;
}
__device__ __forceinline__ void p_attn_naive(const Params& P, Frame& F, int l, bool with_ctx_queries) {
    const int gw = F.bid * NWAVES + F.wave, NGW = F.G * NWAVES;
    const bf16* KQ = WSP(bf16, WS_KQ); const bf16* VT = WSP(bf16, WS_VT); bf16* ATT = WSP(bf16, WS_ATT);
    LAS float* pw = (LAS float*)(F.lds + F.wave * 2048);
    const float* rpb = P.rpb + (size_t)l * 16 * 15 * 31;
    const int nlat = NB * 64 * NH * 64, nitems = nlat + (with_ctx_queries ? NB * NH * CTXL : 0);
    for (int it = gw; it < nitems; it += NGW) {
        const bool lat = it < nlat;
        int b, h, r = 0, qc = 0, rowq;
        if (lat) { qc = it & 63; h = (it >> 6) & 15; r = (it >> 10) & 63; b = it >> 16; rowq = b * SEQ + r * 64 + qc; }
        else { const int i2 = it - nlat; qc = i2 & 255; h = (i2 >> 8) & 15; b = i2 >> 12; rowq = RL + b * CTXL + qc; }
        bf16x8 q[8];
        { const bf16* qp = KQ + (size_t)rowq * 2048 + 1024 + h * 64;
#pragma unroll
          for (int i = 0; i < 8; ++i) q[i] = *(const bf16x8*)(qp + 8 * i); }
        const int rs = min(max(r - 4, 0), 56), cs = min(max(qc - 8, 0), 48);
        float s[6];
        if (lat) {
#pragma unroll
            for (int t = 0; t < 2; ++t) { const int w = F.lane + 64 * t, i = w >> 4, j = w & 15; const int tok = (rs + i) * 64 + cs + j;
                s[t] = dot64(q, KQ + (size_t)(b * SEQ + tok) * 2048 + h * 64) * 0.125f + rpb[(h * 15 + (rs + i - r + 7)) * 31 + (cs + j - qc + 15)]; }
        } else { s[0] = -1e30f; s[1] = -1e30f; }
#pragma unroll
        for (int t = 0; t < 4; ++t) { const int c = F.lane + 64 * t; s[2 + t] = dot64(q, KQ + (size_t)(RL + b * CTXL + c) * 2048 + h * 64) * 0.125f; }
        float mx = s[0];
#pragma unroll
        for (int t = 1; t < 6; ++t) mx = fmaxf(mx, s[t]);
        mx = wave_max(mx);
        float sum = 0.f;
#pragma unroll
        for (int t = 0; t < 6; ++t) { s[t] = (lat || t >= 2) ? __expf(s[t] - mx) : 0.f; sum += s[t]; }
        sum = wave_sum(sum);
        pw[F.lane] = s[0]; pw[F.lane + 64] = s[1];
#pragma unroll
        for (int t = 0; t < 4; ++t) pw[128 + F.lane + 64 * t] = s[2 + t];
        LDS_WAIT(); asm volatile("" ::: "memory");
        float o = 0.f;
        if (lat) { const bf16* vr = VT + ((size_t)b * 1024 + h * 64 + F.lane) * 4096;
#pragma unroll 2
            for (int w = 0; w < 128; ++w) { const int tok = (rs + (w >> 4)) * 64 + cs + (w & 15); o += pw[w] * bf2f(vr[tok]); } }
        { const bf16* vr = VT + YT_CTX_OFF + ((size_t)b * 1024 + h * 64 + F.lane) * 256;
#pragma unroll 2
          for (int c8 = 0; c8 < 32; ++c8) { const u32x4 vw = *(const u32x4*)(vr + 8 * c8); const LAS float* pp = pw + 128 + 8 * c8;
#pragma unroll
              for (int t = 0; t < 4; ++t) o += pp[2 * t] * bflo(vw[t]) + pp[2 * t + 1] * bfhi(vw[t]); } }
        ATT[(size_t)rowq * 1024 + h * 64 + F.lane] = (bf16)f2bf(o / sum);
        LDS_WAIT(); asm volatile("" ::: "memory");
    }
}

constexpr int ACK_STRIDE = 72, ACV_STRIDE = 264;
constexpr int ALDS_CK = 0, ALDS_CV = 256 * ACK_STRIDE * 2, ALDS_RP = ALDS_CV + 64 * ACV_STRIDE * 2;
struct AttnState { float m, sum; f32x4 o[4]; };
__device__ __forceinline__ float xrow16_max(float x) {
    auto s = __builtin_amdgcn_permlane16_swap(__float_as_uint(x), __float_as_uint(x), false, false);
    x = fmaxf(__uint_as_float(s[0]), __uint_as_float(s[1]));
    auto t = __builtin_amdgcn_permlane32_swap(__float_as_uint(x), __float_as_uint(x), false, false);
    return fmaxf(__uint_as_float(t[0]), __uint_as_float(t[1]));
}
__device__ __forceinline__ float xrow16_sum(float x) {
    auto s = __builtin_amdgcn_permlane16_swap(__float_as_uint(x), __float_as_uint(x), false, false);
    x = __uint_as_float(s[0]) + __uint_as_float(s[1]);
    auto t = __builtin_amdgcn_permlane32_swap(__float_as_uint(x), __float_as_uint(x), false, false);
    return __uint_as_float(t[0]) + __uint_as_float(t[1]);
}
#define MFMA16(a, b, c) __builtin_amdgcn_mfma_f32_16x16x32_bf16((a), (b), (c), 0, 0, 0)
template <int NT>
__device__ __forceinline__ void attn_tail(AttnState& S, f32x4 (&sc)[NT], const u32x4 (&vw)[NT / 2][4]) {
    float cm = -1e30f;
#pragma unroll
    for (int t = 0; t < NT; ++t)
#pragma unroll
        for (int j = 0; j < 4; ++j) cm = fmaxf(cm, sc[t][j]);
    cm = xrow16_max(cm);
    const float mn = fmaxf(S.m, cm), scl = __builtin_amdgcn_exp2f(S.m - mn); S.m = mn; float ps = 0.f;
#pragma unroll
    for (int t = 0; t < NT; ++t)
#pragma unroll
        for (int j = 0; j < 4; ++j) { const float p = __builtin_amdgcn_exp2f(sc[t][j] - mn); sc[t][j] = p; ps += p; }
    S.sum = S.sum * scl + ps;
#pragma unroll
    for (int dt = 0; dt < 4; ++dt) S.o[dt] = S.o[dt] * scl;
#pragma unroll
    for (int ks = 0; ks < NT / 2; ++ks) { u32x4 pw; pw.x = pk2(sc[2 * ks][0], sc[2 * ks][1]); pw.y = pk2(sc[2 * ks][2], sc[2 * ks][3]); pw.z = pk2(sc[2 * ks + 1][0], sc[2 * ks + 1][1]); pw.w = pk2(sc[2 * ks + 1][2], sc[2 * ks + 1][3]);
        const bf16x8 pf = __builtin_bit_cast(bf16x8, pw);
#pragma unroll
        for (int dt = 0; dt < 4; ++dt) S.o[dt] = MFMA16(__builtin_bit_cast(bf16x8, vw[ks][dt]), pf, S.o[dt]); }
}
__device__ __forceinline__ void attn_unit2(const bf16* __restrict__ KQ, const bf16* __restrict__ VT, bf16* __restrict__ ATT, LAS unsigned char* lds,
                                           const int b, const int h, const int rowqA, const int rowqB, const bool win, const int r, const int qt, const int lane) {
    const int l15 = lane & 15, g = lane >> 4;
    const f32x4 z = {0.f, 0.f, 0.f, 0.f};
    bf16x8 qA[2], qB[2];
    { const bf16* qp = KQ + (size_t)(rowqA + l15) * 2048 + 1024 + h * 64 + 8 * g; qA[0] = *(const bf16x8*)qp; qA[1] = *(const bf16x8*)(qp + 32); }
    { const bf16* qp = KQ + (size_t)(rowqB + l15) * 2048 + 1024 + h * 64 + 8 * g; qB[0] = *(const bf16x8*)qp; qB[1] = *(const bf16x8*)(qp + 32); }
    AttnState SA, SB; SA.m = -1e30f; SA.sum = 0.f; SB.m = -1e30f; SB.sum = 0.f;
#pragma unroll
    for (int dt = 0; dt < 4; ++dt) { SA.o[dt] = z; SB.o[dt] = z; }
    if (win) {
        const int rsA = min(max(r - 4, 0), 56), dB = min(max(r - 3, 0), 56) - rsA, kc0 = min(max(16 * qt - 8, 0), 32);
        const int q = 16 * qt + l15, csq = min(max(q - 8, 0), 48);
        const int krow0 = 8 * (l15 >> 2) + (l15 & 3);
        const bf16* kb = KQ + (size_t)(b * SEQ + kc0 + krow0) * 2048 + h * 64 + 8 * g;
        const bf16* vb = VT + (size_t)(b * 1024 + h * 64 + l15) * 4096 + kc0 + 8 * g;
        const LAS float* rp = (const LAS float*)(lds + ALDS_RP);
        const int jb = kc0 + 8 * g;
        const int okb = jb - csq;
        const LAS float* rpl = rp + 16 + (jb - q + 15);
        float madd[2][4];
#pragma unroll
        for (int t = 0; t < 2; ++t)
#pragma unroll
            for (int j = 0; j < 4; ++j) madd[t][j] = ((unsigned)(okb + 4 * t + j) < 16u) ? 0.f : -__builtin_inff();
        bf16x8 K0[2][2], K1[2][2]; u32x4 V0[1][4], V1[1][4];
#define ATT_LOADW(KB, VB, i) do { const int gr_ = min(rsA + (i), 63); const bf16* kp_ = kb + (size_t)(gr_ * 64) * 2048; const bf16* vp_ = vb + gr_ * 64; \
        _Pragma("unroll") for (int t = 0; t < 2; ++t) { KB[t][0] = *(const bf16x8*)(kp_ + (size_t)(4 * t) * 2048); KB[t][1] = *(const bf16x8*)(kp_ + (size_t)(4 * t) * 2048 + 32); } \
        _Pragma("unroll") for (int dt = 0; dt < 4; ++dt) VB[0][dt] = *(const u32x4*)(vp_ + (size_t)(16 * dt) * 4096); } while (0)
#define ATT_ONE(ST, QF, KB, VB, roff, rowok) do { f32x4 sc[2]; \
        _Pragma("unroll") for (int t = 0; t < 2; ++t) { sc[t] = MFMA16(KB[t][0], QF[0], z); sc[t] = MFMA16(KB[t][1], QF[1], sc[t]); } \
        const LAS float* bp_ = rpl + ((rowok) ? (roff) : 15) * 64; \
        _Pragma("unroll") for (int t = 0; t < 2; ++t) _Pragma("unroll") for (int j = 0; j < 4; ++j) sc[t][j] = (sc[t][j] + bp_[4 * t + j]) + madd[t][j]; \
        attn_tail<2>(ST, sc, VB); } while (0)
#define ATT_COMPUTE(KB, VB, i) do { const int roffA_ = min(rsA + (i) - r + 7, 14); \
        ATT_ONE(SA, qA, KB, VB, roffA_, (i) <= 7); \
        ATT_ONE(SB, qB, KB, VB, max(roffA_ - 1, 0), (i) >= dB && (i) <= 7 + dB); } while (0)
        ATT_LOADW(K0, V0, 0);
#pragma unroll 1
        for (int i = 0; i < 8; i += 2) { ATT_LOADW(K1, V1, i + 1); ATT_COMPUTE(K0, V0, i); ATT_LOADW(K0, V0, i + 2); ATT_COMPUTE(K1, V1, i + 1); }
        ATT_COMPUTE(K0, V0, 8);
#undef ATT_LOADW
#undef ATT_ONE
#undef ATT_COMPUTE
    }
    { const LAS bf16* ck = (const LAS bf16*)(lds + ALDS_CK) + l15 * ACK_STRIDE + 8 * g;
      const LAS bf16* cv = (const LAS bf16*)(lds + ALDS_CV) + l15 * ACV_STRIDE + 8 * g;
#pragma unroll 1
      for (int c = 0; c < 4; ++c) {
          bf16x8 kf[4][2]; u32x4 vw[2][4];
#pragma unroll
          for (int t = 0; t < 4; ++t) { const LAS bf16* kp = ck + (64 * c + 16 * t) * ACK_STRIDE; kf[t][0] = *(const LAS bf16x8*)kp; kf[t][1] = *(const LAS bf16x8*)(kp + 32); }
#pragma unroll
          for (int ks = 0; ks < 2; ++ks)
#pragma unroll
              for (int dt = 0; dt < 4; ++dt) vw[ks][dt] = *(const LAS u32x4*)(cv + (16 * dt) * ACV_STRIDE + 64 * c + 32 * ks);
          { f32x4 sc[4];
#pragma unroll
            for (int t = 0; t < 4; ++t) { sc[t] = MFMA16(kf[t][0], qA[0], z); sc[t] = MFMA16(kf[t][1], qA[1], sc[t]); }
            attn_tail<4>(SA, sc, vw); }
          { f32x4 sc[4];
#pragma unroll
            for (int t = 0; t < 4; ++t) { sc[t] = MFMA16(kf[t][0], qB[0], z); sc[t] = MFMA16(kf[t][1], qB[1], sc[t]); }
            attn_tail<4>(SB, sc, vw); }
      } }
    { const float inv = 1.0f / xrow16_sum(SA.sum);
#pragma unroll
      for (int dt = 0; dt < 4; ++dt) st_bf4(ATT + (size_t)(rowqA + l15) * 1024 + h * 64 + 16 * dt + 4 * g, SA.o[dt] * inv); }
    { const float inv = 1.0f / xrow16_sum(SB.sum);
#pragma unroll
      for (int dt = 0; dt < 4; ++dt) st_bf4(ATT + (size_t)(rowqB + l15) * 1024 + h * 64 + 16 * dt + 4 * g, SB.o[dt] * inv); }
}
__device__ __forceinline__ void p_attn_mfma(const Params& P, Frame& F, int l, bool with_ctx_queries) {
    const bf16* KQ = WSP(bf16, WS_KQ); const bf16* VT = WSP(bf16, WS_VT); bf16* ATT = WSP(bf16, WS_ATT);
    const float* rpb = P.rpb + (size_t)l * 16 * 465;
    for (int hp = F.bid; hp < 256; hp += F.G) {
        const int p = hp & 127, half = hp >> 7, b = p >> 4, h = p & 15;
        __syncthreads();
        { LAS bf16* ck = (LAS bf16*)(F.lds + ALDS_CK); LAS bf16* cv = (LAS bf16*)(F.lds + ALDS_CV); LAS float* rp = (LAS float*)(F.lds + ALDS_RP);
          { const int key = F.tid >> 1, hf = F.tid & 1; const int k32 = key & 31, pos = (key & ~31) + ((k32 >> 2) & 1) * 16 + 4 * (k32 >> 3) + (k32 & 3);
            const u32x4* src = (const u32x4*)(KQ + (size_t)(RL + b * CTXL + key) * 2048 + h * 64 + hf * 32); LAS u32x4* dst = (LAS u32x4*)(ck + pos * ACK_STRIDE + hf * 32);
#pragma unroll
            for (int i = 0; i < 4; ++i) dst[i] = src[i]; }
          { const int d = F.tid >> 3, sg = F.tid & 7; const u32x4* src = (const u32x4*)(VT + YT_CTX_OFF + (size_t)(b * 1024 + h * 64 + d) * 256 + sg * 32); LAS u32x4* dst = (LAS u32x4*)(cv + d * ACV_STRIDE + sg * 32);
#pragma unroll
            for (int i = 0; i < 4; ++i) dst[i] = src[i]; }
          for (int i = F.tid; i < 16 * 64; i += NTHREADS) { const int rr = i >> 6, cc = (i & 63) - 16; rp[i] = rr == 15 ? -__builtin_inff() : ((cc >= 0 && cc < 31) ? rpb[h * 465 + rr * 31 + cc] * LOG2E : 0.f); } }
        __syncthreads();
        const int qt = F.wave & 3, rpi = F.wave >> 2;
#pragma unroll 1
        for (int st = 0; st < 8; ++st) { const int r = half * 32 + st * 4 + rpi * 2; const int rowqA = b * SEQ + r * 64 + 16 * qt;
            attn_unit2(KQ, VT, ATT, F.lds, b, h, rowqA, rowqA + 64, true, r, qt, F.lane); }
        if (with_ctx_queries && half == 0) { const int rowqA = RL + b * CTXL + 32 * F.wave; attn_unit2(KQ, VT, ATT, F.lds, b, h, rowqA, rowqA + 16, false, 0, 0, F.lane); }
    }
    __syncthreads();
}

__device__ __forceinline__ void ld8(const bf16* p, float (&x)[8]) { const u32x4 w = *(const u32x4*)p;
#pragma unroll
    for (int q = 0; q < 4; ++q) { x[2 * q] = bflo(w[q]); x[2 * q + 1] = bfhi(w[q]); } }
__device__ __forceinline__ void p_pool(Frame& F, int nrows) {
    const bf16* PB = WSP(bf16, WS_PB); bf16* POOL = WSP(bf16, WS_POOL);
    for (int i = F.bid * NTHREADS + F.tid; i < (nrows >> 4) * 64; i += F.G * NTHREADS) {
        const int row0 = (i >> 6) << 4, ch = i & 63, g = ch >> 4, hw = 1 << g;
        int base, t0, Lb; if (row0 < RL) { base = row0 & ~4095; t0 = row0 & 4095; Lb = SEQ; } else { const int rr = row0 - RL; base = RL + (rr & ~255); t0 = rr & 255; Lb = CTXL; }
        const bf16* src = PB + (size_t)base * 512 + ch * 8;
        float S[8];
#pragma unroll
        for (int q = 0; q < 8; ++q) S[q] = 0.f;
#pragma unroll 4
        for (int d = -8; d < 8; ++d) { const int tt = t0 + d; if (d >= -hw && d < hw && tt >= 0 && tt < Lb) { float x[8]; ld8(src + (size_t)tt * 512, x);
#pragma unroll
                for (int q = 0; q < 8; ++q) S[q] += x[q]; } }
#pragma unroll 2
        for (int j = 0; j < 16; ++j) { const int t = t0 + j; const int lo = max(t - hw, 0), hi = min(t + hw, Lb); const float inv = 1.0f / (float)(hi - lo);
            float me[8]; ld8(src + (size_t)t * 512, me);
            u32x4 o;
#pragma unroll
            for (int q = 0; q < 4; ++q) o[q] = pk2(S[2 * q] * inv - me[2 * q], S[2 * q + 1] * inv - me[2 * q + 1]);
            *(u32x4*)(POOL + (size_t)(base + t) * 512 + ch * 8) = o;
            if (t + hw < Lb) { float x[8]; ld8(src + (size_t)(t + hw) * 512, x);
#pragma unroll
                for (int q = 0; q < 8; ++q) S[q] += x[q]; }
            if (t - hw >= 0) { float x[8]; ld8(src + (size_t)(t - hw) * 512, x);
#pragma unroll
                for (int q = 0; q < 8; ++q) S[q] -= x[q]; } }
    }
}

__device__ __forceinline__ int block_sum_i(int v, LAS int* sm, int tid) {
    v = wave_sum_i(v);
    __syncthreads();
    if ((tid & 63) == 0) sm[tid >> 6] = v;
    __syncthreads();
    int s = 0;
#pragma unroll
    for (int i = 0; i < 8; ++i) s += sm[i];
    return s;
}
__device__ __forceinline__ int block_excl_scan(int v, LAS int* sm, int tid, int& total) {
    const int lane = tid & 63, w = tid >> 6; int inc = v;
#pragma unroll
    for (int o = 1; o < 64; o <<= 1) { const int t = __builtin_amdgcn_ds_bpermute(((lane - o) & 63) << 2, inc); if (lane >= o) inc += t; }
    __syncthreads();
    if (lane == 63) sm[w] = inc;
    __syncthreads();
    int base = 0; total = 0;
#pragma unroll
    for (int i = 0; i < 8; ++i) { const int s = sm[i]; if (i < w) base += s; total += s; }
    return base + inc - v;
}
template <int NPT>
__device__ __forceinline__ void topk_pair(Frame& F, int row0, int n, int cap, int e, int slot0) {
    LAS int* sm = (LAS int*)F.lds;
    const float* AFF = WSP(float, WS_AFF); int* SROW = WSP(int, WS_SROW); float* SG = WSP(float, WS_SGATE); int* SEL = WSP(int, WS_SEL);
    unsigned key[NPT];
#pragma unroll
    for (int j = 0; j < NPT; ++j) { const int i = F.tid * NPT + j; key[j] = (i < n) ? __float_as_uint(AFF[(size_t)(row0 + i) * 16 + e]) : 0u; }
    unsigned T = 0u;
    for (int bit = 30; bit >= 0; --bit) { const unsigned cand = T | (1u << bit); int cnt = 0;
#pragma unroll
        for (int j = 0; j < NPT; ++j) cnt += (key[j] >= cand) ? 1 : 0;
        cnt = block_sum_i(cnt, sm, F.tid);
        if (cnt >= cap) T = cand; }
    int ngt = 0, neq = 0;
#pragma unroll
    for (int j = 0; j < NPT; ++j) { ngt += (key[j] > T) ? 1 : 0; neq += (key[j] == T) ? 1 : 0; }
    int tot_gt, tot_eq;
    (void)block_excl_scan(ngt, sm, F.tid, tot_gt);
    int eqr = block_excl_scan(neq, sm, F.tid, tot_eq);
    const int need_eq = cap - tot_gt;
    int nsel = 0; bool selj[NPT];
#pragma unroll
    for (int j = 0; j < NPT; ++j) { bool s = key[j] > T; if (key[j] == T && T != 0u) { s = eqr < need_eq; ++eqr; } selj[j] = s; nsel += s ? 1 : 0; }
    int tot_sel; int pos = block_excl_scan(nsel, sm, F.tid, tot_sel);
#pragma unroll
    for (int j = 0; j < NPT; ++j) { const int i = F.tid * NPT + j;
        if (i < n) { const int row = row0 + i;
            if (selj[j]) { const int slot = slot0 + pos; ++pos; SROW[slot] = row; SG[slot] = __uint_as_float(key[j]); SEL[(size_t)row * 16 + e] = slot; }
            else SEL[(size_t)row * 16 + e] = -1; } }
    __syncthreads();
}
__device__ __forceinline__ void p_topk(Frame& F, bool with_ctx) {
    const int npairs = 128 + (with_ctx ? 128 : 0);
    for (int pi = F.bid; pi < npairs; pi += F.G) {
        if (pi < 128) { const int b = pi >> 4, e = pi & 15; topk_pair<8>(F, b * SEQ, SEQ, CAPL, e, e * SLOT_E + b * CAPL); }
        else { const int p2 = pi - 128, b = p2 >> 4, e = p2 & 15; topk_pair<1>(F, RL + b * CTXL, CTXL, CAPC, e, e * SLOT_E + 4096 + b * CAPC); }
    }
}
__device__ __forceinline__ void p_gather(Frame& F, bool with_ctx) {
    const int gw = F.bid * NWAVES + F.wave, NGW = F.G * NWAVES; const bf16* H = WSP(bf16, WS_H); bf16* XG = WSP(bf16, WS_XG); const int* SROW = WSP(int, WS_SROW);
    for (int s = gw; s < NSLOT; s += NGW) { if (!with_ctx && (s % SLOT_E) >= 4096) continue;
        const int row = SROW[s]; const u32x4* src = (const u32x4*)(H + (size_t)row * DM); u32x4* dst = (u32x4*)(XG + (size_t)s * DM);
        dst[F.lane] = src[F.lane]; dst[F.lane + 64] = src[F.lane + 64]; }
}

template <int PH> __global__ void __launch_bounds__(NTHREADS, 2) fwd_kernel(Params P) {
    extern __shared__ __attribute__((aligned(16))) unsigned char lds_raw[];
    Frame F; F.lds = (LAS unsigned char*)lds_raw; F.tid = threadIdx.x; F.lane = F.tid & 63; F.wave = __builtin_amdgcn_readfirstlane(F.tid >> 6); F.G = gridDim.x; F.bid = blockIdx.x; F.ws = P.ws;
    const int wave0 = __builtin_amdgcn_readfirstlane((int)threadIdx.x >> 6);
    volatile LAS unsigned* MISC = (volatile LAS unsigned*)(F.lds + LDS_MISC);
    if (F.tid < 64) MISC[F.tid] = 0u;
    __syncthreads();
    XcdBarrier bar; bar.bar = WSP(unsigned, WS_CTL) + CW_BAR; bar.x = 0; bar.st = MISC + 8;
    if constexpr (PH < 0) bar = xcd_barrier_post(WSP(unsigned, WS_CTL) + CW_BAR, MISC + 8);
#define IN(k) (PH < 0 || PH == (k))
#define REFRESH() do { unsigned on_ = ~0u; asm volatile("" : "+s"(on_)); int t_ = wave0 * 64 + (int)__builtin_amdgcn_mbcnt_hi(on_, __builtin_amdgcn_mbcnt_lo(on_, 0u)); asm volatile("" : "+v"(t_)); F.tid = t_; F.lane = t_ & 63; F.wave = __builtin_amdgcn_readfirstlane(t_ >> 6); } while (0)
#define SEAM(k) do { if constexpr (PH < 0) xcd_barrier(bar); } while (0)

    if (IN(0)) { REP_BEGIN(100) p_mod(P, F); p_dftgen(F); REP_END REP_BEGIN(101) p_wconv(P, F, 0); REP_END }
    SEAM(0);
    if (IN(1)) { p_rowpass_a0(P, F); }
    SEAM(1);
    for (int l = P.l_lo; l < P.l_hi; ++l) {
        constexpr int pb = 2; const bool L0 = (l == 0);
        bf16* H = WSP(bf16, WS_H);
        if (IN(pb + 0)) { REFRESH(); REP_BEGIN(2)
            { GroupSched S; S.init(1, 128, 22, F.G, F.bid, 8, L0 ? 22 : 4, 128, 0);
              const bf16* WA = WSP(bf16, WS_WA);
              auto AD = [=](const Unit& u) { return Operands{H + (size_t)u.pm * 256 * DM, WA + (size_t)u.pn * 256 * DM, DM, DM, 0, DM}; };
              bf16* KQ = WSP(bf16, WS_KQ); bf16* PBp = WSP(bf16, WS_PB); bf16* GB = WSP(bf16, WS_GB);
              auto E = [=](EPI_ARGS) { const int row0 = u.pm * 256;
                  if (u.pn < 8) { const float qs = (u.pn >= 4) ? QSCALE : 1.0f; EPI_FOR8( st_bf8(KQ + (size_t)(row0 + r) * 2048 + u.pn * 256 + c, v0 * qs, v1 * qs); ) }
                  else if (u.pn < 10) { EPI_FOR8( st_bf8(PBp + (size_t)(row0 + r) * 512 + (u.pn - 8) * 256 + c, v0, v1); ) }
                  else { EPI_FOR8( f32x4 s0; f32x4 s1; _Pragma("unroll") for (int j = 0; j < 4; ++j) { s0[j] = sigmoidf_(v0[j]); s1[j] = sigmoidf_(v1[j]); } st_bf8(GB + (size_t)(row0 + r) * 3072 + (u.pn - 10) * 256 + c, s0, s1); ) } };
              GEMM_P(S, AD, E); }
            REFRESH();
            { GroupSched S; const int g1a_units = 128 * 22 + 8 * (L0 ? 22 : 4);
              S.init(1, 8, 128, F.G, (F.bid + F.G - ((g1a_units % F.G) & ~7)) % F.G, L0 ? 8 : 4, 8, L0 ? 0 : 4, 128);
              const bf16* WFV = WSP(bf16, WS_WFV);
              auto AD = [=](const Unit& u) { const bool fmap = (u.pm < 4) && (u.pn < 128); const int t16 = u.pn & 15;
                  const size_t tok0 = fmap ? (size_t)(u.pn >> 4) * SEQ + 64 * ((t16 >> 1) * 8) + (t16 & 1) * 32 : (size_t)u.pn * 256;
                  return Operands{WFV + (size_t)u.pm * 256 * DM, H + tok0 * DM, DM, DM, 0, DM, fmap ? 1 : 0}; };
              bf16* YT = WSP(bf16, WS_YT); bf16* VT = WSP(bf16, WS_VT);
              auto E = [=](EPI_ARGS) { bf16* T = (u.pm < 4) ? YT : VT; const int rr0 = (u.pm & 3) * 256;
                  if (u.pn < 128) { const int b = u.pn >> 4;
                      if (u.pm < 4) { const int t16 = u.pn & 15, l10 = (t16 >> 1) * 8, l20 = (t16 & 1) * 32;
                          EPI_FOR8( const int fc = rr0 + r; st_bf8(T + (((((size_t)b * 512 + (fc >> 1)) * 32 + (c >> 3)) * 2 + (l20 >> 5)) * 2 + (fc & 1)) * 64 + l10, v0, v1); ) }
                      else { const int l0 = (u.pn & 15) * 256; EPI_FOR8( st_bf8(T + ((size_t)b * 1024 + rr0 + r) * 4096 + l0 + c, v0, v1); ) } }
                  else { const int b = u.pn - 128; EPI_FOR8( st_bf8(T + YT_CTX_OFF + ((size_t)b * 1024 + rr0 + r) * 256 + c, v0, v1); ) } };
              GEMM_P(S, AD, E); }
        REP_END }
        SEAM(pb + 0);
        if (IN(pb + 1)) { REFRESH();
            REP_BEGIN(31) p_attn_mfma(P, F, l, L0); REP_END
            REFRESH();
            REP_BEGIN(32)
            { LAS float* tw = (LAS float*)(F.lds + LDS_TW);
              for (int j = F.tid; j < 4096; j += NTHREADS) tw[j] = cospif((float)j * (1.0f / 2048.0f));
              __syncthreads();
              GroupSched S; S.init(1, 1, 512, F.G, F.bid);
              const bf16* M1 = WSP(bf16, WS_M1T); const bf16* YF = WSP(bf16, WS_YT); bf16* ZP = WSP(bf16, WS_ZP);
              auto AD = [=](const Unit& u) { return Operands{M1, YF + (size_t)u.pn * 256 * 256, 256, 256, 0, 256}; };
              auto E = [=](EPI_ARGS) {
                  const int b = u.pn >> 6, gm0 = (u.pn & 63) * 8 + wc, l20 = 32 * wr + 8 * fq;
#pragma unroll
                  for (int m = 0; m < 4; ++m) { const int k1 = 16 * m + fr;
#pragma unroll
                      for (int bj = 0; bj < 2; ++bj) { const int gm = gm0 + 4 * bj;
                          f32x4 zr[2], zi[2];
#pragma unroll
                          for (int n = 0; n < 2; ++n)
#pragma unroll
                              for (int j = 0; j < 4; ++j) { const int ix = k1 * (l20 + 4 * n + j); const float tc = tw[ix], ts = tw[(ix + 3072) & 4095];
                                  const float ur = acc[0][bj][m][n][j], ui = acc[1][bj][m][n][j]; zr[n][j] = ur * tc - ui * ts; zi[n][j] = ur * ts + ui * tc; }
                          bf16* dst = ZP + (((((size_t)b * 64 + k1) * 128 + (gm & 127)) * 4 + (gm >> 7)) * 2) * 64 + l20;
                          st_bf8(dst, zr[0], zr[1]); st_bf8(dst + 64, zi[0], zi[1]); } } };
              GEMM_P(S, AD, E); }
            REP_END
        }
        SEAM(pb + 1);
        if (IN(pb + 10)) { REFRESH();
            { GroupSched S; S.init(1, 1, 256, F.G, F.bid);
              const bf16* M2 = WSP(bf16, WS_M2T); const bf16* ZP = WSP(bf16, WS_ZP); bf16* FOUR = WSP(bf16, WS_FOUR);
              auto AD = [=](const Unit& u) { return Operands{M2, ZP + (size_t)u.pn * 256 * 512, 512, 512, 0, 512}; };
              auto E = [=](EPI_ARGS) { const float sc = 0.0013810679320049757f;
#pragma unroll
                  for (int ai = 0; ai < 2; ++ai)
#pragma unroll
                      for (int m = 0; m < 4; ++m) { const int q = 2 * ai + wr, k2 = 16 * m + fr;
#pragma unroll
                          for (int bj = 0; bj < 2; ++bj) { const int bk = u.pn * 2 + bj, b = bk >> 6, k1 = bk & 63;
                              st_bf8(FOUR + ((size_t)b * SEQ + k1 + 64 * k2) * 512 + q * 128 + wc * 32 + 8 * fq, acc[ai][bj][m][0] * sc, acc[ai][bj][m][1] * sc); } } };
              GEMM_P(S, AD, E); }
            REFRESH();
            if (L0) { GroupSched S; S.init(1, 1, 16, F.G, (F.bid + F.G - 128 % F.G) % F.G);
              const bf16* DFTC = WSP(bf16, WS_DFTC); const bf16* YTC = WSP(bf16, WS_YT) + YT_CTX_OFF; bf16* FOUR = WSP(bf16, WS_FOUR);
              auto AD = [=](const Unit& u) { return Operands{DFTC, YTC + (size_t)u.pn * 256 * 512, 512, 512, 0, 512}; };
              auto E = [=](EPI_ARGS) { const int b = u.pn >> 1, c0 = (u.pn & 1) * 256; const float sc = 0.005524271728019903f;
                  EPI_FOR8( st_bf8(FOUR + ((size_t)RL + b * CTXL + r) * 512 + c0 + c, v0 * sc, v1 * sc); ) };
              GEMM_P(S, AD, E); }
            REFRESH();
            REP_BEGIN(33) p_pool(F, L0 ? RT : RL); REP_END
        }
        SEAM(pb + 10);
        if (IN(pb + 2)) { REFRESH();
            SegSched<3> S; S.base.init(1, L0 ? 136 : 128, 4, F.G, F.bid);
            const bf16* ATT = WSP(bf16, WS_ATT); const bf16* FOUR = WSP(bf16, WS_FOUR); const bf16* POOL = WSP(bf16, WS_POOL);
            const bf16* WAO = WSP(bf16, WS_WAO); const bf16* WFO = WSP(bf16, WS_WFO); const bf16* WPO = WSP(bf16, WS_WPO);
            const bf16* GB = WSP(bf16, WS_GB); bf16* MRGB = WSP(bf16, WS_MRGB); const float* ps = P.pool_scale + l * 1024;
            auto AD = [=](const Unit& u) {
                if (u.seg == 0) return Operands{ATT + (size_t)u.pm * 256 * 1024, WAO + (size_t)u.pn * 256 * 1024, 1024, 1024, 0, 1024};
                if (u.seg == 1) return Operands{FOUR + (size_t)u.pm * 256 * 512, WFO + (size_t)u.pn * 256 * 512, 512, 512, 0, 512};
                return Operands{POOL + (size_t)u.pm * 256 * 512 + (u.pn >> 1) * 256, WPO + (size_t)u.pn * 256 * 256, 512, 256, 0, 256}; };
            auto E = [=](EPI_ARGS) {
                const int kd = u.seg < 2 ? u.seg + 1 : 2; const bool fin = (u.seg == 2); const int colb = u.pn * 256 + wc * 32 + 8 * fq;
#pragma unroll
                for (int ai = 0; ai < 2; ++ai)
#pragma unroll
                    for (int m = 0; m < 4; ++m) { const size_t row = (size_t)u.pm * 256 + ai * 128 + wr * 64 + m * 16 + fr; const bf16* gr = GB + row * 3072 + colb;
                        u32x4 nr[2], dr[2]; f32x4 psv[2][2];
#pragma unroll
                        for (int bj = 0; bj < 2; ++bj) { nr[bj] = *(const u32x4*)(gr + u.seg * 1024 + bj * 128); dr[bj] = *(const u32x4*)(gr + kd * 1024 + bj * 128);
                            psv[bj][0] = *(const f32x4*)(ps + colb + bj * 128); psv[bj][1] = *(const f32x4*)(ps + colb + bj * 128 + 4); }
#pragma unroll
                        for (int bj = 0; bj < 2; ++bj) { f32x4 o[2];
#pragma unroll
                            for (int n = 0; n < 2; ++n) { f32x4 nu = {bflo(nr[bj][2 * n]), bfhi(nr[bj][2 * n]), bflo(nr[bj][2 * n + 1]), bfhi(nr[bj][2 * n + 1])}, de = {bflo(dr[bj][2 * n]), bfhi(dr[bj][2 * n]), bflo(dr[bj][2 * n + 1]), bfhi(dr[bj][2 * n + 1])};
                                if (u.seg == 2) nu = nu * psv[bj][n];
                                de = de * psv[bj][n];
#pragma unroll
                                for (int j = 0; j < 4; ++j) { const float nj = (fabsf(nu[j]) < 1e-30f) ? copysignf(1e-30f, nu[j]) : nu[j]; const float dj = (fabsf(de[j]) < 1e-30f) ? copysignf(1e-30f, de[j]) : de[j];
                                    o[n][j] = acc[ai][bj][m][n][j] * nj * (fin ? 1.0f : __builtin_amdgcn_rcpf(dj)); }
                                acc[ai][bj][m][n] = o[n]; }
                            if (fin) st_bf8(MRGB + row * 1024 + colb + bj * 128, o[0], o[1]); } } };
            gemm_fast<false, true>(F.lds, F.tid, S, AD, mk_epi_seg(E, 2), nullptr);
        }
        SEAM(pb + 2);
        if (IN(pb + 3)) { REFRESH();
            GroupSched S; S.init(1, L0 ? 136 : 128, 4, F.G, F.bid); const bf16* A = WSP(bf16, WS_MRGB); const bf16* W = WSP(bf16, WS_WOUT);
            const float* xin = L0 ? P.x : P.out; const float* cin = L0 ? P.ctx : WSP(float, WS_XC); float* xo = P.out; float* co = WSP(float, WS_XC);
            const float* MOD = WSP(float, WS_MOD) + (size_t)l * 9 * 6144;
            auto AD = [=](const Unit& u) { return Operands{A + (size_t)u.pm * 256 * 1024, W + (size_t)u.pn * 256 * 1024, 1024, 1024, 0, 1024}; };
            auto E = [=](EPI_ARGS) {
                const int row0 = u.pm * 256, mr = row0 < RL ? (row0 >> 12) : 8, colb = u.pn * 256 + wc * 32 + 4 * fq;
                const float* src0 = row0 < RL ? xin + (size_t)row0 * DM : cin + (size_t)(row0 - RL) * DM; float* dst0 = row0 < RL ? xo + (size_t)row0 * DM : co + (size_t)(row0 - RL) * DM;
                f32x4 gv[2][2];
#pragma unroll
                for (int bj = 0; bj < 2; ++bj)
#pragma unroll
                    for (int n = 0; n < 2; ++n) gv[bj][n] = *(const f32x4*)(MOD + (size_t)mr * 6144 + 2048 + colb + bj * 128 + n * 16);
#pragma unroll
                for (int ai = 0; ai < 2; ++ai) { f32x4 xv[4][2][2];
#pragma unroll
                    for (int m = 0; m < 4; ++m) { const size_t ro = (size_t)(ai * 128 + wr * 64 + m * 16 + fr) * DM + colb;
#pragma unroll
                        for (int bj = 0; bj < 2; ++bj)
#pragma unroll
                            for (int n = 0; n < 2; ++n) xv[m][bj][n] = *(const f32x4*)(src0 + ro + bj * 128 + n * 16); }
#pragma unroll
                    for (int m = 0; m < 4; ++m) { const size_t ro = (size_t)(ai * 128 + wr * 64 + m * 16 + fr) * DM + colb;
#pragma unroll
                        for (int bj = 0; bj < 2; ++bj)
#pragma unroll
                            for (int n = 0; n < 2; ++n) *(f32x4*)(dst0 + ro + bj * 128 + n * 16) = xv[m][bj][n] + gv[bj][n] * acc[ai][bj][m][n]; } } };
            GEMM(S, AD, E, 1024, 1024, 1024);
        }
        SEAM(pb + 3);
        if (IN(pb + 4)) { REFRESH(); REP_BEGIN(6) p_rowpass_f(P, F, l, L0 ? RT : RL); REP_END }
        SEAM(pb + 4);
        if (IN(pb + 5)) { REFRESH(); REP_BEGIN(7) p_topk(F, L0); REP_END }
        SEAM(pb + 5);
        if (IN(pb + 7)) { REFRESH(); REP_BEGIN(9)
            GroupSched S; S.init(16, L0 ? 17 : 16, 22, F.G, F.bid); const bf16* W = WSP(bf16, WS_WGU); bf16* HID = WSP(bf16, WS_HID); const int* SROW = WSP(int, WS_SROW);
            auto AD = [=](const Unit& u) { return Operands{H, W + ((size_t)u.grp * 5632 + u.pn * 256) * DM, DM, DM, u.grp * SLOT_E + u.pm * 256, DM}; };
            auto E = [=](EPI_ARGS) {
#pragma unroll
                for (int ai = 0; ai < 2; ++ai)
#pragma unroll
                    for (int m = 0; m < 4; ++m) { const size_t slot = (size_t)u.grp * SLOT_E + u.pm * 256 + ai * 128 + wr * 64 + m * 16 + fr; f32x4 o[2];
#pragma unroll
                        for (int n = 0; n < 2; ++n) { const f32x4 a = acc[ai][0][m][n], up = acc[ai][1][m][n];
#pragma unroll
                            for (int j = 0; j < 4; ++j) o[n][j] = a[j] * sigmoidf_(a[j]) * up[j]; }
                        st_bf8(HID + slot * FF + u.pn * 128 + wc * 32 + 8 * fq, o[0], o[1]); } };
            GEMM_GATHER(S, AD, E, DM, DM, DM, SROW);
        REP_END }
        SEAM(pb + 7);
        if (IN(pb + 8)) { REFRESH(); REP_BEGIN(10)
            const int tpe = L0 ? 17 : 16;
            GroupSched S; S.init(1, 16 * tpe, 4, F.G, F.bid); const bf16* HID = WSP(bf16, WS_HID); const bf16* W = WSP(bf16, WS_WD); bf16* Y = WSP(bf16, WS_Y); const float* SG = WSP(float, WS_SGATE);
            auto AD = [=](const Unit& u) { const int e = u.pm / tpe, st = e * 17 + (u.pm - e * tpe); return Operands{HID + (size_t)st * 256 * FF, W + ((size_t)e * 1024 + u.pn * 256) * FF, FF, FF, 0, FF}; };
            auto E = [=](EPI_ARGS) { const int e = u.pm / tpe; const size_t slot0 = (size_t)(e * 17 + (u.pm - e * tpe)) * 256 + wr * 64 + fr; float gt[2][4];
#pragma unroll
                for (int ai = 0; ai < 2; ++ai)
#pragma unroll
                    for (int m = 0; m < 4; ++m) gt[ai][m] = SG[slot0 + ai * 128 + m * 16];
#pragma unroll
                for (int ai = 0; ai < 2; ++ai)
#pragma unroll
                    for (int m = 0; m < 4; ++m)
#pragma unroll
                        for (int bj = 0; bj < 2; ++bj) st_bf8(Y + (slot0 + ai * 128 + m * 16) * DM + u.pn * 256 + bj * 128 + wc * 32 + 8 * fq, acc[ai][bj][m][0] * gt[ai][m], acc[ai][bj][m][1] * gt[ai][m]); };
            GEMM_P(S, AD, E);
        REP_END }
        SEAM(pb + 8);
        if (IN(pb + 9)) { REFRESH(); p_rowpass_k(P, F, l, L0 ? RT : RL); if (L0) p_wconv(P, F, 1); }
        if (L0) SEAM(pb + 9);
    }
#undef IN
#undef SEAM
}
template <int PH> static void launch_ph(int grid, const Params& p, hipStream_t stream) { hipLaunchKernelGGL(fwd_kernel<PH>, dim3(grid), dim3(NTHREADS), LDS_BYTES, stream, p); }
template <int PH> static bool set_attr() { return hipFuncSetAttribute((const void*)fwd_kernel<PH>, hipFuncAttributeMaxDynamicSharedMemorySize, LDS_BYTES) == hipSuccess; }

#ifndef DUP_LAUNCH
#define DUP_LAUNCH -1
#endif
extern "C" void kernel_launch(void* const* d_in, const int* in_sizes, int n_in, void* d_out, int out_size, void* d_ws, size_t ws_size, hipStream_t stream) {
    static int grid = 0;
    if (grid == 0) {
        if (n_in != 20 || out_size != RL * DM || ws_size < WS_END) { fprintf(stderr, "kernel_launch: unexpected shapes (n_in %d out %d ws %zu need %zu)\n", n_in, out_size, ws_size, (size_t)WS_END); grid = -1; return; }
        int dev = 0, cus = 0, per_cu = 0;
        if (hipGetDevice(&dev) != hipSuccess || hipDeviceGetAttribute(&cus, hipDeviceAttributeMultiprocessorCount, dev) != hipSuccess) { grid = -1; return; }
#if N_LAUNCH_MODE == 1
        if (!set_attr<-1>()) { fprintf(stderr, "kernel_launch: hipFuncSetAttribute failed\n"); grid = -1; return; }
        if (hipOccupancyMaxActiveBlocksPerMultiprocessor(&per_cu, (const void*)fwd_kernel<-1>, NTHREADS, LDS_BYTES) != hipSuccess || per_cu < 1) fprintf(stderr, "kernel_launch: occupancy query reports %d\n", per_cu);
#else
        if (!(set_attr<0>() && set_attr<1>() && set_attr<2>() && set_attr<3>() && set_attr<12>() && set_attr<4>() && set_attr<5>() && set_attr<6>() && set_attr<7>() && set_attr<9>() && set_attr<10>() && set_attr<11>())) { fprintf(stderr, "kernel_launch: hipFuncSetAttribute failed\n"); grid = -1; return; }
        (void)per_cu;
#endif
        (void)hipGetLastError();
        grid = cus;
    }
    if (grid < 0) return;
    if (hipMemsetAsync((char*)d_ws + WS_CTL, 0, CTL_BYTES, stream) != hipSuccess) return;
    Params p{};
    const float** pp = (const float**)&p;
    for (int i = 0; i < 20; ++i) pp[i] = (const float*)d_in[i];
    p.out = (float*)d_out; p.ws = (unsigned char*)d_ws;
#if N_LAUNCH_MODE == 1
    p.l_lo = 0; p.l_hi = 2;
    launch_ph<-1>(grid, p, stream);
#else
    p.l_lo = 0; p.l_hi = 0; launch_ph<0>(grid, p, stream); if (DUP_LAUNCH == 0) launch_ph<0>(grid, p, stream); launch_ph<1>(grid, p, stream); if (DUP_LAUNCH == 1) launch_ph<1>(grid, p, stream);
#define LP(k) do { launch_ph<k>(grid, p, stream); if (DUP_LAUNCH == (k) && l == 0) launch_ph<k>(grid, p, stream); } while (0)
    for (int l = 0; l < 2; ++l) { p.l_lo = l; p.l_hi = l + 1;
        LP(2); LP(3); LP(12); LP(4); LP(5); LP(6); LP(7); LP(9); LP(10); LP(11); }
#endif
}
```

```cpp
#include <hip/hip_runtime.h>
#include <cstdio>
#include <cstdint>

#ifndef N_LAUNCH_MODE
#define N_LAUNCH_MODE 1
#endif

#define GAS __attribute__((address_space(1)))
#define LAS __attribute__((address_space(3)))
typedef unsigned short bf16;
typedef short bf16x8 __attribute__((ext_vector_type(8)));
typedef float f32x4 __attribute__((ext_vector_type(4)));
typedef unsigned u32x4 __attribute__((ext_vector_type(4)));
typedef unsigned u32x2 __attribute__((ext_vector_type(2)));

constexpr int NB = 8, SEQ = 4096, DM = 1024, CTXL = 256, NH = 16, HD = 64, GRIDW = 64;
constexpr int RL = NB * SEQ, RC = NB * CTXL, RT = RL + RC;
constexpr int INW = 7168, NE = 16, FF = 2816, CAPL = 512, CAPC = 32;
constexpr int SLOT_E = 4352, NSLOT = NE * SLOT_E;
constexpr float RMS_EPS = 1e-6f;
constexpr float LOG2E = 1.4426950408889634f, QSCALE = 0.125f * LOG2E;
constexpr int NWAVES = 8, NTHREADS = 512;

constexpr size_t al256(size_t x) { return (x + 255) & ~(size_t)255; }
constexpr size_t WS_CTL = 0, CTL_BYTES = 1u << 20;
constexpr size_t WS_MOD = WS_CTL + CTL_BYTES;
constexpr size_t WS_XC = al256(WS_MOD + (size_t)2 * 9 * 6144 * 4);
constexpr size_t WS_AFF = al256(WS_XC + (size_t)RC * DM * 4);
constexpr size_t WS_SROW = al256(WS_AFF + (size_t)RT * 16 * 4);
constexpr size_t WS_SGATE = al256(WS_SROW + (size_t)NSLOT * 4);
constexpr size_t WS_SEL = al256(WS_SGATE + (size_t)NSLOT * 4);
constexpr size_t WS_DFTM = al256(WS_SEL + (size_t)RT * 16 * 4);
constexpr size_t WS_DFTC = al256(WS_DFTM + (size_t)4096 * 8192 * 2);
constexpr size_t WS_WA = al256(WS_DFTC + (size_t)256 * 512 * 2);
constexpr size_t WS_WFV = al256(WS_WA + (size_t)5632 * 1024 * 2);
constexpr size_t WS_WAO = al256(WS_WFV + (size_t)2048 * 1024 * 2);
constexpr size_t WS_WFO = al256(WS_WAO + (size_t)1024 * 1024 * 2);
constexpr size_t WS_WPO = al256(WS_WFO + (size_t)1024 * 512 * 2);
constexpr size_t WS_WOUT = al256(WS_WPO + (size_t)1024 * 256 * 2);
constexpr size_t WS_WGU = al256(WS_WOUT + (size_t)1024 * 1024 * 2);
constexpr size_t WS_WD = al256(WS_WGU + (size_t)16 * 5632 * 1024 * 2);
constexpr size_t WS_H = al256(WS_WD + (size_t)16 * 1024 * 2816 * 2);
constexpr size_t WS_R = al256(WS_H + (size_t)RT * DM * 2);
constexpr size_t WS_KQ = WS_R;
constexpr size_t WS_MRG = WS_KQ;
constexpr size_t WS_PB = al256(WS_KQ + (size_t)RT * 2048 * 2);
constexpr size_t WS_GB = al256(WS_PB + (size_t)RT * 512 * 2);
constexpr size_t WS_YT = al256(WS_GB + (size_t)RT * 3072 * 2);
constexpr size_t WS_MRGB = WS_YT;
constexpr size_t WS_VT = al256(WS_YT + (size_t)RT * 1024 * 2);
constexpr size_t WS_FOUR = al256(WS_VT + (size_t)RT * 1024 * 2);
constexpr size_t WS_ATT = al256(WS_FOUR + (size_t)RT * 512 * 2);
constexpr size_t WS_POOL = al256(WS_ATT + (size_t)RT * 1024 * 2);
constexpr size_t WS_MIX_END = al256(WS_POOL + (size_t)RT * 512 * 2);
constexpr size_t WS_XG = WS_R;
constexpr size_t WS_HID = al256(WS_XG + (size_t)NSLOT * 1024 * 2);
constexpr size_t WS_Y = al256(WS_HID + (size_t)NSLOT * 2816 * 2);
constexpr size_t WS_MOE_END = al256(WS_Y + (size_t)NSLOT * 1024 * 2);
constexpr size_t WS_END0 = WS_MIX_END > WS_MOE_END ? WS_MIX_END : WS_MOE_END;
constexpr size_t WS_ZP = WS_END0;
constexpr size_t WS_M1T = al256(WS_ZP + ((size_t)8 * 64 * 512 * 128 + 1024) * 2);
constexpr size_t WS_M2T = al256(WS_M1T + (size_t)256 * 256 * 2);
constexpr size_t WS_END = al256(WS_M2T + (size_t)256 * 512 * 2);
constexpr size_t YT_CTX_OFF = (size_t)8 * 1024 * 4096;

constexpr int CW_BAR = 4096;

constexpr int LDS_BYTES = 155648;
constexpr int LDS_TW = 132096;
constexpr int LDS_MISC = 131072;

__device__ __forceinline__ unsigned f2bf(float f) { unsigned u = __float_as_uint(f); return (u + 0x7fffu + ((u >> 16) & 1u)) >> 16; }
typedef __bf16 hbf16x2 __attribute__((ext_vector_type(2)));
typedef float f32x2 __attribute__((ext_vector_type(2)));
__device__ __forceinline__ unsigned pk2(float lo, float hi) { const f32x2 v = {lo, hi}; return __builtin_bit_cast(unsigned, __builtin_convertvector(v, hbf16x2)); }
__device__ __forceinline__ float bf2f(unsigned b) { return __uint_as_float(b << 16); }
__device__ __forceinline__ float bflo(unsigned w) { return __uint_as_float(w << 16); }
__device__ __forceinline__ float bfhi(unsigned w) { return __uint_as_float(w & 0xffff0000u); }
template <int CTRL> __device__ __forceinline__ float dppf(float x) { return __builtin_bit_cast(float, __builtin_amdgcn_mov_dpp(__builtin_bit_cast(int, x), CTRL, 0xf, 0xf, true)); }
template <int CTRL> __device__ __forceinline__ int dppi(int x) { return __builtin_amdgcn_mov_dpp(x, CTRL, 0xf, 0xf, true); }
constexpr int DPP_XOR1 = 0xB1, DPP_XOR2 = 0x4E, DPP_ROR4 = 0x124, DPP_ROR8 = 0x128;
__device__ __forceinline__ float wave_sum(float v) {
    v += dppf<DPP_XOR1>(v); v += dppf<DPP_XOR2>(v); v += dppf<DPP_ROR4>(v); v += dppf<DPP_ROR8>(v);
    auto s = __builtin_amdgcn_permlane16_swap(__float_as_uint(v), __float_as_uint(v), false, false); v = __uint_as_float(s[0]) + __uint_as_float(s[1]);
    auto t = __builtin_amdgcn_permlane32_swap(__float_as_uint(v), __float_as_uint(v), false, false); return __uint_as_float(t[0]) + __uint_as_float(t[1]);
}
__device__ __forceinline__ float wave_max(float v) {
    v = fmaxf(v, dppf<DPP_XOR1>(v)); v = fmaxf(v, dppf<DPP_XOR2>(v)); v = fmaxf(v, dppf<DPP_ROR4>(v)); v = fmaxf(v, dppf<DPP_ROR8>(v));
    auto s = __builtin_amdgcn_permlane16_swap(__float_as_uint(v), __float_as_uint(v), false, false); v = fmaxf(__uint_as_float(s[0]), __uint_as_float(s[1]));
    auto t = __builtin_amdgcn_permlane32_swap(__float_as_uint(v), __float_as_uint(v), false, false); return fmaxf(__uint_as_float(t[0]), __uint_as_float(t[1]));
}
__device__ __forceinline__ int wave_sum_i(int v) {
    v += dppi<DPP_XOR1>(v); v += dppi<DPP_XOR2>(v); v += dppi<DPP_ROR4>(v); v += dppi<DPP_ROR8>(v);
    auto s = __builtin_amdgcn_permlane16_swap((unsigned)v, (unsigned)v, false, false); v = (int)(s[0] + s[1]);
    auto t = __builtin_amdgcn_permlane32_swap((unsigned)v, (unsigned)v, false, false); return (int)(t[0] + t[1]);
}
__device__ __forceinline__ float sigmoidf_(float x) { return __builtin_amdgcn_rcpf(1.f + __builtin_amdgcn_exp2f(x * -1.4426950408889634f)); }
#define LDS_WAIT() asm volatile("s_waitcnt lgkmcnt(0)" ::: "memory")

#define XB_TMO      128
#define XB_XCNT(j)  (256  + 64 * (j))
#define XB_XSUB(j)  (1280 + 64 * (j))
#define XB_XGEN(j)  (2304 + 64 * (j))
#define XB_TOP      3328
#define XB_TOPGEN   3392
#define XCD_BAR_WORDS 3456
#define XB_SPIN_CAP (1u << 22)

__device__ __forceinline__ unsigned xb_ld(unsigned* p)              { return __hip_atomic_load(p, __ATOMIC_RELAXED, __HIP_MEMORY_SCOPE_AGENT); }
__device__ __forceinline__ unsigned xb_add(unsigned* p, unsigned v) { return __hip_atomic_fetch_add(p, v, __ATOMIC_RELAXED, __HIP_MEMORY_SCOPE_AGENT); }
__device__ __forceinline__ unsigned xb_xcc_id() { return (unsigned)__builtin_amdgcn_s_getreg((3 << 11) | 20) & 0xFu; }
#define XB_SPIN(cond, bar) do { unsigned _sp = 0; while (cond) { __builtin_amdgcn_s_sleep(1); \
    if ((++_sp & 255u) == 0u) { if (xb_ld(&(bar)[XB_TMO])) break; if (_sp > XB_SPIN_CAP) { atomicAdd(&(bar)[XB_TMO], 1u); break; } } } } while (0)

struct XcdBarrier { unsigned* bar; unsigned x; volatile LAS unsigned* st; };

__device__ __forceinline__ XcdBarrier xcd_barrier_post(unsigned* bar, volatile LAS unsigned* st) {
    XcdBarrier b; b.bar = bar; b.x = xb_xcc_id(); b.st = st;
    if (threadIdx.x == 0) (void)xb_add(&bar[XB_XCNT(b.x)], 1u);
    return b;
}
__device__ __forceinline__ void xcd_barrier_complete(unsigned* bar, unsigned x, unsigned& nloc, unsigned& nx) {
    const unsigned G = gridDim.x * gridDim.y * gridDim.z;
    unsigned sum, cnt, mine, sp = 0u;
    for (;;) {
        sum = 0u; cnt = 0u; mine = 0u;
#pragma unroll
        for (unsigned j = 0; j < 16; ++j) { const unsigned c = xb_ld(&bar[XB_XCNT(j)]); sum += c; cnt += (c > 0u) ? 1u : 0u; mine = (j == x) ? c : mine; }
        if (sum == G) break;
        __builtin_amdgcn_s_sleep(1);
        if ((++sp & 255u) == 0u) { if (xb_ld(&bar[XB_TMO])) break; if (sp > XB_SPIN_CAP) { atomicAdd(&bar[XB_TMO], 1u); break; } }
    }
    nloc = mine > 0u ? mine : 1u; nx = cnt > 0u ? cnt : 1u;
}
__device__ __forceinline__ void xcd_barrier(const XcdBarrier& b) {
    asm volatile("s_waitcnt vmcnt(0)" ::: "memory");
    __syncthreads();
    if (threadIdx.x == 0) {
        unsigned* bar = b.bar;
        __builtin_amdgcn_s_waitcnt(0);
        unsigned nloc = b.st[0], nx = b.st[1];
        if (nloc == 0u) { xcd_barrier_complete(bar, b.x, nloc, nx); b.st[0] = nloc; b.st[1] = nx; }
        const unsigned old = xb_add(&bar[XB_XSUB(b.x)], 1u);
        const unsigned gen = old / nloc;
        if (old + 1u == (gen + 1u) * nloc) {
            __builtin_amdgcn_fence(__ATOMIC_RELEASE, "agent");
            asm volatile("s_waitcnt vmcnt(0)" ::: "memory");
            const unsigned og = xb_add(&bar[XB_TOP], 1u);
            const unsigned tg = og / nx;
            if (og + 1u == (tg + 1u) * nx) xb_add(&bar[XB_TOPGEN], 1u);
            else XB_SPIN(xb_ld(&bar[XB_TOPGEN]) == tg, bar);
            __builtin_amdgcn_fence(__ATOMIC_ACQUIRE, "agent");
            xb_add(&bar[XB_XGEN(b.x)], 1u);
            asm volatile("s_waitcnt vmcnt(0)" ::: "memory");
        } else {
            XB_SPIN(xb_ld(&bar[XB_XGEN(b.x)]) == gen, bar);
            __builtin_amdgcn_fence(__ATOMIC_ACQUIRE, "agent");
            asm volatile("s_waitcnt vmcnt(0)" ::: "memory");
        }
    }
    __syncthreads();
}

struct Params {
    const float *x, *c, *ctx, *c_ctx, *ada_w, *ada_b, *norm1_g, *norm2_g, *w_in, *rpb, *w_att_o, *w_fourier, *w_pool, *pool_scale, *w_out, *w_router, *w_eg, *w_eu, *w_ed, *final_g;
    float* out; unsigned char* ws; int l_lo, l_hi;
};
struct Frame {
    LAS unsigned char* lds;
    int tid, lane, wave, G, bid;
    unsigned char* ws;
};
#define WSP(T, off) ((T*)(F.ws + (off)))

struct Unit { int grp, pm, pn, seg; };
struct GroupSched {
    int ng, nM, nN, G, c; int tM, tN, tpm0, tpn0;
    __device__ __forceinline__ void init(int ng_, int nM_, int nN_, int G_, int c_, int tM_ = 0, int tN_ = 0, int tpm0_ = 0, int tpn0_ = 0) { ng = ng_; nM = nM_; nN = nN_; G = G_; c = c_; tM = tM_; tN = tN_; tpm0 = tpm0_; tpn0 = tpn0_; }
    __device__ __forceinline__ bool next(int i, Unit& u) const {
        const int per = nM * nN; const int L = i * G + c;
        if (L < ng * per) {
            u.grp = L / per; int wgid = L - u.grp * per;
            { const int q = per / 8, r = per % 8, xcd = wgid % 8, off = wgid / 8; wgid = (xcd < r ? xcd * (q + 1) : r * (q + 1) + (xcd - r) * q) + off; }
            const int nig = 8 * nN, gid = wgid / nig, fm = gid * 8, gsz = (nM - fm) < 8 ? (nM - fm) : 8;
            u.pm = fm + ((wgid % nig) % gsz); u.pn = (wgid % nig) / gsz; u.seg = 0; return true;
        }
        const int w = L - ng * per;
        if (w < tM * tN) { u.grp = ng; u.pm = tpm0 + (w % tM); u.pn = tpn0 + (w / tM); u.seg = 0; return true; }
        return false;
    }
};
struct Operands { const bf16* A; const bf16* Bt; int lda, ldb, slot0, K; int bmap; };

constexpr int HTB = 128 * 64 * 2;
__device__ __forceinline__ int lds_byte(int r, int c) { const int st = (r >> 4) * 2 + (c >> 5), rr = r & 15, cc = c & 31, ob = rr * 64 + cc * 2; return st * 1024 + (ob ^ (((ob >> 9) & 1) << 5)); }
__device__ __forceinline__ int perm32(int rho) { const int n = rho >> 4, i = rho & 15; return 8 * (i >> 2) + 4 * n + (i & 3); }
__device__ __forceinline__ void stage_rc(int b, int& R, int& C) { const int st = b / 1024, sb = b % 1024, swz = sb ^ (((sb >> 9) & 1) << 5); R = (st >> 1) * 16 + swz / 64; C = (st & 1) * 32 + (swz % 64) / 2; }
template <bool GATHER, bool PERM, class Sched, class Addr, class Epi>
__device__ __forceinline__ void gemm_fast(LAS unsigned char* lds, const int tid, const Sched& S, const Addr& AD, const Epi& E, const int* __restrict__ grows) {
    const int wid = __builtin_amdgcn_readfirstlane(tid >> 6), lane = tid & 63, wr = wid >> 2, wc = wid & 3, fr = lane & 15, fq = lane >> 4;
    int sR[2], sRb[2]; unsigned sC[2];
    unsigned cvg[2][2], nvg[2][2], cvb[2][2], nvb[2][2];
#pragma unroll
    for (int i = 0; i < 2; ++i) { int R, C; stage_rc(tid * 16 + i * 8192, R, C); sR[i] = R; sC[i] = (unsigned)C * 2u; sRb[i] = PERM ? ((R & ~31) + perm32(R & 31)) : R; }
    const size_t kstep = 128;
    const unsigned ldsw = (unsigned)wid * 1024u;
    const int aoff = lds_byte(wr * 64 + fr, fq * 8), boff = lds_byte(wc * 32 + fr, fq * 8);
#define PG8_SA(b, h) (((b) * 2 + (h)) * HTB)
#define PG8_SB(b, h) ((4 + (b) * 2 + (h)) * HTB)
#define PG8_STAGE(bufoff, gbase, voff) do { _Pragma("unroll") for (int _i = 0; _i < 2; ++_i) \
        __builtin_amdgcn_global_load_lds((const unsigned*)((const char*)(gbase) + (voff)[_i]), (LAS unsigned*)(lds + (bufoff) + ldsw + _i * 8192), 16, 0, 0); } while (0)
#define PG8_LDA(dst, b, h) do { _Pragma("unroll") for (int m = 0; m < 4; ++m) _Pragma("unroll") for (int k = 0; k < 2; ++k) dst[m][k] = *(const LAS bf16x8*)(lds + PG8_SA(b, h) + aoff + m * 2048 + k * 1024); } while (0)
#define PG8_LDB(dst, b, h) do { _Pragma("unroll") for (int n = 0; n < 2; ++n) _Pragma("unroll") for (int k = 0; k < 2; ++k) dst[n][k] = *(const LAS bf16x8*)(lds + PG8_SB(b, h) + boff + n * 2048 + k * 1024); } while (0)
#define PG8_MMA(ai, bj, At, Bt) do { __builtin_amdgcn_s_setprio(1); _Pragma("unroll") for (int m = 0; m < 4; ++m) _Pragma("unroll") for (int n = 0; n < 2; ++n) _Pragma("unroll") for (int k = 0; k < 2; ++k) \
        acc[ai][bj][m][n] = __builtin_amdgcn_mfma_f32_16x16x32_bf16(Bt[n][k], At[m][k], acc[ai][bj][m][n], 0, 0, 0); __builtin_amdgcn_s_setprio(0); } while (0)
#define PG8_WAIT_V(n) asm volatile("s_waitcnt vmcnt(" #n ")" ::: "memory")
#define PG8_WAIT_L(n) asm volatile("s_waitcnt lgkmcnt(" #n ")" ::: "memory")
#define PG8_BAR __builtin_amdgcn_s_barrier()
#define PG8_SCHED __builtin_amdgcn_sched_barrier(0)
#define PG8_GIDX(dst, op_) do { _Pragma("unroll") for (int h_ = 0; h_ < 2; ++h_) _Pragma("unroll") for (int i_ = 0; i_ < 2; ++i_) dst[h_][i_] = (unsigned)grows[(op_).slot0 + h_ * 128 + sR[i_]] * (unsigned)((op_).lda * 2) + sC[i_]; } while (0)
#define PG8_AOFF(dst, op_) do { _Pragma("unroll") for (int h_ = 0; h_ < 2; ++h_) _Pragma("unroll") for (int i_ = 0; i_ < 2; ++i_) dst[h_][i_] = (unsigned)((sR[i_] + 128 * h_) * (op_).lda) * 2u + sC[i_]; } while (0)
#define PG8_BOFF(dst, op_) do { _Pragma("unroll") for (int h_ = 0; h_ < 2; ++h_) _Pragma("unroll") for (int i_ = 0; i_ < 2; ++i_) { const int c_ = sRb[i_] + 128 * h_; \
        dst[h_][i_] = (unsigned)(((op_).bmap ? (64 * (c_ & 7) + (c_ >> 3)) : c_) * (op_).ldb) * 2u + sC[i_]; } } while (0)
#define PG8_COPY(dst, src) do { _Pragma("unroll") for (int h_ = 0; h_ < 2; ++h_) _Pragma("unroll") for (int i_ = 0; i_ < 2; ++i_) dst[h_][i_] = src[h_][i_]; } while (0)
    Unit cur, nxt; int ui = 0;
    if (!S.next(0, cur)) return;
    f32x4 acc[2][2][4][2];
#pragma unroll
    for (int a = 0; a < 2; ++a)
#pragma unroll
        for (int b = 0; b < 2; ++b)
#pragma unroll
            for (int m = 0; m < 4; ++m)
#pragma unroll
                for (int n = 0; n < 2; ++n) acc[a][b][m][n] = (f32x4){0.f, 0.f, 0.f, 0.f};
    bf16x8 At[4][2], B0[2][2], B1[2][2];
    const char* cA; const char* cB; int nt;
    { const Operands op = AD(cur); cA = (const char*)op.A; cB = (const char*)op.Bt; nt = op.K / 64; PG8_BOFF(cvb, op);
      Unit u1; const bool h1 = S.next(1, u1); const Operands o1 = h1 ? AD(u1) : op; PG8_BOFF(nvb, o1);
      if constexpr (GATHER) { PG8_GIDX(cvg, op); PG8_GIDX(nvg, o1); PG8_WAIT_V(0); } else { PG8_AOFF(cvg, op); PG8_AOFF(nvg, o1); } }
    PG8_STAGE(PG8_SB(0, 0), cB, cvb[0]); PG8_STAGE(PG8_SB(0, 1), cB, cvb[1]); PG8_STAGE(PG8_SA(0, 0), cA, cvg[0]); PG8_STAGE(PG8_SA(0, 1), cA, cvg[1]);
    if (wr == 1) PG8_BAR;
    PG8_WAIT_V(2); PG8_BAR;
    PG8_STAGE(PG8_SB(1, 0), cB + kstep, cvb[0]); PG8_STAGE(PG8_SA(1, 0), cA + kstep, cvg[0]); PG8_STAGE(PG8_SB(1, 1), cB + kstep, cvb[1]);
    PG8_WAIT_V(6); PG8_BAR;
    for (;;) {
        const bool has_next = S.next(ui + 1, nxt);
        const char* nA = cA; const char* nB = cB; int nnt = nt;
        if (has_next) { const Operands op = AD(nxt); nA = (const char*)op.A; nB = (const char*)op.Bt; nnt = op.K / 64; }
#pragma unroll 1
        for (int t = 0; t < nt; t += 2) {
            const bool last = (t == nt - 2);
            const char* a1 = cA + (size_t)(t + 1) * kstep;
            const char* a2 = last ? nA : cA + (size_t)(t + 2) * kstep; const char* b2 = last ? nB : cB + (size_t)(t + 2) * kstep;
            const char* a3 = a2 + kstep; const char* b3 = b2 + kstep;
            unsigned v2[2][2], w2[2][2];
#pragma unroll
            for (int h_ = 0; h_ < 2; ++h_)
#pragma unroll
                for (int i_ = 0; i_ < 2; ++i_) { v2[h_][i_] = last ? nvg[h_][i_] : cvg[h_][i_]; w2[h_][i_] = last ? nvb[h_][i_] : cvb[h_][i_]; }
            PG8_LDB(B0, 0, 0); PG8_LDB(B1, 0, 1); PG8_SCHED; PG8_LDA(At, 0, 0); PG8_STAGE(PG8_SA(1, 1), a1, cvg[1]);
            PG8_WAIT_V(8); PG8_WAIT_L(0); PG8_BAR; PG8_MMA(0, 0, At, B0); PG8_MMA(0, 1, At, B1); PG8_BAR; PG8_SCHED;
            PG8_LDA(At, 0, 1); PG8_STAGE(PG8_SB(0, 0), b2, w2[0]); PG8_STAGE(PG8_SB(0, 1), b2, w2[1]); PG8_STAGE(PG8_SA(0, 0), a2, v2[0]);
            PG8_WAIT_V(8); PG8_WAIT_L(0); PG8_BAR; PG8_MMA(1, 0, At, B0); PG8_MMA(1, 1, At, B1); PG8_BAR; PG8_SCHED;
            PG8_LDB(B0, 1, 0); PG8_LDB(B1, 1, 1); PG8_SCHED; PG8_LDA(At, 1, 0); PG8_STAGE(PG8_SA(0, 1), a2, v2[1]);
            PG8_WAIT_V(8); PG8_WAIT_L(0); PG8_BAR; PG8_MMA(0, 0, At, B0); PG8_MMA(0, 1, At, B1); PG8_BAR; PG8_SCHED;
            PG8_LDA(At, 1, 1); PG8_STAGE(PG8_SB(1, 0), b3, w2[0]); PG8_STAGE(PG8_SB(1, 1), b3, w2[1]); PG8_STAGE(PG8_SA(1, 0), a3, v2[0]);
            PG8_WAIT_V(8); PG8_WAIT_L(0); PG8_BAR; PG8_MMA(1, 0, At, B0); PG8_MMA(1, 1, At, B1); PG8_BAR; PG8_SCHED;
        }
        if (wr == 0) PG8_BAR;
        unsigned fvg[2][2], fvb[2][2];
        { Unit u2; const bool h2 = S.next(ui + 2, u2);
          if (h2) { const Operands o2 = AD(u2); PG8_BOFF(fvb, o2); if constexpr (GATHER) PG8_GIDX(fvg, o2); else PG8_AOFF(fvg, o2); }
          else { PG8_COPY(fvb, nvb); PG8_COPY(fvg, nvg); } }
        { int fr2 = fr, fq2 = fq; asm volatile("" : "+v"(fr2), "+v"(fq2));
          E(acc, cur, wr, wc, fr2, fq2); }
        if (!has_next) break;
        if constexpr (GATHER) PG8_WAIT_V(0);
        PG8_COPY(cvg, nvg); PG8_COPY(nvg, fvg); PG8_COPY(cvb, nvb); PG8_COPY(nvb, fvb);
        if (E.reset(cur)) {
#pragma unroll
        for (int a = 0; a < 2; ++a)
#pragma unroll
            for (int b = 0; b < 2; ++b)
#pragma unroll
                for (int m = 0; m < 4; ++m)
#pragma unroll
                    for (int n = 0; n < 2; ++n) acc[a][b][m][n] = (f32x4){0.f, 0.f, 0.f, 0.f};
        }
        cur = nxt; cA = nA; cB = nB; nt = nnt; ++ui;
        if (wr == 1) PG8_BAR;
    }
    PG8_WAIT_V(0);
    PG8_BAR;
#undef PG8_SA
#undef PG8_SB
#undef PG8_STAGE
#undef PG8_LDA
#undef PG8_LDB
#undef PG8_MMA
#undef PG8_WAIT_V
#undef PG8_WAIT_L
#undef PG8_BAR
#undef PG8_SCHED
#undef PG8_GIDX
#undef PG8_AOFF
#undef PG8_BOFF
#undef PG8_COPY
}
template <class F> struct EpiFn { F f; __device__ __forceinline__ void operator()(f32x4 (&acc)[2][2][4][2], const Unit& u, int wr, int wc, int fr, int fq) const { f(acc, u, wr, wc, fr, fq); } __device__ __forceinline__ bool reset(const Unit&) const { return true; } };
template <class F> __device__ __forceinline__ EpiFn<F> mk_epi(F f) { return EpiFn<F>{f}; }
template <class F> struct EpiSeg { F f; int last; __device__ __forceinline__ void operator()(f32x4 (&acc)[2][2][4][2], const Unit& u, int wr, int wc, int fr, int fq) const { f(acc, u, wr, wc, fr, fq); } __device__ __forceinline__ bool reset(const Unit& u) const { return u.seg == last; } };
template <class F> __device__ __forceinline__ EpiSeg<F> mk_epi_seg(F f, int last) { return EpiSeg<F>{f, last}; }
template <int NSEG> struct SegSched { GroupSched base; __device__ __forceinline__ bool next(int j, Unit& u) const { if (!base.next(j / NSEG, u)) return false; u.seg = j % NSEG; return true; } };
#ifndef DUP_PH
#define DUP_PH -1
#endif
#define REP_BEGIN(k) _Pragma("unroll 1") for (int rep_ = 0; rep_ < ((DUP_PH == (k)) ? 2 : 1); ++rep_) { if (rep_) { if constexpr (PH < 0) xcd_barrier(bar); }
#define REP_END }
#define GEMM(S, AD, E, K, lda, ldb) gemm_fast<false, false>(F.lds, F.tid, S, AD, mk_epi(E), nullptr)
#define GEMM_P(S, AD, E) gemm_fast<false, true>(F.lds, F.tid, S, AD, mk_epi(E), nullptr)
#define GEMM_GATHER(S, AD, E, K, lda, ldb, rows) gemm_fast<true, true>(F.lds, F.tid, S, AD, mk_epi(E), rows)
#define EPI_ARGS f32x4 (&acc)[2][2][4][2], const Unit& u, int wr, int wc, int fr, int fq
#define EPI_FOR(...) _Pragma("unroll") for (int ai = 0; ai < 2; ++ai) _Pragma("unroll") for (int m = 0; m < 4; ++m) { const int r = ai * 128 + wr * 64 + m * 16 + fr; \
    _Pragma("unroll") for (int bj = 0; bj < 2; ++bj) _Pragma("unroll") for (int n = 0; n < 2; ++n) { const int c = bj * 128 + wc * 32 + n * 16 + 4 * fq; const f32x4 v = acc[ai][bj][m][n]; __VA_ARGS__ } }
#define EPI_FOR8(...) _Pragma("unroll") for (int ai = 0; ai < 2; ++ai) _Pragma("unroll") for (int m = 0; m < 4; ++m) { const int r = ai * 128 + wr * 64 + m * 16 + fr; \
    _Pragma("unroll") for (int bj = 0; bj < 2; ++bj) { const int c = bj * 128 + wc * 32 + 8 * fq; const f32x4 v0 = acc[ai][bj][m][0], v1 = acc[ai][bj][m][1]; __VA_ARGS__ } }
__device__ __forceinline__ void st_bf8(bf16* p, f32x4 a, f32x4 b) { u32x4 w; w.x = pk2(a[0], a[1]); w.y = pk2(a[2], a[3]); w.z = pk2(b[0], b[1]); w.w = pk2(b[2], b[3]); *(u32x4*)p = w; }
__device__ __forceinline__ void st_bf4(bf16* p, f32x4 v) { u32x2 w; w.x = pk2(v[0], v[1]); w.y = pk2(v[2], v[3]); *(u32x2*)p = w; }

__device__ __forceinline__ void p_mod(const Params& P, Frame& F) {
    LAS float* sc = (LAS float*)F.lds;
    LAS float* red = (LAS float*)(F.lds + 9 * 1024 * 4);
    float* MOD = WSP(float, WS_MOD);
    bool have = false;
    for (int it = F.bid; it < 2 * 96; it += F.G) {
        if (!have) {
            for (int i = F.tid; i < 9 * 1024; i += NTHREADS) { const int r = i >> 10, k = i & 1023; const float v = r < 8 ? P.c[r * 1024 + k] : P.c_ctx[k]; sc[i] = v * sigmoidf_(v); }
            have = true;
        }
        __syncthreads();
        const int l = it / 96, j0 = (it % 96) * 64, jj = F.tid & 63, kc = F.tid >> 6;
        const float* W = P.ada_w + (size_t)l * 1024 * 6144 + j0 + jj;
        float a[9];
#pragma unroll
        for (int r = 0; r < 9; ++r) a[r] = 0.f;
#pragma unroll 8
        for (int k = kc * 128; k < kc * 128 + 128; ++k) { const float w = W[(size_t)k * 6144];
#pragma unroll
            for (int r = 0; r < 9; ++r) a[r] += sc[r * 1024 + k] * w; }
#pragma unroll
        for (int r = 0; r < 9; ++r) red[(kc * 9 + r) * 64 + jj] = a[r];
        __syncthreads();
        for (int o = F.tid; o < 9 * 64; o += NTHREADS) { const int r = o >> 6, j = o & 63; float s = 0.f;
#pragma unroll
            for (int q = 0; q < 8; ++q) s += red[(q * 9 + r) * 64 + j];
            MOD[((size_t)l * 9 + r) * 6144 + j0 + j] = s + P.ada_b[l * 6144 + j0 + j]; }
    }
    __syncthreads();
}
__device__ __forceinline__ void p_dftgen(Frame& F) {
    LAS float* tab = (LAS float*)F.lds;
    for (int j = F.tid; j < 4096; j += NTHREADS) tab[j] = cospif((float)j * (1.0f / 2048.0f));
    __syncthreads();
    bf16* DC_ = WSP(bf16, WS_DFTC); bf16* M1 = WSP(bf16, WS_M1T); bf16* M2 = WSP(bf16, WS_M2T);
    const int nchunk = 256 * 64 + 256 * 32 + 256 * 64;
    for (int ch = F.bid * NTHREADS + F.tid; ch < nchunk; ch += F.G * NTHREADS) {
        float v[8]; bf16* dst;
        if (ch < 256 * 64) { const int kf = ch >> 6, col0 = (ch & 63) * 8, cs = col0 >> 8, l0 = col0 & 255;
#pragma unroll
            for (int i = 0; i < 8; ++i) { const int j = ((kf * (l0 + i)) & 255) * 16; v[i] = cs ? -tab[(j + 3072) & 4095] : tab[j]; }
            dst = DC_ + (size_t)kf * 512 + col0; }
        else if (ch < 256 * 64 + 256 * 32) { const int c2 = ch - 256 * 64, row = c2 >> 5, col0 = (c2 & 31) * 8, ri = row >> 7, h = (row >> 6) & 1, k1 = row & 63, h2 = col0 >> 7, cs = (col0 >> 6) & 1, l10 = col0 & 63;
#pragma unroll
            for (int i = 0; i < 8; ++i) { const int j = ((k1 * (l10 + i)) & 63) * 64; const float c = tab[j], sn = tab[(j + 3072) & 4095];
                v[i] = (h != h2) ? 0.f : (ri == 0 ? (cs == 0 ? c : -sn) : (cs == 0 ? sn : c)); }
            dst = M1 + (size_t)row * 256 + col0; }
        else { const int c2 = ch - 256 * 64 - 256 * 32, row = c2 >> 6, col0 = (c2 & 63) * 8, q = row >> 6, k2 = row & 63, q2 = col0 >> 7, ri = (col0 >> 6) & 1, l20 = col0 & 63;
#pragma unroll
            for (int i = 0; i < 8; ++i) { const int j = ((k2 * (l20 + i)) & 63) * 64; const float c = tab[j], sn = tab[(j + 3072) & 4095];
                v[i] = (q != q2) ? 0.f : (ri == 0 ? c : -sn); }
            dst = M2 + (size_t)row * 512 + col0; }
        u32x4 o; o.x = pk2(v[0], v[1]); o.y = pk2(v[2], v[3]); o.z = pk2(v[4], v[5]); o.w = pk2(v[6], v[7]);
        *(u32x4*)dst = o;
    }
    __syncthreads();
}
__device__ __forceinline__ void transpose_item(const float* W, int ldw, int k0, int n0, bf16* WT, int ldt, int drow0, LAS float* scr, int lane) {
    f32x4 ld[8];
#pragma unroll
    for (int i = 0; i < 8; ++i) ld[i] = *(const f32x4*)(W + (size_t)(k0 + 8 * i + (lane >> 3)) * ldw + n0 + 4 * (lane & 7));
#pragma unroll
    for (int i = 0; i < 8; ++i) { LAS float* d = scr + (8 * i + (lane >> 3)) * 33 + 4 * (lane & 7); d[0] = ld[i][0]; d[1] = ld[i][1]; d[2] = ld[i][2]; d[3] = ld[i][3]; }
    LDS_WAIT(); asm volatile("" ::: "memory");
    const int c = lane & 7;
#pragma unroll
    for (int j = 0; j < 4; ++j) { const int n = (lane >> 3) + 8 * j; const LAS float* s = scr + (8 * c) * 33 + n;
        u32x4 o; o.x = pk2(s[0 * 33], s[1 * 33]); o.y = pk2(s[2 * 33], s[3 * 33]); o.z = pk2(s[4 * 33], s[5 * 33]); o.w = pk2(s[6 * 33], s[7 * 33]);
        *(u32x4*)(WT + (size_t)(drow0 + n) * ldt + k0 + 8 * c) = o; }
    LDS_WAIT(); asm volatile("" ::: "memory");
}
__device__ __forceinline__ void p_wconv(const Params& P, Frame& F, int l) {
    LAS float* scr = (LAS float*)(F.lds + F.wave * 16384);
    const int gw = F.bid * NWAVES + F.wave, NGW = F.G * NWAVES;
    const float* w_in = P.w_in + (size_t)l * 1024 * INW;
    bf16* WA = WSP(bf16, WS_WA); bf16* WFV = WSP(bf16, WS_WFV);
    constexpr int I_K = 16 * 32, I_Q = 16 * 32, I_P = 16 * 16, I_G = 16 * 96, I_V = 16 * 32, I_AO = 16 * 32, I_FO = 8 * 32, I_OUT = 16 * 32;
    constexpr int NSM = I_K + I_Q + I_P + I_G + I_V + I_AO + I_FO + I_OUT;
    for (int it = gw; it < NSM; it += NGW) {
        int r = it;
        if (r < I_K) { transpose_item(w_in, INW, (r / 32) * 64, 0 + (r % 32) * 32, WA, 1024, 0 + (r % 32) * 32, scr, F.lane); continue; } r -= I_K;
        if (r < I_Q) { transpose_item(w_in, INW, (r / 32) * 64, 2048 + (r % 32) * 32, WA, 1024, 1024 + (r % 32) * 32, scr, F.lane); continue; } r -= I_Q;
        if (r < I_P) { transpose_item(w_in, INW, (r / 16) * 64, 3584 + (r % 16) * 32, WA, 1024, 2048 + (r % 16) * 32, scr, F.lane); continue; } r -= I_P;
        if (r < I_G) { transpose_item(w_in, INW, (r / 96) * 64, 4096 + (r % 96) * 32, WA, 1024, 2560 + (r % 96) * 32, scr, F.lane); continue; } r -= I_G;
        if (r < I_V) { transpose_item(w_in, INW, (r / 32) * 64, 1024 + (r % 32) * 32, WFV, 1024, 1024 + (r % 32) * 32, scr, F.lane); continue; } r -= I_V;
        if (r < I_AO) { transpose_item(P.w_att_o + (size_t)l * 1024 * 1024, 1024, (r / 32) * 64, (r % 32) * 32, WSP(bf16, WS_WAO), 1024, (r % 32) * 32, scr, F.lane); continue; } r -= I_AO;
        if (r < I_FO) { transpose_item(P.w_fourier + (size_t)l * 512 * 1024, 1024, (r / 32) * 64, (r % 32) * 32, WSP(bf16, WS_WFO), 512, (r % 32) * 32, scr, F.lane); continue; } r -= I_FO;
        transpose_item(P.w_out + (size_t)l * 1024 * 1024, 1024, (r / 32) * 64, (r % 32) * 32, WSP(bf16, WS_WOUT), 1024, (r % 32) * 32, scr, F.lane);
    }
    constexpr int I_E = 16 * 88;
    bf16* WGU = WSP(bf16, WS_WGU); bf16* WD = WSP(bf16, WS_WD);
    for (int it = gw; it < 3 * 16 * I_E; it += NGW) {
        const int which = it / (16 * I_E), r0 = it % (16 * I_E), e = r0 / I_E, r = r0 % I_E;
        if (which < 2) { const int kb = r / 88, nb = r % 88, n0 = nb * 32;
            const float* src = (which == 0 ? P.w_eg : P.w_eu) + ((size_t)l * 16 + e) * 1024 * FF;
            transpose_item(src, FF, kb * 64, n0, WGU + (size_t)e * 5632 * 1024, 1024, (n0 >> 7) * 256 + (which ? 128 : 0) + (n0 & 127), scr, F.lane); }
        else { const int kb = r / 32, nb = r % 32;
            transpose_item(P.w_ed + ((size_t)l * 16 + e) * FF * 1024, 1024, kb * 64, nb * 32, WD + (size_t)e * 1024 * FF, FF, nb * 32, scr, F.lane); }
    }
    { bf16* WPO = WSP(bf16, WS_WPO); const float* wp = P.w_pool + (size_t)l * 4 * 128 * 256;
      for (int i = F.bid * NTHREADS + F.tid; i < 1024 * 256; i += F.G * NTHREADS) { const int n = i >> 8, kk = i & 255, g = n >> 8, f = n & 255;
          WPO[i] = (bf16)(((kk >> 7) == (g & 1)) ? f2bf(wp[((size_t)g * 128 + (kk & 127)) * 256 + f]) : 0u); } }
    { LAS float* t128 = (LAS float*)F.lds;
      __syncthreads();
      for (int j = F.tid; j < 128; j += NTHREADS) t128[j] = cospif((float)j * (1.0f / 64.0f));
      __syncthreads();
      for (int i = F.bid * NTHREADS + F.tid; i < 1024 * 1024; i += F.G * NTHREADS) { const int fc = i >> 10, k = i & 1023, cs = fc & 1, gm = fc >> 1, g = gm >> 7, m = gm & 127;
          const float* src = w_in + (size_t)k * INW + 3072 + g * 128; float s = 0.f; const int ph = cs ? 96 : 0;
          for (int c = 0; c < 128; ++c) s += src[c] * t128[(m * c + ph) & 127];
          WFV[i] = (bf16)f2bf(s); }
      __syncthreads(); }
}

struct RowMod { const float* g; const float* sh; const float* sc; };
__device__ __forceinline__ void row_load(const float* row, int lane, f32x4 (&v)[4]) {
#pragma unroll
    for (int j = 0; j < 4; ++j) v[j] = *(const f32x4*)(row + 4 * lane + 256 * j);
}
__device__ __forceinline__ float row_rstd(const f32x4 (&v)[4]) {
    float s = 0.f;
#pragma unroll
    for (int j = 0; j < 4; ++j) s += (v[j][0] * v[j][0] + v[j][1] * v[j][1]) + (v[j][2] * v[j][2] + v[j][3] * v[j][3]);
    return rsqrtf(wave_sum(s) * (1.0f / 1024.0f) + RMS_EPS);
}
__device__ __forceinline__ void row_modulate(const f32x4 (&v)[4], float rstd, const RowMod& M, int lane, f32x4 (&y)[4]) {
#pragma unroll
    for (int j = 0; j < 4; ++j) { const int k = 4 * lane + 256 * j; const f32x4 g = *(const f32x4*)(M.g + k), sh = *(const f32x4*)(M.sh + k), sc = *(const f32x4*)(M.sc + k);
        y[j] = v[j] * rstd * g * (sc + 1.0f) + sh; }
}
__device__ __forceinline__ void row_store_bf(bf16* row, int lane, const f32x4 (&y)[4]) {
#pragma unroll
    for (int j = 0; j < 4; ++j) st_bf4(row + 4 * lane + 256 * j, y[j]);
}
__device__ __forceinline__ const float* mod_ptr(Frame& F, int l, int row, int which) { const int mr = row < RL ? (row >> 12) : 8; return WSP(float, WS_MOD) + ((size_t)l * 9 + mr) * 6144 + which * 1024; }

__device__ __forceinline__ void p_rowpass_a0(const Params& P, Frame& F) {
    const int gw = F.bid * NWAVES + F.wave, NGW = F.G * NWAVES; bf16* H = WSP(bf16, WS_H);
    f32x4 vn[4]; int row = gw;
    if (row < RT) row_load(row < RL ? P.x + (size_t)row * DM : P.ctx + (size_t)(row - RL) * DM, F.lane, vn);
    for (; row < RT; row += NGW) {
        f32x4 v[4], y[4];
#pragma unroll
        for (int j = 0; j < 4; ++j) v[j] = vn[j];
        { const int nr = row + NGW; if (nr < RT) row_load(nr < RL ? P.x + (size_t)nr * DM : P.ctx + (size_t)(nr - RL) * DM, F.lane, vn); }
        const float rs = row_rstd(v);
        RowMod M{P.norm1_g, mod_ptr(F, 0, row, 0), mod_ptr(F, 0, row, 1)};
        row_modulate(v, rs, M, F.lane, y); row_store_bf(H + (size_t)row * DM, F.lane, y);
    }
}
__device__ __forceinline__ void p_rowpass_f(const Params& P, Frame& F, int l, int nrows) {
    const int gw = F.bid * NWAVES + F.wave, NGW = F.G * NWAVES; bf16* H = WSP(bf16, WS_H); float* AFF = WSP(float, WS_AFF);
    const float* wr = P.w_router + (size_t)l * 1024 * 16;
    LAS float* wl = (LAS float*)F.lds;
    __syncthreads();
    for (int i = F.tid; i < 16384; i += NTHREADS) wl[(i & 15) * 1024 + (i >> 4)] = wr[i];
    __syncthreads();
    f32x4 vn[4]; int row = gw;
    if (row < nrows) row_load(row < RL ? P.out + (size_t)row * DM : WSP(float, WS_XC) + (size_t)(row - RL) * DM, F.lane, vn);
    for (; row < nrows; row += NGW) {
        f32x4 v[4], y[4];
#pragma unroll
        for (int j = 0; j < 4; ++j) v[j] = vn[j];
        { const int nr = row + NGW; if (nr < nrows) row_load(nr < RL ? P.out + (size_t)nr * DM : WSP(float, WS_XC) + (size_t)(nr - RL) * DM, F.lane, vn); }
        const float rs = row_rstd(v);
        RowMod M{P.norm2_g + l * 1024, mod_ptr(F, l, row, 3), mod_ptr(F, l, row, 4)};
        row_modulate(v, rs, M, F.lane, y); row_store_bf(H + (size_t)row * DM, F.lane, y);
        float lg[16];
        int wo = 4 * F.lane; asm volatile("" : "+v"(wo));
#pragma unroll
        for (int e = 0; e < 16; ++e) { float a = 0.f;
#pragma unroll
            for (int j = 0; j < 4; ++j) { const f32x4 w = *(const LAS f32x4*)(wl + e * 1024 + wo + 256 * j); a += (y[j][0] * w[0] + y[j][1] * w[1]) + (y[j][2] * w[2] + y[j][3] * w[3]); }
            lg[e] = a; }
        float mx = -1e30f;
#pragma unroll
        for (int e = 0; e < 16; ++e) { lg[e] = wave_sum(lg[e]); mx = fmaxf(mx, lg[e]); }
        float den = 0.f;
#pragma unroll
        for (int e = 0; e < 16; ++e) { lg[e] = __expf(lg[e] - mx); den += lg[e]; }
        const float inv = 1.0f / den;
        if (F.lane < 16) { float mine = 0.f;
#pragma unroll
            for (int e = 0; e < 16; ++e) mine = (F.lane == e) ? lg[e] : mine;
            AFF[(size_t)row * 16 + F.lane] = mine * inv; }
    }
    __syncthreads();
}
__device__ __forceinline__ void p_rowpass_k(const Params& P, Frame& F, int l, int nrows) {
    const int gw = F.bid * NWAVES + F.wave, NGW = F.G * NWAVES; bf16* H = WSP(bf16, WS_H);
    const int* SEL = WSP(int, WS_SEL); const bf16* Y = WSP(bf16, WS_Y);
    f32x4 vn[4]; int seln = -1; int row = gw;
    if (row < nrows) { row_load(row < RL ? P.out + (size_t)row * DM : WSP(float, WS_XC) + (size_t)(row - RL) * DM, F.lane, vn); seln = F.lane < 16 ? SEL[(size_t)row * 16 + F.lane] : -1; }
    for (; row < nrows; row += NGW) {
        float* xr = row < RL ? P.out + (size_t)row * DM : WSP(float, WS_XC) + (size_t)(row - RL) * DM;
        f32x4 v[4], a[4]; const int sel = seln;
#pragma unroll
        for (int j = 0; j < 4; ++j) { v[j] = vn[j]; a[j] = (f32x4){0.f, 0.f, 0.f, 0.f}; }
        { const int nr = row + NGW; if (nr < nrows) { row_load(nr < RL ? P.out + (size_t)nr * DM : WSP(float, WS_XC) + (size_t)(nr - RL) * DM, F.lane, vn); seln = F.lane < 16 ? SEL[(size_t)nr * 16 + F.lane] : -1; } }
        unsigned em = (unsigned)__ballot(sel >= 0) & 0xffffu;
        while (em) { const int e = __builtin_ctz(em); em &= em - 1; const int s = __builtin_amdgcn_readlane(sel, e); const bf16* yr = Y + (size_t)s * DM;
#pragma unroll
            for (int j = 0; j < 4; ++j) { const u32x2 w = *(const u32x2*)(yr + 4 * F.lane + 256 * j); a[j][0] += bflo(w.x); a[j][1] += bfhi(w.x); a[j][2] += bflo(w.y); a[j][3] += bfhi(w.y); } }
        const float* g2 = mod_ptr(F, l, row, 5);
#pragma unroll
        for (int j = 0; j < 4; ++j) { const f32x4 g = *(const f32x4*)(g2 + 4 * F.lane + 256 * j); v[j] = v[j] + g * a[j]; }
        const float rs = row_rstd(v);
        if (l == 0) {
#pragma unroll
            for (int j = 0; j < 4; ++j) *(f32x4*)(xr + 4 * F.lane + 256 * j) = v[j];
            f32x4 y[4]; RowMod M{P.norm1_g + 1024, mod_ptr(F, 1, row, 0), mod_ptr(F, 1, row, 1)};
            row_modulate(v, rs, M, F.lane, y); row_store_bf(H + (size_t)row * DM, F.lane, y);
        } else {
#pragma unroll
            for (int j = 0; j < 4; ++j) { const f32x4 g = *(const f32x4*)(P.final_g + 4 * F.lane + 256 * j); *(f32x4*)(xr + 4 * F.lane + 256 * j) = v[j] * rs * g; }
        }
    }
}

constexpr int ACK_STRIDE = 72, ACV_STRIDE = 264;
constexpr int ALDS_CK = 0, ALDS_CV = 256 * ACK_STRIDE * 2, ALDS_RP = ALDS_CV + 64 * ACV_STRIDE * 2;
struct AttnState { float m, sum; f32x4 o[4]; };
__device__ __forceinline__ float xrow16_max(float x) {
    auto s = __builtin_amdgcn_permlane16_swap(__float_as_uint(x), __float_as_uint(x), false, false);
    x = fmaxf(__uint_as_float(s[0]), __uint_as_float(s[1]));
    auto t = __builtin_amdgcn_permlane32_swap(__float_as_uint(x), __float_as_uint(x), false, false);
    return fmaxf(__uint_as_float(t[0]), __uint_as_float(t[1]));
}
__device__ __forceinline__ float xrow16_sum(float x) {
    auto s = __builtin_amdgcn_permlane16_swap(__float_as_uint(x), __float_as_uint(x), false, false);
    x = __uint_as_float(s[0]) + __uint_as_float(s[1]);
    auto t = __builtin_amdgcn_permlane32_swap(__float_as_uint(x), __float_as_uint(x), false, false);
    return __uint_as_float(t[0]) + __uint_as_float(t[1]);
}
#define MFMA16(a, b, c) __builtin_amdgcn_mfma_f32_16x16x32_bf16((a), (b), (c), 0, 0, 0)
template <int NT>
__device__ __forceinline__ void attn_tail(AttnState& S, f32x4 (&sc)[NT], const u32x4 (&vw)[NT / 2][4]) {
    float cm = -1e30f;
#pragma unroll
    for (int t = 0; t < NT; ++t)
#pragma unroll
        for (int j = 0; j < 4; ++j) cm = fmaxf(cm, sc[t][j]);
    cm = xrow16_max(cm);
    const float mn = fmaxf(S.m, cm), scl = __builtin_amdgcn_exp2f(S.m - mn); S.m = mn; float ps = 0.f;
#pragma unroll
    for (int t = 0; t < NT; ++t)
#pragma unroll
        for (int j = 0; j < 4; ++j) { const float p = __builtin_amdgcn_exp2f(sc[t][j] - mn); sc[t][j] = p; ps += p; }
    S.sum = S.sum * scl + ps;
#pragma unroll
    for (int dt = 0; dt < 4; ++dt) S.o[dt] = S.o[dt] * scl;
#pragma unroll
    for (int ks = 0; ks < NT / 2; ++ks) { u32x4 pw; pw.x = pk2(sc[2 * ks][0], sc[2 * ks][1]); pw.y = pk2(sc[2 * ks][2], sc[2 * ks][3]); pw.z = pk2(sc[2 * ks + 1][0], sc[2 * ks + 1][1]); pw.w = pk2(sc[2 * ks + 1][2], sc[2 * ks + 1][3]);
        const bf16x8 pf = __builtin_bit_cast(bf16x8, pw);
#pragma unroll
        for (int dt = 0; dt < 4; ++dt) S.o[dt] = MFMA16(__builtin_bit_cast(bf16x8, vw[ks][dt]), pf, S.o[dt]); }
}
__device__ __forceinline__ void attn_unit2(const bf16* __restrict__ KQ, const bf16* __restrict__ VT, bf16* __restrict__ ATT, LAS unsigned char* lds,
                                           const int b, const int h, const int rowqA, const int rowqB, const bool win, const int r, const int qt, const int lane) {
    const int l15 = lane & 15, g = lane >> 4;
    const f32x4 z = {0.f, 0.f, 0.f, 0.f};
    bf16x8 qA[2], qB[2];
    { const bf16* qp = KQ + (size_t)(rowqA + l15) * 2048 + 1024 + h * 64 + 8 * g; qA[0] = *(const bf16x8*)qp; qA[1] = *(const bf16x8*)(qp + 32); }
    { const bf16* qp = KQ + (size_t)(rowqB + l15) * 2048 + 1024 + h * 64 + 8 * g; qB[0] = *(const bf16x8*)qp; qB[1] = *(const bf16x8*)(qp + 32); }
    AttnState SA, SB; SA.m = -1e30f; SA.sum = 0.f; SB.m = -1e30f; SB.sum = 0.f;
#pragma unroll
    for (int dt = 0; dt < 4; ++dt) { SA.o[dt] = z; SB.o[dt] = z; }
    if (win) {
        const int rsA = min(max(r - 4, 0), 56), dB = min(max(r - 3, 0), 56) - rsA, kc0 = min(max(16 * qt - 8, 0), 32);
        const int q = 16 * qt + l15, csq = min(max(q - 8, 0), 48);
        const int krow0 = 8 * (l15 >> 2) + (l15 & 3);
        const bf16* kb = KQ + (size_t)(b * SEQ + kc0 + krow0) * 2048 + h * 64 + 8 * g;
        const bf16* vb = VT + (size_t)(b * 1024 + h * 64 + l15) * 4096 + kc0 + 8 * g;
        const LAS float* rp = (const LAS float*)(lds + ALDS_RP);
        const int jb = kc0 + 8 * g;
        const int okb = jb - csq;
        const LAS float* rpl = rp + 16 + (jb - q + 15);
        float madd[2][4];
#pragma unroll
        for (int t = 0; t < 2; ++t)
#pragma unroll
            for (int j = 0; j < 4; ++j) madd[t][j] = ((unsigned)(okb + 4 * t + j) < 16u) ? 0.f : -__builtin_inff();
        bf16x8 K0[2][2], K1[2][2]; u32x4 V0[1][4], V1[1][4];
#define ATT_LOADW(KB, VB, i) do { const int gr_ = min(rsA + (i), 63); const bf16* kp_ = kb + (size_t)(gr_ * 64) * 2048; const bf16* vp_ = vb + gr_ * 64; \
        _Pragma("unroll") for (int t = 0; t < 2; ++t) { KB[t][0] = *(const bf16x8*)(kp_ + (size_t)(4 * t) * 2048); KB[t][1] = *(const bf16x8*)(kp_ + (size_t)(4 * t) * 2048 + 32); } \
        _Pragma("unroll") for (int dt = 0; dt < 4; ++dt) VB[0][dt] = *(const u32x4*)(vp_ + (size_t)(16 * dt) * 4096); } while (0)
#define ATT_ONE(ST, QF, KB, VB, roff, rowok) do { f32x4 sc[2]; \
        _Pragma("unroll") for (int t = 0; t < 2; ++t) { sc[t] = MFMA16(KB[t][0], QF[0], z); sc[t] = MFMA16(KB[t][1], QF[1], sc[t]); } \
        const LAS float* bp_ = rpl + ((rowok) ? (roff) : 15) * 64; \
        _Pragma("unroll") for (int t = 0; t < 2; ++t) _Pragma("unroll") for (int j = 0; j < 4; ++j) sc[t][j] = (sc[t][j] + bp_[4 * t + j]) + madd[t][j]; \
        attn_tail<2>(ST, sc, VB); } while (0)
#define ATT_COMPUTE(KB, VB, i) do { const int roffA_ = min(rsA + (i) - r + 7, 14); \
        ATT_ONE(SA, qA, KB, VB, roffA_, (i) <= 7); \
        ATT_ONE(SB, qB, KB, VB, max(roffA_ - 1, 0), (i) >= dB && (i) <= 7 + dB); } while (0)
        ATT_LOADW(K0, V0, 0);
#pragma unroll 1
        for (int i = 0; i < 8; i += 2) { ATT_LOADW(K1, V1, i + 1); ATT_COMPUTE(K0, V0, i); ATT_LOADW(K0, V0, i + 2); ATT_COMPUTE(K1, V1, i + 1); }
        ATT_COMPUTE(K0, V0, 8);
#undef ATT_LOADW
#undef ATT_ONE
#undef ATT_COMPUTE
    }
    { const LAS bf16* ck = (const LAS bf16*)(lds + ALDS_CK) + l15 * ACK_STRIDE + 8 * g;
      const LAS bf16* cv = (const LAS bf16*)(lds + ALDS_CV) + l15 * ACV_STRIDE + 8 * g;
#pragma unroll 1
      for (int c = 0; c < 4; ++c) {
          bf16x8 kf[4][2]; u32x4 vw[2][4];
#pragma unroll
          for (int t = 0; t < 4; ++t) { const LAS bf16* kp = ck + (64 * c + 16 * t) * ACK_STRIDE; kf[t][0] = *(const LAS bf16x8*)kp; kf[t][1] = *(const LAS bf16x8*)(kp + 32); }
#pragma unroll
          for (int ks = 0; ks < 2; ++ks)
#pragma unroll
              for (int dt = 0; dt < 4; ++dt) vw[ks][dt] = *(const LAS u32x4*)(cv + (16 * dt) * ACV_STRIDE + 64 * c + 32 * ks);
          { f32x4 sc[4];
#pragma unroll
            for (int t = 0; t < 4; ++t) { sc[t] = MFMA16(kf[t][0], qA[0], z); sc[t] = MFMA16(kf[t][1], qA[1], sc[t]); }
            attn_tail<4>(SA, sc, vw); }
          { f32x4 sc[4];
#pragma unroll
            for (int t = 0; t < 4; ++t) { sc[t] = MFMA16(kf[t][0], qB[0], z); sc[t] = MFMA16(kf[t][1], qB[1], sc[t]); }
            attn_tail<4>(SB, sc, vw); }
      } }
    { const float inv = 1.0f / xrow16_sum(SA.sum);
#pragma unroll
      for (int dt = 0; dt < 4; ++dt) st_bf4(ATT + (size_t)(rowqA + l15) * 1024 + h * 64 + 16 * dt + 4 * g, SA.o[dt] * inv); }
    { const float inv = 1.0f / xrow16_sum(SB.sum);
#pragma unroll
      for (int dt = 0; dt < 4; ++dt) st_bf4(ATT + (size_t)(rowqB + l15) * 1024 + h * 64 + 16 * dt + 4 * g, SB.o[dt] * inv); }
}
__device__ __forceinline__ void p_attn_mfma(const Params& P, Frame& F, int l, bool with_ctx_queries) {
    const bf16* KQ = WSP(bf16, WS_KQ); const bf16* VT = WSP(bf16, WS_VT); bf16* ATT = WSP(bf16, WS_ATT);
    const float* rpb = P.rpb + (size_t)l * 16 * 465;
    for (int hp = F.bid; hp < 256; hp += F.G) {
        const int p = hp & 127, half = hp >> 7, b = p >> 4, h = p & 15;
        __syncthreads();
        { LAS bf16* ck = (LAS bf16*)(F.lds + ALDS_CK); LAS bf16* cv = (LAS bf16*)(F.lds + ALDS_CV); LAS float* rp = (LAS float*)(F.lds + ALDS_RP);
          { const int key = F.tid >> 1, hf = F.tid & 1; const int k32 = key & 31, pos = (key & ~31) + ((k32 >> 2) & 1) * 16 + 4 * (k32 >> 3) + (k32 & 3);
            const u32x4* src = (const u32x4*)(KQ + (size_t)(RL + b * CTXL + key) * 2048 + h * 64 + hf * 32); LAS u32x4* dst = (LAS u32x4*)(ck + pos * ACK_STRIDE + hf * 32);
#pragma unroll
            for (int i = 0; i < 4; ++i) dst[i] = src[i]; }
          { const int d = F.tid >> 3, sg = F.tid & 7; const u32x4* src = (const u32x4*)(VT + YT_CTX_OFF + (size_t)(b * 1024 + h * 64 + d) * 256 + sg * 32); LAS u32x4* dst = (LAS u32x4*)(cv + d * ACV_STRIDE + sg * 32);
#pragma unroll
            for (int i = 0; i < 4; ++i) dst[i] = src[i]; }
          for (int i = F.tid; i < 16 * 64; i += NTHREADS) { const int rr = i >> 6, cc = (i & 63) - 16; rp[i] = rr == 15 ? -__builtin_inff() : ((cc >= 0 && cc < 31) ? rpb[h * 465 + rr * 31 + cc] * LOG2E : 0.f); } }
        __syncthreads();
        const int qt = F.wave & 3, rpi = F.wave >> 2;
#pragma unroll 1
        for (int st = 0; st < 8; ++st) { const int r = half * 32 + st * 4 + rpi * 2; const int rowqA = b * SEQ + r * 64 + 16 * qt;
            attn_unit2(KQ, VT, ATT, F.lds, b, h, rowqA, rowqA + 64, true, r, qt, F.lane); }
        if (with_ctx_queries && half == 0) { const int rowqA = RL + b * CTXL + 32 * F.wave; attn_unit2(KQ, VT, ATT, F.lds, b, h, rowqA, rowqA + 16, false, 0, 0, F.lane); }
    }
    __syncthreads();
}

__device__ __forceinline__ void ld8(const bf16* p, float (&x)[8]) { const u32x4 w = *(const u32x4*)p;
#pragma unroll
    for (int q = 0; q < 4; ++q) { x[2 * q] = bflo(w[q]); x[2 * q + 1] = bfhi(w[q]); } }
__device__ __forceinline__ void p_pool(Frame& F, int nrows) {
    const bf16* PB = WSP(bf16, WS_PB); bf16* POOL = WSP(bf16, WS_POOL);
    for (int i = F.bid * NTHREADS + F.tid; i < (nrows >> 4) * 64; i += F.G * NTHREADS) {
        const int row0 = (i >> 6) << 4, ch = i & 63, g = ch >> 4, hw = 1 << g;
        int base, t0, Lb; if (row0 < RL) { base = row0 & ~4095; t0 = row0 & 4095; Lb = SEQ; } else { const int rr = row0 - RL; base = RL + (rr & ~255); t0 = rr & 255; Lb = CTXL; }
        const bf16* src = PB + (size_t)base * 512 + ch * 8;
        float S[8];
#pragma unroll
        for (int q = 0; q < 8; ++q) S[q] = 0.f;
#pragma unroll 4
        for (int d = -8; d < 8; ++d) { const int tt = t0 + d; if (d >= -hw && d < hw && tt >= 0 && tt < Lb) { float x[8]; ld8(src + (size_t)tt * 512, x);
#pragma unroll
                for (int q = 0; q < 8; ++q) S[q] += x[q]; } }
#pragma unroll 2
        for (int j = 0; j < 16; ++j) { const int t = t0 + j; const int lo = max(t - hw, 0), hi = min(t + hw, Lb); const float inv = 1.0f / (float)(hi - lo);
            float me[8]; ld8(src + (size_t)t * 512, me);
            u32x4 o;
#pragma unroll
            for (int q = 0; q < 4; ++q) o[q] = pk2(S[2 * q] * inv - me[2 * q], S[2 * q + 1] * inv - me[2 * q + 1]);
            *(u32x4*)(POOL + (size_t)(base + t) * 512 + ch * 8) = o;
            if (t + hw < Lb) { float x[8]; ld8(src + (size_t)(t + hw) * 512, x);
#pragma unroll
                for (int q = 0; q < 8; ++q) S[q] += x[q]; }
            if (t - hw >= 0) { float x[8]; ld8(src + (size_t)(t - hw) * 512, x);
#pragma unroll
                for (int q = 0; q < 8; ++q) S[q] -= x[q]; } }
    }
}

__device__ __forceinline__ int block_sum_i(int v, LAS int* sm, int tid) {
    v = wave_sum_i(v);
    __syncthreads();
    if ((tid & 63) == 0) sm[tid >> 6] = v;
    __syncthreads();
    int s = 0;
#pragma unroll
    for (int i = 0; i < 8; ++i) s += sm[i];
    return s;
}
__device__ __forceinline__ int block_excl_scan(int v, LAS int* sm, int tid, int& total) {
    const int lane = tid & 63, w = tid >> 6; int inc = v;
#pragma unroll
    for (int o = 1; o < 64; o <<= 1) { const int t = __builtin_amdgcn_ds_bpermute(((lane - o) & 63) << 2, inc); if (lane >= o) inc += t; }
    __syncthreads();
    if (lane == 63) sm[w] = inc;
    __syncthreads();
    int base = 0; total = 0;
#pragma unroll
    for (int i = 0; i < 8; ++i) { const int s = sm[i]; if (i < w) base += s; total += s; }
    return base + inc - v;
}
template <int NPT>
__device__ __forceinline__ void topk_pair(Frame& F, int row0, int n, int cap, int e, int slot0) {
    LAS int* sm = (LAS int*)F.lds;
    const float* AFF = WSP(float, WS_AFF); int* SROW = WSP(int, WS_SROW); float* SG = WSP(float, WS_SGATE); int* SEL = WSP(int, WS_SEL);
    unsigned key[NPT];
#pragma unroll
    for (int j = 0; j < NPT; ++j) { const int i = F.tid * NPT + j; key[j] = (i < n) ? __float_as_uint(AFF[(size_t)(row0 + i) * 16 + e]) : 0u; }
    unsigned T = 0u;
    for (int bit = 30; bit >= 0; --bit) { const unsigned cand = T | (1u << bit); int cnt = 0;
#pragma unroll
        for (int j = 0; j < NPT; ++j) cnt += (key[j] >= cand) ? 1 : 0;
        cnt = block_sum_i(cnt, sm, F.tid);
        if (cnt >= cap) T = cand; }
    int ngt = 0, neq = 0;
#pragma unroll
    for (int j = 0; j < NPT; ++j) { ngt += (key[j] > T) ? 1 : 0; neq += (key[j] == T) ? 1 : 0; }
    int tot_gt, tot_eq;
    (void)block_excl_scan(ngt, sm, F.tid, tot_gt);
    int eqr = block_excl_scan(neq, sm, F.tid, tot_eq);
    const int need_eq = cap - tot_gt;
    int nsel = 0; bool selj[NPT];
#pragma unroll
    for (int j = 0; j < NPT; ++j) { bool s = key[j] > T; if (key[j] == T && T != 0u) { s = eqr < need_eq; ++eqr; } selj[j] = s; nsel += s ? 1 : 0; }
    int tot_sel; int pos = block_excl_scan(nsel, sm, F.tid, tot_sel);
#pragma unroll
    for (int j = 0; j < NPT; ++j) { const int i = F.tid * NPT + j;
        if (i < n) { const int row = row0 + i;
            if (selj[j]) { const int slot = slot0 + pos; ++pos; SROW[slot] = row; SG[slot] = __uint_as_float(key[j]); SEL[(size_t)row * 16 + e] = slot; }
            else SEL[(size_t)row * 16 + e] = -1; } }
    __syncthreads();
}
__device__ __forceinline__ void p_topk(Frame& F, bool with_ctx) {
    const int npairs = 128 + (with_ctx ? 128 : 0);
    for (int pi = F.bid; pi < npairs; pi += F.G) {
        if (pi < 128) { const int b = pi >> 4, e = pi & 15; topk_pair<8>(F, b * SEQ, SEQ, CAPL, e, e * SLOT_E + b * CAPL); }
        else { const int p2 = pi - 128, b = p2 >> 4, e = p2 & 15; topk_pair<1>(F, RL + b * CTXL, CTXL, CAPC, e, e * SLOT_E + 4096 + b * CAPC); }
    }
}
template <int PH> __global__ void __launch_bounds__(NTHREADS, 2) fwd_kernel(Params P) {
    extern __shared__ __attribute__((aligned(16))) unsigned char lds_raw[];
    Frame F; F.lds = (LAS unsigned char*)lds_raw; F.tid = threadIdx.x; F.lane = F.tid & 63; F.wave = __builtin_amdgcn_readfirstlane(F.tid >> 6); F.G = gridDim.x; F.bid = blockIdx.x; F.ws = P.ws;
    const int wave0 = __builtin_amdgcn_readfirstlane((int)threadIdx.x >> 6);
    volatile LAS unsigned* MISC = (volatile LAS unsigned*)(F.lds + LDS_MISC);
    if (F.tid < 64) MISC[F.tid] = 0u;
    __syncthreads();
    XcdBarrier bar; bar.bar = WSP(unsigned, WS_CTL) + CW_BAR; bar.x = 0; bar.st = MISC + 8;
    if constexpr (PH < 0) bar = xcd_barrier_post(WSP(unsigned, WS_CTL) + CW_BAR, MISC + 8);
#define IN(k) (PH < 0 || PH == (k))
#define REFRESH() do { unsigned on_ = ~0u; asm volatile("" : "+s"(on_)); int t_ = wave0 * 64 + (int)__builtin_amdgcn_mbcnt_hi(on_, __builtin_amdgcn_mbcnt_lo(on_, 0u)); asm volatile("" : "+v"(t_)); F.tid = t_; F.lane = t_ & 63; F.wave = __builtin_amdgcn_readfirstlane(t_ >> 6); } while (0)
#define SEAM(k) do { if constexpr (PH < 0) xcd_barrier(bar); } while (0)

    if (IN(0)) { REP_BEGIN(100) p_mod(P, F); p_dftgen(F); REP_END REP_BEGIN(101) p_wconv(P, F, 0); REP_END }
    SEAM(0);
    if (IN(1)) { p_rowpass_a0(P, F); }
    SEAM(1);
    for (int l = P.l_lo; l < P.l_hi; ++l) {
        constexpr int pb = 2; const bool L0 = (l == 0);
        bf16* H = WSP(bf16, WS_H);
        if (IN(pb + 0)) { REFRESH(); REP_BEGIN(2)
            { GroupSched S; S.init(1, 128, 22, F.G, F.bid, 8, L0 ? 22 : 4, 128, 0);
              const bf16* WA = WSP(bf16, WS_WA);
              auto AD = [=](const Unit& u) { return Operands{H + (size_t)u.pm * 256 * DM, WA + (size_t)u.pn * 256 * DM, DM, DM, 0, DM}; };
              bf16* KQ = WSP(bf16, WS_KQ); bf16* PBp = WSP(bf16, WS_PB); bf16* GB = WSP(bf16, WS_GB);
              auto E = [=](EPI_ARGS) { const int row0 = u.pm * 256;
                  if (u.pn < 8) { const float qs = (u.pn >= 4) ? QSCALE : 1.0f; EPI_FOR8( st_bf8(KQ + (size_t)(row0 + r) * 2048 + u.pn * 256 + c, v0 * qs, v1 * qs); ) }
                  else if (u.pn < 10) { EPI_FOR8( st_bf8(PBp + (size_t)(row0 + r) * 512 + (u.pn - 8) * 256 + c, v0, v1); ) }
                  else { EPI_FOR8( f32x4 s0; f32x4 s1; _Pragma("unroll") for (int j = 0; j < 4; ++j) { s0[j] = sigmoidf_(v0[j]); s1[j] = sigmoidf_(v1[j]); } st_bf8(GB + (size_t)(row0 + r) * 3072 + (u.pn - 10) * 256 + c, s0, s1); ) } };
              GEMM_P(S, AD, E); }
            REFRESH();
            { GroupSched S; const int g1a_units = 128 * 22 + 8 * (L0 ? 22 : 4);
              S.init(1, 8, 128, F.G, (F.bid + F.G - ((g1a_units % F.G) & ~7)) % F.G, L0 ? 8 : 4, 8, L0 ? 0 : 4, 128);
              const bf16* WFV = WSP(bf16, WS_WFV);
              auto AD = [=](const Unit& u) { const bool fmap = (u.pm < 4) && (u.pn < 128); const int t16 = u.pn & 15;
                  const size_t tok0 = fmap ? (size_t)(u.pn >> 4) * SEQ + 64 * ((t16 >> 1) * 8) + (t16 & 1) * 32 : (size_t)u.pn * 256;
                  return Operands{WFV + (size_t)u.pm * 256 * DM, H + tok0 * DM, DM, DM, 0, DM, fmap ? 1 : 0}; };
              bf16* YT = WSP(bf16, WS_YT); bf16* VT = WSP(bf16, WS_VT);
              auto E = [=](EPI_ARGS) { bf16* T = (u.pm < 4) ? YT : VT; const int rr0 = (u.pm & 3) * 256;
                  if (u.pn < 128) { const int b = u.pn >> 4;
                      if (u.pm < 4) { const int t16 = u.pn & 15, l10 = (t16 >> 1) * 8, l20 = (t16 & 1) * 32;
                          EPI_FOR8( const int fc = rr0 + r; st_bf8(T + (((((size_t)b * 512 + (fc >> 1)) * 32 + (c >> 3)) * 2 + (l20 >> 5)) * 2 + (fc & 1)) * 64 + l10, v0, v1); ) }
                      else { const int l0 = (u.pn & 15) * 256; EPI_FOR8( st_bf8(T + ((size_t)b * 1024 + rr0 + r) * 4096 + l0 + c, v0, v1); ) } }
                  else { const int b = u.pn - 128; EPI_FOR8( st_bf8(T + YT_CTX_OFF + ((size_t)b * 1024 + rr0 + r) * 256 + c, v0, v1); ) } };
              GEMM_P(S, AD, E); }
        REP_END }
        SEAM(pb + 0);
        if (IN(pb + 1)) { REFRESH();
            REP_BEGIN(31) p_attn_mfma(P, F, l, L0); REP_END
            REFRESH();
            REP_BEGIN(32)
            { LAS float* tw = (LAS float*)(F.lds + LDS_TW);
              for (int j = F.tid; j < 4096; j += NTHREADS) tw[j] = cospif((float)j * (1.0f / 2048.0f));
              __syncthreads();
              GroupSched S; S.init(1, 1, 512, F.G, F.bid);
              const bf16* M1 = WSP(bf16, WS_M1T); const bf16* YF = WSP(bf16, WS_YT); bf16* ZP = WSP(bf16, WS_ZP);
              auto AD = [=](const Unit& u) { return Operands{M1, YF + (size_t)u.pn * 256 * 256, 256, 256, 0, 256}; };
              auto E = [=](EPI_ARGS) {
                  const int b = u.pn >> 6, gm0 = (u.pn & 63) * 8 + wc, l20 = 32 * wr + 8 * fq;
#pragma unroll
                  for (int m = 0; m < 4; ++m) { const int k1 = 16 * m + fr;
#pragma unroll
                      for (int bj = 0; bj < 2; ++bj) { const int gm = gm0 + 4 * bj;
                          f32x4 zr[2], zi[2];
#pragma unroll
                          for (int n = 0; n < 2; ++n)
#pragma unroll
                              for (int j = 0; j < 4; ++j) { const int ix = k1 * (l20 + 4 * n + j); const float tc = tw[ix], ts = tw[(ix + 3072) & 4095];
                                  const float ur = acc[0][bj][m][n][j], ui = acc[1][bj][m][n][j]; zr[n][j] = ur * tc - ui * ts; zi[n][j] = ur * ts + ui * tc; }
                          bf16* dst = ZP + (((((size_t)b * 64 + k1) * 128 + (gm & 127)) * 4 + (gm >> 7)) * 2) * 64 + l20;
                          st_bf8(dst, zr[0], zr[1]); st_bf8(dst + 64, zi[0], zi[1]); } } };
              GEMM_P(S, AD, E); }
            REP_END
        }
        SEAM(pb + 1);
        if (IN(pb + 10)) { REFRESH();
            { GroupSched S; S.init(1, 1, 256, F.G, F.bid);
              const bf16* M2 = WSP(bf16, WS_M2T); const bf16* ZP = WSP(bf16, WS_ZP); bf16* FOUR = WSP(bf16, WS_FOUR);
              auto AD = [=](const Unit& u) { return Operands{M2, ZP + (size_t)u.pn * 256 * 512, 512, 512, 0, 512}; };
              auto E = [=](EPI_ARGS) { const float sc = 0.0013810679320049757f;
#pragma unroll
                  for (int ai = 0; ai < 2; ++ai)
#pragma unroll
                      for (int m = 0; m < 4; ++m) { const int q = 2 * ai + wr, k2 = 16 * m + fr;
#pragma unroll
                          for (int bj = 0; bj < 2; ++bj) { const int bk = u.pn * 2 + bj, b = bk >> 6, k1 = bk & 63;
                              st_bf8(FOUR + ((size_t)b * SEQ + k1 + 64 * k2) * 512 + q * 128 + wc * 32 + 8 * fq, acc[ai][bj][m][0] * sc, acc[ai][bj][m][1] * sc); } } };
              GEMM_P(S, AD, E); }
            REFRESH();
            if (L0) { GroupSched S; S.init(1, 1, 16, F.G, (F.bid + F.G - 128 % F.G) % F.G);
              const bf16* DFTC = WSP(bf16, WS_DFTC); const bf16* YTC = WSP(bf16, WS_YT) + YT_CTX_OFF; bf16* FOUR = WSP(bf16, WS_FOUR);
              auto AD = [=](const Unit& u) { return Operands{DFTC, YTC + (size_t)u.pn * 256 * 512, 512, 512, 0, 512}; };
              auto E = [=](EPI_ARGS) { const int b = u.pn >> 1, c0 = (u.pn & 1) * 256; const float sc = 0.005524271728019903f;
                  EPI_FOR8( st_bf8(FOUR + ((size_t)RL + b * CTXL + r) * 512 + c0 + c, v0 * sc, v1 * sc); ) };
              GEMM_P(S, AD, E); }
            REFRESH();
            REP_BEGIN(33) p_pool(F, L0 ? RT : RL); REP_END
        }
        SEAM(pb + 10);
        if (IN(pb + 2)) { REFRESH();
            SegSched<3> S; S.base.init(1, L0 ? 136 : 128, 4, F.G, F.bid);
            const bf16* ATT = WSP(bf16, WS_ATT); const bf16* FOUR = WSP(bf16, WS_FOUR); const bf16* POOL = WSP(bf16, WS_POOL);
            const bf16* WAO = WSP(bf16, WS_WAO); const bf16* WFO = WSP(bf16, WS_WFO); const bf16* WPO = WSP(bf16, WS_WPO);
            const bf16* GB = WSP(bf16, WS_GB); bf16* MRGB = WSP(bf16, WS_MRGB); const float* ps = P.pool_scale + l * 1024;
            auto AD = [=](const Unit& u) {
                if (u.seg == 0) return Operands{ATT + (size_t)u.pm * 256 * 1024, WAO + (size_t)u.pn * 256 * 1024, 1024, 1024, 0, 1024};
                if (u.seg == 1) return Operands{FOUR + (size_t)u.pm * 256 * 512, WFO + (size_t)u.pn * 256 * 512, 512, 512, 0, 512};
                return Operands{POOL + (size_t)u.pm * 256 * 512 + (u.pn >> 1) * 256, WPO + (size_t)u.pn * 256 * 256, 512, 256, 0, 256}; };
            auto E = [=](EPI_ARGS) {
                const int kd = u.seg < 2 ? u.seg + 1 : 2; const bool fin = (u.seg == 2); const int colb = u.pn * 256 + wc * 32 + 8 * fq;
#pragma unroll
                for (int ai = 0; ai < 2; ++ai)
#pragma unroll
                    for (int m = 0; m < 4; ++m) { const size_t row = (size_t)u.pm * 256 + ai * 128 + wr * 64 + m * 16 + fr; const bf16* gr = GB + row * 3072 + colb;
                        u32x4 nr[2], dr[2]; f32x4 psv[2][2];
#pragma unroll
                        for (int bj = 0; bj < 2; ++bj) { nr[bj] = *(const u32x4*)(gr + u.seg * 1024 + bj * 128); dr[bj] = *(const u32x4*)(gr + kd * 1024 + bj * 128);
                            psv[bj][0] = *(const f32x4*)(ps + colb + bj * 128); psv[bj][1] = *(const f32x4*)(ps + colb + bj * 128 + 4); }
#pragma unroll
                        for (int bj = 0; bj < 2; ++bj) { f32x4 o[2];
#pragma unroll
                            for (int n = 0; n < 2; ++n) { f32x4 nu = {bflo(nr[bj][2 * n]), bfhi(nr[bj][2 * n]), bflo(nr[bj][2 * n + 1]), bfhi(nr[bj][2 * n + 1])}, de = {bflo(dr[bj][2 * n]), bfhi(dr[bj][2 * n]), bflo(dr[bj][2 * n + 1]), bfhi(dr[bj][2 * n + 1])};
                                if (u.seg == 2) nu = nu * psv[bj][n];
                                de = de * psv[bj][n];
#pragma unroll
                                for (int j = 0; j < 4; ++j) { const float nj = (fabsf(nu[j]) < 1e-30f) ? copysignf(1e-30f, nu[j]) : nu[j]; const float dj = (fabsf(de[j]) < 1e-30f) ? copysignf(1e-30f, de[j]) : de[j];
                                    o[n][j] = acc[ai][bj][m][n][j] * nj * (fin ? 1.0f : __builtin_amdgcn_rcpf(dj)); }
                                acc[ai][bj][m][n] = o[n]; }
                            if (fin) st_bf8(MRGB + row * 1024 + colb + bj * 128, o[0], o[1]); } } };
            gemm_fast<false, true>(F.lds, F.tid, S, AD, mk_epi_seg(E, 2), nullptr);
        }
        SEAM(pb + 2);
        if (IN(pb + 3)) { REFRESH();
            GroupSched S; S.init(1, L0 ? 136 : 128, 4, F.G, F.bid); const bf16* A = WSP(bf16, WS_MRGB); const bf16* W = WSP(bf16, WS_WOUT);
            const float* xin = L0 ? P.x : P.out; const float* cin = L0 ? P.ctx : WSP(float, WS_XC); float* xo = P.out; float* co = WSP(float, WS_XC);
            const float* MOD = WSP(float, WS_MOD) + (size_t)l * 9 * 6144;
            auto AD = [=](const Unit& u) { return Operands{A + (size_t)u.pm * 256 * 1024, W + (size_t)u.pn * 256 * 1024, 1024, 1024, 0, 1024}; };
            auto E = [=](EPI_ARGS) {
                const int row0 = u.pm * 256, mr = row0 < RL ? (row0 >> 12) : 8, colb = u.pn * 256 + wc * 32 + 4 * fq;
                const float* src0 = row0 < RL ? xin + (size_t)row0 * DM : cin + (size_t)(row0 - RL) * DM; float* dst0 = row0 < RL ? xo + (size_t)row0 * DM : co + (size_t)(row0 - RL) * DM;
                f32x4 gv[2][2];
#pragma unroll
                for (int bj = 0; bj < 2; ++bj)
#pragma unroll
                    for (int n = 0; n < 2; ++n) gv[bj][n] = *(const f32x4*)(MOD + (size_t)mr * 6144 + 2048 + colb + bj * 128 + n * 16);
#pragma unroll
                for (int ai = 0; ai < 2; ++ai) { f32x4 xv[4][2][2];
#pragma unroll
                    for (int m = 0; m < 4; ++m) { const size_t ro = (size_t)(ai * 128 + wr * 64 + m * 16 + fr) * DM + colb;
#pragma unroll
                        for (int bj = 0; bj < 2; ++bj)
#pragma unroll
                            for (int n = 0; n < 2; ++n) xv[m][bj][n] = *(const f32x4*)(src0 + ro + bj * 128 + n * 16); }
#pragma unroll
                    for (int m = 0; m < 4; ++m) { const size_t ro = (size_t)(ai * 128 + wr * 64 + m * 16 + fr) * DM + colb;
#pragma unroll
                        for (int bj = 0; bj < 2; ++bj)
#pragma unroll
                            for (int n = 0; n < 2; ++n) *(f32x4*)(dst0 + ro + bj * 128 + n * 16) = xv[m][bj][n] + gv[bj][n] * acc[ai][bj][m][n]; } } };
            GEMM(S, AD, E, 1024, 1024, 1024);
        }
        SEAM(pb + 3);
        if (IN(pb + 4)) { REFRESH(); REP_BEGIN(6) p_rowpass_f(P, F, l, L0 ? RT : RL); REP_END }
        SEAM(pb + 4);
        if (IN(pb + 5)) { REFRESH(); REP_BEGIN(7) p_topk(F, L0); REP_END }
        SEAM(pb + 5);
        if (IN(pb + 7)) { REFRESH(); REP_BEGIN(9)
            GroupSched S; S.init(16, L0 ? 17 : 16, 22, F.G, F.bid); const bf16* W = WSP(bf16, WS_WGU); bf16* HID = WSP(bf16, WS_HID); const int* SROW = WSP(int, WS_SROW);
            auto AD = [=](const Unit& u) { return Operands{H, W + ((size_t)u.grp * 5632 + u.pn * 256) * DM, DM, DM, u.grp * SLOT_E + u.pm * 256, DM}; };
            auto E = [=](EPI_ARGS) {
#pragma unroll
                for (int ai = 0; ai < 2; ++ai)
#pragma unroll
                    for (int m = 0; m < 4; ++m) { const size_t slot = (size_t)u.grp * SLOT_E + u.pm * 256 + ai * 128 + wr * 64 + m * 16 + fr; f32x4 o[2];
#pragma unroll
                        for (int n = 0; n < 2; ++n) { const f32x4 a = acc[ai][0][m][n], up = acc[ai][1][m][n];
#pragma unroll
                            for (int j = 0; j < 4; ++j) o[n][j] = a[j] * sigmoidf_(a[j]) * up[j]; }
                        st_bf8(HID + slot * FF + u.pn * 128 + wc * 32 + 8 * fq, o[0], o[1]); } };
            GEMM_GATHER(S, AD, E, DM, DM, DM, SROW);
        REP_END }
        SEAM(pb + 7);
        if (IN(pb + 8)) { REFRESH(); REP_BEGIN(10)
            const int tpe = L0 ? 17 : 16;
            GroupSched S; S.init(1, 16 * tpe, 4, F.G, F.bid); const bf16* HID = WSP(bf16, WS_HID); const bf16* W = WSP(bf16, WS_WD); bf16* Y = WSP(bf16, WS_Y); const float* SG = WSP(float, WS_SGATE);
            auto AD = [=](const Unit& u) { const int e = u.pm / tpe, st = e * 17 + (u.pm - e * tpe); return Operands{HID + (size_t)st * 256 * FF, W + ((size_t)e * 1024 + u.pn * 256) * FF, FF, FF, 0, FF}; };
            auto E = [=](EPI_ARGS) { const int e = u.pm / tpe; const size_t slot0 = (size_t)(e * 17 + (u.pm - e * tpe)) * 256 + wr * 64 + fr; float gt[2][4];
#pragma unroll
                for (int ai = 0; ai < 2; ++ai)
#pragma unroll
                    for (int m = 0; m < 4; ++m) gt[ai][m] = SG[slot0 + ai * 128 + m * 16];
#pragma unroll
                for (int ai = 0; ai < 2; ++ai)
#pragma unroll
                    for (int m = 0; m < 4; ++m)
#pragma unroll
                        for (int bj = 0; bj < 2; ++bj) st_bf8(Y + (slot0 + ai * 128 + m * 16) * DM + u.pn * 256 + bj * 128 + wc * 32 + 8 * fq, acc[ai][bj][m][0] * gt[ai][m], acc[ai][bj][m][1] * gt[ai][m]); };
            GEMM_P(S, AD, E);
        REP_END }
        SEAM(pb + 8);
        if (IN(pb + 9)) { REFRESH(); p_rowpass_k(P, F, l, L0 ? RT : RL); if (L0) p_wconv(P, F, 1); }
        if (L0) SEAM(pb + 9);
    }
#undef IN
#undef SEAM
}
template <int PH> static void launch_ph(int grid, const Params& p, hipStream_t stream) { hipLaunchKernelGGL(fwd_kernel<PH>, dim3(grid), dim3(NTHREADS), LDS_BYTES, stream, p); }
template <int PH> static bool set_attr() { return hipFuncSetAttribute((const void*)fwd_kernel<PH>, hipFuncAttributeMaxDynamicSharedMemorySize, LDS_BYTES) == hipSuccess; }

#ifndef DUP_LAUNCH
#define DUP_LAUNCH -1
#endif
extern "C" void kernel_launch(void* const* d_in, const int* in_sizes, int n_in, void* d_out, int out_size, void* d_ws, size_t ws_size, hipStream_t stream) {
    static int grid = 0;
    if (grid == 0) {
        if (n_in != 20 || out_size != RL * DM || ws_size < WS_END) { fprintf(stderr, "kernel_launch: unexpected shapes (n_in %d out %d ws %zu need %zu)\n", n_in, out_size, ws_size, (size_t)WS_END); grid = -1; return; }
        int dev = 0, cus = 0, per_cu = 0;
        if (hipGetDevice(&dev) != hipSuccess || hipDeviceGetAttribute(&cus, hipDeviceAttributeMultiprocessorCount, dev) != hipSuccess) { grid = -1; return; }
#if N_LAUNCH_MODE == 1
        if (!set_attr<-1>()) { fprintf(stderr, "kernel_launch: hipFuncSetAttribute failed\n"); grid = -1; return; }
        if (hipOccupancyMaxActiveBlocksPerMultiprocessor(&per_cu, (const void*)fwd_kernel<-1>, NTHREADS, LDS_BYTES) != hipSuccess || per_cu < 1) fprintf(stderr, "kernel_launch: occupancy query reports %d\n", per_cu);
#else
        if (!(set_attr<0>() && set_attr<1>() && set_attr<2>() && set_attr<3>() && set_attr<12>() && set_attr<4>() && set_attr<5>() && set_attr<6>() && set_attr<7>() && set_attr<9>() && set_attr<10>() && set_attr<11>())) { fprintf(stderr, "kernel_launch: hipFuncSetAttribute failed\n"); grid = -1; return; }
        (void)per_cu;
#endif
        (void)hipGetLastError();
        grid = cus;
    }
    if (grid < 0) return;
    if (hipMemsetAsync((char*)d_ws + WS_CTL, 0, CTL_BYTES, stream) != hipSuccess) return;
    Params p{};
    const float** pp = (const float**)&p;
    for (int i = 0; i < 20; ++i) pp[i] = (const float*)d_in[i];
    p.out = (float*)d_out; p.ws = (unsigned char*)d_ws;
#if N_LAUNCH_MODE == 1
    p.l_lo = 0; p.l_hi = 2;
    launch_ph<-1>(grid, p, stream);
#else
    p.l_lo = 0; p.l_hi = 0; launch_ph<0>(grid, p, stream); if (DUP_LAUNCH == 0) launch_ph<0>(grid, p, stream); launch_ph<1>(grid, p, stream); if (DUP_LAUNCH == 1) launch_ph<1>(grid, p, stream);
#define LP(k) do { launch_ph<k>(grid, p, stream); if (DUP_LAUNCH == (k) && l == 0) launch_ph<k>(grid, p, stream); } while (0)
    for (int l = 0; l < 2; ++l) { p.l_lo = l; p.l_hi = l + 1;
        LP(2); LP(3); LP(12); LP(4); LP(5); LP(6); LP(7); LP(9); LP(10); LP(11); }
#endif
}
```

```cpp
#include <hip/hip_runtime.h>
#include <cstdio>
#include <cstdint>

#ifndef N_LAUNCH_MODE
#define N_LAUNCH_MODE 1
#endif

#define GAS __attribute__((address_space(1)))
#define LAS __attribute__((address_space(3)))
typedef unsigned short bf16;
typedef short bf16x8 __attribute__((ext_vector_type(8)));
typedef float f32x4 __attribute__((ext_vector_type(4)));
typedef unsigned u32x4 __attribute__((ext_vector_type(4)));
typedef unsigned u32x2 __attribute__((ext_vector_type(2)));

constexpr int NB = 8, SEQ = 4096, DM = 1024, CTXL = 256, NH = 16, HD = 64, GRIDW = 64;
constexpr int RL = NB * SEQ, RC = NB * CTXL, RT = RL + RC;
constexpr int INW = 7168, NE = 16, FF = 2816, CAPL = 512, CAPC = 32;
constexpr int SLOT_E = 4352, NSLOT = NE * SLOT_E;
constexpr float RMS_EPS = 1e-6f;
constexpr float LOG2E = 1.4426950408889634f, QSCALE = 0.125f * LOG2E;
constexpr int NWAVES = 8, NTHREADS = 512;

constexpr size_t al256(size_t x) { return (x + 255) & ~(size_t)255; }
constexpr size_t WS_CTL = 0, CTL_BYTES = 1u << 20;
constexpr size_t WS_MOD = WS_CTL + CTL_BYTES;
constexpr size_t WS_XC = al256(WS_MOD + (size_t)2 * 9 * 6144 * 4);
constexpr size_t WS_AFF = al256(WS_XC + (size_t)RC * DM * 4);
constexpr size_t WS_SROW = al256(WS_AFF + (size_t)RT * 16 * 4);
constexpr size_t WS_SGATE = al256(WS_SROW + (size_t)NSLOT * 4);
constexpr size_t WS_SEL = al256(WS_SGATE + (size_t)NSLOT * 4);
constexpr size_t WS_DFTM = al256(WS_SEL + (size_t)RT * 16 * 4);
constexpr size_t WS_DFTC = al256(WS_DFTM + (size_t)4096 * 8192 * 2);
constexpr size_t WS_WA = al256(WS_DFTC + (size_t)256 * 512 * 2);
constexpr size_t WS_WFV = al256(WS_WA + (size_t)5632 * 1024 * 2);
constexpr size_t WS_WAO = al256(WS_WFV + (size_t)2048 * 1024 * 2);
constexpr size_t WS_WFO = al256(WS_WAO + (size_t)1024 * 1024 * 2);
constexpr size_t WS_WPO = al256(WS_WFO + (size_t)1024 * 512 * 2);
constexpr size_t WS_WOUT = al256(WS_WPO + (size_t)1024 * 256 * 2);
constexpr size_t WS_WGU = al256(WS_WOUT + (size_t)1024 * 1024 * 2);
constexpr size_t WS_WD = al256(WS_WGU + (size_t)16 * 5632 * 1024 * 2);
constexpr size_t WS_H = al256(WS_WD + (size_t)16 * 1024 * 2816 * 2);
constexpr size_t WS_R = al256(WS_H + (size_t)RT * DM * 2);
constexpr size_t WS_KQ = WS_R;
constexpr size_t WS_MRG = WS_KQ;
constexpr size_t WS_PB = al256(WS_KQ + (size_t)RT * 2048 * 2);
constexpr size_t WS_GB = al256(WS_PB + (size_t)RT * 512 * 2);
constexpr size_t WS_YT = al256(WS_GB + (size_t)RT * 3072 * 2);
constexpr size_t WS_MRGB = WS_YT;
constexpr size_t WS_VT = al256(WS_YT + (size_t)RT * 1024 * 2);
constexpr size_t WS_FOUR = al256(WS_VT + (size_t)RT * 1024 * 2);
constexpr size_t WS_ATT = al256(WS_FOUR + (size_t)RT * 512 * 2);
constexpr size_t WS_POOL = al256(WS_ATT + (size_t)RT * 1024 * 2);
constexpr size_t WS_MIX_END = al256(WS_POOL + (size_t)RT * 512 * 2);
constexpr size_t WS_XG = WS_R;
constexpr size_t WS_HID = al256(WS_XG + (size_t)NSLOT * 1024 * 2);
constexpr size_t WS_Y = al256(WS_HID + (size_t)NSLOT * 2816 * 2);
constexpr size_t WS_MOE_END = al256(WS_Y + (size_t)NSLOT * 1024 * 2);
constexpr size_t WS_END0 = WS_MIX_END > WS_MOE_END ? WS_MIX_END : WS_MOE_END;
constexpr size_t WS_ZP = WS_END0;
constexpr size_t WS_M1T = al256(WS_ZP + ((size_t)8 * 64 * 512 * 128 + 1024) * 2);
constexpr size_t WS_M2T = al256(WS_M1T + (size_t)256 * 256 * 2);
constexpr size_t WS_END = al256(WS_M2T + (size_t)256 * 512 * 2);
constexpr size_t YT_CTX_OFF = (size_t)8 * 1024 * 4096;

constexpr int CW_BAR = 4096;

constexpr int LDS_BYTES = 155648;
constexpr int LDS_TW = 132096;
constexpr int LDS_MISC = 131072;

__device__ __forceinline__ unsigned f2bf(float f) { unsigned u = __float_as_uint(f); return (u + 0x7fffu + ((u >> 16) & 1u)) >> 16; }
typedef __bf16 hbf16x2 __attribute__((ext_vector_type(2)));
typedef float f32x2 __attribute__((ext_vector_type(2)));
__device__ __forceinline__ unsigned pk2(float lo, float hi) { const f32x2 v = {lo, hi}; return __builtin_bit_cast(unsigned, __builtin_convertvector(v, hbf16x2)); }
__device__ __forceinline__ float bf2f(unsigned b) { return __uint_as_float(b << 16); }
__device__ __forceinline__ float bflo(unsigned w) { return __uint_as_float(w << 16); }
__device__ __forceinline__ float bfhi(unsigned w) { return __uint_as_float(w & 0xffff0000u); }
template <int CTRL> __device__ __forceinline__ float dppf(float x) { return __builtin_bit_cast(float, __builtin_amdgcn_mov_dpp(__builtin_bit_cast(int, x), CTRL, 0xf, 0xf, true)); }
template <int CTRL> __device__ __forceinline__ int dppi(int x) { return __builtin_amdgcn_mov_dpp(x, CTRL, 0xf, 0xf, true); }
constexpr int DPP_XOR1 = 0xB1, DPP_XOR2 = 0x4E, DPP_ROR4 = 0x124, DPP_ROR8 = 0x128;
__device__ __forceinline__ float wave_sum(float v) {
    v += dppf<DPP_XOR1>(v); v += dppf<DPP_XOR2>(v); v += dppf<DPP_ROR4>(v); v += dppf<DPP_ROR8>(v);
    auto s = __builtin_amdgcn_permlane16_swap(__float_as_uint(v), __float_as_uint(v), false, false); v = __uint_as_float(s[0]) + __uint_as_float(s[1]);
    auto t = __builtin_amdgcn_permlane32_swap(__float_as_uint(v), __float_as_uint(v), false, false); return __uint_as_float(t[0]) + __uint_as_float(t[1]);
}
__device__ __forceinline__ float wave_max(float v) {
    v = fmaxf(v, dppf<DPP_XOR1>(v)); v = fmaxf(v, dppf<DPP_XOR2>(v)); v = fmaxf(v, dppf<DPP_ROR4>(v)); v = fmaxf(v, dppf<DPP_ROR8>(v));
    auto s = __builtin_amdgcn_permlane16_swap(__float_as_uint(v), __float_as_uint(v), false, false); v = fmaxf(__uint_as_float(s[0]), __uint_as_float(s[1]));
    auto t = __builtin_amdgcn_permlane32_swap(__float_as_uint(v), __float_as_uint(v), false, false); return fmaxf(__uint_as_float(t[0]), __uint_as_float(t[1]));
}
__device__ __forceinline__ int wave_sum_i(int v) {
    v += dppi<DPP_XOR1>(v); v += dppi<DPP_XOR2>(v); v += dppi<DPP_ROR4>(v); v += dppi<DPP_ROR8>(v);
    auto s = __builtin_amdgcn_permlane16_swap((unsigned)v, (unsigned)v, false, false); v = (int)(s[0] + s[1]);
    auto t = __builtin_amdgcn_permlane32_swap((unsigned)v, (unsigned)v, false, false); return (int)(t[0] + t[1]);
}
__device__ __forceinline__ float sigmoidf_(float x) { return __builtin_amdgcn_rcpf(1.f + __builtin_amdgcn_exp2f(x * -1.4426950408889634f)); }
#define LDS_WAIT() asm volatile("s_waitcnt lgkmcnt(0)" ::: "memory")

#define XB_TMO      128
#define XB_XCNT(j)  (256  + 64 * (j))
#define XB_XSUB(j)  (1280 + 64 * (j))
#define XB_XGEN(j)  (2304 + 64 * (j))
#define XB_TOP      3328
#define XB_TOPGEN   3392
#define XCD_BAR_WORDS 3456
#define XB_SPIN_CAP (1u << 22)

__device__ __forceinline__ unsigned xb_ld(unsigned* p)              { return __hip_atomic_load(p, __ATOMIC_RELAXED, __HIP_MEMORY_SCOPE_AGENT); }
__device__ __forceinline__ unsigned xb_add(unsigned* p, unsigned v) { return __hip_atomic_fetch_add(p, v, __ATOMIC_RELAXED, __HIP_MEMORY_SCOPE_AGENT); }
__device__ __forceinline__ unsigned xb_xcc_id() { return (unsigned)__builtin_amdgcn_s_getreg((3 << 11) | 20) & 0xFu; }
#define XB_SPIN(cond, bar) do { unsigned _sp = 0; while (cond) { __builtin_amdgcn_s_sleep(1); \
    if ((++_sp & 255u) == 0u) { if (xb_ld(&(bar)[XB_TMO])) break; if (_sp > XB_SPIN_CAP) { atomicAdd(&(bar)[XB_TMO], 1u); break; } } } } while (0)

struct XcdBarrier { unsigned* bar; unsigned x; volatile LAS unsigned* st; };

__device__ __forceinline__ XcdBarrier xcd_barrier_post(unsigned* bar, volatile LAS unsigned* st) {
    XcdBarrier b; b.bar = bar; b.x = xb_xcc_id(); b.st = st;
    if (threadIdx.x == 0) (void)xb_add(&bar[XB_XCNT(b.x)], 1u);
    return b;
}
__device__ __forceinline__ void xcd_barrier_complete(unsigned* bar, unsigned x, unsigned& nloc, unsigned& nx) {
    const unsigned G = gridDim.x * gridDim.y * gridDim.z;
    unsigned sum, cnt, mine, sp = 0u;
    for (;;) {
        sum = 0u; cnt = 0u; mine = 0u;
#pragma unroll
        for (unsigned j = 0; j < 16; ++j) { const unsigned c = xb_ld(&bar[XB_XCNT(j)]); sum += c; cnt += (c > 0u) ? 1u : 0u; mine = (j == x) ? c : mine; }
        if (sum == G) break;
        __builtin_amdgcn_s_sleep(1);
        if ((++sp & 255u) == 0u) { if (xb_ld(&bar[XB_TMO])) break; if (sp > XB_SPIN_CAP) { atomicAdd(&bar[XB_TMO], 1u); break; } }
    }
    nloc = mine > 0u ? mine : 1u; nx = cnt > 0u ? cnt : 1u;
}
__device__ __forceinline__ void xcd_barrier(const XcdBarrier& b) {
    asm volatile("s_waitcnt vmcnt(0)" ::: "memory");
    __syncthreads();
    if (threadIdx.x == 0) {
        unsigned* bar = b.bar;
        __builtin_amdgcn_s_waitcnt(0);
        unsigned nloc = b.st[0], nx = b.st[1];
        if (nloc == 0u) { xcd_barrier_complete(bar, b.x, nloc, nx); b.st[0] = nloc; b.st[1] = nx; }
        const unsigned old = xb_add(&bar[XB_XSUB(b.x)], 1u);
        const unsigned gen = old / nloc;
        if (old + 1u == (gen + 1u) * nloc) {
            __builtin_amdgcn_fence(__ATOMIC_RELEASE, "agent");
            asm volatile("s_waitcnt vmcnt(0)" ::: "memory");
            const unsigned og = xb_add(&bar[XB_TOP], 1u);
            const unsigned tg = og / nx;
            if (og + 1u == (tg + 1u) * nx) xb_add(&bar[XB_TOPGEN], 1u);
            else XB_SPIN(xb_ld(&bar[XB_TOPGEN]) == tg, bar);
            __builtin_amdgcn_fence(__ATOMIC_ACQUIRE, "agent");
            xb_add(&bar[XB_XGEN(b.x)], 1u);
            asm volatile("s_waitcnt vmcnt(0)" ::: "memory");
        } else {
            XB_SPIN(xb_ld(&bar[XB_XGEN(b.x)]) == gen, bar);
            __builtin_amdgcn_fence(__ATOMIC_ACQUIRE, "agent");
            asm volatile("s_waitcnt vmcnt(0)" ::: "memory");
        }
    }
    __syncthreads();
}

struct Params {
    const float *x, *c, *ctx, *c_ctx, *ada_w, *ada_b, *norm1_g, *norm2_g, *w_in, *rpb, *w_att_o, *w_fourier, *w_pool, *pool_scale, *w_out, *w_router, *w_eg, *w_eu, *w_ed, *final_g;
    float* out; unsigned char* ws; int l_lo, l_hi;
};
struct Frame {
    LAS unsigned char* lds;
    int tid, lane, wave, G, bid;
    unsigned char* ws;
};
#define WSP(T, off) ((T*)(F.ws + (off)))

struct Unit { int grp, pm, pn, seg; };
struct GroupSched {
    int ng, nM, nN, G, c; int tM, tN, tpm0, tpn0;
    __device__ __forceinline__ void init(int ng_, int nM_, int nN_, int G_, int c_, int tM_ = 0, int tN_ = 0, int tpm0_ = 0, int tpn0_ = 0) { ng = ng_; nM = nM_; nN = nN_; G = G_; c = c_; tM = tM_; tN = tN_; tpm0 = tpm0_; tpn0 = tpn0_; }
    __device__ __forceinline__ bool next(int i, Unit& u) const {
        const int per = nM * nN; const int L = i * G + c;
        if (L < ng * per) {
            u.grp = L / per; int wgid = L - u.grp * per;
            { const int q = per / 8, r = per % 8, xcd = wgid % 8, off = wgid / 8; wgid = (xcd < r ? xcd * (q + 1) : r * (q + 1) + (xcd - r) * q) + off; }
            const int nig = 8 * nN, gid = wgid / nig, fm = gid * 8, gsz = (nM - fm) < 8 ? (nM - fm) : 8;
            u.pm = fm + ((wgid % nig) % gsz); u.pn = (wgid % nig) / gsz; u.seg = 0; return true;
        }
        const int w = L - ng * per;
        if (w < tM * tN) { u.grp = ng; u.pm = tpm0 + (w % tM); u.pn = tpn0 + (w / tM); u.seg = 0; return true; }
        return false;
    }
};
struct Operands { const bf16* A; const bf16* Bt; int lda, ldb, slot0, K; int bmap; };

constexpr int HTB = 128 * 64 * 2;
__device__ __forceinline__ int lds_byte(int r, int c) { const int st = (r >> 4) * 2 + (c >> 5), rr = r & 15, cc = c & 31, ob = rr * 64 + cc * 2; return st * 1024 + (ob ^ (((ob >> 9) & 1) << 5)); }
__device__ __forceinline__ int perm32(int rho) { const int n = rho >> 4, i = rho & 15; return 8 * (i >> 2) + 4 * n + (i & 3); }
__device__ __forceinline__ void stage_rc(int b, int& R, int& C) { const int st = b / 1024, sb = b % 1024, swz = sb ^ (((sb >> 9) & 1) << 5); R = (st >> 1) * 16 + swz / 64; C = (st & 1) * 32 + (swz % 64) / 2; }
template <bool GATHER, bool PERM, class Sched, class Addr, class Epi>
__device__ __forceinline__ void gemm_fast(LAS unsigned char* lds, const int tid, const Sched& S, const Addr& AD, const Epi& E, const int* __restrict__ grows) {
    const int wid = __builtin_amdgcn_readfirstlane(tid >> 6), lane = tid & 63, wr = wid >> 2, wc = wid & 3, fr = lane & 15, fq = lane >> 4;
    int sR[2], sRb[2]; unsigned sC[2];
    unsigned cvg[2][2], nvg[2][2], cvb[2][2], nvb[2][2];
#pragma unroll
    for (int i = 0; i < 2; ++i) { int R, C; stage_rc(tid * 16 + i * 8192, R, C); sR[i] = R; sC[i] = (unsigned)C * 2u; sRb[i] = PERM ? ((R & ~31) + perm32(R & 31)) : R; }
    const size_t kstep = 128;
    const unsigned ldsw = (unsigned)wid * 1024u;
    const int aoff = lds_byte(wr * 64 + fr, fq * 8), boff = lds_byte(wc * 32 + fr, fq * 8);
#define PG8_SA(b, h) (((b) * 2 + (h)) * HTB)
#define PG8_SB(b, h) ((4 + (b) * 2 + (h)) * HTB)
#define PG8_STAGE(bufoff, gbase, voff) do { _Pragma("unroll") for (int _i = 0; _i < 2; ++_i) \
        __builtin_amdgcn_global_load_lds((const unsigned*)((const char*)(gbase) + (voff)[_i]), (LAS unsigned*)(lds + (bufoff) + ldsw + _i * 8192), 16, 0, 0); } while (0)
#define PG8_LDA(dst, b, h) do { _Pragma("unroll") for (int m = 0; m < 4; ++m) _Pragma("unroll") for (int k = 0; k < 2; ++k) dst[m][k] = *(const LAS bf16x8*)(lds + PG8_SA(b, h) + aoff + m * 2048 + k * 1024); } while (0)
#define PG8_LDB(dst, b, h) do { _Pragma("unroll") for (int n = 0; n < 2; ++n) _Pragma("unroll") for (int k = 0; k < 2; ++k) dst[n][k] = *(const LAS bf16x8*)(lds + PG8_SB(b, h) + boff + n * 2048 + k * 1024); } while (0)
#define PG8_MMA(ai, bj, At, Bt) do { __builtin_amdgcn_s_setprio(1); _Pragma("unroll") for (int m = 0; m < 4; ++m) _Pragma("unroll") for (int n = 0; n < 2; ++n) _Pragma("unroll") for (int k = 0; k < 2; ++k) \
        acc[ai][bj][m][n] = __builtin_amdgcn_mfma_f32_16x16x32_bf16(Bt[n][k], At[m][k], acc[ai][bj][m][n], 0, 0, 0); __builtin_amdgcn_s_setprio(0); } while (0)
#define PG8_WAIT_V(n) asm volatile("s_waitcnt vmcnt(" #n ")" ::: "memory")
#define PG8_WAIT_L(n) asm volatile("s_waitcnt lgkmcnt(" #n ")" ::: "memory")
#define PG8_BAR __builtin_amdgcn_s_barrier()
#define PG8_SCHED __builtin_amdgcn_sched_barrier(0)
#define PG8_GIDX(dst, op_) do { _Pragma("unroll") for (int h_ = 0; h_ < 2; ++h_) _Pragma("unroll") for (int i_ = 0; i_ < 2; ++i_) dst[h_][i_] = (unsigned)grows[(op_).slot0 + h_ * 128 + sR[i_]] * (unsigned)((op_).lda * 2) + sC[i_]; } while (0)
#define PG8_AOFF(dst, op_) do { _Pragma("unroll") for (int h_ = 0; h_ < 2; ++h_) _Pragma("unroll") for (int i_ = 0; i_ < 2; ++i_) dst[h_][i_] = (unsigned)((sR[i_] + 128 * h_) * (op_).lda) * 2u + sC[i_]; } while (0)
#define PG8_BOFF(dst, op_) do { _Pragma("unroll") for (int h_ = 0; h_ < 2; ++h_) _Pragma("unroll") for (int i_ = 0; i_ < 2; ++i_) { const int c_ = sRb[i_] + 128 * h_; \
        dst[h_][i_] = (unsigned)(((op_).bmap ? (64 * (c_ & 7) + (c_ >> 3)) : c_) * (op_).ldb) * 2u + sC[i_]; } } while (0)
#define PG8_COPY(dst, src) do { _Pragma("unroll") for (int h_ = 0; h_ < 2; ++h_) _Pragma("unroll") for (int i_ = 0; i_ < 2; ++i_) dst[h_][i_] = src[h_][i_]; } while (0)
    Unit cur, nxt; int ui = 0;
    if (!S.next(0, cur)) return;
    f32x4 acc[2][2][4][2];
#pragma unroll
    for (int a = 0; a < 2; ++a)
#pragma unroll
        for (int b = 0; b < 2; ++b)
#pragma unroll
            for (int m = 0; m < 4; ++m)
#pragma unroll
                for (int n = 0; n < 2; ++n) acc[a][b][m][n] = (f32x4){0.f, 0.f, 0.f, 0.f};
    bf16x8 At[4][2], B0[2][2], B1[2][2];
    const char* cA; const char* cB; int nt;
    { const Operands op = AD(cur); cA = (const char*)op.A; cB = (const char*)op.Bt; nt = op.K / 64; PG8_BOFF(cvb, op);
      Unit u1; const bool h1 = S.next(1, u1); const Operands o1 = h1 ? AD(u1) : op; PG8_BOFF(nvb, o1);
      if constexpr (GATHER) { PG8_GIDX(cvg, op); PG8_GIDX(nvg, o1); PG8_WAIT_V(0); } else { PG8_AOFF(cvg, op); PG8_AOFF(nvg, o1); } }
    PG8_STAGE(PG8_SB(0, 0), cB, cvb[0]); PG8_STAGE(PG8_SB(0, 1), cB, cvb[1]); PG8_STAGE(PG8_SA(0, 0), cA, cvg[0]); PG8_STAGE(PG8_SA(0, 1), cA, cvg[1]);
    if (wr == 1) PG8_BAR;
    PG8_WAIT_V(2); PG8_BAR;
    PG8_STAGE(PG8_SB(1, 0), cB + kstep, cvb[0]); PG8_STAGE(PG8_SA(1, 0), cA + kstep, cvg[0]); PG8_STAGE(PG8_SB(1, 1), cB + kstep, cvb[1]);
    PG8_WAIT_V(6); PG8_BAR;
    for (;;) {
        const bool has_next = S.next(ui + 1, nxt);
        const char* nA = cA; const char* nB = cB; int nnt = nt;
        if (has_next) { const Operands op = AD(nxt); nA = (const char*)op.A; nB = (const char*)op.Bt; nnt = op.K / 64; }
#pragma unroll 1
        for (int t = 0; t < nt; t += 2) {
            const bool last = (t == nt - 2);
            const char* a1 = cA + (size_t)(t + 1) * kstep;
            const char* a2 = last ? nA : cA + (size_t)(t + 2) * kstep; const char* b2 = last ? nB : cB + (size_t)(t + 2) * kstep;
            const char* a3 = a2 + kstep; const char* b3 = b2 + kstep;
            unsigned v2[2][2], w2[2][2];
#pragma unroll
            for (int h_ = 0; h_ < 2; ++h_)
#pragma unroll
                for (int i_ = 0; i_ < 2; ++i_) { v2[h_][i_] = last ? nvg[h_][i_] : cvg[h_][i_]; w2[h_][i_] = last ? nvb[h_][i_] : cvb[h_][i_]; }
            PG8_LDB(B0, 0, 0); PG8_LDB(B1, 0, 1); PG8_SCHED; PG8_LDA(At, 0, 0); PG8_STAGE(PG8_SA(1, 1), a1, cvg[1]);
            PG8_WAIT_V(8); PG8_WAIT_L(0); PG8_BAR; PG8_MMA(0, 0, At, B0); PG8_MMA(0, 1, At, B1); PG8_BAR; PG8_SCHED;
            PG8_LDA(At, 0, 1); PG8_STAGE(PG8_SB(0, 0), b2, w2[0]); PG8_STAGE(PG8_SB(0, 1), b2, w2[1]); PG8_STAGE(PG8_SA(0, 0), a2, v2[0]);
            PG8_WAIT_V(8); PG8_WAIT_L(0); PG8_BAR; PG8_MMA(1, 0, At, B0); PG8_MMA(1, 1, At, B1); PG8_BAR; PG8_SCHED;
            PG8_LDB(B0, 1, 0); PG8_LDB(B1, 1, 1); PG8_SCHED; PG8_LDA(At, 1, 0); PG8_STAGE(PG8_SA(0, 1), a2, v2[1]);
            PG8_WAIT_V(8); PG8_WAIT_L(0); PG8_BAR; PG8_MMA(0, 0, At, B0); PG8_MMA(0, 1, At, B1); PG8_BAR; PG8_SCHED;
            PG8_LDA(At, 1, 1); PG8_STAGE(PG8_SB(1, 0), b3, w2[0]); PG8_STAGE(PG8_SB(1, 1), b3, w2[1]); PG8_STAGE(PG8_SA(1, 0), a3, v2[0]);
            PG8_WAIT_V(8); PG8_WAIT_L(0); PG8_BAR; PG8_MMA(1, 0, At, B0); PG8_MMA(1, 1, At, B1); PG8_BAR; PG8_SCHED;
        }
        if (wr == 0) PG8_BAR;
        unsigned fvg[2][2], fvb[2][2];
        { Unit u2; const bool h2 = S.next(ui + 2, u2);
          if (h2) { const Operands o2 = AD(u2); PG8_BOFF(fvb, o2); if constexpr (GATHER) PG8_GIDX(fvg, o2); else PG8_AOFF(fvg, o2); }
          else { PG8_COPY(fvb, nvb); PG8_COPY(fvg, nvg); } }
        { int fr2 = fr, fq2 = fq; asm volatile("" : "+v"(fr2), "+v"(fq2));
          E(acc, cur, wr, wc, fr2, fq2); }
        if (!has_next) break;
        if constexpr (GATHER) PG8_WAIT_V(0);
        PG8_COPY(cvg, nvg); PG8_COPY(nvg, fvg); PG8_COPY(cvb, nvb); PG8_COPY(nvb, fvb);
        if (E.reset(cur)) {
#pragma unroll
        for (int a = 0; a < 2; ++a)
#pragma unroll
            for (int b = 0; b < 2; ++b)
#pragma unroll
                for (int m = 0; m < 4; ++m)
#pragma unroll
                    for (int n = 0; n < 2; ++n) acc[a][b][m][n] = (f32x4){0.f, 0.f, 0.f, 0.f};
        }
        cur = nxt; cA = nA; cB = nB; nt = nnt; ++ui;
        if (wr == 1) PG8_BAR;
    }
    PG8_WAIT_V(0);
    PG8_BAR;
#undef PG8_SA
#undef PG8_SB
#undef PG8_STAGE
#undef PG8_LDA
#undef PG8_LDB
#undef PG8_MMA
#undef PG8_WAIT_V
#undef PG8_WAIT_L
#undef PG8_BAR
#undef PG8_SCHED
#undef PG8_GIDX
#undef PG8_AOFF
#undef PG8_BOFF
#undef PG8_COPY
}
template <class F> struct EpiFn { F f; __device__ __forceinline__ void operator()(f32x4 (&acc)[2][2][4][2], const Unit& u, int wr, int wc, int fr, int fq) const { f(acc, u, wr, wc, fr, fq); } __device__ __forceinline__ bool reset(const Unit&) const { return true; } };
template <class F> __device__ __forceinline__ EpiFn<F> mk_epi(F f) { return EpiFn<F>{f}; }
template <class F> struct EpiSeg { F f; int last; __device__ __forceinline__ void operator()(f32x4 (&acc)[2][2][4][2], const Unit& u, int wr, int wc, int fr, int fq) const { f(acc, u, wr, wc, fr, fq); } __device__ __forceinline__ bool reset(const Unit& u) const { return u.seg == last; } };
template <class F> __device__ __forceinline__ EpiSeg<F> mk_epi_seg(F f, int last) { return EpiSeg<F>{f, last}; }
template <int NSEG> struct SegSched { GroupSched base; __device__ __forceinline__ bool next(int j, Unit& u) const { if (!base.next(j / NSEG, u)) return false; u.seg = j % NSEG; return true; } };
#ifndef DUP_PH
#define DUP_PH -1
#endif
#define REP_BEGIN(k) _Pragma("unroll 1") for (int rep_ = 0; rep_ < ((DUP_PH == (k)) ? 2 : 1); ++rep_) { if (rep_) { if constexpr (PH < 0) xcd_barrier(bar); }
#define REP_END }
#define GEMM(S, AD, E, K, lda, ldb) gemm_fast<false, false>(F.lds, F.tid, S, AD, mk_epi(E), nullptr)
#define GEMM_P(S, AD, E) gemm_fast<false, true>(F.lds, F.tid, S, AD, mk_epi(E), nullptr)
#define GEMM_GATHER(S, AD, E, K, lda, ldb, rows) gemm_fast<true, true>(F.lds, F.tid, S, AD, mk_epi(E), rows)
#define EPI_ARGS f32x4 (&acc)[2][2][4][2], const Unit& u, int wr, int wc, int fr, int fq
#define EPI_FOR(...) _Pragma("unroll") for (int ai = 0; ai < 2; ++ai) _Pragma("unroll") for (int m = 0; m < 4; ++m) { const int r = ai * 128 + wr * 64 + m * 16 + fr; \
    _Pragma("unroll") for (int bj = 0; bj < 2; ++bj) _Pragma("unroll") for (int n = 0; n < 2; ++n) { const int c = bj * 128 + wc * 32 + n * 16 + 4 * fq; const f32x4 v = acc[ai][bj][m][n]; __VA_ARGS__ } }
#define EPI_FOR8(...) _Pragma("unroll") for (int ai = 0; ai < 2; ++ai) _Pragma("unroll") for (int m = 0; m < 4; ++m) { const int r = ai * 128 + wr * 64 + m * 16 + fr; \
    _Pragma("unroll") for (int bj = 0; bj < 2; ++bj) { const int c = bj * 128 + wc * 32 + 8 * fq; const f32x4 v0 = acc[ai][bj][m][0], v1 = acc[ai][bj][m][1]; __VA_ARGS__ } }
__device__ __forceinline__ void st_bf8(bf16* p, f32x4 a, f32x4 b) { u32x4 w; w.x = pk2(a[0], a[1]); w.y = pk2(a[2], a[3]); w.z = pk2(b[0], b[1]); w.w = pk2(b[2], b[3]); *(u32x4*)p = w; }
__device__ __forceinline__ void st_bf4(bf16* p, f32x4 v) { u32x2 w; w.x = pk2(v[0], v[1]); w.y = pk2(v[2], v[3]); *(u32x2*)p = w; }

__device__ __forceinline__ void p_mod(const Params& P, Frame& F) {
    LAS float* sc = (LAS float*)F.lds;
    LAS float* red = (LAS float*)(F.lds + 9 * 1024 * 4);
    float* MOD = WSP(float, WS_MOD);
    bool have = false;
    for (int it = F.bid; it < 2 * 96; it += F.G) {
        if (!have) {
            for (int i = F.tid; i < 9 * 1024; i += NTHREADS) { const int r = i >> 10, k = i & 1023; const float v = r < 8 ? P.c[r * 1024 + k] : P.c_ctx[k]; sc[i] = v * sigmoidf_(v); }
            have = true;
        }
        __syncthreads();
        const int l = it / 96, j0 = (it % 96) * 64, jj = F.tid & 63, kc = F.tid >> 6;
        const float* W = P.ada_w + (size_t)l * 1024 * 6144 + j0 + jj;
        float a[9];
#pragma unroll
        for (int r = 0; r < 9; ++r) a[r] = 0.f;
#pragma unroll 8
        for (int k = kc * 128; k < kc * 128 + 128; ++k) { const float w = W[(size_t)k * 6144];
#pragma unroll
            for (int r = 0; r < 9; ++r) a[r] += sc[r * 1024 + k] * w; }
#pragma unroll
        for (int r = 0; r < 9; ++r) red[(kc * 9 + r) * 64 + jj] = a[r];
        __syncthreads();
        for (int o = F.tid; o < 9 * 64; o += NTHREADS) { const int r = o >> 6, j = o & 63; float s = 0.f;
#pragma unroll
            for (int q = 0; q < 8; ++q) s += red[(q * 9 + r) * 64 + j];
            MOD[((size_t)l * 9 + r) * 6144 + j0 + j] = s + P.ada_b[l * 6144 + j0 + j]; }
    }
    __syncthreads();
}
__device__ __forceinline__ void p_dftgen(Frame& F) {
    LAS float* tab = (LAS float*)F.lds;
    for (int j = F.tid; j < 4096; j += NTHREADS) tab[j] = cospif((float)j * (1.0f / 2048.0f));
    __syncthreads();
    bf16* DC_ = WSP(bf16, WS_DFTC); bf16* M1 = WSP(bf16, WS_M1T); bf16* M2 = WSP(bf16, WS_M2T);
    const int nchunk = 256 * 64 + 256 * 32 + 256 * 64;
    for (int ch = F.bid * NTHREADS + F.tid; ch < nchunk; ch += F.G * NTHREADS) {
        float v[8]; bf16* dst;
        if (ch < 256 * 64) { const int kf = ch >> 6, col0 = (ch & 63) * 8, cs = col0 >> 8, l0 = col0 & 255;
#pragma unroll
            for (int i = 0; i < 8; ++i) { const int j = ((kf * (l0 + i)) & 255) * 16; v[i] = cs ? -tab[(j + 3072) & 4095] : tab[j]; }
            dst = DC_ + (size_t)kf * 512 + col0; }
        else if (ch < 256 * 64 + 256 * 32) { const int c2 = ch - 256 * 64, row = c2 >> 5, col0 = (c2 & 31) * 8, ri = row >> 7, h = (row >> 6) & 1, k1 = row & 63, h2 = col0 >> 7, cs = (col0 >> 6) & 1, l10 = col0 & 63;
#pragma unroll
            for (int i = 0; i < 8; ++i) { const int j = ((k1 * (l10 + i)) & 63) * 64; const float c = tab[j], sn = tab[(j + 3072) & 4095];
                v[i] = (h != h2) ? 0.f : (ri == 0 ? (cs == 0 ? c : -sn) : (cs == 0 ? sn : c)); }
            dst = M1 + (size_t)row * 256 + col0; }
        else { const int c2 = ch - 256 * 64 - 256 * 32, row = c2 >> 6, col0 = (c2 & 63) * 8, q = row >> 6, k2 = row & 63, q2 = col0 >> 7, ri = (col0 >> 6) & 1, l20 = col0 & 63;
#pragma unroll
            for (int i = 0; i < 8; ++i) { const int j = ((k2 * (l20 + i)) & 63) * 64; const float c = tab[j], sn = tab[(j + 3072) & 4095];
                v[i] = (q != q2) ? 0.f : (ri == 0 ? c : -sn); }
            dst = M2 + (size_t)row * 512 + col0; }
        u32x4 o; o.x = pk2(v[0], v[1]); o.y = pk2(v[2], v[3]); o.z = pk2(v[4], v[5]); o.w = pk2(v[6], v[7]);
        *(u32x4*)dst = o;
    }
    __syncthreads();
}
__device__ __forceinline__ void transpose_item(const float* W, int ldw, int k0, int n0, bf16* WT, int ldt, int drow0, LAS float* scr, int lane) {
    f32x4 ld[8];
#pragma unroll
    for (int i = 0; i < 8; ++i) ld[i] = *(const f32x4*)(W + (size_t)(k0 + 8 * i + (lane >> 3)) * ldw + n0 + 4 * (lane & 7));
#pragma unroll
    for (int i = 0; i < 8; ++i) { LAS float* d = scr + (8 * i + (lane >> 3)) * 33 + 4 * (lane & 7); d[0] = ld[i][0]; d[1] = ld[i][1]; d[2] = ld[i][2]; d[3] = ld[i][3]; }
    LDS_WAIT(); asm volatile("" ::: "memory");
    const int c = lane & 7;
#pragma unroll
    for (int j = 0; j < 4; ++j) { const int n = (lane >> 3) + 8 * j; const LAS float* s = scr + (8 * c) * 33 + n;
        u32x4 o; o.x = pk2(s[0 * 33], s[1 * 33]); o.y = pk2(s[2 * 33], s[3 * 33]); o.z = pk2(s[4 * 33], s[5 * 33]); o.w = pk2(s[6 * 33], s[7 * 33]);
        *(u32x4*)(WT + (size_t)(drow0 + n) * ldt + k0 + 8 * c) = o; }
    LDS_WAIT(); asm volatile("" ::: "memory");
}
__device__ __forceinline__ void p_wconv(const Params& P, Frame& F, int l) {
    LAS float* scr = (LAS float*)(F.lds + F.wave * 16384);
    const int gw = F.bid * NWAVES + F.wave, NGW = F.G * NWAVES;
    const float* w_in = P.w_in + (size_t)l * 1024 * INW;
    bf16* WA = WSP(bf16, WS_WA); bf16* WFV = WSP(bf16, WS_WFV);
    constexpr int I_K = 16 * 32, I_Q = 16 * 32, I_P = 16 * 16, I_G = 16 * 96, I_V = 16 * 32, I_AO = 16 * 32, I_FO = 8 * 32, I_OUT = 16 * 32;
    constexpr int NSM = I_K + I_Q + I_P + I_G + I_V + I_AO + I_FO + I_OUT;
    for (int it = gw; it < NSM; it += NGW) {
        int r = it;
        if (r < I_K) { transpose_item(w_in, INW, (r / 32) * 64, 0 + (r % 32) * 32, WA, 1024, 0 + (r % 32) * 32, scr, F.lane); continue; } r -= I_K;
        if (r < I_Q) { transpose_item(w_in, INW, (r / 32) * 64, 2048 + (r % 32) * 32, WA, 1024, 1024 + (r % 32) * 32, scr, F.lane); continue; } r -= I_Q;
        if (r < I_P) { transpose_item(w_in, INW, (r / 16) * 64, 3584 + (r % 16) * 32, WA, 1024, 2048 + (r % 16) * 32, scr, F.lane); continue; } r -= I_P;
        if (r < I_G) { transpose_item(w_in, INW, (r / 96) * 64, 4096 + (r % 96) * 32, WA, 1024, 2560 + (r % 96) * 32, scr, F.lane); continue; } r -= I_G;
        if (r < I_V) { transpose_item(w_in, INW, (r / 32) * 64, 1024 + (r % 32) * 32, WFV, 1024, 1024 + (r % 32) * 32, scr, F.lane); continue; } r -= I_V;
        if (r < I_AO) { transpose_item(P.w_att_o + (size_t)l * 1024 * 1024, 1024, (r / 32) * 64, (r % 32) * 32, WSP(bf16, WS_WAO), 1024, (r % 32) * 32, scr, F.lane); continue; } r -= I_AO;
        if (r < I_FO) { transpose_item(P.w_fourier + (size_t)l * 512 * 1024, 1024, (r / 32) * 64, (r % 32) * 32, WSP(bf16, WS_WFO), 512, (r % 32) * 32, scr, F.lane); continue; } r -= I_FO;
        transpose_item(P.w_out + (size_t)l * 1024 * 1024, 1024, (r / 32) * 64, (r % 32) * 32, WSP(bf16, WS_WOUT), 1024, (r % 32) * 32, scr, F.lane);
    }
    constexpr int I_E = 16 * 88;
    bf16* WGU = WSP(bf16, WS_WGU); bf16* WD = WSP(bf16, WS_WD);
    for (int it = gw; it < 3 * 16 * I_E; it += NGW) {
        const int which = it / (16 * I_E), r0 = it % (16 * I_E), e = r0 / I_E, r = r0 % I_E;
        if (which < 2) { const int kb = r / 88, nb = r % 88, n0 = nb * 32;
            const float* src = (which == 0 ? P.w_eg : P.w_eu) + ((size_t)l * 16 + e) * 1024 * FF;
            transpose_item(src, FF, kb * 64, n0, WGU + (size_t)e * 5632 * 1024, 1024, (n0 >> 7) * 256 + (which ? 128 : 0) + (n0 & 127), scr, F.lane); }
        else { const int kb = r / 32, nb = r % 32;
            transpose_item(P.w_ed + ((size_t)l * 16 + e) * FF * 1024, 1024, kb * 64, nb * 32, WD + (size_t)e * 1024 * FF, FF, nb * 32, scr, F.lane); }
    }
    { bf16* WPO = WSP(bf16, WS_WPO); const float* wp = P.w_pool + (size_t)l * 4 * 128 * 256;
      for (int i = F.bid * NTHREADS + F.tid; i < 1024 * 256; i += F.G * NTHREADS) { const int n = i >> 8, kk = i & 255, g = n >> 8, f = n & 255;
          WPO[i] = (bf16)(((kk >> 7) == (g & 1)) ? f2bf(wp[((size_t)g * 128 + (kk & 127)) * 256 + f]) : 0u); } }
    { LAS float* t128 = (LAS float*)F.lds;
      __syncthreads();
      for (int j = F.tid; j < 128; j += NTHREADS) t128[j] = cospif((float)j * (1.0f / 64.0f));
      __syncthreads();
      for (int i = F.bid * NTHREADS + F.tid; i < 1024 * 1024; i += F.G * NTHREADS) { const int fc = i >> 10, k = i & 1023, cs = fc & 1, gm = fc >> 1, g = gm >> 7, m = gm & 127;
          const float* src = w_in + (size_t)k * INW + 3072 + g * 128; float s = 0.f; const int ph = cs ? 96 : 0;
          for (int c = 0; c < 128; ++c) s += src[c] * t128[(m * c + ph) & 127];
          WFV[i] = (bf16)f2bf(s); }
      __syncthreads(); }
}

struct RowMod { const float* g; const float* sh; const float* sc; };
__device__ __forceinline__ void row_load(const float* row, int lane, f32x4 (&v)[4]) {
#pragma unroll
    for (int j = 0; j < 4; ++j) v[j] = *(const f32x4*)(row + 4 * lane + 256 * j);
}
__device__ __forceinline__ float row_rstd(const f32x4 (&v)[4]) {
    float s = 0.f;
#pragma unroll
    for (int j = 0; j < 4; ++j) s += (v[j][0] * v[j][0] + v[j][1] * v[j][1]) + (v[j][2] * v[j][2] + v[j][3] * v[j][3]);
    return rsqrtf(wave_sum(s) * (1.0f / 1024.0f) + RMS_EPS);
}
__device__ __forceinline__ void row_modulate(const f32x4 (&v)[4], float rstd, const RowMod& M, int lane, f32x4 (&y)[4]) {
#pragma unroll
    for (int j = 0; j < 4; ++j) { const int k = 4 * lane + 256 * j; const f32x4 g = *(const f32x4*)(M.g + k), sh = *(const f32x4*)(M.sh + k), sc = *(const f32x4*)(M.sc + k);
        y[j] = v[j] * rstd * g * (sc + 1.0f) + sh; }
}
__device__ __forceinline__ void row_store_bf(bf16* row, int lane, const f32x4 (&y)[4]) {
#pragma unroll
    for (int j = 0; j < 4; ++j) st_bf4(row + 4 * lane + 256 * j, y[j]);
}
__device__ __forceinline__ const float* mod_ptr(Frame& F, int l, int row, int which) { const int mr = row < RL ? (row >> 12) : 8; return WSP(float, WS_MOD) + ((size_t)l * 9 + mr) * 6144 + which * 1024; }

__device__ __forceinline__ void p_rowpass_a0(const Params& P, Frame& F) {
    const int gw = F.bid * NWAVES + F.wave, NGW = F.G * NWAVES; bf16* H = WSP(bf16, WS_H);
    f32x4 vn[4]; int row = gw;
    if (row < RT) row_load(row < RL ? P.x + (size_t)row * DM : P.ctx + (size_t)(row - RL) * DM, F.lane, vn);
    for (; row < RT; row += NGW) {
        f32x4 v[4], y[4];
#pragma unroll
        for (int j = 0; j < 4; ++j) v[j] = vn[j];
        { const int nr = row + NGW; if (nr < RT) row_load(nr < RL ? P.x + (size_t)nr * DM : P.ctx + (size_t)(nr - RL) * DM, F.lane, vn); }
        const float rs = row_rstd(v);
        RowMod M{P.norm1_g, mod_ptr(F, 0, row, 0), mod_ptr(F, 0, row, 1)};
        row_modulate(v, rs, M, F.lane, y); row_store_bf(H + (size_t)row * DM, F.lane, y);
    }
}
__device__ __forceinline__ void p_rowpass_f(const Params& P, Frame& F, int l, int nrows) {
    const int gw = F.bid * NWAVES + F.wave, NGW = F.G * NWAVES; bf16* H = WSP(bf16, WS_H); float* AFF = WSP(float, WS_AFF);
    const float* wr = P.w_router + (size_t)l * 1024 * 16;
    LAS float* wl = (LAS float*)F.lds;
    __syncthreads();
    for (int i = F.tid; i < 16384; i += NTHREADS) wl[(i & 15) * 1024 + (i >> 4)] = wr[i];
    __syncthreads();
    f32x4 vn[4]; int row = gw;
    if (row < nrows) row_load(row < RL ? P.out + (size_t)row * DM : WSP(float, WS_XC) + (size_t)(row - RL) * DM, F.lane, vn);
    for (; row < nrows; row += NGW) {
        f32x4 v[4], y[4];
#pragma unroll
        for (int j = 0; j < 4; ++j) v[j] = vn[j];
        { const int nr = row + NGW; if (nr < nrows) row_load(nr < RL ? P.out + (size_t)nr * DM : WSP(float, WS_XC) + (size_t)(nr - RL) * DM, F.lane, vn); }
        const float rs = row_rstd(v);
        RowMod M{P.norm2_g + l * 1024, mod_ptr(F, l, row, 3), mod_ptr(F, l, row, 4)};
        row_modulate(v, rs, M, F.lane, y); row_store_bf(H + (size_t)row * DM, F.lane, y);
        float lg[16];
        int wo = 4 * F.lane; asm volatile("" : "+v"(wo));
#pragma unroll
        for (int e = 0; e < 16; ++e) { float a = 0.f;
#pragma unroll
            for (int j = 0; j < 4; ++j) { const f32x4 w = *(const LAS f32x4*)(wl + e * 1024 + wo + 256 * j); a += (y[j][0] * w[0] + y[j][1] * w[1]) + (y[j][2] * w[2] + y[j][3] * w[3]); }
            lg[e] = a; }
        float mx = -1e30f;
#pragma unroll
        for (int e = 0; e < 16; ++e) { lg[e] = wave_sum(lg[e]); mx = fmaxf(mx, lg[e]); }
        float den = 0.f;
#pragma unroll
        for (int e = 0; e < 16; ++e) { lg[e] = __expf(lg[e] - mx); den += lg[e]; }
        const float inv = 1.0f / den;
        if (F.lane < 16) { float mine = 0.f;
#pragma unroll
            for (int e = 0; e < 16; ++e) mine = (F.lane == e) ? lg[e] : mine;
            AFF[(size_t)row * 16 + F.lane] = mine * inv; }
    }
    __syncthreads();
}
__device__ __forceinline__ void p_rowpass_k(const Params& P, Frame& F, int l, int nrows) {
    const int gw = F.bid * NWAVES + F.wave, NGW = F.G * NWAVES; bf16* H = WSP(bf16, WS_H);
    const int* SEL = WSP(int, WS_SEL); const bf16* Y = WSP(bf16, WS_Y);
    f32x4 vn[4]; int seln = -1; int row = gw;
    if (row < nrows) { row_load(row < RL ? P.out + (size_t)row * DM : WSP(float, WS_XC) + (size_t)(row - RL) * DM, F.lane, vn); seln = F.lane < 16 ? SEL[(size_t)row * 16 + F.lane] : -1; }
    for (; row < nrows; row += NGW) {
        float* xr = row < RL ? P.out + (size_t)row * DM : WSP(float, WS_XC) + (size_t)(row - RL) * DM;
        f32x4 v[4], a[4]; const int sel = seln;
#pragma unroll
        for (int j = 0; j < 4; ++j) { v[j] = vn[j]; a[j] = (f32x4){0.f, 0.f, 0.f, 0.f}; }
        { const int nr = row + NGW; if (nr < nrows) { row_load(nr < RL ? P.out + (size_t)nr * DM : WSP(float, WS_XC) + (size_t)(nr - RL) * DM, F.lane, vn); seln = F.lane < 16 ? SEL[(size_t)nr * 16 + F.lane] : -1; } }
        unsigned em = (unsigned)__ballot(sel >= 0) & 0xffffu;
        while (em) { const int e = __builtin_ctz(em); em &= em - 1; const int s = __builtin_amdgcn_readlane(sel, e); const bf16* yr = Y + (size_t)s * DM;
#pragma unroll
            for (int j = 0; j < 4; ++j) { const u32x2 w = *(const u32x2*)(yr + 4 * F.lane + 256 * j); a[j][0] += bflo(w.x); a[j][1] += bfhi(w.x); a[j][2] += bflo(w.y); a[j][3] += bfhi(w.y); } }
        const float* g2 = mod_ptr(F, l, row, 5);
#pragma unroll
        for (int j = 0; j < 4; ++j) { const f32x4 g = *(const f32x4*)(g2 + 4 * F.lane + 256 * j); v[j] = v[j] + g * a[j]; }
        const float rs = row_rstd(v);
        if (l == 0) {
#pragma unroll
            for (int j = 0; j < 4; ++j) *(f32x4*)(xr + 4 * F.lane + 256 * j) = v[j];
            f32x4 y[4]; RowMod M{P.norm1_g + 1024, mod_ptr(F, 1, row, 0), mod_ptr(F, 1, row, 1)};
            row_modulate(v, rs, M, F.lane, y); row_store_bf(H + (size_t)row * DM, F.lane, y);
        } else {
#pragma unroll
            for (int j = 0; j < 4; ++j) { const f32x4 g = *(const f32x4*)(P.final_g + 4 * F.lane + 256 * j); *(f32x4*)(xr + 4 * F.lane + 256 * j) = v[j] * rs * g; }
        }
    }
}

constexpr int ACK_STRIDE = 72, ACV_STRIDE = 264;
constexpr int ALDS_CK = 0, ALDS_CV = 256 * ACK_STRIDE * 2, ALDS_RP = ALDS_CV + 64 * ACV_STRIDE * 2;
struct AttnState { float m, sum; f32x4 o[4]; };
__device__ __forceinline__ float xrow16_max(float x) {
    auto s = __builtin_amdgcn_permlane16_swap(__float_as_uint(x), __float_as_uint(x), false, false);
    x = fmaxf(__uint_as_float(s[0]), __uint_as_float(s[1]));
    auto t = __builtin_amdgcn_permlane32_swap(__float_as_uint(x), __float_as_uint(x), false, false);
    return fmaxf(__uint_as_float(t[0]), __uint_as_float(t[1]));
}
__device__ __forceinline__ float xrow16_sum(float x) {
    auto s = __builtin_amdgcn_permlane16_swap(__float_as_uint(x), __float_as_uint(x), false, false);
    x = __uint_as_float(s[0]) + __uint_as_float(s[1]);
    auto t = __builtin_amdgcn_permlane32_swap(__float_as_uint(x), __float_as_uint(x), false, false);
    return __uint_as_float(t[0]) + __uint_as_float(t[1]);
}
#define MFMA16(a, b, c) __builtin_amdgcn_mfma_f32_16x16x32_bf16((a), (b), (c), 0, 0, 0)
template <int NT>
__device__ __forceinline__ void attn_tail(AttnState& S, f32x4 (&sc)[NT], const u32x4 (&vw)[NT / 2][4]) {
    float cm = -__builtin_inff();
#pragma unroll
    for (int t = 0; t < NT; ++t)
#pragma unroll
        for (int j = 0; j < 4; ++j) cm = fmaxf(cm, sc[t][j]);
    cm = xrow16_max(cm);
    const bool need = (fabsf(cm) > 12.0f) && (cm > -1e30f);
    if (__builtin_amdgcn_ballot_w64(need) != 0ull) {
        const float d = need ? cm : 0.f, scl = __builtin_amdgcn_exp2f(-d);
        S.m += d; S.sum *= scl;
#pragma unroll
        for (int dt = 0; dt < 4; ++dt) S.o[dt] = S.o[dt] * scl;
#pragma unroll
        for (int t = 0; t < NT; ++t)
#pragma unroll
            for (int j = 0; j < 4; ++j) sc[t][j] -= d;
    }
    float ps = 0.f;
#pragma unroll
    for (int t = 0; t < NT; ++t)
#pragma unroll
        for (int j = 0; j < 4; ++j) { const float p = __builtin_amdgcn_exp2f(sc[t][j]); sc[t][j] = p; ps += p; }
    S.sum += ps;
#pragma unroll
    for (int ks = 0; ks < NT / 2; ++ks) { u32x4 pw; pw.x = pk2(sc[2 * ks][0], sc[2 * ks][1]); pw.y = pk2(sc[2 * ks][2], sc[2 * ks][3]); pw.z = pk2(sc[2 * ks + 1][0], sc[2 * ks + 1][1]); pw.w = pk2(sc[2 * ks + 1][2], sc[2 * ks + 1][3]);
        const bf16x8 pf = __builtin_bit_cast(bf16x8, pw);
#pragma unroll
        for (int dt = 0; dt < 4; ++dt) S.o[dt] = MFMA16(__builtin_bit_cast(bf16x8, vw[ks][dt]), pf, S.o[dt]); }
}
__device__ __forceinline__ void attn_unit2(const bf16* __restrict__ KQ, const bf16* __restrict__ VT, bf16* __restrict__ ATT, LAS unsigned char* lds,
                                           const int b, const int h, const int rowqA, const int rowqB, const bool win, const int r, const int qt, const int lane) {
    const int l15 = lane & 15, g = lane >> 4;
    const f32x4 z = {0.f, 0.f, 0.f, 0.f};
    bf16x8 qA[2], qB[2];
    { const bf16* qp = KQ + (size_t)(rowqA + l15) * 2048 + 1024 + h * 64 + 8 * g; qA[0] = *(const bf16x8*)qp; qA[1] = *(const bf16x8*)(qp + 32); }
    { const bf16* qp = KQ + (size_t)(rowqB + l15) * 2048 + 1024 + h * 64 + 8 * g; qB[0] = *(const bf16x8*)qp; qB[1] = *(const bf16x8*)(qp + 32); }
    AttnState SA, SB; SA.m = 0.f; SA.sum = 0.f; SB.m = 0.f; SB.sum = 0.f;
#pragma unroll
    for (int dt = 0; dt < 4; ++dt) { SA.o[dt] = z; SB.o[dt] = z; }
    if (win) {
        const int rsA = min(max(r - 4, 0), 56), dB = min(max(r - 3, 0), 56) - rsA, kc0 = min(max(16 * qt - 8, 0), 32);
        const int q = 16 * qt + l15, csq = min(max(q - 8, 0), 48);
        const int krow0 = 8 * (l15 >> 2) + (l15 & 3);
        const bf16* kb = KQ + (size_t)(b * SEQ + kc0 + krow0) * 2048 + h * 64 + 8 * g;
        const bf16* vb = VT + (size_t)(b * 1024 + h * 64 + l15) * 4096 + kc0 + 8 * g;
        const LAS float* rp = (const LAS float*)(lds + ALDS_RP);
        const int jb = kc0 + 8 * g;
        const int okb = jb - csq;
        const LAS float* rpl = rp + 16 + (jb - q + 15);
        float madd[2][4];
#pragma unroll
        for (int t = 0; t < 2; ++t)
#pragma unroll
            for (int j = 0; j < 4; ++j) madd[t][j] = ((unsigned)(okb + 4 * t + j) < 16u) ? 0.f : -__builtin_inff();
        bf16x8 K0[2][2], K1[2][2]; u32x4 V0[1][4], V1[1][4];
#define ATT_LOADW(KB, VB, i) do { const int gr_ = min(rsA + (i), 63); const bf16* kp_ = kb + (size_t)(gr_ * 64) * 2048; const bf16* vp_ = vb + gr_ * 64; \
        _Pragma("unroll") for (int t = 0; t < 2; ++t) { KB[t][0] = *(const bf16x8*)(kp_ + (size_t)(4 * t) * 2048); KB[t][1] = *(const bf16x8*)(kp_ + (size_t)(4 * t) * 2048 + 32); } \
        _Pragma("unroll") for (int dt = 0; dt < 4; ++dt) VB[0][dt] = *(const u32x4*)(vp_ + (size_t)(16 * dt) * 4096); } while (0)
#define ATT_ONE(ST, QF, KB, VB, roff, rowok) do { f32x4 sc[2]; \
        const LAS float* bp_ = rpl + ((rowok) ? (roff) : 15) * 64; \
        _Pragma("unroll") for (int t = 0; t < 2; ++t) _Pragma("unroll") for (int j = 0; j < 4; ++j) sc[t][j] = (bp_[4 * t + j] + madd[t][j]) - ST.m;     \
        _Pragma("unroll") for (int t = 0; t < 2; ++t) { sc[t] = MFMA16(KB[t][0], QF[0], sc[t]); sc[t] = MFMA16(KB[t][1], QF[1], sc[t]); } \
        attn_tail<2>(ST, sc, VB); } while (0)
#define ATT_COMPUTE(KB, VB, i) do { const int roffA_ = min(rsA + (i) - r + 7, 14); \
        ATT_ONE(SA, qA, KB, VB, roffA_, (i) <= 7); \
        ATT_ONE(SB, qB, KB, VB, max(roffA_ - 1, 0), (i) >= dB && (i) <= 7 + dB); } while (0)
        ATT_LOADW(K0, V0, 0);
#pragma unroll 1
        for (int i = 0; i < 8; i += 2) { ATT_LOADW(K1, V1, i + 1); ATT_COMPUTE(K0, V0, i); ATT_LOADW(K0, V0, i + 2); ATT_COMPUTE(K1, V1, i + 1); }
        ATT_COMPUTE(K0, V0, 8);
#undef ATT_LOADW
#undef ATT_ONE
#undef ATT_COMPUTE
    }
    { const LAS bf16* ck = (const LAS bf16*)(lds + ALDS_CK) + l15 * ACK_STRIDE + 8 * g;
      const LAS bf16* cv = (const LAS bf16*)(lds + ALDS_CV) + l15 * ACV_STRIDE + 8 * g;
#pragma unroll 1
      for (int c = 0; c < 4; ++c) {
          bf16x8 kf[4][2]; u32x4 vw[2][4];
#pragma unroll
          for (int t = 0; t < 4; ++t) { const LAS bf16* kp = ck + (64 * c + 16 * t) * ACK_STRIDE; kf[t][0] = *(const LAS bf16x8*)kp; kf[t][1] = *(const LAS bf16x8*)(kp + 32); }
#pragma unroll
          for (int ks = 0; ks < 2; ++ks)
#pragma unroll
              for (int dt = 0; dt < 4; ++dt) vw[ks][dt] = *(const LAS u32x4*)(cv + (16 * dt) * ACV_STRIDE + 64 * c + 32 * ks);
          { f32x4 sc[4]; const float nm = -SA.m; const f32x4 c0 = {nm, nm, nm, nm};
#pragma unroll
            for (int t = 0; t < 4; ++t) { sc[t] = MFMA16(kf[t][0], qA[0], c0); sc[t] = MFMA16(kf[t][1], qA[1], sc[t]); }
            attn_tail<4>(SA, sc, vw); }
          { f32x4 sc[4]; const float nm = -SB.m; const f32x4 c0 = {nm, nm, nm, nm};
#pragma unroll
            for (int t = 0; t < 4; ++t) { sc[t] = MFMA16(kf[t][0], qB[0], c0); sc[t] = MFMA16(kf[t][1], qB[1], sc[t]); }
            attn_tail<4>(SB, sc, vw); }
      } }
    { const float inv = 1.0f / xrow16_sum(SA.sum);
#pragma unroll
      for (int dt = 0; dt < 4; ++dt) st_bf4(ATT + (size_t)(rowqA + l15) * 1024 + h * 64 + 16 * dt + 4 * g, SA.o[dt] * inv); }
    { const float inv = 1.0f / xrow16_sum(SB.sum);
#pragma unroll
      for (int dt = 0; dt < 4; ++dt) st_bf4(ATT + (size_t)(rowqB + l15) * 1024 + h * 64 + 16 * dt + 4 * g, SB.o[dt] * inv); }
}
__device__ __forceinline__ void p_attn_mfma(const Params& P, Frame& F, int l, bool with_ctx_queries) {
    const bf16* KQ = WSP(bf16, WS_KQ); const bf16* VT = WSP(bf16, WS_VT); bf16* ATT = WSP(bf16, WS_ATT);
    const float* rpb = P.rpb + (size_t)l * 16 * 465;
    for (int hp = F.bid; hp < 256; hp += F.G) {
        const int p = hp & 127, half = hp >> 7, b = p >> 4, h = p & 15;
        __syncthreads();
        { LAS bf16* ck = (LAS bf16*)(F.lds + ALDS_CK); LAS bf16* cv = (LAS bf16*)(F.lds + ALDS_CV); LAS float* rp = (LAS float*)(F.lds + ALDS_RP);
          { const int key = F.tid >> 1, hf = F.tid & 1; const int k32 = key & 31, pos = (key & ~31) + ((k32 >> 2) & 1) * 16 + 4 * (k32 >> 3) + (k32 & 3);
            const u32x4* src = (const u32x4*)(KQ + (size_t)(RL + b * CTXL + key) * 2048 + h * 64 + hf * 32); LAS u32x4* dst = (LAS u32x4*)(ck + pos * ACK_STRIDE + hf * 32);
#pragma unroll
            for (int i = 0; i < 4; ++i) dst[i] = src[i]; }
          { const int d = F.tid >> 3, sg = F.tid & 7; const u32x4* src = (const u32x4*)(VT + YT_CTX_OFF + (size_t)(b * 1024 + h * 64 + d) * 256 + sg * 32); LAS u32x4* dst = (LAS u32x4*)(cv + d * ACV_STRIDE + sg * 32);
#pragma unroll
            for (int i = 0; i < 4; ++i) dst[i] = src[i]; }
          for (int i = F.tid; i < 16 * 64; i += NTHREADS) { const int rr = i >> 6, cc = (i & 63) - 16; rp[i] = rr == 15 ? -__builtin_inff() : ((cc >= 0 && cc < 31) ? rpb[h * 465 + rr * 31 + cc] * LOG2E : 0.f); } }
        __syncthreads();
        const int qt = F.wave & 3, rpi = F.wave >> 2;
#pragma unroll 1
        for (int st = 0; st < 8; ++st) { const int r = half * 32 + st * 4 + rpi * 2; const int rowqA = b * SEQ + r * 64 + 16 * qt;
            attn_unit2(KQ, VT, ATT, F.lds, b, h, rowqA, rowqA + 64, true, r, qt, F.lane); }
        if (with_ctx_queries && half == 0) { const int rowqA = RL + b * CTXL + 32 * F.wave; attn_unit2(KQ, VT, ATT, F.lds, b, h, rowqA, rowqA + 16, false, 0, 0, F.lane); }
    }
    __syncthreads();
}

__device__ __forceinline__ void ld8(const bf16* p, float (&x)[8]) { const u32x4 w = *(const u32x4*)p;
#pragma unroll
    for (int q = 0; q < 4; ++q) { x[2 * q] = bflo(w[q]); x[2 * q + 1] = bfhi(w[q]); } }
__device__ __forceinline__ void p_pool(Frame& F, int nrows) {
    const bf16* PB = WSP(bf16, WS_PB); bf16* POOL = WSP(bf16, WS_POOL);
    for (int i = F.bid * NTHREADS + F.tid; i < (nrows >> 4) * 64; i += F.G * NTHREADS) {
        const int row0 = (i >> 6) << 4, ch = i & 63, g = ch >> 4, hw = 1 << g;
        int base, t0, Lb; if (row0 < RL) { base = row0 & ~4095; t0 = row0 & 4095; Lb = SEQ; } else { const int rr = row0 - RL; base = RL + (rr & ~255); t0 = rr & 255; Lb = CTXL; }
        const bf16* src = PB + (size_t)base * 512 + ch * 8;
        float S[8];
#pragma unroll
        for (int q = 0; q < 8; ++q) S[q] = 0.f;
#pragma unroll 4
        for (int d = -8; d < 8; ++d) { const int tt = t0 + d; if (d >= -hw && d < hw && tt >= 0 && tt < Lb) { float x[8]; ld8(src + (size_t)tt * 512, x);
#pragma unroll
                for (int q = 0; q < 8; ++q) S[q] += x[q]; } }
#pragma unroll 2
        for (int j = 0; j < 16; ++j) { const int t = t0 + j; const int lo = max(t - hw, 0), hi = min(t + hw, Lb); const float inv = 1.0f / (float)(hi - lo);
            float me[8]; ld8(src + (size_t)t * 512, me);
            u32x4 o;
#pragma unroll
            for (int q = 0; q < 4; ++q) o[q] = pk2(S[2 * q] * inv - me[2 * q], S[2 * q + 1] * inv - me[2 * q + 1]);
            *(u32x4*)(POOL + (size_t)(base + t) * 512 + ch * 8) = o;
            if (t + hw < Lb) { float x[8]; ld8(src + (size_t)(t + hw) * 512, x);
#pragma unroll
                for (int q = 0; q < 8; ++q) S[q] += x[q]; }
            if (t - hw >= 0) { float x[8]; ld8(src + (size_t)(t - hw) * 512, x);
#pragma unroll
                for (int q = 0; q < 8; ++q) S[q] -= x[q]; } }
    }
}

__device__ __forceinline__ int block_sum_i(int v, LAS int* sm, int tid) {
    v = wave_sum_i(v);
    __syncthreads();
    if ((tid & 63) == 0) sm[tid >> 6] = v;
    __syncthreads();
    int s = 0;
#pragma unroll
    for (int i = 0; i < 8; ++i) s += sm[i];
    return s;
}
__device__ __forceinline__ int block_excl_scan(int v, LAS int* sm, int tid, int& total) {
    const int lane = tid & 63, w = tid >> 6; int inc = v;
#pragma unroll
    for (int o = 1; o < 64; o <<= 1) { const int t = __builtin_amdgcn_ds_bpermute(((lane - o) & 63) << 2, inc); if (lane >= o) inc += t; }
    __syncthreads();
    if (lane == 63) sm[w] = inc;
    __syncthreads();
    int base = 0; total = 0;
#pragma unroll
    for (int i = 0; i < 8; ++i) { const int s = sm[i]; if (i < w) base += s; total += s; }
    return base + inc - v;
}
template <int NPT>
__device__ __forceinline__ void topk_pair(Frame& F, int row0, int n, int cap, int e, int slot0) {
    LAS int* sm = (LAS int*)F.lds;
    const float* AFF = WSP(float, WS_AFF); int* SROW = WSP(int, WS_SROW); float* SG = WSP(float, WS_SGATE); int* SEL = WSP(int, WS_SEL);
    unsigned key[NPT];
#pragma unroll
    for (int j = 0; j < NPT; ++j) { const int i = F.tid * NPT + j; key[j] = (i < n) ? __float_as_uint(AFF[(size_t)(row0 + i) * 16 + e]) : 0u; }
    unsigned T = 0u;
    for (int bit = 30; bit >= 0; --bit) { const unsigned cand = T | (1u << bit); int cnt = 0;
#pragma unroll
        for (int j = 0; j < NPT; ++j) cnt += (key[j] >= cand) ? 1 : 0;
        cnt = block_sum_i(cnt, sm, F.tid);
        if (cnt >= cap) T = cand; }
    int ngt = 0, neq = 0;
#pragma unroll
    for (int j = 0; j < NPT; ++j) { ngt += (key[j] > T) ? 1 : 0; neq += (key[j] == T) ? 1 : 0; }
    int tot_gt, tot_eq;
    (void)block_excl_scan(ngt, sm, F.tid, tot_gt);
    int eqr = block_excl_scan(neq, sm, F.tid, tot_eq);
    const int need_eq = cap - tot_gt;
    int nsel = 0; bool selj[NPT];
#pragma unroll
    for (int j = 0; j < NPT; ++j) { bool s = key[j] > T; if (key[j] == T && T != 0u) { s = eqr < need_eq; ++eqr; } selj[j] = s; nsel += s ? 1 : 0; }
    int tot_sel; int pos = block_excl_scan(nsel, sm, F.tid, tot_sel);
#pragma unroll
    for (int j = 0; j < NPT; ++j) { const int i = F.tid * NPT + j;
        if (i < n) { const int row = row0 + i;
            if (selj[j]) { const int slot = slot0 + pos; ++pos; SROW[slot] = row; SG[slot] = __uint_as_float(key[j]); SEL[(size_t)row * 16 + e] = slot; }
            else SEL[(size_t)row * 16 + e] = -1; } }
    __syncthreads();
}
__device__ __forceinline__ void p_topk(Frame& F, bool with_ctx) {
    const int npairs = 128 + (with_ctx ? 128 : 0);
    for (int pi = F.bid; pi < npairs; pi += F.G) {
        if (pi < 128) { const int b = pi >> 4, e = pi & 15; topk_pair<8>(F, b * SEQ, SEQ, CAPL, e, e * SLOT_E + b * CAPL); }
        else { const int p2 = pi - 128, b = p2 >> 4, e = p2 & 15; topk_pair<1>(F, RL + b * CTXL, CTXL, CAPC, e, e * SLOT_E + 4096 + b * CAPC); }
    }
}
template <int PH> __global__ void __launch_bounds__(NTHREADS, 2) fwd_kernel(Params P) {
    extern __shared__ __attribute__((aligned(16))) unsigned char lds_raw[];
    Frame F; F.lds = (LAS unsigned char*)lds_raw; F.tid = threadIdx.x; F.lane = F.tid & 63; F.wave = __builtin_amdgcn_readfirstlane(F.tid >> 6); F.G = gridDim.x; F.bid = blockIdx.x; F.ws = P.ws;
    const int wave0 = __builtin_amdgcn_readfirstlane((int)threadIdx.x >> 6);
    volatile LAS unsigned* MISC = (volatile LAS unsigned*)(F.lds + LDS_MISC);
    if (F.tid < 64) MISC[F.tid] = 0u;
    __syncthreads();
    XcdBarrier bar; bar.bar = WSP(unsigned, WS_CTL) + CW_BAR; bar.x = 0; bar.st = MISC + 8;
    if constexpr (PH < 0) bar = xcd_barrier_post(WSP(unsigned, WS_CTL) + CW_BAR, MISC + 8);
#define IN(k) (PH < 0 || PH == (k))
#define REFRESH() do { unsigned on_ = ~0u; asm volatile("" : "+s"(on_)); int t_ = wave0 * 64 + (int)__builtin_amdgcn_mbcnt_hi(on_, __builtin_amdgcn_mbcnt_lo(on_, 0u)); asm volatile("" : "+v"(t_)); F.tid = t_; F.lane = t_ & 63; F.wave = __builtin_amdgcn_readfirstlane(t_ >> 6); } while (0)
#define SEAM(k) do { if constexpr (PH < 0) xcd_barrier(bar); } while (0)

    if (IN(0)) { REP_BEGIN(100) p_mod(P, F); p_dftgen(F); REP_END REP_BEGIN(101) p_wconv(P, F, 0); REP_END }
    SEAM(0);
    if (IN(1)) { p_rowpass_a0(P, F); }
    SEAM(1);
    for (int l = P.l_lo; l < P.l_hi; ++l) {
        constexpr int pb = 2; const bool L0 = (l == 0);
        bf16* H = WSP(bf16, WS_H);
        if (IN(pb + 0)) { REFRESH(); REP_BEGIN(2)
            { GroupSched S; S.init(1, 128, 22, F.G, F.bid, 8, L0 ? 22 : 4, 128, 0);
              const bf16* WA = WSP(bf16, WS_WA);
              auto AD = [=](const Unit& u) { return Operands{H + (size_t)u.pm * 256 * DM, WA + (size_t)u.pn * 256 * DM, DM, DM, 0, DM}; };
              bf16* KQ = WSP(bf16, WS_KQ); bf16* PBp = WSP(bf16, WS_PB); bf16* GB = WSP(bf16, WS_GB);
              auto E = [=](EPI_ARGS) { const int row0 = u.pm * 256;
                  if (u.pn < 8) { const float qs = (u.pn >= 4) ? QSCALE : 1.0f; EPI_FOR8( st_bf8(KQ + (size_t)(row0 + r) * 2048 + u.pn * 256 + c, v0 * qs, v1 * qs); ) }
                  else if (u.pn < 10) { EPI_FOR8( st_bf8(PBp + (size_t)(row0 + r) * 512 + (u.pn - 8) * 256 + c, v0, v1); ) }
                  else { EPI_FOR8( f32x4 s0; f32x4 s1; _Pragma("unroll") for (int j = 0; j < 4; ++j) { s0[j] = sigmoidf_(v0[j]); s1[j] = sigmoidf_(v1[j]); } st_bf8(GB + (size_t)(row0 + r) * 3072 + (u.pn - 10) * 256 + c, s0, s1); ) } };
              GEMM_P(S, AD, E); }
            REFRESH();
            { GroupSched S; const int g1a_units = 128 * 22 + 8 * (L0 ? 22 : 4);
              S.init(1, 8, 128, F.G, (F.bid + F.G - ((g1a_units % F.G) & ~7)) % F.G, L0 ? 8 : 4, 8, L0 ? 0 : 4, 128);
              const bf16* WFV = WSP(bf16, WS_WFV);
              auto AD = [=](const Unit& u) { const bool fmap = (u.pm < 4) && (u.pn < 128); const int t16 = u.pn & 15;
                  const size_t tok0 = fmap ? (size_t)(u.pn >> 4) * SEQ + 64 * ((t16 >> 1) * 8) + (t16 & 1) * 32 : (size_t)u.pn * 256;
                  return Operands{WFV + (size_t)u.pm * 256 * DM, H + tok0 * DM, DM, DM, 0, DM, fmap ? 1 : 0}; };
              bf16* YT = WSP(bf16, WS_YT); bf16* VT = WSP(bf16, WS_VT);
              auto E = [=](EPI_ARGS) { bf16* T = (u.pm < 4) ? YT : VT; const int rr0 = (u.pm & 3) * 256;
                  if (u.pn < 128) { const int b = u.pn >> 4;
                      if (u.pm < 4) { const int t16 = u.pn & 15, l10 = (t16 >> 1) * 8, l20 = (t16 & 1) * 32;
                          EPI_FOR8( const int fc = rr0 + r; st_bf8(T + (((((size_t)b * 512 + (fc >> 1)) * 32 + (c >> 3)) * 2 + (l20 >> 5)) * 2 + (fc & 1)) * 64 + l10, v0, v1); ) }
                      else { const int l0 = (u.pn & 15) * 256; EPI_FOR8( st_bf8(T + ((size_t)b * 1024 + rr0 + r) * 4096 + l0 + c, v0, v1); ) } }
                  else { const int b = u.pn - 128; EPI_FOR8( st_bf8(T + YT_CTX_OFF + ((size_t)b * 1024 + rr0 + r) * 256 + c, v0, v1); ) } };
              GEMM_P(S, AD, E); }
        REP_END }
        SEAM(pb + 0);
        if (IN(pb + 1)) { REFRESH();
            REP_BEGIN(31) p_attn_mfma(P, F, l, L0); REP_END
            REFRESH();
            REP_BEGIN(32)
            { LAS float* tw = (LAS float*)(F.lds + LDS_TW);
              for (int j = F.tid; j < 4096; j += NTHREADS) tw[j] = cospif((float)j * (1.0f / 2048.0f));
              __syncthreads();
              GroupSched S; S.init(1, 1, 512, F.G, F.bid);
              const bf16* M1 = WSP(bf16, WS_M1T); const bf16* YF = WSP(bf16, WS_YT); bf16* ZP = WSP(bf16, WS_ZP);
              auto AD = [=](const Unit& u) { return Operands{M1, YF + (size_t)u.pn * 256 * 256, 256, 256, 0, 256}; };
              auto E = [=](EPI_ARGS) {
                  const int b = u.pn >> 6, gm0 = (u.pn & 63) * 8 + wc, l20 = 32 * wr + 8 * fq;
#pragma unroll
                  for (int m = 0; m < 4; ++m) { const int k1 = 16 * m + fr;
#pragma unroll
                      for (int bj = 0; bj < 2; ++bj) { const int gm = gm0 + 4 * bj;
                          f32x4 zr[2], zi[2];
#pragma unroll
                          for (int n = 0; n < 2; ++n)
#pragma unroll
                              for (int j = 0; j < 4; ++j) { const int ix = k1 * (l20 + 4 * n + j); const float tc = tw[ix], ts = tw[(ix + 3072) & 4095];
                                  const float ur = acc[0][bj][m][n][j], ui = acc[1][bj][m][n][j]; zr[n][j] = ur * tc - ui * ts; zi[n][j] = ur * ts + ui * tc; }
                          bf16* dst = ZP + (((((size_t)b * 64 + k1) * 128 + (gm & 127)) * 4 + (gm >> 7)) * 2) * 64 + l20;
                          st_bf8(dst, zr[0], zr[1]); st_bf8(dst + 64, zi[0], zi[1]); } } };
              GEMM_P(S, AD, E); }
            REP_END
        }
        SEAM(pb + 1);
        if (IN(pb + 10)) { REFRESH();
            { GroupSched S; S.init(1, 1, 256, F.G, F.bid);
              const bf16* M2 = WSP(bf16, WS_M2T); const bf16* ZP = WSP(bf16, WS_ZP); bf16* FOUR = WSP(bf16, WS_FOUR);
              auto AD = [=](const Unit& u) { return Operands{M2, ZP + (size_t)u.pn * 256 * 512, 512, 512, 0, 512}; };
              auto E = [=](EPI_ARGS) { const float sc = 0.0013810679320049757f;
#pragma unroll
                  for (int ai = 0; ai < 2; ++ai)
#pragma unroll
                      for (int m = 0; m < 4; ++m) { const int q = 2 * ai + wr, k2 = 16 * m + fr;
#pragma unroll
                          for (int bj = 0; bj < 2; ++bj) { const int bk = u.pn * 2 + bj, b = bk >> 6, k1 = bk & 63;
                              st_bf8(FOUR + ((size_t)b * SEQ + k1 + 64 * k2) * 512 + q * 128 + wc * 32 + 8 * fq, acc[ai][bj][m][0] * sc, acc[ai][bj][m][1] * sc); } } };
              GEMM_P(S, AD, E); }
            REFRESH();
            if (L0) { GroupSched S; S.init(1, 1, 16, F.G, (F.bid + F.G - 128 % F.G) % F.G);
              const bf16* DFTC = WSP(bf16, WS_DFTC); const bf16* YTC = WSP(bf16, WS_YT) + YT_CTX_OFF; bf16* FOUR = WSP(bf16, WS_FOUR);
              auto AD = [=](const Unit& u) { return Operands{DFTC, YTC + (size_t)u.pn * 256 * 512, 512, 512, 0, 512}; };
              auto E = [=](EPI_ARGS) { const int b = u.pn >> 1, c0 = (u.pn & 1) * 256; const float sc = 0.005524271728019903f;
                  EPI_FOR8( st_bf8(FOUR + ((size_t)RL + b * CTXL + r) * 512 + c0 + c, v0 * sc, v1 * sc); ) };
              GEMM_P(S, AD, E); }
            REFRESH();
            REP_BEGIN(33) p_pool(F, L0 ? RT : RL); REP_END
        }
        SEAM(pb + 10);
        if (IN(pb + 2)) { REFRESH();
            SegSched<3> S; S.base.init(1, L0 ? 136 : 128, 4, F.G, F.bid);
            const bf16* ATT = WSP(bf16, WS_ATT); const bf16* FOUR = WSP(bf16, WS_FOUR); const bf16* POOL = WSP(bf16, WS_POOL);
            const bf16* WAO = WSP(bf16, WS_WAO); const bf16* WFO = WSP(bf16, WS_WFO); const bf16* WPO = WSP(bf16, WS_WPO);
            const bf16* GB = WSP(bf16, WS_GB); bf16* MRGB = WSP(bf16, WS_MRGB); const float* ps = P.pool_scale + l * 1024;
            auto AD = [=](const Unit& u) {
                if (u.seg == 0) return Operands{ATT + (size_t)u.pm * 256 * 1024, WAO + (size_t)u.pn * 256 * 1024, 1024, 1024, 0, 1024};
                if (u.seg == 1) return Operands{FOUR + (size_t)u.pm * 256 * 512, WFO + (size_t)u.pn * 256 * 512, 512, 512, 0, 512};
                return Operands{POOL + (size_t)u.pm * 256 * 512 + (u.pn >> 1) * 256, WPO + (size_t)u.pn * 256 * 256, 512, 256, 0, 256}; };
            auto E = [=](EPI_ARGS) {
                const int kd = u.seg < 2 ? u.seg + 1 : 2; const bool fin = (u.seg == 2); const int colb = u.pn * 256 + wc * 32 + 8 * fq;
#pragma unroll
                for (int ai = 0; ai < 2; ++ai)
#pragma unroll
                    for (int m = 0; m < 4; ++m) { const size_t row = (size_t)u.pm * 256 + ai * 128 + wr * 64 + m * 16 + fr; const bf16* gr = GB + row * 3072 + colb;
                        u32x4 nr[2], dr[2]; f32x4 psv[2][2];
#pragma unroll
                        for (int bj = 0; bj < 2; ++bj) { nr[bj] = *(const u32x4*)(gr + u.seg * 1024 + bj * 128); dr[bj] = *(const u32x4*)(gr + kd * 1024 + bj * 128);
                            psv[bj][0] = *(const f32x4*)(ps + colb + bj * 128); psv[bj][1] = *(const f32x4*)(ps + colb + bj * 128 + 4); }
#pragma unroll
                        for (int bj = 0; bj < 2; ++bj) { f32x4 o[2];
#pragma unroll
                            for (int n = 0; n < 2; ++n) { f32x4 nu = {bflo(nr[bj][2 * n]), bfhi(nr[bj][2 * n]), bflo(nr[bj][2 * n + 1]), bfhi(nr[bj][2 * n + 1])}, de = {bflo(dr[bj][2 * n]), bfhi(dr[bj][2 * n]), bflo(dr[bj][2 * n + 1]), bfhi(dr[bj][2 * n + 1])};
                                if (u.seg == 2) nu = nu * psv[bj][n];
                                de = de * psv[bj][n];
#pragma unroll
                                for (int j = 0; j < 4; ++j) { const float nj = (fabsf(nu[j]) < 1e-30f) ? copysignf(1e-30f, nu[j]) : nu[j]; const float dj = (fabsf(de[j]) < 1e-30f) ? copysignf(1e-30f, de[j]) : de[j];
                                    o[n][j] = acc[ai][bj][m][n][j] * nj * (fin ? 1.0f : __builtin_amdgcn_rcpf(dj)); }
                                acc[ai][bj][m][n] = o[n]; }
                            if (fin) st_bf8(MRGB + row * 1024 + colb + bj * 128, o[0], o[1]); } } };
            gemm_fast<false, true>(F.lds, F.tid, S, AD, mk_epi_seg(E, 2), nullptr);
        }
        SEAM(pb + 2);
        if (IN(pb + 3)) { REFRESH();
            GroupSched S; S.init(1, L0 ? 136 : 128, 4, F.G, F.bid); const bf16* A = WSP(bf16, WS_MRGB); const bf16* W = WSP(bf16, WS_WOUT);
            const float* xin = L0 ? P.x : P.out; const float* cin = L0 ? P.ctx : WSP(float, WS_XC); float* xo = P.out; float* co = WSP(float, WS_XC);
            const float* MOD = WSP(float, WS_MOD) + (size_t)l * 9 * 6144;
            auto AD = [=](const Unit& u) { return Operands{A + (size_t)u.pm * 256 * 1024, W + (size_t)u.pn * 256 * 1024, 1024, 1024, 0, 1024}; };
            auto E = [=](EPI_ARGS) {
                const int row0 = u.pm * 256, mr = row0 < RL ? (row0 >> 12) : 8, colb = u.pn * 256 + wc * 32 + 4 * fq;
                const float* src0 = row0 < RL ? xin + (size_t)row0 * DM : cin + (size_t)(row0 - RL) * DM; float* dst0 = row0 < RL ? xo + (size_t)row0 * DM : co + (size_t)(row0 - RL) * DM;
                f32x4 gv[2][2];
#pragma unroll
                for (int bj = 0; bj < 2; ++bj)
#pragma unroll
                    for (int n = 0; n < 2; ++n) gv[bj][n] = *(const f32x4*)(MOD + (size_t)mr * 6144 + 2048 + colb + bj * 128 + n * 16);
#pragma unroll
                for (int ai = 0; ai < 2; ++ai) { f32x4 xv[4][2][2];
#pragma unroll
                    for (int m = 0; m < 4; ++m) { const size_t ro = (size_t)(ai * 128 + wr * 64 + m * 16 + fr) * DM + colb;
#pragma unroll
                        for (int bj = 0; bj < 2; ++bj)
#pragma unroll
                            for (int n = 0; n < 2; ++n) xv[m][bj][n] = *(const f32x4*)(src0 + ro + bj * 128 + n * 16); }
#pragma unroll
                    for (int m = 0; m < 4; ++m) { const size_t ro = (size_t)(ai * 128 + wr * 64 + m * 16 + fr) * DM + colb;
#pragma unroll
                        for (int bj = 0; bj < 2; ++bj)
#pragma unroll
                            for (int n = 0; n < 2; ++n) *(f32x4*)(dst0 + ro + bj * 128 + n * 16) = xv[m][bj][n] + gv[bj][n] * acc[ai][bj][m][n]; } } };
            GEMM(S, AD, E, 1024, 1024, 1024);
        }
        SEAM(pb + 3);
        if (IN(pb + 4)) { REFRESH(); REP_BEGIN(6) p_rowpass_f(P, F, l, L0 ? RT : RL); REP_END }
        SEAM(pb + 4);
        if (IN(pb + 5)) { REFRESH(); REP_BEGIN(7) p_topk(F, L0); REP_END }
        SEAM(pb + 5);
        if (IN(pb + 7)) { REFRESH(); REP_BEGIN(9)
            GroupSched S; S.init(16, L0 ? 17 : 16, 22, F.G, F.bid); const bf16* W = WSP(bf16, WS_WGU); bf16* HID = WSP(bf16, WS_HID); const int* SROW = WSP(int, WS_SROW);
            auto AD = [=](const Unit& u) { return Operands{H, W + ((size_t)u.grp * 5632 + u.pn * 256) * DM, DM, DM, u.grp * SLOT_E + u.pm * 256, DM}; };
            auto E = [=](EPI_ARGS) {
#pragma unroll
                for (int ai = 0; ai < 2; ++ai)
#pragma unroll
                    for (int m = 0; m < 4; ++m) { const size_t slot = (size_t)u.grp * SLOT_E + u.pm * 256 + ai * 128 + wr * 64 + m * 16 + fr; f32x4 o[2];
#pragma unroll
                        for (int n = 0; n < 2; ++n) { const f32x4 a = acc[ai][0][m][n], up = acc[ai][1][m][n];
#pragma unroll
                            for (int j = 0; j < 4; ++j) o[n][j] = a[j] * sigmoidf_(a[j]) * up[j]; }
                        st_bf8(HID + slot * FF + u.pn * 128 + wc * 32 + 8 * fq, o[0], o[1]); } };
            GEMM_GATHER(S, AD, E, DM, DM, DM, SROW);
        REP_END }
        SEAM(pb + 7);
        if (IN(pb + 8)) { REFRESH(); REP_BEGIN(10)
            const int tpe = L0 ? 17 : 16;
            GroupSched S; S.init(1, 16 * tpe, 4, F.G, F.bid); const bf16* HID = WSP(bf16, WS_HID); const bf16* W = WSP(bf16, WS_WD); bf16* Y = WSP(bf16, WS_Y); const float* SG = WSP(float, WS_SGATE);
            auto AD = [=](const Unit& u) { const int e = u.pm / tpe, st = e * 17 + (u.pm - e * tpe); return Operands{HID + (size_t)st * 256 * FF, W + ((size_t)e * 1024 + u.pn * 256) * FF, FF, FF, 0, FF}; };
            auto E = [=](EPI_ARGS) { const int e = u.pm / tpe; const size_t slot0 = (size_t)(e * 17 + (u.pm - e * tpe)) * 256 + wr * 64 + fr; float gt[2][4];
#pragma unroll
                for (int ai = 0; ai < 2; ++ai)
#pragma unroll
                    for (int m = 0; m < 4; ++m) gt[ai][m] = SG[slot0 + ai * 128 + m * 16];
#pragma unroll
                for (int ai = 0; ai < 2; ++ai)
#pragma unroll
                    for (int m = 0; m < 4; ++m)
#pragma unroll
                        for (int bj = 0; bj < 2; ++bj) st_bf8(Y + (slot0 + ai * 128 + m * 16) * DM + u.pn * 256 + bj * 128 + wc * 32 + 8 * fq, acc[ai][bj][m][0] * gt[ai][m], acc[ai][bj][m][1] * gt[ai][m]); };
            GEMM_P(S, AD, E);
        REP_END }
        SEAM(pb + 8);
        if (IN(pb + 9)) { REFRESH(); p_rowpass_k(P, F, l, L0 ? RT : RL); if (L0) p_wconv(P, F, 1); }
        if (L0) SEAM(pb + 9);
    }
#undef IN
#undef SEAM
}
template <int PH> static void launch_ph(int grid, const Params& p, hipStream_t stream) { hipLaunchKernelGGL(fwd_kernel<PH>, dim3(grid), dim3(NTHREADS), LDS_BYTES, stream, p); }
template <int PH> static bool set_attr() { return hipFuncSetAttribute((const void*)fwd_kernel<PH>, hipFuncAttributeMaxDynamicSharedMemorySize, LDS_BYTES) == hipSuccess; }

#ifndef DUP_LAUNCH
#define DUP_LAUNCH -1
#endif
extern "C" void kernel_launch(void* const* d_in, const int* in_sizes, int n_in, void* d_out, int out_size, void* d_ws, size_t ws_size, hipStream_t stream) {
    static int grid = 0;
    if (grid == 0) {
        if (n_in != 20 || out_size != RL * DM || ws_size < WS_END) { fprintf(stderr, "kernel_launch: unexpected shapes (n_in %d out %d ws %zu need %zu)\n", n_in, out_size, ws_size, (size_t)WS_END); grid = -1; return; }
        int dev = 0, cus = 0, per_cu = 0;
        if (hipGetDevice(&dev) != hipSuccess || hipDeviceGetAttribute(&cus, hipDeviceAttributeMultiprocessorCount, dev) != hipSuccess) { grid = -1; return; }
#if N_LAUNCH_MODE == 1
        if (!set_attr<-1>()) { fprintf(stderr, "kernel_launch: hipFuncSetAttribute failed\n"); grid = -1; return; }
        if (hipOccupancyMaxActiveBlocksPerMultiprocessor(&per_cu, (const void*)fwd_kernel<-1>, NTHREADS, LDS_BYTES) != hipSuccess || per_cu < 1) fprintf(stderr, "kernel_launch: occupancy query reports %d\n", per_cu);
#else
        if (!(set_attr<0>() && set_attr<1>() && set_attr<2>() && set_attr<3>() && set_attr<12>() && set_attr<4>() && set_attr<5>() && set_attr<6>() && set_attr<7>() && set_attr<9>() && set_attr<10>() && set_attr<11>())) { fprintf(stderr, "kernel_launch: hipFuncSetAttribute failed\n"); grid = -1; return; }
        (void)per_cu;
#endif
        (void)hipGetLastError();
        grid = cus;
    }
    if (grid < 0) return;
    if (hipMemsetAsync((char*)d_ws + WS_CTL, 0, CTL_BYTES, stream) != hipSuccess) return;
    Params p{};
    const float** pp = (const float**)&p;
    for (int i = 0; i < 20; ++i) pp[i] = (const float*)d_in[i];
    p.out = (float*)d_out; p.ws = (unsigned char*)d_ws;
#if N_LAUNCH_MODE == 1
    p.l_lo = 0; p.l_hi = 2;
    launch_ph<-1>(grid, p, stream);
#else
    p.l_lo = 0; p.l_hi = 0; launch_ph<0>(grid, p, stream); if (DUP_LAUNCH == 0) launch_ph<0>(grid, p, stream); launch_ph<1>(grid, p, stream); if (DUP_LAUNCH == 1) launch_ph<1>(grid, p, stream);
#define LP(k) do { launch_ph<k>(grid, p, stream); if (DUP_LAUNCH == (k) && l == 0) launch_ph<k>(grid, p, stream); } while (0)
    for (int l = 0; l < 2; ++l) { p.l_lo = l; p.l_hi = l + 1;
        LP(2); LP(3); LP(12); LP(4); LP(5); LP(6); LP(7); LP(9); LP(10); LP(11); }
#endif
}
```

```cpp
#include <hip/hip_runtime.h>
#include <cstdio>
#include <cstdint>

#ifndef N_LAUNCH_MODE
#define N_LAUNCH_MODE 1
#endif

#define GAS __attribute__((address_space(1)))
#define LAS __attribute__((address_space(3)))
typedef unsigned short bf16;
typedef short bf16x8 __attribute__((ext_vector_type(8)));
typedef float f32x4 __attribute__((ext_vector_type(4)));
typedef unsigned u32x4 __attribute__((ext_vector_type(4)));
typedef unsigned u32x2 __attribute__((ext_vector_type(2)));

constexpr int NB = 8, SEQ = 4096, DM = 1024, CTXL = 256, NH = 16, HD = 64, GRIDW = 64;
constexpr int RL = NB * SEQ, RC = NB * CTXL, RT = RL + RC;
constexpr int INW = 7168, NE = 16, FF = 2816, CAPL = 512, CAPC = 32;
constexpr int SLOT_E = 4352, NSLOT = NE * SLOT_E;
constexpr float RMS_EPS = 1e-6f;
constexpr float LOG2E = 1.4426950408889634f, QSCALE = 0.125f * LOG2E;
constexpr int NWAVES = 8, NTHREADS = 512;

constexpr size_t al256(size_t x) { return (x + 255) & ~(size_t)255; }
constexpr size_t WS_CTL = 0, CTL_BYTES = 1u << 20;
constexpr size_t WS_MOD = WS_CTL + CTL_BYTES;
constexpr size_t WS_XC = al256(WS_MOD + (size_t)2 * 9 * 6144 * 4);
constexpr size_t WS_AFF = al256(WS_XC + (size_t)RC * DM * 4);
constexpr size_t WS_SROW = al256(WS_AFF + (size_t)RT * 16 * 4);
constexpr size_t WS_SGATE = al256(WS_SROW + (size_t)NSLOT * 4);
constexpr size_t WS_SEL = al256(WS_SGATE + (size_t)NSLOT * 4);
constexpr size_t WS_DFTM = al256(WS_SEL + (size_t)RT * 16 * 4);
constexpr size_t WS_DFTC = al256(WS_DFTM + (size_t)4096 * 8192 * 2);
constexpr size_t WS_WA = al256(WS_DFTC + (size_t)256 * 512 * 2);
constexpr size_t WS_WFV = al256(WS_WA + (size_t)5632 * 1024 * 2);
constexpr size_t WS_WAO = al256(WS_WFV + (size_t)2048 * 1024 * 2);
constexpr size_t WS_WFO = al256(WS_WAO + (size_t)1024 * 1024 * 2);
constexpr size_t WS_WPO = al256(WS_WFO + (size_t)1024 * 512 * 2);
constexpr size_t WS_WOUT = al256(WS_WPO + (size_t)1024 * 256 * 2);
constexpr size_t WS_WGU = al256(WS_WOUT + (size_t)1024 * 1024 * 2);
constexpr size_t WS_WD = al256(WS_WGU + (size_t)16 * 5632 * 1024 * 2);
constexpr size_t WS_H = al256(WS_WD + (size_t)16 * 1024 * 2816 * 2);
constexpr size_t WS_R = al256(WS_H + (size_t)RT * DM * 2);
constexpr size_t WS_KQ = WS_R;
constexpr size_t WS_MRG = WS_KQ;
constexpr size_t WS_PB = al256(WS_KQ + (size_t)RT * 2048 * 2);
constexpr size_t WS_GB = al256(WS_PB + (size_t)RT * 512 * 2);
constexpr size_t WS_YT = al256(WS_GB + (size_t)RT * 3072 * 2);
constexpr size_t WS_MRGB = WS_YT;
constexpr size_t WS_VT = al256(WS_YT + (size_t)RT * 1024 * 2);
constexpr size_t WS_FOUR = al256(WS_VT + (size_t)RT * 1024 * 2);
constexpr size_t WS_ATT = al256(WS_FOUR + (size_t)RT * 512 * 2);
constexpr size_t WS_POOL = al256(WS_ATT + (size_t)RT * 1024 * 2);
constexpr size_t WS_MIX_END = al256(WS_POOL + (size_t)RT * 512 * 2);
constexpr size_t WS_XG = WS_R;
constexpr size_t WS_HID = al256(WS_XG + (size_t)NSLOT * 1024 * 2);
constexpr size_t WS_Y = al256(WS_HID + (size_t)NSLOT * 2816 * 2);
constexpr size_t WS_MOE_END = al256(WS_Y + (size_t)NSLOT * 1024 * 2);
constexpr size_t WS_END0 = WS_MIX_END > WS_MOE_END ? WS_MIX_END : WS_MOE_END;
constexpr size_t WS_ZP = WS_END0;
constexpr size_t WS_M1T = al256(WS_ZP + ((size_t)8 * 64 * 512 * 128 + 1024) * 2);
constexpr size_t WS_M2T = al256(WS_M1T + (size_t)256 * 256 * 2);
constexpr size_t WS_END = al256(WS_M2T + (size_t)256 * 512 * 2);
constexpr size_t YT_CTX_OFF = (size_t)8 * 1024 * 4096;

constexpr int CW_BAR = 4096;

constexpr int LDS_BYTES = 155648;
constexpr int LDS_TW = 132096;
constexpr int LDS_MISC = 131072;

__device__ __forceinline__ unsigned f2bf(float f) { unsigned u = __float_as_uint(f); return (u + 0x7fffu + ((u >> 16) & 1u)) >> 16; }
typedef __bf16 hbf16x2 __attribute__((ext_vector_type(2)));
typedef float f32x2 __attribute__((ext_vector_type(2)));
__device__ __forceinline__ unsigned pk2(float lo, float hi) { const f32x2 v = {lo, hi}; return __builtin_bit_cast(unsigned, __builtin_convertvector(v, hbf16x2)); }
__device__ __forceinline__ float bf2f(unsigned b) { return __uint_as_float(b << 16); }
__device__ __forceinline__ float bflo(unsigned w) { return __uint_as_float(w << 16); }
__device__ __forceinline__ float bfhi(unsigned w) { return __uint_as_float(w & 0xffff0000u); }
template <int CTRL> __device__ __forceinline__ float dppf(float x) { return __builtin_bit_cast(float, __builtin_amdgcn_mov_dpp(__builtin_bit_cast(int, x), CTRL, 0xf, 0xf, true)); }
template <int CTRL> __device__ __forceinline__ int dppi(int x) { return __builtin_amdgcn_mov_dpp(x, CTRL, 0xf, 0xf, true); }
constexpr int DPP_XOR1 = 0xB1, DPP_XOR2 = 0x4E, DPP_ROR4 = 0x124, DPP_ROR8 = 0x128;
__device__ __forceinline__ float wave_sum(float v) {
    v += dppf<DPP_XOR1>(v); v += dppf<DPP_XOR2>(v); v += dppf<DPP_ROR4>(v); v += dppf<DPP_ROR8>(v);
    auto s = __builtin_amdgcn_permlane16_swap(__float_as_uint(v), __float_as_uint(v), false, false); v = __uint_as_float(s[0]) + __uint_as_float(s[1]);
    auto t = __builtin_amdgcn_permlane32_swap(__float_as_uint(v), __float_as_uint(v), false, false); return __uint_as_float(t[0]) + __uint_as_float(t[1]);
}
__device__ __forceinline__ float wave_max(float v) {
    v = fmaxf(v, dppf<DPP_XOR1>(v)); v = fmaxf(v, dppf<DPP_XOR2>(v)); v = fmaxf(v, dppf<DPP_ROR4>(v)); v = fmaxf(v, dppf<DPP_ROR8>(v));
    auto s = __builtin_amdgcn_permlane16_swap(__float_as_uint(v), __float_as_uint(v), false, false); v = fmaxf(__uint_as_float(s[0]), __uint_as_float(s[1]));
    auto t = __builtin_amdgcn_permlane32_swap(__float_as_uint(v), __float_as_uint(v), false, false); return fmaxf(__uint_as_float(t[0]), __uint_as_float(t[1]));
}
__device__ __forceinline__ int wave_sum_i(int v) {
    v += dppi<DPP_XOR1>(v); v += dppi<DPP_XOR2>(v); v += dppi<DPP_ROR4>(v); v += dppi<DPP_ROR8>(v);
    auto s = __builtin_amdgcn_permlane16_swap((unsigned)v, (unsigned)v, false, false); v = (int)(s[0] + s[1]);
    auto t = __builtin_amdgcn_permlane32_swap((unsigned)v, (unsigned)v, false, false); return (int)(t[0] + t[1]);
}
__device__ __forceinline__ float sigmoidf_(float x) { return __builtin_amdgcn_rcpf(1.f + __builtin_amdgcn_exp2f(x * -1.4426950408889634f)); }
#define LDS_WAIT() asm volatile("s_waitcnt lgkmcnt(0)" ::: "memory")

#define XB_TMO      128
#define XB_XCNT(j)  (256  + 64 * (j))
#define XB_XSUB(j)  (1280 + 64 * (j))
#define XB_XGEN(j)  (2304 + 64 * (j))
#define XB_TOP      3328
#define XB_TOPGEN   3392
#define XCD_BAR_WORDS 3456
#define XB_SPIN_CAP (1u << 22)

__device__ __forceinline__ unsigned xb_ld(unsigned* p)              { return __hip_atomic_load(p, __ATOMIC_RELAXED, __HIP_MEMORY_SCOPE_AGENT); }
__device__ __forceinline__ unsigned xb_add(unsigned* p, unsigned v) { return __hip_atomic_fetch_add(p, v, __ATOMIC_RELAXED, __HIP_MEMORY_SCOPE_AGENT); }
__device__ __forceinline__ unsigned xb_xcc_id() { return (unsigned)__builtin_amdgcn_s_getreg((3 << 11) | 20) & 0xFu; }
#define XB_SPIN(cond, bar) do { unsigned _sp = 0; while (cond) { __builtin_amdgcn_s_sleep(1); \
    if ((++_sp & 255u) == 0u) { if (xb_ld(&(bar)[XB_TMO])) break; if (_sp > XB_SPIN_CAP) { atomicAdd(&(bar)[XB_TMO], 1u); break; } } } } while (0)

struct XcdBarrier { unsigned* bar; unsigned x; volatile LAS unsigned* st; };

__device__ __forceinline__ XcdBarrier xcd_barrier_post(unsigned* bar, volatile LAS unsigned* st) {
    XcdBarrier b; b.bar = bar; b.x = xb_xcc_id(); b.st = st;
    if (threadIdx.x == 0) (void)xb_add(&bar[XB_XCNT(b.x)], 1u);
    return b;
}
__device__ __forceinline__ void xcd_barrier_complete(unsigned* bar, unsigned x, unsigned& nloc, unsigned& nx) {
    const unsigned G = gridDim.x * gridDim.y * gridDim.z;
    unsigned sum, cnt, mine, sp = 0u;
    for (;;) {
        sum = 0u; cnt = 0u; mine = 0u;
#pragma unroll
        for (unsigned j = 0; j < 16; ++j) { const unsigned c = xb_ld(&bar[XB_XCNT(j)]); sum += c; cnt += (c > 0u) ? 1u : 0u; mine = (j == x) ? c : mine; }
        if (sum == G) break;
        __builtin_amdgcn_s_sleep(1);
        if ((++sp & 255u) == 0u) { if (xb_ld(&bar[XB_TMO])) break; if (sp > XB_SPIN_CAP) { atomicAdd(&bar[XB_TMO], 1u); break; } }
    }
    nloc = mine > 0u ? mine : 1u; nx = cnt > 0u ? cnt : 1u;
}
__device__ __forceinline__ void xcd_barrier(const XcdBarrier& b) {
    asm volatile("s_waitcnt vmcnt(0)" ::: "memory");
    __syncthreads();
    if (threadIdx.x == 0) {
        unsigned* bar = b.bar;
        __builtin_amdgcn_s_waitcnt(0);
        unsigned nloc = b.st[0], nx = b.st[1];
        if (nloc == 0u) { xcd_barrier_complete(bar, b.x, nloc, nx); b.st[0] = nloc; b.st[1] = nx; }
        const unsigned old = xb_add(&bar[XB_XSUB(b.x)], 1u);
        const unsigned gen = old / nloc;
        if (old + 1u == (gen + 1u) * nloc) {
            __builtin_amdgcn_fence(__ATOMIC_RELEASE, "agent");
            asm volatile("s_waitcnt vmcnt(0)" ::: "memory");
            const unsigned og = xb_add(&bar[XB_TOP], 1u);
            const unsigned tg = og / nx;
            if (og + 1u == (tg + 1u) * nx) xb_add(&bar[XB_TOPGEN], 1u);
            else XB_SPIN(xb_ld(&bar[XB_TOPGEN]) == tg, bar);
            __builtin_amdgcn_fence(__ATOMIC_ACQUIRE, "agent");
            xb_add(&bar[XB_XGEN(b.x)], 1u);
            asm volatile("s_waitcnt vmcnt(0)" ::: "memory");
        } else {
            XB_SPIN(xb_ld(&bar[XB_XGEN(b.x)]) == gen, bar);
            __builtin_amdgcn_fence(__ATOMIC_ACQUIRE, "agent");
            asm volatile("s_waitcnt vmcnt(0)" ::: "memory");
        }
    }
    __syncthreads();
}

struct Params {
    const float *x, *c, *ctx, *c_ctx, *ada_w, *ada_b, *norm1_g, *norm2_g, *w_in, *rpb, *w_att_o, *w_fourier, *w_pool, *pool_scale, *w_out, *w_router, *w_eg, *w_eu, *w_ed, *final_g;
    float* out; unsigned char* ws; int l_lo, l_hi;
};
struct Frame {
    LAS unsigned char* lds;
    int tid, lane, wave, G, bid;
    unsigned char* ws;
};
#define WSP(T, off) ((T*)(F.ws + (off)))

struct Unit { int grp, pm, pn, seg; };
struct GroupSched {
    int ng, nM, nN, G, c; int tM, tN, tpm0, tpn0;
    __device__ __forceinline__ void init(int ng_, int nM_, int nN_, int G_, int c_, int tM_ = 0, int tN_ = 0, int tpm0_ = 0, int tpn0_ = 0) { ng = ng_; nM = nM_; nN = nN_; G = G_; c = c_; tM = tM_; tN = tN_; tpm0 = tpm0_; tpn0 = tpn0_; }
    __device__ __forceinline__ bool next(int i, Unit& u) const {
        const int per = nM * nN; const int L = i * G + c;
        if (L < ng * per) {
            u.grp = L / per; int wgid = L - u.grp * per;
            { const int q = per / 8, r = per % 8, xcd = wgid % 8, off = wgid / 8; wgid = (xcd < r ? xcd * (q + 1) : r * (q + 1) + (xcd - r) * q) + off; }
            const int nig = 8 * nN, gid = wgid / nig, fm = gid * 8, gsz = (nM - fm) < 8 ? (nM - fm) : 8;
            u.pm = fm + ((wgid % nig) % gsz); u.pn = (wgid % nig) / gsz; u.seg = 0; return true;
        }
        const int w = L - ng * per;
        if (w < tM * tN) { u.grp = ng; u.pm = tpm0 + (w % tM); u.pn = tpn0 + (w / tM); u.seg = 0; return true; }
        return false;
    }
};
struct Operands { const bf16* A; const bf16* Bt; int lda, ldb, slot0, K; int bmap; };

constexpr int HTB = 128 * 64 * 2;
__device__ __forceinline__ int lds_byte(int r, int c) { const int st = (r >> 4) * 2 + (c >> 5), rr = r & 15, cc = c & 31, ob = rr * 64 + cc * 2; return st * 1024 + (ob ^ (((ob >> 9) & 1) << 5)); }
__device__ __forceinline__ int perm32(int rho) { const int n = rho >> 4, i = rho & 15; return 8 * (i >> 2) + 4 * n + (i & 3); }
__device__ __forceinline__ void stage_rc(int b, int& R, int& C) { const int st = b / 1024, sb = b % 1024, swz = sb ^ (((sb >> 9) & 1) << 5); R = (st >> 1) * 16 + swz / 64; C = (st & 1) * 32 + (swz % 64) / 2; }
template <bool GATHER, bool PERM, class Sched, class Addr, class Epi>
__device__ __forceinline__ void gemm_fast(LAS unsigned char* lds, const int tid, const Sched& S, const Addr& AD, const Epi& E, const int* __restrict__ grows) {
    const int wid = __builtin_amdgcn_readfirstlane(tid >> 6), lane = tid & 63, wr = wid >> 2, wc = wid & 3, fr = lane & 15, fq = lane >> 4;
    int sR[2], sRb[2]; unsigned sC[2];
    unsigned cvg[2][2], nvg[2][2], cvb[2][2], nvb[2][2];
#pragma unroll
    for (int i = 0; i < 2; ++i) { int R, C; stage_rc(tid * 16 + i * 8192, R, C); sR[i] = R; sC[i] = (unsigned)C * 2u; sRb[i] = PERM ? ((R & ~31) + perm32(R & 31)) : R; }
    const size_t kstep = 128;
    const unsigned ldsw = (unsigned)wid * 1024u;
    const int aoff = lds_byte(wr * 64 + fr, fq * 8), boff = lds_byte(wc * 32 + fr, fq * 8);
#define PG8_SA(b, h) (((b) * 2 + (h)) * HTB)
#define PG8_SB(b, h) ((4 + (b) * 2 + (h)) * HTB)
#define PG8_STAGE(bufoff, gbase, voff) do { _Pragma("unroll") for (int _i = 0; _i < 2; ++_i) \
        __builtin_amdgcn_global_load_lds((const unsigned*)((const char*)(gbase) + (voff)[_i]), (LAS unsigned*)(lds + (bufoff) + ldsw + _i * 8192), 16, 0, 0); } while (0)
#define PG8_LDA(dst, b, h) do { _Pragma("unroll") for (int m = 0; m < 4; ++m) _Pragma("unroll") for (int k = 0; k < 2; ++k) dst[m][k] = *(const LAS bf16x8*)(lds + PG8_SA(b, h) + aoff + m * 2048 + k * 1024); } while (0)
#define PG8_LDB(dst, b, h) do { _Pragma("unroll") for (int n = 0; n < 2; ++n) _Pragma("unroll") for (int k = 0; k < 2; ++k) dst[n][k] = *(const LAS bf16x8*)(lds + PG8_SB(b, h) + boff + n * 2048 + k * 1024); } while (0)
#define PG8_MMA(ai, bj, At, Bt) do { __builtin_amdgcn_s_setprio(1); _Pragma("unroll") for (int m = 0; m < 4; ++m) _Pragma("unroll") for (int n = 0; n < 2; ++n) _Pragma("unroll") for (int k = 0; k < 2; ++k) \
        acc[ai][bj][m][n] = __builtin_amdgcn_mfma_f32_16x16x32_bf16(Bt[n][k], At[m][k], acc[ai][bj][m][n], 0, 0, 0); __builtin_amdgcn_s_setprio(0); } while (0)
#define PG8_WAIT_V(n) asm volatile("s_waitcnt vmcnt(" #n ")" ::: "memory")
#define PG8_WAIT_L(n) asm volatile("s_waitcnt lgkmcnt(" #n ")" ::: "memory")
#define PG8_BAR __builtin_amdgcn_s_barrier()
#define PG8_SCHED __builtin_amdgcn_sched_barrier(0)
#define PG8_GIDX(dst, op_) do { _Pragma("unroll") for (int h_ = 0; h_ < 2; ++h_) _Pragma("unroll") for (int i_ = 0; i_ < 2; ++i_) dst[h_][i_] = (unsigned)grows[(op_).slot0 + h_ * 128 + sR[i_]] * (unsigned)((op_).lda * 2) + sC[i_]; } while (0)
#define PG8_AOFF(dst, op_) do { _Pragma("unroll") for (int h_ = 0; h_ < 2; ++h_) _Pragma("unroll") for (int i_ = 0; i_ < 2; ++i_) dst[h_][i_] = (unsigned)((sR[i_] + 128 * h_) * (op_).lda) * 2u + sC[i_]; } while (0)
#define PG8_BOFF(dst, op_) do { _Pragma("unroll") for (int h_ = 0; h_ < 2; ++h_) _Pragma("unroll") for (int i_ = 0; i_ < 2; ++i_) { const int c_ = sRb[i_] + 128 * h_; \
        dst[h_][i_] = (unsigned)(((op_).bmap ? (64 * (c_ & 7) + (c_ >> 3)) : c_) * (op_).ldb) * 2u + sC[i_]; } } while (0)
#define PG8_COPY(dst, src) do { _Pragma("unroll") for (int h_ = 0; h_ < 2; ++h_) _Pragma("unroll") for (int i_ = 0; i_ < 2; ++i_) dst[h_][i_] = src[h_][i_]; } while (0)
    Unit cur, nxt; int ui = 0;
    if (!S.next(0, cur)) return;
    f32x4 acc[2][2][4][2];
#pragma unroll
    for (int a = 0; a < 2; ++a)
#pragma unroll
        for (int b = 0; b < 2; ++b)
#pragma unroll
            for (int m = 0; m < 4; ++m)
#pragma unroll
                for (int n = 0; n < 2; ++n) acc[a][b][m][n] = (f32x4){0.f, 0.f, 0.f, 0.f};
    bf16x8 At[4][2], B0[2][2], B1[2][2];
    const char* cA; const char* cB; int nt;
    bool has_next; const char* nA; const char* nB; int nnt;
    { const Operands op = AD(cur); cA = (const char*)op.A; cB = (const char*)op.Bt; nt = op.K / 64; PG8_BOFF(cvb, op);
      has_next = S.next(1, nxt); const Operands o1 = has_next ? AD(nxt) : op; PG8_BOFF(nvb, o1); nA = (const char*)o1.A; nB = (const char*)o1.Bt; nnt = o1.K / 64;
      if constexpr (GATHER) { PG8_GIDX(cvg, op); PG8_GIDX(nvg, o1); PG8_WAIT_V(0); } else { PG8_AOFF(cvg, op); PG8_AOFF(nvg, o1); } }
    PG8_STAGE(PG8_SB(0, 0), cB, cvb[0]); PG8_STAGE(PG8_SB(0, 1), cB, cvb[1]); PG8_STAGE(PG8_SA(0, 0), cA, cvg[0]); PG8_STAGE(PG8_SA(0, 1), cA, cvg[1]);
    if (wr == 1) PG8_BAR;
    PG8_WAIT_V(2); PG8_BAR;
    PG8_STAGE(PG8_SB(1, 0), cB + kstep, cvb[0]); PG8_STAGE(PG8_SA(1, 0), cA + kstep, cvg[0]); PG8_STAGE(PG8_SB(1, 1), cB + kstep, cvb[1]);
    PG8_WAIT_V(6); PG8_BAR;
    for (;;) {
#pragma unroll 1
        for (int t = 0; t < nt; t += 2) {
            const bool last = (t == nt - 2);
            const char* a1 = cA + (size_t)(t + 1) * kstep;
            const char* a2 = last ? nA : cA + (size_t)(t + 2) * kstep; const char* b2 = last ? nB : cB + (size_t)(t + 2) * kstep;
            const char* a3 = a2 + kstep; const char* b3 = b2 + kstep;
            unsigned v2[2][2], w2[2][2];
#pragma unroll
            for (int h_ = 0; h_ < 2; ++h_)
#pragma unroll
                for (int i_ = 0; i_ < 2; ++i_) { v2[h_][i_] = last ? nvg[h_][i_] : cvg[h_][i_]; w2[h_][i_] = last ? nvb[h_][i_] : cvb[h_][i_]; }
            PG8_LDB(B0, 0, 0); PG8_LDB(B1, 0, 1); PG8_SCHED; PG8_LDA(At, 0, 0); PG8_STAGE(PG8_SA(1, 1), a1, cvg[1]);
            PG8_WAIT_V(8); PG8_WAIT_L(0); PG8_BAR; PG8_MMA(0, 0, At, B0); PG8_MMA(0, 1, At, B1); PG8_BAR; PG8_SCHED;
            PG8_LDA(At, 0, 1); PG8_STAGE(PG8_SB(0, 0), b2, w2[0]); PG8_STAGE(PG8_SB(0, 1), b2, w2[1]); PG8_STAGE(PG8_SA(0, 0), a2, v2[0]);
            PG8_WAIT_V(8); PG8_WAIT_L(0); PG8_BAR; PG8_MMA(1, 0, At, B0); PG8_MMA(1, 1, At, B1); PG8_BAR; PG8_SCHED;
            PG8_LDB(B0, 1, 0); PG8_LDB(B1, 1, 1); PG8_SCHED; PG8_LDA(At, 1, 0); PG8_STAGE(PG8_SA(0, 1), a2, v2[1]);
            PG8_WAIT_V(8); PG8_WAIT_L(0); PG8_BAR; PG8_MMA(0, 0, At, B0); PG8_MMA(0, 1, At, B1); PG8_BAR; PG8_SCHED;
            PG8_LDA(At, 1, 1); PG8_STAGE(PG8_SB(1, 0), b3, w2[0]); PG8_STAGE(PG8_SB(1, 1), b3, w2[1]); PG8_STAGE(PG8_SA(1, 0), a3, v2[0]);
            PG8_WAIT_V(8); PG8_WAIT_L(0); PG8_BAR; PG8_MMA(1, 0, At, B0); PG8_MMA(1, 1, At, B1); PG8_BAR; PG8_SCHED;
        }
        if (wr == 0) PG8_BAR;
        unsigned fvg[2][2], fvb[2][2];
        Unit u2; const bool h2 = S.next(ui + 2, u2); const char* fA = nA; const char* fB = nB; int fnt = nnt;
        if (h2) { const Operands o2 = AD(u2); fA = (const char*)o2.A; fB = (const char*)o2.Bt; fnt = o2.K / 64; PG8_BOFF(fvb, o2); if constexpr (GATHER) PG8_GIDX(fvg, o2); else PG8_AOFF(fvg, o2); }
        else { PG8_COPY(fvb, nvb); PG8_COPY(fvg, nvg); }
        { int fr2 = fr, fq2 = fq; asm volatile("" : "+v"(fr2), "+v"(fq2));
          E(acc, cur, wr, wc, fr2, fq2); }
        if (!has_next) break;
        if constexpr (GATHER) PG8_WAIT_V(0);
        PG8_COPY(cvg, nvg); PG8_COPY(nvg, fvg); PG8_COPY(cvb, nvb); PG8_COPY(nvb, fvb);
        if (E.reset(cur)) {
#pragma unroll
        for (int a = 0; a < 2; ++a)
#pragma unroll
            for (int b = 0; b < 2; ++b)
#pragma unroll
                for (int m = 0; m < 4; ++m)
#pragma unroll
                    for (int n = 0; n < 2; ++n) acc[a][b][m][n] = (f32x4){0.f, 0.f, 0.f, 0.f};
        }
        cur = nxt; cA = nA; cB = nB; nt = nnt; ++ui;
        nxt = u2; has_next = h2; nA = fA; nB = fB; nnt = fnt;
        if (wr == 1) PG8_BAR;
    }
    PG8_WAIT_V(0);
    PG8_BAR;
#undef PG8_SA
#undef PG8_SB
#undef PG8_STAGE
#undef PG8_LDA
#undef PG8_LDB
#undef PG8_MMA
#undef PG8_WAIT_V
#undef PG8_WAIT_L
#undef PG8_BAR
#undef PG8_SCHED
#undef PG8_GIDX
#undef PG8_AOFF
#undef PG8_BOFF
#undef PG8_COPY
}
template <class F> struct EpiFn { F f; __device__ __forceinline__ void operator()(f32x4 (&acc)[2][2][4][2], const Unit& u, int wr, int wc, int fr, int fq) const { f(acc, u, wr, wc, fr, fq); } __device__ __forceinline__ bool reset(const Unit&) const { return true; } };
template <class F> __device__ __forceinline__ EpiFn<F> mk_epi(F f) { return EpiFn<F>{f}; }
template <class F> struct EpiSeg { F f; int last; __device__ __forceinline__ void operator()(f32x4 (&acc)[2][2][4][2], const Unit& u, int wr, int wc, int fr, int fq) const { f(acc, u, wr, wc, fr, fq); } __device__ __forceinline__ bool reset(const Unit& u) const { return u.seg == last; } };
template <class F> __device__ __forceinline__ EpiSeg<F> mk_epi_seg(F f, int last) { return EpiSeg<F>{f, last}; }
template <int NSEG> struct SegSched { GroupSched base; __device__ __forceinline__ bool next(int j, Unit& u) const { if (!base.next(j / NSEG, u)) return false; u.seg = j % NSEG; return true; } };
#ifndef DUP_PH
#define DUP_PH -1
#endif
#define REP_BEGIN(k) _Pragma("unroll 1") for (int rep_ = 0; rep_ < ((DUP_PH == (k)) ? 2 : 1); ++rep_) { if (rep_) { if constexpr (PH < 0) xcd_barrier(bar); }
#define REP_END }
#define GEMM(S, AD, E, K, lda, ldb) gemm_fast<false, false>(F.lds, F.tid, S, AD, mk_epi(E), nullptr)
#define GEMM_P(S, AD, E) gemm_fast<false, true>(F.lds, F.tid, S, AD, mk_epi(E), nullptr)
#define GEMM_GATHER(S, AD, E, K, lda, ldb, rows) gemm_fast<true, true>(F.lds, F.tid, S, AD, mk_epi(E), rows)
#define EPI_ARGS f32x4 (&acc)[2][2][4][2], const Unit& u, int wr, int wc, int fr, int fq
#define EPI_FOR(...) _Pragma("unroll") for (int ai = 0; ai < 2; ++ai) _Pragma("unroll") for (int m = 0; m < 4; ++m) { const int r = ai * 128 + wr * 64 + m * 16 + fr; \
    _Pragma("unroll") for (int bj = 0; bj < 2; ++bj) _Pragma("unroll") for (int n = 0; n < 2; ++n) { const int c = bj * 128 + wc * 32 + n * 16 + 4 * fq; const f32x4 v = acc[ai][bj][m][n]; __VA_ARGS__ } }
#define EPI_FOR8(...) _Pragma("unroll") for (int ai = 0; ai < 2; ++ai) _Pragma("unroll") for (int m = 0; m < 4; ++m) { const int r = ai * 128 + wr * 64 + m * 16 + fr; \
    _Pragma("unroll") for (int bj = 0; bj < 2; ++bj) { const int c = bj * 128 + wc * 32 + 8 * fq; const f32x4 v0 = acc[ai][bj][m][0], v1 = acc[ai][bj][m][1]; __VA_ARGS__ } }
__device__ __forceinline__ void st_bf8(bf16* p, f32x4 a, f32x4 b) { u32x4 w; w.x = pk2(a[0], a[1]); w.y = pk2(a[2], a[3]); w.z = pk2(b[0], b[1]); w.w = pk2(b[2], b[3]); *(u32x4*)p = w; }
__device__ __forceinline__ void st_bf4(bf16* p, f32x4 v) { u32x2 w; w.x = pk2(v[0], v[1]); w.y = pk2(v[2], v[3]); *(u32x2*)p = w; }

__device__ __forceinline__ void p_mod(const Params& P, Frame& F) {
    LAS float* sc = (LAS float*)F.lds;
    LAS float* red = (LAS float*)(F.lds + 9 * 1024 * 4);
    float* MOD = WSP(float, WS_MOD);
    bool have = false;
    for (int it = F.bid; it < 2 * 96; it += F.G) {
        if (!have) {
            for (int i = F.tid; i < 9 * 1024; i += NTHREADS) { const int r = i >> 10, k = i & 1023; const float v = r < 8 ? P.c[r * 1024 + k] : P.c_ctx[k]; sc[i] = v * sigmoidf_(v); }
            have = true;
        }
        __syncthreads();
        const int l = it / 96, j0 = (it % 96) * 64, jj = F.tid & 63, kc = F.tid >> 6;
        const float* W = P.ada_w + (size_t)l * 1024 * 6144 + j0 + jj;
        float a[9];
#pragma unroll
        for (int r = 0; r < 9; ++r) a[r] = 0.f;
#pragma unroll 8
        for (int k = kc * 128; k < kc * 128 + 128; ++k) { const float w = W[(size_t)k * 6144];
#pragma unroll
            for (int r = 0; r < 9; ++r) a[r] += sc[r * 1024 + k] * w; }
#pragma unroll
        for (int r = 0; r < 9; ++r) red[(kc * 9 + r) * 64 + jj] = a[r];
        __syncthreads();
        for (int o = F.tid; o < 9 * 64; o += NTHREADS) { const int r = o >> 6, j = o & 63; float s = 0.f;
#pragma unroll
            for (int q = 0; q < 8; ++q) s += red[(q * 9 + r) * 64 + j];
            MOD[((size_t)l * 9 + r) * 6144 + j0 + j] = s + P.ada_b[l * 6144 + j0 + j]; }
    }
    __syncthreads();
}
__device__ __forceinline__ void p_dftgen(Frame& F) {
    LAS float* tab = (LAS float*)F.lds;
    for (int j = F.tid; j < 4096; j += NTHREADS) tab[j] = cospif((float)j * (1.0f / 2048.0f));
    __syncthreads();
    bf16* DC_ = WSP(bf16, WS_DFTC); bf16* M1 = WSP(bf16, WS_M1T); bf16* M2 = WSP(bf16, WS_M2T);
    const int nchunk = 256 * 64 + 256 * 32 + 256 * 64;
    for (int ch = F.bid * NTHREADS + F.tid; ch < nchunk; ch += F.G * NTHREADS) {
        float v[8]; bf16* dst;
        if (ch < 256 * 64) { const int kf = ch >> 6, col0 = (ch & 63) * 8, cs = col0 >> 8, l0 = col0 & 255;
#pragma unroll
            for (int i = 0; i < 8; ++i) { const int j = ((kf * (l0 + i)) & 255) * 16; v[i] = cs ? -tab[(j + 3072) & 4095] : tab[j]; }
            dst = DC_ + (size_t)kf * 512 + col0; }
        else if (ch < 256 * 64 + 256 * 32) { const int c2 = ch - 256 * 64, row = c2 >> 5, col0 = (c2 & 31) * 8, ri = row >> 7, h = (row >> 6) & 1, k1 = row & 63, h2 = col0 >> 7, cs = (col0 >> 6) & 1, l10 = col0 & 63;
#pragma unroll
            for (int i = 0; i < 8; ++i) { const int j = ((k1 * (l10 + i)) & 63) * 64; const float c = tab[j], sn = tab[(j + 3072) & 4095];
                v[i] = (h != h2) ? 0.f : (ri == 0 ? (cs == 0 ? c : -sn) : (cs == 0 ? sn : c)); }
            dst = M1 + (size_t)row * 256 + col0; }
        else { const int c2 = ch - 256 * 64 - 256 * 32, row = c2 >> 6, col0 = (c2 & 63) * 8, q = row >> 6, k2 = row & 63, q2 = col0 >> 7, ri = (col0 >> 6) & 1, l20 = col0 & 63;
#pragma unroll
            for (int i = 0; i < 8; ++i) { const int j = ((k2 * (l20 + i)) & 63) * 64; const float c = tab[j], sn = tab[(j + 3072) & 4095];
                v[i] = (q != q2) ? 0.f : (ri == 0 ? c : -sn); }
            dst = M2 + (size_t)row * 512 + col0; }
        u32x4 o; o.x = pk2(v[0], v[1]); o.y = pk2(v[2], v[3]); o.z = pk2(v[4], v[5]); o.w = pk2(v[6], v[7]);
        *(u32x4*)dst = o;
    }
    __syncthreads();
}
__device__ __forceinline__ void transpose_item(const float* W, int ldw, int k0, int n0, bf16* WT, int ldt, int drow0, LAS float* scr, int lane) {
    f32x4 ld[8];
#pragma unroll
    for (int i = 0; i < 8; ++i) ld[i] = *(const f32x4*)(W + (size_t)(k0 + 8 * i + (lane >> 3)) * ldw + n0 + 4 * (lane & 7));
#pragma unroll
    for (int i = 0; i < 8; ++i) { LAS float* d = scr + (8 * i + (lane >> 3)) * 33 + 4 * (lane & 7); d[0] = ld[i][0]; d[1] = ld[i][1]; d[2] = ld[i][2]; d[3] = ld[i][3]; }
    LDS_WAIT(); asm volatile("" ::: "memory");
    const int c = lane & 7;
#pragma unroll
    for (int j = 0; j < 4; ++j) { const int n = (lane >> 3) + 8 * j; const LAS float* s = scr + (8 * c) * 33 + n;
        u32x4 o; o.x = pk2(s[0 * 33], s[1 * 33]); o.y = pk2(s[2 * 33], s[3 * 33]); o.z = pk2(s[4 * 33], s[5 * 33]); o.w = pk2(s[6 * 33], s[7 * 33]);
        *(u32x4*)(WT + (size_t)(drow0 + n) * ldt + k0 + 8 * c) = o; }
    LDS_WAIT(); asm volatile("" ::: "memory");
}
__device__ __forceinline__ void p_wconv(const Params& P, Frame& F, int l) {
    LAS float* scr = (LAS float*)(F.lds + F.wave * 16384);
    const int gw = F.bid * NWAVES + F.wave, NGW = F.G * NWAVES;
    const float* w_in = P.w_in + (size_t)l * 1024 * INW;
    bf16* WA = WSP(bf16, WS_WA); bf16* WFV = WSP(bf16, WS_WFV);
    constexpr int I_K = 16 * 32, I_Q = 16 * 32, I_P = 16 * 16, I_G = 16 * 96, I_V = 16 * 32, I_AO = 16 * 32, I_FO = 8 * 32, I_OUT = 16 * 32;
    constexpr int NSM = I_K + I_Q + I_P + I_G + I_V + I_AO + I_FO + I_OUT;
    for (int it = gw; it < NSM; it += NGW) {
        int r = it;
        if (r < I_K) { transpose_item(w_in, INW, (r / 32) * 64, 0 + (r % 32) * 32, WA, 1024, 0 + (r % 32) * 32, scr, F.lane); continue; } r -= I_K;
        if (r < I_Q) { transpose_item(w_in, INW, (r / 32) * 64, 2048 + (r % 32) * 32, WA, 1024, 1024 + (r % 32) * 32, scr, F.lane); continue; } r -= I_Q;
        if (r < I_P) { transpose_item(w_in, INW, (r / 16) * 64, 3584 + (r % 16) * 32, WA, 1024, 2048 + (r % 16) * 32, scr, F.lane); continue; } r -= I_P;
        if (r < I_G) { transpose_item(w_in, INW, (r / 96) * 64, 4096 + (r % 96) * 32, WA, 1024, 2560 + (r % 96) * 32, scr, F.lane); continue; } r -= I_G;
        if (r < I_V) { transpose_item(w_in, INW, (r / 32) * 64, 1024 + (r % 32) * 32, WFV, 1024, 1024 + (r % 32) * 32, scr, F.lane); continue; } r -= I_V;
        if (r < I_AO) { transpose_item(P.w_att_o + (size_t)l * 1024 * 1024, 1024, (r / 32) * 64, (r % 32) * 32, WSP(bf16, WS_WAO), 1024, (r % 32) * 32, scr, F.lane); continue; } r -= I_AO;
        if (r < I_FO) { transpose_item(P.w_fourier + (size_t)l * 512 * 1024, 1024, (r / 32) * 64, (r % 32) * 32, WSP(bf16, WS_WFO), 512, (r % 32) * 32, scr, F.lane); continue; } r -= I_FO;
        transpose_item(P.w_out + (size_t)l * 1024 * 1024, 1024, (r / 32) * 64, (r % 32) * 32, WSP(bf16, WS_WOUT), 1024, (r % 32) * 32, scr, F.lane);
    }
    constexpr int I_E = 16 * 88;
    bf16* WGU = WSP(bf16, WS_WGU); bf16* WD = WSP(bf16, WS_WD);
    for (int it = gw; it < 3 * 16 * I_E; it += NGW) {
        const int which = it / (16 * I_E), r0 = it % (16 * I_E), e = r0 / I_E, r = r0 % I_E;
        if (which < 2) { const int kb = r / 88, nb = r % 88, n0 = nb * 32;
            const float* src = (which == 0 ? P.w_eg : P.w_eu) + ((size_t)l * 16 + e) * 1024 * FF;
            transpose_item(src, FF, kb * 64, n0, WGU + (size_t)e * 5632 * 1024, 1024, (n0 >> 7) * 256 + (which ? 128 : 0) + (n0 & 127), scr, F.lane); }
        else { const int kb = r / 32, nb = r % 32;
            transpose_item(P.w_ed + ((size_t)l * 16 + e) * FF * 1024, 1024, kb * 64, nb * 32, WD + (size_t)e * 1024 * FF, FF, nb * 32, scr, F.lane); }
    }
    { bf16* WPO = WSP(bf16, WS_WPO); const float* wp = P.w_pool + (size_t)l * 4 * 128 * 256;
      for (int i = F.bid * NTHREADS + F.tid; i < 1024 * 256; i += F.G * NTHREADS) { const int n = i >> 8, kk = i & 255, g = n >> 8, f = n & 255;
          WPO[i] = (bf16)(((kk >> 7) == (g & 1)) ? f2bf(wp[((size_t)g * 128 + (kk & 127)) * 256 + f]) : 0u); } }
    { LAS float* t128 = (LAS float*)F.lds;
      __syncthreads();
      for (int j = F.tid; j < 128; j += NTHREADS) t128[j] = cospif((float)j * (1.0f / 64.0f));
      __syncthreads();
      for (int i = F.bid * NTHREADS + F.tid; i < 1024 * 1024; i += F.G * NTHREADS) { const int fc = i >> 10, k = i & 1023, cs = fc & 1, gm = fc >> 1, g = gm >> 7, m = gm & 127;
          const float* src = w_in + (size_t)k * INW + 3072 + g * 128; float s = 0.f; const int ph = cs ? 96 : 0;
          for (int c = 0; c < 128; ++c) s += src[c] * t128[(m * c + ph) & 127];
          WFV[i] = (bf16)f2bf(s); }
      __syncthreads(); }
}

struct RowMod { const float* g; const float* sh; const float* sc; };
__device__ __forceinline__ void row_load(const float* row, int lane, f32x4 (&v)[4]) {
#pragma unroll
    for (int j = 0; j < 4; ++j) v[j] = *(const f32x4*)(row + 4 * lane + 256 * j);
}
__device__ __forceinline__ float row_rstd(const f32x4 (&v)[4]) {
    float s = 0.f;
#pragma unroll
    for (int j = 0; j < 4; ++j) s += (v[j][0] * v[j][0] + v[j][1] * v[j][1]) + (v[j][2] * v[j][2] + v[j][3] * v[j][3]);
    return rsqrtf(wave_sum(s) * (1.0f / 1024.0f) + RMS_EPS);
}
__device__ __forceinline__ void row_modulate(const f32x4 (&v)[4], float rstd, const RowMod& M, int lane, f32x4 (&y)[4]) {
#pragma unroll
    for (int j = 0; j < 4; ++j) { const int k = 4 * lane + 256 * j; const f32x4 g = *(const f32x4*)(M.g + k), sh = *(const f32x4*)(M.sh + k), sc = *(const f32x4*)(M.sc + k);
        y[j] = v[j] * rstd * g * (sc + 1.0f) + sh; }
}
__device__ __forceinline__ void row_store_bf(bf16* row, int lane, const f32x4 (&y)[4]) {
#pragma unroll
    for (int j = 0; j < 4; ++j) st_bf4(row + 4 * lane + 256 * j, y[j]);
}
__device__ __forceinline__ const float* mod_ptr(Frame& F, int l, int row, int which) { const int mr = row < RL ? (row >> 12) : 8; return WSP(float, WS_MOD) + ((size_t)l * 9 + mr) * 6144 + which * 1024; }

__device__ __forceinline__ void p_rowpass_a0(const Params& P, Frame& F) {
    const int gw = F.bid * NWAVES + F.wave, NGW = F.G * NWAVES; bf16* H = WSP(bf16, WS_H);
    f32x4 vn[4]; int row = gw;
    if (row < RT) row_load(row < RL ? P.x + (size_t)row * DM : P.ctx + (size_t)(row - RL) * DM, F.lane, vn);
    for (; row < RT; row += NGW) {
        f32x4 v[4], y[4];
#pragma unroll
        for (int j = 0; j < 4; ++j) v[j] = vn[j];
        { const int nr = row + NGW; if (nr < RT) row_load(nr < RL ? P.x + (size_t)nr * DM : P.ctx + (size_t)(nr - RL) * DM, F.lane, vn); }
        const float rs = row_rstd(v);
        RowMod M{P.norm1_g, mod_ptr(F, 0, row, 0), mod_ptr(F, 0, row, 1)};
        row_modulate(v, rs, M, F.lane, y); row_store_bf(H + (size_t)row * DM, F.lane, y);
    }
}
__device__ __forceinline__ void p_rowpass_f(const Params& P, Frame& F, int l, int nrows) {
    const int gw = F.bid * NWAVES + F.wave, NGW = F.G * NWAVES; bf16* H = WSP(bf16, WS_H); float* AFF = WSP(float, WS_AFF);
    const float* wr = P.w_router + (size_t)l * 1024 * 16;
    LAS float* wl = (LAS float*)F.lds;
    __syncthreads();
    for (int i = F.tid; i < 16384; i += NTHREADS) wl[(i & 15) * 1024 + (i >> 4)] = wr[i];
    __syncthreads();
    f32x4 vn[4]; int row = gw;
    if (row < nrows) row_load(row < RL ? P.out + (size_t)row * DM : WSP(float, WS_XC) + (size_t)(row - RL) * DM, F.lane, vn);
    for (; row < nrows; row += NGW) {
        f32x4 v[4], y[4];
#pragma unroll
        for (int j = 0; j < 4; ++j) v[j] = vn[j];
        { const int nr = row + NGW; if (nr < nrows) row_load(nr < RL ? P.out + (size_t)nr * DM : WSP(float, WS_XC) + (size_t)(nr - RL) * DM, F.lane, vn); }
        const float rs = row_rstd(v);
        RowMod M{P.norm2_g + l * 1024, mod_ptr(F, l, row, 3), mod_ptr(F, l, row, 4)};
        row_modulate(v, rs, M, F.lane, y); row_store_bf(H + (size_t)row * DM, F.lane, y);
        float lg[16];
        int wo = 4 * F.lane; asm volatile("" : "+v"(wo));
#pragma unroll
        for (int e = 0; e < 16; ++e) { float a = 0.f;
#pragma unroll
            for (int j = 0; j < 4; ++j) { const f32x4 w = *(const LAS f32x4*)(wl + e * 1024 + wo + 256 * j); a += (y[j][0] * w[0] + y[j][1] * w[1]) + (y[j][2] * w[2] + y[j][3] * w[3]); }
            lg[e] = a; }
        float mx = -1e30f;
#pragma unroll
        for (int e = 0; e < 16; ++e) { lg[e] = wave_sum(lg[e]); mx = fmaxf(mx, lg[e]); }
        float den = 0.f;
#pragma unroll
        for (int e = 0; e < 16; ++e) { lg[e] = __expf(lg[e] - mx); den += lg[e]; }
        const float inv = 1.0f / den;
        if (F.lane < 16) { float mine = 0.f;
#pragma unroll
            for (int e = 0; e < 16; ++e) mine = (F.lane == e) ? lg[e] : mine;
            AFF[(size_t)row * 16 + F.lane] = mine * inv; }
    }
    __syncthreads();
}
__device__ __forceinline__ void p_rowpass_k(const Params& P, Frame& F, int l, int nrows) {
    const int gw = F.bid * NWAVES + F.wave, NGW = F.G * NWAVES; bf16* H = WSP(bf16, WS_H);
    const int* SEL = WSP(int, WS_SEL); const bf16* Y = WSP(bf16, WS_Y);
    f32x4 vn[4]; int seln = -1; int row = gw;
    if (row < nrows) { row_load(row < RL ? P.out + (size_t)row * DM : WSP(float, WS_XC) + (size_t)(row - RL) * DM, F.lane, vn); seln = F.lane < 16 ? SEL[(size_t)row * 16 + F.lane] : -1; }
    for (; row < nrows; row += NGW) {
        float* xr = row < RL ? P.out + (size_t)row * DM : WSP(float, WS_XC) + (size_t)(row - RL) * DM;
        f32x4 v[4], a[4]; const int sel = seln;
#pragma unroll
        for (int j = 0; j < 4; ++j) { v[j] = vn[j]; a[j] = (f32x4){0.f, 0.f, 0.f, 0.f}; }
        { const int nr = row + NGW; if (nr < nrows) { row_load(nr < RL ? P.out + (size_t)nr * DM : WSP(float, WS_XC) + (size_t)(nr - RL) * DM, F.lane, vn); seln = F.lane < 16 ? SEL[(size_t)nr * 16 + F.lane] : -1; } }
        unsigned em = (unsigned)__ballot(sel >= 0) & 0xffffu;
        while (em) { const int e = __builtin_ctz(em); em &= em - 1; const int s = __builtin_amdgcn_readlane(sel, e); const bf16* yr = Y + (size_t)s * DM;
#pragma unroll
            for (int j = 0; j < 4; ++j) { const u32x2 w = *(const u32x2*)(yr + 4 * F.lane + 256 * j); a[j][0] += bflo(w.x); a[j][1] += bfhi(w.x); a[j][2] += bflo(w.y); a[j][3] += bfhi(w.y); } }
        const float* g2 = mod_ptr(F, l, row, 5);
#pragma unroll
        for (int j = 0; j < 4; ++j) { const f32x4 g = *(const f32x4*)(g2 + 4 * F.lane + 256 * j); v[j] = v[j] + g * a[j]; }
        const float rs = row_rstd(v);
        if (l == 0) {
#pragma unroll
            for (int j = 0; j < 4; ++j) *(f32x4*)(xr + 4 * F.lane + 256 * j) = v[j];
            f32x4 y[4]; RowMod M{P.norm1_g + 1024, mod_ptr(F, 1, row, 0), mod_ptr(F, 1, row, 1)};
            row_modulate(v, rs, M, F.lane, y); row_store_bf(H + (size_t)row * DM, F.lane, y);
        } else {
#pragma unroll
            for (int j = 0; j < 4; ++j) { const f32x4 g = *(const f32x4*)(P.final_g + 4 * F.lane + 256 * j); *(f32x4*)(xr + 4 * F.lane + 256 * j) = v[j] * rs * g; }
        }
    }
}

constexpr int ACK_STRIDE = 72, ACV_STRIDE = 264;
constexpr int ALDS_CK = 0, ALDS_CV = 256 * ACK_STRIDE * 2, ALDS_RP = ALDS_CV + 64 * ACV_STRIDE * 2;
struct AttnState { float m, sum; f32x4 o[4]; };
__device__ __forceinline__ float xrow16_max(float x) {
    auto s = __builtin_amdgcn_permlane16_swap(__float_as_uint(x), __float_as_uint(x), false, false);
    x = fmaxf(__uint_as_float(s[0]), __uint_as_float(s[1]));
    auto t = __builtin_amdgcn_permlane32_swap(__float_as_uint(x), __float_as_uint(x), false, false);
    return fmaxf(__uint_as_float(t[0]), __uint_as_float(t[1]));
}
__device__ __forceinline__ float xrow16_sum(float x) {
    auto s = __builtin_amdgcn_permlane16_swap(__float_as_uint(x), __float_as_uint(x), false, false);
    x = __uint_as_float(s[0]) + __uint_as_float(s[1]);
    auto t = __builtin_amdgcn_permlane32_swap(__float_as_uint(x), __float_as_uint(x), false, false);
    return __uint_as_float(t[0]) + __uint_as_float(t[1]);
}
#define MFMA16(a, b, c) __builtin_amdgcn_mfma_f32_16x16x32_bf16((a), (b), (c), 0, 0, 0)
template <int NT>
__device__ __forceinline__ void attn_tail(AttnState& S, f32x4 (&sc)[NT], const u32x4 (&vw)[NT / 2][4]) {
    float cm = -__builtin_inff();
#pragma unroll
    for (int t = 0; t < NT; ++t)
#pragma unroll
        for (int j = 0; j < 4; ++j) cm = fmaxf(cm, sc[t][j]);
    cm = xrow16_max(cm);
    const bool need = (fabsf(cm) > 12.0f) && (cm > -1e30f);
    if (__builtin_amdgcn_ballot_w64(need) != 0ull) {
        const float d = need ? cm : 0.f, scl = __builtin_amdgcn_exp2f(-d);
        S.m += d; S.sum *= scl;
#pragma unroll
        for (int dt = 0; dt < 4; ++dt) S.o[dt] = S.o[dt] * scl;
#pragma unroll
        for (int t = 0; t < NT; ++t)
#pragma unroll
            for (int j = 0; j < 4; ++j) sc[t][j] -= d;
    }
    float ps = 0.f;
#pragma unroll
    for (int t = 0; t < NT; ++t)
#pragma unroll
        for (int j = 0; j < 4; ++j) { const float p = __builtin_amdgcn_exp2f(sc[t][j]); sc[t][j] = p; ps += p; }
    S.sum += ps;
#pragma unroll
    for (int ks = 0; ks < NT / 2; ++ks) { u32x4 pw; pw.x = pk2(sc[2 * ks][0], sc[2 * ks][1]); pw.y = pk2(sc[2 * ks][2], sc[2 * ks][3]); pw.z = pk2(sc[2 * ks + 1][0], sc[2 * ks + 1][1]); pw.w = pk2(sc[2 * ks + 1][2], sc[2 * ks + 1][3]);
        const bf16x8 pf = __builtin_bit_cast(bf16x8, pw);
#pragma unroll
        for (int dt = 0; dt < 4; ++dt) S.o[dt] = MFMA16(__builtin_bit_cast(bf16x8, vw[ks][dt]), pf, S.o[dt]); }
}
__device__ __forceinline__ void attn_unit2(const bf16* __restrict__ KQ, const bf16* __restrict__ VT, bf16* __restrict__ ATT, LAS unsigned char* lds,
                                           const int b, const int h, const int rowqA, const int rowqB, const bool win, const int r, const int qt, const int lane) {
    const int l15 = lane & 15, g = lane >> 4;
    const f32x4 z = {0.f, 0.f, 0.f, 0.f};
    bf16x8 qA[2], qB[2];
    { const bf16* qp = KQ + (size_t)(rowqA + l15) * 2048 + 1024 + h * 64 + 8 * g; qA[0] = *(const bf16x8*)qp; qA[1] = *(const bf16x8*)(qp + 32); }
    { const bf16* qp = KQ + (size_t)(rowqB + l15) * 2048 + 1024 + h * 64 + 8 * g; qB[0] = *(const bf16x8*)qp; qB[1] = *(const bf16x8*)(qp + 32); }
    AttnState SA, SB; SA.m = 0.f; SA.sum = 0.f; SB.m = 0.f; SB.sum = 0.f;
#pragma unroll
    for (int dt = 0; dt < 4; ++dt) { SA.o[dt] = z; SB.o[dt] = z; }
    if (win) {
        const int rsA = min(max(r - 4, 0), 56), dB = min(max(r - 3, 0), 56) - rsA, kc0 = min(max(16 * qt - 8, 0), 32);
        const int q = 16 * qt + l15, csq = min(max(q - 8, 0), 48);
        const int krow0 = 8 * (l15 >> 2) + (l15 & 3);
        const bf16* kb = KQ + (size_t)(b * SEQ + kc0 + krow0) * 2048 + h * 64 + 8 * g;
        const bf16* vb = VT + (size_t)(b * 1024 + h * 64 + l15) * 4096 + kc0 + 8 * g;
        const LAS float* rp = (const LAS float*)(lds + ALDS_RP);
        const int jb = kc0 + 8 * g;
        const int okb = jb - csq;
        const LAS float* rpl = rp + 16 + (jb - q + 15);
        float madd[2][4];
#pragma unroll
        for (int t = 0; t < 2; ++t)
#pragma unroll
            for (int j = 0; j < 4; ++j) madd[t][j] = ((unsigned)(okb + 4 * t + j) < 16u) ? 0.f : -__builtin_inff();
        bf16x8 K0[2][2], K1[2][2]; u32x4 V0[1][4], V1[1][4];
#define ATT_LOADW(KB, VB, i) do { const int gr_ = min(rsA + (i), 63); const bf16* kp_ = kb + (size_t)(gr_ * 64) * 2048; const bf16* vp_ = vb + gr_ * 64; \
        _Pragma("unroll") for (int t = 0; t < 2; ++t) { KB[t][0] = *(const bf16x8*)(kp_ + (size_t)(4 * t) * 2048); KB[t][1] = *(const bf16x8*)(kp_ + (size_t)(4 * t) * 2048 + 32); } \
        _Pragma("unroll") for (int dt = 0; dt < 4; ++dt) VB[0][dt] = *(const u32x4*)(vp_ + (size_t)(16 * dt) * 4096); } while (0)
#define ATT_ONE(ST, QF, KB, VB, roff, rowok) do { f32x4 sc[2]; \
        const LAS float* bp_ = rpl + ((rowok) ? (roff) : 15) * 64; \
        _Pragma("unroll") for (int t = 0; t < 2; ++t) _Pragma("unroll") for (int j = 0; j < 4; ++j) sc[t][j] = (bp_[4 * t + j] + madd[t][j]) - ST.m;     \
        _Pragma("unroll") for (int t = 0; t < 2; ++t) { sc[t] = MFMA16(KB[t][0], QF[0], sc[t]); sc[t] = MFMA16(KB[t][1], QF[1], sc[t]); } \
        attn_tail<2>(ST, sc, VB); } while (0)
#define ATT_COMPUTE(KB, VB, i) do { const int roffA_ = min(rsA + (i) - r + 7, 14); \
        ATT_ONE(SA, qA, KB, VB, roffA_, (i) <= 7); \
        ATT_ONE(SB, qB, KB, VB, max(roffA_ - 1, 0), (i) >= dB && (i) <= 7 + dB); } while (0)
        ATT_LOADW(K0, V0, 0);
#pragma unroll 1
        for (int i = 0; i < 8; i += 2) { ATT_LOADW(K1, V1, i + 1); ATT_COMPUTE(K0, V0, i); ATT_LOADW(K0, V0, i + 2); ATT_COMPUTE(K1, V1, i + 1); }
        ATT_COMPUTE(K0, V0, 8);
#undef ATT_LOADW
#undef ATT_ONE
#undef ATT_COMPUTE
    }
    { const LAS bf16* ck = (const LAS bf16*)(lds + ALDS_CK) + l15 * ACK_STRIDE + 8 * g;
      const LAS bf16* cv = (const LAS bf16*)(lds + ALDS_CV) + l15 * ACV_STRIDE + 8 * g;
#pragma unroll 1
      for (int c = 0; c < 4; ++c) {
          bf16x8 kf[4][2]; u32x4 vw[2][4];
#pragma unroll
          for (int t = 0; t < 4; ++t) { const LAS bf16* kp = ck + (64 * c + 16 * t) * ACK_STRIDE; kf[t][0] = *(const LAS bf16x8*)kp; kf[t][1] = *(const LAS bf16x8*)(kp + 32); }
#pragma unroll
          for (int ks = 0; ks < 2; ++ks)
#pragma unroll
              for (int dt = 0; dt < 4; ++dt) vw[ks][dt] = *(const LAS u32x4*)(cv + (16 * dt) * ACV_STRIDE + 64 * c + 32 * ks);
          { f32x4 sc[4]; const float nm = -SA.m; const f32x4 c0 = {nm, nm, nm, nm};
#pragma unroll
            for (int t = 0; t < 4; ++t) { sc[t] = MFMA16(kf[t][0], qA[0], c0); sc[t] = MFMA16(kf[t][1], qA[1], sc[t]); }
            attn_tail<4>(SA, sc, vw); }
          { f32x4 sc[4]; const float nm = -SB.m; const f32x4 c0 = {nm, nm, nm, nm};
#pragma unroll
            for (int t = 0; t < 4; ++t) { sc[t] = MFMA16(kf[t][0], qB[0], c0); sc[t] = MFMA16(kf[t][1], qB[1], sc[t]); }
            attn_tail<4>(SB, sc, vw); }
      } }
    { const float inv = 1.0f / xrow16_sum(SA.sum);
#pragma unroll
      for (int dt = 0; dt < 4; ++dt) st_bf4(ATT + (size_t)(rowqA + l15) * 1024 + h * 64 + 16 * dt + 4 * g, SA.o[dt] * inv); }
    { const float inv = 1.0f / xrow16_sum(SB.sum);
#pragma unroll
      for (int dt = 0; dt < 4; ++dt) st_bf4(ATT + (size_t)(rowqB + l15) * 1024 + h * 64 + 16 * dt + 4 * g, SB.o[dt] * inv); }
}
__device__ __forceinline__ void p_attn_mfma(const Params& P, Frame& F, int l, bool with_ctx_queries) {
    const bf16* KQ = WSP(bf16, WS_KQ); const bf16* VT = WSP(bf16, WS_VT); bf16* ATT = WSP(bf16, WS_ATT);
    const float* rpb = P.rpb + (size_t)l * 16 * 465;
    for (int hp = F.bid; hp < 256; hp += F.G) {
        const int p = hp & 127, half = hp >> 7, b = p >> 4, h = p & 15;
        __syncthreads();
        { LAS bf16* ck = (LAS bf16*)(F.lds + ALDS_CK); LAS bf16* cv = (LAS bf16*)(F.lds + ALDS_CV); LAS float* rp = (LAS float*)(F.lds + ALDS_RP);
          { const int key = F.tid >> 1, hf = F.tid & 1; const int k32 = key & 31, pos = (key & ~31) + ((k32 >> 2) & 1) * 16 + 4 * (k32 >> 3) + (k32 & 3);
            const u32x4* src = (const u32x4*)(KQ + (size_t)(RL + b * CTXL + key) * 2048 + h * 64 + hf * 32); LAS u32x4* dst = (LAS u32x4*)(ck + pos * ACK_STRIDE + hf * 32);
#pragma unroll
            for (int i = 0; i < 4; ++i) dst[i] = src[i]; }
          { const int d = F.tid >> 3, sg = F.tid & 7; const u32x4* src = (const u32x4*)(VT + YT_CTX_OFF + (size_t)(b * 1024 + h * 64 + d) * 256 + sg * 32); LAS u32x4* dst = (LAS u32x4*)(cv + d * ACV_STRIDE + sg * 32);
#pragma unroll
            for (int i = 0; i < 4; ++i) dst[i] = src[i]; }
          for (int i = F.tid; i < 16 * 64; i += NTHREADS) { const int rr = i >> 6, cc = (i & 63) - 16; rp[i] = rr == 15 ? -__builtin_inff() : ((cc >= 0 && cc < 31) ? rpb[h * 465 + rr * 31 + cc] * LOG2E : 0.f); } }
        __syncthreads();
        const int qt = F.wave & 3, rpi = F.wave >> 2;
#pragma unroll 1
        for (int st = 0; st < 8; ++st) { const int r = half * 32 + st * 4 + rpi * 2; const int rowqA = b * SEQ + r * 64 + 16 * qt;
            attn_unit2(KQ, VT, ATT, F.lds, b, h, rowqA, rowqA + 64, true, r, qt, F.lane); }
        if (with_ctx_queries && half == 0) { const int rowqA = RL + b * CTXL + 32 * F.wave; attn_unit2(KQ, VT, ATT, F.lds, b, h, rowqA, rowqA + 16, false, 0, 0, F.lane); }
    }
    __syncthreads();
}

__device__ __forceinline__ void ld8(const bf16* p, float (&x)[8]) { const u32x4 w = *(const u32x4*)p;
#pragma unroll
    for (int q = 0; q < 4; ++q) { x[2 * q] = bflo(w[q]); x[2 * q + 1] = bfhi(w[q]); } }
__device__ __forceinline__ void p_pool(Frame& F, int nrows) {
    const bf16* PB = WSP(bf16, WS_PB); bf16* POOL = WSP(bf16, WS_POOL);
    for (int i = F.bid * NTHREADS + F.tid; i < (nrows >> 4) * 64; i += F.G * NTHREADS) {
        const int row0 = (i >> 6) << 4, ch = i & 63, g = ch >> 4, hw = 1 << g;
        int base, t0, Lb; if (row0 < RL) { base = row0 & ~4095; t0 = row0 & 4095; Lb = SEQ; } else { const int rr = row0 - RL; base = RL + (rr & ~255); t0 = rr & 255; Lb = CTXL; }
        const bf16* src = PB + (size_t)base * 512 + ch * 8;
        float S[8];
#pragma unroll
        for (int q = 0; q < 8; ++q) S[q] = 0.f;
#pragma unroll 4
        for (int d = -8; d < 8; ++d) { const int tt = t0 + d; if (d >= -hw && d < hw && tt >= 0 && tt < Lb) { float x[8]; ld8(src + (size_t)tt * 512, x);
#pragma unroll
                for (int q = 0; q < 8; ++q) S[q] += x[q]; } }
#pragma unroll 2
        for (int j = 0; j < 16; ++j) { const int t = t0 + j; const int lo = max(t - hw, 0), hi = min(t + hw, Lb); const float inv = 1.0f / (float)(hi - lo);
            float me[8]; ld8(src + (size_t)t * 512, me);
            u32x4 o;
#pragma unroll
            for (int q = 0; q < 4; ++q) o[q] = pk2(S[2 * q] * inv - me[2 * q], S[2 * q + 1] * inv - me[2 * q + 1]);
            *(u32x4*)(POOL + (size_t)(base + t) * 512 + ch * 8) = o;
            if (t + hw < Lb) { float x[8]; ld8(src + (size_t)(t + hw) * 512, x);
#pragma unroll
                for (int q = 0; q < 8; ++q) S[q] += x[q]; }
            if (t - hw >= 0) { float x[8]; ld8(src + (size_t)(t - hw) * 512, x);
#pragma unroll
                for (int q = 0; q < 8; ++q) S[q] -= x[q]; } }
    }
}

__device__ __forceinline__ int block_sum_i(int v, LAS int* sm, int tid) {
    v = wave_sum_i(v);
    __syncthreads();
    if ((tid & 63) == 0) sm[tid >> 6] = v;
    __syncthreads();
    int s = 0;
#pragma unroll
    for (int i = 0; i < 8; ++i) s += sm[i];
    return s;
}
__device__ __forceinline__ int block_excl_scan(int v, LAS int* sm, int tid, int& total) {
    const int lane = tid & 63, w = tid >> 6; int inc = v;
#pragma unroll
    for (int o = 1; o < 64; o <<= 1) { const int t = __builtin_amdgcn_ds_bpermute(((lane - o) & 63) << 2, inc); if (lane >= o) inc += t; }
    __syncthreads();
    if (lane == 63) sm[w] = inc;
    __syncthreads();
    int base = 0; total = 0;
#pragma unroll
    for (int i = 0; i < 8; ++i) { const int s = sm[i]; if (i < w) base += s; total += s; }
    return base + inc - v;
}
template <int NPT>
__device__ __forceinline__ void topk_pair(Frame& F, int row0, int n, int cap, int e, int slot0) {
    LAS int* sm = (LAS int*)F.lds;
    const float* AFF = WSP(float, WS_AFF); int* SROW = WSP(int, WS_SROW); float* SG = WSP(float, WS_SGATE); int* SEL = WSP(int, WS_SEL);
    unsigned key[NPT];
#pragma unroll
    for (int j = 0; j < NPT; ++j) { const int i = F.tid * NPT + j; key[j] = (i < n) ? __float_as_uint(AFF[(size_t)(row0 + i) * 16 + e]) : 0u; }
    unsigned T = 0u;
    for (int bit = 30; bit >= 0; --bit) { const unsigned cand = T | (1u << bit); int cnt = 0;
#pragma unroll
        for (int j = 0; j < NPT; ++j) cnt += (key[j] >= cand) ? 1 : 0;
        cnt = block_sum_i(cnt, sm, F.tid);
        if (cnt >= cap) T = cand; }
    int ngt = 0, neq = 0;
#pragma unroll
    for (int j = 0; j < NPT; ++j) { ngt += (key[j] > T) ? 1 : 0; neq += (key[j] == T) ? 1 : 0; }
    int tot_gt, tot_eq;
    (void)block_excl_scan(ngt, sm, F.tid, tot_gt);
    int eqr = block_excl_scan(neq, sm, F.tid, tot_eq);
    const int need_eq = cap - tot_gt;
    int nsel = 0; bool selj[NPT];
#pragma unroll
    for (int j = 0; j < NPT; ++j) { bool s = key[j] > T; if (key[j] == T && T != 0u) { s = eqr < need_eq; ++eqr; } selj[j] = s; nsel += s ? 1 : 0; }
    int tot_sel; int pos = block_excl_scan(nsel, sm, F.tid, tot_sel);
#pragma unroll
    for (int j = 0; j < NPT; ++j) { const int i = F.tid * NPT + j;
        if (i < n) { const int row = row0 + i;
            if (selj[j]) { const int slot = slot0 + pos; ++pos; SROW[slot] = row; SG[slot] = __uint_as_float(key[j]); SEL[(size_t)row * 16 + e] = slot; }
            else SEL[(size_t)row * 16 + e] = -1; } }
    __syncthreads();
}
__device__ __forceinline__ void p_topk(Frame& F, bool with_ctx) {
    const int npairs = 128 + (with_ctx ? 128 : 0);
    for (int pi = F.bid; pi < npairs; pi += F.G) {
        if (pi < 128) { const int b = pi >> 4, e = pi & 15; topk_pair<8>(F, b * SEQ, SEQ, CAPL, e, e * SLOT_E + b * CAPL); }
        else { const int p2 = pi - 128, b = p2 >> 4, e = p2 & 15; topk_pair<1>(F, RL + b * CTXL, CTXL, CAPC, e, e * SLOT_E + 4096 + b * CAPC); }
    }
}
template <int PH> __global__ void __launch_bounds__(NTHREADS, 2) fwd_kernel(Params P) {
    extern __shared__ __attribute__((aligned(16))) unsigned char lds_raw[];
    Frame F; F.lds = (LAS unsigned char*)lds_raw; F.tid = threadIdx.x; F.lane = F.tid & 63; F.wave = __builtin_amdgcn_readfirstlane(F.tid >> 6); F.G = gridDim.x; F.bid = blockIdx.x; F.ws = P.ws;
    const int wave0 = __builtin_amdgcn_readfirstlane((int)threadIdx.x >> 6);
    volatile LAS unsigned* MISC = (volatile LAS unsigned*)(F.lds + LDS_MISC);
    if (F.tid < 64) MISC[F.tid] = 0u;
    __syncthreads();
    XcdBarrier bar; bar.bar = WSP(unsigned, WS_CTL) + CW_BAR; bar.x = 0; bar.st = MISC + 8;
    if constexpr (PH < 0) bar = xcd_barrier_post(WSP(unsigned, WS_CTL) + CW_BAR, MISC + 8);
#define IN(k) (PH < 0 || PH == (k))
#define REFRESH() do { unsigned on_ = ~0u; asm volatile("" : "+s"(on_)); int t_ = wave0 * 64 + (int)__builtin_amdgcn_mbcnt_hi(on_, __builtin_amdgcn_mbcnt_lo(on_, 0u)); asm volatile("" : "+v"(t_)); F.tid = t_; F.lane = t_ & 63; F.wave = __builtin_amdgcn_readfirstlane(t_ >> 6); } while (0)
#define SEAM(k) do { if constexpr (PH < 0) xcd_barrier(bar); } while (0)

    if (IN(0)) { REP_BEGIN(100) p_mod(P, F); p_dftgen(F); REP_END REP_BEGIN(101) p_wconv(P, F, 0); REP_END }
    SEAM(0);
    if (IN(1)) { p_rowpass_a0(P, F); }
    SEAM(1);
    for (int l = P.l_lo; l < P.l_hi; ++l) {
        constexpr int pb = 2; const bool L0 = (l == 0);
        bf16* H = WSP(bf16, WS_H);
        if (IN(pb + 0)) { REFRESH(); REP_BEGIN(2)
            { GroupSched S; S.init(1, 128, 22, F.G, F.bid, 8, L0 ? 22 : 4, 128, 0);
              const bf16* WA = WSP(bf16, WS_WA);
              auto AD = [=](const Unit& u) { return Operands{H + (size_t)u.pm * 256 * DM, WA + (size_t)u.pn * 256 * DM, DM, DM, 0, DM}; };
              bf16* KQ = WSP(bf16, WS_KQ); bf16* PBp = WSP(bf16, WS_PB); bf16* GB = WSP(bf16, WS_GB);
              auto E = [=](EPI_ARGS) { const int row0 = u.pm * 256;
                  if (u.pn < 8) { const float qs = (u.pn >= 4) ? QSCALE : 1.0f; EPI_FOR8( st_bf8(KQ + (size_t)(row0 + r) * 2048 + u.pn * 256 + c, v0 * qs, v1 * qs); ) }
                  else if (u.pn < 10) { EPI_FOR8( st_bf8(PBp + (size_t)(row0 + r) * 512 + (u.pn - 8) * 256 + c, v0, v1); ) }
                  else { EPI_FOR8( f32x4 s0; f32x4 s1; _Pragma("unroll") for (int j = 0; j < 4; ++j) { s0[j] = sigmoidf_(v0[j]); s1[j] = sigmoidf_(v1[j]); } st_bf8(GB + (size_t)(row0 + r) * 3072 + (u.pn - 10) * 256 + c, s0, s1); ) } };
              GEMM_P(S, AD, E); }
            REFRESH();
            { GroupSched S; const int g1a_units = 128 * 22 + 8 * (L0 ? 22 : 4);
              S.init(1, 8, 128, F.G, (F.bid + F.G - ((g1a_units % F.G) & ~7)) % F.G, L0 ? 8 : 4, 8, L0 ? 0 : 4, 128);
              const bf16* WFV = WSP(bf16, WS_WFV);
              auto AD = [=](const Unit& u) { const bool fmap = (u.pm < 4) && (u.pn < 128); const int t16 = u.pn & 15;
                  const size_t tok0 = fmap ? (size_t)(u.pn >> 4) * SEQ + 64 * ((t16 >> 1) * 8) + (t16 & 1) * 32 : (size_t)u.pn * 256;
                  return Operands{WFV + (size_t)u.pm * 256 * DM, H + tok0 * DM, DM, DM, 0, DM, fmap ? 1 : 0}; };
              bf16* YT = WSP(bf16, WS_YT); bf16* VT = WSP(bf16, WS_VT);
              auto E = [=](EPI_ARGS) { bf16* T = (u.pm < 4) ? YT : VT; const int rr0 = (u.pm & 3) * 256;
                  if (u.pn < 128) { const int b = u.pn >> 4;
                      if (u.pm < 4) { const int t16 = u.pn & 15, l10 = (t16 >> 1) * 8, l20 = (t16 & 1) * 32;
                          EPI_FOR8( const int fc = rr0 + r; st_bf8(T + (((((size_t)b * 512 + (fc >> 1)) * 32 + (c >> 3)) * 2 + (l20 >> 5)) * 2 + (fc & 1)) * 64 + l10, v0, v1); ) }
                      else { const int l0 = (u.pn & 15) * 256; EPI_FOR8( st_bf8(T + ((size_t)b * 1024 + rr0 + r) * 4096 + l0 + c, v0, v1); ) } }
                  else { const int b = u.pn - 128; EPI_FOR8( st_bf8(T + YT_CTX_OFF + ((size_t)b * 1024 + rr0 + r) * 256 + c, v0, v1); ) } };
              GEMM_P(S, AD, E); }
        REP_END }
        SEAM(pb + 0);
        if (IN(pb + 1)) { REFRESH();
            REP_BEGIN(31) p_attn_mfma(P, F, l, L0); REP_END
            REFRESH();
            REP_BEGIN(32)
            { LAS float* tw = (LAS float*)(F.lds + LDS_TW);
              for (int j = F.tid; j < 4096; j += NTHREADS) tw[j] = cospif((float)j * (1.0f / 2048.0f));
              __syncthreads();
              GroupSched S; S.init(1, 1, 512, F.G, F.bid);
              const bf16* M1 = WSP(bf16, WS_M1T); const bf16* YF = WSP(bf16, WS_YT); bf16* ZP = WSP(bf16, WS_ZP);
              auto AD = [=](const Unit& u) { return Operands{M1, YF + (size_t)u.pn * 256 * 256, 256, 256, 0, 256}; };
              auto E = [=](EPI_ARGS) {
                  const int b = u.pn >> 6, gm0 = (u.pn & 63) * 8 + wc, l20 = 32 * wr + 8 * fq;
#pragma unroll
                  for (int m = 0; m < 4; ++m) { const int k1 = 16 * m + fr;
#pragma unroll
                      for (int bj = 0; bj < 2; ++bj) { const int gm = gm0 + 4 * bj;
                          f32x4 zr[2], zi[2];
#pragma unroll
                          for (int n = 0; n < 2; ++n)
#pragma unroll
                              for (int j = 0; j < 4; ++j) { const int ix = k1 * (l20 + 4 * n + j); const float tc = tw[ix], ts = tw[(ix + 3072) & 4095];
                                  const float ur = acc[0][bj][m][n][j], ui = acc[1][bj][m][n][j]; zr[n][j] = ur * tc - ui * ts; zi[n][j] = ur * ts + ui * tc; }
                          bf16* dst = ZP + (((((size_t)b * 64 + k1) * 128 + (gm & 127)) * 4 + (gm >> 7)) * 2) * 64 + l20;
                          st_bf8(dst, zr[0], zr[1]); st_bf8(dst + 64, zi[0], zi[1]); } } };
              GEMM_P(S, AD, E); }
            REP_END
        }
        SEAM(pb + 1);
        if (IN(pb + 10)) { REFRESH();
            { GroupSched S; S.init(1, 1, 256, F.G, F.bid);
              const bf16* M2 = WSP(bf16, WS_M2T); const bf16* ZP = WSP(bf16, WS_ZP); bf16* FOUR = WSP(bf16, WS_FOUR);
              auto AD = [=](const Unit& u) { return Operands{M2, ZP + (size_t)u.pn * 256 * 512, 512, 512, 0, 512}; };
              auto E = [=](EPI_ARGS) { const float sc = 0.0013810679320049757f;
#pragma unroll
                  for (int ai = 0; ai < 2; ++ai)
#pragma unroll
                      for (int m = 0; m < 4; ++m) { const int q = 2 * ai + wr, k2 = 16 * m + fr;
#pragma unroll
                          for (int bj = 0; bj < 2; ++bj) { const int bk = u.pn * 2 + bj, b = bk >> 6, k1 = bk & 63;
                              st_bf8(FOUR + ((size_t)b * SEQ + k1 + 64 * k2) * 512 + q * 128 + wc * 32 + 8 * fq, acc[ai][bj][m][0] * sc, acc[ai][bj][m][1] * sc); } } };
              GEMM_P(S, AD, E); }
            REFRESH();
            if (L0) { GroupSched S; S.init(1, 1, 16, F.G, (F.bid + F.G - 128 % F.G) % F.G);
              const bf16* DFTC = WSP(bf16, WS_DFTC); const bf16* YTC = WSP(bf16, WS_YT) + YT_CTX_OFF; bf16* FOUR = WSP(bf16, WS_FOUR);
              auto AD = [=](const Unit& u) { return Operands{DFTC, YTC + (size_t)u.pn * 256 * 512, 512, 512, 0, 512}; };
              auto E = [=](EPI_ARGS) { const int b = u.pn >> 1, c0 = (u.pn & 1) * 256; const float sc = 0.005524271728019903f;
                  EPI_FOR8( st_bf8(FOUR + ((size_t)RL + b * CTXL + r) * 512 + c0 + c, v0 * sc, v1 * sc); ) };
              GEMM_P(S, AD, E); }
            REFRESH();
            REP_BEGIN(33) p_pool(F, L0 ? RT : RL); REP_END
        }
        SEAM(pb + 10);
        if (IN(pb + 2)) { REFRESH();
            SegSched<3> S; S.base.init(1, L0 ? 136 : 128, 4, F.G, F.bid);
            const bf16* ATT = WSP(bf16, WS_ATT); const bf16* FOUR = WSP(bf16, WS_FOUR); const bf16* POOL = WSP(bf16, WS_POOL);
            const bf16* WAO = WSP(bf16, WS_WAO); const bf16* WFO = WSP(bf16, WS_WFO); const bf16* WPO = WSP(bf16, WS_WPO);
            const bf16* GB = WSP(bf16, WS_GB); bf16* MRGB = WSP(bf16, WS_MRGB); const float* ps = P.pool_scale + l * 1024;
            auto AD = [=](const Unit& u) {
                if (u.seg == 0) return Operands{ATT + (size_t)u.pm * 256 * 1024, WAO + (size_t)u.pn * 256 * 1024, 1024, 1024, 0, 1024};
                if (u.seg == 1) return Operands{FOUR + (size_t)u.pm * 256 * 512, WFO + (size_t)u.pn * 256 * 512, 512, 512, 0, 512};
                return Operands{POOL + (size_t)u.pm * 256 * 512 + (u.pn >> 1) * 256, WPO + (size_t)u.pn * 256 * 256, 512, 256, 0, 256}; };
            auto E = [=](EPI_ARGS) {
                const int kd = u.seg < 2 ? u.seg + 1 : 2; const bool fin = (u.seg == 2); const int colb = u.pn * 256 + wc * 32 + 8 * fq;
#pragma unroll
                for (int ai = 0; ai < 2; ++ai)
#pragma unroll
                    for (int m = 0; m < 4; ++m) { const size_t row = (size_t)u.pm * 256 + ai * 128 + wr * 64 + m * 16 + fr; const bf16* gr = GB + row * 3072 + colb;
                        u32x4 nr[2], dr[2]; f32x4 psv[2][2];
#pragma unroll
                        for (int bj = 0; bj < 2; ++bj) { nr[bj] = *(const u32x4*)(gr + u.seg * 1024 + bj * 128); dr[bj] = *(const u32x4*)(gr + kd * 1024 + bj * 128);
                            psv[bj][0] = *(const f32x4*)(ps + colb + bj * 128); psv[bj][1] = *(const f32x4*)(ps + colb + bj * 128 + 4); }
#pragma unroll
                        for (int bj = 0; bj < 2; ++bj) { f32x4 o[2];
#pragma unroll
                            for (int n = 0; n < 2; ++n) { f32x4 nu = {bflo(nr[bj][2 * n]), bfhi(nr[bj][2 * n]), bflo(nr[bj][2 * n + 1]), bfhi(nr[bj][2 * n + 1])}, de = {bflo(dr[bj][2 * n]), bfhi(dr[bj][2 * n]), bflo(dr[bj][2 * n + 1]), bfhi(dr[bj][2 * n + 1])};
                                if (u.seg == 2) nu = nu * psv[bj][n];
                                de = de * psv[bj][n];
#pragma unroll
                                for (int j = 0; j < 4; ++j) { const float nj = (fabsf(nu[j]) < 1e-30f) ? copysignf(1e-30f, nu[j]) : nu[j]; const float dj = (fabsf(de[j]) < 1e-30f) ? copysignf(1e-30f, de[j]) : de[j];
                                    o[n][j] = acc[ai][bj][m][n][j] * nj * (fin ? 1.0f : __builtin_amdgcn_rcpf(dj)); }
                                acc[ai][bj][m][n] = o[n]; }
                            if (fin) st_bf8(MRGB + row * 1024 + colb + bj * 128, o[0], o[1]); } } };
            gemm_fast<false, true>(F.lds, F.tid, S, AD, mk_epi_seg(E, 2), nullptr);
        }
        SEAM(pb + 2);
        if (IN(pb + 3)) { REFRESH();
            GroupSched S; S.init(1, L0 ? 136 : 128, 4, F.G, F.bid); const bf16* A = WSP(bf16, WS_MRGB); const bf16* W = WSP(bf16, WS_WOUT);
            const float* xin = L0 ? P.x : P.out; const float* cin = L0 ? P.ctx : WSP(float, WS_XC); float* xo = P.out; float* co = WSP(float, WS_XC);
            const float* MOD = WSP(float, WS_MOD) + (size_t)l * 9 * 6144;
            auto AD = [=](const Unit& u) { return Operands{A + (size_t)u.pm * 256 * 1024, W + (size_t)u.pn * 256 * 1024, 1024, 1024, 0, 1024}; };
            auto E = [=](EPI_ARGS) {
                const int row0 = u.pm * 256, mr = row0 < RL ? (row0 >> 12) : 8, colb = u.pn * 256 + wc * 32 + 4 * fq;
                const float* src0 = row0 < RL ? xin + (size_t)row0 * DM : cin + (size_t)(row0 - RL) * DM; float* dst0 = row0 < RL ? xo + (size_t)row0 * DM : co + (size_t)(row0 - RL) * DM;
                f32x4 gv[2][2];
#pragma unroll
                for (int bj = 0; bj < 2; ++bj)
#pragma unroll
                    for (int n = 0; n < 2; ++n) gv[bj][n] = *(const f32x4*)(MOD + (size_t)mr * 6144 + 2048 + colb + bj * 128 + n * 16);
#pragma unroll
                for (int ai = 0; ai < 2; ++ai) { f32x4 xv[4][2][2];
#pragma unroll
                    for (int m = 0; m < 4; ++m) { const size_t ro = (size_t)(ai * 128 + wr * 64 + m * 16 + fr) * DM + colb;
#pragma unroll
                        for (int bj = 0; bj < 2; ++bj)
#pragma unroll
                            for (int n = 0; n < 2; ++n) xv[m][bj][n] = *(const f32x4*)(src0 + ro + bj * 128 + n * 16); }
#pragma unroll
                    for (int m = 0; m < 4; ++m) { const size_t ro = (size_t)(ai * 128 + wr * 64 + m * 16 + fr) * DM + colb;
#pragma unroll
                        for (int bj = 0; bj < 2; ++bj)
#pragma unroll
                            for (int n = 0; n < 2; ++n) *(f32x4*)(dst0 + ro + bj * 128 + n * 16) = xv[m][bj][n] + gv[bj][n] * acc[ai][bj][m][n]; } } };
            GEMM(S, AD, E, 1024, 1024, 1024);
        }
        SEAM(pb + 3);
        if (IN(pb + 4)) { REFRESH(); REP_BEGIN(6) p_rowpass_f(P, F, l, L0 ? RT : RL); REP_END }
        SEAM(pb + 4);
        if (IN(pb + 5)) { REFRESH(); REP_BEGIN(7) p_topk(F, L0); REP_END }
        SEAM(pb + 5);
        if (IN(pb + 7)) { REFRESH(); REP_BEGIN(9)
            GroupSched S; S.init(16, L0 ? 17 : 16, 22, F.G, F.bid); const bf16* W = WSP(bf16, WS_WGU); bf16* HID = WSP(bf16, WS_HID); const int* SROW = WSP(int, WS_SROW);
            auto AD = [=](const Unit& u) { return Operands{H, W + ((size_t)u.grp * 5632 + u.pn * 256) * DM, DM, DM, u.grp * SLOT_E + u.pm * 256, DM}; };
            auto E = [=](EPI_ARGS) {
#pragma unroll
                for (int ai = 0; ai < 2; ++ai)
#pragma unroll
                    for (int m = 0; m < 4; ++m) { const size_t slot = (size_t)u.grp * SLOT_E + u.pm * 256 + ai * 128 + wr * 64 + m * 16 + fr; f32x4 o[2];
#pragma unroll
                        for (int n = 0; n < 2; ++n) { const f32x4 a = acc[ai][0][m][n], up = acc[ai][1][m][n];
#pragma unroll
                            for (int j = 0; j < 4; ++j) o[n][j] = a[j] * sigmoidf_(a[j]) * up[j]; }
                        st_bf8(HID + slot * FF + u.pn * 128 + wc * 32 + 8 * fq, o[0], o[1]); } };
            GEMM_GATHER(S, AD, E, DM, DM, DM, SROW);
        REP_END }
        SEAM(pb + 7);
        if (IN(pb + 8)) { REFRESH(); REP_BEGIN(10)
            const int tpe = L0 ? 17 : 16;
            GroupSched S; S.init(1, 16 * tpe, 4, F.G, F.bid); const bf16* HID = WSP(bf16, WS_HID); const bf16* W = WSP(bf16, WS_WD); bf16* Y = WSP(bf16, WS_Y); const float* SG = WSP(float, WS_SGATE);
            auto AD = [=](const Unit& u) { const int e = u.pm / tpe, st = e * 17 + (u.pm - e * tpe); return Operands{HID + (size_t)st * 256 * FF, W + ((size_t)e * 1024 + u.pn * 256) * FF, FF, FF, 0, FF}; };
            auto E = [=](EPI_ARGS) { const int e = u.pm / tpe; const size_t slot0 = (size_t)(e * 17 + (u.pm - e * tpe)) * 256 + wr * 64 + fr; float gt[2][4];
#pragma unroll
                for (int ai = 0; ai < 2; ++ai)
#pragma unroll
                    for (int m = 0; m < 4; ++m) gt[ai][m] = SG[slot0 + ai * 128 + m * 16];
#pragma unroll
                for (int ai = 0; ai < 2; ++ai)
#pragma unroll
                    for (int m = 0; m < 4; ++m)
#pragma unroll
                        for (int bj = 0; bj < 2; ++bj) st_bf8(Y + (slot0 + ai * 128 + m * 16) * DM + u.pn * 256 + bj * 128 + wc * 32 + 8 * fq, acc[ai][bj][m][0] * gt[ai][m], acc[ai][bj][m][1] * gt[ai][m]); };
            GEMM_P(S, AD, E);
        REP_END }
        SEAM(pb + 8);
        if (IN(pb + 9)) { REFRESH(); p_rowpass_k(P, F, l, L0 ? RT : RL); if (L0) p_wconv(P, F, 1); }
        if (L0) SEAM(pb + 9);
    }
#undef IN
#undef SEAM
}
template <int PH> static void launch_ph(int grid, const Params& p, hipStream_t stream) { hipLaunchKernelGGL(fwd_kernel<PH>, dim3(grid), dim3(NTHREADS), LDS_BYTES, stream, p); }
template <int PH> static bool set_attr() { return hipFuncSetAttribute((const void*)fwd_kernel<PH>, hipFuncAttributeMaxDynamicSharedMemorySize, LDS_BYTES) == hipSuccess; }

#ifndef DUP_LAUNCH
#define DUP_LAUNCH -1
#endif
extern "C" void kernel_launch(void* const* d_in, const int* in_sizes, int n_in, void* d_out, int out_size, void* d_ws, size_t ws_size, hipStream_t stream) {
    static int grid = 0;
    if (grid == 0) {
        if (n_in != 20 || out_size != RL * DM || ws_size < WS_END) { fprintf(stderr, "kernel_launch: unexpected shapes (n_in %d out %d ws %zu need %zu)\n", n_in, out_size, ws_size, (size_t)WS_END); grid = -1; return; }
        int dev = 0, cus = 0, per_cu = 0;
        if (hipGetDevice(&dev) != hipSuccess || hipDeviceGetAttribute(&cus, hipDeviceAttributeMultiprocessorCount, dev) != hipSuccess) { grid = -1; return; }
#if N_LAUNCH_MODE == 1
        if (!set_attr<-1>()) { fprintf(stderr, "kernel_launch: hipFuncSetAttribute failed\n"); grid = -1; return; }
        if (hipOccupancyMaxActiveBlocksPerMultiprocessor(&per_cu, (const void*)fwd_kernel<-1>, NTHREADS, LDS_BYTES) != hipSuccess || per_cu < 1) fprintf(stderr, "kernel_launch: occupancy query reports %d\n", per_cu);
#else
        if (!(set_attr<0>() && set_attr<1>() && set_attr<2>() && set_attr<3>() && set_attr<12>() && set_attr<4>() && set_attr<5>() && set_attr<6>() && set_attr<7>() && set_attr<9>() && set_attr<10>() && set_attr<11>())) { fprintf(stderr, "kernel_launch: hipFuncSetAttribute failed\n"); grid = -1; return; }
        (void)per_cu;
#endif
        (void)hipGetLastError();
        grid = cus;
    }
    if (grid < 0) return;
    if (hipMemsetAsync((char*)d_ws + WS_CTL, 0, CTL_BYTES, stream) != hipSuccess) return;
    Params p{};
    const float** pp = (const float**)&p;
    for (int i = 0; i < 20; ++i) pp[i] = (const float*)d_in[i];
    p.out = (float*)d_out; p.ws = (unsigned char*)d_ws;
#if N_LAUNCH_MODE == 1
    p.l_lo = 0; p.l_hi = 2;
    launch_ph<-1>(grid, p, stream);
#else
    p.l_lo = 0; p.l_hi = 0; launch_ph<0>(grid, p, stream); if (DUP_LAUNCH == 0) launch_ph<0>(grid, p, stream); launch_ph<1>(grid, p, stream); if (DUP_LAUNCH == 1) launch_ph<1>(grid, p, stream);
#define LP(k) do { launch_ph<k>(grid, p, stream); if (DUP_LAUNCH == (k) && l == 0) launch_ph<k>(grid, p, stream); } while (0)
    for (int l = 0; l < 2; ++l) { p.l_lo = l; p.l_hi = l + 1;
        LP(2); LP(3); LP(12); LP(4); LP(5); LP(6); LP(7); LP(9); LP(10); LP(11); }
#endif
}
```

```cpp
#include <hip/hip_runtime.h>
#include <cstdio>
#include <cstdint>

#ifndef N_LAUNCH_MODE
#define N_LAUNCH_MODE 1
#endif

#define GAS __attribute__((address_space(1)))
#define LAS __attribute__((address_space(3)))
typedef unsigned short bf16;
typedef short bf16x8 __attribute__((ext_vector_type(8)));
typedef float f32x4 __attribute__((ext_vector_type(4)));
typedef unsigned u32x4 __attribute__((ext_vector_type(4)));
typedef unsigned u32x2 __attribute__((ext_vector_type(2)));

constexpr int NB = 8, SEQ = 4096, DM = 1024, CTXL = 256, NH = 16, HD = 64, GRIDW = 64;
constexpr int RL = NB * SEQ, RC = NB * CTXL, RT = RL + RC;
constexpr int INW = 7168, NE = 16, FF = 2816, CAPL = 512, CAPC = 32;
constexpr int SLOT_E = 4352, NSLOT = NE * SLOT_E;
constexpr float RMS_EPS = 1e-6f;
constexpr float LOG2E = 1.4426950408889634f, QSCALE = 0.125f * LOG2E;
constexpr float A8S = 8.0f, W8S = 64.0f, INV8 = 1.0f / (A8S * W8S);
constexpr int NWAVES = 8, NTHREADS = 512;

constexpr size_t al256(size_t x) { return (x + 255) & ~(size_t)255; }
constexpr size_t WS_CTL = 0, CTL_BYTES = 1u << 20;
constexpr size_t WS_MOD = WS_CTL + CTL_BYTES;
constexpr size_t WS_XC = al256(WS_MOD + (size_t)2 * 9 * 6144 * 4);
constexpr size_t WS_AFF = al256(WS_XC + (size_t)RC * DM * 4);
constexpr size_t WS_SROW = al256(WS_AFF + (size_t)RT * 16 * 4);
constexpr size_t WS_SGATE = al256(WS_SROW + (size_t)NSLOT * 4);
constexpr size_t WS_SEL = al256(WS_SGATE + (size_t)NSLOT * 4);
constexpr size_t WS_DFTM = al256(WS_SEL + (size_t)RT * 16 * 4);
constexpr size_t WS_DFTC = al256(WS_DFTM + (size_t)4096 * 8192 * 2);
constexpr size_t WS_WA = al256(WS_DFTC + (size_t)256 * 512 * 2);
constexpr size_t WS_WFV = al256(WS_WA + (size_t)5632 * 1024 * 2);
constexpr size_t WS_WAO = al256(WS_WFV + (size_t)2048 * 1024 * 2);
constexpr size_t WS_WFO = al256(WS_WAO + (size_t)1024 * 1024 * 2);
constexpr size_t WS_WPO = al256(WS_WFO + (size_t)1024 * 512 * 2);
constexpr size_t WS_WOUT = al256(WS_WPO + (size_t)1024 * 256 * 2);
constexpr size_t WS_WGU = al256(WS_WOUT + (size_t)1024 * 1024 * 2);
constexpr size_t WS_WD = al256(WS_WGU + (size_t)16 * 5632 * 1024);
constexpr size_t WS_H = al256(WS_WD + (size_t)16 * 1024 * 2816);
constexpr size_t WS_H8 = al256(WS_H + (size_t)RT * DM * 2);
constexpr size_t WS_R = al256(WS_H8 + (size_t)RT * DM);
constexpr size_t WS_KQ = WS_R;
constexpr size_t WS_MRG = WS_KQ;
constexpr size_t WS_PB = al256(WS_KQ + (size_t)RT * 2048 * 2);
constexpr size_t WS_GB = al256(WS_PB + (size_t)RT * 512 * 2);
constexpr size_t WS_YT = al256(WS_GB + (size_t)RT * 3072 * 2);
constexpr size_t WS_MRGB = WS_YT;
constexpr size_t WS_VT = al256(WS_YT + (size_t)RT * 1024 * 2);
constexpr size_t WS_FOUR = al256(WS_VT + (size_t)RT * 1024 * 2);
constexpr size_t WS_ATT = al256(WS_FOUR + (size_t)RT * 512 * 2);
constexpr size_t WS_POOL = al256(WS_ATT + (size_t)RT * 1024 * 2);
constexpr size_t WS_MIX_END = al256(WS_POOL + (size_t)RT * 512 * 2);
constexpr size_t WS_XG = WS_R;
constexpr size_t WS_HID = al256(WS_XG + (size_t)NSLOT * 1024 * 2);
constexpr size_t WS_Y = al256(WS_HID + (size_t)NSLOT * 2816);
constexpr size_t WS_MOE_END = al256(WS_Y + (size_t)NSLOT * 1024 * 2);
constexpr size_t WS_END0 = WS_MIX_END > WS_MOE_END ? WS_MIX_END : WS_MOE_END;
constexpr size_t WS_ZP = WS_END0;
constexpr size_t WS_M1T = al256(WS_ZP + ((size_t)8 * 64 * 512 * 128 + 1024) * 2);
constexpr size_t WS_M2T = al256(WS_M1T + (size_t)256 * 256 * 2);
constexpr size_t WS_END = al256(WS_M2T + (size_t)256 * 512 * 2);
constexpr size_t YT_CTX_OFF = (size_t)8 * 1024 * 4096;

constexpr int CW_BAR = 4096;

constexpr int LDS_BYTES = 155648;
constexpr int LDS_TW = 132096;
constexpr int LDS_MISC = 131072;

__device__ __forceinline__ unsigned f2bf(float f) { unsigned u = __float_as_uint(f); return (u + 0x7fffu + ((u >> 16) & 1u)) >> 16; }
typedef __bf16 hbf16x2 __attribute__((ext_vector_type(2)));
typedef float f32x2 __attribute__((ext_vector_type(2)));
__device__ __forceinline__ unsigned pk2(float lo, float hi) { const f32x2 v = {lo, hi}; return __builtin_bit_cast(unsigned, __builtin_convertvector(v, hbf16x2)); }
__device__ __forceinline__ unsigned pk4_fp8(float a, float b, float c, float d) {
    a = __builtin_amdgcn_fmed3f(a, -448.f, 448.f); b = __builtin_amdgcn_fmed3f(b, -448.f, 448.f); c = __builtin_amdgcn_fmed3f(c, -448.f, 448.f); d = __builtin_amdgcn_fmed3f(d, -448.f, 448.f);
    int w = 0; w = __builtin_amdgcn_cvt_pk_fp8_f32(a, b, w, false); w = __builtin_amdgcn_cvt_pk_fp8_f32(c, d, w, true); return (unsigned)w; }
__device__ __forceinline__ float bf2f(unsigned b) { return __uint_as_float(b << 16); }
__device__ __forceinline__ float bflo(unsigned w) { return __uint_as_float(w << 16); }
__device__ __forceinline__ float bfhi(unsigned w) { return __uint_as_float(w & 0xffff0000u); }
template <int CTRL> __device__ __forceinline__ float dppf(float x) { return __builtin_bit_cast(float, __builtin_amdgcn_mov_dpp(__builtin_bit_cast(int, x), CTRL, 0xf, 0xf, true)); }
template <int CTRL> __device__ __forceinline__ int dppi(int x) { return __builtin_amdgcn_mov_dpp(x, CTRL, 0xf, 0xf, true); }
constexpr int DPP_XOR1 = 0xB1, DPP_XOR2 = 0x4E, DPP_ROR4 = 0x124, DPP_ROR8 = 0x128;
__device__ __forceinline__ float wave_sum(float v) {
    v += dppf<DPP_XOR1>(v); v += dppf<DPP_XOR2>(v); v += dppf<DPP_ROR4>(v); v += dppf<DPP_ROR8>(v);
    auto s = __builtin_amdgcn_permlane16_swap(__float_as_uint(v), __float_as_uint(v), false, false); v = __uint_as_float(s[0]) + __uint_as_float(s[1]);
    auto t = __builtin_amdgcn_permlane32_swap(__float_as_uint(v), __float_as_uint(v), false, false); return __uint_as_float(t[0]) + __uint_as_float(t[1]);
}
__device__ __forceinline__ float wave_max(float v) {
    v = fmaxf(v, dppf<DPP_XOR1>(v)); v = fmaxf(v, dppf<DPP_XOR2>(v)); v = fmaxf(v, dppf<DPP_ROR4>(v)); v = fmaxf(v, dppf<DPP_ROR8>(v));
    auto s = __builtin_amdgcn_permlane16_swap(__float_as_uint(v), __float_as_uint(v), false, false); v = fmaxf(__uint_as_float(s[0]), __uint_as_float(s[1]));
    auto t = __builtin_amdgcn_permlane32_swap(__float_as_uint(v), __float_as_uint(v), false, false); return fmaxf(__uint_as_float(t[0]), __uint_as_float(t[1]));
}
__device__ __forceinline__ int wave_sum_i(int v) {
    v += dppi<DPP_XOR1>(v); v += dppi<DPP_XOR2>(v); v += dppi<DPP_ROR4>(v); v += dppi<DPP_ROR8>(v);
    auto s = __builtin_amdgcn_permlane16_swap((unsigned)v, (unsigned)v, false, false); v = (int)(s[0] + s[1]);
    auto t = __builtin_amdgcn_permlane32_swap((unsigned)v, (unsigned)v, false, false); return (int)(t[0] + t[1]);
}
__device__ __forceinline__ float sigmoidf_(float x) { return __builtin_amdgcn_rcpf(1.f + __builtin_amdgcn_exp2f(x * -1.4426950408889634f)); }
#define LDS_WAIT() asm volatile("s_waitcnt lgkmcnt(0)" ::: "memory")

#define XB_TMO      128
#define XB_XCNT(j)  (256  + 64 * (j))
#define XB_XSUB(j)  (1280 + 64 * (j))
#define XB_XGEN(j)  (2304 + 64 * (j))
#define XB_TOP      3328
#define XB_TOPGEN   3392
#define XCD_BAR_WORDS 3456
#define XB_SPIN_CAP (1u << 22)

__device__ __forceinline__ unsigned xb_ld(unsigned* p)              { return __hip_atomic_load(p, __ATOMIC_RELAXED, __HIP_MEMORY_SCOPE_AGENT); }
__device__ __forceinline__ unsigned xb_add(unsigned* p, unsigned v) { return __hip_atomic_fetch_add(p, v, __ATOMIC_RELAXED, __HIP_MEMORY_SCOPE_AGENT); }
__device__ __forceinline__ unsigned xb_xcc_id() { return (unsigned)__builtin_amdgcn_s_getreg((3 << 11) | 20) & 0xFu; }
#define XB_SPIN(cond, bar) do { unsigned _sp = 0; while (cond) { __builtin_amdgcn_s_sleep(1); \
    if ((++_sp & 255u) == 0u) { if (xb_ld(&(bar)[XB_TMO])) break; if (_sp > XB_SPIN_CAP) { atomicAdd(&(bar)[XB_TMO], 1u); break; } } } } while (0)

struct XcdBarrier { unsigned* bar; unsigned x; volatile LAS unsigned* st; };

__device__ __forceinline__ XcdBarrier xcd_barrier_post(unsigned* bar, volatile LAS unsigned* st) {
    XcdBarrier b; b.bar = bar; b.x = xb_xcc_id(); b.st = st;
    if (threadIdx.x == 0) (void)xb_add(&bar[XB_XCNT(b.x)], 1u);
    return b;
}
__device__ __forceinline__ void xcd_barrier_complete(unsigned* bar, unsigned x, unsigned& nloc, unsigned& nx) {
    const unsigned G = gridDim.x * gridDim.y * gridDim.z;
    unsigned sum, cnt, mine, sp = 0u;
    for (;;) {
        sum = 0u; cnt = 0u; mine = 0u;
#pragma unroll
        for (unsigned j = 0; j < 16; ++j) { const unsigned c = xb_ld(&bar[XB_XCNT(j)]); sum += c; cnt += (c > 0u) ? 1u : 0u; mine = (j == x) ? c : mine; }
        if (sum == G) break;
        __builtin_amdgcn_s_sleep(1);
        if ((++sp & 255u) == 0u) { if (xb_ld(&bar[XB_TMO])) break; if (sp > XB_SPIN_CAP) { atomicAdd(&bar[XB_TMO], 1u); break; } }
    }
    nloc = mine > 0u ? mine : 1u; nx = cnt > 0u ? cnt : 1u;
}
__device__ __forceinline__ void xcd_barrier(const XcdBarrier& b) {
    asm volatile("s_waitcnt vmcnt(0)" ::: "memory");
    __syncthreads();
    if (threadIdx.x == 0) {
        unsigned* bar = b.bar;
        __builtin_amdgcn_s_waitcnt(0);
        unsigned nloc = b.st[0], nx = b.st[1];
        if (nloc == 0u) { xcd_barrier_complete(bar, b.x, nloc, nx); b.st[0] = nloc; b.st[1] = nx; }
        const unsigned old = xb_add(&bar[XB_XSUB(b.x)], 1u);
        const unsigned gen = old / nloc;
        if (old + 1u == (gen + 1u) * nloc) {
            __builtin_amdgcn_fence(__ATOMIC_RELEASE, "agent");
            asm volatile("s_waitcnt vmcnt(0)" ::: "memory");
            const unsigned og = xb_add(&bar[XB_TOP], 1u);
            const unsigned tg = og / nx;
            if (og + 1u == (tg + 1u) * nx) xb_add(&bar[XB_TOPGEN], 1u);
            else XB_SPIN(xb_ld(&bar[XB_TOPGEN]) == tg, bar);
            __builtin_amdgcn_fence(__ATOMIC_ACQUIRE, "agent");
            xb_add(&bar[XB_XGEN(b.x)], 1u);
            asm volatile("s_waitcnt vmcnt(0)" ::: "memory");
        } else {
            XB_SPIN(xb_ld(&bar[XB_XGEN(b.x)]) == gen, bar);
            __builtin_amdgcn_fence(__ATOMIC_ACQUIRE, "agent");
            asm volatile("s_waitcnt vmcnt(0)" ::: "memory");
        }
    }
    __syncthreads();
}

struct Params {
    const float *x, *c, *ctx, *c_ctx, *ada_w, *ada_b, *norm1_g, *norm2_g, *w_in, *rpb, *w_att_o, *w_fourier, *w_pool, *pool_scale, *w_out, *w_router, *w_eg, *w_eu, *w_ed, *final_g;
    float* out; unsigned char* ws; int l_lo, l_hi;
};
struct Frame {
    LAS unsigned char* lds;
    int tid, lane, wave, G, bid;
    unsigned char* ws;
};
#define WSP(T, off) ((T*)(F.ws + (off)))

struct Unit { int grp, pm, pn, seg; };
struct GroupSched {
    int ng, nM, nN, G, c; int tM, tN, tpm0, tpn0;
    __device__ __forceinline__ void init(int ng_, int nM_, int nN_, int G_, int c_, int tM_ = 0, int tN_ = 0, int tpm0_ = 0, int tpn0_ = 0) { ng = ng_; nM = nM_; nN = nN_; G = G_; c = c_; tM = tM_; tN = tN_; tpm0 = tpm0_; tpn0 = tpn0_; }
    __device__ __forceinline__ bool next(int i, Unit& u) const {
        const int per = nM * nN; const int L = i * G + c;
        if (L < ng * per) {
            u.grp = L / per; int wgid = L - u.grp * per;
            { const int q = per / 8, r = per % 8, xcd = wgid % 8, off = wgid / 8; wgid = (xcd < r ? xcd * (q + 1) : r * (q + 1) + (xcd - r) * q) + off; }
            const int nig = 8 * nN, gid = wgid / nig, fm = gid * 8, gsz = (nM - fm) < 8 ? (nM - fm) : 8;
            u.pm = fm + ((wgid % nig) % gsz); u.pn = (wgid % nig) / gsz; u.seg = 0; return true;
        }
        const int w = L - ng * per;
        if (w < tM * tN) { u.grp = ng; u.pm = tpm0 + (w % tM); u.pn = tpn0 + (w / tM); u.seg = 0; return true; }
        return false;
    }
};
struct Operands { const bf16* A; const bf16* Bt; int lda, ldb, slot0, K; int bmap; };

constexpr int HTB = 128 * 64 * 2;
__device__ __forceinline__ int lds_byte(int r, int c) { const int st = (r >> 4) * 2 + (c >> 5), rr = r & 15, cc = c & 31, ob = rr * 64 + cc * 2; return st * 1024 + (ob ^ (((ob >> 9) & 1) << 5)); }
__device__ __forceinline__ int perm32(int rho) { const int n = rho >> 4, i = rho & 15; return 8 * (i >> 2) + 4 * n + (i & 3); }
__device__ __forceinline__ void stage_rc(int b, int& R, int& C) { const int st = b / 1024, sb = b % 1024, swz = sb ^ (((sb >> 9) & 1) << 5); R = (st >> 1) * 16 + swz / 64; C = (st & 1) * 32 + (swz % 64) / 2; }
typedef int i32x8 __attribute__((ext_vector_type(8)));
typedef int i32x4 __attribute__((ext_vector_type(4)));
__device__ __forceinline__ i32x8 cat8(bf16x8 lo, bf16x8 hi) { const i32x4 a = __builtin_bit_cast(i32x4, lo), b = __builtin_bit_cast(i32x4, hi); return (i32x8){a[0], a[1], a[2], a[3], b[0], b[1], b[2], b[3]}; }
template <bool GATHER, bool PERM, bool FP8, class Sched, class Addr, class Epi>
__device__ __forceinline__ void gemm_fast(LAS unsigned char* lds, const int tid, const Sched& S, const Addr& AD, const Epi& E, const int* __restrict__ grows) {
    const int wid = __builtin_amdgcn_readfirstlane(tid >> 6), lane = tid & 63, wr = wid >> 2, wc = wid & 3, fr = lane & 15, fq = lane >> 4;
    unsigned cvg[2][2], nvg[2][2], cvb[2][2], nvb[2][2];
#define PG8_RC(i_) int R_, C_; stage_rc(tid * 16 + (i_) * 8192, R_, C_); const int sR_ = R_; const unsigned sC_ = (unsigned)C_ * 2u; const int sRb_ = PERM ? ((R_ & ~31) + perm32(R_ & 31)) : R_; (void)sR_; (void)sRb_; (void)sC_
    const size_t kstep = 128;
    const unsigned ldsw = (unsigned)wid * 1024u;
    const int aoff = lds_byte(wr * 64 + fr, fq * 8), boff = lds_byte(wc * 32 + fr, fq * 8);
#define PG8_SA(b, h) (((b) * 2 + (h)) * HTB)
#define PG8_SB(b, h) ((4 + (b) * 2 + (h)) * HTB)
#define PG8_STAGE(bufoff, gbase, voff) do { _Pragma("unroll") for (int _i = 0; _i < 2; ++_i) \
        __builtin_amdgcn_global_load_lds((const unsigned*)((const char*)(gbase) + (voff)[_i]), (LAS unsigned*)(lds + (bufoff) + ldsw + _i * 8192), 16, 0, 0); } while (0)
#define PG8_LDA(dst, b, h) do { if constexpr (FP8) { _Pragma("unroll") for (int m = 0; m < 4; ++m) dst##8[m] = cat8(*(const LAS bf16x8*)(lds + PG8_SA(b, h) + aoff + m * 2048), *(const LAS bf16x8*)(lds + PG8_SA(b, h) + aoff + m * 2048 + 1024)); } \
        else { _Pragma("unroll") for (int m = 0; m < 4; ++m) _Pragma("unroll") for (int k = 0; k < 2; ++k) dst[m][k] = *(const LAS bf16x8*)(lds + PG8_SA(b, h) + aoff + m * 2048 + k * 1024); } } while (0)
#define PG8_LDB(dst, b, h) do { if constexpr (FP8) { _Pragma("unroll") for (int n = 0; n < 2; ++n) dst##8[n] = cat8(*(const LAS bf16x8*)(lds + PG8_SB(b, h) + boff + n * 2048), *(const LAS bf16x8*)(lds + PG8_SB(b, h) + boff + n * 2048 + 1024)); } \
        else { _Pragma("unroll") for (int n = 0; n < 2; ++n) _Pragma("unroll") for (int k = 0; k < 2; ++k) dst[n][k] = *(const LAS bf16x8*)(lds + PG8_SB(b, h) + boff + n * 2048 + k * 1024); } } while (0)
#define PG8_MMA(ai, bj, At, Bt) do { __builtin_amdgcn_s_setprio(1); \
        if constexpr (FP8) { _Pragma("unroll") for (int m = 0; m < 4; ++m) _Pragma("unroll") for (int n = 0; n < 2; ++n)   \
            asm volatile("v_mfma_scale_f32_16x16x128_f8f6f4 %0, %1, %2, %0, %3, %3 op_sel_hi:[0,0,0]" : "+v"(acc[ai][bj][m][n]) : "v"(Bt##8[n]), "v"(At##8[m]), "v"(one_scale)); } \
        else { _Pragma("unroll") for (int m = 0; m < 4; ++m) _Pragma("unroll") for (int n = 0; n < 2; ++n) _Pragma("unroll") for (int k = 0; k < 2; ++k) \
            acc[ai][bj][m][n] = __builtin_amdgcn_mfma_f32_16x16x32_bf16(Bt[n][k], At[m][k], acc[ai][bj][m][n], 0, 0, 0); } \
        __builtin_amdgcn_s_setprio(0); } while (0)
#define PG8_WAIT_V(n) asm volatile("s_waitcnt vmcnt(" #n ")" ::: "memory")
#define PG8_WAIT_L(n) asm volatile("s_waitcnt lgkmcnt(" #n ")" ::: "memory")
#define PG8_BAR __builtin_amdgcn_s_barrier()
#define PG8_SCHED __builtin_amdgcn_sched_barrier(0)
#define PG8_GIDX(dst, op_) do { _Pragma("unroll") for (int i_ = 0; i_ < 2; ++i_) { PG8_RC(i_); _Pragma("unroll") for (int h_ = 0; h_ < 2; ++h_) dst[h_][i_] = (unsigned)grows[(op_).slot0 + h_ * 128 + sR_] * (unsigned)((op_).lda * 2) + sC_; } } while (0)
#define PG8_AOFF(dst, op_) do { _Pragma("unroll") for (int i_ = 0; i_ < 2; ++i_) { PG8_RC(i_); _Pragma("unroll") for (int h_ = 0; h_ < 2; ++h_) dst[h_][i_] = (unsigned)((sR_ + 128 * h_) * (op_).lda) * 2u + sC_; } } while (0)
#define PG8_BOFF(dst, op_) do { _Pragma("unroll") for (int i_ = 0; i_ < 2; ++i_) { PG8_RC(i_); _Pragma("unroll") for (int h_ = 0; h_ < 2; ++h_) { const int c_ = sRb_ + 128 * h_; \
        dst[h_][i_] = (unsigned)(((op_).bmap ? (64 * (c_ & 7) + (c_ >> 3)) : c_) * (op_).ldb) * 2u + sC_; } } } while (0)
#define PG8_COPY(dst, src) do { _Pragma("unroll") for (int h_ = 0; h_ < 2; ++h_) _Pragma("unroll") for (int i_ = 0; i_ < 2; ++i_) dst[h_][i_] = src[h_][i_]; } while (0)
    Unit cur, nxt; int ui = 0;
    if (!S.next(0, cur)) return;
    f32x4 acc[2][2][4][2];
#pragma unroll
    for (int a = 0; a < 2; ++a)
#pragma unroll
        for (int b = 0; b < 2; ++b)
#pragma unroll
            for (int m = 0; m < 4; ++m)
#pragma unroll
                for (int n = 0; n < 2; ++n) acc[a][b][m][n] = (f32x4){0.f, 0.f, 0.f, 0.f};
    bf16x8 At[4][2], B0[2][2], B1[2][2]; i32x8 At8[4], B08[2], B18[2];
    const int one_scale = 0x7F7F7F7F;
    const char* cA; const char* cB; int nt;
    bool has_next; const char* nA; const char* nB; int nnt;
    { const Operands op = AD(cur); cA = (const char*)op.A; cB = (const char*)op.Bt; nt = op.K / 64; PG8_BOFF(cvb, op);
      has_next = S.next(1, nxt); const Operands o1 = has_next ? AD(nxt) : op; PG8_BOFF(nvb, o1); nA = (const char*)o1.A; nB = (const char*)o1.Bt; nnt = o1.K / 64;
      if constexpr (GATHER) { PG8_GIDX(cvg, op); PG8_GIDX(nvg, o1); PG8_WAIT_V(0); } else { PG8_AOFF(cvg, op); PG8_AOFF(nvg, o1); } }
    PG8_STAGE(PG8_SB(0, 0), cB, cvb[0]); PG8_STAGE(PG8_SB(0, 1), cB, cvb[1]); PG8_STAGE(PG8_SA(0, 0), cA, cvg[0]); PG8_STAGE(PG8_SA(0, 1), cA, cvg[1]);
    if (wr == 1) PG8_BAR;
    PG8_WAIT_V(2); PG8_BAR;
    PG8_STAGE(PG8_SB(1, 0), cB + kstep, cvb[0]); PG8_STAGE(PG8_SA(1, 0), cA + kstep, cvg[0]); PG8_STAGE(PG8_SB(1, 1), cB + kstep, cvb[1]);
    PG8_WAIT_V(6); PG8_BAR;
    for (;;) {
#pragma unroll 1
        for (int t = 0; t < nt; t += 2) {
            const bool last = (t == nt - 2);
            const char* a1 = cA + (size_t)(t + 1) * kstep;
            const char* a2 = last ? nA : cA + (size_t)(t + 2) * kstep; const char* b2 = last ? nB : cB + (size_t)(t + 2) * kstep;
            const char* a3 = a2 + kstep; const char* b3 = b2 + kstep;
            unsigned v2[2][2], w2[2][2];
#pragma unroll
            for (int h_ = 0; h_ < 2; ++h_)
#pragma unroll
                for (int i_ = 0; i_ < 2; ++i_) { v2[h_][i_] = last ? nvg[h_][i_] : cvg[h_][i_]; w2[h_][i_] = last ? nvb[h_][i_] : cvb[h_][i_]; }
            PG8_LDB(B0, 0, 0); PG8_LDB(B1, 0, 1); PG8_SCHED; PG8_LDA(At, 0, 0); PG8_STAGE(PG8_SA(1, 1), a1, cvg[1]);
            PG8_WAIT_V(8); PG8_WAIT_L(0); PG8_BAR; PG8_MMA(0, 0, At, B0); PG8_MMA(0, 1, At, B1); PG8_BAR; PG8_SCHED;
            PG8_LDA(At, 0, 1); PG8_STAGE(PG8_SB(0, 0), b2, w2[0]); PG8_STAGE(PG8_SB(0, 1), b2, w2[1]); PG8_STAGE(PG8_SA(0, 0), a2, v2[0]);
            PG8_WAIT_V(8); PG8_WAIT_L(0); PG8_BAR; PG8_MMA(1, 0, At, B0); PG8_MMA(1, 1, At, B1); PG8_BAR; PG8_SCHED;
            PG8_LDB(B0, 1, 0); PG8_LDB(B1, 1, 1); PG8_SCHED; PG8_LDA(At, 1, 0); PG8_STAGE(PG8_SA(0, 1), a2, v2[1]);
            PG8_WAIT_V(8); PG8_WAIT_L(0); PG8_BAR; PG8_MMA(0, 0, At, B0); PG8_MMA(0, 1, At, B1); PG8_BAR; PG8_SCHED;
            PG8_LDA(At, 1, 1); PG8_STAGE(PG8_SB(1, 0), b3, w2[0]); PG8_STAGE(PG8_SB(1, 1), b3, w2[1]); PG8_STAGE(PG8_SA(1, 0), a3, v2[0]);
            PG8_WAIT_V(8); PG8_WAIT_L(0); PG8_BAR; PG8_MMA(1, 0, At, B0); PG8_MMA(1, 1, At, B1); PG8_BAR; PG8_SCHED;
        }
        if constexpr (FP8) asm volatile("s_nop 15\n\ts_nop 15" ::: "memory");
        if (wr == 0) PG8_BAR;
        unsigned fvg[2][2], fvb[2][2];
        Unit u2; const bool h2 = S.next(ui + 2, u2); const char* fA = nA; const char* fB = nB; int fnt = nnt;
        if (h2) { const Operands o2 = AD(u2); fA = (const char*)o2.A; fB = (const char*)o2.Bt; fnt = o2.K / 64; PG8_BOFF(fvb, o2); if constexpr (GATHER) PG8_GIDX(fvg, o2); else PG8_AOFF(fvg, o2); }
        else { PG8_COPY(fvb, nvb); PG8_COPY(fvg, nvg); }
        { int fr2 = fr, fq2 = fq; asm volatile("" : "+v"(fr2), "+v"(fq2));
          E(acc, cur, wr, wc, fr2, fq2); }
        if (!has_next) break;
        if constexpr (GATHER) PG8_WAIT_V(0);
        PG8_COPY(cvg, nvg); PG8_COPY(nvg, fvg); PG8_COPY(cvb, nvb); PG8_COPY(nvb, fvb);
        if (E.reset(cur)) {
#pragma unroll
        for (int a = 0; a < 2; ++a)
#pragma unroll
            for (int b = 0; b < 2; ++b)
#pragma unroll
                for (int m = 0; m < 4; ++m)
#pragma unroll
                    for (int n = 0; n < 2; ++n) acc[a][b][m][n] = (f32x4){0.f, 0.f, 0.f, 0.f};
        }
        cur = nxt; cA = nA; cB = nB; nt = nnt; ++ui;
        nxt = u2; has_next = h2; nA = fA; nB = fB; nnt = fnt;
        if (wr == 1) PG8_BAR;
    }
    PG8_WAIT_V(0);
    PG8_BAR;
#undef PG8_SA
#undef PG8_SB
#undef PG8_STAGE
#undef PG8_LDA
#undef PG8_LDB
#undef PG8_MMA
#undef PG8_WAIT_V
#undef PG8_WAIT_L
#undef PG8_BAR
#undef PG8_SCHED
#undef PG8_GIDX
#undef PG8_AOFF
#undef PG8_BOFF
#undef PG8_COPY
#undef PG8_RC
}
template <class F> struct EpiFn { F f; __device__ __forceinline__ void operator()(f32x4 (&acc)[2][2][4][2], const Unit& u, int wr, int wc, int fr, int fq) const { f(acc, u, wr, wc, fr, fq); } __device__ __forceinline__ bool reset(const Unit&) const { return true; } };
template <class F> __device__ __forceinline__ EpiFn<F> mk_epi(F f) { return EpiFn<F>{f}; }
template <class F> struct EpiSeg { F f; int last; __device__ __forceinline__ void operator()(f32x4 (&acc)[2][2][4][2], const Unit& u, int wr, int wc, int fr, int fq) const { f(acc, u, wr, wc, fr, fq); } __device__ __forceinline__ bool reset(const Unit& u) const { return u.seg == last; } };
template <class F> __device__ __forceinline__ EpiSeg<F> mk_epi_seg(F f, int last) { return EpiSeg<F>{f, last}; }
template <int NSEG> struct SegSched { GroupSched base; __device__ __forceinline__ bool next(int j, Unit& u) const { if (!base.next(j / NSEG, u)) return false; u.seg = j % NSEG; return true; } };
#ifndef DUP_PH
#define DUP_PH -1
#endif
#define REP_BEGIN(k) _Pragma("unroll 1") for (int rep_ = 0; rep_ < ((DUP_PH == (k)) ? 2 : 1); ++rep_) { if (rep_) { if constexpr (PH < 0) xcd_barrier(bar); }
#define REP_END }
#define GEMM(S, AD, E, K, lda, ldb) gemm_fast<false, false, false>(F.lds, F.tid, S, AD, mk_epi(E), nullptr)
#define GEMM_P(S, AD, E) gemm_fast<false, true, false>(F.lds, F.tid, S, AD, mk_epi(E), nullptr)
#define GEMM_P8(S, AD, E) gemm_fast<false, true, true>(F.lds, F.tid, S, AD, mk_epi(E), nullptr)
#define GEMM_GATHER8(S, AD, E, rows) gemm_fast<true, true, true>(F.lds, F.tid, S, AD, mk_epi(E), rows)
#define EPI_ARGS f32x4 (&acc)[2][2][4][2], const Unit& u, int wr, int wc, int fr, int fq
#define EPI_FOR(...) _Pragma("unroll") for (int ai = 0; ai < 2; ++ai) _Pragma("unroll") for (int m = 0; m < 4; ++m) { const int r = ai * 128 + wr * 64 + m * 16 + fr; \
    _Pragma("unroll") for (int bj = 0; bj < 2; ++bj) _Pragma("unroll") for (int n = 0; n < 2; ++n) { const int c = bj * 128 + wc * 32 + n * 16 + 4 * fq; const f32x4 v = acc[ai][bj][m][n]; __VA_ARGS__ } }
#define EPI_FOR8(...) _Pragma("unroll") for (int ai = 0; ai < 2; ++ai) _Pragma("unroll") for (int m = 0; m < 4; ++m) { const int r = ai * 128 + wr * 64 + m * 16 + fr; \
    _Pragma("unroll") for (int bj = 0; bj < 2; ++bj) { const int c = bj * 128 + wc * 32 + 8 * fq; const f32x4 v0 = acc[ai][bj][m][0], v1 = acc[ai][bj][m][1]; __VA_ARGS__ } }
__device__ __forceinline__ void st_bf8(bf16* p, f32x4 a, f32x4 b) { u32x4 w; w.x = pk2(a[0], a[1]); w.y = pk2(a[2], a[3]); w.z = pk2(b[0], b[1]); w.w = pk2(b[2], b[3]); *(u32x4*)p = w; }
__device__ __forceinline__ void st_bf4(bf16* p, f32x4 v) { u32x2 w; w.x = pk2(v[0], v[1]); w.y = pk2(v[2], v[3]); *(u32x2*)p = w; }

__device__ __forceinline__ void p_mod(const Params& P, Frame& F) {
    LAS float* sc = (LAS float*)F.lds;
    LAS float* red = (LAS float*)(F.lds + 9 * 1024 * 4);
    float* MOD = WSP(float, WS_MOD);
    bool have = false;
    for (int it = F.bid; it < 2 * 96; it += F.G) {
        if (!have) {
            for (int i = F.tid; i < 9 * 1024; i += NTHREADS) { const int r = i >> 10, k = i & 1023; const float v = r < 8 ? P.c[r * 1024 + k] : P.c_ctx[k]; sc[i] = v * sigmoidf_(v); }
            have = true;
        }
        __syncthreads();
        const int l = it / 96, j0 = (it % 96) * 64, jj = F.tid & 63, kc = F.tid >> 6;
        const float* W = P.ada_w + (size_t)l * 1024 * 6144 + j0 + jj;
        float a[9];
#pragma unroll
        for (int r = 0; r < 9; ++r) a[r] = 0.f;
#pragma unroll 8
        for (int k = kc * 128; k < kc * 128 + 128; ++k) { const float w = W[(size_t)k * 6144];
#pragma unroll
            for (int r = 0; r < 9; ++r) a[r] += sc[r * 1024 + k] * w; }
#pragma unroll
        for (int r = 0; r < 9; ++r) red[(kc * 9 + r) * 64 + jj] = a[r];
        __syncthreads();
        for (int o = F.tid; o < 9 * 64; o += NTHREADS) { const int r = o >> 6, j = o & 63; float s = 0.f;
#pragma unroll
            for (int q = 0; q < 8; ++q) s += red[(q * 9 + r) * 64 + j];
            MOD[((size_t)l * 9 + r) * 6144 + j0 + j] = s + P.ada_b[l * 6144 + j0 + j]; }
    }
    __syncthreads();
}
__device__ __forceinline__ void p_dftgen(Frame& F) {
    LAS float* tab = (LAS float*)F.lds;
    for (int j = F.tid; j < 4096; j += NTHREADS) tab[j] = cospif((float)j * (1.0f / 2048.0f));
    __syncthreads();
    bf16* DC_ = WSP(bf16, WS_DFTC); bf16* M1 = WSP(bf16, WS_M1T); bf16* M2 = WSP(bf16, WS_M2T);
    const int nchunk = 256 * 64 + 256 * 32 + 256 * 64;
    for (int ch = F.bid * NTHREADS + F.tid; ch < nchunk; ch += F.G * NTHREADS) {
        float v[8]; bf16* dst;
        if (ch < 256 * 64) { const int kf = ch >> 6, col0 = (ch & 63) * 8, cs = col0 >> 8, l0 = col0 & 255;
#pragma unroll
            for (int i = 0; i < 8; ++i) { const int j = ((kf * (l0 + i)) & 255) * 16; v[i] = cs ? -tab[(j + 3072) & 4095] : tab[j]; }
            dst = DC_ + (size_t)kf * 512 + col0; }
        else if (ch < 256 * 64 + 256 * 32) { const int c2 = ch - 256 * 64, row = c2 >> 5, col0 = (c2 & 31) * 8, ri = row >> 7, h = (row >> 6) & 1, k1 = row & 63, h2 = col0 >> 7, cs = (col0 >> 6) & 1, l10 = col0 & 63;
#pragma unroll
            for (int i = 0; i < 8; ++i) { const int j = ((k1 * (l10 + i)) & 63) * 64; const float c = tab[j], sn = tab[(j + 3072) & 4095];
                v[i] = (h != h2) ? 0.f : (ri == 0 ? (cs == 0 ? c : -sn) : (cs == 0 ? sn : c)); }
            dst = M1 + (size_t)row * 256 + col0; }
        else { const int c2 = ch - 256 * 64 - 256 * 32, row = c2 >> 6, col0 = (c2 & 63) * 8, q = row >> 6, k2 = row & 63, q2 = col0 >> 7, ri = (col0 >> 6) & 1, l20 = col0 & 63;
#pragma unroll
            for (int i = 0; i < 8; ++i) { const int j = ((k2 * (l20 + i)) & 63) * 64; const float c = tab[j], sn = tab[(j + 3072) & 4095];
                v[i] = (q != q2) ? 0.f : (ri == 0 ? c : -sn); }
            dst = M2 + (size_t)row * 512 + col0; }
        u32x4 o; o.x = pk2(v[0], v[1]); o.y = pk2(v[2], v[3]); o.z = pk2(v[4], v[5]); o.w = pk2(v[6], v[7]);
        *(u32x4*)dst = o;
    }
    __syncthreads();
}
__device__ __forceinline__ void transpose_item(const float* W, int ldw, int k0, int n0, bf16* WT, int ldt, int drow0, LAS float* scr, int lane) {
    f32x4 ld[8];
#pragma unroll
    for (int i = 0; i < 8; ++i) ld[i] = *(const f32x4*)(W + (size_t)(k0 + 8 * i + (lane >> 3)) * ldw + n0 + 4 * (lane & 7));
#pragma unroll
    for (int i = 0; i < 8; ++i) { LAS float* d = scr + (8 * i + (lane >> 3)) * 33 + 4 * (lane & 7); d[0] = ld[i][0]; d[1] = ld[i][1]; d[2] = ld[i][2]; d[3] = ld[i][3]; }
    LDS_WAIT(); asm volatile("" ::: "memory");
    const int c = lane & 7;
#pragma unroll
    for (int j = 0; j < 4; ++j) { const int n = (lane >> 3) + 8 * j; const LAS float* s = scr + (8 * c) * 33 + n;
        u32x4 o; o.x = pk2(s[0 * 33], s[1 * 33]); o.y = pk2(s[2 * 33], s[3 * 33]); o.z = pk2(s[4 * 33], s[5 * 33]); o.w = pk2(s[6 * 33], s[7 * 33]);
        *(u32x4*)(WT + (size_t)(drow0 + n) * ldt + k0 + 8 * c) = o; }
    LDS_WAIT(); asm volatile("" ::: "memory");
}
__device__ __forceinline__ void transpose_item8(const float* W, int ldw, int k0, int n0, unsigned char* WT, int ldt, int drow0, LAS float* scr, int lane) {
    f32x4 ld[8];
#pragma unroll
    for (int i = 0; i < 8; ++i) ld[i] = *(const f32x4*)(W + (size_t)(k0 + 8 * i + (lane >> 3)) * ldw + n0 + 4 * (lane & 7));
#pragma unroll
    for (int i = 0; i < 8; ++i) { LAS float* d = scr + (8 * i + (lane >> 3)) * 33 + 4 * (lane & 7); d[0] = ld[i][0]; d[1] = ld[i][1]; d[2] = ld[i][2]; d[3] = ld[i][3]; }
    LDS_WAIT(); asm volatile("" ::: "memory");
    const int c = lane & 7;
#pragma unroll
    for (int j = 0; j < 4; ++j) { const int n = (lane >> 3) + 8 * j; const LAS float* s = scr + (8 * c) * 33 + n;
        u32x2 o; o.x = pk4_fp8(s[0 * 33] * W8S, s[1 * 33] * W8S, s[2 * 33] * W8S, s[3 * 33] * W8S); o.y = pk4_fp8(s[4 * 33] * W8S, s[5 * 33] * W8S, s[6 * 33] * W8S, s[7 * 33] * W8S);
        *(u32x2*)(WT + (size_t)(drow0 + n) * ldt + k0 + 8 * c) = o; }
    LDS_WAIT(); asm volatile("" ::: "memory");
}
__device__ __forceinline__ void p_wconv(const Params& P, Frame& F, int l) {
    LAS float* scr = (LAS float*)(F.lds + F.wave * 16384);
    const int gw = F.bid * NWAVES + F.wave, NGW = F.G * NWAVES;
    const float* w_in = P.w_in + (size_t)l * 1024 * INW;
    bf16* WA = WSP(bf16, WS_WA); bf16* WFV = WSP(bf16, WS_WFV);
    constexpr int I_K = 16 * 32, I_Q = 16 * 32, I_P = 16 * 16, I_G = 16 * 96, I_V = 16 * 32, I_AO = 16 * 32, I_FO = 8 * 32, I_OUT = 16 * 32;
    constexpr int NSM = I_K + I_Q + I_P + I_G + I_V + I_AO + I_FO + I_OUT;
    for (int it = gw; it < NSM; it += NGW) {
        int r = it;
        if (r < I_K) { transpose_item(w_in, INW, (r / 32) * 64, 0 + (r % 32) * 32, WA, 1024, 0 + (r % 32) * 32, scr, F.lane); continue; } r -= I_K;
        if (r < I_Q) { transpose_item(w_in, INW, (r / 32) * 64, 2048 + (r % 32) * 32, WA, 1024, 1024 + (r % 32) * 32, scr, F.lane); continue; } r -= I_Q;
        if (r < I_P) { transpose_item(w_in, INW, (r / 16) * 64, 3584 + (r % 16) * 32, WA, 1024, 2048 + (r % 16) * 32, scr, F.lane); continue; } r -= I_P;
        if (r < I_G) { transpose_item(w_in, INW, (r / 96) * 64, 4096 + (r % 96) * 32, WA, 1024, 2560 + (r % 96) * 32, scr, F.lane); continue; } r -= I_G;
        if (r < I_V) { transpose_item(w_in, INW, (r / 32) * 64, 1024 + (r % 32) * 32, WFV, 1024, 1024 + (r % 32) * 32, scr, F.lane); continue; } r -= I_V;
        if (r < I_AO) { transpose_item(P.w_att_o + (size_t)l * 1024 * 1024, 1024, (r / 32) * 64, (r % 32) * 32, WSP(bf16, WS_WAO), 1024, (r % 32) * 32, scr, F.lane); continue; } r -= I_AO;
        if (r < I_FO) { transpose_item(P.w_fourier + (size_t)l * 512 * 1024, 1024, (r / 32) * 64, (r % 32) * 32, WSP(bf16, WS_WFO), 512, (r % 32) * 32, scr, F.lane); continue; } r -= I_FO;
        transpose_item(P.w_out + (size_t)l * 1024 * 1024, 1024, (r / 32) * 64, (r % 32) * 32, WSP(bf16, WS_WOUT), 1024, (r % 32) * 32, scr, F.lane);
    }
    constexpr int I_E = 16 * 88;
    unsigned char* WGU = WSP(unsigned char, WS_WGU); unsigned char* WD = WSP(unsigned char, WS_WD);
    for (int it = gw; it < 3 * 16 * I_E; it += NGW) {
        const int which = it / (16 * I_E), r0 = it % (16 * I_E), e = r0 / I_E, r = r0 % I_E;
        if (which < 2) { const int kb = r / 88, nb = r % 88, n0 = nb * 32;
            const float* src = (which == 0 ? P.w_eg : P.w_eu) + ((size_t)l * 16 + e) * 1024 * FF;
            transpose_item8(src, FF, kb * 64, n0, WGU + (size_t)e * 5632 * 1024, 1024, (n0 >> 7) * 256 + (which ? 128 : 0) + (n0 & 127), scr, F.lane); }
        else { const int kb = r / 32, nb = r % 32;
            transpose_item8(P.w_ed + ((size_t)l * 16 + e) * FF * 1024, 1024, kb * 64, nb * 32, WD + (size_t)e * 1024 * FF, FF, nb * 32, scr, F.lane); }
    }
    { bf16* WPO = WSP(bf16, WS_WPO); const float* wp = P.w_pool + (size_t)l * 4 * 128 * 256;
      for (int i = F.bid * NTHREADS + F.tid; i < 1024 * 256; i += F.G * NTHREADS) { const int n = i >> 8, kk = i & 255, g = n >> 8, f = n & 255;
          WPO[i] = (bf16)(((kk >> 7) == (g & 1)) ? f2bf(wp[((size_t)g * 128 + (kk & 127)) * 256 + f]) : 0u); } }
    { LAS float* t128 = (LAS float*)F.lds;
      __syncthreads();
      for (int j = F.tid; j < 128; j += NTHREADS) t128[j] = cospif((float)j * (1.0f / 64.0f));
      __syncthreads();
      for (int i = F.bid * NTHREADS + F.tid; i < 1024 * 1024; i += F.G * NTHREADS) { const int fc = i >> 10, k = i & 1023, cs = fc & 1, gm = fc >> 1, g = gm >> 7, m = gm & 127;
          const float* src = w_in + (size_t)k * INW + 3072 + g * 128; float s = 0.f; const int ph = cs ? 96 : 0;
          for (int c = 0; c < 128; ++c) s += src[c] * t128[(m * c + ph) & 127];
          WFV[i] = (bf16)f2bf(s); }
      __syncthreads(); }
}

struct RowMod { const float* g; const float* sh; const float* sc; };
__device__ __forceinline__ void row_load(const float* row, int lane, f32x4 (&v)[4]) {
#pragma unroll
    for (int j = 0; j < 4; ++j) v[j] = *(const f32x4*)(row + 4 * lane + 256 * j);
}
__device__ __forceinline__ float row_rstd(const f32x4 (&v)[4]) {
    float s = 0.f;
#pragma unroll
    for (int j = 0; j < 4; ++j) s += (v[j][0] * v[j][0] + v[j][1] * v[j][1]) + (v[j][2] * v[j][2] + v[j][3] * v[j][3]);
    return rsqrtf(wave_sum(s) * (1.0f / 1024.0f) + RMS_EPS);
}
__device__ __forceinline__ void row_modulate(const f32x4 (&v)[4], float rstd, const RowMod& M, int lane, f32x4 (&y)[4]) {
#pragma unroll
    for (int j = 0; j < 4; ++j) { const int k = 4 * lane + 256 * j; const f32x4 g = *(const f32x4*)(M.g + k), sh = *(const f32x4*)(M.sh + k), sc = *(const f32x4*)(M.sc + k);
        y[j] = v[j] * rstd * g * (sc + 1.0f) + sh; }
}
__device__ __forceinline__ void row_store_bf(bf16* row, int lane, const f32x4 (&y)[4]) {
#pragma unroll
    for (int j = 0; j < 4; ++j) st_bf4(row + 4 * lane + 256 * j, y[j]);
}
__device__ __forceinline__ const float* mod_ptr(Frame& F, int l, int row, int which) { const int mr = row < RL ? (row >> 12) : 8; return WSP(float, WS_MOD) + ((size_t)l * 9 + mr) * 6144 + which * 1024; }

__device__ __forceinline__ void p_rowpass_a0(const Params& P, Frame& F) {
    const int gw = F.bid * NWAVES + F.wave, NGW = F.G * NWAVES; bf16* H = WSP(bf16, WS_H);
    f32x4 vn[4]; int row = gw;
    if (row < RT) row_load(row < RL ? P.x + (size_t)row * DM : P.ctx + (size_t)(row - RL) * DM, F.lane, vn);
    for (; row < RT; row += NGW) {
        f32x4 v[4], y[4];
#pragma unroll
        for (int j = 0; j < 4; ++j) v[j] = vn[j];
        { const int nr = row + NGW; if (nr < RT) row_load(nr < RL ? P.x + (size_t)nr * DM : P.ctx + (size_t)(nr - RL) * DM, F.lane, vn); }
        const float rs = row_rstd(v);
        RowMod M{P.norm1_g, mod_ptr(F, 0, row, 0), mod_ptr(F, 0, row, 1)};
        row_modulate(v, rs, M, F.lane, y); row_store_bf(H + (size_t)row * DM, F.lane, y);
    }
}
__device__ __forceinline__ void p_rowpass_f(const Params& P, Frame& F, int l, int nrows) {
    const int gw = F.bid * NWAVES + F.wave, NGW = F.G * NWAVES; unsigned char* H8 = WSP(unsigned char, WS_H8); float* AFF = WSP(float, WS_AFF);
    const float* wr = P.w_router + (size_t)l * 1024 * 16;
    LAS float* wl = (LAS float*)F.lds;
    __syncthreads();
    for (int i = F.tid; i < 16384; i += NTHREADS) wl[(i & 15) * 1024 + (i >> 4)] = wr[i];
    __syncthreads();
    f32x4 vn[4]; int row = gw;
    if (row < nrows) row_load(row < RL ? P.out + (size_t)row * DM : WSP(float, WS_XC) + (size_t)(row - RL) * DM, F.lane, vn);
    for (; row < nrows; row += NGW) {
        f32x4 v[4], y[4];
#pragma unroll
        for (int j = 0; j < 4; ++j) v[j] = vn[j];
        { const int nr = row + NGW; if (nr < nrows) row_load(nr < RL ? P.out + (size_t)nr * DM : WSP(float, WS_XC) + (size_t)(nr - RL) * DM, F.lane, vn); }
        const float rs = row_rstd(v);
        RowMod M{P.norm2_g + l * 1024, mod_ptr(F, l, row, 3), mod_ptr(F, l, row, 4)};
        row_modulate(v, rs, M, F.lane, y);
#pragma unroll
        for (int j = 0; j < 4; ++j) *(unsigned*)(H8 + (size_t)row * DM + 4 * F.lane + 256 * j) = pk4_fp8(y[j][0] * A8S, y[j][1] * A8S, y[j][2] * A8S, y[j][3] * A8S);
        float lg[16];
        int wo = 4 * F.lane; asm volatile("" : "+v"(wo));
#pragma unroll
        for (int e = 0; e < 16; ++e) { float a = 0.f;
#pragma unroll
            for (int j = 0; j < 4; ++j) { const f32x4 w = *(const LAS f32x4*)(wl + e * 1024 + wo + 256 * j); a += (y[j][0] * w[0] + y[j][1] * w[1]) + (y[j][2] * w[2] + y[j][3] * w[3]); }
            lg[e] = a; }
        float mx = -1e30f;
#pragma unroll
        for (int e = 0; e < 16; ++e) { lg[e] = wave_sum(lg[e]); mx = fmaxf(mx, lg[e]); }
        float den = 0.f;
#pragma unroll
        for (int e = 0; e < 16; ++e) { lg[e] = __expf(lg[e] - mx); den += lg[e]; }
        const float inv = 1.0f / den;
        if (F.lane < 16) { float mine = 0.f;
#pragma unroll
            for (int e = 0; e < 16; ++e) mine = (F.lane == e) ? lg[e] : mine;
            AFF[(size_t)row * 16 + F.lane] = mine * inv; }
    }
    __syncthreads();
}
__device__ __forceinline__ void p_rowpass_k(const Params& P, Frame& F, int l, int nrows) {
    const int gw = F.bid * NWAVES + F.wave, NGW = F.G * NWAVES; bf16* H = WSP(bf16, WS_H);
    const int* SEL = WSP(int, WS_SEL); const bf16* Y = WSP(bf16, WS_Y);
    f32x4 vn[4]; int seln = -1; int row = gw;
    if (row < nrows) { row_load(row < RL ? P.out + (size_t)row * DM : WSP(float, WS_XC) + (size_t)(row - RL) * DM, F.lane, vn); seln = F.lane < 16 ? SEL[(size_t)row * 16 + F.lane] : -1; }
    for (; row < nrows; row += NGW) {
        float* xr = row < RL ? P.out + (size_t)row * DM : WSP(float, WS_XC) + (size_t)(row - RL) * DM;
        f32x4 v[4], a[4]; const int sel = seln;
#pragma unroll
        for (int j = 0; j < 4; ++j) { v[j] = vn[j]; a[j] = (f32x4){0.f, 0.f, 0.f, 0.f}; }
        { const int nr = row + NGW; if (nr < nrows) { row_load(nr < RL ? P.out + (size_t)nr * DM : WSP(float, WS_XC) + (size_t)(nr - RL) * DM, F.lane, vn); seln = F.lane < 16 ? SEL[(size_t)nr * 16 + F.lane] : -1; } }
        unsigned em = (unsigned)__ballot(sel >= 0) & 0xffffu;
        while (em) { const int e = __builtin_ctz(em); em &= em - 1; const int s = __builtin_amdgcn_readlane(sel, e); const bf16* yr = Y + (size_t)s * DM;
#pragma unroll
            for (int j = 0; j < 4; ++j) { const u32x2 w = *(const u32x2*)(yr + 4 * F.lane + 256 * j); a[j][0] += bflo(w.x); a[j][1] += bfhi(w.x); a[j][2] += bflo(w.y); a[j][3] += bfhi(w.y); } }
        const float* g2 = mod_ptr(F, l, row, 5);
#pragma unroll
        for (int j = 0; j < 4; ++j) { const f32x4 g = *(const f32x4*)(g2 + 4 * F.lane + 256 * j); v[j] = v[j] + g * a[j]; }
        const float rs = row_rstd(v);
        if (l == 0) {
#pragma unroll
            for (int j = 0; j < 4; ++j) *(f32x4*)(xr + 4 * F.lane + 256 * j) = v[j];
            f32x4 y[4]; RowMod M{P.norm1_g + 1024, mod_ptr(F, 1, row, 0), mod_ptr(F, 1, row, 1)};
            row_modulate(v, rs, M, F.lane, y); row_store_bf(H + (size_t)row * DM, F.lane, y);
        } else {
#pragma unroll
            for (int j = 0; j < 4; ++j) { const f32x4 g = *(const f32x4*)(P.final_g + 4 * F.lane + 256 * j); *(f32x4*)(xr + 4 * F.lane + 256 * j) = v[j] * rs * g; }
        }
    }
}

constexpr int ACK_STRIDE = 72, ACV_STRIDE = 264;
constexpr int ALDS_CK = 0, ALDS_CV = 256 * ACK_STRIDE * 2, ALDS_RP = ALDS_CV + 64 * ACV_STRIDE * 2;
struct AttnState { float m, sum; f32x4 o[4]; };
__device__ __forceinline__ float xrow16_max(float x) {
    auto s = __builtin_amdgcn_permlane16_swap(__float_as_uint(x), __float_as_uint(x), false, false);
    x = fmaxf(__uint_as_float(s[0]), __uint_as_float(s[1]));
    auto t = __builtin_amdgcn_permlane32_swap(__float_as_uint(x), __float_as_uint(x), false, false);
    return fmaxf(__uint_as_float(t[0]), __uint_as_float(t[1]));
}
__device__ __forceinline__ float xrow16_sum(float x) {
    auto s = __builtin_amdgcn_permlane16_swap(__float_as_uint(x), __float_as_uint(x), false, false);
    x = __uint_as_float(s[0]) + __uint_as_float(s[1]);
    auto t = __builtin_amdgcn_permlane32_swap(__float_as_uint(x), __float_as_uint(x), false, false);
    return __uint_as_float(t[0]) + __uint_as_float(t[1]);
}
#define MFMA16(a, b, c) __builtin_amdgcn_mfma_f32_16x16x32_bf16((a), (b), (c), 0, 0, 0)
template <int NT>
__device__ __forceinline__ void attn_tail(AttnState& S, f32x4 (&sc)[NT], const u32x4 (&vw)[NT / 2][4]) {
    float cm = -__builtin_inff();
#pragma unroll
    for (int t = 0; t < NT; ++t)
#pragma unroll
        for (int j = 0; j < 4; ++j) cm = fmaxf(cm, sc[t][j]);
    cm = xrow16_max(cm);
    const bool need = (fabsf(cm) > 12.0f) && (cm > -1e30f);
    if (__builtin_amdgcn_ballot_w64(need) != 0ull) {
        const float d = need ? cm : 0.f, scl = __builtin_amdgcn_exp2f(-d);
        S.m += d; S.sum *= scl;
#pragma unroll
        for (int dt = 0; dt < 4; ++dt) S.o[dt] = S.o[dt] * scl;
#pragma unroll
        for (int t = 0; t < NT; ++t)
#pragma unroll
            for (int j = 0; j < 4; ++j) sc[t][j] -= d;
    }
    float ps = 0.f;
#pragma unroll
    for (int t = 0; t < NT; ++t)
#pragma unroll
        for (int j = 0; j < 4; ++j) { const float p = __builtin_amdgcn_exp2f(sc[t][j]); sc[t][j] = p; ps += p; }
    S.sum += ps;
#pragma unroll
    for (int ks = 0; ks < NT / 2; ++ks) { u32x4 pw; pw.x = pk2(sc[2 * ks][0], sc[2 * ks][1]); pw.y = pk2(sc[2 * ks][2], sc[2 * ks][3]); pw.z = pk2(sc[2 * ks + 1][0], sc[2 * ks + 1][1]); pw.w = pk2(sc[2 * ks + 1][2], sc[2 * ks + 1][3]);
        const bf16x8 pf = __builtin_bit_cast(bf16x8, pw);
#pragma unroll
        for (int dt = 0; dt < 4; ++dt) S.o[dt] = MFMA16(__builtin_bit_cast(bf16x8, vw[ks][dt]), pf, S.o[dt]); }
}
__device__ __forceinline__ void attn_unit2(const bf16* __restrict__ KQ, const bf16* __restrict__ VT, bf16* __restrict__ ATT, LAS unsigned char* lds,
                                           const int b, const int h, const int rowqA, const int rowqB, const bool win, const int r, const int qt, const int lane) {
    const int l15 = lane & 15, g = lane >> 4;
    const f32x4 z = {0.f, 0.f, 0.f, 0.f};
    bf16x8 qA[2], qB[2];
    { const bf16* qp = KQ + (size_t)(rowqA + l15) * 2048 + 1024 + h * 64 + 8 * g; qA[0] = *(const bf16x8*)qp; qA[1] = *(const bf16x8*)(qp + 32); }
    { const bf16* qp = KQ + (size_t)(rowqB + l15) * 2048 + 1024 + h * 64 + 8 * g; qB[0] = *(const bf16x8*)qp; qB[1] = *(const bf16x8*)(qp + 32); }
    AttnState SA, SB; SA.m = 0.f; SA.sum = 0.f; SB.m = 0.f; SB.sum = 0.f;
#pragma unroll
    for (int dt = 0; dt < 4; ++dt) { SA.o[dt] = z; SB.o[dt] = z; }
    if (win) {
        const int rsA = min(max(r - 4, 0), 56), dB = min(max(r - 3, 0), 56) - rsA, kc0 = min(max(16 * qt - 8, 0), 32);
        const int q = 16 * qt + l15, csq = min(max(q - 8, 0), 48);
        const int krow0 = 8 * (l15 >> 2) + (l15 & 3);
        const bf16* kb = KQ + (size_t)(b * SEQ + kc0 + krow0) * 2048 + h * 64 + 8 * g;
        const bf16* vb = VT + (size_t)(b * 1024 + h * 64 + l15) * 4096 + kc0 + 8 * g;
        const LAS float* rp = (const LAS float*)(lds + ALDS_RP);
        const int jb = kc0 + 8 * g;
        const int okb = jb - csq;
        const LAS float* rpl = rp + 16 + (jb - q + 15);
        float madd[2][4];
#pragma unroll
        for (int t = 0; t < 2; ++t)
#pragma unroll
            for (int j = 0; j < 4; ++j) madd[t][j] = ((unsigned)(okb + 4 * t + j) < 16u) ? 0.f : -__builtin_inff();
        bf16x8 K0[2][2], K1[2][2]; u32x4 V0[1][4], V1[1][4];
#define ATT_LOADW(KB, VB, i) do { const int gr_ = min(rsA + (i), 63); const bf16* kp_ = kb + (size_t)(gr_ * 64) * 2048; const bf16* vp_ = vb + gr_ * 64; \
        _Pragma("unroll") for (int t = 0; t < 2; ++t) { KB[t][0] = *(const bf16x8*)(kp_ + (size_t)(4 * t) * 2048); KB[t][1] = *(const bf16x8*)(kp_ + (size_t)(4 * t) * 2048 + 32); } \
        _Pragma("unroll") for (int dt = 0; dt < 4; ++dt) VB[0][dt] = *(const u32x4*)(vp_ + (size_t)(16 * dt) * 4096); } while (0)
#define ATT_ONE(ST, QF, KB, VB, roff, rowok) do { f32x4 sc[2]; \
        const LAS float* bp_ = rpl + ((rowok) ? (roff) : 15) * 64; \
        _Pragma("unroll") for (int t = 0; t < 2; ++t) _Pragma("unroll") for (int j = 0; j < 4; ++j) sc[t][j] = (bp_[4 * t + j] + madd[t][j]) - ST.m;     \
        _Pragma("unroll") for (int t = 0; t < 2; ++t) { sc[t] = MFMA16(KB[t][0], QF[0], sc[t]); sc[t] = MFMA16(KB[t][1], QF[1], sc[t]); } \
        attn_tail<2>(ST, sc, VB); } while (0)
#define ATT_COMPUTE(KB, VB, i) do { const int roffA_ = min(rsA + (i) - r + 7, 14); \
        ATT_ONE(SA, qA, KB, VB, roffA_, (i) <= 7); \
        ATT_ONE(SB, qB, KB, VB, max(roffA_ - 1, 0), (i) >= dB && (i) <= 7 + dB); } while (0)
        ATT_LOADW(K0, V0, 0);
#pragma unroll 1
        for (int i = 0; i < 8; i += 2) { ATT_LOADW(K1, V1, i + 1); ATT_COMPUTE(K0, V0, i); ATT_LOADW(K0, V0, i + 2); ATT_COMPUTE(K1, V1, i + 1); }
        ATT_COMPUTE(K0, V0, 8);
#undef ATT_LOADW
#undef ATT_ONE
#undef ATT_COMPUTE
    }
    { const LAS bf16* ck = (const LAS bf16*)(lds + ALDS_CK) + l15 * ACK_STRIDE + 8 * g;
      const LAS bf16* cv = (const LAS bf16*)(lds + ALDS_CV) + l15 * ACV_STRIDE + 8 * g;
#pragma unroll 1
      for (int c = 0; c < 4; ++c) {
          bf16x8 kf[4][2]; u32x4 vw[2][4];
#pragma unroll
          for (int t = 0; t < 4; ++t) { const LAS bf16* kp = ck + (64 * c + 16 * t) * ACK_STRIDE; kf[t][0] = *(const LAS bf16x8*)kp; kf[t][1] = *(const LAS bf16x8*)(kp + 32); }
#pragma unroll
          for (int ks = 0; ks < 2; ++ks)
#pragma unroll
              for (int dt = 0; dt < 4; ++dt) vw[ks][dt] = *(const LAS u32x4*)(cv + (16 * dt) * ACV_STRIDE + 64 * c + 32 * ks);
          { f32x4 sc[4]; const float nm = -SA.m; const f32x4 c0 = {nm, nm, nm, nm};
#pragma unroll
            for (int t = 0; t < 4; ++t) { sc[t] = MFMA16(kf[t][0], qA[0], c0); sc[t] = MFMA16(kf[t][1], qA[1], sc[t]); }
            attn_tail<4>(SA, sc, vw); }
          { f32x4 sc[4]; const float nm = -SB.m; const f32x4 c0 = {nm, nm, nm, nm};
#pragma unroll
            for (int t = 0; t < 4; ++t) { sc[t] = MFMA16(kf[t][0], qB[0], c0); sc[t] = MFMA16(kf[t][1], qB[1], sc[t]); }
            attn_tail<4>(SB, sc, vw); }
      } }
    { const float inv = 1.0f / xrow16_sum(SA.sum);
#pragma unroll
      for (int dt = 0; dt < 4; ++dt) st_bf4(ATT + (size_t)(rowqA + l15) * 1024 + h * 64 + 16 * dt + 4 * g, SA.o[dt] * inv); }
    { const float inv = 1.0f / xrow16_sum(SB.sum);
#pragma unroll
      for (int dt = 0; dt < 4; ++dt) st_bf4(ATT + (size_t)(rowqB + l15) * 1024 + h * 64 + 16 * dt + 4 * g, SB.o[dt] * inv); }
}
__device__ __forceinline__ void p_attn_mfma(const Params& P, Frame& F, int l, bool with_ctx_queries) {
    const bf16* KQ = WSP(bf16, WS_KQ); const bf16* VT = WSP(bf16, WS_VT); bf16* ATT = WSP(bf16, WS_ATT);
    const float* rpb = P.rpb + (size_t)l * 16 * 465;
    for (int hp = F.bid; hp < 256; hp += F.G) {
        const int p = hp & 127, half = hp >> 7, b = p >> 4, h = p & 15;
        __syncthreads();
        { LAS bf16* ck = (LAS bf16*)(F.lds + ALDS_CK); LAS bf16* cv = (LAS bf16*)(F.lds + ALDS_CV); LAS float* rp = (LAS float*)(F.lds + ALDS_RP);
          { const int key = F.tid >> 1, hf = F.tid & 1; const int k32 = key & 31, pos = (key & ~31) + ((k32 >> 2) & 1) * 16 + 4 * (k32 >> 3) + (k32 & 3);
            const u32x4* src = (const u32x4*)(KQ + (size_t)(RL + b * CTXL + key) * 2048 + h * 64 + hf * 32); LAS u32x4* dst = (LAS u32x4*)(ck + pos * ACK_STRIDE + hf * 32);
#pragma unroll
            for (int i = 0; i < 4; ++i) dst[i] = src[i]; }
          { const int d = F.tid >> 3, sg = F.tid & 7; const u32x4* src = (const u32x4*)(VT + YT_CTX_OFF + (size_t)(b * 1024 + h * 64 + d) * 256 + sg * 32); LAS u32x4* dst = (LAS u32x4*)(cv + d * ACV_STRIDE + sg * 32);
#pragma unroll
            for (int i = 0; i < 4; ++i) dst[i] = src[i]; }
          for (int i = F.tid; i < 16 * 64; i += NTHREADS) { const int rr = i >> 6, cc = (i & 63) - 16; rp[i] = rr == 15 ? -__builtin_inff() : ((cc >= 0 && cc < 31) ? rpb[h * 465 + rr * 31 + cc] * LOG2E : 0.f); } }
        __syncthreads();
        const int qt = F.wave & 3, rpi = F.wave >> 2;
#pragma unroll 1
        for (int st = 0; st < 8; ++st) { const int r = half * 32 + st * 4 + rpi * 2; const int rowqA = b * SEQ + r * 64 + 16 * qt;
            attn_unit2(KQ, VT, ATT, F.lds, b, h, rowqA, rowqA + 64, true, r, qt, F.lane); }
        if (with_ctx_queries && half == 0) { const int rowqA = RL + b * CTXL + 32 * F.wave; attn_unit2(KQ, VT, ATT, F.lds, b, h, rowqA, rowqA + 16, false, 0, 0, F.lane); }
    }
    __syncthreads();
}

__device__ __forceinline__ void ld8(const bf16* p, float (&x)[8]) { const u32x4 w = *(const u32x4*)p;
#pragma unroll
    for (int q = 0; q < 4; ++q) { x[2 * q] = bflo(w[q]); x[2 * q + 1] = bfhi(w[q]); } }
__device__ __forceinline__ void p_pool(Frame& F, int nrows) {
    const bf16* PB = WSP(bf16, WS_PB); bf16* POOL = WSP(bf16, WS_POOL);
    for (int i = F.bid * NTHREADS + F.tid; i < (nrows >> 4) * 64; i += F.G * NTHREADS) {
        const int row0 = (i >> 6) << 4, ch = i & 63, g = ch >> 4, hw = 1 << g;
        int base, t0, Lb; if (row0 < RL) { base = row0 & ~4095; t0 = row0 & 4095; Lb = SEQ; } else { const int rr = row0 - RL; base = RL + (rr & ~255); t0 = rr & 255; Lb = CTXL; }
        const bf16* src = PB + (size_t)base * 512 + ch * 8;
        float S[8];
#pragma unroll
        for (int q = 0; q < 8; ++q) S[q] = 0.f;
#pragma unroll 4
        for (int d = -8; d < 8; ++d) { const int tt = t0 + d; if (d >= -hw && d < hw && tt >= 0 && tt < Lb) { float x[8]; ld8(src + (size_t)tt * 512, x);
#pragma unroll
                for (int q = 0; q < 8; ++q) S[q] += x[q]; } }
#pragma unroll 2
        for (int j = 0; j < 16; ++j) { const int t = t0 + j; const int lo = max(t - hw, 0), hi = min(t + hw, Lb); const float inv = 1.0f / (float)(hi - lo);
            float me[8]; ld8(src + (size_t)t * 512, me);
            u32x4 o;
#pragma unroll
            for (int q = 0; q < 4; ++q) o[q] = pk2(S[2 * q] * inv - me[2 * q], S[2 * q + 1] * inv - me[2 * q + 1]);
            *(u32x4*)(POOL + (size_t)(base + t) * 512 + ch * 8) = o;
            if (t + hw < Lb) { float x[8]; ld8(src + (size_t)(t + hw) * 512, x);
#pragma unroll
                for (int q = 0; q < 8; ++q) S[q] += x[q]; }
            if (t - hw >= 0) { float x[8]; ld8(src + (size_t)(t - hw) * 512, x);
#pragma unroll
                for (int q = 0; q < 8; ++q) S[q] -= x[q]; } }
    }
}

__device__ __forceinline__ int block_sum_i(int v, LAS int* sm, int tid) {
    v = wave_sum_i(v);
    __syncthreads();
    if ((tid & 63) == 0) sm[tid >> 6] = v;
    __syncthreads();
    int s = 0;
#pragma unroll
    for (int i = 0; i < 8; ++i) s += sm[i];
    return s;
}
__device__ __forceinline__ int block_excl_scan(int v, LAS int* sm, int tid, int& total) {
    const int lane = tid & 63, w = tid >> 6; int inc = v;
#pragma unroll
    for (int o = 1; o < 64; o <<= 1) { const int t = __builtin_amdgcn_ds_bpermute(((lane - o) & 63) << 2, inc); if (lane >= o) inc += t; }
    __syncthreads();
    if (lane == 63) sm[w] = inc;
    __syncthreads();
    int base = 0; total = 0;
#pragma unroll
    for (int i = 0; i < 8; ++i) { const int s = sm[i]; if (i < w) base += s; total += s; }
    return base + inc - v;
}
template <int NPT>
__device__ __forceinline__ void topk_pair(Frame& F, int row0, int n, int cap, int e, int slot0) {
    LAS int* sm = (LAS int*)F.lds;
    const float* AFF = WSP(float, WS_AFF); int* SROW = WSP(int, WS_SROW); float* SG = WSP(float, WS_SGATE); int* SEL = WSP(int, WS_SEL);
    unsigned key[NPT];
#pragma unroll
    for (int j = 0; j < NPT; ++j) { const int i = F.tid * NPT + j; key[j] = (i < n) ? __float_as_uint(AFF[(size_t)(row0 + i) * 16 + e]) : 0u; }
    unsigned T = 0u;
    for (int bit = 30; bit >= 0; --bit) { const unsigned cand = T | (1u << bit); int cnt = 0;
#pragma unroll
        for (int j = 0; j < NPT; ++j) cnt += (key[j] >= cand) ? 1 : 0;
        cnt = block_sum_i(cnt, sm, F.tid);
        if (cnt >= cap) T = cand; }
    int ngt = 0, neq = 0;
#pragma unroll
    for (int j = 0; j < NPT; ++j) { ngt += (key[j] > T) ? 1 : 0; neq += (key[j] == T) ? 1 : 0; }
    int tot_gt, tot_eq;
    (void)block_excl_scan(ngt, sm, F.tid, tot_gt);
    int eqr = block_excl_scan(neq, sm, F.tid, tot_eq);
    const int need_eq = cap - tot_gt;
    int nsel = 0; bool selj[NPT];
#pragma unroll
    for (int j = 0; j < NPT; ++j) { bool s = key[j] > T; if (key[j] == T && T != 0u) { s = eqr < need_eq; ++eqr; } selj[j] = s; nsel += s ? 1 : 0; }
    int tot_sel; int pos = block_excl_scan(nsel, sm, F.tid, tot_sel);
#pragma unroll
    for (int j = 0; j < NPT; ++j) { const int i = F.tid * NPT + j;
        if (i < n) { const int row = row0 + i;
            if (selj[j]) { const int slot = slot0 + pos; ++pos; SROW[slot] = row; SG[slot] = __uint_as_float(key[j]); SEL[(size_t)row * 16 + e] = slot; }
            else SEL[(size_t)row * 16 + e] = -1; } }
    __syncthreads();
}
__device__ __forceinline__ void p_topk(Frame& F, bool with_ctx) {
    const int npairs = 128 + (with_ctx ? 128 : 0);
    for (int pi = F.bid; pi < npairs; pi += F.G) {
        if (pi < 128) { const int b = pi >> 4, e = pi & 15; topk_pair<8>(F, b * SEQ, SEQ, CAPL, e, e * SLOT_E + b * CAPL); }
        else { const int p2 = pi - 128, b = p2 >> 4, e = p2 & 15; topk_pair<1>(F, RL + b * CTXL, CTXL, CAPC, e, e * SLOT_E + 4096 + b * CAPC); }
    }
}
template <int PH> __global__ void __launch_bounds__(NTHREADS, 2) fwd_kernel(Params P) {
    extern __shared__ __attribute__((aligned(16))) unsigned char lds_raw[];
    Frame F; F.lds = (LAS unsigned char*)lds_raw; F.tid = threadIdx.x; F.lane = F.tid & 63; F.wave = __builtin_amdgcn_readfirstlane(F.tid >> 6); F.G = gridDim.x; F.bid = blockIdx.x; F.ws = P.ws;
    const int wave0 = __builtin_amdgcn_readfirstlane((int)threadIdx.x >> 6);
    volatile LAS unsigned* MISC = (volatile LAS unsigned*)(F.lds + LDS_MISC);
    if (F.tid < 64) MISC[F.tid] = 0u;
    __syncthreads();
    XcdBarrier bar; bar.bar = WSP(unsigned, WS_CTL) + CW_BAR; bar.x = 0; bar.st = MISC + 8;
    if constexpr (PH < 0) bar = xcd_barrier_post(WSP(unsigned, WS_CTL) + CW_BAR, MISC + 8);
#define IN(k) (PH < 0 || PH == (k))
#define REFRESH() do { unsigned on_ = ~0u; asm volatile("" : "+s"(on_)); int t_ = wave0 * 64 + (int)__builtin_amdgcn_mbcnt_hi(on_, __builtin_amdgcn_mbcnt_lo(on_, 0u)); asm volatile("" : "+v"(t_)); F.tid = t_; F.lane = t_ & 63; F.wave = __builtin_amdgcn_readfirstlane(t_ >> 6); } while (0)
#define SEAM(k) do { if constexpr (PH < 0) xcd_barrier(bar); } while (0)

    if (IN(0)) { REP_BEGIN(100) p_mod(P, F); p_dftgen(F); REP_END REP_BEGIN(101) p_wconv(P, F, 0); REP_END }
    SEAM(0);
    if (IN(1)) { p_rowpass_a0(P, F); }
    SEAM(1);
    for (int l = P.l_lo; l < P.l_hi; ++l) {
        constexpr int pb = 2; const bool L0 = (l == 0);
        bf16* H = WSP(bf16, WS_H);
        if (IN(pb + 0)) { REFRESH(); REP_BEGIN(2)
            { GroupSched S; S.init(1, 128, 22, F.G, F.bid, 8, L0 ? 22 : 4, 128, 0);
              const bf16* WA = WSP(bf16, WS_WA);
              auto AD = [=](const Unit& u) { return Operands{H + (size_t)u.pm * 256 * DM, WA + (size_t)u.pn * 256 * DM, DM, DM, 0, DM}; };
              bf16* KQ = WSP(bf16, WS_KQ); bf16* PBp = WSP(bf16, WS_PB); bf16* GB = WSP(bf16, WS_GB);
              auto E = [=](EPI_ARGS) { const int row0 = u.pm * 256;
                  if (u.pn < 8) { const float qs = (u.pn >= 4) ? QSCALE : 1.0f; EPI_FOR8( st_bf8(KQ + (size_t)(row0 + r) * 2048 + u.pn * 256 + c, v0 * qs, v1 * qs); ) }
                  else if (u.pn < 10) { EPI_FOR8( st_bf8(PBp + (size_t)(row0 + r) * 512 + (u.pn - 8) * 256 + c, v0, v1); ) }
                  else { EPI_FOR8( f32x4 s0; f32x4 s1; _Pragma("unroll") for (int j = 0; j < 4; ++j) { s0[j] = sigmoidf_(v0[j]); s1[j] = sigmoidf_(v1[j]); } st_bf8(GB + (size_t)(row0 + r) * 3072 + (u.pn - 10) * 256 + c, s0, s1); ) } };
              GEMM_P(S, AD, E); }
            REFRESH();
            { GroupSched S; const int g1a_units = 128 * 22 + 8 * (L0 ? 22 : 4);
              S.init(1, 8, 128, F.G, (F.bid + F.G - ((g1a_units % F.G) & ~7)) % F.G, L0 ? 8 : 4, 8, L0 ? 0 : 4, 128);
              const bf16* WFV = WSP(bf16, WS_WFV);
              auto AD = [=](const Unit& u) { const bool fmap = (u.pm < 4) && (u.pn < 128); const int t16 = u.pn & 15;
                  const size_t tok0 = fmap ? (size_t)(u.pn >> 4) * SEQ + 64 * ((t16 >> 1) * 8) + (t16 & 1) * 32 : (size_t)u.pn * 256;
                  return Operands{WFV + (size_t)u.pm * 256 * DM, H + tok0 * DM, DM, DM, 0, DM, fmap ? 1 : 0}; };
              bf16* YT = WSP(bf16, WS_YT); bf16* VT = WSP(bf16, WS_VT);
              auto E = [=](EPI_ARGS) { bf16* T = (u.pm < 4) ? YT : VT; const int rr0 = (u.pm & 3) * 256;
                  if (u.pn < 128) { const int b = u.pn >> 4;
                      if (u.pm < 4) { const int t16 = u.pn & 15, l10 = (t16 >> 1) * 8, l20 = (t16 & 1) * 32;
                          EPI_FOR8( const int fc = rr0 + r; st_bf8(T + (((((size_t)b * 512 + (fc >> 1)) * 32 + (c >> 3)) * 2 + (l20 >> 5)) * 2 + (fc & 1)) * 64 + l10, v0, v1); ) }
                      else { const int l0 = (u.pn & 15) * 256; EPI_FOR8( st_bf8(T + ((size_t)b * 1024 + rr0 + r) * 4096 + l0 + c, v0, v1); ) } }
                  else { const int b = u.pn - 128; EPI_FOR8( st_bf8(T + YT_CTX_OFF + ((size_t)b * 1024 + rr0 + r) * 256 + c, v0, v1); ) } };
              GEMM_P(S, AD, E); }
        REP_END }
        SEAM(pb + 0);
        if (IN(pb + 1)) { REFRESH();
            REP_BEGIN(31) p_attn_mfma(P, F, l, L0); REP_END
            REFRESH();
            REP_BEGIN(32)
            { LAS float* tw = (LAS float*)(F.lds + LDS_TW);
              for (int j = F.tid; j < 4096; j += NTHREADS) tw[j] = cospif((float)j * (1.0f / 2048.0f));
              __syncthreads();
              GroupSched S; S.init(1, 1, 512, F.G, F.bid);
              const bf16* M1 = WSP(bf16, WS_M1T); const bf16* YF = WSP(bf16, WS_YT); bf16* ZP = WSP(bf16, WS_ZP);
              auto AD = [=](const Unit& u) { return Operands{M1, YF + (size_t)u.pn * 256 * 256, 256, 256, 0, 256}; };
              auto E = [=](EPI_ARGS) {
                  const int b = u.pn >> 6, gm0 = (u.pn & 63) * 8 + wc, l20 = 32 * wr + 8 * fq;
#pragma unroll
                  for (int m = 0; m < 4; ++m) { const int k1 = 16 * m + fr;
#pragma unroll
                      for (int bj = 0; bj < 2; ++bj) { const int gm = gm0 + 4 * bj;
                          f32x4 zr[2], zi[2];
#pragma unroll
                          for (int n = 0; n < 2; ++n)
#pragma unroll
                              for (int j = 0; j < 4; ++j) { const int ix = k1 * (l20 + 4 * n + j); const float tc = tw[ix], ts = tw[(ix + 3072) & 4095];
                                  const float ur = acc[0][bj][m][n][j], ui = acc[1][bj][m][n][j]; zr[n][j] = ur * tc - ui * ts; zi[n][j] = ur * ts + ui * tc; }
                          bf16* dst = ZP + (((((size_t)b * 64 + k1) * 128 + (gm & 127)) * 4 + (gm >> 7)) * 2) * 64 + l20;
                          st_bf8(dst, zr[0], zr[1]); st_bf8(dst + 64, zi[0], zi[1]); } } };
              GEMM_P(S, AD, E); }
            REP_END
        }
        SEAM(pb + 1);
        if (IN(pb + 10)) { REFRESH();
            { GroupSched S; S.init(1, 1, 256, F.G, F.bid);
              const bf16* M2 = WSP(bf16, WS_M2T); const bf16* ZP = WSP(bf16, WS_ZP); bf16* FOUR = WSP(bf16, WS_FOUR);
              auto AD = [=](const Unit& u) { return Operands{M2, ZP + (size_t)u.pn * 256 * 512, 512, 512, 0, 512}; };
              auto E = [=](EPI_ARGS) { const float sc = 0.0013810679320049757f;
#pragma unroll
                  for (int ai = 0; ai < 2; ++ai)
#pragma unroll
                      for (int m = 0; m < 4; ++m) { const int q = 2 * ai + wr, k2 = 16 * m + fr;
#pragma unroll
                          for (int bj = 0; bj < 2; ++bj) { const int bk = u.pn * 2 + bj, b = bk >> 6, k1 = bk & 63;
                              st_bf8(FOUR + ((size_t)b * SEQ + k1 + 64 * k2) * 512 + q * 128 + wc * 32 + 8 * fq, acc[ai][bj][m][0] * sc, acc[ai][bj][m][1] * sc); } } };
              GEMM_P(S, AD, E); }
            REFRESH();
            if (L0) { GroupSched S; S.init(1, 1, 16, F.G, (F.bid + F.G - 128 % F.G) % F.G);
              const bf16* DFTC = WSP(bf16, WS_DFTC); const bf16* YTC = WSP(bf16, WS_YT) + YT_CTX_OFF; bf16* FOUR = WSP(bf16, WS_FOUR);
              auto AD = [=](const Unit& u) { return Operands{DFTC, YTC + (size_t)u.pn * 256 * 512, 512, 512, 0, 512}; };
              auto E = [=](EPI_ARGS) { const int b = u.pn >> 1, c0 = (u.pn & 1) * 256; const float sc = 0.005524271728019903f;
                  EPI_FOR8( st_bf8(FOUR + ((size_t)RL + b * CTXL + r) * 512 + c0 + c, v0 * sc, v1 * sc); ) };
              GEMM_P(S, AD, E); }
            REFRESH();
            REP_BEGIN(33) p_pool(F, L0 ? RT : RL); REP_END
        }
        SEAM(pb + 10);
        if (IN(pb + 2)) { REFRESH();
            SegSched<3> S; S.base.init(1, L0 ? 136 : 128, 4, F.G, F.bid);
            const bf16* ATT = WSP(bf16, WS_ATT); const bf16* FOUR = WSP(bf16, WS_FOUR); const bf16* POOL = WSP(bf16, WS_POOL);
            const bf16* WAO = WSP(bf16, WS_WAO); const bf16* WFO = WSP(bf16, WS_WFO); const bf16* WPO = WSP(bf16, WS_WPO);
            const bf16* GB = WSP(bf16, WS_GB); bf16* MRGB = WSP(bf16, WS_MRGB); const float* ps = P.pool_scale + l * 1024;
            auto AD = [=](const Unit& u) {
                if (u.seg == 0) return Operands{ATT + (size_t)u.pm * 256 * 1024, WAO + (size_t)u.pn * 256 * 1024, 1024, 1024, 0, 1024};
                if (u.seg == 1) return Operands{FOUR + (size_t)u.pm * 256 * 512, WFO + (size_t)u.pn * 256 * 512, 512, 512, 0, 512};
                return Operands{POOL + (size_t)u.pm * 256 * 512 + (u.pn >> 1) * 256, WPO + (size_t)u.pn * 256 * 256, 512, 256, 0, 256}; };
            auto E = [=](EPI_ARGS) {
                const int kd = u.seg < 2 ? u.seg + 1 : 2; const bool fin = (u.seg == 2); const int colb = u.pn * 256 + wc * 32 + 8 * fq;
#pragma unroll
                for (int ai = 0; ai < 2; ++ai)
#pragma unroll
                    for (int m = 0; m < 4; ++m) { const size_t row = (size_t)u.pm * 256 + ai * 128 + wr * 64 + m * 16 + fr; const bf16* gr = GB + row * 3072 + colb;
                        u32x4 nr[2], dr[2]; f32x4 psv[2][2];
#pragma unroll
                        for (int bj = 0; bj < 2; ++bj) { nr[bj] = *(const u32x4*)(gr + u.seg * 1024 + bj * 128); dr[bj] = *(const u32x4*)(gr + kd * 1024 + bj * 128);
                            psv[bj][0] = *(const f32x4*)(ps + colb + bj * 128); psv[bj][1] = *(const f32x4*)(ps + colb + bj * 128 + 4); }
#pragma unroll
                        for (int bj = 0; bj < 2; ++bj) { f32x4 o[2];
#pragma unroll
                            for (int n = 0; n < 2; ++n) { f32x4 nu = {bflo(nr[bj][2 * n]), bfhi(nr[bj][2 * n]), bflo(nr[bj][2 * n + 1]), bfhi(nr[bj][2 * n + 1])}, de = {bflo(dr[bj][2 * n]), bfhi(dr[bj][2 * n]), bflo(dr[bj][2 * n + 1]), bfhi(dr[bj][2 * n + 1])};
                                if (u.seg == 2) nu = nu * psv[bj][n];
                                de = de * psv[bj][n];
#pragma unroll
                                for (int j = 0; j < 4; ++j) { const float nj = (fabsf(nu[j]) < 1e-30f) ? copysignf(1e-30f, nu[j]) : nu[j]; const float dj = (fabsf(de[j]) < 1e-30f) ? copysignf(1e-30f, de[j]) : de[j];
                                    o[n][j] = acc[ai][bj][m][n][j] * nj * (fin ? 1.0f : __builtin_amdgcn_rcpf(dj)); }
                                acc[ai][bj][m][n] = o[n]; }
                            if (fin) st_bf8(MRGB + row * 1024 + colb + bj * 128, o[0], o[1]); } } };
            gemm_fast<false, true, false>(F.lds, F.tid, S, AD, mk_epi_seg(E, 2), nullptr);
        }
        SEAM(pb + 2);
        if (IN(pb + 3)) { REFRESH();
            GroupSched S; S.init(1, L0 ? 136 : 128, 4, F.G, F.bid); const bf16* A = WSP(bf16, WS_MRGB); const bf16* W = WSP(bf16, WS_WOUT);
            const float* xin = L0 ? P.x : P.out; const float* cin = L0 ? P.ctx : WSP(float, WS_XC); float* xo = P.out; float* co = WSP(float, WS_XC);
            const float* MOD = WSP(float, WS_MOD) + (size_t)l * 9 * 6144;
            auto AD = [=](const Unit& u) { return Operands{A + (size_t)u.pm * 256 * 1024, W + (size_t)u.pn * 256 * 1024, 1024, 1024, 0, 1024}; };
            auto E = [=](EPI_ARGS) {
                const int row0 = u.pm * 256, mr = row0 < RL ? (row0 >> 12) : 8, colb = u.pn * 256 + wc * 32 + 4 * fq;
                const float* src0 = row0 < RL ? xin + (size_t)row0 * DM : cin + (size_t)(row0 - RL) * DM; float* dst0 = row0 < RL ? xo + (size_t)row0 * DM : co + (size_t)(row0 - RL) * DM;
                f32x4 gv[2][2];
#pragma unroll
                for (int bj = 0; bj < 2; ++bj)
#pragma unroll
                    for (int n = 0; n < 2; ++n) gv[bj][n] = *(const f32x4*)(MOD + (size_t)mr * 6144 + 2048 + colb + bj * 128 + n * 16);
#pragma unroll
                for (int ai = 0; ai < 2; ++ai) { f32x4 xv[4][2][2];
#pragma unroll
                    for (int m = 0; m < 4; ++m) { const size_t ro = (size_t)(ai * 128 + wr * 64 + m * 16 + fr) * DM + colb;
#pragma unroll
                        for (int bj = 0; bj < 2; ++bj)
#pragma unroll
                            for (int n = 0; n < 2; ++n) xv[m][bj][n] = *(const f32x4*)(src0 + ro + bj * 128 + n * 16); }
#pragma unroll
                    for (int m = 0; m < 4; ++m) { const size_t ro = (size_t)(ai * 128 + wr * 64 + m * 16 + fr) * DM + colb;
#pragma unroll
                        for (int bj = 0; bj < 2; ++bj)
#pragma unroll
                            for (int n = 0; n < 2; ++n) *(f32x4*)(dst0 + ro + bj * 128 + n * 16) = xv[m][bj][n] + gv[bj][n] * acc[ai][bj][m][n]; } } };
            GEMM(S, AD, E, 1024, 1024, 1024);
        }
        SEAM(pb + 3);
        if (IN(pb + 4)) { REFRESH(); REP_BEGIN(6) p_rowpass_f(P, F, l, L0 ? RT : RL); REP_END }
        SEAM(pb + 4);
        if (IN(pb + 5)) { REFRESH(); REP_BEGIN(7) p_topk(F, L0); REP_END }
        SEAM(pb + 5);
        if (IN(pb + 7)) { REFRESH(); REP_BEGIN(9)
            GroupSched S; S.init(16, L0 ? 17 : 16, 22, F.G, F.bid); const bf16* H8 = WSP(bf16, WS_H8); const bf16* W = WSP(bf16, WS_WGU); unsigned char* HID = WSP(unsigned char, WS_HID); const int* SROW = WSP(int, WS_SROW);
            auto AD = [=](const Unit& u) { return Operands{H8, W + ((size_t)u.grp * 5632 + u.pn * 256) * 512, 512, 512, u.grp * SLOT_E + u.pm * 256, 512}; };
            auto E = [=](EPI_ARGS) {
#pragma unroll
                for (int ai = 0; ai < 2; ++ai)
#pragma unroll
                    for (int m = 0; m < 4; ++m) { const size_t slot = (size_t)u.grp * SLOT_E + u.pm * 256 + ai * 128 + wr * 64 + m * 16 + fr; f32x4 o[2];
#pragma unroll
                        for (int n = 0; n < 2; ++n) { const f32x4 a = acc[ai][0][m][n] * INV8, up = acc[ai][1][m][n] * (INV8 * A8S);
#pragma unroll
                            for (int j = 0; j < 4; ++j) o[n][j] = a[j] * sigmoidf_(a[j]) * up[j]; }
                        u32x2 w; w.x = pk4_fp8(o[0][0], o[0][1], o[0][2], o[0][3]); w.y = pk4_fp8(o[1][0], o[1][1], o[1][2], o[1][3]);
                        *(u32x2*)(HID + slot * FF + u.pn * 128 + wc * 32 + 8 * fq) = w; } };
            GEMM_GATHER8(S, AD, E, SROW);
        REP_END }
        SEAM(pb + 7);
        if (IN(pb + 8)) { REFRESH(); REP_BEGIN(10)
            const int tpe = L0 ? 17 : 16;
            GroupSched S; S.init(1, 16 * tpe, 4, F.G, F.bid); const bf16* HID = WSP(bf16, WS_HID); const bf16* W = WSP(bf16, WS_WD); bf16* Y = WSP(bf16, WS_Y); const float* SG = WSP(float, WS_SGATE);
            auto AD = [=](const Unit& u) { const int e = u.pm / tpe, st = e * 17 + (u.pm - e * tpe); return Operands{HID + (size_t)st * 256 * (FF / 2), W + ((size_t)e * 1024 + u.pn * 256) * (FF / 2), FF / 2, FF / 2, 0, FF / 2}; };
            auto E = [=](EPI_ARGS) { const int e = u.pm / tpe; const size_t slot0 = (size_t)(e * 17 + (u.pm - e * tpe)) * 256 + wr * 64 + fr; float gt[2][4];
#pragma unroll
                for (int ai = 0; ai < 2; ++ai)
#pragma unroll
                    for (int m = 0; m < 4; ++m) gt[ai][m] = SG[slot0 + ai * 128 + m * 16] * INV8;
#pragma unroll
                for (int ai = 0; ai < 2; ++ai)
#pragma unroll
                    for (int m = 0; m < 4; ++m)
#pragma unroll
                        for (int bj = 0; bj < 2; ++bj) st_bf8(Y + (slot0 + ai * 128 + m * 16) * DM + u.pn * 256 + bj * 128 + wc * 32 + 8 * fq, acc[ai][bj][m][0] * gt[ai][m], acc[ai][bj][m][1] * gt[ai][m]); };
            GEMM_P8(S, AD, E);
        REP_END }
        SEAM(pb + 8);
        if (IN(pb + 9)) { REFRESH(); p_rowpass_k(P, F, l, L0 ? RT : RL); if (L0) p_wconv(P, F, 1); }
        if (L0) SEAM(pb + 9);
    }
#undef IN
#undef SEAM
}
template <int PH> static void launch_ph(int grid, const Params& p, hipStream_t stream) { hipLaunchKernelGGL(fwd_kernel<PH>, dim3(grid), dim3(NTHREADS), LDS_BYTES, stream, p); }
template <int PH> static bool set_attr() { return hipFuncSetAttribute((const void*)fwd_kernel<PH>, hipFuncAttributeMaxDynamicSharedMemorySize, LDS_BYTES) == hipSuccess; }

#ifndef DUP_LAUNCH
#define DUP_LAUNCH -1
#endif
extern "C" void kernel_launch(void* const* d_in, const int* in_sizes, int n_in, void* d_out, int out_size, void* d_ws, size_t ws_size, hipStream_t stream) {
    static int grid = 0;
    if (grid == 0) {
        if (n_in != 20 || out_size != RL * DM || ws_size < WS_END) { fprintf(stderr, "kernel_launch: unexpected shapes (n_in %d out %d ws %zu need %zu)\n", n_in, out_size, ws_size, (size_t)WS_END); grid = -1; return; }
        int dev = 0, cus = 0, per_cu = 0;
        if (hipGetDevice(&dev) != hipSuccess || hipDeviceGetAttribute(&cus, hipDeviceAttributeMultiprocessorCount, dev) != hipSuccess) { grid = -1; return; }
#if N_LAUNCH_MODE == 1
        if (!set_attr<-1>()) { fprintf(stderr, "kernel_launch: hipFuncSetAttribute failed\n"); grid = -1; return; }
        if (hipOccupancyMaxActiveBlocksPerMultiprocessor(&per_cu, (const void*)fwd_kernel<-1>, NTHREADS, LDS_BYTES) != hipSuccess || per_cu < 1) fprintf(stderr, "kernel_launch: occupancy query reports %d\n", per_cu);
#else
        if (!(set_attr<0>() && set_attr<1>() && set_attr<2>() && set_attr<3>() && set_attr<12>() && set_attr<4>() && set_attr<5>() && set_attr<6>() && set_attr<7>() && set_attr<9>() && set_attr<10>() && set_attr<11>())) { fprintf(stderr, "kernel_launch: hipFuncSetAttribute failed\n"); grid = -1; return; }
        (void)per_cu;
#endif
        (void)hipGetLastError();
        grid = cus;
    }
    if (grid < 0) return;
    if (hipMemsetAsync((char*)d_ws + WS_CTL, 0, CTL_BYTES, stream) != hipSuccess) return;
    Params p{};
    const float** pp = (const float**)&p;
    for (int i = 0; i < 20; ++i) pp[i] = (const float*)d_in[i];
    p.out = (float*)d_out; p.ws = (unsigned char*)d_ws;
#if N_LAUNCH_MODE == 1
    p.l_lo = 0; p.l_hi = 2;
    launch_ph<-1>(grid, p, stream);
#else
    p.l_lo = 0; p.l_hi = 0; launch_ph<0>(grid, p, stream); if (DUP_LAUNCH == 0) launch_ph<0>(grid, p, stream); launch_ph<1>(grid, p, stream); if (DUP_LAUNCH == 1) launch_ph<1>(grid, p, stream);
#define LP(k) do { launch_ph<k>(grid, p, stream); if (DUP_LAUNCH == (k) && l == 0) launch_ph<k>(grid, p, stream); } while (0)
    for (int l = 0; l < 2; ++l) { p.l_lo = l; p.l_hi = l + 1;
        LP(2); LP(3); LP(12); LP(4); LP(5); LP(6); LP(7); LP(9); LP(10); LP(11); }
#endif
}
```

```cpp
#include <hip/hip_runtime.h>
#include <cstdio>
#include <cstdint>

#ifndef N_LAUNCH_MODE
#define N_LAUNCH_MODE 1
#endif

#define GAS __attribute__((address_space(1)))
#define LAS __attribute__((address_space(3)))
typedef unsigned short bf16;
typedef short bf16x8 __attribute__((ext_vector_type(8)));
typedef float f32x4 __attribute__((ext_vector_type(4)));
typedef unsigned u32x4 __attribute__((ext_vector_type(4)));
typedef unsigned u32x2 __attribute__((ext_vector_type(2)));

constexpr int NB = 8, SEQ = 4096, DM = 1024, CTXL = 256, NH = 16, HD = 64, GRIDW = 64;
constexpr int RL = NB * SEQ, RC = NB * CTXL, RT = RL + RC;
constexpr int INW = 7168, NE = 16, FF = 2816, CAPL = 512, CAPC = 32;
constexpr int SLOT_E = 4352, NSLOT = NE * SLOT_E;
constexpr float RMS_EPS = 1e-6f;
constexpr float LOG2E = 1.4426950408889634f, QSCALE = 0.125f * LOG2E;
constexpr float A8S = 8.0f, W8S = 64.0f, INV8 = 1.0f / (A8S * W8S);
constexpr int NWAVES = 8, NTHREADS = 512;

constexpr size_t al256(size_t x) { return (x + 255) & ~(size_t)255; }
constexpr size_t WS_CTL = 0, CTL_BYTES = 1u << 20;
constexpr size_t WS_MOD = WS_CTL + CTL_BYTES;
constexpr size_t WS_XC = al256(WS_MOD + (size_t)2 * 9 * 6144 * 4);
constexpr size_t WS_AFF = al256(WS_XC + (size_t)RC * DM * 4);
constexpr size_t WS_SROW = al256(WS_AFF + (size_t)RT * 16 * 4);
constexpr size_t WS_SGATE = al256(WS_SROW + (size_t)NSLOT * 4);
constexpr size_t WS_SEL = al256(WS_SGATE + (size_t)NSLOT * 4);
constexpr size_t WS_DFTM = al256(WS_SEL + (size_t)RT * 16 * 4);
constexpr size_t WS_DFTC = al256(WS_DFTM + (size_t)4096 * 8192 * 2);
constexpr size_t WS_WA = al256(WS_DFTC + (size_t)256 * 512 * 2);
constexpr size_t WS_WFV = al256(WS_WA + (size_t)5632 * 1024 * 2);
constexpr size_t WS_WAO = al256(WS_WFV + (size_t)2048 * 1024 * 2);
constexpr size_t WS_WFO = al256(WS_WAO + (size_t)1024 * 1024 * 2);
constexpr size_t WS_WPO = al256(WS_WFO + (size_t)1024 * 512 * 2);
constexpr size_t WS_WOUT = al256(WS_WPO + (size_t)1024 * 256 * 2);
constexpr size_t WS_WGU = al256(WS_WOUT + (size_t)1024 * 1024 * 2);
constexpr size_t WS_WD = al256(WS_WGU + (size_t)16 * 5632 * 1024);
constexpr size_t WS_H = al256(WS_WD + (size_t)16 * 1024 * 2816);
constexpr size_t WS_H8 = al256(WS_H + (size_t)RT * DM * 2);
constexpr size_t WS_R = al256(WS_H8 + (size_t)RT * DM);
constexpr size_t WS_KQ = WS_R;
constexpr size_t WS_MRG = WS_KQ;
constexpr size_t WS_PB = al256(WS_KQ + (size_t)RT * 2048 * 2);
constexpr size_t WS_GB = al256(WS_PB + (size_t)RT * 512 * 2);
constexpr size_t WS_YT = al256(WS_GB + (size_t)RT * 3072 * 2);
constexpr size_t WS_MRGB = WS_YT;
constexpr size_t WS_VT = al256(WS_YT + (size_t)RT * 1024 * 2);
constexpr size_t WS_FOUR = al256(WS_VT + (size_t)RT * 1024 * 2);
constexpr size_t WS_ATT = al256(WS_FOUR + (size_t)RT * 512 * 2);
constexpr size_t WS_POOL = al256(WS_ATT + (size_t)RT * 1024 * 2);
constexpr size_t WS_MIX_END = al256(WS_POOL + (size_t)RT * 512 * 2);
constexpr size_t WS_XG = WS_R;
constexpr size_t WS_HID = al256(WS_XG + (size_t)NSLOT * 1024 * 2);
constexpr size_t WS_Y = al256(WS_HID + (size_t)NSLOT * 2816);
constexpr size_t WS_MOE_END = al256(WS_Y + (size_t)NSLOT * 1024 * 2);
constexpr size_t WS_END0 = WS_MIX_END > WS_MOE_END ? WS_MIX_END : WS_MOE_END;
constexpr size_t WS_ZP = WS_END0;
constexpr size_t WS_M1T = al256(WS_ZP + ((size_t)8 * 64 * 512 * 128 + 1024) * 2);
constexpr size_t WS_M2T = al256(WS_M1T + (size_t)256 * 256 * 2);
constexpr size_t WS_END = al256(WS_M2T + (size_t)256 * 512 * 2);
constexpr size_t YT_CTX_OFF = (size_t)8 * 1024 * 4096;

constexpr int CW_BAR = 4096;

constexpr int LDS_BYTES = 155648;
constexpr int LDS_TW = 132096;
constexpr int LDS_MISC = 131072;

__device__ __forceinline__ unsigned f2bf(float f) { unsigned u = __float_as_uint(f); return (u + 0x7fffu + ((u >> 16) & 1u)) >> 16; }
typedef __bf16 hbf16x2 __attribute__((ext_vector_type(2)));
typedef float f32x2 __attribute__((ext_vector_type(2)));
__device__ __forceinline__ unsigned pk2(float lo, float hi) { const f32x2 v = {lo, hi}; return __builtin_bit_cast(unsigned, __builtin_convertvector(v, hbf16x2)); }
__device__ __forceinline__ unsigned pk4_fp8(float a, float b, float c, float d) {
    a = __builtin_amdgcn_fmed3f(a, -448.f, 448.f); b = __builtin_amdgcn_fmed3f(b, -448.f, 448.f); c = __builtin_amdgcn_fmed3f(c, -448.f, 448.f); d = __builtin_amdgcn_fmed3f(d, -448.f, 448.f);
    int w = 0; w = __builtin_amdgcn_cvt_pk_fp8_f32(a, b, w, false); w = __builtin_amdgcn_cvt_pk_fp8_f32(c, d, w, true); return (unsigned)w; }
__device__ __forceinline__ float bf2f(unsigned b) { return __uint_as_float(b << 16); }
__device__ __forceinline__ float bflo(unsigned w) { return __uint_as_float(w << 16); }
__device__ __forceinline__ float bfhi(unsigned w) { return __uint_as_float(w & 0xffff0000u); }
template <int CTRL> __device__ __forceinline__ float dppf(float x) { return __builtin_bit_cast(float, __builtin_amdgcn_mov_dpp(__builtin_bit_cast(int, x), CTRL, 0xf, 0xf, true)); }
template <int CTRL> __device__ __forceinline__ int dppi(int x) { return __builtin_amdgcn_mov_dpp(x, CTRL, 0xf, 0xf, true); }
constexpr int DPP_XOR1 = 0xB1, DPP_XOR2 = 0x4E, DPP_ROR4 = 0x124, DPP_ROR8 = 0x128;
__device__ __forceinline__ float wave_sum(float v) {
    v += dppf<DPP_XOR1>(v); v += dppf<DPP_XOR2>(v); v += dppf<DPP_ROR4>(v); v += dppf<DPP_ROR8>(v);
    auto s = __builtin_amdgcn_permlane16_swap(__float_as_uint(v), __float_as_uint(v), false, false); v = __uint_as_float(s[0]) + __uint_as_float(s[1]);
    auto t = __builtin_amdgcn_permlane32_swap(__float_as_uint(v), __float_as_uint(v), false, false); return __uint_as_float(t[0]) + __uint_as_float(t[1]);
}
__device__ __forceinline__ float wave_max(float v) {
    v = fmaxf(v, dppf<DPP_XOR1>(v)); v = fmaxf(v, dppf<DPP_XOR2>(v)); v = fmaxf(v, dppf<DPP_ROR4>(v)); v = fmaxf(v, dppf<DPP_ROR8>(v));
    auto s = __builtin_amdgcn_permlane16_swap(__float_as_uint(v), __float_as_uint(v), false, false); v = fmaxf(__uint_as_float(s[0]), __uint_as_float(s[1]));
    auto t = __builtin_amdgcn_permlane32_swap(__float_as_uint(v), __float_as_uint(v), false, false); return fmaxf(__uint_as_float(t[0]), __uint_as_float(t[1]));
}
__device__ __forceinline__ int wave_sum_i(int v) {
    v += dppi<DPP_XOR1>(v); v += dppi<DPP_XOR2>(v); v += dppi<DPP_ROR4>(v); v += dppi<DPP_ROR8>(v);
    auto s = __builtin_amdgcn_permlane16_swap((unsigned)v, (unsigned)v, false, false); v = (int)(s[0] + s[1]);
    auto t = __builtin_amdgcn_permlane32_swap((unsigned)v, (unsigned)v, false, false); return (int)(t[0] + t[1]);
}
__device__ __forceinline__ float sigmoidf_(float x) { return __builtin_amdgcn_rcpf(1.f + __builtin_amdgcn_exp2f(x * -1.4426950408889634f)); }
#define LDS_WAIT() asm volatile("s_waitcnt lgkmcnt(0)" ::: "memory")

#define XB_TMO      128
#define XB_XCNT(j)  (256  + 64 * (j))
#define XB_XSUB(j)  (1280 + 64 * (j))
#define XB_XGEN(j)  (2304 + 64 * (j))
#define XB_TOP      3328
#define XB_TOPGEN   3392
#define XCD_BAR_WORDS 3456
#define XB_SPIN_CAP (1u << 22)

__device__ __forceinline__ unsigned xb_ld(unsigned* p)              { return __hip_atomic_load(p, __ATOMIC_RELAXED, __HIP_MEMORY_SCOPE_AGENT); }
__device__ __forceinline__ unsigned xb_add(unsigned* p, unsigned v) { return __hip_atomic_fetch_add(p, v, __ATOMIC_RELAXED, __HIP_MEMORY_SCOPE_AGENT); }
__device__ __forceinline__ unsigned xb_xcc_id() { return (unsigned)__builtin_amdgcn_s_getreg((3 << 11) | 20) & 0xFu; }
#define XB_SPIN(cond, bar) do { unsigned _sp = 0; while (cond) { __builtin_amdgcn_s_sleep(1); \
    if ((++_sp & 255u) == 0u) { if (xb_ld(&(bar)[XB_TMO])) break; if (_sp > XB_SPIN_CAP) { atomicAdd(&(bar)[XB_TMO], 1u); break; } } } } while (0)

struct XcdBarrier { unsigned* bar; unsigned x; volatile LAS unsigned* st; };

__device__ __forceinline__ XcdBarrier xcd_barrier_post(unsigned* bar, volatile LAS unsigned* st) {
    XcdBarrier b; b.bar = bar; b.x = xb_xcc_id(); b.st = st;
    if (threadIdx.x == 0) (void)xb_add(&bar[XB_XCNT(b.x)], 1u);
    return b;
}
__device__ __forceinline__ void xcd_barrier_complete(unsigned* bar, unsigned x, unsigned& nloc, unsigned& nx) {
    const unsigned G = gridDim.x * gridDim.y * gridDim.z;
    unsigned sum, cnt, mine, sp = 0u;
    for (;;) {
        sum = 0u; cnt = 0u; mine = 0u;
#pragma unroll
        for (unsigned j = 0; j < 16; ++j) { const unsigned c = xb_ld(&bar[XB_XCNT(j)]); sum += c; cnt += (c > 0u) ? 1u : 0u; mine = (j == x) ? c : mine; }
        if (sum == G) break;
        __builtin_amdgcn_s_sleep(1);
        if ((++sp & 255u) == 0u) { if (xb_ld(&bar[XB_TMO])) break; if (sp > XB_SPIN_CAP) { atomicAdd(&bar[XB_TMO], 1u); break; } }
    }
    nloc = mine > 0u ? mine : 1u; nx = cnt > 0u ? cnt : 1u;
}
__device__ __forceinline__ void xcd_barrier(const XcdBarrier& b) {
    asm volatile("s_waitcnt vmcnt(0)" ::: "memory");
    __syncthreads();
    if (threadIdx.x == 0) {
        unsigned* bar = b.bar;
        __builtin_amdgcn_s_waitcnt(0);
        unsigned nloc = b.st[0], nx = b.st[1];
        if (nloc == 0u) { xcd_barrier_complete(bar, b.x, nloc, nx); b.st[0] = nloc; b.st[1] = nx; }
        const unsigned old = xb_add(&bar[XB_XSUB(b.x)], 1u);
        const unsigned gen = old / nloc;
        if (old + 1u == (gen + 1u) * nloc) {
            __builtin_amdgcn_fence(__ATOMIC_RELEASE, "agent");
            asm volatile("s_waitcnt vmcnt(0)" ::: "memory");
            const unsigned og = xb_add(&bar[XB_TOP], 1u);
            const unsigned tg = og / nx;
            if (og + 1u == (tg + 1u) * nx) xb_add(&bar[XB_TOPGEN], 1u);
            else XB_SPIN(xb_ld(&bar[XB_TOPGEN]) == tg, bar);
            __builtin_amdgcn_fence(__ATOMIC_ACQUIRE, "agent");
            xb_add(&bar[XB_XGEN(b.x)], 1u);
            asm volatile("s_waitcnt vmcnt(0)" ::: "memory");
        } else {
            XB_SPIN(xb_ld(&bar[XB_XGEN(b.x)]) == gen, bar);
            __builtin_amdgcn_fence(__ATOMIC_ACQUIRE, "agent");
            asm volatile("s_waitcnt vmcnt(0)" ::: "memory");
        }
    }
    __syncthreads();
}

struct Params {
    const float *x, *c, *ctx, *c_ctx, *ada_w, *ada_b, *norm1_g, *norm2_g, *w_in, *rpb, *w_att_o, *w_fourier, *w_pool, *pool_scale, *w_out, *w_router, *w_eg, *w_eu, *w_ed, *final_g;
    float* out; unsigned char* ws; int l_lo, l_hi;
};
struct Frame {
    LAS unsigned char* lds;
    int tid, lane, wave, G, bid;
    unsigned char* ws;
};
#define WSP(T, off) ((T*)(F.ws + (off)))

struct Unit { int grp, pm, pn, seg; };
struct GroupSched {
    int ng, nM, nN, G, c; int tM, tN, tpm0, tpn0;
    __device__ __forceinline__ void init(int ng_, int nM_, int nN_, int G_, int c_, int tM_ = 0, int tN_ = 0, int tpm0_ = 0, int tpn0_ = 0) { ng = ng_; nM = nM_; nN = nN_; G = G_; c = c_; tM = tM_; tN = tN_; tpm0 = tpm0_; tpn0 = tpn0_; }
    __device__ __forceinline__ bool next(int i, Unit& u) const {
        const int per = nM * nN; const int L = i * G + c;
        if (L < ng * per) {
            u.grp = L / per; int wgid = L - u.grp * per;
            { const int q = per / 8, r = per % 8, xcd = wgid % 8, off = wgid / 8; wgid = (xcd < r ? xcd * (q + 1) : r * (q + 1) + (xcd - r) * q) + off; }
            const int nig = 8 * nN, gid = wgid / nig, fm = gid * 8, gsz = (nM - fm) < 8 ? (nM - fm) : 8;
            u.pm = fm + ((wgid % nig) % gsz); u.pn = (wgid % nig) / gsz; u.seg = 0; return true;
        }
        const int w = L - ng * per;
        if (w < tM * tN) { u.grp = ng; u.pm = tpm0 + (w % tM); u.pn = tpn0 + (w / tM); u.seg = 0; return true; }
        return false;
    }
};
struct Operands { const bf16* A; const bf16* Bt; int lda, ldb, slot0, K; int bmap; };

constexpr int HTB = 128 * 64 * 2;
__device__ __forceinline__ int lds_byte(int r, int c) { const int st = (r >> 4) * 2 + (c >> 5), rr = r & 15, cc = c & 31, ob = rr * 64 + cc * 2; return st * 1024 + (ob ^ (((ob >> 9) & 1) << 5)); }
__device__ __forceinline__ int perm32(int rho) { const int n = rho >> 4, i = rho & 15; return 8 * (i >> 2) + 4 * n + (i & 3); }
__device__ __forceinline__ void stage_rc(int b, int& R, int& C) { const int st = b / 1024, sb = b % 1024, swz = sb ^ (((sb >> 9) & 1) << 5); R = (st >> 1) * 16 + swz / 64; C = (st & 1) * 32 + (swz % 64) / 2; }
typedef int i32x8 __attribute__((ext_vector_type(8)));
typedef int i32x4 __attribute__((ext_vector_type(4)));
__device__ __forceinline__ i32x8 cat8(bf16x8 lo, bf16x8 hi) { const i32x4 a = __builtin_bit_cast(i32x4, lo), b = __builtin_bit_cast(i32x4, hi); return (i32x8){a[0], a[1], a[2], a[3], b[0], b[1], b[2], b[3]}; }
template <bool GATHER, bool PERM, bool FP8, class Sched, class Addr, class Epi>
__device__ __forceinline__ void gemm_fast(LAS unsigned char* lds, const int tid, const Sched& S, const Addr& AD, const Epi& E, const int* __restrict__ grows) {
    const int wid = __builtin_amdgcn_readfirstlane(tid >> 6), lane = tid & 63, wr = wid >> 2, wc = wid & 3, fr = lane & 15, fq = lane >> 4;
    unsigned cvg[2][2], nvg[2][2], cvb[2][2], nvb[2][2];
#define PG8_RC(i_) int R_, C_; stage_rc(tid * 16 + (i_) * 8192, R_, C_); const int sR_ = R_; const unsigned sC_ = (unsigned)C_ * 2u; const int sRb_ = PERM ? ((R_ & ~31) + perm32(R_ & 31)) : R_; (void)sR_; (void)sRb_; (void)sC_
    const size_t kstep = 128;
    const unsigned ldsw = (unsigned)wid * 1024u;
    const int aoff = lds_byte(wr * 64 + fr, fq * 8), boff = lds_byte(wc * 32 + fr, fq * 8);
#define PG8_SA(b, h) (((b) * 2 + (h)) * HTB)
#define PG8_SB(b, h) ((4 + (b) * 2 + (h)) * HTB)
#define PG8_STAGE(bufoff, gbase, voff) do { _Pragma("unroll") for (int _i = 0; _i < 2; ++_i) \
        __builtin_amdgcn_global_load_lds((const unsigned*)((const char*)(gbase) + (voff)[_i]), (LAS unsigned*)(lds + (bufoff) + ldsw + _i * 8192), 16, 0, 0); } while (0)
#define PG8_LDA(dst, b, h) do { if constexpr (FP8) { _Pragma("unroll") for (int m = 0; m < 4; ++m) dst##8[m] = cat8(*(const LAS bf16x8*)(lds + PG8_SA(b, h) + aoff + m * 2048), *(const LAS bf16x8*)(lds + PG8_SA(b, h) + aoff + m * 2048 + 1024)); } \
        else { _Pragma("unroll") for (int m = 0; m < 4; ++m) _Pragma("unroll") for (int k = 0; k < 2; ++k) dst[m][k] = *(const LAS bf16x8*)(lds + PG8_SA(b, h) + aoff + m * 2048 + k * 1024); } } while (0)
#define PG8_LDB(dst, b, h) do { if constexpr (FP8) { _Pragma("unroll") for (int n = 0; n < 2; ++n) dst##8[n] = cat8(*(const LAS bf16x8*)(lds + PG8_SB(b, h) + boff + n * 2048), *(const LAS bf16x8*)(lds + PG8_SB(b, h) + boff + n * 2048 + 1024)); } \
        else { _Pragma("unroll") for (int n = 0; n < 2; ++n) _Pragma("unroll") for (int k = 0; k < 2; ++k) dst[n][k] = *(const LAS bf16x8*)(lds + PG8_SB(b, h) + boff + n * 2048 + k * 1024); } } while (0)
#define PG8_MMA(ai, bj, At, Bt) do { __builtin_amdgcn_s_setprio(1); \
        if constexpr (FP8) { _Pragma("unroll") for (int m = 0; m < 4; ++m) _Pragma("unroll") for (int n = 0; n < 2; ++n)   \
            asm volatile("v_mfma_scale_f32_16x16x128_f8f6f4 %0, %1, %2, %0, %3, %3 op_sel_hi:[0,0,0]" : "+v"(acc[ai][bj][m][n]) : "v"(Bt##8[n]), "v"(At##8[m]), "v"(one_scale)); } \
        else { _Pragma("unroll") for (int m = 0; m < 4; ++m) _Pragma("unroll") for (int n = 0; n < 2; ++n) _Pragma("unroll") for (int k = 0; k < 2; ++k) \
            acc[ai][bj][m][n] = __builtin_amdgcn_mfma_f32_16x16x32_bf16(Bt[n][k], At[m][k], acc[ai][bj][m][n], 0, 0, 0); } \
        __builtin_amdgcn_s_setprio(0); } while (0)
#define PG8_WAIT_V(n) asm volatile("s_waitcnt vmcnt(" #n ")" ::: "memory")
#define PG8_WAIT_L(n) asm volatile("s_waitcnt lgkmcnt(" #n ")" ::: "memory")
#define PG8_BAR __builtin_amdgcn_s_barrier()
#define PG8_SCHED __builtin_amdgcn_sched_barrier(0)
#define PG8_GIDX(dst, op_) do { _Pragma("unroll") for (int i_ = 0; i_ < 2; ++i_) { PG8_RC(i_); _Pragma("unroll") for (int h_ = 0; h_ < 2; ++h_) dst[h_][i_] = (unsigned)grows[(op_).slot0 + h_ * 128 + sR_] * (unsigned)((op_).lda * 2) + sC_; } } while (0)
#define PG8_AOFF(dst, op_) do { _Pragma("unroll") for (int i_ = 0; i_ < 2; ++i_) { PG8_RC(i_); _Pragma("unroll") for (int h_ = 0; h_ < 2; ++h_) dst[h_][i_] = (unsigned)((sR_ + 128 * h_) * (op_).lda) * 2u + sC_; } } while (0)
#define PG8_BOFF(dst, op_) do { _Pragma("unroll") for (int i_ = 0; i_ < 2; ++i_) { PG8_RC(i_); _Pragma("unroll") for (int h_ = 0; h_ < 2; ++h_) { const int c_ = sRb_ + 128 * h_; \
        dst[h_][i_] = (unsigned)(((op_).bmap ? (64 * (c_ & 7) + (c_ >> 3)) : c_) * (op_).ldb) * 2u + sC_; } } } while (0)
#define PG8_COPY(dst, src) do { _Pragma("unroll") for (int h_ = 0; h_ < 2; ++h_) _Pragma("unroll") for (int i_ = 0; i_ < 2; ++i_) dst[h_][i_] = src[h_][i_]; } while (0)
    Unit cur, nxt; int ui = 0;
    if (!S.next(0, cur)) return;
    f32x4 acc[2][2][4][2];
#pragma unroll
    for (int a = 0; a < 2; ++a)
#pragma unroll
        for (int b = 0; b < 2; ++b)
#pragma unroll
            for (int m = 0; m < 4; ++m)
#pragma unroll
                for (int n = 0; n < 2; ++n) acc[a][b][m][n] = (f32x4){0.f, 0.f, 0.f, 0.f};
    bf16x8 At[4][2], B0[2][2], B1[2][2]; i32x8 At8[4], B08[2], B18[2];
    const int one_scale = 0x7F7F7F7F;
    const char* cA; const char* cB; int nt;
    bool has_next; const char* nA; const char* nB; int nnt;
    { const Operands op = AD(cur); cA = (const char*)op.A; cB = (const char*)op.Bt; nt = op.K / 64; PG8_BOFF(cvb, op);
      has_next = S.next(1, nxt); const Operands o1 = has_next ? AD(nxt) : op; PG8_BOFF(nvb, o1); nA = (const char*)o1.A; nB = (const char*)o1.Bt; nnt = o1.K / 64;
      if constexpr (GATHER) { PG8_GIDX(cvg, op); PG8_GIDX(nvg, o1); PG8_WAIT_V(0); } else { PG8_AOFF(cvg, op); PG8_AOFF(nvg, o1); } }
    PG8_STAGE(PG8_SB(0, 0), cB, cvb[0]); PG8_STAGE(PG8_SB(0, 1), cB, cvb[1]); PG8_STAGE(PG8_SA(0, 0), cA, cvg[0]); PG8_STAGE(PG8_SA(0, 1), cA, cvg[1]);
    if (wr == 1) PG8_BAR;
    PG8_WAIT_V(2); PG8_BAR;
    PG8_STAGE(PG8_SB(1, 0), cB + kstep, cvb[0]); PG8_STAGE(PG8_SA(1, 0), cA + kstep, cvg[0]); PG8_STAGE(PG8_SB(1, 1), cB + kstep, cvb[1]);
    PG8_WAIT_V(6); PG8_BAR;
    for (;;) {
#pragma unroll 1
        for (int t = 0; t < nt; t += 2) {
            const bool last = (t == nt - 2);
            const char* a1 = cA + (size_t)(t + 1) * kstep;
            const char* a2 = last ? nA : cA + (size_t)(t + 2) * kstep; const char* b2 = last ? nB : cB + (size_t)(t + 2) * kstep;
            const char* a3 = a2 + kstep; const char* b3 = b2 + kstep;
            unsigned v2[2][2], w2[2][2];
#pragma unroll
            for (int h_ = 0; h_ < 2; ++h_)
#pragma unroll
                for (int i_ = 0; i_ < 2; ++i_) { v2[h_][i_] = last ? nvg[h_][i_] : cvg[h_][i_]; w2[h_][i_] = last ? nvb[h_][i_] : cvb[h_][i_]; }
            PG8_LDB(B0, 0, 0); PG8_LDB(B1, 0, 1); PG8_SCHED; PG8_LDA(At, 0, 0); PG8_STAGE(PG8_SA(1, 1), a1, cvg[1]);
            PG8_WAIT_V(8); PG8_WAIT_L(0); PG8_BAR; PG8_MMA(0, 0, At, B0); PG8_MMA(0, 1, At, B1); PG8_BAR; PG8_SCHED;
            PG8_LDA(At, 0, 1); PG8_STAGE(PG8_SB(0, 0), b2, w2[0]); PG8_STAGE(PG8_SB(0, 1), b2, w2[1]); PG8_STAGE(PG8_SA(0, 0), a2, v2[0]);
            PG8_WAIT_V(8); PG8_WAIT_L(0); PG8_BAR; PG8_MMA(1, 0, At, B0); PG8_MMA(1, 1, At, B1); PG8_BAR; PG8_SCHED;
            PG8_LDB(B0, 1, 0); PG8_LDB(B1, 1, 1); PG8_SCHED; PG8_LDA(At, 1, 0); PG8_STAGE(PG8_SA(0, 1), a2, v2[1]);
            PG8_WAIT_V(8); PG8_WAIT_L(0); PG8_BAR; PG8_MMA(0, 0, At, B0); PG8_MMA(0, 1, At, B1); PG8_BAR; PG8_SCHED;
            PG8_LDA(At, 1, 1); PG8_STAGE(PG8_SB(1, 0), b3, w2[0]); PG8_STAGE(PG8_SB(1, 1), b3, w2[1]); PG8_STAGE(PG8_SA(1, 0), a3, v2[0]);
            PG8_WAIT_V(8); PG8_WAIT_L(0); PG8_BAR; PG8_MMA(1, 0, At, B0); PG8_MMA(1, 1, At, B1); PG8_BAR; PG8_SCHED;
        }
        if constexpr (FP8) asm volatile("s_nop 15\n\ts_nop 15" ::: "memory");
        if (wr == 0) PG8_BAR;
        unsigned fvg[2][2], fvb[2][2];
        Unit u2; const bool h2 = S.next(ui + 2, u2); const char* fA = nA; const char* fB = nB; int fnt = nnt;
        if (h2) { const Operands o2 = AD(u2); fA = (const char*)o2.A; fB = (const char*)o2.Bt; fnt = o2.K / 64; PG8_BOFF(fvb, o2); if constexpr (GATHER) PG8_GIDX(fvg, o2); else PG8_AOFF(fvg, o2); }
        else { PG8_COPY(fvb, nvb); PG8_COPY(fvg, nvg); }
        { int fr2 = fr, fq2 = fq; asm volatile("" : "+v"(fr2), "+v"(fq2));
          E(acc, cur, wr, wc, fr2, fq2); }
        if (!has_next) break;
        if constexpr (GATHER) PG8_WAIT_V(0);
        PG8_COPY(cvg, nvg); PG8_COPY(nvg, fvg); PG8_COPY(cvb, nvb); PG8_COPY(nvb, fvb);
        if (E.reset(cur)) {
#pragma unroll
        for (int a = 0; a < 2; ++a)
#pragma unroll
            for (int b = 0; b < 2; ++b)
#pragma unroll
                for (int m = 0; m < 4; ++m)
#pragma unroll
                    for (int n = 0; n < 2; ++n) acc[a][b][m][n] = (f32x4){0.f, 0.f, 0.f, 0.f};
        }
        cur = nxt; cA = nA; cB = nB; nt = nnt; ++ui;
        nxt = u2; has_next = h2; nA = fA; nB = fB; nnt = fnt;
        if (wr == 1) PG8_BAR;
    }
    PG8_WAIT_V(0);
    PG8_BAR;
#undef PG8_SA
#undef PG8_SB
#undef PG8_STAGE
#undef PG8_LDA
#undef PG8_LDB
#undef PG8_MMA
#undef PG8_WAIT_V
#undef PG8_WAIT_L
#undef PG8_BAR
#undef PG8_SCHED
#undef PG8_GIDX
#undef PG8_AOFF
#undef PG8_BOFF
#undef PG8_COPY
#undef PG8_RC
}
template <class F> struct EpiFn { F f; __device__ __forceinline__ void operator()(f32x4 (&acc)[2][2][4][2], const Unit& u, int wr, int wc, int fr, int fq) const { f(acc, u, wr, wc, fr, fq); } __device__ __forceinline__ bool reset(const Unit&) const { return true; } };
template <class F> __device__ __forceinline__ EpiFn<F> mk_epi(F f) { return EpiFn<F>{f}; }
template <class F> struct EpiSeg { F f; int last; __device__ __forceinline__ void operator()(f32x4 (&acc)[2][2][4][2], const Unit& u, int wr, int wc, int fr, int fq) const { f(acc, u, wr, wc, fr, fq); } __device__ __forceinline__ bool reset(const Unit& u) const { return u.seg == last; } };
template <class F> __device__ __forceinline__ EpiSeg<F> mk_epi_seg(F f, int last) { return EpiSeg<F>{f, last}; }
template <int NSEG> struct SegSched { GroupSched base; __device__ __forceinline__ bool next(int j, Unit& u) const { if (!base.next(j / NSEG, u)) return false; u.seg = j % NSEG; return true; } };
#ifndef DUP_PH
#define DUP_PH -1
#endif
#define REP_BEGIN(k) _Pragma("unroll 1") for (int rep_ = 0; rep_ < ((DUP_PH == (k)) ? 2 : 1); ++rep_) { if (rep_) { if constexpr (PH < 0) xcd_barrier(bar); }
#define REP_END }
#define GEMM(S, AD, E, K, lda, ldb) gemm_fast<false, false, false>(F.lds, F.tid, S, AD, mk_epi(E), nullptr)
#define GEMM_P(S, AD, E) gemm_fast<false, true, false>(F.lds, F.tid, S, AD, mk_epi(E), nullptr)
#define GEMM_P8(S, AD, E) gemm_fast<false, true, true>(F.lds, F.tid, S, AD, mk_epi(E), nullptr)
#define GEMM_GATHER8(S, AD, E, rows) gemm_fast<true, true, true>(F.lds, F.tid, S, AD, mk_epi(E), rows)
#define EPI_ARGS f32x4 (&acc)[2][2][4][2], const Unit& u, int wr, int wc, int fr, int fq
#define EPI_FOR(...) _Pragma("unroll") for (int ai = 0; ai < 2; ++ai) _Pragma("unroll") for (int m = 0; m < 4; ++m) { const int r = ai * 128 + wr * 64 + m * 16 + fr; \
    _Pragma("unroll") for (int bj = 0; bj < 2; ++bj) _Pragma("unroll") for (int n = 0; n < 2; ++n) { const int c = bj * 128 + wc * 32 + n * 16 + 4 * fq; const f32x4 v = acc[ai][bj][m][n]; __VA_ARGS__ } }
#define EPI_FOR8(...) _Pragma("unroll") for (int ai = 0; ai < 2; ++ai) _Pragma("unroll") for (int m = 0; m < 4; ++m) { const int r = ai * 128 + wr * 64 + m * 16 + fr; \
    _Pragma("unroll") for (int bj = 0; bj < 2; ++bj) { const int c = bj * 128 + wc * 32 + 8 * fq; const f32x4 v0 = acc[ai][bj][m][0], v1 = acc[ai][bj][m][1]; __VA_ARGS__ } }
__device__ __forceinline__ void st_bf8(bf16* p, f32x4 a, f32x4 b) { u32x4 w; w.x = pk2(a[0], a[1]); w.y = pk2(a[2], a[3]); w.z = pk2(b[0], b[1]); w.w = pk2(b[2], b[3]); *(u32x4*)p = w; }
__device__ __forceinline__ void st_bf4(bf16* p, f32x4 v) { u32x2 w; w.x = pk2(v[0], v[1]); w.y = pk2(v[2], v[3]); *(u32x2*)p = w; }

__device__ __forceinline__ void p_mod(const Params& P, Frame& F) {
    LAS float* sc = (LAS float*)F.lds;
    LAS float* red = (LAS float*)(F.lds + 9 * 1024 * 4);
    float* MOD = WSP(float, WS_MOD);
    bool have = false;
    for (int it = F.bid; it < 2 * 96; it += F.G) {
        if (!have) {
            for (int i = F.tid; i < 9 * 1024; i += NTHREADS) { const int r = i >> 10, k = i & 1023; const float v = r < 8 ? P.c[r * 1024 + k] : P.c_ctx[k]; sc[i] = v * sigmoidf_(v); }
            have = true;
        }
        __syncthreads();
        const int l = it / 96, j0 = (it % 96) * 64, jj = F.tid & 63, kc = F.tid >> 6;
        const float* W = P.ada_w + (size_t)l * 1024 * 6144 + j0 + jj;
        float a[9];
#pragma unroll
        for (int r = 0; r < 9; ++r) a[r] = 0.f;
#pragma unroll 8
        for (int k = kc * 128; k < kc * 128 + 128; ++k) { const float w = W[(size_t)k * 6144];
#pragma unroll
            for (int r = 0; r < 9; ++r) a[r] += sc[r * 1024 + k] * w; }
#pragma unroll
        for (int r = 0; r < 9; ++r) red[(kc * 9 + r) * 64 + jj] = a[r];
        __syncthreads();
        for (int o = F.tid; o < 9 * 64; o += NTHREADS) { const int r = o >> 6, j = o & 63; float s = 0.f;
#pragma unroll
            for (int q = 0; q < 8; ++q) s += red[(q * 9 + r) * 64 + j];
            MOD[((size_t)l * 9 + r) * 6144 + j0 + j] = s + P.ada_b[l * 6144 + j0 + j]; }
    }
    __syncthreads();
}
__device__ __forceinline__ void p_dftgen(Frame& F) {
    LAS float* tab = (LAS float*)F.lds;
    for (int j = F.tid; j < 4096; j += NTHREADS) tab[j] = cospif((float)j * (1.0f / 2048.0f));
    __syncthreads();
    bf16* DC_ = WSP(bf16, WS_DFTC); bf16* M1 = WSP(bf16, WS_M1T); bf16* M2 = WSP(bf16, WS_M2T);
    const int nchunk = 256 * 64 + 256 * 32 + 256 * 64;
    for (int ch = F.bid * NTHREADS + F.tid; ch < nchunk; ch += F.G * NTHREADS) {
        float v[8]; bf16* dst;
        if (ch < 256 * 64) { const int kf = ch >> 6, col0 = (ch & 63) * 8, cs = col0 >> 8, l0 = col0 & 255;
#pragma unroll
            for (int i = 0; i < 8; ++i) { const int j = ((kf * (l0 + i)) & 255) * 16; v[i] = cs ? -tab[(j + 3072) & 4095] : tab[j]; }
            dst = DC_ + (size_t)kf * 512 + col0; }
        else if (ch < 256 * 64 + 256 * 32) { const int c2 = ch - 256 * 64, row = c2 >> 5, col0 = (c2 & 31) * 8, ri = row >> 7, h = (row >> 6) & 1, k1 = row & 63, h2 = col0 >> 7, cs = (col0 >> 6) & 1, l10 = col0 & 63;
#pragma unroll
            for (int i = 0; i < 8; ++i) { const int j = ((k1 * (l10 + i)) & 63) * 64; const float c = tab[j], sn = tab[(j + 3072) & 4095];
                v[i] = (h != h2) ? 0.f : (ri == 0 ? (cs == 0 ? c : -sn) : (cs == 0 ? sn : c)); }
            dst = M1 + (size_t)row * 256 + col0; }
        else { const int c2 = ch - 256 * 64 - 256 * 32, row = c2 >> 6, col0 = (c2 & 63) * 8, q = row >> 6, k2 = row & 63, q2 = col0 >> 7, ri = (col0 >> 6) & 1, l20 = col0 & 63;
#pragma unroll
            for (int i = 0; i < 8; ++i) { const int j = ((k2 * (l20 + i)) & 63) * 64; const float c = tab[j], sn = tab[(j + 3072) & 4095];
                v[i] = (q != q2) ? 0.f : (ri == 0 ? c : -sn); }
            dst = M2 + (size_t)row * 512 + col0; }
        u32x4 o; o.x = pk2(v[0], v[1]); o.y = pk2(v[2], v[3]); o.z = pk2(v[4], v[5]); o.w = pk2(v[6], v[7]);
        *(u32x4*)dst = o;
    }
    __syncthreads();
}
__device__ __forceinline__ void transpose_item(const float* W, int ldw, int k0, int n0, bf16* WT, int ldt, int drow0, LAS float* scr, int lane) {
    f32x4 ld[8];
#pragma unroll
    for (int i = 0; i < 8; ++i) ld[i] = *(const f32x4*)(W + (size_t)(k0 + 8 * i + (lane >> 3)) * ldw + n0 + 4 * (lane & 7));
#pragma unroll
    for (int i = 0; i < 8; ++i) { LAS float* d = scr + (8 * i + (lane >> 3)) * 33 + 4 * (lane & 7); d[0] = ld[i][0]; d[1] = ld[i][1]; d[2] = ld[i][2]; d[3] = ld[i][3]; }
    LDS_WAIT(); asm volatile("" ::: "memory");
    const int c = lane & 7;
#pragma unroll
    for (int j = 0; j < 4; ++j) { const int n = (lane >> 3) + 8 * j; const LAS float* s = scr + (8 * c) * 33 + n;
        u32x4 o; o.x = pk2(s[0 * 33], s[1 * 33]); o.y = pk2(s[2 * 33], s[3 * 33]); o.z = pk2(s[4 * 33], s[5 * 33]); o.w = pk2(s[6 * 33], s[7 * 33]);
        *(u32x4*)(WT + (size_t)(drow0 + n) * ldt + k0 + 8 * c) = o; }
    LDS_WAIT(); asm volatile("" ::: "memory");
}
__device__ __forceinline__ void transpose_item8(const float* W, int ldw, int k0, int n0, unsigned char* WT, int ldt, int drow0, LAS float* scr, int lane) {
    f32x4 ld[8];
#pragma unroll
    for (int i = 0; i < 8; ++i) ld[i] = *(const f32x4*)(W + (size_t)(k0 + 8 * i + (lane >> 3)) * ldw + n0 + 4 * (lane & 7));
#pragma unroll
    for (int i = 0; i < 8; ++i) { LAS float* d = scr + (8 * i + (lane >> 3)) * 33 + 4 * (lane & 7); d[0] = ld[i][0]; d[1] = ld[i][1]; d[2] = ld[i][2]; d[3] = ld[i][3]; }
    LDS_WAIT(); asm volatile("" ::: "memory");
    const int c = lane & 7;
#pragma unroll
    for (int j = 0; j < 4; ++j) { const int n = (lane >> 3) + 8 * j; const LAS float* s = scr + (8 * c) * 33 + n;
        u32x2 o; o.x = pk4_fp8(s[0 * 33] * W8S, s[1 * 33] * W8S, s[2 * 33] * W8S, s[3 * 33] * W8S); o.y = pk4_fp8(s[4 * 33] * W8S, s[5 * 33] * W8S, s[6 * 33] * W8S, s[7 * 33] * W8S);
        *(u32x2*)(WT + (size_t)(drow0 + n) * ldt + k0 + 8 * c) = o; }
    LDS_WAIT(); asm volatile("" ::: "memory");
}
__device__ __forceinline__ void wconv_experts(const Params& P, Frame& F, int l, int rank, int nblk) {
    LAS float* scr = (LAS float*)(F.lds + F.wave * 16384);
    const int gw = rank * NWAVES + F.wave, NGW = nblk * NWAVES;
    constexpr int I_E = 16 * 88;
    unsigned char* WGU = WSP(unsigned char, WS_WGU); unsigned char* WD = WSP(unsigned char, WS_WD);
    for (int it = gw; it < 3 * 16 * I_E; it += NGW) {
        const int which = it / (16 * I_E), r0 = it % (16 * I_E), e = r0 / I_E, r = r0 % I_E;
        if (which < 2) { const int kb = r / 88, nb = r % 88, n0 = nb * 32;
            const float* src = (which == 0 ? P.w_eg : P.w_eu) + ((size_t)l * 16 + e) * 1024 * FF;
            transpose_item8(src, FF, kb * 64, n0, WGU + (size_t)e * 5632 * 1024, 1024, (n0 >> 7) * 256 + (which ? 128 : 0) + (n0 & 127), scr, F.lane); }
        else { const int kb = r / 32, nb = r % 32;
            transpose_item8(P.w_ed + ((size_t)l * 16 + e) * FF * 1024, 1024, kb * 64, nb * 32, WD + (size_t)e * 1024 * FF, FF, nb * 32, scr, F.lane); }
    }
    __syncthreads();
}
__device__ __forceinline__ void p_wconv(const Params& P, Frame& F, int l) {
    LAS float* scr = (LAS float*)(F.lds + F.wave * 16384);
    const int gw = F.bid * NWAVES + F.wave, NGW = F.G * NWAVES;
    const float* w_in = P.w_in + (size_t)l * 1024 * INW;
    bf16* WA = WSP(bf16, WS_WA); bf16* WFV = WSP(bf16, WS_WFV);
    constexpr int I_K = 16 * 32, I_Q = 16 * 32, I_P = 16 * 16, I_G = 16 * 96, I_V = 16 * 32, I_AO = 16 * 32, I_FO = 8 * 32, I_OUT = 16 * 32;
    constexpr int NSM = I_K + I_Q + I_P + I_G + I_V + I_AO + I_FO + I_OUT;
    for (int it = gw; it < NSM; it += NGW) {
        int r = it;
        if (r < I_K) { transpose_item(w_in, INW, (r / 32) * 64, 0 + (r % 32) * 32, WA, 1024, 0 + (r % 32) * 32, scr, F.lane); continue; } r -= I_K;
        if (r < I_Q) { transpose_item(w_in, INW, (r / 32) * 64, 2048 + (r % 32) * 32, WA, 1024, 1024 + (r % 32) * 32, scr, F.lane); continue; } r -= I_Q;
        if (r < I_P) { transpose_item(w_in, INW, (r / 16) * 64, 3584 + (r % 16) * 32, WA, 1024, 2048 + (r % 16) * 32, scr, F.lane); continue; } r -= I_P;
        if (r < I_G) { transpose_item(w_in, INW, (r / 96) * 64, 4096 + (r % 96) * 32, WA, 1024, 2560 + (r % 96) * 32, scr, F.lane); continue; } r -= I_G;
        if (r < I_V) { transpose_item(w_in, INW, (r / 32) * 64, 1024 + (r % 32) * 32, WFV, 1024, 1024 + (r % 32) * 32, scr, F.lane); continue; } r -= I_V;
        if (r < I_AO) { transpose_item(P.w_att_o + (size_t)l * 1024 * 1024, 1024, (r / 32) * 64, (r % 32) * 32, WSP(bf16, WS_WAO), 1024, (r % 32) * 32, scr, F.lane); continue; } r -= I_AO;
        if (r < I_FO) { transpose_item(P.w_fourier + (size_t)l * 512 * 1024, 1024, (r / 32) * 64, (r % 32) * 32, WSP(bf16, WS_WFO), 512, (r % 32) * 32, scr, F.lane); continue; } r -= I_FO;
        transpose_item(P.w_out + (size_t)l * 1024 * 1024, 1024, (r / 32) * 64, (r % 32) * 32, WSP(bf16, WS_WOUT), 1024, (r % 32) * 32, scr, F.lane);
    }
    { bf16* WPO = WSP(bf16, WS_WPO); const float* wp = P.w_pool + (size_t)l * 4 * 128 * 256;
      for (int i = F.bid * NTHREADS + F.tid; i < 1024 * 256; i += F.G * NTHREADS) { const int n = i >> 8, kk = i & 255, g = n >> 8, f = n & 255;
          WPO[i] = (bf16)(((kk >> 7) == (g & 1)) ? f2bf(wp[((size_t)g * 128 + (kk & 127)) * 256 + f]) : 0u); } }
    { LAS float* t128 = (LAS float*)F.lds;
      __syncthreads();
      for (int j = F.tid; j < 128; j += NTHREADS) t128[j] = cospif((float)j * (1.0f / 64.0f));
      __syncthreads();
      for (int i = F.bid * NTHREADS + F.tid; i < 1024 * 1024; i += F.G * NTHREADS) { const int fc = i >> 10, k = i & 1023, cs = fc & 1, gm = fc >> 1, g = gm >> 7, m = gm & 127;
          const float* src = w_in + (size_t)k * INW + 3072 + g * 128; float s = 0.f; const int ph = cs ? 96 : 0;
          for (int c = 0; c < 128; ++c) s += src[c] * t128[(m * c + ph) & 127];
          WFV[i] = (bf16)f2bf(s); }
      __syncthreads(); }
}

struct RowMod { const float* g; const float* sh; const float* sc; };
__device__ __forceinline__ void row_load(const float* row, int lane, f32x4 (&v)[4]) {
#pragma unroll
    for (int j = 0; j < 4; ++j) v[j] = *(const f32x4*)(row + 4 * lane + 256 * j);
}
__device__ __forceinline__ float row_rstd(const f32x4 (&v)[4]) {
    float s = 0.f;
#pragma unroll
    for (int j = 0; j < 4; ++j) s += (v[j][0] * v[j][0] + v[j][1] * v[j][1]) + (v[j][2] * v[j][2] + v[j][3] * v[j][3]);
    return rsqrtf(wave_sum(s) * (1.0f / 1024.0f) + RMS_EPS);
}
__device__ __forceinline__ void row_modulate(const f32x4 (&v)[4], float rstd, const RowMod& M, int lane, f32x4 (&y)[4]) {
#pragma unroll
    for (int j = 0; j < 4; ++j) { const int k = 4 * lane + 256 * j; const f32x4 g = *(const f32x4*)(M.g + k), sh = *(const f32x4*)(M.sh + k), sc = *(const f32x4*)(M.sc + k);
        y[j] = v[j] * rstd * g * (sc + 1.0f) + sh; }
}
__device__ __forceinline__ void row_store_bf(bf16* row, int lane, const f32x4 (&y)[4]) {
#pragma unroll
    for (int j = 0; j < 4; ++j) st_bf4(row + 4 * lane + 256 * j, y[j]);
}
__device__ __forceinline__ const float* mod_ptr(Frame& F, int l, int row, int which) { const int mr = row < RL ? (row >> 12) : 8; return WSP(float, WS_MOD) + ((size_t)l * 9 + mr) * 6144 + which * 1024; }

__device__ __forceinline__ void p_rowpass_a0(const Params& P, Frame& F) {
    const int gw = F.bid * NWAVES + F.wave, NGW = F.G * NWAVES; bf16* H = WSP(bf16, WS_H);
    f32x4 vn[4]; int row = gw;
    if (row < RT) row_load(row < RL ? P.x + (size_t)row * DM : P.ctx + (size_t)(row - RL) * DM, F.lane, vn);
    for (; row < RT; row += NGW) {
        f32x4 v[4], y[4];
#pragma unroll
        for (int j = 0; j < 4; ++j) v[j] = vn[j];
        { const int nr = row + NGW; if (nr < RT) row_load(nr < RL ? P.x + (size_t)nr * DM : P.ctx + (size_t)(nr - RL) * DM, F.lane, vn); }
        const float rs = row_rstd(v);
        RowMod M{P.norm1_g, mod_ptr(F, 0, row, 0), mod_ptr(F, 0, row, 1)};
        row_modulate(v, rs, M, F.lane, y); row_store_bf(H + (size_t)row * DM, F.lane, y);
    }
}
__device__ __forceinline__ void p_rowpass_f(const Params& P, Frame& F, int l, int nrows) {
    const int gw = F.bid * NWAVES + F.wave, NGW = F.G * NWAVES; unsigned char* H8 = WSP(unsigned char, WS_H8); float* AFF = WSP(float, WS_AFF);
    const float* wr = P.w_router + (size_t)l * 1024 * 16;
    LAS float* wl = (LAS float*)F.lds;
    __syncthreads();
    for (int i = F.tid; i < 16384; i += NTHREADS) wl[(i & 15) * 1024 + (i >> 4)] = wr[i];
    __syncthreads();
    f32x4 vn[4]; int row = gw;
    if (row < nrows) row_load(row < RL ? P.out + (size_t)row * DM : WSP(float, WS_XC) + (size_t)(row - RL) * DM, F.lane, vn);
    for (; row < nrows; row += NGW) {
        f32x4 v[4], y[4];
#pragma unroll
        for (int j = 0; j < 4; ++j) v[j] = vn[j];
        { const int nr = row + NGW; if (nr < nrows) row_load(nr < RL ? P.out + (size_t)nr * DM : WSP(float, WS_XC) + (size_t)(nr - RL) * DM, F.lane, vn); }
        const float rs = row_rstd(v);
        RowMod M{P.norm2_g + l * 1024, mod_ptr(F, l, row, 3), mod_ptr(F, l, row, 4)};
        row_modulate(v, rs, M, F.lane, y);
#pragma unroll
        for (int j = 0; j < 4; ++j) *(unsigned*)(H8 + (size_t)row * DM + 4 * F.lane + 256 * j) = pk4_fp8(y[j][0] * A8S, y[j][1] * A8S, y[j][2] * A8S, y[j][3] * A8S);
        float lg[16];
        int wo = 4 * F.lane; asm volatile("" : "+v"(wo));
#pragma unroll
        for (int e = 0; e < 16; ++e) { float a = 0.f;
#pragma unroll
            for (int j = 0; j < 4; ++j) { const f32x4 w = *(const LAS f32x4*)(wl + e * 1024 + wo + 256 * j); a += (y[j][0] * w[0] + y[j][1] * w[1]) + (y[j][2] * w[2] + y[j][3] * w[3]); }
            lg[e] = a; }
        float mx = -1e30f;
#pragma unroll
        for (int e = 0; e < 16; ++e) { lg[e] = wave_sum(lg[e]); mx = fmaxf(mx, lg[e]); }
        float den = 0.f;
#pragma unroll
        for (int e = 0; e < 16; ++e) { lg[e] = __expf(lg[e] - mx); den += lg[e]; }
        const float inv = 1.0f / den;
        if (F.lane < 16) { float mine = 0.f;
#pragma unroll
            for (int e = 0; e < 16; ++e) mine = (F.lane == e) ? lg[e] : mine;
            AFF[(size_t)row * 16 + F.lane] = mine * inv; }
    }
    __syncthreads();
}
__device__ __forceinline__ void p_rowpass_k(const Params& P, Frame& F, int l, int nrows) {
    const int gw = F.bid * NWAVES + F.wave, NGW = F.G * NWAVES; bf16* H = WSP(bf16, WS_H);
    const int* SEL = WSP(int, WS_SEL); const bf16* Y = WSP(bf16, WS_Y);
    f32x4 vn[4]; int seln = -1; int row = gw;
    if (row < nrows) { row_load(row < RL ? P.out + (size_t)row * DM : WSP(float, WS_XC) + (size_t)(row - RL) * DM, F.lane, vn); seln = F.lane < 16 ? SEL[(size_t)row * 16 + F.lane] : -1; }
    for (; row < nrows; row += NGW) {
        float* xr = row < RL ? P.out + (size_t)row * DM : WSP(float, WS_XC) + (size_t)(row - RL) * DM;
        f32x4 v[4], a[4]; const int sel = seln;
#pragma unroll
        for (int j = 0; j < 4; ++j) { v[j] = vn[j]; a[j] = (f32x4){0.f, 0.f, 0.f, 0.f}; }
        { const int nr = row + NGW; if (nr < nrows) { row_load(nr < RL ? P.out + (size_t)nr * DM : WSP(float, WS_XC) + (size_t)(nr - RL) * DM, F.lane, vn); seln = F.lane < 16 ? SEL[(size_t)nr * 16 + F.lane] : -1; } }
        unsigned em = (unsigned)__ballot(sel >= 0) & 0xffffu;
        while (em) { const int e = __builtin_ctz(em); em &= em - 1; const int s = __builtin_amdgcn_readlane(sel, e); const bf16* yr = Y + (size_t)s * DM;
#pragma unroll
            for (int j = 0; j < 4; ++j) { const u32x2 w = *(const u32x2*)(yr + 4 * F.lane + 256 * j); a[j][0] += bflo(w.x); a[j][1] += bfhi(w.x); a[j][2] += bflo(w.y); a[j][3] += bfhi(w.y); } }
        const float* g2 = mod_ptr(F, l, row, 5);
#pragma unroll
        for (int j = 0; j < 4; ++j) { const f32x4 g = *(const f32x4*)(g2 + 4 * F.lane + 256 * j); v[j] = v[j] + g * a[j]; }
        const float rs = row_rstd(v);
        if (l == 0) {
#pragma unroll
            for (int j = 0; j < 4; ++j) *(f32x4*)(xr + 4 * F.lane + 256 * j) = v[j];
            f32x4 y[4]; RowMod M{P.norm1_g + 1024, mod_ptr(F, 1, row, 0), mod_ptr(F, 1, row, 1)};
            row_modulate(v, rs, M, F.lane, y); row_store_bf(H + (size_t)row * DM, F.lane, y);
        } else {
#pragma unroll
            for (int j = 0; j < 4; ++j) { const f32x4 g = *(const f32x4*)(P.final_g + 4 * F.lane + 256 * j); *(f32x4*)(xr + 4 * F.lane + 256 * j) = v[j] * rs * g; }
        }
    }
}

constexpr int ACK_STRIDE = 72, ACV_STRIDE = 264;
constexpr int ALDS_CK = 0, ALDS_CV = 256 * ACK_STRIDE * 2, ALDS_RP = ALDS_CV + 64 * ACV_STRIDE * 2;
struct AttnState { float m, sum; f32x4 o[4]; };
__device__ __forceinline__ float xrow16_max(float x) {
    auto s = __builtin_amdgcn_permlane16_swap(__float_as_uint(x), __float_as_uint(x), false, false);
    x = fmaxf(__uint_as_float(s[0]), __uint_as_float(s[1]));
    auto t = __builtin_amdgcn_permlane32_swap(__float_as_uint(x), __float_as_uint(x), false, false);
    return fmaxf(__uint_as_float(t[0]), __uint_as_float(t[1]));
}
__device__ __forceinline__ float xrow16_sum(float x) {
    auto s = __builtin_amdgcn_permlane16_swap(__float_as_uint(x), __float_as_uint(x), false, false);
    x = __uint_as_float(s[0]) + __uint_as_float(s[1]);
    auto t = __builtin_amdgcn_permlane32_swap(__float_as_uint(x), __float_as_uint(x), false, false);
    return __uint_as_float(t[0]) + __uint_as_float(t[1]);
}
#define MFMA16(a, b, c) __builtin_amdgcn_mfma_f32_16x16x32_bf16((a), (b), (c), 0, 0, 0)
template <int NT>
__device__ __forceinline__ void attn_tail(AttnState& S, f32x4 (&sc)[NT], const u32x4 (&vw)[NT / 2][4]) {
    float cm = -__builtin_inff();
#pragma unroll
    for (int t = 0; t < NT; ++t)
#pragma unroll
        for (int j = 0; j < 4; ++j) cm = fmaxf(cm, sc[t][j]);
    cm = xrow16_max(cm);
    const bool need = (fabsf(cm) > 12.0f) && (cm > -1e30f);
    if (__builtin_amdgcn_ballot_w64(need) != 0ull) {
        const float d = need ? cm : 0.f, scl = __builtin_amdgcn_exp2f(-d);
        S.m += d; S.sum *= scl;
#pragma unroll
        for (int dt = 0; dt < 4; ++dt) S.o[dt] = S.o[dt] * scl;
#pragma unroll
        for (int t = 0; t < NT; ++t)
#pragma unroll
            for (int j = 0; j < 4; ++j) sc[t][j] -= d;
    }
    float ps = 0.f;
#pragma unroll
    for (int t = 0; t < NT; ++t)
#pragma unroll
        for (int j = 0; j < 4; ++j) { const float p = __builtin_amdgcn_exp2f(sc[t][j]); sc[t][j] = p; ps += p; }
    S.sum += ps;
#pragma unroll
    for (int ks = 0; ks < NT / 2; ++ks) { u32x4 pw; pw.x = pk2(sc[2 * ks][0], sc[2 * ks][1]); pw.y = pk2(sc[2 * ks][2], sc[2 * ks][3]); pw.z = pk2(sc[2 * ks + 1][0], sc[2 * ks + 1][1]); pw.w = pk2(sc[2 * ks + 1][2], sc[2 * ks + 1][3]);
        const bf16x8 pf = __builtin_bit_cast(bf16x8, pw);
#pragma unroll
        for (int dt = 0; dt < 4; ++dt) S.o[dt] = MFMA16(__builtin_bit_cast(bf16x8, vw[ks][dt]), pf, S.o[dt]); }
}
__device__ __forceinline__ void attn_unit2(const bf16* __restrict__ KQ, const bf16* __restrict__ VT, bf16* __restrict__ ATT, LAS unsigned char* lds,
                                           const int b, const int h, const int rowqA, const int rowqB, const bool win, const int r, const int qt, const int lane) {
    const int l15 = lane & 15, g = lane >> 4;
    const f32x4 z = {0.f, 0.f, 0.f, 0.f};
    bf16x8 qA[2], qB[2];
    { const bf16* qp = KQ + (size_t)(rowqA + l15) * 2048 + 1024 + h * 64 + 8 * g; qA[0] = *(const bf16x8*)qp; qA[1] = *(const bf16x8*)(qp + 32); }
    { const bf16* qp = KQ + (size_t)(rowqB + l15) * 2048 + 1024 + h * 64 + 8 * g; qB[0] = *(const bf16x8*)qp; qB[1] = *(const bf16x8*)(qp + 32); }
    AttnState SA, SB; SA.m = 0.f; SA.sum = 0.f; SB.m = 0.f; SB.sum = 0.f;
#pragma unroll
    for (int dt = 0; dt < 4; ++dt) { SA.o[dt] = z; SB.o[dt] = z; }
    if (win) {
        const int rsA = min(max(r - 4, 0), 56), dB = min(max(r - 3, 0), 56) - rsA, kc0 = min(max(16 * qt - 8, 0), 32);
        const int q = 16 * qt + l15, csq = min(max(q - 8, 0), 48);
        const int krow0 = 8 * (l15 >> 2) + (l15 & 3);
        const bf16* kb = KQ + (size_t)(b * SEQ + kc0 + krow0) * 2048 + h * 64 + 8 * g;
        const bf16* vb = VT + (size_t)(b * 1024 + h * 64 + l15) * 4096 + kc0 + 8 * g;
        const LAS float* rp = (const LAS float*)(lds + ALDS_RP);
        const int jb = kc0 + 8 * g;
        const int okb = jb - csq;
        const LAS float* rpl = rp + 16 + (jb - q + 15);
        float madd[2][4];
#pragma unroll
        for (int t = 0; t < 2; ++t)
#pragma unroll
            for (int j = 0; j < 4; ++j) madd[t][j] = ((unsigned)(okb + 4 * t + j) < 16u) ? 0.f : -__builtin_inff();
        bf16x8 K0[2][2], K1[2][2]; u32x4 V0[1][4], V1[1][4];
#define ATT_LOADW(KB, VB, i) do { const int gr_ = min(rsA + (i), 63); const bf16* kp_ = kb + (size_t)(gr_ * 64) * 2048; const bf16* vp_ = vb + gr_ * 64; \
        _Pragma("unroll") for (int t = 0; t < 2; ++t) { KB[t][0] = *(const bf16x8*)(kp_ + (size_t)(4 * t) * 2048); KB[t][1] = *(const bf16x8*)(kp_ + (size_t)(4 * t) * 2048 + 32); } \
        _Pragma("unroll") for (int dt = 0; dt < 4; ++dt) VB[0][dt] = *(const u32x4*)(vp_ + (size_t)(16 * dt) * 4096); } while (0)
#define ATT_ONE(ST, QF, KB, VB, roff, rowok) do { f32x4 sc[2]; \
        const LAS float* bp_ = rpl + ((rowok) ? (roff) : 15) * 64; \
        _Pragma("unroll") for (int t = 0; t < 2; ++t) _Pragma("unroll") for (int j = 0; j < 4; ++j) sc[t][j] = (bp_[4 * t + j] + madd[t][j]) - ST.m;     \
        _Pragma("unroll") for (int t = 0; t < 2; ++t) { sc[t] = MFMA16(KB[t][0], QF[0], sc[t]); sc[t] = MFMA16(KB[t][1], QF[1], sc[t]); } \
        attn_tail<2>(ST, sc, VB); } while (0)
#define ATT_COMPUTE(KB, VB, i) do { const int roffA_ = min(rsA + (i) - r + 7, 14); \
        ATT_ONE(SA, qA, KB, VB, roffA_, (i) <= 7); \
        ATT_ONE(SB, qB, KB, VB, max(roffA_ - 1, 0), (i) >= dB && (i) <= 7 + dB); } while (0)
        ATT_LOADW(K0, V0, 0);
#pragma unroll 1
        for (int i = 0; i < 8; i += 2) { ATT_LOADW(K1, V1, i + 1); ATT_COMPUTE(K0, V0, i); ATT_LOADW(K0, V0, i + 2); ATT_COMPUTE(K1, V1, i + 1); }
        ATT_COMPUTE(K0, V0, 8);
#undef ATT_LOADW
#undef ATT_ONE
#undef ATT_COMPUTE
    }
    { const LAS bf16* ck = (const LAS bf16*)(lds + ALDS_CK) + l15 * ACK_STRIDE + 8 * g;
      const LAS bf16* cv = (const LAS bf16*)(lds + ALDS_CV) + l15 * ACV_STRIDE + 8 * g;
#pragma unroll 1
      for (int c = 0; c < 4; ++c) {
          bf16x8 kf[4][2]; u32x4 vw[2][4];
#pragma unroll
          for (int t = 0; t < 4; ++t) { const LAS bf16* kp = ck + (64 * c + 16 * t) * ACK_STRIDE; kf[t][0] = *(const LAS bf16x8*)kp; kf[t][1] = *(const LAS bf16x8*)(kp + 32); }
#pragma unroll
          for (int ks = 0; ks < 2; ++ks)
#pragma unroll
              for (int dt = 0; dt < 4; ++dt) vw[ks][dt] = *(const LAS u32x4*)(cv + (16 * dt) * ACV_STRIDE + 64 * c + 32 * ks);
          { f32x4 sc[4]; const float nm = -SA.m; const f32x4 c0 = {nm, nm, nm, nm};
#pragma unroll
            for (int t = 0; t < 4; ++t) { sc[t] = MFMA16(kf[t][0], qA[0], c0); sc[t] = MFMA16(kf[t][1], qA[1], sc[t]); }
            attn_tail<4>(SA, sc, vw); }
          { f32x4 sc[4]; const float nm = -SB.m; const f32x4 c0 = {nm, nm, nm, nm};
#pragma unroll
            for (int t = 0; t < 4; ++t) { sc[t] = MFMA16(kf[t][0], qB[0], c0); sc[t] = MFMA16(kf[t][1], qB[1], sc[t]); }
            attn_tail<4>(SB, sc, vw); }
      } }
    { const float inv = 1.0f / xrow16_sum(SA.sum);
#pragma unroll
      for (int dt = 0; dt < 4; ++dt) st_bf4(ATT + (size_t)(rowqA + l15) * 1024 + h * 64 + 16 * dt + 4 * g, SA.o[dt] * inv); }
    { const float inv = 1.0f / xrow16_sum(SB.sum);
#pragma unroll
      for (int dt = 0; dt < 4; ++dt) st_bf4(ATT + (size_t)(rowqB + l15) * 1024 + h * 64 + 16 * dt + 4 * g, SB.o[dt] * inv); }
}
__device__ __forceinline__ void p_attn_mfma(const Params& P, Frame& F, int l, bool with_ctx_queries, int nblk, int rank) {
    const bf16* KQ = WSP(bf16, WS_KQ); const bf16* VT = WSP(bf16, WS_VT); bf16* ATT = WSP(bf16, WS_ATT);
    const float* rpb = P.rpb + (size_t)l * 16 * 465;
    for (int hp = rank; hp < 512; hp += nblk) {
        const int p = hp & 127, quarter = hp >> 7, b = p >> 4, h = p & 15;
        __syncthreads();
        { LAS bf16* ck = (LAS bf16*)(F.lds + ALDS_CK); LAS bf16* cv = (LAS bf16*)(F.lds + ALDS_CV); LAS float* rp = (LAS float*)(F.lds + ALDS_RP);
          { const int key = F.tid >> 1, hf = F.tid & 1; const int k32 = key & 31, pos = (key & ~31) + ((k32 >> 2) & 1) * 16 + 4 * (k32 >> 3) + (k32 & 3);
            const u32x4* src = (const u32x4*)(KQ + (size_t)(RL + b * CTXL + key) * 2048 + h * 64 + hf * 32); LAS u32x4* dst = (LAS u32x4*)(ck + pos * ACK_STRIDE + hf * 32);
#pragma unroll
            for (int i = 0; i < 4; ++i) dst[i] = src[i]; }
          { const int d = F.tid >> 3, sg = F.tid & 7; const u32x4* src = (const u32x4*)(VT + YT_CTX_OFF + (size_t)(b * 1024 + h * 64 + d) * 256 + sg * 32); LAS u32x4* dst = (LAS u32x4*)(cv + d * ACV_STRIDE + sg * 32);
#pragma unroll
            for (int i = 0; i < 4; ++i) dst[i] = src[i]; }
          for (int i = F.tid; i < 16 * 64; i += NTHREADS) { const int rr = i >> 6, cc = (i & 63) - 16; rp[i] = rr == 15 ? -__builtin_inff() : ((cc >= 0 && cc < 31) ? rpb[h * 465 + rr * 31 + cc] * LOG2E : 0.f); } }
        __syncthreads();
        const int qt = F.wave & 3, rpi = F.wave >> 2;
#pragma unroll 1
        for (int st = 0; st < 4; ++st) { const int r = quarter * 16 + st * 4 + rpi * 2; const int rowqA = b * SEQ + r * 64 + 16 * qt;
            attn_unit2(KQ, VT, ATT, F.lds, b, h, rowqA, rowqA + 64, true, r, qt, F.lane); }
        if (with_ctx_queries && quarter == 0) { const int rowqA = RL + b * CTXL + 32 * F.wave; attn_unit2(KQ, VT, ATT, F.lds, b, h, rowqA, rowqA + 16, false, 0, 0, F.lane); }
    }
    __syncthreads();
}

__device__ __forceinline__ void ld8(const bf16* p, float (&x)[8]) { const u32x4 w = *(const u32x4*)p;
#pragma unroll
    for (int q = 0; q < 4; ++q) { x[2 * q] = bflo(w[q]); x[2 * q + 1] = bfhi(w[q]); } }
__device__ __forceinline__ void p_pool(Frame& F, int nrows) {
    const bf16* PB = WSP(bf16, WS_PB); bf16* POOL = WSP(bf16, WS_POOL);
    for (int i = F.bid * NTHREADS + F.tid; i < (nrows >> 4) * 64; i += F.G * NTHREADS) {
        const int row0 = (i >> 6) << 4, ch = i & 63, g = ch >> 4, hw = 1 << g;
        int base, t0, Lb; if (row0 < RL) { base = row0 & ~4095; t0 = row0 & 4095; Lb = SEQ; } else { const int rr = row0 - RL; base = RL + (rr & ~255); t0 = rr & 255; Lb = CTXL; }
        const bf16* src = PB + (size_t)base * 512 + ch * 8;
        float S[8];
#pragma unroll
        for (int q = 0; q < 8; ++q) S[q] = 0.f;
#pragma unroll 4
        for (int d = -8; d < 8; ++d) { const int tt = t0 + d; if (d >= -hw && d < hw && tt >= 0 && tt < Lb) { float x[8]; ld8(src + (size_t)tt * 512, x);
#pragma unroll
                for (int q = 0; q < 8; ++q) S[q] += x[q]; } }
#pragma unroll 2
        for (int j = 0; j < 16; ++j) { const int t = t0 + j; const int lo = max(t - hw, 0), hi = min(t + hw, Lb); const float inv = 1.0f / (float)(hi - lo);
            float me[8]; ld8(src + (size_t)t * 512, me);
            u32x4 o;
#pragma unroll
            for (int q = 0; q < 4; ++q) o[q] = pk2(S[2 * q] * inv - me[2 * q], S[2 * q + 1] * inv - me[2 * q + 1]);
            *(u32x4*)(POOL + (size_t)(base + t) * 512 + ch * 8) = o;
            if (t + hw < Lb) { float x[8]; ld8(src + (size_t)(t + hw) * 512, x);
#pragma unroll
                for (int q = 0; q < 8; ++q) S[q] += x[q]; }
            if (t - hw >= 0) { float x[8]; ld8(src + (size_t)(t - hw) * 512, x);
#pragma unroll
                for (int q = 0; q < 8; ++q) S[q] -= x[q]; } }
    }
}

__device__ __forceinline__ int block_sum_i(int v, LAS int* sm, int tid) {
    v = wave_sum_i(v);
    __syncthreads();
    if ((tid & 63) == 0) sm[tid >> 6] = v;
    __syncthreads();
    int s = 0;
#pragma unroll
    for (int i = 0; i < 8; ++i) s += sm[i];
    return s;
}
__device__ __forceinline__ int block_excl_scan(int v, LAS int* sm, int tid, int& total) {
    const int lane = tid & 63, w = tid >> 6; int inc = v;
#pragma unroll
    for (int o = 1; o < 64; o <<= 1) { const int t = __builtin_amdgcn_ds_bpermute(((lane - o) & 63) << 2, inc); if (lane >= o) inc += t; }
    __syncthreads();
    if (lane == 63) sm[w] = inc;
    __syncthreads();
    int base = 0; total = 0;
#pragma unroll
    for (int i = 0; i < 8; ++i) { const int s = sm[i]; if (i < w) base += s; total += s; }
    return base + inc - v;
}
template <int NPT>
__device__ __forceinline__ void topk_pair(Frame& F, int row0, int n, int cap, int e, int slot0) {
    LAS int* sm = (LAS int*)F.lds;
    const float* AFF = WSP(float, WS_AFF); int* SROW = WSP(int, WS_SROW); float* SG = WSP(float, WS_SGATE); int* SEL = WSP(int, WS_SEL);
    unsigned key[NPT];
#pragma unroll
    for (int j = 0; j < NPT; ++j) { const int i = F.tid * NPT + j; key[j] = (i < n) ? __float_as_uint(AFF[(size_t)(row0 + i) * 16 + e]) : 0u; }
    unsigned T = 0u;
    for (int bit = 30; bit >= 0; --bit) { const unsigned cand = T | (1u << bit); int cnt = 0;
#pragma unroll
        for (int j = 0; j < NPT; ++j) cnt += (key[j] >= cand) ? 1 : 0;
        cnt = block_sum_i(cnt, sm, F.tid);
        if (cnt >= cap) T = cand; }
    int ngt = 0, neq = 0;
#pragma unroll
    for (int j = 0; j < NPT; ++j) { ngt += (key[j] > T) ? 1 : 0; neq += (key[j] == T) ? 1 : 0; }
    int tot_gt, tot_eq;
    (void)block_excl_scan(ngt, sm, F.tid, tot_gt);
    int eqr = block_excl_scan(neq, sm, F.tid, tot_eq);
    const int need_eq = cap - tot_gt;
    int nsel = 0; bool selj[NPT];
#pragma unroll
    for (int j = 0; j < NPT; ++j) { bool s = key[j] > T; if (key[j] == T && T != 0u) { s = eqr < need_eq; ++eqr; } selj[j] = s; nsel += s ? 1 : 0; }
    int tot_sel; int pos = block_excl_scan(nsel, sm, F.tid, tot_sel);
#pragma unroll
    for (int j = 0; j < NPT; ++j) { const int i = F.tid * NPT + j;
        if (i < n) { const int row = row0 + i;
            if (selj[j]) { const int slot = slot0 + pos; ++pos; SROW[slot] = row; SG[slot] = __uint_as_float(key[j]); SEL[(size_t)row * 16 + e] = slot; }
            else SEL[(size_t)row * 16 + e] = -1; } }
    __syncthreads();
}
__device__ __forceinline__ void p_topk(Frame& F, bool with_ctx) {
    const int npairs = 128 + (with_ctx ? 128 : 0);
    for (int pi = F.bid; pi < npairs; pi += F.G) {
        if (pi < 128) { const int b = pi >> 4, e = pi & 15; topk_pair<8>(F, b * SEQ, SEQ, CAPL, e, e * SLOT_E + b * CAPL); }
        else { const int p2 = pi - 128, b = p2 >> 4, e = p2 & 15; topk_pair<1>(F, RL + b * CTXL, CTXL, CAPC, e, e * SLOT_E + 4096 + b * CAPC); }
    }
}
template <int PH> __global__ void __launch_bounds__(NTHREADS, 2) fwd_kernel(Params P) {
    extern __shared__ __attribute__((aligned(16))) unsigned char lds_raw[];
    Frame F; F.lds = (LAS unsigned char*)lds_raw; F.tid = threadIdx.x; F.lane = F.tid & 63; F.wave = __builtin_amdgcn_readfirstlane(F.tid >> 6); F.G = gridDim.x; F.bid = blockIdx.x; F.ws = P.ws;
    const int wave0 = __builtin_amdgcn_readfirstlane((int)threadIdx.x >> 6);
    volatile LAS unsigned* MISC = (volatile LAS unsigned*)(F.lds + LDS_MISC);
    if (F.tid < 64) MISC[F.tid] = 0u;
    __syncthreads();
    XcdBarrier bar; bar.bar = WSP(unsigned, WS_CTL) + CW_BAR; bar.x = 0; bar.st = MISC + 8;
    if constexpr (PH < 0) bar = xcd_barrier_post(WSP(unsigned, WS_CTL) + CW_BAR, MISC + 8);
#define IN(k) (PH < 0 || PH == (k))
#define REFRESH() do { unsigned on_ = ~0u; asm volatile("" : "+s"(on_)); int t_ = wave0 * 64 + (int)__builtin_amdgcn_mbcnt_hi(on_, __builtin_amdgcn_mbcnt_lo(on_, 0u)); asm volatile("" : "+v"(t_)); F.tid = t_; F.lane = t_ & 63; F.wave = __builtin_amdgcn_readfirstlane(t_ >> 6); } while (0)
#define SEAM(k) do { if constexpr (PH < 0) xcd_barrier(bar); } while (0)

    if (IN(0)) { REP_BEGIN(100) p_mod(P, F); p_dftgen(F); REP_END REP_BEGIN(101) p_wconv(P, F, 0); REP_END }
    SEAM(0);
    if (IN(1)) { p_rowpass_a0(P, F); }
    SEAM(1);
    for (int l = P.l_lo; l < P.l_hi; ++l) {
        constexpr int pb = 2; const bool L0 = (l == 0);
        bf16* H = WSP(bf16, WS_H);
        if (IN(pb + 0)) { REFRESH(); REP_BEGIN(2)
            { GroupSched S; S.init(1, 128, 22, F.G, F.bid, 8, L0 ? 22 : 4, 128, 0);
              const bf16* WA = WSP(bf16, WS_WA);
              auto AD = [=](const Unit& u) { return Operands{H + (size_t)u.pm * 256 * DM, WA + (size_t)u.pn * 256 * DM, DM, DM, 0, DM}; };
              bf16* KQ = WSP(bf16, WS_KQ); bf16* PBp = WSP(bf16, WS_PB); bf16* GB = WSP(bf16, WS_GB);
              auto E = [=](EPI_ARGS) { const int row0 = u.pm * 256;
                  if (u.pn < 8) { const float qs = (u.pn >= 4) ? QSCALE : 1.0f; EPI_FOR8( st_bf8(KQ + (size_t)(row0 + r) * 2048 + u.pn * 256 + c, v0 * qs, v1 * qs); ) }
                  else if (u.pn < 10) { EPI_FOR8( st_bf8(PBp + (size_t)(row0 + r) * 512 + (u.pn - 8) * 256 + c, v0, v1); ) }
                  else { EPI_FOR8( f32x4 s0; f32x4 s1; _Pragma("unroll") for (int j = 0; j < 4; ++j) { s0[j] = sigmoidf_(v0[j]); s1[j] = sigmoidf_(v1[j]); } st_bf8(GB + (size_t)(row0 + r) * 3072 + (u.pn - 10) * 256 + c, s0, s1); ) } };
              GEMM_P(S, AD, E); }
            REFRESH();
            { GroupSched S; const int g1a_units = 128 * 22 + 8 * (L0 ? 22 : 4);
              S.init(1, 8, 128, F.G, (F.bid + F.G - ((g1a_units % F.G) & ~7)) % F.G, L0 ? 8 : 4, 8, L0 ? 0 : 4, 128);
              const bf16* WFV = WSP(bf16, WS_WFV);
              auto AD = [=](const Unit& u) { const bool fmap = (u.pm < 4) && (u.pn < 128); const int t16 = u.pn & 15;
                  const size_t tok0 = fmap ? (size_t)(u.pn >> 4) * SEQ + 64 * ((t16 >> 1) * 8) + (t16 & 1) * 32 : (size_t)u.pn * 256;
                  return Operands{WFV + (size_t)u.pm * 256 * DM, H + tok0 * DM, DM, DM, 0, DM, fmap ? 1 : 0}; };
              bf16* YT = WSP(bf16, WS_YT); bf16* VT = WSP(bf16, WS_VT);
              auto E = [=](EPI_ARGS) { bf16* T = (u.pm < 4) ? YT : VT; const int rr0 = (u.pm & 3) * 256;
                  if (u.pn < 128) { const int b = u.pn >> 4;
                      if (u.pm < 4) { const int t16 = u.pn & 15, l10 = (t16 >> 1) * 8, l20 = (t16 & 1) * 32;
                          EPI_FOR8( const int fc = rr0 + r; st_bf8(T + (((((size_t)b * 512 + (fc >> 1)) * 32 + (c >> 3)) * 2 + (l20 >> 5)) * 2 + (fc & 1)) * 64 + l10, v0, v1); ) }
                      else { const int l0 = (u.pn & 15) * 256; EPI_FOR8( st_bf8(T + ((size_t)b * 1024 + rr0 + r) * 4096 + l0 + c, v0, v1); ) } }
                  else { const int b = u.pn - 128; EPI_FOR8( st_bf8(T + YT_CTX_OFF + ((size_t)b * 1024 + rr0 + r) * 256 + c, v0, v1); ) } };
              GEMM_P(S, AD, E); }
        REP_END }
        SEAM(pb + 0);
        if (IN(pb + 1)) { REFRESH();
            { const int nc0 = (F.G * 5 / 16) & ~7, nconv = nc0 > 0 ? nc0 : 1, na = F.G - nconv;
              if (F.bid < na) p_attn_mfma(P, F, l, L0, na, F.bid);
              else wconv_experts(P, F, l, F.bid - na, nconv); }
            REFRESH();
            REP_BEGIN(32)
            { LAS float* tw = (LAS float*)(F.lds + LDS_TW);
              for (int j = F.tid; j < 4096; j += NTHREADS) tw[j] = cospif((float)j * (1.0f / 2048.0f));
              __syncthreads();
              GroupSched S; S.init(1, 1, 512, F.G, F.bid);
              const bf16* M1 = WSP(bf16, WS_M1T); const bf16* YF = WSP(bf16, WS_YT); bf16* ZP = WSP(bf16, WS_ZP);
              auto AD = [=](const Unit& u) { return Operands{M1, YF + (size_t)u.pn * 256 * 256, 256, 256, 0, 256}; };
              auto E = [=](EPI_ARGS) {
                  const int b = u.pn >> 6, gm0 = (u.pn & 63) * 8 + wc, l20 = 32 * wr + 8 * fq;
#pragma unroll
                  for (int m = 0; m < 4; ++m) { const int k1 = 16 * m + fr;
#pragma unroll
                      for (int bj = 0; bj < 2; ++bj) { const int gm = gm0 + 4 * bj;
                          f32x4 zr[2], zi[2];
#pragma unroll
                          for (int n = 0; n < 2; ++n)
#pragma unroll
                              for (int j = 0; j < 4; ++j) { const int ix = k1 * (l20 + 4 * n + j); const float tc = tw[ix], ts = tw[(ix + 3072) & 4095];
                                  const float ur = acc[0][bj][m][n][j], ui = acc[1][bj][m][n][j]; zr[n][j] = ur * tc - ui * ts; zi[n][j] = ur * ts + ui * tc; }
                          bf16* dst = ZP + (((((size_t)b * 64 + k1) * 128 + (gm & 127)) * 4 + (gm >> 7)) * 2) * 64 + l20;
                          st_bf8(dst, zr[0], zr[1]); st_bf8(dst + 64, zi[0], zi[1]); } } };
              GEMM_P(S, AD, E); }
            REP_END
        }
        SEAM(pb + 1);
        if (IN(pb + 10)) { REFRESH();
            { GroupSched S; S.init(1, 1, 256, F.G, F.bid);
              const bf16* M2 = WSP(bf16, WS_M2T); const bf16* ZP = WSP(bf16, WS_ZP); bf16* FOUR = WSP(bf16, WS_FOUR);
              auto AD = [=](const Unit& u) { return Operands{M2, ZP + (size_t)u.pn * 256 * 512, 512, 512, 0, 512}; };
              auto E = [=](EPI_ARGS) { const float sc = 0.0013810679320049757f;
#pragma unroll
                  for (int ai = 0; ai < 2; ++ai)
#pragma unroll
                      for (int m = 0; m < 4; ++m) { const int q = 2 * ai + wr, k2 = 16 * m + fr;
#pragma unroll
                          for (int bj = 0; bj < 2; ++bj) { const int bk = u.pn * 2 + bj, b = bk >> 6, k1 = bk & 63;
                              st_bf8(FOUR + ((size_t)b * SEQ + k1 + 64 * k2) * 512 + q * 128 + wc * 32 + 8 * fq, acc[ai][bj][m][0] * sc, acc[ai][bj][m][1] * sc); } } };
              GEMM_P(S, AD, E); }
            REFRESH();
            if (L0) { GroupSched S; S.init(1, 1, 16, F.G, (F.bid + F.G - 128 % F.G) % F.G);
              const bf16* DFTC = WSP(bf16, WS_DFTC); const bf16* YTC = WSP(bf16, WS_YT) + YT_CTX_OFF; bf16* FOUR = WSP(bf16, WS_FOUR);
              auto AD = [=](const Unit& u) { return Operands{DFTC, YTC + (size_t)u.pn * 256 * 512, 512, 512, 0, 512}; };
              auto E = [=](EPI_ARGS) { const int b = u.pn >> 1, c0 = (u.pn & 1) * 256; const float sc = 0.005524271728019903f;
                  EPI_FOR8( st_bf8(FOUR + ((size_t)RL + b * CTXL + r) * 512 + c0 + c, v0 * sc, v1 * sc); ) };
              GEMM_P(S, AD, E); }
            REFRESH();
            REP_BEGIN(33) p_pool(F, L0 ? RT : RL); REP_END
        }
        SEAM(pb + 10);
        if (IN(pb + 2)) { REFRESH();
            SegSched<3> S; S.base.init(1, L0 ? 136 : 128, 4, F.G, F.bid);
            const bf16* ATT = WSP(bf16, WS_ATT); const bf16* FOUR = WSP(bf16, WS_FOUR); const bf16* POOL = WSP(bf16, WS_POOL);
            const bf16* WAO = WSP(bf16, WS_WAO); const bf16* WFO = WSP(bf16, WS_WFO); const bf16* WPO = WSP(bf16, WS_WPO);
            const bf16* GB = WSP(bf16, WS_GB); bf16* MRGB = WSP(bf16, WS_MRGB); const float* ps = P.pool_scale + l * 1024;
            auto AD = [=](const Unit& u) {
                if (u.seg == 0) return Operands{ATT + (size_t)u.pm * 256 * 1024, WAO + (size_t)u.pn * 256 * 1024, 1024, 1024, 0, 1024};
                if (u.seg == 1) return Operands{FOUR + (size_t)u.pm * 256 * 512, WFO + (size_t)u.pn * 256 * 512, 512, 512, 0, 512};
                return Operands{POOL + (size_t)u.pm * 256 * 512 + (u.pn >> 1) * 256, WPO + (size_t)u.pn * 256 * 256, 512, 256, 0, 256}; };
            auto E = [=](EPI_ARGS) {
                const int kd = u.seg < 2 ? u.seg + 1 : 2; const bool fin = (u.seg == 2); const int colb = u.pn * 256 + wc * 32 + 8 * fq;
#pragma unroll
                for (int ai = 0; ai < 2; ++ai)
#pragma unroll
                    for (int m = 0; m < 4; ++m) { const size_t row = (size_t)u.pm * 256 + ai * 128 + wr * 64 + m * 16 + fr; const bf16* gr = GB + row * 3072 + colb;
                        u32x4 nr[2], dr[2]; f32x4 psv[2][2];
#pragma unroll
                        for (int bj = 0; bj < 2; ++bj) { nr[bj] = *(const u32x4*)(gr + u.seg * 1024 + bj * 128); dr[bj] = *(const u32x4*)(gr + kd * 1024 + bj * 128);
                            psv[bj][0] = *(const f32x4*)(ps + colb + bj * 128); psv[bj][1] = *(const f32x4*)(ps + colb + bj * 128 + 4); }
#pragma unroll
                        for (int bj = 0; bj < 2; ++bj) { f32x4 o[2];
#pragma unroll
                            for (int n = 0; n < 2; ++n) { f32x4 nu = {bflo(nr[bj][2 * n]), bfhi(nr[bj][2 * n]), bflo(nr[bj][2 * n + 1]), bfhi(nr[bj][2 * n + 1])}, de = {bflo(dr[bj][2 * n]), bfhi(dr[bj][2 * n]), bflo(dr[bj][2 * n + 1]), bfhi(dr[bj][2 * n + 1])};
                                if (u.seg == 2) nu = nu * psv[bj][n];
                                de = de * psv[bj][n];
#pragma unroll
                                for (int j = 0; j < 4; ++j) { const float nj = (fabsf(nu[j]) < 1e-30f) ? copysignf(1e-30f, nu[j]) : nu[j]; const float dj = (fabsf(de[j]) < 1e-30f) ? copysignf(1e-30f, de[j]) : de[j];
                                    o[n][j] = acc[ai][bj][m][n][j] * nj * (fin ? 1.0f : __builtin_amdgcn_rcpf(dj)); }
                                acc[ai][bj][m][n] = o[n]; }
                            if (fin) st_bf8(MRGB + row * 1024 + colb + bj * 128, o[0], o[1]); } } };
            gemm_fast<false, true, false>(F.lds, F.tid, S, AD, mk_epi_seg(E, 2), nullptr);
        }
        SEAM(pb + 2);
        if (IN(pb + 3)) { REFRESH();
            GroupSched S; S.init(1, L0 ? 136 : 128, 4, F.G, F.bid); const bf16* A = WSP(bf16, WS_MRGB); const bf16* W = WSP(bf16, WS_WOUT);
            const float* xin = L0 ? P.x : P.out; const float* cin = L0 ? P.ctx : WSP(float, WS_XC); float* xo = P.out; float* co = WSP(float, WS_XC);
            const float* MOD = WSP(float, WS_MOD) + (size_t)l * 9 * 6144;
            auto AD = [=](const Unit& u) { return Operands{A + (size_t)u.pm * 256 * 1024, W + (size_t)u.pn * 256 * 1024, 1024, 1024, 0, 1024}; };
            auto E = [=](EPI_ARGS) {
                const int row0 = u.pm * 256, mr = row0 < RL ? (row0 >> 12) : 8, colb = u.pn * 256 + wc * 32 + 4 * fq;
                const float* src0 = row0 < RL ? xin + (size_t)row0 * DM : cin + (size_t)(row0 - RL) * DM; float* dst0 = row0 < RL ? xo + (size_t)row0 * DM : co + (size_t)(row0 - RL) * DM;
                f32x4 gv[2][2];
#pragma unroll
                for (int bj = 0; bj < 2; ++bj)
#pragma unroll
                    for (int n = 0; n < 2; ++n) gv[bj][n] = *(const f32x4*)(MOD + (size_t)mr * 6144 + 2048 + colb + bj * 128 + n * 16);
#pragma unroll
                for (int ai = 0; ai < 2; ++ai) { f32x4 xv[4][2][2];
#pragma unroll
                    for (int m = 0; m < 4; ++m) { const size_t ro = (size_t)(ai * 128 + wr * 64 + m * 16 + fr) * DM + colb;
#pragma unroll
                        for (int bj = 0; bj < 2; ++bj)
#pragma unroll
                            for (int n = 0; n < 2; ++n) xv[m][bj][n] = *(const f32x4*)(src0 + ro + bj * 128 + n * 16); }
#pragma unroll
                    for (int m = 0; m < 4; ++m) { const size_t ro = (size_t)(ai * 128 + wr * 64 + m * 16 + fr) * DM + colb;
#pragma unroll
                        for (int bj = 0; bj < 2; ++bj)
#pragma unroll
                            for (int n = 0; n < 2; ++n) *(f32x4*)(dst0 + ro + bj * 128 + n * 16) = xv[m][bj][n] + gv[bj][n] * acc[ai][bj][m][n]; } } };
            GEMM(S, AD, E, 1024, 1024, 1024);
        }
        SEAM(pb + 3);
        if (IN(pb + 4)) { REFRESH(); REP_BEGIN(6) p_rowpass_f(P, F, l, L0 ? RT : RL); REP_END }
        SEAM(pb + 4);
        if (IN(pb + 5)) { REFRESH(); REP_BEGIN(7) p_topk(F, L0); REP_END }
        SEAM(pb + 5);
        if (IN(pb + 7)) { REFRESH(); REP_BEGIN(9)
            GroupSched S; S.init(16, L0 ? 17 : 16, 22, F.G, F.bid); const bf16* H8 = WSP(bf16, WS_H8); const bf16* W = WSP(bf16, WS_WGU); unsigned char* HID = WSP(unsigned char, WS_HID); const int* SROW = WSP(int, WS_SROW);
            auto AD = [=](const Unit& u) { return Operands{H8, W + ((size_t)u.grp * 5632 + u.pn * 256) * 512, 512, 512, u.grp * SLOT_E + u.pm * 256, 512}; };
            auto E = [=](EPI_ARGS) {
#pragma unroll
                for (int ai = 0; ai < 2; ++ai)
#pragma unroll
                    for (int m = 0; m < 4; ++m) { const size_t slot = (size_t)u.grp * SLOT_E + u.pm * 256 + ai * 128 + wr * 64 + m * 16 + fr; f32x4 o[2];
#pragma unroll
                        for (int n = 0; n < 2; ++n) { const f32x4 a = acc[ai][0][m][n] * INV8, up = acc[ai][1][m][n] * (INV8 * A8S);
#pragma unroll
                            for (int j = 0; j < 4; ++j) o[n][j] = a[j] * sigmoidf_(a[j]) * up[j]; }
                        u32x2 w; w.x = pk4_fp8(o[0][0], o[0][1], o[0][2], o[0][3]); w.y = pk4_fp8(o[1][0], o[1][1], o[1][2], o[1][3]);
                        *(u32x2*)(HID + slot * FF + u.pn * 128 + wc * 32 + 8 * fq) = w; } };
            GEMM_GATHER8(S, AD, E, SROW);
        REP_END }
        SEAM(pb + 7);
        if (IN(pb + 8)) { REFRESH(); REP_BEGIN(10)
            const int tpe = L0 ? 17 : 16;
            GroupSched S; S.init(1, 16 * tpe, 4, F.G, F.bid); const bf16* HID = WSP(bf16, WS_HID); const bf16* W = WSP(bf16, WS_WD); bf16* Y = WSP(bf16, WS_Y); const float* SG = WSP(float, WS_SGATE);
            auto AD = [=](const Unit& u) { const int e = u.pm / tpe, st = e * 17 + (u.pm - e * tpe); return Operands{HID + (size_t)st * 256 * (FF / 2), W + ((size_t)e * 1024 + u.pn * 256) * (FF / 2), FF / 2, FF / 2, 0, FF / 2}; };
            auto E = [=](EPI_ARGS) { const int e = u.pm / tpe; const size_t slot0 = (size_t)(e * 17 + (u.pm - e * tpe)) * 256 + wr * 64 + fr; float gt[2][4];
#pragma unroll
                for (int ai = 0; ai < 2; ++ai)
#pragma unroll
                    for (int m = 0; m < 4; ++m) gt[ai][m] = SG[slot0 + ai * 128 + m * 16] * INV8;
#pragma unroll
                for (int ai = 0; ai < 2; ++ai)
#pragma unroll
                    for (int m = 0; m < 4; ++m)
#pragma unroll
                        for (int bj = 0; bj < 2; ++bj) st_bf8(Y + (slot0 + ai * 128 + m * 16) * DM + u.pn * 256 + bj * 128 + wc * 32 + 8 * fq, acc[ai][bj][m][0] * gt[ai][m], acc[ai][bj][m][1] * gt[ai][m]); };
            GEMM_P8(S, AD, E);
        REP_END }
        SEAM(pb + 8);
        if (IN(pb + 9)) { REFRESH(); p_rowpass_k(P, F, l, L0 ? RT : RL); if (L0) p_wconv(P, F, 1); }
        if (L0) SEAM(pb + 9);
    }
#undef IN
#undef SEAM
}
template <int PH> static void launch_ph(int grid, const Params& p, hipStream_t stream) { hipLaunchKernelGGL(fwd_kernel<PH>, dim3(grid), dim3(NTHREADS), LDS_BYTES, stream, p); }
template <int PH> static bool set_attr() { return hipFuncSetAttribute((const void*)fwd_kernel<PH>, hipFuncAttributeMaxDynamicSharedMemorySize, LDS_BYTES) == hipSuccess; }

#ifndef DUP_LAUNCH
#define DUP_LAUNCH -1
#endif
extern "C" void kernel_launch(void* const* d_in, const int* in_sizes, int n_in, void* d_out, int out_size, void* d_ws, size_t ws_size, hipStream_t stream) {
    static int grid = 0;
    if (grid == 0) {
        if (n_in != 20 || out_size != RL * DM || ws_size < WS_END) { fprintf(stderr, "kernel_launch: unexpected shapes (n_in %d out %d ws %zu need %zu)\n", n_in, out_size, ws_size, (size_t)WS_END); grid = -1; return; }
        int dev = 0, cus = 0, per_cu = 0;
        if (hipGetDevice(&dev) != hipSuccess || hipDeviceGetAttribute(&cus, hipDeviceAttributeMultiprocessorCount, dev) != hipSuccess) { grid = -1; return; }
#if N_LAUNCH_MODE == 1
        if (!set_attr<-1>()) { fprintf(stderr, "kernel_launch: hipFuncSetAttribute failed\n"); grid = -1; return; }
        if (hipOccupancyMaxActiveBlocksPerMultiprocessor(&per_cu, (const void*)fwd_kernel<-1>, NTHREADS, LDS_BYTES) != hipSuccess || per_cu < 1) fprintf(stderr, "kernel_launch: occupancy query reports %d\n", per_cu);
#else
        if (!(set_attr<0>() && set_attr<1>() && set_attr<2>() && set_attr<3>() && set_attr<12>() && set_attr<4>() && set_attr<5>() && set_attr<6>() && set_attr<7>() && set_attr<9>() && set_attr<10>() && set_attr<11>())) { fprintf(stderr, "kernel_launch: hipFuncSetAttribute failed\n"); grid = -1; return; }
        (void)per_cu;
#endif
        (void)hipGetLastError();
        grid = cus;
    }
    if (grid < 0) return;
    if (hipMemsetAsync((char*)d_ws + WS_CTL, 0, CTL_BYTES, stream) != hipSuccess) return;
    Params p{};
    const float** pp = (const float**)&p;
    for (int i = 0; i < 20; ++i) pp[i] = (const float*)d_in[i];
    p.out = (float*)d_out; p.ws = (unsigned char*)d_ws;
#if N_LAUNCH_MODE == 1
    p.l_lo = 0; p.l_hi = 2;
    launch_ph<-1>(grid, p, stream);
#else
    p.l_lo = 0; p.l_hi = 0; launch_ph<0>(grid, p, stream); if (DUP_LAUNCH == 0) launch_ph<0>(grid, p, stream); launch_ph<1>(grid, p, stream); if (DUP_LAUNCH == 1) launch_ph<1>(grid, p, stream);
#define LP(k) do { launch_ph<k>(grid, p, stream); if (DUP_LAUNCH == (k) && l == 0) launch_ph<k>(grid, p, stream); } while (0)
    for (int l = 0; l < 2; ++l) { p.l_lo = l; p.l_hi = l + 1;
        LP(2); LP(3); LP(12); LP(4); LP(5); LP(6); LP(7); LP(9); LP(10); LP(11); }
#endif
}
```

```cpp
#include <hip/hip_runtime.h>
#include <cstdio>
#include <cstdint>

#ifndef N_LAUNCH_MODE
#define N_LAUNCH_MODE 1
#endif

#define GAS __attribute__((address_space(1)))
#define LAS __attribute__((address_space(3)))
typedef unsigned short bf16;
typedef short bf16x8 __attribute__((ext_vector_type(8)));
typedef float f32x4 __attribute__((ext_vector_type(4)));
typedef unsigned u32x4 __attribute__((ext_vector_type(4)));
typedef unsigned u32x2 __attribute__((ext_vector_type(2)));

constexpr int NB = 8, SEQ = 4096, DM = 1024, CTXL = 256, NH = 16, HD = 64, GRIDW = 64;
constexpr int RL = NB * SEQ, RC = NB * CTXL, RT = RL + RC;
constexpr int INW = 7168, NE = 16, FF = 2816, CAPL = 512, CAPC = 32;
constexpr int SLOT_E = 4352, NSLOT = NE * SLOT_E;
constexpr float RMS_EPS = 1e-6f;
constexpr float LOG2E = 1.4426950408889634f, QSCALE = 0.125f * LOG2E;
constexpr float A8S = 8.0f, W8S = 64.0f, INV8 = 1.0f / (A8S * W8S);
constexpr int NWAVES = 8, NTHREADS = 512;

constexpr size_t al256(size_t x) { return (x + 255) & ~(size_t)255; }
constexpr size_t WS_CTL = 0, CTL_BYTES = 1u << 20;
constexpr size_t WS_MOD = WS_CTL + CTL_BYTES;
constexpr size_t WS_XC = al256(WS_MOD + (size_t)2 * 9 * 6144 * 4);
constexpr size_t WS_AFF = al256(WS_XC + (size_t)RC * DM * 4);
constexpr size_t WS_SROW = al256(WS_AFF + (size_t)RT * 16 * 4);
constexpr size_t WS_SGATE = al256(WS_SROW + (size_t)NSLOT * 4);
constexpr size_t WS_SEL = al256(WS_SGATE + (size_t)NSLOT * 4);
constexpr size_t WS_DFTM = al256(WS_SEL + (size_t)RT * 16 * 4);
constexpr size_t WS_DFTC = al256(WS_DFTM + (size_t)4096 * 8192 * 2);
constexpr size_t WS_WA = al256(WS_DFTC + (size_t)256 * 512 * 2);
constexpr size_t WS_WFV = al256(WS_WA + (size_t)5632 * 1024 * 2);
constexpr size_t WS_WAO = al256(WS_WFV + (size_t)2048 * 1024 * 2);
constexpr size_t WS_WFO = al256(WS_WAO + (size_t)1024 * 1024 * 2);
constexpr size_t WS_WPO = al256(WS_WFO + (size_t)1024 * 512 * 2);
constexpr size_t WS_WOUT = al256(WS_WPO + (size_t)1024 * 256 * 2);
constexpr size_t WS_WGU = al256(WS_WOUT + (size_t)1024 * 1024 * 2);
constexpr size_t WS_WD = al256(WS_WGU + (size_t)16 * 5632 * 1024);
constexpr size_t WS_H = al256(WS_WD + (size_t)16 * 1024 * 2816);
constexpr size_t WS_H8 = al256(WS_H + (size_t)RT * DM * 2);
constexpr size_t WS_R = al256(WS_H8 + (size_t)RT * DM);
constexpr size_t WS_KQ = WS_R;
constexpr size_t WS_MRG = WS_KQ;
constexpr size_t WS_PB = al256(WS_KQ + (size_t)RT * 2048 * 2);
constexpr size_t WS_GB = al256(WS_PB + (size_t)RT * 512 * 2);
constexpr size_t WS_YT = al256(WS_GB + (size_t)RT * 3072 * 2);
constexpr size_t WS_MRGB = WS_YT;
constexpr size_t WS_VT = al256(WS_YT + (size_t)RT * 1024 * 2);
constexpr size_t WS_FOUR = al256(WS_VT + (size_t)RT * 1024 * 2);
constexpr size_t WS_ATT = al256(WS_FOUR + (size_t)RT * 512 * 2);
constexpr size_t WS_POOL = al256(WS_ATT + (size_t)RT * 1024 * 2);
constexpr size_t WS_MIX_END = al256(WS_POOL + (size_t)RT * 512 * 2);
constexpr size_t WS_XG = WS_R;
constexpr size_t WS_HID = al256(WS_XG + (size_t)NSLOT * 1024 * 2);
constexpr size_t WS_Y = al256(WS_HID + (size_t)NSLOT * 2816);
constexpr size_t WS_MOE_END = al256(WS_Y + (size_t)NSLOT * 1024 * 2);
constexpr size_t WS_END0 = WS_MIX_END > WS_MOE_END ? WS_MIX_END : WS_MOE_END;
constexpr size_t WS_ZP = WS_END0;
constexpr size_t WS_M1T = al256(WS_ZP + ((size_t)8 * 64 * 512 * 128 + 1024) * 2);
constexpr size_t WS_M2T = al256(WS_M1T + (size_t)256 * 256 * 2);
constexpr size_t WS_END = al256(WS_M2T + (size_t)256 * 512 * 2);
constexpr size_t YT_CTX_OFF = (size_t)8 * 1024 * 4096;

constexpr int CW_BAR = 4096;

constexpr int LDS_BYTES = 155648;
constexpr int LDS_TW = 132096;
constexpr int LDS_MISC = 131072;

__device__ __forceinline__ unsigned f2bf(float f) { unsigned u = __float_as_uint(f); return (u + 0x7fffu + ((u >> 16) & 1u)) >> 16; }
typedef __bf16 hbf16x2 __attribute__((ext_vector_type(2)));
typedef float f32x2 __attribute__((ext_vector_type(2)));
__device__ __forceinline__ unsigned pk2(float lo, float hi) { const f32x2 v = {lo, hi}; return __builtin_bit_cast(unsigned, __builtin_convertvector(v, hbf16x2)); }
__device__ __forceinline__ unsigned pk4_fp8(float a, float b, float c, float d) {
    a = __builtin_amdgcn_fmed3f(a, -448.f, 448.f); b = __builtin_amdgcn_fmed3f(b, -448.f, 448.f); c = __builtin_amdgcn_fmed3f(c, -448.f, 448.f); d = __builtin_amdgcn_fmed3f(d, -448.f, 448.f);
    int w = 0; w = __builtin_amdgcn_cvt_pk_fp8_f32(a, b, w, false); w = __builtin_amdgcn_cvt_pk_fp8_f32(c, d, w, true); return (unsigned)w; }
__device__ __forceinline__ float bf2f(unsigned b) { return __uint_as_float(b << 16); }
__device__ __forceinline__ float bflo(unsigned w) { return __uint_as_float(w << 16); }
__device__ __forceinline__ float bfhi(unsigned w) { return __uint_as_float(w & 0xffff0000u); }
template <int CTRL> __device__ __forceinline__ float dppf(float x) { return __builtin_bit_cast(float, __builtin_amdgcn_mov_dpp(__builtin_bit_cast(int, x), CTRL, 0xf, 0xf, true)); }
template <int CTRL> __device__ __forceinline__ int dppi(int x) { return __builtin_amdgcn_mov_dpp(x, CTRL, 0xf, 0xf, true); }
constexpr int DPP_XOR1 = 0xB1, DPP_XOR2 = 0x4E, DPP_ROR4 = 0x124, DPP_ROR8 = 0x128;
__device__ __forceinline__ float wave_sum(float v) {
    v += dppf<DPP_XOR1>(v); v += dppf<DPP_XOR2>(v); v += dppf<DPP_ROR4>(v); v += dppf<DPP_ROR8>(v);
    auto s = __builtin_amdgcn_permlane16_swap(__float_as_uint(v), __float_as_uint(v), false, false); v = __uint_as_float(s[0]) + __uint_as_float(s[1]);
    auto t = __builtin_amdgcn_permlane32_swap(__float_as_uint(v), __float_as_uint(v), false, false); return __uint_as_float(t[0]) + __uint_as_float(t[1]);
}
__device__ __forceinline__ float wave_max(float v) {
    v = fmaxf(v, dppf<DPP_XOR1>(v)); v = fmaxf(v, dppf<DPP_XOR2>(v)); v = fmaxf(v, dppf<DPP_ROR4>(v)); v = fmaxf(v, dppf<DPP_ROR8>(v));
    auto s = __builtin_amdgcn_permlane16_swap(__float_as_uint(v), __float_as_uint(v), false, false); v = fmaxf(__uint_as_float(s[0]), __uint_as_float(s[1]));
    auto t = __builtin_amdgcn_permlane32_swap(__float_as_uint(v), __float_as_uint(v), false, false); return fmaxf(__uint_as_float(t[0]), __uint_as_float(t[1]));
}
__device__ __forceinline__ int wave_sum_i(int v) {
    v += dppi<DPP_XOR1>(v); v += dppi<DPP_XOR2>(v); v += dppi<DPP_ROR4>(v); v += dppi<DPP_ROR8>(v);
    auto s = __builtin_amdgcn_permlane16_swap((unsigned)v, (unsigned)v, false, false); v = (int)(s[0] + s[1]);
    auto t = __builtin_amdgcn_permlane32_swap((unsigned)v, (unsigned)v, false, false); return (int)(t[0] + t[1]);
}
__device__ __forceinline__ float sigmoidf_(float x) { return __builtin_amdgcn_rcpf(1.f + __builtin_amdgcn_exp2f(x * -1.4426950408889634f)); }
#define LDS_WAIT() asm volatile("s_waitcnt lgkmcnt(0)" ::: "memory")

#define XB_TMO      128
#define XB_XCNT(j)  (256  + 64 * (j))
#define XB_XSUB(j)  (1280 + 64 * (j))
#define XB_XGEN(j)  (2304 + 64 * (j))
#define XB_TOP      3328
#define XB_TOPGEN   3392
#define XCD_BAR_WORDS 3456
#define XB_SPIN_CAP (1u << 22)

__device__ __forceinline__ unsigned xb_ld(unsigned* p)              { return __hip_atomic_load(p, __ATOMIC_RELAXED, __HIP_MEMORY_SCOPE_AGENT); }
__device__ __forceinline__ unsigned xb_add(unsigned* p, unsigned v) { return __hip_atomic_fetch_add(p, v, __ATOMIC_RELAXED, __HIP_MEMORY_SCOPE_AGENT); }
__device__ __forceinline__ unsigned xb_xcc_id() { return (unsigned)__builtin_amdgcn_s_getreg((3 << 11) | 20) & 0xFu; }
#define XB_SPIN(cond, bar) do { unsigned _sp = 0; while (cond) { __builtin_amdgcn_s_sleep(1); \
    if ((++_sp & 255u) == 0u) { if (xb_ld(&(bar)[XB_TMO])) break; if (_sp > XB_SPIN_CAP) { atomicAdd(&(bar)[XB_TMO], 1u); break; } } } } while (0)

struct XcdBarrier { unsigned* bar; unsigned x; volatile LAS unsigned* st; };

__device__ __forceinline__ XcdBarrier xcd_barrier_post(unsigned* bar, volatile LAS unsigned* st) {
    XcdBarrier b; b.bar = bar; b.x = xb_xcc_id(); b.st = st;
    if (threadIdx.x == 0) (void)xb_add(&bar[XB_XCNT(b.x)], 1u);
    return b;
}
__device__ __forceinline__ void xcd_barrier_complete(unsigned* bar, unsigned x, unsigned& nloc, unsigned& nx) {
    const unsigned G = gridDim.x * gridDim.y * gridDim.z;
    unsigned sum, cnt, mine, sp = 0u;
    for (;;) {
        sum = 0u; cnt = 0u; mine = 0u;
#pragma unroll
        for (unsigned j = 0; j < 16; ++j) { const unsigned c = xb_ld(&bar[XB_XCNT(j)]); sum += c; cnt += (c > 0u) ? 1u : 0u; mine = (j == x) ? c : mine; }
        if (sum == G) break;
        __builtin_amdgcn_s_sleep(1);
        if ((++sp & 255u) == 0u) { if (xb_ld(&bar[XB_TMO])) break; if (sp > XB_SPIN_CAP) { atomicAdd(&bar[XB_TMO], 1u); break; } }
    }
    nloc = mine > 0u ? mine : 1u; nx = cnt > 0u ? cnt : 1u;
}
__device__ __forceinline__ void xcd_barrier(const XcdBarrier& b) {
    asm volatile("s_waitcnt vmcnt(0)" ::: "memory");
    __syncthreads();
    if (threadIdx.x == 0) {
        unsigned* bar = b.bar;
        __builtin_amdgcn_s_waitcnt(0);
        unsigned nloc = b.st[0], nx = b.st[1];
        if (nloc == 0u) { xcd_barrier_complete(bar, b.x, nloc, nx); b.st[0] = nloc; b.st[1] = nx; }
        const unsigned old = xb_add(&bar[XB_XSUB(b.x)], 1u);
        const unsigned gen = old / nloc;
        if (old + 1u == (gen + 1u) * nloc) {
            __builtin_amdgcn_fence(__ATOMIC_RELEASE, "agent");
            asm volatile("s_waitcnt vmcnt(0)" ::: "memory");
            const unsigned og = xb_add(&bar[XB_TOP], 1u);
            const unsigned tg = og / nx;
            if (og + 1u == (tg + 1u) * nx) xb_add(&bar[XB_TOPGEN], 1u);
            else XB_SPIN(xb_ld(&bar[XB_TOPGEN]) == tg, bar);
            __builtin_amdgcn_fence(__ATOMIC_ACQUIRE, "agent");
            xb_add(&bar[XB_XGEN(b.x)], 1u);
            asm volatile("s_waitcnt vmcnt(0)" ::: "memory");
        } else {
            XB_SPIN(xb_ld(&bar[XB_XGEN(b.x)]) == gen, bar);
            __builtin_amdgcn_fence(__ATOMIC_ACQUIRE, "agent");
            asm volatile("s_waitcnt vmcnt(0)" ::: "memory");
        }
    }
    __syncthreads();
}

struct Params {
    const float *x, *c, *ctx, *c_ctx, *ada_w, *ada_b, *norm1_g, *norm2_g, *w_in, *rpb, *w_att_o, *w_fourier, *w_pool, *pool_scale, *w_out, *w_router, *w_eg, *w_eu, *w_ed, *final_g;
    float* out; unsigned char* ws; int l_lo, l_hi;
};
struct Frame {
    LAS unsigned char* lds;
    int tid, lane, wave, G, bid;
    unsigned char* ws;
};
#define WSP(T, off) ((T*)(F.ws + (off)))

struct Unit { int grp, pm, pn, seg; };
struct GroupSched {
    int ng, nM, nN, G, c; int tM, tN, tpm0, tpn0;
    __device__ __forceinline__ void init(int ng_, int nM_, int nN_, int G_, int c_, int tM_ = 0, int tN_ = 0, int tpm0_ = 0, int tpn0_ = 0) { ng = ng_; nM = nM_; nN = nN_; G = G_; c = c_; tM = tM_; tN = tN_; tpm0 = tpm0_; tpn0 = tpn0_; }
    __device__ __forceinline__ bool next(int i, Unit& u) const {
        const int per = nM * nN; const int L = i * G + c;
        if (L < ng * per) {
            u.grp = L / per; int wgid = L - u.grp * per;
            { const int q = per / 8, r = per % 8, xcd = wgid % 8, off = wgid / 8; wgid = (xcd < r ? xcd * (q + 1) : r * (q + 1) + (xcd - r) * q) + off; }
            const int nig = 8 * nN, gid = wgid / nig, fm = gid * 8, gsz = (nM - fm) < 8 ? (nM - fm) : 8;
            u.pm = fm + ((wgid % nig) % gsz); u.pn = (wgid % nig) / gsz; u.seg = 0; return true;
        }
        const int w = L - ng * per;
        if (w < tM * tN) { u.grp = ng; u.pm = tpm0 + (w % tM); u.pn = tpn0 + (w / tM); u.seg = 0; return true; }
        return false;
    }
};
struct Operands { const bf16* A; const bf16* Bt; int lda, ldb, slot0, K; int bmap; };

constexpr int HTB = 128 * 64 * 2;
__device__ __forceinline__ int lds_byte(int r, int c) { const int st = (r >> 4) * 2 + (c >> 5), rr = r & 15, cc = c & 31, ob = rr * 64 + cc * 2; return st * 1024 + (ob ^ (((ob >> 9) & 1) << 5)); }
__device__ __forceinline__ int perm32(int rho) { const int n = rho >> 4, i = rho & 15; return 8 * (i >> 2) + 4 * n + (i & 3); }
__device__ __forceinline__ void stage_rc(int b, int& R, int& C) { const int st = b / 1024, sb = b % 1024, swz = sb ^ (((sb >> 9) & 1) << 5); R = (st >> 1) * 16 + swz / 64; C = (st & 1) * 32 + (swz % 64) / 2; }
typedef int i32x8 __attribute__((ext_vector_type(8)));
typedef int i32x4 __attribute__((ext_vector_type(4)));
__device__ __forceinline__ i32x8 cat8(bf16x8 lo, bf16x8 hi) { const i32x4 a = __builtin_bit_cast(i32x4, lo), b = __builtin_bit_cast(i32x4, hi); return (i32x8){a[0], a[1], a[2], a[3], b[0], b[1], b[2], b[3]}; }
template <bool GATHER, bool PERM, bool FP8, class Sched, class Addr, class Epi>
__device__ __forceinline__ void gemm_fast(LAS unsigned char* lds, const int tid, const Sched& S, const Addr& AD, const Epi& E, const int* __restrict__ grows) {
    const int wid = __builtin_amdgcn_readfirstlane(tid >> 6), lane = tid & 63, wr = wid >> 2, wc = wid & 3, fr = lane & 15, fq = lane >> 4;
    unsigned cvg[2][2], nvg[2][2], cvb[2][2], nvb[2][2];
#define PG8_RC(i_) int R_, C_; stage_rc(tid * 16 + (i_) * 8192, R_, C_); const int sR_ = R_; const unsigned sC_ = (unsigned)C_ * 2u; const int sRb_ = PERM ? ((R_ & ~31) + perm32(R_ & 31)) : R_; (void)sR_; (void)sRb_; (void)sC_
    const size_t kstep = 128;
    const unsigned ldsw = (unsigned)wid * 1024u;
    const int aoff = lds_byte(wr * 64 + fr, fq * 8), boff = lds_byte(wc * 32 + fr, fq * 8);
#define PG8_SA(b, h) (((b) * 2 + (h)) * HTB)
#define PG8_SB(b, h) ((4 + (b) * 2 + (h)) * HTB)
#define PG8_STAGE(bufoff, gbase, voff) do { _Pragma("unroll") for (int _i = 0; _i < 2; ++_i) \
        __builtin_amdgcn_global_load_lds((const unsigned*)((const char*)(gbase) + (voff)[_i]), (LAS unsigned*)(lds + (bufoff) + ldsw + _i * 8192), 16, 0, 0); } while (0)
#define PG8_LDA(dst, b, h) do { if constexpr (FP8) { _Pragma("unroll") for (int m = 0; m < 4; ++m) dst##8[m] = cat8(*(const LAS bf16x8*)(lds + PG8_SA(b, h) + aoff + m * 2048), *(const LAS bf16x8*)(lds + PG8_SA(b, h) + aoff + m * 2048 + 1024)); } \
        else { _Pragma("unroll") for (int m = 0; m < 4; ++m) _Pragma("unroll") for (int k = 0; k < 2; ++k) dst[m][k] = *(const LAS bf16x8*)(lds + PG8_SA(b, h) + aoff + m * 2048 + k * 1024); } } while (0)
#define PG8_LDB(dst, b, h) do { if constexpr (FP8) { _Pragma("unroll") for (int n = 0; n < 2; ++n) dst##8[n] = cat8(*(const LAS bf16x8*)(lds + PG8_SB(b, h) + boff + n * 2048), *(const LAS bf16x8*)(lds + PG8_SB(b, h) + boff + n * 2048 + 1024)); } \
        else { _Pragma("unroll") for (int n = 0; n < 2; ++n) _Pragma("unroll") for (int k = 0; k < 2; ++k) dst[n][k] = *(const LAS bf16x8*)(lds + PG8_SB(b, h) + boff + n * 2048 + k * 1024); } } while (0)
#define PG8_MMA(ai, bj, At, Bt) do { __builtin_amdgcn_s_setprio(1); \
        if constexpr (FP8) { _Pragma("unroll") for (int m = 0; m < 4; ++m) _Pragma("unroll") for (int n = 0; n < 2; ++n)   \
            asm volatile("v_mfma_scale_f32_16x16x128_f8f6f4 %0, %1, %2, %0, %3, %3 op_sel_hi:[0,0,0]" : "+v"(acc[ai][bj][m][n]) : "v"(Bt##8[n]), "v"(At##8[m]), "v"(one_scale)); } \
        else { _Pragma("unroll") for (int m = 0; m < 4; ++m) _Pragma("unroll") for (int n = 0; n < 2; ++n) _Pragma("unroll") for (int k = 0; k < 2; ++k) \
            acc[ai][bj][m][n] = __builtin_amdgcn_mfma_f32_16x16x32_bf16(Bt[n][k], At[m][k], acc[ai][bj][m][n], 0, 0, 0); } \
        __builtin_amdgcn_s_setprio(0); } while (0)
#define PG8_WAIT_V(n) asm volatile("s_waitcnt vmcnt(" #n ")" ::: "memory")
#define PG8_WAIT_L(n) asm volatile("s_waitcnt lgkmcnt(" #n ")" ::: "memory")
#define PG8_BAR __builtin_amdgcn_s_barrier()
#define PG8_SCHED __builtin_amdgcn_sched_barrier(0)
#define PG8_GIDX(dst, op_) do { _Pragma("unroll") for (int i_ = 0; i_ < 2; ++i_) { PG8_RC(i_); _Pragma("unroll") for (int h_ = 0; h_ < 2; ++h_) dst[h_][i_] = (unsigned)grows[(op_).slot0 + h_ * 128 + sR_] * (unsigned)((op_).lda * 2) + sC_; } } while (0)
#define PG8_AOFF(dst, op_) do { _Pragma("unroll") for (int i_ = 0; i_ < 2; ++i_) { PG8_RC(i_); _Pragma("unroll") for (int h_ = 0; h_ < 2; ++h_) dst[h_][i_] = (unsigned)((sR_ + 128 * h_) * (op_).lda) * 2u + sC_; } } while (0)
#define PG8_BOFF(dst, op_) do { _Pragma("unroll") for (int i_ = 0; i_ < 2; ++i_) { PG8_RC(i_); _Pragma("unroll") for (int h_ = 0; h_ < 2; ++h_) { const int c_ = sRb_ + 128 * h_; \
        dst[h_][i_] = (unsigned)(((op_).bmap ? (64 * (c_ & 7) + (c_ >> 3)) : c_) * (op_).ldb) * 2u + sC_; } } } while (0)
#define PG8_COPY(dst, src) do { _Pragma("unroll") for (int h_ = 0; h_ < 2; ++h_) _Pragma("unroll") for (int i_ = 0; i_ < 2; ++i_) dst[h_][i_] = src[h_][i_]; } while (0)
    Unit cur, nxt; int ui = 0;
    if (!S.next(0, cur)) return;
    f32x4 acc[2][2][4][2];
#pragma unroll
    for (int a = 0; a < 2; ++a)
#pragma unroll
        for (int b = 0; b < 2; ++b)
#pragma unroll
            for (int m = 0; m < 4; ++m)
#pragma unroll
                for (int n = 0; n < 2; ++n) acc[a][b][m][n] = (f32x4){0.f, 0.f, 0.f, 0.f};
    bf16x8 At[4][2], B0[2][2], B1[2][2]; i32x8 At8[4], B08[2], B18[2];
    const int one_scale = 0x7F7F7F7F;
    const char* cA; const char* cB; int nt;
    bool has_next; const char* nA; const char* nB; int nnt;
    { const Operands op = AD(cur); cA = (const char*)op.A; cB = (const char*)op.Bt; nt = op.K / 64; PG8_BOFF(cvb, op);
      has_next = S.next(1, nxt); const Operands o1 = has_next ? AD(nxt) : op; PG8_BOFF(nvb, o1); nA = (const char*)o1.A; nB = (const char*)o1.Bt; nnt = o1.K / 64;
      if constexpr (GATHER) { PG8_GIDX(cvg, op); PG8_GIDX(nvg, o1); PG8_WAIT_V(0); } else { PG8_AOFF(cvg, op); PG8_AOFF(nvg, o1); } }
    PG8_STAGE(PG8_SB(0, 0), cB, cvb[0]); PG8_STAGE(PG8_SB(0, 1), cB, cvb[1]); PG8_STAGE(PG8_SA(0, 0), cA, cvg[0]); PG8_STAGE(PG8_SA(0, 1), cA, cvg[1]);
    if (wr == 1) PG8_BAR;
    PG8_WAIT_V(2); PG8_BAR;
    PG8_STAGE(PG8_SB(1, 0), cB + kstep, cvb[0]); PG8_STAGE(PG8_SA(1, 0), cA + kstep, cvg[0]); PG8_STAGE(PG8_SB(1, 1), cB + kstep, cvb[1]);
    PG8_WAIT_V(6); PG8_BAR;
    for (;;) {
#pragma unroll 1
        for (int t = 0; t < nt; t += 2) {
            const bool last = (t == nt - 2);
            const char* a1 = cA + (size_t)(t + 1) * kstep;
            const char* a2 = last ? nA : cA + (size_t)(t + 2) * kstep; const char* b2 = last ? nB : cB + (size_t)(t + 2) * kstep;
            const char* a3 = a2 + kstep; const char* b3 = b2 + kstep;
            unsigned v2[2][2], w2[2][2];
#pragma unroll
            for (int h_ = 0; h_ < 2; ++h_)
#pragma unroll
                for (int i_ = 0; i_ < 2; ++i_) { v2[h_][i_] = last ? nvg[h_][i_] : cvg[h_][i_]; w2[h_][i_] = last ? nvb[h_][i_] : cvb[h_][i_]; }
            PG8_LDB(B0, 0, 0); PG8_LDB(B1, 0, 1); PG8_SCHED; PG8_LDA(At, 0, 0); PG8_STAGE(PG8_SA(1, 1), a1, cvg[1]);
            PG8_WAIT_V(8); PG8_WAIT_L(0); PG8_BAR; PG8_MMA(0, 0, At, B0); PG8_MMA(0, 1, At, B1); PG8_BAR; PG8_SCHED;
            PG8_LDA(At, 0, 1); PG8_STAGE(PG8_SB(0, 0), b2, w2[0]); PG8_STAGE(PG8_SB(0, 1), b2, w2[1]); PG8_STAGE(PG8_SA(0, 0), a2, v2[0]);
            PG8_WAIT_V(8); PG8_WAIT_L(0); PG8_BAR; PG8_MMA(1, 0, At, B0); PG8_MMA(1, 1, At, B1); PG8_BAR; PG8_SCHED;
            PG8_LDB(B0, 1, 0); PG8_LDB(B1, 1, 1); PG8_SCHED; PG8_LDA(At, 1, 0); PG8_STAGE(PG8_SA(0, 1), a2, v2[1]);
            PG8_WAIT_V(8); PG8_WAIT_L(0); PG8_BAR; PG8_MMA(0, 0, At, B0); PG8_MMA(0, 1, At, B1); PG8_BAR; PG8_SCHED;
            PG8_LDA(At, 1, 1); PG8_STAGE(PG8_SB(1, 0), b3, w2[0]); PG8_STAGE(PG8_SB(1, 1), b3, w2[1]); PG8_STAGE(PG8_SA(1, 0), a3, v2[0]);
            PG8_WAIT_V(8); PG8_WAIT_L(0); PG8_BAR; PG8_MMA(1, 0, At, B0); PG8_MMA(1, 1, At, B1); PG8_BAR; PG8_SCHED;
        }
        if constexpr (FP8) asm volatile("s_nop 15\n\ts_nop 15" ::: "memory");
        if (wr == 0) PG8_BAR;
        unsigned fvg[2][2], fvb[2][2];
        Unit u2; const bool h2 = S.next(ui + 2, u2); const char* fA = nA; const char* fB = nB; int fnt = nnt;
        if (h2) { const Operands o2 = AD(u2); fA = (const char*)o2.A; fB = (const char*)o2.Bt; fnt = o2.K / 64; PG8_BOFF(fvb, o2); if constexpr (GATHER) PG8_GIDX(fvg, o2); else PG8_AOFF(fvg, o2); }
        else { PG8_COPY(fvb, nvb); PG8_COPY(fvg, nvg); }
        { int fr2 = fr, fq2 = fq; asm volatile("" : "+v"(fr2), "+v"(fq2));
          E(acc, cur, wr, wc, fr2, fq2); }
        if (!has_next) break;
        if constexpr (GATHER) PG8_WAIT_V(0);
        PG8_COPY(cvg, nvg); PG8_COPY(nvg, fvg); PG8_COPY(cvb, nvb); PG8_COPY(nvb, fvb);
        if (E.reset(cur)) {
#pragma unroll
        for (int a = 0; a < 2; ++a)
#pragma unroll
            for (int b = 0; b < 2; ++b)
#pragma unroll
                for (int m = 0; m < 4; ++m)
#pragma unroll
                    for (int n = 0; n < 2; ++n) acc[a][b][m][n] = (f32x4){0.f, 0.f, 0.f, 0.f};
        }
        cur = nxt; cA = nA; cB = nB; nt = nnt; ++ui;
        nxt = u2; has_next = h2; nA = fA; nB = fB; nnt = fnt;
        if (wr == 1) PG8_BAR;
    }
    PG8_WAIT_V(0);
    PG8_BAR;
#undef PG8_SA
#undef PG8_SB
#undef PG8_STAGE
#undef PG8_LDA
#undef PG8_LDB
#undef PG8_MMA
#undef PG8_WAIT_V
#undef PG8_WAIT_L
#undef PG8_BAR
#undef PG8_SCHED
#undef PG8_GIDX
#undef PG8_AOFF
#undef PG8_BOFF
#undef PG8_COPY
#undef PG8_RC
}
template <class F> struct EpiFn { F f; __device__ __forceinline__ void operator()(f32x4 (&acc)[2][2][4][2], const Unit& u, int wr, int wc, int fr, int fq) const { f(acc, u, wr, wc, fr, fq); } __device__ __forceinline__ bool reset(const Unit&) const { return true; } };
template <class F> __device__ __forceinline__ EpiFn<F> mk_epi(F f) { return EpiFn<F>{f}; }
template <class F> struct EpiSeg { F f; int last; __device__ __forceinline__ void operator()(f32x4 (&acc)[2][2][4][2], const Unit& u, int wr, int wc, int fr, int fq) const { f(acc, u, wr, wc, fr, fq); } __device__ __forceinline__ bool reset(const Unit& u) const { return u.seg == last; } };
template <class F> __device__ __forceinline__ EpiSeg<F> mk_epi_seg(F f, int last) { return EpiSeg<F>{f, last}; }
template <int NSEG> struct SegSched { GroupSched base; __device__ __forceinline__ bool next(int j, Unit& u) const { if (!base.next(j / NSEG, u)) return false; u.seg = j % NSEG; return true; } };
#ifndef DUP_PH
#define DUP_PH -1
#endif
#define REP_BEGIN(k) _Pragma("unroll 1") for (int rep_ = 0; rep_ < ((DUP_PH == (k)) ? 2 : 1); ++rep_) { if (rep_) { if constexpr (PH < 0) xcd_barrier(bar); }
#define REP_END }
#define GEMM(S, AD, E, K, lda, ldb) gemm_fast<false, false, false>(F.lds, F.tid, S, AD, mk_epi(E), nullptr)
#define GEMM_P(S, AD, E) gemm_fast<false, true, false>(F.lds, F.tid, S, AD, mk_epi(E), nullptr)
#define GEMM_P8(S, AD, E) gemm_fast<false, true, true>(F.lds, F.tid, S, AD, mk_epi(E), nullptr)
#define GEMM_GATHER8(S, AD, E, rows) gemm_fast<true, true, true>(F.lds, F.tid, S, AD, mk_epi(E), rows)
#define EPI_ARGS f32x4 (&acc)[2][2][4][2], const Unit& u, int wr, int wc, int fr, int fq
#define EPI_FOR(...) _Pragma("unroll") for (int ai = 0; ai < 2; ++ai) _Pragma("unroll") for (int m = 0; m < 4; ++m) { const int r = ai * 128 + wr * 64 + m * 16 + fr; \
    _Pragma("unroll") for (int bj = 0; bj < 2; ++bj) _Pragma("unroll") for (int n = 0; n < 2; ++n) { const int c = bj * 128 + wc * 32 + n * 16 + 4 * fq; const f32x4 v = acc[ai][bj][m][n]; __VA_ARGS__ } }
#define EPI_FOR8(...) _Pragma("unroll") for (int ai = 0; ai < 2; ++ai) _Pragma("unroll") for (int m = 0; m < 4; ++m) { const int r = ai * 128 + wr * 64 + m * 16 + fr; \
    _Pragma("unroll") for (int bj = 0; bj < 2; ++bj) { const int c = bj * 128 + wc * 32 + 8 * fq; const f32x4 v0 = acc[ai][bj][m][0], v1 = acc[ai][bj][m][1]; __VA_ARGS__ } }
__device__ __forceinline__ void st_bf8(bf16* p, f32x4 a, f32x4 b) { u32x4 w; w.x = pk2(a[0], a[1]); w.y = pk2(a[2], a[3]); w.z = pk2(b[0], b[1]); w.w = pk2(b[2], b[3]); *(u32x4*)p = w; }
__device__ __forceinline__ void st_bf4(bf16* p, f32x4 v) { u32x2 w; w.x = pk2(v[0], v[1]); w.y = pk2(v[2], v[3]); *(u32x2*)p = w; }

__device__ __forceinline__ void p_mod(const Params& P, Frame& F) {
    LAS float* sc = (LAS float*)F.lds;
    LAS float* red = (LAS float*)(F.lds + 9 * 1024 * 4);
    float* MOD = WSP(float, WS_MOD);
    bool have = false;
    for (int it = F.bid; it < 2 * 96; it += F.G) {
        if (!have) {
            for (int i = F.tid; i < 9 * 1024; i += NTHREADS) { const int r = i >> 10, k = i & 1023; const float v = r < 8 ? P.c[r * 1024 + k] : P.c_ctx[k]; sc[i] = v * sigmoidf_(v); }
            have = true;
        }
        __syncthreads();
        const int l = it / 96, j0 = (it % 96) * 64, jj = F.tid & 63, kc = F.tid >> 6;
        const float* W = P.ada_w + (size_t)l * 1024 * 6144 + j0 + jj;
        float a[9];
#pragma unroll
        for (int r = 0; r < 9; ++r) a[r] = 0.f;
#pragma unroll 8
        for (int k = kc * 128; k < kc * 128 + 128; ++k) { const float w = W[(size_t)k * 6144];
#pragma unroll
            for (int r = 0; r < 9; ++r) a[r] += sc[r * 1024 + k] * w; }
#pragma unroll
        for (int r = 0; r < 9; ++r) red[(kc * 9 + r) * 64 + jj] = a[r];
        __syncthreads();
        for (int o = F.tid; o < 9 * 64; o += NTHREADS) { const int r = o >> 6, j = o & 63; float s = 0.f;
#pragma unroll
            for (int q = 0; q < 8; ++q) s += red[(q * 9 + r) * 64 + j];
            MOD[((size_t)l * 9 + r) * 6144 + j0 + j] = s + P.ada_b[l * 6144 + j0 + j]; }
    }
    __syncthreads();
}
__device__ __forceinline__ void p_dftgen(Frame& F) {
    LAS float* tab = (LAS float*)F.lds;
    for (int j = F.tid; j < 4096; j += NTHREADS) tab[j] = cospif((float)j * (1.0f / 2048.0f));
    __syncthreads();
    bf16* DC_ = WSP(bf16, WS_DFTC); bf16* M1 = WSP(bf16, WS_M1T); bf16* M2 = WSP(bf16, WS_M2T);
    const int nchunk = 256 * 64 + 256 * 32 + 256 * 64;
    for (int ch = F.bid * NTHREADS + F.tid; ch < nchunk; ch += F.G * NTHREADS) {
        float v[8]; bf16* dst;
        if (ch < 256 * 64) { const int kf = ch >> 6, col0 = (ch & 63) * 8, cs = col0 >> 8, l0 = col0 & 255;
#pragma unroll
            for (int i = 0; i < 8; ++i) { const int j = ((kf * (l0 + i)) & 255) * 16; v[i] = cs ? -tab[(j + 3072) & 4095] : tab[j]; }
            dst = DC_ + (size_t)kf * 512 + col0; }
        else if (ch < 256 * 64 + 256 * 32) { const int c2 = ch - 256 * 64, row = c2 >> 5, col0 = (c2 & 31) * 8, ri = row >> 7, h = (row >> 6) & 1, k1 = row & 63, h2 = col0 >> 7, cs = (col0 >> 6) & 1, l10 = col0 & 63;
#pragma unroll
            for (int i = 0; i < 8; ++i) { const int j = ((k1 * (l10 + i)) & 63) * 64; const float c = tab[j], sn = tab[(j + 3072) & 4095];
                v[i] = (h != h2) ? 0.f : (ri == 0 ? (cs == 0 ? c : -sn) : (cs == 0 ? sn : c)); }
            dst = M1 + (size_t)row * 256 + col0; }
        else { const int c2 = ch - 256 * 64 - 256 * 32, row = c2 >> 6, col0 = (c2 & 63) * 8, q = row >> 6, k2 = row & 63, q2 = col0 >> 7, ri = (col0 >> 6) & 1, l20 = col0 & 63;
#pragma unroll
            for (int i = 0; i < 8; ++i) { const int j = ((k2 * (l20 + i)) & 63) * 64; const float c = tab[j], sn = tab[(j + 3072) & 4095];
                v[i] = (q != q2) ? 0.f : (ri == 0 ? c : -sn); }
            dst = M2 + (size_t)row * 512 + col0; }
        u32x4 o; o.x = pk2(v[0], v[1]); o.y = pk2(v[2], v[3]); o.z = pk2(v[4], v[5]); o.w = pk2(v[6], v[7]);
        *(u32x4*)dst = o;
    }
    __syncthreads();
}
__device__ __forceinline__ void transpose_item(const float* W, int ldw, int k0, int n0, bf16* WT, int ldt, int drow0, LAS float* scr, int lane) {
    f32x4 ld[8];
#pragma unroll
    for (int i = 0; i < 8; ++i) ld[i] = *(const f32x4*)(W + (size_t)(k0 + 8 * i + (lane >> 3)) * ldw + n0 + 4 * (lane & 7));
#pragma unroll
    for (int i = 0; i < 8; ++i) { LAS float* d = scr + (8 * i + (lane >> 3)) * 33 + 4 * (lane & 7); d[0] = ld[i][0]; d[1] = ld[i][1]; d[2] = ld[i][2]; d[3] = ld[i][3]; }
    LDS_WAIT(); asm volatile("" ::: "memory");
    const int c = lane & 7;
#pragma unroll
    for (int j = 0; j < 4; ++j) { const int n = (lane >> 3) + 8 * j; const LAS float* s = scr + (8 * c) * 33 + n;
        u32x4 o; o.x = pk2(s[0 * 33], s[1 * 33]); o.y = pk2(s[2 * 33], s[3 * 33]); o.z = pk2(s[4 * 33], s[5 * 33]); o.w = pk2(s[6 * 33], s[7 * 33]);
        *(u32x4*)(WT + (size_t)(drow0 + n) * ldt + k0 + 8 * c) = o; }
    LDS_WAIT(); asm volatile("" ::: "memory");
}
__device__ __forceinline__ void transpose_item8(const float* W, int ldw, int k0, int n0, unsigned char* WT, int ldt, int drow0, LAS float* scr, int lane) {
    f32x4 ld[8];
#pragma unroll
    for (int i = 0; i < 8; ++i) ld[i] = *(const f32x4*)(W + (size_t)(k0 + 8 * i + (lane >> 3)) * ldw + n0 + 4 * (lane & 7));
#pragma unroll
    for (int i = 0; i < 8; ++i) { LAS float* d = scr + (8 * i + (lane >> 3)) * 33 + 4 * (lane & 7); d[0] = ld[i][0]; d[1] = ld[i][1]; d[2] = ld[i][2]; d[3] = ld[i][3]; }
    LDS_WAIT(); asm volatile("" ::: "memory");
    const int c = lane & 7;
#pragma unroll
    for (int j = 0; j < 4; ++j) { const int n = (lane >> 3) + 8 * j; const LAS float* s = scr + (8 * c) * 33 + n;
        u32x2 o; o.x = pk4_fp8(s[0 * 33] * W8S, s[1 * 33] * W8S, s[2 * 33] * W8S, s[3 * 33] * W8S); o.y = pk4_fp8(s[4 * 33] * W8S, s[5 * 33] * W8S, s[6 * 33] * W8S, s[7 * 33] * W8S);
        *(u32x2*)(WT + (size_t)(drow0 + n) * ldt + k0 + 8 * c) = o; }
    LDS_WAIT(); asm volatile("" ::: "memory");
}
__device__ __forceinline__ void transpose_item8w(const float* W, int ldw, int k0, int n0, unsigned char* WT, int ldt, int drow0, LAS float* scr, int lane) {
    f32x4 ld[16];
#pragma unroll
    for (int i = 0; i < 16; ++i) ld[i] = *(const f32x4*)(W + (size_t)(k0 + 4 * i + (lane >> 4)) * ldw + n0 + 4 * (lane & 15));
#pragma unroll
    for (int i = 0; i < 16; ++i) { LAS float* d = scr + (4 * i + (lane >> 4)) * 65 + 4 * (lane & 15); d[0] = ld[i][0]; d[1] = ld[i][1]; d[2] = ld[i][2]; d[3] = ld[i][3]; }
    LDS_WAIT(); asm volatile("" ::: "memory");
    const int c = lane & 3;
#pragma unroll
    for (int p = 0; p < 4; ++p) { const int n = (lane >> 2) + 16 * p; const LAS float* s = scr + (16 * c) * 65 + n; u32x4 o;
#pragma unroll
        for (int q = 0; q < 4; ++q) o[q] = pk4_fp8(s[(4 * q) * 65] * W8S, s[(4 * q + 1) * 65] * W8S, s[(4 * q + 2) * 65] * W8S, s[(4 * q + 3) * 65] * W8S);
        *(u32x4*)(WT + (size_t)(drow0 + n) * ldt + k0 + 16 * c) = o; }
    LDS_WAIT(); asm volatile("" ::: "memory");
}
__device__ __forceinline__ void wconv_experts(const Params& P, Frame& F, int l, int rank, int nblk) {
    LAS float* scr = (LAS float*)(F.lds + (F.wave < 7 ? F.wave * 17408 : 131584));
    const int gw = rank * NWAVES + F.wave, NGW = nblk * NWAVES;
    constexpr int I_E = 16 * 44;
    unsigned char* WGU = WSP(unsigned char, WS_WGU); unsigned char* WD = WSP(unsigned char, WS_WD);
    for (int it = gw; it < 3 * 16 * I_E; it += NGW) {
        const int which = it / (16 * I_E), r0 = it % (16 * I_E), e = r0 / I_E, r = r0 % I_E;
        if (which < 2) { const int kb = r / 44, nb = r % 44, n0 = nb * 64;
            const float* src = (which == 0 ? P.w_eg : P.w_eu) + ((size_t)l * 16 + e) * 1024 * FF;
            transpose_item8w(src, FF, kb * 64, n0, WGU + (size_t)e * 5632 * 1024, 1024, (n0 >> 7) * 256 + (which ? 128 : 0) + (n0 & 127), scr, F.lane); }
        else { const int kb = r / 16, nb = r % 16;
            transpose_item8w(P.w_ed + ((size_t)l * 16 + e) * FF * 1024, 1024, kb * 64, nb * 64, WD + (size_t)e * 1024 * FF, FF, nb * 64, scr, F.lane); }
    }
    __syncthreads();
}
__device__ __forceinline__ void p_wconv(const Params& P, Frame& F, int l) {
    LAS float* scr = (LAS float*)(F.lds + F.wave * 16384);
    const int gw = F.bid * NWAVES + F.wave, NGW = F.G * NWAVES;
    const float* w_in = P.w_in + (size_t)l * 1024 * INW;
    bf16* WA = WSP(bf16, WS_WA); bf16* WFV = WSP(bf16, WS_WFV);
    constexpr int I_K = 16 * 32, I_Q = 16 * 32, I_P = 16 * 16, I_G = 16 * 96, I_V = 16 * 32, I_AO = 16 * 32, I_FO = 8 * 32, I_OUT = 16 * 32;
    constexpr int NSM = I_K + I_Q + I_P + I_G + I_V + I_AO + I_FO + I_OUT;
    for (int it = gw; it < NSM; it += NGW) {
        int r = it;
        if (r < I_K) { transpose_item(w_in, INW, (r / 32) * 64, 0 + (r % 32) * 32, WA, 1024, 0 + (r % 32) * 32, scr, F.lane); continue; } r -= I_K;
        if (r < I_Q) { transpose_item(w_in, INW, (r / 32) * 64, 2048 + (r % 32) * 32, WA, 1024, 1024 + (r % 32) * 32, scr, F.lane); continue; } r -= I_Q;
        if (r < I_P) { transpose_item(w_in, INW, (r / 16) * 64, 3584 + (r % 16) * 32, WA, 1024, 2048 + (r % 16) * 32, scr, F.lane); continue; } r -= I_P;
        if (r < I_G) { transpose_item(w_in, INW, (r / 96) * 64, 4096 + (r % 96) * 32, WA, 1024, 2560 + (r % 96) * 32, scr, F.lane); continue; } r -= I_G;
        if (r < I_V) { transpose_item(w_in, INW, (r / 32) * 64, 1024 + (r % 32) * 32, WFV, 1024, 1024 + (r % 32) * 32, scr, F.lane); continue; } r -= I_V;
        if (r < I_AO) { transpose_item(P.w_att_o + (size_t)l * 1024 * 1024, 1024, (r / 32) * 64, (r % 32) * 32, WSP(bf16, WS_WAO), 1024, (r % 32) * 32, scr, F.lane); continue; } r -= I_AO;
        if (r < I_FO) { transpose_item(P.w_fourier + (size_t)l * 512 * 1024, 1024, (r / 32) * 64, (r % 32) * 32, WSP(bf16, WS_WFO), 512, (r % 32) * 32, scr, F.lane); continue; } r -= I_FO;
        transpose_item(P.w_out + (size_t)l * 1024 * 1024, 1024, (r / 32) * 64, (r % 32) * 32, WSP(bf16, WS_WOUT), 1024, (r % 32) * 32, scr, F.lane);
    }
    { bf16* WPO = WSP(bf16, WS_WPO); const float* wp = P.w_pool + (size_t)l * 4 * 128 * 256;
      for (int i = F.bid * NTHREADS + F.tid; i < 1024 * 256; i += F.G * NTHREADS) { const int n = i >> 8, kk = i & 255, g = n >> 8, f = n & 255;
          WPO[i] = (bf16)(((kk >> 7) == (g & 1)) ? f2bf(wp[((size_t)g * 128 + (kk & 127)) * 256 + f]) : 0u); } }
    { LAS float* t128 = (LAS float*)F.lds;
      __syncthreads();
      for (int j = F.tid; j < 128; j += NTHREADS) t128[j] = cospif((float)j * (1.0f / 64.0f));
      __syncthreads();
      for (int i = F.bid * NTHREADS + F.tid; i < 1024 * 1024; i += F.G * NTHREADS) { const int fc = i >> 10, k = i & 1023, cs = fc & 1, gm = fc >> 1, g = gm >> 7, m = gm & 127;
          const float* src = w_in + (size_t)k * INW + 3072 + g * 128; float s = 0.f; const int ph = cs ? 96 : 0;
          for (int c = 0; c < 128; ++c) s += src[c] * t128[(m * c + ph) & 127];
          WFV[i] = (bf16)f2bf(s); }
      __syncthreads(); }
}

struct RowMod { const float* g; const float* sh; const float* sc; };
__device__ __forceinline__ void row_load(const float* row, int lane, f32x4 (&v)[4]) {
#pragma unroll
    for (int j = 0; j < 4; ++j) v[j] = *(const f32x4*)(row + 4 * lane + 256 * j);
}
__device__ __forceinline__ float row_rstd(const f32x4 (&v)[4]) {
    float s = 0.f;
#pragma unroll
    for (int j = 0; j < 4; ++j) s += (v[j][0] * v[j][0] + v[j][1] * v[j][1]) + (v[j][2] * v[j][2] + v[j][3] * v[j][3]);
    return rsqrtf(wave_sum(s) * (1.0f / 1024.0f) + RMS_EPS);
}
__device__ __forceinline__ void row_modulate(const f32x4 (&v)[4], float rstd, const RowMod& M, int lane, f32x4 (&y)[4]) {
#pragma unroll
    for (int j = 0; j < 4; ++j) { const int k = 4 * lane + 256 * j; const f32x4 g = *(const f32x4*)(M.g + k), sh = *(const f32x4*)(M.sh + k), sc = *(const f32x4*)(M.sc + k);
        y[j] = v[j] * rstd * g * (sc + 1.0f) + sh; }
}
__device__ __forceinline__ void row_store_bf(bf16* row, int lane, const f32x4 (&y)[4]) {
#pragma unroll
    for (int j = 0; j < 4; ++j) st_bf4(row + 4 * lane + 256 * j, y[j]);
}
__device__ __forceinline__ const float* mod_ptr(Frame& F, int l, int row, int which) { const int mr = row < RL ? (row >> 12) : 8; return WSP(float, WS_MOD) + ((size_t)l * 9 + mr) * 6144 + which * 1024; }

__device__ __forceinline__ void p_rowpass_a0(const Params& P, Frame& F) {
    const int gw = F.bid * NWAVES + F.wave, NGW = F.G * NWAVES; bf16* H = WSP(bf16, WS_H);
    f32x4 vn[4]; int row = gw;
    if (row < RT) row_load(row < RL ? P.x + (size_t)row * DM : P.ctx + (size_t)(row - RL) * DM, F.lane, vn);
    for (; row < RT; row += NGW) {
        f32x4 v[4], y[4];
#pragma unroll
        for (int j = 0; j < 4; ++j) v[j] = vn[j];
        { const int nr = row + NGW; if (nr < RT) row_load(nr < RL ? P.x + (size_t)nr * DM : P.ctx + (size_t)(nr - RL) * DM, F.lane, vn); }
        const float rs = row_rstd(v);
        RowMod M{P.norm1_g, mod_ptr(F, 0, row, 0), mod_ptr(F, 0, row, 1)};
        row_modulate(v, rs, M, F.lane, y); row_store_bf(H + (size_t)row * DM, F.lane, y);
    }
}
__device__ __forceinline__ void p_rowpass_f(const Params& P, Frame& F, int l, int nrows) {
    const int gw = F.bid * NWAVES + F.wave, NGW = F.G * NWAVES; unsigned char* H8 = WSP(unsigned char, WS_H8); float* AFF = WSP(float, WS_AFF);
    const float* wr = P.w_router + (size_t)l * 1024 * 16;
    LAS float* wl = (LAS float*)F.lds;
    __syncthreads();
    for (int i = F.tid; i < 16384; i += NTHREADS) wl[(i & 15) * 1024 + (i >> 4)] = wr[i];
    __syncthreads();
    f32x4 vn[4]; int row = gw;
    if (row < nrows) row_load(row < RL ? P.out + (size_t)row * DM : WSP(float, WS_XC) + (size_t)(row - RL) * DM, F.lane, vn);
    for (; row < nrows; row += NGW) {
        f32x4 v[4], y[4];
#pragma unroll
        for (int j = 0; j < 4; ++j) v[j] = vn[j];
        { const int nr = row + NGW; if (nr < nrows) row_load(nr < RL ? P.out + (size_t)nr * DM : WSP(float, WS_XC) + (size_t)(nr - RL) * DM, F.lane, vn); }
        const float rs = row_rstd(v);
        RowMod M{P.norm2_g + l * 1024, mod_ptr(F, l, row, 3), mod_ptr(F, l, row, 4)};
        row_modulate(v, rs, M, F.lane, y);
#pragma unroll
        for (int j = 0; j < 4; ++j) *(unsigned*)(H8 + (size_t)row * DM + 4 * F.lane + 256 * j) = pk4_fp8(y[j][0] * A8S, y[j][1] * A8S, y[j][2] * A8S, y[j][3] * A8S);
        float lg[16];
        int wo = 4 * F.lane; asm volatile("" : "+v"(wo));
#pragma unroll
        for (int e = 0; e < 16; ++e) { float a = 0.f;
#pragma unroll
            for (int j = 0; j < 4; ++j) { const f32x4 w = *(const LAS f32x4*)(wl + e * 1024 + wo + 256 * j); a += (y[j][0] * w[0] + y[j][1] * w[1]) + (y[j][2] * w[2] + y[j][3] * w[3]); }
            lg[e] = a; }
        float mx = -1e30f;
#pragma unroll
        for (int e = 0; e < 16; ++e) { lg[e] = wave_sum(lg[e]); mx = fmaxf(mx, lg[e]); }
        float den = 0.f;
#pragma unroll
        for (int e = 0; e < 16; ++e) { lg[e] = __expf(lg[e] - mx); den += lg[e]; }
        const float inv = 1.0f / den;
        if (F.lane < 16) { float mine = 0.f;
#pragma unroll
            for (int e = 0; e < 16; ++e) mine = (F.lane == e) ? lg[e] : mine;
            AFF[(size_t)row * 16 + F.lane] = mine * inv; }
    }
    __syncthreads();
}
__device__ __forceinline__ void p_rowpass_k(const Params& P, Frame& F, int l, int nrows) {
    const int gw = F.bid * NWAVES + F.wave, NGW = F.G * NWAVES; bf16* H = WSP(bf16, WS_H);
    const int* SEL = WSP(int, WS_SEL); const bf16* Y = WSP(bf16, WS_Y);
    f32x4 vn[4]; int seln = -1; int row = gw;
    if (row < nrows) { row_load(row < RL ? P.out + (size_t)row * DM : WSP(float, WS_XC) + (size_t)(row - RL) * DM, F.lane, vn); seln = F.lane < 16 ? SEL[(size_t)row * 16 + F.lane] : -1; }
    for (; row < nrows; row += NGW) {
        float* xr = row < RL ? P.out + (size_t)row * DM : WSP(float, WS_XC) + (size_t)(row - RL) * DM;
        f32x4 v[4], a[4]; const int sel = seln;
#pragma unroll
        for (int j = 0; j < 4; ++j) { v[j] = vn[j]; a[j] = (f32x4){0.f, 0.f, 0.f, 0.f}; }
        { const int nr = row + NGW; if (nr < nrows) { row_load(nr < RL ? P.out + (size_t)nr * DM : WSP(float, WS_XC) + (size_t)(nr - RL) * DM, F.lane, vn); seln = F.lane < 16 ? SEL[(size_t)nr * 16 + F.lane] : -1; } }
        unsigned em = (unsigned)__ballot(sel >= 0) & 0xffffu;
        while (em) { const int e = __builtin_ctz(em); em &= em - 1; const int s = __builtin_amdgcn_readlane(sel, e); const bf16* yr = Y + (size_t)s * DM;
#pragma unroll
            for (int j = 0; j < 4; ++j) { const u32x2 w = *(const u32x2*)(yr + 4 * F.lane + 256 * j); a[j][0] += bflo(w.x); a[j][1] += bfhi(w.x); a[j][2] += bflo(w.y); a[j][3] += bfhi(w.y); } }
        const float* g2 = mod_ptr(F, l, row, 5);
#pragma unroll
        for (int j = 0; j < 4; ++j) { const f32x4 g = *(const f32x4*)(g2 + 4 * F.lane + 256 * j); v[j] = v[j] + g * a[j]; }
        const float rs = row_rstd(v);
        if (l == 0) {
#pragma unroll
            for (int j = 0; j < 4; ++j) *(f32x4*)(xr + 4 * F.lane + 256 * j) = v[j];
            f32x4 y[4]; RowMod M{P.norm1_g + 1024, mod_ptr(F, 1, row, 0), mod_ptr(F, 1, row, 1)};
            row_modulate(v, rs, M, F.lane, y); row_store_bf(H + (size_t)row * DM, F.lane, y);
        } else {
#pragma unroll
            for (int j = 0; j < 4; ++j) { const f32x4 g = *(const f32x4*)(P.final_g + 4 * F.lane + 256 * j); *(f32x4*)(xr + 4 * F.lane + 256 * j) = v[j] * rs * g; }
        }
    }
}

constexpr int ACK_STRIDE = 72, ACV_STRIDE = 264;
constexpr int ALDS_CK = 0, ALDS_CV = 256 * ACK_STRIDE * 2, ALDS_RP = ALDS_CV + 64 * ACV_STRIDE * 2;
struct AttnState { float m, sum; f32x4 o[4]; };
__device__ __forceinline__ float xrow16_max(float x) {
    auto s = __builtin_amdgcn_permlane16_swap(__float_as_uint(x), __float_as_uint(x), false, false);
    x = fmaxf(__uint_as_float(s[0]), __uint_as_float(s[1]));
    auto t = __builtin_amdgcn_permlane32_swap(__float_as_uint(x), __float_as_uint(x), false, false);
    return fmaxf(__uint_as_float(t[0]), __uint_as_float(t[1]));
}
__device__ __forceinline__ float xrow16_sum(float x) {
    auto s = __builtin_amdgcn_permlane16_swap(__float_as_uint(x), __float_as_uint(x), false, false);
    x = __uint_as_float(s[0]) + __uint_as_float(s[1]);
    auto t = __builtin_amdgcn_permlane32_swap(__float_as_uint(x), __float_as_uint(x), false, false);
    return __uint_as_float(t[0]) + __uint_as_float(t[1]);
}
#define MFMA16(a, b, c) __builtin_amdgcn_mfma_f32_16x16x32_bf16((a), (b), (c), 0, 0, 0)
template <int NT>
__device__ __forceinline__ void attn_tail(AttnState& S, f32x4 (&sc)[NT], const u32x4 (&vw)[NT / 2][4]) {
    float cm = -__builtin_inff();
#pragma unroll
    for (int t = 0; t < NT; ++t)
#pragma unroll
        for (int j = 0; j < 4; ++j) cm = fmaxf(cm, sc[t][j]);
    cm = xrow16_max(cm);
    const bool need = (fabsf(cm) > 12.0f) && (cm > -1e30f);
    if (__builtin_amdgcn_ballot_w64(need) != 0ull) {
        const float d = need ? cm : 0.f, scl = __builtin_amdgcn_exp2f(-d);
        S.m += d; S.sum *= scl;
#pragma unroll
        for (int dt = 0; dt < 4; ++dt) S.o[dt] = S.o[dt] * scl;
#pragma unroll
        for (int t = 0; t < NT; ++t)
#pragma unroll
            for (int j = 0; j < 4; ++j) sc[t][j] -= d;
    }
    float ps = 0.f;
#pragma unroll
    for (int t = 0; t < NT; ++t)
#pragma unroll
        for (int j = 0; j < 4; ++j) { const float p = __builtin_amdgcn_exp2f(sc[t][j]); sc[t][j] = p; ps += p; }
    S.sum += ps;
#pragma unroll
    for (int ks = 0; ks < NT / 2; ++ks) { u32x4 pw; pw.x = pk2(sc[2 * ks][0], sc[2 * ks][1]); pw.y = pk2(sc[2 * ks][2], sc[2 * ks][3]); pw.z = pk2(sc[2 * ks + 1][0], sc[2 * ks + 1][1]); pw.w = pk2(sc[2 * ks + 1][2], sc[2 * ks + 1][3]);
        const bf16x8 pf = __builtin_bit_cast(bf16x8, pw);
#pragma unroll
        for (int dt = 0; dt < 4; ++dt) S.o[dt] = MFMA16(__builtin_bit_cast(bf16x8, vw[ks][dt]), pf, S.o[dt]); }
}
__device__ __forceinline__ void attn_unit2(const bf16* __restrict__ KQ, const bf16* __restrict__ VT, bf16* __restrict__ ATT, LAS unsigned char* lds,
                                           const int b, const int h, const int rowqA, const int rowqB, const bool win, const int r, const int qt, const int lane) {
    const int l15 = lane & 15, g = lane >> 4;
    const f32x4 z = {0.f, 0.f, 0.f, 0.f};
    bf16x8 qA[2], qB[2];
    { const bf16* qp = KQ + (size_t)(rowqA + l15) * 2048 + 1024 + h * 64 + 8 * g; qA[0] = *(const bf16x8*)qp; qA[1] = *(const bf16x8*)(qp + 32); }
    { const bf16* qp = KQ + (size_t)(rowqB + l15) * 2048 + 1024 + h * 64 + 8 * g; qB[0] = *(const bf16x8*)qp; qB[1] = *(const bf16x8*)(qp + 32); }
    AttnState SA, SB; SA.m = 0.f; SA.sum = 0.f; SB.m = 0.f; SB.sum = 0.f;
#pragma unroll
    for (int dt = 0; dt < 4; ++dt) { SA.o[dt] = z; SB.o[dt] = z; }
    if (win) {
        const int rsA = min(max(r - 4, 0), 56), dB = min(max(r - 3, 0), 56) - rsA, kc0 = min(max(16 * qt - 8, 0), 32);
        const int q = 16 * qt + l15, csq = min(max(q - 8, 0), 48);
        const int krow0 = 8 * (l15 >> 2) + (l15 & 3);
        const bf16* kb = KQ + (size_t)(b * SEQ + kc0 + krow0) * 2048 + h * 64 + 8 * g;
        const bf16* vb = VT + (size_t)(b * 1024 + h * 64 + l15) * 4096 + kc0 + 8 * g;
        const LAS float* rp = (const LAS float*)(lds + ALDS_RP);
        const int jb = kc0 + 8 * g;
        const int okb = jb - csq;
        const LAS float* rpl = rp + 16 + (jb - q + 15);
        float madd[2][4];
#pragma unroll
        for (int t = 0; t < 2; ++t)
#pragma unroll
            for (int j = 0; j < 4; ++j) madd[t][j] = ((unsigned)(okb + 4 * t + j) < 16u) ? 0.f : -__builtin_inff();
        bf16x8 K0[2][2], K1[2][2]; u32x4 V0[1][4], V1[1][4];
#define ATT_LOADW(KB, VB, i) do { const int gr_ = min(rsA + (i), 63); const bf16* kp_ = kb + (size_t)(gr_ * 64) * 2048; const bf16* vp_ = vb + gr_ * 64; \
        _Pragma("unroll") for (int t = 0; t < 2; ++t) { KB[t][0] = *(const bf16x8*)(kp_ + (size_t)(4 * t) * 2048); KB[t][1] = *(const bf16x8*)(kp_ + (size_t)(4 * t) * 2048 + 32); } \
        _Pragma("unroll") for (int dt = 0; dt < 4; ++dt) VB[0][dt] = *(const u32x4*)(vp_ + (size_t)(16 * dt) * 4096); } while (0)
#define ATT_ONE(ST, QF, KB, VB, roff, rowok) do { f32x4 sc[2]; \
        const LAS float* bp_ = rpl + ((rowok) ? (roff) : 15) * 64; \
        _Pragma("unroll") for (int t = 0; t < 2; ++t) _Pragma("unroll") for (int j = 0; j < 4; ++j) sc[t][j] = (bp_[4 * t + j] + madd[t][j]) - ST.m;     \
        _Pragma("unroll") for (int t = 0; t < 2; ++t) { sc[t] = MFMA16(KB[t][0], QF[0], sc[t]); sc[t] = MFMA16(KB[t][1], QF[1], sc[t]); } \
        attn_tail<2>(ST, sc, VB); } while (0)
#define ATT_COMPUTE(KB, VB, i) do { const int roffA_ = min(rsA + (i) - r + 7, 14); \
        ATT_ONE(SA, qA, KB, VB, roffA_, (i) <= 7); \
        ATT_ONE(SB, qB, KB, VB, max(roffA_ - 1, 0), (i) >= dB && (i) <= 7 + dB); } while (0)
        ATT_LOADW(K0, V0, 0);
#pragma unroll 1
        for (int i = 0; i < 8; i += 2) { ATT_LOADW(K1, V1, i + 1); ATT_COMPUTE(K0, V0, i); ATT_LOADW(K0, V0, i + 2); ATT_COMPUTE(K1, V1, i + 1); }
        ATT_COMPUTE(K0, V0, 8);
#undef ATT_LOADW
#undef ATT_ONE
#undef ATT_COMPUTE
    }
    { const LAS bf16* ck = (const LAS bf16*)(lds + ALDS_CK) + l15 * ACK_STRIDE + 8 * g;
      const LAS bf16* cv = (const LAS bf16*)(lds + ALDS_CV) + l15 * ACV_STRIDE + 8 * g;
#pragma unroll 1
      for (int c = 0; c < 4; ++c) {
          bf16x8 kf[4][2]; u32x4 vw[2][4];
#pragma unroll
          for (int t = 0; t < 4; ++t) { const LAS bf16* kp = ck + (64 * c + 16 * t) * ACK_STRIDE; kf[t][0] = *(const LAS bf16x8*)kp; kf[t][1] = *(const LAS bf16x8*)(kp + 32); }
#pragma unroll
          for (int ks = 0; ks < 2; ++ks)
#pragma unroll
              for (int dt = 0; dt < 4; ++dt) vw[ks][dt] = *(const LAS u32x4*)(cv + (16 * dt) * ACV_STRIDE + 64 * c + 32 * ks);
          { f32x4 sc[4]; const float nm = -SA.m; const f32x4 c0 = {nm, nm, nm, nm};
#pragma unroll
            for (int t = 0; t < 4; ++t) { sc[t] = MFMA16(kf[t][0], qA[0], c0); sc[t] = MFMA16(kf[t][1], qA[1], sc[t]); }
            attn_tail<4>(SA, sc, vw); }
          { f32x4 sc[4]; const float nm = -SB.m; const f32x4 c0 = {nm, nm, nm, nm};
#pragma unroll
            for (int t = 0; t < 4; ++t) { sc[t] = MFMA16(kf[t][0], qB[0], c0); sc[t] = MFMA16(kf[t][1], qB[1], sc[t]); }
            attn_tail<4>(SB, sc, vw); }
      } }
    { const float inv = 1.0f / xrow16_sum(SA.sum);
#pragma unroll
      for (int dt = 0; dt < 4; ++dt) st_bf4(ATT + (size_t)(rowqA + l15) * 1024 + h * 64 + 16 * dt + 4 * g, SA.o[dt] * inv); }
    { const float inv = 1.0f / xrow16_sum(SB.sum);
#pragma unroll
      for (int dt = 0; dt < 4; ++dt) st_bf4(ATT + (size_t)(rowqB + l15) * 1024 + h * 64 + 16 * dt + 4 * g, SB.o[dt] * inv); }
}
__device__ __forceinline__ void p_attn_mfma(const Params& P, Frame& F, int l, bool with_ctx_queries, int nblk, int rank) {
    const bf16* KQ = WSP(bf16, WS_KQ); const bf16* VT = WSP(bf16, WS_VT); bf16* ATT = WSP(bf16, WS_ATT);
    const float* rpb = P.rpb + (size_t)l * 16 * 465;
    const int it0 = (int)(((long)rank * 1024) / nblk), it1 = (int)(((long)(rank + 1) * 1024) / nblk);
    int pcur = -1;
    for (int hp = it0; hp < it1; ++hp) {
        const int p = hp >> 3, eighth = hp & 7, b = p >> 4, h = p & 15;
        if (p != pcur) { pcur = p;
        __syncthreads();
        { LAS bf16* ck = (LAS bf16*)(F.lds + ALDS_CK); LAS bf16* cv = (LAS bf16*)(F.lds + ALDS_CV); LAS float* rp = (LAS float*)(F.lds + ALDS_RP);
          { const int key = F.tid >> 1, hf = F.tid & 1; const int k32 = key & 31, pos = (key & ~31) + ((k32 >> 2) & 1) * 16 + 4 * (k32 >> 3) + (k32 & 3);
            const u32x4* src = (const u32x4*)(KQ + (size_t)(RL + b * CTXL + key) * 2048 + h * 64 + hf * 32); LAS u32x4* dst = (LAS u32x4*)(ck + pos * ACK_STRIDE + hf * 32);
#pragma unroll
            for (int i = 0; i < 4; ++i) dst[i] = src[i]; }
          { const int d = F.tid >> 3, sg = F.tid & 7; const u32x4* src = (const u32x4*)(VT + YT_CTX_OFF + (size_t)(b * 1024 + h * 64 + d) * 256 + sg * 32); LAS u32x4* dst = (LAS u32x4*)(cv + d * ACV_STRIDE + sg * 32);
#pragma unroll
            for (int i = 0; i < 4; ++i) dst[i] = src[i]; }
          for (int i = F.tid; i < 16 * 64; i += NTHREADS) { const int rr = i >> 6, cc = (i & 63) - 16; rp[i] = rr == 15 ? -__builtin_inff() : ((cc >= 0 && cc < 31) ? rpb[h * 465 + rr * 31 + cc] * LOG2E : 0.f); } }
        __syncthreads(); }
        const int qt = F.wave & 3, rpi = F.wave >> 2;
#pragma unroll 1
        for (int st = 0; st < 2; ++st) { const int r = eighth * 8 + st * 4 + rpi * 2; const int rowqA = b * SEQ + r * 64 + 16 * qt;
            attn_unit2(KQ, VT, ATT, F.lds, b, h, rowqA, rowqA + 64, true, r, qt, F.lane); }
        if (with_ctx_queries && eighth == 0) { const int rowqA = RL + b * CTXL + 32 * F.wave; attn_unit2(KQ, VT, ATT, F.lds, b, h, rowqA, rowqA + 16, false, 0, 0, F.lane); }
    }
    __syncthreads();
}

__device__ __forceinline__ void ld8(const bf16* p, float (&x)[8]) { const u32x4 w = *(const u32x4*)p;
#pragma unroll
    for (int q = 0; q < 4; ++q) { x[2 * q] = bflo(w[q]); x[2 * q + 1] = bfhi(w[q]); } }
__device__ __forceinline__ void p_pool(Frame& F, int nrows) {
    const bf16* PB = WSP(bf16, WS_PB); bf16* POOL = WSP(bf16, WS_POOL);
    for (int i = F.bid * NTHREADS + F.tid; i < (nrows >> 4) * 64; i += F.G * NTHREADS) {
        const int row0 = (i >> 6) << 4, ch = i & 63, g = ch >> 4, hw = 1 << g;
        int base, t0, Lb; if (row0 < RL) { base = row0 & ~4095; t0 = row0 & 4095; Lb = SEQ; } else { const int rr = row0 - RL; base = RL + (rr & ~255); t0 = rr & 255; Lb = CTXL; }
        const bf16* src = PB + (size_t)base * 512 + ch * 8;
        float S[8];
#pragma unroll
        for (int q = 0; q < 8; ++q) S[q] = 0.f;
#pragma unroll 4
        for (int d = -8; d < 8; ++d) { const int tt = t0 + d; if (d >= -hw && d < hw && tt >= 0 && tt < Lb) { float x[8]; ld8(src + (size_t)tt * 512, x);
#pragma unroll
                for (int q = 0; q < 8; ++q) S[q] += x[q]; } }
#pragma unroll 2
        for (int j = 0; j < 16; ++j) { const int t = t0 + j; const int lo = max(t - hw, 0), hi = min(t + hw, Lb); const float inv = 1.0f / (float)(hi - lo);
            float me[8]; ld8(src + (size_t)t * 512, me);
            u32x4 o;
#pragma unroll
            for (int q = 0; q < 4; ++q) o[q] = pk2(S[2 * q] * inv - me[2 * q], S[2 * q + 1] * inv - me[2 * q + 1]);
            *(u32x4*)(POOL + (size_t)(base + t) * 512 + ch * 8) = o;
            if (t + hw < Lb) { float x[8]; ld8(src + (size_t)(t + hw) * 512, x);
#pragma unroll
                for (int q = 0; q < 8; ++q) S[q] += x[q]; }
            if (t - hw >= 0) { float x[8]; ld8(src + (size_t)(t - hw) * 512, x);
#pragma unroll
                for (int q = 0; q < 8; ++q) S[q] -= x[q]; } }
    }
}

__device__ __forceinline__ int block_sum_i(int v, LAS int* sm, int tid) {
    v = wave_sum_i(v);
    __syncthreads();
    if ((tid & 63) == 0) sm[tid >> 6] = v;
    __syncthreads();
    int s = 0;
#pragma unroll
    for (int i = 0; i < 8; ++i) s += sm[i];
    return s;
}
__device__ __forceinline__ int block_excl_scan(int v, LAS int* sm, int tid, int& total) {
    const int lane = tid & 63, w = tid >> 6; int inc = v;
#pragma unroll
    for (int o = 1; o < 64; o <<= 1) { const int t = __builtin_amdgcn_ds_bpermute(((lane - o) & 63) << 2, inc); if (lane >= o) inc += t; }
    __syncthreads();
    if (lane == 63) sm[w] = inc;
    __syncthreads();
    int base = 0; total = 0;
#pragma unroll
    for (int i = 0; i < 8; ++i) { const int s = sm[i]; if (i < w) base += s; total += s; }
    return base + inc - v;
}
template <int NPT>
__device__ __forceinline__ void topk_pair(Frame& F, int row0, int n, int cap, int e, int slot0) {
    LAS int* sm = (LAS int*)F.lds;
    const float* AFF = WSP(float, WS_AFF); int* SROW = WSP(int, WS_SROW); float* SG = WSP(float, WS_SGATE); int* SEL = WSP(int, WS_SEL);
    unsigned key[NPT];
#pragma unroll
    for (int j = 0; j < NPT; ++j) { const int i = F.tid * NPT + j; key[j] = (i < n) ? __float_as_uint(AFF[(size_t)(row0 + i) * 16 + e]) : 0u; }
    unsigned T = 0u;
    for (int bit = 30; bit >= 0; --bit) { const unsigned cand = T | (1u << bit); int cnt = 0;
#pragma unroll
        for (int j = 0; j < NPT; ++j) cnt += (key[j] >= cand) ? 1 : 0;
        cnt = block_sum_i(cnt, sm, F.tid);
        if (cnt >= cap) T = cand; }
    int ngt = 0, neq = 0;
#pragma unroll
    for (int j = 0; j < NPT; ++j) { ngt += (key[j] > T) ? 1 : 0; neq += (key[j] == T) ? 1 : 0; }
    int tot_gt, tot_eq;
    (void)block_excl_scan(ngt, sm, F.tid, tot_gt);
    int eqr = block_excl_scan(neq, sm, F.tid, tot_eq);
    const int need_eq = cap - tot_gt;
    int nsel = 0; bool selj[NPT];
#pragma unroll
    for (int j = 0; j < NPT; ++j) { bool s = key[j] > T; if (key[j] == T && T != 0u) { s = eqr < need_eq; ++eqr; } selj[j] = s; nsel += s ? 1 : 0; }
    int tot_sel; int pos = block_excl_scan(nsel, sm, F.tid, tot_sel);
#pragma unroll
    for (int j = 0; j < NPT; ++j) { const int i = F.tid * NPT + j;
        if (i < n) { const int row = row0 + i;
            if (selj[j]) { const int slot = slot0 + pos; ++pos; SROW[slot] = row; SG[slot] = __uint_as_float(key[j]); SEL[(size_t)row * 16 + e] = slot; }
            else SEL[(size_t)row * 16 + e] = -1; } }
    __syncthreads();
}
__device__ __forceinline__ void p_topk(Frame& F, bool with_ctx) {
    const int npairs = 128 + (with_ctx ? 128 : 0);
    for (int pi = F.bid; pi < npairs; pi += F.G) {
        if (pi < 128) { const int b = pi >> 4, e = pi & 15; topk_pair<8>(F, b * SEQ, SEQ, CAPL, e, e * SLOT_E + b * CAPL); }
        else { const int p2 = pi - 128, b = p2 >> 4, e = p2 & 15; topk_pair<1>(F, RL + b * CTXL, CTXL, CAPC, e, e * SLOT_E + 4096 + b * CAPC); }
    }
}
template <int PH> __global__ void __launch_bounds__(NTHREADS, 2) fwd_kernel(Params P) {
    extern __shared__ __attribute__((aligned(16))) unsigned char lds_raw[];
    Frame F; F.lds = (LAS unsigned char*)lds_raw; F.tid = threadIdx.x; F.lane = F.tid & 63; F.wave = __builtin_amdgcn_readfirstlane(F.tid >> 6); F.G = gridDim.x; F.bid = blockIdx.x; F.ws = P.ws;
    const int wave0 = __builtin_amdgcn_readfirstlane((int)threadIdx.x >> 6);
    volatile LAS unsigned* MISC = (volatile LAS unsigned*)(F.lds + LDS_MISC);
    if (F.tid < 64) MISC[F.tid] = 0u;
    __syncthreads();
    XcdBarrier bar; bar.bar = WSP(unsigned, WS_CTL) + CW_BAR; bar.x = 0; bar.st = MISC + 8;
    if constexpr (PH < 0) bar = xcd_barrier_post(WSP(unsigned, WS_CTL) + CW_BAR, MISC + 8);
#define IN(k) (PH < 0 || PH == (k))
#define REFRESH() do { unsigned on_ = ~0u; asm volatile("" : "+s"(on_)); int t_ = wave0 * 64 + (int)__builtin_amdgcn_mbcnt_hi(on_, __builtin_amdgcn_mbcnt_lo(on_, 0u)); asm volatile("" : "+v"(t_)); F.tid = t_; F.lane = t_ & 63; F.wave = __builtin_amdgcn_readfirstlane(t_ >> 6); } while (0)
#define SEAM(k) do { if constexpr (PH < 0) xcd_barrier(bar); } while (0)

    if (IN(0)) { REP_BEGIN(100) p_mod(P, F); p_dftgen(F); REP_END REP_BEGIN(101) p_wconv(P, F, 0); REP_END }
    SEAM(0);
    if (IN(1)) { p_rowpass_a0(P, F); }
    SEAM(1);
    for (int l = P.l_lo; l < P.l_hi; ++l) {
        constexpr int pb = 2; const bool L0 = (l == 0);
        bf16* H = WSP(bf16, WS_H);
        if (IN(pb + 0)) { REFRESH(); REP_BEGIN(2)
            { GroupSched S; S.init(1, 128, 22, F.G, F.bid, 8, L0 ? 22 : 4, 128, 0);
              const bf16* WA = WSP(bf16, WS_WA);
              auto AD = [=](const Unit& u) { return Operands{H + (size_t)u.pm * 256 * DM, WA + (size_t)u.pn * 256 * DM, DM, DM, 0, DM}; };
              bf16* KQ = WSP(bf16, WS_KQ); bf16* PBp = WSP(bf16, WS_PB); bf16* GB = WSP(bf16, WS_GB);
              auto E = [=](EPI_ARGS) { const int row0 = u.pm * 256;
                  if (u.pn < 8) { const float qs = (u.pn >= 4) ? QSCALE : 1.0f; EPI_FOR8( st_bf8(KQ + (size_t)(row0 + r) * 2048 + u.pn * 256 + c, v0 * qs, v1 * qs); ) }
                  else if (u.pn < 10) { EPI_FOR8( st_bf8(PBp + (size_t)(row0 + r) * 512 + (u.pn - 8) * 256 + c, v0, v1); ) }
                  else { EPI_FOR8( f32x4 s0; f32x4 s1; _Pragma("unroll") for (int j = 0; j < 4; ++j) { s0[j] = sigmoidf_(v0[j]); s1[j] = sigmoidf_(v1[j]); } st_bf8(GB + (size_t)(row0 + r) * 3072 + (u.pn - 10) * 256 + c, s0, s1); ) } };
              GEMM_P(S, AD, E); }
            REFRESH();
            { GroupSched S; const int g1a_units = 128 * 22 + 8 * (L0 ? 22 : 4);
              S.init(1, 8, 128, F.G, (F.bid + F.G - ((g1a_units % F.G) & ~7)) % F.G, L0 ? 8 : 4, 8, L0 ? 0 : 4, 128);
              const bf16* WFV = WSP(bf16, WS_WFV);
              auto AD = [=](const Unit& u) { const bool fmap = (u.pm < 4) && (u.pn < 128); const int t16 = u.pn & 15;
                  const size_t tok0 = fmap ? (size_t)(u.pn >> 4) * SEQ + 64 * ((t16 >> 1) * 8) + (t16 & 1) * 32 : (size_t)u.pn * 256;
                  return Operands{WFV + (size_t)u.pm * 256 * DM, H + tok0 * DM, DM, DM, 0, DM, fmap ? 1 : 0}; };
              bf16* YT = WSP(bf16, WS_YT); bf16* VT = WSP(bf16, WS_VT);
              auto E = [=](EPI_ARGS) { bf16* T = (u.pm < 4) ? YT : VT; const int rr0 = (u.pm & 3) * 256;
                  if (u.pn < 128) { const int b = u.pn >> 4;
                      if (u.pm < 4) { const int t16 = u.pn & 15, l10 = (t16 >> 1) * 8, l20 = (t16 & 1) * 32;
                          EPI_FOR8( const int fc = rr0 + r; st_bf8(T + (((((size_t)b * 512 + (fc >> 1)) * 32 + (c >> 3)) * 2 + (l20 >> 5)) * 2 + (fc & 1)) * 64 + l10, v0, v1); ) }
                      else { const int l0 = (u.pn & 15) * 256; EPI_FOR8( st_bf8(T + ((size_t)b * 1024 + rr0 + r) * 4096 + l0 + c, v0, v1); ) } }
                  else { const int b = u.pn - 128; EPI_FOR8( st_bf8(T + YT_CTX_OFF + ((size_t)b * 1024 + rr0 + r) * 256 + c, v0, v1); ) } };
              GEMM_P(S, AD, E); }
        REP_END }
        SEAM(pb + 0);
        if (IN(pb + 1)) { REFRESH();
            { const int nc0 = (F.G * 5 / 16) & ~7, nconv = nc0 > 0 ? nc0 : 1, na = F.G - nconv;
              if (F.bid < na) p_attn_mfma(P, F, l, L0, na, F.bid);
              else wconv_experts(P, F, l, F.bid - na, nconv); }
            REFRESH();
            REP_BEGIN(32)
            { LAS float* tw = (LAS float*)(F.lds + LDS_TW);
              for (int j = F.tid; j < 4096; j += NTHREADS) tw[j] = cospif((float)j * (1.0f / 2048.0f));
              __syncthreads();
              GroupSched S; S.init(1, 1, 512, F.G, F.bid);
              const bf16* M1 = WSP(bf16, WS_M1T); const bf16* YF = WSP(bf16, WS_YT); bf16* ZP = WSP(bf16, WS_ZP);
              auto AD = [=](const Unit& u) { return Operands{M1, YF + (size_t)u.pn * 256 * 256, 256, 256, 0, 256}; };
              auto E = [=](EPI_ARGS) {
                  const int b = u.pn >> 6, gm0 = (u.pn & 63) * 8 + wc, l20 = 32 * wr + 8 * fq;
#pragma unroll
                  for (int m = 0; m < 4; ++m) { const int k1 = 16 * m + fr;
#pragma unroll
                      for (int bj = 0; bj < 2; ++bj) { const int gm = gm0 + 4 * bj;
                          f32x4 zr[2], zi[2];
#pragma unroll
                          for (int n = 0; n < 2; ++n)
#pragma unroll
                              for (int j = 0; j < 4; ++j) { const int ix = k1 * (l20 + 4 * n + j); const float tc = tw[ix], ts = tw[(ix + 3072) & 4095];
                                  const float ur = acc[0][bj][m][n][j], ui = acc[1][bj][m][n][j]; zr[n][j] = ur * tc - ui * ts; zi[n][j] = ur * ts + ui * tc; }
                          bf16* dst = ZP + (((((size_t)b * 64 + k1) * 128 + (gm & 127)) * 4 + (gm >> 7)) * 2) * 64 + l20;
                          st_bf8(dst, zr[0], zr[1]); st_bf8(dst + 64, zi[0], zi[1]); } } };
              GEMM_P(S, AD, E); }
            REP_END
        }
        SEAM(pb + 1);
        if (IN(pb + 10)) { REFRESH();
            { GroupSched S; S.init(1, 1, 256, F.G, F.bid);
              const bf16* M2 = WSP(bf16, WS_M2T); const bf16* ZP = WSP(bf16, WS_ZP); bf16* FOUR = WSP(bf16, WS_FOUR);
              auto AD = [=](const Unit& u) { return Operands{M2, ZP + (size_t)u.pn * 256 * 512, 512, 512, 0, 512}; };
              auto E = [=](EPI_ARGS) { const float sc = 0.0013810679320049757f;
#pragma unroll
                  for (int ai = 0; ai < 2; ++ai)
#pragma unroll
                      for (int m = 0; m < 4; ++m) { const int q = 2 * ai + wr, k2 = 16 * m + fr;
#pragma unroll
                          for (int bj = 0; bj < 2; ++bj) { const int bk = u.pn * 2 + bj, b = bk >> 6, k1 = bk & 63;
                              st_bf8(FOUR + ((size_t)b * SEQ + k1 + 64 * k2) * 512 + q * 128 + wc * 32 + 8 * fq, acc[ai][bj][m][0] * sc, acc[ai][bj][m][1] * sc); } } };
              GEMM_P(S, AD, E); }
            REFRESH();
            if (L0) { GroupSched S; S.init(1, 1, 16, F.G, (F.bid + F.G - 128 % F.G) % F.G);
              const bf16* DFTC = WSP(bf16, WS_DFTC); const bf16* YTC = WSP(bf16, WS_YT) + YT_CTX_OFF; bf16* FOUR = WSP(bf16, WS_FOUR);
              auto AD = [=](const Unit& u) { return Operands{DFTC, YTC + (size_t)u.pn * 256 * 512, 512, 512, 0, 512}; };
              auto E = [=](EPI_ARGS) { const int b = u.pn >> 1, c0 = (u.pn & 1) * 256; const float sc = 0.005524271728019903f;
                  EPI_FOR8( st_bf8(FOUR + ((size_t)RL + b * CTXL + r) * 512 + c0 + c, v0 * sc, v1 * sc); ) };
              GEMM_P(S, AD, E); }
            REFRESH();
            REP_BEGIN(33) p_pool(F, L0 ? RT : RL); REP_END
        }
        SEAM(pb + 10);
        if (IN(pb + 2)) { REFRESH();
            SegSched<3> S; S.base.init(1, L0 ? 136 : 128, 4, F.G, F.bid);
            const bf16* ATT = WSP(bf16, WS_ATT); const bf16* FOUR = WSP(bf16, WS_FOUR); const bf16* POOL = WSP(bf16, WS_POOL);
            const bf16* WAO = WSP(bf16, WS_WAO); const bf16* WFO = WSP(bf16, WS_WFO); const bf16* WPO = WSP(bf16, WS_WPO);
            const bf16* GB = WSP(bf16, WS_GB); bf16* MRGB = WSP(bf16, WS_MRGB); const float* ps = P.pool_scale + l * 1024;
            auto AD = [=](const Unit& u) {
                if (u.seg == 0) return Operands{ATT + (size_t)u.pm * 256 * 1024, WAO + (size_t)u.pn * 256 * 1024, 1024, 1024, 0, 1024};
                if (u.seg == 1) return Operands{FOUR + (size_t)u.pm * 256 * 512, WFO + (size_t)u.pn * 256 * 512, 512, 512, 0, 512};
                return Operands{POOL + (size_t)u.pm * 256 * 512 + (u.pn >> 1) * 256, WPO + (size_t)u.pn * 256 * 256, 512, 256, 0, 256}; };
            auto E = [=](EPI_ARGS) {
                const int kd = u.seg < 2 ? u.seg + 1 : 2; const bool fin = (u.seg == 2); const int colb = u.pn * 256 + wc * 32 + 8 * fq;
#pragma unroll
                for (int ai = 0; ai < 2; ++ai)
#pragma unroll
                    for (int m = 0; m < 4; ++m) { const size_t row = (size_t)u.pm * 256 + ai * 128 + wr * 64 + m * 16 + fr; const bf16* gr = GB + row * 3072 + colb;
                        u32x4 nr[2], dr[2]; f32x4 psv[2][2];
#pragma unroll
                        for (int bj = 0; bj < 2; ++bj) { nr[bj] = *(const u32x4*)(gr + u.seg * 1024 + bj * 128); dr[bj] = *(const u32x4*)(gr + kd * 1024 + bj * 128);
                            psv[bj][0] = *(const f32x4*)(ps + colb + bj * 128); psv[bj][1] = *(const f32x4*)(ps + colb + bj * 128 + 4); }
#pragma unroll
                        for (int bj = 0; bj < 2; ++bj) { f32x4 o[2];
#pragma unroll
                            for (int n = 0; n < 2; ++n) { f32x4 nu = {bflo(nr[bj][2 * n]), bfhi(nr[bj][2 * n]), bflo(nr[bj][2 * n + 1]), bfhi(nr[bj][2 * n + 1])}, de = {bflo(dr[bj][2 * n]), bfhi(dr[bj][2 * n]), bflo(dr[bj][2 * n + 1]), bfhi(dr[bj][2 * n + 1])};
                                if (u.seg == 2) nu = nu * psv[bj][n];
                                de = de * psv[bj][n];
#pragma unroll
                                for (int j = 0; j < 4; ++j) { const float nj = (fabsf(nu[j]) < 1e-30f) ? copysignf(1e-30f, nu[j]) : nu[j]; const float dj = (fabsf(de[j]) < 1e-30f) ? copysignf(1e-30f, de[j]) : de[j];
                                    o[n][j] = acc[ai][bj][m][n][j] * nj * (fin ? 1.0f : __builtin_amdgcn_rcpf(dj)); }
                                acc[ai][bj][m][n] = o[n]; }
                            if (fin) st_bf8(MRGB + row * 1024 + colb + bj * 128, o[0], o[1]); } } };
            gemm_fast<false, true, false>(F.lds, F.tid, S, AD, mk_epi_seg(E, 2), nullptr);
        }
        SEAM(pb + 2);
        if (IN(pb + 3)) { REFRESH();
            GroupSched S; S.init(1, L0 ? 136 : 128, 4, F.G, F.bid); const bf16* A = WSP(bf16, WS_MRGB); const bf16* W = WSP(bf16, WS_WOUT);
            const float* xin = L0 ? P.x : P.out; const float* cin = L0 ? P.ctx : WSP(float, WS_XC); float* xo = P.out; float* co = WSP(float, WS_XC);
            const float* MOD = WSP(float, WS_MOD) + (size_t)l * 9 * 6144;
            auto AD = [=](const Unit& u) { return Operands{A + (size_t)u.pm * 256 * 1024, W + (size_t)u.pn * 256 * 1024, 1024, 1024, 0, 1024}; };
            auto E = [=](EPI_ARGS) {
                const int row0 = u.pm * 256, mr = row0 < RL ? (row0 >> 12) : 8, colb = u.pn * 256 + wc * 32 + 4 * fq;
                const float* src0 = row0 < RL ? xin + (size_t)row0 * DM : cin + (size_t)(row0 - RL) * DM; float* dst0 = row0 < RL ? xo + (size_t)row0 * DM : co + (size_t)(row0 - RL) * DM;
                f32x4 gv[2][2];
#pragma unroll
                for (int bj = 0; bj < 2; ++bj)
#pragma unroll
                    for (int n = 0; n < 2; ++n) gv[bj][n] = *(const f32x4*)(MOD + (size_t)mr * 6144 + 2048 + colb + bj * 128 + n * 16);
#pragma unroll
                for (int ai = 0; ai < 2; ++ai) { f32x4 xv[4][2][2];
#pragma unroll
                    for (int m = 0; m < 4; ++m) { const size_t ro = (size_t)(ai * 128 + wr * 64 + m * 16 + fr) * DM + colb;
#pragma unroll
                        for (int bj = 0; bj < 2; ++bj)
#pragma unroll
                            for (int n = 0; n < 2; ++n) xv[m][bj][n] = *(const f32x4*)(src0 + ro + bj * 128 + n * 16); }
#pragma unroll
                    for (int m = 0; m < 4; ++m) { const size_t ro = (size_t)(ai * 128 + wr * 64 + m * 16 + fr) * DM + colb;
#pragma unroll
                        for (int bj = 0; bj < 2; ++bj)
#pragma unroll
                            for (int n = 0; n < 2; ++n) *(f32x4*)(dst0 + ro + bj * 128 + n * 16) = xv[m][bj][n] + gv[bj][n] * acc[ai][bj][m][n]; } } };
            GEMM(S, AD, E, 1024, 1024, 1024);
        }
        SEAM(pb + 3);
        if (IN(pb + 4)) { REFRESH(); REP_BEGIN(6) p_rowpass_f(P, F, l, L0 ? RT : RL); REP_END }
        SEAM(pb + 4);
        if (IN(pb + 5)) { REFRESH(); REP_BEGIN(7) p_topk(F, L0); REP_END }
        SEAM(pb + 5);
        if (IN(pb + 7)) { REFRESH(); REP_BEGIN(9)
            GroupSched S; S.init(16, L0 ? 17 : 16, 22, F.G, F.bid); const bf16* H8 = WSP(bf16, WS_H8); const bf16* W = WSP(bf16, WS_WGU); unsigned char* HID = WSP(unsigned char, WS_HID); const int* SROW = WSP(int, WS_SROW);
            auto AD = [=](const Unit& u) { return Operands{H8, W + ((size_t)u.grp * 5632 + u.pn * 256) * 512, 512, 512, u.grp * SLOT_E + u.pm * 256, 512}; };
            auto E = [=](EPI_ARGS) {
#pragma unroll
                for (int ai = 0; ai < 2; ++ai)
#pragma unroll
                    for (int m = 0; m < 4; ++m) { const size_t slot = (size_t)u.grp * SLOT_E + u.pm * 256 + ai * 128 + wr * 64 + m * 16 + fr; f32x4 o[2];
#pragma unroll
                        for (int n = 0; n < 2; ++n) { const f32x4 a = acc[ai][0][m][n] * INV8, up = acc[ai][1][m][n] * (INV8 * A8S);
#pragma unroll
                            for (int j = 0; j < 4; ++j) o[n][j] = a[j] * sigmoidf_(a[j]) * up[j]; }
                        u32x2 w; w.x = pk4_fp8(o[0][0], o[0][1], o[0][2], o[0][3]); w.y = pk4_fp8(o[1][0], o[1][1], o[1][2], o[1][3]);
                        *(u32x2*)(HID + slot * FF + u.pn * 128 + wc * 32 + 8 * fq) = w; } };
            GEMM_GATHER8(S, AD, E, SROW);
        REP_END }
        SEAM(pb + 7);
        if (IN(pb + 8)) { REFRESH(); REP_BEGIN(10)
            const int tpe = L0 ? 17 : 16;
            GroupSched S; S.init(1, 16 * tpe, 4, F.G, F.bid); const bf16* HID = WSP(bf16, WS_HID); const bf16* W = WSP(bf16, WS_WD); bf16* Y = WSP(bf16, WS_Y); const float* SG = WSP(float, WS_SGATE);
            auto AD = [=](const Unit& u) { const int e = u.pm / tpe, st = e * 17 + (u.pm - e * tpe); return Operands{HID + (size_t)st * 256 * (FF / 2), W + ((size_t)e * 1024 + u.pn * 256) * (FF / 2), FF / 2, FF / 2, 0, FF / 2}; };
            auto E = [=](EPI_ARGS) { const int e = u.pm / tpe; const size_t slot0 = (size_t)(e * 17 + (u.pm - e * tpe)) * 256 + wr * 64 + fr; float gt[2][4];
#pragma unroll
                for (int ai = 0; ai < 2; ++ai)
#pragma unroll
                    for (int m = 0; m < 4; ++m) gt[ai][m] = SG[slot0 + ai * 128 + m * 16] * INV8;
#pragma unroll
                for (int ai = 0; ai < 2; ++ai)
#pragma unroll
                    for (int m = 0; m < 4; ++m)
#pragma unroll
                        for (int bj = 0; bj < 2; ++bj) st_bf8(Y + (slot0 + ai * 128 + m * 16) * DM + u.pn * 256 + bj * 128 + wc * 32 + 8 * fq, acc[ai][bj][m][0] * gt[ai][m], acc[ai][bj][m][1] * gt[ai][m]); };
            GEMM_P8(S, AD, E);
        REP_END }
        SEAM(pb + 8);
        if (IN(pb + 9)) { REFRESH(); p_rowpass_k(P, F, l, L0 ? RT : RL); if (L0) p_wconv(P, F, 1); }
        if (L0) SEAM(pb + 9);
    }
#undef IN
#undef SEAM
}
template <int PH> static void launch_ph(int grid, const Params& p, hipStream_t stream) { hipLaunchKernelGGL(fwd_kernel<PH>, dim3(grid), dim3(NTHREADS), LDS_BYTES, stream, p); }
template <int PH> static bool set_attr() { return hipFuncSetAttribute((const void*)fwd_kernel<PH>, hipFuncAttributeMaxDynamicSharedMemorySize, LDS_BYTES) == hipSuccess; }

#ifndef DUP_LAUNCH
#define DUP_LAUNCH -1
#endif
extern "C" void kernel_launch(void* const* d_in, const int* in_sizes, int n_in, void* d_out, int out_size, void* d_ws, size_t ws_size, hipStream_t stream) {
    static int grid = 0;
    if (grid == 0) {
        if (n_in != 20 || out_size != RL * DM || ws_size < WS_END) { fprintf(stderr, "kernel_launch: unexpected shapes (n_in %d out %d ws %zu need %zu)\n", n_in, out_size, ws_size, (size_t)WS_END); grid = -1; return; }
        int dev = 0, cus = 0, per_cu = 0;
        if (hipGetDevice(&dev) != hipSuccess || hipDeviceGetAttribute(&cus, hipDeviceAttributeMultiprocessorCount, dev) != hipSuccess) { grid = -1; return; }
#if N_LAUNCH_MODE == 1
        if (!set_attr<-1>()) { fprintf(stderr, "kernel_launch: hipFuncSetAttribute failed\n"); grid = -1; return; }
        if (hipOccupancyMaxActiveBlocksPerMultiprocessor(&per_cu, (const void*)fwd_kernel<-1>, NTHREADS, LDS_BYTES) != hipSuccess || per_cu < 1) fprintf(stderr, "kernel_launch: occupancy query reports %d\n", per_cu);
#else
        if (!(set_attr<0>() && set_attr<1>() && set_attr<2>() && set_attr<3>() && set_attr<12>() && set_attr<4>() && set_attr<5>() && set_attr<6>() && set_attr<7>() && set_attr<9>() && set_attr<10>() && set_attr<11>())) { fprintf(stderr, "kernel_launch: hipFuncSetAttribute failed\n"); grid = -1; return; }
        (void)per_cu;
#endif
        (void)hipGetLastError();
        grid = cus;
    }
    if (grid < 0) return;
    if (hipMemsetAsync((char*)d_ws + WS_CTL, 0, CTL_BYTES, stream) != hipSuccess) return;
    Params p{};
    const float** pp = (const float**)&p;
    for (int i = 0; i < 20; ++i) pp[i] = (const float*)d_in[i];
    p.out = (float*)d_out; p.ws = (unsigned char*)d_ws;
#if N_LAUNCH_MODE == 1
    p.l_lo = 0; p.l_hi = 2;
    launch_ph<-1>(grid, p, stream);
#else
    p.l_lo = 0; p.l_hi = 0; launch_ph<0>(grid, p, stream); if (DUP_LAUNCH == 0) launch_ph<0>(grid, p, stream); launch_ph<1>(grid, p, stream); if (DUP_LAUNCH == 1) launch_ph<1>(grid, p, stream);
#define LP(k) do { launch_ph<k>(grid, p, stream); if (DUP_LAUNCH == (k) && l == 0) launch_ph<k>(grid, p, stream); } while (0)
    for (int l = 0; l < 2; ++l) { p.l_lo = l; p.l_hi = l + 1;
        LP(2); LP(3); LP(12); LP(4); LP(5); LP(6); LP(7); LP(9); LP(10); LP(11); }
#endif
}
```

```cpp
#include <hip/hip_runtime.h>
#include <cstdio>
#include <cstdint>

#ifndef N_LAUNCH_MODE
#define N_LAUNCH_MODE 1
#endif

#define GAS __attribute__((address_space(1)))
#define LAS __attribute__((address_space(3)))
typedef unsigned short bf16;
typedef short bf16x8 __attribute__((ext_vector_type(8)));
typedef float f32x4 __attribute__((ext_vector_type(4)));
typedef unsigned u32x4 __attribute__((ext_vector_type(4)));
typedef unsigned u32x2 __attribute__((ext_vector_type(2)));

constexpr int NB = 8, SEQ = 4096, DM = 1024, CTXL = 256, NH = 16, HD = 64, GRIDW = 64;
constexpr int RL = NB * SEQ, RC = NB * CTXL, RT = RL + RC;
constexpr int INW = 7168, NE = 16, FF = 2816, CAPL = 512, CAPC = 32;
constexpr int SLOT_E = 4352, NSLOT = NE * SLOT_E;
constexpr float RMS_EPS = 1e-6f;
constexpr float LOG2E = 1.4426950408889634f, QSCALE = 0.125f * LOG2E;
constexpr float A8S = 8.0f, W8S = 64.0f, INV8 = 1.0f / (A8S * W8S);
constexpr int NWAVES = 8, NTHREADS = 512;

constexpr size_t al256(size_t x) { return (x + 255) & ~(size_t)255; }
constexpr size_t WS_CTL = 0, CTL_BYTES = 1u << 20;
constexpr size_t WS_MOD = WS_CTL + CTL_BYTES;
constexpr size_t WS_XC = al256(WS_MOD + (size_t)2 * 9 * 6144 * 4);
constexpr size_t WS_AFF = al256(WS_XC + (size_t)RC * DM * 4);
constexpr size_t WS_SROW = al256(WS_AFF + (size_t)RT * 16 * 4);
constexpr size_t WS_SGATE = al256(WS_SROW + (size_t)NSLOT * 4);
constexpr size_t WS_SEL = al256(WS_SGATE + (size_t)NSLOT * 4);
constexpr size_t WS_DFTM = al256(WS_SEL + (size_t)RT * 16 * 4);
constexpr size_t WS_DFTC = al256(WS_DFTM + (size_t)4096 * 8192 * 2);
constexpr size_t WS_WA = al256(WS_DFTC + (size_t)256 * 512 * 2);
constexpr size_t WS_WFV = al256(WS_WA + (size_t)5632 * 1024 * 2);
constexpr size_t WS_WAO = al256(WS_WFV + (size_t)2048 * 1024 * 2);
constexpr size_t WS_WFO = al256(WS_WAO + (size_t)1024 * 1024 * 2);
constexpr size_t WS_WPO = al256(WS_WFO + (size_t)1024 * 512 * 2);
constexpr size_t WS_WOUT = al256(WS_WPO + (size_t)1024 * 256 * 2);
constexpr size_t WS_WGU = al256(WS_WOUT + (size_t)1024 * 1024 * 2);
constexpr size_t WS_WD = al256(WS_WGU + (size_t)16 * 5632 * 1024);
constexpr size_t WS_WA8 = al256(WS_WD + (size_t)16 * 1024 * 2816);
constexpr size_t WS_H = al256(WS_WA8 + (size_t)3072 * 1024);
constexpr size_t WS_H8 = al256(WS_H + (size_t)RT * DM * 2);
constexpr size_t WS_R = al256(WS_H8 + (size_t)RT * DM);
constexpr size_t WS_KQ = WS_R;
constexpr size_t WS_MRG = WS_KQ;
constexpr size_t WS_PB = al256(WS_KQ + (size_t)RT * 2048 * 2);
constexpr size_t WS_GB = al256(WS_PB + (size_t)RT * 512 * 2);
constexpr size_t WS_YT = al256(WS_GB + (size_t)RT * 3072 * 2);
constexpr size_t WS_MRGB = WS_YT;
constexpr size_t WS_VT = al256(WS_YT + (size_t)RT * 1024 * 2);
constexpr size_t WS_FOUR = al256(WS_VT + (size_t)RT * 1024 * 2);
constexpr size_t WS_ATT = al256(WS_FOUR + (size_t)RT * 512 * 2);
constexpr size_t WS_POOL = al256(WS_ATT + (size_t)RT * 1024 * 2);
constexpr size_t WS_MIX_END = al256(WS_POOL + (size_t)RT * 512 * 2);
constexpr size_t WS_XG = WS_R;
constexpr size_t WS_HID = al256(WS_XG + (size_t)NSLOT * 1024 * 2);
constexpr size_t WS_Y = al256(WS_HID + (size_t)NSLOT * 2816);
constexpr size_t WS_MOE_END = al256(WS_Y + (size_t)NSLOT * 1024 * 2);
constexpr size_t WS_END0 = WS_MIX_END > WS_MOE_END ? WS_MIX_END : WS_MOE_END;
constexpr size_t WS_ZP = WS_END0;
constexpr size_t WS_M1T = al256(WS_ZP + ((size_t)8 * 64 * 512 * 128 + 1024) * 2);
constexpr size_t WS_M2T = al256(WS_M1T + (size_t)256 * 256 * 2);
constexpr size_t WS_END = al256(WS_M2T + (size_t)256 * 512 * 2);
constexpr size_t YT_CTX_OFF = (size_t)8 * 1024 * 4096;

constexpr int CW_BAR = 4096;

constexpr int LDS_BYTES = 155648;
constexpr int LDS_TW = 132096;
constexpr int LDS_MISC = 131072;

__device__ __forceinline__ unsigned f2bf(float f) { unsigned u = __float_as_uint(f); return (u + 0x7fffu + ((u >> 16) & 1u)) >> 16; }
typedef __bf16 hbf16x2 __attribute__((ext_vector_type(2)));
typedef float f32x2 __attribute__((ext_vector_type(2)));
__device__ __forceinline__ unsigned pk2(float lo, float hi) { const f32x2 v = {lo, hi}; return __builtin_bit_cast(unsigned, __builtin_convertvector(v, hbf16x2)); }
__device__ __forceinline__ unsigned pk4_fp8(float a, float b, float c, float d) {
    a = __builtin_amdgcn_fmed3f(a, -448.f, 448.f); b = __builtin_amdgcn_fmed3f(b, -448.f, 448.f); c = __builtin_amdgcn_fmed3f(c, -448.f, 448.f); d = __builtin_amdgcn_fmed3f(d, -448.f, 448.f);
    int w = 0; w = __builtin_amdgcn_cvt_pk_fp8_f32(a, b, w, false); w = __builtin_amdgcn_cvt_pk_fp8_f32(c, d, w, true); return (unsigned)w; }
__device__ __forceinline__ float bf2f(unsigned b) { return __uint_as_float(b << 16); }
__device__ __forceinline__ float bflo(unsigned w) { return __uint_as_float(w << 16); }
__device__ __forceinline__ float bfhi(unsigned w) { return __uint_as_float(w & 0xffff0000u); }
template <int CTRL> __device__ __forceinline__ float dppf(float x) { return __builtin_bit_cast(float, __builtin_amdgcn_mov_dpp(__builtin_bit_cast(int, x), CTRL, 0xf, 0xf, true)); }
template <int CTRL> __device__ __forceinline__ int dppi(int x) { return __builtin_amdgcn_mov_dpp(x, CTRL, 0xf, 0xf, true); }
constexpr int DPP_XOR1 = 0xB1, DPP_XOR2 = 0x4E, DPP_ROR4 = 0x124, DPP_ROR8 = 0x128;
__device__ __forceinline__ float wave_sum(float v) {
    v += dppf<DPP_XOR1>(v); v += dppf<DPP_XOR2>(v); v += dppf<DPP_ROR4>(v); v += dppf<DPP_ROR8>(v);
    auto s = __builtin_amdgcn_permlane16_swap(__float_as_uint(v), __float_as_uint(v), false, false); v = __uint_as_float(s[0]) + __uint_as_float(s[1]);
    auto t = __builtin_amdgcn_permlane32_swap(__float_as_uint(v), __float_as_uint(v), false, false); return __uint_as_float(t[0]) + __uint_as_float(t[1]);
}
__device__ __forceinline__ float wave_max(float v) {
    v = fmaxf(v, dppf<DPP_XOR1>(v)); v = fmaxf(v, dppf<DPP_XOR2>(v)); v = fmaxf(v, dppf<DPP_ROR4>(v)); v = fmaxf(v, dppf<DPP_ROR8>(v));
    auto s = __builtin_amdgcn_permlane16_swap(__float_as_uint(v), __float_as_uint(v), false, false); v = fmaxf(__uint_as_float(s[0]), __uint_as_float(s[1]));
    auto t = __builtin_amdgcn_permlane32_swap(__float_as_uint(v), __float_as_uint(v), false, false); return fmaxf(__uint_as_float(t[0]), __uint_as_float(t[1]));
}
__device__ __forceinline__ int wave_sum_i(int v) {
    v += dppi<DPP_XOR1>(v); v += dppi<DPP_XOR2>(v); v += dppi<DPP_ROR4>(v); v += dppi<DPP_ROR8>(v);
    auto s = __builtin_amdgcn_permlane16_swap((unsigned)v, (unsigned)v, false, false); v = (int)(s[0] + s[1]);
    auto t = __builtin_amdgcn_permlane32_swap((unsigned)v, (unsigned)v, false, false); return (int)(t[0] + t[1]);
}
__device__ __forceinline__ float sigmoidf_(float x) { return __builtin_amdgcn_rcpf(1.f + __builtin_amdgcn_exp2f(x * -1.4426950408889634f)); }
#define LDS_WAIT() asm volatile("s_waitcnt lgkmcnt(0)" ::: "memory")

#define XB_TMO      128
#define XB_XCNT(j)  (256  + 64 * (j))
#define XB_XSUB(j)  (1280 + 64 * (j))
#define XB_XGEN(j)  (2304 + 64 * (j))
#define XB_TOP      3328
#define XB_TOPGEN   3392
#define XCD_BAR_WORDS 3456
#define XB_SPIN_CAP (1u << 22)

__device__ __forceinline__ unsigned xb_ld(unsigned* p)              { return __hip_atomic_load(p, __ATOMIC_RELAXED, __HIP_MEMORY_SCOPE_AGENT); }
__device__ __forceinline__ unsigned xb_add(unsigned* p, unsigned v) { return __hip_atomic_fetch_add(p, v, __ATOMIC_RELAXED, __HIP_MEMORY_SCOPE_AGENT); }
__device__ __forceinline__ unsigned xb_xcc_id() { return (unsigned)__builtin_amdgcn_s_getreg((3 << 11) | 20) & 0xFu; }
#define XB_SPIN(cond, bar) do { unsigned _sp = 0; while (cond) { __builtin_amdgcn_s_sleep(1); \
    if ((++_sp & 255u) == 0u) { if (xb_ld(&(bar)[XB_TMO])) break; if (_sp > XB_SPIN_CAP) { atomicAdd(&(bar)[XB_TMO], 1u); break; } } } } while (0)

struct XcdBarrier { unsigned* bar; unsigned x; volatile LAS unsigned* st; };

__device__ __forceinline__ XcdBarrier xcd_barrier_post(unsigned* bar, volatile LAS unsigned* st) {
    XcdBarrier b; b.bar = bar; b.x = xb_xcc_id(); b.st = st;
    if (threadIdx.x == 0) (void)xb_add(&bar[XB_XCNT(b.x)], 1u);
    return b;
}
__device__ __forceinline__ void xcd_barrier_complete(unsigned* bar, unsigned x, unsigned& nloc, unsigned& nx) {
    const unsigned G = gridDim.x * gridDim.y * gridDim.z;
    unsigned sum, cnt, mine, sp = 0u;
    for (;;) {
        sum = 0u; cnt = 0u; mine = 0u;
#pragma unroll
        for (unsigned j = 0; j < 16; ++j) { const unsigned c = xb_ld(&bar[XB_XCNT(j)]); sum += c; cnt += (c > 0u) ? 1u : 0u; mine = (j == x) ? c : mine; }
        if (sum == G) break;
        __builtin_amdgcn_s_sleep(1);
        if ((++sp & 255u) == 0u) { if (xb_ld(&bar[XB_TMO])) break; if (sp > XB_SPIN_CAP) { atomicAdd(&bar[XB_TMO], 1u); break; } }
    }
    nloc = mine > 0u ? mine : 1u; nx = cnt > 0u ? cnt : 1u;
}
__device__ __forceinline__ void xcd_barrier(const XcdBarrier& b) {
    asm volatile("s_waitcnt vmcnt(0)" ::: "memory");
    __syncthreads();
    if (threadIdx.x == 0) {
        unsigned* bar = b.bar;
        __builtin_amdgcn_s_waitcnt(0);
        unsigned nloc = b.st[0], nx = b.st[1];
        if (nloc == 0u) { xcd_barrier_complete(bar, b.x, nloc, nx); b.st[0] = nloc; b.st[1] = nx; }
        const unsigned old = xb_add(&bar[XB_XSUB(b.x)], 1u);
        const unsigned gen = old / nloc;
        if (old + 1u == (gen + 1u) * nloc) {
            __builtin_amdgcn_fence(__ATOMIC_RELEASE, "agent");
            asm volatile("s_waitcnt vmcnt(0)" ::: "memory");
            const unsigned og = xb_add(&bar[XB_TOP], 1u);
            const unsigned tg = og / nx;
            if (og + 1u == (tg + 1u) * nx) xb_add(&bar[XB_TOPGEN], 1u);
            else XB_SPIN(xb_ld(&bar[XB_TOPGEN]) == tg, bar);
            __builtin_amdgcn_fence(__ATOMIC_ACQUIRE, "agent");
            xb_add(&bar[XB_XGEN(b.x)], 1u);
            asm volatile("s_waitcnt vmcnt(0)" ::: "memory");
        } else {
            XB_SPIN(xb_ld(&bar[XB_XGEN(b.x)]) == gen, bar);
            __builtin_amdgcn_fence(__ATOMIC_ACQUIRE, "agent");
            asm volatile("s_waitcnt vmcnt(0)" ::: "memory");
        }
    }
    __syncthreads();
}

struct Params {
    const float *x, *c, *ctx, *c_ctx, *ada_w, *ada_b, *norm1_g, *norm2_g, *w_in, *rpb, *w_att_o, *w_fourier, *w_pool, *pool_scale, *w_out, *w_router, *w_eg, *w_eu, *w_ed, *final_g;
    float* out; unsigned char* ws; int l_lo, l_hi;
};
struct Frame {
    LAS unsigned char* lds;
    int tid, lane, wave, G, bid;
    unsigned char* ws;
};
#define WSP(T, off) ((T*)(F.ws + (off)))

struct Unit { int grp, pm, pn, seg; };
struct GroupSched {
    int ng, nM, nN, G, c; int tM, tN, tpm0, tpn0;
    __device__ __forceinline__ void init(int ng_, int nM_, int nN_, int G_, int c_, int tM_ = 0, int tN_ = 0, int tpm0_ = 0, int tpn0_ = 0) { ng = ng_; nM = nM_; nN = nN_; G = G_; c = c_; tM = tM_; tN = tN_; tpm0 = tpm0_; tpn0 = tpn0_; }
    __device__ __forceinline__ bool next(int i, Unit& u) const {
        const int per = nM * nN; const int L = i * G + c;
        if (L < ng * per) {
            u.grp = L / per; int wgid = L - u.grp * per;
            { const int q = per / 8, r = per % 8, xcd = wgid % 8, off = wgid / 8; wgid = (xcd < r ? xcd * (q + 1) : r * (q + 1) + (xcd - r) * q) + off; }
            const int nig = 8 * nN, gid = wgid / nig, fm = gid * 8, gsz = (nM - fm) < 8 ? (nM - fm) : 8;
            u.pm = fm + ((wgid % nig) % gsz); u.pn = (wgid % nig) / gsz; u.seg = 0; return true;
        }
        const int w = L - ng * per;
        if (w < tM * tN) { u.grp = ng; u.pm = tpm0 + (w % tM); u.pn = tpn0 + (w / tM); u.seg = 0; return true; }
        return false;
    }
};
struct Operands { const bf16* A; const bf16* Bt; int lda, ldb, slot0, K; int bmap; };

constexpr int HTB = 128 * 64 * 2;
__device__ __forceinline__ int lds_byte(int r, int c) { const int st = (r >> 4) * 2 + (c >> 5), rr = r & 15, cc = c & 31, ob = rr * 64 + cc * 2; return st * 1024 + (ob ^ (((ob >> 9) & 1) << 5)); }
__device__ __forceinline__ int perm32(int rho) { const int n = rho >> 4, i = rho & 15; return 8 * (i >> 2) + 4 * n + (i & 3); }
__device__ __forceinline__ void stage_rc(int b, int& R, int& C) { const int st = b / 1024, sb = b % 1024, swz = sb ^ (((sb >> 9) & 1) << 5); R = (st >> 1) * 16 + swz / 64; C = (st & 1) * 32 + (swz % 64) / 2; }
typedef int i32x8 __attribute__((ext_vector_type(8)));
typedef int i32x4 __attribute__((ext_vector_type(4)));
__device__ __forceinline__ i32x8 cat8(bf16x8 lo, bf16x8 hi) { const i32x4 a = __builtin_bit_cast(i32x4, lo), b = __builtin_bit_cast(i32x4, hi); return (i32x8){a[0], a[1], a[2], a[3], b[0], b[1], b[2], b[3]}; }
template <bool GATHER, bool PERM, bool FP8, class Sched, class Addr, class Epi>
__device__ __forceinline__ void gemm_fast(LAS unsigned char* lds, const int tid, const Sched& S, const Addr& AD, const Epi& E, const int* __restrict__ grows) {
    const int wid = __builtin_amdgcn_readfirstlane(tid >> 6), lane = tid & 63, wr = wid >> 2, wc = wid & 3, fr = lane & 15, fq = lane >> 4;
    unsigned cvg[2][2], nvg[2][2], cvb[2][2], nvb[2][2];
#define PG8_RC(i_) int R_, C_; stage_rc(tid * 16 + (i_) * 8192, R_, C_); const int sR_ = R_; const unsigned sC_ = (unsigned)C_ * 2u; const int sRb_ = PERM ? ((R_ & ~31) + perm32(R_ & 31)) : R_; (void)sR_; (void)sRb_; (void)sC_
    const size_t kstep = 128;
    const unsigned ldsw = (unsigned)wid * 1024u;
    const int aoff = lds_byte(wr * 64 + fr, fq * 8), boff = lds_byte(wc * 32 + fr, fq * 8);
#define PG8_SA(b, h) (((b) * 2 + (h)) * HTB)
#define PG8_SB(b, h) ((4 + (b) * 2 + (h)) * HTB)
#define PG8_STAGE(bufoff, gbase, voff) do { _Pragma("unroll") for (int _i = 0; _i < 2; ++_i) \
        __builtin_amdgcn_global_load_lds((const unsigned*)((const char*)(gbase) + (voff)[_i]), (LAS unsigned*)(lds + (bufoff) + ldsw + _i * 8192), 16, 0, 0); } while (0)
#define PG8_LDA(dst, b, h) do { if constexpr (FP8) { _Pragma("unroll") for (int m = 0; m < 4; ++m) dst##8[m] = cat8(*(const LAS bf16x8*)(lds + PG8_SA(b, h) + aoff + m * 2048), *(const LAS bf16x8*)(lds + PG8_SA(b, h) + aoff + m * 2048 + 1024)); } \
        else { _Pragma("unroll") for (int m = 0; m < 4; ++m) _Pragma("unroll") for (int k = 0; k < 2; ++k) dst[m][k] = *(const LAS bf16x8*)(lds + PG8_SA(b, h) + aoff + m * 2048 + k * 1024); } } while (0)
#define PG8_LDB(dst, b, h) do { if constexpr (FP8) { _Pragma("unroll") for (int n = 0; n < 2; ++n) dst##8[n] = cat8(*(const LAS bf16x8*)(lds + PG8_SB(b, h) + boff + n * 2048), *(const LAS bf16x8*)(lds + PG8_SB(b, h) + boff + n * 2048 + 1024)); } \
        else { _Pragma("unroll") for (int n = 0; n < 2; ++n) _Pragma("unroll") for (int k = 0; k < 2; ++k) dst[n][k] = *(const LAS bf16x8*)(lds + PG8_SB(b, h) + boff + n * 2048 + k * 1024); } } while (0)
#define PG8_MMA(ai, bj, At, Bt) do { __builtin_amdgcn_s_setprio(1); \
        if constexpr (FP8) { _Pragma("unroll") for (int m = 0; m < 4; ++m) _Pragma("unroll") for (int n = 0; n < 2; ++n)   \
            asm volatile("v_mfma_scale_f32_16x16x128_f8f6f4 %0, %1, %2, %0, %3, %3 op_sel_hi:[0,0,0]" : "+v"(acc[ai][bj][m][n]) : "v"(Bt##8[n]), "v"(At##8[m]), "v"(one_scale)); } \
        else { _Pragma("unroll") for (int m = 0; m < 4; ++m) _Pragma("unroll") for (int n = 0; n < 2; ++n) _Pragma("unroll") for (int k = 0; k < 2; ++k) \
            acc[ai][bj][m][n] = __builtin_amdgcn_mfma_f32_16x16x32_bf16(Bt[n][k], At[m][k], acc[ai][bj][m][n], 0, 0, 0); } \
        __builtin_amdgcn_s_setprio(0); } while (0)
#define PG8_WAIT_V(n) asm volatile("s_waitcnt vmcnt(" #n ")" ::: "memory")
#define PG8_WAIT_L(n) asm volatile("s_waitcnt lgkmcnt(" #n ")" ::: "memory")
#define PG8_BAR __builtin_amdgcn_s_barrier()
#define PG8_SCHED __builtin_amdgcn_sched_barrier(0)
#define PG8_GIDX(dst, op_) do { _Pragma("unroll") for (int i_ = 0; i_ < 2; ++i_) { PG8_RC(i_); _Pragma("unroll") for (int h_ = 0; h_ < 2; ++h_) dst[h_][i_] = (unsigned)grows[(op_).slot0 + h_ * 128 + sR_] * (unsigned)((op_).lda * 2) + sC_; } } while (0)
#define PG8_AOFF(dst, op_) do { _Pragma("unroll") for (int i_ = 0; i_ < 2; ++i_) { PG8_RC(i_); _Pragma("unroll") for (int h_ = 0; h_ < 2; ++h_) dst[h_][i_] = (unsigned)((sR_ + 128 * h_) * (op_).lda) * 2u + sC_; } } while (0)
#define PG8_BOFF(dst, op_) do { _Pragma("unroll") for (int i_ = 0; i_ < 2; ++i_) { PG8_RC(i_); _Pragma("unroll") for (int h_ = 0; h_ < 2; ++h_) { const int c_ = sRb_ + 128 * h_; \
        dst[h_][i_] = (unsigned)(((op_).bmap ? (64 * (c_ & 7) + (c_ >> 3)) : c_) * (op_).ldb) * 2u + sC_; } } } while (0)
#define PG8_COPY(dst, src) do { _Pragma("unroll") for (int h_ = 0; h_ < 2; ++h_) _Pragma("unroll") for (int i_ = 0; i_ < 2; ++i_) dst[h_][i_] = src[h_][i_]; } while (0)
    Unit cur, nxt; int ui = 0;
    if (!S.next(0, cur)) return;
    f32x4 acc[2][2][4][2];
#pragma unroll
    for (int a = 0; a < 2; ++a)
#pragma unroll
        for (int b = 0; b < 2; ++b)
#pragma unroll
            for (int m = 0; m < 4; ++m)
#pragma unroll
                for (int n = 0; n < 2; ++n) acc[a][b][m][n] = (f32x4){0.f, 0.f, 0.f, 0.f};
    bf16x8 At[4][2], B0[2][2], B1[2][2]; i32x8 At8[4], B08[2], B18[2];
    const int one_scale = 0x7F7F7F7F;
    const char* cA; const char* cB; int nt;
    bool has_next; const char* nA; const char* nB; int nnt;
    { const Operands op = AD(cur); cA = (const char*)op.A; cB = (const char*)op.Bt; nt = op.K / 64; PG8_BOFF(cvb, op);
      has_next = S.next(1, nxt); const Operands o1 = has_next ? AD(nxt) : op; PG8_BOFF(nvb, o1); nA = (const char*)o1.A; nB = (const char*)o1.Bt; nnt = o1.K / 64;
      if constexpr (GATHER) { PG8_GIDX(cvg, op); PG8_GIDX(nvg, o1); PG8_WAIT_V(0); } else { PG8_AOFF(cvg, op); PG8_AOFF(nvg, o1); } }
    PG8_STAGE(PG8_SB(0, 0), cB, cvb[0]); PG8_STAGE(PG8_SB(0, 1), cB, cvb[1]); PG8_STAGE(PG8_SA(0, 0), cA, cvg[0]); PG8_STAGE(PG8_SA(0, 1), cA, cvg[1]);
    if (wr == 1) PG8_BAR;
    PG8_WAIT_V(2); PG8_BAR;
    PG8_STAGE(PG8_SB(1, 0), cB + kstep, cvb[0]); PG8_STAGE(PG8_SA(1, 0), cA + kstep, cvg[0]); PG8_STAGE(PG8_SB(1, 1), cB + kstep, cvb[1]);
    PG8_WAIT_V(6); PG8_BAR;
    for (;;) {
#pragma unroll 1
        for (int t = 0; t < nt; t += 2) {
            const bool last = (t == nt - 2);
            const char* a1 = cA + (size_t)(t + 1) * kstep;
            const char* a2 = last ? nA : cA + (size_t)(t + 2) * kstep; const char* b2 = last ? nB : cB + (size_t)(t + 2) * kstep;
            const char* a3 = a2 + kstep; const char* b3 = b2 + kstep;
            unsigned v2[2][2], w2[2][2];
#pragma unroll
            for (int h_ = 0; h_ < 2; ++h_)
#pragma unroll
                for (int i_ = 0; i_ < 2; ++i_) { v2[h_][i_] = last ? nvg[h_][i_] : cvg[h_][i_]; w2[h_][i_] = last ? nvb[h_][i_] : cvb[h_][i_]; }
            PG8_LDB(B0, 0, 0); PG8_LDB(B1, 0, 1); PG8_SCHED; PG8_LDA(At, 0, 0); PG8_STAGE(PG8_SA(1, 1), a1, cvg[1]);
            PG8_WAIT_V(8); PG8_WAIT_L(0); PG8_BAR; PG8_MMA(0, 0, At, B0); PG8_MMA(0, 1, At, B1); PG8_BAR; PG8_SCHED;
            PG8_LDA(At, 0, 1); PG8_STAGE(PG8_SB(0, 0), b2, w2[0]); PG8_STAGE(PG8_SB(0, 1), b2, w2[1]); PG8_STAGE(PG8_SA(0, 0), a2, v2[0]);
            PG8_WAIT_V(8); PG8_WAIT_L(0); PG8_BAR; PG8_MMA(1, 0, At, B0); PG8_MMA(1, 1, At, B1); PG8_BAR; PG8_SCHED;
            PG8_LDB(B0, 1, 0); PG8_LDB(B1, 1, 1); PG8_SCHED; PG8_LDA(At, 1, 0); PG8_STAGE(PG8_SA(0, 1), a2, v2[1]);
            PG8_WAIT_V(8); PG8_WAIT_L(0); PG8_BAR; PG8_MMA(0, 0, At, B0); PG8_MMA(0, 1, At, B1); PG8_BAR; PG8_SCHED;
            PG8_LDA(At, 1, 1); PG8_STAGE(PG8_SB(1, 0), b3, w2[0]); PG8_STAGE(PG8_SB(1, 1), b3, w2[1]); PG8_STAGE(PG8_SA(1, 0), a3, v2[0]);
            PG8_WAIT_V(8); PG8_WAIT_L(0); PG8_BAR; PG8_MMA(1, 0, At, B0); PG8_MMA(1, 1, At, B1); PG8_BAR; PG8_SCHED;
        }
        if constexpr (FP8) asm volatile("s_nop 15\n\ts_nop 15" ::: "memory");
        if (wr == 0) PG8_BAR;
        unsigned fvg[2][2], fvb[2][2];
        Unit u2; const bool h2 = S.next(ui + 2, u2); const char* fA = nA; const char* fB = nB; int fnt = nnt;
        if (h2) { const Operands o2 = AD(u2); fA = (const char*)o2.A; fB = (const char*)o2.Bt; fnt = o2.K / 64; PG8_BOFF(fvb, o2); if constexpr (GATHER) PG8_GIDX(fvg, o2); else PG8_AOFF(fvg, o2); }
        else { PG8_COPY(fvb, nvb); PG8_COPY(fvg, nvg); }
        { int fr2 = fr, fq2 = fq; asm volatile("" : "+v"(fr2), "+v"(fq2));
          E(acc, cur, wr, wc, fr2, fq2); }
        if (!has_next) break;
        if constexpr (GATHER) PG8_WAIT_V(0);
        PG8_COPY(cvg, nvg); PG8_COPY(nvg, fvg); PG8_COPY(cvb, nvb); PG8_COPY(nvb, fvb);
        if (E.reset(cur)) {
#pragma unroll
        for (int a = 0; a < 2; ++a)
#pragma unroll
            for (int b = 0; b < 2; ++b)
#pragma unroll
                for (int m = 0; m < 4; ++m)
#pragma unroll
                    for (int n = 0; n < 2; ++n) acc[a][b][m][n] = (f32x4){0.f, 0.f, 0.f, 0.f};
        }
        cur = nxt; cA = nA; cB = nB; nt = nnt; ++ui;
        nxt = u2; has_next = h2; nA = fA; nB = fB; nnt = fnt;
        if (wr == 1) PG8_BAR;
    }
    PG8_WAIT_V(0);
    PG8_BAR;
#undef PG8_SA
#undef PG8_SB
#undef PG8_STAGE
#undef PG8_LDA
#undef PG8_LDB
#undef PG8_MMA
#undef PG8_WAIT_V
#undef PG8_WAIT_L
#undef PG8_BAR
#undef PG8_SCHED
#undef PG8_GIDX
#undef PG8_AOFF
#undef PG8_BOFF
#undef PG8_COPY
#undef PG8_RC
}
template <class F> struct EpiFn { F f; __device__ __forceinline__ void operator()(f32x4 (&acc)[2][2][4][2], const Unit& u, int wr, int wc, int fr, int fq) const { f(acc, u, wr, wc, fr, fq); } __device__ __forceinline__ bool reset(const Unit&) const { return true; } };
template <class F> __device__ __forceinline__ EpiFn<F> mk_epi(F f) { return EpiFn<F>{f}; }
template <class F> struct EpiSeg { F f; int last; __device__ __forceinline__ void operator()(f32x4 (&acc)[2][2][4][2], const Unit& u, int wr, int wc, int fr, int fq) const { f(acc, u, wr, wc, fr, fq); } __device__ __forceinline__ bool reset(const Unit& u) const { return u.seg == last; } };
template <class F> __device__ __forceinline__ EpiSeg<F> mk_epi_seg(F f, int last) { return EpiSeg<F>{f, last}; }
template <int NSEG> struct SegSched { GroupSched base; __device__ __forceinline__ bool next(int j, Unit& u) const { if (!base.next(j / NSEG, u)) return false; u.seg = j % NSEG; return true; } };
#ifndef DUP_PH
#define DUP_PH -1
#endif
#define REP_BEGIN(k) _Pragma("unroll 1") for (int rep_ = 0; rep_ < ((DUP_PH == (k)) ? 2 : 1); ++rep_) { if (rep_) { if constexpr (PH < 0) xcd_barrier(bar); }
#define REP_END }
#define GEMM(S, AD, E, K, lda, ldb) gemm_fast<false, false, false>(F.lds, F.tid, S, AD, mk_epi(E), nullptr)
#define GEMM_P(S, AD, E) gemm_fast<false, true, false>(F.lds, F.tid, S, AD, mk_epi(E), nullptr)
#define GEMM_P8(S, AD, E) gemm_fast<false, true, true>(F.lds, F.tid, S, AD, mk_epi(E), nullptr)
#define GEMM_GATHER8(S, AD, E, rows) gemm_fast<true, true, true>(F.lds, F.tid, S, AD, mk_epi(E), rows)
#define EPI_ARGS f32x4 (&acc)[2][2][4][2], const Unit& u, int wr, int wc, int fr, int fq
#define EPI_FOR(...) _Pragma("unroll") for (int ai = 0; ai < 2; ++ai) _Pragma("unroll") for (int m = 0; m < 4; ++m) { const int r = ai * 128 + wr * 64 + m * 16 + fr; \
    _Pragma("unroll") for (int bj = 0; bj < 2; ++bj) _Pragma("unroll") for (int n = 0; n < 2; ++n) { const int c = bj * 128 + wc * 32 + n * 16 + 4 * fq; const f32x4 v = acc[ai][bj][m][n]; __VA_ARGS__ } }
#define EPI_FOR8(...) _Pragma("unroll") for (int ai = 0; ai < 2; ++ai) _Pragma("unroll") for (int m = 0; m < 4; ++m) { const int r = ai * 128 + wr * 64 + m * 16 + fr; \
    _Pragma("unroll") for (int bj = 0; bj < 2; ++bj) { const int c = bj * 128 + wc * 32 + 8 * fq; const f32x4 v0 = acc[ai][bj][m][0], v1 = acc[ai][bj][m][1]; __VA_ARGS__ } }
__device__ __forceinline__ void st_bf8(bf16* p, f32x4 a, f32x4 b) { u32x4 w; w.x = pk2(a[0], a[1]); w.y = pk2(a[2], a[3]); w.z = pk2(b[0], b[1]); w.w = pk2(b[2], b[3]); *(u32x4*)p = w; }
__device__ __forceinline__ void st_bf4(bf16* p, f32x4 v) { u32x2 w; w.x = pk2(v[0], v[1]); w.y = pk2(v[2], v[3]); *(u32x2*)p = w; }

__device__ __forceinline__ void p_mod(const Params& P, Frame& F) {
    LAS float* sc = (LAS float*)F.lds;
    LAS float* red = (LAS float*)(F.lds + 9 * 1024 * 4);
    float* MOD = WSP(float, WS_MOD);
    bool have = false;
    for (int it = F.bid; it < 2 * 96; it += F.G) {
        if (!have) {
            for (int i = F.tid; i < 9 * 1024; i += NTHREADS) { const int r = i >> 10, k = i & 1023; const float v = r < 8 ? P.c[r * 1024 + k] : P.c_ctx[k]; sc[i] = v * sigmoidf_(v); }
            have = true;
        }
        __syncthreads();
        const int l = it / 96, j0 = (it % 96) * 64, jj = F.tid & 63, kc = F.tid >> 6;
        const float* W = P.ada_w + (size_t)l * 1024 * 6144 + j0 + jj;
        float a[9];
#pragma unroll
        for (int r = 0; r < 9; ++r) a[r] = 0.f;
#pragma unroll 8
        for (int k = kc * 128; k < kc * 128 + 128; ++k) { const float w = W[(size_t)k * 6144];
#pragma unroll
            for (int r = 0; r < 9; ++r) a[r] += sc[r * 1024 + k] * w; }
#pragma unroll
        for (int r = 0; r < 9; ++r) red[(kc * 9 + r) * 64 + jj] = a[r];
        __syncthreads();
        for (int o = F.tid; o < 9 * 64; o += NTHREADS) { const int r = o >> 6, j = o & 63; float s = 0.f;
#pragma unroll
            for (int q = 0; q < 8; ++q) s += red[(q * 9 + r) * 64 + j];
            MOD[((size_t)l * 9 + r) * 6144 + j0 + j] = s + P.ada_b[l * 6144 + j0 + j]; }
    }
    __syncthreads();
}
__device__ __forceinline__ void p_dftgen(Frame& F) {
    LAS float* tab = (LAS float*)F.lds;
    for (int j = F.tid; j < 4096; j += NTHREADS) tab[j] = cospif((float)j * (1.0f / 2048.0f));
    __syncthreads();
    bf16* DC_ = WSP(bf16, WS_DFTC); bf16* M1 = WSP(bf16, WS_M1T); bf16* M2 = WSP(bf16, WS_M2T);
    const int nchunk = 256 * 64 + 256 * 32 + 256 * 64;
    for (int ch = F.bid * NTHREADS + F.tid; ch < nchunk; ch += F.G * NTHREADS) {
        float v[8]; bf16* dst;
        if (ch < 256 * 64) { const int kf = ch >> 6, col0 = (ch & 63) * 8, cs = col0 >> 8, l0 = col0 & 255;
#pragma unroll
            for (int i = 0; i < 8; ++i) { const int j = ((kf * (l0 + i)) & 255) * 16; v[i] = cs ? -tab[(j + 3072) & 4095] : tab[j]; }
            dst = DC_ + (size_t)kf * 512 + col0; }
        else if (ch < 256 * 64 + 256 * 32) { const int c2 = ch - 256 * 64, row = c2 >> 5, col0 = (c2 & 31) * 8, ri = row >> 7, h = (row >> 6) & 1, k1 = row & 63, h2 = col0 >> 7, cs = (col0 >> 6) & 1, l10 = col0 & 63;
#pragma unroll
            for (int i = 0; i < 8; ++i) { const int j = ((k1 * (l10 + i)) & 63) * 64; const float c = tab[j], sn = tab[(j + 3072) & 4095];
                v[i] = (h != h2) ? 0.f : (ri == 0 ? (cs == 0 ? c : -sn) : (cs == 0 ? sn : c)); }
            dst = M1 + (size_t)row * 256 + col0; }
        else { const int c2 = ch - 256 * 64 - 256 * 32, row = c2 >> 6, col0 = (c2 & 63) * 8, q = row >> 6, k2 = row & 63, q2 = col0 >> 7, ri = (col0 >> 6) & 1, l20 = col0 & 63;
#pragma unroll
            for (int i = 0; i < 8; ++i) { const int j = ((k2 * (l20 + i)) & 63) * 64; const float c = tab[j], sn = tab[(j + 3072) & 4095];
                v[i] = (q != q2) ? 0.f : (ri == 0 ? c : -sn); }
            dst = M2 + (size_t)row * 512 + col0; }
        u32x4 o; o.x = pk2(v[0], v[1]); o.y = pk2(v[2], v[3]); o.z = pk2(v[4], v[5]); o.w = pk2(v[6], v[7]);
        *(u32x4*)dst = o;
    }
    __syncthreads();
}
__device__ __forceinline__ void transpose_item(const float* W, int ldw, int k0, int n0, bf16* WT, int ldt, int drow0, LAS float* scr, int lane) {
    f32x4 ld[8];
#pragma unroll
    for (int i = 0; i < 8; ++i) ld[i] = *(const f32x4*)(W + (size_t)(k0 + 8 * i + (lane >> 3)) * ldw + n0 + 4 * (lane & 7));
#pragma unroll
    for (int i = 0; i < 8; ++i) { LAS float* d = scr + (8 * i + (lane >> 3)) * 33 + 4 * (lane & 7); d[0] = ld[i][0]; d[1] = ld[i][1]; d[2] = ld[i][2]; d[3] = ld[i][3]; }
    LDS_WAIT(); asm volatile("" ::: "memory");
    const int c = lane & 7;
#pragma unroll
    for (int j = 0; j < 4; ++j) { const int n = (lane >> 3) + 8 * j; const LAS float* s = scr + (8 * c) * 33 + n;
        u32x4 o; o.x = pk2(s[0 * 33], s[1 * 33]); o.y = pk2(s[2 * 33], s[3 * 33]); o.z = pk2(s[4 * 33], s[5 * 33]); o.w = pk2(s[6 * 33], s[7 * 33]);
        *(u32x4*)(WT + (size_t)(drow0 + n) * ldt + k0 + 8 * c) = o; }
    LDS_WAIT(); asm volatile("" ::: "memory");
}
__device__ __forceinline__ void transpose_item8(const float* W, int ldw, int k0, int n0, unsigned char* WT, int ldt, int drow0, LAS float* scr, int lane) {
    f32x4 ld[8];
#pragma unroll
    for (int i = 0; i < 8; ++i) ld[i] = *(const f32x4*)(W + (size_t)(k0 + 8 * i + (lane >> 3)) * ldw + n0 + 4 * (lane & 7));
#pragma unroll
    for (int i = 0; i < 8; ++i) { LAS float* d = scr + (8 * i + (lane >> 3)) * 33 + 4 * (lane & 7); d[0] = ld[i][0]; d[1] = ld[i][1]; d[2] = ld[i][2]; d[3] = ld[i][3]; }
    LDS_WAIT(); asm volatile("" ::: "memory");
    const int c = lane & 7;
#pragma unroll
    for (int j = 0; j < 4; ++j) { const int n = (lane >> 3) + 8 * j; const LAS float* s = scr + (8 * c) * 33 + n;
        u32x2 o; o.x = pk4_fp8(s[0 * 33] * W8S, s[1 * 33] * W8S, s[2 * 33] * W8S, s[3 * 33] * W8S); o.y = pk4_fp8(s[4 * 33] * W8S, s[5 * 33] * W8S, s[6 * 33] * W8S, s[7 * 33] * W8S);
        *(u32x2*)(WT + (size_t)(drow0 + n) * ldt + k0 + 8 * c) = o; }
    LDS_WAIT(); asm volatile("" ::: "memory");
}
__device__ __forceinline__ void transpose_item8w(const float* W, int ldw, int k0, int n0, unsigned char* WT, int ldt, int drow0, LAS float* scr, int lane) {
    f32x4 ld[16];
#pragma unroll
    for (int i = 0; i < 16; ++i) ld[i] = *(const f32x4*)(W + (size_t)(k0 + 4 * i + (lane >> 4)) * ldw + n0 + 4 * (lane & 15));
#pragma unroll
    for (int i = 0; i < 16; ++i) { LAS float* d = scr + (4 * i + (lane >> 4)) * 65 + 4 * (lane & 15); d[0] = ld[i][0]; d[1] = ld[i][1]; d[2] = ld[i][2]; d[3] = ld[i][3]; }
    LDS_WAIT(); asm volatile("" ::: "memory");
    const int c = lane & 3;
#pragma unroll
    for (int p = 0; p < 4; ++p) { const int n = (lane >> 2) + 16 * p; const LAS float* s = scr + (16 * c) * 65 + n; u32x4 o;
#pragma unroll
        for (int q = 0; q < 4; ++q) o[q] = pk4_fp8(s[(4 * q) * 65] * W8S, s[(4 * q + 1) * 65] * W8S, s[(4 * q + 2) * 65] * W8S, s[(4 * q + 3) * 65] * W8S);
        *(u32x4*)(WT + (size_t)(drow0 + n) * ldt + k0 + 16 * c) = o; }
    LDS_WAIT(); asm volatile("" ::: "memory");
}
__device__ __forceinline__ void wconv_experts(const Params& P, Frame& F, int l, int rank, int nblk) {
    LAS float* scr = (LAS float*)(F.lds + (F.wave < 7 ? F.wave * 17408 : 131584));
    const int gw = rank * NWAVES + F.wave, NGW = nblk * NWAVES;
    constexpr int I_E = 16 * 44;
    unsigned char* WGU = WSP(unsigned char, WS_WGU); unsigned char* WD = WSP(unsigned char, WS_WD);
    for (int it = gw; it < 3 * 16 * I_E; it += NGW) {
        const int which = it / (16 * I_E), r0 = it % (16 * I_E), e = r0 / I_E, r = r0 % I_E;
        if (which < 2) { const int kb = r / 44, nb = r % 44, n0 = nb * 64;
            const float* src = (which == 0 ? P.w_eg : P.w_eu) + ((size_t)l * 16 + e) * 1024 * FF;
            transpose_item8w(src, FF, kb * 64, n0, WGU + (size_t)e * 5632 * 1024, 1024, (n0 >> 7) * 256 + (which ? 128 : 0) + (n0 & 127), scr, F.lane); }
        else { const int kb = r / 16, nb = r % 16;
            transpose_item8w(P.w_ed + ((size_t)l * 16 + e) * FF * 1024, 1024, kb * 64, nb * 64, WD + (size_t)e * 1024 * FF, FF, nb * 64, scr, F.lane); }
    }
    __syncthreads();
}
__device__ __forceinline__ void p_wconv(const Params& P, Frame& F, int l) {
    LAS float* scr = (LAS float*)(F.lds + F.wave * 16384);
    const int gw = F.bid * NWAVES + F.wave, NGW = F.G * NWAVES;
    const float* w_in = P.w_in + (size_t)l * 1024 * INW;
    bf16* WA = WSP(bf16, WS_WA); bf16* WFV = WSP(bf16, WS_WFV);
    constexpr int I_K = 16 * 32, I_Q = 16 * 32, I_P = 16 * 16, I_G = 16 * 96, I_V = 16 * 32, I_AO = 16 * 32, I_FO = 8 * 32, I_OUT = 16 * 32;
    constexpr int NSM = I_K + I_Q + I_P + I_G + I_V + I_AO + I_FO + I_OUT;
    for (int it = gw; it < NSM; it += NGW) {
        int r = it;
        if (r < I_K) { transpose_item8(w_in, INW, (r / 32) * 64, 0 + (r % 32) * 32, WSP(unsigned char, WS_WA8), 1024, 0 + (r % 32) * 32, scr, F.lane); continue; } r -= I_K;
        if (r < I_Q) { transpose_item8(w_in, INW, (r / 32) * 64, 2048 + (r % 32) * 32, WSP(unsigned char, WS_WA8), 1024, 1024 + (r % 32) * 32, scr, F.lane); continue; } r -= I_Q;
        if (r < I_P) { transpose_item(w_in, INW, (r / 16) * 64, 3584 + (r % 16) * 32, WA, 1024, 2048 + (r % 16) * 32, scr, F.lane); continue; } r -= I_P;
        if (r < I_G) { transpose_item(w_in, INW, (r / 96) * 64, 4096 + (r % 96) * 32, WA, 1024, 2560 + (r % 96) * 32, scr, F.lane); continue; } r -= I_G;
        if (r < I_V) { transpose_item8(w_in, INW, (r / 32) * 64, 1024 + (r % 32) * 32, WSP(unsigned char, WS_WA8), 1024, 2048 + (r % 32) * 32, scr, F.lane); continue; } r -= I_V;
        if (r < I_AO) { transpose_item(P.w_att_o + (size_t)l * 1024 * 1024, 1024, (r / 32) * 64, (r % 32) * 32, WSP(bf16, WS_WAO), 1024, (r % 32) * 32, scr, F.lane); continue; } r -= I_AO;
        if (r < I_FO) { transpose_item(P.w_fourier + (size_t)l * 512 * 1024, 1024, (r / 32) * 64, (r % 32) * 32, WSP(bf16, WS_WFO), 512, (r % 32) * 32, scr, F.lane); continue; } r -= I_FO;
        transpose_item(P.w_out + (size_t)l * 1024 * 1024, 1024, (r / 32) * 64, (r % 32) * 32, WSP(bf16, WS_WOUT), 1024, (r % 32) * 32, scr, F.lane);
    }
    { bf16* WPO = WSP(bf16, WS_WPO); const float* wp = P.w_pool + (size_t)l * 4 * 128 * 256;
      for (int i = F.bid * NTHREADS + F.tid; i < 1024 * 256; i += F.G * NTHREADS) { const int n = i >> 8, kk = i & 255, g = n >> 8, f = n & 255;
          WPO[i] = (bf16)(((kk >> 7) == (g & 1)) ? f2bf(wp[((size_t)g * 128 + (kk & 127)) * 256 + f]) : 0u); } }
    { LAS float* t128 = (LAS float*)F.lds;
      __syncthreads();
      for (int j = F.tid; j < 128; j += NTHREADS) t128[j] = cospif((float)j * (1.0f / 64.0f));
      __syncthreads();
      for (int i = F.bid * NTHREADS + F.tid; i < 1024 * 1024; i += F.G * NTHREADS) { const int fc = i >> 10, k = i & 1023, cs = fc & 1, gm = fc >> 1, g = gm >> 7, m = gm & 127;
          const float* src = w_in + (size_t)k * INW + 3072 + g * 128; float s = 0.f; const int ph = cs ? 96 : 0;
          for (int c = 0; c < 128; ++c) s += src[c] * t128[(m * c + ph) & 127];
          WFV[i] = (bf16)f2bf(s); }
      __syncthreads(); }
}

struct RowMod { const float* g; const float* sh; const float* sc; };
__device__ __forceinline__ void row_load(const float* row, int lane, f32x4 (&v)[4]) {
#pragma unroll
    for (int j = 0; j < 4; ++j) v[j] = *(const f32x4*)(row + 4 * lane + 256 * j);
}
__device__ __forceinline__ float row_rstd(const f32x4 (&v)[4]) {
    float s = 0.f;
#pragma unroll
    for (int j = 0; j < 4; ++j) s += (v[j][0] * v[j][0] + v[j][1] * v[j][1]) + (v[j][2] * v[j][2] + v[j][3] * v[j][3]);
    return rsqrtf(wave_sum(s) * (1.0f / 1024.0f) + RMS_EPS);
}
__device__ __forceinline__ void row_modulate(const f32x4 (&v)[4], float rstd, const RowMod& M, int lane, f32x4 (&y)[4]) {
#pragma unroll
    for (int j = 0; j < 4; ++j) { const int k = 4 * lane + 256 * j; const f32x4 g = *(const f32x4*)(M.g + k), sh = *(const f32x4*)(M.sh + k), sc = *(const f32x4*)(M.sc + k);
        y[j] = v[j] * rstd * g * (sc + 1.0f) + sh; }
}
__device__ __forceinline__ void row_store_bf(bf16* row, int lane, const f32x4 (&y)[4]) {
#pragma unroll
    for (int j = 0; j < 4; ++j) st_bf4(row + 4 * lane + 256 * j, y[j]);
}
__device__ __forceinline__ void row_store_f8(unsigned char* row, int lane, const f32x4 (&y)[4]) {
#pragma unroll
    for (int j = 0; j < 4; ++j) *(unsigned*)(row + 4 * lane + 256 * j) = pk4_fp8(y[j][0] * A8S, y[j][1] * A8S, y[j][2] * A8S, y[j][3] * A8S);
}
__device__ __forceinline__ const float* mod_ptr(Frame& F, int l, int row, int which) { const int mr = row < RL ? (row >> 12) : 8; return WSP(float, WS_MOD) + ((size_t)l * 9 + mr) * 6144 + which * 1024; }

__device__ __forceinline__ void p_rowpass_a0(const Params& P, Frame& F) {
    const int gw = F.bid * NWAVES + F.wave, NGW = F.G * NWAVES; bf16* H = WSP(bf16, WS_H);
    f32x4 vn[4]; int row = gw;
    if (row < RT) row_load(row < RL ? P.x + (size_t)row * DM : P.ctx + (size_t)(row - RL) * DM, F.lane, vn);
    for (; row < RT; row += NGW) {
        f32x4 v[4], y[4];
#pragma unroll
        for (int j = 0; j < 4; ++j) v[j] = vn[j];
        { const int nr = row + NGW; if (nr < RT) row_load(nr < RL ? P.x + (size_t)nr * DM : P.ctx + (size_t)(nr - RL) * DM, F.lane, vn); }
        const float rs = row_rstd(v);
        RowMod M{P.norm1_g, mod_ptr(F, 0, row, 0), mod_ptr(F, 0, row, 1)};
        row_modulate(v, rs, M, F.lane, y); row_store_bf(H + (size_t)row * DM, F.lane, y); row_store_f8(WSP(unsigned char, WS_H8) + (size_t)row * DM, F.lane, y);
    }
}
__device__ __forceinline__ void p_rowpass_f(const Params& P, Frame& F, int l, int nrows) {
    const int gw = F.bid * NWAVES + F.wave, NGW = F.G * NWAVES; unsigned char* H8 = WSP(unsigned char, WS_H8); float* AFF = WSP(float, WS_AFF);
    const float* wr = P.w_router + (size_t)l * 1024 * 16;
    LAS float* wl = (LAS float*)F.lds;
    __syncthreads();
    for (int i = F.tid; i < 16384; i += NTHREADS) wl[(i & 15) * 1024 + (i >> 4)] = wr[i];
    __syncthreads();
    f32x4 vn[4]; int row = gw;
    if (row < nrows) row_load(row < RL ? P.out + (size_t)row * DM : WSP(float, WS_XC) + (size_t)(row - RL) * DM, F.lane, vn);
    for (; row < nrows; row += NGW) {
        f32x4 v[4], y[4];
#pragma unroll
        for (int j = 0; j < 4; ++j) v[j] = vn[j];
        { const int nr = row + NGW; if (nr < nrows) row_load(nr < RL ? P.out + (size_t)nr * DM : WSP(float, WS_XC) + (size_t)(nr - RL) * DM, F.lane, vn); }
        const float rs = row_rstd(v);
        RowMod M{P.norm2_g + l * 1024, mod_ptr(F, l, row, 3), mod_ptr(F, l, row, 4)};
        row_modulate(v, rs, M, F.lane, y);
        row_store_f8(H8 + (size_t)row * DM, F.lane, y);
        float lg[16];
        int wo = 4 * F.lane; asm volatile("" : "+v"(wo));
#pragma unroll
        for (int e = 0; e < 16; ++e) { float a = 0.f;
#pragma unroll
            for (int j = 0; j < 4; ++j) { const f32x4 w = *(const LAS f32x4*)(wl + e * 1024 + wo + 256 * j); a += (y[j][0] * w[0] + y[j][1] * w[1]) + (y[j][2] * w[2] + y[j][3] * w[3]); }
            lg[e] = a; }
        float mx = -1e30f;
#pragma unroll
        for (int e = 0; e < 16; ++e) { lg[e] = wave_sum(lg[e]); mx = fmaxf(mx, lg[e]); }
        float den = 0.f;
#pragma unroll
        for (int e = 0; e < 16; ++e) { lg[e] = __expf(lg[e] - mx); den += lg[e]; }
        const float inv = 1.0f / den;
        if (F.lane < 16) { float mine = 0.f;
#pragma unroll
            for (int e = 0; e < 16; ++e) mine = (F.lane == e) ? lg[e] : mine;
            AFF[(size_t)row * 16 + F.lane] = mine * inv; }
    }
    __syncthreads();
}
__device__ __forceinline__ void p_rowpass_k(const Params& P, Frame& F, int l, int nrows) {
    const int gw = F.bid * NWAVES + F.wave, NGW = F.G * NWAVES; bf16* H = WSP(bf16, WS_H);
    const int* SEL = WSP(int, WS_SEL); const bf16* Y = WSP(bf16, WS_Y);
    f32x4 vn[4]; int seln = -1; int row = gw;
    if (row < nrows) { row_load(row < RL ? P.out + (size_t)row * DM : WSP(float, WS_XC) + (size_t)(row - RL) * DM, F.lane, vn); seln = F.lane < 16 ? SEL[(size_t)row * 16 + F.lane] : -1; }
    for (; row < nrows; row += NGW) {
        float* xr = row < RL ? P.out + (size_t)row * DM : WSP(float, WS_XC) + (size_t)(row - RL) * DM;
        f32x4 v[4], a[4]; const int sel = seln;
#pragma unroll
        for (int j = 0; j < 4; ++j) { v[j] = vn[j]; a[j] = (f32x4){0.f, 0.f, 0.f, 0.f}; }
        { const int nr = row + NGW; if (nr < nrows) { row_load(nr < RL ? P.out + (size_t)nr * DM : WSP(float, WS_XC) + (size_t)(nr - RL) * DM, F.lane, vn); seln = F.lane < 16 ? SEL[(size_t)nr * 16 + F.lane] : -1; } }
        unsigned em = (unsigned)__ballot(sel >= 0) & 0xffffu;
        while (em) { const int e = __builtin_ctz(em); em &= em - 1; const int s = __builtin_amdgcn_readlane(sel, e); const bf16* yr = Y + (size_t)s * DM;
#pragma unroll
            for (int j = 0; j < 4; ++j) { const u32x2 w = *(const u32x2*)(yr + 4 * F.lane + 256 * j); a[j][0] += bflo(w.x); a[j][1] += bfhi(w.x); a[j][2] += bflo(w.y); a[j][3] += bfhi(w.y); } }
        const float* g2 = mod_ptr(F, l, row, 5);
#pragma unroll
        for (int j = 0; j < 4; ++j) { const f32x4 g = *(const f32x4*)(g2 + 4 * F.lane + 256 * j); v[j] = v[j] + g * a[j]; }
        const float rs = row_rstd(v);
        if (l == 0) {
#pragma unroll
            for (int j = 0; j < 4; ++j) *(f32x4*)(xr + 4 * F.lane + 256 * j) = v[j];
            f32x4 y[4]; RowMod M{P.norm1_g + 1024, mod_ptr(F, 1, row, 0), mod_ptr(F, 1, row, 1)};
            row_modulate(v, rs, M, F.lane, y); row_store_bf(H + (size_t)row * DM, F.lane, y); row_store_f8(WSP(unsigned char, WS_H8) + (size_t)row * DM, F.lane, y);
        } else {
#pragma unroll
            for (int j = 0; j < 4; ++j) { const f32x4 g = *(const f32x4*)(P.final_g + 4 * F.lane + 256 * j); *(f32x4*)(xr + 4 * F.lane + 256 * j) = v[j] * rs * g; }
        }
    }
}

constexpr int ACK_STRIDE = 72, ACV_STRIDE = 264;
constexpr int ALDS_CK = 0, ALDS_CV = 256 * ACK_STRIDE * 2, ALDS_RP = ALDS_CV + 64 * ACV_STRIDE * 2;
struct AttnState { float m, sum; f32x4 o[4]; };
__device__ __forceinline__ float xrow16_max(float x) {
    auto s = __builtin_amdgcn_permlane16_swap(__float_as_uint(x), __float_as_uint(x), false, false);
    x = fmaxf(__uint_as_float(s[0]), __uint_as_float(s[1]));
    auto t = __builtin_amdgcn_permlane32_swap(__float_as_uint(x), __float_as_uint(x), false, false);
    return fmaxf(__uint_as_float(t[0]), __uint_as_float(t[1]));
}
__device__ __forceinline__ float xrow16_sum(float x) {
    auto s = __builtin_amdgcn_permlane16_swap(__float_as_uint(x), __float_as_uint(x), false, false);
    x = __uint_as_float(s[0]) + __uint_as_float(s[1]);
    auto t = __builtin_amdgcn_permlane32_swap(__float_as_uint(x), __float_as_uint(x), false, false);
    return __uint_as_float(t[0]) + __uint_as_float(t[1]);
}
#define MFMA16(a, b, c) __builtin_amdgcn_mfma_f32_16x16x32_bf16((a), (b), (c), 0, 0, 0)
template <int NT>
__device__ __forceinline__ void attn_tail(AttnState& S, f32x4 (&sc)[NT], const u32x4 (&vw)[NT / 2][4]) {
    float cm = -__builtin_inff();
#pragma unroll
    for (int t = 0; t < NT; ++t)
#pragma unroll
        for (int j = 0; j < 4; ++j) cm = fmaxf(cm, sc[t][j]);
    cm = xrow16_max(cm);
    const bool need = (fabsf(cm) > 12.0f) && (cm > -1e30f);
    if (__builtin_amdgcn_ballot_w64(need) != 0ull) {
        const float d = need ? cm : 0.f, scl = __builtin_amdgcn_exp2f(-d);
        S.m += d; S.sum *= scl;
#pragma unroll
        for (int dt = 0; dt < 4; ++dt) S.o[dt] = S.o[dt] * scl;
#pragma unroll
        for (int t = 0; t < NT; ++t)
#pragma unroll
            for (int j = 0; j < 4; ++j) sc[t][j] -= d;
    }
    float ps = 0.f;
#pragma unroll
    for (int t = 0; t < NT; ++t)
#pragma unroll
        for (int j = 0; j < 4; ++j) { const float p = __builtin_amdgcn_exp2f(sc[t][j]); sc[t][j] = p; ps += p; }
    S.sum += ps;
#pragma unroll
    for (int ks = 0; ks < NT / 2; ++ks) { u32x4 pw; pw.x = pk2(sc[2 * ks][0], sc[2 * ks][1]); pw.y = pk2(sc[2 * ks][2], sc[2 * ks][3]); pw.z = pk2(sc[2 * ks + 1][0], sc[2 * ks + 1][1]); pw.w = pk2(sc[2 * ks + 1][2], sc[2 * ks + 1][3]);
        const bf16x8 pf = __builtin_bit_cast(bf16x8, pw);
#pragma unroll
        for (int dt = 0; dt < 4; ++dt) S.o[dt] = MFMA16(__builtin_bit_cast(bf16x8, vw[ks][dt]), pf, S.o[dt]); }
}
__device__ __forceinline__ void attn_unit2(const bf16* __restrict__ KQ, const bf16* __restrict__ VT, bf16* __restrict__ ATT, LAS unsigned char* lds,
                                           const int b, const int h, const int rowqA, const int rowqB, const bool win, const int r, const int qt, const int lane) {
    const int l15 = lane & 15, g = lane >> 4;
    const f32x4 z = {0.f, 0.f, 0.f, 0.f};
    bf16x8 qA[2], qB[2];
    { const bf16* qp = KQ + (size_t)(rowqA + l15) * 2048 + 1024 + h * 64 + 8 * g; qA[0] = *(const bf16x8*)qp; qA[1] = *(const bf16x8*)(qp + 32); }
    { const bf16* qp = KQ + (size_t)(rowqB + l15) * 2048 + 1024 + h * 64 + 8 * g; qB[0] = *(const bf16x8*)qp; qB[1] = *(const bf16x8*)(qp + 32); }
    AttnState SA, SB; SA.m = 0.f; SA.sum = 0.f; SB.m = 0.f; SB.sum = 0.f;
#pragma unroll
    for (int dt = 0; dt < 4; ++dt) { SA.o[dt] = z; SB.o[dt] = z; }
    if (win) {
        const int rsA = min(max(r - 4, 0), 56), dB = min(max(r - 3, 0), 56) - rsA, kc0 = min(max(16 * qt - 8, 0), 32);
        const int q = 16 * qt + l15, csq = min(max(q - 8, 0), 48);
        const int krow0 = 8 * (l15 >> 2) + (l15 & 3);
        const bf16* kb = KQ + (size_t)(b * SEQ + kc0 + krow0) * 2048 + h * 64 + 8 * g;
        const bf16* vb = VT + (size_t)(b * 1024 + h * 64 + l15) * 4096 + kc0 + 8 * g;
        const LAS float* rp = (const LAS float*)(lds + ALDS_RP);
        const int jb = kc0 + 8 * g;
        const int okb = jb - csq;
        const LAS float* rpl = rp + 16 + (jb - q + 15);
        float madd[2][4];
#pragma unroll
        for (int t = 0; t < 2; ++t)
#pragma unroll
            for (int j = 0; j < 4; ++j) madd[t][j] = ((unsigned)(okb + 4 * t + j) < 16u) ? 0.f : -__builtin_inff();
        bf16x8 K0[2][2], K1[2][2]; u32x4 V0[1][4], V1[1][4];
#define ATT_LOADW(KB, VB, i) do { const int gr_ = min(rsA + (i), 63); const bf16* kp_ = kb + (size_t)(gr_ * 64) * 2048; const bf16* vp_ = vb + gr_ * 64; \
        _Pragma("unroll") for (int t = 0; t < 2; ++t) { KB[t][0] = *(const bf16x8*)(kp_ + (size_t)(4 * t) * 2048); KB[t][1] = *(const bf16x8*)(kp_ + (size_t)(4 * t) * 2048 + 32); } \
        _Pragma("unroll") for (int dt = 0; dt < 4; ++dt) VB[0][dt] = *(const u32x4*)(vp_ + (size_t)(16 * dt) * 4096); } while (0)
#define ATT_ONE(ST, QF, KB, VB, roff, rowok) do { f32x4 sc[2]; \
        const LAS float* bp_ = rpl + ((rowok) ? (roff) : 15) * 64; \
        _Pragma("unroll") for (int t = 0; t < 2; ++t) _Pragma("unroll") for (int j = 0; j < 4; ++j) sc[t][j] = (bp_[4 * t + j] + madd[t][j]) - ST.m;     \
        _Pragma("unroll") for (int t = 0; t < 2; ++t) { sc[t] = MFMA16(KB[t][0], QF[0], sc[t]); sc[t] = MFMA16(KB[t][1], QF[1], sc[t]); } \
        attn_tail<2>(ST, sc, VB); } while (0)
#define ATT_COMPUTE(KB, VB, i) do { const int roffA_ = min(rsA + (i) - r + 7, 14); \
        ATT_ONE(SA, qA, KB, VB, roffA_, (i) <= 7); \
        ATT_ONE(SB, qB, KB, VB, max(roffA_ - 1, 0), (i) >= dB && (i) <= 7 + dB); } while (0)
        ATT_LOADW(K0, V0, 0);
#pragma unroll 1
        for (int i = 0; i < 8; i += 2) { ATT_LOADW(K1, V1, i + 1); ATT_COMPUTE(K0, V0, i); ATT_LOADW(K0, V0, i + 2); ATT_COMPUTE(K1, V1, i + 1); }
        ATT_COMPUTE(K0, V0, 8);
#undef ATT_LOADW
#undef ATT_ONE
#undef ATT_COMPUTE
    }
    { const LAS bf16* ck = (const LAS bf16*)(lds + ALDS_CK) + l15 * ACK_STRIDE + 8 * g;
      const LAS bf16* cv = (const LAS bf16*)(lds + ALDS_CV) + l15 * ACV_STRIDE + 8 * g;
#pragma unroll 1
      for (int c = 0; c < 4; ++c) {
          bf16x8 kf[4][2]; u32x4 vw[2][4];
#pragma unroll
          for (int t = 0; t < 4; ++t) { const LAS bf16* kp = ck + (64 * c + 16 * t) * ACK_STRIDE; kf[t][0] = *(const LAS bf16x8*)kp; kf[t][1] = *(const LAS bf16x8*)(kp + 32); }
#pragma unroll
          for (int ks = 0; ks < 2; ++ks)
#pragma unroll
              for (int dt = 0; dt < 4; ++dt) vw[ks][dt] = *(const LAS u32x4*)(cv + (16 * dt) * ACV_STRIDE + 64 * c + 32 * ks);
          { f32x4 sc[4]; const float nm = -SA.m; const f32x4 c0 = {nm, nm, nm, nm};
#pragma unroll
            for (int t = 0; t < 4; ++t) { sc[t] = MFMA16(kf[t][0], qA[0], c0); sc[t] = MFMA16(kf[t][1], qA[1], sc[t]); }
            attn_tail<4>(SA, sc, vw); }
          { f32x4 sc[4]; const float nm = -SB.m; const f32x4 c0 = {nm, nm, nm, nm};
#pragma unroll
            for (int t = 0; t < 4; ++t) { sc[t] = MFMA16(kf[t][0], qB[0], c0); sc[t] = MFMA16(kf[t][1], qB[1], sc[t]); }
            attn_tail<4>(SB, sc, vw); }
      } }
    { const float inv = 1.0f / xrow16_sum(SA.sum);
#pragma unroll
      for (int dt = 0; dt < 4; ++dt) st_bf4(ATT + (size_t)(rowqA + l15) * 1024 + h * 64 + 16 * dt + 4 * g, SA.o[dt] * inv); }
    { const float inv = 1.0f / xrow16_sum(SB.sum);
#pragma unroll
      for (int dt = 0; dt < 4; ++dt) st_bf4(ATT + (size_t)(rowqB + l15) * 1024 + h * 64 + 16 * dt + 4 * g, SB.o[dt] * inv); }
}
__device__ __forceinline__ void p_attn_mfma(const Params& P, Frame& F, int l, bool with_ctx_queries, int nblk, int rank) {
    const bf16* KQ = WSP(bf16, WS_KQ); const bf16* VT = WSP(bf16, WS_VT); bf16* ATT = WSP(bf16, WS_ATT);
    const float* rpb = P.rpb + (size_t)l * 16 * 465;
    const int it0 = (int)(((long)rank * 1024) / nblk), it1 = (int)(((long)(rank + 1) * 1024) / nblk);
    int pcur = -1;
    for (int hp = it0; hp < it1; ++hp) {
        const int p = hp >> 3, eighth = hp & 7, b = p >> 4, h = p & 15;
        if (p != pcur) { pcur = p;
        __syncthreads();
        { LAS bf16* ck = (LAS bf16*)(F.lds + ALDS_CK); LAS bf16* cv = (LAS bf16*)(F.lds + ALDS_CV); LAS float* rp = (LAS float*)(F.lds + ALDS_RP);
          { const int key = F.tid >> 1, hf = F.tid & 1; const int k32 = key & 31, pos = (key & ~31) + ((k32 >> 2) & 1) * 16 + 4 * (k32 >> 3) + (k32 & 3);
            const u32x4* src = (const u32x4*)(KQ + (size_t)(RL + b * CTXL + key) * 2048 + h * 64 + hf * 32); LAS u32x4* dst = (LAS u32x4*)(ck + pos * ACK_STRIDE + hf * 32);
#pragma unroll
            for (int i = 0; i < 4; ++i) dst[i] = src[i]; }
          { const int d = F.tid >> 3, sg = F.tid & 7; const u32x4* src = (const u32x4*)(VT + YT_CTX_OFF + (size_t)(b * 1024 + h * 64 + d) * 256 + sg * 32); LAS u32x4* dst = (LAS u32x4*)(cv + d * ACV_STRIDE + sg * 32);
#pragma unroll
            for (int i = 0; i < 4; ++i) dst[i] = src[i]; }
          for (int i = F.tid; i < 16 * 64; i += NTHREADS) { const int rr = i >> 6, cc = (i & 63) - 16; rp[i] = rr == 15 ? -__builtin_inff() : ((cc >= 0 && cc < 31) ? rpb[h * 465 + rr * 31 + cc] * LOG2E : 0.f); } }
        __syncthreads(); }
        const int qt = F.wave & 3, rpi = F.wave >> 2;
#pragma unroll 1
        for (int st = 0; st < 2; ++st) { const int r = eighth * 8 + st * 4 + rpi * 2; const int rowqA = b * SEQ + r * 64 + 16 * qt;
            attn_unit2(KQ, VT, ATT, F.lds, b, h, rowqA, rowqA + 64, true, r, qt, F.lane); }
        if (with_ctx_queries && eighth == 0) { const int rowqA = RL + b * CTXL + 32 * F.wave; attn_unit2(KQ, VT, ATT, F.lds, b, h, rowqA, rowqA + 16, false, 0, 0, F.lane); }
    }
    __syncthreads();
}

__device__ __forceinline__ void ld8(const bf16* p, float (&x)[8]) { const u32x4 w = *(const u32x4*)p;
#pragma unroll
    for (int q = 0; q < 4; ++q) { x[2 * q] = bflo(w[q]); x[2 * q + 1] = bfhi(w[q]); } }
__device__ __forceinline__ void p_pool(Frame& F, int nrows) {
    const bf16* PB = WSP(bf16, WS_PB); bf16* POOL = WSP(bf16, WS_POOL);
    for (int i = F.bid * NTHREADS + F.tid; i < (nrows >> 4) * 64; i += F.G * NTHREADS) {
        const int row0 = (i >> 6) << 4, ch = i & 63, g = ch >> 4, hw = 1 << g;
        int base, t0, Lb; if (row0 < RL) { base = row0 & ~4095; t0 = row0 & 4095; Lb = SEQ; } else { const int rr = row0 - RL; base = RL + (rr & ~255); t0 = rr & 255; Lb = CTXL; }
        const bf16* src = PB + (size_t)base * 512 + ch * 8;
        float S[8];
#pragma unroll
        for (int q = 0; q < 8; ++q) S[q] = 0.f;
#pragma unroll 4
        for (int d = -8; d < 8; ++d) { const int tt = t0 + d; if (d >= -hw && d < hw && tt >= 0 && tt < Lb) { float x[8]; ld8(src + (size_t)tt * 512, x);
#pragma unroll
                for (int q = 0; q < 8; ++q) S[q] += x[q]; } }
#pragma unroll 2
        for (int j = 0; j < 16; ++j) { const int t = t0 + j; const int lo = max(t - hw, 0), hi = min(t + hw, Lb); const float inv = 1.0f / (float)(hi - lo);
            float me[8]; ld8(src + (size_t)t * 512, me);
            u32x4 o;
#pragma unroll
            for (int q = 0; q < 4; ++q) o[q] = pk2(S[2 * q] * inv - me[2 * q], S[2 * q + 1] * inv - me[2 * q + 1]);
            *(u32x4*)(POOL + (size_t)(base + t) * 512 + ch * 8) = o;
            if (t + hw < Lb) { float x[8]; ld8(src + (size_t)(t + hw) * 512, x);
#pragma unroll
                for (int q = 0; q < 8; ++q) S[q] += x[q]; }
            if (t - hw >= 0) { float x[8]; ld8(src + (size_t)(t - hw) * 512, x);
#pragma unroll
                for (int q = 0; q < 8; ++q) S[q] -= x[q]; } }
    }
}

__device__ __forceinline__ int block_sum_i(int v, LAS int* sm, int tid) {
    v = wave_sum_i(v);
    __syncthreads();
    if ((tid & 63) == 0) sm[tid >> 6] = v;
    __syncthreads();
    int s = 0;
#pragma unroll
    for (int i = 0; i < 8; ++i) s += sm[i];
    return s;
}
__device__ __forceinline__ int block_excl_scan(int v, LAS int* sm, int tid, int& total) {
    const int lane = tid & 63, w = tid >> 6; int inc = v;
#pragma unroll
    for (int o = 1; o < 64; o <<= 1) { const int t = __builtin_amdgcn_ds_bpermute(((lane - o) & 63) << 2, inc); if (lane >= o) inc += t; }
    __syncthreads();
    if (lane == 63) sm[w] = inc;
    __syncthreads();
    int base = 0; total = 0;
#pragma unroll
    for (int i = 0; i < 8; ++i) { const int s = sm[i]; if (i < w) base += s; total += s; }
    return base + inc - v;
}
template <int NPT>
__device__ __forceinline__ void topk_pair(Frame& F, int row0, int n, int cap, int e, int slot0) {
    LAS int* sm = (LAS int*)F.lds;
    const float* AFF = WSP(float, WS_AFF); int* SROW = WSP(int, WS_SROW); float* SG = WSP(float, WS_SGATE); int* SEL = WSP(int, WS_SEL);
    unsigned key[NPT];
#pragma unroll
    for (int j = 0; j < NPT; ++j) { const int i = F.tid * NPT + j; key[j] = (i < n) ? __float_as_uint(AFF[(size_t)(row0 + i) * 16 + e]) : 0u; }
    unsigned T = 0u;
    for (int bit = 30; bit >= 0; --bit) { const unsigned cand = T | (1u << bit); int cnt = 0;
#pragma unroll
        for (int j = 0; j < NPT; ++j) cnt += (key[j] >= cand) ? 1 : 0;
        cnt = block_sum_i(cnt, sm, F.tid);
        if (cnt >= cap) T = cand; }
    int ngt = 0, neq = 0;
#pragma unroll
    for (int j = 0; j < NPT; ++j) { ngt += (key[j] > T) ? 1 : 0; neq += (key[j] == T) ? 1 : 0; }
    int tot_gt, tot_eq;
    (void)block_excl_scan(ngt, sm, F.tid, tot_gt);
    int eqr = block_excl_scan(neq, sm, F.tid, tot_eq);
    const int need_eq = cap - tot_gt;
    int nsel = 0; bool selj[NPT];
#pragma unroll
    for (int j = 0; j < NPT; ++j) { bool s = key[j] > T; if (key[j] == T && T != 0u) { s = eqr < need_eq; ++eqr; } selj[j] = s; nsel += s ? 1 : 0; }
    int tot_sel; int pos = block_excl_scan(nsel, sm, F.tid, tot_sel);
#pragma unroll
    for (int j = 0; j < NPT; ++j) { const int i = F.tid * NPT + j;
        if (i < n) { const int row = row0 + i;
            if (selj[j]) { const int slot = slot0 + pos; ++pos; SROW[slot] = row; SG[slot] = __uint_as_float(key[j]); SEL[(size_t)row * 16 + e] = slot; }
            else SEL[(size_t)row * 16 + e] = -1; } }
    __syncthreads();
}
__device__ __forceinline__ void p_topk(Frame& F, bool with_ctx) {
    const int npairs = 128 + (with_ctx ? 128 : 0);
    for (int pi = F.bid; pi < npairs; pi += F.G) {
        if (pi < 128) { const int b = pi >> 4, e = pi & 15; topk_pair<8>(F, b * SEQ, SEQ, CAPL, e, e * SLOT_E + b * CAPL); }
        else { const int p2 = pi - 128, b = p2 >> 4, e = p2 & 15; topk_pair<1>(F, RL + b * CTXL, CTXL, CAPC, e, e * SLOT_E + 4096 + b * CAPC); }
    }
}
template <int PH> __global__ void __launch_bounds__(NTHREADS, 2) fwd_kernel(Params P) {
    extern __shared__ __attribute__((aligned(16))) unsigned char lds_raw[];
    Frame F; F.lds = (LAS unsigned char*)lds_raw; F.tid = threadIdx.x; F.lane = F.tid & 63; F.wave = __builtin_amdgcn_readfirstlane(F.tid >> 6); F.G = gridDim.x; F.bid = blockIdx.x; F.ws = P.ws;
    const int wave0 = __builtin_amdgcn_readfirstlane((int)threadIdx.x >> 6);
    volatile LAS unsigned* MISC = (volatile LAS unsigned*)(F.lds + LDS_MISC);
    if (F.tid < 64) MISC[F.tid] = 0u;
    __syncthreads();
    XcdBarrier bar; bar.bar = WSP(unsigned, WS_CTL) + CW_BAR; bar.x = 0; bar.st = MISC + 8;
    if constexpr (PH < 0) bar = xcd_barrier_post(WSP(unsigned, WS_CTL) + CW_BAR, MISC + 8);
#define IN(k) (PH < 0 || PH == (k))
#define REFRESH() do { unsigned on_ = ~0u; asm volatile("" : "+s"(on_)); int t_ = wave0 * 64 + (int)__builtin_amdgcn_mbcnt_hi(on_, __builtin_amdgcn_mbcnt_lo(on_, 0u)); asm volatile("" : "+v"(t_)); F.tid = t_; F.lane = t_ & 63; F.wave = __builtin_amdgcn_readfirstlane(t_ >> 6); } while (0)
#define SEAM(k) do { if constexpr (PH < 0) xcd_barrier(bar); } while (0)

    if (IN(0)) { REP_BEGIN(100) p_mod(P, F); p_dftgen(F); REP_END REP_BEGIN(101) p_wconv(P, F, 0); REP_END }
    SEAM(0);
    if (IN(1)) { p_rowpass_a0(P, F); }
    SEAM(1);
    for (int l = P.l_lo; l < P.l_hi; ++l) {
        constexpr int pb = 2; const bool L0 = (l == 0);
        bf16* H = WSP(bf16, WS_H);
        if (IN(pb + 0)) { REFRESH(); REP_BEGIN(2)
            const int u1 = 128 * 8 + 8 * (L0 ? 8 : 4), u2 = 128 * 14 + (L0 ? 8 * 14 : 0), u3 = 4 * 128 + (L0 ? 4 * 8 : 0);
            const bf16* H8 = WSP(bf16, WS_H8); const bf16* WA8 = WSP(bf16, WS_WA8);
            { GroupSched S; S.init(1, 128, 8, F.G, F.bid, 8, L0 ? 8 : 4, 128, 0);
              auto AD = [=](const Unit& u) { return Operands{H8 + (size_t)u.pm * 256 * 512, WA8 + (size_t)u.pn * 256 * 512, 512, 512, 0, 512}; };
              bf16* KQ = WSP(bf16, WS_KQ);
              auto E = [=](EPI_ARGS) { const int row0 = u.pm * 256; const float qs = (u.pn >= 4) ? QSCALE * INV8 : INV8;
                  EPI_FOR8( st_bf8(KQ + (size_t)(row0 + r) * 2048 + u.pn * 256 + c, v0 * qs, v1 * qs); ) };
              GEMM_P8(S, AD, E); }
            REFRESH();
            { GroupSched S; S.init(1, 128, 14, F.G, (F.bid + F.G - ((u1 % F.G) & ~7)) % F.G, L0 ? 8 : 0, 14, 128, 0);
              const bf16* WA = WSP(bf16, WS_WA);
              auto AD = [=](const Unit& u) { return Operands{H + (size_t)u.pm * 256 * DM, WA + (size_t)(u.pn + 8) * 256 * DM, DM, DM, 0, DM}; };
              bf16* PBp = WSP(bf16, WS_PB); bf16* GB = WSP(bf16, WS_GB);
              auto E = [=](EPI_ARGS) { const int row0 = u.pm * 256;
                  if (u.pn < 2) { EPI_FOR8( st_bf8(PBp + (size_t)(row0 + r) * 512 + u.pn * 256 + c, v0, v1); ) }
                  else { EPI_FOR8( f32x4 s0; f32x4 s1; _Pragma("unroll") for (int j = 0; j < 4; ++j) { s0[j] = sigmoidf_(v0[j]); s1[j] = sigmoidf_(v1[j]); } st_bf8(GB + (size_t)(row0 + r) * 3072 + (u.pn - 2) * 256 + c, s0, s1); ) } };
              GEMM_P(S, AD, E); }
            REFRESH();
            { GroupSched S; S.init(1, 4, 128, F.G, (F.bid + F.G - (((u1 + u2) % F.G) & ~7)) % F.G, L0 ? 4 : 0, 8, 0, 128);
              const bf16* WFV = WSP(bf16, WS_WFV);
              auto AD = [=](const Unit& u) { const bool fmap = (u.pn < 128); const int t16 = u.pn & 15;
                  const size_t tok0 = fmap ? (size_t)(u.pn >> 4) * SEQ + 64 * ((t16 >> 1) * 8) + (t16 & 1) * 32 : (size_t)u.pn * 256;
                  return Operands{WFV + (size_t)u.pm * 256 * DM, H + tok0 * DM, DM, DM, 0, DM, fmap ? 1 : 0}; };
              bf16* YT = WSP(bf16, WS_YT);
              auto E = [=](EPI_ARGS) { const int rr0 = u.pm * 256;
                  if (u.pn < 128) { const int b = u.pn >> 4; const int t16 = u.pn & 15, l10 = (t16 >> 1) * 8, l20 = (t16 & 1) * 32;
                      EPI_FOR8( const int fc = rr0 + r; st_bf8(YT + (((((size_t)b * 512 + (fc >> 1)) * 32 + (c >> 3)) * 2 + (l20 >> 5)) * 2 + (fc & 1)) * 64 + l10, v0, v1); ) }
                  else { const int b = u.pn - 128; EPI_FOR8( st_bf8(YT + YT_CTX_OFF + ((size_t)b * 1024 + rr0 + r) * 256 + c, v0, v1); ) } };
              GEMM_P(S, AD, E); }
            REFRESH();
            { GroupSched S; S.init(1, 4, 128, F.G, (F.bid + F.G - (((u1 + u2 + u3) % F.G) & ~7)) % F.G, 4, 8, 0, 128);
              auto AD = [=](const Unit& u) { return Operands{WA8 + (size_t)(2048 + u.pm * 256) * 512, H8 + (size_t)u.pn * 256 * 512, 512, 512, 0, 512}; };
              bf16* VT = WSP(bf16, WS_VT);
              auto E = [=](EPI_ARGS) { const int rr0 = u.pm * 256;
                  if (u.pn < 128) { const int b = u.pn >> 4, l0 = (u.pn & 15) * 256; EPI_FOR8( st_bf8(VT + ((size_t)b * 1024 + rr0 + r) * 4096 + l0 + c, v0 * INV8, v1 * INV8); ) }
                  else { const int b = u.pn - 128; EPI_FOR8( st_bf8(VT + YT_CTX_OFF + ((size_t)b * 1024 + rr0 + r) * 256 + c, v0 * INV8, v1 * INV8); ) } };
              GEMM_P8(S, AD, E); }
        REP_END }
        SEAM(pb + 0);
        if (IN(pb + 1)) { REFRESH();
            { const int nc0 = (F.G * 5 / 16) & ~7, nconv = nc0 > 0 ? nc0 : 1, na = F.G - nconv;
              if (F.bid < na) p_attn_mfma(P, F, l, L0, na, F.bid);
              else wconv_experts(P, F, l, F.bid - na, nconv); }
            REFRESH();
            REP_BEGIN(32)
            { LAS float* tw = (LAS float*)(F.lds + LDS_TW);
              for (int j = F.tid; j < 4096; j += NTHREADS) tw[j] = cospif((float)j * (1.0f / 2048.0f));
              __syncthreads();
              GroupSched S; S.init(1, 1, 512, F.G, F.bid);
              const bf16* M1 = WSP(bf16, WS_M1T); const bf16* YF = WSP(bf16, WS_YT); bf16* ZP = WSP(bf16, WS_ZP);
              auto AD = [=](const Unit& u) { return Operands{M1, YF + (size_t)u.pn * 256 * 256, 256, 256, 0, 256}; };
              auto E = [=](EPI_ARGS) {
                  const int b = u.pn >> 6, gm0 = (u.pn & 63) * 8 + wc, l20 = 32 * wr + 8 * fq;
#pragma unroll
                  for (int m = 0; m < 4; ++m) { const int k1 = 16 * m + fr;
#pragma unroll
                      for (int bj = 0; bj < 2; ++bj) { const int gm = gm0 + 4 * bj;
                          f32x4 zr[2], zi[2];
#pragma unroll
                          for (int n = 0; n < 2; ++n)
#pragma unroll
                              for (int j = 0; j < 4; ++j) { const int ix = k1 * (l20 + 4 * n + j); const float tc = tw[ix], ts = tw[(ix + 3072) & 4095];
                                  const float ur = acc[0][bj][m][n][j], ui = acc[1][bj][m][n][j]; zr[n][j] = ur * tc - ui * ts; zi[n][j] = ur * ts + ui * tc; }
                          bf16* dst = ZP + (((((size_t)b * 64 + k1) * 128 + (gm & 127)) * 4 + (gm >> 7)) * 2) * 64 + l20;
                          st_bf8(dst, zr[0], zr[1]); st_bf8(dst + 64, zi[0], zi[1]); } } };
              GEMM_P(S, AD, E); }
            REP_END
        }
        SEAM(pb + 1);
        if (IN(pb + 10)) { REFRESH();
            { GroupSched S; S.init(1, 1, 256, F.G, F.bid);
              const bf16* M2 = WSP(bf16, WS_M2T); const bf16* ZP = WSP(bf16, WS_ZP); bf16* FOUR = WSP(bf16, WS_FOUR);
              auto AD = [=](const Unit& u) { return Operands{M2, ZP + (size_t)u.pn * 256 * 512, 512, 512, 0, 512}; };
              auto E = [=](EPI_ARGS) { const float sc = 0.0013810679320049757f;
#pragma unroll
                  for (int ai = 0; ai < 2; ++ai)
#pragma unroll
                      for (int m = 0; m < 4; ++m) { const int q = 2 * ai + wr, k2 = 16 * m + fr;
#pragma unroll
                          for (int bj = 0; bj < 2; ++bj) { const int bk = u.pn * 2 + bj, b = bk >> 6, k1 = bk & 63;
                              st_bf8(FOUR + ((size_t)b * SEQ + k1 + 64 * k2) * 512 + q * 128 + wc * 32 + 8 * fq, acc[ai][bj][m][0] * sc, acc[ai][bj][m][1] * sc); } } };
              GEMM_P(S, AD, E); }
            REFRESH();
            if (L0) { GroupSched S; S.init(1, 1, 16, F.G, (F.bid + F.G - 128 % F.G) % F.G);
              const bf16* DFTC = WSP(bf16, WS_DFTC); const bf16* YTC = WSP(bf16, WS_YT) + YT_CTX_OFF; bf16* FOUR = WSP(bf16, WS_FOUR);
              auto AD = [=](const Unit& u) { return Operands{DFTC, YTC + (size_t)u.pn * 256 * 512, 512, 512, 0, 512}; };
              auto E = [=](EPI_ARGS) { const int b = u.pn >> 1, c0 = (u.pn & 1) * 256; const float sc = 0.005524271728019903f;
                  EPI_FOR8( st_bf8(FOUR + ((size_t)RL + b * CTXL + r) * 512 + c0 + c, v0 * sc, v1 * sc); ) };
              GEMM_P(S, AD, E); }
            REFRESH();
            REP_BEGIN(33) p_pool(F, L0 ? RT : RL); REP_END
        }
        SEAM(pb + 10);
        if (IN(pb + 2)) { REFRESH();
            SegSched<3> S; S.base.init(1, L0 ? 136 : 128, 4, F.G, F.bid);
            const bf16* ATT = WSP(bf16, WS_ATT); const bf16* FOUR = WSP(bf16, WS_FOUR); const bf16* POOL = WSP(bf16, WS_POOL);
            const bf16* WAO = WSP(bf16, WS_WAO); const bf16* WFO = WSP(bf16, WS_WFO); const bf16* WPO = WSP(bf16, WS_WPO);
            const bf16* GB = WSP(bf16, WS_GB); bf16* MRGB = WSP(bf16, WS_MRGB); const float* ps = P.pool_scale + l * 1024;
            auto AD = [=](const Unit& u) {
                if (u.seg == 0) return Operands{ATT + (size_t)u.pm * 256 * 1024, WAO + (size_t)u.pn * 256 * 1024, 1024, 1024, 0, 1024};
                if (u.seg == 1) return Operands{FOUR + (size_t)u.pm * 256 * 512, WFO + (size_t)u.pn * 256 * 512, 512, 512, 0, 512};
                return Operands{POOL + (size_t)u.pm * 256 * 512 + (u.pn >> 1) * 256, WPO + (size_t)u.pn * 256 * 256, 512, 256, 0, 256}; };
            auto E = [=](EPI_ARGS) {
                const int kd = u.seg < 2 ? u.seg + 1 : 2; const bool fin = (u.seg == 2); const int colb = u.pn * 256 + wc * 32 + 8 * fq;
#pragma unroll
                for (int ai = 0; ai < 2; ++ai)
#pragma unroll
                    for (int m = 0; m < 4; ++m) { const size_t row = (size_t)u.pm * 256 + ai * 128 + wr * 64 + m * 16 + fr; const bf16* gr = GB + row * 3072 + colb;
                        u32x4 nr[2], dr[2]; f32x4 psv[2][2];
#pragma unroll
                        for (int bj = 0; bj < 2; ++bj) { nr[bj] = *(const u32x4*)(gr + u.seg * 1024 + bj * 128); dr[bj] = *(const u32x4*)(gr + kd * 1024 + bj * 128);
                            psv[bj][0] = *(const f32x4*)(ps + colb + bj * 128); psv[bj][1] = *(const f32x4*)(ps + colb + bj * 128 + 4); }
#pragma unroll
                        for (int bj = 0; bj < 2; ++bj) { f32x4 o[2];
#pragma unroll
                            for (int n = 0; n < 2; ++n) { f32x4 nu = {bflo(nr[bj][2 * n]), bfhi(nr[bj][2 * n]), bflo(nr[bj][2 * n + 1]), bfhi(nr[bj][2 * n + 1])}, de = {bflo(dr[bj][2 * n]), bfhi(dr[bj][2 * n]), bflo(dr[bj][2 * n + 1]), bfhi(dr[bj][2 * n + 1])};
                                if (u.seg == 2) nu = nu * psv[bj][n];
                                de = de * psv[bj][n];
#pragma unroll
                                for (int j = 0; j < 4; ++j) { const float nj = (fabsf(nu[j]) < 1e-30f) ? copysignf(1e-30f, nu[j]) : nu[j]; const float dj = (fabsf(de[j]) < 1e-30f) ? copysignf(1e-30f, de[j]) : de[j];
                                    o[n][j] = acc[ai][bj][m][n][j] * nj * (fin ? 1.0f : __builtin_amdgcn_rcpf(dj)); }
                                acc[ai][bj][m][n] = o[n]; }
                            if (fin) st_bf8(MRGB + row * 1024 + colb + bj * 128, o[0], o[1]); } } };
            gemm_fast<false, true, false>(F.lds, F.tid, S, AD, mk_epi_seg(E, 2), nullptr);
        }
        SEAM(pb + 2);
        if (IN(pb + 3)) { REFRESH();
            GroupSched S; S.init(1, L0 ? 136 : 128, 4, F.G, F.bid); const bf16* A = WSP(bf16, WS_MRGB); const bf16* W = WSP(bf16, WS_WOUT);
            const float* xin = L0 ? P.x : P.out; const float* cin = L0 ? P.ctx : WSP(float, WS_XC); float* xo = P.out; float* co = WSP(float, WS_XC);
            const float* MOD = WSP(float, WS_MOD) + (size_t)l * 9 * 6144;
            auto AD = [=](const Unit& u) { return Operands{A + (size_t)u.pm * 256 * 1024, W + (size_t)u.pn * 256 * 1024, 1024, 1024, 0, 1024}; };
            auto E = [=](EPI_ARGS) {
                const int row0 = u.pm * 256, mr = row0 < RL ? (row0 >> 12) : 8, colb = u.pn * 256 + wc * 32 + 4 * fq;
                const float* src0 = row0 < RL ? xin + (size_t)row0 * DM : cin + (size_t)(row0 - RL) * DM; float* dst0 = row0 < RL ? xo + (size_t)row0 * DM : co + (size_t)(row0 - RL) * DM;
                f32x4 gv[2][2];
#pragma unroll
                for (int bj = 0; bj < 2; ++bj)
#pragma unroll
                    for (int n = 0; n < 2; ++n) gv[bj][n] = *(const f32x4*)(MOD + (size_t)mr * 6144 + 2048 + colb + bj * 128 + n * 16);
#pragma unroll
                for (int ai = 0; ai < 2; ++ai) { f32x4 xv[4][2][2];
#pragma unroll
                    for (int m = 0; m < 4; ++m) { const size_t ro = (size_t)(ai * 128 + wr * 64 + m * 16 + fr) * DM + colb;
#pragma unroll
                        for (int bj = 0; bj < 2; ++bj)
#pragma unroll
                            for (int n = 0; n < 2; ++n) xv[m][bj][n] = *(const f32x4*)(src0 + ro + bj * 128 + n * 16); }
#pragma unroll
                    for (int m = 0; m < 4; ++m) { const size_t ro = (size_t)(ai * 128 + wr * 64 + m * 16 + fr) * DM + colb;
#pragma unroll
                        for (int bj = 0; bj < 2; ++bj)
#pragma unroll
                            for (int n = 0; n < 2; ++n) *(f32x4*)(dst0 + ro + bj * 128 + n * 16) = xv[m][bj][n] + gv[bj][n] * acc[ai][bj][m][n]; } } };
            GEMM(S, AD, E, 1024, 1024, 1024);
        }
        SEAM(pb + 3);
        if (IN(pb + 4)) { REFRESH(); REP_BEGIN(6) p_rowpass_f(P, F, l, L0 ? RT : RL); REP_END }
        SEAM(pb + 4);
        if (IN(pb + 5)) { REFRESH(); REP_BEGIN(7) p_topk(F, L0); REP_END }
        SEAM(pb + 5);
        if (IN(pb + 7)) { REFRESH(); REP_BEGIN(9)
            GroupSched S; S.init(16, L0 ? 17 : 16, 22, F.G, F.bid); const bf16* H8 = WSP(bf16, WS_H8); const bf16* W = WSP(bf16, WS_WGU); unsigned char* HID = WSP(unsigned char, WS_HID); const int* SROW = WSP(int, WS_SROW);
            auto AD = [=](const Unit& u) { return Operands{H8, W + ((size_t)u.grp * 5632 + u.pn * 256) * 512, 512, 512, u.grp * SLOT_E + u.pm * 256, 512}; };
            auto E = [=](EPI_ARGS) {
#pragma unroll
                for (int ai = 0; ai < 2; ++ai)
#pragma unroll
                    for (int m = 0; m < 4; ++m) { const size_t slot = (size_t)u.grp * SLOT_E + u.pm * 256 + ai * 128 + wr * 64 + m * 16 + fr; f32x4 o[2];
#pragma unroll
                        for (int n = 0; n < 2; ++n) { const f32x4 a = acc[ai][0][m][n] * INV8, up = acc[ai][1][m][n] * (INV8 * A8S);
#pragma unroll
                            for (int j = 0; j < 4; ++j) o[n][j] = a[j] * sigmoidf_(a[j]) * up[j]; }
                        u32x2 w; w.x = pk4_fp8(o[0][0], o[0][1], o[0][2], o[0][3]); w.y = pk4_fp8(o[1][0], o[1][1], o[1][2], o[1][3]);
                        *(u32x2*)(HID + slot * FF + u.pn * 128 + wc * 32 + 8 * fq) = w; } };
            GEMM_GATHER8(S, AD, E, SROW);
        REP_END }
        SEAM(pb + 7);
        if (IN(pb + 8)) { REFRESH(); REP_BEGIN(10)
            const int tpe = L0 ? 17 : 16;
            GroupSched S; S.init(1, 16 * tpe, 4, F.G, F.bid); const bf16* HID = WSP(bf16, WS_HID); const bf16* W = WSP(bf16, WS_WD); bf16* Y = WSP(bf16, WS_Y); const float* SG = WSP(float, WS_SGATE);
            auto AD = [=](const Unit& u) { const int e = u.pm / tpe, st = e * 17 + (u.pm - e * tpe); return Operands{HID + (size_t)st * 256 * (FF / 2), W + ((size_t)e * 1024 + u.pn * 256) * (FF / 2), FF / 2, FF / 2, 0, FF / 2}; };
            auto E = [=](EPI_ARGS) { const int e = u.pm / tpe; const size_t slot0 = (size_t)(e * 17 + (u.pm - e * tpe)) * 256 + wr * 64 + fr; float gt[2][4];
#pragma unroll
                for (int ai = 0; ai < 2; ++ai)
#pragma unroll
                    for (int m = 0; m < 4; ++m) gt[ai][m] = SG[slot0 + ai * 128 + m * 16] * INV8;
#pragma unroll
                for (int ai = 0; ai < 2; ++ai)
#pragma unroll
                    for (int m = 0; m < 4; ++m)
#pragma unroll
                        for (int bj = 0; bj < 2; ++bj) st_bf8(Y + (slot0 + ai * 128 + m * 16) * DM + u.pn * 256 + bj * 128 + wc * 32 + 8 * fq, acc[ai][bj][m][0] * gt[ai][m], acc[ai][bj][m][1] * gt[ai][m]); };
            GEMM_P8(S, AD, E);
        REP_END }
        SEAM(pb + 8);
        if (IN(pb + 9)) { REFRESH(); p_rowpass_k(P, F, l, L0 ? RT : RL); if (L0) p_wconv(P, F, 1); }
        if (L0) SEAM(pb + 9);
    }
#undef IN
#undef SEAM
}
template <int PH> static void launch_ph(int grid, const Params& p, hipStream_t stream) { hipLaunchKernelGGL(fwd_kernel<PH>, dim3(grid), dim3(NTHREADS), LDS_BYTES, stream, p); }
template <int PH> static bool set_attr() { return hipFuncSetAttribute((const void*)fwd_kernel<PH>, hipFuncAttributeMaxDynamicSharedMemorySize, LDS_BYTES) == hipSuccess; }

#ifndef DUP_LAUNCH
#define DUP_LAUNCH -1
#endif
extern "C" void kernel_launch(void* const* d_in, const int* in_sizes, int n_in, void* d_out, int out_size, void* d_ws, size_t ws_size, hipStream_t stream) {
    static int grid = 0;
    if (grid == 0) {
        if (n_in != 20 || out_size != RL * DM || ws_size < WS_END) { fprintf(stderr, "kernel_launch: unexpected shapes (n_in %d out %d ws %zu need %zu)\n", n_in, out_size, ws_size, (size_t)WS_END); grid = -1; return; }
        int dev = 0, cus = 0, per_cu = 0;
        if (hipGetDevice(&dev) != hipSuccess || hipDeviceGetAttribute(&cus, hipDeviceAttributeMultiprocessorCount, dev) != hipSuccess) { grid = -1; return; }
#if N_LAUNCH_MODE == 1
        if (!set_attr<-1>()) { fprintf(stderr, "kernel_launch: hipFuncSetAttribute failed\n"); grid = -1; return; }
        if (hipOccupancyMaxActiveBlocksPerMultiprocessor(&per_cu, (const void*)fwd_kernel<-1>, NTHREADS, LDS_BYTES) != hipSuccess || per_cu < 1) fprintf(stderr, "kernel_launch: occupancy query reports %d\n", per_cu);
#else
        if (!(set_attr<0>() && set_attr<1>() && set_attr<2>() && set_attr<3>() && set_attr<12>() && set_attr<4>() && set_attr<5>() && set_attr<6>() && set_attr<7>() && set_attr<9>() && set_attr<10>() && set_attr<11>())) { fprintf(stderr, "kernel_launch: hipFuncSetAttribute failed\n"); grid = -1; return; }
        (void)per_cu;
#endif
        (void)hipGetLastError();
        grid = cus;
    }
    if (grid < 0) return;
    if (hipMemsetAsync((char*)d_ws + WS_CTL, 0, CTL_BYTES, stream) != hipSuccess) return;
    Params p{};
    const float** pp = (const float**)&p;
    for (int i = 0; i < 20; ++i) pp[i] = (const float*)d_in[i];
    p.out = (float*)d_out; p.ws = (unsigned char*)d_ws;
#if N_LAUNCH_MODE == 1
    p.l_lo = 0; p.l_hi = 2;
    launch_ph<-1>(grid, p, stream);
#else
    p.l_lo = 0; p.l_hi = 0; launch_ph<0>(grid, p, stream); if (DUP_LAUNCH == 0) launch_ph<0>(grid, p, stream); launch_ph<1>(grid, p, stream); if (DUP_LAUNCH == 1) launch_ph<1>(grid, p, stream);
#define LP(k) do { launch_ph<k>(grid, p, stream); if (DUP_LAUNCH == (k) && l == 0) launch_ph<k>(grid, p, stream); } while (0)
    for (int l = 0; l < 2; ++l) { p.l_lo = l; p.l_hi = l + 1;
        LP(2); LP(3); LP(12); LP(4); LP(5); LP(6); LP(7); LP(9); LP(10); LP(11); }
#endif
}
```

```cpp
#include <hip/hip_runtime.h>
#include <cstdio>
#include <cstdint>

#ifndef N_LAUNCH_MODE
#define N_LAUNCH_MODE 1
#endif

#define GAS __attribute__((address_space(1)))
#define LAS __attribute__((address_space(3)))
typedef unsigned short bf16;
typedef short bf16x8 __attribute__((ext_vector_type(8)));
typedef float f32x4 __attribute__((ext_vector_type(4)));
typedef unsigned u32x4 __attribute__((ext_vector_type(4)));
typedef unsigned u32x2 __attribute__((ext_vector_type(2)));

constexpr int NB = 8, SEQ = 4096, DM = 1024, CTXL = 256, NH = 16, HD = 64, GRIDW = 64;
constexpr int RL = NB * SEQ, RC = NB * CTXL, RT = RL + RC;
constexpr int INW = 7168, NE = 16, FF = 2816, CAPL = 512, CAPC = 32;
constexpr int SLOT_E = 4352, NSLOT = NE * SLOT_E;
constexpr float RMS_EPS = 1e-6f;
constexpr float LOG2E = 1.4426950408889634f, QSCALE = 0.125f * LOG2E;
constexpr float A8S = 8.0f, W8S = 64.0f, INV8 = 1.0f / (A8S * W8S);
constexpr int NWAVES = 8, NTHREADS = 512;

constexpr size_t al256(size_t x) { return (x + 255) & ~(size_t)255; }
constexpr size_t WS_CTL = 0, CTL_BYTES = 1u << 20;
constexpr size_t WS_MOD = WS_CTL + CTL_BYTES;
constexpr size_t WS_XC = al256(WS_MOD + (size_t)2 * 9 * 6144 * 4);
constexpr size_t WS_AFF = al256(WS_XC + (size_t)RC * DM * 4);
constexpr size_t WS_SROW = al256(WS_AFF + (size_t)RT * 16 * 4);
constexpr size_t WS_SGATE = al256(WS_SROW + (size_t)NSLOT * 4);
constexpr size_t WS_SEL = al256(WS_SGATE + (size_t)NSLOT * 4);
constexpr size_t WS_DFTM = al256(WS_SEL + (size_t)RT * 16 * 4);
constexpr size_t WS_DFTC = al256(WS_DFTM + (size_t)4096 * 8192 * 2);
constexpr size_t WS_WA = al256(WS_DFTC + (size_t)256 * 512 * 2);
constexpr size_t WS_WFV = al256(WS_WA + (size_t)5632 * 1024 * 2);
constexpr size_t WS_WAO = al256(WS_WFV + (size_t)2048 * 1024 * 2);
constexpr size_t WS_WFO = al256(WS_WAO + (size_t)1024 * 1024 * 2);
constexpr size_t WS_WPO = al256(WS_WFO + (size_t)1024 * 512 * 2);
constexpr size_t WS_WOUT = al256(WS_WPO + (size_t)1024 * 256 * 2);
constexpr size_t WS_WGU = al256(WS_WOUT + (size_t)1024 * 1024 * 2);
constexpr size_t WS_WD = al256(WS_WGU + (size_t)16 * 5632 * 1024);
constexpr size_t WS_WA8 = al256(WS_WD + (size_t)16 * 1024 * 2816);
constexpr size_t WS_H = al256(WS_WA8 + (size_t)6144 * 1024);
constexpr size_t WS_H8 = al256(WS_H + (size_t)RT * DM * 2);
constexpr size_t WS_R = al256(WS_H8 + (size_t)RT * DM);
constexpr size_t WS_KQ = WS_R;
constexpr size_t WS_MRG = WS_KQ;
constexpr size_t WS_PB = al256(WS_KQ + (size_t)RT * 2048 * 2);
constexpr size_t WS_GB = al256(WS_PB + (size_t)RT * 512 * 2);
constexpr size_t WS_YT = al256(WS_GB + (size_t)RT * 3072 * 2);
constexpr size_t WS_MRGB = WS_YT;
constexpr size_t WS_VT = al256(WS_YT + (size_t)RT * 1024 * 2);
constexpr size_t WS_FOUR = al256(WS_VT + (size_t)RT * 1024 * 2);
constexpr size_t WS_ATT = al256(WS_FOUR + (size_t)RT * 512 * 2);
constexpr size_t WS_POOL = al256(WS_ATT + (size_t)RT * 1024 * 2);
constexpr size_t WS_MIX_END = al256(WS_POOL + (size_t)RT * 512 * 2);
constexpr size_t WS_XG = WS_R;
constexpr size_t WS_HID = al256(WS_XG + (size_t)NSLOT * 1024 * 2);
constexpr size_t WS_Y = al256(WS_HID + (size_t)NSLOT * 2816);
constexpr size_t WS_MOE_END = al256(WS_Y + (size_t)NSLOT * 1024 * 2);
constexpr size_t WS_END0 = WS_MIX_END > WS_MOE_END ? WS_MIX_END : WS_MOE_END;
constexpr size_t WS_ZP = WS_END0;
constexpr size_t WS_M1T = al256(WS_ZP + ((size_t)8 * 64 * 512 * 128 + 1024) * 2);
constexpr size_t WS_M2T = al256(WS_M1T + (size_t)256 * 256 * 2);
constexpr size_t WS_END = al256(WS_M2T + (size_t)256 * 512 * 2);
constexpr size_t YT_CTX_OFF = (size_t)8 * 1024 * 4096;

constexpr int CW_BAR = 4096;

constexpr int LDS_BYTES = 155648;
constexpr int LDS_TW = 132096;
constexpr int LDS_MISC = 131072;

__device__ __forceinline__ unsigned f2bf(float f) { unsigned u = __float_as_uint(f); return (u + 0x7fffu + ((u >> 16) & 1u)) >> 16; }
typedef __bf16 hbf16x2 __attribute__((ext_vector_type(2)));
typedef float f32x2 __attribute__((ext_vector_type(2)));
__device__ __forceinline__ unsigned pk2(float lo, float hi) { const f32x2 v = {lo, hi}; return __builtin_bit_cast(unsigned, __builtin_convertvector(v, hbf16x2)); }
__device__ __forceinline__ unsigned pk4_fp8(float a, float b, float c, float d) {
    a = __builtin_amdgcn_fmed3f(a, -448.f, 448.f); b = __builtin_amdgcn_fmed3f(b, -448.f, 448.f); c = __builtin_amdgcn_fmed3f(c, -448.f, 448.f); d = __builtin_amdgcn_fmed3f(d, -448.f, 448.f);
    int w = 0; w = __builtin_amdgcn_cvt_pk_fp8_f32(a, b, w, false); w = __builtin_amdgcn_cvt_pk_fp8_f32(c, d, w, true); return (unsigned)w; }
__device__ __forceinline__ float bf2f(unsigned b) { return __uint_as_float(b << 16); }
__device__ __forceinline__ float bflo(unsigned w) { return __uint_as_float(w << 16); }
__device__ __forceinline__ float bfhi(unsigned w) { return __uint_as_float(w & 0xffff0000u); }
template <int CTRL> __device__ __forceinline__ float dppf(float x) { return __builtin_bit_cast(float, __builtin_amdgcn_mov_dpp(__builtin_bit_cast(int, x), CTRL, 0xf, 0xf, true)); }
template <int CTRL> __device__ __forceinline__ int dppi(int x) { return __builtin_amdgcn_mov_dpp(x, CTRL, 0xf, 0xf, true); }
constexpr int DPP_XOR1 = 0xB1, DPP_XOR2 = 0x4E, DPP_ROR4 = 0x124, DPP_ROR8 = 0x128;
__device__ __forceinline__ float wave_sum(float v) {
    v += dppf<DPP_XOR1>(v); v += dppf<DPP_XOR2>(v); v += dppf<DPP_ROR4>(v); v += dppf<DPP_ROR8>(v);
    auto s = __builtin_amdgcn_permlane16_swap(__float_as_uint(v), __float_as_uint(v), false, false); v = __uint_as_float(s[0]) + __uint_as_float(s[1]);
    auto t = __builtin_amdgcn_permlane32_swap(__float_as_uint(v), __float_as_uint(v), false, false); return __uint_as_float(t[0]) + __uint_as_float(t[1]);
}
__device__ __forceinline__ float wave_max(float v) {
    v = fmaxf(v, dppf<DPP_XOR1>(v)); v = fmaxf(v, dppf<DPP_XOR2>(v)); v = fmaxf(v, dppf<DPP_ROR4>(v)); v = fmaxf(v, dppf<DPP_ROR8>(v));
    auto s = __builtin_amdgcn_permlane16_swap(__float_as_uint(v), __float_as_uint(v), false, false); v = fmaxf(__uint_as_float(s[0]), __uint_as_float(s[1]));
    auto t = __builtin_amdgcn_permlane32_swap(__float_as_uint(v), __float_as_uint(v), false, false); return fmaxf(__uint_as_float(t[0]), __uint_as_float(t[1]));
}
__device__ __forceinline__ int wave_sum_i(int v) {
    v += dppi<DPP_XOR1>(v); v += dppi<DPP_XOR2>(v); v += dppi<DPP_ROR4>(v); v += dppi<DPP_ROR8>(v);
    auto s = __builtin_amdgcn_permlane16_swap((unsigned)v, (unsigned)v, false, false); v = (int)(s[0] + s[1]);
    auto t = __builtin_amdgcn_permlane32_swap((unsigned)v, (unsigned)v, false, false); return (int)(t[0] + t[1]);
}
__device__ __forceinline__ float sigmoidf_(float x) { return __builtin_amdgcn_rcpf(1.f + __builtin_amdgcn_exp2f(x * -1.4426950408889634f)); }
#define LDS_WAIT() asm volatile("s_waitcnt lgkmcnt(0)" ::: "memory")

#define XB_TMO      128
#define XB_XCNT(j)  (256  + 64 * (j))
#define XB_XSUB(j)  (1280 + 64 * (j))
#define XB_XGEN(j)  (2304 + 64 * (j))
#define XB_TOP      3328
#define XB_TOPGEN   3392
#define XCD_BAR_WORDS 3456
#define XB_SPIN_CAP (1u << 22)

__device__ __forceinline__ unsigned xb_ld(unsigned* p)              { return __hip_atomic_load(p, __ATOMIC_RELAXED, __HIP_MEMORY_SCOPE_AGENT); }
__device__ __forceinline__ unsigned xb_add(unsigned* p, unsigned v) { return __hip_atomic_fetch_add(p, v, __ATOMIC_RELAXED, __HIP_MEMORY_SCOPE_AGENT); }
__device__ __forceinline__ unsigned xb_xcc_id() { return (unsigned)__builtin_amdgcn_s_getreg((3 << 11) | 20) & 0xFu; }
#define XB_SPIN(cond, bar) do { unsigned _sp = 0; while (cond) { __builtin_amdgcn_s_sleep(1); \
    if ((++_sp & 255u) == 0u) { if (xb_ld(&(bar)[XB_TMO])) break; if (_sp > XB_SPIN_CAP) { atomicAdd(&(bar)[XB_TMO], 1u); break; } } } } while (0)

struct XcdBarrier { unsigned* bar; unsigned x; volatile LAS unsigned* st; };

__device__ __forceinline__ XcdBarrier xcd_barrier_post(unsigned* bar, volatile LAS unsigned* st) {
    XcdBarrier b; b.bar = bar; b.x = xb_xcc_id(); b.st = st;
    if (threadIdx.x == 0) (void)xb_add(&bar[XB_XCNT(b.x)], 1u);
    return b;
}
__device__ __forceinline__ void xcd_barrier_complete(unsigned* bar, unsigned x, unsigned& nloc, unsigned& nx) {
    const unsigned G = gridDim.x * gridDim.y * gridDim.z;
    unsigned sum, cnt, mine, sp = 0u;
    for (;;) {
        sum = 0u; cnt = 0u; mine = 0u;
#pragma unroll
        for (unsigned j = 0; j < 16; ++j) { const unsigned c = xb_ld(&bar[XB_XCNT(j)]); sum += c; cnt += (c > 0u) ? 1u : 0u; mine = (j == x) ? c : mine; }
        if (sum == G) break;
        __builtin_amdgcn_s_sleep(1);
        if ((++sp & 255u) == 0u) { if (xb_ld(&bar[XB_TMO])) break; if (sp > XB_SPIN_CAP) { atomicAdd(&bar[XB_TMO], 1u); break; } }
    }
    nloc = mine > 0u ? mine : 1u; nx = cnt > 0u ? cnt : 1u;
}
__device__ __forceinline__ void xcd_barrier(const XcdBarrier& b) {
    asm volatile("s_waitcnt vmcnt(0)" ::: "memory");
    __syncthreads();
    if (threadIdx.x == 0) {
        unsigned* bar = b.bar;
        __builtin_amdgcn_s_waitcnt(0);
        unsigned nloc = b.st[0], nx = b.st[1];
        if (nloc == 0u) { xcd_barrier_complete(bar, b.x, nloc, nx); b.st[0] = nloc; b.st[1] = nx; }
        const unsigned old = xb_add(&bar[XB_XSUB(b.x)], 1u);
        const unsigned gen = old / nloc;
        if (old + 1u == (gen + 1u) * nloc) {
            __builtin_amdgcn_fence(__ATOMIC_RELEASE, "agent");
            asm volatile("s_waitcnt vmcnt(0)" ::: "memory");
            const unsigned og = xb_add(&bar[XB_TOP], 1u);
            const unsigned tg = og / nx;
            if (og + 1u == (tg + 1u) * nx) xb_add(&bar[XB_TOPGEN], 1u);
            else XB_SPIN(xb_ld(&bar[XB_TOPGEN]) == tg, bar);
            __builtin_amdgcn_fence(__ATOMIC_ACQUIRE, "agent");
            xb_add(&bar[XB_XGEN(b.x)], 1u);
            asm volatile("s_waitcnt vmcnt(0)" ::: "memory");
        } else {
            XB_SPIN(xb_ld(&bar[XB_XGEN(b.x)]) == gen, bar);
            __builtin_amdgcn_fence(__ATOMIC_ACQUIRE, "agent");
            asm volatile("s_waitcnt vmcnt(0)" ::: "memory");
        }
    }
    __syncthreads();
}

struct Params {
    const float *x, *c, *ctx, *c_ctx, *ada_w, *ada_b, *norm1_g, *norm2_g, *w_in, *rpb, *w_att_o, *w_fourier, *w_pool, *pool_scale, *w_out, *w_router, *w_eg, *w_eu, *w_ed, *final_g;
    float* out; unsigned char* ws; int l_lo, l_hi;
};
struct Frame {
    LAS unsigned char* lds;
    int tid, lane, wave, G, bid;
    unsigned char* ws;
};
#define WSP(T, off) ((T*)(F.ws + (off)))

struct Unit { int grp, pm, pn, seg; };
struct GroupSched {
    int ng, nM, nN, G, c; int tM, tN, tpm0, tpn0;
    __device__ __forceinline__ void init(int ng_, int nM_, int nN_, int G_, int c_, int tM_ = 0, int tN_ = 0, int tpm0_ = 0, int tpn0_ = 0) { ng = ng_; nM = nM_; nN = nN_; G = G_; c = c_; tM = tM_; tN = tN_; tpm0 = tpm0_; tpn0 = tpn0_; }
    __device__ __forceinline__ bool next(int i, Unit& u) const {
        const int per = nM * nN; const int L = i * G + c;
        if (L < ng * per) {
            u.grp = L / per; int wgid = L - u.grp * per;
            { const int q = per / 8, r = per % 8, xcd = wgid % 8, off = wgid / 8; wgid = (xcd < r ? xcd * (q + 1) : r * (q + 1) + (xcd - r) * q) + off; }
            const int nig = 8 * nN, gid = wgid / nig, fm = gid * 8, gsz = (nM - fm) < 8 ? (nM - fm) : 8;
            u.pm = fm + ((wgid % nig) % gsz); u.pn = (wgid % nig) / gsz; u.seg = 0; return true;
        }
        const int w = L - ng * per;
        if (w < tM * tN) { u.grp = ng; u.pm = tpm0 + (w % tM); u.pn = tpn0 + (w / tM); u.seg = 0; return true; }
        return false;
    }
};
struct Operands { const bf16* A; const bf16* Bt; int lda, ldb, slot0, K; int bmap; };

constexpr int HTB = 128 * 64 * 2;
__device__ __forceinline__ int lds_byte(int r, int c) { const int st = (r >> 4) * 2 + (c >> 5), rr = r & 15, cc = c & 31, ob = rr * 64 + cc * 2; return st * 1024 + (ob ^ (((ob >> 9) & 1) << 5)); }
__device__ __forceinline__ int perm32(int rho) { const int n = rho >> 4, i = rho & 15; return 8 * (i >> 2) + 4 * n + (i & 3); }
__device__ __forceinline__ void stage_rc(int b, int& R, int& C) { const int st = b / 1024, sb = b % 1024, swz = sb ^ (((sb >> 9) & 1) << 5); R = (st >> 1) * 16 + swz / 64; C = (st & 1) * 32 + (swz % 64) / 2; }
typedef int i32x8 __attribute__((ext_vector_type(8)));
typedef int i32x4 __attribute__((ext_vector_type(4)));
__device__ __forceinline__ i32x8 cat8(bf16x8 lo, bf16x8 hi) { const i32x4 a = __builtin_bit_cast(i32x4, lo), b = __builtin_bit_cast(i32x4, hi); return (i32x8){a[0], a[1], a[2], a[3], b[0], b[1], b[2], b[3]}; }
template <bool GATHER, bool PERM, bool FP8, class Sched, class Addr, class Epi>
__device__ __forceinline__ void gemm_fast(LAS unsigned char* lds, const int tid, const Sched& S, const Addr& AD, const Epi& E, const int* __restrict__ grows) {
    const int wid = __builtin_amdgcn_readfirstlane(tid >> 6), lane = tid & 63, wr = wid >> 2, wc = wid & 3, fr = lane & 15, fq = lane >> 4;
    unsigned cvg[2][2], nvg[2][2], cvb[2][2], nvb[2][2];
#define PG8_RC(i_) int R_, C_; stage_rc(tid * 16 + (i_) * 8192, R_, C_); const int sR_ = R_; const unsigned sC_ = (unsigned)C_ * 2u; const int sRb_ = PERM ? ((R_ & ~31) + perm32(R_ & 31)) : R_; (void)sR_; (void)sRb_; (void)sC_
    const size_t kstep = 128;
    const unsigned ldsw = (unsigned)wid * 1024u;
    const int aoff = lds_byte(wr * 64 + fr, fq * 8), boff = lds_byte(wc * 32 + fr, fq * 8);
#define PG8_SA(b, h) (((b) * 2 + (h)) * HTB)
#define PG8_SB(b, h) ((4 + (b) * 2 + (h)) * HTB)
#define PG8_STAGE(bufoff, gbase, voff) do { _Pragma("unroll") for (int _i = 0; _i < 2; ++_i) \
        __builtin_amdgcn_global_load_lds((const unsigned*)((const char*)(gbase) + (voff)[_i]), (LAS unsigned*)(lds + (bufoff) + ldsw + _i * 8192), 16, 0, 0); } while (0)
#define PG8_LDA(dst, b, h) do { if constexpr (FP8) { _Pragma("unroll") for (int m = 0; m < 4; ++m) dst##8[m] = cat8(*(const LAS bf16x8*)(lds + PG8_SA(b, h) + aoff + m * 2048), *(const LAS bf16x8*)(lds + PG8_SA(b, h) + aoff + m * 2048 + 1024)); } \
        else { _Pragma("unroll") for (int m = 0; m < 4; ++m) _Pragma("unroll") for (int k = 0; k < 2; ++k) dst[m][k] = *(const LAS bf16x8*)(lds + PG8_SA(b, h) + aoff + m * 2048 + k * 1024); } } while (0)
#define PG8_LDB(dst, b, h) do { if constexpr (FP8) { _Pragma("unroll") for (int n = 0; n < 2; ++n) dst##8[n] = cat8(*(const LAS bf16x8*)(lds + PG8_SB(b, h) + boff + n * 2048), *(const LAS bf16x8*)(lds + PG8_SB(b, h) + boff + n * 2048 + 1024)); } \
        else { _Pragma("unroll") for (int n = 0; n < 2; ++n) _Pragma("unroll") for (int k = 0; k < 2; ++k) dst[n][k] = *(const LAS bf16x8*)(lds + PG8_SB(b, h) + boff + n * 2048 + k * 1024); } } while (0)
#define PG8_MMA(ai, bj, At, Bt) do { __builtin_amdgcn_s_setprio(1); \
        if constexpr (FP8) { _Pragma("unroll") for (int m = 0; m < 4; ++m) _Pragma("unroll") for (int n = 0; n < 2; ++n)   \
            asm volatile("v_mfma_scale_f32_16x16x128_f8f6f4 %0, %1, %2, %0, %3, %3 op_sel_hi:[0,0,0]" : "+v"(acc[ai][bj][m][n]) : "v"(Bt##8[n]), "v"(At##8[m]), "v"(one_scale)); } \
        else { _Pragma("unroll") for (int m = 0; m < 4; ++m) _Pragma("unroll") for (int n = 0; n < 2; ++n) _Pragma("unroll") for (int k = 0; k < 2; ++k) \
            acc[ai][bj][m][n] = __builtin_amdgcn_mfma_f32_16x16x32_bf16(Bt[n][k], At[m][k], acc[ai][bj][m][n], 0, 0, 0); } \
        __builtin_amdgcn_s_setprio(0); } while (0)
#define PG8_WAIT_V(n) asm volatile("s_waitcnt vmcnt(" #n ")" ::: "memory")
#define PG8_WAIT_L(n) asm volatile("s_waitcnt lgkmcnt(" #n ")" ::: "memory")
#define PG8_BAR __builtin_amdgcn_s_barrier()
#define PG8_SCHED __builtin_amdgcn_sched_barrier(0)
#define PG8_GIDX(dst, op_) do { _Pragma("unroll") for (int i_ = 0; i_ < 2; ++i_) { PG8_RC(i_); _Pragma("unroll") for (int h_ = 0; h_ < 2; ++h_) dst[h_][i_] = (unsigned)grows[(op_).slot0 + h_ * 128 + sR_] * (unsigned)((op_).lda * 2) + sC_; } } while (0)
#define PG8_AOFF(dst, op_) do { _Pragma("unroll") for (int i_ = 0; i_ < 2; ++i_) { PG8_RC(i_); _Pragma("unroll") for (int h_ = 0; h_ < 2; ++h_) dst[h_][i_] = (unsigned)((sR_ + 128 * h_) * (op_).lda) * 2u + sC_; } } while (0)
#define PG8_BOFF(dst, op_) do { _Pragma("unroll") for (int i_ = 0; i_ < 2; ++i_) { PG8_RC(i_); _Pragma("unroll") for (int h_ = 0; h_ < 2; ++h_) { const int c_ = sRb_ + 128 * h_; \
        dst[h_][i_] = (unsigned)(((op_).bmap ? (64 * (c_ & 7) + (c_ >> 3)) : c_) * (op_).ldb) * 2u + sC_; } } } while (0)
#define PG8_COPY(dst, src) do { _Pragma("unroll") for (int h_ = 0; h_ < 2; ++h_) _Pragma("unroll") for (int i_ = 0; i_ < 2; ++i_) dst[h_][i_] = src[h_][i_]; } while (0)
    Unit cur, nxt; int ui = 0;
    if (!S.next(0, cur)) return;
    f32x4 acc[2][2][4][2];
#pragma unroll
    for (int a = 0; a < 2; ++a)
#pragma unroll
        for (int b = 0; b < 2; ++b)
#pragma unroll
            for (int m = 0; m < 4; ++m)
#pragma unroll
                for (int n = 0; n < 2; ++n) acc[a][b][m][n] = (f32x4){0.f, 0.f, 0.f, 0.f};
    bf16x8 At[4][2], B0[2][2], B1[2][2]; i32x8 At8[4], B08[2], B18[2];
    const int one_scale = 0x7F7F7F7F;
    const char* cA; const char* cB; int nt;
    bool has_next; const char* nA; const char* nB; int nnt;
    { const Operands op = AD(cur); cA = (const char*)op.A; cB = (const char*)op.Bt; nt = op.K / 64; PG8_BOFF(cvb, op);
      has_next = S.next(1, nxt); const Operands o1 = has_next ? AD(nxt) : op; PG8_BOFF(nvb, o1); nA = (const char*)o1.A; nB = (const char*)o1.Bt; nnt = o1.K / 64;
      if constexpr (GATHER) { PG8_GIDX(cvg, op); PG8_GIDX(nvg, o1); PG8_WAIT_V(0); } else { PG8_AOFF(cvg, op); PG8_AOFF(nvg, o1); } }
    PG8_STAGE(PG8_SB(0, 0), cB, cvb[0]); PG8_STAGE(PG8_SB(0, 1), cB, cvb[1]); PG8_STAGE(PG8_SA(0, 0), cA, cvg[0]); PG8_STAGE(PG8_SA(0, 1), cA, cvg[1]);
    if (wr == 1) PG8_BAR;
    PG8_WAIT_V(2); PG8_BAR;
    PG8_STAGE(PG8_SB(1, 0), cB + kstep, cvb[0]); PG8_STAGE(PG8_SA(1, 0), cA + kstep, cvg[0]); PG8_STAGE(PG8_SB(1, 1), cB + kstep, cvb[1]);
    PG8_WAIT_V(6); PG8_BAR;
    for (;;) {
#pragma unroll 1
        for (int t = 0; t < nt; t += 2) {
            const bool last = (t == nt - 2);
            const char* a1 = cA + (size_t)(t + 1) * kstep;
            const char* a2 = last ? nA : cA + (size_t)(t + 2) * kstep; const char* b2 = last ? nB : cB + (size_t)(t + 2) * kstep;
            const char* a3 = a2 + kstep; const char* b3 = b2 + kstep;
            unsigned v2[2][2], w2[2][2];
#pragma unroll
            for (int h_ = 0; h_ < 2; ++h_)
#pragma unroll
                for (int i_ = 0; i_ < 2; ++i_) { v2[h_][i_] = last ? nvg[h_][i_] : cvg[h_][i_]; w2[h_][i_] = last ? nvb[h_][i_] : cvb[h_][i_]; }
            PG8_LDB(B0, 0, 0); PG8_LDB(B1, 0, 1); PG8_SCHED; PG8_LDA(At, 0, 0); PG8_STAGE(PG8_SA(1, 1), a1, cvg[1]);
            PG8_WAIT_V(8); PG8_WAIT_L(0); PG8_BAR; PG8_MMA(0, 0, At, B0); PG8_MMA(0, 1, At, B1); PG8_BAR; PG8_SCHED;
            PG8_LDA(At, 0, 1); PG8_STAGE(PG8_SB(0, 0), b2, w2[0]); PG8_STAGE(PG8_SB(0, 1), b2, w2[1]); PG8_STAGE(PG8_SA(0, 0), a2, v2[0]);
            PG8_WAIT_V(8); PG8_WAIT_L(0); PG8_BAR; PG8_MMA(1, 0, At, B0); PG8_MMA(1, 1, At, B1); PG8_BAR; PG8_SCHED;
            PG8_LDB(B0, 1, 0); PG8_LDB(B1, 1, 1); PG8_SCHED; PG8_LDA(At, 1, 0); PG8_STAGE(PG8_SA(0, 1), a2, v2[1]);
            PG8_WAIT_V(8); PG8_WAIT_L(0); PG8_BAR; PG8_MMA(0, 0, At, B0); PG8_MMA(0, 1, At, B1); PG8_BAR; PG8_SCHED;
            PG8_LDA(At, 1, 1); PG8_STAGE(PG8_SB(1, 0), b3, w2[0]); PG8_STAGE(PG8_SB(1, 1), b3, w2[1]); PG8_STAGE(PG8_SA(1, 0), a3, v2[0]);
            PG8_WAIT_V(8); PG8_WAIT_L(0); PG8_BAR; PG8_MMA(1, 0, At, B0); PG8_MMA(1, 1, At, B1); PG8_BAR; PG8_SCHED;
        }
        if constexpr (FP8) asm volatile("s_nop 15\n\ts_nop 15" ::: "memory");
        if (wr == 0) PG8_BAR;
        unsigned fvg[2][2], fvb[2][2];
        Unit u2; const bool h2 = S.next(ui + 2, u2); const char* fA = nA; const char* fB = nB; int fnt = nnt;
        if (h2) { const Operands o2 = AD(u2); fA = (const char*)o2.A; fB = (const char*)o2.Bt; fnt = o2.K / 64; PG8_BOFF(fvb, o2); if constexpr (GATHER) PG8_GIDX(fvg, o2); else PG8_AOFF(fvg, o2); }
        else { PG8_COPY(fvb, nvb); PG8_COPY(fvg, nvg); }
        { int fr2 = fr, fq2 = fq; asm volatile("" : "+v"(fr2), "+v"(fq2));
          E(acc, cur, wr, wc, fr2, fq2); }
        if (!has_next) break;
        if constexpr (GATHER) PG8_WAIT_V(0);
        PG8_COPY(cvg, nvg); PG8_COPY(nvg, fvg); PG8_COPY(cvb, nvb); PG8_COPY(nvb, fvb);
        if (E.reset(cur)) {
#pragma unroll
        for (int a = 0; a < 2; ++a)
#pragma unroll
            for (int b = 0; b < 2; ++b)
#pragma unroll
                for (int m = 0; m < 4; ++m)
#pragma unroll
                    for (int n = 0; n < 2; ++n) acc[a][b][m][n] = (f32x4){0.f, 0.f, 0.f, 0.f};
        }
        cur = nxt; cA = nA; cB = nB; nt = nnt; ++ui;
        nxt = u2; has_next = h2; nA = fA; nB = fB; nnt = fnt;
        if (wr == 1) PG8_BAR;
    }
    PG8_WAIT_V(0);
    PG8_BAR;
#undef PG8_SA
#undef PG8_SB
#undef PG8_STAGE
#undef PG8_LDA
#undef PG8_LDB
#undef PG8_MMA
#undef PG8_WAIT_V
#undef PG8_WAIT_L
#undef PG8_BAR
#undef PG8_SCHED
#undef PG8_GIDX
#undef PG8_AOFF
#undef PG8_BOFF
#undef PG8_COPY
#undef PG8_RC
}
template <class F> struct EpiFn { F f; __device__ __forceinline__ void operator()(f32x4 (&acc)[2][2][4][2], const Unit& u, int wr, int wc, int fr, int fq) const { f(acc, u, wr, wc, fr, fq); } __device__ __forceinline__ bool reset(const Unit&) const { return true; } };
template <class F> __device__ __forceinline__ EpiFn<F> mk_epi(F f) { return EpiFn<F>{f}; }
template <class F> struct EpiSeg { F f; int last; __device__ __forceinline__ void operator()(f32x4 (&acc)[2][2][4][2], const Unit& u, int wr, int wc, int fr, int fq) const { f(acc, u, wr, wc, fr, fq); } __device__ __forceinline__ bool reset(const Unit& u) const { return u.seg == last; } };
template <class F> __device__ __forceinline__ EpiSeg<F> mk_epi_seg(F f, int last) { return EpiSeg<F>{f, last}; }
template <int NSEG> struct SegSched { GroupSched base; __device__ __forceinline__ bool next(int j, Unit& u) const { if (!base.next(j / NSEG, u)) return false; u.seg = j % NSEG; return true; } };
#ifndef DUP_PH
#define DUP_PH -1
#endif
#define REP_BEGIN(k) _Pragma("unroll 1") for (int rep_ = 0; rep_ < ((DUP_PH == (k)) ? 2 : 1); ++rep_) { if (rep_) { if constexpr (PH < 0) xcd_barrier(bar); }
#define REP_END }
#define GEMM(S, AD, E, K, lda, ldb) gemm_fast<false, false, false>(F.lds, F.tid, S, AD, mk_epi(E), nullptr)
#define GEMM_P(S, AD, E) gemm_fast<false, true, false>(F.lds, F.tid, S, AD, mk_epi(E), nullptr)
#define GEMM_P8(S, AD, E) gemm_fast<false, true, true>(F.lds, F.tid, S, AD, mk_epi(E), nullptr)
#define GEMM_GATHER8(S, AD, E, rows) gemm_fast<true, true, true>(F.lds, F.tid, S, AD, mk_epi(E), rows)
#define EPI_ARGS f32x4 (&acc)[2][2][4][2], const Unit& u, int wr, int wc, int fr, int fq
#define EPI_FOR(...) _Pragma("unroll") for (int ai = 0; ai < 2; ++ai) _Pragma("unroll") for (int m = 0; m < 4; ++m) { const int r = ai * 128 + wr * 64 + m * 16 + fr; \
    _Pragma("unroll") for (int bj = 0; bj < 2; ++bj) _Pragma("unroll") for (int n = 0; n < 2; ++n) { const int c = bj * 128 + wc * 32 + n * 16 + 4 * fq; const f32x4 v = acc[ai][bj][m][n]; __VA_ARGS__ } }
#define EPI_FOR8(...) _Pragma("unroll") for (int ai = 0; ai < 2; ++ai) _Pragma("unroll") for (int m = 0; m < 4; ++m) { const int r = ai * 128 + wr * 64 + m * 16 + fr; \
    _Pragma("unroll") for (int bj = 0; bj < 2; ++bj) { const int c = bj * 128 + wc * 32 + 8 * fq; const f32x4 v0 = acc[ai][bj][m][0], v1 = acc[ai][bj][m][1]; __VA_ARGS__ } }
__device__ __forceinline__ void st_bf8(bf16* p, f32x4 a, f32x4 b) { u32x4 w; w.x = pk2(a[0], a[1]); w.y = pk2(a[2], a[3]); w.z = pk2(b[0], b[1]); w.w = pk2(b[2], b[3]); *(u32x4*)p = w; }
__device__ __forceinline__ void st_bf4(bf16* p, f32x4 v) { u32x2 w; w.x = pk2(v[0], v[1]); w.y = pk2(v[2], v[3]); *(u32x2*)p = w; }

__device__ __forceinline__ void p_mod(const Params& P, Frame& F) {
    LAS float* sc = (LAS float*)F.lds;
    LAS float* red = (LAS float*)(F.lds + 9 * 1024 * 4);
    float* MOD = WSP(float, WS_MOD);
    bool have = false;
    for (int it = F.bid; it < 2 * 96; it += F.G) {
        if (!have) {
            for (int i = F.tid; i < 9 * 1024; i += NTHREADS) { const int r = i >> 10, k = i & 1023; const float v = r < 8 ? P.c[r * 1024 + k] : P.c_ctx[k]; sc[i] = v * sigmoidf_(v); }
            have = true;
        }
        __syncthreads();
        const int l = it / 96, j0 = (it % 96) * 64, jj = F.tid & 63, kc = F.tid >> 6;
        const float* W = P.ada_w + (size_t)l * 1024 * 6144 + j0 + jj;
        float a[9];
#pragma unroll
        for (int r = 0; r < 9; ++r) a[r] = 0.f;
#pragma unroll 8
        for (int k = kc * 128; k < kc * 128 + 128; ++k) { const float w = W[(size_t)k * 6144];
#pragma unroll
            for (int r = 0; r < 9; ++r) a[r] += sc[r * 1024 + k] * w; }
#pragma unroll
        for (int r = 0; r < 9; ++r) red[(kc * 9 + r) * 64 + jj] = a[r];
        __syncthreads();
        for (int o = F.tid; o < 9 * 64; o += NTHREADS) { const int r = o >> 6, j = o & 63; float s = 0.f;
#pragma unroll
            for (int q = 0; q < 8; ++q) s += red[(q * 9 + r) * 64 + j];
            MOD[((size_t)l * 9 + r) * 6144 + j0 + j] = s + P.ada_b[l * 6144 + j0 + j]; }
    }
    __syncthreads();
}
__device__ __forceinline__ void p_dftgen(Frame& F) {
    LAS float* tab = (LAS float*)F.lds;
    for (int j = F.tid; j < 4096; j += NTHREADS) tab[j] = cospif((float)j * (1.0f / 2048.0f));
    __syncthreads();
    bf16* DC_ = WSP(bf16, WS_DFTC); bf16* M1 = WSP(bf16, WS_M1T); bf16* M2 = WSP(bf16, WS_M2T);
    const int nchunk = 256 * 64 + 256 * 32 + 256 * 64;
    for (int ch = F.bid * NTHREADS + F.tid; ch < nchunk; ch += F.G * NTHREADS) {
        float v[8]; bf16* dst;
        if (ch < 256 * 64) { const int kf = ch >> 6, col0 = (ch & 63) * 8, cs = col0 >> 8, l0 = col0 & 255;
#pragma unroll
            for (int i = 0; i < 8; ++i) { const int j = ((kf * (l0 + i)) & 255) * 16; v[i] = cs ? -tab[(j + 3072) & 4095] : tab[j]; }
            dst = DC_ + (size_t)kf * 512 + col0; }
        else if (ch < 256 * 64 + 256 * 32) { const int c2 = ch - 256 * 64, row = c2 >> 5, col0 = (c2 & 31) * 8, ri = row >> 7, h = (row >> 6) & 1, k1 = row & 63, h2 = col0 >> 7, cs = (col0 >> 6) & 1, l10 = col0 & 63;
#pragma unroll
            for (int i = 0; i < 8; ++i) { const int j = ((k1 * (l10 + i)) & 63) * 64; const float c = tab[j], sn = tab[(j + 3072) & 4095];
                v[i] = (h != h2) ? 0.f : (ri == 0 ? (cs == 0 ? c : -sn) : (cs == 0 ? sn : c)); }
            dst = M1 + (size_t)row * 256 + col0; }
        else { const int c2 = ch - 256 * 64 - 256 * 32, row = c2 >> 6, col0 = (c2 & 63) * 8, q = row >> 6, k2 = row & 63, q2 = col0 >> 7, ri = (col0 >> 6) & 1, l20 = col0 & 63;
#pragma unroll
            for (int i = 0; i < 8; ++i) { const int j = ((k2 * (l20 + i)) & 63) * 64; const float c = tab[j], sn = tab[(j + 3072) & 4095];
                v[i] = (q != q2) ? 0.f : (ri == 0 ? c : -sn); }
            dst = M2 + (size_t)row * 512 + col0; }
        u32x4 o; o.x = pk2(v[0], v[1]); o.y = pk2(v[2], v[3]); o.z = pk2(v[4], v[5]); o.w = pk2(v[6], v[7]);
        *(u32x4*)dst = o;
    }
    __syncthreads();
}
__device__ __forceinline__ void transpose_item(const float* W, int ldw, int k0, int n0, bf16* WT, int ldt, int drow0, LAS float* scr, int lane) {
    f32x4 ld[8];
#pragma unroll
    for (int i = 0; i < 8; ++i) ld[i] = *(const f32x4*)(W + (size_t)(k0 + 8 * i + (lane >> 3)) * ldw + n0 + 4 * (lane & 7));
#pragma unroll
    for (int i = 0; i < 8; ++i) { LAS float* d = scr + (8 * i + (lane >> 3)) * 33 + 4 * (lane & 7); d[0] = ld[i][0]; d[1] = ld[i][1]; d[2] = ld[i][2]; d[3] = ld[i][3]; }
    LDS_WAIT(); asm volatile("" ::: "memory");
    const int c = lane & 7;
#pragma unroll
    for (int j = 0; j < 4; ++j) { const int n = (lane >> 3) + 8 * j; const LAS float* s = scr + (8 * c) * 33 + n;
        u32x4 o; o.x = pk2(s[0 * 33], s[1 * 33]); o.y = pk2(s[2 * 33], s[3 * 33]); o.z = pk2(s[4 * 33], s[5 * 33]); o.w = pk2(s[6 * 33], s[7 * 33]);
        *(u32x4*)(WT + (size_t)(drow0 + n) * ldt + k0 + 8 * c) = o; }
    LDS_WAIT(); asm volatile("" ::: "memory");
}
__device__ __forceinline__ void transpose_item8(const float* W, int ldw, int k0, int n0, unsigned char* WT, int ldt, int drow0, LAS float* scr, int lane) {
    f32x4 ld[8];
#pragma unroll
    for (int i = 0; i < 8; ++i) ld[i] = *(const f32x4*)(W + (size_t)(k0 + 8 * i + (lane >> 3)) * ldw + n0 + 4 * (lane & 7));
#pragma unroll
    for (int i = 0; i < 8; ++i) { LAS float* d = scr + (8 * i + (lane >> 3)) * 33 + 4 * (lane & 7); d[0] = ld[i][0]; d[1] = ld[i][1]; d[2] = ld[i][2]; d[3] = ld[i][3]; }
    LDS_WAIT(); asm volatile("" ::: "memory");
    const int c = lane & 7;
#pragma unroll
    for (int j = 0; j < 4; ++j) { const int n = (lane >> 3) + 8 * j; const LAS float* s = scr + (8 * c) * 33 + n;
        u32x2 o; o.x = pk4_fp8(s[0 * 33] * W8S, s[1 * 33] * W8S, s[2 * 33] * W8S, s[3 * 33] * W8S); o.y = pk4_fp8(s[4 * 33] * W8S, s[5 * 33] * W8S, s[6 * 33] * W8S, s[7 * 33] * W8S);
        *(u32x2*)(WT + (size_t)(drow0 + n) * ldt + k0 + 8 * c) = o; }
    LDS_WAIT(); asm volatile("" ::: "memory");
}
__device__ __forceinline__ void transpose_item8w(const float* W, int ldw, int k0, int n0, unsigned char* WT, int ldt, int drow0, LAS float* scr, int lane) {
    f32x4 ld[16];
#pragma unroll
    for (int i = 0; i < 16; ++i) ld[i] = *(const f32x4*)(W + (size_t)(k0 + 4 * i + (lane >> 4)) * ldw + n0 + 4 * (lane & 15));
#pragma unroll
    for (int i = 0; i < 16; ++i) { LAS float* d = scr + (4 * i + (lane >> 4)) * 65 + 4 * (lane & 15); d[0] = ld[i][0]; d[1] = ld[i][1]; d[2] = ld[i][2]; d[3] = ld[i][3]; }
    LDS_WAIT(); asm volatile("" ::: "memory");
    const int c = lane & 3;
#pragma unroll
    for (int p = 0; p < 4; ++p) { const int n = (lane >> 2) + 16 * p; const LAS float* s = scr + (16 * c) * 65 + n; u32x4 o;
#pragma unroll
        for (int q = 0; q < 4; ++q) o[q] = pk4_fp8(s[(4 * q) * 65] * W8S, s[(4 * q + 1) * 65] * W8S, s[(4 * q + 2) * 65] * W8S, s[(4 * q + 3) * 65] * W8S);
        *(u32x4*)(WT + (size_t)(drow0 + n) * ldt + k0 + 16 * c) = o; }
    LDS_WAIT(); asm volatile("" ::: "memory");
}
__device__ __forceinline__ void wconv_experts(const Params& P, Frame& F, int l, int rank, int nblk) {
    LAS float* scr = (LAS float*)(F.lds + (F.wave < 7 ? F.wave * 17408 : 131584));
    const int gw = rank * NWAVES + F.wave, NGW = nblk * NWAVES;
    constexpr int I_E = 16 * 44;
    unsigned char* WGU = WSP(unsigned char, WS_WGU); unsigned char* WD = WSP(unsigned char, WS_WD);
    for (int it = gw; it < 3 * 16 * I_E; it += NGW) {
        const int which = it / (16 * I_E), r0 = it % (16 * I_E), e = r0 / I_E, r = r0 % I_E;
        if (which < 2) { const int kb = r / 44, nb = r % 44, n0 = nb * 64;
            const float* src = (which == 0 ? P.w_eg : P.w_eu) + ((size_t)l * 16 + e) * 1024 * FF;
            transpose_item8w(src, FF, kb * 64, n0, WGU + (size_t)e * 5632 * 1024, 1024, (n0 >> 7) * 256 + (which ? 128 : 0) + (n0 & 127), scr, F.lane); }
        else { const int kb = r / 16, nb = r % 16;
            transpose_item8w(P.w_ed + ((size_t)l * 16 + e) * FF * 1024, 1024, kb * 64, nb * 64, WD + (size_t)e * 1024 * FF, FF, nb * 64, scr, F.lane); }
    }
    __syncthreads();
}
__device__ __forceinline__ void p_wconv(const Params& P, Frame& F, int l) {
    LAS float* scr = (LAS float*)(F.lds + F.wave * 16384);
    const int gw = F.bid * NWAVES + F.wave, NGW = F.G * NWAVES;
    const float* w_in = P.w_in + (size_t)l * 1024 * INW;
    bf16* WA = WSP(bf16, WS_WA); bf16* WFV = WSP(bf16, WS_WFV);
    constexpr int I_K = 16 * 32, I_Q = 16 * 32, I_P = 16 * 16, I_G = 16 * 96, I_V = 16 * 32, I_AO = 16 * 32, I_FO = 8 * 32, I_OUT = 16 * 32;
    constexpr int NSM = I_K + I_Q + I_P + I_G + I_V + I_AO + I_FO + I_OUT;
    for (int it = gw; it < NSM; it += NGW) {
        int r = it;
        if (r < I_K) { transpose_item8(w_in, INW, (r / 32) * 64, 0 + (r % 32) * 32, WSP(unsigned char, WS_WA8), 1024, 0 + (r % 32) * 32, scr, F.lane); continue; } r -= I_K;
        if (r < I_Q) { transpose_item8(w_in, INW, (r / 32) * 64, 2048 + (r % 32) * 32, WSP(unsigned char, WS_WA8), 1024, 1024 + (r % 32) * 32, scr, F.lane); continue; } r -= I_Q;
        if (r < I_P) { transpose_item(w_in, INW, (r / 16) * 64, 3584 + (r % 16) * 32, WA, 1024, 2048 + (r % 16) * 32, scr, F.lane); continue; } r -= I_P;
        if (r < I_G) { transpose_item8(w_in, INW, (r / 96) * 64, 4096 + (r % 96) * 32, WSP(unsigned char, WS_WA8), 1024, 3072 + (r % 96) * 32, scr, F.lane); continue; } r -= I_G;
        if (r < I_V) { transpose_item8(w_in, INW, (r / 32) * 64, 1024 + (r % 32) * 32, WSP(unsigned char, WS_WA8), 1024, 2048 + (r % 32) * 32, scr, F.lane); continue; } r -= I_V;
        if (r < I_AO) { transpose_item(P.w_att_o + (size_t)l * 1024 * 1024, 1024, (r / 32) * 64, (r % 32) * 32, WSP(bf16, WS_WAO), 1024, (r % 32) * 32, scr, F.lane); continue; } r -= I_AO;
        if (r < I_FO) { transpose_item(P.w_fourier + (size_t)l * 512 * 1024, 1024, (r / 32) * 64, (r % 32) * 32, WSP(bf16, WS_WFO), 512, (r % 32) * 32, scr, F.lane); continue; } r -= I_FO;
        transpose_item(P.w_out + (size_t)l * 1024 * 1024, 1024, (r / 32) * 64, (r % 32) * 32, WSP(bf16, WS_WOUT), 1024, (r % 32) * 32, scr, F.lane);
    }
    { bf16* WPO = WSP(bf16, WS_WPO); const float* wp = P.w_pool + (size_t)l * 4 * 128 * 256;
      for (int i = F.bid * NTHREADS + F.tid; i < 1024 * 256; i += F.G * NTHREADS) { const int n = i >> 8, kk = i & 255, g = n >> 8, f = n & 255;
          WPO[i] = (bf16)(((kk >> 7) == (g & 1)) ? f2bf(wp[((size_t)g * 128 + (kk & 127)) * 256 + f]) : 0u); } }
    { LAS float* t128 = (LAS float*)F.lds;
      __syncthreads();
      for (int j = F.tid; j < 128; j += NTHREADS) t128[j] = cospif((float)j * (1.0f / 64.0f));
      __syncthreads();
      for (int i = F.bid * NTHREADS + F.tid; i < 1024 * 1024; i += F.G * NTHREADS) { const int fc = i >> 10, k = i & 1023, cs = fc & 1, gm = fc >> 1, g = gm >> 7, m = gm & 127;
          const float* src = w_in + (size_t)k * INW + 3072 + g * 128; float s = 0.f; const int ph = cs ? 96 : 0;
          for (int c = 0; c < 128; ++c) s += src[c] * t128[(m * c + ph) & 127];
          WFV[i] = (bf16)f2bf(s); }
      __syncthreads(); }
}

struct RowMod { const float* g; const float* sh; const float* sc; };
__device__ __forceinline__ void row_load(const float* row, int lane, f32x4 (&v)[4]) {
#pragma unroll
    for (int j = 0; j < 4; ++j) v[j] = *(const f32x4*)(row + 4 * lane + 256 * j);
}
__device__ __forceinline__ float row_rstd(const f32x4 (&v)[4]) {
    float s = 0.f;
#pragma unroll
    for (int j = 0; j < 4; ++j) s += (v[j][0] * v[j][0] + v[j][1] * v[j][1]) + (v[j][2] * v[j][2] + v[j][3] * v[j][3]);
    return rsqrtf(wave_sum(s) * (1.0f / 1024.0f) + RMS_EPS);
}
__device__ __forceinline__ void row_modulate(const f32x4 (&v)[4], float rstd, const RowMod& M, int lane, f32x4 (&y)[4]) {
#pragma unroll
    for (int j = 0; j < 4; ++j) { const int k = 4 * lane + 256 * j; const f32x4 g = *(const f32x4*)(M.g + k), sh = *(const f32x4*)(M.sh + k), sc = *(const f32x4*)(M.sc + k);
        y[j] = v[j] * rstd * g * (sc + 1.0f) + sh; }
}
__device__ __forceinline__ void row_store_bf(bf16* row, int lane, const f32x4 (&y)[4]) {
#pragma unroll
    for (int j = 0; j < 4; ++j) st_bf4(row + 4 * lane + 256 * j, y[j]);
}
__device__ __forceinline__ void row_store_f8(unsigned char* row, int lane, const f32x4 (&y)[4]) {
#pragma unroll
    for (int j = 0; j < 4; ++j) *(unsigned*)(row + 4 * lane + 256 * j) = pk4_fp8(y[j][0] * A8S, y[j][1] * A8S, y[j][2] * A8S, y[j][3] * A8S);
}
__device__ __forceinline__ const float* mod_ptr(Frame& F, int l, int row, int which) { const int mr = row < RL ? (row >> 12) : 8; return WSP(float, WS_MOD) + ((size_t)l * 9 + mr) * 6144 + which * 1024; }

__device__ __forceinline__ void p_rowpass_a0(const Params& P, Frame& F) {
    const int gw = F.bid * NWAVES + F.wave, NGW = F.G * NWAVES; bf16* H = WSP(bf16, WS_H);
    f32x4 vn[4]; int row = gw;
    if (row < RT) row_load(row < RL ? P.x + (size_t)row * DM : P.ctx + (size_t)(row - RL) * DM, F.lane, vn);
    for (; row < RT; row += NGW) {
        f32x4 v[4], y[4];
#pragma unroll
        for (int j = 0; j < 4; ++j) v[j] = vn[j];
        { const int nr = row + NGW; if (nr < RT) row_load(nr < RL ? P.x + (size_t)nr * DM : P.ctx + (size_t)(nr - RL) * DM, F.lane, vn); }
        const float rs = row_rstd(v);
        RowMod M{P.norm1_g, mod_ptr(F, 0, row, 0), mod_ptr(F, 0, row, 1)};
        row_modulate(v, rs, M, F.lane, y); row_store_bf(H + (size_t)row * DM, F.lane, y); row_store_f8(WSP(unsigned char, WS_H8) + (size_t)row * DM, F.lane, y);
    }
}
__device__ __forceinline__ void p_rowpass_f(const Params& P, Frame& F, int l, int nrows) {
    const int gw = F.bid * NWAVES + F.wave, NGW = F.G * NWAVES; unsigned char* H8 = WSP(unsigned char, WS_H8); float* AFF = WSP(float, WS_AFF);
    const float* wr = P.w_router + (size_t)l * 1024 * 16;
    LAS float* wl = (LAS float*)F.lds;
    __syncthreads();
    for (int i = F.tid; i < 16384; i += NTHREADS) wl[(i & 15) * 1024 + (i >> 4)] = wr[i];
    __syncthreads();
    f32x4 vn[4]; int row = gw;
    if (row < nrows) row_load(row < RL ? P.out + (size_t)row * DM : WSP(float, WS_XC) + (size_t)(row - RL) * DM, F.lane, vn);
    for (; row < nrows; row += NGW) {
        f32x4 v[4], y[4];
#pragma unroll
        for (int j = 0; j < 4; ++j) v[j] = vn[j];
        { const int nr = row + NGW; if (nr < nrows) row_load(nr < RL ? P.out + (size_t)nr * DM : WSP(float, WS_XC) + (size_t)(nr - RL) * DM, F.lane, vn); }
        const float rs = row_rstd(v);
        RowMod M{P.norm2_g + l * 1024, mod_ptr(F, l, row, 3), mod_ptr(F, l, row, 4)};
        row_modulate(v, rs, M, F.lane, y);
        row_store_f8(H8 + (size_t)row * DM, F.lane, y);
        float lg[16];
        int wo = 4 * F.lane; asm volatile("" : "+v"(wo));
#pragma unroll
        for (int e = 0; e < 16; ++e) { float a = 0.f;
#pragma unroll
            for (int j = 0; j < 4; ++j) { const f32x4 w = *(const LAS f32x4*)(wl + e * 1024 + wo + 256 * j); a += (y[j][0] * w[0] + y[j][1] * w[1]) + (y[j][2] * w[2] + y[j][3] * w[3]); }
            lg[e] = a; }
        float mx = -1e30f;
#pragma unroll
        for (int e = 0; e < 16; ++e) { lg[e] = wave_sum(lg[e]); mx = fmaxf(mx, lg[e]); }
        float den = 0.f;
#pragma unroll
        for (int e = 0; e < 16; ++e) { lg[e] = __expf(lg[e] - mx); den += lg[e]; }
        const float inv = 1.0f / den;
        if (F.lane < 16) { float mine = 0.f;
#pragma unroll
            for (int e = 0; e < 16; ++e) mine = (F.lane == e) ? lg[e] : mine;
            AFF[(size_t)row * 16 + F.lane] = mine * inv; }
    }
    __syncthreads();
}
__device__ __forceinline__ void p_rowpass_k(const Params& P, Frame& F, int l, int nrows) {
    const int gw = F.bid * NWAVES + F.wave, NGW = F.G * NWAVES; bf16* H = WSP(bf16, WS_H);
    const int* SEL = WSP(int, WS_SEL); const bf16* Y = WSP(bf16, WS_Y);
    f32x4 vn[4]; int seln = -1; int row = gw;
    if (row < nrows) { row_load(row < RL ? P.out + (size_t)row * DM : WSP(float, WS_XC) + (size_t)(row - RL) * DM, F.lane, vn); seln = F.lane < 16 ? SEL[(size_t)row * 16 + F.lane] : -1; }
    for (; row < nrows; row += NGW) {
        float* xr = row < RL ? P.out + (size_t)row * DM : WSP(float, WS_XC) + (size_t)(row - RL) * DM;
        f32x4 v[4], a[4]; const int sel = seln;
#pragma unroll
        for (int j = 0; j < 4; ++j) { v[j] = vn[j]; a[j] = (f32x4){0.f, 0.f, 0.f, 0.f}; }
        { const int nr = row + NGW; if (nr < nrows) { row_load(nr < RL ? P.out + (size_t)nr * DM : WSP(float, WS_XC) + (size_t)(nr - RL) * DM, F.lane, vn); seln = F.lane < 16 ? SEL[(size_t)nr * 16 + F.lane] : -1; } }
        unsigned em = (unsigned)__ballot(sel >= 0) & 0xffffu;
        while (em) { const int e = __builtin_ctz(em); em &= em - 1; const int s = __builtin_amdgcn_readlane(sel, e); const bf16* yr = Y + (size_t)s * DM;
#pragma unroll
            for (int j = 0; j < 4; ++j) { const u32x2 w = *(const u32x2*)(yr + 4 * F.lane + 256 * j); a[j][0] += bflo(w.x); a[j][1] += bfhi(w.x); a[j][2] += bflo(w.y); a[j][3] += bfhi(w.y); } }
        const float* g2 = mod_ptr(F, l, row, 5);
#pragma unroll
        for (int j = 0; j < 4; ++j) { const f32x4 g = *(const f32x4*)(g2 + 4 * F.lane + 256 * j); v[j] = v[j] + g * a[j]; }
        const float rs = row_rstd(v);
        if (l == 0) {
#pragma unroll
            for (int j = 0; j < 4; ++j) *(f32x4*)(xr + 4 * F.lane + 256 * j) = v[j];
            f32x4 y[4]; RowMod M{P.norm1_g + 1024, mod_ptr(F, 1, row, 0), mod_ptr(F, 1, row, 1)};
            row_modulate(v, rs, M, F.lane, y); row_store_bf(H + (size_t)row * DM, F.lane, y); row_store_f8(WSP(unsigned char, WS_H8) + (size_t)row * DM, F.lane, y);
        } else {
#pragma unroll
            for (int j = 0; j < 4; ++j) { const f32x4 g = *(const f32x4*)(P.final_g + 4 * F.lane + 256 * j); *(f32x4*)(xr + 4 * F.lane + 256 * j) = v[j] * rs * g; }
        }
    }
}

constexpr int ACK_STRIDE = 72, ACV_STRIDE = 264;
constexpr int ALDS_CK = 0, ALDS_CV = 256 * ACK_STRIDE * 2, ALDS_RP = ALDS_CV + 64 * ACV_STRIDE * 2;
struct AttnState { float m, sum; f32x4 o[4]; };
__device__ __forceinline__ float xrow16_max(float x) {
    auto s = __builtin_amdgcn_permlane16_swap(__float_as_uint(x), __float_as_uint(x), false, false);
    x = fmaxf(__uint_as_float(s[0]), __uint_as_float(s[1]));
    auto t = __builtin_amdgcn_permlane32_swap(__float_as_uint(x), __float_as_uint(x), false, false);
    return fmaxf(__uint_as_float(t[0]), __uint_as_float(t[1]));
}
__device__ __forceinline__ float xrow16_sum(float x) {
    auto s = __builtin_amdgcn_permlane16_swap(__float_as_uint(x), __float_as_uint(x), false, false);
    x = __uint_as_float(s[0]) + __uint_as_float(s[1]);
    auto t = __builtin_amdgcn_permlane32_swap(__float_as_uint(x), __float_as_uint(x), false, false);
    return __uint_as_float(t[0]) + __uint_as_float(t[1]);
}
#define MFMA16(a, b, c) __builtin_amdgcn_mfma_f32_16x16x32_bf16((a), (b), (c), 0, 0, 0)
template <int NT>
__device__ __forceinline__ void attn_tail(AttnState& S, f32x4 (&sc)[NT], const u32x4 (&vw)[NT / 2][4]) {
    float cm = -__builtin_inff();
#pragma unroll
    for (int t = 0; t < NT; ++t)
#pragma unroll
        for (int j = 0; j < 4; ++j) cm = fmaxf(cm, sc[t][j]);
    cm = xrow16_max(cm);
    const bool need = (fabsf(cm) > 12.0f) && (cm > -1e30f);
    if (__builtin_amdgcn_ballot_w64(need) != 0ull) {
        const float d = need ? cm : 0.f, scl = __builtin_amdgcn_exp2f(-d);
        S.m += d; S.sum *= scl;
#pragma unroll
        for (int dt = 0; dt < 4; ++dt) S.o[dt] = S.o[dt] * scl;
#pragma unroll
        for (int t = 0; t < NT; ++t)
#pragma unroll
            for (int j = 0; j < 4; ++j) sc[t][j] -= d;
    }
    float ps = 0.f;
#pragma unroll
    for (int t = 0; t < NT; ++t)
#pragma unroll
        for (int j = 0; j < 4; ++j) { const float p = __builtin_amdgcn_exp2f(sc[t][j]); sc[t][j] = p; ps += p; }
    S.sum += ps;
#pragma unroll
    for (int ks = 0; ks < NT / 2; ++ks) { u32x4 pw; pw.x = pk2(sc[2 * ks][0], sc[2 * ks][1]); pw.y = pk2(sc[2 * ks][2], sc[2 * ks][3]); pw.z = pk2(sc[2 * ks + 1][0], sc[2 * ks + 1][1]); pw.w = pk2(sc[2 * ks + 1][2], sc[2 * ks + 1][3]);
        const bf16x8 pf = __builtin_bit_cast(bf16x8, pw);
#pragma unroll
        for (int dt = 0; dt < 4; ++dt) S.o[dt] = MFMA16(__builtin_bit_cast(bf16x8, vw[ks][dt]), pf, S.o[dt]); }
}
__device__ __forceinline__ void attn_unit2(const bf16* __restrict__ KQ, const bf16* __restrict__ VT, bf16* __restrict__ ATT, LAS unsigned char* lds,
                                           const int b, const int h, const int rowqA, const int rowqB, const bool win, const int r, const int qt, const int lane) {
    const int l15 = lane & 15, g = lane >> 4;
    const f32x4 z = {0.f, 0.f, 0.f, 0.f};
    bf16x8 qA[2], qB[2];
    { const bf16* qp = KQ + (size_t)(rowqA + l15) * 2048 + 1024 + h * 64 + 8 * g; qA[0] = *(const bf16x8*)qp; qA[1] = *(const bf16x8*)(qp + 32); }
    { const bf16* qp = KQ + (size_t)(rowqB + l15) * 2048 + 1024 + h * 64 + 8 * g; qB[0] = *(const bf16x8*)qp; qB[1] = *(const bf16x8*)(qp + 32); }
    AttnState SA, SB; SA.m = 0.f; SA.sum = 0.f; SB.m = 0.f; SB.sum = 0.f;
#pragma unroll
    for (int dt = 0; dt < 4; ++dt) { SA.o[dt] = z; SB.o[dt] = z; }
    if (win) {
        const int rsA = min(max(r - 4, 0), 56), dB = min(max(r - 3, 0), 56) - rsA, kc0 = min(max(16 * qt - 8, 0), 32);
        const int q = 16 * qt + l15, csq = min(max(q - 8, 0), 48);
        const int krow0 = 8 * (l15 >> 2) + (l15 & 3);
        const bf16* kb = KQ + (size_t)(b * SEQ + kc0 + krow0) * 2048 + h * 64 + 8 * g;
        const bf16* vb = VT + (size_t)(b * 1024 + h * 64 + l15) * 4096 + kc0 + 8 * g;
        const LAS float* rp = (const LAS float*)(lds + ALDS_RP);
        const int jb = kc0 + 8 * g;
        const int okb = jb - csq;
        const LAS float* rpl = rp + 16 + (jb - q + 15);
        float madd[2][4];
#pragma unroll
        for (int t = 0; t < 2; ++t)
#pragma unroll
            for (int j = 0; j < 4; ++j) madd[t][j] = ((unsigned)(okb + 4 * t + j) < 16u) ? 0.f : -__builtin_inff();
        bf16x8 K0[2][2], K1[2][2]; u32x4 V0[1][4], V1[1][4];
#define ATT_LOADW(KB, VB, i) do { const int gr_ = min(rsA + (i), 63); const bf16* kp_ = kb + (size_t)(gr_ * 64) * 2048; const bf16* vp_ = vb + gr_ * 64; \
        _Pragma("unroll") for (int t = 0; t < 2; ++t) { KB[t][0] = *(const bf16x8*)(kp_ + (size_t)(4 * t) * 2048); KB[t][1] = *(const bf16x8*)(kp_ + (size_t)(4 * t) * 2048 + 32); } \
        _Pragma("unroll") for (int dt = 0; dt < 4; ++dt) VB[0][dt] = *(const u32x4*)(vp_ + (size_t)(16 * dt) * 4096); } while (0)
#define ATT_ONE(ST, QF, KB, VB, roff, rowok) do { f32x4 sc[2]; \
        const LAS float* bp_ = rpl + ((rowok) ? (roff) : 15) * 64; \
        _Pragma("unroll") for (int t = 0; t < 2; ++t) _Pragma("unroll") for (int j = 0; j < 4; ++j) sc[t][j] = (bp_[4 * t + j] + madd[t][j]) - ST.m;     \
        _Pragma("unroll") for (int t = 0; t < 2; ++t) { sc[t] = MFMA16(KB[t][0], QF[0], sc[t]); sc[t] = MFMA16(KB[t][1], QF[1], sc[t]); } \
        attn_tail<2>(ST, sc, VB); } while (0)
#define ATT_COMPUTE(KB, VB, i) do { const int roffA_ = min(rsA + (i) - r + 7, 14); \
        ATT_ONE(SA, qA, KB, VB, roffA_, (i) <= 7); \
        ATT_ONE(SB, qB, KB, VB, max(roffA_ - 1, 0), (i) >= dB && (i) <= 7 + dB); } while (0)
        ATT_LOADW(K0, V0, 0);
#pragma unroll 1
        for (int i = 0; i < 8; i += 2) { ATT_LOADW(K1, V1, i + 1); ATT_COMPUTE(K0, V0, i); ATT_LOADW(K0, V0, i + 2); ATT_COMPUTE(K1, V1, i + 1); }
        ATT_COMPUTE(K0, V0, 8);
#undef ATT_LOADW
#undef ATT_ONE
#undef ATT_COMPUTE
    }
    { const LAS bf16* ck = (const LAS bf16*)(lds + ALDS_CK) + l15 * ACK_STRIDE + 8 * g;
      const LAS bf16* cv = (const LAS bf16*)(lds + ALDS_CV) + l15 * ACV_STRIDE + 8 * g;
#pragma unroll 1
      for (int c = 0; c < 4; ++c) {
          bf16x8 kf[4][2]; u32x4 vw[2][4];
#pragma unroll
          for (int t = 0; t < 4; ++t) { const LAS bf16* kp = ck + (64 * c + 16 * t) * ACK_STRIDE; kf[t][0] = *(const LAS bf16x8*)kp; kf[t][1] = *(const LAS bf16x8*)(kp + 32); }
#pragma unroll
          for (int ks = 0; ks < 2; ++ks)
#pragma unroll
              for (int dt = 0; dt < 4; ++dt) vw[ks][dt] = *(const LAS u32x4*)(cv + (16 * dt) * ACV_STRIDE + 64 * c + 32 * ks);
          { f32x4 sc[4]; const float nm = -SA.m; const f32x4 c0 = {nm, nm, nm, nm};
#pragma unroll
            for (int t = 0; t < 4; ++t) { sc[t] = MFMA16(kf[t][0], qA[0], c0); sc[t] = MFMA16(kf[t][1], qA[1], sc[t]); }
            attn_tail<4>(SA, sc, vw); }
          { f32x4 sc[4]; const float nm = -SB.m; const f32x4 c0 = {nm, nm, nm, nm};
#pragma unroll
            for (int t = 0; t < 4; ++t) { sc[t] = MFMA16(kf[t][0], qB[0], c0); sc[t] = MFMA16(kf[t][1], qB[1], sc[t]); }
            attn_tail<4>(SB, sc, vw); }
      } }
    { const float inv = 1.0f / xrow16_sum(SA.sum);
#pragma unroll
      for (int dt = 0; dt < 4; ++dt) st_bf4(ATT + (size_t)(rowqA + l15) * 1024 + h * 64 + 16 * dt + 4 * g, SA.o[dt] * inv); }
    { const float inv = 1.0f / xrow16_sum(SB.sum);
#pragma unroll
      for (int dt = 0; dt < 4; ++dt) st_bf4(ATT + (size_t)(rowqB + l15) * 1024 + h * 64 + 16 * dt + 4 * g, SB.o[dt] * inv); }
}
__device__ __forceinline__ void p_attn_mfma(const Params& P, Frame& F, int l, bool with_ctx_queries, int nblk, int rank) {
    const bf16* KQ = WSP(bf16, WS_KQ); const bf16* VT = WSP(bf16, WS_VT); bf16* ATT = WSP(bf16, WS_ATT);
    const float* rpb = P.rpb + (size_t)l * 16 * 465;
    const int it0 = (int)(((long)rank * 1024) / nblk), it1 = (int)(((long)(rank + 1) * 1024) / nblk);
    int pcur = -1;
    for (int hp = it0; hp < it1; ++hp) {
        const int p = hp >> 3, eighth = hp & 7, b = p >> 4, h = p & 15;
        if (p != pcur) { pcur = p;
        __syncthreads();
        { LAS bf16* ck = (LAS bf16*)(F.lds + ALDS_CK); LAS bf16* cv = (LAS bf16*)(F.lds + ALDS_CV); LAS float* rp = (LAS float*)(F.lds + ALDS_RP);
          { const int key = F.tid >> 1, hf = F.tid & 1; const int k32 = key & 31, pos = (key & ~31) + ((k32 >> 2) & 1) * 16 + 4 * (k32 >> 3) + (k32 & 3);
            const u32x4* src = (const u32x4*)(KQ + (size_t)(RL + b * CTXL + key) * 2048 + h * 64 + hf * 32); LAS u32x4* dst = (LAS u32x4*)(ck + pos * ACK_STRIDE + hf * 32);
#pragma unroll
            for (int i = 0; i < 4; ++i) dst[i] = src[i]; }
          { const int d = F.tid >> 3, sg = F.tid & 7; const u32x4* src = (const u32x4*)(VT + YT_CTX_OFF + (size_t)(b * 1024 + h * 64 + d) * 256 + sg * 32); LAS u32x4* dst = (LAS u32x4*)(cv + d * ACV_STRIDE + sg * 32);
#pragma unroll
            for (int i = 0; i < 4; ++i) dst[i] = src[i]; }
          for (int i = F.tid; i < 16 * 64; i += NTHREADS) { const int rr = i >> 6, cc = (i & 63) - 16; rp[i] = rr == 15 ? -__builtin_inff() : ((cc >= 0 && cc < 31) ? rpb[h * 465 + rr * 31 + cc] * LOG2E : 0.f); } }
        __syncthreads(); }
        const int qt = F.wave & 3, rpi = F.wave >> 2;
#pragma unroll 1
        for (int st = 0; st < 2; ++st) { const int r = eighth * 8 + st * 4 + rpi * 2; const int rowqA = b * SEQ + r * 64 + 16 * qt;
            attn_unit2(KQ, VT, ATT, F.lds, b, h, rowqA, rowqA + 64, true, r, qt, F.lane); }
        if (with_ctx_queries && eighth == 0) { const int rowqA = RL + b * CTXL + 32 * F.wave; attn_unit2(KQ, VT, ATT, F.lds, b, h, rowqA, rowqA + 16, false, 0, 0, F.lane); }
    }
    __syncthreads();
}

__device__ __forceinline__ void ld8(const bf16* p, float (&x)[8]) { const u32x4 w = *(const u32x4*)p;
#pragma unroll
    for (int q = 0; q < 4; ++q) { x[2 * q] = bflo(w[q]); x[2 * q + 1] = bfhi(w[q]); } }
__device__ __forceinline__ void p_pool(Frame& F, int nrows) {
    const bf16* PB = WSP(bf16, WS_PB); bf16* POOL = WSP(bf16, WS_POOL);
    for (int i = F.bid * NTHREADS + F.tid; i < (nrows >> 4) * 64; i += F.G * NTHREADS) {
        const int row0 = (i >> 6) << 4, ch = i & 63, g = ch >> 4, hw = 1 << g;
        int base, t0, Lb; if (row0 < RL) { base = row0 & ~4095; t0 = row0 & 4095; Lb = SEQ; } else { const int rr = row0 - RL; base = RL + (rr & ~255); t0 = rr & 255; Lb = CTXL; }
        const bf16* src = PB + (size_t)base * 512 + ch * 8;
        float S[8];
#pragma unroll
        for (int q = 0; q < 8; ++q) S[q] = 0.f;
#pragma unroll 4
        for (int d = -8; d < 8; ++d) { const int tt = t0 + d; if (d >= -hw && d < hw && tt >= 0 && tt < Lb) { float x[8]; ld8(src + (size_t)tt * 512, x);
#pragma unroll
                for (int q = 0; q < 8; ++q) S[q] += x[q]; } }
#pragma unroll 2
        for (int j = 0; j < 16; ++j) { const int t = t0 + j; const int lo = max(t - hw, 0), hi = min(t + hw, Lb); const float inv = 1.0f / (float)(hi - lo);
            float me[8]; ld8(src + (size_t)t * 512, me);
            u32x4 o;
#pragma unroll
            for (int q = 0; q < 4; ++q) o[q] = pk2(S[2 * q] * inv - me[2 * q], S[2 * q + 1] * inv - me[2 * q + 1]);
            *(u32x4*)(POOL + (size_t)(base + t) * 512 + ch * 8) = o;
            if (t + hw < Lb) { float x[8]; ld8(src + (size_t)(t + hw) * 512, x);
#pragma unroll
                for (int q = 0; q < 8; ++q) S[q] += x[q]; }
            if (t - hw >= 0) { float x[8]; ld8(src + (size_t)(t - hw) * 512, x);
#pragma unroll
                for (int q = 0; q < 8; ++q) S[q] -= x[q]; } }
    }
}

__device__ __forceinline__ int block_sum_i(int v, LAS int* sm, int tid) {
    v = wave_sum_i(v);
    __syncthreads();
    if ((tid & 63) == 0) sm[tid >> 6] = v;
    __syncthreads();
    int s = 0;
#pragma unroll
    for (int i = 0; i < 8; ++i) s += sm[i];
    return s;
}
__device__ __forceinline__ int block_excl_scan(int v, LAS int* sm, int tid, int& total) {
    const int lane = tid & 63, w = tid >> 6; int inc = v;
#pragma unroll
    for (int o = 1; o < 64; o <<= 1) { const int t = __builtin_amdgcn_ds_bpermute(((lane - o) & 63) << 2, inc); if (lane >= o) inc += t; }
    __syncthreads();
    if (lane == 63) sm[w] = inc;
    __syncthreads();
    int base = 0; total = 0;
#pragma unroll
    for (int i = 0; i < 8; ++i) { const int s = sm[i]; if (i < w) base += s; total += s; }
    return base + inc - v;
}
template <int NPT>
__device__ __forceinline__ void topk_pair(Frame& F, int row0, int n, int cap, int e, int slot0) {
    LAS int* sm = (LAS int*)F.lds;
    const float* AFF = WSP(float, WS_AFF); int* SROW = WSP(int, WS_SROW); float* SG = WSP(float, WS_SGATE); int* SEL = WSP(int, WS_SEL);
    unsigned key[NPT];
#pragma unroll
    for (int j = 0; j < NPT; ++j) { const int i = F.tid * NPT + j; key[j] = (i < n) ? __float_as_uint(AFF[(size_t)(row0 + i) * 16 + e]) : 0u; }
    unsigned T = 0u;
    for (int bit = 30; bit >= 0; --bit) { const unsigned cand = T | (1u << bit); int cnt = 0;
#pragma unroll
        for (int j = 0; j < NPT; ++j) cnt += (key[j] >= cand) ? 1 : 0;
        cnt = block_sum_i(cnt, sm, F.tid);
        if (cnt >= cap) T = cand; }
    int ngt = 0, neq = 0;
#pragma unroll
    for (int j = 0; j < NPT; ++j) { ngt += (key[j] > T) ? 1 : 0; neq += (key[j] == T) ? 1 : 0; }
    int tot_gt, tot_eq;
    (void)block_excl_scan(ngt, sm, F.tid, tot_gt);
    int eqr = block_excl_scan(neq, sm, F.tid, tot_eq);
    const int need_eq = cap - tot_gt;
    int nsel = 0; bool selj[NPT];
#pragma unroll
    for (int j = 0; j < NPT; ++j) { bool s = key[j] > T; if (key[j] == T && T != 0u) { s = eqr < need_eq; ++eqr; } selj[j] = s; nsel += s ? 1 : 0; }
    int tot_sel; int pos = block_excl_scan(nsel, sm, F.tid, tot_sel);
#pragma unroll
    for (int j = 0; j < NPT; ++j) { const int i = F.tid * NPT + j;
        if (i < n) { const int row = row0 + i;
            if (selj[j]) { const int slot = slot0 + pos; ++pos; SROW[slot] = row; SG[slot] = __uint_as_float(key[j]); SEL[(size_t)row * 16 + e] = slot; }
            else SEL[(size_t)row * 16 + e] = -1; } }
    __syncthreads();
}
__device__ __forceinline__ void p_topk(Frame& F, bool with_ctx) {
    const int npairs = 128 + (with_ctx ? 128 : 0);
    for (int pi = F.bid; pi < npairs; pi += F.G) {
        if (pi < 128) { const int b = pi >> 4, e = pi & 15; topk_pair<8>(F, b * SEQ, SEQ, CAPL, e, e * SLOT_E + b * CAPL); }
        else { const int p2 = pi - 128, b = p2 >> 4, e = p2 & 15; topk_pair<1>(F, RL + b * CTXL, CTXL, CAPC, e, e * SLOT_E + 4096 + b * CAPC); }
    }
}
template <int PH> __global__ void __launch_bounds__(NTHREADS, 2) fwd_kernel(Params P) {
    extern __shared__ __attribute__((aligned(16))) unsigned char lds_raw[];
    Frame F; F.lds = (LAS unsigned char*)lds_raw; F.tid = threadIdx.x; F.lane = F.tid & 63; F.wave = __builtin_amdgcn_readfirstlane(F.tid >> 6); F.G = gridDim.x; F.bid = blockIdx.x; F.ws = P.ws;
    const int wave0 = __builtin_amdgcn_readfirstlane((int)threadIdx.x >> 6);
    volatile LAS unsigned* MISC = (volatile LAS unsigned*)(F.lds + LDS_MISC);
    if (F.tid < 64) MISC[F.tid] = 0u;
    __syncthreads();
    XcdBarrier bar; bar.bar = WSP(unsigned, WS_CTL) + CW_BAR; bar.x = 0; bar.st = MISC + 8;
    if constexpr (PH < 0) bar = xcd_barrier_post(WSP(unsigned, WS_CTL) + CW_BAR, MISC + 8);
#define IN(k) (PH < 0 || PH == (k))
#define REFRESH() do { unsigned on_ = ~0u; asm volatile("" : "+s"(on_)); int t_ = wave0 * 64 + (int)__builtin_amdgcn_mbcnt_hi(on_, __builtin_amdgcn_mbcnt_lo(on_, 0u)); asm volatile("" : "+v"(t_)); F.tid = t_; F.lane = t_ & 63; F.wave = __builtin_amdgcn_readfirstlane(t_ >> 6); } while (0)
#define SEAM(k) do { if constexpr (PH < 0) xcd_barrier(bar); } while (0)

    if (IN(0)) { REP_BEGIN(100) p_mod(P, F); p_dftgen(F); REP_END REP_BEGIN(101) p_wconv(P, F, 0); REP_END }
    SEAM(0);
    if (IN(1)) { p_rowpass_a0(P, F); }
    SEAM(1);
    for (int l = P.l_lo; l < P.l_hi; ++l) {
        constexpr int pb = 2; const bool L0 = (l == 0);
        bf16* H = WSP(bf16, WS_H);
        if (IN(pb + 0)) { REFRESH(); REP_BEGIN(2)
            const int u1 = 128 * 8 + 8 * (L0 ? 8 : 4), u2a = 128 * 2 + (L0 ? 8 * 2 : 0), u2 = u2a + 128 * 12 + (L0 ? 8 * 12 : 0), u3 = 4 * 128 + (L0 ? 4 * 8 : 0);
            const bf16* H8 = WSP(bf16, WS_H8); const bf16* WA8 = WSP(bf16, WS_WA8);
            { GroupSched S; S.init(1, 128, 8, F.G, F.bid, 8, L0 ? 8 : 4, 128, 0);
              auto AD = [=](const Unit& u) { return Operands{H8 + (size_t)u.pm * 256 * 512, WA8 + (size_t)u.pn * 256 * 512, 512, 512, 0, 512}; };
              bf16* KQ = WSP(bf16, WS_KQ);
              auto E = [=](EPI_ARGS) { const int row0 = u.pm * 256; const float qs = (u.pn >= 4) ? QSCALE * INV8 : INV8;
                  EPI_FOR8( st_bf8(KQ + (size_t)(row0 + r) * 2048 + u.pn * 256 + c, v0 * qs, v1 * qs); ) };
              GEMM_P8(S, AD, E); }
            REFRESH();
            { GroupSched S; S.init(1, 128, 2, F.G, (F.bid + F.G - ((u1 % F.G) & ~7)) % F.G, L0 ? 8 : 0, 2, 128, 0);
              const bf16* WA = WSP(bf16, WS_WA);
              auto AD = [=](const Unit& u) { return Operands{H + (size_t)u.pm * 256 * DM, WA + (size_t)(u.pn + 8) * 256 * DM, DM, DM, 0, DM}; };
              bf16* PBp = WSP(bf16, WS_PB);
              auto E = [=](EPI_ARGS) { const int row0 = u.pm * 256; EPI_FOR8( st_bf8(PBp + (size_t)(row0 + r) * 512 + u.pn * 256 + c, v0, v1); ) };
              GEMM_P(S, AD, E); }
            REFRESH();
            { GroupSched S; S.init(1, 128, 12, F.G, (F.bid + F.G - (((u1 + u2a) % F.G) & ~7)) % F.G, L0 ? 8 : 0, 12, 128, 0);
              bf16* GB = WSP(bf16, WS_GB);
              auto AD = [=](const Unit& u) { return Operands{H8 + (size_t)u.pm * 256 * 512, WA8 + (size_t)(3072 + u.pn * 256) * 512, 512, 512, 0, 512}; };
              auto E = [=](EPI_ARGS) { const int row0 = u.pm * 256;
                  EPI_FOR8( f32x4 s0; f32x4 s1; _Pragma("unroll") for (int j = 0; j < 4; ++j) { s0[j] = sigmoidf_(v0[j] * INV8); s1[j] = sigmoidf_(v1[j] * INV8); } st_bf8(GB + (size_t)(row0 + r) * 3072 + u.pn * 256 + c, s0, s1); ) };
              GEMM_P8(S, AD, E); }
            REFRESH();
            { GroupSched S; S.init(1, 4, 128, F.G, (F.bid + F.G - (((u1 + u2) % F.G) & ~7)) % F.G, L0 ? 4 : 0, 8, 0, 128);
              const bf16* WFV = WSP(bf16, WS_WFV);
              auto AD = [=](const Unit& u) { const bool fmap = (u.pn < 128); const int t16 = u.pn & 15;
                  const size_t tok0 = fmap ? (size_t)(u.pn >> 4) * SEQ + 64 * ((t16 >> 1) * 8) + (t16 & 1) * 32 : (size_t)u.pn * 256;
                  return Operands{WFV + (size_t)u.pm * 256 * DM, H + tok0 * DM, DM, DM, 0, DM, fmap ? 1 : 0}; };
              bf16* YT = WSP(bf16, WS_YT);
              auto E = [=](EPI_ARGS) { const int rr0 = u.pm * 256;
                  if (u.pn < 128) { const int b = u.pn >> 4; const int t16 = u.pn & 15, l10 = (t16 >> 1) * 8, l20 = (t16 & 1) * 32;
                      EPI_FOR8( const int fc = rr0 + r; st_bf8(YT + (((((size_t)b * 512 + (fc >> 1)) * 32 + (c >> 3)) * 2 + (l20 >> 5)) * 2 + (fc & 1)) * 64 + l10, v0, v1); ) }
                  else { const int b = u.pn - 128; EPI_FOR8( st_bf8(YT + YT_CTX_OFF + ((size_t)b * 1024 + rr0 + r) * 256 + c, v0, v1); ) } };
              GEMM_P(S, AD, E); }
            REFRESH();
            { GroupSched S; S.init(1, 4, 128, F.G, (F.bid + F.G - (((u1 + u2 + u3) % F.G) & ~7)) % F.G, 4, 8, 0, 128);
              auto AD = [=](const Unit& u) { return Operands{WA8 + (size_t)(2048 + u.pm * 256) * 512, H8 + (size_t)u.pn * 256 * 512, 512, 512, 0, 512}; };
              bf16* VT = WSP(bf16, WS_VT);
              auto E = [=](EPI_ARGS) { const int rr0 = u.pm * 256;
                  if (u.pn < 128) { const int b = u.pn >> 4, l0 = (u.pn & 15) * 256; EPI_FOR8( st_bf8(VT + ((size_t)b * 1024 + rr0 + r) * 4096 + l0 + c, v0 * INV8, v1 * INV8); ) }
                  else { const int b = u.pn - 128; EPI_FOR8( st_bf8(VT + YT_CTX_OFF + ((size_t)b * 1024 + rr0 + r) * 256 + c, v0 * INV8, v1 * INV8); ) } };
              GEMM_P8(S, AD, E); }
        REP_END }
        SEAM(pb + 0);
        if (IN(pb + 1)) { REFRESH();
            { const int nc0 = (F.G * 5 / 16) & ~7, nconv = nc0 > 0 ? nc0 : 1, na = F.G - nconv;
              if (F.bid < na) p_attn_mfma(P, F, l, L0, na, F.bid);
              else wconv_experts(P, F, l, F.bid - na, nconv); }
            REFRESH();
            REP_BEGIN(32)
            { LAS float* tw = (LAS float*)(F.lds + LDS_TW);
              for (int j = F.tid; j < 4096; j += NTHREADS) tw[j] = cospif((float)j * (1.0f / 2048.0f));
              __syncthreads();
              GroupSched S; S.init(1, 1, 512, F.G, F.bid);
              const bf16* M1 = WSP(bf16, WS_M1T); const bf16* YF = WSP(bf16, WS_YT); bf16* ZP = WSP(bf16, WS_ZP);
              auto AD = [=](const Unit& u) { return Operands{M1, YF + (size_t)u.pn * 256 * 256, 256, 256, 0, 256}; };
              auto E = [=](EPI_ARGS) {
                  const int b = u.pn >> 6, gm0 = (u.pn & 63) * 8 + wc, l20 = 32 * wr + 8 * fq;
#pragma unroll
                  for (int m = 0; m < 4; ++m) { const int k1 = 16 * m + fr;
#pragma unroll
                      for (int bj = 0; bj < 2; ++bj) { const int gm = gm0 + 4 * bj;
                          f32x4 zr[2], zi[2];
#pragma unroll
                          for (int n = 0; n < 2; ++n)
#pragma unroll
                              for (int j = 0; j < 4; ++j) { const int ix = k1 * (l20 + 4 * n + j); const float tc = tw[ix], ts = tw[(ix + 3072) & 4095];
                                  const float ur = acc[0][bj][m][n][j], ui = acc[1][bj][m][n][j]; zr[n][j] = ur * tc - ui * ts; zi[n][j] = ur * ts + ui * tc; }
                          bf16* dst = ZP + (((((size_t)b * 64 + k1) * 128 + (gm & 127)) * 4 + (gm >> 7)) * 2) * 64 + l20;
                          st_bf8(dst, zr[0], zr[1]); st_bf8(dst + 64, zi[0], zi[1]); } } };
              GEMM_P(S, AD, E); }
            REP_END
        }
        SEAM(pb + 1);
        if (IN(pb + 10)) { REFRESH();
            { GroupSched S; S.init(1, 1, 256, F.G, F.bid);
              const bf16* M2 = WSP(bf16, WS_M2T); const bf16* ZP = WSP(bf16, WS_ZP); bf16* FOUR = WSP(bf16, WS_FOUR);
              auto AD = [=](const Unit& u) { return Operands{M2, ZP + (size_t)u.pn * 256 * 512, 512, 512, 0, 512}; };
              auto E = [=](EPI_ARGS) { const float sc = 0.0013810679320049757f;
#pragma unroll
                  for (int ai = 0; ai < 2; ++ai)
#pragma unroll
                      for (int m = 0; m < 4; ++m) { const int q = 2 * ai + wr, k2 = 16 * m + fr;
#pragma unroll
                          for (int bj = 0; bj < 2; ++bj) { const int bk = u.pn * 2 + bj, b = bk >> 6, k1 = bk & 63;
                              st_bf8(FOUR + ((size_t)b * SEQ + k1 + 64 * k2) * 512 + q * 128 + wc * 32 + 8 * fq, acc[ai][bj][m][0] * sc, acc[ai][bj][m][1] * sc); } } };
              GEMM_P(S, AD, E); }
            REFRESH();
            if (L0) { GroupSched S; S.init(1, 1, 16, F.G, (F.bid + F.G - 128 % F.G) % F.G);
              const bf16* DFTC = WSP(bf16, WS_DFTC); const bf16* YTC = WSP(bf16, WS_YT) + YT_CTX_OFF; bf16* FOUR = WSP(bf16, WS_FOUR);
              auto AD = [=](const Unit& u) { return Operands{DFTC, YTC + (size_t)u.pn * 256 * 512, 512, 512, 0, 512}; };
              auto E = [=](EPI_ARGS) { const int b = u.pn >> 1, c0 = (u.pn & 1) * 256; const float sc = 0.005524271728019903f;
                  EPI_FOR8( st_bf8(FOUR + ((size_t)RL + b * CTXL + r) * 512 + c0 + c, v0 * sc, v1 * sc); ) };
              GEMM_P(S, AD, E); }
            REFRESH();
            REP_BEGIN(33) p_pool(F, L0 ? RT : RL); REP_END
        }
        SEAM(pb + 10);
        if (IN(pb + 2)) { REFRESH();
            SegSched<3> S; S.base.init(1, L0 ? 136 : 128, 4, F.G, F.bid);
            const bf16* ATT = WSP(bf16, WS_ATT); const bf16* FOUR = WSP(bf16, WS_FOUR); const bf16* POOL = WSP(bf16, WS_POOL);
            const bf16* WAO = WSP(bf16, WS_WAO); const bf16* WFO = WSP(bf16, WS_WFO); const bf16* WPO = WSP(bf16, WS_WPO);
            const bf16* GB = WSP(bf16, WS_GB); bf16* MRGB = WSP(bf16, WS_MRGB); const float* ps = P.pool_scale + l * 1024;
            auto AD = [=](const Unit& u) {
                if (u.seg == 0) return Operands{ATT + (size_t)u.pm * 256 * 1024, WAO + (size_t)u.pn * 256 * 1024, 1024, 1024, 0, 1024};
                if (u.seg == 1) return Operands{FOUR + (size_t)u.pm * 256 * 512, WFO + (size_t)u.pn * 256 * 512, 512, 512, 0, 512};
                return Operands{POOL + (size_t)u.pm * 256 * 512 + (u.pn >> 1) * 256, WPO + (size_t)u.pn * 256 * 256, 512, 256, 0, 256}; };
            auto E = [=](EPI_ARGS) {
                const int kd = u.seg < 2 ? u.seg + 1 : 2; const bool fin = (u.seg == 2); const int colb = u.pn * 256 + wc * 32 + 8 * fq;
#pragma unroll
                for (int ai = 0; ai < 2; ++ai)
#pragma unroll
                    for (int m = 0; m < 4; ++m) { const size_t row = (size_t)u.pm * 256 + ai * 128 + wr * 64 + m * 16 + fr; const bf16* gr = GB + row * 3072 + colb;
                        u32x4 nr[2], dr[2]; f32x4 psv[2][2];
#pragma unroll
                        for (int bj = 0; bj < 2; ++bj) { nr[bj] = *(const u32x4*)(gr + u.seg * 1024 + bj * 128); dr[bj] = *(const u32x4*)(gr + kd * 1024 + bj * 128);
                            psv[bj][0] = *(const f32x4*)(ps + colb + bj * 128); psv[bj][1] = *(const f32x4*)(ps + colb + bj * 128 + 4); }
#pragma unroll
                        for (int bj = 0; bj < 2; ++bj) { f32x4 o[2];
#pragma unroll
                            for (int n = 0; n < 2; ++n) { f32x4 nu = {bflo(nr[bj][2 * n]), bfhi(nr[bj][2 * n]), bflo(nr[bj][2 * n + 1]), bfhi(nr[bj][2 * n + 1])}, de = {bflo(dr[bj][2 * n]), bfhi(dr[bj][2 * n]), bflo(dr[bj][2 * n + 1]), bfhi(dr[bj][2 * n + 1])};
                                if (u.seg == 2) nu = nu * psv[bj][n];
                                de = de * psv[bj][n];
#pragma unroll
                                for (int j = 0; j < 4; ++j) { const float nj = (fabsf(nu[j]) < 1e-30f) ? copysignf(1e-30f, nu[j]) : nu[j]; const float dj = (fabsf(de[j]) < 1e-30f) ? copysignf(1e-30f, de[j]) : de[j];
                                    o[n][j] = acc[ai][bj][m][n][j] * nj * (fin ? 1.0f : __builtin_amdgcn_rcpf(dj)); }
                                acc[ai][bj][m][n] = o[n]; }
                            if (fin) st_bf8(MRGB + row * 1024 + colb + bj * 128, o[0], o[1]); } } };
            gemm_fast<false, true, false>(F.lds, F.tid, S, AD, mk_epi_seg(E, 2), nullptr);
        }
        SEAM(pb + 2);
        if (IN(pb + 3)) { REFRESH();
            GroupSched S; S.init(1, L0 ? 136 : 128, 4, F.G, F.bid); const bf16* A = WSP(bf16, WS_MRGB); const bf16* W = WSP(bf16, WS_WOUT);
            const float* xin = L0 ? P.x : P.out; const float* cin = L0 ? P.ctx : WSP(float, WS_XC); float* xo = P.out; float* co = WSP(float, WS_XC);
            const float* MOD = WSP(float, WS_MOD) + (size_t)l * 9 * 6144;
            auto AD = [=](const Unit& u) { return Operands{A + (size_t)u.pm * 256 * 1024, W + (size_t)u.pn * 256 * 1024, 1024, 1024, 0, 1024}; };
            auto E = [=](EPI_ARGS) {
                const int row0 = u.pm * 256, mr = row0 < RL ? (row0 >> 12) : 8, colb = u.pn * 256 + wc * 32 + 4 * fq;
                const float* src0 = row0 < RL ? xin + (size_t)row0 * DM : cin + (size_t)(row0 - RL) * DM; float* dst0 = row0 < RL ? xo + (size_t)row0 * DM : co + (size_t)(row0 - RL) * DM;
                f32x4 gv[2][2];
#pragma unroll
                for (int bj = 0; bj < 2; ++bj)
#pragma unroll
                    for (int n = 0; n < 2; ++n) gv[bj][n] = *(const f32x4*)(MOD + (size_t)mr * 6144 + 2048 + colb + bj * 128 + n * 16);
#pragma unroll
                for (int ai = 0; ai < 2; ++ai) { f32x4 xv[4][2][2];
#pragma unroll
                    for (int m = 0; m < 4; ++m) { const size_t ro = (size_t)(ai * 128 + wr * 64 + m * 16 + fr) * DM + colb;
#pragma unroll
                        for (int bj = 0; bj < 2; ++bj)
#pragma unroll
                            for (int n = 0; n < 2; ++n) xv[m][bj][n] = *(const f32x4*)(src0 + ro + bj * 128 + n * 16); }
#pragma unroll
                    for (int m = 0; m < 4; ++m) { const size_t ro = (size_t)(ai * 128 + wr * 64 + m * 16 + fr) * DM + colb;
#pragma unroll
                        for (int bj = 0; bj < 2; ++bj)
#pragma unroll
                            for (int n = 0; n < 2; ++n) *(f32x4*)(dst0 + ro + bj * 128 + n * 16) = xv[m][bj][n] + gv[bj][n] * acc[ai][bj][m][n]; } } };
            GEMM(S, AD, E, 1024, 1024, 1024);
        }
        SEAM(pb + 3);
        if (IN(pb + 4)) { REFRESH(); REP_BEGIN(6) p_rowpass_f(P, F, l, L0 ? RT : RL); REP_END }
        SEAM(pb + 4);
        if (IN(pb + 5)) { REFRESH(); REP_BEGIN(7) p_topk(F, L0); REP_END }
        SEAM(pb + 5);
        if (IN(pb + 7)) { REFRESH(); REP_BEGIN(9)
            GroupSched S; S.init(16, L0 ? 17 : 16, 22, F.G, F.bid); const bf16* H8 = WSP(bf16, WS_H8); const bf16* W = WSP(bf16, WS_WGU); unsigned char* HID = WSP(unsigned char, WS_HID); const int* SROW = WSP(int, WS_SROW);
            auto AD = [=](const Unit& u) { return Operands{H8, W + ((size_t)u.grp * 5632 + u.pn * 256) * 512, 512, 512, u.grp * SLOT_E + u.pm * 256, 512}; };
            auto E = [=](EPI_ARGS) {
#pragma unroll
                for (int ai = 0; ai < 2; ++ai)
#pragma unroll
                    for (int m = 0; m < 4; ++m) { const size_t slot = (size_t)u.grp * SLOT_E + u.pm * 256 + ai * 128 + wr * 64 + m * 16 + fr; f32x4 o[2];
#pragma unroll
                        for (int n = 0; n < 2; ++n) { const f32x4 a = acc[ai][0][m][n] * INV8, up = acc[ai][1][m][n] * (INV8 * A8S);
#pragma unroll
                            for (int j = 0; j < 4; ++j) o[n][j] = a[j] * sigmoidf_(a[j]) * up[j]; }
                        u32x2 w; w.x = pk4_fp8(o[0][0], o[0][1], o[0][2], o[0][3]); w.y = pk4_fp8(o[1][0], o[1][1], o[1][2], o[1][3]);
                        *(u32x2*)(HID + slot * FF + u.pn * 128 + wc * 32 + 8 * fq) = w; } };
            GEMM_GATHER8(S, AD, E, SROW);
        REP_END }
        SEAM(pb + 7);
        if (IN(pb + 8)) { REFRESH(); REP_BEGIN(10)
            const int tpe = L0 ? 17 : 16;
            GroupSched S; S.init(1, 16 * tpe, 4, F.G, F.bid); const bf16* HID = WSP(bf16, WS_HID); const bf16* W = WSP(bf16, WS_WD); bf16* Y = WSP(bf16, WS_Y); const float* SG = WSP(float, WS_SGATE);
            auto AD = [=](const Unit& u) { const int e = u.pm / tpe, st = e * 17 + (u.pm - e * tpe); return Operands{HID + (size_t)st * 256 * (FF / 2), W + ((size_t)e * 1024 + u.pn * 256) * (FF / 2), FF / 2, FF / 2, 0, FF / 2}; };
            auto E = [=](EPI_ARGS) { const int e = u.pm / tpe; const size_t slot0 = (size_t)(e * 17 + (u.pm - e * tpe)) * 256 + wr * 64 + fr; float gt[2][4];
#pragma unroll
                for (int ai = 0; ai < 2; ++ai)
#pragma unroll
                    for (int m = 0; m < 4; ++m) gt[ai][m] = SG[slot0 + ai * 128 + m * 16] * INV8;
#pragma unroll
                for (int ai = 0; ai < 2; ++ai)
#pragma unroll
                    for (int m = 0; m < 4; ++m)
#pragma unroll
                        for (int bj = 0; bj < 2; ++bj) st_bf8(Y + (slot0 + ai * 128 + m * 16) * DM + u.pn * 256 + bj * 128 + wc * 32 + 8 * fq, acc[ai][bj][m][0] * gt[ai][m], acc[ai][bj][m][1] * gt[ai][m]); };
            GEMM_P8(S, AD, E);
        REP_END }
        SEAM(pb + 8);
        if (IN(pb + 9)) { REFRESH(); p_rowpass_k(P, F, l, L0 ? RT : RL); if (L0) p_wconv(P, F, 1); }
        if (L0) SEAM(pb + 9);
    }
#undef IN
#undef SEAM
}
template <int PH> static void launch_ph(int grid, const Params& p, hipStream_t stream) { hipLaunchKernelGGL(fwd_kernel<PH>, dim3(grid), dim3(NTHREADS), LDS_BYTES, stream, p); }
template <int PH> static bool set_attr() { return hipFuncSetAttribute((const void*)fwd_kernel<PH>, hipFuncAttributeMaxDynamicSharedMemorySize, LDS_BYTES) == hipSuccess; }

#ifndef DUP_LAUNCH
#define DUP_LAUNCH -1
#endif
extern "C" void kernel_launch(void* const* d_in, const int* in_sizes, int n_in, void* d_out, int out_size, void* d_ws, size_t ws_size, hipStream_t stream) {
    static int grid = 0;
    if (grid == 0) {
        if (n_in != 20 || out_size != RL * DM || ws_size < WS_END) { fprintf(stderr, "kernel_launch: unexpected shapes (n_in %d out %d ws %zu need %zu)\n", n_in, out_size, ws_size, (size_t)WS_END); grid = -1; return; }
        int dev = 0, cus = 0, per_cu = 0;
        if (hipGetDevice(&dev) != hipSuccess || hipDeviceGetAttribute(&cus, hipDeviceAttributeMultiprocessorCount, dev) != hipSuccess) { grid = -1; return; }
#if N_LAUNCH_MODE == 1
        if (!set_attr<-1>()) { fprintf(stderr, "kernel_launch: hipFuncSetAttribute failed\n"); grid = -1; return; }
        if (hipOccupancyMaxActiveBlocksPerMultiprocessor(&per_cu, (const void*)fwd_kernel<-1>, NTHREADS, LDS_BYTES) != hipSuccess || per_cu < 1) fprintf(stderr, "kernel_launch: occupancy query reports %d\n", per_cu);
#else
        if (!(set_attr<0>() && set_attr<1>() && set_attr<2>() && set_attr<3>() && set_attr<12>() && set_attr<4>() && set_attr<5>() && set_attr<6>() && set_attr<7>() && set_attr<9>() && set_attr<10>() && set_attr<11>())) { fprintf(stderr, "kernel_launch: hipFuncSetAttribute failed\n"); grid = -1; return; }
        (void)per_cu;
#endif
        (void)hipGetLastError();
        grid = cus;
    }
    if (grid < 0) return;
    if (hipMemsetAsync((char*)d_ws + WS_CTL, 0, CTL_BYTES, stream) != hipSuccess) return;
    Params p{};
    const float** pp = (const float**)&p;
    for (int i = 0; i < 20; ++i) pp[i] = (const float*)d_in[i];
    p.out = (float*)d_out; p.ws = (unsigned char*)d_ws;
#if N_LAUNCH_MODE == 1
    p.l_lo = 0; p.l_hi = 2;
    launch_ph<-1>(grid, p, stream);
#else
    p.l_lo = 0; p.l_hi = 0; launch_ph<0>(grid, p, stream); if (DUP_LAUNCH == 0) launch_ph<0>(grid, p, stream); launch_ph<1>(grid, p, stream); if (DUP_LAUNCH == 1) launch_ph<1>(grid, p, stream);
#define LP(k) do { launch_ph<k>(grid, p, stream); if (DUP_LAUNCH == (k) && l == 0) launch_ph<k>(grid, p, stream); } while (0)
    for (int l = 0; l < 2; ++l) { p.l_lo = l; p.l_hi = l + 1;
        LP(2); LP(3); LP(12); LP(4); LP(5); LP(6); LP(7); LP(9); LP(10); LP(11); }
#endif
}
```

```cpp
#include <hip/hip_runtime.h>
#include <cstdio>
#include <cstdint>

#ifndef N_LAUNCH_MODE
#define N_LAUNCH_MODE 1
#endif

#define GAS __attribute__((address_space(1)))
#define LAS __attribute__((address_space(3)))
typedef unsigned short bf16;
typedef short bf16x8 __attribute__((ext_vector_type(8)));
typedef float f32x4 __attribute__((ext_vector_type(4)));
typedef unsigned u32x4 __attribute__((ext_vector_type(4)));
typedef unsigned u32x2 __attribute__((ext_vector_type(2)));

constexpr int NB = 8, SEQ = 4096, DM = 1024, CTXL = 256, NH = 16, HD = 64, GRIDW = 64;
constexpr int RL = NB * SEQ, RC = NB * CTXL, RT = RL + RC;
constexpr int INW = 7168, NE = 16, FF = 2816, CAPL = 512, CAPC = 32;
constexpr int SLOT_E = 4352, NSLOT = NE * SLOT_E;
constexpr float RMS_EPS = 1e-6f;
constexpr float LOG2E = 1.4426950408889634f, QSCALE = 0.125f * LOG2E;
constexpr float A8S = 8.0f, W8S = 64.0f, INV8 = 1.0f / (A8S * W8S);
constexpr float ATS = 32.0f, INVAT = 1.0f / (ATS * W8S);
constexpr int NWAVES = 8, NTHREADS = 512;

constexpr size_t al256(size_t x) { return (x + 255) & ~(size_t)255; }
constexpr size_t WS_CTL = 0, CTL_BYTES = 1u << 20;
constexpr size_t WS_MOD = WS_CTL + CTL_BYTES;
constexpr size_t WS_XC = al256(WS_MOD + (size_t)2 * 9 * 6144 * 4);
constexpr size_t WS_AFF = al256(WS_XC + (size_t)RC * DM * 4);
constexpr size_t WS_SROW = al256(WS_AFF + (size_t)RT * 16 * 4);
constexpr size_t WS_SGATE = al256(WS_SROW + (size_t)NSLOT * 4);
constexpr size_t WS_SEL = al256(WS_SGATE + (size_t)NSLOT * 4);
constexpr size_t WS_DFTM = al256(WS_SEL + (size_t)RT * 16 * 4);
constexpr size_t WS_DFTC = al256(WS_DFTM + (size_t)4096 * 8192 * 2);
constexpr size_t WS_WA = al256(WS_DFTC + (size_t)256 * 512 * 2);
constexpr size_t WS_WFV = al256(WS_WA + (size_t)5632 * 1024 * 2);
constexpr size_t WS_WAO = al256(WS_WFV + (size_t)2048 * 1024 * 2);
constexpr size_t WS_WFO = al256(WS_WAO + (size_t)1024 * 1024 * 2);
constexpr size_t WS_WPO = al256(WS_WFO + (size_t)1024 * 512 * 2);
constexpr size_t WS_WOUT = al256(WS_WPO + (size_t)1024 * 256 * 2);
constexpr size_t WS_WGU = al256(WS_WOUT + (size_t)1024 * 1024 * 2);
constexpr size_t WS_WD = al256(WS_WGU + (size_t)16 * 5632 * 1024);
constexpr size_t WS_WA8 = al256(WS_WD + (size_t)16 * 1024 * 2816);
constexpr size_t WS_H = al256(WS_WA8 + (size_t)6144 * 1024);
constexpr size_t WS_H8 = al256(WS_H + (size_t)RT * DM * 2);
constexpr size_t WS_R = al256(WS_H8 + (size_t)RT * DM);
constexpr size_t WS_KQ = WS_R;
constexpr size_t WS_MRG = WS_KQ;
constexpr size_t WS_PB = al256(WS_KQ + (size_t)RT * 2048 * 2);
constexpr size_t WS_GB = al256(WS_PB + (size_t)RT * 512 * 2);
constexpr size_t WS_YT = al256(WS_GB + (size_t)RT * 3072 * 2);
constexpr size_t WS_MRGB = WS_YT;
constexpr size_t WS_VT = al256(WS_YT + (size_t)RT * 1024 * 2);
constexpr size_t WS_FOUR = al256(WS_VT + (size_t)RT * 1024 * 2);
constexpr size_t WS_ATT = al256(WS_FOUR + (size_t)RT * 512 * 2);
constexpr size_t WS_POOL = al256(WS_ATT + (size_t)RT * 1024 * 2);
constexpr size_t WS_MIX_END = al256(WS_POOL + (size_t)RT * 512 * 2);
constexpr size_t WS_XG = WS_R;
constexpr size_t WS_HID = al256(WS_XG + (size_t)NSLOT * 1024 * 2);
constexpr size_t WS_Y = al256(WS_HID + (size_t)NSLOT * 2816);
constexpr size_t WS_MOE_END = al256(WS_Y + (size_t)NSLOT * 1024 * 2);
constexpr size_t WS_END0 = WS_MIX_END > WS_MOE_END ? WS_MIX_END : WS_MOE_END;
constexpr size_t WS_ZP = WS_END0;
constexpr size_t WS_M1T = al256(WS_ZP + ((size_t)8 * 64 * 512 * 128 + 1024) * 2);
constexpr size_t WS_M2T = al256(WS_M1T + (size_t)256 * 256 * 2);
constexpr size_t WS_END = al256(WS_M2T + (size_t)256 * 512 * 2);
constexpr size_t YT_CTX_OFF = (size_t)8 * 1024 * 4096;

constexpr int CW_BAR = 4096;

constexpr int LDS_BYTES = 155648;
constexpr int LDS_TW = 132096;
constexpr int LDS_MISC = 131072;

__device__ __forceinline__ unsigned f2bf(float f) { unsigned u = __float_as_uint(f); return (u + 0x7fffu + ((u >> 16) & 1u)) >> 16; }
typedef __bf16 hbf16x2 __attribute__((ext_vector_type(2)));
typedef float f32x2 __attribute__((ext_vector_type(2)));
__device__ __forceinline__ unsigned pk2(float lo, float hi) { const f32x2 v = {lo, hi}; return __builtin_bit_cast(unsigned, __builtin_convertvector(v, hbf16x2)); }
__device__ __forceinline__ unsigned pk4_fp8(float a, float b, float c, float d) {
    a = __builtin_amdgcn_fmed3f(a, -448.f, 448.f); b = __builtin_amdgcn_fmed3f(b, -448.f, 448.f); c = __builtin_amdgcn_fmed3f(c, -448.f, 448.f); d = __builtin_amdgcn_fmed3f(d, -448.f, 448.f);
    int w = 0; w = __builtin_amdgcn_cvt_pk_fp8_f32(a, b, w, false); w = __builtin_amdgcn_cvt_pk_fp8_f32(c, d, w, true); return (unsigned)w; }
__device__ __forceinline__ float bf2f(unsigned b) { return __uint_as_float(b << 16); }
__device__ __forceinline__ float bflo(unsigned w) { return __uint_as_float(w << 16); }
__device__ __forceinline__ float bfhi(unsigned w) { return __uint_as_float(w & 0xffff0000u); }
template <int CTRL> __device__ __forceinline__ float dppf(float x) { return __builtin_bit_cast(float, __builtin_amdgcn_mov_dpp(__builtin_bit_cast(int, x), CTRL, 0xf, 0xf, true)); }
template <int CTRL> __device__ __forceinline__ int dppi(int x) { return __builtin_amdgcn_mov_dpp(x, CTRL, 0xf, 0xf, true); }
constexpr int DPP_XOR1 = 0xB1, DPP_XOR2 = 0x4E, DPP_ROR4 = 0x124, DPP_ROR8 = 0x128;
__device__ __forceinline__ float wave_sum(float v) {
    v += dppf<DPP_XOR1>(v); v += dppf<DPP_XOR2>(v); v += dppf<DPP_ROR4>(v); v += dppf<DPP_ROR8>(v);
    auto s = __builtin_amdgcn_permlane16_swap(__float_as_uint(v), __float_as_uint(v), false, false); v = __uint_as_float(s[0]) + __uint_as_float(s[1]);
    auto t = __builtin_amdgcn_permlane32_swap(__float_as_uint(v), __float_as_uint(v), false, false); return __uint_as_float(t[0]) + __uint_as_float(t[1]);
}
__device__ __forceinline__ float wave_max(float v) {
    v = fmaxf(v, dppf<DPP_XOR1>(v)); v = fmaxf(v, dppf<DPP_XOR2>(v)); v = fmaxf(v, dppf<DPP_ROR4>(v)); v = fmaxf(v, dppf<DPP_ROR8>(v));
    auto s = __builtin_amdgcn_permlane16_swap(__float_as_uint(v), __float_as_uint(v), false, false); v = fmaxf(__uint_as_float(s[0]), __uint_as_float(s[1]));
    auto t = __builtin_amdgcn_permlane32_swap(__float_as_uint(v), __float_as_uint(v), false, false); return fmaxf(__uint_as_float(t[0]), __uint_as_float(t[1]));
}
__device__ __forceinline__ int wave_sum_i(int v) {
    v += dppi<DPP_XOR1>(v); v += dppi<DPP_XOR2>(v); v += dppi<DPP_ROR4>(v); v += dppi<DPP_ROR8>(v);
    auto s = __builtin_amdgcn_permlane16_swap((unsigned)v, (unsigned)v, false, false); v = (int)(s[0] + s[1]);
    auto t = __builtin_amdgcn_permlane32_swap((unsigned)v, (unsigned)v, false, false); return (int)(t[0] + t[1]);
}
__device__ __forceinline__ float sigmoidf_(float x) { return __builtin_amdgcn_rcpf(1.f + __builtin_amdgcn_exp2f(x * -1.4426950408889634f)); }
#define LDS_WAIT() asm volatile("s_waitcnt lgkmcnt(0)" ::: "memory")

#define XB_TMO      128
#define XB_XCNT(j)  (256  + 64 * (j))
#define XB_XSUB(j)  (1280 + 64 * (j))
#define XB_XGEN(j)  (2304 + 64 * (j))
#define XB_TOP      3328
#define XB_TOPGEN   3392
#define XCD_BAR_WORDS 3456
#define XB_SPIN_CAP (1u << 22)

__device__ __forceinline__ unsigned xb_ld(unsigned* p)              { return __hip_atomic_load(p, __ATOMIC_RELAXED, __HIP_MEMORY_SCOPE_AGENT); }
__device__ __forceinline__ unsigned xb_add(unsigned* p, unsigned v) { return __hip_atomic_fetch_add(p, v, __ATOMIC_RELAXED, __HIP_MEMORY_SCOPE_AGENT); }
__device__ __forceinline__ unsigned xb_xcc_id() { return (unsigned)__builtin_amdgcn_s_getreg((3 << 11) | 20) & 0xFu; }
#define XB_SPIN(cond, bar) do { unsigned _sp = 0; while (cond) { __builtin_amdgcn_s_sleep(1); \
    if ((++_sp & 255u) == 0u) { if (xb_ld(&(bar)[XB_TMO])) break; if (_sp > XB_SPIN_CAP) { atomicAdd(&(bar)[XB_TMO], 1u); break; } } } } while (0)

struct XcdBarrier { unsigned* bar; unsigned x; volatile LAS unsigned* st; };

__device__ __forceinline__ XcdBarrier xcd_barrier_post(unsigned* bar, volatile LAS unsigned* st) {
    XcdBarrier b; b.bar = bar; b.x = xb_xcc_id(); b.st = st;
    if (threadIdx.x == 0) (void)xb_add(&bar[XB_XCNT(b.x)], 1u);
    return b;
}
__device__ __forceinline__ void xcd_barrier_complete(unsigned* bar, unsigned x, unsigned& nloc, unsigned& nx) {
    const unsigned G = gridDim.x * gridDim.y * gridDim.z;
    unsigned sum, cnt, mine, sp = 0u;
    for (;;) {
        sum = 0u; cnt = 0u; mine = 0u;
#pragma unroll
        for (unsigned j = 0; j < 16; ++j) { const unsigned c = xb_ld(&bar[XB_XCNT(j)]); sum += c; cnt += (c > 0u) ? 1u : 0u; mine = (j == x) ? c : mine; }
        if (sum == G) break;
        __builtin_amdgcn_s_sleep(1);
        if ((++sp & 255u) == 0u) { if (xb_ld(&bar[XB_TMO])) break; if (sp > XB_SPIN_CAP) { atomicAdd(&bar[XB_TMO], 1u); break; } }
    }
    nloc = mine > 0u ? mine : 1u; nx = cnt > 0u ? cnt : 1u;
}
__device__ __forceinline__ void xcd_barrier(const XcdBarrier& b) {
    asm volatile("s_waitcnt vmcnt(0)" ::: "memory");
    __syncthreads();
    if (threadIdx.x == 0) {
        unsigned* bar = b.bar;
        __builtin_amdgcn_s_waitcnt(0);
        unsigned nloc = b.st[0], nx = b.st[1];
        if (nloc == 0u) { xcd_barrier_complete(bar, b.x, nloc, nx); b.st[0] = nloc; b.st[1] = nx; }
        const unsigned old = xb_add(&bar[XB_XSUB(b.x)], 1u);
        const unsigned gen = old / nloc;
        if (old + 1u == (gen + 1u) * nloc) {
            __builtin_amdgcn_fence(__ATOMIC_RELEASE, "agent");
            asm volatile("s_waitcnt vmcnt(0)" ::: "memory");
            const unsigned og = xb_add(&bar[XB_TOP], 1u);
            const unsigned tg = og / nx;
            if (og + 1u == (tg + 1u) * nx) xb_add(&bar[XB_TOPGEN], 1u);
            else XB_SPIN(xb_ld(&bar[XB_TOPGEN]) == tg, bar);
            __builtin_amdgcn_fence(__ATOMIC_ACQUIRE, "agent");
            xb_add(&bar[XB_XGEN(b.x)], 1u);
            asm volatile("s_waitcnt vmcnt(0)" ::: "memory");
        } else {
            XB_SPIN(xb_ld(&bar[XB_XGEN(b.x)]) == gen, bar);
            __builtin_amdgcn_fence(__ATOMIC_ACQUIRE, "agent");
            asm volatile("s_waitcnt vmcnt(0)" ::: "memory");
        }
    }
    __syncthreads();
}

struct Params {
    const float *x, *c, *ctx, *c_ctx, *ada_w, *ada_b, *norm1_g, *norm2_g, *w_in, *rpb, *w_att_o, *w_fourier, *w_pool, *pool_scale, *w_out, *w_router, *w_eg, *w_eu, *w_ed, *final_g;
    float* out; unsigned char* ws; int l_lo, l_hi;
};
struct Frame {
    LAS unsigned char* lds;
    int tid, lane, wave, G, bid;
    unsigned char* ws;
};
#define WSP(T, off) ((T*)(F.ws + (off)))

struct Unit { int grp, pm, pn, seg; };
struct GroupSched {
    int ng, nM, nN, G, c; int tM, tN, tpm0, tpn0;
    __device__ __forceinline__ void init(int ng_, int nM_, int nN_, int G_, int c_, int tM_ = 0, int tN_ = 0, int tpm0_ = 0, int tpn0_ = 0) { ng = ng_; nM = nM_; nN = nN_; G = G_; c = c_; tM = tM_; tN = tN_; tpm0 = tpm0_; tpn0 = tpn0_; }
    __device__ __forceinline__ bool next(int i, Unit& u) const {
        const int per = nM * nN; const int L = i * G + c;
        if (L < ng * per) {
            u.grp = L / per; int wgid = L - u.grp * per;
            { const int q = per / 8, r = per % 8, xcd = wgid % 8, off = wgid / 8; wgid = (xcd < r ? xcd * (q + 1) : r * (q + 1) + (xcd - r) * q) + off; }
            const int nig = 8 * nN, gid = wgid / nig, fm = gid * 8, gsz = (nM - fm) < 8 ? (nM - fm) : 8;
            u.pm = fm + ((wgid % nig) % gsz); u.pn = (wgid % nig) / gsz; u.seg = 0; return true;
        }
        const int w = L - ng * per;
        if (w < tM * tN) { u.grp = ng; u.pm = tpm0 + (w % tM); u.pn = tpn0 + (w / tM); u.seg = 0; return true; }
        return false;
    }
};
struct Operands { const bf16* A; const bf16* Bt; int lda, ldb, slot0, K; int bmap; };

constexpr int HTB = 128 * 64 * 2;
__device__ __forceinline__ int lds_byte(int r, int c) { const int st = (r >> 4) * 2 + (c >> 5), rr = r & 15, cc = c & 31, ob = rr * 64 + cc * 2; return st * 1024 + (ob ^ (((ob >> 9) & 1) << 5)); }
__device__ __forceinline__ int perm32(int rho) { const int n = rho >> 4, i = rho & 15; return 8 * (i >> 2) + 4 * n + (i & 3); }
__device__ __forceinline__ void stage_rc(int b, int& R, int& C) { const int st = b / 1024, sb = b % 1024, swz = sb ^ (((sb >> 9) & 1) << 5); R = (st >> 1) * 16 + swz / 64; C = (st & 1) * 32 + (swz % 64) / 2; }
typedef int i32x8 __attribute__((ext_vector_type(8)));
typedef int i32x4 __attribute__((ext_vector_type(4)));
__device__ __forceinline__ i32x8 cat8(bf16x8 lo, bf16x8 hi) { const i32x4 a = __builtin_bit_cast(i32x4, lo), b = __builtin_bit_cast(i32x4, hi); return (i32x8){a[0], a[1], a[2], a[3], b[0], b[1], b[2], b[3]}; }
template <bool GATHER, bool PERM, bool FP8, class Sched, class Addr, class Epi>
__device__ __forceinline__ void gemm_fast(LAS unsigned char* lds, const int tid, const Sched& S, const Addr& AD, const Epi& E, const int* __restrict__ grows) {
    const int wid = __builtin_amdgcn_readfirstlane(tid >> 6), lane = tid & 63, wr = wid >> 2, wc = wid & 3, fr = lane & 15, fq = lane >> 4;
    unsigned cvg[2][2], nvg[2][2], cvb[2][2], nvb[2][2];
#define PG8_RC(i_) int R_, C_; stage_rc(tid * 16 + (i_) * 8192, R_, C_); const int sR_ = R_; const unsigned sC_ = (unsigned)C_ * 2u; const int sRb_ = PERM ? ((R_ & ~31) + perm32(R_ & 31)) : R_; (void)sR_; (void)sRb_; (void)sC_
    const size_t kstep = 128;
    const unsigned ldsw = (unsigned)wid * 1024u;
    const int aoff = lds_byte(wr * 64 + fr, fq * 8), boff = lds_byte(wc * 32 + fr, fq * 8);
#define PG8_SA(b, h) (((b) * 2 + (h)) * HTB)
#define PG8_SB(b, h) ((4 + (b) * 2 + (h)) * HTB)
#define PG8_STAGE(bufoff, gbase, voff) do { _Pragma("unroll") for (int _i = 0; _i < 2; ++_i) \
        __builtin_amdgcn_global_load_lds((const unsigned*)((const char*)(gbase) + (voff)[_i]), (LAS unsigned*)(lds + (bufoff) + ldsw + _i * 8192), 16, 0, 0); } while (0)
#define PG8_LDA(dst, b, h) do { if constexpr (FP8) { _Pragma("unroll") for (int m = 0; m < 4; ++m) dst##8[m] = cat8(*(const LAS bf16x8*)(lds + PG8_SA(b, h) + aoff + m * 2048), *(const LAS bf16x8*)(lds + PG8_SA(b, h) + aoff + m * 2048 + 1024)); } \
        else { _Pragma("unroll") for (int m = 0; m < 4; ++m) _Pragma("unroll") for (int k = 0; k < 2; ++k) dst[m][k] = *(const LAS bf16x8*)(lds + PG8_SA(b, h) + aoff + m * 2048 + k * 1024); } } while (0)
#define PG8_LDB(dst, b, h) do { if constexpr (FP8) { _Pragma("unroll") for (int n = 0; n < 2; ++n) dst##8[n] = cat8(*(const LAS bf16x8*)(lds + PG8_SB(b, h) + boff + n * 2048), *(const LAS bf16x8*)(lds + PG8_SB(b, h) + boff + n * 2048 + 1024)); } \
        else { _Pragma("unroll") for (int n = 0; n < 2; ++n) _Pragma("unroll") for (int k = 0; k < 2; ++k) dst[n][k] = *(const LAS bf16x8*)(lds + PG8_SB(b, h) + boff + n * 2048 + k * 1024); } } while (0)
#define PG8_MMA(ai, bj, At, Bt) do { __builtin_amdgcn_s_setprio(1); \
        if constexpr (FP8) { _Pragma("unroll") for (int m = 0; m < 4; ++m) _Pragma("unroll") for (int n = 0; n < 2; ++n)   \
            asm volatile("v_mfma_scale_f32_16x16x128_f8f6f4 %0, %1, %2, %0, %3, %3 op_sel_hi:[0,0,0]" : "+v"(acc[ai][bj][m][n]) : "v"(Bt##8[n]), "v"(At##8[m]), "v"(one_scale)); } \
        else { _Pragma("unroll") for (int m = 0; m < 4; ++m) _Pragma("unroll") for (int n = 0; n < 2; ++n) _Pragma("unroll") for (int k = 0; k < 2; ++k) \
            acc[ai][bj][m][n] = __builtin_amdgcn_mfma_f32_16x16x32_bf16(Bt[n][k], At[m][k], acc[ai][bj][m][n], 0, 0, 0); } \
        __builtin_amdgcn_s_setprio(0); } while (0)
#define PG8_WAIT_V(n) asm volatile("s_waitcnt vmcnt(" #n ")" ::: "memory")
#define PG8_WAIT_L(n) asm volatile("s_waitcnt lgkmcnt(" #n ")" ::: "memory")
#define PG8_BAR __builtin_amdgcn_s_barrier()
#define PG8_SCHED __builtin_amdgcn_sched_barrier(0)
#define PG8_GIDX(dst, op_) do { _Pragma("unroll") for (int i_ = 0; i_ < 2; ++i_) { PG8_RC(i_); _Pragma("unroll") for (int h_ = 0; h_ < 2; ++h_) dst[h_][i_] = (unsigned)grows[(op_).slot0 + h_ * 128 + sR_] * (unsigned)((op_).lda * 2) + sC_; } } while (0)
#define PG8_AOFF(dst, op_) do { _Pragma("unroll") for (int i_ = 0; i_ < 2; ++i_) { PG8_RC(i_); _Pragma("unroll") for (int h_ = 0; h_ < 2; ++h_) dst[h_][i_] = (unsigned)((sR_ + 128 * h_) * (op_).lda) * 2u + sC_; } } while (0)
#define PG8_BOFF(dst, op_) do { _Pragma("unroll") for (int i_ = 0; i_ < 2; ++i_) { PG8_RC(i_); _Pragma("unroll") for (int h_ = 0; h_ < 2; ++h_) { const int c_ = sRb_ + 128 * h_; \
        dst[h_][i_] = (unsigned)(((op_).bmap ? (64 * (c_ & 7) + (c_ >> 3)) : c_) * (op_).ldb) * 2u + sC_; } } } while (0)
#define PG8_COPY(dst, src) do { _Pragma("unroll") for (int h_ = 0; h_ < 2; ++h_) _Pragma("unroll") for (int i_ = 0; i_ < 2; ++i_) dst[h_][i_] = src[h_][i_]; } while (0)
    Unit cur, nxt; int ui = 0;
    if (!S.next(0, cur)) return;
    f32x4 acc[2][2][4][2];
#pragma unroll
    for (int a = 0; a < 2; ++a)
#pragma unroll
        for (int b = 0; b < 2; ++b)
#pragma unroll
            for (int m = 0; m < 4; ++m)
#pragma unroll
                for (int n = 0; n < 2; ++n) acc[a][b][m][n] = (f32x4){0.f, 0.f, 0.f, 0.f};
    bf16x8 At[4][2], B0[2][2], B1[2][2]; i32x8 At8[4], B08[2], B18[2];
    const int one_scale = 0x7F7F7F7F;
    const char* cA; const char* cB; int nt;
    bool has_next; const char* nA; const char* nB; int nnt;
    { const Operands op = AD(cur); cA = (const char*)op.A; cB = (const char*)op.Bt; nt = op.K / 64; PG8_BOFF(cvb, op);
      has_next = S.next(1, nxt); const Operands o1 = has_next ? AD(nxt) : op; PG8_BOFF(nvb, o1); nA = (const char*)o1.A; nB = (const char*)o1.Bt; nnt = o1.K / 64;
      if constexpr (GATHER) { PG8_GIDX(cvg, op); PG8_GIDX(nvg, o1); PG8_WAIT_V(0); } else { PG8_AOFF(cvg, op); PG8_AOFF(nvg, o1); } }
    PG8_STAGE(PG8_SB(0, 0), cB, cvb[0]); PG8_STAGE(PG8_SB(0, 1), cB, cvb[1]); PG8_STAGE(PG8_SA(0, 0), cA, cvg[0]); PG8_STAGE(PG8_SA(0, 1), cA, cvg[1]);
    if (wr == 1) PG8_BAR;
    PG8_WAIT_V(2); PG8_BAR;
    PG8_STAGE(PG8_SB(1, 0), cB + kstep, cvb[0]); PG8_STAGE(PG8_SA(1, 0), cA + kstep, cvg[0]); PG8_STAGE(PG8_SB(1, 1), cB + kstep, cvb[1]);
    PG8_WAIT_V(6); PG8_BAR;
    for (;;) {
#pragma unroll 1
        for (int t = 0; t < nt; t += 2) {
            const bool last = (t == nt - 2);
            const char* a1 = cA + (size_t)(t + 1) * kstep;
            const char* a2 = last ? nA : cA + (size_t)(t + 2) * kstep; const char* b2 = last ? nB : cB + (size_t)(t + 2) * kstep;
            const char* a3 = a2 + kstep; const char* b3 = b2 + kstep;
            unsigned v2[2][2], w2[2][2];
#pragma unroll
            for (int h_ = 0; h_ < 2; ++h_)
#pragma unroll
                for (int i_ = 0; i_ < 2; ++i_) { v2[h_][i_] = last ? nvg[h_][i_] : cvg[h_][i_]; w2[h_][i_] = last ? nvb[h_][i_] : cvb[h_][i_]; }
            PG8_LDB(B0, 0, 0); PG8_LDB(B1, 0, 1); PG8_SCHED; PG8_LDA(At, 0, 0); PG8_STAGE(PG8_SA(1, 1), a1, cvg[1]);
            PG8_WAIT_V(8); PG8_WAIT_L(0); PG8_BAR; PG8_MMA(0, 0, At, B0); PG8_MMA(0, 1, At, B1); PG8_BAR; PG8_SCHED;
            PG8_LDA(At, 0, 1); PG8_STAGE(PG8_SB(0, 0), b2, w2[0]); PG8_STAGE(PG8_SB(0, 1), b2, w2[1]); PG8_STAGE(PG8_SA(0, 0), a2, v2[0]);
            PG8_WAIT_V(8); PG8_WAIT_L(0); PG8_BAR; PG8_MMA(1, 0, At, B0); PG8_MMA(1, 1, At, B1); PG8_BAR; PG8_SCHED;
            PG8_LDB(B0, 1, 0); PG8_LDB(B1, 1, 1); PG8_SCHED; PG8_LDA(At, 1, 0); PG8_STAGE(PG8_SA(0, 1), a2, v2[1]);
            PG8_WAIT_V(8); PG8_WAIT_L(0); PG8_BAR; PG8_MMA(0, 0, At, B0); PG8_MMA(0, 1, At, B1); PG8_BAR; PG8_SCHED;
            PG8_LDA(At, 1, 1); PG8_STAGE(PG8_SB(1, 0), b3, w2[0]); PG8_STAGE(PG8_SB(1, 1), b3, w2[1]); PG8_STAGE(PG8_SA(1, 0), a3, v2[0]);
            PG8_WAIT_V(8); PG8_WAIT_L(0); PG8_BAR; PG8_MMA(1, 0, At, B0); PG8_MMA(1, 1, At, B1); PG8_BAR; PG8_SCHED;
        }
        if constexpr (FP8) asm volatile("s_nop 15\n\ts_nop 15" ::: "memory");
        if (wr == 0) PG8_BAR;
        unsigned fvg[2][2], fvb[2][2];
        Unit u2; const bool h2 = S.next(ui + 2, u2); const char* fA = nA; const char* fB = nB; int fnt = nnt;
        if (h2) { const Operands o2 = AD(u2); fA = (const char*)o2.A; fB = (const char*)o2.Bt; fnt = o2.K / 64; PG8_BOFF(fvb, o2); if constexpr (GATHER) PG8_GIDX(fvg, o2); else PG8_AOFF(fvg, o2); }
        else { PG8_COPY(fvb, nvb); PG8_COPY(fvg, nvg); }
        { int fr2 = fr, fq2 = fq; asm volatile("" : "+v"(fr2), "+v"(fq2));
          E(acc, cur, wr, wc, fr2, fq2); }
        if (!has_next) break;
        if constexpr (GATHER) PG8_WAIT_V(0);
        PG8_COPY(cvg, nvg); PG8_COPY(nvg, fvg); PG8_COPY(cvb, nvb); PG8_COPY(nvb, fvb);
        if (E.reset(cur)) {
#pragma unroll
        for (int a = 0; a < 2; ++a)
#pragma unroll
            for (int b = 0; b < 2; ++b)
#pragma unroll
                for (int m = 0; m < 4; ++m)
#pragma unroll
                    for (int n = 0; n < 2; ++n) acc[a][b][m][n] = (f32x4){0.f, 0.f, 0.f, 0.f};
        }
        cur = nxt; cA = nA; cB = nB; nt = nnt; ++ui;
        nxt = u2; has_next = h2; nA = fA; nB = fB; nnt = fnt;
        if (wr == 1) PG8_BAR;
    }
    PG8_WAIT_V(0);
    PG8_BAR;
#undef PG8_SA
#undef PG8_SB
#undef PG8_STAGE
#undef PG8_LDA
#undef PG8_LDB
#undef PG8_MMA
#undef PG8_WAIT_V
#undef PG8_WAIT_L
#undef PG8_BAR
#undef PG8_SCHED
#undef PG8_GIDX
#undef PG8_AOFF
#undef PG8_BOFF
#undef PG8_COPY
#undef PG8_RC
}
template <class F> struct EpiFn { F f; __device__ __forceinline__ void operator()(f32x4 (&acc)[2][2][4][2], const Unit& u, int wr, int wc, int fr, int fq) const { f(acc, u, wr, wc, fr, fq); } __device__ __forceinline__ bool reset(const Unit&) const { return true; } };
template <class F> __device__ __forceinline__ EpiFn<F> mk_epi(F f) { return EpiFn<F>{f}; }
template <class F> struct EpiSeg { F f; int last; __device__ __forceinline__ void operator()(f32x4 (&acc)[2][2][4][2], const Unit& u, int wr, int wc, int fr, int fq) const { f(acc, u, wr, wc, fr, fq); } __device__ __forceinline__ bool reset(const Unit& u) const { return u.seg == last; } };
template <class F> __device__ __forceinline__ EpiSeg<F> mk_epi_seg(F f, int last) { return EpiSeg<F>{f, last}; }
template <int NSEG> struct SegSched { GroupSched base; __device__ __forceinline__ bool next(int j, Unit& u) const { if (!base.next(j / NSEG, u)) return false; u.seg = j % NSEG; return true; } };
#ifndef DUP_PH
#define DUP_PH -1
#endif
#define REP_BEGIN(k) _Pragma("unroll 1") for (int rep_ = 0; rep_ < ((DUP_PH == (k)) ? 2 : 1); ++rep_) { if (rep_) { if constexpr (PH < 0) xcd_barrier(bar); }
#define REP_END }
#define GEMM(S, AD, E, K, lda, ldb) gemm_fast<false, false, false>(F.lds, F.tid, S, AD, mk_epi(E), nullptr)
#define GEMM_P(S, AD, E) gemm_fast<false, true, false>(F.lds, F.tid, S, AD, mk_epi(E), nullptr)
#define GEMM_P8(S, AD, E) gemm_fast<false, true, true>(F.lds, F.tid, S, AD, mk_epi(E), nullptr)
#define GEMM_GATHER8(S, AD, E, rows) gemm_fast<true, true, true>(F.lds, F.tid, S, AD, mk_epi(E), rows)
#define EPI_ARGS f32x4 (&acc)[2][2][4][2], const Unit& u, int wr, int wc, int fr, int fq
#define EPI_FOR(...) _Pragma("unroll") for (int ai = 0; ai < 2; ++ai) _Pragma("unroll") for (int m = 0; m < 4; ++m) { const int r = ai * 128 + wr * 64 + m * 16 + fr; \
    _Pragma("unroll") for (int bj = 0; bj < 2; ++bj) _Pragma("unroll") for (int n = 0; n < 2; ++n) { const int c = bj * 128 + wc * 32 + n * 16 + 4 * fq; const f32x4 v = acc[ai][bj][m][n]; __VA_ARGS__ } }
#define EPI_FOR8(...) _Pragma("unroll") for (int ai = 0; ai < 2; ++ai) _Pragma("unroll") for (int m = 0; m < 4; ++m) { const int r = ai * 128 + wr * 64 + m * 16 + fr; \
    _Pragma("unroll") for (int bj = 0; bj < 2; ++bj) { const int c = bj * 128 + wc * 32 + 8 * fq; const f32x4 v0 = acc[ai][bj][m][0], v1 = acc[ai][bj][m][1]; __VA_ARGS__ } }
__device__ __forceinline__ void st_bf8(bf16* p, f32x4 a, f32x4 b) { u32x4 w; w.x = pk2(a[0], a[1]); w.y = pk2(a[2], a[3]); w.z = pk2(b[0], b[1]); w.w = pk2(b[2], b[3]); *(u32x4*)p = w; }
__device__ __forceinline__ void st_bf4(bf16* p, f32x4 v) { u32x2 w; w.x = pk2(v[0], v[1]); w.y = pk2(v[2], v[3]); *(u32x2*)p = w; }

__device__ __forceinline__ void p_mod(const Params& P, Frame& F) {
    LAS float* sc = (LAS float*)F.lds;
    LAS float* red = (LAS float*)(F.lds + 9 * 1024 * 4);
    float* MOD = WSP(float, WS_MOD);
    bool have = false;
    for (int it = F.bid; it < 2 * 96; it += F.G) {
        if (!have) {
            for (int i = F.tid; i < 9 * 1024; i += NTHREADS) { const int r = i >> 10, k = i & 1023; const float v = r < 8 ? P.c[r * 1024 + k] : P.c_ctx[k]; sc[i] = v * sigmoidf_(v); }
            have = true;
        }
        __syncthreads();
        const int l = it / 96, j0 = (it % 96) * 64, jj = F.tid & 63, kc = F.tid >> 6;
        const float* W = P.ada_w + (size_t)l * 1024 * 6144 + j0 + jj;
        float a[9];
#pragma unroll
        for (int r = 0; r < 9; ++r) a[r] = 0.f;
#pragma unroll 8
        for (int k = kc * 128; k < kc * 128 + 128; ++k) { const float w = W[(size_t)k * 6144];
#pragma unroll
            for (int r = 0; r < 9; ++r) a[r] += sc[r * 1024 + k] * w; }
#pragma unroll
        for (int r = 0; r < 9; ++r) red[(kc * 9 + r) * 64 + jj] = a[r];
        __syncthreads();
        for (int o = F.tid; o < 9 * 64; o += NTHREADS) { const int r = o >> 6, j = o & 63; float s = 0.f;
#pragma unroll
            for (int q = 0; q < 8; ++q) s += red[(q * 9 + r) * 64 + j];
            MOD[((size_t)l * 9 + r) * 6144 + j0 + j] = s + P.ada_b[l * 6144 + j0 + j]; }
    }
    __syncthreads();
}
__device__ __forceinline__ void p_dftgen(Frame& F) {
    LAS float* tab = (LAS float*)F.lds;
    for (int j = F.tid; j < 4096; j += NTHREADS) tab[j] = cospif((float)j * (1.0f / 2048.0f));
    __syncthreads();
    bf16* DC_ = WSP(bf16, WS_DFTC); bf16* M1 = WSP(bf16, WS_M1T); bf16* M2 = WSP(bf16, WS_M2T);
    const int nchunk = 256 * 64 + 256 * 32 + 256 * 64;
    for (int ch = F.bid * NTHREADS + F.tid; ch < nchunk; ch += F.G * NTHREADS) {
        float v[8]; bf16* dst;
        if (ch < 256 * 64) { const int kf = ch >> 6, col0 = (ch & 63) * 8, cs = col0 >> 8, l0 = col0 & 255;
#pragma unroll
            for (int i = 0; i < 8; ++i) { const int j = ((kf * (l0 + i)) & 255) * 16; v[i] = cs ? -tab[(j + 3072) & 4095] : tab[j]; }
            dst = DC_ + (size_t)kf * 512 + col0; }
        else if (ch < 256 * 64 + 256 * 32) { const int c2 = ch - 256 * 64, row = c2 >> 5, col0 = (c2 & 31) * 8, ri = row >> 7, h = (row >> 6) & 1, k1 = row & 63, h2 = col0 >> 7, cs = (col0 >> 6) & 1, l10 = col0 & 63;
#pragma unroll
            for (int i = 0; i < 8; ++i) { const int j = ((k1 * (l10 + i)) & 63) * 64; const float c = tab[j], sn = tab[(j + 3072) & 4095];
                v[i] = (h != h2) ? 0.f : (ri == 0 ? (cs == 0 ? c : -sn) : (cs == 0 ? sn : c)); }
            dst = M1 + (size_t)row * 256 + col0; }
        else { const int c2 = ch - 256 * 64 - 256 * 32, row = c2 >> 6, col0 = (c2 & 63) * 8, q = row >> 6, k2 = row & 63, q2 = col0 >> 7, ri = (col0 >> 6) & 1, l20 = col0 & 63;
#pragma unroll
            for (int i = 0; i < 8; ++i) { const int j = ((k2 * (l20 + i)) & 63) * 64; const float c = tab[j], sn = tab[(j + 3072) & 4095];
                v[i] = (q != q2) ? 0.f : (ri == 0 ? c : -sn); }
            dst = M2 + (size_t)row * 512 + col0; }
        u32x4 o; o.x = pk2(v[0], v[1]); o.y = pk2(v[2], v[3]); o.z = pk2(v[4], v[5]); o.w = pk2(v[6], v[7]);
        *(u32x4*)dst = o;
    }
    __syncthreads();
}
__device__ __forceinline__ void transpose_item(const float* W, int ldw, int k0, int n0, bf16* WT, int ldt, int drow0, LAS float* scr, int lane) {
    f32x4 ld[8];
#pragma unroll
    for (int i = 0; i < 8; ++i) ld[i] = *(const f32x4*)(W + (size_t)(k0 + 8 * i + (lane >> 3)) * ldw + n0 + 4 * (lane & 7));
#pragma unroll
    for (int i = 0; i < 8; ++i) { LAS float* d = scr + (8 * i + (lane >> 3)) * 33 + 4 * (lane & 7); d[0] = ld[i][0]; d[1] = ld[i][1]; d[2] = ld[i][2]; d[3] = ld[i][3]; }
    LDS_WAIT(); asm volatile("" ::: "memory");
    const int c = lane & 7;
#pragma unroll
    for (int j = 0; j < 4; ++j) { const int n = (lane >> 3) + 8 * j; const LAS float* s = scr + (8 * c) * 33 + n;
        u32x4 o; o.x = pk2(s[0 * 33], s[1 * 33]); o.y = pk2(s[2 * 33], s[3 * 33]); o.z = pk2(s[4 * 33], s[5 * 33]); o.w = pk2(s[6 * 33], s[7 * 33]);
        *(u32x4*)(WT + (size_t)(drow0 + n) * ldt + k0 + 8 * c) = o; }
    LDS_WAIT(); asm volatile("" ::: "memory");
}
__device__ __forceinline__ void transpose_item8(const float* W, int ldw, int k0, int n0, unsigned char* WT, int ldt, int drow0, LAS float* scr, int lane) {
    f32x4 ld[8];
#pragma unroll
    for (int i = 0; i < 8; ++i) ld[i] = *(const f32x4*)(W + (size_t)(k0 + 8 * i + (lane >> 3)) * ldw + n0 + 4 * (lane & 7));
#pragma unroll
    for (int i = 0; i < 8; ++i) { LAS float* d = scr + (8 * i + (lane >> 3)) * 33 + 4 * (lane & 7); d[0] = ld[i][0]; d[1] = ld[i][1]; d[2] = ld[i][2]; d[3] = ld[i][3]; }
    LDS_WAIT(); asm volatile("" ::: "memory");
    const int c = lane & 7;
#pragma unroll
    for (int j = 0; j < 4; ++j) { const int n = (lane >> 3) + 8 * j; const LAS float* s = scr + (8 * c) * 33 + n;
        u32x2 o; o.x = pk4_fp8(s[0 * 33] * W8S, s[1 * 33] * W8S, s[2 * 33] * W8S, s[3 * 33] * W8S); o.y = pk4_fp8(s[4 * 33] * W8S, s[5 * 33] * W8S, s[6 * 33] * W8S, s[7 * 33] * W8S);
        *(u32x2*)(WT + (size_t)(drow0 + n) * ldt + k0 + 8 * c) = o; }
    LDS_WAIT(); asm volatile("" ::: "memory");
}
__device__ __forceinline__ void transpose_item8w(const float* W, int ldw, int k0, int n0, unsigned char* WT, int ldt, int drow0, LAS float* scr, int lane) {
    f32x4 ld[16];
#pragma unroll
    for (int i = 0; i < 16; ++i) ld[i] = *(const f32x4*)(W + (size_t)(k0 + 4 * i + (lane >> 4)) * ldw + n0 + 4 * (lane & 15));
#pragma unroll
    for (int i = 0; i < 16; ++i) { LAS float* d = scr + (4 * i + (lane >> 4)) * 65 + 4 * (lane & 15); d[0] = ld[i][0]; d[1] = ld[i][1]; d[2] = ld[i][2]; d[3] = ld[i][3]; }
    LDS_WAIT(); asm volatile("" ::: "memory");
    const int c = lane & 3;
#pragma unroll
    for (int p = 0; p < 4; ++p) { const int n = (lane >> 2) + 16 * p; const LAS float* s = scr + (16 * c) * 65 + n; u32x4 o;
#pragma unroll
        for (int q = 0; q < 4; ++q) o[q] = pk4_fp8(s[(4 * q) * 65] * W8S, s[(4 * q + 1) * 65] * W8S, s[(4 * q + 2) * 65] * W8S, s[(4 * q + 3) * 65] * W8S);
        *(u32x4*)(WT + (size_t)(drow0 + n) * ldt + k0 + 16 * c) = o; }
    LDS_WAIT(); asm volatile("" ::: "memory");
}
__device__ __forceinline__ void wconv_experts(const Params& P, Frame& F, int l, int rank, int nblk) {
    LAS float* scr = (LAS float*)(F.lds + (F.wave < 7 ? F.wave * 17408 : 131584));
    const int gw = rank * NWAVES + F.wave, NGW = nblk * NWAVES;
    constexpr int I_E = 16 * 44;
    unsigned char* WGU = WSP(unsigned char, WS_WGU); unsigned char* WD = WSP(unsigned char, WS_WD);
    for (int it = gw; it < 3 * 16 * I_E; it += NGW) {
        const int which = it / (16 * I_E), r0 = it % (16 * I_E), e = r0 / I_E, r = r0 % I_E;
        if (which < 2) { const int kb = r / 44, nb = r % 44, n0 = nb * 64;
            const float* src = (which == 0 ? P.w_eg : P.w_eu) + ((size_t)l * 16 + e) * 1024 * FF;
            transpose_item8w(src, FF, kb * 64, n0, WGU + (size_t)e * 5632 * 1024, 1024, (n0 >> 7) * 256 + (which ? 128 : 0) + (n0 & 127), scr, F.lane); }
        else { const int kb = r / 16, nb = r % 16;
            transpose_item8w(P.w_ed + ((size_t)l * 16 + e) * FF * 1024, 1024, kb * 64, nb * 64, WD + (size_t)e * 1024 * FF, FF, nb * 64, scr, F.lane); }
    }
    __syncthreads();
}
__device__ __forceinline__ void p_wconv(const Params& P, Frame& F, int l) {
    LAS float* scr = (LAS float*)(F.lds + F.wave * 16384);
    const int gw = F.bid * NWAVES + F.wave, NGW = F.G * NWAVES;
    const float* w_in = P.w_in + (size_t)l * 1024 * INW;
    bf16* WA = WSP(bf16, WS_WA); bf16* WFV = WSP(bf16, WS_WFV);
    constexpr int I_K = 16 * 32, I_Q = 16 * 32, I_P = 16 * 16, I_G = 16 * 96, I_V = 16 * 32, I_AO = 16 * 32, I_FO = 8 * 32, I_OUT = 16 * 32;
    constexpr int NSM = I_K + I_Q + I_P + I_G + I_V + I_AO + I_FO + I_OUT;
    for (int it = gw; it < NSM; it += NGW) {
        int r = it;
        if (r < I_K) { transpose_item8(w_in, INW, (r / 32) * 64, 0 + (r % 32) * 32, WSP(unsigned char, WS_WA8), 1024, 0 + (r % 32) * 32, scr, F.lane); continue; } r -= I_K;
        if (r < I_Q) { transpose_item8(w_in, INW, (r / 32) * 64, 2048 + (r % 32) * 32, WSP(unsigned char, WS_WA8), 1024, 1024 + (r % 32) * 32, scr, F.lane); continue; } r -= I_Q;
        if (r < I_P) { transpose_item(w_in, INW, (r / 16) * 64, 3584 + (r % 16) * 32, WA, 1024, 2048 + (r % 16) * 32, scr, F.lane); continue; } r -= I_P;
        if (r < I_G) { transpose_item8(w_in, INW, (r / 96) * 64, 4096 + (r % 96) * 32, WSP(unsigned char, WS_WA8), 1024, 3072 + (r % 96) * 32, scr, F.lane); continue; } r -= I_G;
        if (r < I_V) { transpose_item8(w_in, INW, (r / 32) * 64, 1024 + (r % 32) * 32, WSP(unsigned char, WS_WA8), 1024, 2048 + (r % 32) * 32, scr, F.lane); continue; } r -= I_V;
        if (r < I_AO) { transpose_item8(P.w_att_o + (size_t)l * 1024 * 1024, 1024, (r / 32) * 64, (r % 32) * 32, WSP(unsigned char, WS_WAO), 1024, (r % 32) * 32, scr, F.lane); continue; } r -= I_AO;
        if (r < I_FO) { transpose_item(P.w_fourier + (size_t)l * 512 * 1024, 1024, (r / 32) * 64, (r % 32) * 32, WSP(bf16, WS_WFO), 512, (r % 32) * 32, scr, F.lane); continue; } r -= I_FO;
        transpose_item(P.w_out + (size_t)l * 1024 * 1024, 1024, (r / 32) * 64, (r % 32) * 32, WSP(bf16, WS_WOUT), 1024, (r % 32) * 32, scr, F.lane);
    }
    { bf16* WPO = WSP(bf16, WS_WPO); const float* wp = P.w_pool + (size_t)l * 4 * 128 * 256;
      for (int i = F.bid * NTHREADS + F.tid; i < 1024 * 256; i += F.G * NTHREADS) { const int n = i >> 8, kk = i & 255, g = n >> 8, f = n & 255;
          WPO[i] = (bf16)(((kk >> 7) == (g & 1)) ? f2bf(wp[((size_t)g * 128 + (kk & 127)) * 256 + f]) : 0u); } }
    { LAS float* t128 = (LAS float*)F.lds;
      __syncthreads();
      for (int j = F.tid; j < 128; j += NTHREADS) t128[j] = cospif((float)j * (1.0f / 64.0f));
      __syncthreads();
      for (int i = F.bid * NTHREADS + F.tid; i < 1024 * 1024; i += F.G * NTHREADS) { const int fc = i >> 10, k = i & 1023, cs = fc & 1, gm = fc >> 1, g = gm >> 7, m = gm & 127;
          const float* src = w_in + (size_t)k * INW + 3072 + g * 128; float s = 0.f; const int ph = cs ? 96 : 0;
          for (int c = 0; c < 128; ++c) s += src[c] * t128[(m * c + ph) & 127];
          WFV[i] = (bf16)f2bf(s); }
      __syncthreads(); }
}

struct RowMod { const float* g; const float* sh; const float* sc; };
__device__ __forceinline__ void row_load(const float* row, int lane, f32x4 (&v)[4]) {
#pragma unroll
    for (int j = 0; j < 4; ++j) v[j] = *(const f32x4*)(row + 4 * lane + 256 * j);
}
__device__ __forceinline__ float row_rstd(const f32x4 (&v)[4]) {
    float s = 0.f;
#pragma unroll
    for (int j = 0; j < 4; ++j) s += (v[j][0] * v[j][0] + v[j][1] * v[j][1]) + (v[j][2] * v[j][2] + v[j][3] * v[j][3]);
    return rsqrtf(wave_sum(s) * (1.0f / 1024.0f) + RMS_EPS);
}
__device__ __forceinline__ void row_modulate(const f32x4 (&v)[4], float rstd, const RowMod& M, int lane, f32x4 (&y)[4]) {
#pragma unroll
    for (int j = 0; j < 4; ++j) { const int k = 4 * lane + 256 * j; const f32x4 g = *(const f32x4*)(M.g + k), sh = *(const f32x4*)(M.sh + k), sc = *(const f32x4*)(M.sc + k);
        y[j] = v[j] * rstd * g * (sc + 1.0f) + sh; }
}
__device__ __forceinline__ void row_store_bf(bf16* row, int lane, const f32x4 (&y)[4]) {
#pragma unroll
    for (int j = 0; j < 4; ++j) st_bf4(row + 4 * lane + 256 * j, y[j]);
}
__device__ __forceinline__ void row_store_f8(unsigned char* row, int lane, const f32x4 (&y)[4]) {
#pragma unroll
    for (int j = 0; j < 4; ++j) *(unsigned*)(row + 4 * lane + 256 * j) = pk4_fp8(y[j][0] * A8S, y[j][1] * A8S, y[j][2] * A8S, y[j][3] * A8S);
}
__device__ __forceinline__ const float* mod_ptr(Frame& F, int l, int row, int which) { const int mr = row < RL ? (row >> 12) : 8; return WSP(float, WS_MOD) + ((size_t)l * 9 + mr) * 6144 + which * 1024; }

__device__ __forceinline__ void p_rowpass_a0(const Params& P, Frame& F) {
    const int gw = F.bid * NWAVES + F.wave, NGW = F.G * NWAVES; bf16* H = WSP(bf16, WS_H);
    f32x4 vn[4]; int row = gw;
    if (row < RT) row_load(row < RL ? P.x + (size_t)row * DM : P.ctx + (size_t)(row - RL) * DM, F.lane, vn);
    for (; row < RT; row += NGW) {
        f32x4 v[4], y[4];
#pragma unroll
        for (int j = 0; j < 4; ++j) v[j] = vn[j];
        { const int nr = row + NGW; if (nr < RT) row_load(nr < RL ? P.x + (size_t)nr * DM : P.ctx + (size_t)(nr - RL) * DM, F.lane, vn); }
        const float rs = row_rstd(v);
        RowMod M{P.norm1_g, mod_ptr(F, 0, row, 0), mod_ptr(F, 0, row, 1)};
        row_modulate(v, rs, M, F.lane, y); row_store_bf(H + (size_t)row * DM, F.lane, y); row_store_f8(WSP(unsigned char, WS_H8) + (size_t)row * DM, F.lane, y);
    }
}
__device__ __forceinline__ void p_rowpass_f(const Params& P, Frame& F, int l, int nrows) {
    const int gw = F.bid * NWAVES + F.wave, NGW = F.G * NWAVES; unsigned char* H8 = WSP(unsigned char, WS_H8); float* AFF = WSP(float, WS_AFF);
    const float* wr = P.w_router + (size_t)l * 1024 * 16;
    LAS float* wl = (LAS float*)F.lds;
    __syncthreads();
    for (int i = F.tid; i < 16384; i += NTHREADS) wl[(i & 15) * 1024 + (i >> 4)] = wr[i];
    __syncthreads();
    f32x4 vn[4]; int row = gw;
    if (row < nrows) row_load(row < RL ? P.out + (size_t)row * DM : WSP(float, WS_XC) + (size_t)(row - RL) * DM, F.lane, vn);
    for (; row < nrows; row += NGW) {
        f32x4 v[4], y[4];
#pragma unroll
        for (int j = 0; j < 4; ++j) v[j] = vn[j];
        { const int nr = row + NGW; if (nr < nrows) row_load(nr < RL ? P.out + (size_t)nr * DM : WSP(float, WS_XC) + (size_t)(nr - RL) * DM, F.lane, vn); }
        const float rs = row_rstd(v);
        RowMod M{P.norm2_g + l * 1024, mod_ptr(F, l, row, 3), mod_ptr(F, l, row, 4)};
        row_modulate(v, rs, M, F.lane, y);
        row_store_f8(H8 + (size_t)row * DM, F.lane, y);
        float lg[16];
        int wo = 4 * F.lane; asm volatile("" : "+v"(wo));
#pragma unroll
        for (int e = 0; e < 16; ++e) { float a = 0.f;
#pragma unroll
            for (int j = 0; j < 4; ++j) { const f32x4 w = *(const LAS f32x4*)(wl + e * 1024 + wo + 256 * j); a += (y[j][0] * w[0] + y[j][1] * w[1]) + (y[j][2] * w[2] + y[j][3] * w[3]); }
            lg[e] = a; }
        float mx = -1e30f;
#pragma unroll
        for (int e = 0; e < 16; ++e) { lg[e] = wave_sum(lg[e]); mx = fmaxf(mx, lg[e]); }
        float den = 0.f;
#pragma unroll
        for (int e = 0; e < 16; ++e) { lg[e] = __expf(lg[e] - mx); den += lg[e]; }
        const float inv = 1.0f / den;
        if (F.lane < 16) { float mine = 0.f;
#pragma unroll
            for (int e = 0; e < 16; ++e) mine = (F.lane == e) ? lg[e] : mine;
            AFF[(size_t)row * 16 + F.lane] = mine * inv; }
    }
    __syncthreads();
}
__device__ __forceinline__ void p_rowpass_k(const Params& P, Frame& F, int l, int nrows) {
    const int gw = F.bid * NWAVES + F.wave, NGW = F.G * NWAVES; bf16* H = WSP(bf16, WS_H);
    const int* SEL = WSP(int, WS_SEL); const bf16* Y = WSP(bf16, WS_Y);
    f32x4 vn[4]; int seln = -1; int row = gw;
    if (row < nrows) { row_load(row < RL ? P.out + (size_t)row * DM : WSP(float, WS_XC) + (size_t)(row - RL) * DM, F.lane, vn); seln = F.lane < 16 ? SEL[(size_t)row * 16 + F.lane] : -1; }
    for (; row < nrows; row += NGW) {
        float* xr = row < RL ? P.out + (size_t)row * DM : WSP(float, WS_XC) + (size_t)(row - RL) * DM;
        f32x4 v[4], a[4]; const int sel = seln;
#pragma unroll
        for (int j = 0; j < 4; ++j) { v[j] = vn[j]; a[j] = (f32x4){0.f, 0.f, 0.f, 0.f}; }
        { const int nr = row + NGW; if (nr < nrows) { row_load(nr < RL ? P.out + (size_t)nr * DM : WSP(float, WS_XC) + (size_t)(nr - RL) * DM, F.lane, vn); seln = F.lane < 16 ? SEL[(size_t)nr * 16 + F.lane] : -1; } }
        unsigned em = (unsigned)__ballot(sel >= 0) & 0xffffu;
        while (em) { const int e = __builtin_ctz(em); em &= em - 1; const int s = __builtin_amdgcn_readlane(sel, e); const bf16* yr = Y + (size_t)s * DM;
#pragma unroll
            for (int j = 0; j < 4; ++j) { const u32x2 w = *(const u32x2*)(yr + 4 * F.lane + 256 * j); a[j][0] += bflo(w.x); a[j][1] += bfhi(w.x); a[j][2] += bflo(w.y); a[j][3] += bfhi(w.y); } }
        const float* g2 = mod_ptr(F, l, row, 5);
#pragma unroll
        for (int j = 0; j < 4; ++j) { const f32x4 g = *(const f32x4*)(g2 + 4 * F.lane + 256 * j); v[j] = v[j] + g * a[j]; }
        const float rs = row_rstd(v);
        if (l == 0) {
#pragma unroll
            for (int j = 0; j < 4; ++j) *(f32x4*)(xr + 4 * F.lane + 256 * j) = v[j];
            f32x4 y[4]; RowMod M{P.norm1_g + 1024, mod_ptr(F, 1, row, 0), mod_ptr(F, 1, row, 1)};
            row_modulate(v, rs, M, F.lane, y); row_store_bf(H + (size_t)row * DM, F.lane, y); row_store_f8(WSP(unsigned char, WS_H8) + (size_t)row * DM, F.lane, y);
        } else {
#pragma unroll
            for (int j = 0; j < 4; ++j) { const f32x4 g = *(const f32x4*)(P.final_g + 4 * F.lane + 256 * j); *(f32x4*)(xr + 4 * F.lane + 256 * j) = v[j] * rs * g; }
        }
    }
}

constexpr int ACK_STRIDE = 72, ACV_STRIDE = 264;
constexpr int ALDS_CK = 0, ALDS_CV = 256 * ACK_STRIDE * 2, ALDS_RP = ALDS_CV + 64 * ACV_STRIDE * 2;
struct AttnState { float m, sum; f32x4 o[4]; };
__device__ __forceinline__ float xrow16_max(float x) {
    auto s = __builtin_amdgcn_permlane16_swap(__float_as_uint(x), __float_as_uint(x), false, false);
    x = fmaxf(__uint_as_float(s[0]), __uint_as_float(s[1]));
    auto t = __builtin_amdgcn_permlane32_swap(__float_as_uint(x), __float_as_uint(x), false, false);
    return fmaxf(__uint_as_float(t[0]), __uint_as_float(t[1]));
}
__device__ __forceinline__ float xrow16_sum(float x) {
    auto s = __builtin_amdgcn_permlane16_swap(__float_as_uint(x), __float_as_uint(x), false, false);
    x = __uint_as_float(s[0]) + __uint_as_float(s[1]);
    auto t = __builtin_amdgcn_permlane32_swap(__float_as_uint(x), __float_as_uint(x), false, false);
    return __uint_as_float(t[0]) + __uint_as_float(t[1]);
}
#define MFMA16(a, b, c) __builtin_amdgcn_mfma_f32_16x16x32_bf16((a), (b), (c), 0, 0, 0)
template <int NT>
__device__ __forceinline__ void attn_tail(AttnState& S, f32x4 (&sc)[NT], const u32x4 (&vw)[NT / 2][4]) {
    float cm = -__builtin_inff();
#pragma unroll
    for (int t = 0; t < NT; ++t)
#pragma unroll
        for (int j = 0; j < 4; ++j) cm = fmaxf(cm, sc[t][j]);
    cm = xrow16_max(cm);
    const bool need = (fabsf(cm) > 12.0f) && (cm > -1e30f);
    if (__builtin_amdgcn_ballot_w64(need) != 0ull) {
        const float d = need ? cm : 0.f, scl = __builtin_amdgcn_exp2f(-d);
        S.m += d; S.sum *= scl;
#pragma unroll
        for (int dt = 0; dt < 4; ++dt) S.o[dt] = S.o[dt] * scl;
#pragma unroll
        for (int t = 0; t < NT; ++t)
#pragma unroll
            for (int j = 0; j < 4; ++j) sc[t][j] -= d;
    }
    float ps = 0.f;
#pragma unroll
    for (int t = 0; t < NT; ++t)
#pragma unroll
        for (int j = 0; j < 4; ++j) { const float p = __builtin_amdgcn_exp2f(sc[t][j]); sc[t][j] = p; ps += p; }
    S.sum += ps;
#pragma unroll
    for (int ks = 0; ks < NT / 2; ++ks) { u32x4 pw; pw.x = pk2(sc[2 * ks][0], sc[2 * ks][1]); pw.y = pk2(sc[2 * ks][2], sc[2 * ks][3]); pw.z = pk2(sc[2 * ks + 1][0], sc[2 * ks + 1][1]); pw.w = pk2(sc[2 * ks + 1][2], sc[2 * ks + 1][3]);
        const bf16x8 pf = __builtin_bit_cast(bf16x8, pw);
#pragma unroll
        for (int dt = 0; dt < 4; ++dt) S.o[dt] = MFMA16(__builtin_bit_cast(bf16x8, vw[ks][dt]), pf, S.o[dt]); }
}
__device__ __forceinline__ void attn_unit2(const bf16* __restrict__ KQ, const bf16* __restrict__ VT, unsigned char* __restrict__ ATT, LAS unsigned char* lds,
                                           const int b, const int h, const int rowqA, const int rowqB, const bool win, const int r, const int qt, const int lane) {
    const int l15 = lane & 15, g = lane >> 4;
    const f32x4 z = {0.f, 0.f, 0.f, 0.f};
    bf16x8 qA[2], qB[2];
    { const bf16* qp = KQ + (size_t)(rowqA + l15) * 2048 + 1024 + h * 64 + 8 * g; qA[0] = *(const bf16x8*)qp; qA[1] = *(const bf16x8*)(qp + 32); }
    { const bf16* qp = KQ + (size_t)(rowqB + l15) * 2048 + 1024 + h * 64 + 8 * g; qB[0] = *(const bf16x8*)qp; qB[1] = *(const bf16x8*)(qp + 32); }
    AttnState SA, SB; SA.m = 0.f; SA.sum = 0.f; SB.m = 0.f; SB.sum = 0.f;
#pragma unroll
    for (int dt = 0; dt < 4; ++dt) { SA.o[dt] = z; SB.o[dt] = z; }
    if (win) {
        const int rsA = min(max(r - 4, 0), 56), dB = min(max(r - 3, 0), 56) - rsA, kc0 = min(max(16 * qt - 8, 0), 32);
        const int q = 16 * qt + l15, csq = min(max(q - 8, 0), 48);
        const int krow0 = 8 * (l15 >> 2) + (l15 & 3);
        const bf16* kb = KQ + (size_t)(b * SEQ + kc0 + krow0) * 2048 + h * 64 + 8 * g;
        const bf16* vb = VT + (size_t)(b * 1024 + h * 64 + l15) * 4096 + kc0 + 8 * g;
        const LAS float* rp = (const LAS float*)(lds + ALDS_RP);
        const int jb = kc0 + 8 * g;
        const int okb = jb - csq;
        const LAS float* rpl = rp + 16 + (jb - q + 15);
        float madd[2][4];
#pragma unroll
        for (int t = 0; t < 2; ++t)
#pragma unroll
            for (int j = 0; j < 4; ++j) madd[t][j] = ((unsigned)(okb + 4 * t + j) < 16u) ? 0.f : -__builtin_inff();
        bf16x8 K0[2][2], K1[2][2]; u32x4 V0[1][4], V1[1][4];
#define ATT_LOADW(KB, VB, i) do { const int gr_ = min(rsA + (i), 63); const bf16* kp_ = kb + (size_t)(gr_ * 64) * 2048; const bf16* vp_ = vb + gr_ * 64; \
        _Pragma("unroll") for (int t = 0; t < 2; ++t) { KB[t][0] = *(const bf16x8*)(kp_ + (size_t)(4 * t) * 2048); KB[t][1] = *(const bf16x8*)(kp_ + (size_t)(4 * t) * 2048 + 32); } \
        _Pragma("unroll") for (int dt = 0; dt < 4; ++dt) VB[0][dt] = *(const u32x4*)(vp_ + (size_t)(16 * dt) * 4096); } while (0)
#define ATT_ONE(ST, QF, KB, VB, roff, rowok) do { f32x4 sc[2]; \
        const LAS float* bp_ = rpl + ((rowok) ? (roff) : 15) * 64; \
        _Pragma("unroll") for (int t = 0; t < 2; ++t) _Pragma("unroll") for (int j = 0; j < 4; ++j) sc[t][j] = (bp_[4 * t + j] + madd[t][j]) - ST.m;     \
        _Pragma("unroll") for (int t = 0; t < 2; ++t) { sc[t] = MFMA16(KB[t][0], QF[0], sc[t]); sc[t] = MFMA16(KB[t][1], QF[1], sc[t]); } \
        attn_tail<2>(ST, sc, VB); } while (0)
#define ATT_COMPUTE(KB, VB, i) do { const int roffA_ = min(rsA + (i) - r + 7, 14); \
        ATT_ONE(SA, qA, KB, VB, roffA_, (i) <= 7); \
        ATT_ONE(SB, qB, KB, VB, max(roffA_ - 1, 0), (i) >= dB && (i) <= 7 + dB); } while (0)
        ATT_LOADW(K0, V0, 0);
#pragma unroll 1
        for (int i = 0; i < 8; i += 2) { ATT_LOADW(K1, V1, i + 1); ATT_COMPUTE(K0, V0, i); ATT_LOADW(K0, V0, i + 2); ATT_COMPUTE(K1, V1, i + 1); }
        ATT_COMPUTE(K0, V0, 8);
#undef ATT_LOADW
#undef ATT_ONE
#undef ATT_COMPUTE
    }
    { const LAS bf16* ck = (const LAS bf16*)(lds + ALDS_CK) + l15 * ACK_STRIDE + 8 * g;
      const LAS bf16* cv = (const LAS bf16*)(lds + ALDS_CV) + l15 * ACV_STRIDE + 8 * g;
#pragma unroll 1
      for (int c = 0; c < 4; ++c) {
          bf16x8 kf[4][2]; u32x4 vw[2][4];
#pragma unroll
          for (int t = 0; t < 4; ++t) { const LAS bf16* kp = ck + (64 * c + 16 * t) * ACK_STRIDE; kf[t][0] = *(const LAS bf16x8*)kp; kf[t][1] = *(const LAS bf16x8*)(kp + 32); }
#pragma unroll
          for (int ks = 0; ks < 2; ++ks)
#pragma unroll
              for (int dt = 0; dt < 4; ++dt) vw[ks][dt] = *(const LAS u32x4*)(cv + (16 * dt) * ACV_STRIDE + 64 * c + 32 * ks);
          { f32x4 sc[4]; const float nm = -SA.m; const f32x4 c0 = {nm, nm, nm, nm};
#pragma unroll
            for (int t = 0; t < 4; ++t) { sc[t] = MFMA16(kf[t][0], qA[0], c0); sc[t] = MFMA16(kf[t][1], qA[1], sc[t]); }
            attn_tail<4>(SA, sc, vw); }
          { f32x4 sc[4]; const float nm = -SB.m; const f32x4 c0 = {nm, nm, nm, nm};
#pragma unroll
            for (int t = 0; t < 4; ++t) { sc[t] = MFMA16(kf[t][0], qB[0], c0); sc[t] = MFMA16(kf[t][1], qB[1], sc[t]); }
            attn_tail<4>(SB, sc, vw); }
      } }
    { const float inv = 1.0f / xrow16_sum(SA.sum);
#pragma unroll
      for (int dt = 0; dt < 4; ++dt) { const f32x4 o = SA.o[dt] * (inv * ATS); *(unsigned*)(ATT + (size_t)(rowqA + l15) * 1024 + h * 64 + 16 * dt + 4 * g) = pk4_fp8(o[0], o[1], o[2], o[3]); } }
    { const float inv = 1.0f / xrow16_sum(SB.sum);
#pragma unroll
      for (int dt = 0; dt < 4; ++dt) { const f32x4 o = SB.o[dt] * (inv * ATS); *(unsigned*)(ATT + (size_t)(rowqB + l15) * 1024 + h * 64 + 16 * dt + 4 * g) = pk4_fp8(o[0], o[1], o[2], o[3]); } }
}
__device__ __forceinline__ void p_attn_mfma(const Params& P, Frame& F, int l, bool with_ctx_queries, int nblk, int rank) {
    const bf16* KQ = WSP(bf16, WS_KQ); const bf16* VT = WSP(bf16, WS_VT); unsigned char* ATT = WSP(unsigned char, WS_ATT);
    const float* rpb = P.rpb + (size_t)l * 16 * 465;
    const int it0 = (int)(((long)rank * 1024) / nblk), it1 = (int)(((long)(rank + 1) * 1024) / nblk);
    int pcur = -1;
    for (int hp = it0; hp < it1; ++hp) {
        const int p = hp >> 3, eighth = hp & 7, b = p >> 4, h = p & 15;
        if (p != pcur) { pcur = p;
        __syncthreads();
        { LAS bf16* ck = (LAS bf16*)(F.lds + ALDS_CK); LAS bf16* cv = (LAS bf16*)(F.lds + ALDS_CV); LAS float* rp = (LAS float*)(F.lds + ALDS_RP);
          { const int key = F.tid >> 1, hf = F.tid & 1; const int k32 = key & 31, pos = (key & ~31) + ((k32 >> 2) & 1) * 16 + 4 * (k32 >> 3) + (k32 & 3);
            const u32x4* src = (const u32x4*)(KQ + (size_t)(RL + b * CTXL + key) * 2048 + h * 64 + hf * 32); LAS u32x4* dst = (LAS u32x4*)(ck + pos * ACK_STRIDE + hf * 32);
#pragma unroll
            for (int i = 0; i < 4; ++i) dst[i] = src[i]; }
          { const int d = F.tid >> 3, sg = F.tid & 7; const u32x4* src = (const u32x4*)(VT + YT_CTX_OFF + (size_t)(b * 1024 + h * 64 + d) * 256 + sg * 32); LAS u32x4* dst = (LAS u32x4*)(cv + d * ACV_STRIDE + sg * 32);
#pragma unroll
            for (int i = 0; i < 4; ++i) dst[i] = src[i]; }
          for (int i = F.tid; i < 16 * 64; i += NTHREADS) { const int rr = i >> 6, cc = (i & 63) - 16; rp[i] = rr == 15 ? -__builtin_inff() : ((cc >= 0 && cc < 31) ? rpb[h * 465 + rr * 31 + cc] * LOG2E : 0.f); } }
        __syncthreads(); }
        const int qt = F.wave & 3, rpi = F.wave >> 2;
#pragma unroll 1
        for (int st = 0; st < 2; ++st) { const int r = eighth * 8 + st * 4 + rpi * 2; const int rowqA = b * SEQ + r * 64 + 16 * qt;
            attn_unit2(KQ, VT, ATT, F.lds, b, h, rowqA, rowqA + 64, true, r, qt, F.lane); }
        if (with_ctx_queries && eighth == 0) { const int rowqA = RL + b * CTXL + 32 * F.wave; attn_unit2(KQ, VT, ATT, F.lds, b, h, rowqA, rowqA + 16, false, 0, 0, F.lane); }
    }
    __syncthreads();
}

__device__ __forceinline__ void ld8(const bf16* p, float (&x)[8]) { const u32x4 w = *(const u32x4*)p;
#pragma unroll
    for (int q = 0; q < 4; ++q) { x[2 * q] = bflo(w[q]); x[2 * q + 1] = bfhi(w[q]); } }
__device__ __forceinline__ void p_pool(Frame& F, int nrows) {
    const bf16* PB = WSP(bf16, WS_PB); bf16* POOL = WSP(bf16, WS_POOL);
    for (int i = F.bid * NTHREADS + F.tid; i < (nrows >> 4) * 64; i += F.G * NTHREADS) {
        const int row0 = (i >> 6) << 4, ch = i & 63, g = ch >> 4, hw = 1 << g;
        int base, t0, Lb; if (row0 < RL) { base = row0 & ~4095; t0 = row0 & 4095; Lb = SEQ; } else { const int rr = row0 - RL; base = RL + (rr & ~255); t0 = rr & 255; Lb = CTXL; }
        const bf16* src = PB + (size_t)base * 512 + ch * 8;
        float S[8];
#pragma unroll
        for (int q = 0; q < 8; ++q) S[q] = 0.f;
#pragma unroll 4
        for (int d = -8; d < 8; ++d) { const int tt = t0 + d; if (d >= -hw && d < hw && tt >= 0 && tt < Lb) { float x[8]; ld8(src + (size_t)tt * 512, x);
#pragma unroll
                for (int q = 0; q < 8; ++q) S[q] += x[q]; } }
#pragma unroll 2
        for (int j = 0; j < 16; ++j) { const int t = t0 + j; const int lo = max(t - hw, 0), hi = min(t + hw, Lb); const float inv = 1.0f / (float)(hi - lo);
            float me[8]; ld8(src + (size_t)t * 512, me);
            u32x4 o;
#pragma unroll
            for (int q = 0; q < 4; ++q) o[q] = pk2(S[2 * q] * inv - me[2 * q], S[2 * q + 1] * inv - me[2 * q + 1]);
            *(u32x4*)(POOL + (size_t)(base + t) * 512 + ch * 8) = o;
            if (t + hw < Lb) { float x[8]; ld8(src + (size_t)(t + hw) * 512, x);
#pragma unroll
                for (int q = 0; q < 8; ++q) S[q] += x[q]; }
            if (t - hw >= 0) { float x[8]; ld8(src + (size_t)(t - hw) * 512, x);
#pragma unroll
                for (int q = 0; q < 8; ++q) S[q] -= x[q]; } }
    }
}

__device__ __forceinline__ int block_sum_i(int v, LAS int* sm, int tid) {
    v = wave_sum_i(v);
    __syncthreads();
    if ((tid & 63) == 0) sm[tid >> 6] = v;
    __syncthreads();
    int s = 0;
#pragma unroll
    for (int i = 0; i < 8; ++i) s += sm[i];
    return s;
}
__device__ __forceinline__ int block_excl_scan(int v, LAS int* sm, int tid, int& total) {
    const int lane = tid & 63, w = tid >> 6; int inc = v;
#pragma unroll
    for (int o = 1; o < 64; o <<= 1) { const int t = __builtin_amdgcn_ds_bpermute(((lane - o) & 63) << 2, inc); if (lane >= o) inc += t; }
    __syncthreads();
    if (lane == 63) sm[w] = inc;
    __syncthreads();
    int base = 0; total = 0;
#pragma unroll
    for (int i = 0; i < 8; ++i) { const int s = sm[i]; if (i < w) base += s; total += s; }
    return base + inc - v;
}
template <int NPT>
__device__ __forceinline__ void topk_pair(Frame& F, int row0, int n, int cap, int e, int slot0) {
    LAS int* sm = (LAS int*)F.lds;
    const float* AFF = WSP(float, WS_AFF); int* SROW = WSP(int, WS_SROW); float* SG = WSP(float, WS_SGATE); int* SEL = WSP(int, WS_SEL);
    unsigned key[NPT];
#pragma unroll
    for (int j = 0; j < NPT; ++j) { const int i = F.tid * NPT + j; key[j] = (i < n) ? __float_as_uint(AFF[(size_t)(row0 + i) * 16 + e]) : 0u; }
    unsigned T = 0u;
    for (int bit = 30; bit >= 0; --bit) { const unsigned cand = T | (1u << bit); int cnt = 0;
#pragma unroll
        for (int j = 0; j < NPT; ++j) cnt += (key[j] >= cand) ? 1 : 0;
        cnt = block_sum_i(cnt, sm, F.tid);
        if (cnt >= cap) T = cand; }
    int ngt = 0, neq = 0;
#pragma unroll
    for (int j = 0; j < NPT; ++j) { ngt += (key[j] > T) ? 1 : 0; neq += (key[j] == T) ? 1 : 0; }
    int tot_gt, tot_eq;
    (void)block_excl_scan(ngt, sm, F.tid, tot_gt);
    int eqr = block_excl_scan(neq, sm, F.tid, tot_eq);
    const int need_eq = cap - tot_gt;
    int nsel = 0; bool selj[NPT];
#pragma unroll
    for (int j = 0; j < NPT; ++j) { bool s = key[j] > T; if (key[j] == T && T != 0u) { s = eqr < need_eq; ++eqr; } selj[j] = s; nsel += s ? 1 : 0; }
    int tot_sel; int pos = block_excl_scan(nsel, sm, F.tid, tot_sel);
#pragma unroll
    for (int j = 0; j < NPT; ++j) { const int i = F.tid * NPT + j;
        if (i < n) { const int row = row0 + i;
            if (selj[j]) { const int slot = slot0 + pos; ++pos; SROW[slot] = row; SG[slot] = __uint_as_float(key[j]); SEL[(size_t)row * 16 + e] = slot; }
            else SEL[(size_t)row * 16 + e] = -1; } }
    __syncthreads();
}
__device__ __forceinline__ void p_topk(Frame& F, bool with_ctx) {
    const int npairs = 128 + (with_ctx ? 128 : 0);
    for (int pi = F.bid; pi < npairs; pi += F.G) {
        if (pi < 128) { const int b = pi >> 4, e = pi & 15; topk_pair<8>(F, b * SEQ, SEQ, CAPL, e, e * SLOT_E + b * CAPL); }
        else { const int p2 = pi - 128, b = p2 >> 4, e = p2 & 15; topk_pair<1>(F, RL + b * CTXL, CTXL, CAPC, e, e * SLOT_E + 4096 + b * CAPC); }
    }
}
template <int PH> __global__ void __launch_bounds__(NTHREADS, 2) fwd_kernel(Params P) {
    extern __shared__ __attribute__((aligned(16))) unsigned char lds_raw[];
    Frame F; F.lds = (LAS unsigned char*)lds_raw; F.tid = threadIdx.x; F.lane = F.tid & 63; F.wave = __builtin_amdgcn_readfirstlane(F.tid >> 6); F.G = gridDim.x; F.bid = blockIdx.x; F.ws = P.ws;
    const int wave0 = __builtin_amdgcn_readfirstlane((int)threadIdx.x >> 6);
    volatile LAS unsigned* MISC = (volatile LAS unsigned*)(F.lds + LDS_MISC);
    if (F.tid < 64) MISC[F.tid] = 0u;
    __syncthreads();
    XcdBarrier bar; bar.bar = WSP(unsigned, WS_CTL) + CW_BAR; bar.x = 0; bar.st = MISC + 8;
    if constexpr (PH < 0) bar = xcd_barrier_post(WSP(unsigned, WS_CTL) + CW_BAR, MISC + 8);
#define IN(k) (PH < 0 || PH == (k))
#define REFRESH() do { unsigned on_ = ~0u; asm volatile("" : "+s"(on_)); int t_ = wave0 * 64 + (int)__builtin_amdgcn_mbcnt_hi(on_, __builtin_amdgcn_mbcnt_lo(on_, 0u)); asm volatile("" : "+v"(t_)); F.tid = t_; F.lane = t_ & 63; F.wave = __builtin_amdgcn_readfirstlane(t_ >> 6); } while (0)
#define SEAM(k) do { if constexpr (PH < 0) xcd_barrier(bar); } while (0)

    if (IN(0)) { REP_BEGIN(100) p_mod(P, F); p_dftgen(F); REP_END REP_BEGIN(101) p_wconv(P, F, 0); REP_END }
    SEAM(0);
    if (IN(1)) { p_rowpass_a0(P, F); }
    SEAM(1);
    for (int l = P.l_lo; l < P.l_hi; ++l) {
        constexpr int pb = 2; const bool L0 = (l == 0);
        bf16* H = WSP(bf16, WS_H);
        if (IN(pb + 0)) { REFRESH(); REP_BEGIN(2)
            const int u1 = 128 * 8 + 8 * (L0 ? 8 : 4), u2a = 128 * 2 + (L0 ? 8 * 2 : 0), u2 = u2a + 128 * 12 + (L0 ? 8 * 12 : 0), u3 = 4 * 128 + (L0 ? 4 * 8 : 0);
            const bf16* H8 = WSP(bf16, WS_H8); const bf16* WA8 = WSP(bf16, WS_WA8);
            { GroupSched S; S.init(1, 128, 8, F.G, F.bid, 8, L0 ? 8 : 4, 128, 0);
              auto AD = [=](const Unit& u) { return Operands{H8 + (size_t)u.pm * 256 * 512, WA8 + (size_t)u.pn * 256 * 512, 512, 512, 0, 512}; };
              bf16* KQ = WSP(bf16, WS_KQ);
              auto E = [=](EPI_ARGS) { const int row0 = u.pm * 256; const float qs = (u.pn >= 4) ? QSCALE * INV8 : INV8;
                  EPI_FOR8( st_bf8(KQ + (size_t)(row0 + r) * 2048 + u.pn * 256 + c, v0 * qs, v1 * qs); ) };
              GEMM_P8(S, AD, E); }
            REFRESH();
            { GroupSched S; S.init(1, 128, 2, F.G, (F.bid + F.G - ((u1 % F.G) & ~7)) % F.G, L0 ? 8 : 0, 2, 128, 0);
              const bf16* WA = WSP(bf16, WS_WA);
              auto AD = [=](const Unit& u) { return Operands{H + (size_t)u.pm * 256 * DM, WA + (size_t)(u.pn + 8) * 256 * DM, DM, DM, 0, DM}; };
              bf16* PBp = WSP(bf16, WS_PB);
              auto E = [=](EPI_ARGS) { const int row0 = u.pm * 256; EPI_FOR8( st_bf8(PBp + (size_t)(row0 + r) * 512 + u.pn * 256 + c, v0, v1); ) };
              GEMM_P(S, AD, E); }
            REFRESH();
            { GroupSched S; S.init(1, 128, 12, F.G, (F.bid + F.G - (((u1 + u2a) % F.G) & ~7)) % F.G, L0 ? 8 : 0, 12, 128, 0);
              bf16* GB = WSP(bf16, WS_GB);
              auto AD = [=](const Unit& u) { return Operands{H8 + (size_t)u.pm * 256 * 512, WA8 + (size_t)(3072 + u.pn * 256) * 512, 512, 512, 0, 512}; };
              auto E = [=](EPI_ARGS) { const int row0 = u.pm * 256;
                  EPI_FOR8( f32x4 s0; f32x4 s1; _Pragma("unroll") for (int j = 0; j < 4; ++j) { s0[j] = sigmoidf_(v0[j] * INV8); s1[j] = sigmoidf_(v1[j] * INV8); } st_bf8(GB + (size_t)(row0 + r) * 3072 + u.pn * 256 + c, s0, s1); ) };
              GEMM_P8(S, AD, E); }
            REFRESH();
            { GroupSched S; S.init(1, 4, 128, F.G, (F.bid + F.G - (((u1 + u2) % F.G) & ~7)) % F.G, L0 ? 4 : 0, 8, 0, 128);
              const bf16* WFV = WSP(bf16, WS_WFV);
              auto AD = [=](const Unit& u) { const bool fmap = (u.pn < 128); const int t16 = u.pn & 15;
                  const size_t tok0 = fmap ? (size_t)(u.pn >> 4) * SEQ + 64 * ((t16 >> 1) * 8) + (t16 & 1) * 32 : (size_t)u.pn * 256;
                  return Operands{WFV + (size_t)u.pm * 256 * DM, H + tok0 * DM, DM, DM, 0, DM, fmap ? 1 : 0}; };
              bf16* YT = WSP(bf16, WS_YT);
              auto E = [=](EPI_ARGS) { const int rr0 = u.pm * 256;
                  if (u.pn < 128) { const int b = u.pn >> 4; const int t16 = u.pn & 15, l10 = (t16 >> 1) * 8, l20 = (t16 & 1) * 32;
                      EPI_FOR8( const int fc = rr0 + r; st_bf8(YT + (((((size_t)b * 512 + (fc >> 1)) * 32 + (c >> 3)) * 2 + (l20 >> 5)) * 2 + (fc & 1)) * 64 + l10, v0, v1); ) }
                  else { const int b = u.pn - 128; EPI_FOR8( st_bf8(YT + YT_CTX_OFF + ((size_t)b * 1024 + rr0 + r) * 256 + c, v0, v1); ) } };
              GEMM_P(S, AD, E); }
            REFRESH();
            { GroupSched S; S.init(1, 4, 128, F.G, (F.bid + F.G - (((u1 + u2 + u3) % F.G) & ~7)) % F.G, 4, 8, 0, 128);
              auto AD = [=](const Unit& u) { return Operands{WA8 + (size_t)(2048 + u.pm * 256) * 512, H8 + (size_t)u.pn * 256 * 512, 512, 512, 0, 512}; };
              bf16* VT = WSP(bf16, WS_VT);
              auto E = [=](EPI_ARGS) { const int rr0 = u.pm * 256;
                  if (u.pn < 128) { const int b = u.pn >> 4, l0 = (u.pn & 15) * 256; EPI_FOR8( st_bf8(VT + ((size_t)b * 1024 + rr0 + r) * 4096 + l0 + c, v0 * INV8, v1 * INV8); ) }
                  else { const int b = u.pn - 128; EPI_FOR8( st_bf8(VT + YT_CTX_OFF + ((size_t)b * 1024 + rr0 + r) * 256 + c, v0 * INV8, v1 * INV8); ) } };
              GEMM_P8(S, AD, E); }
        REP_END }
        SEAM(pb + 0);
        if (IN(pb + 1)) { REFRESH();
            { const int nc0 = (F.G * 5 / 16) & ~7, nconv = nc0 > 0 ? nc0 : 1, na = F.G - nconv;
              if (F.bid < na) p_attn_mfma(P, F, l, L0, na, F.bid);
              else wconv_experts(P, F, l, F.bid - na, nconv); }
            REFRESH();
            REP_BEGIN(32)
            { LAS float* tw = (LAS float*)(F.lds + LDS_TW);
              for (int j = F.tid; j < 4096; j += NTHREADS) tw[j] = cospif((float)j * (1.0f / 2048.0f));
              __syncthreads();
              GroupSched S; S.init(1, 1, 512, F.G, F.bid);
              const bf16* M1 = WSP(bf16, WS_M1T); const bf16* YF = WSP(bf16, WS_YT); bf16* ZP = WSP(bf16, WS_ZP);
              auto AD = [=](const Unit& u) { return Operands{M1, YF + (size_t)u.pn * 256 * 256, 256, 256, 0, 256}; };
              auto E = [=](EPI_ARGS) {
                  const int b = u.pn >> 6, gm0 = (u.pn & 63) * 8 + wc, l20 = 32 * wr + 8 * fq;
#pragma unroll
                  for (int m = 0; m < 4; ++m) { const int k1 = 16 * m + fr;
#pragma unroll
                      for (int bj = 0; bj < 2; ++bj) { const int gm = gm0 + 4 * bj;
                          f32x4 zr[2], zi[2];
#pragma unroll
                          for (int n = 0; n < 2; ++n)
#pragma unroll
                              for (int j = 0; j < 4; ++j) { const int ix = k1 * (l20 + 4 * n + j); const float tc = tw[ix], ts = tw[(ix + 3072) & 4095];
                                  const float ur = acc[0][bj][m][n][j], ui = acc[1][bj][m][n][j]; zr[n][j] = ur * tc - ui * ts; zi[n][j] = ur * ts + ui * tc; }
                          bf16* dst = ZP + (((((size_t)b * 64 + k1) * 128 + (gm & 127)) * 4 + (gm >> 7)) * 2) * 64 + l20;
                          st_bf8(dst, zr[0], zr[1]); st_bf8(dst + 64, zi[0], zi[1]); } } };
              GEMM_P(S, AD, E); }
            REP_END
        }
        SEAM(pb + 1);
        if (IN(pb + 10)) { REFRESH();
            { GroupSched S; S.init(1, L0 ? 136 : 128, 4, F.G, F.bid);
              const bf16* A8 = WSP(bf16, WS_ATT); const bf16* W8 = WSP(bf16, WS_WAO); const bf16* GB = WSP(bf16, WS_GB); bf16* YA = WSP(bf16, WS_KQ);
              auto AD = [=](const Unit& u) { return Operands{A8 + (size_t)u.pm * 256 * 512, W8 + (size_t)u.pn * 256 * 512, 512, 512, 0, 512}; };
              auto E = [=](EPI_ARGS) { const int colb = u.pn * 256 + wc * 32 + 8 * fq;
#pragma unroll
                  for (int ai = 0; ai < 2; ++ai) { u32x4 g0[4][2];
#pragma unroll
                      for (int m = 0; m < 4; ++m)
#pragma unroll
                          for (int bj = 0; bj < 2; ++bj) g0[m][bj] = *(const u32x4*)(GB + ((size_t)u.pm * 256 + ai * 128 + wr * 64 + m * 16 + fr) * 3072 + colb + bj * 128);
#pragma unroll
                      for (int m = 0; m < 4; ++m)
#pragma unroll
                          for (int bj = 0; bj < 2; ++bj) { const u32x4 g = g0[m][bj]; const f32x4 ga = {bflo(g[0]), bfhi(g[0]), bflo(g[1]), bfhi(g[1])}, gb = {bflo(g[2]), bfhi(g[2]), bflo(g[3]), bfhi(g[3])};
                              st_bf8(YA + ((size_t)u.pm * 256 + ai * 128 + wr * 64 + m * 16 + fr) * 1024 + colb + bj * 128, acc[ai][bj][m][0] * ga * INVAT, acc[ai][bj][m][1] * gb * INVAT); } } };
              GEMM_P8(S, AD, E); }
            REFRESH();
            { GroupSched S; S.init(1, 1, 256, F.G, F.bid);
              const bf16* M2 = WSP(bf16, WS_M2T); const bf16* ZP = WSP(bf16, WS_ZP); bf16* FOUR = WSP(bf16, WS_FOUR);
              auto AD = [=](const Unit& u) { return Operands{M2, ZP + (size_t)u.pn * 256 * 512, 512, 512, 0, 512}; };
              auto E = [=](EPI_ARGS) { const float sc = 0.0013810679320049757f;
#pragma unroll
                  for (int ai = 0; ai < 2; ++ai)
#pragma unroll
                      for (int m = 0; m < 4; ++m) { const int q = 2 * ai + wr, k2 = 16 * m + fr;
#pragma unroll
                          for (int bj = 0; bj < 2; ++bj) { const int bk = u.pn * 2 + bj, b = bk >> 6, k1 = bk & 63;
                              st_bf8(FOUR + ((size_t)b * SEQ + k1 + 64 * k2) * 512 + q * 128 + wc * 32 + 8 * fq, acc[ai][bj][m][0] * sc, acc[ai][bj][m][1] * sc); } } };
              GEMM_P(S, AD, E); }
            REFRESH();
            if (L0) { GroupSched S; S.init(1, 1, 16, F.G, (F.bid + F.G - 128 % F.G) % F.G);
              const bf16* DFTC = WSP(bf16, WS_DFTC); const bf16* YTC = WSP(bf16, WS_YT) + YT_CTX_OFF; bf16* FOUR = WSP(bf16, WS_FOUR);
              auto AD = [=](const Unit& u) { return Operands{DFTC, YTC + (size_t)u.pn * 256 * 512, 512, 512, 0, 512}; };
              auto E = [=](EPI_ARGS) { const int b = u.pn >> 1, c0 = (u.pn & 1) * 256; const float sc = 0.005524271728019903f;
                  EPI_FOR8( st_bf8(FOUR + ((size_t)RL + b * CTXL + r) * 512 + c0 + c, v0 * sc, v1 * sc); ) };
              GEMM_P(S, AD, E); }
            REFRESH();
            REP_BEGIN(33) p_pool(F, L0 ? RT : RL); REP_END
        }
        SEAM(pb + 10);
        if (IN(pb + 2)) { REFRESH();
            SegSched<2> S; S.base.init(1, L0 ? 136 : 128, 4, F.G, F.bid);
            const bf16* FOUR = WSP(bf16, WS_FOUR); const bf16* POOL = WSP(bf16, WS_POOL); const bf16* WFO = WSP(bf16, WS_WFO); const bf16* WPO = WSP(bf16, WS_WPO);
            const bf16* GB = WSP(bf16, WS_GB); const bf16* YA = WSP(bf16, WS_KQ); bf16* MRGB = WSP(bf16, WS_MRGB); const float* ps = P.pool_scale + l * 1024;
            auto AD = [=](const Unit& u) {
                if (u.seg == 0) return Operands{FOUR + (size_t)u.pm * 256 * 512, WFO + (size_t)u.pn * 256 * 512, 512, 512, 0, 512};
                return Operands{POOL + (size_t)u.pm * 256 * 512 + (u.pn >> 1) * 256, WPO + (size_t)u.pn * 256 * 256, 512, 256, 0, 256}; };
            auto E = [=](EPI_ARGS) {
                const bool fin = (u.seg == 1); const int colb = u.pn * 256 + wc * 32 + 8 * fq;
                f32x4 psv[2][2];
#pragma unroll
                for (int bj = 0; bj < 2; ++bj)
#pragma unroll
                    for (int n = 0; n < 2; ++n) { f32x4 p = *(const f32x4*)(ps + colb + bj * 128 + 4 * n);
#pragma unroll
                        for (int j = 0; j < 4; ++j) p[j] = (fabsf(p[j]) < 1e-18f) ? copysignf(1e-18f, p[j]) : p[j];
                        psv[bj][n] = p; }
#pragma unroll
                for (int ai = 0; ai < 2; ++ai)
#pragma unroll
                    for (int m = 0; m < 4; ++m) { const size_t row = (size_t)u.pm * 256 + ai * 128 + wr * 64 + m * 16 + fr; const bf16* gr = GB + row * 3072 + colb;
                        u32x4 g1r[2], g2r[2], yar[2];
#pragma unroll
                        for (int bj = 0; bj < 2; ++bj) { g2r[bj] = *(const u32x4*)(gr + 2048 + bj * 128); if (fin) yar[bj] = *(const u32x4*)(YA + row * 1024 + colb + bj * 128); else g1r[bj] = *(const u32x4*)(gr + 1024 + bj * 128); }
#pragma unroll
                        for (int bj = 0; bj < 2; ++bj) { f32x4 o[2];
#pragma unroll
                            for (int n = 0; n < 2; ++n) { const u32x4 xr = fin ? yar[bj] : g1r[bj];
                                const f32x4 g2 = (f32x4){fmaxf(bflo(g2r[bj][2 * n]), 1e-18f), fmaxf(bfhi(g2r[bj][2 * n]), 1e-18f), fmaxf(bflo(g2r[bj][2 * n + 1]), 1e-18f), fmaxf(bfhi(g2r[bj][2 * n + 1]), 1e-18f)} * psv[bj][n];
                                const f32x4 x = {bflo(xr[2 * n]), bfhi(xr[2 * n]), bflo(xr[2 * n + 1]), bfhi(xr[2 * n + 1])};
#pragma unroll
                                for (int j = 0; j < 4; ++j) o[n][j] = fin ? (x[j] + acc[ai][bj][m][n][j] * g2[j]) : (acc[ai][bj][m][n][j] * x[j] * __builtin_amdgcn_rcpf(g2[j]));
                                acc[ai][bj][m][n] = o[n]; }
                            if (fin) st_bf8(MRGB + row * 1024 + colb + bj * 128, o[0], o[1]); } } };
            gemm_fast<false, true, false>(F.lds, F.tid, S, AD, mk_epi_seg(E, 1), nullptr);
        }
        SEAM(pb + 2);
        if (IN(pb + 3)) { REFRESH();
            GroupSched S; S.init(1, L0 ? 136 : 128, 4, F.G, F.bid); const bf16* A = WSP(bf16, WS_MRGB); const bf16* W = WSP(bf16, WS_WOUT);
            const float* xin = L0 ? P.x : P.out; const float* cin = L0 ? P.ctx : WSP(float, WS_XC); float* xo = P.out; float* co = WSP(float, WS_XC);
            const float* MOD = WSP(float, WS_MOD) + (size_t)l * 9 * 6144;
            auto AD = [=](const Unit& u) { return Operands{A + (size_t)u.pm * 256 * 1024, W + (size_t)u.pn * 256 * 1024, 1024, 1024, 0, 1024}; };
            auto E = [=](EPI_ARGS) {
                const int row0 = u.pm * 256, mr = row0 < RL ? (row0 >> 12) : 8, colb = u.pn * 256 + wc * 32 + 4 * fq;
                const float* src0 = row0 < RL ? xin + (size_t)row0 * DM : cin + (size_t)(row0 - RL) * DM; float* dst0 = row0 < RL ? xo + (size_t)row0 * DM : co + (size_t)(row0 - RL) * DM;
                f32x4 gv[2][2];
#pragma unroll
                for (int bj = 0; bj < 2; ++bj)
#pragma unroll
                    for (int n = 0; n < 2; ++n) gv[bj][n] = *(const f32x4*)(MOD + (size_t)mr * 6144 + 2048 + colb + bj * 128 + n * 16);
#pragma unroll
                for (int ai = 0; ai < 2; ++ai) { f32x4 xv[4][2][2];
#pragma unroll
                    for (int m = 0; m < 4; ++m) { const size_t ro = (size_t)(ai * 128 + wr * 64 + m * 16 + fr) * DM + colb;
#pragma unroll
                        for (int bj = 0; bj < 2; ++bj)
#pragma unroll
                            for (int n = 0; n < 2; ++n) xv[m][bj][n] = *(const f32x4*)(src0 + ro + bj * 128 + n * 16); }
#pragma unroll
                    for (int m = 0; m < 4; ++m) { const size_t ro = (size_t)(ai * 128 + wr * 64 + m * 16 + fr) * DM + colb;
#pragma unroll
                        for (int bj = 0; bj < 2; ++bj)
#pragma unroll
                            for (int n = 0; n < 2; ++n) *(f32x4*)(dst0 + ro + bj * 128 + n * 16) = xv[m][bj][n] + gv[bj][n] * acc[ai][bj][m][n]; } } };
            GEMM(S, AD, E, 1024, 1024, 1024);
        }
        SEAM(pb + 3);
        if (IN(pb + 4)) { REFRESH(); REP_BEGIN(6) p_rowpass_f(P, F, l, L0 ? RT : RL); REP_END }
        SEAM(pb + 4);
        if (IN(pb + 5)) { REFRESH(); REP_BEGIN(7) p_topk(F, L0); REP_END }
        SEAM(pb + 5);
        if (IN(pb + 7)) { REFRESH(); REP_BEGIN(9)
            GroupSched S; S.init(16, L0 ? 17 : 16, 22, F.G, F.bid); const bf16* H8 = WSP(bf16, WS_H8); const bf16* W = WSP(bf16, WS_WGU); unsigned char* HID = WSP(unsigned char, WS_HID); const int* SROW = WSP(int, WS_SROW);
            auto AD = [=](const Unit& u) { return Operands{H8, W + ((size_t)u.grp * 5632 + u.pn * 256) * 512, 512, 512, u.grp * SLOT_E + u.pm * 256, 512}; };
            auto E = [=](EPI_ARGS) {
#pragma unroll
                for (int ai = 0; ai < 2; ++ai)
#pragma unroll
                    for (int m = 0; m < 4; ++m) { const size_t slot = (size_t)u.grp * SLOT_E + u.pm * 256 + ai * 128 + wr * 64 + m * 16 + fr; f32x4 o[2];
#pragma unroll
                        for (int n = 0; n < 2; ++n) { const f32x4 a = acc[ai][0][m][n] * INV8, up = acc[ai][1][m][n] * (INV8 * A8S);
#pragma unroll
                            for (int j = 0; j < 4; ++j) o[n][j] = a[j] * sigmoidf_(a[j]) * up[j]; }
                        u32x2 w; w.x = pk4_fp8(o[0][0], o[0][1], o[0][2], o[0][3]); w.y = pk4_fp8(o[1][0], o[1][1], o[1][2], o[1][3]);
                        *(u32x2*)(HID + slot * FF + u.pn * 128 + wc * 32 + 8 * fq) = w; } };
            GEMM_GATHER8(S, AD, E, SROW);
        REP_END }
        SEAM(pb + 7);
        if (IN(pb + 8)) { REFRESH(); REP_BEGIN(10)
            const int tpe = L0 ? 17 : 16;
            GroupSched S; S.init(1, 16 * tpe, 4, F.G, F.bid); const bf16* HID = WSP(bf16, WS_HID); const bf16* W = WSP(bf16, WS_WD); bf16* Y = WSP(bf16, WS_Y); const float* SG = WSP(float, WS_SGATE);
            auto AD = [=](const Unit& u) { const int e = u.pm / tpe, st = e * 17 + (u.pm - e * tpe); return Operands{HID + (size_t)st * 256 * (FF / 2), W + ((size_t)e * 1024 + u.pn * 256) * (FF / 2), FF / 2, FF / 2, 0, FF / 2}; };
            auto E = [=](EPI_ARGS) { const int e = u.pm / tpe; const size_t slot0 = (size_t)(e * 17 + (u.pm - e * tpe)) * 256 + wr * 64 + fr; float gt[2][4];
#pragma unroll
                for (int ai = 0; ai < 2; ++ai)
#pragma unroll
                    for (int m = 0; m < 4; ++m) gt[ai][m] = SG[slot0 + ai * 128 + m * 16] * INV8;
#pragma unroll
                for (int ai = 0; ai < 2; ++ai)
#pragma unroll
                    for (int m = 0; m < 4; ++m)
#pragma unroll
                        for (int bj = 0; bj < 2; ++bj) st_bf8(Y + (slot0 + ai * 128 + m * 16) * DM + u.pn * 256 + bj * 128 + wc * 32 + 8 * fq, acc[ai][bj][m][0] * gt[ai][m], acc[ai][bj][m][1] * gt[ai][m]); };
            GEMM_P8(S, AD, E);
        REP_END }
        SEAM(pb + 8);
        if (IN(pb + 9)) { REFRESH(); p_rowpass_k(P, F, l, L0 ? RT : RL); if (L0) p_wconv(P, F, 1); }
        if (L0) SEAM(pb + 9);
    }
#undef IN
#undef SEAM
}
template <int PH> static void launch_ph(int grid, const Params& p, hipStream_t stream) { hipLaunchKernelGGL(fwd_kernel<PH>, dim3(grid), dim3(NTHREADS), LDS_BYTES, stream, p); }
template <int PH> static bool set_attr() { return hipFuncSetAttribute((const void*)fwd_kernel<PH>, hipFuncAttributeMaxDynamicSharedMemorySize, LDS_BYTES) == hipSuccess; }

#ifndef DUP_LAUNCH
#define DUP_LAUNCH -1
#endif
extern "C" void kernel_launch(void* const* d_in, const int* in_sizes, int n_in, void* d_out, int out_size, void* d_ws, size_t ws_size, hipStream_t stream) {
    static int grid = 0;
    if (grid == 0) {
        if (n_in != 20 || out_size != RL * DM || ws_size < WS_END) { fprintf(stderr, "kernel_launch: unexpected shapes (n_in %d out %d ws %zu need %zu)\n", n_in, out_size, ws_size, (size_t)WS_END); grid = -1; return; }
        int dev = 0, cus = 0, per_cu = 0;
        if (hipGetDevice(&dev) != hipSuccess || hipDeviceGetAttribute(&cus, hipDeviceAttributeMultiprocessorCount, dev) != hipSuccess) { grid = -1; return; }
#if N_LAUNCH_MODE == 1
        if (!set_attr<-1>()) { fprintf(stderr, "kernel_launch: hipFuncSetAttribute failed\n"); grid = -1; return; }
        if (hipOccupancyMaxActiveBlocksPerMultiprocessor(&per_cu, (const void*)fwd_kernel<-1>, NTHREADS, LDS_BYTES) != hipSuccess || per_cu < 1) fprintf(stderr, "kernel_launch: occupancy query reports %d\n", per_cu);
#else
        if (!(set_attr<0>() && set_attr<1>() && set_attr<2>() && set_attr<3>() && set_attr<12>() && set_attr<4>() && set_attr<5>() && set_attr<6>() && set_attr<7>() && set_attr<9>() && set_attr<10>() && set_attr<11>())) { fprintf(stderr, "kernel_launch: hipFuncSetAttribute failed\n"); grid = -1; return; }
        (void)per_cu;
#endif
        (void)hipGetLastError();
        grid = cus;
    }
    if (grid < 0) return;
    if (hipMemsetAsync((char*)d_ws + WS_CTL, 0, CTL_BYTES, stream) != hipSuccess) return;
    Params p{};
    const float** pp = (const float**)&p;
    for (int i = 0; i < 20; ++i) pp[i] = (const float*)d_in[i];
    p.out = (float*)d_out; p.ws = (unsigned char*)d_ws;
#if N_LAUNCH_MODE == 1
    p.l_lo = 0; p.l_hi = 2;
    launch_ph<-1>(grid, p, stream);
#else
    p.l_lo = 0; p.l_hi = 0; launch_ph<0>(grid, p, stream); if (DUP_LAUNCH == 0) launch_ph<0>(grid, p, stream); launch_ph<1>(grid, p, stream); if (DUP_LAUNCH == 1) launch_ph<1>(grid, p, stream);
#define LP(k) do { launch_ph<k>(grid, p, stream); if (DUP_LAUNCH == (k) && l == 0) launch_ph<k>(grid, p, stream); } while (0)
    for (int l = 0; l < 2; ++l) { p.l_lo = l; p.l_hi = l + 1;
        LP(2); LP(3); LP(12); LP(4); LP(5); LP(6); LP(7); LP(9); LP(10); LP(11); }
#endif
}
```

```cpp
#include <hip/hip_runtime.h>
#include <cstdio>
#include <cstdint>

#ifndef N_LAUNCH_MODE
#define N_LAUNCH_MODE 1
#endif

#define GAS __attribute__((address_space(1)))
#define LAS __attribute__((address_space(3)))
typedef unsigned short bf16;
typedef short bf16x8 __attribute__((ext_vector_type(8)));
typedef float f32x4 __attribute__((ext_vector_type(4)));
typedef unsigned u32x4 __attribute__((ext_vector_type(4)));
typedef unsigned u32x2 __attribute__((ext_vector_type(2)));

constexpr int NB = 8, SEQ = 4096, DM = 1024, CTXL = 256, NH = 16, HD = 64, GRIDW = 64;
constexpr int RL = NB * SEQ, RC = NB * CTXL, RT = RL + RC;
constexpr int INW = 7168, NE = 16, FF = 2816, CAPL = 512, CAPC = 32;
constexpr int SLOT_E = 4352, NSLOT = NE * SLOT_E;
constexpr float RMS_EPS = 1e-6f;
constexpr float LOG2E = 1.4426950408889634f, QSCALE = 0.125f * LOG2E;
constexpr float A8S = 8.0f, W8S = 64.0f, INV8 = 1.0f / (A8S * W8S);
constexpr float ATS = 32.0f, INVAT = 1.0f / (ATS * W8S);
constexpr int NWAVES = 8, NTHREADS = 512;

constexpr size_t al256(size_t x) { return (x + 255) & ~(size_t)255; }
constexpr size_t WS_CTL = 0, CTL_BYTES = 1u << 20;
constexpr size_t WS_MOD = WS_CTL + CTL_BYTES;
constexpr size_t WS_XC = al256(WS_MOD + (size_t)2 * 9 * 6144 * 4);
constexpr size_t WS_AFF = al256(WS_XC + (size_t)RC * DM * 4);
constexpr size_t WS_SROW = al256(WS_AFF + (size_t)RT * 16 * 4);
constexpr size_t WS_SGATE = al256(WS_SROW + (size_t)NSLOT * 4);
constexpr size_t WS_SEL = al256(WS_SGATE + (size_t)NSLOT * 4);
constexpr size_t WS_DFTM = al256(WS_SEL + (size_t)RT * 16 * 4);
constexpr size_t WS_DFTC = al256(WS_DFTM + (size_t)4096 * 8192 * 2);
constexpr size_t WS_WA = al256(WS_DFTC + (size_t)256 * 512 * 2);
constexpr size_t WS_WFV = al256(WS_WA + (size_t)5632 * 1024 * 2);
constexpr size_t WS_WAO = al256(WS_WFV + (size_t)2048 * 1024 * 2);
constexpr size_t WS_WFO = al256(WS_WAO + (size_t)1024 * 1024 * 2);
constexpr size_t WS_WPO = al256(WS_WFO + (size_t)1024 * 512 * 2);
constexpr size_t WS_WOUT = al256(WS_WPO + (size_t)1024 * 256 * 2);
constexpr size_t WS_WGU = al256(WS_WOUT + (size_t)1024 * 1024 * 2);
constexpr size_t WS_WD = al256(WS_WGU + (size_t)16 * 5632 * 1024);
constexpr size_t WS_WA8 = al256(WS_WD + (size_t)16 * 1024 * 2816);
constexpr size_t WS_H = al256(WS_WA8 + (size_t)6144 * 1024);
constexpr size_t WS_H8 = al256(WS_H + (size_t)RT * DM * 2);
constexpr size_t WS_R = al256(WS_H8 + (size_t)RT * DM);
constexpr size_t WS_KQ = WS_R;
constexpr size_t WS_MRG = WS_KQ;
constexpr size_t WS_PB = al256(WS_KQ + (size_t)RT * 2048 * 2);
constexpr size_t WS_GB = al256(WS_PB + (size_t)RT * 512 * 2);
constexpr size_t WS_YT = al256(WS_GB + (size_t)RT * 3072 * 2);
constexpr size_t WS_MRGB = WS_YT;
constexpr size_t WS_VT = al256(WS_YT + (size_t)RT * 1024 * 2);
constexpr size_t WS_FOUR = al256(WS_VT + (size_t)RT * 1024 * 2);
constexpr size_t WS_ATT = al256(WS_FOUR + (size_t)RT * 512 * 2);
constexpr size_t WS_POOL = al256(WS_ATT + (size_t)RT * 1024 * 2);
constexpr size_t WS_MIX_END = al256(WS_POOL + (size_t)RT * 512 * 2);
constexpr size_t WS_XG = WS_R;
constexpr size_t WS_HID = al256(WS_XG + (size_t)NSLOT * 1024 * 2);
constexpr size_t WS_Y = al256(WS_HID + (size_t)NSLOT * 2816);
constexpr size_t WS_MOE_END = al256(WS_Y + (size_t)NSLOT * 1024 * 2);
constexpr size_t WS_END0 = WS_MIX_END > WS_MOE_END ? WS_MIX_END : WS_MOE_END;
constexpr size_t WS_ZP = WS_END0;
constexpr size_t WS_M1T = al256(WS_ZP + ((size_t)8 * 64 * 512 * 128 + 1024) * 2);
constexpr size_t WS_M2T = al256(WS_M1T + (size_t)256 * 256 * 2);
constexpr size_t WS_END = al256(WS_M2T + (size_t)256 * 512 * 2);
constexpr size_t YT_CTX_OFF = (size_t)8 * 1024 * 4096;

constexpr int CW_BAR = 4096;

constexpr int LDS_BYTES = 155648;
constexpr int LDS_TW = 132096;
constexpr int LDS_MISC = 131072;

__device__ __forceinline__ unsigned f2bf(float f) { unsigned u = __float_as_uint(f); return (u + 0x7fffu + ((u >> 16) & 1u)) >> 16; }
typedef __bf16 hbf16x2 __attribute__((ext_vector_type(2)));
typedef float f32x2 __attribute__((ext_vector_type(2)));
__device__ __forceinline__ unsigned pk2(float lo, float hi) { const f32x2 v = {lo, hi}; return __builtin_bit_cast(unsigned, __builtin_convertvector(v, hbf16x2)); }
__device__ __forceinline__ unsigned pk4_fp8(float a, float b, float c, float d) {
    a = __builtin_amdgcn_fmed3f(a, -448.f, 448.f); b = __builtin_amdgcn_fmed3f(b, -448.f, 448.f); c = __builtin_amdgcn_fmed3f(c, -448.f, 448.f); d = __builtin_amdgcn_fmed3f(d, -448.f, 448.f);
    int w = 0; w = __builtin_amdgcn_cvt_pk_fp8_f32(a, b, w, false); w = __builtin_amdgcn_cvt_pk_fp8_f32(c, d, w, true); return (unsigned)w; }
__device__ __forceinline__ float bf2f(unsigned b) { return __uint_as_float(b << 16); }
__device__ __forceinline__ float bflo(unsigned w) { return __uint_as_float(w << 16); }
__device__ __forceinline__ float bfhi(unsigned w) { return __uint_as_float(w & 0xffff0000u); }
template <int CTRL> __device__ __forceinline__ float dppf(float x) { return __builtin_bit_cast(float, __builtin_amdgcn_mov_dpp(__builtin_bit_cast(int, x), CTRL, 0xf, 0xf, true)); }
template <int CTRL> __device__ __forceinline__ int dppi(int x) { return __builtin_amdgcn_mov_dpp(x, CTRL, 0xf, 0xf, true); }
constexpr int DPP_XOR1 = 0xB1, DPP_XOR2 = 0x4E, DPP_ROR4 = 0x124, DPP_ROR8 = 0x128;
__device__ __forceinline__ float wave_sum(float v) {
    v += dppf<DPP_XOR1>(v); v += dppf<DPP_XOR2>(v); v += dppf<DPP_ROR4>(v); v += dppf<DPP_ROR8>(v);
    auto s = __builtin_amdgcn_permlane16_swap(__float_as_uint(v), __float_as_uint(v), false, false); v = __uint_as_float(s[0]) + __uint_as_float(s[1]);
    auto t = __builtin_amdgcn_permlane32_swap(__float_as_uint(v), __float_as_uint(v), false, false); return __uint_as_float(t[0]) + __uint_as_float(t[1]);
}
__device__ __forceinline__ float wave_max(float v) {
    v = fmaxf(v, dppf<DPP_XOR1>(v)); v = fmaxf(v, dppf<DPP_XOR2>(v)); v = fmaxf(v, dppf<DPP_ROR4>(v)); v = fmaxf(v, dppf<DPP_ROR8>(v));
    auto s = __builtin_amdgcn_permlane16_swap(__float_as_uint(v), __float_as_uint(v), false, false); v = fmaxf(__uint_as_float(s[0]), __uint_as_float(s[1]));
    auto t = __builtin_amdgcn_permlane32_swap(__float_as_uint(v), __float_as_uint(v), false, false); return fmaxf(__uint_as_float(t[0]), __uint_as_float(t[1]));
}
__device__ __forceinline__ int wave_sum_i(int v) {
    v += dppi<DPP_XOR1>(v); v += dppi<DPP_XOR2>(v); v += dppi<DPP_ROR4>(v); v += dppi<DPP_ROR8>(v);
    auto s = __builtin_amdgcn_permlane16_swap((unsigned)v, (unsigned)v, false, false); v = (int)(s[0] + s[1]);
    auto t = __builtin_amdgcn_permlane32_swap((unsigned)v, (unsigned)v, false, false); return (int)(t[0] + t[1]);
}
__device__ __forceinline__ float sigmoidf_(float x) { return __builtin_amdgcn_rcpf(1.f + __builtin_amdgcn_exp2f(x * -1.4426950408889634f)); }
#define LDS_WAIT() asm volatile("s_waitcnt lgkmcnt(0)" ::: "memory")

#define XB_TMO      128
#define XB_XCNT(j)  (256  + 64 * (j))
#define XB_XSUB(j)  (1280 + 64 * (j))
#define XB_XGEN(j)  (2304 + 64 * (j))
#define XB_TOP      3328
#define XB_TOPGEN   3392
#define XCD_BAR_WORDS 3456
#define XB_SPIN_CAP (1u << 22)

__device__ __forceinline__ unsigned xb_ld(unsigned* p)              { return __hip_atomic_load(p, __ATOMIC_RELAXED, __HIP_MEMORY_SCOPE_AGENT); }
__device__ __forceinline__ unsigned xb_add(unsigned* p, unsigned v) { return __hip_atomic_fetch_add(p, v, __ATOMIC_RELAXED, __HIP_MEMORY_SCOPE_AGENT); }
__device__ __forceinline__ unsigned xb_xcc_id() { return (unsigned)__builtin_amdgcn_s_getreg((3 << 11) | 20) & 0xFu; }
#define XB_SPIN(cond, bar) do { unsigned _sp = 0; while (cond) { __builtin_amdgcn_s_sleep(1); \
    if ((++_sp & 255u) == 0u) { if (xb_ld(&(bar)[XB_TMO])) break; if (_sp > XB_SPIN_CAP) { atomicAdd(&(bar)[XB_TMO], 1u); break; } } } } while (0)

struct XcdBarrier { unsigned* bar; unsigned x; volatile LAS unsigned* st; };

__device__ __forceinline__ XcdBarrier xcd_barrier_post(unsigned* bar, volatile LAS unsigned* st) {
    XcdBarrier b; b.bar = bar; b.x = xb_xcc_id(); b.st = st;
    if (threadIdx.x == 0) (void)xb_add(&bar[XB_XCNT(b.x)], 1u);
    return b;
}
__device__ __forceinline__ void xcd_barrier_complete(unsigned* bar, unsigned x, unsigned& nloc, unsigned& nx) {
    const unsigned G = gridDim.x * gridDim.y * gridDim.z;
    unsigned sum, cnt, mine, sp = 0u;
    for (;;) {
        sum = 0u; cnt = 0u; mine = 0u;
#pragma unroll
        for (unsigned j = 0; j < 16; ++j) { const unsigned c = xb_ld(&bar[XB_XCNT(j)]); sum += c; cnt += (c > 0u) ? 1u : 0u; mine = (j == x) ? c : mine; }
        if (sum == G) break;
        __builtin_amdgcn_s_sleep(1);
        if ((++sp & 255u) == 0u) { if (xb_ld(&bar[XB_TMO])) break; if (sp > XB_SPIN_CAP) { atomicAdd(&bar[XB_TMO], 1u); break; } }
    }
    nloc = mine > 0u ? mine : 1u; nx = cnt > 0u ? cnt : 1u;
}
__device__ __forceinline__ void xcd_barrier(const XcdBarrier& b) {
    asm volatile("s_waitcnt vmcnt(0)" ::: "memory");
    __syncthreads();
    if (threadIdx.x == 0) {
        unsigned* bar = b.bar;
        __builtin_amdgcn_s_waitcnt(0);
        unsigned nloc = b.st[0], nx = b.st[1];
        if (nloc == 0u) { xcd_barrier_complete(bar, b.x, nloc, nx); b.st[0] = nloc; b.st[1] = nx; }
        const unsigned old = xb_add(&bar[XB_XSUB(b.x)], 1u);
        const unsigned gen = old / nloc;
        if (old + 1u == (gen + 1u) * nloc) {
            __builtin_amdgcn_fence(__ATOMIC_RELEASE, "agent");
            asm volatile("s_waitcnt vmcnt(0)" ::: "memory");
            const unsigned og = xb_add(&bar[XB_TOP], 1u);
            const unsigned tg = og / nx;
            if (og + 1u == (tg + 1u) * nx) xb_add(&bar[XB_TOPGEN], 1u);
            else XB_SPIN(xb_ld(&bar[XB_TOPGEN]) == tg, bar);
            __builtin_amdgcn_fence(__ATOMIC_ACQUIRE, "agent");
            xb_add(&bar[XB_XGEN(b.x)], 1u);
            asm volatile("s_waitcnt vmcnt(0)" ::: "memory");
        } else {
            XB_SPIN(xb_ld(&bar[XB_XGEN(b.x)]) == gen, bar);
            __builtin_amdgcn_fence(__ATOMIC_ACQUIRE, "agent");
            asm volatile("s_waitcnt vmcnt(0)" ::: "memory");
        }
    }
    __syncthreads();
}

struct Params {
    const float *x, *c, *ctx, *c_ctx, *ada_w, *ada_b, *norm1_g, *norm2_g, *w_in, *rpb, *w_att_o, *w_fourier, *w_pool, *pool_scale, *w_out, *w_router, *w_eg, *w_eu, *w_ed, *final_g;
    float* out; unsigned char* ws; int l_lo, l_hi;
};
struct Frame {
    LAS unsigned char* lds;
    int tid, lane, wave, G, bid;
    unsigned char* ws;
};
#define WSP(T, off) ((T*)(F.ws + (off)))

struct Unit { int grp, pm, pn, seg; };
struct GroupSched {
    int ng, nM, nN, G, c; int tM, tN, tpm0, tpn0;
    __device__ __forceinline__ void init(int ng_, int nM_, int nN_, int G_, int c_, int tM_ = 0, int tN_ = 0, int tpm0_ = 0, int tpn0_ = 0) { ng = ng_; nM = nM_; nN = nN_; G = G_; c = c_; tM = tM_; tN = tN_; tpm0 = tpm0_; tpn0 = tpn0_; }
    __device__ __forceinline__ bool next(int i, Unit& u) const {
        const int per = nM * nN; const int L = i * G + c;
        if (L < ng * per) {
            u.grp = L / per; int wgid = L - u.grp * per;
            { const int q = per / 8, r = per % 8, xcd = wgid % 8, off = wgid / 8; wgid = (xcd < r ? xcd * (q + 1) : r * (q + 1) + (xcd - r) * q) + off; }
            const int nig = 8 * nN, gid = wgid / nig, fm = gid * 8, gsz = (nM - fm) < 8 ? (nM - fm) : 8;
            u.pm = fm + ((wgid % nig) % gsz); u.pn = (wgid % nig) / gsz; u.seg = 0; return true;
        }
        const int w = L - ng * per;
        if (w < tM * tN) { u.grp = ng; u.pm = tpm0 + (w % tM); u.pn = tpn0 + (w / tM); u.seg = 0; return true; }
        return false;
    }
};
struct Operands { const bf16* A; const bf16* Bt; int lda, ldb, slot0, K; int bmap; };

constexpr int HTB = 128 * 64 * 2;
__device__ __forceinline__ int lds_byte(int r, int c) { const int st = (r >> 4) * 2 + (c >> 5), rr = r & 15, cc = c & 31, ob = rr * 64 + cc * 2; return st * 1024 + (ob ^ (((ob >> 9) & 1) << 5)); }
__device__ __forceinline__ int perm32(int rho) { const int n = rho >> 4, i = rho & 15; return 8 * (i >> 2) + 4 * n + (i & 3); }
__device__ __forceinline__ void stage_rc(int b, int& R, int& C) { const int st = b / 1024, sb = b % 1024, swz = sb ^ (((sb >> 9) & 1) << 5); R = (st >> 1) * 16 + swz / 64; C = (st & 1) * 32 + (swz % 64) / 2; }
typedef int i32x8 __attribute__((ext_vector_type(8)));
typedef int i32x4 __attribute__((ext_vector_type(4)));
__device__ __forceinline__ i32x8 cat8(bf16x8 lo, bf16x8 hi) { const i32x4 a = __builtin_bit_cast(i32x4, lo), b = __builtin_bit_cast(i32x4, hi); return (i32x8){a[0], a[1], a[2], a[3], b[0], b[1], b[2], b[3]}; }
template <bool GATHER, bool PERM, bool FP8, class Sched, class Addr, class Epi>
__device__ __forceinline__ void gemm_fast(LAS unsigned char* lds, const int tid, const Sched& S, const Addr& AD, const Epi& E, const int* __restrict__ grows) {
    const int wid = __builtin_amdgcn_readfirstlane(tid >> 6), lane = tid & 63, wr = wid >> 2, wc = wid & 3, fr = lane & 15, fq = lane >> 4;
    unsigned cvg[2][2], nvg[2][2], cvb[2][2], nvb[2][2];
#define PG8_RC(i_) int R_, C_; stage_rc(tid * 16 + (i_) * 8192, R_, C_); const int sR_ = R_; const unsigned sC_ = (unsigned)C_ * 2u; const int sRb_ = PERM ? ((R_ & ~31) + perm32(R_ & 31)) : R_; (void)sR_; (void)sRb_; (void)sC_
    const size_t kstep = 128;
    const unsigned ldsw = (unsigned)wid * 1024u;
    const int aoff = lds_byte(wr * 64 + fr, fq * 8), boff = lds_byte(wc * 32 + fr, fq * 8);
#define PG8_SA(b, h) (((b) * 2 + (h)) * HTB)
#define PG8_SB(b, h) ((4 + (b) * 2 + (h)) * HTB)
#define PG8_STAGE(bufoff, gbase, voff) do { _Pragma("unroll") for (int _i = 0; _i < 2; ++_i) \
        __builtin_amdgcn_global_load_lds((const unsigned*)((const char*)(gbase) + (voff)[_i]), (LAS unsigned*)(lds + (bufoff) + ldsw + _i * 8192), 16, 0, 0); } while (0)
#define PG8_LDA(dst, b, h) do { if constexpr (FP8) { _Pragma("unroll") for (int m = 0; m < 4; ++m) dst##8[m] = cat8(*(const LAS bf16x8*)(lds + PG8_SA(b, h) + aoff + m * 2048), *(const LAS bf16x8*)(lds + PG8_SA(b, h) + aoff + m * 2048 + 1024)); } \
        else { _Pragma("unroll") for (int m = 0; m < 4; ++m) _Pragma("unroll") for (int k = 0; k < 2; ++k) dst[m][k] = *(const LAS bf16x8*)(lds + PG8_SA(b, h) + aoff + m * 2048 + k * 1024); } } while (0)
#define PG8_LDB(dst, b, h) do { if constexpr (FP8) { _Pragma("unroll") for (int n = 0; n < 2; ++n) dst##8[n] = cat8(*(const LAS bf16x8*)(lds + PG8_SB(b, h) + boff + n * 2048), *(const LAS bf16x8*)(lds + PG8_SB(b, h) + boff + n * 2048 + 1024)); } \
        else { _Pragma("unroll") for (int n = 0; n < 2; ++n) _Pragma("unroll") for (int k = 0; k < 2; ++k) dst[n][k] = *(const LAS bf16x8*)(lds + PG8_SB(b, h) + boff + n * 2048 + k * 1024); } } while (0)
#define PG8_MMA(ai, bj, At, Bt) do { __builtin_amdgcn_s_setprio(1); \
        if constexpr (FP8) { _Pragma("unroll") for (int m = 0; m < 4; ++m) _Pragma("unroll") for (int n = 0; n < 2; ++n)   \
            asm volatile("v_mfma_scale_f32_16x16x128_f8f6f4 %0, %1, %2, %0, %3, %3 op_sel_hi:[0,0,0]" : "+v"(acc[ai][bj][m][n]) : "v"(Bt##8[n]), "v"(At##8[m]), "v"(one_scale)); } \
        else { _Pragma("unroll") for (int m = 0; m < 4; ++m) _Pragma("unroll") for (int n = 0; n < 2; ++n) _Pragma("unroll") for (int k = 0; k < 2; ++k) \
            acc[ai][bj][m][n] = __builtin_amdgcn_mfma_f32_16x16x32_bf16(Bt[n][k], At[m][k], acc[ai][bj][m][n], 0, 0, 0); } \
        __builtin_amdgcn_s_setprio(0); } while (0)
#define PG8_WAIT_V(n) asm volatile("s_waitcnt vmcnt(" #n ")" ::: "memory")
#define PG8_WAIT_L(n) asm volatile("s_waitcnt lgkmcnt(" #n ")" ::: "memory")
#define PG8_BAR __builtin_amdgcn_s_barrier()
#define PG8_SCHED __builtin_amdgcn_sched_barrier(0)
#define PG8_GIDX(dst, op_) do { _Pragma("unroll") for (int i_ = 0; i_ < 2; ++i_) { PG8_RC(i_); _Pragma("unroll") for (int h_ = 0; h_ < 2; ++h_) dst[h_][i_] = (unsigned)grows[(op_).slot0 + h_ * 128 + sR_] * (unsigned)((op_).lda * 2) + sC_; } } while (0)
#define PG8_AOFF(dst, op_) do { _Pragma("unroll") for (int i_ = 0; i_ < 2; ++i_) { PG8_RC(i_); _Pragma("unroll") for (int h_ = 0; h_ < 2; ++h_) dst[h_][i_] = (unsigned)((sR_ + 128 * h_) * (op_).lda) * 2u + sC_; } } while (0)
#define PG8_BOFF(dst, op_) do { _Pragma("unroll") for (int i_ = 0; i_ < 2; ++i_) { PG8_RC(i_); _Pragma("unroll") for (int h_ = 0; h_ < 2; ++h_) { const int c_ = sRb_ + 128 * h_; \
        dst[h_][i_] = (unsigned)(((op_).bmap ? (64 * (c_ & 7) + (c_ >> 3)) : c_) * (op_).ldb) * 2u + sC_; } } } while (0)
#define PG8_COPY(dst, src) do { _Pragma("unroll") for (int h_ = 0; h_ < 2; ++h_) _Pragma("unroll") for (int i_ = 0; i_ < 2; ++i_) dst[h_][i_] = src[h_][i_]; } while (0)
    Unit cur, nxt; int ui = 0;
    if (!S.next(0, cur)) return;
    f32x4 acc[2][2][4][2];
#pragma unroll
    for (int a = 0; a < 2; ++a)
#pragma unroll
        for (int b = 0; b < 2; ++b)
#pragma unroll
            for (int m = 0; m < 4; ++m)
#pragma unroll
                for (int n = 0; n < 2; ++n) acc[a][b][m][n] = (f32x4){0.f, 0.f, 0.f, 0.f};
    bf16x8 At[4][2], B0[2][2], B1[2][2]; i32x8 At8[4], B08[2], B18[2];
    const int one_scale = 0x7F7F7F7F;
    const char* cA; const char* cB; int nt;
    bool has_next; const char* nA; const char* nB; int nnt;
    { const Operands op = AD(cur); cA = (const char*)op.A; cB = (const char*)op.Bt; nt = op.K / 64; PG8_BOFF(cvb, op);
      has_next = S.next(1, nxt); const Operands o1 = has_next ? AD(nxt) : op; PG8_BOFF(nvb, o1); nA = (const char*)o1.A; nB = (const char*)o1.Bt; nnt = o1.K / 64;
      if constexpr (GATHER) { PG8_GIDX(cvg, op); PG8_GIDX(nvg, o1); PG8_WAIT_V(0); } else { PG8_AOFF(cvg, op); PG8_AOFF(nvg, o1); } }
    PG8_STAGE(PG8_SB(0, 0), cB, cvb[0]); PG8_STAGE(PG8_SB(0, 1), cB, cvb[1]); PG8_STAGE(PG8_SA(0, 0), cA, cvg[0]); PG8_STAGE(PG8_SA(0, 1), cA, cvg[1]);
    if (wr == 1) PG8_BAR;
    PG8_WAIT_V(2); PG8_BAR;
    PG8_STAGE(PG8_SB(1, 0), cB + kstep, cvb[0]); PG8_STAGE(PG8_SA(1, 0), cA + kstep, cvg[0]); PG8_STAGE(PG8_SB(1, 1), cB + kstep, cvb[1]);
    PG8_WAIT_V(6); PG8_BAR;
    for (;;) {
#pragma unroll 1
        for (int t = 0; t < nt; t += 2) {
            const bool last = (t == nt - 2);
            const char* a1 = cA + (size_t)(t + 1) * kstep;
            const char* a2 = last ? nA : cA + (size_t)(t + 2) * kstep; const char* b2 = last ? nB : cB + (size_t)(t + 2) * kstep;
            const char* a3 = a2 + kstep; const char* b3 = b2 + kstep;
            unsigned v2[2][2], w2[2][2];
#pragma unroll
            for (int h_ = 0; h_ < 2; ++h_)
#pragma unroll
                for (int i_ = 0; i_ < 2; ++i_) { v2[h_][i_] = last ? nvg[h_][i_] : cvg[h_][i_]; w2[h_][i_] = last ? nvb[h_][i_] : cvb[h_][i_]; }
            PG8_LDB(B0, 0, 0); PG8_LDB(B1, 0, 1); PG8_SCHED; PG8_LDA(At, 0, 0); PG8_STAGE(PG8_SA(1, 1), a1, cvg[1]);
            PG8_WAIT_V(8); PG8_WAIT_L(0); PG8_BAR; PG8_MMA(0, 0, At, B0); PG8_MMA(0, 1, At, B1); PG8_BAR; PG8_SCHED;
            PG8_LDA(At, 0, 1); PG8_STAGE(PG8_SB(0, 0), b2, w2[0]); PG8_STAGE(PG8_SB(0, 1), b2, w2[1]); PG8_STAGE(PG8_SA(0, 0), a2, v2[0]);
            PG8_WAIT_V(8); PG8_WAIT_L(0); PG8_BAR; PG8_MMA(1, 0, At, B0); PG8_MMA(1, 1, At, B1); PG8_BAR; PG8_SCHED;
            PG8_LDB(B0, 1, 0); PG8_LDB(B1, 1, 1); PG8_SCHED; PG8_LDA(At, 1, 0); PG8_STAGE(PG8_SA(0, 1), a2, v2[1]);
            PG8_WAIT_V(8); PG8_WAIT_L(0); PG8_BAR; PG8_MMA(0, 0, At, B0); PG8_MMA(0, 1, At, B1); PG8_BAR; PG8_SCHED;
            PG8_LDA(At, 1, 1); PG8_STAGE(PG8_SB(1, 0), b3, w2[0]); PG8_STAGE(PG8_SB(1, 1), b3, w2[1]); PG8_STAGE(PG8_SA(1, 0), a3, v2[0]);
            PG8_WAIT_V(8); PG8_WAIT_L(0); PG8_BAR; PG8_MMA(1, 0, At, B0); PG8_MMA(1, 1, At, B1); PG8_BAR; PG8_SCHED;
        }
        if constexpr (FP8) asm volatile("s_nop 15\n\ts_nop 15" ::: "memory");
        if (wr == 0) PG8_BAR;
        unsigned fvg[2][2], fvb[2][2];
        Unit u2; const bool h2 = S.next(ui + 2, u2); const char* fA = nA; const char* fB = nB; int fnt = nnt;
        if (h2) { const Operands o2 = AD(u2); fA = (const char*)o2.A; fB = (const char*)o2.Bt; fnt = o2.K / 64; PG8_BOFF(fvb, o2); if constexpr (GATHER) PG8_GIDX(fvg, o2); else PG8_AOFF(fvg, o2); }
        else { PG8_COPY(fvb, nvb); PG8_COPY(fvg, nvg); }
        { int fr2 = fr, fq2 = fq; asm volatile("" : "+v"(fr2), "+v"(fq2));
          E(acc, cur, wr, wc, fr2, fq2); }
        if (!has_next) break;
        if constexpr (GATHER) PG8_WAIT_V(0);
        PG8_COPY(cvg, nvg); PG8_COPY(nvg, fvg); PG8_COPY(cvb, nvb); PG8_COPY(nvb, fvb);
        if (E.reset(cur)) {
#pragma unroll
        for (int a = 0; a < 2; ++a)
#pragma unroll
            for (int b = 0; b < 2; ++b)
#pragma unroll
                for (int m = 0; m < 4; ++m)
#pragma unroll
                    for (int n = 0; n < 2; ++n) acc[a][b][m][n] = (f32x4){0.f, 0.f, 0.f, 0.f};
        }
        cur = nxt; cA = nA; cB = nB; nt = nnt; ++ui;
        nxt = u2; has_next = h2; nA = fA; nB = fB; nnt = fnt;
        if (wr == 1) PG8_BAR;
    }
    PG8_WAIT_V(0);
    PG8_BAR;
#undef PG8_SA
#undef PG8_SB
#undef PG8_STAGE
#undef PG8_LDA
#undef PG8_LDB
#undef PG8_MMA
#undef PG8_WAIT_V
#undef PG8_WAIT_L
#undef PG8_BAR
#undef PG8_SCHED
#undef PG8_GIDX
#undef PG8_AOFF
#undef PG8_BOFF
#undef PG8_COPY
#undef PG8_RC
}
template <class F> struct EpiFn { F f; __device__ __forceinline__ void operator()(f32x4 (&acc)[2][2][4][2], const Unit& u, int wr, int wc, int fr, int fq) const { f(acc, u, wr, wc, fr, fq); } __device__ __forceinline__ bool reset(const Unit&) const { return true; } };
template <class F> __device__ __forceinline__ EpiFn<F> mk_epi(F f) { return EpiFn<F>{f}; }
template <class F> struct EpiSeg { F f; int last; __device__ __forceinline__ void operator()(f32x4 (&acc)[2][2][4][2], const Unit& u, int wr, int wc, int fr, int fq) const { f(acc, u, wr, wc, fr, fq); } __device__ __forceinline__ bool reset(const Unit& u) const { return u.seg == last; } };
template <class F> __device__ __forceinline__ EpiSeg<F> mk_epi_seg(F f, int last) { return EpiSeg<F>{f, last}; }
template <int NSEG> struct SegSched { GroupSched base; __device__ __forceinline__ bool next(int j, Unit& u) const { if (!base.next(j / NSEG, u)) return false; u.seg = j % NSEG; return true; } };
#ifndef DUP_PH
#define DUP_PH -1
#endif
#define REP_BEGIN(k) _Pragma("unroll 1") for (int rep_ = 0; rep_ < ((DUP_PH == (k)) ? 2 : 1); ++rep_) { if (rep_) { if constexpr (PH < 0) xcd_barrier(bar); }
#define REP_END }
#define GEMM(S, AD, E, K, lda, ldb) gemm_fast<false, false, false>(F.lds, F.tid, S, AD, mk_epi(E), nullptr)
#define GEMM_P(S, AD, E) gemm_fast<false, true, false>(F.lds, F.tid, S, AD, mk_epi(E), nullptr)
#define GEMM_P8(S, AD, E) gemm_fast<false, true, true>(F.lds, F.tid, S, AD, mk_epi(E), nullptr)
#define GEMM_GATHER8(S, AD, E, rows) gemm_fast<true, true, true>(F.lds, F.tid, S, AD, mk_epi(E), rows)
#define EPI_ARGS f32x4 (&acc)[2][2][4][2], const Unit& u, int wr, int wc, int fr, int fq
#define EPI_FOR(...) _Pragma("unroll") for (int ai = 0; ai < 2; ++ai) _Pragma("unroll") for (int m = 0; m < 4; ++m) { const int r = ai * 128 + wr * 64 + m * 16 + fr; \
    _Pragma("unroll") for (int bj = 0; bj < 2; ++bj) _Pragma("unroll") for (int n = 0; n < 2; ++n) { const int c = bj * 128 + wc * 32 + n * 16 + 4 * fq; const f32x4 v = acc[ai][bj][m][n]; __VA_ARGS__ } }
#define EPI_FOR8(...) _Pragma("unroll") for (int ai = 0; ai < 2; ++ai) _Pragma("unroll") for (int m = 0; m < 4; ++m) { const int r = ai * 128 + wr * 64 + m * 16 + fr; \
    _Pragma("unroll") for (int bj = 0; bj < 2; ++bj) { const int c = bj * 128 + wc * 32 + 8 * fq; const f32x4 v0 = acc[ai][bj][m][0], v1 = acc[ai][bj][m][1]; __VA_ARGS__ } }
__device__ __forceinline__ void st_bf8(bf16* p, f32x4 a, f32x4 b) { u32x4 w; w.x = pk2(a[0], a[1]); w.y = pk2(a[2], a[3]); w.z = pk2(b[0], b[1]); w.w = pk2(b[2], b[3]); *(u32x4*)p = w; }
__device__ __forceinline__ void st_bf4(bf16* p, f32x4 v) { u32x2 w; w.x = pk2(v[0], v[1]); w.y = pk2(v[2], v[3]); *(u32x2*)p = w; }

__device__ __forceinline__ void p_mod(const Params& P, Frame& F) {
    LAS float* sc = (LAS float*)F.lds;
    LAS float* red = (LAS float*)(F.lds + 9 * 1024 * 4);
    float* MOD = WSP(float, WS_MOD);
    bool have = false;
    for (int it = F.bid; it < 2 * 96; it += F.G) {
        if (!have) {
            for (int i = F.tid; i < 9 * 1024; i += NTHREADS) { const int r = i >> 10, k = i & 1023; const float v = r < 8 ? P.c[r * 1024 + k] : P.c_ctx[k]; sc[i] = v * sigmoidf_(v); }
            have = true;
        }
        __syncthreads();
        const int l = it / 96, j0 = (it % 96) * 64, jj = F.tid & 63, kc = F.tid >> 6;
        const float* W = P.ada_w + (size_t)l * 1024 * 6144 + j0 + jj;
        float a[9];
#pragma unroll
        for (int r = 0; r < 9; ++r) a[r] = 0.f;
#pragma unroll 8
        for (int k = kc * 128; k < kc * 128 + 128; ++k) { const float w = W[(size_t)k * 6144];
#pragma unroll
            for (int r = 0; r < 9; ++r) a[r] += sc[r * 1024 + k] * w; }
#pragma unroll
        for (int r = 0; r < 9; ++r) red[(kc * 9 + r) * 64 + jj] = a[r];
        __syncthreads();
        for (int o = F.tid; o < 9 * 64; o += NTHREADS) { const int r = o >> 6, j = o & 63; float s = 0.f;
#pragma unroll
            for (int q = 0; q < 8; ++q) s += red[(q * 9 + r) * 64 + j];
            MOD[((size_t)l * 9 + r) * 6144 + j0 + j] = s + P.ada_b[l * 6144 + j0 + j]; }
    }
    __syncthreads();
}
__device__ __forceinline__ void p_dftgen(Frame& F) {
    LAS float* tab = (LAS float*)F.lds;
    for (int j = F.tid; j < 4096; j += NTHREADS) tab[j] = cospif((float)j * (1.0f / 2048.0f));
    __syncthreads();
    bf16* DC_ = WSP(bf16, WS_DFTC); bf16* M1 = WSP(bf16, WS_M1T); bf16* M2 = WSP(bf16, WS_M2T);
    const int nchunk = 256 * 64 + 256 * 32 + 256 * 64;
    for (int ch = F.bid * NTHREADS + F.tid; ch < nchunk; ch += F.G * NTHREADS) {
        float v[8]; bf16* dst;
        if (ch < 256 * 64) { const int kf = ch >> 6, col0 = (ch & 63) * 8, cs = col0 >> 8, l0 = col0 & 255;
#pragma unroll
            for (int i = 0; i < 8; ++i) { const int j = ((kf * (l0 + i)) & 255) * 16; v[i] = cs ? -tab[(j + 3072) & 4095] : tab[j]; }
            dst = DC_ + (size_t)kf * 512 + col0; }
        else if (ch < 256 * 64 + 256 * 32) { const int c2 = ch - 256 * 64, row = c2 >> 5, col0 = (c2 & 31) * 8, ri = row >> 7, h = (row >> 6) & 1, k1 = row & 63, h2 = col0 >> 7, cs = (col0 >> 6) & 1, l10 = col0 & 63;
#pragma unroll
            for (int i = 0; i < 8; ++i) { const int j = ((k1 * (l10 + i)) & 63) * 64; const float c = tab[j], sn = tab[(j + 3072) & 4095];
                v[i] = (h != h2) ? 0.f : (ri == 0 ? (cs == 0 ? c : -sn) : (cs == 0 ? sn : c)); }
            dst = M1 + (size_t)row * 256 + col0; }
        else { const int c2 = ch - 256 * 64 - 256 * 32, row = c2 >> 6, col0 = (c2 & 63) * 8, q = row >> 6, k2 = row & 63, q2 = col0 >> 7, ri = (col0 >> 6) & 1, l20 = col0 & 63;
#pragma unroll
            for (int i = 0; i < 8; ++i) { const int j = ((k2 * (l20 + i)) & 63) * 64; const float c = tab[j], sn = tab[(j + 3072) & 4095];
                v[i] = (q != q2) ? 0.f : (ri == 0 ? c : -sn); }
            dst = M2 + (size_t)row * 512 + col0; }
        u32x4 o; o.x = pk2(v[0], v[1]); o.y = pk2(v[2], v[3]); o.z = pk2(v[4], v[5]); o.w = pk2(v[6], v[7]);
        *(u32x4*)dst = o;
    }
    __syncthreads();
}
__device__ __forceinline__ void transpose_item(const float* W, int ldw, int k0, int n0, bf16* WT, int ldt, int drow0, LAS float* scr, int lane) {
    f32x4 ld[8];
#pragma unroll
    for (int i = 0; i < 8; ++i) ld[i] = *(const f32x4*)(W + (size_t)(k0 + 8 * i + (lane >> 3)) * ldw + n0 + 4 * (lane & 7));
#pragma unroll
    for (int i = 0; i < 8; ++i) { LAS float* d = scr + (8 * i + (lane >> 3)) * 33 + 4 * (lane & 7); d[0] = ld[i][0]; d[1] = ld[i][1]; d[2] = ld[i][2]; d[3] = ld[i][3]; }
    LDS_WAIT(); asm volatile("" ::: "memory");
    const int c = lane & 7;
#pragma unroll
    for (int j = 0; j < 4; ++j) { const int n = (lane >> 3) + 8 * j; const LAS float* s = scr + (8 * c) * 33 + n;
        u32x4 o; o.x = pk2(s[0 * 33], s[1 * 33]); o.y = pk2(s[2 * 33], s[3 * 33]); o.z = pk2(s[4 * 33], s[5 * 33]); o.w = pk2(s[6 * 33], s[7 * 33]);
        *(u32x4*)(WT + (size_t)(drow0 + n) * ldt + k0 + 8 * c) = o; }
    LDS_WAIT(); asm volatile("" ::: "memory");
}
__device__ __forceinline__ void transpose_item8(const float* W, int ldw, int k0, int n0, unsigned char* WT, int ldt, int drow0, LAS float* scr, int lane) {
    f32x4 ld[8];
#pragma unroll
    for (int i = 0; i < 8; ++i) ld[i] = *(const f32x4*)(W + (size_t)(k0 + 8 * i + (lane >> 3)) * ldw + n0 + 4 * (lane & 7));
#pragma unroll
    for (int i = 0; i < 8; ++i) { LAS float* d = scr + (8 * i + (lane >> 3)) * 33 + 4 * (lane & 7); d[0] = ld[i][0]; d[1] = ld[i][1]; d[2] = ld[i][2]; d[3] = ld[i][3]; }
    LDS_WAIT(); asm volatile("" ::: "memory");
    const int c = lane & 7;
#pragma unroll
    for (int j = 0; j < 4; ++j) { const int n = (lane >> 3) + 8 * j; const LAS float* s = scr + (8 * c) * 33 + n;
        u32x2 o; o.x = pk4_fp8(s[0 * 33] * W8S, s[1 * 33] * W8S, s[2 * 33] * W8S, s[3 * 33] * W8S); o.y = pk4_fp8(s[4 * 33] * W8S, s[5 * 33] * W8S, s[6 * 33] * W8S, s[7 * 33] * W8S);
        *(u32x2*)(WT + (size_t)(drow0 + n) * ldt + k0 + 8 * c) = o; }
    LDS_WAIT(); asm volatile("" ::: "memory");
}
__device__ __forceinline__ void transpose_item8w(const float* W, int ldw, int k0, int n0, unsigned char* WT, int ldt, int drow0, LAS float* scr, int lane) {
    f32x4 ld[16];
#pragma unroll
    for (int i = 0; i < 16; ++i) ld[i] = *(const f32x4*)(W + (size_t)(k0 + 4 * i + (lane >> 4)) * ldw + n0 + 4 * (lane & 15));
#pragma unroll
    for (int i = 0; i < 16; ++i) { LAS float* d = scr + (4 * i + (lane >> 4)) * 65 + 4 * (lane & 15); d[0] = ld[i][0]; d[1] = ld[i][1]; d[2] = ld[i][2]; d[3] = ld[i][3]; }
    LDS_WAIT(); asm volatile("" ::: "memory");
    const int c = lane & 3;
#pragma unroll
    for (int p = 0; p < 4; ++p) { const int n = (lane >> 2) + 16 * p; const LAS float* s = scr + (16 * c) * 65 + n; u32x4 o;
#pragma unroll
        for (int q = 0; q < 4; ++q) o[q] = pk4_fp8(s[(4 * q) * 65] * W8S, s[(4 * q + 1) * 65] * W8S, s[(4 * q + 2) * 65] * W8S, s[(4 * q + 3) * 65] * W8S);
        *(u32x4*)(WT + (size_t)(drow0 + n) * ldt + k0 + 16 * c) = o; }
    LDS_WAIT(); asm volatile("" ::: "memory");
}
__device__ __forceinline__ void wconv_experts(const Params& P, Frame& F, int l, int rank, int nblk) {
    LAS float* scr = (LAS float*)(F.lds + (F.wave < 7 ? F.wave * 17408 : 131584));
    const int gw = rank * NWAVES + F.wave, NGW = nblk * NWAVES;
    constexpr int I_E = 16 * 44;
    unsigned char* WGU = WSP(unsigned char, WS_WGU); unsigned char* WD = WSP(unsigned char, WS_WD);
    for (int it = gw; it < 3 * 16 * I_E; it += NGW) {
        const int which = it / (16 * I_E), r0 = it % (16 * I_E), e = r0 / I_E, r = r0 % I_E;
        if (which < 2) { const int kb = r / 44, nb = r % 44, n0 = nb * 64;
            const float* src = (which == 0 ? P.w_eg : P.w_eu) + ((size_t)l * 16 + e) * 1024 * FF;
            transpose_item8w(src, FF, kb * 64, n0, WGU + (size_t)e * 5632 * 1024, 1024, (n0 >> 7) * 256 + (which ? 128 : 0) + (n0 & 127), scr, F.lane); }
        else { const int kb = r / 16, nb = r % 16;
            transpose_item8w(P.w_ed + ((size_t)l * 16 + e) * FF * 1024, 1024, kb * 64, nb * 64, WD + (size_t)e * 1024 * FF, FF, nb * 64, scr, F.lane); }
    }
    __syncthreads();
}
__device__ __forceinline__ void p_wconv(const Params& P, Frame& F, int l) {
    LAS float* scr = (LAS float*)(F.lds + F.wave * 16384);
    const int gw = F.bid * NWAVES + F.wave, NGW = F.G * NWAVES;
    const float* w_in = P.w_in + (size_t)l * 1024 * INW;
    bf16* WA = WSP(bf16, WS_WA); bf16* WFV = WSP(bf16, WS_WFV);
    constexpr int I_K = 16 * 32, I_Q = 16 * 32, I_P = 16 * 16, I_G = 16 * 96, I_V = 16 * 32, I_AO = 16 * 32, I_FO = 8 * 32, I_OUT = 16 * 32;
    constexpr int NSM = I_K + I_Q + I_P + I_G + I_V + I_AO + I_FO + I_OUT;
    for (int it = gw; it < NSM; it += NGW) {
        int r = it;
        if (r < I_K) { transpose_item8(w_in, INW, (r / 32) * 64, 0 + (r % 32) * 32, WSP(unsigned char, WS_WA8), 1024, 0 + (r % 32) * 32, scr, F.lane); continue; } r -= I_K;
        if (r < I_Q) { transpose_item8(w_in, INW, (r / 32) * 64, 2048 + (r % 32) * 32, WSP(unsigned char, WS_WA8), 1024, 1024 + (r % 32) * 32, scr, F.lane); continue; } r -= I_Q;
        if (r < I_P) { transpose_item(w_in, INW, (r / 16) * 64, 3584 + (r % 16) * 32, WA, 1024, 2048 + (r % 16) * 32, scr, F.lane); continue; } r -= I_P;
        if (r < I_G) { transpose_item8(w_in, INW, (r / 96) * 64, 4096 + (r % 96) * 32, WSP(unsigned char, WS_WA8), 1024, 3072 + (r % 96) * 32, scr, F.lane); continue; } r -= I_G;
        if (r < I_V) { transpose_item8(w_in, INW, (r / 32) * 64, 1024 + (r % 32) * 32, WSP(unsigned char, WS_WA8), 1024, 2048 + (r % 32) * 32, scr, F.lane); continue; } r -= I_V;
        if (r < I_AO) { transpose_item8(P.w_att_o + (size_t)l * 1024 * 1024, 1024, (r / 32) * 64, (r % 32) * 32, WSP(unsigned char, WS_WAO), 1024, (r % 32) * 32, scr, F.lane); continue; } r -= I_AO;
        if (r < I_FO) { transpose_item(P.w_fourier + (size_t)l * 512 * 1024, 1024, (r / 32) * 64, (r % 32) * 32, WSP(bf16, WS_WFO), 512, (r % 32) * 32, scr, F.lane); continue; } r -= I_FO;
        transpose_item(P.w_out + (size_t)l * 1024 * 1024, 1024, (r / 32) * 64, (r % 32) * 32, WSP(bf16, WS_WOUT), 1024, (r % 32) * 32, scr, F.lane);
    }
    { bf16* WPO = WSP(bf16, WS_WPO); const float* wp = P.w_pool + (size_t)l * 4 * 128 * 256;
      for (int i = F.bid * NTHREADS + F.tid; i < 1024 * 256; i += F.G * NTHREADS) { const int n = i >> 8, kk = i & 255, g = n >> 8, f = n & 255;
          WPO[i] = (bf16)(((kk >> 7) == (g & 1)) ? f2bf(wp[((size_t)g * 128 + (kk & 127)) * 256 + f]) : 0u); } }
    { LAS float* t128 = (LAS float*)F.lds;
      __syncthreads();
      for (int j = F.tid; j < 128; j += NTHREADS) t128[j] = cospif((float)j * (1.0f / 64.0f));
      __syncthreads();
      for (int i = F.bid * NTHREADS + F.tid; i < 1024 * 1024; i += F.G * NTHREADS) { const int fc = i >> 10, k = i & 1023, cs = fc & 1, gm = fc >> 1, g = gm >> 7, m = gm & 127;
          const float* src = w_in + (size_t)k * INW + 3072 + g * 128; float s = 0.f; const int ph = cs ? 96 : 0;
          for (int c = 0; c < 128; ++c) s += src[c] * t128[(m * c + ph) & 127];
          WFV[i] = (bf16)f2bf(s); }
      __syncthreads(); }
}

struct RowMod { const float* g; const float* sh; const float* sc; };
__device__ __forceinline__ void row_load(const float* row, int lane, f32x4 (&v)[4]) {
#pragma unroll
    for (int j = 0; j < 4; ++j) v[j] = *(const f32x4*)(row + 4 * lane + 256 * j);
}
__device__ __forceinline__ float row_rstd(const f32x4 (&v)[4]) {
    float s = 0.f;
#pragma unroll
    for (int j = 0; j < 4; ++j) s += (v[j][0] * v[j][0] + v[j][1] * v[j][1]) + (v[j][2] * v[j][2] + v[j][3] * v[j][3]);
    return rsqrtf(wave_sum(s) * (1.0f / 1024.0f) + RMS_EPS);
}
__device__ __forceinline__ void row_modulate(const f32x4 (&v)[4], float rstd, const RowMod& M, int lane, f32x4 (&y)[4]) {
#pragma unroll
    for (int j = 0; j < 4; ++j) { const int k = 4 * lane + 256 * j; const f32x4 g = *(const f32x4*)(M.g + k), sh = *(const f32x4*)(M.sh + k), sc = *(const f32x4*)(M.sc + k);
        y[j] = v[j] * rstd * g * (sc + 1.0f) + sh; }
}
__device__ __forceinline__ void row_store_bf(bf16* row, int lane, const f32x4 (&y)[4]) {
#pragma unroll
    for (int j = 0; j < 4; ++j) st_bf4(row + 4 * lane + 256 * j, y[j]);
}
__device__ __forceinline__ void row_store_f8(unsigned char* row, int lane, const f32x4 (&y)[4]) {
#pragma unroll
    for (int j = 0; j < 4; ++j) *(unsigned*)(row + 4 * lane + 256 * j) = pk4_fp8(y[j][0] * A8S, y[j][1] * A8S, y[j][2] * A8S, y[j][3] * A8S);
}
__device__ __forceinline__ const float* mod_ptr(Frame& F, int l, int row, int which) { const int mr = row < RL ? (row >> 12) : 8; return WSP(float, WS_MOD) + ((size_t)l * 9 + mr) * 6144 + which * 1024; }

__device__ __forceinline__ void row_modulate2(const f32x4 (&v0)[4], const f32x4 (&v1)[4], float rs0, float rs1, const RowMod& M, int lane, f32x4 (&y0)[4], f32x4 (&y1)[4]) {
#pragma unroll
    for (int j = 0; j < 4; ++j) { const int k = 4 * lane + 256 * j; const f32x4 g = *(const f32x4*)(M.g + k), sh = *(const f32x4*)(M.sh + k), sc = *(const f32x4*)(M.sc + k); const f32x4 m = g * (sc + 1.0f);
        y0[j] = v0[j] * rs0 * m + sh; y1[j] = v1[j] * rs1 * m + sh; }
}
__device__ __forceinline__ void p_rowpass_a0(const Params& P, Frame& F) {
    const int gw = F.bid * NWAVES + F.wave, NGW = F.G * NWAVES; bf16* H = WSP(bf16, WS_H); unsigned char* H8 = WSP(unsigned char, WS_H8);
    f32x4 vn[2][4]; int p = gw;
    if (p < RT / 2) { const int row = 2 * p; const float* src = row < RL ? P.x + (size_t)row * DM : P.ctx + (size_t)(row - RL) * DM; row_load(src, F.lane, vn[0]); row_load(src + DM, F.lane, vn[1]); }
    for (; p < RT / 2; p += NGW) { const int row = 2 * p;
        f32x4 v0[4], v1[4], y0[4], y1[4];
#pragma unroll
        for (int j = 0; j < 4; ++j) { v0[j] = vn[0][j]; v1[j] = vn[1][j]; }
        { const int nr = 2 * (p + NGW); if (nr < RT) { const float* src = nr < RL ? P.x + (size_t)nr * DM : P.ctx + (size_t)(nr - RL) * DM; row_load(src, F.lane, vn[0]); row_load(src + DM, F.lane, vn[1]); } }
        const float rs0 = row_rstd(v0), rs1 = row_rstd(v1);
        RowMod M{P.norm1_g, mod_ptr(F, 0, row, 0), mod_ptr(F, 0, row, 1)};
        row_modulate2(v0, v1, rs0, rs1, M, F.lane, y0, y1);
        row_store_bf(H + (size_t)row * DM, F.lane, y0); row_store_f8(H8 + (size_t)row * DM, F.lane, y0);
        row_store_bf(H + (size_t)(row + 1) * DM, F.lane, y1); row_store_f8(H8 + (size_t)(row + 1) * DM, F.lane, y1);
    }
}
constexpr int DPP_MIRROR = 0x140, DPP_HMIRROR = 0x141;
__device__ __forceinline__ float reduce_scatter32(const float (&a)[32], int lane) {
    const bool b3 = lane & 8, b2 = lane & 4, b1 = lane & 2, b0 = lane & 1;
    float s16[16], s8[8], s4[4], s2[2];
#pragma unroll
    for (int i = 0; i < 16; ++i) { const float keep = b3 ? a[16 + i] : a[i], send = b3 ? a[i] : a[16 + i]; s16[i] = keep + dppf<DPP_MIRROR>(send); }
#pragma unroll
    for (int i = 0; i < 8; ++i) { const float keep = b2 ? s16[8 + i] : s16[i], send = b2 ? s16[i] : s16[8 + i]; s8[i] = keep + dppf<DPP_HMIRROR>(send); }
#pragma unroll
    for (int i = 0; i < 4; ++i) { const float keep = b1 ? s8[4 + i] : s8[i], send = b1 ? s8[i] : s8[4 + i]; s4[i] = keep + dppf<DPP_XOR2>(send); }
#pragma unroll
    for (int i = 0; i < 2; ++i) { const float keep = b0 ? s4[2 + i] : s4[i], send = b0 ? s4[i] : s4[2 + i]; s2[i] = keep + dppf<DPP_XOR1>(send); }
    auto s = __builtin_amdgcn_permlane16_swap(__float_as_uint(s2[0]), __float_as_uint(s2[1]), false, false); const float v = __uint_as_float(s[0]) + __uint_as_float(s[1]);
    auto t = __builtin_amdgcn_permlane32_swap(__float_as_uint(v), __float_as_uint(v), false, false); return __uint_as_float(t[0]) + __uint_as_float(t[1]);
}
__device__ __forceinline__ void p_rowpass_f(const Params& P, Frame& F, int l, int nrows) {
    const int gw = F.bid * NWAVES + F.wave, NGW = F.G * NWAVES; unsigned char* H8 = WSP(unsigned char, WS_H8); float* AFF = WSP(float, WS_AFF);
    const float* wr = P.w_router + (size_t)l * 1024 * 16;
    LAS float* wl = (LAS float*)F.lds;
    __syncthreads();
    for (int i = F.tid; i < 16384; i += NTHREADS) wl[(i & 15) * 1024 + (i >> 4)] = wr[i];
    __syncthreads();
    f32x4 vn[2][4]; int p = gw; const int NP = nrows >> 1;
    if (p < NP) { const int row = 2 * p; const float* src = row < RL ? P.out + (size_t)row * DM : WSP(float, WS_XC) + (size_t)(row - RL) * DM; row_load(src, F.lane, vn[0]); row_load(src + DM, F.lane, vn[1]); }
    for (; p < NP; p += NGW) { const int row = 2 * p;
        f32x4 v0[4], v1[4], y0[4], y1[4];
#pragma unroll
        for (int j = 0; j < 4; ++j) { v0[j] = vn[0][j]; v1[j] = vn[1][j]; }
        { const int nr = 2 * (p + NGW); if (nr < nrows) { const float* src = nr < RL ? P.out + (size_t)nr * DM : WSP(float, WS_XC) + (size_t)(nr - RL) * DM; row_load(src, F.lane, vn[0]); row_load(src + DM, F.lane, vn[1]); } }
        const float rs0 = row_rstd(v0), rs1 = row_rstd(v1);
        RowMod M{P.norm2_g + l * 1024, mod_ptr(F, l, row, 3), mod_ptr(F, l, row, 4)};
        row_modulate2(v0, v1, rs0, rs1, M, F.lane, y0, y1);
        row_store_f8(H8 + (size_t)row * DM, F.lane, y0); row_store_f8(H8 + (size_t)(row + 1) * DM, F.lane, y1);
        float lg[32];
        int wo = 4 * F.lane; asm volatile("" : "+v"(wo));
#pragma unroll
        for (int e = 0; e < 16; ++e) { f32x2 a = {0.f, 0.f};
#pragma unroll
            for (int j = 0; j < 4; ++j) { const f32x4 w = *(const LAS f32x4*)(wl + e * 1024 + wo + 256 * j);
#pragma unroll
                for (int c = 0; c < 4; ++c) a += (f32x2){y0[j][c], y1[j][c]} * (f32x2){w[c], w[c]}; }
            lg[e] = a[0]; lg[16 + e] = a[1]; }
        const float tot = reduce_scatter32(lg, F.lane);
        float mx = tot;
        mx = fmaxf(mx, dppf<DPP_XOR1>(mx)); mx = fmaxf(mx, dppf<DPP_XOR2>(mx)); mx = fmaxf(mx, dppf<DPP_HMIRROR>(mx));
        { auto s = __builtin_amdgcn_permlane16_swap(__float_as_uint(mx), __float_as_uint(mx), false, false); mx = fmaxf(__uint_as_float(s[0]), __uint_as_float(s[1])); }
        const float ex = __expf(tot - mx); float den = ex;
        den += dppf<DPP_XOR1>(den); den += dppf<DPP_XOR2>(den); den += dppf<DPP_HMIRROR>(den);
        { auto s = __builtin_amdgcn_permlane16_swap(__float_as_uint(den), __float_as_uint(den), false, false); den = __uint_as_float(s[0]) + __uint_as_float(s[1]); }
        if (F.lane < 32) { const int r = (F.lane >> 3) & 1, e = (F.lane & 4) * 2 + (F.lane & 2) * 2 + (F.lane & 1) * 2 + (F.lane >> 4);
            AFF[(size_t)(row + r) * 16 + e] = ex / den; }
    }
    __syncthreads();
}
__device__ __forceinline__ void p_rowpass_k(const Params& P, Frame& F, int l, int nrows) {
    const int gw = F.bid * NWAVES + F.wave, NGW = F.G * NWAVES; bf16* H = WSP(bf16, WS_H);
    const int* SEL = WSP(int, WS_SEL); const bf16* Y = WSP(bf16, WS_Y);
    f32x4 vn[2][4]; int seln = -1; int p = gw; const int NP = nrows >> 1;
    if (p < NP) { const int row = 2 * p; const float* src = row < RL ? P.out + (size_t)row * DM : WSP(float, WS_XC) + (size_t)(row - RL) * DM; row_load(src, F.lane, vn[0]); row_load(src + DM, F.lane, vn[1]);
        seln = F.lane < 32 ? SEL[(size_t)row * 16 + F.lane] : -1; }
    for (; p < NP; p += NGW) { const int row = 2 * p;
        float* xr = row < RL ? P.out + (size_t)row * DM : WSP(float, WS_XC) + (size_t)(row - RL) * DM;
        f32x4 v0[4], v1[4], a0[4], a1[4]; const int sel = seln;
#pragma unroll
        for (int j = 0; j < 4; ++j) { v0[j] = vn[0][j]; v1[j] = vn[1][j]; a0[j] = (f32x4){0.f, 0.f, 0.f, 0.f}; a1[j] = (f32x4){0.f, 0.f, 0.f, 0.f}; }
        { const int nr = 2 * (p + NGW); if (nr < nrows) { const float* src = nr < RL ? P.out + (size_t)nr * DM : WSP(float, WS_XC) + (size_t)(nr - RL) * DM; row_load(src, F.lane, vn[0]); row_load(src + DM, F.lane, vn[1]);
            seln = F.lane < 32 ? SEL[(size_t)nr * 16 + F.lane] : -1; } }
        const unsigned emall = (unsigned)__ballot(sel >= 0);
        unsigned em = emall & 0xffffu;
        while (em) { const int e = __builtin_ctz(em); em &= em - 1; const int s = __builtin_amdgcn_readlane(sel, e); const bf16* yr = Y + (size_t)s * DM;
#pragma unroll
            for (int j = 0; j < 4; ++j) { const u32x2 w = *(const u32x2*)(yr + 4 * F.lane + 256 * j); a0[j][0] += bflo(w.x); a0[j][1] += bfhi(w.x); a0[j][2] += bflo(w.y); a0[j][3] += bfhi(w.y); } }
        em = (emall >> 16) & 0xffffu;
        while (em) { const int e = __builtin_ctz(em); em &= em - 1; const int s = __builtin_amdgcn_readlane(sel, 16 + e); const bf16* yr = Y + (size_t)s * DM;
#pragma unroll
            for (int j = 0; j < 4; ++j) { const u32x2 w = *(const u32x2*)(yr + 4 * F.lane + 256 * j); a1[j][0] += bflo(w.x); a1[j][1] += bfhi(w.x); a1[j][2] += bflo(w.y); a1[j][3] += bfhi(w.y); } }
        const float* g2 = mod_ptr(F, l, row, 5);
#pragma unroll
        for (int j = 0; j < 4; ++j) { const f32x4 g = *(const f32x4*)(g2 + 4 * F.lane + 256 * j); v0[j] = v0[j] + g * a0[j]; v1[j] = v1[j] + g * a1[j]; }
        const float rs0 = row_rstd(v0), rs1 = row_rstd(v1);
        if (l == 0) {
#pragma unroll
            for (int j = 0; j < 4; ++j) { *(f32x4*)(xr + 4 * F.lane + 256 * j) = v0[j]; *(f32x4*)(xr + DM + 4 * F.lane + 256 * j) = v1[j]; }
            f32x4 y0[4], y1[4]; RowMod M{P.norm1_g + 1024, mod_ptr(F, 1, row, 0), mod_ptr(F, 1, row, 1)};
            row_modulate2(v0, v1, rs0, rs1, M, F.lane, y0, y1);
            row_store_bf(H + (size_t)row * DM, F.lane, y0); row_store_f8(WSP(unsigned char, WS_H8) + (size_t)row * DM, F.lane, y0);
            row_store_bf(H + (size_t)(row + 1) * DM, F.lane, y1); row_store_f8(WSP(unsigned char, WS_H8) + (size_t)(row + 1) * DM, F.lane, y1);
        } else {
#pragma unroll
            for (int j = 0; j < 4; ++j) { const f32x4 g = *(const f32x4*)(P.final_g + 4 * F.lane + 256 * j); *(f32x4*)(xr + 4 * F.lane + 256 * j) = v0[j] * rs0 * g; *(f32x4*)(xr + DM + 4 * F.lane + 256 * j) = v1[j] * rs1 * g; }
        }
    }
}

constexpr int ACK_STRIDE = 72, ACV_STRIDE = 264;
constexpr int ALDS_CK = 0, ALDS_CV = 256 * ACK_STRIDE * 2, ALDS_RP = ALDS_CV + 64 * ACV_STRIDE * 2;
struct AttnState { float m, sum; f32x4 o[4]; };
__device__ __forceinline__ float xrow16_max(float x) {
    auto s = __builtin_amdgcn_permlane16_swap(__float_as_uint(x), __float_as_uint(x), false, false);
    x = fmaxf(__uint_as_float(s[0]), __uint_as_float(s[1]));
    auto t = __builtin_amdgcn_permlane32_swap(__float_as_uint(x), __float_as_uint(x), false, false);
    return fmaxf(__uint_as_float(t[0]), __uint_as_float(t[1]));
}
__device__ __forceinline__ float xrow16_sum(float x) {
    auto s = __builtin_amdgcn_permlane16_swap(__float_as_uint(x), __float_as_uint(x), false, false);
    x = __uint_as_float(s[0]) + __uint_as_float(s[1]);
    auto t = __builtin_amdgcn_permlane32_swap(__float_as_uint(x), __float_as_uint(x), false, false);
    return __uint_as_float(t[0]) + __uint_as_float(t[1]);
}
#define MFMA16(a, b, c) __builtin_amdgcn_mfma_f32_16x16x32_bf16((a), (b), (c), 0, 0, 0)
template <int NT>
__device__ __forceinline__ void attn_tail(AttnState& S, f32x4 (&sc)[NT], const u32x4 (&vw)[NT / 2][4]) {
    float cm = -__builtin_inff();
#pragma unroll
    for (int t = 0; t < NT; ++t)
#pragma unroll
        for (int j = 0; j < 4; ++j) cm = fmaxf(cm, sc[t][j]);
    cm = xrow16_max(cm);
    const bool need = (fabsf(cm) > 12.0f) && (cm > -1e30f);
    if (__builtin_amdgcn_ballot_w64(need) != 0ull) {
        const float d = need ? cm : 0.f, scl = __builtin_amdgcn_exp2f(-d);
        S.m += d; S.sum *= scl;
#pragma unroll
        for (int dt = 0; dt < 4; ++dt) S.o[dt] = S.o[dt] * scl;
#pragma unroll
        for (int t = 0; t < NT; ++t)
#pragma unroll
            for (int j = 0; j < 4; ++j) sc[t][j] -= d;
    }
    float ps = 0.f;
#pragma unroll
    for (int t = 0; t < NT; ++t)
#pragma unroll
        for (int j = 0; j < 4; ++j) { const float p = __builtin_amdgcn_exp2f(sc[t][j]); sc[t][j] = p; ps += p; }
    S.sum += ps;
#pragma unroll
    for (int ks = 0; ks < NT / 2; ++ks) { u32x4 pw; pw.x = pk2(sc[2 * ks][0], sc[2 * ks][1]); pw.y = pk2(sc[2 * ks][2], sc[2 * ks][3]); pw.z = pk2(sc[2 * ks + 1][0], sc[2 * ks + 1][1]); pw.w = pk2(sc[2 * ks + 1][2], sc[2 * ks + 1][3]);
        const bf16x8 pf = __builtin_bit_cast(bf16x8, pw);
#pragma unroll
        for (int dt = 0; dt < 4; ++dt) S.o[dt] = MFMA16(__builtin_bit_cast(bf16x8, vw[ks][dt]), pf, S.o[dt]); }
}
__device__ __forceinline__ void attn_unit2(const bf16* __restrict__ KQ, const bf16* __restrict__ VT, unsigned char* __restrict__ ATT, LAS unsigned char* lds,
                                           const int b, const int h, const int rowqA, const int rowqB, const bool win, const int r, const int qt, const int lane) {
    const int l15 = lane & 15, g = lane >> 4;
    const f32x4 z = {0.f, 0.f, 0.f, 0.f};
    bf16x8 qA[2], qB[2];
    { const bf16* qp = KQ + (size_t)(rowqA + l15) * 2048 + 1024 + h * 64 + 8 * g; qA[0] = *(const bf16x8*)qp; qA[1] = *(const bf16x8*)(qp + 32); }
    { const bf16* qp = KQ + (size_t)(rowqB + l15) * 2048 + 1024 + h * 64 + 8 * g; qB[0] = *(const bf16x8*)qp; qB[1] = *(const bf16x8*)(qp + 32); }
    AttnState SA, SB; SA.m = 0.f; SA.sum = 0.f; SB.m = 0.f; SB.sum = 0.f;
#pragma unroll
    for (int dt = 0; dt < 4; ++dt) { SA.o[dt] = z; SB.o[dt] = z; }
    if (win) {
        const int rsA = min(max(r - 4, 0), 56), dB = min(max(r - 3, 0), 56) - rsA, kc0 = min(max(16 * qt - 8, 0), 32);
        const int q = 16 * qt + l15, csq = min(max(q - 8, 0), 48);
        const int krow0 = 8 * (l15 >> 2) + (l15 & 3);
        const bf16* kb = KQ + (size_t)(b * SEQ + kc0 + krow0) * 2048 + h * 64 + 8 * g;
        const bf16* vb = VT + (size_t)(b * 1024 + h * 64 + l15) * 4096 + kc0 + 8 * g;
        const LAS float* rp = (const LAS float*)(lds + ALDS_RP);
        const int jb = kc0 + 8 * g;
        const int okb = jb - csq;
        const LAS float* rpl = rp + 16 + (jb - q + 15);
        float madd[2][4];
#pragma unroll
        for (int t = 0; t < 2; ++t)
#pragma unroll
            for (int j = 0; j < 4; ++j) madd[t][j] = ((unsigned)(okb + 4 * t + j) < 16u) ? 0.f : -__builtin_inff();
        bf16x8 K0[2][2], K1[2][2]; u32x4 V0[1][4], V1[1][4];
#define ATT_LOADW(KB, VB, i) do { const int gr_ = min(rsA + (i), 63); const bf16* kp_ = kb + (size_t)(gr_ * 64) * 2048; const bf16* vp_ = vb + gr_ * 64; \
        _Pragma("unroll") for (int t = 0; t < 2; ++t) { KB[t][0] = *(const bf16x8*)(kp_ + (size_t)(4 * t) * 2048); KB[t][1] = *(const bf16x8*)(kp_ + (size_t)(4 * t) * 2048 + 32); } \
        _Pragma("unroll") for (int dt = 0; dt < 4; ++dt) VB[0][dt] = *(const u32x4*)(vp_ + (size_t)(16 * dt) * 4096); } while (0)
#define ATT_ONE(ST, QF, KB, VB, roff, rowok) do { f32x4 sc[2]; \
        const LAS float* bp_ = rpl + ((rowok) ? (roff) : 15) * 64; \
        _Pragma("unroll") for (int t = 0; t < 2; ++t) _Pragma("unroll") for (int j = 0; j < 4; ++j) sc[t][j] = (bp_[4 * t + j] + madd[t][j]) - ST.m;     \
        _Pragma("unroll") for (int t = 0; t < 2; ++t) { sc[t] = MFMA16(KB[t][0], QF[0], sc[t]); sc[t] = MFMA16(KB[t][1], QF[1], sc[t]); } \
        attn_tail<2>(ST, sc, VB); } while (0)
#define ATT_COMPUTE(KB, VB, i) do { const int roffA_ = min(rsA + (i) - r + 7, 14); \
        ATT_ONE(SA, qA, KB, VB, roffA_, (i) <= 7); \
        ATT_ONE(SB, qB, KB, VB, max(roffA_ - 1, 0), (i) >= dB && (i) <= 7 + dB); } while (0)
        ATT_LOADW(K0, V0, 0);
#pragma unroll 1
        for (int i = 0; i < 8; i += 2) { ATT_LOADW(K1, V1, i + 1); ATT_COMPUTE(K0, V0, i); ATT_LOADW(K0, V0, i + 2); ATT_COMPUTE(K1, V1, i + 1); }
        ATT_COMPUTE(K0, V0, 8);
#undef ATT_LOADW
#undef ATT_ONE
#undef ATT_COMPUTE
    }
    { const LAS bf16* ck = (const LAS bf16*)(lds + ALDS_CK) + l15 * ACK_STRIDE + 8 * g;
      const LAS bf16* cv = (const LAS bf16*)(lds + ALDS_CV) + l15 * ACV_STRIDE + 8 * g;
#pragma unroll 1
      for (int c = 0; c < 4; ++c) {
          bf16x8 kf[4][2]; u32x4 vw[2][4];
#pragma unroll
          for (int t = 0; t < 4; ++t) { const LAS bf16* kp = ck + (64 * c + 16 * t) * ACK_STRIDE; kf[t][0] = *(const LAS bf16x8*)kp; kf[t][1] = *(const LAS bf16x8*)(kp + 32); }
#pragma unroll
          for (int ks = 0; ks < 2; ++ks)
#pragma unroll
              for (int dt = 0; dt < 4; ++dt) vw[ks][dt] = *(const LAS u32x4*)(cv + (16 * dt) * ACV_STRIDE + 64 * c + 32 * ks);
          { f32x4 sc[4]; const float nm = -SA.m; const f32x4 c0 = {nm, nm, nm, nm};
#pragma unroll
            for (int t = 0; t < 4; ++t) { sc[t] = MFMA16(kf[t][0], qA[0], c0); sc[t] = MFMA16(kf[t][1], qA[1], sc[t]); }
            attn_tail<4>(SA, sc, vw); }
          { f32x4 sc[4]; const float nm = -SB.m; const f32x4 c0 = {nm, nm, nm, nm};
#pragma unroll
            for (int t = 0; t < 4; ++t) { sc[t] = MFMA16(kf[t][0], qB[0], c0); sc[t] = MFMA16(kf[t][1], qB[1], sc[t]); }
            attn_tail<4>(SB, sc, vw); }
      } }
    { const float inv = 1.0f / xrow16_sum(SA.sum);
#pragma unroll
      for (int dt = 0; dt < 4; ++dt) { const f32x4 o = SA.o[dt] * (inv * ATS); *(unsigned*)(ATT + (size_t)(rowqA + l15) * 1024 + h * 64 + 16 * dt + 4 * g) = pk4_fp8(o[0], o[1], o[2], o[3]); } }
    { const float inv = 1.0f / xrow16_sum(SB.sum);
#pragma unroll
      for (int dt = 0; dt < 4; ++dt) { const f32x4 o = SB.o[dt] * (inv * ATS); *(unsigned*)(ATT + (size_t)(rowqB + l15) * 1024 + h * 64 + 16 * dt + 4 * g) = pk4_fp8(o[0], o[1], o[2], o[3]); } }
}
__device__ __forceinline__ void p_attn_mfma(const Params& P, Frame& F, int l, bool with_ctx_queries, int nblk, int rank) {
    const bf16* KQ = WSP(bf16, WS_KQ); const bf16* VT = WSP(bf16, WS_VT); unsigned char* ATT = WSP(unsigned char, WS_ATT);
    const float* rpb = P.rpb + (size_t)l * 16 * 465;
    const int it0 = (int)(((long)rank * 1024) / nblk), it1 = (int)(((long)(rank + 1) * 1024) / nblk);
    int pcur = -1;
    for (int hp = it0; hp < it1; ++hp) {
        const int p = hp >> 3, eighth = hp & 7, b = p >> 4, h = p & 15;
        if (p != pcur) { pcur = p;
        __syncthreads();
        { LAS bf16* ck = (LAS bf16*)(F.lds + ALDS_CK); LAS bf16* cv = (LAS bf16*)(F.lds + ALDS_CV); LAS float* rp = (LAS float*)(F.lds + ALDS_RP);
          { const int key = F.tid >> 1, hf = F.tid & 1; const int k32 = key & 31, pos = (key & ~31) + ((k32 >> 2) & 1) * 16 + 4 * (k32 >> 3) + (k32 & 3);
            const u32x4* src = (const u32x4*)(KQ + (size_t)(RL + b * CTXL + key) * 2048 + h * 64 + hf * 32); LAS u32x4* dst = (LAS u32x4*)(ck + pos * ACK_STRIDE + hf * 32);
#pragma unroll
            for (int i = 0; i < 4; ++i) dst[i] = src[i]; }
          { const int d = F.tid >> 3, sg = F.tid & 7; const u32x4* src = (const u32x4*)(VT + YT_CTX_OFF + (size_t)(b * 1024 + h * 64 + d) * 256 + sg * 32); LAS u32x4* dst = (LAS u32x4*)(cv + d * ACV_STRIDE + sg * 32);
#pragma unroll
            for (int i = 0; i < 4; ++i) dst[i] = src[i]; }
          for (int i = F.tid; i < 16 * 64; i += NTHREADS) { const int rr = i >> 6, cc = (i & 63) - 16; rp[i] = rr == 15 ? -__builtin_inff() : ((cc >= 0 && cc < 31) ? rpb[h * 465 + rr * 31 + cc] * LOG2E : 0.f); } }
        __syncthreads(); }
        const int qt = F.wave & 3, rpi = F.wave >> 2;
#pragma unroll 1
        for (int st = 0; st < 2; ++st) { const int r = eighth * 8 + st * 4 + rpi * 2; const int rowqA = b * SEQ + r * 64 + 16 * qt;
            attn_unit2(KQ, VT, ATT, F.lds, b, h, rowqA, rowqA + 64, true, r, qt, F.lane); }
        if (with_ctx_queries && eighth == 0) { const int rowqA = RL + b * CTXL + 32 * F.wave; attn_unit2(KQ, VT, ATT, F.lds, b, h, rowqA, rowqA + 16, false, 0, 0, F.lane); }
    }
    __syncthreads();
}

__device__ __forceinline__ void ld8(const bf16* p, float (&x)[8]) { const u32x4 w = *(const u32x4*)p;
#pragma unroll
    for (int q = 0; q < 4; ++q) { x[2 * q] = bflo(w[q]); x[2 * q + 1] = bfhi(w[q]); } }
__device__ __forceinline__ void p_pool(Frame& F, int nrows) {
    const bf16* PB = WSP(bf16, WS_PB); bf16* POOL = WSP(bf16, WS_POOL);
    for (int i = F.bid * NTHREADS + F.tid; i < (nrows >> 4) * 64; i += F.G * NTHREADS) {
        const int row0 = (i >> 6) << 4, ch = i & 63, g = ch >> 4, hw = 1 << g;
        int base, t0, Lb; if (row0 < RL) { base = row0 & ~4095; t0 = row0 & 4095; Lb = SEQ; } else { const int rr = row0 - RL; base = RL + (rr & ~255); t0 = rr & 255; Lb = CTXL; }
        const bf16* src = PB + (size_t)base * 512 + ch * 8;
        float S[8];
#pragma unroll
        for (int q = 0; q < 8; ++q) S[q] = 0.f;
#pragma unroll 4
        for (int d = -8; d < 8; ++d) { const int tt = t0 + d; if (d >= -hw && d < hw && tt >= 0 && tt < Lb) { float x[8]; ld8(src + (size_t)tt * 512, x);
#pragma unroll
                for (int q = 0; q < 8; ++q) S[q] += x[q]; } }
#pragma unroll 2
        for (int j = 0; j < 16; ++j) { const int t = t0 + j; const int lo = max(t - hw, 0), hi = min(t + hw, Lb); const float inv = 1.0f / (float)(hi - lo);
            float me[8]; ld8(src + (size_t)t * 512, me);
            u32x4 o;
#pragma unroll
            for (int q = 0; q < 4; ++q) o[q] = pk2(S[2 * q] * inv - me[2 * q], S[2 * q + 1] * inv - me[2 * q + 1]);
            *(u32x4*)(POOL + (size_t)(base + t) * 512 + ch * 8) = o;
            if (t + hw < Lb) { float x[8]; ld8(src + (size_t)(t + hw) * 512, x);
#pragma unroll
                for (int q = 0; q < 8; ++q) S[q] += x[q]; }
            if (t - hw >= 0) { float x[8]; ld8(src + (size_t)(t - hw) * 512, x);
#pragma unroll
                for (int q = 0; q < 8; ++q) S[q] -= x[q]; } }
    }
}

__device__ __forceinline__ int block_sum_i(int v, LAS int* sm, int tid) {
    v = wave_sum_i(v);
    __syncthreads();
    if ((tid & 63) == 0) sm[tid >> 6] = v;
    __syncthreads();
    int s = 0;
#pragma unroll
    for (int i = 0; i < 8; ++i) s += sm[i];
    return s;
}
__device__ __forceinline__ int block_excl_scan(int v, LAS int* sm, int tid, int& total) {
    const int lane = tid & 63, w = tid >> 6; int inc = v;
#pragma unroll
    for (int o = 1; o < 64; o <<= 1) { const int t = __builtin_amdgcn_ds_bpermute(((lane - o) & 63) << 2, inc); if (lane >= o) inc += t; }
    __syncthreads();
    if (lane == 63) sm[w] = inc;
    __syncthreads();
    int base = 0; total = 0;
#pragma unroll
    for (int i = 0; i < 8; ++i) { const int s = sm[i]; if (i < w) base += s; total += s; }
    return base + inc - v;
}
template <int NPT>
__device__ __forceinline__ void topk_pair(Frame& F, int row0, int n, int cap, int e, int slot0) {
    LAS int* sm = (LAS int*)F.lds;
    const float* AFF = WSP(float, WS_AFF); int* SROW = WSP(int, WS_SROW); float* SG = WSP(float, WS_SGATE); int* SEL = WSP(int, WS_SEL);
    unsigned key[NPT];
#pragma unroll
    for (int j = 0; j < NPT; ++j) { const int i = F.tid * NPT + j; key[j] = (i < n) ? __float_as_uint(AFF[(size_t)(row0 + i) * 16 + e]) : 0u; }
    unsigned T = 0u;
    for (int bit = 30; bit >= 0; --bit) { const unsigned cand = T | (1u << bit); int cnt = 0;
#pragma unroll
        for (int j = 0; j < NPT; ++j) cnt += (key[j] >= cand) ? 1 : 0;
        cnt = block_sum_i(cnt, sm, F.tid);
        if (cnt >= cap) T = cand; }
    int ngt = 0, neq = 0;
#pragma unroll
    for (int j = 0; j < NPT; ++j) { ngt += (key[j] > T) ? 1 : 0; neq += (key[j] == T) ? 1 : 0; }
    int tot_gt, tot_eq;
    (void)block_excl_scan(ngt, sm, F.tid, tot_gt);
    int eqr = block_excl_scan(neq, sm, F.tid, tot_eq);
    const int need_eq = cap - tot_gt;
    int nsel = 0; bool selj[NPT];
#pragma unroll
    for (int j = 0; j < NPT; ++j) { bool s = key[j] > T; if (key[j] == T && T != 0u) { s = eqr < need_eq; ++eqr; } selj[j] = s; nsel += s ? 1 : 0; }
    int tot_sel; int pos = block_excl_scan(nsel, sm, F.tid, tot_sel);
#pragma unroll
    for (int j = 0; j < NPT; ++j) { const int i = F.tid * NPT + j;
        if (i < n) { const int row = row0 + i;
            if (selj[j]) { const int slot = slot0 + pos; ++pos; SROW[slot] = row; SG[slot] = __uint_as_float(key[j]); SEL[(size_t)row * 16 + e] = slot; }
            else SEL[(size_t)row * 16 + e] = -1; } }
    __syncthreads();
}
__device__ __forceinline__ void p_topk(Frame& F, bool with_ctx) {
    const int npairs = 128 + (with_ctx ? 128 : 0);
    for (int pi = F.bid; pi < npairs; pi += F.G) {
        if (pi < 128) { const int b = pi >> 4, e = pi & 15; topk_pair<8>(F, b * SEQ, SEQ, CAPL, e, e * SLOT_E + b * CAPL); }
        else { const int p2 = pi - 128, b = p2 >> 4, e = p2 & 15; topk_pair<1>(F, RL + b * CTXL, CTXL, CAPC, e, e * SLOT_E + 4096 + b * CAPC); }
    }
}
template <int PH> __global__ void __launch_bounds__(NTHREADS, 2) fwd_kernel(Params P) {
    extern __shared__ __attribute__((aligned(16))) unsigned char lds_raw[];
    Frame F; F.lds = (LAS unsigned char*)lds_raw; F.tid = threadIdx.x; F.lane = F.tid & 63; F.wave = __builtin_amdgcn_readfirstlane(F.tid >> 6); F.G = gridDim.x; F.bid = blockIdx.x; F.ws = P.ws;
    const int wave0 = __builtin_amdgcn_readfirstlane((int)threadIdx.x >> 6);
    volatile LAS unsigned* MISC = (volatile LAS unsigned*)(F.lds + LDS_MISC);
    if (F.tid < 64) MISC[F.tid] = 0u;
    __syncthreads();
    XcdBarrier bar; bar.bar = WSP(unsigned, WS_CTL) + CW_BAR; bar.x = 0; bar.st = MISC + 8;
    if constexpr (PH < 0) bar = xcd_barrier_post(WSP(unsigned, WS_CTL) + CW_BAR, MISC + 8);
#define IN(k) (PH < 0 || PH == (k))
#define REFRESH() do { unsigned on_ = ~0u; asm volatile("" : "+s"(on_)); int t_ = wave0 * 64 + (int)__builtin_amdgcn_mbcnt_hi(on_, __builtin_amdgcn_mbcnt_lo(on_, 0u)); asm volatile("" : "+v"(t_)); F.tid = t_; F.lane = t_ & 63; F.wave = __builtin_amdgcn_readfirstlane(t_ >> 6); } while (0)
#define SEAM(k) do { if constexpr (PH < 0) xcd_barrier(bar); } while (0)

    if (IN(0)) { REP_BEGIN(100) p_mod(P, F); p_dftgen(F); REP_END REP_BEGIN(101) p_wconv(P, F, 0); REP_END }
    SEAM(0);
    if (IN(1)) { p_rowpass_a0(P, F); }
    SEAM(1);
    for (int l = P.l_lo; l < P.l_hi; ++l) {
        constexpr int pb = 2; const bool L0 = (l == 0);
        bf16* H = WSP(bf16, WS_H);
        if (IN(pb + 0)) { REFRESH(); REP_BEGIN(2)
            const int u1 = 128 * 8 + 8 * (L0 ? 8 : 4), u2a = 128 * 2 + (L0 ? 8 * 2 : 0), u2 = u2a + 128 * 12 + (L0 ? 8 * 12 : 0), u3 = 4 * 128 + (L0 ? 4 * 8 : 0);
            const bf16* H8 = WSP(bf16, WS_H8); const bf16* WA8 = WSP(bf16, WS_WA8);
            { GroupSched S; S.init(1, 128, 8, F.G, F.bid, 8, L0 ? 8 : 4, 128, 0);
              auto AD = [=](const Unit& u) { return Operands{H8 + (size_t)u.pm * 256 * 512, WA8 + (size_t)u.pn * 256 * 512, 512, 512, 0, 512}; };
              bf16* KQ = WSP(bf16, WS_KQ);
              auto E = [=](EPI_ARGS) { const int row0 = u.pm * 256; const float qs = (u.pn >= 4) ? QSCALE * INV8 : INV8;
                  EPI_FOR8( st_bf8(KQ + (size_t)(row0 + r) * 2048 + u.pn * 256 + c, v0 * qs, v1 * qs); ) };
              GEMM_P8(S, AD, E); }
            REFRESH();
            { GroupSched S; S.init(1, 128, 2, F.G, (F.bid + F.G - ((u1 % F.G) & ~7)) % F.G, L0 ? 8 : 0, 2, 128, 0);
              const bf16* WA = WSP(bf16, WS_WA);
              auto AD = [=](const Unit& u) { return Operands{H + (size_t)u.pm * 256 * DM, WA + (size_t)(u.pn + 8) * 256 * DM, DM, DM, 0, DM}; };
              bf16* PBp = WSP(bf16, WS_PB);
              auto E = [=](EPI_ARGS) { const int row0 = u.pm * 256; EPI_FOR8( st_bf8(PBp + (size_t)(row0 + r) * 512 + u.pn * 256 + c, v0, v1); ) };
              GEMM_P(S, AD, E); }
            REFRESH();
            { GroupSched S; S.init(1, 128, 12, F.G, (F.bid + F.G - (((u1 + u2a) % F.G) & ~7)) % F.G, L0 ? 8 : 0, 12, 128, 0);
              bf16* GB = WSP(bf16, WS_GB);
              auto AD = [=](const Unit& u) { return Operands{H8 + (size_t)u.pm * 256 * 512, WA8 + (size_t)(3072 + u.pn * 256) * 512, 512, 512, 0, 512}; };
              auto E = [=](EPI_ARGS) { const int row0 = u.pm * 256;
                  EPI_FOR8( f32x4 s0; f32x4 s1; _Pragma("unroll") for (int j = 0; j < 4; ++j) { s0[j] = sigmoidf_(v0[j] * INV8); s1[j] = sigmoidf_(v1[j] * INV8); } st_bf8(GB + (size_t)(row0 + r) * 3072 + u.pn * 256 + c, s0, s1); ) };
              GEMM_P8(S, AD, E); }
            REFRESH();
            { GroupSched S; S.init(1, 4, 128, F.G, (F.bid + F.G - (((u1 + u2) % F.G) & ~7)) % F.G, L0 ? 4 : 0, 8, 0, 128);
              const bf16* WFV = WSP(bf16, WS_WFV);
              auto AD = [=](const Unit& u) { const bool fmap = (u.pn < 128); const int t16 = u.pn & 15;
                  const size_t tok0 = fmap ? (size_t)(u.pn >> 4) * SEQ + 64 * ((t16 >> 1) * 8) + (t16 & 1) * 32 : (size_t)u.pn * 256;
                  return Operands{WFV + (size_t)u.pm * 256 * DM, H + tok0 * DM, DM, DM, 0, DM, fmap ? 1 : 0}; };
              bf16* YT = WSP(bf16, WS_YT);
              auto E = [=](EPI_ARGS) { const int rr0 = u.pm * 256;
                  if (u.pn < 128) { const int b = u.pn >> 4; const int t16 = u.pn & 15, l10 = (t16 >> 1) * 8, l20 = (t16 & 1) * 32;
                      EPI_FOR8( const int fc = rr0 + r; st_bf8(YT + (((((size_t)b * 512 + (fc >> 1)) * 32 + (c >> 3)) * 2 + (l20 >> 5)) * 2 + (fc & 1)) * 64 + l10, v0, v1); ) }
                  else { const int b = u.pn - 128; EPI_FOR8( st_bf8(YT + YT_CTX_OFF + ((size_t)b * 1024 + rr0 + r) * 256 + c, v0, v1); ) } };
              GEMM_P(S, AD, E); }
            REFRESH();
            { GroupSched S; S.init(1, 4, 128, F.G, (F.bid + F.G - (((u1 + u2 + u3) % F.G) & ~7)) % F.G, 4, 8, 0, 128);
              auto AD = [=](const Unit& u) { return Operands{WA8 + (size_t)(2048 + u.pm * 256) * 512, H8 + (size_t)u.pn * 256 * 512, 512, 512, 0, 512}; };
              bf16* VT = WSP(bf16, WS_VT);
              auto E = [=](EPI_ARGS) { const int rr0 = u.pm * 256;
                  if (u.pn < 128) { const int b = u.pn >> 4, l0 = (u.pn & 15) * 256; EPI_FOR8( st_bf8(VT + ((size_t)b * 1024 + rr0 + r) * 4096 + l0 + c, v0 * INV8, v1 * INV8); ) }
                  else { const int b = u.pn - 128; EPI_FOR8( st_bf8(VT + YT_CTX_OFF + ((size_t)b * 1024 + rr0 + r) * 256 + c, v0 * INV8, v1 * INV8); ) } };
              GEMM_P8(S, AD, E); }
        REP_END }
        SEAM(pb + 0);
        if (IN(pb + 1)) { REFRESH();
            { const int nc0 = (F.G * 5 / 16) & ~7, nconv = nc0 > 0 ? nc0 : 1, na = F.G - nconv;
              if (F.bid < na) p_attn_mfma(P, F, l, L0, na, F.bid);
              else wconv_experts(P, F, l, F.bid - na, nconv); }
            REFRESH();
            REP_BEGIN(32)
            { LAS float* tw = (LAS float*)(F.lds + LDS_TW);
              for (int j = F.tid; j < 4096; j += NTHREADS) tw[j] = cospif((float)j * (1.0f / 2048.0f));
              __syncthreads();
              GroupSched S; S.init(1, 1, 512, F.G, F.bid);
              const bf16* M1 = WSP(bf16, WS_M1T); const bf16* YF = WSP(bf16, WS_YT); bf16* ZP = WSP(bf16, WS_ZP);
              auto AD = [=](const Unit& u) { return Operands{M1, YF + (size_t)u.pn * 256 * 256, 256, 256, 0, 256}; };
              auto E = [=](EPI_ARGS) {
                  const int b = u.pn >> 6, gm0 = (u.pn & 63) * 8 + wc, l20 = 32 * wr + 8 * fq;
#pragma unroll
                  for (int m = 0; m < 4; ++m) { const int k1 = 16 * m + fr;
#pragma unroll
                      for (int bj = 0; bj < 2; ++bj) { const int gm = gm0 + 4 * bj;
                          f32x4 zr[2], zi[2];
#pragma unroll
                          for (int n = 0; n < 2; ++n)
#pragma unroll
                              for (int j = 0; j < 4; ++j) { const int ix = k1 * (l20 + 4 * n + j); const float tc = tw[ix], ts = tw[(ix + 3072) & 4095];
                                  const float ur = acc[0][bj][m][n][j], ui = acc[1][bj][m][n][j]; zr[n][j] = ur * tc - ui * ts; zi[n][j] = ur * ts + ui * tc; }
                          bf16* dst = ZP + (((((size_t)b * 64 + k1) * 128 + (gm & 127)) * 4 + (gm >> 7)) * 2) * 64 + l20;
                          st_bf8(dst, zr[0], zr[1]); st_bf8(dst + 64, zi[0], zi[1]); } } };
              GEMM_P(S, AD, E); }
            REP_END
        }
        SEAM(pb + 1);
        if (IN(pb + 10)) { REFRESH();
            { GroupSched S; S.init(1, L0 ? 136 : 128, 4, F.G, F.bid);
              const bf16* A8 = WSP(bf16, WS_ATT); const bf16* W8 = WSP(bf16, WS_WAO); const bf16* GB = WSP(bf16, WS_GB); bf16* YA = WSP(bf16, WS_KQ);
              auto AD = [=](const Unit& u) { return Operands{A8 + (size_t)u.pm * 256 * 512, W8 + (size_t)u.pn * 256 * 512, 512, 512, 0, 512}; };
              auto E = [=](EPI_ARGS) { const int colb = u.pn * 256 + wc * 32 + 8 * fq;
#pragma unroll
                  for (int ai = 0; ai < 2; ++ai) { u32x4 g0[4][2];
#pragma unroll
                      for (int m = 0; m < 4; ++m)
#pragma unroll
                          for (int bj = 0; bj < 2; ++bj) g0[m][bj] = *(const u32x4*)(GB + ((size_t)u.pm * 256 + ai * 128 + wr * 64 + m * 16 + fr) * 3072 + colb + bj * 128);
#pragma unroll
                      for (int m = 0; m < 4; ++m)
#pragma unroll
                          for (int bj = 0; bj < 2; ++bj) { const u32x4 g = g0[m][bj]; const f32x4 ga = {bflo(g[0]), bfhi(g[0]), bflo(g[1]), bfhi(g[1])}, gb = {bflo(g[2]), bfhi(g[2]), bflo(g[3]), bfhi(g[3])};
                              st_bf8(YA + ((size_t)u.pm * 256 + ai * 128 + wr * 64 + m * 16 + fr) * 1024 + colb + bj * 128, acc[ai][bj][m][0] * ga * INVAT, acc[ai][bj][m][1] * gb * INVAT); } } };
              GEMM_P8(S, AD, E); }
            REFRESH();
            { GroupSched S; S.init(1, 1, 256, F.G, F.bid);
              const bf16* M2 = WSP(bf16, WS_M2T); const bf16* ZP = WSP(bf16, WS_ZP); bf16* FOUR = WSP(bf16, WS_FOUR);
              auto AD = [=](const Unit& u) { return Operands{M2, ZP + (size_t)u.pn * 256 * 512, 512, 512, 0, 512}; };
              auto E = [=](EPI_ARGS) { const float sc = 0.0013810679320049757f;
#pragma unroll
                  for (int ai = 0; ai < 2; ++ai)
#pragma unroll
                      for (int m = 0; m < 4; ++m) { const int q = 2 * ai + wr, k2 = 16 * m + fr;
#pragma unroll
                          for (int bj = 0; bj < 2; ++bj) { const int bk = u.pn * 2 + bj, b = bk >> 6, k1 = bk & 63;
                              st_bf8(FOUR + ((size_t)b * SEQ + k1 + 64 * k2) * 512 + q * 128 + wc * 32 + 8 * fq, acc[ai][bj][m][0] * sc, acc[ai][bj][m][1] * sc); } } };
              GEMM_P(S, AD, E); }
            REFRESH();
            if (L0) { GroupSched S; S.init(1, 1, 16, F.G, (F.bid + F.G - 128 % F.G) % F.G);
              const bf16* DFTC = WSP(bf16, WS_DFTC); const bf16* YTC = WSP(bf16, WS_YT) + YT_CTX_OFF; bf16* FOUR = WSP(bf16, WS_FOUR);
              auto AD = [=](const Unit& u) { return Operands{DFTC, YTC + (size_t)u.pn * 256 * 512, 512, 512, 0, 512}; };
              auto E = [=](EPI_ARGS) { const int b = u.pn >> 1, c0 = (u.pn & 1) * 256; const float sc = 0.005524271728019903f;
                  EPI_FOR8( st_bf8(FOUR + ((size_t)RL + b * CTXL + r) * 512 + c0 + c, v0 * sc, v1 * sc); ) };
              GEMM_P(S, AD, E); }
            REFRESH();
            REP_BEGIN(33) p_pool(F, L0 ? RT : RL); REP_END
        }
        SEAM(pb + 10);
        if (IN(pb + 2)) { REFRESH();
            SegSched<2> S; S.base.init(1, L0 ? 136 : 128, 4, F.G, F.bid);
            const bf16* FOUR = WSP(bf16, WS_FOUR); const bf16* POOL = WSP(bf16, WS_POOL); const bf16* WFO = WSP(bf16, WS_WFO); const bf16* WPO = WSP(bf16, WS_WPO);
            const bf16* GB = WSP(bf16, WS_GB); const bf16* YA = WSP(bf16, WS_KQ); bf16* MRGB = WSP(bf16, WS_MRGB); const float* ps = P.pool_scale + l * 1024;
            auto AD = [=](const Unit& u) {
                if (u.seg == 0) return Operands{FOUR + (size_t)u.pm * 256 * 512, WFO + (size_t)u.pn * 256 * 512, 512, 512, 0, 512};
                return Operands{POOL + (size_t)u.pm * 256 * 512 + (u.pn >> 1) * 256, WPO + (size_t)u.pn * 256 * 256, 512, 256, 0, 256}; };
            auto E = [=](EPI_ARGS) {
                const bool fin = (u.seg == 1); const int colb = u.pn * 256 + wc * 32 + 8 * fq;
                f32x4 psv[2][2];
#pragma unroll
                for (int bj = 0; bj < 2; ++bj)
#pragma unroll
                    for (int n = 0; n < 2; ++n) { f32x4 p = *(const f32x4*)(ps + colb + bj * 128 + 4 * n);
#pragma unroll
                        for (int j = 0; j < 4; ++j) p[j] = (fabsf(p[j]) < 1e-18f) ? copysignf(1e-18f, p[j]) : p[j];
                        psv[bj][n] = p; }
#pragma unroll
                for (int ai = 0; ai < 2; ++ai)
#pragma unroll
                    for (int m = 0; m < 4; ++m) { const size_t row = (size_t)u.pm * 256 + ai * 128 + wr * 64 + m * 16 + fr; const bf16* gr = GB + row * 3072 + colb;
                        u32x4 g1r[2], g2r[2], yar[2];
#pragma unroll
                        for (int bj = 0; bj < 2; ++bj) { g2r[bj] = *(const u32x4*)(gr + 2048 + bj * 128); if (fin) yar[bj] = *(const u32x4*)(YA + row * 1024 + colb + bj * 128); else g1r[bj] = *(const u32x4*)(gr + 1024 + bj * 128); }
#pragma unroll
                        for (int bj = 0; bj < 2; ++bj) { f32x4 o[2];
#pragma unroll
                            for (int n = 0; n < 2; ++n) { const u32x4 xr = fin ? yar[bj] : g1r[bj];
                                const f32x4 g2 = (f32x4){fmaxf(bflo(g2r[bj][2 * n]), 1e-18f), fmaxf(bfhi(g2r[bj][2 * n]), 1e-18f), fmaxf(bflo(g2r[bj][2 * n + 1]), 1e-18f), fmaxf(bfhi(g2r[bj][2 * n + 1]), 1e-18f)} * psv[bj][n];
                                const f32x4 x = {bflo(xr[2 * n]), bfhi(xr[2 * n]), bflo(xr[2 * n + 1]), bfhi(xr[2 * n + 1])};
#pragma unroll
                                for (int j = 0; j < 4; ++j) o[n][j] = fin ? (x[j] + acc[ai][bj][m][n][j] * g2[j]) : (acc[ai][bj][m][n][j] * x[j] * __builtin_amdgcn_rcpf(g2[j]));
                                acc[ai][bj][m][n] = o[n]; }
                            if (fin) st_bf8(MRGB + row * 1024 + colb + bj * 128, o[0], o[1]); } } };
            gemm_fast<false, true, false>(F.lds, F.tid, S, AD, mk_epi_seg(E, 1), nullptr);
        }
        SEAM(pb + 2);
        if (IN(pb + 3)) { REFRESH();
            GroupSched S; S.init(1, L0 ? 136 : 128, 4, F.G, F.bid); const bf16* A = WSP(bf16, WS_MRGB); const bf16* W = WSP(bf16, WS_WOUT);
            const float* xin = L0 ? P.x : P.out; const float* cin = L0 ? P.ctx : WSP(float, WS_XC); float* xo = P.out; float* co = WSP(float, WS_XC);
            const float* MOD = WSP(float, WS_MOD) + (size_t)l * 9 * 6144;
            auto AD = [=](const Unit& u) { return Operands{A + (size_t)u.pm * 256 * 1024, W + (size_t)u.pn * 256 * 1024, 1024, 1024, 0, 1024}; };
            auto E = [=](EPI_ARGS) {
                const int row0 = u.pm * 256, mr = row0 < RL ? (row0 >> 12) : 8, colb = u.pn * 256 + wc * 32 + 4 * fq;
                const float* src0 = row0 < RL ? xin + (size_t)row0 * DM : cin + (size_t)(row0 - RL) * DM; float* dst0 = row0 < RL ? xo + (size_t)row0 * DM : co + (size_t)(row0 - RL) * DM;
                f32x4 gv[2][2];
#pragma unroll
                for (int bj = 0; bj < 2; ++bj)
#pragma unroll
                    for (int n = 0; n < 2; ++n) gv[bj][n] = *(const f32x4*)(MOD + (size_t)mr * 6144 + 2048 + colb + bj * 128 + n * 16);
#pragma unroll
                for (int ai = 0; ai < 2; ++ai) { f32x4 xv[4][2][2];
#pragma unroll
                    for (int m = 0; m < 4; ++m) { const size_t ro = (size_t)(ai * 128 + wr * 64 + m * 16 + fr) * DM + colb;
#pragma unroll
                        for (int bj = 0; bj < 2; ++bj)
#pragma unroll
                            for (int n = 0; n < 2; ++n) xv[m][bj][n] = *(const f32x4*)(src0 + ro + bj * 128 + n * 16); }
#pragma unroll
                    for (int m = 0; m < 4; ++m) { const size_t ro = (size_t)(ai * 128 + wr * 64 + m * 16 + fr) * DM + colb;
#pragma unroll
                        for (int bj = 0; bj < 2; ++bj)
#pragma unroll
                            for (int n = 0; n < 2; ++n) *(f32x4*)(dst0 + ro + bj * 128 + n * 16) = xv[m][bj][n] + gv[bj][n] * acc[ai][bj][m][n]; } } };
            GEMM(S, AD, E, 1024, 1024, 1024);
        }
        SEAM(pb + 3);
        if (IN(pb + 4)) { REFRESH(); REP_BEGIN(6) p_rowpass_f(P, F, l, L0 ? RT : RL); REP_END }
        SEAM(pb + 4);
        if (IN(pb + 5)) { REFRESH(); REP_BEGIN(7) p_topk(F, L0); REP_END }
        SEAM(pb + 5);
        if (IN(pb + 7)) { REFRESH(); REP_BEGIN(9)
            GroupSched S; S.init(16, L0 ? 17 : 16, 22, F.G, F.bid); const bf16* H8 = WSP(bf16, WS_H8); const bf16* W = WSP(bf16, WS_WGU); unsigned char* HID = WSP(unsigned char, WS_HID); const int* SROW = WSP(int, WS_SROW);
            auto AD = [=](const Unit& u) { return Operands{H8, W + ((size_t)u.grp * 5632 + u.pn * 256) * 512, 512, 512, u.grp * SLOT_E + u.pm * 256, 512}; };
            auto E = [=](EPI_ARGS) {
#pragma unroll
                for (int ai = 0; ai < 2; ++ai)
#pragma unroll
                    for (int m = 0; m < 4; ++m) { const size_t slot = (size_t)u.grp * SLOT_E + u.pm * 256 + ai * 128 + wr * 64 + m * 16 + fr; f32x4 o[2];
#pragma unroll
                        for (int n = 0; n < 2; ++n) { const f32x4 a = acc[ai][0][m][n] * INV8, up = acc[ai][1][m][n] * (INV8 * A8S);
#pragma unroll
                            for (int j = 0; j < 4; ++j) o[n][j] = a[j] * sigmoidf_(a[j]) * up[j]; }
                        u32x2 w; w.x = pk4_fp8(o[0][0], o[0][1], o[0][2], o[0][3]); w.y = pk4_fp8(o[1][0], o[1][1], o[1][2], o[1][3]);
                        *(u32x2*)(HID + slot * FF + u.pn * 128 + wc * 32 + 8 * fq) = w; } };
            GEMM_GATHER8(S, AD, E, SROW);
        REP_END }
        SEAM(pb + 7);
        if (IN(pb + 8)) { REFRESH(); REP_BEGIN(10)
            const int tpe = L0 ? 17 : 16;
            GroupSched S; S.init(1, 16 * tpe, 4, F.G, F.bid); const bf16* HID = WSP(bf16, WS_HID); const bf16* W = WSP(bf16, WS_WD); bf16* Y = WSP(bf16, WS_Y); const float* SG = WSP(float, WS_SGATE);
            auto AD = [=](const Unit& u) { const int e = u.pm / tpe, st = e * 17 + (u.pm - e * tpe); return Operands{HID + (size_t)st * 256 * (FF / 2), W + ((size_t)e * 1024 + u.pn * 256) * (FF / 2), FF / 2, FF / 2, 0, FF / 2}; };
            auto E = [=](EPI_ARGS) { const int e = u.pm / tpe; const size_t slot0 = (size_t)(e * 17 + (u.pm - e * tpe)) * 256 + wr * 64 + fr; float gt[2][4];
#pragma unroll
                for (int ai = 0; ai < 2; ++ai)
#pragma unroll
                    for (int m = 0; m < 4; ++m) gt[ai][m] = SG[slot0 + ai * 128 + m * 16] * INV8;
#pragma unroll
                for (int ai = 0; ai < 2; ++ai)
#pragma unroll
                    for (int m = 0; m < 4; ++m)
#pragma unroll
                        for (int bj = 0; bj < 2; ++bj) st_bf8(Y + (slot0 + ai * 128 + m * 16) * DM + u.pn * 256 + bj * 128 + wc * 32 + 8 * fq, acc[ai][bj][m][0] * gt[ai][m], acc[ai][bj][m][1] * gt[ai][m]); };
            GEMM_P8(S, AD, E);
        REP_END }
        SEAM(pb + 8);
        if (IN(pb + 9)) { REFRESH(); p_rowpass_k(P, F, l, L0 ? RT : RL); if (L0) p_wconv(P, F, 1); }
        if (L0) SEAM(pb + 9);
    }
#undef IN
#undef SEAM
}
template <int PH> static void launch_ph(int grid, const Params& p, hipStream_t stream) { hipLaunchKernelGGL(fwd_kernel<PH>, dim3(grid), dim3(NTHREADS), LDS_BYTES, stream, p); }
template <int PH> static bool set_attr() { return hipFuncSetAttribute((const void*)fwd_kernel<PH>, hipFuncAttributeMaxDynamicSharedMemorySize, LDS_BYTES) == hipSuccess; }

#ifndef DUP_LAUNCH
#define DUP_LAUNCH -1
#endif
extern "C" void kernel_launch(void* const* d_in, const int* in_sizes, int n_in, void* d_out, int out_size, void* d_ws, size_t ws_size, hipStream_t stream) {
    static int grid = 0;
    if (grid == 0) {
        if (n_in != 20 || out_size != RL * DM || ws_size < WS_END) { fprintf(stderr, "kernel_launch: unexpected shapes (n_in %d out %d ws %zu need %zu)\n", n_in, out_size, ws_size, (size_t)WS_END); grid = -1; return; }
        int dev = 0, cus = 0, per_cu = 0;
        if (hipGetDevice(&dev) != hipSuccess || hipDeviceGetAttribute(&cus, hipDeviceAttributeMultiprocessorCount, dev) != hipSuccess) { grid = -1; return; }
#if N_LAUNCH_MODE == 1
        if (!set_attr<-1>()) { fprintf(stderr, "kernel_launch: hipFuncSetAttribute failed\n"); grid = -1; return; }
        if (hipOccupancyMaxActiveBlocksPerMultiprocessor(&per_cu, (const void*)fwd_kernel<-1>, NTHREADS, LDS_BYTES) != hipSuccess || per_cu < 1) fprintf(stderr, "kernel_launch: occupancy query reports %d\n", per_cu);
#else
        if (!(set_attr<0>() && set_attr<1>() && set_attr<2>() && set_attr<3>() && set_attr<12>() && set_attr<4>() && set_attr<5>() && set_attr<6>() && set_attr<7>() && set_attr<9>() && set_attr<10>() && set_attr<11>())) { fprintf(stderr, "kernel_launch: hipFuncSetAttribute failed\n"); grid = -1; return; }
        (void)per_cu;
#endif
        (void)hipGetLastError();
        grid = cus;
    }
    if (grid < 0) return;
    if (hipMemsetAsync((char*)d_ws + WS_CTL, 0, CTL_BYTES, stream) != hipSuccess) return;
    Params p{};
    const float** pp = (const float**)&p;
    for (int i = 0; i < 20; ++i) pp[i] = (const float*)d_in[i];
    p.out = (float*)d_out; p.ws = (unsigned char*)d_ws;
#if N_LAUNCH_MODE == 1
    p.l_lo = 0; p.l_hi = 2;
    launch_ph<-1>(grid, p, stream);
#else
    p.l_lo = 0; p.l_hi = 0; launch_ph<0>(grid, p, stream); if (DUP_LAUNCH == 0) launch_ph<0>(grid, p, stream); launch_ph<1>(grid, p, stream); if (DUP_LAUNCH == 1) launch_ph<1>(grid, p, stream);
#define LP(k) do { launch_ph<k>(grid, p, stream); if (DUP_LAUNCH == (k) && l == 0) launch_ph<k>(grid, p, stream); } while (0)
    for (int l = 0; l < 2; ++l) { p.l_lo = l; p.l_hi = l + 1;
        LP(2); LP(3); LP(12); LP(4); LP(5); LP(6); LP(7); LP(9); LP(10); LP(11); }
#endif
}
```

```cpp
#include <hip/hip_runtime.h>
#include <cstdio>
#include <cstdint>

#ifndef N_LAUNCH_MODE
#define N_LAUNCH_MODE 1
#endif

#define GAS __attribute__((address_space(1)))
#define LAS __attribute__((address_space(3)))
typedef unsigned short bf16;
typedef short bf16x8 __attribute__((ext_vector_type(8)));
typedef float f32x4 __attribute__((ext_vector_type(4)));
typedef unsigned u32x4 __attribute__((ext_vector_type(4)));
typedef unsigned u32x2 __attribute__((ext_vector_type(2)));

constexpr int NB = 8, SEQ = 4096, DM = 1024, CTXL = 256, NH = 16, HD = 64, GRIDW = 64;
constexpr int RL = NB * SEQ, RC = NB * CTXL, RT = RL + RC;
constexpr int INW = 7168, NE = 16, FF = 2816, CAPL = 512, CAPC = 32;
constexpr int SLOT_E = 4352, NSLOT = NE * SLOT_E;
constexpr float RMS_EPS = 1e-6f;
constexpr float LOG2E = 1.4426950408889634f, QSCALE = 0.125f * LOG2E;
constexpr float A8S = 8.0f, W8S = 64.0f, INV8 = 1.0f / (A8S * W8S);
constexpr float ATS = 32.0f, INVAT = 1.0f / (ATS * W8S);
constexpr int NWAVES = 8, NTHREADS = 512;

constexpr size_t al256(size_t x) { return (x + 255) & ~(size_t)255; }
constexpr size_t WS_CTL = 0, CTL_BYTES = 1u << 20;
constexpr size_t WS_MOD = WS_CTL + CTL_BYTES;
constexpr size_t WS_XC = al256(WS_MOD + (size_t)2 * 9 * 6144 * 4);
constexpr size_t WS_AFF = al256(WS_XC + (size_t)RC * DM * 4);
constexpr size_t WS_SROW = al256(WS_AFF + (size_t)RT * 16 * 4);
constexpr size_t WS_SGATE = al256(WS_SROW + (size_t)NSLOT * 4);
constexpr size_t WS_SEL = al256(WS_SGATE + (size_t)NSLOT * 4);
constexpr size_t WS_DFTM = al256(WS_SEL + (size_t)RT * 16 * 4);
constexpr size_t WS_DFTC = al256(WS_DFTM + (size_t)4096 * 8192 * 2);
constexpr size_t WS_WA = al256(WS_DFTC + (size_t)256 * 512 * 2);
constexpr size_t WS_WFV = al256(WS_WA + (size_t)5632 * 1024 * 2);
constexpr size_t WS_WAO = al256(WS_WFV + (size_t)2048 * 1024 * 2);
constexpr size_t WS_WFO = al256(WS_WAO + (size_t)1024 * 1024 * 2);
constexpr size_t WS_WPO = al256(WS_WFO + (size_t)1024 * 512 * 2);
constexpr size_t WS_WOUT = al256(WS_WPO + (size_t)1024 * 256 * 2);
constexpr size_t WS_WGU = al256(WS_WOUT + (size_t)1024 * 1024 * 2);
constexpr size_t WS_WD = al256(WS_WGU + (size_t)16 * 5632 * 1024);
constexpr size_t WS_WA8 = al256(WS_WD + (size_t)16 * 1024 * 2816);
constexpr size_t WS_H = al256(WS_WA8 + (size_t)6144 * 1024);
constexpr size_t WS_H8 = al256(WS_H + (size_t)RT * DM * 2);
constexpr size_t WS_R = al256(WS_H8 + (size_t)RT * DM);
constexpr size_t WS_KQ = WS_R;
constexpr size_t WS_MRG = WS_KQ;
constexpr size_t WS_PB = al256(WS_KQ + (size_t)RT * 2048 * 2);
constexpr size_t WS_GB = al256(WS_PB + (size_t)RT * 512 * 2);
constexpr size_t WS_YT = al256(WS_GB + (size_t)RT * 3072 * 2);
constexpr size_t WS_MRGB = WS_YT;
constexpr size_t WS_VT = al256(WS_YT + (size_t)RT * 1024 * 2);
constexpr size_t WS_FOUR = al256(WS_VT + (size_t)RT * 1024 * 2);
constexpr size_t WS_ATT = al256(WS_FOUR + (size_t)RT * 512 * 2);
constexpr size_t WS_POOL = al256(WS_ATT + (size_t)RT * 1024 * 2);
constexpr size_t WS_MIX_END = al256(WS_POOL + (size_t)RT * 512 * 2);
constexpr size_t WS_XG = WS_R;
constexpr size_t WS_HID = al256(WS_XG + (size_t)NSLOT * 1024 * 2);
constexpr size_t WS_Y = al256(WS_HID + (size_t)NSLOT * 2816);
constexpr size_t WS_MOE_END = al256(WS_Y + (size_t)NSLOT * 1024 * 2);
constexpr size_t WS_END0 = WS_MIX_END > WS_MOE_END ? WS_MIX_END : WS_MOE_END;
constexpr size_t WS_ZP = WS_END0;
constexpr size_t WS_M1T = al256(WS_ZP + ((size_t)8 * 64 * 512 * 128 + 1024) * 2);
constexpr size_t WS_M2T = al256(WS_M1T + (size_t)256 * 256 * 2);
constexpr size_t WS_XB = al256(WS_M2T + (size_t)256 * 512 * 2);
constexpr size_t WS_END = al256(WS_XB + (size_t)RT * DM * 2);
constexpr size_t YT_CTX_OFF = (size_t)8 * 1024 * 4096;

constexpr int CW_BAR = 4096;

constexpr int LDS_BYTES = 155648;
constexpr int LDS_TW = 132096;
constexpr int LDS_MISC = 131072;

__device__ __forceinline__ unsigned f2bf(float f) { unsigned u = __float_as_uint(f); return (u + 0x7fffu + ((u >> 16) & 1u)) >> 16; }
typedef __bf16 hbf16x2 __attribute__((ext_vector_type(2)));
typedef float f32x2 __attribute__((ext_vector_type(2)));
__device__ __forceinline__ unsigned pk2(float lo, float hi) { const f32x2 v = {lo, hi}; return __builtin_bit_cast(unsigned, __builtin_convertvector(v, hbf16x2)); }
__device__ __forceinline__ unsigned pk4_fp8(float a, float b, float c, float d) {
    a = __builtin_amdgcn_fmed3f(a, -448.f, 448.f); b = __builtin_amdgcn_fmed3f(b, -448.f, 448.f); c = __builtin_amdgcn_fmed3f(c, -448.f, 448.f); d = __builtin_amdgcn_fmed3f(d, -448.f, 448.f);
    int w = 0; w = __builtin_amdgcn_cvt_pk_fp8_f32(a, b, w, false); w = __builtin_amdgcn_cvt_pk_fp8_f32(c, d, w, true); return (unsigned)w; }
__device__ __forceinline__ float bf2f(unsigned b) { return __uint_as_float(b << 16); }
__device__ __forceinline__ float bflo(unsigned w) { return __uint_as_float(w << 16); }
__device__ __forceinline__ float bfhi(unsigned w) { return __uint_as_float(w & 0xffff0000u); }
template <int CTRL> __device__ __forceinline__ float dppf(float x) { return __builtin_bit_cast(float, __builtin_amdgcn_mov_dpp(__builtin_bit_cast(int, x), CTRL, 0xf, 0xf, true)); }
template <int CTRL> __device__ __forceinline__ int dppi(int x) { return __builtin_amdgcn_mov_dpp(x, CTRL, 0xf, 0xf, true); }
constexpr int DPP_XOR1 = 0xB1, DPP_XOR2 = 0x4E, DPP_ROR4 = 0x124, DPP_ROR8 = 0x128;
__device__ __forceinline__ float wave_sum(float v) {
    v += dppf<DPP_XOR1>(v); v += dppf<DPP_XOR2>(v); v += dppf<DPP_ROR4>(v); v += dppf<DPP_ROR8>(v);
    auto s = __builtin_amdgcn_permlane16_swap(__float_as_uint(v), __float_as_uint(v), false, false); v = __uint_as_float(s[0]) + __uint_as_float(s[1]);
    auto t = __builtin_amdgcn_permlane32_swap(__float_as_uint(v), __float_as_uint(v), false, false); return __uint_as_float(t[0]) + __uint_as_float(t[1]);
}
__device__ __forceinline__ float wave_max(float v) {
    v = fmaxf(v, dppf<DPP_XOR1>(v)); v = fmaxf(v, dppf<DPP_XOR2>(v)); v = fmaxf(v, dppf<DPP_ROR4>(v)); v = fmaxf(v, dppf<DPP_ROR8>(v));
    auto s = __builtin_amdgcn_permlane16_swap(__float_as_uint(v), __float_as_uint(v), false, false); v = fmaxf(__uint_as_float(s[0]), __uint_as_float(s[1]));
    auto t = __builtin_amdgcn_permlane32_swap(__float_as_uint(v), __float_as_uint(v), false, false); return fmaxf(__uint_as_float(t[0]), __uint_as_float(t[1]));
}
__device__ __forceinline__ int wave_sum_i(int v) {
    v += dppi<DPP_XOR1>(v); v += dppi<DPP_XOR2>(v); v += dppi<DPP_ROR4>(v); v += dppi<DPP_ROR8>(v);
    auto s = __builtin_amdgcn_permlane16_swap((unsigned)v, (unsigned)v, false, false); v = (int)(s[0] + s[1]);
    auto t = __builtin_amdgcn_permlane32_swap((unsigned)v, (unsigned)v, false, false); return (int)(t[0] + t[1]);
}
__device__ __forceinline__ float sigmoidf_(float x) { return __builtin_amdgcn_rcpf(1.f + __builtin_amdgcn_exp2f(x * -1.4426950408889634f)); }
#define LDS_WAIT() asm volatile("s_waitcnt lgkmcnt(0)" ::: "memory")

#define XB_TMO      128
#define XB_XCNT(j)  (256  + 64 * (j))
#define XB_XSUB(j)  (1280 + 64 * (j))
#define XB_XGEN(j)  (2304 + 64 * (j))
#define XB_TOP      3328
#define XB_TOPGEN   3392
#define XCD_BAR_WORDS 3456
#define XB_SPIN_CAP (1u << 22)

__device__ __forceinline__ unsigned xb_ld(unsigned* p)              { return __hip_atomic_load(p, __ATOMIC_RELAXED, __HIP_MEMORY_SCOPE_AGENT); }
__device__ __forceinline__ unsigned xb_add(unsigned* p, unsigned v) { return __hip_atomic_fetch_add(p, v, __ATOMIC_RELAXED, __HIP_MEMORY_SCOPE_AGENT); }
__device__ __forceinline__ unsigned xb_xcc_id() { return (unsigned)__builtin_amdgcn_s_getreg((3 << 11) | 20) & 0xFu; }
#define XB_SPIN(cond, bar) do { unsigned _sp = 0; while (cond) { __builtin_amdgcn_s_sleep(1); \
    if ((++_sp & 255u) == 0u) { if (xb_ld(&(bar)[XB_TMO])) break; if (_sp > XB_SPIN_CAP) { atomicAdd(&(bar)[XB_TMO], 1u); break; } } } } while (0)

struct XcdBarrier { unsigned* bar; unsigned x; volatile LAS unsigned* st; };

__device__ __forceinline__ XcdBarrier xcd_barrier_post(unsigned* bar, volatile LAS unsigned* st) {
    XcdBarrier b; b.bar = bar; b.x = xb_xcc_id(); b.st = st;
    if (threadIdx.x == 0) (void)xb_add(&bar[XB_XCNT(b.x)], 1u);
    return b;
}
__device__ __forceinline__ void xcd_barrier_complete(unsigned* bar, unsigned x, unsigned& nloc, unsigned& nx) {
    const unsigned G = gridDim.x * gridDim.y * gridDim.z;
    unsigned sum, cnt, mine, sp = 0u;
    for (;;) {
        sum = 0u; cnt = 0u; mine = 0u;
#pragma unroll
        for (unsigned j = 0; j < 16; ++j) { const unsigned c = xb_ld(&bar[XB_XCNT(j)]); sum += c; cnt += (c > 0u) ? 1u : 0u; mine = (j == x) ? c : mine; }
        if (sum == G) break;
        __builtin_amdgcn_s_sleep(1);
        if ((++sp & 255u) == 0u) { if (xb_ld(&bar[XB_TMO])) break; if (sp > XB_SPIN_CAP) { atomicAdd(&bar[XB_TMO], 1u); break; } }
    }
    nloc = mine > 0u ? mine : 1u; nx = cnt > 0u ? cnt : 1u;
}
__device__ __forceinline__ void xcd_barrier(const XcdBarrier& b) {
    asm volatile("s_waitcnt vmcnt(0)" ::: "memory");
    __syncthreads();
    if (threadIdx.x == 0) {
        unsigned* bar = b.bar;
        __builtin_amdgcn_s_waitcnt(0);
        unsigned nloc = b.st[0], nx = b.st[1];
        if (nloc == 0u) { xcd_barrier_complete(bar, b.x, nloc, nx); b.st[0] = nloc; b.st[1] = nx; }
        const unsigned old = xb_add(&bar[XB_XSUB(b.x)], 1u);
        const unsigned gen = old / nloc;
        if (old + 1u == (gen + 1u) * nloc) {
            __builtin_amdgcn_fence(__ATOMIC_RELEASE, "agent");
            asm volatile("s_waitcnt vmcnt(0)" ::: "memory");
            const unsigned og = xb_add(&bar[XB_TOP], 1u);
            const unsigned tg = og / nx;
            if (og + 1u == (tg + 1u) * nx) xb_add(&bar[XB_TOPGEN], 1u);
            else XB_SPIN(xb_ld(&bar[XB_TOPGEN]) == tg, bar);
            __builtin_amdgcn_fence(__ATOMIC_ACQUIRE, "agent");
            xb_add(&bar[XB_XGEN(b.x)], 1u);
            asm volatile("s_waitcnt vmcnt(0)" ::: "memory");
        } else {
            XB_SPIN(xb_ld(&bar[XB_XGEN(b.x)]) == gen, bar);
            __builtin_amdgcn_fence(__ATOMIC_ACQUIRE, "agent");
            asm volatile("s_waitcnt vmcnt(0)" ::: "memory");
        }
    }
    __syncthreads();
}

struct Params {
    const float *x, *c, *ctx, *c_ctx, *ada_w, *ada_b, *norm1_g, *norm2_g, *w_in, *rpb, *w_att_o, *w_fourier, *w_pool, *pool_scale, *w_out, *w_router, *w_eg, *w_eu, *w_ed, *final_g;
    float* out; unsigned char* ws; int l_lo, l_hi;
};
struct Frame {
    LAS unsigned char* lds;
    int tid, lane, wave, G, bid;
    unsigned char* ws;
};
#define WSP(T, off) ((T*)(F.ws + (off)))

struct Unit { int grp, pm, pn, seg; };
struct GroupSched {
    int ng, nM, nN, G, c; int tM, tN, tpm0, tpn0;
    __device__ __forceinline__ void init(int ng_, int nM_, int nN_, int G_, int c_, int tM_ = 0, int tN_ = 0, int tpm0_ = 0, int tpn0_ = 0) { ng = ng_; nM = nM_; nN = nN_; G = G_; c = c_; tM = tM_; tN = tN_; tpm0 = tpm0_; tpn0 = tpn0_; }
    __device__ __forceinline__ bool next(int i, Unit& u) const {
        const int per = nM * nN; const int L = i * G + c;
        if (L < ng * per) {
            u.grp = L / per; int wgid = L - u.grp * per;
            { const int q = per / 8, r = per % 8, xcd = wgid % 8, off = wgid / 8; wgid = (xcd < r ? xcd * (q + 1) : r * (q + 1) + (xcd - r) * q) + off; }
            const int nig = 8 * nN, gid = wgid / nig, fm = gid * 8, gsz = (nM - fm) < 8 ? (nM - fm) : 8;
            u.pm = fm + ((wgid % nig) % gsz); u.pn = (wgid % nig) / gsz; u.seg = 0; return true;
        }
        const int w = L - ng * per;
        if (w < tM * tN) { u.grp = ng; u.pm = tpm0 + (w % tM); u.pn = tpn0 + (w / tM); u.seg = 0; return true; }
        return false;
    }
};
struct Operands { const bf16* A; const bf16* Bt; int lda, ldb, slot0, K; int bmap; };

constexpr int HTB = 128 * 64 * 2;
__device__ __forceinline__ int lds_byte(int r, int c) { const int st = (r >> 4) * 2 + (c >> 5), rr = r & 15, cc = c & 31, ob = rr * 64 + cc * 2; return st * 1024 + (ob ^ (((ob >> 9) & 1) << 5)); }
__device__ __forceinline__ int perm32(int rho) { const int n = rho >> 4, i = rho & 15; return 8 * (i >> 2) + 4 * n + (i & 3); }
__device__ __forceinline__ void stage_rc(int b, int& R, int& C) { const int st = b / 1024, sb = b % 1024, swz = sb ^ (((sb >> 9) & 1) << 5); R = (st >> 1) * 16 + swz / 64; C = (st & 1) * 32 + (swz % 64) / 2; }
typedef int i32x8 __attribute__((ext_vector_type(8)));
typedef int i32x4 __attribute__((ext_vector_type(4)));
__device__ __forceinline__ i32x8 cat8(bf16x8 lo, bf16x8 hi) { const i32x4 a = __builtin_bit_cast(i32x4, lo), b = __builtin_bit_cast(i32x4, hi); return (i32x8){a[0], a[1], a[2], a[3], b[0], b[1], b[2], b[3]}; }
template <bool GATHER, bool PERM, bool FP8, class Sched, class Addr, class Epi>
__device__ __forceinline__ void gemm_fast(LAS unsigned char* lds, const int tid, const Sched& S, const Addr& AD, const Epi& E, const int* __restrict__ grows) {
    const int wid = __builtin_amdgcn_readfirstlane(tid >> 6), lane = tid & 63, wr = wid >> 2, wc = wid & 3, fr = lane & 15, fq = lane >> 4;
    unsigned cvg[2][2], nvg[2][2], cvb[2][2], nvb[2][2];
#define PG8_RC(i_) int R_, C_; stage_rc(tid * 16 + (i_) * 8192, R_, C_); const int sR_ = R_; const unsigned sC_ = (unsigned)C_ * 2u; const int sRb_ = PERM ? ((R_ & ~31) + perm32(R_ & 31)) : R_; (void)sR_; (void)sRb_; (void)sC_
    const size_t kstep = 128;
    const unsigned ldsw = (unsigned)wid * 1024u;
    const int aoff = lds_byte(wr * 64 + fr, fq * 8), boff = lds_byte(wc * 32 + fr, fq * 8);
#define PG8_SA(b, h) (((b) * 2 + (h)) * HTB)
#define PG8_SB(b, h) ((4 + (b) * 2 + (h)) * HTB)
#define PG8_STAGE(bufoff, gbase, voff) do { _Pragma("unroll") for (int _i = 0; _i < 2; ++_i) \
        __builtin_amdgcn_global_load_lds((const unsigned*)((const char*)(gbase) + (voff)[_i]), (LAS unsigned*)(lds + (bufoff) + ldsw + _i * 8192), 16, 0, 0); } while (0)
#define PG8_LDA(dst, b, h) do { if constexpr (FP8) { _Pragma("unroll") for (int m = 0; m < 4; ++m) dst##8[m] = cat8(*(const LAS bf16x8*)(lds + PG8_SA(b, h) + aoff + m * 2048), *(const LAS bf16x8*)(lds + PG8_SA(b, h) + aoff + m * 2048 + 1024)); } \
        else { _Pragma("unroll") for (int m = 0; m < 4; ++m) _Pragma("unroll") for (int k = 0; k < 2; ++k) dst[m][k] = *(const LAS bf16x8*)(lds + PG8_SA(b, h) + aoff + m * 2048 + k * 1024); } } while (0)
#define PG8_LDB(dst, b, h) do { if constexpr (FP8) { _Pragma("unroll") for (int n = 0; n < 2; ++n) dst##8[n] = cat8(*(const LAS bf16x8*)(lds + PG8_SB(b, h) + boff + n * 2048), *(const LAS bf16x8*)(lds + PG8_SB(b, h) + boff + n * 2048 + 1024)); } \
        else { _Pragma("unroll") for (int n = 0; n < 2; ++n) _Pragma("unroll") for (int k = 0; k < 2; ++k) dst[n][k] = *(const LAS bf16x8*)(lds + PG8_SB(b, h) + boff + n * 2048 + k * 1024); } } while (0)
#define PG8_MMA(ai, bj, At, Bt) do { __builtin_amdgcn_s_setprio(1); \
        if constexpr (FP8) { _Pragma("unroll") for (int m = 0; m < 4; ++m) _Pragma("unroll") for (int n = 0; n < 2; ++n)   \
            asm volatile("v_mfma_scale_f32_16x16x128_f8f6f4 %0, %1, %2, %0, %3, %3 op_sel_hi:[0,0,0]" : "+v"(acc[ai][bj][m][n]) : "v"(Bt##8[n]), "v"(At##8[m]), "v"(one_scale)); } \
        else { _Pragma("unroll") for (int m = 0; m < 4; ++m) _Pragma("unroll") for (int n = 0; n < 2; ++n) _Pragma("unroll") for (int k = 0; k < 2; ++k) \
            acc[ai][bj][m][n] = __builtin_amdgcn_mfma_f32_16x16x32_bf16(Bt[n][k], At[m][k], acc[ai][bj][m][n], 0, 0, 0); } \
        __builtin_amdgcn_s_setprio(0); } while (0)
#define PG8_WAIT_V(n) asm volatile("s_waitcnt vmcnt(" #n ")" ::: "memory")
#define PG8_WAIT_L(n) asm volatile("s_waitcnt lgkmcnt(" #n ")" ::: "memory")
#define PG8_BAR __builtin_amdgcn_s_barrier()
#define PG8_SCHED __builtin_amdgcn_sched_barrier(0)
#define PG8_GIDX(dst, op_) do { _Pragma("unroll") for (int i_ = 0; i_ < 2; ++i_) { PG8_RC(i_); _Pragma("unroll") for (int h_ = 0; h_ < 2; ++h_) dst[h_][i_] = (unsigned)grows[(op_).slot0 + h_ * 128 + sR_] * (unsigned)((op_).lda * 2) + sC_; } } while (0)
#define PG8_AOFF(dst, op_) do { _Pragma("unroll") for (int i_ = 0; i_ < 2; ++i_) { PG8_RC(i_); _Pragma("unroll") for (int h_ = 0; h_ < 2; ++h_) dst[h_][i_] = (unsigned)((sR_ + 128 * h_) * (op_).lda) * 2u + sC_; } } while (0)
#define PG8_BOFF(dst, op_) do { _Pragma("unroll") for (int i_ = 0; i_ < 2; ++i_) { PG8_RC(i_); _Pragma("unroll") for (int h_ = 0; h_ < 2; ++h_) { const int c_ = sRb_ + 128 * h_; \
        dst[h_][i_] = (unsigned)(((op_).bmap ? (64 * (c_ & 7) + (c_ >> 3)) : c_) * (op_).ldb) * 2u + sC_; } } } while (0)
#define PG8_COPY(dst, src) do { _Pragma("unroll") for (int h_ = 0; h_ < 2; ++h_) _Pragma("unroll") for (int i_ = 0; i_ < 2; ++i_) dst[h_][i_] = src[h_][i_]; } while (0)
    Unit cur, nxt; int ui = 0;
    if (!S.next(0, cur)) return;
    f32x4 acc[2][2][4][2];
#pragma unroll
    for (int a = 0; a < 2; ++a)
#pragma unroll
        for (int b = 0; b < 2; ++b)
#pragma unroll
            for (int m = 0; m < 4; ++m)
#pragma unroll
                for (int n = 0; n < 2; ++n) acc[a][b][m][n] = (f32x4){0.f, 0.f, 0.f, 0.f};
    bf16x8 At[4][2], B0[2][2], B1[2][2]; i32x8 At8[4], B08[2], B18[2];
    const int one_scale = 0x7F7F7F7F;
    const char* cA; const char* cB; int nt;
    bool has_next; const char* nA; const char* nB; int nnt;
    { const Operands op = AD(cur); cA = (const char*)op.A; cB = (const char*)op.Bt; nt = op.K / 64; PG8_BOFF(cvb, op);
      has_next = S.next(1, nxt); const Operands o1 = has_next ? AD(nxt) : op; PG8_BOFF(nvb, o1); nA = (const char*)o1.A; nB = (const char*)o1.Bt; nnt = o1.K / 64;
      if constexpr (GATHER) { PG8_GIDX(cvg, op); PG8_GIDX(nvg, o1); PG8_WAIT_V(0); } else { PG8_AOFF(cvg, op); PG8_AOFF(nvg, o1); } }
    PG8_STAGE(PG8_SB(0, 0), cB, cvb[0]); PG8_STAGE(PG8_SB(0, 1), cB, cvb[1]); PG8_STAGE(PG8_SA(0, 0), cA, cvg[0]); PG8_STAGE(PG8_SA(0, 1), cA, cvg[1]);
    if (wr == 1) PG8_BAR;
    PG8_WAIT_V(2); PG8_BAR;
    PG8_STAGE(PG8_SB(1, 0), cB + kstep, cvb[0]); PG8_STAGE(PG8_SA(1, 0), cA + kstep, cvg[0]); PG8_STAGE(PG8_SB(1, 1), cB + kstep, cvb[1]);
    PG8_WAIT_V(6); PG8_BAR;
    for (;;) {
#pragma unroll 1
        for (int t = 0; t < nt; t += 2) {
            const bool last = (t == nt - 2);
            const char* a1 = cA + (size_t)(t + 1) * kstep;
            const char* a2 = last ? nA : cA + (size_t)(t + 2) * kstep; const char* b2 = last ? nB : cB + (size_t)(t + 2) * kstep;
            const char* a3 = a2 + kstep; const char* b3 = b2 + kstep;
            unsigned v2[2][2], w2[2][2];
#pragma unroll
            for (int h_ = 0; h_ < 2; ++h_)
#pragma unroll
                for (int i_ = 0; i_ < 2; ++i_) { v2[h_][i_] = last ? nvg[h_][i_] : cvg[h_][i_]; w2[h_][i_] = last ? nvb[h_][i_] : cvb[h_][i_]; }
            PG8_LDB(B0, 0, 0); PG8_LDB(B1, 0, 1); PG8_SCHED; PG8_LDA(At, 0, 0); PG8_STAGE(PG8_SA(1, 1), a1, cvg[1]);
            PG8_WAIT_V(8); PG8_WAIT_L(0); PG8_BAR; PG8_MMA(0, 0, At, B0); PG8_MMA(0, 1, At, B1); PG8_BAR; PG8_SCHED;
            PG8_LDA(At, 0, 1); PG8_STAGE(PG8_SB(0, 0), b2, w2[0]); PG8_STAGE(PG8_SB(0, 1), b2, w2[1]); PG8_STAGE(PG8_SA(0, 0), a2, v2[0]);
            PG8_WAIT_V(8); PG8_WAIT_L(0); PG8_BAR; PG8_MMA(1, 0, At, B0); PG8_MMA(1, 1, At, B1); PG8_BAR; PG8_SCHED;
            PG8_LDB(B0, 1, 0); PG8_LDB(B1, 1, 1); PG8_SCHED; PG8_LDA(At, 1, 0); PG8_STAGE(PG8_SA(0, 1), a2, v2[1]);
            PG8_WAIT_V(8); PG8_WAIT_L(0); PG8_BAR; PG8_MMA(0, 0, At, B0); PG8_MMA(0, 1, At, B1); PG8_BAR; PG8_SCHED;
            PG8_LDA(At, 1, 1); PG8_STAGE(PG8_SB(1, 0), b3, w2[0]); PG8_STAGE(PG8_SB(1, 1), b3, w2[1]); PG8_STAGE(PG8_SA(1, 0), a3, v2[0]);
            PG8_WAIT_V(8); PG8_WAIT_L(0); PG8_BAR; PG8_MMA(1, 0, At, B0); PG8_MMA(1, 1, At, B1); PG8_BAR; PG8_SCHED;
        }
        if constexpr (FP8) asm volatile("s_nop 15\n\ts_nop 15" ::: "memory");
        if (wr == 0) PG8_BAR;
        unsigned fvg[2][2], fvb[2][2];
        Unit u2; const bool h2 = S.next(ui + 2, u2); const char* fA = nA; const char* fB = nB; int fnt = nnt;
        if (h2) { const Operands o2 = AD(u2); fA = (const char*)o2.A; fB = (const char*)o2.Bt; fnt = o2.K / 64; PG8_BOFF(fvb, o2); if constexpr (GATHER) PG8_GIDX(fvg, o2); else PG8_AOFF(fvg, o2); }
        else { PG8_COPY(fvb, nvb); PG8_COPY(fvg, nvg); }
        { int fr2 = fr, fq2 = fq; asm volatile("" : "+v"(fr2), "+v"(fq2));
          E(acc, cur, wr, wc, fr2, fq2); }
        if (!has_next) break;
        if constexpr (GATHER) PG8_WAIT_V(0);
        PG8_COPY(cvg, nvg); PG8_COPY(nvg, fvg); PG8_COPY(cvb, nvb); PG8_COPY(nvb, fvb);
        if (E.reset(cur)) {
#pragma unroll
        for (int a = 0; a < 2; ++a)
#pragma unroll
            for (int b = 0; b < 2; ++b)
#pragma unroll
                for (int m = 0; m < 4; ++m)
#pragma unroll
                    for (int n = 0; n < 2; ++n) acc[a][b][m][n] = (f32x4){0.f, 0.f, 0.f, 0.f};
        }
        cur = nxt; cA = nA; cB = nB; nt = nnt; ++ui;
        nxt = u2; has_next = h2; nA = fA; nB = fB; nnt = fnt;
        if (wr == 1) PG8_BAR;
    }
    PG8_WAIT_V(0);
    PG8_BAR;
#undef PG8_SA
#undef PG8_SB
#undef PG8_STAGE
#undef PG8_LDA
#undef PG8_LDB
#undef PG8_MMA
#undef PG8_WAIT_V
#undef PG8_WAIT_L
#undef PG8_BAR
#undef PG8_SCHED
#undef PG8_GIDX
#undef PG8_AOFF
#undef PG8_BOFF
#undef PG8_COPY
#undef PG8_RC
}
template <class F> struct EpiFn { F f; __device__ __forceinline__ void operator()(f32x4 (&acc)[2][2][4][2], const Unit& u, int wr, int wc, int fr, int fq) const { f(acc, u, wr, wc, fr, fq); } __device__ __forceinline__ bool reset(const Unit&) const { return true; } };
template <class F> __device__ __forceinline__ EpiFn<F> mk_epi(F f) { return EpiFn<F>{f}; }
template <class F> struct EpiSeg { F f; int last; __device__ __forceinline__ void operator()(f32x4 (&acc)[2][2][4][2], const Unit& u, int wr, int wc, int fr, int fq) const { f(acc, u, wr, wc, fr, fq); } __device__ __forceinline__ bool reset(const Unit& u) const { return u.seg == last; } };
template <class F> __device__ __forceinline__ EpiSeg<F> mk_epi_seg(F f, int last) { return EpiSeg<F>{f, last}; }
template <int NSEG> struct SegSched { GroupSched base; __device__ __forceinline__ bool next(int j, Unit& u) const { if (!base.next(j / NSEG, u)) return false; u.seg = j % NSEG; return true; } };
#ifndef DUP_PH
#define DUP_PH -1
#endif
#define REP_BEGIN(k) _Pragma("unroll 1") for (int rep_ = 0; rep_ < ((DUP_PH == (k)) ? 2 : 1); ++rep_) { if (rep_) { if constexpr (PH < 0) xcd_barrier(bar); }
#define REP_END }
#define GEMM(S, AD, E, K, lda, ldb) gemm_fast<false, false, false>(F.lds, F.tid, S, AD, mk_epi(E), nullptr)
#define GEMM_P(S, AD, E) gemm_fast<false, true, false>(F.lds, F.tid, S, AD, mk_epi(E), nullptr)
#define GEMM_P8(S, AD, E) gemm_fast<false, true, true>(F.lds, F.tid, S, AD, mk_epi(E), nullptr)
#define GEMM_GATHER8(S, AD, E, rows) gemm_fast<true, true, true>(F.lds, F.tid, S, AD, mk_epi(E), rows)
#define EPI_ARGS f32x4 (&acc)[2][2][4][2], const Unit& u, int wr, int wc, int fr, int fq
#define EPI_FOR(...) _Pragma("unroll") for (int ai = 0; ai < 2; ++ai) _Pragma("unroll") for (int m = 0; m < 4; ++m) { const int r = ai * 128 + wr * 64 + m * 16 + fr; \
    _Pragma("unroll") for (int bj = 0; bj < 2; ++bj) _Pragma("unroll") for (int n = 0; n < 2; ++n) { const int c = bj * 128 + wc * 32 + n * 16 + 4 * fq; const f32x4 v = acc[ai][bj][m][n]; __VA_ARGS__ } }
#define EPI_FOR8(...) _Pragma("unroll") for (int ai = 0; ai < 2; ++ai) _Pragma("unroll") for (int m = 0; m < 4; ++m) { const int r = ai * 128 + wr * 64 + m * 16 + fr; \
    _Pragma("unroll") for (int bj = 0; bj < 2; ++bj) { const int c = bj * 128 + wc * 32 + 8 * fq; const f32x4 v0 = acc[ai][bj][m][0], v1 = acc[ai][bj][m][1]; __VA_ARGS__ } }
__device__ __forceinline__ void st_bf8(bf16* p, f32x4 a, f32x4 b) { u32x4 w; w.x = pk2(a[0], a[1]); w.y = pk2(a[2], a[3]); w.z = pk2(b[0], b[1]); w.w = pk2(b[2], b[3]); *(u32x4*)p = w; }
__device__ __forceinline__ void st_bf4(bf16* p, f32x4 v) { u32x2 w; w.x = pk2(v[0], v[1]); w.y = pk2(v[2], v[3]); *(u32x2*)p = w; }

__device__ __forceinline__ void p_mod(const Params& P, Frame& F) {
    LAS float* sc = (LAS float*)F.lds;
    LAS float* red = (LAS float*)(F.lds + 9 * 1024 * 4);
    float* MOD = WSP(float, WS_MOD);
    bool have = false;
    for (int it = F.bid; it < 2 * 96; it += F.G) {
        if (!have) {
            for (int i = F.tid; i < 9 * 1024; i += NTHREADS) { const int r = i >> 10, k = i & 1023; const float v = r < 8 ? P.c[r * 1024 + k] : P.c_ctx[k]; sc[i] = v * sigmoidf_(v); }
            have = true;
        }
        __syncthreads();
        const int l = it / 96, j0 = (it % 96) * 64, jj = F.tid & 63, kc = F.tid >> 6;
        const float* W = P.ada_w + (size_t)l * 1024 * 6144 + j0 + jj;
        float a[9];
#pragma unroll
        for (int r = 0; r < 9; ++r) a[r] = 0.f;
#pragma unroll 8
        for (int k = kc * 128; k < kc * 128 + 128; ++k) { const float w = W[(size_t)k * 6144];
#pragma unroll
            for (int r = 0; r < 9; ++r) a[r] += sc[r * 1024 + k] * w; }
#pragma unroll
        for (int r = 0; r < 9; ++r) red[(kc * 9 + r) * 64 + jj] = a[r];
        __syncthreads();
        for (int o = F.tid; o < 9 * 64; o += NTHREADS) { const int r = o >> 6, j = o & 63; float s = 0.f;
#pragma unroll
            for (int q = 0; q < 8; ++q) s += red[(q * 9 + r) * 64 + j];
            MOD[((size_t)l * 9 + r) * 6144 + j0 + j] = s + P.ada_b[l * 6144 + j0 + j]; }
    }
    __syncthreads();
}
__device__ __forceinline__ void p_dftgen(Frame& F) {
    LAS float* tab = (LAS float*)F.lds;
    for (int j = F.tid; j < 4096; j += NTHREADS) tab[j] = cospif((float)j * (1.0f / 2048.0f));
    __syncthreads();
    bf16* DC_ = WSP(bf16, WS_DFTC); bf16* M1 = WSP(bf16, WS_M1T); bf16* M2 = WSP(bf16, WS_M2T);
    const int nchunk = 256 * 64 + 256 * 32 + 256 * 64;
    for (int ch = F.bid * NTHREADS + F.tid; ch < nchunk; ch += F.G * NTHREADS) {
        float v[8]; bf16* dst;
        if (ch < 256 * 64) { const int kf = ch >> 6, col0 = (ch & 63) * 8, cs = col0 >> 8, l0 = col0 & 255;
#pragma unroll
            for (int i = 0; i < 8; ++i) { const int j = ((kf * (l0 + i)) & 255) * 16; v[i] = cs ? -tab[(j + 3072) & 4095] : tab[j]; }
            dst = DC_ + (size_t)kf * 512 + col0; }
        else if (ch < 256 * 64 + 256 * 32) { const int c2 = ch - 256 * 64, row = c2 >> 5, col0 = (c2 & 31) * 8, ri = row >> 7, h = (row >> 6) & 1, k1 = row & 63, h2 = col0 >> 7, cs = (col0 >> 6) & 1, l10 = col0 & 63;
#pragma unroll
            for (int i = 0; i < 8; ++i) { const int j = ((k1 * (l10 + i)) & 63) * 64; const float c = tab[j], sn = tab[(j + 3072) & 4095];
                v[i] = (h != h2) ? 0.f : (ri == 0 ? (cs == 0 ? c : -sn) : (cs == 0 ? sn : c)); }
            dst = M1 + (size_t)row * 256 + col0; }
        else { const int c2 = ch - 256 * 64 - 256 * 32, row = c2 >> 6, col0 = (c2 & 63) * 8, q = row >> 6, k2 = row & 63, q2 = col0 >> 7, ri = (col0 >> 6) & 1, l20 = col0 & 63;
#pragma unroll
            for (int i = 0; i < 8; ++i) { const int j = ((k2 * (l20 + i)) & 63) * 64; const float c = tab[j], sn = tab[(j + 3072) & 4095];
                v[i] = (q != q2) ? 0.f : (ri == 0 ? c : -sn); }
            dst = M2 + (size_t)row * 512 + col0; }
        u32x4 o; o.x = pk2(v[0], v[1]); o.y = pk2(v[2], v[3]); o.z = pk2(v[4], v[5]); o.w = pk2(v[6], v[7]);
        *(u32x4*)dst = o;
    }
    __syncthreads();
}
__device__ __forceinline__ void transpose_item(const float* W, int ldw, int k0, int n0, bf16* WT, int ldt, int drow0, LAS float* scr, int lane) {
    f32x4 ld[8];
#pragma unroll
    for (int i = 0; i < 8; ++i) ld[i] = *(const f32x4*)(W + (size_t)(k0 + 8 * i + (lane >> 3)) * ldw + n0 + 4 * (lane & 7));
#pragma unroll
    for (int i = 0; i < 8; ++i) { LAS float* d = scr + (8 * i + (lane >> 3)) * 33 + 4 * (lane & 7); d[0] = ld[i][0]; d[1] = ld[i][1]; d[2] = ld[i][2]; d[3] = ld[i][3]; }
    LDS_WAIT(); asm volatile("" ::: "memory");
    const int c = lane & 7;
#pragma unroll
    for (int j = 0; j < 4; ++j) { const int n = (lane >> 3) + 8 * j; const LAS float* s = scr + (8 * c) * 33 + n;
        u32x4 o; o.x = pk2(s[0 * 33], s[1 * 33]); o.y = pk2(s[2 * 33], s[3 * 33]); o.z = pk2(s[4 * 33], s[5 * 33]); o.w = pk2(s[6 * 33], s[7 * 33]);
        *(u32x4*)(WT + (size_t)(drow0 + n) * ldt + k0 + 8 * c) = o; }
    LDS_WAIT(); asm volatile("" ::: "memory");
}
__device__ __forceinline__ void transpose_item8(const float* W, int ldw, int k0, int n0, unsigned char* WT, int ldt, int drow0, LAS float* scr, int lane) {
    f32x4 ld[8];
#pragma unroll
    for (int i = 0; i < 8; ++i) ld[i] = *(const f32x4*)(W + (size_t)(k0 + 8 * i + (lane >> 3)) * ldw + n0 + 4 * (lane & 7));
#pragma unroll
    for (int i = 0; i < 8; ++i) { LAS float* d = scr + (8 * i + (lane >> 3)) * 33 + 4 * (lane & 7); d[0] = ld[i][0]; d[1] = ld[i][1]; d[2] = ld[i][2]; d[3] = ld[i][3]; }
    LDS_WAIT(); asm volatile("" ::: "memory");
    const int c = lane & 7;
#pragma unroll
    for (int j = 0; j < 4; ++j) { const int n = (lane >> 3) + 8 * j; const LAS float* s = scr + (8 * c) * 33 + n;
        u32x2 o; o.x = pk4_fp8(s[0 * 33] * W8S, s[1 * 33] * W8S, s[2 * 33] * W8S, s[3 * 33] * W8S); o.y = pk4_fp8(s[4 * 33] * W8S, s[5 * 33] * W8S, s[6 * 33] * W8S, s[7 * 33] * W8S);
        *(u32x2*)(WT + (size_t)(drow0 + n) * ldt + k0 + 8 * c) = o; }
    LDS_WAIT(); asm volatile("" ::: "memory");
}
__device__ __forceinline__ void transpose_item8w(const float* W, int ldw, int k0, int n0, unsigned char* WT, int ldt, int drow0, LAS float* scr, int lane) {
    f32x4 ld[16];
#pragma unroll
    for (int i = 0; i < 16; ++i) ld[i] = *(const f32x4*)(W + (size_t)(k0 + 4 * i + (lane >> 4)) * ldw + n0 + 4 * (lane & 15));
#pragma unroll
    for (int i = 0; i < 16; ++i) { LAS float* d = scr + (4 * i + (lane >> 4)) * 65 + 4 * (lane & 15); d[0] = ld[i][0]; d[1] = ld[i][1]; d[2] = ld[i][2]; d[3] = ld[i][3]; }
    LDS_WAIT(); asm volatile("" ::: "memory");
    const int c = lane & 3;
#pragma unroll
    for (int p = 0; p < 4; ++p) { const int n = (lane >> 2) + 16 * p; const LAS float* s = scr + (16 * c) * 65 + n; u32x4 o;
#pragma unroll
        for (int q = 0; q < 4; ++q) o[q] = pk4_fp8(s[(4 * q) * 65] * W8S, s[(4 * q + 1) * 65] * W8S, s[(4 * q + 2) * 65] * W8S, s[(4 * q + 3) * 65] * W8S);
        *(u32x4*)(WT + (size_t)(drow0 + n) * ldt + k0 + 16 * c) = o; }
    LDS_WAIT(); asm volatile("" ::: "memory");
}
__device__ __forceinline__ void wconv_experts(const Params& P, Frame& F, int l, int rank, int nblk) {
    LAS float* scr = (LAS float*)(F.lds + (F.wave < 7 ? F.wave * 17408 : 131584));
    const int gw = rank * NWAVES + F.wave, NGW = nblk * NWAVES;
    constexpr int I_E = 16 * 44;
    unsigned char* WGU = WSP(unsigned char, WS_WGU); unsigned char* WD = WSP(unsigned char, WS_WD);
    for (int it = gw; it < 3 * 16 * I_E; it += NGW) {
        const int which = it / (16 * I_E), r0 = it % (16 * I_E), e = r0 / I_E, r = r0 % I_E;
        if (which < 2) { const int kb = r / 44, nb = r % 44, n0 = nb * 64;
            const float* src = (which == 0 ? P.w_eg : P.w_eu) + ((size_t)l * 16 + e) * 1024 * FF;
            transpose_item8w(src, FF, kb * 64, n0, WGU + (size_t)e * 5632 * 1024, 1024, (n0 >> 7) * 256 + (which ? 128 : 0) + (n0 & 127), scr, F.lane); }
        else { const int kb = r / 16, nb = r % 16;
            transpose_item8w(P.w_ed + ((size_t)l * 16 + e) * FF * 1024, 1024, kb * 64, nb * 64, WD + (size_t)e * 1024 * FF, FF, nb * 64, scr, F.lane); }
    }
    __syncthreads();
}
__device__ __forceinline__ void p_wconv(const Params& P, Frame& F, int l) {
    LAS float* scr = (LAS float*)(F.lds + F.wave * 16384);
    const int gw = F.bid * NWAVES + F.wave, NGW = F.G * NWAVES;
    const float* w_in = P.w_in + (size_t)l * 1024 * INW;
    bf16* WA = WSP(bf16, WS_WA); bf16* WFV = WSP(bf16, WS_WFV);
    constexpr int I_K = 16 * 32, I_Q = 16 * 32, I_P = 16 * 16, I_G = 16 * 96, I_V = 16 * 32, I_AO = 16 * 32, I_FO = 8 * 32, I_OUT = 16 * 32;
    constexpr int NSM = I_K + I_Q + I_P + I_G + I_V + I_AO + I_FO + I_OUT;
    for (int it = gw; it < NSM; it += NGW) {
        int r = it;
        if (r < I_K) { transpose_item8(w_in, INW, (r / 32) * 64, 0 + (r % 32) * 32, WSP(unsigned char, WS_WA8), 1024, 0 + (r % 32) * 32, scr, F.lane); continue; } r -= I_K;
        if (r < I_Q) { transpose_item8(w_in, INW, (r / 32) * 64, 2048 + (r % 32) * 32, WSP(unsigned char, WS_WA8), 1024, 1024 + (r % 32) * 32, scr, F.lane); continue; } r -= I_Q;
        if (r < I_P) { transpose_item(w_in, INW, (r / 16) * 64, 3584 + (r % 16) * 32, WA, 1024, 2048 + (r % 16) * 32, scr, F.lane); continue; } r -= I_P;
        if (r < I_G) { transpose_item8(w_in, INW, (r / 96) * 64, 4096 + (r % 96) * 32, WSP(unsigned char, WS_WA8), 1024, 3072 + (r % 96) * 32, scr, F.lane); continue; } r -= I_G;
        if (r < I_V) { transpose_item8(w_in, INW, (r / 32) * 64, 1024 + (r % 32) * 32, WSP(unsigned char, WS_WA8), 1024, 2048 + (r % 32) * 32, scr, F.lane); continue; } r -= I_V;
        if (r < I_AO) { transpose_item8(P.w_att_o + (size_t)l * 1024 * 1024, 1024, (r / 32) * 64, (r % 32) * 32, WSP(unsigned char, WS_WAO), 1024, (r % 32) * 32, scr, F.lane); continue; } r -= I_AO;
        if (r < I_FO) { transpose_item(P.w_fourier + (size_t)l * 512 * 1024, 1024, (r / 32) * 64, (r % 32) * 32, WSP(bf16, WS_WFO), 512, (r % 32) * 32, scr, F.lane); continue; } r -= I_FO;
        transpose_item(P.w_out + (size_t)l * 1024 * 1024, 1024, (r / 32) * 64, (r % 32) * 32, WSP(bf16, WS_WOUT), 1024, (r % 32) * 32, scr, F.lane);
    }
    { bf16* WPO = WSP(bf16, WS_WPO); const float* wp = P.w_pool + (size_t)l * 4 * 128 * 256;
      for (int i = F.bid * NTHREADS + F.tid; i < 1024 * 256; i += F.G * NTHREADS) { const int n = i >> 8, kk = i & 255, g = n >> 8, f = n & 255;
          WPO[i] = (bf16)(((kk >> 7) == (g & 1)) ? f2bf(wp[((size_t)g * 128 + (kk & 127)) * 256 + f]) : 0u); } }
    { LAS float* t128 = (LAS float*)F.lds;
      __syncthreads();
      for (int j = F.tid; j < 128; j += NTHREADS) t128[j] = cospif((float)j * (1.0f / 64.0f));
      __syncthreads();
      for (int i = F.bid * NTHREADS + F.tid; i < 1024 * 1024; i += F.G * NTHREADS) { const int fc = i >> 10, k = i & 1023, cs = fc & 1, gm = fc >> 1, g = gm >> 7, m = gm & 127;
          const float* src = w_in + (size_t)k * INW + 3072 + g * 128; float s = 0.f; const int ph = cs ? 96 : 0;
          for (int c = 0; c < 128; ++c) s += src[c] * t128[(m * c + ph) & 127];
          WFV[i] = (bf16)f2bf(s); }
      __syncthreads(); }
}

struct RowMod { const float* g; const float* sh; const float* sc; };
__device__ __forceinline__ void row_load(const float* row, int lane, f32x4 (&v)[4]) {
#pragma unroll
    for (int j = 0; j < 4; ++j) v[j] = *(const f32x4*)(row + 4 * lane + 256 * j);
}
__device__ __forceinline__ void row_load_bf(const bf16* row, int lane, f32x4 (&v)[4]) {
#pragma unroll
    for (int j = 0; j < 4; ++j) { const u32x2 w = *(const u32x2*)(row + 4 * lane + 256 * j); v[j] = (f32x4){bflo(w.x), bfhi(w.x), bflo(w.y), bfhi(w.y)}; }
}
__device__ __forceinline__ float row_rstd(const f32x4 (&v)[4]) {
    float s = 0.f;
#pragma unroll
    for (int j = 0; j < 4; ++j) s += (v[j][0] * v[j][0] + v[j][1] * v[j][1]) + (v[j][2] * v[j][2] + v[j][3] * v[j][3]);
    return rsqrtf(wave_sum(s) * (1.0f / 1024.0f) + RMS_EPS);
}
__device__ __forceinline__ void row_modulate(const f32x4 (&v)[4], float rstd, const RowMod& M, int lane, f32x4 (&y)[4]) {
#pragma unroll
    for (int j = 0; j < 4; ++j) { const int k = 4 * lane + 256 * j; const f32x4 g = *(const f32x4*)(M.g + k), sh = *(const f32x4*)(M.sh + k), sc = *(const f32x4*)(M.sc + k);
        y[j] = v[j] * rstd * g * (sc + 1.0f) + sh; }
}
__device__ __forceinline__ void row_store_bf(bf16* row, int lane, const f32x4 (&y)[4]) {
#pragma unroll
    for (int j = 0; j < 4; ++j) st_bf4(row + 4 * lane + 256 * j, y[j]);
}
__device__ __forceinline__ void row_store_f8(unsigned char* row, int lane, const f32x4 (&y)[4]) {
#pragma unroll
    for (int j = 0; j < 4; ++j) *(unsigned*)(row + 4 * lane + 256 * j) = pk4_fp8(y[j][0] * A8S, y[j][1] * A8S, y[j][2] * A8S, y[j][3] * A8S);
}
__device__ __forceinline__ const float* mod_ptr(Frame& F, int l, int row, int which) { const int mr = row < RL ? (row >> 12) : 8; return WSP(float, WS_MOD) + ((size_t)l * 9 + mr) * 6144 + which * 1024; }

__device__ __forceinline__ void row_modulate2(const f32x4 (&v0)[4], const f32x4 (&v1)[4], float rs0, float rs1, const RowMod& M, int lane, f32x4 (&y0)[4], f32x4 (&y1)[4]) {
#pragma unroll
    for (int j = 0; j < 4; ++j) { const int k = 4 * lane + 256 * j; const f32x4 g = *(const f32x4*)(M.g + k), sh = *(const f32x4*)(M.sh + k), sc = *(const f32x4*)(M.sc + k); const f32x4 m = g * (sc + 1.0f);
        y0[j] = v0[j] * rs0 * m + sh; y1[j] = v1[j] * rs1 * m + sh; }
}
__device__ __forceinline__ void p_rowpass_a0(const Params& P, Frame& F) {
    const int gw = F.bid * NWAVES + F.wave, NGW = F.G * NWAVES; bf16* H = WSP(bf16, WS_H); unsigned char* H8 = WSP(unsigned char, WS_H8);
    f32x4 vn[2][4]; int p = gw;
    if (p < RT / 2) { const int row = 2 * p; const float* src = row < RL ? P.x + (size_t)row * DM : P.ctx + (size_t)(row - RL) * DM; row_load(src, F.lane, vn[0]); row_load(src + DM, F.lane, vn[1]); }
    for (; p < RT / 2; p += NGW) { const int row = 2 * p;
        f32x4 v0[4], v1[4], y0[4], y1[4];
#pragma unroll
        for (int j = 0; j < 4; ++j) { v0[j] = vn[0][j]; v1[j] = vn[1][j]; }
        { const int nr = 2 * (p + NGW); if (nr < RT) { const float* src = nr < RL ? P.x + (size_t)nr * DM : P.ctx + (size_t)(nr - RL) * DM; row_load(src, F.lane, vn[0]); row_load(src + DM, F.lane, vn[1]); } }
        const float rs0 = row_rstd(v0), rs1 = row_rstd(v1);
        RowMod M{P.norm1_g, mod_ptr(F, 0, row, 0), mod_ptr(F, 0, row, 1)};
        row_modulate2(v0, v1, rs0, rs1, M, F.lane, y0, y1);
        row_store_bf(H + (size_t)row * DM, F.lane, y0); row_store_f8(H8 + (size_t)row * DM, F.lane, y0);
        row_store_bf(H + (size_t)(row + 1) * DM, F.lane, y1); row_store_f8(H8 + (size_t)(row + 1) * DM, F.lane, y1);
    }
}
constexpr int DPP_MIRROR = 0x140, DPP_HMIRROR = 0x141;
__device__ __forceinline__ float reduce_scatter32(const float (&a)[32], int lane) {
    const bool b3 = lane & 8, b2 = lane & 4, b1 = lane & 2, b0 = lane & 1;
    float s16[16], s8[8], s4[4], s2[2];
#pragma unroll
    for (int i = 0; i < 16; ++i) { const float keep = b3 ? a[16 + i] : a[i], send = b3 ? a[i] : a[16 + i]; s16[i] = keep + dppf<DPP_MIRROR>(send); }
#pragma unroll
    for (int i = 0; i < 8; ++i) { const float keep = b2 ? s16[8 + i] : s16[i], send = b2 ? s16[i] : s16[8 + i]; s8[i] = keep + dppf<DPP_HMIRROR>(send); }
#pragma unroll
    for (int i = 0; i < 4; ++i) { const float keep = b1 ? s8[4 + i] : s8[i], send = b1 ? s8[i] : s8[4 + i]; s4[i] = keep + dppf<DPP_XOR2>(send); }
#pragma unroll
    for (int i = 0; i < 2; ++i) { const float keep = b0 ? s4[2 + i] : s4[i], send = b0 ? s4[i] : s4[2 + i]; s2[i] = keep + dppf<DPP_XOR1>(send); }
    auto s = __builtin_amdgcn_permlane16_swap(__float_as_uint(s2[0]), __float_as_uint(s2[1]), false, false); const float v = __uint_as_float(s[0]) + __uint_as_float(s[1]);
    auto t = __builtin_amdgcn_permlane32_swap(__float_as_uint(v), __float_as_uint(v), false, false); return __uint_as_float(t[0]) + __uint_as_float(t[1]);
}
__device__ __forceinline__ void p_rowpass_f(const Params& P, Frame& F, int l, int nrows) {
    const int gw = F.bid * NWAVES + F.wave, NGW = F.G * NWAVES; unsigned char* H8 = WSP(unsigned char, WS_H8); float* AFF = WSP(float, WS_AFF);
    const float* wr = P.w_router + (size_t)l * 1024 * 16;
    LAS float* wl = (LAS float*)F.lds;
    __syncthreads();
    for (int i = F.tid; i < 16384; i += NTHREADS) wl[(i & 15) * 1024 + (i >> 4)] = wr[i];
    __syncthreads();
    f32x4 vn[2][4]; int p = gw; const int NP = nrows >> 1;
    const bf16* XB = WSP(bf16, WS_XB);
    if (p < NP) { const bf16* src = XB + (size_t)(2 * p) * DM; row_load_bf(src, F.lane, vn[0]); row_load_bf(src + DM, F.lane, vn[1]); }
    for (; p < NP; p += NGW) { const int row = 2 * p;
        f32x4 v0[4], v1[4], y0[4], y1[4];
#pragma unroll
        for (int j = 0; j < 4; ++j) { v0[j] = vn[0][j]; v1[j] = vn[1][j]; }
        { const int nr = 2 * (p + NGW); if (nr < nrows) { const bf16* src = XB + (size_t)nr * DM; row_load_bf(src, F.lane, vn[0]); row_load_bf(src + DM, F.lane, vn[1]); } }
        const float rs0 = row_rstd(v0), rs1 = row_rstd(v1);
        RowMod M{P.norm2_g + l * 1024, mod_ptr(F, l, row, 3), mod_ptr(F, l, row, 4)};
        row_modulate2(v0, v1, rs0, rs1, M, F.lane, y0, y1);
        row_store_f8(H8 + (size_t)row * DM, F.lane, y0); row_store_f8(H8 + (size_t)(row + 1) * DM, F.lane, y1);
        float lg[32];
        int wo = 4 * F.lane; asm volatile("" : "+v"(wo));
#pragma unroll
        for (int e = 0; e < 16; ++e) { f32x2 a = {0.f, 0.f};
#pragma unroll
            for (int j = 0; j < 4; ++j) { const f32x4 w = *(const LAS f32x4*)(wl + e * 1024 + wo + 256 * j);
#pragma unroll
                for (int c = 0; c < 4; ++c) a += (f32x2){y0[j][c], y1[j][c]} * (f32x2){w[c], w[c]}; }
            lg[e] = a[0]; lg[16 + e] = a[1]; }
        const float tot = reduce_scatter32(lg, F.lane);
        float mx = tot;
        mx = fmaxf(mx, dppf<DPP_XOR1>(mx)); mx = fmaxf(mx, dppf<DPP_XOR2>(mx)); mx = fmaxf(mx, dppf<DPP_HMIRROR>(mx));
        { auto s = __builtin_amdgcn_permlane16_swap(__float_as_uint(mx), __float_as_uint(mx), false, false); mx = fmaxf(__uint_as_float(s[0]), __uint_as_float(s[1])); }
        const float ex = __expf(tot - mx); float den = ex;
        den += dppf<DPP_XOR1>(den); den += dppf<DPP_XOR2>(den); den += dppf<DPP_HMIRROR>(den);
        { auto s = __builtin_amdgcn_permlane16_swap(__float_as_uint(den), __float_as_uint(den), false, false); den = __uint_as_float(s[0]) + __uint_as_float(s[1]); }
        if (F.lane < 32) { const int r = (F.lane >> 3) & 1, e = (F.lane & 4) * 2 + (F.lane & 2) * 2 + (F.lane & 1) * 2 + (F.lane >> 4);
            AFF[(size_t)(row + r) * 16 + e] = ex / den; }
    }
    __syncthreads();
}
__device__ __forceinline__ void p_rowpass_k(const Params& P, Frame& F, int l, int nrows) {
    const int gw = F.bid * NWAVES + F.wave, NGW = F.G * NWAVES; bf16* H = WSP(bf16, WS_H);
    const int* SEL = WSP(int, WS_SEL); const bf16* Y = WSP(bf16, WS_Y);
    f32x4 vn[2][4]; int seln = -1; int p = gw; const int NP = nrows >> 1;
    bf16* XB = WSP(bf16, WS_XB);
    if (p < NP) { const int row = 2 * p; const bf16* src = XB + (size_t)row * DM; row_load_bf(src, F.lane, vn[0]); row_load_bf(src + DM, F.lane, vn[1]);
        seln = F.lane < 32 ? SEL[(size_t)row * 16 + F.lane] : -1; }
    for (; p < NP; p += NGW) { const int row = 2 * p;
        f32x4 v0[4], v1[4], a0[4], a1[4]; const int sel = seln;
#pragma unroll
        for (int j = 0; j < 4; ++j) { v0[j] = vn[0][j]; v1[j] = vn[1][j]; a0[j] = (f32x4){0.f, 0.f, 0.f, 0.f}; a1[j] = (f32x4){0.f, 0.f, 0.f, 0.f}; }
        { const int nr = 2 * (p + NGW); if (nr < nrows) { const bf16* src = XB + (size_t)nr * DM; row_load_bf(src, F.lane, vn[0]); row_load_bf(src + DM, F.lane, vn[1]);
            seln = F.lane < 32 ? SEL[(size_t)nr * 16 + F.lane] : -1; } }
        const unsigned emall = (unsigned)__ballot(sel >= 0);
        unsigned em = emall & 0xffffu;
        while (em) { const int e = __builtin_ctz(em); em &= em - 1; const int s = __builtin_amdgcn_readlane(sel, e); const bf16* yr = Y + (size_t)s * DM;
#pragma unroll
            for (int j = 0; j < 4; ++j) { const u32x2 w = *(const u32x2*)(yr + 4 * F.lane + 256 * j); a0[j][0] += bflo(w.x); a0[j][1] += bfhi(w.x); a0[j][2] += bflo(w.y); a0[j][3] += bfhi(w.y); } }
        em = (emall >> 16) & 0xffffu;
        while (em) { const int e = __builtin_ctz(em); em &= em - 1; const int s = __builtin_amdgcn_readlane(sel, 16 + e); const bf16* yr = Y + (size_t)s * DM;
#pragma unroll
            for (int j = 0; j < 4; ++j) { const u32x2 w = *(const u32x2*)(yr + 4 * F.lane + 256 * j); a1[j][0] += bflo(w.x); a1[j][1] += bfhi(w.x); a1[j][2] += bflo(w.y); a1[j][3] += bfhi(w.y); } }
        const float* g2 = mod_ptr(F, l, row, 5);
#pragma unroll
        for (int j = 0; j < 4; ++j) { const f32x4 g = *(const f32x4*)(g2 + 4 * F.lane + 256 * j); v0[j] = v0[j] + g * a0[j]; v1[j] = v1[j] + g * a1[j]; }
        const float rs0 = row_rstd(v0), rs1 = row_rstd(v1);
        if (l == 0) {
#pragma unroll
            for (int j = 0; j < 4; ++j) { st_bf4(XB + (size_t)row * DM + 4 * F.lane + 256 * j, v0[j]); st_bf4(XB + (size_t)(row + 1) * DM + 4 * F.lane + 256 * j, v1[j]); }
            f32x4 y0[4], y1[4]; RowMod M{P.norm1_g + 1024, mod_ptr(F, 1, row, 0), mod_ptr(F, 1, row, 1)};
            row_modulate2(v0, v1, rs0, rs1, M, F.lane, y0, y1);
            row_store_bf(H + (size_t)row * DM, F.lane, y0); row_store_f8(WSP(unsigned char, WS_H8) + (size_t)row * DM, F.lane, y0);
            row_store_bf(H + (size_t)(row + 1) * DM, F.lane, y1); row_store_f8(WSP(unsigned char, WS_H8) + (size_t)(row + 1) * DM, F.lane, y1);
        } else {
#pragma unroll
            for (int j = 0; j < 4; ++j) { const f32x4 g = *(const f32x4*)(P.final_g + 4 * F.lane + 256 * j); float* xr = P.out + (size_t)row * DM + 4 * F.lane + 256 * j; *(f32x4*)xr = v0[j] * rs0 * g; *(f32x4*)(xr + DM) = v1[j] * rs1 * g; }
        }
    }
}

constexpr int ACK_STRIDE = 72, ACV_STRIDE = 264;
constexpr int ALDS_CK = 0, ALDS_CV = 256 * ACK_STRIDE * 2, ALDS_RP = ALDS_CV + 64 * ACV_STRIDE * 2;
struct AttnState { float m, sum; f32x4 o[4]; };
__device__ __forceinline__ float xrow16_max(float x) {
    auto s = __builtin_amdgcn_permlane16_swap(__float_as_uint(x), __float_as_uint(x), false, false);
    x = fmaxf(__uint_as_float(s[0]), __uint_as_float(s[1]));
    auto t = __builtin_amdgcn_permlane32_swap(__float_as_uint(x), __float_as_uint(x), false, false);
    return fmaxf(__uint_as_float(t[0]), __uint_as_float(t[1]));
}
__device__ __forceinline__ float xrow16_sum(float x) {
    auto s = __builtin_amdgcn_permlane16_swap(__float_as_uint(x), __float_as_uint(x), false, false);
    x = __uint_as_float(s[0]) + __uint_as_float(s[1]);
    auto t = __builtin_amdgcn_permlane32_swap(__float_as_uint(x), __float_as_uint(x), false, false);
    return __uint_as_float(t[0]) + __uint_as_float(t[1]);
}
#define MFMA16(a, b, c) __builtin_amdgcn_mfma_f32_16x16x32_bf16((a), (b), (c), 0, 0, 0)
template <int NT>
__device__ __forceinline__ void attn_tail(AttnState& S, f32x4 (&sc)[NT], const u32x4 (&vw)[NT / 2][4]) {
    float cm = -__builtin_inff();
#pragma unroll
    for (int t = 0; t < NT; ++t)
#pragma unroll
        for (int j = 0; j < 4; ++j) cm = fmaxf(cm, sc[t][j]);
    cm = xrow16_max(cm);
    const bool need = (fabsf(cm) > 12.0f) && (cm > -1e30f);
    if (__builtin_amdgcn_ballot_w64(need) != 0ull) {
        const float d = need ? cm : 0.f, scl = __builtin_amdgcn_exp2f(-d);
        S.m += d; S.sum *= scl;
#pragma unroll
        for (int dt = 0; dt < 4; ++dt) S.o[dt] = S.o[dt] * scl;
#pragma unroll
        for (int t = 0; t < NT; ++t)
#pragma unroll
            for (int j = 0; j < 4; ++j) sc[t][j] -= d;
    }
    float ps = 0.f;
#pragma unroll
    for (int t = 0; t < NT; ++t)
#pragma unroll
        for (int j = 0; j < 4; ++j) { const float p = __builtin_amdgcn_exp2f(sc[t][j]); sc[t][j] = p; ps += p; }
    S.sum += ps;
#pragma unroll
    for (int ks = 0; ks < NT / 2; ++ks) { u32x4 pw; pw.x = pk2(sc[2 * ks][0], sc[2 * ks][1]); pw.y = pk2(sc[2 * ks][2], sc[2 * ks][3]); pw.z = pk2(sc[2 * ks + 1][0], sc[2 * ks + 1][1]); pw.w = pk2(sc[2 * ks + 1][2], sc[2 * ks + 1][3]);
        const bf16x8 pf = __builtin_bit_cast(bf16x8, pw);
#pragma unroll
        for (int dt = 0; dt < 4; ++dt) S.o[dt] = MFMA16(__builtin_bit_cast(bf16x8, vw[ks][dt]), pf, S.o[dt]); }
}
__device__ __forceinline__ void attn_unit2(const bf16* __restrict__ KQ, const bf16* __restrict__ VT, unsigned char* __restrict__ ATT, LAS unsigned char* lds,
                                           const int b, const int h, const int rowqA, const int rowqB, const bool win, const int r, const int qt, const int lane) {
    const int l15 = lane & 15, g = lane >> 4;
    const f32x4 z = {0.f, 0.f, 0.f, 0.f};
    bf16x8 qA[2], qB[2];
    { const bf16* qp = KQ + (size_t)(rowqA + l15) * 2048 + 1024 + h * 64 + 8 * g; qA[0] = *(const bf16x8*)qp; qA[1] = *(const bf16x8*)(qp + 32); }
    { const bf16* qp = KQ + (size_t)(rowqB + l15) * 2048 + 1024 + h * 64 + 8 * g; qB[0] = *(const bf16x8*)qp; qB[1] = *(const bf16x8*)(qp + 32); }
    AttnState SA, SB; SA.m = 0.f; SA.sum = 0.f; SB.m = 0.f; SB.sum = 0.f;
#pragma unroll
    for (int dt = 0; dt < 4; ++dt) { SA.o[dt] = z; SB.o[dt] = z; }
    if (win) {
        const int rsA = min(max(r - 4, 0), 56), dB = min(max(r - 3, 0), 56) - rsA, kc0 = min(max(16 * qt - 8, 0), 32);
        const int q = 16 * qt + l15, csq = min(max(q - 8, 0), 48);
        const int krow0 = 8 * (l15 >> 2) + (l15 & 3);
        const bf16* kb = KQ + (size_t)(b * SEQ + kc0 + krow0) * 2048 + h * 64 + 8 * g;
        const bf16* vb = VT + (size_t)(b * 1024 + h * 64 + l15) * 4096 + kc0 + 8 * g;
        const LAS float* rp = (const LAS float*)(lds + ALDS_RP);
        const int jb = kc0 + 8 * g;
        const int okb = jb - csq;
        const LAS float* rpl = rp + 16 + (jb - q + 15);
        float madd[2][4];
#pragma unroll
        for (int t = 0; t < 2; ++t)
#pragma unroll
            for (int j = 0; j < 4; ++j) madd[t][j] = ((unsigned)(okb + 4 * t + j) < 16u) ? 0.f : -__builtin_inff();
        bf16x8 K0[2][2], K1[2][2]; u32x4 V0[1][4], V1[1][4];
#define ATT_LOADW(KB, VB, i) do { const int gr_ = min(rsA + (i), 63); const bf16* kp_ = kb + (size_t)(gr_ * 64) * 2048; const bf16* vp_ = vb + gr_ * 64; \
        _Pragma("unroll") for (int t = 0; t < 2; ++t) { KB[t][0] = *(const bf16x8*)(kp_ + (size_t)(4 * t) * 2048); KB[t][1] = *(const bf16x8*)(kp_ + (size_t)(4 * t) * 2048 + 32); } \
        _Pragma("unroll") for (int dt = 0; dt < 4; ++dt) VB[0][dt] = *(const u32x4*)(vp_ + (size_t)(16 * dt) * 4096); } while (0)
#define ATT_ONE(ST, QF, KB, VB, roff, rowok) do { f32x4 sc[2]; \
        const LAS float* bp_ = rpl + ((rowok) ? (roff) : 15) * 64; \
        _Pragma("unroll") for (int t = 0; t < 2; ++t) _Pragma("unroll") for (int j = 0; j < 4; ++j) sc[t][j] = (bp_[4 * t + j] + madd[t][j]) - ST.m;     \
        _Pragma("unroll") for (int t = 0; t < 2; ++t) { sc[t] = MFMA16(KB[t][0], QF[0], sc[t]); sc[t] = MFMA16(KB[t][1], QF[1], sc[t]); } \
        attn_tail<2>(ST, sc, VB); } while (0)
#define ATT_COMPUTE(KB, VB, i) do { const int roffA_ = min(rsA + (i) - r + 7, 14); \
        ATT_ONE(SA, qA, KB, VB, roffA_, (i) <= 7); \
        ATT_ONE(SB, qB, KB, VB, max(roffA_ - 1, 0), (i) >= dB && (i) <= 7 + dB); } while (0)
        ATT_LOADW(K0, V0, 0);
#pragma unroll 1
        for (int i = 0; i < 8; i += 2) { ATT_LOADW(K1, V1, i + 1); ATT_COMPUTE(K0, V0, i); ATT_LOADW(K0, V0, i + 2); ATT_COMPUTE(K1, V1, i + 1); }
        ATT_COMPUTE(K0, V0, 8);
#undef ATT_LOADW
#undef ATT_ONE
#undef ATT_COMPUTE
    }
    { const LAS bf16* ck = (const LAS bf16*)(lds + ALDS_CK) + l15 * ACK_STRIDE + 8 * g;
      const LAS bf16* cv = (const LAS bf16*)(lds + ALDS_CV) + l15 * ACV_STRIDE + 8 * g;
#pragma unroll 1
      for (int c = 0; c < 4; ++c) {
          bf16x8 kf[4][2]; u32x4 vw[2][4];
#pragma unroll
          for (int t = 0; t < 4; ++t) { const LAS bf16* kp = ck + (64 * c + 16 * t) * ACK_STRIDE; kf[t][0] = *(const LAS bf16x8*)kp; kf[t][1] = *(const LAS bf16x8*)(kp + 32); }
#pragma unroll
          for (int ks = 0; ks < 2; ++ks)
#pragma unroll
              for (int dt = 0; dt < 4; ++dt) vw[ks][dt] = *(const LAS u32x4*)(cv + (16 * dt) * ACV_STRIDE + 64 * c + 32 * ks);
          { f32x4 sc[4]; const float nm = -SA.m; const f32x4 c0 = {nm, nm, nm, nm};
#pragma unroll
            for (int t = 0; t < 4; ++t) { sc[t] = MFMA16(kf[t][0], qA[0], c0); sc[t] = MFMA16(kf[t][1], qA[1], sc[t]); }
            attn_tail<4>(SA, sc, vw); }
          { f32x4 sc[4]; const float nm = -SB.m; const f32x4 c0 = {nm, nm, nm, nm};
#pragma unroll
            for (int t = 0; t < 4; ++t) { sc[t] = MFMA16(kf[t][0], qB[0], c0); sc[t] = MFMA16(kf[t][1], qB[1], sc[t]); }
            attn_tail<4>(SB, sc, vw); }
      } }
    { const float inv = 1.0f / xrow16_sum(SA.sum);
#pragma unroll
      for (int dt = 0; dt < 4; ++dt) { const f32x4 o = SA.o[dt] * (inv * ATS); *(unsigned*)(ATT + (size_t)(rowqA + l15) * 1024 + h * 64 + 16 * dt + 4 * g) = pk4_fp8(o[0], o[1], o[2], o[3]); } }
    { const float inv = 1.0f / xrow16_sum(SB.sum);
#pragma unroll
      for (int dt = 0; dt < 4; ++dt) { const f32x4 o = SB.o[dt] * (inv * ATS); *(unsigned*)(ATT + (size_t)(rowqB + l15) * 1024 + h * 64 + 16 * dt + 4 * g) = pk4_fp8(o[0], o[1], o[2], o[3]); } }
}
__device__ __forceinline__ void p_attn_mfma(const Params& P, Frame& F, int l, bool with_ctx_queries, int nblk, int rank) {
    const bf16* KQ = WSP(bf16, WS_KQ); const bf16* VT = WSP(bf16, WS_VT); unsigned char* ATT = WSP(unsigned char, WS_ATT);
    const float* rpb = P.rpb + (size_t)l * 16 * 465;
    const int it0 = (int)(((long)rank * 1024) / nblk), it1 = (int)(((long)(rank + 1) * 1024) / nblk);
    int pcur = -1;
    for (int hp = it0; hp < it1; ++hp) {
        const int p = hp >> 3, eighth = hp & 7, b = p >> 4, h = p & 15;
        if (p != pcur) { pcur = p;
        __syncthreads();
        { LAS bf16* ck = (LAS bf16*)(F.lds + ALDS_CK); LAS bf16* cv = (LAS bf16*)(F.lds + ALDS_CV); LAS float* rp = (LAS float*)(F.lds + ALDS_RP);
          { const int key = F.tid >> 1, hf = F.tid & 1; const int k32 = key & 31, pos = (key & ~31) + ((k32 >> 2) & 1) * 16 + 4 * (k32 >> 3) + (k32 & 3);
            const u32x4* src = (const u32x4*)(KQ + (size_t)(RL + b * CTXL + key) * 2048 + h * 64 + hf * 32); LAS u32x4* dst = (LAS u32x4*)(ck + pos * ACK_STRIDE + hf * 32);
#pragma unroll
            for (int i = 0; i < 4; ++i) dst[i] = src[i]; }
          { const int d = F.tid >> 3, sg = F.tid & 7; const u32x4* src = (const u32x4*)(VT + YT_CTX_OFF + (size_t)(b * 1024 + h * 64 + d) * 256 + sg * 32); LAS u32x4* dst = (LAS u32x4*)(cv + d * ACV_STRIDE + sg * 32);
#pragma unroll
            for (int i = 0; i < 4; ++i) dst[i] = src[i]; }
          for (int i = F.tid; i < 16 * 64; i += NTHREADS) { const int rr = i >> 6, cc = (i & 63) - 16; rp[i] = rr == 15 ? -__builtin_inff() : ((cc >= 0 && cc < 31) ? rpb[h * 465 + rr * 31 + cc] * LOG2E : 0.f); } }
        __syncthreads(); }
        const int qt = F.wave & 3, rpi = F.wave >> 2;
#pragma unroll 1
        for (int st = 0; st < 2; ++st) { const int r = eighth * 8 + st * 4 + rpi * 2; const int rowqA = b * SEQ + r * 64 + 16 * qt;
            attn_unit2(KQ, VT, ATT, F.lds, b, h, rowqA, rowqA + 64, true, r, qt, F.lane); }
        if (with_ctx_queries && eighth == 0) { const int rowqA = RL + b * CTXL + 32 * F.wave; attn_unit2(KQ, VT, ATT, F.lds, b, h, rowqA, rowqA + 16, false, 0, 0, F.lane); }
    }
    __syncthreads();
}

__device__ __forceinline__ void ld8(const bf16* p, float (&x)[8]) { const u32x4 w = *(const u32x4*)p;
#pragma unroll
    for (int q = 0; q < 4; ++q) { x[2 * q] = bflo(w[q]); x[2 * q + 1] = bfhi(w[q]); } }
__device__ __forceinline__ void p_pool(Frame& F, int nrows) {
    const bf16* PB = WSP(bf16, WS_PB); bf16* POOL = WSP(bf16, WS_POOL);
    for (int i = F.bid * NTHREADS + F.tid; i < (nrows >> 4) * 64; i += F.G * NTHREADS) {
        const int row0 = (i >> 6) << 4, ch = i & 63, g = ch >> 4, hw = 1 << g;
        int base, t0, Lb; if (row0 < RL) { base = row0 & ~4095; t0 = row0 & 4095; Lb = SEQ; } else { const int rr = row0 - RL; base = RL + (rr & ~255); t0 = rr & 255; Lb = CTXL; }
        const bf16* src = PB + (size_t)base * 512 + ch * 8;
        float S[8];
#pragma unroll
        for (int q = 0; q < 8; ++q) S[q] = 0.f;
#pragma unroll 4
        for (int d = -8; d < 8; ++d) { const int tt = t0 + d; if (d >= -hw && d < hw && tt >= 0 && tt < Lb) { float x[8]; ld8(src + (size_t)tt * 512, x);
#pragma unroll
                for (int q = 0; q < 8; ++q) S[q] += x[q]; } }
#pragma unroll 2
        for (int j = 0; j < 16; ++j) { const int t = t0 + j; const int lo = max(t - hw, 0), hi = min(t + hw, Lb); const float inv = 1.0f / (float)(hi - lo);
            float me[8]; ld8(src + (size_t)t * 512, me);
            u32x4 o;
#pragma unroll
            for (int q = 0; q < 4; ++q) o[q] = pk2(S[2 * q] * inv - me[2 * q], S[2 * q + 1] * inv - me[2 * q + 1]);
            *(u32x4*)(POOL + (size_t)(base + t) * 512 + ch * 8) = o;
            if (t + hw < Lb) { float x[8]; ld8(src + (size_t)(t + hw) * 512, x);
#pragma unroll
                for (int q = 0; q < 8; ++q) S[q] += x[q]; }
            if (t - hw >= 0) { float x[8]; ld8(src + (size_t)(t - hw) * 512, x);
#pragma unroll
                for (int q = 0; q < 8; ++q) S[q] -= x[q]; } }
    }
}

__device__ __forceinline__ int block_sum_i(int v, LAS int* sm, int tid) {
    v = wave_sum_i(v);
    __syncthreads();
    if ((tid & 63) == 0) sm[tid >> 6] = v;
    __syncthreads();
    int s = 0;
#pragma unroll
    for (int i = 0; i < 8; ++i) s += sm[i];
    return s;
}
__device__ __forceinline__ int block_excl_scan(int v, LAS int* sm, int tid, int& total) {
    const int lane = tid & 63, w = tid >> 6; int inc = v;
#pragma unroll
    for (int o = 1; o < 64; o <<= 1) { const int t = __builtin_amdgcn_ds_bpermute(((lane - o) & 63) << 2, inc); if (lane >= o) inc += t; }
    __syncthreads();
    if (lane == 63) sm[w] = inc;
    __syncthreads();
    int base = 0; total = 0;
#pragma unroll
    for (int i = 0; i < 8; ++i) { const int s = sm[i]; if (i < w) base += s; total += s; }
    return base + inc - v;
}
template <int NPT>
__device__ __forceinline__ void topk_pair(Frame& F, int row0, int n, int cap, int e, int slot0) {
    LAS int* sm = (LAS int*)F.lds;
    const float* AFF = WSP(float, WS_AFF); int* SROW = WSP(int, WS_SROW); float* SG = WSP(float, WS_SGATE); int* SEL = WSP(int, WS_SEL);
    unsigned key[NPT];
#pragma unroll
    for (int j = 0; j < NPT; ++j) { const int i = F.tid * NPT + j; key[j] = (i < n) ? __float_as_uint(AFF[(size_t)(row0 + i) * 16 + e]) : 0u; }
    unsigned T = 0u;
    for (int bit = 30; bit >= 0; --bit) { const unsigned cand = T | (1u << bit); int cnt = 0;
#pragma unroll
        for (int j = 0; j < NPT; ++j) cnt += (key[j] >= cand) ? 1 : 0;
        cnt = block_sum_i(cnt, sm, F.tid);
        if (cnt >= cap) T = cand; }
    int ngt = 0, neq = 0;
#pragma unroll
    for (int j = 0; j < NPT; ++j) { ngt += (key[j] > T) ? 1 : 0; neq += (key[j] == T) ? 1 : 0; }
    int tot_gt, tot_eq;
    (void)block_excl_scan(ngt, sm, F.tid, tot_gt);
    int eqr = block_excl_scan(neq, sm, F.tid, tot_eq);
    const int need_eq = cap - tot_gt;
    int nsel = 0; bool selj[NPT];
#pragma unroll
    for (int j = 0; j < NPT; ++j) { bool s = key[j] > T; if (key[j] == T && T != 0u) { s = eqr < need_eq; ++eqr; } selj[j] = s; nsel += s ? 1 : 0; }
    int tot_sel; int pos = block_excl_scan(nsel, sm, F.tid, tot_sel);
#pragma unroll
    for (int j = 0; j < NPT; ++j) { const int i = F.tid * NPT + j;
        if (i < n) { const int row = row0 + i;
            if (selj[j]) { const int slot = slot0 + pos; ++pos; SROW[slot] = row; SG[slot] = __uint_as_float(key[j]); SEL[(size_t)row * 16 + e] = slot; }
            else SEL[(size_t)row * 16 + e] = -1; } }
    __syncthreads();
}
__device__ __forceinline__ void p_topk(Frame& F, bool with_ctx) {
    const int npairs = 128 + (with_ctx ? 128 : 0);
    for (int pi = F.bid; pi < npairs; pi += F.G) {
        if (pi < 128) { const int b = pi >> 4, e = pi & 15; topk_pair<8>(F, b * SEQ, SEQ, CAPL, e, e * SLOT_E + b * CAPL); }
        else { const int p2 = pi - 128, b = p2 >> 4, e = p2 & 15; topk_pair<1>(F, RL + b * CTXL, CTXL, CAPC, e, e * SLOT_E + 4096 + b * CAPC); }
    }
}
template <int PH> __global__ void __launch_bounds__(NTHREADS, 2) fwd_kernel(Params P) {
    extern __shared__ __attribute__((aligned(16))) unsigned char lds_raw[];
    Frame F; F.lds = (LAS unsigned char*)lds_raw; F.tid = threadIdx.x; F.lane = F.tid & 63; F.wave = __builtin_amdgcn_readfirstlane(F.tid >> 6); F.G = gridDim.x; F.bid = blockIdx.x; F.ws = P.ws;
    const int wave0 = __builtin_amdgcn_readfirstlane((int)threadIdx.x >> 6);
    volatile LAS unsigned* MISC = (volatile LAS unsigned*)(F.lds + LDS_MISC);
    if (F.tid < 64) MISC[F.tid] = 0u;
    __syncthreads();
    XcdBarrier bar; bar.bar = WSP(unsigned, WS_CTL) + CW_BAR; bar.x = 0; bar.st = MISC + 8;
    if constexpr (PH < 0) bar = xcd_barrier_post(WSP(unsigned, WS_CTL) + CW_BAR, MISC + 8);
#define IN(k) (PH < 0 || PH == (k))
#define REFRESH() do { unsigned on_ = ~0u; asm volatile("" : "+s"(on_)); int t_ = wave0 * 64 + (int)__builtin_amdgcn_mbcnt_hi(on_, __builtin_amdgcn_mbcnt_lo(on_, 0u)); asm volatile("" : "+v"(t_)); F.tid = t_; F.lane = t_ & 63; F.wave = __builtin_amdgcn_readfirstlane(t_ >> 6); } while (0)
#define SEAM(k) do { if constexpr (PH < 0) xcd_barrier(bar); } while (0)

    if (IN(0)) { REP_BEGIN(100) p_mod(P, F); p_dftgen(F); REP_END REP_BEGIN(101) p_wconv(P, F, 0); REP_END }
    SEAM(0);
    if (IN(1)) { p_rowpass_a0(P, F); }
    SEAM(1);
    for (int l = P.l_lo; l < P.l_hi; ++l) {
        constexpr int pb = 2; const bool L0 = (l == 0);
        bf16* H = WSP(bf16, WS_H);
        if (IN(pb + 0)) { REFRESH(); REP_BEGIN(2)
            const int u1 = 128 * 8 + 8 * (L0 ? 8 : 4), u2a = 128 * 2 + (L0 ? 8 * 2 : 0), u2 = u2a + 128 * 12 + (L0 ? 8 * 12 : 0), u3 = 4 * 128 + (L0 ? 4 * 8 : 0);
            const bf16* H8 = WSP(bf16, WS_H8); const bf16* WA8 = WSP(bf16, WS_WA8);
            { GroupSched S; S.init(1, 128, 8, F.G, F.bid, 8, L0 ? 8 : 4, 128, 0);
              auto AD = [=](const Unit& u) { return Operands{H8 + (size_t)u.pm * 256 * 512, WA8 + (size_t)u.pn * 256 * 512, 512, 512, 0, 512}; };
              bf16* KQ = WSP(bf16, WS_KQ);
              auto E = [=](EPI_ARGS) { const int row0 = u.pm * 256; const float qs = (u.pn >= 4) ? QSCALE * INV8 : INV8;
                  EPI_FOR8( st_bf8(KQ + (size_t)(row0 + r) * 2048 + u.pn * 256 + c, v0 * qs, v1 * qs); ) };
              GEMM_P8(S, AD, E); }
            REFRESH();
            { GroupSched S; S.init(1, 128, 2, F.G, (F.bid + F.G - ((u1 % F.G) & ~7)) % F.G, L0 ? 8 : 0, 2, 128, 0);
              const bf16* WA = WSP(bf16, WS_WA);
              auto AD = [=](const Unit& u) { return Operands{H + (size_t)u.pm * 256 * DM, WA + (size_t)(u.pn + 8) * 256 * DM, DM, DM, 0, DM}; };
              bf16* PBp = WSP(bf16, WS_PB);
              auto E = [=](EPI_ARGS) { const int row0 = u.pm * 256; EPI_FOR8( st_bf8(PBp + (size_t)(row0 + r) * 512 + u.pn * 256 + c, v0, v1); ) };
              GEMM_P(S, AD, E); }
            REFRESH();
            { GroupSched S; S.init(1, 128, 12, F.G, (F.bid + F.G - (((u1 + u2a) % F.G) & ~7)) % F.G, L0 ? 8 : 0, 12, 128, 0);
              bf16* GB = WSP(bf16, WS_GB);
              auto AD = [=](const Unit& u) { return Operands{H8 + (size_t)u.pm * 256 * 512, WA8 + (size_t)(3072 + u.pn * 256) * 512, 512, 512, 0, 512}; };
              auto E = [=](EPI_ARGS) { const int row0 = u.pm * 256;
                  EPI_FOR8( f32x4 s0; f32x4 s1; _Pragma("unroll") for (int j = 0; j < 4; ++j) { s0[j] = sigmoidf_(v0[j] * INV8); s1[j] = sigmoidf_(v1[j] * INV8); } st_bf8(GB + (size_t)(row0 + r) * 3072 + u.pn * 256 + c, s0, s1); ) };
              GEMM_P8(S, AD, E); }
            REFRESH();
            { GroupSched S; S.init(1, 4, 128, F.G, (F.bid + F.G - (((u1 + u2) % F.G) & ~7)) % F.G, L0 ? 4 : 0, 8, 0, 128);
              const bf16* WFV = WSP(bf16, WS_WFV);
              auto AD = [=](const Unit& u) { const bool fmap = (u.pn < 128); const int t16 = u.pn & 15;
                  const size_t tok0 = fmap ? (size_t)(u.pn >> 4) * SEQ + 64 * ((t16 >> 1) * 8) + (t16 & 1) * 32 : (size_t)u.pn * 256;
                  return Operands{WFV + (size_t)u.pm * 256 * DM, H + tok0 * DM, DM, DM, 0, DM, fmap ? 1 : 0}; };
              bf16* YT = WSP(bf16, WS_YT);
              auto E = [=](EPI_ARGS) { const int rr0 = u.pm * 256;
                  if (u.pn < 128) { const int b = u.pn >> 4; const int t16 = u.pn & 15, l10 = (t16 >> 1) * 8, l20 = (t16 & 1) * 32;
                      EPI_FOR8( const int fc = rr0 + r; st_bf8(YT + (((((size_t)b * 512 + (fc >> 1)) * 32 + (c >> 3)) * 2 + (l20 >> 5)) * 2 + (fc & 1)) * 64 + l10, v0, v1); ) }
                  else { const int b = u.pn - 128; EPI_FOR8( st_bf8(YT + YT_CTX_OFF + ((size_t)b * 1024 + rr0 + r) * 256 + c, v0, v1); ) } };
              GEMM_P(S, AD, E); }
            REFRESH();
            { GroupSched S; S.init(1, 4, 128, F.G, (F.bid + F.G - (((u1 + u2 + u3) % F.G) & ~7)) % F.G, 4, 8, 0, 128);
              auto AD = [=](const Unit& u) { return Operands{WA8 + (size_t)(2048 + u.pm * 256) * 512, H8 + (size_t)u.pn * 256 * 512, 512, 512, 0, 512}; };
              bf16* VT = WSP(bf16, WS_VT);
              auto E = [=](EPI_ARGS) { const int rr0 = u.pm * 256;
                  if (u.pn < 128) { const int b = u.pn >> 4, l0 = (u.pn & 15) * 256; EPI_FOR8( st_bf8(VT + ((size_t)b * 1024 + rr0 + r) * 4096 + l0 + c, v0 * INV8, v1 * INV8); ) }
                  else { const int b = u.pn - 128; EPI_FOR8( st_bf8(VT + YT_CTX_OFF + ((size_t)b * 1024 + rr0 + r) * 256 + c, v0 * INV8, v1 * INV8); ) } };
              GEMM_P8(S, AD, E); }
        REP_END }
        SEAM(pb + 0);
        if (IN(pb + 1)) { REFRESH();
            { const int nc0 = (F.G * 5 / 16) & ~7, nconv = nc0 > 0 ? nc0 : 1, na = F.G - nconv;
              if (F.bid < na) p_attn_mfma(P, F, l, L0, na, F.bid);
              else wconv_experts(P, F, l, F.bid - na, nconv); }
            REFRESH();
            REP_BEGIN(32)
            { LAS float* tw = (LAS float*)(F.lds + LDS_TW);
              for (int j = F.tid; j < 4096; j += NTHREADS) tw[j] = cospif((float)j * (1.0f / 2048.0f));
              __syncthreads();
              GroupSched S; S.init(1, 1, 512, F.G, F.bid);
              const bf16* M1 = WSP(bf16, WS_M1T); const bf16* YF = WSP(bf16, WS_YT); bf16* ZP = WSP(bf16, WS_ZP);
              auto AD = [=](const Unit& u) { return Operands{M1, YF + (size_t)u.pn * 256 * 256, 256, 256, 0, 256}; };
              auto E = [=](EPI_ARGS) {
                  const int b = u.pn >> 6, gm0 = (u.pn & 63) * 8 + wc, l20 = 32 * wr + 8 * fq;
#pragma unroll
                  for (int m = 0; m < 4; ++m) { const int k1 = 16 * m + fr;
#pragma unroll
                      for (int bj = 0; bj < 2; ++bj) { const int gm = gm0 + 4 * bj;
                          f32x4 zr[2], zi[2];
#pragma unroll
                          for (int n = 0; n < 2; ++n)
#pragma unroll
                              for (int j = 0; j < 4; ++j) { const int ix = k1 * (l20 + 4 * n + j); const float tc = tw[ix], ts = tw[(ix + 3072) & 4095];
                                  const float ur = acc[0][bj][m][n][j], ui = acc[1][bj][m][n][j]; zr[n][j] = ur * tc - ui * ts; zi[n][j] = ur * ts + ui * tc; }
                          bf16* dst = ZP + (((((size_t)b * 64 + k1) * 128 + (gm & 127)) * 4 + (gm >> 7)) * 2) * 64 + l20;
                          st_bf8(dst, zr[0], zr[1]); st_bf8(dst + 64, zi[0], zi[1]); } } };
              GEMM_P(S, AD, E); }
            REP_END
        }
        SEAM(pb + 1);
        if (IN(pb + 10)) { REFRESH();
            { GroupSched S; S.init(1, L0 ? 136 : 128, 4, F.G, F.bid);
              const bf16* A8 = WSP(bf16, WS_ATT); const bf16* W8 = WSP(bf16, WS_WAO); const bf16* GB = WSP(bf16, WS_GB); bf16* YA = WSP(bf16, WS_KQ);
              auto AD = [=](const Unit& u) { return Operands{A8 + (size_t)u.pm * 256 * 512, W8 + (size_t)u.pn * 256 * 512, 512, 512, 0, 512}; };
              auto E = [=](EPI_ARGS) { const int colb = u.pn * 256 + wc * 32 + 8 * fq;
#pragma unroll
                  for (int ai = 0; ai < 2; ++ai) { u32x4 g0[4][2];
#pragma unroll
                      for (int m = 0; m < 4; ++m)
#pragma unroll
                          for (int bj = 0; bj < 2; ++bj) g0[m][bj] = *(const u32x4*)(GB + ((size_t)u.pm * 256 + ai * 128 + wr * 64 + m * 16 + fr) * 3072 + colb + bj * 128);
#pragma unroll
                      for (int m = 0; m < 4; ++m)
#pragma unroll
                          for (int bj = 0; bj < 2; ++bj) { const u32x4 g = g0[m][bj]; const f32x4 ga = {bflo(g[0]), bfhi(g[0]), bflo(g[1]), bfhi(g[1])}, gb = {bflo(g[2]), bfhi(g[2]), bflo(g[3]), bfhi(g[3])};
                              st_bf8(YA + ((size_t)u.pm * 256 + ai * 128 + wr * 64 + m * 16 + fr) * 1024 + colb + bj * 128, acc[ai][bj][m][0] * ga * INVAT, acc[ai][bj][m][1] * gb * INVAT); } } };
              GEMM_P8(S, AD, E); }
            REFRESH();
            { GroupSched S; S.init(1, 1, 256, F.G, F.bid);
              const bf16* M2 = WSP(bf16, WS_M2T); const bf16* ZP = WSP(bf16, WS_ZP); bf16* FOUR = WSP(bf16, WS_FOUR);
              auto AD = [=](const Unit& u) { return Operands{M2, ZP + (size_t)u.pn * 256 * 512, 512, 512, 0, 512}; };
              auto E = [=](EPI_ARGS) { const float sc = 0.0013810679320049757f;
#pragma unroll
                  for (int ai = 0; ai < 2; ++ai)
#pragma unroll
                      for (int m = 0; m < 4; ++m) { const int q = 2 * ai + wr, k2 = 16 * m + fr;
#pragma unroll
                          for (int bj = 0; bj < 2; ++bj) { const int bk = u.pn * 2 + bj, b = bk >> 6, k1 = bk & 63;
                              st_bf8(FOUR + ((size_t)b * SEQ + k1 + 64 * k2) * 512 + q * 128 + wc * 32 + 8 * fq, acc[ai][bj][m][0] * sc, acc[ai][bj][m][1] * sc); } } };
              GEMM_P(S, AD, E); }
            REFRESH();
            if (L0) { GroupSched S; S.init(1, 1, 16, F.G, (F.bid + F.G - 128 % F.G) % F.G);
              const bf16* DFTC = WSP(bf16, WS_DFTC); const bf16* YTC = WSP(bf16, WS_YT) + YT_CTX_OFF; bf16* FOUR = WSP(bf16, WS_FOUR);
              auto AD = [=](const Unit& u) { return Operands{DFTC, YTC + (size_t)u.pn * 256 * 512, 512, 512, 0, 512}; };
              auto E = [=](EPI_ARGS) { const int b = u.pn >> 1, c0 = (u.pn & 1) * 256; const float sc = 0.005524271728019903f;
                  EPI_FOR8( st_bf8(FOUR + ((size_t)RL + b * CTXL + r) * 512 + c0 + c, v0 * sc, v1 * sc); ) };
              GEMM_P(S, AD, E); }
            REFRESH();
            REP_BEGIN(33) p_pool(F, L0 ? RT : RL); REP_END
        }
        SEAM(pb + 10);
        if (IN(pb + 2)) { REFRESH();
            SegSched<2> S; S.base.init(1, L0 ? 136 : 128, 4, F.G, F.bid);
            const bf16* FOUR = WSP(bf16, WS_FOUR); const bf16* POOL = WSP(bf16, WS_POOL); const bf16* WFO = WSP(bf16, WS_WFO); const bf16* WPO = WSP(bf16, WS_WPO);
            const bf16* GB = WSP(bf16, WS_GB); const bf16* YA = WSP(bf16, WS_KQ); bf16* MRGB = WSP(bf16, WS_MRGB); const float* ps = P.pool_scale + l * 1024;
            auto AD = [=](const Unit& u) {
                if (u.seg == 0) return Operands{FOUR + (size_t)u.pm * 256 * 512, WFO + (size_t)u.pn * 256 * 512, 512, 512, 0, 512};
                return Operands{POOL + (size_t)u.pm * 256 * 512 + (u.pn >> 1) * 256, WPO + (size_t)u.pn * 256 * 256, 512, 256, 0, 256}; };
            auto E = [=](EPI_ARGS) {
                const bool fin = (u.seg == 1); const int colb = u.pn * 256 + wc * 32 + 8 * fq;
                f32x4 psv[2][2];
#pragma unroll
                for (int bj = 0; bj < 2; ++bj)
#pragma unroll
                    for (int n = 0; n < 2; ++n) { f32x4 p = *(const f32x4*)(ps + colb + bj * 128 + 4 * n);
#pragma unroll
                        for (int j = 0; j < 4; ++j) p[j] = (fabsf(p[j]) < 1e-18f) ? copysignf(1e-18f, p[j]) : p[j];
                        psv[bj][n] = p; }
#pragma unroll
                for (int ai = 0; ai < 2; ++ai)
#pragma unroll
                    for (int m = 0; m < 4; ++m) { const size_t row = (size_t)u.pm * 256 + ai * 128 + wr * 64 + m * 16 + fr; const bf16* gr = GB + row * 3072 + colb;
                        u32x4 g1r[2], g2r[2], yar[2];
#pragma unroll
                        for (int bj = 0; bj < 2; ++bj) { g2r[bj] = *(const u32x4*)(gr + 2048 + bj * 128); if (fin) yar[bj] = *(const u32x4*)(YA + row * 1024 + colb + bj * 128); else g1r[bj] = *(const u32x4*)(gr + 1024 + bj * 128); }
#pragma unroll
                        for (int bj = 0; bj < 2; ++bj) { f32x4 o[2];
#pragma unroll
                            for (int n = 0; n < 2; ++n) { const u32x4 xr = fin ? yar[bj] : g1r[bj];
                                const f32x4 g2 = (f32x4){fmaxf(bflo(g2r[bj][2 * n]), 1e-18f), fmaxf(bfhi(g2r[bj][2 * n]), 1e-18f), fmaxf(bflo(g2r[bj][2 * n + 1]), 1e-18f), fmaxf(bfhi(g2r[bj][2 * n + 1]), 1e-18f)} * psv[bj][n];
                                const f32x4 x = {bflo(xr[2 * n]), bfhi(xr[2 * n]), bflo(xr[2 * n + 1]), bfhi(xr[2 * n + 1])};
#pragma unroll
                                for (int j = 0; j < 4; ++j) o[n][j] = fin ? (x[j] + acc[ai][bj][m][n][j] * g2[j]) : (acc[ai][bj][m][n][j] * x[j] * __builtin_amdgcn_rcpf(g2[j]));
                                acc[ai][bj][m][n] = o[n]; }
                            if (fin) st_bf8(MRGB + row * 1024 + colb + bj * 128, o[0], o[1]); } } };
            gemm_fast<false, true, false>(F.lds, F.tid, S, AD, mk_epi_seg(E, 1), nullptr);
        }
        SEAM(pb + 2);
        if (IN(pb + 3)) { REFRESH();
            GroupSched S; S.init(1, L0 ? 136 : 128, 4, F.G, F.bid); const bf16* A = WSP(bf16, WS_MRGB); const bf16* W = WSP(bf16, WS_WOUT);
            bf16* XB = WSP(bf16, WS_XB); const float* MOD = WSP(float, WS_MOD) + (size_t)l * 9 * 6144;
            auto AD = [=](const Unit& u) { return Operands{A + (size_t)u.pm * 256 * 1024, W + (size_t)u.pn * 256 * 1024, 1024, 1024, 0, 1024}; };
            auto E = [=](EPI_ARGS) {
                const int row0 = u.pm * 256, mr = row0 < RL ? (row0 >> 12) : 8, colb = u.pn * 256 + wc * 32 + 8 * fq;
                bf16* dst0 = XB + (size_t)row0 * DM;
                f32x4 gv[2][2];
#pragma unroll
                for (int bj = 0; bj < 2; ++bj)
#pragma unroll
                    for (int n = 0; n < 2; ++n) gv[bj][n] = *(const f32x4*)(MOD + (size_t)mr * 6144 + 2048 + colb + bj * 128 + 4 * n);
                if (L0) { const float* src0 = row0 < RL ? P.x + (size_t)row0 * DM : P.ctx + (size_t)(row0 - RL) * DM;
#pragma unroll
                    for (int am = 0; am < 4; ++am) { const int ai = am >> 1, mh = (am & 1) * 2; f32x4 xv[2][2][2];
#pragma unroll
                        for (int m = 0; m < 2; ++m) { const size_t ro = (size_t)(ai * 128 + wr * 64 + (mh + m) * 16 + fr) * DM + colb;
#pragma unroll
                            for (int bj = 0; bj < 2; ++bj)
#pragma unroll
                                for (int n = 0; n < 2; ++n) xv[m][bj][n] = *(const f32x4*)(src0 + ro + bj * 128 + 4 * n); }
#pragma unroll
                        for (int m = 0; m < 2; ++m) { const size_t ro = (size_t)(ai * 128 + wr * 64 + (mh + m) * 16 + fr) * DM + colb;
#pragma unroll
                            for (int bj = 0; bj < 2; ++bj) st_bf8(dst0 + ro + bj * 128, xv[m][bj][0] + gv[bj][0] * acc[ai][bj][mh + m][0], xv[m][bj][1] + gv[bj][1] * acc[ai][bj][mh + m][1]); } }
                } else {
#pragma unroll
                    for (int ai = 0; ai < 2; ++ai) { u32x4 xr[4][2];
#pragma unroll
                        for (int m = 0; m < 4; ++m) { const size_t ro = (size_t)(ai * 128 + wr * 64 + m * 16 + fr) * DM + colb;
#pragma unroll
                            for (int bj = 0; bj < 2; ++bj) xr[m][bj] = *(const u32x4*)(dst0 + ro + bj * 128); }
#pragma unroll
                        for (int m = 0; m < 4; ++m) { const size_t ro = (size_t)(ai * 128 + wr * 64 + m * 16 + fr) * DM + colb;
#pragma unroll
                            for (int bj = 0; bj < 2; ++bj) { const u32x4 x = xr[m][bj]; const f32x4 xa = {bflo(x[0]), bfhi(x[0]), bflo(x[1]), bfhi(x[1])}, xb = {bflo(x[2]), bfhi(x[2]), bflo(x[3]), bfhi(x[3])};
                                st_bf8(dst0 + ro + bj * 128, xa + gv[bj][0] * acc[ai][bj][m][0], xb + gv[bj][1] * acc[ai][bj][m][1]); } } } } };
            GEMM_P(S, AD, E);
        }
        SEAM(pb + 3);
        if (IN(pb + 4)) { REFRESH(); REP_BEGIN(6) p_rowpass_f(P, F, l, L0 ? RT : RL); REP_END }
        SEAM(pb + 4);
        if (IN(pb + 5)) { REFRESH(); REP_BEGIN(7) p_topk(F, L0); REP_END }
        SEAM(pb + 5);
        if (IN(pb + 7)) { REFRESH(); REP_BEGIN(9)
            GroupSched S; S.init(16, L0 ? 17 : 16, 22, F.G, F.bid); const bf16* H8 = WSP(bf16, WS_H8); const bf16* W = WSP(bf16, WS_WGU); unsigned char* HID = WSP(unsigned char, WS_HID); const int* SROW = WSP(int, WS_SROW);
            auto AD = [=](const Unit& u) { return Operands{H8, W + ((size_t)u.grp * 5632 + u.pn * 256) * 512, 512, 512, u.grp * SLOT_E + u.pm * 256, 512}; };
            auto E = [=](EPI_ARGS) {
#pragma unroll
                for (int ai = 0; ai < 2; ++ai)
#pragma unroll
                    for (int m = 0; m < 4; ++m) { const size_t slot = (size_t)u.grp * SLOT_E + u.pm * 256 + ai * 128 + wr * 64 + m * 16 + fr; f32x4 o[2];
#pragma unroll
                        for (int n = 0; n < 2; ++n) { const f32x4 a = acc[ai][0][m][n] * INV8, up = acc[ai][1][m][n] * (INV8 * A8S);
#pragma unroll
                            for (int j = 0; j < 4; ++j) o[n][j] = a[j] * sigmoidf_(a[j]) * up[j]; }
                        u32x2 w; w.x = pk4_fp8(o[0][0], o[0][1], o[0][2], o[0][3]); w.y = pk4_fp8(o[1][0], o[1][1], o[1][2], o[1][3]);
                        *(u32x2*)(HID + slot * FF + u.pn * 128 + wc * 32 + 8 * fq) = w; } };
            GEMM_GATHER8(S, AD, E, SROW);
        REP_END }
        SEAM(pb + 7);
        if (IN(pb + 8)) { REFRESH(); REP_BEGIN(10)
            const int tpe = L0 ? 17 : 16;
            GroupSched S; S.init(1, 16 * tpe, 4, F.G, F.bid); const bf16* HID = WSP(bf16, WS_HID); const bf16* W = WSP(bf16, WS_WD); bf16* Y = WSP(bf16, WS_Y); const float* SG = WSP(float, WS_SGATE);
            auto AD = [=](const Unit& u) { const int e = u.pm / tpe, st = e * 17 + (u.pm - e * tpe); return Operands{HID + (size_t)st * 256 * (FF / 2), W + ((size_t)e * 1024 + u.pn * 256) * (FF / 2), FF / 2, FF / 2, 0, FF / 2}; };
            auto E = [=](EPI_ARGS) { const int e = u.pm / tpe; const size_t slot0 = (size_t)(e * 17 + (u.pm - e * tpe)) * 256 + wr * 64 + fr; float gt[2][4];
#pragma unroll
                for (int ai = 0; ai < 2; ++ai)
#pragma unroll
                    for (int m = 0; m < 4; ++m) gt[ai][m] = SG[slot0 + ai * 128 + m * 16] * INV8;
#pragma unroll
                for (int ai = 0; ai < 2; ++ai)
#pragma unroll
                    for (int m = 0; m < 4; ++m)
#pragma unroll
                        for (int bj = 0; bj < 2; ++bj) st_bf8(Y + (slot0 + ai * 128 + m * 16) * DM + u.pn * 256 + bj * 128 + wc * 32 + 8 * fq, acc[ai][bj][m][0] * gt[ai][m], acc[ai][bj][m][1] * gt[ai][m]); };
            GEMM_P8(S, AD, E);
        REP_END }
        SEAM(pb + 8);
        if (IN(pb + 9)) { REFRESH(); p_rowpass_k(P, F, l, L0 ? RT : RL); if (L0) p_wconv(P, F, 1); }
        if (L0) SEAM(pb + 9);
    }
#undef IN
#undef SEAM
}
template <int PH> static void launch_ph(int grid, const Params& p, hipStream_t stream) { hipLaunchKernelGGL(fwd_kernel<PH>, dim3(grid), dim3(NTHREADS), LDS_BYTES, stream, p); }
template <int PH> static bool set_attr() { return hipFuncSetAttribute((const void*)fwd_kernel<PH>, hipFuncAttributeMaxDynamicSharedMemorySize, LDS_BYTES) == hipSuccess; }

#ifndef DUP_LAUNCH
#define DUP_LAUNCH -1
#endif
extern "C" void kernel_launch(void* const* d_in, const int* in_sizes, int n_in, void* d_out, int out_size, void* d_ws, size_t ws_size, hipStream_t stream) {
    static int grid = 0;
    if (grid == 0) {
        if (n_in != 20 || out_size != RL * DM || ws_size < WS_END) { fprintf(stderr, "kernel_launch: unexpected shapes (n_in %d out %d ws %zu need %zu)\n", n_in, out_size, ws_size, (size_t)WS_END); grid = -1; return; }
        int dev = 0, cus = 0, per_cu = 0;
        if (hipGetDevice(&dev) != hipSuccess || hipDeviceGetAttribute(&cus, hipDeviceAttributeMultiprocessorCount, dev) != hipSuccess) { grid = -1; return; }
#if N_LAUNCH_MODE == 1
        if (!set_attr<-1>()) { fprintf(stderr, "kernel_launch: hipFuncSetAttribute failed\n"); grid = -1; return; }
        if (hipOccupancyMaxActiveBlocksPerMultiprocessor(&per_cu, (const void*)fwd_kernel<-1>, NTHREADS, LDS_BYTES) != hipSuccess || per_cu < 1) fprintf(stderr, "kernel_launch: occupancy query reports %d\n", per_cu);
#else
        if (!(set_attr<0>() && set_attr<1>() && set_attr<2>() && set_attr<3>() && set_attr<12>() && set_attr<4>() && set_attr<5>() && set_attr<6>() && set_attr<7>() && set_attr<9>() && set_attr<10>() && set_attr<11>())) { fprintf(stderr, "kernel_launch: hipFuncSetAttribute failed\n"); grid = -1; return; }
        (void)per_cu;
#endif
        (void)hipGetLastError();
        grid = cus;
    }
    if (grid < 0) return;
    if (hipMemsetAsync((char*)d_ws + WS_CTL, 0, CTL_BYTES, stream) != hipSuccess) return;
    Params p{};
    const float** pp = (const float**)&p;
    for (int i = 0; i < 20; ++i) pp[i] = (const float*)d_in[i];
    p.out = (float*)d_out; p.ws = (unsigned char*)d_ws;
#if N_LAUNCH_MODE == 1
    p.l_lo = 0; p.l_hi = 2;
    launch_ph<-1>(grid, p, stream);
#else
    p.l_lo = 0; p.l_hi = 0; launch_ph<0>(grid, p, stream); if (DUP_LAUNCH == 0) launch_ph<0>(grid, p, stream); launch_ph<1>(grid, p, stream); if (DUP_LAUNCH == 1) launch_ph<1>(grid, p, stream);
#define LP(k) do { launch_ph<k>(grid, p, stream); if (DUP_LAUNCH == (k) && l == 0) launch_ph<k>(grid, p, stream); } while (0)
    for (int l = 0; l < 2; ++l) { p.l_lo = l; p.l_hi = l + 1;
        LP(2); LP(3); LP(12); LP(4); LP(5); LP(6); LP(7); LP(9); LP(10); LP(11); }
#endif
}
```

```cpp
#include <hip/hip_runtime.h>
#include <cstdio>
#include <cstdint>

#ifndef N_LAUNCH_MODE
#define N_LAUNCH_MODE 1
#endif

#define GAS __attribute__((address_space(1)))
#define LAS __attribute__((address_space(3)))
typedef unsigned short bf16;
typedef short bf16x8 __attribute__((ext_vector_type(8)));
typedef float f32x4 __attribute__((ext_vector_type(4)));
typedef unsigned u32x4 __attribute__((ext_vector_type(4)));
typedef unsigned u32x2 __attribute__((ext_vector_type(2)));

constexpr int NB = 8, SEQ = 4096, DM = 1024, CTXL = 256, NH = 16, HD = 64, GRIDW = 64;
constexpr int RL = NB * SEQ, RC = NB * CTXL, RT = RL + RC;
constexpr int INW = 7168, NE = 16, FF = 2816, CAPL = 512, CAPC = 32;
constexpr int SLOT_E = 4352, NSLOT = NE * SLOT_E;
constexpr float RMS_EPS = 1e-6f;
constexpr float LOG2E = 1.4426950408889634f, QSCALE = 0.125f * LOG2E;
constexpr float A8S = 8.0f, W8S = 64.0f, INV8 = 1.0f / (A8S * W8S);
constexpr float ATS = 32.0f, INVAT = 1.0f / (ATS * W8S);
constexpr int NWAVES = 8, NTHREADS = 512;

constexpr size_t al256(size_t x) { return (x + 255) & ~(size_t)255; }
constexpr size_t WS_CTL = 0, CTL_BYTES = 1u << 20;
constexpr size_t WS_MOD = WS_CTL + CTL_BYTES;
constexpr size_t WS_XC = al256(WS_MOD + (size_t)2 * 9 * 6144 * 4);
constexpr size_t WS_AFF = al256(WS_XC + (size_t)RC * DM * 4);
constexpr size_t WS_SROW = al256(WS_AFF + (size_t)RT * 16 * 4);
constexpr size_t WS_SGATE = al256(WS_SROW + (size_t)NSLOT * 4);
constexpr size_t WS_SEL = al256(WS_SGATE + (size_t)NSLOT * 4);
constexpr size_t WS_DFTM = al256(WS_SEL + (size_t)RT * 16 * 4);
constexpr size_t WS_DFTC = al256(WS_DFTM + (size_t)4096 * 8192 * 2);
constexpr size_t WS_WA = al256(WS_DFTC + (size_t)256 * 512 * 2);
constexpr size_t WS_WFV = al256(WS_WA + (size_t)5632 * 1024 * 2);
constexpr size_t WS_WAO = al256(WS_WFV + (size_t)2048 * 1024 * 2);
constexpr size_t WS_WFO = al256(WS_WAO + (size_t)1024 * 1024 * 2);
constexpr size_t WS_WPO = al256(WS_WFO + (size_t)1024 * 512 * 2);
constexpr size_t WS_WOUT = al256(WS_WPO + (size_t)1024 * 256 * 2);
constexpr size_t WS_WGU = al256(WS_WOUT + (size_t)1024 * 1024 * 2);
constexpr size_t WS_WD = al256(WS_WGU + (size_t)16 * 5632 * 1024);
constexpr size_t WS_WA8 = al256(WS_WD + (size_t)16 * 1024 * 2816);
constexpr size_t WS_H = al256(WS_WA8 + (size_t)6144 * 1024);
constexpr size_t WS_H8 = al256(WS_H + (size_t)RT * DM * 2);
constexpr size_t WS_R = al256(WS_H8 + (size_t)RT * DM);
constexpr size_t WS_KQ = WS_R;
constexpr size_t WS_MRG = WS_KQ;
constexpr size_t WS_PB = al256(WS_KQ + (size_t)RT * 2048 * 2);
constexpr size_t WS_GB = al256(WS_PB + (size_t)RT * 512 * 2);
constexpr size_t WS_YT = al256(WS_GB + (size_t)RT * 3072 * 2);
constexpr size_t WS_MRGB = WS_YT;
constexpr size_t WS_VT = al256(WS_YT + (size_t)RT * 1024 * 2);
constexpr size_t WS_FOUR = al256(WS_VT + (size_t)RT * 1024 * 2);
constexpr size_t WS_ATT = al256(WS_FOUR + (size_t)RT * 512 * 2);
constexpr size_t WS_POOL = al256(WS_ATT + (size_t)RT * 1024 * 2);
constexpr size_t WS_MIX_END = al256(WS_POOL + (size_t)RT * 512 * 2);
constexpr size_t WS_XG = WS_R;
constexpr size_t WS_HID = al256(WS_XG + (size_t)NSLOT * 1024 * 2);
constexpr size_t WS_Y = al256(WS_HID + (size_t)NSLOT * 2816);
constexpr size_t WS_MOE_END = al256(WS_Y + (size_t)NSLOT * 1024 * 2);
constexpr size_t WS_END0 = WS_MIX_END > WS_MOE_END ? WS_MIX_END : WS_MOE_END;
constexpr size_t WS_ZP = WS_END0;
constexpr size_t WS_M1T = al256(WS_ZP + ((size_t)8 * 64 * 512 * 128 + 1024) * 2);
constexpr size_t WS_M2T = al256(WS_M1T + (size_t)256 * 256 * 2);
constexpr size_t WS_XB = al256(WS_M2T + (size_t)256 * 512 * 2);
constexpr int RF_PITCH = 1032, RF_TBL = 2 * 16 * RF_PITCH * 2 + 4096 + 4096 + 64;
constexpr size_t WS_RFT = al256(WS_XB + (size_t)RT * DM * 2);
constexpr size_t WS_END = al256(WS_RFT + (size_t)18 * RF_TBL);
constexpr size_t YT_CTX_OFF = (size_t)8 * 1024 * 4096;

constexpr int CW_BAR = 4096;

constexpr int LDS_BYTES = 155648;
constexpr int LDS_TW = 132096;
constexpr int LDS_MISC = 131072;

__device__ __forceinline__ unsigned f2bf(float f) { unsigned u = __float_as_uint(f); return (u + 0x7fffu + ((u >> 16) & 1u)) >> 16; }
typedef __bf16 hbf16x2 __attribute__((ext_vector_type(2)));
typedef float f32x2 __attribute__((ext_vector_type(2)));
__device__ __forceinline__ unsigned pk2(float lo, float hi) { const f32x2 v = {lo, hi}; return __builtin_bit_cast(unsigned, __builtin_convertvector(v, hbf16x2)); }
__device__ __forceinline__ unsigned pk4_fp8(float a, float b, float c, float d) {
    a = __builtin_amdgcn_fmed3f(a, -448.f, 448.f); b = __builtin_amdgcn_fmed3f(b, -448.f, 448.f); c = __builtin_amdgcn_fmed3f(c, -448.f, 448.f); d = __builtin_amdgcn_fmed3f(d, -448.f, 448.f);
    int w = 0; w = __builtin_amdgcn_cvt_pk_fp8_f32(a, b, w, false); w = __builtin_amdgcn_cvt_pk_fp8_f32(c, d, w, true); return (unsigned)w; }
__device__ __forceinline__ float bf2f(unsigned b) { return __uint_as_float(b << 16); }
__device__ __forceinline__ float bflo(unsigned w) { return __uint_as_float(w << 16); }
__device__ __forceinline__ float bfhi(unsigned w) { return __uint_as_float(w & 0xffff0000u); }
template <int CTRL> __device__ __forceinline__ float dppf(float x) { return __builtin_bit_cast(float, __builtin_amdgcn_mov_dpp(__builtin_bit_cast(int, x), CTRL, 0xf, 0xf, true)); }
template <int CTRL> __device__ __forceinline__ int dppi(int x) { return __builtin_amdgcn_mov_dpp(x, CTRL, 0xf, 0xf, true); }
constexpr int DPP_XOR1 = 0xB1, DPP_XOR2 = 0x4E, DPP_ROR4 = 0x124, DPP_ROR8 = 0x128;
__device__ __forceinline__ float wave_sum(float v) {
    v += dppf<DPP_XOR1>(v); v += dppf<DPP_XOR2>(v); v += dppf<DPP_ROR4>(v); v += dppf<DPP_ROR8>(v);
    auto s = __builtin_amdgcn_permlane16_swap(__float_as_uint(v), __float_as_uint(v), false, false); v = __uint_as_float(s[0]) + __uint_as_float(s[1]);
    auto t = __builtin_amdgcn_permlane32_swap(__float_as_uint(v), __float_as_uint(v), false, false); return __uint_as_float(t[0]) + __uint_as_float(t[1]);
}
__device__ __forceinline__ float wave_max(float v) {
    v = fmaxf(v, dppf<DPP_XOR1>(v)); v = fmaxf(v, dppf<DPP_XOR2>(v)); v = fmaxf(v, dppf<DPP_ROR4>(v)); v = fmaxf(v, dppf<DPP_ROR8>(v));
    auto s = __builtin_amdgcn_permlane16_swap(__float_as_uint(v), __float_as_uint(v), false, false); v = fmaxf(__uint_as_float(s[0]), __uint_as_float(s[1]));
    auto t = __builtin_amdgcn_permlane32_swap(__float_as_uint(v), __float_as_uint(v), false, false); return fmaxf(__uint_as_float(t[0]), __uint_as_float(t[1]));
}
__device__ __forceinline__ int wave_sum_i(int v) {
    v += dppi<DPP_XOR1>(v); v += dppi<DPP_XOR2>(v); v += dppi<DPP_ROR4>(v); v += dppi<DPP_ROR8>(v);
    auto s = __builtin_amdgcn_permlane16_swap((unsigned)v, (unsigned)v, false, false); v = (int)(s[0] + s[1]);
    auto t = __builtin_amdgcn_permlane32_swap((unsigned)v, (unsigned)v, false, false); return (int)(t[0] + t[1]);
}
__device__ __forceinline__ float sigmoidf_(float x) { return __builtin_amdgcn_rcpf(1.f + __builtin_amdgcn_exp2f(x * -1.4426950408889634f)); }
#define LDS_WAIT() asm volatile("s_waitcnt lgkmcnt(0)" ::: "memory")

#define XB_TMO      128
#define XB_XCNT(j)  (256  + 64 * (j))
#define XB_XSUB(j)  (1280 + 64 * (j))
#define XB_XGEN(j)  (2304 + 64 * (j))
#define XB_TOP      3328
#define XB_TOPGEN   3392
#define XCD_BAR_WORDS 3456
#define XB_SPIN_CAP (1u << 22)

__device__ __forceinline__ unsigned xb_ld(unsigned* p)              { return __hip_atomic_load(p, __ATOMIC_RELAXED, __HIP_MEMORY_SCOPE_AGENT); }
__device__ __forceinline__ unsigned xb_add(unsigned* p, unsigned v) { return __hip_atomic_fetch_add(p, v, __ATOMIC_RELAXED, __HIP_MEMORY_SCOPE_AGENT); }
__device__ __forceinline__ unsigned xb_xcc_id() { return (unsigned)__builtin_amdgcn_s_getreg((3 << 11) | 20) & 0xFu; }
#define XB_SPIN(cond, bar) do { unsigned _sp = 0; while (cond) { __builtin_amdgcn_s_sleep(1); \
    if ((++_sp & 255u) == 0u) { if (xb_ld(&(bar)[XB_TMO])) break; if (_sp > XB_SPIN_CAP) { atomicAdd(&(bar)[XB_TMO], 1u); break; } } } } while (0)

struct XcdBarrier { unsigned* bar; unsigned x; volatile LAS unsigned* st; };

__device__ __forceinline__ XcdBarrier xcd_barrier_post(unsigned* bar, volatile LAS unsigned* st) {
    XcdBarrier b; b.bar = bar; b.x = xb_xcc_id(); b.st = st;
    if (threadIdx.x == 0) (void)xb_add(&bar[XB_XCNT(b.x)], 1u);
    return b;
}
__device__ __forceinline__ void xcd_barrier_complete(unsigned* bar, unsigned x, unsigned& nloc, unsigned& nx) {
    const unsigned G = gridDim.x * gridDim.y * gridDim.z;
    unsigned sum, cnt, mine, sp = 0u;
    for (;;) {
        sum = 0u; cnt = 0u; mine = 0u;
#pragma unroll
        for (unsigned j = 0; j < 16; ++j) { const unsigned c = xb_ld(&bar[XB_XCNT(j)]); sum += c; cnt += (c > 0u) ? 1u : 0u; mine = (j == x) ? c : mine; }
        if (sum == G) break;
        __builtin_amdgcn_s_sleep(1);
        if ((++sp & 255u) == 0u) { if (xb_ld(&bar[XB_TMO])) break; if (sp > XB_SPIN_CAP) { atomicAdd(&bar[XB_TMO], 1u); break; } }
    }
    nloc = mine > 0u ? mine : 1u; nx = cnt > 0u ? cnt : 1u;
}
__device__ __forceinline__ void xcd_barrier(const XcdBarrier& b) {
    asm volatile("s_waitcnt vmcnt(0)" ::: "memory");
    __syncthreads();
    if (threadIdx.x == 0) {
        unsigned* bar = b.bar;
        __builtin_amdgcn_s_waitcnt(0);
        unsigned nloc = b.st[0], nx = b.st[1];
        if (nloc == 0u) { xcd_barrier_complete(bar, b.x, nloc, nx); b.st[0] = nloc; b.st[1] = nx; }
        const unsigned old = xb_add(&bar[XB_XSUB(b.x)], 1u);
        const unsigned gen = old / nloc;
        if (old + 1u == (gen + 1u) * nloc) {
            __builtin_amdgcn_fence(__ATOMIC_RELEASE, "agent");
            asm volatile("s_waitcnt vmcnt(0)" ::: "memory");
            const unsigned og = xb_add(&bar[XB_TOP], 1u);
            const unsigned tg = og / nx;
            if (og + 1u == (tg + 1u) * nx) xb_add(&bar[XB_TOPGEN], 1u);
            else XB_SPIN(xb_ld(&bar[XB_TOPGEN]) == tg, bar);
            __builtin_amdgcn_fence(__ATOMIC_ACQUIRE, "agent");
            xb_add(&bar[XB_XGEN(b.x)], 1u);
            asm volatile("s_waitcnt vmcnt(0)" ::: "memory");
        } else {
            XB_SPIN(xb_ld(&bar[XB_XGEN(b.x)]) == gen, bar);
            __builtin_amdgcn_fence(__ATOMIC_ACQUIRE, "agent");
            asm volatile("s_waitcnt vmcnt(0)" ::: "memory");
        }
    }
    __syncthreads();
}

struct Params {
    const float *x, *c, *ctx, *c_ctx, *ada_w, *ada_b, *norm1_g, *norm2_g, *w_in, *rpb, *w_att_o, *w_fourier, *w_pool, *pool_scale, *w_out, *w_router, *w_eg, *w_eu, *w_ed, *final_g;
    float* out; unsigned char* ws; int l_lo, l_hi;
};
struct Frame {
    LAS unsigned char* lds;
    int tid, lane, wave, G, bid;
    unsigned char* ws;
};
#define WSP(T, off) ((T*)(F.ws + (off)))

struct Unit { int grp, pm, pn, seg; };
struct GroupSched {
    int ng, nM, nN, G, c; int tM, tN, tpm0, tpn0;
    __device__ __forceinline__ void init(int ng_, int nM_, int nN_, int G_, int c_, int tM_ = 0, int tN_ = 0, int tpm0_ = 0, int tpn0_ = 0) { ng = ng_; nM = nM_; nN = nN_; G = G_; c = c_; tM = tM_; tN = tN_; tpm0 = tpm0_; tpn0 = tpn0_; }
    __device__ __forceinline__ bool next(int i, Unit& u) const {
        const int per = nM * nN; const int L = i * G + c;
        if (L < ng * per) {
            u.grp = L / per; int wgid = L - u.grp * per;
            { const int q = per / 8, r = per % 8, xcd = wgid % 8, off = wgid / 8; wgid = (xcd < r ? xcd * (q + 1) : r * (q + 1) + (xcd - r) * q) + off; }
            const int nig = 8 * nN, gid = wgid / nig, fm = gid * 8, gsz = (nM - fm) < 8 ? (nM - fm) : 8;
            u.pm = fm + ((wgid % nig) % gsz); u.pn = (wgid % nig) / gsz; u.seg = 0; return true;
        }
        const int w = L - ng * per;
        if (w < tM * tN) { u.grp = ng; u.pm = tpm0 + (w % tM); u.pn = tpn0 + (w / tM); u.seg = 0; return true; }
        return false;
    }
};
struct Operands { const bf16* A; const bf16* Bt; int lda, ldb, slot0, K; int bmap; };

constexpr int HTB = 128 * 64 * 2;
__device__ __forceinline__ int lds_byte(int r, int c) { const int st = (r >> 4) * 2 + (c >> 5), rr = r & 15, cc = c & 31, ob = rr * 64 + cc * 2; return st * 1024 + (ob ^ (((ob >> 9) & 1) << 5)); }
__device__ __forceinline__ int perm32(int rho) { const int n = rho >> 4, i = rho & 15; return 8 * (i >> 2) + 4 * n + (i & 3); }
__device__ __forceinline__ void stage_rc(int b, int& R, int& C) { const int st = b / 1024, sb = b % 1024, swz = sb ^ (((sb >> 9) & 1) << 5); R = (st >> 1) * 16 + swz / 64; C = (st & 1) * 32 + (swz % 64) / 2; }
typedef int i32x8 __attribute__((ext_vector_type(8)));
typedef int i32x4 __attribute__((ext_vector_type(4)));
__device__ __forceinline__ i32x8 cat8(bf16x8 lo, bf16x8 hi) { const i32x4 a = __builtin_bit_cast(i32x4, lo), b = __builtin_bit_cast(i32x4, hi); return (i32x8){a[0], a[1], a[2], a[3], b[0], b[1], b[2], b[3]}; }
template <bool GATHER, bool PERM, bool FP8, class Sched, class Addr, class Epi>
__device__ __forceinline__ void gemm_fast(LAS unsigned char* lds, const int tid, const Sched& S, const Addr& AD, const Epi& E, const int* __restrict__ grows) {
    const int wid = __builtin_amdgcn_readfirstlane(tid >> 6), lane = tid & 63, wr = wid >> 2, wc = wid & 3, fr = lane & 15, fq = lane >> 4;
    unsigned cvg[2][2], nvg[2][2], cvb[2][2], nvb[2][2];
#define PG8_RC(i_) int R_, C_; stage_rc(tid * 16 + (i_) * 8192, R_, C_); const int sR_ = R_; const unsigned sC_ = (unsigned)C_ * 2u; const int sRb_ = PERM ? ((R_ & ~31) + perm32(R_ & 31)) : R_; (void)sR_; (void)sRb_; (void)sC_
    const size_t kstep = 128;
    const unsigned ldsw = (unsigned)wid * 1024u;
    const int aoff = lds_byte(wr * 64 + fr, fq * 8), boff = lds_byte(wc * 32 + fr, fq * 8);
#define PG8_SA(b, h) (((b) * 2 + (h)) * HTB)
#define PG8_SB(b, h) ((4 + (b) * 2 + (h)) * HTB)
#define PG8_STAGE(bufoff, gbase, voff) do { _Pragma("unroll") for (int _i = 0; _i < 2; ++_i) \
        __builtin_amdgcn_global_load_lds((const unsigned*)((const char*)(gbase) + (voff)[_i]), (LAS unsigned*)(lds + (bufoff) + ldsw + _i * 8192), 16, 0, 0); } while (0)
#define PG8_LDA(dst, b, h) do { if constexpr (FP8) { _Pragma("unroll") for (int m = 0; m < 4; ++m) dst##8[m] = cat8(*(const LAS bf16x8*)(lds + PG8_SA(b, h) + aoff + m * 2048), *(const LAS bf16x8*)(lds + PG8_SA(b, h) + aoff + m * 2048 + 1024)); } \
        else { _Pragma("unroll") for (int m = 0; m < 4; ++m) _Pragma("unroll") for (int k = 0; k < 2; ++k) dst[m][k] = *(const LAS bf16x8*)(lds + PG8_SA(b, h) + aoff + m * 2048 + k * 1024); } } while (0)
#define PG8_LDB(dst, b, h) do { if constexpr (FP8) { _Pragma("unroll") for (int n = 0; n < 2; ++n) dst##8[n] = cat8(*(const LAS bf16x8*)(lds + PG8_SB(b, h) + boff + n * 2048), *(const LAS bf16x8*)(lds + PG8_SB(b, h) + boff + n * 2048 + 1024)); } \
        else { _Pragma("unroll") for (int n = 0; n < 2; ++n) _Pragma("unroll") for (int k = 0; k < 2; ++k) dst[n][k] = *(const LAS bf16x8*)(lds + PG8_SB(b, h) + boff + n * 2048 + k * 1024); } } while (0)
#define PG8_MMA(ai, bj, At, Bt) do { __builtin_amdgcn_s_setprio(1); \
        if constexpr (FP8) { _Pragma("unroll") for (int m = 0; m < 4; ++m) _Pragma("unroll") for (int n = 0; n < 2; ++n)   \
            asm volatile("v_mfma_scale_f32_16x16x128_f8f6f4 %0, %1, %2, %0, %3, %3 op_sel_hi:[0,0,0]" : "+v"(acc[ai][bj][m][n]) : "v"(Bt##8[n]), "v"(At##8[m]), "v"(one_scale)); } \
        else { _Pragma("unroll") for (int m = 0; m < 4; ++m) _Pragma("unroll") for (int n = 0; n < 2; ++n) _Pragma("unroll") for (int k = 0; k < 2; ++k) \
            acc[ai][bj][m][n] = __builtin_amdgcn_mfma_f32_16x16x32_bf16(Bt[n][k], At[m][k], acc[ai][bj][m][n], 0, 0, 0); } \
        __builtin_amdgcn_s_setprio(0); } while (0)
#define PG8_WAIT_V(n) asm volatile("s_waitcnt vmcnt(" #n ")" ::: "memory")
#define PG8_WAIT_L(n) asm volatile("s_waitcnt lgkmcnt(" #n ")" ::: "memory")
#define PG8_BAR __builtin_amdgcn_s_barrier()
#define PG8_SCHED __builtin_amdgcn_sched_barrier(0)
#define PG8_GIDX(dst, op_) do { _Pragma("unroll") for (int i_ = 0; i_ < 2; ++i_) { PG8_RC(i_); _Pragma("unroll") for (int h_ = 0; h_ < 2; ++h_) dst[h_][i_] = (unsigned)grows[(op_).slot0 + h_ * 128 + sR_] * (unsigned)((op_).lda * 2) + sC_; } } while (0)
#define PG8_AOFF(dst, op_) do { _Pragma("unroll") for (int i_ = 0; i_ < 2; ++i_) { PG8_RC(i_); _Pragma("unroll") for (int h_ = 0; h_ < 2; ++h_) dst[h_][i_] = (unsigned)((sR_ + 128 * h_) * (op_).lda) * 2u + sC_; } } while (0)
#define PG8_BOFF(dst, op_) do { _Pragma("unroll") for (int i_ = 0; i_ < 2; ++i_) { PG8_RC(i_); _Pragma("unroll") for (int h_ = 0; h_ < 2; ++h_) { const int c_ = sRb_ + 128 * h_; \
        dst[h_][i_] = (unsigned)(((op_).bmap ? (64 * (c_ & 7) + (c_ >> 3)) : c_) * (op_).ldb) * 2u + sC_; } } } while (0)
#define PG8_COPY(dst, src) do { _Pragma("unroll") for (int h_ = 0; h_ < 2; ++h_) _Pragma("unroll") for (int i_ = 0; i_ < 2; ++i_) dst[h_][i_] = src[h_][i_]; } while (0)
    Unit cur, nxt; int ui = 0;
    if (!S.next(0, cur)) return;
    f32x4 acc[2][2][4][2];
#pragma unroll
    for (int a = 0; a < 2; ++a)
#pragma unroll
        for (int b = 0; b < 2; ++b)
#pragma unroll
            for (int m = 0; m < 4; ++m)
#pragma unroll
                for (int n = 0; n < 2; ++n) acc[a][b][m][n] = (f32x4){0.f, 0.f, 0.f, 0.f};
    bf16x8 At[4][2], B0[2][2], B1[2][2]; i32x8 At8[4], B08[2], B18[2];
    const int one_scale = 0x7F7F7F7F;
    const char* cA; const char* cB; int nt;
    bool has_next; const char* nA; const char* nB; int nnt;
    { const Operands op = AD(cur); cA = (const char*)op.A; cB = (const char*)op.Bt; nt = op.K / 64; PG8_BOFF(cvb, op);
      has_next = S.next(1, nxt); const Operands o1 = has_next ? AD(nxt) : op; PG8_BOFF(nvb, o1); nA = (const char*)o1.A; nB = (const char*)o1.Bt; nnt = o1.K / 64;
      if constexpr (GATHER) { PG8_GIDX(cvg, op); PG8_GIDX(nvg, o1); PG8_WAIT_V(0); } else { PG8_AOFF(cvg, op); PG8_AOFF(nvg, o1); } }
    PG8_STAGE(PG8_SB(0, 0), cB, cvb[0]); PG8_STAGE(PG8_SB(0, 1), cB, cvb[1]); PG8_STAGE(PG8_SA(0, 0), cA, cvg[0]); PG8_STAGE(PG8_SA(0, 1), cA, cvg[1]);
    if (wr == 1) PG8_BAR;
    PG8_WAIT_V(2); PG8_BAR;
    PG8_STAGE(PG8_SB(1, 0), cB + kstep, cvb[0]); PG8_STAGE(PG8_SA(1, 0), cA + kstep, cvg[0]); PG8_STAGE(PG8_SB(1, 1), cB + kstep, cvb[1]);
    PG8_WAIT_V(6); PG8_BAR;
    for (;;) {
#pragma unroll 1
        for (int t = 0; t < nt; t += 2) {
            const bool last = (t == nt - 2);
            const char* a1 = cA + (size_t)(t + 1) * kstep;
            const char* a2 = last ? nA : cA + (size_t)(t + 2) * kstep; const char* b2 = last ? nB : cB + (size_t)(t + 2) * kstep;
            const char* a3 = a2 + kstep; const char* b3 = b2 + kstep;
            unsigned v2[2][2], w2[2][2];
#pragma unroll
            for (int h_ = 0; h_ < 2; ++h_)
#pragma unroll
                for (int i_ = 0; i_ < 2; ++i_) { v2[h_][i_] = last ? nvg[h_][i_] : cvg[h_][i_]; w2[h_][i_] = last ? nvb[h_][i_] : cvb[h_][i_]; }
            PG8_LDB(B0, 0, 0); PG8_LDB(B1, 0, 1); PG8_SCHED; PG8_LDA(At, 0, 0); PG8_STAGE(PG8_SA(1, 1), a1, cvg[1]);
            PG8_WAIT_V(8); PG8_WAIT_L(0); PG8_BAR; PG8_MMA(0, 0, At, B0); PG8_MMA(0, 1, At, B1); PG8_BAR; PG8_SCHED;
            PG8_LDA(At, 0, 1); PG8_STAGE(PG8_SB(0, 0), b2, w2[0]); PG8_STAGE(PG8_SB(0, 1), b2, w2[1]); PG8_STAGE(PG8_SA(0, 0), a2, v2[0]);
            PG8_WAIT_V(8); PG8_WAIT_L(0); PG8_BAR; PG8_MMA(1, 0, At, B0); PG8_MMA(1, 1, At, B1); PG8_BAR; PG8_SCHED;
            PG8_LDB(B0, 1, 0); PG8_LDB(B1, 1, 1); PG8_SCHED; PG8_LDA(At, 1, 0); PG8_STAGE(PG8_SA(0, 1), a2, v2[1]);
            PG8_WAIT_V(8); PG8_WAIT_L(0); PG8_BAR; PG8_MMA(0, 0, At, B0); PG8_MMA(0, 1, At, B1); PG8_BAR; PG8_SCHED;
            PG8_LDA(At, 1, 1); PG8_STAGE(PG8_SB(1, 0), b3, w2[0]); PG8_STAGE(PG8_SB(1, 1), b3, w2[1]); PG8_STAGE(PG8_SA(1, 0), a3, v2[0]);
            PG8_WAIT_V(8); PG8_WAIT_L(0); PG8_BAR; PG8_MMA(1, 0, At, B0); PG8_MMA(1, 1, At, B1); PG8_BAR; PG8_SCHED;
        }
        if constexpr (FP8) asm volatile("s_nop 15\n\ts_nop 15" ::: "memory");
        if (wr == 0) PG8_BAR;
        unsigned fvg[2][2], fvb[2][2];
        Unit u2; const bool h2 = S.next(ui + 2, u2); const char* fA = nA; const char* fB = nB; int fnt = nnt;
        if (h2) { const Operands o2 = AD(u2); fA = (const char*)o2.A; fB = (const char*)o2.Bt; fnt = o2.K / 64; PG8_BOFF(fvb, o2); if constexpr (GATHER) PG8_GIDX(fvg, o2); else PG8_AOFF(fvg, o2); }
        else { PG8_COPY(fvb, nvb); PG8_COPY(fvg, nvg); }
        { int fr2 = fr, fq2 = fq; asm volatile("" : "+v"(fr2), "+v"(fq2));
          E(acc, cur, wr, wc, fr2, fq2); }
        if (!has_next) break;
        if constexpr (GATHER) PG8_WAIT_V(0);
        PG8_COPY(cvg, nvg); PG8_COPY(nvg, fvg); PG8_COPY(cvb, nvb); PG8_COPY(nvb, fvb);
        if (E.reset(cur)) {
#pragma unroll
        for (int a = 0; a < 2; ++a)
#pragma unroll
            for (int b = 0; b < 2; ++b)
#pragma unroll
                for (int m = 0; m < 4; ++m)
#pragma unroll
                    for (int n = 0; n < 2; ++n) acc[a][b][m][n] = (f32x4){0.f, 0.f, 0.f, 0.f};
        }
        cur = nxt; cA = nA; cB = nB; nt = nnt; ++ui;
        nxt = u2; has_next = h2; nA = fA; nB = fB; nnt = fnt;
        if (wr == 1) PG8_BAR;
    }
    PG8_WAIT_V(0);
    PG8_BAR;
#undef PG8_SA
#undef PG8_SB
#undef PG8_STAGE
#undef PG8_LDA
#undef PG8_LDB
#undef PG8_MMA
#undef PG8_WAIT_V
#undef PG8_WAIT_L
#undef PG8_BAR
#undef PG8_SCHED
#undef PG8_GIDX
#undef PG8_AOFF
#undef PG8_BOFF
#undef PG8_COPY
#undef PG8_RC
}
template <class F> struct EpiFn { F f; __device__ __forceinline__ void operator()(f32x4 (&acc)[2][2][4][2], const Unit& u, int wr, int wc, int fr, int fq) const { f(acc, u, wr, wc, fr, fq); } __device__ __forceinline__ bool reset(const Unit&) const { return true; } };
template <class F> __device__ __forceinline__ EpiFn<F> mk_epi(F f) { return EpiFn<F>{f}; }
template <class F> struct EpiSeg { F f; int last; __device__ __forceinline__ void operator()(f32x4 (&acc)[2][2][4][2], const Unit& u, int wr, int wc, int fr, int fq) const { f(acc, u, wr, wc, fr, fq); } __device__ __forceinline__ bool reset(const Unit& u) const { return u.seg == last; } };
template <class F> __device__ __forceinline__ EpiSeg<F> mk_epi_seg(F f, int last) { return EpiSeg<F>{f, last}; }
template <int NSEG> struct SegSched { GroupSched base; __device__ __forceinline__ bool next(int j, Unit& u) const { if (!base.next(j / NSEG, u)) return false; u.seg = j % NSEG; return true; } };
#ifndef DUP_PH
#define DUP_PH -1
#endif
#define REP_BEGIN(k) _Pragma("unroll 1") for (int rep_ = 0; rep_ < ((DUP_PH == (k)) ? 2 : 1); ++rep_) { if (rep_) { if constexpr (PH < 0) xcd_barrier(bar); }
#define REP_END }
#define GEMM(S, AD, E, K, lda, ldb) gemm_fast<false, false, false>(F.lds, F.tid, S, AD, mk_epi(E), nullptr)
#define GEMM_P(S, AD, E) gemm_fast<false, true, false>(F.lds, F.tid, S, AD, mk_epi(E), nullptr)
#define GEMM_P8(S, AD, E) gemm_fast<false, true, true>(F.lds, F.tid, S, AD, mk_epi(E), nullptr)
#define GEMM_GATHER8(S, AD, E, rows) gemm_fast<true, true, true>(F.lds, F.tid, S, AD, mk_epi(E), rows)
#define EPI_ARGS f32x4 (&acc)[2][2][4][2], const Unit& u, int wr, int wc, int fr, int fq
#define EPI_FOR(...) _Pragma("unroll") for (int ai = 0; ai < 2; ++ai) _Pragma("unroll") for (int m = 0; m < 4; ++m) { const int r = ai * 128 + wr * 64 + m * 16 + fr; \
    _Pragma("unroll") for (int bj = 0; bj < 2; ++bj) _Pragma("unroll") for (int n = 0; n < 2; ++n) { const int c = bj * 128 + wc * 32 + n * 16 + 4 * fq; const f32x4 v = acc[ai][bj][m][n]; __VA_ARGS__ } }
#define EPI_FOR8(...) _Pragma("unroll") for (int ai = 0; ai < 2; ++ai) _Pragma("unroll") for (int m = 0; m < 4; ++m) { const int r = ai * 128 + wr * 64 + m * 16 + fr; \
    _Pragma("unroll") for (int bj = 0; bj < 2; ++bj) { const int c = bj * 128 + wc * 32 + 8 * fq; const f32x4 v0 = acc[ai][bj][m][0], v1 = acc[ai][bj][m][1]; __VA_ARGS__ } }
__device__ __forceinline__ void st_bf8(bf16* p, f32x4 a, f32x4 b) { u32x4 w; w.x = pk2(a[0], a[1]); w.y = pk2(a[2], a[3]); w.z = pk2(b[0], b[1]); w.w = pk2(b[2], b[3]); *(u32x4*)p = w; }
__device__ __forceinline__ void st_bf4(bf16* p, f32x4 v) { u32x2 w; w.x = pk2(v[0], v[1]); w.y = pk2(v[2], v[3]); *(u32x2*)p = w; }

__device__ __forceinline__ void p_mod(const Params& P, Frame& F) {
    LAS float* sc = (LAS float*)F.lds;
    LAS float* red = (LAS float*)(F.lds + 9 * 1024 * 4);
    float* MOD = WSP(float, WS_MOD);
    bool have = false;
    for (int it = F.bid; it < 2 * 96; it += F.G) {
        if (!have) {
            for (int i = F.tid; i < 9 * 1024; i += NTHREADS) { const int r = i >> 10, k = i & 1023; const float v = r < 8 ? P.c[r * 1024 + k] : P.c_ctx[k]; sc[i] = v * sigmoidf_(v); }
            have = true;
        }
        __syncthreads();
        const int l = it / 96, j0 = (it % 96) * 64, jj = F.tid & 63, kc = F.tid >> 6;
        const float* W = P.ada_w + (size_t)l * 1024 * 6144 + j0 + jj;
        float a[9];
#pragma unroll
        for (int r = 0; r < 9; ++r) a[r] = 0.f;
#pragma unroll 8
        for (int k = kc * 128; k < kc * 128 + 128; ++k) { const float w = W[(size_t)k * 6144];
#pragma unroll
            for (int r = 0; r < 9; ++r) a[r] += sc[r * 1024 + k] * w; }
#pragma unroll
        for (int r = 0; r < 9; ++r) red[(kc * 9 + r) * 64 + jj] = a[r];
        __syncthreads();
        for (int o = F.tid; o < 9 * 64; o += NTHREADS) { const int r = o >> 6, j = o & 63; float s = 0.f;
#pragma unroll
            for (int q = 0; q < 8; ++q) s += red[(q * 9 + r) * 64 + j];
            MOD[((size_t)l * 9 + r) * 6144 + j0 + j] = s + P.ada_b[l * 6144 + j0 + j]; }
    }
    __syncthreads();
}
__device__ __forceinline__ void p_dftgen(Frame& F) {
    LAS float* tab = (LAS float*)F.lds;
    for (int j = F.tid; j < 4096; j += NTHREADS) tab[j] = cospif((float)j * (1.0f / 2048.0f));
    __syncthreads();
    bf16* DC_ = WSP(bf16, WS_DFTC); bf16* M1 = WSP(bf16, WS_M1T); bf16* M2 = WSP(bf16, WS_M2T);
    const int nchunk = 256 * 64 + 256 * 32 + 256 * 64;
    for (int ch = F.bid * NTHREADS + F.tid; ch < nchunk; ch += F.G * NTHREADS) {
        float v[8]; bf16* dst;
        if (ch < 256 * 64) { const int kf = ch >> 6, col0 = (ch & 63) * 8, cs = col0 >> 8, l0 = col0 & 255;
#pragma unroll
            for (int i = 0; i < 8; ++i) { const int j = ((kf * (l0 + i)) & 255) * 16; v[i] = cs ? -tab[(j + 3072) & 4095] : tab[j]; }
            dst = DC_ + (size_t)kf * 512 + col0; }
        else if (ch < 256 * 64 + 256 * 32) { const int c2 = ch - 256 * 64, row = c2 >> 5, col0 = (c2 & 31) * 8, ri = row >> 7, h = (row >> 6) & 1, k1 = row & 63, h2 = col0 >> 7, cs = (col0 >> 6) & 1, l10 = col0 & 63;
#pragma unroll
            for (int i = 0; i < 8; ++i) { const int j = ((k1 * (l10 + i)) & 63) * 64; const float c = tab[j], sn = tab[(j + 3072) & 4095];
                v[i] = (h != h2) ? 0.f : (ri == 0 ? (cs == 0 ? c : -sn) : (cs == 0 ? sn : c)); }
            dst = M1 + (size_t)row * 256 + col0; }
        else { const int c2 = ch - 256 * 64 - 256 * 32, row = c2 >> 6, col0 = (c2 & 63) * 8, q = row >> 6, k2 = row & 63, q2 = col0 >> 7, ri = (col0 >> 6) & 1, l20 = col0 & 63;
#pragma unroll
            for (int i = 0; i < 8; ++i) { const int j = ((k2 * (l20 + i)) & 63) * 64; const float c = tab[j], sn = tab[(j + 3072) & 4095];
                v[i] = (q != q2) ? 0.f : (ri == 0 ? c : -sn); }
            dst = M2 + (size_t)row * 512 + col0; }
        u32x4 o; o.x = pk2(v[0], v[1]); o.y = pk2(v[2], v[3]); o.z = pk2(v[4], v[5]); o.w = pk2(v[6], v[7]);
        *(u32x4*)dst = o;
    }
    __syncthreads();
}
__device__ __forceinline__ void transpose_item(const float* W, int ldw, int k0, int n0, bf16* WT, int ldt, int drow0, LAS float* scr, int lane) {
    f32x4 ld[8];
#pragma unroll
    for (int i = 0; i < 8; ++i) ld[i] = *(const f32x4*)(W + (size_t)(k0 + 8 * i + (lane >> 3)) * ldw + n0 + 4 * (lane & 7));
#pragma unroll
    for (int i = 0; i < 8; ++i) { LAS float* d = scr + (8 * i + (lane >> 3)) * 33 + 4 * (lane & 7); d[0] = ld[i][0]; d[1] = ld[i][1]; d[2] = ld[i][2]; d[3] = ld[i][3]; }
    LDS_WAIT(); asm volatile("" ::: "memory");
    const int c = lane & 7;
#pragma unroll
    for (int j = 0; j < 4; ++j) { const int n = (lane >> 3) + 8 * j; const LAS float* s = scr + (8 * c) * 33 + n;
        u32x4 o; o.x = pk2(s[0 * 33], s[1 * 33]); o.y = pk2(s[2 * 33], s[3 * 33]); o.z = pk2(s[4 * 33], s[5 * 33]); o.w = pk2(s[6 * 33], s[7 * 33]);
        *(u32x4*)(WT + (size_t)(drow0 + n) * ldt + k0 + 8 * c) = o; }
    LDS_WAIT(); asm volatile("" ::: "memory");
}
__device__ __forceinline__ void transpose_item8(const float* W, int ldw, int k0, int n0, unsigned char* WT, int ldt, int drow0, LAS float* scr, int lane) {
    f32x4 ld[8];
#pragma unroll
    for (int i = 0; i < 8; ++i) ld[i] = *(const f32x4*)(W + (size_t)(k0 + 8 * i + (lane >> 3)) * ldw + n0 + 4 * (lane & 7));
#pragma unroll
    for (int i = 0; i < 8; ++i) { LAS float* d = scr + (8 * i + (lane >> 3)) * 33 + 4 * (lane & 7); d[0] = ld[i][0]; d[1] = ld[i][1]; d[2] = ld[i][2]; d[3] = ld[i][3]; }
    LDS_WAIT(); asm volatile("" ::: "memory");
    const int c = lane & 7;
#pragma unroll
    for (int j = 0; j < 4; ++j) { const int n = (lane >> 3) + 8 * j; const LAS float* s = scr + (8 * c) * 33 + n;
        u32x2 o; o.x = pk4_fp8(s[0 * 33] * W8S, s[1 * 33] * W8S, s[2 * 33] * W8S, s[3 * 33] * W8S); o.y = pk4_fp8(s[4 * 33] * W8S, s[5 * 33] * W8S, s[6 * 33] * W8S, s[7 * 33] * W8S);
        *(u32x2*)(WT + (size_t)(drow0 + n) * ldt + k0 + 8 * c) = o; }
    LDS_WAIT(); asm volatile("" ::: "memory");
}
__device__ __forceinline__ void transpose_item8w(const float* W, int ldw, int k0, int n0, unsigned char* WT, int ldt, int drow0, LAS float* scr, int lane) {
    f32x4 ld[16];
#pragma unroll
    for (int i = 0; i < 16; ++i) ld[i] = *(const f32x4*)(W + (size_t)(k0 + 4 * i + (lane >> 4)) * ldw + n0 + 4 * (lane & 15));
#pragma unroll
    for (int i = 0; i < 16; ++i) { LAS float* d = scr + (4 * i + (lane >> 4)) * 65 + 4 * (lane & 15); d[0] = ld[i][0]; d[1] = ld[i][1]; d[2] = ld[i][2]; d[3] = ld[i][3]; }
    LDS_WAIT(); asm volatile("" ::: "memory");
    const int c = lane & 3;
#pragma unroll
    for (int p = 0; p < 4; ++p) { const int n = (lane >> 2) + 16 * p; const LAS float* s = scr + (16 * c) * 65 + n; u32x4 o;
#pragma unroll
        for (int q = 0; q < 4; ++q) o[q] = pk4_fp8(s[(4 * q) * 65] * W8S, s[(4 * q + 1) * 65] * W8S, s[(4 * q + 2) * 65] * W8S, s[(4 * q + 3) * 65] * W8S);
        *(u32x4*)(WT + (size_t)(drow0 + n) * ldt + k0 + 16 * c) = o; }
    LDS_WAIT(); asm volatile("" ::: "memory");
}
__device__ __forceinline__ void wconv_experts(const Params& P, Frame& F, int l, int rank, int nblk) {
    LAS float* scr = (LAS float*)(F.lds + (F.wave < 7 ? F.wave * 17408 : 131584));
    const int gw = rank * NWAVES + F.wave, NGW = nblk * NWAVES;
    constexpr int I_E = 16 * 44;
    unsigned char* WGU = WSP(unsigned char, WS_WGU); unsigned char* WD = WSP(unsigned char, WS_WD);
    for (int it = gw; it < 3 * 16 * I_E; it += NGW) {
        const int which = it / (16 * I_E), r0 = it % (16 * I_E), e = r0 / I_E, r = r0 % I_E;
        if (which < 2) { const int kb = r / 44, nb = r % 44, n0 = nb * 64;
            const float* src = (which == 0 ? P.w_eg : P.w_eu) + ((size_t)l * 16 + e) * 1024 * FF;
            transpose_item8w(src, FF, kb * 64, n0, WGU + (size_t)e * 5632 * 1024, 1024, (n0 >> 7) * 256 + (which ? 128 : 0) + (n0 & 127), scr, F.lane); }
        else { const int kb = r / 16, nb = r % 16;
            transpose_item8w(P.w_ed + ((size_t)l * 16 + e) * FF * 1024, 1024, kb * 64, nb * 64, WD + (size_t)e * 1024 * FF, FF, nb * 64, scr, F.lane); }
    }
    __syncthreads();
}
__device__ __forceinline__ void p_wconv(const Params& P, Frame& F, int l) {
    LAS float* scr = (LAS float*)(F.lds + F.wave * 16384);
    const int gw = F.bid * NWAVES + F.wave, NGW = F.G * NWAVES;
    const float* w_in = P.w_in + (size_t)l * 1024 * INW;
    bf16* WA = WSP(bf16, WS_WA); bf16* WFV = WSP(bf16, WS_WFV);
    constexpr int I_K = 16 * 32, I_Q = 16 * 32, I_P = 16 * 16, I_G = 16 * 96, I_V = 16 * 32, I_AO = 16 * 32, I_FO = 8 * 32, I_OUT = 16 * 32;
    constexpr int NSM = I_K + I_Q + I_P + I_G + I_V + I_AO + I_FO + I_OUT;
    for (int it = gw; it < NSM; it += NGW) {
        int r = it;
        if (r < I_K) { transpose_item8(w_in, INW, (r / 32) * 64, 0 + (r % 32) * 32, WSP(unsigned char, WS_WA8), 1024, 0 + (r % 32) * 32, scr, F.lane); continue; } r -= I_K;
        if (r < I_Q) { transpose_item8(w_in, INW, (r / 32) * 64, 2048 + (r % 32) * 32, WSP(unsigned char, WS_WA8), 1024, 1024 + (r % 32) * 32, scr, F.lane); continue; } r -= I_Q;
        if (r < I_P) { transpose_item(w_in, INW, (r / 16) * 64, 3584 + (r % 16) * 32, WA, 1024, 2048 + (r % 16) * 32, scr, F.lane); continue; } r -= I_P;
        if (r < I_G) { transpose_item8(w_in, INW, (r / 96) * 64, 4096 + (r % 96) * 32, WSP(unsigned char, WS_WA8), 1024, 3072 + (r % 96) * 32, scr, F.lane); continue; } r -= I_G;
        if (r < I_V) { transpose_item8(w_in, INW, (r / 32) * 64, 1024 + (r % 32) * 32, WSP(unsigned char, WS_WA8), 1024, 2048 + (r % 32) * 32, scr, F.lane); continue; } r -= I_V;
        if (r < I_AO) { transpose_item8(P.w_att_o + (size_t)l * 1024 * 1024, 1024, (r / 32) * 64, (r % 32) * 32, WSP(unsigned char, WS_WAO), 1024, (r % 32) * 32, scr, F.lane); continue; } r -= I_AO;
        if (r < I_FO) { transpose_item(P.w_fourier + (size_t)l * 512 * 1024, 1024, (r / 32) * 64, (r % 32) * 32, WSP(bf16, WS_WFO), 512, (r % 32) * 32, scr, F.lane); continue; } r -= I_FO;
        transpose_item(P.w_out + (size_t)l * 1024 * 1024, 1024, (r / 32) * 64, (r % 32) * 32, WSP(bf16, WS_WOUT), 1024, (r % 32) * 32, scr, F.lane);
    }
    { bf16* WPO = WSP(bf16, WS_WPO); const float* wp = P.w_pool + (size_t)l * 4 * 128 * 256;
      for (int i = F.bid * NTHREADS + F.tid; i < 1024 * 256; i += F.G * NTHREADS) { const int n = i >> 8, kk = i & 255, g = n >> 8, f = n & 255;
          WPO[i] = (bf16)(((kk >> 7) == (g & 1)) ? f2bf(wp[((size_t)g * 128 + (kk & 127)) * 256 + f]) : 0u); } }
    { LAS float* t128 = (LAS float*)F.lds;
      __syncthreads();
      for (int j = F.tid; j < 128; j += NTHREADS) t128[j] = cospif((float)j * (1.0f / 64.0f));
      __syncthreads();
      for (int i = F.bid * NTHREADS + F.tid; i < 1024 * 1024; i += F.G * NTHREADS) { const int fc = i >> 10, k = i & 1023, cs = fc & 1, gm = fc >> 1, g = gm >> 7, m = gm & 127;
          const float* src = w_in + (size_t)k * INW + 3072 + g * 128; float s = 0.f; const int ph = cs ? 96 : 0;
          for (int c = 0; c < 128; ++c) s += src[c] * t128[(m * c + ph) & 127];
          WFV[i] = (bf16)f2bf(s); }
      __syncthreads(); }
}

struct RowMod { const float* g; const float* sh; const float* sc; };
__device__ __forceinline__ void row_load(const float* row, int lane, f32x4 (&v)[4]) {
#pragma unroll
    for (int j = 0; j < 4; ++j) v[j] = *(const f32x4*)(row + 4 * lane + 256 * j);
}
__device__ __forceinline__ void row_load_bf(const bf16* row, int lane, f32x4 (&v)[4]) {
#pragma unroll
    for (int j = 0; j < 4; ++j) { const u32x2 w = *(const u32x2*)(row + 4 * lane + 256 * j); v[j] = (f32x4){bflo(w.x), bfhi(w.x), bflo(w.y), bfhi(w.y)}; }
}
__device__ __forceinline__ float row_rstd(const f32x4 (&v)[4]) {
    float s = 0.f;
#pragma unroll
    for (int j = 0; j < 4; ++j) s += (v[j][0] * v[j][0] + v[j][1] * v[j][1]) + (v[j][2] * v[j][2] + v[j][3] * v[j][3]);
    return rsqrtf(wave_sum(s) * (1.0f / 1024.0f) + RMS_EPS);
}
__device__ __forceinline__ void row_modulate(const f32x4 (&v)[4], float rstd, const RowMod& M, int lane, f32x4 (&y)[4]) {
#pragma unroll
    for (int j = 0; j < 4; ++j) { const int k = 4 * lane + 256 * j; const f32x4 g = *(const f32x4*)(M.g + k), sh = *(const f32x4*)(M.sh + k), sc = *(const f32x4*)(M.sc + k);
        y[j] = v[j] * rstd * g * (sc + 1.0f) + sh; }
}
__device__ __forceinline__ void row_store_bf(bf16* row, int lane, const f32x4 (&y)[4]) {
#pragma unroll
    for (int j = 0; j < 4; ++j) st_bf4(row + 4 * lane + 256 * j, y[j]);
}
__device__ __forceinline__ void row_store_f8(unsigned char* row, int lane, const f32x4 (&y)[4]) {
#pragma unroll
    for (int j = 0; j < 4; ++j) *(unsigned*)(row + 4 * lane + 256 * j) = pk4_fp8(y[j][0] * A8S, y[j][1] * A8S, y[j][2] * A8S, y[j][3] * A8S);
}
__device__ __forceinline__ const float* mod_ptr(Frame& F, int l, int row, int which) { const int mr = row < RL ? (row >> 12) : 8; return WSP(float, WS_MOD) + ((size_t)l * 9 + mr) * 6144 + which * 1024; }

__device__ __forceinline__ void row_modulate2(const f32x4 (&v0)[4], const f32x4 (&v1)[4], float rs0, float rs1, const RowMod& M, int lane, f32x4 (&y0)[4], f32x4 (&y1)[4]) {
#pragma unroll
    for (int j = 0; j < 4; ++j) { const int k = 4 * lane + 256 * j; const f32x4 g = *(const f32x4*)(M.g + k), sh = *(const f32x4*)(M.sh + k), sc = *(const f32x4*)(M.sc + k); const f32x4 m = g * (sc + 1.0f);
        y0[j] = v0[j] * rs0 * m + sh; y1[j] = v1[j] * rs1 * m + sh; }
}
__device__ __forceinline__ void p_rowpass_a0(const Params& P, Frame& F) {
    const int gw = F.bid * NWAVES + F.wave, NGW = F.G * NWAVES; bf16* H = WSP(bf16, WS_H); unsigned char* H8 = WSP(unsigned char, WS_H8);
    f32x4 vn[2][4]; int p = gw;
    if (p < RT / 2) { const int row = 2 * p; const float* src = row < RL ? P.x + (size_t)row * DM : P.ctx + (size_t)(row - RL) * DM; row_load(src, F.lane, vn[0]); row_load(src + DM, F.lane, vn[1]); }
    for (; p < RT / 2; p += NGW) { const int row = 2 * p;
        f32x4 v0[4], v1[4], y0[4], y1[4];
#pragma unroll
        for (int j = 0; j < 4; ++j) { v0[j] = vn[0][j]; v1[j] = vn[1][j]; }
        { const int nr = 2 * (p + NGW); if (nr < RT) { const float* src = nr < RL ? P.x + (size_t)nr * DM : P.ctx + (size_t)(nr - RL) * DM; row_load(src, F.lane, vn[0]); row_load(src + DM, F.lane, vn[1]); } }
        const float rs0 = row_rstd(v0), rs1 = row_rstd(v1);
        RowMod M{P.norm1_g, mod_ptr(F, 0, row, 0), mod_ptr(F, 0, row, 1)};
        row_modulate2(v0, v1, rs0, rs1, M, F.lane, y0, y1);
        row_store_bf(H + (size_t)row * DM, F.lane, y0); row_store_f8(H8 + (size_t)row * DM, F.lane, y0);
        row_store_bf(H + (size_t)(row + 1) * DM, F.lane, y1); row_store_f8(H8 + (size_t)(row + 1) * DM, F.lane, y1);
    }
}
constexpr int DPP_MIRROR = 0x140, DPP_HMIRROR = 0x141;
__device__ __forceinline__ void p_rowpass_k(const Params& P, Frame& F, int l, int nrows) {
    const int gw = F.bid * NWAVES + F.wave, NGW = F.G * NWAVES; bf16* H = WSP(bf16, WS_H);
    const int* SEL = WSP(int, WS_SEL); const bf16* Y = WSP(bf16, WS_Y);
    f32x4 vn[2][4]; int seln = -1; int p = gw; const int NP = nrows >> 1;
    bf16* XB = WSP(bf16, WS_XB);
    if (p < NP) { const int row = 2 * p; const bf16* src = XB + (size_t)row * DM; row_load_bf(src, F.lane, vn[0]); row_load_bf(src + DM, F.lane, vn[1]);
        seln = F.lane < 32 ? SEL[(size_t)row * 16 + F.lane] : -1; }
    for (; p < NP; p += NGW) { const int row = 2 * p;
        f32x4 v0[4], v1[4], a0[4], a1[4]; const int sel = seln;
#pragma unroll
        for (int j = 0; j < 4; ++j) { v0[j] = vn[0][j]; v1[j] = vn[1][j]; a0[j] = (f32x4){0.f, 0.f, 0.f, 0.f}; a1[j] = (f32x4){0.f, 0.f, 0.f, 0.f}; }
        { const int nr = 2 * (p + NGW); if (nr < nrows) { const bf16* src = XB + (size_t)nr * DM; row_load_bf(src, F.lane, vn[0]); row_load_bf(src + DM, F.lane, vn[1]);
            seln = F.lane < 32 ? SEL[(size_t)nr * 16 + F.lane] : -1; } }
        const unsigned emall = (unsigned)__ballot(sel >= 0);
        unsigned em = emall & 0xffffu;
        while (em) { const int e = __builtin_ctz(em); em &= em - 1; const int s = __builtin_amdgcn_readlane(sel, e); const bf16* yr = Y + (size_t)s * DM;
#pragma unroll
            for (int j = 0; j < 4; ++j) { const u32x2 w = *(const u32x2*)(yr + 4 * F.lane + 256 * j); a0[j][0] += bflo(w.x); a0[j][1] += bfhi(w.x); a0[j][2] += bflo(w.y); a0[j][3] += bfhi(w.y); } }
        em = (emall >> 16) & 0xffffu;
        while (em) { const int e = __builtin_ctz(em); em &= em - 1; const int s = __builtin_amdgcn_readlane(sel, 16 + e); const bf16* yr = Y + (size_t)s * DM;
#pragma unroll
            for (int j = 0; j < 4; ++j) { const u32x2 w = *(const u32x2*)(yr + 4 * F.lane + 256 * j); a1[j][0] += bflo(w.x); a1[j][1] += bfhi(w.x); a1[j][2] += bflo(w.y); a1[j][3] += bfhi(w.y); } }
        const float* g2 = mod_ptr(F, l, row, 5);
#pragma unroll
        for (int j = 0; j < 4; ++j) { const f32x4 g = *(const f32x4*)(g2 + 4 * F.lane + 256 * j); v0[j] = v0[j] + g * a0[j]; v1[j] = v1[j] + g * a1[j]; }
        const float rs0 = row_rstd(v0), rs1 = row_rstd(v1);
        if (l == 0) {
#pragma unroll
            for (int j = 0; j < 4; ++j) { st_bf4(XB + (size_t)row * DM + 4 * F.lane + 256 * j, v0[j]); st_bf4(XB + (size_t)(row + 1) * DM + 4 * F.lane + 256 * j, v1[j]); }
            f32x4 y0[4], y1[4]; RowMod M{P.norm1_g + 1024, mod_ptr(F, 1, row, 0), mod_ptr(F, 1, row, 1)};
            row_modulate2(v0, v1, rs0, rs1, M, F.lane, y0, y1);
            row_store_bf(H + (size_t)row * DM, F.lane, y0); row_store_f8(WSP(unsigned char, WS_H8) + (size_t)row * DM, F.lane, y0);
            row_store_bf(H + (size_t)(row + 1) * DM, F.lane, y1); row_store_f8(WSP(unsigned char, WS_H8) + (size_t)(row + 1) * DM, F.lane, y1);
        } else {
#pragma unroll
            for (int j = 0; j < 4; ++j) { const f32x4 g = *(const f32x4*)(P.final_g + 4 * F.lane + 256 * j); float* xr = P.out + (size_t)row * DM + 4 * F.lane + 256 * j; *(f32x4*)xr = v0[j] * rs0 * g; *(f32x4*)(xr + DM) = v1[j] * rs1 * g; }
        }
    }
}

constexpr int RF_WH = 0, RF_WL = 16 * RF_PITCH * 2, RF_M8 = 2 * RF_WL, RF_S8 = RF_M8 + 4096, RF_BIAS = RF_S8 + 4096, RF_RS = RF_BIAS + 64;
__device__ __forceinline__ void p_rftables(const Params& P, Frame& F) {
    LAS float* red = (LAS float*)F.lds;
    for (int job = F.bid; job < 2 * 9 * 16; job += F.G) { const int e = job & 15, lm = job >> 4, l = lm / 9;
        int tid = F.tid; asm volatile("" : "+v"(tid));
        const float* wr = P.w_router + (size_t)l * 1024 * 16; const float* g2n = P.norm2_g + l * 1024;
        const float* sh = WSP(float, WS_MOD) + (size_t)lm * 6144 + 3 * 1024; const float* sc = sh + 1024;
        unsigned char* T = WSP(unsigned char, WS_RFT) + (size_t)lm * RF_TBL;
        float bs = 0.f;
#pragma unroll
        for (int q = 0; q < 2; ++q) { const int k = tid + 512 * q; const float m = g2n[k] * (1.0f + sc[k]), r = wr[k * 16 + e], w = m * r;
            const unsigned hi = f2bf(w); const float lo = w - bf2f(hi);
            ((bf16*)(T + RF_WH))[e * RF_PITCH + k] = (bf16)hi; ((bf16*)(T + RF_WL))[e * RF_PITCH + k] = (bf16)f2bf(lo);
            bs += sh[k] * r;
            if (e == 0) { ((float*)(T + RF_M8))[k] = m * A8S; ((float*)(T + RF_S8))[k] = sh[k] * A8S; } }
        bs = wave_sum(bs);
        __syncthreads();
        if (F.lane == 0) red[F.wave] = bs;
        __syncthreads();
        if (tid == 0) { float a = 0.f;
#pragma unroll
            for (int w = 0; w < NWAVES; ++w) a += red[w];
            ((float*)(T + RF_BIAS))[e] = a; }
    }
    __syncthreads();
}
__device__ __forceinline__ void rf_copy(Frame& F, const unsigned char* T) {
    int tid = F.tid; asm volatile("" : "+v"(tid));
    __syncthreads();
    u32x4 v[10];
#pragma unroll
    for (int q = 0; q < 10; ++q) { const int c = tid + 512 * q; if (c < RF_TBL / 16) v[q] = *(const u32x4*)(T + (size_t)c * 16); }
#pragma unroll
    for (int q = 0; q < 10; ++q) { const int c = tid + 512 * q; if (c < RF_TBL / 16) *(LAS u32x4*)(F.lds + c * 16) = v[q]; }
    __syncthreads();
}
__device__ __forceinline__ void rf_compute(Frame& F, const u32x4 (&xw)[32], unsigned char* H8, float* AFF, int row0) {
    const int i = F.lane & 15, g = F.lane >> 4;
    int og = 8 * g; asm volatile("" : "+v"(og));
    f32x2 s2 = {0.f, 0.f};
#pragma unroll
    for (int t = 0; t < 32; ++t)
#pragma unroll
        for (int q = 0; q < 4; ++q) { const f32x2 v = {bflo(xw[t][q]), bfhi(xw[t][q])}; s2 += v * v; }
    float ss = s2[0] + s2[1];
    { auto a = __builtin_amdgcn_permlane16_swap(__float_as_uint(ss), __float_as_uint(ss), false, false); ss = __uint_as_float(a[0]) + __uint_as_float(a[1]);
      auto b = __builtin_amdgcn_permlane32_swap(__float_as_uint(ss), __float_as_uint(ss), false, false); ss = __uint_as_float(b[0]) + __uint_as_float(b[1]); }
    const float rstd = rsqrtf(ss * (1.0f / 1024.0f) + RMS_EPS);
    LAS float* RS = (LAS float*)(F.lds + RF_RS) + F.wave * 16;
    if (F.lane < 16) RS[F.lane] = rstd;
    f32x4 acc = {0.f, 0.f, 0.f, 0.f};
    const LAS unsigned char* wb = F.lds + (i * RF_PITCH + og) * 2;
#pragma unroll
    for (int t = 0; t < 32; ++t) { const bf16x8 bh = *(const LAS bf16x8*)(wb + RF_WH + 64 * t), bl = *(const LAS bf16x8*)(wb + RF_WL + 64 * t); const bf16x8 a = __builtin_bit_cast(bf16x8, xw[t]);
        acc = __builtin_amdgcn_mfma_f32_16x16x32_bf16(a, bh, acc, 0, 0, 0); acc = __builtin_amdgcn_mfma_f32_16x16x32_bf16(a, bl, acc, 0, 0, 0);
        if ((t & 3) == 3) asm volatile("" ::: "memory"); }
    { const LAS float* M8 = (const LAS float*)(F.lds + RF_M8) + og; const LAS float* S8 = (const LAS float*)(F.lds + RF_S8) + og; unsigned char* hr = H8 + (size_t)(row0 + i) * DM + 8 * g;
#pragma unroll
      for (int t = 0; t < 32; ++t) { const f32x4 m0 = *(const LAS f32x4*)(M8 + 32 * t), m1 = *(const LAS f32x4*)(M8 + 32 * t + 4), h0 = *(const LAS f32x4*)(S8 + 32 * t), h1 = *(const LAS f32x4*)(S8 + 32 * t + 4);
          u32x4 x = xw[t]; asm volatile("" : "+v"(x));
          const f32x4 xa = {bflo(x[0]), bfhi(x[0]), bflo(x[1]), bfhi(x[1])}, xb = {bflo(x[2]), bfhi(x[2]), bflo(x[3]), bfhi(x[3])};
          const f32x4 ya = xa * rstd * m0 + h0, yb = xb * rstd * m1 + h1;
          u32x2 w; w.x = pk4_fp8(ya[0], ya[1], ya[2], ya[3]); w.y = pk4_fp8(yb[0], yb[1], yb[2], yb[3]); *(u32x2*)(hr + 32 * t) = w;
          if (t & 1) asm volatile("" ::: "memory"); } }
    LDS_WAIT(); asm volatile("" ::: "memory");
    const f32x4 rs4 = *(const LAS f32x4*)(RS + 4 * g); const float bias = ((const LAS float*)(F.lds + RF_BIAS))[i];
#pragma unroll
    for (int r = 0; r < 4; ++r) { const float lg = acc[r] * rs4[r] + bias; float mx = lg;
        mx = fmaxf(mx, dppf<DPP_XOR1>(mx)); mx = fmaxf(mx, dppf<DPP_XOR2>(mx)); mx = fmaxf(mx, dppf<DPP_HMIRROR>(mx)); mx = fmaxf(mx, dppf<DPP_MIRROR>(mx));
        const float ex = __expf(lg - mx); float den = ex;
        den += dppf<DPP_XOR1>(den); den += dppf<DPP_XOR2>(den); den += dppf<DPP_HMIRROR>(den); den += dppf<DPP_MIRROR>(den);
        AFF[(size_t)(row0 + 4 * g + r) * 16 + i] = ex / den; }
}
__device__ __forceinline__ void p_rowpass_f(const Params& P, Frame& F, int l, int nrows) {
    const bf16* XB = WSP(bf16, WS_XB); unsigned char* H8 = WSP(unsigned char, WS_H8); float* AFF = WSP(float, WS_AFF);
    int cur = -1;
    for (int it = F.bid; it < nrows / 128; it += F.G) { const int row0 = it * 128 + 16 * F.wave, mr = row0 < RL ? (row0 >> 12) : 8;
        const bf16* xr = XB + (size_t)(row0 + (F.lane & 15)) * DM + 8 * (F.lane >> 4);
        u32x4 xw[32];
#pragma unroll
        for (int t = 0; t < 32; ++t) xw[t] = *(const u32x4*)(xr + 32 * t);
        if (mr != cur) { rf_copy(F, WSP(unsigned char, WS_RFT) + (size_t)(l * 9 + mr) * RF_TBL); cur = mr; }
        rf_compute(F, xw, H8, AFF, row0); }
    __syncthreads();
}
constexpr int ACK_STRIDE = 72, ACV_STRIDE = 264;
constexpr int ALDS_CK = 0, ALDS_CV = 256 * ACK_STRIDE * 2, ALDS_RP = ALDS_CV + 64 * ACV_STRIDE * 2;
struct AttnState { float m, sum; f32x4 o[4]; };
__device__ __forceinline__ float xrow16_max(float x) {
    auto s = __builtin_amdgcn_permlane16_swap(__float_as_uint(x), __float_as_uint(x), false, false);
    x = fmaxf(__uint_as_float(s[0]), __uint_as_float(s[1]));
    auto t = __builtin_amdgcn_permlane32_swap(__float_as_uint(x), __float_as_uint(x), false, false);
    return fmaxf(__uint_as_float(t[0]), __uint_as_float(t[1]));
}
__device__ __forceinline__ float xrow16_sum(float x) {
    auto s = __builtin_amdgcn_permlane16_swap(__float_as_uint(x), __float_as_uint(x), false, false);
    x = __uint_as_float(s[0]) + __uint_as_float(s[1]);
    auto t = __builtin_amdgcn_permlane32_swap(__float_as_uint(x), __float_as_uint(x), false, false);
    return __uint_as_float(t[0]) + __uint_as_float(t[1]);
}
#define MFMA16(a, b, c) __builtin_amdgcn_mfma_f32_16x16x32_bf16((a), (b), (c), 0, 0, 0)
template <int NT>
__device__ __forceinline__ void attn_tail(AttnState& S, f32x4 (&sc)[NT], const u32x4 (&vw)[NT / 2][4]) {
    float cm = -__builtin_inff();
#pragma unroll
    for (int t = 0; t < NT; ++t)
#pragma unroll
        for (int j = 0; j < 4; ++j) cm = fmaxf(cm, sc[t][j]);
    cm = xrow16_max(cm);
    const bool need = (fabsf(cm) > 12.0f) && (cm > -1e30f);
    if (__builtin_amdgcn_ballot_w64(need) != 0ull) {
        const float d = need ? cm : 0.f, scl = __builtin_amdgcn_exp2f(-d);
        S.m += d; S.sum *= scl;
#pragma unroll
        for (int dt = 0; dt < 4; ++dt) S.o[dt] = S.o[dt] * scl;
#pragma unroll
        for (int t = 0; t < NT; ++t)
#pragma unroll
            for (int j = 0; j < 4; ++j) sc[t][j] -= d;
    }
    float ps = 0.f;
#pragma unroll
    for (int t = 0; t < NT; ++t)
#pragma unroll
        for (int j = 0; j < 4; ++j) { const float p = __builtin_amdgcn_exp2f(sc[t][j]); sc[t][j] = p; ps += p; }
    S.sum += ps;
#pragma unroll
    for (int ks = 0; ks < NT / 2; ++ks) { u32x4 pw; pw.x = pk2(sc[2 * ks][0], sc[2 * ks][1]); pw.y = pk2(sc[2 * ks][2], sc[2 * ks][3]); pw.z = pk2(sc[2 * ks + 1][0], sc[2 * ks + 1][1]); pw.w = pk2(sc[2 * ks + 1][2], sc[2 * ks + 1][3]);
        const bf16x8 pf = __builtin_bit_cast(bf16x8, pw);
#pragma unroll
        for (int dt = 0; dt < 4; ++dt) S.o[dt] = MFMA16(__builtin_bit_cast(bf16x8, vw[ks][dt]), pf, S.o[dt]); }
}
__device__ __forceinline__ void attn_unit2(const bf16* __restrict__ KQ, const bf16* __restrict__ VT, unsigned char* __restrict__ ATT, LAS unsigned char* lds,
                                           const int b, const int h, const int rowqA, const int rowqB, const bool win, const int r, const int qt, const int lane) {
    const int l15 = lane & 15, g = lane >> 4;
    const f32x4 z = {0.f, 0.f, 0.f, 0.f};
    bf16x8 qA[2], qB[2];
    { const bf16* qp = KQ + (size_t)(rowqA + l15) * 2048 + 1024 + h * 64 + 8 * g; qA[0] = *(const bf16x8*)qp; qA[1] = *(const bf16x8*)(qp + 32); }
    { const bf16* qp = KQ + (size_t)(rowqB + l15) * 2048 + 1024 + h * 64 + 8 * g; qB[0] = *(const bf16x8*)qp; qB[1] = *(const bf16x8*)(qp + 32); }
    AttnState SA, SB; SA.m = 0.f; SA.sum = 0.f; SB.m = 0.f; SB.sum = 0.f;
#pragma unroll
    for (int dt = 0; dt < 4; ++dt) { SA.o[dt] = z; SB.o[dt] = z; }
    if (win) {
        const int rsA = min(max(r - 4, 0), 56), dB = min(max(r - 3, 0), 56) - rsA, kc0 = min(max(16 * qt - 8, 0), 32);
        const int q = 16 * qt + l15, csq = min(max(q - 8, 0), 48);
        const int krow0 = 8 * (l15 >> 2) + (l15 & 3);
        const bf16* kb = KQ + (size_t)(b * SEQ + kc0 + krow0) * 2048 + h * 64 + 8 * g;
        const bf16* vb = VT + (size_t)(b * 1024 + h * 64 + l15) * 4096 + kc0 + 8 * g;
        const LAS float* rp = (const LAS float*)(lds + ALDS_RP);
        const int jb = kc0 + 8 * g;
        const int okb = jb - csq;
        const LAS float* rpl = rp + 16 + (jb - q + 15);
        float madd[2][4];
#pragma unroll
        for (int t = 0; t < 2; ++t)
#pragma unroll
            for (int j = 0; j < 4; ++j) madd[t][j] = ((unsigned)(okb + 4 * t + j) < 16u) ? 0.f : -__builtin_inff();
        bf16x8 K0[2][2], K1[2][2]; u32x4 V0[1][4], V1[1][4];
#define ATT_LOADW(KB, VB, i) do { const int gr_ = min(rsA + (i), 63); const bf16* kp_ = kb + (size_t)(gr_ * 64) * 2048; const bf16* vp_ = vb + gr_ * 64; \
        _Pragma("unroll") for (int t = 0; t < 2; ++t) { KB[t][0] = *(const bf16x8*)(kp_ + (size_t)(4 * t) * 2048); KB[t][1] = *(const bf16x8*)(kp_ + (size_t)(4 * t) * 2048 + 32); } \
        _Pragma("unroll") for (int dt = 0; dt < 4; ++dt) VB[0][dt] = *(const u32x4*)(vp_ + (size_t)(16 * dt) * 4096); } while (0)
#define ATT_ONE(ST, QF, KB, VB, roff, rowok) do { f32x4 sc[2]; \
        const LAS float* bp_ = rpl + ((rowok) ? (roff) : 15) * 64; \
        _Pragma("unroll") for (int t = 0; t < 2; ++t) _Pragma("unroll") for (int j = 0; j < 4; ++j) sc[t][j] = (bp_[4 * t + j] + madd[t][j]) - ST.m;     \
        _Pragma("unroll") for (int t = 0; t < 2; ++t) { sc[t] = MFMA16(KB[t][0], QF[0], sc[t]); sc[t] = MFMA16(KB[t][1], QF[1], sc[t]); } \
        attn_tail<2>(ST, sc, VB); } while (0)
#define ATT_COMPUTE(KB, VB, i) do { const int roffA_ = min(rsA + (i) - r + 7, 14); \
        ATT_ONE(SA, qA, KB, VB, roffA_, (i) <= 7); \
        ATT_ONE(SB, qB, KB, VB, max(roffA_ - 1, 0), (i) >= dB && (i) <= 7 + dB); } while (0)
        ATT_LOADW(K0, V0, 0);
#pragma unroll 1
        for (int i = 0; i < 8; i += 2) { ATT_LOADW(K1, V1, i + 1); ATT_COMPUTE(K0, V0, i); ATT_LOADW(K0, V0, i + 2); ATT_COMPUTE(K1, V1, i + 1); }
        ATT_COMPUTE(K0, V0, 8);
#undef ATT_LOADW
#undef ATT_ONE
#undef ATT_COMPUTE
    }
    { const LAS bf16* ck = (const LAS bf16*)(lds + ALDS_CK) + l15 * ACK_STRIDE + 8 * g;
      const LAS bf16* cv = (const LAS bf16*)(lds + ALDS_CV) + l15 * ACV_STRIDE + 8 * g;
#pragma unroll 1
      for (int c = 0; c < 4; ++c) {
          bf16x8 kf[4][2]; u32x4 vw[2][4];
#pragma unroll
          for (int t = 0; t < 4; ++t) { const LAS bf16* kp = ck + (64 * c + 16 * t) * ACK_STRIDE; kf[t][0] = *(const LAS bf16x8*)kp; kf[t][1] = *(const LAS bf16x8*)(kp + 32); }
#pragma unroll
          for (int ks = 0; ks < 2; ++ks)
#pragma unroll
              for (int dt = 0; dt < 4; ++dt) vw[ks][dt] = *(const LAS u32x4*)(cv + (16 * dt) * ACV_STRIDE + 64 * c + 32 * ks);
          { f32x4 sc[4]; const float nm = -SA.m; const f32x4 c0 = {nm, nm, nm, nm};
#pragma unroll
            for (int t = 0; t < 4; ++t) { sc[t] = MFMA16(kf[t][0], qA[0], c0); sc[t] = MFMA16(kf[t][1], qA[1], sc[t]); }
            attn_tail<4>(SA, sc, vw); }
          { f32x4 sc[4]; const float nm = -SB.m; const f32x4 c0 = {nm, nm, nm, nm};
#pragma unroll
            for (int t = 0; t < 4; ++t) { sc[t] = MFMA16(kf[t][0], qB[0], c0); sc[t] = MFMA16(kf[t][1], qB[1], sc[t]); }
            attn_tail<4>(SB, sc, vw); }
      } }
    { const float inv = 1.0f / xrow16_sum(SA.sum);
#pragma unroll
      for (int dt = 0; dt < 4; ++dt) { const f32x4 o = SA.o[dt] * (inv * ATS); *(unsigned*)(ATT + (size_t)(rowqA + l15) * 1024 + h * 64 + 16 * dt + 4 * g) = pk4_fp8(o[0], o[1], o[2], o[3]); } }
    { const float inv = 1.0f / xrow16_sum(SB.sum);
#pragma unroll
      for (int dt = 0; dt < 4; ++dt) { const f32x4 o = SB.o[dt] * (inv * ATS); *(unsigned*)(ATT + (size_t)(rowqB + l15) * 1024 + h * 64 + 16 * dt + 4 * g) = pk4_fp8(o[0], o[1], o[2], o[3]); } }
}
__device__ __forceinline__ void p_attn_mfma(const Params& P, Frame& F, int l, bool with_ctx_queries, int nblk, int rank) {
    const bf16* KQ = WSP(bf16, WS_KQ); const bf16* VT = WSP(bf16, WS_VT); unsigned char* ATT = WSP(unsigned char, WS_ATT);
    const float* rpb = P.rpb + (size_t)l * 16 * 465;
    const int it0 = (int)(((long)rank * 1024) / nblk), it1 = (int)(((long)(rank + 1) * 1024) / nblk);
    int pcur = -1;
    for (int hp = it0; hp < it1; ++hp) {
        const int p = hp >> 3, eighth = hp & 7, b = p >> 4, h = p & 15;
        if (p != pcur) { pcur = p;
        __syncthreads();
        { LAS bf16* ck = (LAS bf16*)(F.lds + ALDS_CK); LAS bf16* cv = (LAS bf16*)(F.lds + ALDS_CV); LAS float* rp = (LAS float*)(F.lds + ALDS_RP);
          { const int key = F.tid >> 1, hf = F.tid & 1; const int k32 = key & 31, pos = (key & ~31) + ((k32 >> 2) & 1) * 16 + 4 * (k32 >> 3) + (k32 & 3);
            const u32x4* src = (const u32x4*)(KQ + (size_t)(RL + b * CTXL + key) * 2048 + h * 64 + hf * 32); LAS u32x4* dst = (LAS u32x4*)(ck + pos * ACK_STRIDE + hf * 32);
#pragma unroll
            for (int i = 0; i < 4; ++i) dst[i] = src[i]; }
          { const int d = F.tid >> 3, sg = F.tid & 7; const u32x4* src = (const u32x4*)(VT + YT_CTX_OFF + (size_t)(b * 1024 + h * 64 + d) * 256 + sg * 32); LAS u32x4* dst = (LAS u32x4*)(cv + d * ACV_STRIDE + sg * 32);
#pragma unroll
            for (int i = 0; i < 4; ++i) dst[i] = src[i]; }
          for (int i = F.tid; i < 16 * 64; i += NTHREADS) { const int rr = i >> 6, cc = (i & 63) - 16; rp[i] = rr == 15 ? -__builtin_inff() : ((cc >= 0 && cc < 31) ? rpb[h * 465 + rr * 31 + cc] * LOG2E : 0.f); } }
        __syncthreads(); }
        const int qt = F.wave & 3, rpi = F.wave >> 2;
#pragma unroll 1
        for (int st = 0; st < 2; ++st) { const int r = eighth * 8 + st * 4 + rpi * 2; const int rowqA = b * SEQ + r * 64 + 16 * qt;
            attn_unit2(KQ, VT, ATT, F.lds, b, h, rowqA, rowqA + 64, true, r, qt, F.lane); }
        if (with_ctx_queries && eighth == 0) { const int rowqA = RL + b * CTXL + 32 * F.wave; attn_unit2(KQ, VT, ATT, F.lds, b, h, rowqA, rowqA + 16, false, 0, 0, F.lane); }
    }
    __syncthreads();
}

__device__ __forceinline__ void ld8(const bf16* p, float (&x)[8]) { const u32x4 w = *(const u32x4*)p;
#pragma unroll
    for (int q = 0; q < 4; ++q) { x[2 * q] = bflo(w[q]); x[2 * q + 1] = bfhi(w[q]); } }
__device__ __forceinline__ void p_pool(Frame& F, int nrows) {
    const bf16* PB = WSP(bf16, WS_PB); bf16* POOL = WSP(bf16, WS_POOL);
    for (int i = F.bid * NTHREADS + F.tid; i < (nrows >> 4) * 64; i += F.G * NTHREADS) {
        const int row0 = (i >> 6) << 4, ch = i & 63, g = ch >> 4, hw = 1 << g;
        int base, t0, Lb; if (row0 < RL) { base = row0 & ~4095; t0 = row0 & 4095; Lb = SEQ; } else { const int rr = row0 - RL; base = RL + (rr & ~255); t0 = rr & 255; Lb = CTXL; }
        const bf16* src = PB + (size_t)base * 512 + ch * 8;
        float S[8];
#pragma unroll
        for (int q = 0; q < 8; ++q) S[q] = 0.f;
#pragma unroll 4
        for (int d = -8; d < 8; ++d) { const int tt = t0 + d; if (d >= -hw && d < hw && tt >= 0 && tt < Lb) { float x[8]; ld8(src + (size_t)tt * 512, x);
#pragma unroll
                for (int q = 0; q < 8; ++q) S[q] += x[q]; } }
#pragma unroll 2
        for (int j = 0; j < 16; ++j) { const int t = t0 + j; const int lo = max(t - hw, 0), hi = min(t + hw, Lb); const float inv = 1.0f / (float)(hi - lo);
            float me[8]; ld8(src + (size_t)t * 512, me);
            u32x4 o;
#pragma unroll
            for (int q = 0; q < 4; ++q) o[q] = pk2(S[2 * q] * inv - me[2 * q], S[2 * q + 1] * inv - me[2 * q + 1]);
            *(u32x4*)(POOL + (size_t)(base + t) * 512 + ch * 8) = o;
            if (t + hw < Lb) { float x[8]; ld8(src + (size_t)(t + hw) * 512, x);
#pragma unroll
                for (int q = 0; q < 8; ++q) S[q] += x[q]; }
            if (t - hw >= 0) { float x[8]; ld8(src + (size_t)(t - hw) * 512, x);
#pragma unroll
                for (int q = 0; q < 8; ++q) S[q] -= x[q]; } }
    }
}

__device__ __forceinline__ int block_sum_i(int v, LAS int* sm, int tid) {
    v = wave_sum_i(v);
    __syncthreads();
    if ((tid & 63) == 0) sm[tid >> 6] = v;
    __syncthreads();
    int s = 0;
#pragma unroll
    for (int i = 0; i < 8; ++i) s += sm[i];
    return s;
}
__device__ __forceinline__ int block_excl_scan(int v, LAS int* sm, int tid, int& total) {
    const int lane = tid & 63, w = tid >> 6; int inc = v;
#pragma unroll
    for (int o = 1; o < 64; o <<= 1) { const int t = __builtin_amdgcn_ds_bpermute(((lane - o) & 63) << 2, inc); if (lane >= o) inc += t; }
    __syncthreads();
    if (lane == 63) sm[w] = inc;
    __syncthreads();
    int base = 0; total = 0;
#pragma unroll
    for (int i = 0; i < 8; ++i) { const int s = sm[i]; if (i < w) base += s; total += s; }
    return base + inc - v;
}
template <int NPT>
__device__ __forceinline__ void topk_pair(Frame& F, int row0, int n, int cap, int e, int slot0) {
    LAS int* sm = (LAS int*)F.lds;
    const float* AFF = WSP(float, WS_AFF); int* SROW = WSP(int, WS_SROW); float* SG = WSP(float, WS_SGATE); int* SEL = WSP(int, WS_SEL);
    unsigned key[NPT];
#pragma unroll
    for (int j = 0; j < NPT; ++j) { const int i = F.tid * NPT + j; key[j] = (i < n) ? __float_as_uint(AFF[(size_t)(row0 + i) * 16 + e]) : 0u; }
    unsigned T = 0u;
    for (int bit = 30; bit >= 0; --bit) { const unsigned cand = T | (1u << bit); int cnt = 0;
#pragma unroll
        for (int j = 0; j < NPT; ++j) cnt += (key[j] >= cand) ? 1 : 0;
        cnt = block_sum_i(cnt, sm, F.tid);
        if (cnt >= cap) T = cand; }
    int ngt = 0, neq = 0;
#pragma unroll
    for (int j = 0; j < NPT; ++j) { ngt += (key[j] > T) ? 1 : 0; neq += (key[j] == T) ? 1 : 0; }
    int tot_gt, tot_eq;
    (void)block_excl_scan(ngt, sm, F.tid, tot_gt);
    int eqr = block_excl_scan(neq, sm, F.tid, tot_eq);
    const int need_eq = cap - tot_gt;
    int nsel = 0; bool selj[NPT];
#pragma unroll
    for (int j = 0; j < NPT; ++j) { bool s = key[j] > T; if (key[j] == T && T != 0u) { s = eqr < need_eq; ++eqr; } selj[j] = s; nsel += s ? 1 : 0; }
    int tot_sel; int pos = block_excl_scan(nsel, sm, F.tid, tot_sel);
#pragma unroll
    for (int j = 0; j < NPT; ++j) { const int i = F.tid * NPT + j;
        if (i < n) { const int row = row0 + i;
            if (selj[j]) { const int slot = slot0 + pos; ++pos; SROW[slot] = row; SG[slot] = __uint_as_float(key[j]); SEL[(size_t)row * 16 + e] = slot; }
            else SEL[(size_t)row * 16 + e] = -1; } }
    __syncthreads();
}
__device__ __forceinline__ void p_topk(Frame& F, bool with_ctx) {
    const int npairs = 128 + (with_ctx ? 128 : 0);
    for (int pi = F.bid; pi < npairs; pi += F.G) {
        if (pi < 128) { const int b = pi >> 4, e = pi & 15; topk_pair<8>(F, b * SEQ, SEQ, CAPL, e, e * SLOT_E + b * CAPL); }
        else { const int p2 = pi - 128, b = p2 >> 4, e = p2 & 15; topk_pair<1>(F, RL + b * CTXL, CTXL, CAPC, e, e * SLOT_E + 4096 + b * CAPC); }
    }
}
template <int PH> __global__ void __launch_bounds__(NTHREADS, 2) fwd_kernel(Params P) {
    extern __shared__ __attribute__((aligned(16))) unsigned char lds_raw[];
    Frame F; F.lds = (LAS unsigned char*)lds_raw; F.tid = threadIdx.x; F.lane = F.tid & 63; F.wave = __builtin_amdgcn_readfirstlane(F.tid >> 6); F.G = gridDim.x; F.bid = blockIdx.x; F.ws = P.ws;
    const int wave0 = __builtin_amdgcn_readfirstlane((int)threadIdx.x >> 6);
    volatile LAS unsigned* MISC = (volatile LAS unsigned*)(F.lds + LDS_MISC);
    if (F.tid < 64) MISC[F.tid] = 0u;
    __syncthreads();
    XcdBarrier bar; bar.bar = WSP(unsigned, WS_CTL) + CW_BAR; bar.x = 0; bar.st = MISC + 8;
    if constexpr (PH < 0) bar = xcd_barrier_post(WSP(unsigned, WS_CTL) + CW_BAR, MISC + 8);
#define IN(k) (PH < 0 || PH == (k))
#define REFRESH() do { unsigned on_ = ~0u; asm volatile("" : "+s"(on_)); int t_ = wave0 * 64 + (int)__builtin_amdgcn_mbcnt_hi(on_, __builtin_amdgcn_mbcnt_lo(on_, 0u)); asm volatile("" : "+v"(t_)); F.tid = t_; F.lane = t_ & 63; F.wave = __builtin_amdgcn_readfirstlane(t_ >> 6); } while (0)
#define SEAM(k) do { if constexpr (PH < 0) xcd_barrier(bar); } while (0)

    if (IN(0)) { REP_BEGIN(100) p_mod(P, F); p_dftgen(F); REP_END REP_BEGIN(101) p_wconv(P, F, 0); REP_END }
    SEAM(0);
    if (IN(1)) { p_rftables(P, F); p_rowpass_a0(P, F); }
    SEAM(1);
    for (int l = P.l_lo; l < P.l_hi; ++l) {
        constexpr int pb = 2; const bool L0 = (l == 0);
        bf16* H = WSP(bf16, WS_H);
        if (IN(pb + 0)) { REFRESH(); REP_BEGIN(2)
            const int u1 = 128 * 8 + 8 * (L0 ? 8 : 4), u2a = 128 * 2 + (L0 ? 8 * 2 : 0), u2 = u2a + 128 * 12 + (L0 ? 8 * 12 : 0), u3 = 4 * 128 + (L0 ? 4 * 8 : 0);
            const bf16* H8 = WSP(bf16, WS_H8); const bf16* WA8 = WSP(bf16, WS_WA8);
            { GroupSched S; S.init(1, 128, 8, F.G, F.bid, 8, L0 ? 8 : 4, 128, 0);
              auto AD = [=](const Unit& u) { return Operands{H8 + (size_t)u.pm * 256 * 512, WA8 + (size_t)u.pn * 256 * 512, 512, 512, 0, 512}; };
              bf16* KQ = WSP(bf16, WS_KQ);
              auto E = [=](EPI_ARGS) { const int row0 = u.pm * 256; const float qs = (u.pn >= 4) ? QSCALE * INV8 : INV8;
                  EPI_FOR8( st_bf8(KQ + (size_t)(row0 + r) * 2048 + u.pn * 256 + c, v0 * qs, v1 * qs); ) };
              GEMM_P8(S, AD, E); }
            REFRESH();
            { GroupSched S; S.init(1, 128, 2, F.G, (F.bid + F.G - ((u1 % F.G) & ~7)) % F.G, L0 ? 8 : 0, 2, 128, 0);
              const bf16* WA = WSP(bf16, WS_WA);
              auto AD = [=](const Unit& u) { return Operands{H + (size_t)u.pm * 256 * DM, WA + (size_t)(u.pn + 8) * 256 * DM, DM, DM, 0, DM}; };
              bf16* PBp = WSP(bf16, WS_PB);
              auto E = [=](EPI_ARGS) { const int row0 = u.pm * 256; EPI_FOR8( st_bf8(PBp + (size_t)(row0 + r) * 512 + u.pn * 256 + c, v0, v1); ) };
              GEMM_P(S, AD, E); }
            REFRESH();
            { GroupSched S; S.init(1, 128, 12, F.G, (F.bid + F.G - (((u1 + u2a) % F.G) & ~7)) % F.G, L0 ? 8 : 0, 12, 128, 0);
              bf16* GB = WSP(bf16, WS_GB);
              auto AD = [=](const Unit& u) { return Operands{H8 + (size_t)u.pm * 256 * 512, WA8 + (size_t)(3072 + u.pn * 256) * 512, 512, 512, 0, 512}; };
              auto E = [=](EPI_ARGS) { const int row0 = u.pm * 256;
                  EPI_FOR8( f32x4 s0; f32x4 s1; _Pragma("unroll") for (int j = 0; j < 4; ++j) { s0[j] = sigmoidf_(v0[j] * INV8); s1[j] = sigmoidf_(v1[j] * INV8); } st_bf8(GB + (size_t)(row0 + r) * 3072 + u.pn * 256 + c, s0, s1); ) };
              GEMM_P8(S, AD, E); }
            REFRESH();
            { GroupSched S; S.init(1, 4, 128, F.G, (F.bid + F.G - (((u1 + u2) % F.G) & ~7)) % F.G, L0 ? 4 : 0, 8, 0, 128);
              const bf16* WFV = WSP(bf16, WS_WFV);
              auto AD = [=](const Unit& u) { const bool fmap = (u.pn < 128); const int t16 = u.pn & 15;
                  const size_t tok0 = fmap ? (size_t)(u.pn >> 4) * SEQ + 64 * ((t16 >> 1) * 8) + (t16 & 1) * 32 : (size_t)u.pn * 256;
                  return Operands{WFV + (size_t)u.pm * 256 * DM, H + tok0 * DM, DM, DM, 0, DM, fmap ? 1 : 0}; };
              bf16* YT = WSP(bf16, WS_YT);
              auto E = [=](EPI_ARGS) { const int rr0 = u.pm * 256;
                  if (u.pn < 128) { const int b = u.pn >> 4; const int t16 = u.pn & 15, l10 = (t16 >> 1) * 8, l20 = (t16 & 1) * 32;
                      EPI_FOR8( const int fc = rr0 + r; st_bf8(YT + (((((size_t)b * 512 + (fc >> 1)) * 32 + (c >> 3)) * 2 + (l20 >> 5)) * 2 + (fc & 1)) * 64 + l10, v0, v1); ) }
                  else { const int b = u.pn - 128; EPI_FOR8( st_bf8(YT + YT_CTX_OFF + ((size_t)b * 1024 + rr0 + r) * 256 + c, v0, v1); ) } };
              GEMM_P(S, AD, E); }
            REFRESH();
            { GroupSched S; S.init(1, 4, 128, F.G, (F.bid + F.G - (((u1 + u2 + u3) % F.G) & ~7)) % F.G, 4, 8, 0, 128);
              auto AD = [=](const Unit& u) { return Operands{WA8 + (size_t)(2048 + u.pm * 256) * 512, H8 + (size_t)u.pn * 256 * 512, 512, 512, 0, 512}; };
              bf16* VT = WSP(bf16, WS_VT);
              auto E = [=](EPI_ARGS) { const int rr0 = u.pm * 256;
                  if (u.pn < 128) { const int b = u.pn >> 4, l0 = (u.pn & 15) * 256; EPI_FOR8( st_bf8(VT + ((size_t)b * 1024 + rr0 + r) * 4096 + l0 + c, v0 * INV8, v1 * INV8); ) }
                  else { const int b = u.pn - 128; EPI_FOR8( st_bf8(VT + YT_CTX_OFF + ((size_t)b * 1024 + rr0 + r) * 256 + c, v0 * INV8, v1 * INV8); ) } };
              GEMM_P8(S, AD, E); }
        REP_END }
        SEAM(pb + 0);
        if (IN(pb + 1)) { REFRESH();
            { const int nc0 = (F.G * 5 / 16) & ~7, nconv = nc0 > 0 ? nc0 : 1, na = F.G - nconv;
              if (F.bid < na) p_attn_mfma(P, F, l, L0, na, F.bid);
              else wconv_experts(P, F, l, F.bid - na, nconv); }
            REFRESH();
            REP_BEGIN(32)
            { LAS float* tw = (LAS float*)(F.lds + LDS_TW);
              for (int j = F.tid; j < 4096; j += NTHREADS) tw[j] = cospif((float)j * (1.0f / 2048.0f));
              __syncthreads();
              GroupSched S; S.init(1, 1, 512, F.G, F.bid);
              const bf16* M1 = WSP(bf16, WS_M1T); const bf16* YF = WSP(bf16, WS_YT); bf16* ZP = WSP(bf16, WS_ZP);
              auto AD = [=](const Unit& u) { return Operands{M1, YF + (size_t)u.pn * 256 * 256, 256, 256, 0, 256}; };
              auto E = [=](EPI_ARGS) {
                  const int b = u.pn >> 6, gm0 = (u.pn & 63) * 8 + wc, l20 = 32 * wr + 8 * fq;
#pragma unroll
                  for (int m = 0; m < 4; ++m) { const int k1 = 16 * m + fr;
#pragma unroll
                      for (int bj = 0; bj < 2; ++bj) { const int gm = gm0 + 4 * bj;
                          f32x4 zr[2], zi[2];
#pragma unroll
                          for (int n = 0; n < 2; ++n)
#pragma unroll
                              for (int j = 0; j < 4; ++j) { const int ix = k1 * (l20 + 4 * n + j); const float tc = tw[ix], ts = tw[(ix + 3072) & 4095];
                                  const float ur = acc[0][bj][m][n][j], ui = acc[1][bj][m][n][j]; zr[n][j] = ur * tc - ui * ts; zi[n][j] = ur * ts + ui * tc; }
                          bf16* dst = ZP + (((((size_t)b * 64 + k1) * 128 + (gm & 127)) * 4 + (gm >> 7)) * 2) * 64 + l20;
                          st_bf8(dst, zr[0], zr[1]); st_bf8(dst + 64, zi[0], zi[1]); } } };
              GEMM_P(S, AD, E); }
            REP_END
        }
        SEAM(pb + 1);
        if (IN(pb + 10)) { REFRESH();
            { GroupSched S; S.init(1, L0 ? 136 : 128, 4, F.G, F.bid);
              const bf16* A8 = WSP(bf16, WS_ATT); const bf16* W8 = WSP(bf16, WS_WAO); const bf16* GB = WSP(bf16, WS_GB); bf16* YA = WSP(bf16, WS_KQ);
              auto AD = [=](const Unit& u) { return Operands{A8 + (size_t)u.pm * 256 * 512, W8 + (size_t)u.pn * 256 * 512, 512, 512, 0, 512}; };
              auto E = [=](EPI_ARGS) { const int colb = u.pn * 256 + wc * 32 + 8 * fq;
#pragma unroll
                  for (int ai = 0; ai < 2; ++ai) { u32x4 g0[4][2];
#pragma unroll
                      for (int m = 0; m < 4; ++m)
#pragma unroll
                          for (int bj = 0; bj < 2; ++bj) g0[m][bj] = *(const u32x4*)(GB + ((size_t)u.pm * 256 + ai * 128 + wr * 64 + m * 16 + fr) * 3072 + colb + bj * 128);
#pragma unroll
                      for (int m = 0; m < 4; ++m)
#pragma unroll
                          for (int bj = 0; bj < 2; ++bj) { const u32x4 g = g0[m][bj]; const f32x4 ga = {bflo(g[0]), bfhi(g[0]), bflo(g[1]), bfhi(g[1])}, gb = {bflo(g[2]), bfhi(g[2]), bflo(g[3]), bfhi(g[3])};
                              st_bf8(YA + ((size_t)u.pm * 256 + ai * 128 + wr * 64 + m * 16 + fr) * 1024 + colb + bj * 128, acc[ai][bj][m][0] * ga * INVAT, acc[ai][bj][m][1] * gb * INVAT); } } };
              GEMM_P8(S, AD, E); }
            REFRESH();
            { GroupSched S; S.init(1, 1, 256, F.G, F.bid);
              const bf16* M2 = WSP(bf16, WS_M2T); const bf16* ZP = WSP(bf16, WS_ZP); bf16* FOUR = WSP(bf16, WS_FOUR);
              auto AD = [=](const Unit& u) { return Operands{M2, ZP + (size_t)u.pn * 256 * 512, 512, 512, 0, 512}; };
              auto E = [=](EPI_ARGS) { const float sc = 0.0013810679320049757f;
#pragma unroll
                  for (int ai = 0; ai < 2; ++ai)
#pragma unroll
                      for (int m = 0; m < 4; ++m) { const int q = 2 * ai + wr, k2 = 16 * m + fr;
#pragma unroll
                          for (int bj = 0; bj < 2; ++bj) { const int bk = u.pn * 2 + bj, b = bk >> 6, k1 = bk & 63;
                              st_bf8(FOUR + ((size_t)b * SEQ + k1 + 64 * k2) * 512 + q * 128 + wc * 32 + 8 * fq, acc[ai][bj][m][0] * sc, acc[ai][bj][m][1] * sc); } } };
              GEMM_P(S, AD, E); }
            REFRESH();
            if (L0) { GroupSched S; S.init(1, 1, 16, F.G, (F.bid + F.G - 128 % F.G) % F.G);
              const bf16* DFTC = WSP(bf16, WS_DFTC); const bf16* YTC = WSP(bf16, WS_YT) + YT_CTX_OFF; bf16* FOUR = WSP(bf16, WS_FOUR);
              auto AD = [=](const Unit& u) { return Operands{DFTC, YTC + (size_t)u.pn * 256 * 512, 512, 512, 0, 512}; };
              auto E = [=](EPI_ARGS) { const int b = u.pn >> 1, c0 = (u.pn & 1) * 256; const float sc = 0.005524271728019903f;
                  EPI_FOR8( st_bf8(FOUR + ((size_t)RL + b * CTXL + r) * 512 + c0 + c, v0 * sc, v1 * sc); ) };
              GEMM_P(S, AD, E); }
            REFRESH();
            REP_BEGIN(33) p_pool(F, L0 ? RT : RL); REP_END
        }
        SEAM(pb + 10);
        if (IN(pb + 2)) { REFRESH();
            SegSched<2> S; S.base.init(1, L0 ? 136 : 128, 4, F.G, F.bid);
            const bf16* FOUR = WSP(bf16, WS_FOUR); const bf16* POOL = WSP(bf16, WS_POOL); const bf16* WFO = WSP(bf16, WS_WFO); const bf16* WPO = WSP(bf16, WS_WPO);
            const bf16* GB = WSP(bf16, WS_GB); const bf16* YA = WSP(bf16, WS_KQ); bf16* MRGB = WSP(bf16, WS_MRGB); const float* ps = P.pool_scale + l * 1024;
            auto AD = [=](const Unit& u) {
                if (u.seg == 0) return Operands{FOUR + (size_t)u.pm * 256 * 512, WFO + (size_t)u.pn * 256 * 512, 512, 512, 0, 512};
                return Operands{POOL + (size_t)u.pm * 256 * 512 + (u.pn >> 1) * 256, WPO + (size_t)u.pn * 256 * 256, 512, 256, 0, 256}; };
            auto E = [=](EPI_ARGS) {
                const bool fin = (u.seg == 1); const int colb = u.pn * 256 + wc * 32 + 8 * fq;
                f32x4 psv[2][2];
#pragma unroll
                for (int bj = 0; bj < 2; ++bj)
#pragma unroll
                    for (int n = 0; n < 2; ++n) { f32x4 p = *(const f32x4*)(ps + colb + bj * 128 + 4 * n);
#pragma unroll
                        for (int j = 0; j < 4; ++j) p[j] = (fabsf(p[j]) < 1e-18f) ? copysignf(1e-18f, p[j]) : p[j];
                        psv[bj][n] = p; }
#pragma unroll
                for (int ai = 0; ai < 2; ++ai)
#pragma unroll
                    for (int m = 0; m < 4; ++m) { const size_t row = (size_t)u.pm * 256 + ai * 128 + wr * 64 + m * 16 + fr; const bf16* gr = GB + row * 3072 + colb;
                        u32x4 g1r[2], g2r[2], yar[2];
#pragma unroll
                        for (int bj = 0; bj < 2; ++bj) { g2r[bj] = *(const u32x4*)(gr + 2048 + bj * 128); if (fin) yar[bj] = *(const u32x4*)(YA + row * 1024 + colb + bj * 128); else g1r[bj] = *(const u32x4*)(gr + 1024 + bj * 128); }
#pragma unroll
                        for (int bj = 0; bj < 2; ++bj) { f32x4 o[2];
#pragma unroll
                            for (int n = 0; n < 2; ++n) { const u32x4 xr = fin ? yar[bj] : g1r[bj];
                                const f32x4 g2 = (f32x4){fmaxf(bflo(g2r[bj][2 * n]), 1e-18f), fmaxf(bfhi(g2r[bj][2 * n]), 1e-18f), fmaxf(bflo(g2r[bj][2 * n + 1]), 1e-18f), fmaxf(bfhi(g2r[bj][2 * n + 1]), 1e-18f)} * psv[bj][n];
                                const f32x4 x = {bflo(xr[2 * n]), bfhi(xr[2 * n]), bflo(xr[2 * n + 1]), bfhi(xr[2 * n + 1])};
#pragma unroll
                                for (int j = 0; j < 4; ++j) o[n][j] = fin ? (x[j] + acc[ai][bj][m][n][j] * g2[j]) : (acc[ai][bj][m][n][j] * x[j] * __builtin_amdgcn_rcpf(g2[j]));
                                acc[ai][bj][m][n] = o[n]; }
                            if (fin) st_bf8(MRGB + row * 1024 + colb + bj * 128, o[0], o[1]); } } };
            gemm_fast<false, true, false>(F.lds, F.tid, S, AD, mk_epi_seg(E, 1), nullptr);
        }
        SEAM(pb + 2);
        if (IN(pb + 3)) { REFRESH();
            GroupSched S; S.init(1, L0 ? 136 : 128, 4, F.G, F.bid); const bf16* A = WSP(bf16, WS_MRGB); const bf16* W = WSP(bf16, WS_WOUT);
            bf16* XB = WSP(bf16, WS_XB); const float* MOD = WSP(float, WS_MOD) + (size_t)l * 9 * 6144;
            auto AD = [=](const Unit& u) { return Operands{A + (size_t)u.pm * 256 * 1024, W + (size_t)u.pn * 256 * 1024, 1024, 1024, 0, 1024}; };
            auto E = [=](EPI_ARGS) {
                const int row0 = u.pm * 256, mr = row0 < RL ? (row0 >> 12) : 8, colb = u.pn * 256 + wc * 32 + 8 * fq;
                bf16* dst0 = XB + (size_t)row0 * DM;
                f32x4 gv[2][2];
#pragma unroll
                for (int bj = 0; bj < 2; ++bj)
#pragma unroll
                    for (int n = 0; n < 2; ++n) gv[bj][n] = *(const f32x4*)(MOD + (size_t)mr * 6144 + 2048 + colb + bj * 128 + 4 * n);
                if (L0) { const float* src0 = row0 < RL ? P.x + (size_t)row0 * DM : P.ctx + (size_t)(row0 - RL) * DM;
#pragma unroll
                    for (int am = 0; am < 4; ++am) { const int ai = am >> 1, mh = (am & 1) * 2; f32x4 xv[2][2][2];
#pragma unroll
                        for (int m = 0; m < 2; ++m) { const size_t ro = (size_t)(ai * 128 + wr * 64 + (mh + m) * 16 + fr) * DM + colb;
#pragma unroll
                            for (int bj = 0; bj < 2; ++bj)
#pragma unroll
                                for (int n = 0; n < 2; ++n) xv[m][bj][n] = *(const f32x4*)(src0 + ro + bj * 128 + 4 * n); }
#pragma unroll
                        for (int m = 0; m < 2; ++m) { const size_t ro = (size_t)(ai * 128 + wr * 64 + (mh + m) * 16 + fr) * DM + colb;
#pragma unroll
                            for (int bj = 0; bj < 2; ++bj) st_bf8(dst0 + ro + bj * 128, xv[m][bj][0] + gv[bj][0] * acc[ai][bj][mh + m][0], xv[m][bj][1] + gv[bj][1] * acc[ai][bj][mh + m][1]); } }
                } else {
#pragma unroll
                    for (int ai = 0; ai < 2; ++ai) { u32x4 xr[4][2];
#pragma unroll
                        for (int m = 0; m < 4; ++m) { const size_t ro = (size_t)(ai * 128 + wr * 64 + m * 16 + fr) * DM + colb;
#pragma unroll
                            for (int bj = 0; bj < 2; ++bj) xr[m][bj] = *(const u32x4*)(dst0 + ro + bj * 128); }
#pragma unroll
                        for (int m = 0; m < 4; ++m) { const size_t ro = (size_t)(ai * 128 + wr * 64 + m * 16 + fr) * DM + colb;
#pragma unroll
                            for (int bj = 0; bj < 2; ++bj) { const u32x4 x = xr[m][bj]; const f32x4 xa = {bflo(x[0]), bfhi(x[0]), bflo(x[1]), bfhi(x[1])}, xb = {bflo(x[2]), bfhi(x[2]), bflo(x[3]), bfhi(x[3])};
                                st_bf8(dst0 + ro + bj * 128, xa + gv[bj][0] * acc[ai][bj][m][0], xb + gv[bj][1] * acc[ai][bj][m][1]); } } } } };
            GEMM_P(S, AD, E);
        }
        SEAM(pb + 3);
        if (IN(pb + 4)) { REFRESH(); REP_BEGIN(6) p_rowpass_f(P, F, l, L0 ? RT : RL); REP_END }
        SEAM(pb + 4);
        if (IN(pb + 5)) { REFRESH(); REP_BEGIN(7) p_topk(F, L0); REP_END }
        SEAM(pb + 5);
        if (IN(pb + 7)) { REFRESH(); REP_BEGIN(9)
            GroupSched S; S.init(16, L0 ? 17 : 16, 22, F.G, F.bid); const bf16* H8 = WSP(bf16, WS_H8); const bf16* W = WSP(bf16, WS_WGU); unsigned char* HID = WSP(unsigned char, WS_HID); const int* SROW = WSP(int, WS_SROW);
            auto AD = [=](const Unit& u) { return Operands{H8, W + ((size_t)u.grp * 5632 + u.pn * 256) * 512, 512, 512, u.grp * SLOT_E + u.pm * 256, 512}; };
            auto E = [=](EPI_ARGS) {
#pragma unroll
                for (int ai = 0; ai < 2; ++ai)
#pragma unroll
                    for (int m = 0; m < 4; ++m) { const size_t slot = (size_t)u.grp * SLOT_E + u.pm * 256 + ai * 128 + wr * 64 + m * 16 + fr; f32x4 o[2];
#pragma unroll
                        for (int n = 0; n < 2; ++n) { const f32x4 a = acc[ai][0][m][n] * INV8, up = acc[ai][1][m][n] * (INV8 * A8S);
#pragma unroll
                            for (int j = 0; j < 4; ++j) o[n][j] = a[j] * sigmoidf_(a[j]) * up[j]; }
                        u32x2 w; w.x = pk4_fp8(o[0][0], o[0][1], o[0][2], o[0][3]); w.y = pk4_fp8(o[1][0], o[1][1], o[1][2], o[1][3]);
                        *(u32x2*)(HID + slot * FF + u.pn * 128 + wc * 32 + 8 * fq) = w; } };
            GEMM_GATHER8(S, AD, E, SROW);
        REP_END }
        SEAM(pb + 7);
        if (IN(pb + 8)) { REFRESH(); REP_BEGIN(10)
            const int tpe = L0 ? 17 : 16;
            GroupSched S; S.init(1, 16 * tpe, 4, F.G, F.bid); const bf16* HID = WSP(bf16, WS_HID); const bf16* W = WSP(bf16, WS_WD); bf16* Y = WSP(bf16, WS_Y); const float* SG = WSP(float, WS_SGATE);
            auto AD = [=](const Unit& u) { const int e = u.pm / tpe, st = e * 17 + (u.pm - e * tpe); return Operands{HID + (size_t)st * 256 * (FF / 2), W + ((size_t)e * 1024 + u.pn * 256) * (FF / 2), FF / 2, FF / 2, 0, FF / 2}; };
            auto E = [=](EPI_ARGS) { const int e = u.pm / tpe; const size_t slot0 = (size_t)(e * 17 + (u.pm - e * tpe)) * 256 + wr * 64 + fr; float gt[2][4];
#pragma unroll
                for (int ai = 0; ai < 2; ++ai)
#pragma unroll
                    for (int m = 0; m < 4; ++m) gt[ai][m] = SG[slot0 + ai * 128 + m * 16] * INV8;
#pragma unroll
                for (int ai = 0; ai < 2; ++ai)
#pragma unroll
                    for (int m = 0; m < 4; ++m)
#pragma unroll
                        for (int bj = 0; bj < 2; ++bj) st_bf8(Y + (slot0 + ai * 128 + m * 16) * DM + u.pn * 256 + bj * 128 + wc * 32 + 8 * fq, acc[ai][bj][m][0] * gt[ai][m], acc[ai][bj][m][1] * gt[ai][m]); };
            GEMM_P8(S, AD, E);
        REP_END }
        SEAM(pb + 8);
        if (IN(pb + 9)) { REFRESH(); p_rowpass_k(P, F, l, L0 ? RT : RL); if (L0) p_wconv(P, F, 1); }
        if (L0) SEAM(pb + 9);
    }
#undef IN
#undef SEAM
}
template <int PH> static void launch_ph(int grid, const Params& p, hipStream_t stream) { hipLaunchKernelGGL(fwd_kernel<PH>, dim3(grid), dim3(NTHREADS), LDS_BYTES, stream, p); }
template <int PH> static bool set_attr() { return hipFuncSetAttribute((const void*)fwd_kernel<PH>, hipFuncAttributeMaxDynamicSharedMemorySize, LDS_BYTES) == hipSuccess; }

#ifndef DUP_LAUNCH
#define DUP_LAUNCH -1
#endif
extern "C" void kernel_launch(void* const* d_in, const int* in_sizes, int n_in, void* d_out, int out_size, void* d_ws, size_t ws_size, hipStream_t stream) {
    static int grid = 0;
    if (grid == 0) {
        if (n_in != 20 || out_size != RL * DM || ws_size < WS_END) { fprintf(stderr, "kernel_launch: unexpected shapes (n_in %d out %d ws %zu need %zu)\n", n_in, out_size, ws_size, (size_t)WS_END); grid = -1; return; }
        int dev = 0, cus = 0, per_cu = 0;
        if (hipGetDevice(&dev) != hipSuccess || hipDeviceGetAttribute(&cus, hipDeviceAttributeMultiprocessorCount, dev) != hipSuccess) { grid = -1; return; }
#if N_LAUNCH_MODE == 1
        if (!set_attr<-1>()) { fprintf(stderr, "kernel_launch: hipFuncSetAttribute failed\n"); grid = -1; return; }
        if (hipOccupancyMaxActiveBlocksPerMultiprocessor(&per_cu, (const void*)fwd_kernel<-1>, NTHREADS, LDS_BYTES) != hipSuccess || per_cu < 1) fprintf(stderr, "kernel_launch: occupancy query reports %d\n", per_cu);
#else
        if (!(set_attr<0>() && set_attr<1>() && set_attr<2>() && set_attr<3>() && set_attr<12>() && set_attr<4>() && set_attr<5>() && set_attr<6>() && set_attr<7>() && set_attr<9>() && set_attr<10>() && set_attr<11>())) { fprintf(stderr, "kernel_launch: hipFuncSetAttribute failed\n"); grid = -1; return; }
        (void)per_cu;
#endif
        (void)hipGetLastError();
        grid = cus;
    }
    if (grid < 0) return;
    if (hipMemsetAsync((char*)d_ws + WS_CTL, 0, CTL_BYTES, stream) != hipSuccess) return;
    Params p{};
    const float** pp = (const float**)&p;
    for (int i = 0; i < 20; ++i) pp[i] = (const float*)d_in[i];
    p.out = (float*)d_out; p.ws = (unsigned char*)d_ws;
#if N_LAUNCH_MODE == 1
    p.l_lo = 0; p.l_hi = 2;
    launch_ph<-1>(grid, p, stream);
#else
    p.l_lo = 0; p.l_hi = 0; launch_ph<0>(grid, p, stream); if (DUP_LAUNCH == 0) launch_ph<0>(grid, p, stream); launch_ph<1>(grid, p, stream); if (DUP_LAUNCH == 1) launch_ph<1>(grid, p, stream);
#define LP(k) do { launch_ph<k>(grid, p, stream); if (DUP_LAUNCH == (k) && l == 0) launch_ph<k>(grid, p, stream); } while (0)
    for (int l = 0; l < 2; ++l) { p.l_lo = l; p.l_hi = l + 1;
        LP(2); LP(3); LP(12); LP(4); LP(5); LP(6); LP(7); LP(9); LP(10); LP(11); }
#endif
}
```

```cpp
#include <hip/hip_runtime.h>
#include <cstdio>
#include <cstdint>

#ifndef N_LAUNCH_MODE
#define N_LAUNCH_MODE 1
#endif

#define GAS __attribute__((address_space(1)))
#define LAS __attribute__((address_space(3)))
typedef unsigned short bf16;
typedef short bf16x8 __attribute__((ext_vector_type(8)));
typedef float f32x4 __attribute__((ext_vector_type(4)));
typedef unsigned u32x4 __attribute__((ext_vector_type(4)));
typedef unsigned u32x2 __attribute__((ext_vector_type(2)));

constexpr int NB = 8, SEQ = 4096, DM = 1024, CTXL = 256, NH = 16, HD = 64, GRIDW = 64;
constexpr int RL = NB * SEQ, RC = NB * CTXL, RT = RL + RC;
constexpr int INW = 7168, NE = 16, FF = 2816, CAPL = 512, CAPC = 32;
constexpr int SLOT_E = 4352, NSLOT = NE * SLOT_E;
constexpr float RMS_EPS = 1e-6f;
constexpr float LOG2E = 1.4426950408889634f, QSCALE = 0.125f * LOG2E;
constexpr float A8S = 8.0f, W8S = 64.0f, INV8 = 1.0f / (A8S * W8S);
constexpr float ATS = 32.0f, INVAT = 1.0f / (ATS * W8S);
constexpr int NWAVES = 8, NTHREADS = 512;

constexpr size_t al256(size_t x) { return (x + 255) & ~(size_t)255; }
constexpr size_t WS_CTL = 0, CTL_BYTES = 1u << 20;
constexpr size_t WS_MOD = WS_CTL + CTL_BYTES;
constexpr size_t WS_XC = al256(WS_MOD + (size_t)2 * 9 * 6144 * 4);
constexpr size_t WS_AFF = al256(WS_XC + (size_t)RC * DM * 4);
constexpr size_t WS_SROW = al256(WS_AFF + (size_t)RT * 16 * 4);
constexpr size_t WS_SGATE = al256(WS_SROW + (size_t)NSLOT * 4);
constexpr size_t WS_SEL = al256(WS_SGATE + (size_t)NSLOT * 4);
constexpr size_t WS_DFTM = al256(WS_SEL + (size_t)RT * 16 * 4);
constexpr size_t WS_DFTC = al256(WS_DFTM + (size_t)4096 * 8192 * 2);
constexpr size_t WS_WA = al256(WS_DFTC + (size_t)256 * 512 * 2);
constexpr size_t WS_WFV = al256(WS_WA + (size_t)5632 * 1024 * 2);
constexpr size_t WS_WAO = al256(WS_WFV + (size_t)2048 * 1024 * 2);
constexpr size_t WS_WFO = al256(WS_WAO + (size_t)1024 * 1024 * 2);
constexpr size_t WS_WPO = al256(WS_WFO + (size_t)1024 * 512 * 2);
constexpr size_t WS_WOUT = al256(WS_WPO + (size_t)1024 * 256 * 2);
constexpr size_t WS_WGU = al256(WS_WOUT + (size_t)1024 * 1024 * 2);
constexpr size_t WS_WD = al256(WS_WGU + (size_t)16 * 5632 * 1024);
constexpr size_t WS_WA8 = al256(WS_WD + (size_t)16 * 1024 * 2816);
constexpr size_t WS_H = al256(WS_WA8 + (size_t)6144 * 1024);
constexpr size_t WS_H8 = al256(WS_H + (size_t)RT * DM * 2);
constexpr size_t WS_R = al256(WS_H8 + (size_t)RT * DM);
constexpr size_t WS_KQ = WS_R;
constexpr size_t WS_MRG = WS_KQ;
constexpr size_t WS_PB = al256(WS_KQ + (size_t)RT * 2048 * 2);
constexpr size_t WS_GB = al256(WS_PB + (size_t)RT * 512 * 2);
constexpr size_t WS_YT = al256(WS_GB + (size_t)RT * 3072 * 2);
constexpr size_t WS_MRGB = WS_YT;
constexpr size_t WS_VT = al256(WS_YT + (size_t)RT * 1024 * 2);
constexpr size_t WS_FOUR = al256(WS_VT + (size_t)RT * 1024 * 2);
constexpr size_t WS_ATT = al256(WS_FOUR + (size_t)RT * 512 * 2);
constexpr size_t WS_POOL = al256(WS_ATT + (size_t)RT * 1024 * 2);
constexpr size_t WS_MIX_END = al256(WS_POOL + (size_t)RT * 512 * 2);
constexpr size_t WS_XG = WS_R;
constexpr size_t WS_HID = al256(WS_XG + (size_t)NSLOT * 1024 * 2);
constexpr size_t WS_Y = al256(WS_HID + (size_t)NSLOT * 2816);
constexpr size_t WS_MOE_END = al256(WS_Y + (size_t)NSLOT * 1024 * 2);
constexpr size_t WS_END0 = WS_MIX_END > WS_MOE_END ? WS_MIX_END : WS_MOE_END;
constexpr size_t WS_ZP = WS_END0;
constexpr size_t WS_M1T = al256(WS_ZP + ((size_t)8 * 64 * 512 * 128 + 1024) * 2);
constexpr size_t WS_M2T = al256(WS_M1T + (size_t)256 * 256 * 2);
constexpr size_t WS_XB = al256(WS_M2T + (size_t)256 * 512 * 2);
constexpr int RF_PITCH = 1032, RF_TBL = 2 * 16 * RF_PITCH * 2 + 4096 + 4096 + 64;
constexpr size_t WS_RFT = al256(WS_XB + (size_t)RT * DM * 2);
constexpr size_t WS_END = al256(WS_RFT + (size_t)18 * RF_TBL);
constexpr size_t YT_CTX_OFF = (size_t)8 * 1024 * 4096;

constexpr int CW_BAR = 4096;

constexpr int LDS_BYTES = 155648;
constexpr int LDS_TW = 132096;
constexpr int LDS_MISC = 131072;

__device__ __forceinline__ unsigned f2bf(float f) { unsigned u = __float_as_uint(f); return (u + 0x7fffu + ((u >> 16) & 1u)) >> 16; }
typedef __bf16 hbf16x2 __attribute__((ext_vector_type(2)));
typedef float f32x2 __attribute__((ext_vector_type(2)));
__device__ __forceinline__ unsigned pk2(float lo, float hi) { const f32x2 v = {lo, hi}; return __builtin_bit_cast(unsigned, __builtin_convertvector(v, hbf16x2)); }
__device__ __forceinline__ unsigned pk4_fp8(float a, float b, float c, float d) {
    a = __builtin_amdgcn_fmed3f(a, -448.f, 448.f); b = __builtin_amdgcn_fmed3f(b, -448.f, 448.f); c = __builtin_amdgcn_fmed3f(c, -448.f, 448.f); d = __builtin_amdgcn_fmed3f(d, -448.f, 448.f);
    int w = 0; w = __builtin_amdgcn_cvt_pk_fp8_f32(a, b, w, false); w = __builtin_amdgcn_cvt_pk_fp8_f32(c, d, w, true); return (unsigned)w; }
__device__ __forceinline__ float bf2f(unsigned b) { return __uint_as_float(b << 16); }
__device__ __forceinline__ float bflo(unsigned w) { return __uint_as_float(w << 16); }
__device__ __forceinline__ float bfhi(unsigned w) { return __uint_as_float(w & 0xffff0000u); }
template <int CTRL> __device__ __forceinline__ float dppf(float x) { return __builtin_bit_cast(float, __builtin_amdgcn_mov_dpp(__builtin_bit_cast(int, x), CTRL, 0xf, 0xf, true)); }
template <int CTRL> __device__ __forceinline__ int dppi(int x) { return __builtin_amdgcn_mov_dpp(x, CTRL, 0xf, 0xf, true); }
constexpr int DPP_XOR1 = 0xB1, DPP_XOR2 = 0x4E, DPP_ROR4 = 0x124, DPP_ROR8 = 0x128;
__device__ __forceinline__ float wave_sum(float v) {
    v += dppf<DPP_XOR1>(v); v += dppf<DPP_XOR2>(v); v += dppf<DPP_ROR4>(v); v += dppf<DPP_ROR8>(v);
    auto s = __builtin_amdgcn_permlane16_swap(__float_as_uint(v), __float_as_uint(v), false, false); v = __uint_as_float(s[0]) + __uint_as_float(s[1]);
    auto t = __builtin_amdgcn_permlane32_swap(__float_as_uint(v), __float_as_uint(v), false, false); return __uint_as_float(t[0]) + __uint_as_float(t[1]);
}
__device__ __forceinline__ float wave_max(float v) {
    v = fmaxf(v, dppf<DPP_XOR1>(v)); v = fmaxf(v, dppf<DPP_XOR2>(v)); v = fmaxf(v, dppf<DPP_ROR4>(v)); v = fmaxf(v, dppf<DPP_ROR8>(v));
    auto s = __builtin_amdgcn_permlane16_swap(__float_as_uint(v), __float_as_uint(v), false, false); v = fmaxf(__uint_as_float(s[0]), __uint_as_float(s[1]));
    auto t = __builtin_amdgcn_permlane32_swap(__float_as_uint(v), __float_as_uint(v), false, false); return fmaxf(__uint_as_float(t[0]), __uint_as_float(t[1]));
}
__device__ __forceinline__ int wave_sum_i(int v) {
    v += dppi<DPP_XOR1>(v); v += dppi<DPP_XOR2>(v); v += dppi<DPP_ROR4>(v); v += dppi<DPP_ROR8>(v);
    auto s = __builtin_amdgcn_permlane16_swap((unsigned)v, (unsigned)v, false, false); v = (int)(s[0] + s[1]);
    auto t = __builtin_amdgcn_permlane32_swap((unsigned)v, (unsigned)v, false, false); return (int)(t[0] + t[1]);
}
__device__ __forceinline__ float sigmoidf_(float x) { return __builtin_amdgcn_rcpf(1.f + __builtin_amdgcn_exp2f(x * -1.4426950408889634f)); }
#define LDS_WAIT() asm volatile("s_waitcnt lgkmcnt(0)" ::: "memory")

#define XB_TMO      128
#define XB_XCNT(j)  (256  + 64 * (j))
#define XB_XSUB(j)  (1280 + 64 * (j))
#define XB_XGEN(j)  (2304 + 64 * (j))
#define XB_TOP      3328
#define XB_TOPGEN   3392
#define XCD_BAR_WORDS 3456
#define XB_SPIN_CAP (1u << 22)

__device__ __forceinline__ unsigned xb_ld(unsigned* p)              { return __hip_atomic_load(p, __ATOMIC_RELAXED, __HIP_MEMORY_SCOPE_AGENT); }
__device__ __forceinline__ unsigned xb_add(unsigned* p, unsigned v) { return __hip_atomic_fetch_add(p, v, __ATOMIC_RELAXED, __HIP_MEMORY_SCOPE_AGENT); }
__device__ __forceinline__ unsigned xb_xcc_id() { return (unsigned)__builtin_amdgcn_s_getreg((3 << 11) | 20) & 0xFu; }
#define XB_SPIN(cond, bar) do { unsigned _sp = 0; while (cond) { __builtin_amdgcn_s_sleep(1); \
    if ((++_sp & 255u) == 0u) { if (xb_ld(&(bar)[XB_TMO])) break; if (_sp > XB_SPIN_CAP) { atomicAdd(&(bar)[XB_TMO], 1u); break; } } } } while (0)

struct XcdBarrier { unsigned* bar; unsigned x; volatile LAS unsigned* st; };

__device__ __forceinline__ XcdBarrier xcd_barrier_post(unsigned* bar, volatile LAS unsigned* st) {
    XcdBarrier b; b.bar = bar; b.x = xb_xcc_id(); b.st = st;
    if (threadIdx.x == 0) (void)xb_add(&bar[XB_XCNT(b.x)], 1u);
    return b;
}
__device__ __forceinline__ void xcd_barrier_complete(unsigned* bar, unsigned x, unsigned& nloc, unsigned& nx) {
    const unsigned G = gridDim.x * gridDim.y * gridDim.z;
    unsigned sum, cnt, mine, sp = 0u;
    for (;;) {
        sum = 0u; cnt = 0u; mine = 0u;
#pragma unroll
        for (unsigned j = 0; j < 16; ++j) { const unsigned c = xb_ld(&bar[XB_XCNT(j)]); sum += c; cnt += (c > 0u) ? 1u : 0u; mine = (j == x) ? c : mine; }
        if (sum == G) break;
        __builtin_amdgcn_s_sleep(1);
        if ((++sp & 255u) == 0u) { if (xb_ld(&bar[XB_TMO])) break; if (sp > XB_SPIN_CAP) { atomicAdd(&bar[XB_TMO], 1u); break; } }
    }
    nloc = mine > 0u ? mine : 1u; nx = cnt > 0u ? cnt : 1u;
}
__device__ __forceinline__ void xcd_barrier(const XcdBarrier& b) {
    asm volatile("s_waitcnt vmcnt(0)" ::: "memory");
    __syncthreads();
    if (threadIdx.x == 0) {
        unsigned* bar = b.bar;
        __builtin_amdgcn_s_waitcnt(0);
        unsigned nloc = b.st[0], nx = b.st[1];
        if (nloc == 0u) { xcd_barrier_complete(bar, b.x, nloc, nx); b.st[0] = nloc; b.st[1] = nx; }
        const unsigned old = xb_add(&bar[XB_XSUB(b.x)], 1u);
        const unsigned gen = old / nloc;
        if (old + 1u == (gen + 1u) * nloc) {
            __builtin_amdgcn_fence(__ATOMIC_RELEASE, "agent");
            asm volatile("s_waitcnt vmcnt(0)" ::: "memory");
            const unsigned og = xb_add(&bar[XB_TOP], 1u);
            const unsigned tg = og / nx;
            if (og + 1u == (tg + 1u) * nx) xb_add(&bar[XB_TOPGEN], 1u);
            else XB_SPIN(xb_ld(&bar[XB_TOPGEN]) == tg, bar);
            __builtin_amdgcn_fence(__ATOMIC_ACQUIRE, "agent");
            xb_add(&bar[XB_XGEN(b.x)], 1u);
            asm volatile("s_waitcnt vmcnt(0)" ::: "memory");
        } else {
            XB_SPIN(xb_ld(&bar[XB_XGEN(b.x)]) == gen, bar);
            __builtin_amdgcn_fence(__ATOMIC_ACQUIRE, "agent");
            asm volatile("s_waitcnt vmcnt(0)" ::: "memory");
        }
    }
    __syncthreads();
}

struct Params {
    const float *x, *c, *ctx, *c_ctx, *ada_w, *ada_b, *norm1_g, *norm2_g, *w_in, *rpb, *w_att_o, *w_fourier, *w_pool, *pool_scale, *w_out, *w_router, *w_eg, *w_eu, *w_ed, *final_g;
    float* out; unsigned char* ws; int l_lo, l_hi;
};
struct Frame {
    LAS unsigned char* lds;
    int tid, lane, wave, G, bid;
    unsigned char* ws;
};
#define WSP(T, off) ((T*)(F.ws + (off)))

struct Unit { int grp, pm, pn, seg; };
struct GroupSched {
    int ng, nM, nN, G, c; int tM, tN, tpm0, tpn0;
    __device__ __forceinline__ void init(int ng_, int nM_, int nN_, int G_, int c_, int tM_ = 0, int tN_ = 0, int tpm0_ = 0, int tpn0_ = 0) { ng = ng_; nM = nM_; nN = nN_; G = G_; c = c_; tM = tM_; tN = tN_; tpm0 = tpm0_; tpn0 = tpn0_; }
    __device__ __forceinline__ bool next(int i, Unit& u) const {
        const int per = nM * nN; const int L = i * G + c;
        if (L < ng * per) {
            u.grp = L / per; int wgid = L - u.grp * per;
            { const int q = per / 8, r = per % 8, xcd = wgid % 8, off = wgid / 8; wgid = (xcd < r ? xcd * (q + 1) : r * (q + 1) + (xcd - r) * q) + off; }
            const int nig = 8 * nN, gid = wgid / nig, fm = gid * 8, gsz = (nM - fm) < 8 ? (nM - fm) : 8;
            u.pm = fm + ((wgid % nig) % gsz); u.pn = (wgid % nig) / gsz; u.seg = 0; return true;
        }
        const int w = L - ng * per;
        if (w < tM * tN) { u.grp = ng; u.pm = tpm0 + (w % tM); u.pn = tpn0 + (w / tM); u.seg = 0; return true; }
        return false;
    }
};
struct Operands { const bf16* A; const bf16* Bt; int lda, ldb, slot0, K; int bmap; };

constexpr int HTB = 128 * 64 * 2;
__device__ __forceinline__ int lds_byte(int r, int c) { const int st = (r >> 4) * 2 + (c >> 5), rr = r & 15, cc = c & 31, ob = rr * 64 + cc * 2; return st * 1024 + (ob ^ (((ob >> 9) & 1) << 5)); }
__device__ __forceinline__ int perm32(int rho) { const int n = rho >> 4, i = rho & 15; return 8 * (i >> 2) + 4 * n + (i & 3); }
__device__ __forceinline__ void stage_rc(int b, int& R, int& C) { const int st = b / 1024, sb = b % 1024, swz = sb ^ (((sb >> 9) & 1) << 5); R = (st >> 1) * 16 + swz / 64; C = (st & 1) * 32 + (swz % 64) / 2; }
typedef int i32x8 __attribute__((ext_vector_type(8)));
typedef int i32x4 __attribute__((ext_vector_type(4)));
__device__ __forceinline__ i32x8 cat8(bf16x8 lo, bf16x8 hi) { const i32x4 a = __builtin_bit_cast(i32x4, lo), b = __builtin_bit_cast(i32x4, hi); return (i32x8){a[0], a[1], a[2], a[3], b[0], b[1], b[2], b[3]}; }
template <bool GATHER, bool PERM, bool FP8, class Sched, class Addr, class Epi>
__device__ __forceinline__ void gemm_fast(LAS unsigned char* lds, const int tid, const Sched& S, const Addr& AD, const Epi& E, const int* __restrict__ grows) {
    const int wid = __builtin_amdgcn_readfirstlane(tid >> 6), lane = tid & 63, wr = wid >> 2, wc = wid & 3, fr = lane & 15, fq = lane >> 4;
    unsigned cvg[2][2], nvg[2][2], cvb[2][2], nvb[2][2];
#define PG8_RC(i_) int R_, C_; stage_rc(tid * 16 + (i_) * 8192, R_, C_); const int sR_ = R_; const unsigned sC_ = (unsigned)C_ * 2u; const int sRb_ = PERM ? ((R_ & ~31) + perm32(R_ & 31)) : R_; (void)sR_; (void)sRb_; (void)sC_
    const size_t kstep = 128;
    const unsigned ldsw = (unsigned)wid * 1024u;
    const int aoff = lds_byte(wr * 64 + fr, fq * 8), boff = lds_byte(wc * 32 + fr, fq * 8);
#define PG8_SA(b, h) (((b) * 2 + (h)) * HTB)
#define PG8_SB(b, h) ((4 + (b) * 2 + (h)) * HTB)
#define PG8_STAGE(bufoff, gbase, voff) do { _Pragma("unroll") for (int _i = 0; _i < 2; ++_i) \
        __builtin_amdgcn_global_load_lds((const unsigned*)((const char*)(gbase) + (voff)[_i]), (LAS unsigned*)(lds + (bufoff) + ldsw + _i * 8192), 16, 0, 0); } while (0)
#define PG8_LDA(dst, b, h) do { if constexpr (FP8) { _Pragma("unroll") for (int m = 0; m < 4; ++m) dst##8[m] = cat8(*(const LAS bf16x8*)(lds + PG8_SA(b, h) + aoff + m * 2048), *(const LAS bf16x8*)(lds + PG8_SA(b, h) + aoff + m * 2048 + 1024)); } \
        else { _Pragma("unroll") for (int m = 0; m < 4; ++m) _Pragma("unroll") for (int k = 0; k < 2; ++k) dst[m][k] = *(const LAS bf16x8*)(lds + PG8_SA(b, h) + aoff + m * 2048 + k * 1024); } } while (0)
#define PG8_LDB(dst, b, h) do { if constexpr (FP8) { _Pragma("unroll") for (int n = 0; n < 2; ++n) dst##8[n] = cat8(*(const LAS bf16x8*)(lds + PG8_SB(b, h) + boff + n * 2048), *(const LAS bf16x8*)(lds + PG8_SB(b, h) + boff + n * 2048 + 1024)); } \
        else { _Pragma("unroll") for (int n = 0; n < 2; ++n) _Pragma("unroll") for (int k = 0; k < 2; ++k) dst[n][k] = *(const LAS bf16x8*)(lds + PG8_SB(b, h) + boff + n * 2048 + k * 1024); } } while (0)
#define PG8_MMA(ai, bj, At, Bt) do { __builtin_amdgcn_s_setprio(1); \
        if constexpr (FP8) { _Pragma("unroll") for (int m = 0; m < 4; ++m) _Pragma("unroll") for (int n = 0; n < 2; ++n)   \
            asm volatile("v_mfma_scale_f32_16x16x128_f8f6f4 %0, %1, %2, %0, %3, %3 op_sel_hi:[0,0,0]" : "+v"(acc[ai][bj][m][n]) : "v"(Bt##8[n]), "v"(At##8[m]), "v"(one_scale)); } \
        else { _Pragma("unroll") for (int m = 0; m < 4; ++m) _Pragma("unroll") for (int n = 0; n < 2; ++n) _Pragma("unroll") for (int k = 0; k < 2; ++k) \
            acc[ai][bj][m][n] = __builtin_amdgcn_mfma_f32_16x16x32_bf16(Bt[n][k], At[m][k], acc[ai][bj][m][n], 0, 0, 0); } \
        __builtin_amdgcn_s_setprio(0); } while (0)
#define PG8_WAIT_V(n) asm volatile("s_waitcnt vmcnt(" #n ")" ::: "memory")
#define PG8_WAIT_L(n) asm volatile("s_waitcnt lgkmcnt(" #n ")" ::: "memory")
#define PG8_BAR __builtin_amdgcn_s_barrier()
#define PG8_SCHED __builtin_amdgcn_sched_barrier(0)
#define PG8_GIDX(dst, op_) do { _Pragma("unroll") for (int i_ = 0; i_ < 2; ++i_) { PG8_RC(i_); _Pragma("unroll") for (int h_ = 0; h_ < 2; ++h_) dst[h_][i_] = (unsigned)grows[(op_).slot0 + h_ * 128 + sR_] * (unsigned)((op_).lda * 2) + sC_; } } while (0)
#define PG8_AOFF(dst, op_) do { _Pragma("unroll") for (int i_ = 0; i_ < 2; ++i_) { PG8_RC(i_); _Pragma("unroll") for (int h_ = 0; h_ < 2; ++h_) dst[h_][i_] = (unsigned)((sR_ + 128 * h_) * (op_).lda) * 2u + sC_; } } while (0)
#define PG8_BOFF(dst, op_) do { _Pragma("unroll") for (int i_ = 0; i_ < 2; ++i_) { PG8_RC(i_); _Pragma("unroll") for (int h_ = 0; h_ < 2; ++h_) { const int c_ = sRb_ + 128 * h_; \
        dst[h_][i_] = (unsigned)(((op_).bmap ? (64 * (c_ & 7) + (c_ >> 3)) : c_) * (op_).ldb) * 2u + sC_; } } } while (0)
#define PG8_COPY(dst, src) do { _Pragma("unroll") for (int h_ = 0; h_ < 2; ++h_) _Pragma("unroll") for (int i_ = 0; i_ < 2; ++i_) dst[h_][i_] = src[h_][i_]; } while (0)
    Unit cur, nxt; int ui = 0;
    if (!S.next(0, cur)) return;
    f32x4 acc[2][2][4][2];
#pragma unroll
    for (int a = 0; a < 2; ++a)
#pragma unroll
        for (int b = 0; b < 2; ++b)
#pragma unroll
            for (int m = 0; m < 4; ++m)
#pragma unroll
                for (int n = 0; n < 2; ++n) acc[a][b][m][n] = (f32x4){0.f, 0.f, 0.f, 0.f};
    bf16x8 At[4][2], B0[2][2], B1[2][2]; i32x8 At8[4], B08[2], B18[2];
    const int one_scale = 0x7F7F7F7F;
    const char* cA; const char* cB; int nt;
    bool has_next; const char* nA; const char* nB; int nnt;
    { const Operands op = AD(cur); cA = (const char*)op.A; cB = (const char*)op.Bt; nt = op.K / 64; PG8_BOFF(cvb, op);
      has_next = S.next(1, nxt); const Operands o1 = has_next ? AD(nxt) : op; PG8_BOFF(nvb, o1); nA = (const char*)o1.A; nB = (const char*)o1.Bt; nnt = o1.K / 64;
      if constexpr (GATHER) { PG8_GIDX(cvg, op); PG8_GIDX(nvg, o1); PG8_WAIT_V(0); } else { PG8_AOFF(cvg, op); PG8_AOFF(nvg, o1); } }
    PG8_STAGE(PG8_SB(0, 0), cB, cvb[0]); PG8_STAGE(PG8_SB(0, 1), cB, cvb[1]); PG8_STAGE(PG8_SA(0, 0), cA, cvg[0]); PG8_STAGE(PG8_SA(0, 1), cA, cvg[1]);
    if (wr == 1) PG8_BAR;
    PG8_WAIT_V(2); PG8_BAR;
    PG8_STAGE(PG8_SB(1, 0), cB + kstep, cvb[0]); PG8_STAGE(PG8_SA(1, 0), cA + kstep, cvg[0]); PG8_STAGE(PG8_SB(1, 1), cB + kstep, cvb[1]);
    PG8_WAIT_V(6); PG8_BAR;
    for (;;) {
#pragma unroll 1
        for (int t = 0; t < nt; t += 2) {
            const bool last = (t == nt - 2);
            const char* a1 = cA + (size_t)(t + 1) * kstep;
            const char* a2 = last ? nA : cA + (size_t)(t + 2) * kstep; const char* b2 = last ? nB : cB + (size_t)(t + 2) * kstep;
            const char* a3 = a2 + kstep; const char* b3 = b2 + kstep;
            unsigned v2[2][2], w2[2][2];
#pragma unroll
            for (int h_ = 0; h_ < 2; ++h_)
#pragma unroll
                for (int i_ = 0; i_ < 2; ++i_) { v2[h_][i_] = last ? nvg[h_][i_] : cvg[h_][i_]; w2[h_][i_] = last ? nvb[h_][i_] : cvb[h_][i_]; }
            PG8_LDB(B0, 0, 0); PG8_LDB(B1, 0, 1); PG8_SCHED; PG8_LDA(At, 0, 0); PG8_STAGE(PG8_SA(1, 1), a1, cvg[1]);
            PG8_WAIT_V(8); PG8_WAIT_L(0); PG8_BAR; PG8_MMA(0, 0, At, B0); PG8_MMA(0, 1, At, B1); PG8_BAR; PG8_SCHED;
            PG8_LDA(At, 0, 1); PG8_STAGE(PG8_SB(0, 0), b2, w2[0]); PG8_STAGE(PG8_SB(0, 1), b2, w2[1]); PG8_STAGE(PG8_SA(0, 0), a2, v2[0]);
            PG8_WAIT_V(8); PG8_WAIT_L(0); PG8_BAR; PG8_MMA(1, 0, At, B0); PG8_MMA(1, 1, At, B1); PG8_BAR; PG8_SCHED;
            PG8_LDB(B0, 1, 0); PG8_LDB(B1, 1, 1); PG8_SCHED; PG8_LDA(At, 1, 0); PG8_STAGE(PG8_SA(0, 1), a2, v2[1]);
            PG8_WAIT_V(8); PG8_WAIT_L(0); PG8_BAR; PG8_MMA(0, 0, At, B0); PG8_MMA(0, 1, At, B1); PG8_BAR; PG8_SCHED;
            PG8_LDA(At, 1, 1); PG8_STAGE(PG8_SB(1, 0), b3, w2[0]); PG8_STAGE(PG8_SB(1, 1), b3, w2[1]); PG8_STAGE(PG8_SA(1, 0), a3, v2[0]);
            PG8_WAIT_V(8); PG8_WAIT_L(0); PG8_BAR; PG8_MMA(1, 0, At, B0); PG8_MMA(1, 1, At, B1); PG8_BAR; PG8_SCHED;
        }
        if constexpr (FP8) asm volatile("s_nop 15\n\ts_nop 15" ::: "memory");
        if (wr == 0) PG8_BAR;
        unsigned fvg[2][2], fvb[2][2];
        Unit u2; const bool h2 = S.next(ui + 2, u2); const char* fA = nA; const char* fB = nB; int fnt = nnt;
        if (h2) { const Operands o2 = AD(u2); fA = (const char*)o2.A; fB = (const char*)o2.Bt; fnt = o2.K / 64; PG8_BOFF(fvb, o2); if constexpr (GATHER) PG8_GIDX(fvg, o2); else PG8_AOFF(fvg, o2); }
        else { PG8_COPY(fvb, nvb); PG8_COPY(fvg, nvg); }
        { int fr2 = fr, fq2 = fq; asm volatile("" : "+v"(fr2), "+v"(fq2));
          E(acc, cur, wr, wc, fr2, fq2); }
        if (!has_next) break;
        if constexpr (GATHER) PG8_WAIT_V(0);
        PG8_COPY(cvg, nvg); PG8_COPY(nvg, fvg); PG8_COPY(cvb, nvb); PG8_COPY(nvb, fvb);
        if (E.reset(cur)) {
#pragma unroll
        for (int a = 0; a < 2; ++a)
#pragma unroll
            for (int b = 0; b < 2; ++b)
#pragma unroll
                for (int m = 0; m < 4; ++m)
#pragma unroll
                    for (int n = 0; n < 2; ++n) acc[a][b][m][n] = (f32x4){0.f, 0.f, 0.f, 0.f};
        }
        cur = nxt; cA = nA; cB = nB; nt = nnt; ++ui;
        nxt = u2; has_next = h2; nA = fA; nB = fB; nnt = fnt;
        if (wr == 1) PG8_BAR;
    }
    PG8_WAIT_V(0);
    PG8_BAR;
#undef PG8_SA
#undef PG8_SB
#undef PG8_STAGE
#undef PG8_LDA
#undef PG8_LDB
#undef PG8_MMA
#undef PG8_WAIT_V
#undef PG8_WAIT_L
#undef PG8_BAR
#undef PG8_SCHED
#undef PG8_GIDX
#undef PG8_AOFF
#undef PG8_BOFF
#undef PG8_COPY
#undef PG8_RC
}
template <class F> struct EpiFn { F f; __device__ __forceinline__ void operator()(f32x4 (&acc)[2][2][4][2], const Unit& u, int wr, int wc, int fr, int fq) const { f(acc, u, wr, wc, fr, fq); } __device__ __forceinline__ bool reset(const Unit&) const { return true; } };
template <class F> __device__ __forceinline__ EpiFn<F> mk_epi(F f) { return EpiFn<F>{f}; }
template <class F> struct EpiSeg { F f; int last; __device__ __forceinline__ void operator()(f32x4 (&acc)[2][2][4][2], const Unit& u, int wr, int wc, int fr, int fq) const { f(acc, u, wr, wc, fr, fq); } __device__ __forceinline__ bool reset(const Unit& u) const { return u.seg == last; } };
template <class F> __device__ __forceinline__ EpiSeg<F> mk_epi_seg(F f, int last) { return EpiSeg<F>{f, last}; }
template <int NSEG> struct SegSched { GroupSched base; __device__ __forceinline__ bool next(int j, Unit& u) const { if (!base.next(j / NSEG, u)) return false; u.seg = j % NSEG; return true; } };
#ifndef DUP_PH
#define DUP_PH -1
#endif
#define REP_BEGIN(k) _Pragma("unroll 1") for (int rep_ = 0; rep_ < ((DUP_PH == (k)) ? 2 : 1); ++rep_) { if (rep_) { if constexpr (PH < 0) xcd_barrier(bar); }
#define REP_END }
#define GEMM(S, AD, E, K, lda, ldb) gemm_fast<false, false, false>(F.lds, F.tid, S, AD, mk_epi(E), nullptr)
#define GEMM_P(S, AD, E) gemm_fast<false, true, false>(F.lds, F.tid, S, AD, mk_epi(E), nullptr)
#define GEMM_P8(S, AD, E) gemm_fast<false, true, true>(F.lds, F.tid, S, AD, mk_epi(E), nullptr)
#define GEMM_GATHER8(S, AD, E, rows) gemm_fast<true, true, true>(F.lds, F.tid, S, AD, mk_epi(E), rows)
#define EPI_ARGS f32x4 (&acc)[2][2][4][2], const Unit& u, int wr, int wc, int fr, int fq
#define EPI_FOR(...) _Pragma("unroll") for (int ai = 0; ai < 2; ++ai) _Pragma("unroll") for (int m = 0; m < 4; ++m) { const int r = ai * 128 + wr * 64 + m * 16 + fr; \
    _Pragma("unroll") for (int bj = 0; bj < 2; ++bj) _Pragma("unroll") for (int n = 0; n < 2; ++n) { const int c = bj * 128 + wc * 32 + n * 16 + 4 * fq; const f32x4 v = acc[ai][bj][m][n]; __VA_ARGS__ } }
#define EPI_FOR8(...) _Pragma("unroll") for (int ai = 0; ai < 2; ++ai) _Pragma("unroll") for (int m = 0; m < 4; ++m) { const int r = ai * 128 + wr * 64 + m * 16 + fr; \
    _Pragma("unroll") for (int bj = 0; bj < 2; ++bj) { const int c = bj * 128 + wc * 32 + 8 * fq; const f32x4 v0 = acc[ai][bj][m][0], v1 = acc[ai][bj][m][1]; __VA_ARGS__ } }
__device__ __forceinline__ void st_bf8(bf16* p, f32x4 a, f32x4 b) { u32x4 w; w.x = pk2(a[0], a[1]); w.y = pk2(a[2], a[3]); w.z = pk2(b[0], b[1]); w.w = pk2(b[2], b[3]); *(u32x4*)p = w; }
__device__ __forceinline__ void st_bf4(bf16* p, f32x4 v) { u32x2 w; w.x = pk2(v[0], v[1]); w.y = pk2(v[2], v[3]); *(u32x2*)p = w; }

__device__ __forceinline__ void p_mod(const Params& P, Frame& F) {
    LAS float* sc = (LAS float*)F.lds;
    LAS float* red = (LAS float*)(F.lds + 9 * 1024 * 4);
    float* MOD = WSP(float, WS_MOD);
    bool have = false;
    for (int it = F.bid; it < 2 * 96; it += F.G) {
        if (!have) {
            for (int i = F.tid; i < 9 * 1024; i += NTHREADS) { const int r = i >> 10, k = i & 1023; const float v = r < 8 ? P.c[r * 1024 + k] : P.c_ctx[k]; sc[i] = v * sigmoidf_(v); }
            have = true;
        }
        __syncthreads();
        const int l = it / 96, j0 = (it % 96) * 64, jj = F.tid & 63, kc = F.tid >> 6;
        const float* W = P.ada_w + (size_t)l * 1024 * 6144 + j0 + jj;
        float a[9];
#pragma unroll
        for (int r = 0; r < 9; ++r) a[r] = 0.f;
#pragma unroll 8
        for (int k = kc * 128; k < kc * 128 + 128; ++k) { const float w = W[(size_t)k * 6144];
#pragma unroll
            for (int r = 0; r < 9; ++r) a[r] += sc[r * 1024 + k] * w; }
#pragma unroll
        for (int r = 0; r < 9; ++r) red[(kc * 9 + r) * 64 + jj] = a[r];
        __syncthreads();
        for (int o = F.tid; o < 9 * 64; o += NTHREADS) { const int r = o >> 6, j = o & 63; float s = 0.f;
#pragma unroll
            for (int q = 0; q < 8; ++q) s += red[(q * 9 + r) * 64 + j];
            MOD[((size_t)l * 9 + r) * 6144 + j0 + j] = s + P.ada_b[l * 6144 + j0 + j]; }
    }
    __syncthreads();
}
__device__ __forceinline__ void p_dftgen(Frame& F) {
    LAS float* tab = (LAS float*)F.lds;
    for (int j = F.tid; j < 4096; j += NTHREADS) tab[j] = cospif((float)j * (1.0f / 2048.0f));
    __syncthreads();
    bf16* DC_ = WSP(bf16, WS_DFTC); bf16* M1 = WSP(bf16, WS_M1T); bf16* M2 = WSP(bf16, WS_M2T);
    const int nchunk = 256 * 64 + 256 * 32 + 256 * 64;
    for (int ch = F.bid * NTHREADS + F.tid; ch < nchunk; ch += F.G * NTHREADS) {
        float v[8]; bf16* dst;
        if (ch < 256 * 64) { const int kf = ch >> 6, col0 = (ch & 63) * 8, cs = col0 >> 8, l0 = col0 & 255;
#pragma unroll
            for (int i = 0; i < 8; ++i) { const int j = ((kf * (l0 + i)) & 255) * 16; v[i] = cs ? -tab[(j + 3072) & 4095] : tab[j]; }
            dst = DC_ + (size_t)kf * 512 + col0; }
        else if (ch < 256 * 64 + 256 * 32) { const int c2 = ch - 256 * 64, row = c2 >> 5, col0 = (c2 & 31) * 8, ri = row >> 7, h = (row >> 6) & 1, k1 = row & 63, h2 = col0 >> 7, cs = (col0 >> 6) & 1, l10 = col0 & 63;
#pragma unroll
            for (int i = 0; i < 8; ++i) { const int j = ((k1 * (l10 + i)) & 63) * 64; const float c = tab[j], sn = tab[(j + 3072) & 4095];
                v[i] = (h != h2) ? 0.f : (ri == 0 ? (cs == 0 ? c : -sn) : (cs == 0 ? sn : c)); }
            dst = M1 + (size_t)row * 256 + col0; }
        else { const int c2 = ch - 256 * 64 - 256 * 32, row = c2 >> 6, col0 = (c2 & 63) * 8, q = row >> 6, k2 = row & 63, q2 = col0 >> 7, ri = (col0 >> 6) & 1, l20 = col0 & 63;
#pragma unroll
            for (int i = 0; i < 8; ++i) { const int j = ((k2 * (l20 + i)) & 63) * 64; const float c = tab[j], sn = tab[(j + 3072) & 4095];
                v[i] = (q != q2) ? 0.f : (ri == 0 ? c : -sn); }
            dst = M2 + (size_t)row * 512 + col0; }
        u32x4 o; o.x = pk2(v[0], v[1]); o.y = pk2(v[2], v[3]); o.z = pk2(v[4], v[5]); o.w = pk2(v[6], v[7]);
        *(u32x4*)dst = o;
    }
    __syncthreads();
}
__device__ __forceinline__ void transpose_item(const float* W, int ldw, int k0, int n0, bf16* WT, int ldt, int drow0, LAS float* scr, int lane) {
    f32x4 ld[8];
#pragma unroll
    for (int i = 0; i < 8; ++i) ld[i] = *(const f32x4*)(W + (size_t)(k0 + 8 * i + (lane >> 3)) * ldw + n0 + 4 * (lane & 7));
#pragma unroll
    for (int i = 0; i < 8; ++i) { LAS float* d = scr + (8 * i + (lane >> 3)) * 33 + 4 * (lane & 7); d[0] = ld[i][0]; d[1] = ld[i][1]; d[2] = ld[i][2]; d[3] = ld[i][3]; }
    LDS_WAIT(); asm volatile("" ::: "memory");
    const int c = lane & 7;
#pragma unroll
    for (int j = 0; j < 4; ++j) { const int n = (lane >> 3) + 8 * j; const LAS float* s = scr + (8 * c) * 33 + n;
        u32x4 o; o.x = pk2(s[0 * 33], s[1 * 33]); o.y = pk2(s[2 * 33], s[3 * 33]); o.z = pk2(s[4 * 33], s[5 * 33]); o.w = pk2(s[6 * 33], s[7 * 33]);
        *(u32x4*)(WT + (size_t)(drow0 + n) * ldt + k0 + 8 * c) = o; }
    LDS_WAIT(); asm volatile("" ::: "memory");
}
__device__ __forceinline__ void transpose_item8(const float* W, int ldw, int k0, int n0, unsigned char* WT, int ldt, int drow0, LAS float* scr, int lane) {
    f32x4 ld[8];
#pragma unroll
    for (int i = 0; i < 8; ++i) ld[i] = *(const f32x4*)(W + (size_t)(k0 + 8 * i + (lane >> 3)) * ldw + n0 + 4 * (lane & 7));
#pragma unroll
    for (int i = 0; i < 8; ++i) { LAS float* d = scr + (8 * i + (lane >> 3)) * 33 + 4 * (lane & 7); d[0] = ld[i][0]; d[1] = ld[i][1]; d[2] = ld[i][2]; d[3] = ld[i][3]; }
    LDS_WAIT(); asm volatile("" ::: "memory");
    const int c = lane & 7;
#pragma unroll
    for (int j = 0; j < 4; ++j) { const int n = (lane >> 3) + 8 * j; const LAS float* s = scr + (8 * c) * 33 + n;
        u32x2 o; o.x = pk4_fp8(s[0 * 33] * W8S, s[1 * 33] * W8S, s[2 * 33] * W8S, s[3 * 33] * W8S); o.y = pk4_fp8(s[4 * 33] * W8S, s[5 * 33] * W8S, s[6 * 33] * W8S, s[7 * 33] * W8S);
        *(u32x2*)(WT + (size_t)(drow0 + n) * ldt + k0 + 8 * c) = o; }
    LDS_WAIT(); asm volatile("" ::: "memory");
}
__device__ __forceinline__ void transpose_item8w(const float* W, int ldw, int k0, int n0, unsigned char* WT, int ldt, int drow0, LAS float* scr, int lane) {
    f32x4 ld[16];
#pragma unroll
    for (int i = 0; i < 16; ++i) ld[i] = *(const f32x4*)(W + (size_t)(k0 + 4 * i + (lane >> 4)) * ldw + n0 + 4 * (lane & 15));
#pragma unroll
    for (int i = 0; i < 16; ++i) { LAS float* d = scr + (4 * i + (lane >> 4)) * 65 + 4 * (lane & 15); d[0] = ld[i][0]; d[1] = ld[i][1]; d[2] = ld[i][2]; d[3] = ld[i][3]; }
    LDS_WAIT(); asm volatile("" ::: "memory");
    const int c = lane & 3;
#pragma unroll
    for (int p = 0; p < 4; ++p) { const int n = (lane >> 2) + 16 * p; const LAS float* s = scr + (16 * c) * 65 + n; u32x4 o;
#pragma unroll
        for (int q = 0; q < 4; ++q) o[q] = pk4_fp8(s[(4 * q) * 65] * W8S, s[(4 * q + 1) * 65] * W8S, s[(4 * q + 2) * 65] * W8S, s[(4 * q + 3) * 65] * W8S);
        *(u32x4*)(WT + (size_t)(drow0 + n) * ldt + k0 + 16 * c) = o; }
    LDS_WAIT(); asm volatile("" ::: "memory");
}
__device__ __forceinline__ void wconv_experts(const Params& P, Frame& F, int l, int rank, int nblk) {
    LAS float* scr = (LAS float*)(F.lds + (F.wave < 7 ? F.wave * 17408 : 131584));
    const int gw = rank * NWAVES + F.wave, NGW = nblk * NWAVES;
    constexpr int I_E = 16 * 44;
    unsigned char* WGU = WSP(unsigned char, WS_WGU); unsigned char* WD = WSP(unsigned char, WS_WD);
    for (int it = gw; it < 3 * 16 * I_E; it += NGW) {
        const int which = it / (16 * I_E), r0 = it % (16 * I_E), e = r0 / I_E, r = r0 % I_E;
        if (which < 2) { const int kb = r / 44, nb = r % 44, n0 = nb * 64;
            const float* src = (which == 0 ? P.w_eg : P.w_eu) + ((size_t)l * 16 + e) * 1024 * FF;
            transpose_item8w(src, FF, kb * 64, n0, WGU + (size_t)e * 5632 * 1024, 1024, (n0 >> 7) * 256 + (which ? 128 : 0) + (n0 & 127), scr, F.lane); }
        else { const int kb = r / 16, nb = r % 16;
            transpose_item8w(P.w_ed + ((size_t)l * 16 + e) * FF * 1024, 1024, kb * 64, nb * 64, WD + (size_t)e * 1024 * FF, FF, nb * 64, scr, F.lane); }
    }
    __syncthreads();
}
__device__ __forceinline__ void p_wconv(const Params& P, Frame& F, int l) {
    LAS float* scr = (LAS float*)(F.lds + F.wave * 16384);
    const int gw = F.bid * NWAVES + F.wave, NGW = F.G * NWAVES;
    const float* w_in = P.w_in + (size_t)l * 1024 * INW;
    bf16* WA = WSP(bf16, WS_WA); bf16* WFV = WSP(bf16, WS_WFV);
    constexpr int I_K = 16 * 32, I_Q = 16 * 32, I_P = 16 * 16, I_G = 16 * 96, I_V = 16 * 32, I_AO = 16 * 32, I_FO = 8 * 32, I_OUT = 16 * 32;
    constexpr int NSM = I_K + I_Q + I_P + I_G + I_V + I_AO + I_FO + I_OUT;
    for (int it = gw; it < NSM; it += NGW) {
        int r = it;
        if (r < I_K) { transpose_item8(w_in, INW, (r / 32) * 64, 0 + (r % 32) * 32, WSP(unsigned char, WS_WA8), 1024, 0 + (r % 32) * 32, scr, F.lane); continue; } r -= I_K;
        if (r < I_Q) { transpose_item8(w_in, INW, (r / 32) * 64, 2048 + (r % 32) * 32, WSP(unsigned char, WS_WA8), 1024, 1024 + (r % 32) * 32, scr, F.lane); continue; } r -= I_Q;
        if (r < I_P) { transpose_item(w_in, INW, (r / 16) * 64, 3584 + (r % 16) * 32, WA, 1024, 2048 + (r % 16) * 32, scr, F.lane); continue; } r -= I_P;
        if (r < I_G) { transpose_item8(w_in, INW, (r / 96) * 64, 4096 + (r % 96) * 32, WSP(unsigned char, WS_WA8), 1024, 3072 + (r % 96) * 32, scr, F.lane); continue; } r -= I_G;
        if (r < I_V) { transpose_item8(w_in, INW, (r / 32) * 64, 1024 + (r % 32) * 32, WSP(unsigned char, WS_WA8), 1024, 2048 + (r % 32) * 32, scr, F.lane); continue; } r -= I_V;
        if (r < I_AO) { transpose_item8(P.w_att_o + (size_t)l * 1024 * 1024, 1024, (r / 32) * 64, (r % 32) * 32, WSP(unsigned char, WS_WAO), 1024, (r % 32) * 32, scr, F.lane); continue; } r -= I_AO;
        if (r < I_FO) { transpose_item(P.w_fourier + (size_t)l * 512 * 1024, 1024, (r / 32) * 64, (r % 32) * 32, WSP(bf16, WS_WFO), 512, (r % 32) * 32, scr, F.lane); continue; } r -= I_FO;
        transpose_item(P.w_out + (size_t)l * 1024 * 1024, 1024, (r / 32) * 64, (r % 32) * 32, WSP(bf16, WS_WOUT), 1024, (r % 32) * 32, scr, F.lane);
    }
    { bf16* WPO = WSP(bf16, WS_WPO); const float* wp = P.w_pool + (size_t)l * 4 * 128 * 256;
      for (int i = F.bid * NTHREADS + F.tid; i < 1024 * 256; i += F.G * NTHREADS) { const int n = i >> 8, kk = i & 255, g = n >> 8, f = n & 255;
          WPO[i] = (bf16)(((kk >> 7) == (g & 1)) ? f2bf(wp[((size_t)g * 128 + (kk & 127)) * 256 + f]) : 0u); } }
    { LAS float* t128 = (LAS float*)F.lds; LAS float* srcs = t128 + 128;
      int tid = F.tid; asm volatile("" : "+v"(tid));
      __syncthreads();
      for (int j = tid; j < 128; j += NTHREADS) t128[j] = cospif((float)j * (1.0f / 64.0f));
      for (int tile = F.bid; tile < 256; tile += F.G) { const int g = tile >> 6, kb = tile & 63;
          __syncthreads();
          { const int kk = tid >> 5, c4 = (tid & 31) * 4; const f32x4 v = *(const f32x4*)(w_in + (size_t)(kb * 16 + kk) * INW + 3072 + g * 128 + c4); LAS float* d = srcs + kk * 129 + c4; d[0] = v[0]; d[1] = v[1]; d[2] = v[2]; d[3] = v[3]; }
          __syncthreads();
          const int m = tid >> 2, kq = tid & 3; float sc_[4] = {0.f, 0.f, 0.f, 0.f}, ss_[4] = {0.f, 0.f, 0.f, 0.f}; const LAS float* sp = srcs + (4 * kq) * 129;
#pragma unroll 4
          for (int c = 0; c < 128; ++c) { const float tc = t128[(m * c) & 127], ts = t128[(m * c + 96) & 127];
#pragma unroll
              for (int j = 0; j < 4; ++j) { const float v = sp[j * 129 + c]; sc_[j] += v * tc; ss_[j] += v * ts; } }
          bf16* o = WFV + (size_t)((g * 128 + m) * 2) * 1024 + kb * 16 + 4 * kq;
          st_bf4(o, (f32x4){sc_[0], sc_[1], sc_[2], sc_[3]}); st_bf4(o + 1024, (f32x4){ss_[0], ss_[1], ss_[2], ss_[3]}); }
      __syncthreads(); }
}

struct RowMod { const float* g; const float* sh; const float* sc; };
__device__ __forceinline__ void row_load(const float* row, int lane, f32x4 (&v)[4]) {
#pragma unroll
    for (int j = 0; j < 4; ++j) v[j] = *(const f32x4*)(row + 4 * lane + 256 * j);
}
__device__ __forceinline__ void row_load_bf(const bf16* row, int lane, f32x4 (&v)[4]) {
#pragma unroll
    for (int j = 0; j < 4; ++j) { const u32x2 w = *(const u32x2*)(row + 4 * lane + 256 * j); v[j] = (f32x4){bflo(w.x), bfhi(w.x), bflo(w.y), bfhi(w.y)}; }
}
__device__ __forceinline__ float row_rstd(const f32x4 (&v)[4]) {
    float s = 0.f;
#pragma unroll
    for (int j = 0; j < 4; ++j) s += (v[j][0] * v[j][0] + v[j][1] * v[j][1]) + (v[j][2] * v[j][2] + v[j][3] * v[j][3]);
    return rsqrtf(wave_sum(s) * (1.0f / 1024.0f) + RMS_EPS);
}
__device__ __forceinline__ void row_modulate(const f32x4 (&v)[4], float rstd, const RowMod& M, int lane, f32x4 (&y)[4]) {
#pragma unroll
    for (int j = 0; j < 4; ++j) { const int k = 4 * lane + 256 * j; const f32x4 g = *(const f32x4*)(M.g + k), sh = *(const f32x4*)(M.sh + k), sc = *(const f32x4*)(M.sc + k);
        y[j] = v[j] * rstd * g * (sc + 1.0f) + sh; }
}
__device__ __forceinline__ void row_store_bf(bf16* row, int lane, const f32x4 (&y)[4]) {
#pragma unroll
    for (int j = 0; j < 4; ++j) st_bf4(row + 4 * lane + 256 * j, y[j]);
}
__device__ __forceinline__ void row_store_f8(unsigned char* row, int lane, const f32x4 (&y)[4]) {
#pragma unroll
    for (int j = 0; j < 4; ++j) *(unsigned*)(row + 4 * lane + 256 * j) = pk4_fp8(y[j][0] * A8S, y[j][1] * A8S, y[j][2] * A8S, y[j][3] * A8S);
}
__device__ __forceinline__ const float* mod_ptr(Frame& F, int l, int row, int which) { const int mr = row < RL ? (row >> 12) : 8; return WSP(float, WS_MOD) + ((size_t)l * 9 + mr) * 6144 + which * 1024; }

__device__ __forceinline__ void row_modulate2(const f32x4 (&v0)[4], const f32x4 (&v1)[4], float rs0, float rs1, const RowMod& M, int lane, f32x4 (&y0)[4], f32x4 (&y1)[4]) {
#pragma unroll
    for (int j = 0; j < 4; ++j) { const int k = 4 * lane + 256 * j; const f32x4 g = *(const f32x4*)(M.g + k), sh = *(const f32x4*)(M.sh + k), sc = *(const f32x4*)(M.sc + k); const f32x4 m = g * (sc + 1.0f);
        y0[j] = v0[j] * rs0 * m + sh; y1[j] = v1[j] * rs1 * m + sh; }
}
__device__ __forceinline__ void p_rowpass_a0(const Params& P, Frame& F) {
    const int gw = F.bid * NWAVES + F.wave, NGW = F.G * NWAVES; bf16* H = WSP(bf16, WS_H); unsigned char* H8 = WSP(unsigned char, WS_H8);
    f32x4 vn[2][4]; int p = gw;
    if (p < RT / 2) { const int row = 2 * p; const float* src = row < RL ? P.x + (size_t)row * DM : P.ctx + (size_t)(row - RL) * DM; row_load(src, F.lane, vn[0]); row_load(src + DM, F.lane, vn[1]); }
    for (; p < RT / 2; p += NGW) { const int row = 2 * p;
        f32x4 v0[4], v1[4], y0[4], y1[4];
#pragma unroll
        for (int j = 0; j < 4; ++j) { v0[j] = vn[0][j]; v1[j] = vn[1][j]; }
        { const int nr = 2 * (p + NGW); if (nr < RT) { const float* src = nr < RL ? P.x + (size_t)nr * DM : P.ctx + (size_t)(nr - RL) * DM; row_load(src, F.lane, vn[0]); row_load(src + DM, F.lane, vn[1]); } }
        const float rs0 = row_rstd(v0), rs1 = row_rstd(v1);
        RowMod M{P.norm1_g, mod_ptr(F, 0, row, 0), mod_ptr(F, 0, row, 1)};
        row_modulate2(v0, v1, rs0, rs1, M, F.lane, y0, y1);
        row_store_bf(H + (size_t)row * DM, F.lane, y0); row_store_f8(H8 + (size_t)row * DM, F.lane, y0);
        row_store_bf(H + (size_t)(row + 1) * DM, F.lane, y1); row_store_f8(H8 + (size_t)(row + 1) * DM, F.lane, y1);
    }
}
constexpr int DPP_MIRROR = 0x140, DPP_HMIRROR = 0x141;
__device__ __forceinline__ void p_rowpass_k(const Params& P, Frame& F, int l, int nrows) {
    const int gw = F.bid * NWAVES + F.wave, NGW = F.G * NWAVES; bf16* H = WSP(bf16, WS_H);
    const int* SEL = WSP(int, WS_SEL); const bf16* Y = WSP(bf16, WS_Y);
    f32x4 vn[2][4]; int seln = -1; int p = gw; const int NP = nrows >> 1;
    bf16* XB = WSP(bf16, WS_XB);
    if (p < NP) { const int row = 2 * p; const bf16* src = XB + (size_t)row * DM; row_load_bf(src, F.lane, vn[0]); row_load_bf(src + DM, F.lane, vn[1]);
        seln = F.lane < 32 ? SEL[(size_t)row * 16 + F.lane] : -1; }
    for (; p < NP; p += NGW) { const int row = 2 * p;
        f32x4 v0[4], v1[4], a0[4], a1[4]; const int sel = seln;
#pragma unroll
        for (int j = 0; j < 4; ++j) { v0[j] = vn[0][j]; v1[j] = vn[1][j]; a0[j] = (f32x4){0.f, 0.f, 0.f, 0.f}; a1[j] = (f32x4){0.f, 0.f, 0.f, 0.f}; }
        { const int nr = 2 * (p + NGW); if (nr < nrows) { const bf16* src = XB + (size_t)nr * DM; row_load_bf(src, F.lane, vn[0]); row_load_bf(src + DM, F.lane, vn[1]);
            seln = F.lane < 32 ? SEL[(size_t)nr * 16 + F.lane] : -1; } }
        const unsigned emall = (unsigned)__ballot(sel >= 0);
        unsigned em = emall & 0xffffu;
        while (em) { const int e = __builtin_ctz(em); em &= em - 1; const int s = __builtin_amdgcn_readlane(sel, e); const bf16* yr = Y + (size_t)s * DM;
#pragma unroll
            for (int j = 0; j < 4; ++j) { const u32x2 w = *(const u32x2*)(yr + 4 * F.lane + 256 * j); a0[j][0] += bflo(w.x); a0[j][1] += bfhi(w.x); a0[j][2] += bflo(w.y); a0[j][3] += bfhi(w.y); } }
        em = (emall >> 16) & 0xffffu;
        while (em) { const int e = __builtin_ctz(em); em &= em - 1; const int s = __builtin_amdgcn_readlane(sel, 16 + e); const bf16* yr = Y + (size_t)s * DM;
#pragma unroll
            for (int j = 0; j < 4; ++j) { const u32x2 w = *(const u32x2*)(yr + 4 * F.lane + 256 * j); a1[j][0] += bflo(w.x); a1[j][1] += bfhi(w.x); a1[j][2] += bflo(w.y); a1[j][3] += bfhi(w.y); } }
        const float* g2 = mod_ptr(F, l, row, 5);
#pragma unroll
        for (int j = 0; j < 4; ++j) { const f32x4 g = *(const f32x4*)(g2 + 4 * F.lane + 256 * j); v0[j] = v0[j] + g * a0[j]; v1[j] = v1[j] + g * a1[j]; }
        const float rs0 = row_rstd(v0), rs1 = row_rstd(v1);
        if (l == 0) {
#pragma unroll
            for (int j = 0; j < 4; ++j) { st_bf4(XB + (size_t)row * DM + 4 * F.lane + 256 * j, v0[j]); st_bf4(XB + (size_t)(row + 1) * DM + 4 * F.lane + 256 * j, v1[j]); }
            f32x4 y0[4], y1[4]; RowMod M{P.norm1_g + 1024, mod_ptr(F, 1, row, 0), mod_ptr(F, 1, row, 1)};
            row_modulate2(v0, v1, rs0, rs1, M, F.lane, y0, y1);
            row_store_bf(H + (size_t)row * DM, F.lane, y0); row_store_f8(WSP(unsigned char, WS_H8) + (size_t)row * DM, F.lane, y0);
            row_store_bf(H + (size_t)(row + 1) * DM, F.lane, y1); row_store_f8(WSP(unsigned char, WS_H8) + (size_t)(row + 1) * DM, F.lane, y1);
        } else {
#pragma unroll
            for (int j = 0; j < 4; ++j) { const f32x4 g = *(const f32x4*)(P.final_g + 4 * F.lane + 256 * j); float* xr = P.out + (size_t)row * DM + 4 * F.lane + 256 * j; *(f32x4*)xr = v0[j] * rs0 * g; *(f32x4*)(xr + DM) = v1[j] * rs1 * g; }
        }
    }
}

constexpr int RF_WH = 0, RF_WL = 16 * RF_PITCH * 2, RF_M8 = 2 * RF_WL, RF_S8 = RF_M8 + 4096, RF_BIAS = RF_S8 + 4096, RF_RS = RF_BIAS + 64;
__device__ __forceinline__ void p_rftables(const Params& P, Frame& F) {
    LAS float* red = (LAS float*)F.lds;
    for (int job = F.bid; job < 2 * 9 * 16; job += F.G) { const int e = job & 15, lm = job >> 4, l = lm / 9;
        int tid = F.tid; asm volatile("" : "+v"(tid));
        const float* wr = P.w_router + (size_t)l * 1024 * 16; const float* g2n = P.norm2_g + l * 1024;
        const float* sh = WSP(float, WS_MOD) + (size_t)lm * 6144 + 3 * 1024; const float* sc = sh + 1024;
        unsigned char* T = WSP(unsigned char, WS_RFT) + (size_t)lm * RF_TBL;
        float bs = 0.f;
#pragma unroll
        for (int q = 0; q < 2; ++q) { const int k = tid + 512 * q; const float m = g2n[k] * (1.0f + sc[k]), r = wr[k * 16 + e], w = m * r;
            const unsigned hi = f2bf(w); const float lo = w - bf2f(hi);
            ((bf16*)(T + RF_WH))[e * RF_PITCH + k] = (bf16)hi; ((bf16*)(T + RF_WL))[e * RF_PITCH + k] = (bf16)f2bf(lo);
            bs += sh[k] * r;
            if (e == 0) { ((float*)(T + RF_M8))[k] = m * A8S; ((float*)(T + RF_S8))[k] = sh[k] * A8S; } }
        bs = wave_sum(bs);
        __syncthreads();
        if (F.lane == 0) red[F.wave] = bs;
        __syncthreads();
        if (tid == 0) { float a = 0.f;
#pragma unroll
            for (int w = 0; w < NWAVES; ++w) a += red[w];
            ((float*)(T + RF_BIAS))[e] = a; }
    }
    __syncthreads();
}
__device__ __forceinline__ void rf_copy(Frame& F, const unsigned char* T) {
    int tid = F.tid; asm volatile("" : "+v"(tid));
    __syncthreads();
    u32x4 v[10];
#pragma unroll
    for (int q = 0; q < 10; ++q) { const int c = tid + 512 * q; if (c < RF_TBL / 16) v[q] = *(const u32x4*)(T + (size_t)c * 16); }
#pragma unroll
    for (int q = 0; q < 10; ++q) { const int c = tid + 512 * q; if (c < RF_TBL / 16) *(LAS u32x4*)(F.lds + c * 16) = v[q]; }
    __syncthreads();
}
__device__ __forceinline__ void rf_compute(Frame& F, const u32x4 (&xw)[32], unsigned char* H8, float* AFF, int row0) {
    const int i = F.lane & 15, g = F.lane >> 4;
    int og = 8 * g; asm volatile("" : "+v"(og));
    f32x2 s2 = {0.f, 0.f};
#pragma unroll
    for (int t = 0; t < 32; ++t)
#pragma unroll
        for (int q = 0; q < 4; ++q) { const f32x2 v = {bflo(xw[t][q]), bfhi(xw[t][q])}; s2 += v * v; }
    float ss = s2[0] + s2[1];
    { auto a = __builtin_amdgcn_permlane16_swap(__float_as_uint(ss), __float_as_uint(ss), false, false); ss = __uint_as_float(a[0]) + __uint_as_float(a[1]);
      auto b = __builtin_amdgcn_permlane32_swap(__float_as_uint(ss), __float_as_uint(ss), false, false); ss = __uint_as_float(b[0]) + __uint_as_float(b[1]); }
    const float rstd = rsqrtf(ss * (1.0f / 1024.0f) + RMS_EPS);
    LAS float* RS = (LAS float*)(F.lds + RF_RS) + F.wave * 16;
    if (F.lane < 16) RS[F.lane] = rstd;
    f32x4 acc = {0.f, 0.f, 0.f, 0.f};
    const LAS unsigned char* wb = F.lds + (i * RF_PITCH + og) * 2;
#pragma unroll
    for (int t = 0; t < 32; ++t) { const bf16x8 bh = *(const LAS bf16x8*)(wb + RF_WH + 64 * t), bl = *(const LAS bf16x8*)(wb + RF_WL + 64 * t); const bf16x8 a = __builtin_bit_cast(bf16x8, xw[t]);
        acc = __builtin_amdgcn_mfma_f32_16x16x32_bf16(a, bh, acc, 0, 0, 0); acc = __builtin_amdgcn_mfma_f32_16x16x32_bf16(a, bl, acc, 0, 0, 0);
        if ((t & 3) == 3) asm volatile("" ::: "memory"); }
    { const LAS float* M8 = (const LAS float*)(F.lds + RF_M8) + og; const LAS float* S8 = (const LAS float*)(F.lds + RF_S8) + og; unsigned char* hr = H8 + (size_t)(row0 + i) * DM + 8 * g;
#pragma unroll
      for (int t = 0; t < 32; ++t) { const f32x4 m0 = *(const LAS f32x4*)(M8 + 32 * t), m1 = *(const LAS f32x4*)(M8 + 32 * t + 4), h0 = *(const LAS f32x4*)(S8 + 32 * t), h1 = *(const LAS f32x4*)(S8 + 32 * t + 4);
          u32x4 x = xw[t]; asm volatile("" : "+v"(x));
          const f32x4 xa = {bflo(x[0]), bfhi(x[0]), bflo(x[1]), bfhi(x[1])}, xb = {bflo(x[2]), bfhi(x[2]), bflo(x[3]), bfhi(x[3])};
          const f32x4 ya = xa * rstd * m0 + h0, yb = xb * rstd * m1 + h1;
          u32x2 w; w.x = pk4_fp8(ya[0], ya[1], ya[2], ya[3]); w.y = pk4_fp8(yb[0], yb[1], yb[2], yb[3]); *(u32x2*)(hr + 32 * t) = w;
          if (t & 1) asm volatile("" ::: "memory"); } }
    LDS_WAIT(); asm volatile("" ::: "memory");
    const f32x4 rs4 = *(const LAS f32x4*)(RS + 4 * g); const float bias = ((const LAS float*)(F.lds + RF_BIAS))[i];
#pragma unroll
    for (int r = 0; r < 4; ++r) { const float lg = acc[r] * rs4[r] + bias; float mx = lg;
        mx = fmaxf(mx, dppf<DPP_XOR1>(mx)); mx = fmaxf(mx, dppf<DPP_XOR2>(mx)); mx = fmaxf(mx, dppf<DPP_HMIRROR>(mx)); mx = fmaxf(mx, dppf<DPP_MIRROR>(mx));
        const float ex = __expf(lg - mx); float den = ex;
        den += dppf<DPP_XOR1>(den); den += dppf<DPP_XOR2>(den); den += dppf<DPP_HMIRROR>(den); den += dppf<DPP_MIRROR>(den);
        AFF[(size_t)(row0 + 4 * g + r) * 16 + i] = ex / den; }
}
__device__ __forceinline__ void p_rowpass_f(const Params& P, Frame& F, int l, int nrows) {
    const bf16* XB = WSP(bf16, WS_XB); unsigned char* H8 = WSP(unsigned char, WS_H8); float* AFF = WSP(float, WS_AFF);
    int cur = -1;
    for (int it = F.bid; it < nrows / 128; it += F.G) { const int row0 = it * 128 + 16 * F.wave, mr = row0 < RL ? (row0 >> 12) : 8;
        const bf16* xr = XB + (size_t)(row0 + (F.lane & 15)) * DM + 8 * (F.lane >> 4);
        u32x4 xw[32];
#pragma unroll
        for (int t = 0; t < 32; ++t) xw[t] = *(const u32x4*)(xr + 32 * t);
        if (mr != cur) { rf_copy(F, WSP(unsigned char, WS_RFT) + (size_t)(l * 9 + mr) * RF_TBL); cur = mr; }
        rf_compute(F, xw, H8, AFF, row0); }
    __syncthreads();
}
constexpr int ACK_STRIDE = 72, ACV_STRIDE = 264;
constexpr int ALDS_CK = 0, ALDS_CV = 256 * ACK_STRIDE * 2, ALDS_RP = ALDS_CV + 64 * ACV_STRIDE * 2;
struct AttnState { float m, sum; f32x4 o[4]; };
__device__ __forceinline__ float xrow16_max(float x) {
    auto s = __builtin_amdgcn_permlane16_swap(__float_as_uint(x), __float_as_uint(x), false, false);
    x = fmaxf(__uint_as_float(s[0]), __uint_as_float(s[1]));
    auto t = __builtin_amdgcn_permlane32_swap(__float_as_uint(x), __float_as_uint(x), false, false);
    return fmaxf(__uint_as_float(t[0]), __uint_as_float(t[1]));
}
__device__ __forceinline__ float xrow16_sum(float x) {
    auto s = __builtin_amdgcn_permlane16_swap(__float_as_uint(x), __float_as_uint(x), false, false);
    x = __uint_as_float(s[0]) + __uint_as_float(s[1]);
    auto t = __builtin_amdgcn_permlane32_swap(__float_as_uint(x), __float_as_uint(x), false, false);
    return __uint_as_float(t[0]) + __uint_as_float(t[1]);
}
#define MFMA16(a, b, c) __builtin_amdgcn_mfma_f32_16x16x32_bf16((a), (b), (c), 0, 0, 0)
template <int NT>
__device__ __forceinline__ void attn_tail(AttnState& S, f32x4 (&sc)[NT], const u32x4 (&vw)[NT / 2][4]) {
    float cm = -__builtin_inff();
#pragma unroll
    for (int t = 0; t < NT; ++t)
#pragma unroll
        for (int j = 0; j < 4; ++j) cm = fmaxf(cm, sc[t][j]);
    cm = xrow16_max(cm);
    const bool need = (fabsf(cm) > 12.0f) && (cm > -1e30f);
    if (__builtin_amdgcn_ballot_w64(need) != 0ull) {
        const float d = need ? cm : 0.f, scl = __builtin_amdgcn_exp2f(-d);
        S.m += d; S.sum *= scl;
#pragma unroll
        for (int dt = 0; dt < 4; ++dt) S.o[dt] = S.o[dt] * scl;
#pragma unroll
        for (int t = 0; t < NT; ++t)
#pragma unroll
            for (int j = 0; j < 4; ++j) sc[t][j] -= d;
    }
    float ps = 0.f;
#pragma unroll
    for (int t = 0; t < NT; ++t)
#pragma unroll
        for (int j = 0; j < 4; ++j) { const float p = __builtin_amdgcn_exp2f(sc[t][j]); sc[t][j] = p; ps += p; }
    S.sum += ps;
#pragma unroll
    for (int ks = 0; ks < NT / 2; ++ks) { u32x4 pw; pw.x = pk2(sc[2 * ks][0], sc[2 * ks][1]); pw.y = pk2(sc[2 * ks][2], sc[2 * ks][3]); pw.z = pk2(sc[2 * ks + 1][0], sc[2 * ks + 1][1]); pw.w = pk2(sc[2 * ks + 1][2], sc[2 * ks + 1][3]);
        const bf16x8 pf = __builtin_bit_cast(bf16x8, pw);
#pragma unroll
        for (int dt = 0; dt < 4; ++dt) S.o[dt] = MFMA16(__builtin_bit_cast(bf16x8, vw[ks][dt]), pf, S.o[dt]); }
}
__device__ __forceinline__ void attn_unit2(const bf16* __restrict__ KQ, const bf16* __restrict__ VT, unsigned char* __restrict__ ATT, LAS unsigned char* lds,
                                           const int b, const int h, const int rowqA, const int rowqB, const bool win, const int r, const int qt, const int lane) {
    const int l15 = lane & 15, g = lane >> 4;
    const f32x4 z = {0.f, 0.f, 0.f, 0.f};
    bf16x8 qA[2], qB[2];
    { const bf16* qp = KQ + (size_t)(rowqA + l15) * 2048 + 1024 + h * 64 + 8 * g; qA[0] = *(const bf16x8*)qp; qA[1] = *(const bf16x8*)(qp + 32); }
    { const bf16* qp = KQ + (size_t)(rowqB + l15) * 2048 + 1024 + h * 64 + 8 * g; qB[0] = *(const bf16x8*)qp; qB[1] = *(const bf16x8*)(qp + 32); }
    AttnState SA, SB; SA.m = 0.f; SA.sum = 0.f; SB.m = 0.f; SB.sum = 0.f;
#pragma unroll
    for (int dt = 0; dt < 4; ++dt) { SA.o[dt] = z; SB.o[dt] = z; }
    if (win) {
        const int rsA = min(max(r - 4, 0), 56), dB = min(max(r - 3, 0), 56) - rsA, kc0 = min(max(16 * qt - 8, 0), 32);
        const int q = 16 * qt + l15, csq = min(max(q - 8, 0), 48);
        const int krow0 = 8 * (l15 >> 2) + (l15 & 3);
        const bf16* kb = KQ + (size_t)(b * SEQ + kc0 + krow0) * 2048 + h * 64 + 8 * g;
        const bf16* vb = VT + (size_t)(b * 1024 + h * 64 + l15) * 4096 + kc0 + 8 * g;
        const LAS float* rp = (const LAS float*)(lds + ALDS_RP);
        const int jb = kc0 + 8 * g;
        const int okb = jb - csq;
        const LAS float* rpl = rp + 16 + (jb - q + 15);
        float madd[2][4];
#pragma unroll
        for (int t = 0; t < 2; ++t)
#pragma unroll
            for (int j = 0; j < 4; ++j) madd[t][j] = ((unsigned)(okb + 4 * t + j) < 16u) ? 0.f : -__builtin_inff();
        bf16x8 K0[2][2], K1[2][2]; u32x4 V0[1][4], V1[1][4];
#define ATT_LOADW(KB, VB, i) do { const int gr_ = min(rsA + (i), 63); const bf16* kp_ = kb + (size_t)(gr_ * 64) * 2048; const bf16* vp_ = vb + gr_ * 64; \
        _Pragma("unroll") for (int t = 0; t < 2; ++t) { KB[t][0] = *(const bf16x8*)(kp_ + (size_t)(4 * t) * 2048); KB[t][1] = *(const bf16x8*)(kp_ + (size_t)(4 * t) * 2048 + 32); } \
        _Pragma("unroll") for (int dt = 0; dt < 4; ++dt) VB[0][dt] = *(const u32x4*)(vp_ + (size_t)(16 * dt) * 4096); } while (0)
#define ATT_ONE(ST, QF, KB, VB, roff, rowok) do { f32x4 sc[2]; \
        const LAS float* bp_ = rpl + ((rowok) ? (roff) : 15) * 64; \
        _Pragma("unroll") for (int t = 0; t < 2; ++t) _Pragma("unroll") for (int j = 0; j < 4; ++j) sc[t][j] = (bp_[4 * t + j] + madd[t][j]) - ST.m;     \
        _Pragma("unroll") for (int t = 0; t < 2; ++t) { sc[t] = MFMA16(KB[t][0], QF[0], sc[t]); sc[t] = MFMA16(KB[t][1], QF[1], sc[t]); } \
        attn_tail<2>(ST, sc, VB); } while (0)
#define ATT_COMPUTE(KB, VB, i) do { const int roffA_ = min(rsA + (i) - r + 7, 14); \
        ATT_ONE(SA, qA, KB, VB, roffA_, (i) <= 7); \
        ATT_ONE(SB, qB, KB, VB, max(roffA_ - 1, 0), (i) >= dB && (i) <= 7 + dB); } while (0)
        ATT_LOADW(K0, V0, 0);
#pragma unroll 1
        for (int i = 0; i < 8; i += 2) { ATT_LOADW(K1, V1, i + 1); ATT_COMPUTE(K0, V0, i); ATT_LOADW(K0, V0, i + 2); ATT_COMPUTE(K1, V1, i + 1); }
        ATT_COMPUTE(K0, V0, 8);
#undef ATT_LOADW
#undef ATT_ONE
#undef ATT_COMPUTE
    }
    { const LAS bf16* ck = (const LAS bf16*)(lds + ALDS_CK) + l15 * ACK_STRIDE + 8 * g;
      const LAS bf16* cv = (const LAS bf16*)(lds + ALDS_CV) + l15 * ACV_STRIDE + 8 * g;
#pragma unroll 1
      for (int c = 0; c < 4; ++c) {
          bf16x8 kf[4][2]; u32x4 vw[2][4];
#pragma unroll
          for (int t = 0; t < 4; ++t) { const LAS bf16* kp = ck + (64 * c + 16 * t) * ACK_STRIDE; kf[t][0] = *(const LAS bf16x8*)kp; kf[t][1] = *(const LAS bf16x8*)(kp + 32); }
#pragma unroll
          for (int ks = 0; ks < 2; ++ks)
#pragma unroll
              for (int dt = 0; dt < 4; ++dt) vw[ks][dt] = *(const LAS u32x4*)(cv + (16 * dt) * ACV_STRIDE + 64 * c + 32 * ks);
          { f32x4 sc[4]; const float nm = -SA.m; const f32x4 c0 = {nm, nm, nm, nm};
#pragma unroll
            for (int t = 0; t < 4; ++t) { sc[t] = MFMA16(kf[t][0], qA[0], c0); sc[t] = MFMA16(kf[t][1], qA[1], sc[t]); }
            attn_tail<4>(SA, sc, vw); }
          { f32x4 sc[4]; const float nm = -SB.m; const f32x4 c0 = {nm, nm, nm, nm};
#pragma unroll
            for (int t = 0; t < 4; ++t) { sc[t] = MFMA16(kf[t][0], qB[0], c0); sc[t] = MFMA16(kf[t][1], qB[1], sc[t]); }
            attn_tail<4>(SB, sc, vw); }
      } }
    { const float inv = 1.0f / xrow16_sum(SA.sum);
#pragma unroll
      for (int dt = 0; dt < 4; ++dt) { const f32x4 o = SA.o[dt] * (inv * ATS); *(unsigned*)(ATT + (size_t)(rowqA + l15) * 1024 + h * 64 + 16 * dt + 4 * g) = pk4_fp8(o[0], o[1], o[2], o[3]); } }
    { const float inv = 1.0f / xrow16_sum(SB.sum);
#pragma unroll
      for (int dt = 0; dt < 4; ++dt) { const f32x4 o = SB.o[dt] * (inv * ATS); *(unsigned*)(ATT + (size_t)(rowqB + l15) * 1024 + h * 64 + 16 * dt + 4 * g) = pk4_fp8(o[0], o[1], o[2], o[3]); } }
}
__device__ __forceinline__ void p_attn_mfma(const Params& P, Frame& F, int l, bool with_ctx_queries, int nblk, int rank) {
    const bf16* KQ = WSP(bf16, WS_KQ); const bf16* VT = WSP(bf16, WS_VT); unsigned char* ATT = WSP(unsigned char, WS_ATT);
    const float* rpb = P.rpb + (size_t)l * 16 * 465;
    const int it0 = (int)(((long)rank * 1024) / nblk), it1 = (int)(((long)(rank + 1) * 1024) / nblk);
    int pcur = -1;
    for (int hp = it0; hp < it1; ++hp) {
        const int p = hp >> 3, eighth = hp & 7, b = p >> 4, h = p & 15;
        if (p != pcur) { pcur = p;
        __syncthreads();
        { LAS bf16* ck = (LAS bf16*)(F.lds + ALDS_CK); LAS bf16* cv = (LAS bf16*)(F.lds + ALDS_CV); LAS float* rp = (LAS float*)(F.lds + ALDS_RP);
          { const int key = F.tid >> 1, hf = F.tid & 1; const int k32 = key & 31, pos = (key & ~31) + ((k32 >> 2) & 1) * 16 + 4 * (k32 >> 3) + (k32 & 3);
            const u32x4* src = (const u32x4*)(KQ + (size_t)(RL + b * CTXL + key) * 2048 + h * 64 + hf * 32); LAS u32x4* dst = (LAS u32x4*)(ck + pos * ACK_STRIDE + hf * 32);
#pragma unroll
            for (int i = 0; i < 4; ++i) dst[i] = src[i]; }
          { const int d = F.tid >> 3, sg = F.tid & 7; const u32x4* src = (const u32x4*)(VT + YT_CTX_OFF + (size_t)(b * 1024 + h * 64 + d) * 256 + sg * 32); LAS u32x4* dst = (LAS u32x4*)(cv + d * ACV_STRIDE + sg * 32);
#pragma unroll
            for (int i = 0; i < 4; ++i) dst[i] = src[i]; }
          for (int i = F.tid; i < 16 * 64; i += NTHREADS) { const int rr = i >> 6, cc = (i & 63) - 16; rp[i] = rr == 15 ? -__builtin_inff() : ((cc >= 0 && cc < 31) ? rpb[h * 465 + rr * 31 + cc] * LOG2E : 0.f); } }
        __syncthreads(); }
        const int qt = F.wave & 3, rpi = F.wave >> 2;
#pragma unroll 1
        for (int st = 0; st < 2; ++st) { const int r = eighth * 8 + st * 4 + rpi * 2; const int rowqA = b * SEQ + r * 64 + 16 * qt;
            attn_unit2(KQ, VT, ATT, F.lds, b, h, rowqA, rowqA + 64, true, r, qt, F.lane); }
        if (with_ctx_queries && eighth == 0) { const int rowqA = RL + b * CTXL + 32 * F.wave; attn_unit2(KQ, VT, ATT, F.lds, b, h, rowqA, rowqA + 16, false, 0, 0, F.lane); }
    }
    __syncthreads();
}

__device__ __forceinline__ void ld8(const bf16* p, float (&x)[8]) { const u32x4 w = *(const u32x4*)p;
#pragma unroll
    for (int q = 0; q < 4; ++q) { x[2 * q] = bflo(w[q]); x[2 * q + 1] = bfhi(w[q]); } }
__device__ __forceinline__ void p_pool(Frame& F, int nrows) {
    const bf16* PB = WSP(bf16, WS_PB); bf16* POOL = WSP(bf16, WS_POOL);
    for (int i = F.bid * NTHREADS + F.tid; i < (nrows >> 4) * 64; i += F.G * NTHREADS) {
        const int row0 = (i >> 6) << 4, ch = i & 63, g = ch >> 4, hw = 1 << g;
        int base, t0, Lb; if (row0 < RL) { base = row0 & ~4095; t0 = row0 & 4095; Lb = SEQ; } else { const int rr = row0 - RL; base = RL + (rr & ~255); t0 = rr & 255; Lb = CTXL; }
        const bf16* src = PB + (size_t)base * 512 + ch * 8;
        float S[8];
#pragma unroll
        for (int q = 0; q < 8; ++q) S[q] = 0.f;
#pragma unroll 4
        for (int d = -8; d < 8; ++d) { const int tt = t0 + d; if (d >= -hw && d < hw && tt >= 0 && tt < Lb) { float x[8]; ld8(src + (size_t)tt * 512, x);
#pragma unroll
                for (int q = 0; q < 8; ++q) S[q] += x[q]; } }
#pragma unroll 2
        for (int j = 0; j < 16; ++j) { const int t = t0 + j; const int lo = max(t - hw, 0), hi = min(t + hw, Lb); const float inv = 1.0f / (float)(hi - lo);
            float me[8]; ld8(src + (size_t)t * 512, me);
            u32x4 o;
#pragma unroll
            for (int q = 0; q < 4; ++q) o[q] = pk2(S[2 * q] * inv - me[2 * q], S[2 * q + 1] * inv - me[2 * q + 1]);
            *(u32x4*)(POOL + (size_t)(base + t) * 512 + ch * 8) = o;
            if (t + hw < Lb) { float x[8]; ld8(src + (size_t)(t + hw) * 512, x);
#pragma unroll
                for (int q = 0; q < 8; ++q) S[q] += x[q]; }
            if (t - hw >= 0) { float x[8]; ld8(src + (size_t)(t - hw) * 512, x);
#pragma unroll
                for (int q = 0; q < 8; ++q) S[q] -= x[q]; } }
    }
}

__device__ __forceinline__ int block_sum_i(int v, LAS int* sm, int tid) {
    v = wave_sum_i(v);
    __syncthreads();
    if ((tid & 63) == 0) sm[tid >> 6] = v;
    __syncthreads();
    int s = 0;
#pragma unroll
    for (int i = 0; i < 8; ++i) s += sm[i];
    return s;
}
__device__ __forceinline__ int block_excl_scan(int v, LAS int* sm, int tid, int& total) {
    const int lane = tid & 63, w = tid >> 6; int inc = v;
#pragma unroll
    for (int o = 1; o < 64; o <<= 1) { const int t = __builtin_amdgcn_ds_bpermute(((lane - o) & 63) << 2, inc); if (lane >= o) inc += t; }
    __syncthreads();
    if (lane == 63) sm[w] = inc;
    __syncthreads();
    int base = 0; total = 0;
#pragma unroll
    for (int i = 0; i < 8; ++i) { const int s = sm[i]; if (i < w) base += s; total += s; }
    return base + inc - v;
}
template <int NPT>
__device__ __forceinline__ void topk_pair(Frame& F, int row0, int n, int cap, int e, int slot0) {
    LAS int* sm = (LAS int*)F.lds;
    const float* AFF = WSP(float, WS_AFF); int* SROW = WSP(int, WS_SROW); float* SG = WSP(float, WS_SGATE); int* SEL = WSP(int, WS_SEL);
    unsigned key[NPT];
#pragma unroll
    for (int j = 0; j < NPT; ++j) { const int i = F.tid * NPT + j; key[j] = (i < n) ? __float_as_uint(AFF[(size_t)(row0 + i) * 16 + e]) : 0u; }
    unsigned T = 0u;
    for (int bit = 30; bit >= 0; --bit) { const unsigned cand = T | (1u << bit); int cnt = 0;
#pragma unroll
        for (int j = 0; j < NPT; ++j) cnt += (key[j] >= cand) ? 1 : 0;
        cnt = block_sum_i(cnt, sm, F.tid);
        if (cnt >= cap) T = cand; }
    int ngt = 0, neq = 0;
#pragma unroll
    for (int j = 0; j < NPT; ++j) { ngt += (key[j] > T) ? 1 : 0; neq += (key[j] == T) ? 1 : 0; }
    int tot_gt, tot_eq;
    (void)block_excl_scan(ngt, sm, F.tid, tot_gt);
    int eqr = block_excl_scan(neq, sm, F.tid, tot_eq);
    const int need_eq = cap - tot_gt;
    int nsel = 0; bool selj[NPT];
#pragma unroll
    for (int j = 0; j < NPT; ++j) { bool s = key[j] > T; if (key[j] == T && T != 0u) { s = eqr < need_eq; ++eqr; } selj[j] = s; nsel += s ? 1 : 0; }
    int tot_sel; int pos = block_excl_scan(nsel, sm, F.tid, tot_sel);
#pragma unroll
    for (int j = 0; j < NPT; ++j) { const int i = F.tid * NPT + j;
        if (i < n) { const int row = row0 + i;
            if (selj[j]) { const int slot = slot0 + pos; ++pos; SROW[slot] = row; SG[slot] = __uint_as_float(key[j]); SEL[(size_t)row * 16 + e] = slot; }
            else SEL[(size_t)row * 16 + e] = -1; } }
    __syncthreads();
}
__device__ __forceinline__ void p_topk(Frame& F, bool with_ctx) {
    const int npairs = 128 + (with_ctx ? 128 : 0);
    for (int pi = F.bid; pi < npairs; pi += F.G) {
        if (pi < 128) { const int b = pi >> 4, e = pi & 15; topk_pair<8>(F, b * SEQ, SEQ, CAPL, e, e * SLOT_E + b * CAPL); }
        else { const int p2 = pi - 128, b = p2 >> 4, e = p2 & 15; topk_pair<1>(F, RL + b * CTXL, CTXL, CAPC, e, e * SLOT_E + 4096 + b * CAPC); }
    }
}
template <int PH> __global__ void __launch_bounds__(NTHREADS, 2) fwd_kernel(Params P) {
    extern __shared__ __attribute__((aligned(16))) unsigned char lds_raw[];
    Frame F; F.lds = (LAS unsigned char*)lds_raw; F.tid = threadIdx.x; F.lane = F.tid & 63; F.wave = __builtin_amdgcn_readfirstlane(F.tid >> 6); F.G = gridDim.x; F.bid = blockIdx.x; F.ws = P.ws;
    const int wave0 = __builtin_amdgcn_readfirstlane((int)threadIdx.x >> 6);
    volatile LAS unsigned* MISC = (volatile LAS unsigned*)(F.lds + LDS_MISC);
    if (F.tid < 64) MISC[F.tid] = 0u;
    __syncthreads();
    XcdBarrier bar; bar.bar = WSP(unsigned, WS_CTL) + CW_BAR; bar.x = 0; bar.st = MISC + 8;
    if constexpr (PH < 0) bar = xcd_barrier_post(WSP(unsigned, WS_CTL) + CW_BAR, MISC + 8);
#define IN(k) (PH < 0 || PH == (k))
#define REFRESH() do { unsigned on_ = ~0u; asm volatile("" : "+s"(on_)); int t_ = wave0 * 64 + (int)__builtin_amdgcn_mbcnt_hi(on_, __builtin_amdgcn_mbcnt_lo(on_, 0u)); asm volatile("" : "+v"(t_)); F.tid = t_; F.lane = t_ & 63; F.wave = __builtin_amdgcn_readfirstlane(t_ >> 6); } while (0)
#define SEAM(k) do { if constexpr (PH < 0) xcd_barrier(bar); } while (0)

    if (IN(0)) { REP_BEGIN(100) p_mod(P, F); p_dftgen(F); REP_END REP_BEGIN(101) p_wconv(P, F, 0); REP_END }
    SEAM(0);
    if (IN(1)) { p_rftables(P, F); p_rowpass_a0(P, F); }
    SEAM(1);
    for (int l = P.l_lo; l < P.l_hi; ++l) {
        constexpr int pb = 2; const bool L0 = (l == 0);
        bf16* H = WSP(bf16, WS_H);
        if (IN(pb + 0)) { REFRESH(); REP_BEGIN(2)
            const int u1 = 128 * 8 + 8 * (L0 ? 8 : 4), u2a = 128 * 2 + (L0 ? 8 * 2 : 0), u2 = u2a + 128 * 12 + (L0 ? 8 * 12 : 0), u3 = 4 * 128 + (L0 ? 4 * 8 : 0);
            const bf16* H8 = WSP(bf16, WS_H8); const bf16* WA8 = WSP(bf16, WS_WA8);
            { GroupSched S; S.init(1, 128, 8, F.G, F.bid, 8, L0 ? 8 : 4, 128, 0);
              auto AD = [=](const Unit& u) { return Operands{H8 + (size_t)u.pm * 256 * 512, WA8 + (size_t)u.pn * 256 * 512, 512, 512, 0, 512}; };
              bf16* KQ = WSP(bf16, WS_KQ);
              auto E = [=](EPI_ARGS) { const int row0 = u.pm * 256; const float qs = (u.pn >= 4) ? QSCALE * INV8 : INV8;
                  EPI_FOR8( st_bf8(KQ + (size_t)(row0 + r) * 2048 + u.pn * 256 + c, v0 * qs, v1 * qs); ) };
              GEMM_P8(S, AD, E); }
            REFRESH();
            { GroupSched S; S.init(1, 128, 2, F.G, (F.bid + F.G - ((u1 % F.G) & ~7)) % F.G, L0 ? 8 : 0, 2, 128, 0);
              const bf16* WA = WSP(bf16, WS_WA);
              auto AD = [=](const Unit& u) { return Operands{H + (size_t)u.pm * 256 * DM, WA + (size_t)(u.pn + 8) * 256 * DM, DM, DM, 0, DM}; };
              bf16* PBp = WSP(bf16, WS_PB);
              auto E = [=](EPI_ARGS) { const int row0 = u.pm * 256; EPI_FOR8( st_bf8(PBp + (size_t)(row0 + r) * 512 + u.pn * 256 + c, v0, v1); ) };
              GEMM_P(S, AD, E); }
            REFRESH();
            { GroupSched S; S.init(1, 128, 12, F.G, (F.bid + F.G - (((u1 + u2a) % F.G) & ~7)) % F.G, L0 ? 8 : 0, 12, 128, 0);
              bf16* GB = WSP(bf16, WS_GB);
              auto AD = [=](const Unit& u) { return Operands{H8 + (size_t)u.pm * 256 * 512, WA8 + (size_t)(3072 + u.pn * 256) * 512, 512, 512, 0, 512}; };
              auto E = [=](EPI_ARGS) { const int row0 = u.pm * 256;
                  EPI_FOR8( f32x4 s0; f32x4 s1; _Pragma("unroll") for (int j = 0; j < 4; ++j) { s0[j] = sigmoidf_(v0[j] * INV8); s1[j] = sigmoidf_(v1[j] * INV8); } st_bf8(GB + (size_t)(row0 + r) * 3072 + u.pn * 256 + c, s0, s1); ) };
              GEMM_P8(S, AD, E); }
            REFRESH();
            { GroupSched S; S.init(1, 4, 128, F.G, (F.bid + F.G - (((u1 + u2) % F.G) & ~7)) % F.G, L0 ? 4 : 0, 8, 0, 128);
              const bf16* WFV = WSP(bf16, WS_WFV);
              auto AD = [=](const Unit& u) { const bool fmap = (u.pn < 128); const int t16 = u.pn & 15;
                  const size_t tok0 = fmap ? (size_t)(u.pn >> 4) * SEQ + 64 * ((t16 >> 1) * 8) + (t16 & 1) * 32 : (size_t)u.pn * 256;
                  return Operands{WFV + (size_t)u.pm * 256 * DM, H + tok0 * DM, DM, DM, 0, DM, fmap ? 1 : 0}; };
              bf16* YT = WSP(bf16, WS_YT);
              auto E = [=](EPI_ARGS) { const int rr0 = u.pm * 256;
                  if (u.pn < 128) { const int b = u.pn >> 4; const int t16 = u.pn & 15, l10 = (t16 >> 1) * 8, l20 = (t16 & 1) * 32;
                      EPI_FOR8( const int fc = rr0 + r; st_bf8(YT + (((((size_t)b * 512 + (fc >> 1)) * 32 + (c >> 3)) * 2 + (l20 >> 5)) * 2 + (fc & 1)) * 64 + l10, v0, v1); ) }
                  else { const int b = u.pn - 128; EPI_FOR8( st_bf8(YT + YT_CTX_OFF + ((size_t)b * 1024 + rr0 + r) * 256 + c, v0, v1); ) } };
              GEMM_P(S, AD, E); }
            REFRESH();
            { GroupSched S; S.init(1, 4, 128, F.G, (F.bid + F.G - (((u1 + u2 + u3) % F.G) & ~7)) % F.G, 4, 8, 0, 128);
              auto AD = [=](const Unit& u) { return Operands{WA8 + (size_t)(2048 + u.pm * 256) * 512, H8 + (size_t)u.pn * 256 * 512, 512, 512, 0, 512}; };
              bf16* VT = WSP(bf16, WS_VT);
              auto E = [=](EPI_ARGS) { const int rr0 = u.pm * 256;
                  if (u.pn < 128) { const int b = u.pn >> 4, l0 = (u.pn & 15) * 256; EPI_FOR8( st_bf8(VT + ((size_t)b * 1024 + rr0 + r) * 4096 + l0 + c, v0 * INV8, v1 * INV8); ) }
                  else { const int b = u.pn - 128; EPI_FOR8( st_bf8(VT + YT_CTX_OFF + ((size_t)b * 1024 + rr0 + r) * 256 + c, v0 * INV8, v1 * INV8); ) } };
              GEMM_P8(S, AD, E); }
        REP_END }
        SEAM(pb + 0);
        if (IN(pb + 1)) { REFRESH();
            { const int nc0 = (F.G * 5 / 16) & ~7, nconv = nc0 > 0 ? nc0 : 1, na = F.G - nconv;
              if (F.bid < na) p_attn_mfma(P, F, l, L0, na, F.bid);
              else wconv_experts(P, F, l, F.bid - na, nconv); }
            REFRESH();
            REP_BEGIN(32)
            { LAS float* tw = (LAS float*)(F.lds + LDS_TW);
              for (int j = F.tid; j < 4096; j += NTHREADS) tw[j] = cospif((float)j * (1.0f / 2048.0f));
              __syncthreads();
              GroupSched S; S.init(1, 1, 512, F.G, F.bid);
              const bf16* M1 = WSP(bf16, WS_M1T); const bf16* YF = WSP(bf16, WS_YT); bf16* ZP = WSP(bf16, WS_ZP);
              auto AD = [=](const Unit& u) { return Operands{M1, YF + (size_t)u.pn * 256 * 256, 256, 256, 0, 256}; };
              auto E = [=](EPI_ARGS) {
                  const int b = u.pn >> 6, gm0 = (u.pn & 63) * 8 + wc, l20 = 32 * wr + 8 * fq;
#pragma unroll
                  for (int m = 0; m < 4; ++m) { const int k1 = 16 * m + fr;
#pragma unroll
                      for (int bj = 0; bj < 2; ++bj) { const int gm = gm0 + 4 * bj;
                          f32x4 zr[2], zi[2];
#pragma unroll
                          for (int n = 0; n < 2; ++n)
#pragma unroll
                              for (int j = 0; j < 4; ++j) { const int ix = k1 * (l20 + 4 * n + j); const float tc = tw[ix], ts = tw[(ix + 3072) & 4095];
                                  const float ur = acc[0][bj][m][n][j], ui = acc[1][bj][m][n][j]; zr[n][j] = ur * tc - ui * ts; zi[n][j] = ur * ts + ui * tc; }
                          bf16* dst = ZP + (((((size_t)b * 64 + k1) * 128 + (gm & 127)) * 4 + (gm >> 7)) * 2) * 64 + l20;
                          st_bf8(dst, zr[0], zr[1]); st_bf8(dst + 64, zi[0], zi[1]); } } };
              GEMM_P(S, AD, E); }
            REP_END
        }
        SEAM(pb + 1);
        if (IN(pb + 10)) { REFRESH();
            { GroupSched S; S.init(1, L0 ? 136 : 128, 4, F.G, F.bid);
              const bf16* A8 = WSP(bf16, WS_ATT); const bf16* W8 = WSP(bf16, WS_WAO); const bf16* GB = WSP(bf16, WS_GB); bf16* YA = WSP(bf16, WS_KQ);
              auto AD = [=](const Unit& u) { return Operands{A8 + (size_t)u.pm * 256 * 512, W8 + (size_t)u.pn * 256 * 512, 512, 512, 0, 512}; };
              auto E = [=](EPI_ARGS) { const int colb = u.pn * 256 + wc * 32 + 8 * fq;
#pragma unroll
                  for (int ai = 0; ai < 2; ++ai) { u32x4 g0[4][2];
#pragma unroll
                      for (int m = 0; m < 4; ++m)
#pragma unroll
                          for (int bj = 0; bj < 2; ++bj) g0[m][bj] = *(const u32x4*)(GB + ((size_t)u.pm * 256 + ai * 128 + wr * 64 + m * 16 + fr) * 3072 + colb + bj * 128);
#pragma unroll
                      for (int m = 0; m < 4; ++m)
#pragma unroll
                          for (int bj = 0; bj < 2; ++bj) { const u32x4 g = g0[m][bj]; const f32x4 ga = {bflo(g[0]), bfhi(g[0]), bflo(g[1]), bfhi(g[1])}, gb = {bflo(g[2]), bfhi(g[2]), bflo(g[3]), bfhi(g[3])};
                              st_bf8(YA + ((size_t)u.pm * 256 + ai * 128 + wr * 64 + m * 16 + fr) * 1024 + colb + bj * 128, acc[ai][bj][m][0] * ga * INVAT, acc[ai][bj][m][1] * gb * INVAT); } } };
              GEMM_P8(S, AD, E); }
            REFRESH();
            { GroupSched S; S.init(1, 1, 256, F.G, F.bid);
              const bf16* M2 = WSP(bf16, WS_M2T); const bf16* ZP = WSP(bf16, WS_ZP); bf16* FOUR = WSP(bf16, WS_FOUR);
              auto AD = [=](const Unit& u) { return Operands{M2, ZP + (size_t)u.pn * 256 * 512, 512, 512, 0, 512}; };
              auto E = [=](EPI_ARGS) { const float sc = 0.0013810679320049757f;
#pragma unroll
                  for (int ai = 0; ai < 2; ++ai)
#pragma unroll
                      for (int m = 0; m < 4; ++m) { const int q = 2 * ai + wr, k2 = 16 * m + fr;
#pragma unroll
                          for (int bj = 0; bj < 2; ++bj) { const int bk = u.pn * 2 + bj, b = bk >> 6, k1 = bk & 63;
                              st_bf8(FOUR + ((size_t)b * SEQ + k1 + 64 * k2) * 512 + q * 128 + wc * 32 + 8 * fq, acc[ai][bj][m][0] * sc, acc[ai][bj][m][1] * sc); } } };
              GEMM_P(S, AD, E); }
            REFRESH();
            if (L0) { GroupSched S; S.init(1, 1, 16, F.G, (F.bid + F.G - 128 % F.G) % F.G);
              const bf16* DFTC = WSP(bf16, WS_DFTC); const bf16* YTC = WSP(bf16, WS_YT) + YT_CTX_OFF; bf16* FOUR = WSP(bf16, WS_FOUR);
              auto AD = [=](const Unit& u) { return Operands{DFTC, YTC + (size_t)u.pn * 256 * 512, 512, 512, 0, 512}; };
              auto E = [=](EPI_ARGS) { const int b = u.pn >> 1, c0 = (u.pn & 1) * 256; const float sc = 0.005524271728019903f;
                  EPI_FOR8( st_bf8(FOUR + ((size_t)RL + b * CTXL + r) * 512 + c0 + c, v0 * sc, v1 * sc); ) };
              GEMM_P(S, AD, E); }
            REFRESH();
            REP_BEGIN(33) p_pool(F, L0 ? RT : RL); REP_END
        }
        SEAM(pb + 10);
        if (IN(pb + 2)) { REFRESH();
            SegSched<2> S; S.base.init(1, L0 ? 136 : 128, 4, F.G, F.bid);
            const bf16* FOUR = WSP(bf16, WS_FOUR); const bf16* POOL = WSP(bf16, WS_POOL); const bf16* WFO = WSP(bf16, WS_WFO); const bf16* WPO = WSP(bf16, WS_WPO);
            const bf16* GB = WSP(bf16, WS_GB); const bf16* YA = WSP(bf16, WS_KQ); bf16* MRGB = WSP(bf16, WS_MRGB); const float* ps = P.pool_scale + l * 1024;
            auto AD = [=](const Unit& u) {
                if (u.seg == 0) return Operands{FOUR + (size_t)u.pm * 256 * 512, WFO + (size_t)u.pn * 256 * 512, 512, 512, 0, 512};
                return Operands{POOL + (size_t)u.pm * 256 * 512 + (u.pn >> 1) * 256, WPO + (size_t)u.pn * 256 * 256, 512, 256, 0, 256}; };
            auto E = [=](EPI_ARGS) {
                const bool fin = (u.seg == 1); const int colb = u.pn * 256 + wc * 32 + 8 * fq;
                f32x4 psv[2][2];
#pragma unroll
                for (int bj = 0; bj < 2; ++bj)
#pragma unroll
                    for (int n = 0; n < 2; ++n) { f32x4 p = *(const f32x4*)(ps + colb + bj * 128 + 4 * n);
#pragma unroll
                        for (int j = 0; j < 4; ++j) p[j] = (fabsf(p[j]) < 1e-18f) ? copysignf(1e-18f, p[j]) : p[j];
                        psv[bj][n] = p; }
#pragma unroll
                for (int ai = 0; ai < 2; ++ai)
#pragma unroll
                    for (int m = 0; m < 4; ++m) { const size_t row = (size_t)u.pm * 256 + ai * 128 + wr * 64 + m * 16 + fr; const bf16* gr = GB + row * 3072 + colb;
                        u32x4 g1r[2], g2r[2], yar[2];
#pragma unroll
                        for (int bj = 0; bj < 2; ++bj) { g2r[bj] = *(const u32x4*)(gr + 2048 + bj * 128); if (fin) yar[bj] = *(const u32x4*)(YA + row * 1024 + colb + bj * 128); else g1r[bj] = *(const u32x4*)(gr + 1024 + bj * 128); }
#pragma unroll
                        for (int bj = 0; bj < 2; ++bj) { f32x4 o[2];
#pragma unroll
                            for (int n = 0; n < 2; ++n) { const u32x4 xr = fin ? yar[bj] : g1r[bj];
                                const f32x4 g2 = (f32x4){fmaxf(bflo(g2r[bj][2 * n]), 1e-18f), fmaxf(bfhi(g2r[bj][2 * n]), 1e-18f), fmaxf(bflo(g2r[bj][2 * n + 1]), 1e-18f), fmaxf(bfhi(g2r[bj][2 * n + 1]), 1e-18f)} * psv[bj][n];
                                const f32x4 x = {bflo(xr[2 * n]), bfhi(xr[2 * n]), bflo(xr[2 * n + 1]), bfhi(xr[2 * n + 1])};
#pragma unroll
                                for (int j = 0; j < 4; ++j) o[n][j] = fin ? (x[j] + acc[ai][bj][m][n][j] * g2[j]) : (acc[ai][bj][m][n][j] * x[j] * __builtin_amdgcn_rcpf(g2[j]));
                                acc[ai][bj][m][n] = o[n]; }
                            if (fin) st_bf8(MRGB + row * 1024 + colb + bj * 128, o[0], o[1]); } } };
            gemm_fast<false, true, false>(F.lds, F.tid, S, AD, mk_epi_seg(E, 1), nullptr);
        }
        SEAM(pb + 2);
        if (IN(pb + 3)) { REFRESH();
            GroupSched S; S.init(1, L0 ? 136 : 128, 4, F.G, F.bid); const bf16* A = WSP(bf16, WS_MRGB); const bf16* W = WSP(bf16, WS_WOUT);
            bf16* XB = WSP(bf16, WS_XB); const float* MOD = WSP(float, WS_MOD) + (size_t)l * 9 * 6144;
            auto AD = [=](const Unit& u) { return Operands{A + (size_t)u.pm * 256 * 1024, W + (size_t)u.pn * 256 * 1024, 1024, 1024, 0, 1024}; };
            auto E = [=](EPI_ARGS) {
                const int row0 = u.pm * 256, mr = row0 < RL ? (row0 >> 12) : 8, colb = u.pn * 256 + wc * 32 + 8 * fq;
                bf16* dst0 = XB + (size_t)row0 * DM;
                f32x4 gv[2][2];
#pragma unroll
                for (int bj = 0; bj < 2; ++bj)
#pragma unroll
                    for (int n = 0; n < 2; ++n) gv[bj][n] = *(const f32x4*)(MOD + (size_t)mr * 6144 + 2048 + colb + bj * 128 + 4 * n);
                if (L0) { const float* src0 = row0 < RL ? P.x + (size_t)row0 * DM : P.ctx + (size_t)(row0 - RL) * DM;
#pragma unroll
                    for (int am = 0; am < 4; ++am) { const int ai = am >> 1, mh = (am & 1) * 2; f32x4 xv[2][2][2];
#pragma unroll
                        for (int m = 0; m < 2; ++m) { const size_t ro = (size_t)(ai * 128 + wr * 64 + (mh + m) * 16 + fr) * DM + colb;
#pragma unroll
                            for (int bj = 0; bj < 2; ++bj)
#pragma unroll
                                for (int n = 0; n < 2; ++n) xv[m][bj][n] = *(const f32x4*)(src0 + ro + bj * 128 + 4 * n); }
#pragma unroll
                        for (int m = 0; m < 2; ++m) { const size_t ro = (size_t)(ai * 128 + wr * 64 + (mh + m) * 16 + fr) * DM + colb;
#pragma unroll
                            for (int bj = 0; bj < 2; ++bj) st_bf8(dst0 + ro + bj * 128, xv[m][bj][0] + gv[bj][0] * acc[ai][bj][mh + m][0], xv[m][bj][1] + gv[bj][1] * acc[ai][bj][mh + m][1]); } }
                } else {
#pragma unroll
                    for (int ai = 0; ai < 2; ++ai) { u32x4 xr[4][2];
#pragma unroll
                        for (int m = 0; m < 4; ++m) { const size_t ro = (size_t)(ai * 128 + wr * 64 + m * 16 + fr) * DM + colb;
#pragma unroll
                            for (int bj = 0; bj < 2; ++bj) xr[m][bj] = *(const u32x4*)(dst0 + ro + bj * 128); }
#pragma unroll
                        for (int m = 0; m < 4; ++m) { const size_t ro = (size_t)(ai * 128 + wr * 64 + m * 16 + fr) * DM + colb;
#pragma unroll
                            for (int bj = 0; bj < 2; ++bj) { const u32x4 x = xr[m][bj]; const f32x4 xa = {bflo(x[0]), bfhi(x[0]), bflo(x[1]), bfhi(x[1])}, xb = {bflo(x[2]), bfhi(x[2]), bflo(x[3]), bfhi(x[3])};
                                st_bf8(dst0 + ro + bj * 128, xa + gv[bj][0] * acc[ai][bj][m][0], xb + gv[bj][1] * acc[ai][bj][m][1]); } } } } };
            GEMM_P(S, AD, E);
        }
        SEAM(pb + 3);
        if (IN(pb + 4)) { REFRESH(); REP_BEGIN(6) p_rowpass_f(P, F, l, L0 ? RT : RL); REP_END }
        SEAM(pb + 4);
        if (IN(pb + 5)) { REFRESH(); REP_BEGIN(7) p_topk(F, L0); REP_END }
        SEAM(pb + 5);
        if (IN(pb + 7)) { REFRESH(); REP_BEGIN(9)
            GroupSched S; S.init(16, L0 ? 17 : 16, 22, F.G, F.bid); const bf16* H8 = WSP(bf16, WS_H8); const bf16* W = WSP(bf16, WS_WGU); unsigned char* HID = WSP(unsigned char, WS_HID); const int* SROW = WSP(int, WS_SROW);
            auto AD = [=](const Unit& u) { return Operands{H8, W + ((size_t)u.grp * 5632 + u.pn * 256) * 512, 512, 512, u.grp * SLOT_E + u.pm * 256, 512}; };
            auto E = [=](EPI_ARGS) {
#pragma unroll
                for (int ai = 0; ai < 2; ++ai)
#pragma unroll
                    for (int m = 0; m < 4; ++m) { const size_t slot = (size_t)u.grp * SLOT_E + u.pm * 256 + ai * 128 + wr * 64 + m * 16 + fr; f32x4 o[2];
#pragma unroll
                        for (int n = 0; n < 2; ++n) { const f32x4 a = acc[ai][0][m][n] * INV8, up = acc[ai][1][m][n] * (INV8 * A8S);
#pragma unroll
                            for (int j = 0; j < 4; ++j) o[n][j] = a[j] * sigmoidf_(a[j]) * up[j]; }
                        u32x2 w; w.x = pk4_fp8(o[0][0], o[0][1], o[0][2], o[0][3]); w.y = pk4_fp8(o[1][0], o[1][1], o[1][2], o[1][3]);
                        *(u32x2*)(HID + slot * FF + u.pn * 128 + wc * 32 + 8 * fq) = w; } };
            GEMM_GATHER8(S, AD, E, SROW);
        REP_END }
        SEAM(pb + 7);
        if (IN(pb + 8)) { REFRESH(); REP_BEGIN(10)
            const int tpe = L0 ? 17 : 16;
            GroupSched S; S.init(1, 16 * tpe, 4, F.G, F.bid); const bf16* HID = WSP(bf16, WS_HID); const bf16* W = WSP(bf16, WS_WD); bf16* Y = WSP(bf16, WS_Y); const float* SG = WSP(float, WS_SGATE);
            auto AD = [=](const Unit& u) { const int e = u.pm / tpe, st = e * 17 + (u.pm - e * tpe); return Operands{HID + (size_t)st * 256 * (FF / 2), W + ((size_t)e * 1024 + u.pn * 256) * (FF / 2), FF / 2, FF / 2, 0, FF / 2}; };
            auto E = [=](EPI_ARGS) { const int e = u.pm / tpe; const size_t slot0 = (size_t)(e * 17 + (u.pm - e * tpe)) * 256 + wr * 64 + fr; float gt[2][4];
#pragma unroll
                for (int ai = 0; ai < 2; ++ai)
#pragma unroll
                    for (int m = 0; m < 4; ++m) gt[ai][m] = SG[slot0 + ai * 128 + m * 16] * INV8;
#pragma unroll
                for (int ai = 0; ai < 2; ++ai)
#pragma unroll
                    for (int m = 0; m < 4; ++m)
#pragma unroll
                        for (int bj = 0; bj < 2; ++bj) st_bf8(Y + (slot0 + ai * 128 + m * 16) * DM + u.pn * 256 + bj * 128 + wc * 32 + 8 * fq, acc[ai][bj][m][0] * gt[ai][m], acc[ai][bj][m][1] * gt[ai][m]); };
            GEMM_P8(S, AD, E);
        REP_END }
        SEAM(pb + 8);
        if (IN(pb + 9)) { REFRESH(); p_rowpass_k(P, F, l, L0 ? RT : RL); if (L0) p_wconv(P, F, 1); }
        if (L0) SEAM(pb + 9);
    }
#undef IN
#undef SEAM
}
template <int PH> static void launch_ph(int grid, const Params& p, hipStream_t stream) { hipLaunchKernelGGL(fwd_kernel<PH>, dim3(grid), dim3(NTHREADS), LDS_BYTES, stream, p); }
template <int PH> static bool set_attr() { return hipFuncSetAttribute((const void*)fwd_kernel<PH>, hipFuncAttributeMaxDynamicSharedMemorySize, LDS_BYTES) == hipSuccess; }

#ifndef DUP_LAUNCH
#define DUP_LAUNCH -1
#endif
extern "C" void kernel_launch(void* const* d_in, const int* in_sizes, int n_in, void* d_out, int out_size, void* d_ws, size_t ws_size, hipStream_t stream) {
    static int grid = 0;
    if (grid == 0) {
        if (n_in != 20 || out_size != RL * DM || ws_size < WS_END) { fprintf(stderr, "kernel_launch: unexpected shapes (n_in %d out %d ws %zu need %zu)\n", n_in, out_size, ws_size, (size_t)WS_END); grid = -1; return; }
        int dev = 0, cus = 0, per_cu = 0;
        if (hipGetDevice(&dev) != hipSuccess || hipDeviceGetAttribute(&cus, hipDeviceAttributeMultiprocessorCount, dev) != hipSuccess) { grid = -1; return; }
#if N_LAUNCH_MODE == 1
        if (!set_attr<-1>()) { fprintf(stderr, "kernel_launch: hipFuncSetAttribute failed\n"); grid = -1; return; }
        if (hipOccupancyMaxActiveBlocksPerMultiprocessor(&per_cu, (const void*)fwd_kernel<-1>, NTHREADS, LDS_BYTES) != hipSuccess || per_cu < 1) fprintf(stderr, "kernel_launch: occupancy query reports %d\n", per_cu);
#else
        if (!(set_attr<0>() && set_attr<1>() && set_attr<2>() && set_attr<3>() && set_attr<12>() && set_attr<4>() && set_attr<5>() && set_attr<6>() && set_attr<7>() && set_attr<9>() && set_attr<10>() && set_attr<11>())) { fprintf(stderr, "kernel_launch: hipFuncSetAttribute failed\n"); grid = -1; return; }
        (void)per_cu;
#endif
        (void)hipGetLastError();
        grid = cus;
    }
    if (grid < 0) return;
    if (hipMemsetAsync((char*)d_ws + WS_CTL, 0, CTL_BYTES, stream) != hipSuccess) return;
    Params p{};
    const float** pp = (const float**)&p;
    for (int i = 0; i < 20; ++i) pp[i] = (const float*)d_in[i];
    p.out = (float*)d_out; p.ws = (unsigned char*)d_ws;
#if N_LAUNCH_MODE == 1
    p.l_lo = 0; p.l_hi = 2;
    launch_ph<-1>(grid, p, stream);
#else
    p.l_lo = 0; p.l_hi = 0; launch_ph<0>(grid, p, stream); if (DUP_LAUNCH == 0) launch_ph<0>(grid, p, stream); launch_ph<1>(grid, p, stream); if (DUP_LAUNCH == 1) launch_ph<1>(grid, p, stream);
#define LP(k) do { launch_ph<k>(grid, p, stream); if (DUP_LAUNCH == (k) && l == 0) launch_ph<k>(grid, p, stream); } while (0)
    for (int l = 0; l < 2; ++l) { p.l_lo = l; p.l_hi = l + 1;
        LP(2); LP(3); LP(12); LP(4); LP(5); LP(6); LP(7); LP(9); LP(10); LP(11); }
#endif
}
```

```cpp
#include <hip/hip_runtime.h>
#include <cstdio>
#include <cstdint>

#ifndef N_LAUNCH_MODE
#define N_LAUNCH_MODE 1
#endif

#define GAS __attribute__((address_space(1)))
#define LAS __attribute__((address_space(3)))
typedef unsigned short bf16;
typedef short bf16x8 __attribute__((ext_vector_type(8)));
typedef float f32x4 __attribute__((ext_vector_type(4)));
typedef unsigned u32x4 __attribute__((ext_vector_type(4)));
typedef unsigned u32x2 __attribute__((ext_vector_type(2)));

constexpr int NB = 8, SEQ = 4096, DM = 1024, CTXL = 256, NH = 16, HD = 64, GRIDW = 64;
constexpr int RL = NB * SEQ, RC = NB * CTXL, RT = RL + RC;
constexpr int INW = 7168, NE = 16, FF = 2816, CAPL = 512, CAPC = 32;
constexpr int SLOT_E = 4352, NSLOT = NE * SLOT_E;
constexpr float RMS_EPS = 1e-6f;
constexpr float LOG2E = 1.4426950408889634f, QSCALE = 0.125f * LOG2E;
constexpr float A8S = 8.0f, W8S = 64.0f, INV8 = 1.0f / (A8S * W8S);
constexpr float ATS = 32.0f, INVAT = 1.0f / (ATS * W8S);
constexpr int NWAVES = 8, NTHREADS = 512;

constexpr size_t al256(size_t x) { return (x + 255) & ~(size_t)255; }
constexpr size_t WS_CTL = 0, CTL_BYTES = 1u << 20;
constexpr size_t WS_MOD = WS_CTL + CTL_BYTES;
constexpr size_t WS_XC = al256(WS_MOD + (size_t)2 * 9 * 6144 * 4);
constexpr size_t WS_AFF = al256(WS_XC + (size_t)RC * DM * 4);
constexpr size_t WS_SROW = al256(WS_AFF + (size_t)RT * 16 * 4);
constexpr size_t WS_SGATE = al256(WS_SROW + (size_t)NSLOT * 4);
constexpr size_t WS_SEL = al256(WS_SGATE + (size_t)NSLOT * 4);
constexpr size_t WS_DFTM = al256(WS_SEL + (size_t)RT * 16 * 4);
constexpr size_t WS_DFTC = al256(WS_DFTM + (size_t)4096 * 8192 * 2);
constexpr size_t WS_WA = al256(WS_DFTC + (size_t)256 * 512 * 2);
constexpr size_t WS_WFV = al256(WS_WA + (size_t)5632 * 1024 * 2);
constexpr size_t WS_WAO = al256(WS_WFV + (size_t)2048 * 1024 * 2);
constexpr size_t WS_WFO = al256(WS_WAO + (size_t)1024 * 1024 * 2);
constexpr size_t WS_WPO = al256(WS_WFO + (size_t)1024 * 512 * 2);
constexpr size_t WS_WOUT = al256(WS_WPO + (size_t)1024 * 256 * 2);
constexpr size_t WS_WGU = al256(WS_WOUT + (size_t)1024 * 1024 * 2);
constexpr size_t WS_WD = al256(WS_WGU + (size_t)16 * 5632 * 1024);
constexpr size_t WS_WA8 = al256(WS_WD + (size_t)16 * 1024 * 2816);
constexpr size_t WS_H = al256(WS_WA8 + (size_t)6144 * 1024);
constexpr size_t WS_H8 = al256(WS_H + (size_t)RT * DM * 2);
constexpr size_t WS_R = al256(WS_H8 + (size_t)RT * DM);
constexpr size_t WS_KQ = WS_R;
constexpr size_t WS_MRG = WS_KQ;
constexpr size_t WS_PB = al256(WS_KQ + (size_t)RT * 2048 * 2);
constexpr size_t WS_GB = al256(WS_PB + (size_t)RT * 512 * 2);
constexpr size_t WS_YT = al256(WS_GB + (size_t)RT * 3072 * 2);
constexpr size_t WS_MRGB = WS_YT;
constexpr size_t WS_VT = al256(WS_YT + (size_t)RT * 1024 * 2);
constexpr size_t WS_FOUR = al256(WS_VT + (size_t)RT * 1024 * 2);
constexpr size_t WS_ATT = al256(WS_FOUR + (size_t)RT * 512 * 2);
constexpr size_t WS_POOL = al256(WS_ATT + (size_t)RT * 1024 * 2);
constexpr size_t WS_MIX_END = al256(WS_POOL + (size_t)RT * 512 * 2);
constexpr size_t WS_XG = WS_R;
constexpr size_t WS_HID = al256(WS_XG + (size_t)NSLOT * 1024 * 2);
constexpr size_t WS_Y = al256(WS_HID + (size_t)NSLOT * 2816);
constexpr size_t WS_MOE_END = al256(WS_Y + (size_t)NSLOT * 1024 * 2);
constexpr size_t WS_END0 = WS_MIX_END > WS_MOE_END ? WS_MIX_END : WS_MOE_END;
constexpr size_t WS_ZP = WS_END0;
constexpr size_t WS_M1T = al256(WS_ZP + ((size_t)8 * 64 * 512 * 128 + 1024) * 2);
constexpr size_t WS_M2T = al256(WS_M1T + (size_t)256 * 256 * 2);
constexpr size_t WS_XB = al256(WS_M2T + (size_t)256 * 512 * 2);
constexpr int RF_PITCH = 1032, RF_TBL = 2 * 16 * RF_PITCH * 2 + 4096 + 4096 + 64;
constexpr size_t WS_RFT = al256(WS_XB + (size_t)RT * DM * 2);
constexpr size_t WS_END = al256(WS_RFT + (size_t)18 * RF_TBL);
constexpr size_t YT_CTX_OFF = (size_t)8 * 1024 * 4096;

constexpr int CW_BAR = 4096;

constexpr int LDS_BYTES = 155648;
constexpr int LDS_TW = 132096;
constexpr int LDS_MISC = 131072;

__device__ __forceinline__ unsigned f2bf(float f) { unsigned u = __float_as_uint(f); return (u + 0x7fffu + ((u >> 16) & 1u)) >> 16; }
typedef __bf16 hbf16x2 __attribute__((ext_vector_type(2)));
typedef float f32x2 __attribute__((ext_vector_type(2)));
__device__ __forceinline__ unsigned pk2(float lo, float hi) { const f32x2 v = {lo, hi}; return __builtin_bit_cast(unsigned, __builtin_convertvector(v, hbf16x2)); }
__device__ __forceinline__ unsigned pk4_fp8(float a, float b, float c, float d) {
    a = __builtin_amdgcn_fmed3f(a, -448.f, 448.f); b = __builtin_amdgcn_fmed3f(b, -448.f, 448.f); c = __builtin_amdgcn_fmed3f(c, -448.f, 448.f); d = __builtin_amdgcn_fmed3f(d, -448.f, 448.f);
    int w = 0; w = __builtin_amdgcn_cvt_pk_fp8_f32(a, b, w, false); w = __builtin_amdgcn_cvt_pk_fp8_f32(c, d, w, true); return (unsigned)w; }
__device__ __forceinline__ float bf2f(unsigned b) { return __uint_as_float(b << 16); }
__device__ __forceinline__ float bflo(unsigned w) { return __uint_as_float(w << 16); }
__device__ __forceinline__ float bfhi(unsigned w) { return __uint_as_float(w & 0xffff0000u); }
template <int CTRL> __device__ __forceinline__ float dppf(float x) { return __builtin_bit_cast(float, __builtin_amdgcn_mov_dpp(__builtin_bit_cast(int, x), CTRL, 0xf, 0xf, true)); }
template <int CTRL> __device__ __forceinline__ int dppi(int x) { return __builtin_amdgcn_mov_dpp(x, CTRL, 0xf, 0xf, true); }
constexpr int DPP_XOR1 = 0xB1, DPP_XOR2 = 0x4E, DPP_ROR4 = 0x124, DPP_ROR8 = 0x128;
__device__ __forceinline__ float wave_sum(float v) {
    v += dppf<DPP_XOR1>(v); v += dppf<DPP_XOR2>(v); v += dppf<DPP_ROR4>(v); v += dppf<DPP_ROR8>(v);
    auto s = __builtin_amdgcn_permlane16_swap(__float_as_uint(v), __float_as_uint(v), false, false); v = __uint_as_float(s[0]) + __uint_as_float(s[1]);
    auto t = __builtin_amdgcn_permlane32_swap(__float_as_uint(v), __float_as_uint(v), false, false); return __uint_as_float(t[0]) + __uint_as_float(t[1]);
}
__device__ __forceinline__ float wave_max(float v) {
    v = fmaxf(v, dppf<DPP_XOR1>(v)); v = fmaxf(v, dppf<DPP_XOR2>(v)); v = fmaxf(v, dppf<DPP_ROR4>(v)); v = fmaxf(v, dppf<DPP_ROR8>(v));
    auto s = __builtin_amdgcn_permlane16_swap(__float_as_uint(v), __float_as_uint(v), false, false); v = fmaxf(__uint_as_float(s[0]), __uint_as_float(s[1]));
    auto t = __builtin_amdgcn_permlane32_swap(__float_as_uint(v), __float_as_uint(v), false, false); return fmaxf(__uint_as_float(t[0]), __uint_as_float(t[1]));
}
__device__ __forceinline__ int wave_sum_i(int v) {
    v += dppi<DPP_XOR1>(v); v += dppi<DPP_XOR2>(v); v += dppi<DPP_ROR4>(v); v += dppi<DPP_ROR8>(v);
    auto s = __builtin_amdgcn_permlane16_swap((unsigned)v, (unsigned)v, false, false); v = (int)(s[0] + s[1]);
    auto t = __builtin_amdgcn_permlane32_swap((unsigned)v, (unsigned)v, false, false); return (int)(t[0] + t[1]);
}
__device__ __forceinline__ float sigmoidf_(float x) { return __builtin_amdgcn_rcpf(1.f + __builtin_amdgcn_exp2f(x * -1.4426950408889634f)); }
#define LDS_WAIT() asm volatile("s_waitcnt lgkmcnt(0)" ::: "memory")

#define XB_TMO      128
#define XB_XCNT(j)  (256  + 64 * (j))
#define XB_XSUB(j)  (1280 + 64 * (j))
#define XB_XGEN(j)  (2304 + 64 * (j))
#define XB_TOP      3328
#define XB_TOPGEN   3392
#define XCD_BAR_WORDS 3456
#define XB_SPIN_CAP (1u << 22)

__device__ __forceinline__ unsigned xb_ld(unsigned* p)              { return __hip_atomic_load(p, __ATOMIC_RELAXED, __HIP_MEMORY_SCOPE_AGENT); }
__device__ __forceinline__ unsigned xb_add(unsigned* p, unsigned v) { return __hip_atomic_fetch_add(p, v, __ATOMIC_RELAXED, __HIP_MEMORY_SCOPE_AGENT); }
__device__ __forceinline__ unsigned xb_xcc_id() { return (unsigned)__builtin_amdgcn_s_getreg((3 << 11) | 20) & 0xFu; }
#define XB_SPIN(cond, bar) do { unsigned _sp = 0; while (cond) { __builtin_amdgcn_s_sleep(1); \
    if ((++_sp & 255u) == 0u) { if (xb_ld(&(bar)[XB_TMO])) break; if (_sp > XB_SPIN_CAP) { atomicAdd(&(bar)[XB_TMO], 1u); break; } } } } while (0)

struct XcdBarrier { unsigned* bar; unsigned x; volatile LAS unsigned* st; };

__device__ __forceinline__ XcdBarrier xcd_barrier_post(unsigned* bar, volatile LAS unsigned* st) {
    XcdBarrier b; b.bar = bar; b.x = xb_xcc_id(); b.st = st;
    if (threadIdx.x == 0) (void)xb_add(&bar[XB_XCNT(b.x)], 1u);
    return b;
}
__device__ __forceinline__ void xcd_barrier_complete(unsigned* bar, unsigned x, unsigned& nloc, unsigned& nx) {
    const unsigned G = gridDim.x * gridDim.y * gridDim.z;
    unsigned sum, cnt, mine, sp = 0u;
    for (;;) {
        sum = 0u; cnt = 0u; mine = 0u;
#pragma unroll
        for (unsigned j = 0; j < 16; ++j) { const unsigned c = xb_ld(&bar[XB_XCNT(j)]); sum += c; cnt += (c > 0u) ? 1u : 0u; mine = (j == x) ? c : mine; }
        if (sum == G) break;
        __builtin_amdgcn_s_sleep(1);
        if ((++sp & 255u) == 0u) { if (xb_ld(&bar[XB_TMO])) break; if (sp > XB_SPIN_CAP) { atomicAdd(&bar[XB_TMO], 1u); break; } }
    }
    nloc = mine > 0u ? mine : 1u; nx = cnt > 0u ? cnt : 1u;
}
__device__ __forceinline__ void xcd_barrier(const XcdBarrier& b) {
    asm volatile("s_waitcnt vmcnt(0)" ::: "memory");
    __syncthreads();
    if (threadIdx.x == 0) {
        unsigned* bar = b.bar;
        __builtin_amdgcn_s_waitcnt(0);
        unsigned nloc = b.st[0], nx = b.st[1];
        if (nloc == 0u) { xcd_barrier_complete(bar, b.x, nloc, nx); b.st[0] = nloc; b.st[1] = nx; }
        const unsigned old = xb_add(&bar[XB_XSUB(b.x)], 1u);
        const unsigned gen = old / nloc;
        if (old + 1u == (gen + 1u) * nloc) {
            __builtin_amdgcn_fence(__ATOMIC_RELEASE, "agent");
            asm volatile("s_waitcnt vmcnt(0)" ::: "memory");
            const unsigned og = xb_add(&bar[XB_TOP], 1u);
            const unsigned tg = og / nx;
            if (og + 1u == (tg + 1u) * nx) xb_add(&bar[XB_TOPGEN], 1u);
            else XB_SPIN(xb_ld(&bar[XB_TOPGEN]) == tg, bar);
            __builtin_amdgcn_fence(__ATOMIC_ACQUIRE, "agent");
            xb_add(&bar[XB_XGEN(b.x)], 1u);
            asm volatile("s_waitcnt vmcnt(0)" ::: "memory");
        } else {
            XB_SPIN(xb_ld(&bar[XB_XGEN(b.x)]) == gen, bar);
            __builtin_amdgcn_fence(__ATOMIC_ACQUIRE, "agent");
            asm volatile("s_waitcnt vmcnt(0)" ::: "memory");
        }
    }
    __syncthreads();
}

struct Params {
    const float *x, *c, *ctx, *c_ctx, *ada_w, *ada_b, *norm1_g, *norm2_g, *w_in, *rpb, *w_att_o, *w_fourier, *w_pool, *pool_scale, *w_out, *w_router, *w_eg, *w_eu, *w_ed, *final_g;
    float* out; unsigned char* ws; int l_lo, l_hi;
};
struct Frame {
    LAS unsigned char* lds;
    int tid, lane, wave, G, bid;
    unsigned char* ws;
};
#define WSP(T, off) ((T*)(F.ws + (off)))

struct Unit { int grp, pm, pn, seg; };
struct GroupSched {
    int ng, nM, nN, G, c; int tM, tN, tpm0, tpn0;
    __device__ __forceinline__ void init(int ng_, int nM_, int nN_, int G_, int c_, int tM_ = 0, int tN_ = 0, int tpm0_ = 0, int tpn0_ = 0) { ng = ng_; nM = nM_; nN = nN_; G = G_; c = c_; tM = tM_; tN = tN_; tpm0 = tpm0_; tpn0 = tpn0_; }
    __device__ __forceinline__ bool next(int i, Unit& u) const {
        const int per = nM * nN; const int L = i * G + c;
        if (L < ng * per) {
            u.grp = L / per; int wgid = L - u.grp * per;
            { const int q = per / 8, r = per % 8, xcd = wgid % 8, off = wgid / 8; wgid = (xcd < r ? xcd * (q + 1) : r * (q + 1) + (xcd - r) * q) + off; }
            const int nig = 8 * nN, gid = wgid / nig, fm = gid * 8, gsz = (nM - fm) < 8 ? (nM - fm) : 8;
            u.pm = fm + ((wgid % nig) % gsz); u.pn = (wgid % nig) / gsz; u.seg = 0; return true;
        }
        const int w = L - ng * per;
        if (w < tM * tN) { u.grp = ng; u.pm = tpm0 + (w % tM); u.pn = tpn0 + (w / tM); u.seg = 0; return true; }
        return false;
    }
};
struct Operands { const bf16* A; const bf16* Bt; int lda, ldb, slot0, K; int bmap; };

constexpr int HTB = 128 * 64 * 2;
__device__ __forceinline__ int lds_byte(int r, int c) { const int st = (r >> 4) * 2 + (c >> 5), rr = r & 15, cc = c & 31, ob = rr * 64 + cc * 2; return st * 1024 + (ob ^ (((ob >> 9) & 1) << 5)); }
__device__ __forceinline__ int perm32(int rho) { const int n = rho >> 4, i = rho & 15; return 8 * (i >> 2) + 4 * n + (i & 3); }
__device__ __forceinline__ void stage_rc(int b, int& R, int& C) { const int st = b / 1024, sb = b % 1024, swz = sb ^ (((sb >> 9) & 1) << 5); R = (st >> 1) * 16 + swz / 64; C = (st & 1) * 32 + (swz % 64) / 2; }
typedef int i32x8 __attribute__((ext_vector_type(8)));
typedef int i32x4 __attribute__((ext_vector_type(4)));
__device__ __forceinline__ i32x8 cat8(bf16x8 lo, bf16x8 hi) { const i32x4 a = __builtin_bit_cast(i32x4, lo), b = __builtin_bit_cast(i32x4, hi); return (i32x8){a[0], a[1], a[2], a[3], b[0], b[1], b[2], b[3]}; }
template <bool GATHER, bool PERM, bool FP8, class Sched, class Addr, class Epi>
__device__ __forceinline__ void gemm_fast(LAS unsigned char* lds, const int tid, const Sched& S, const Addr& AD, const Epi& E, const int* __restrict__ grows) {
    const int wid = __builtin_amdgcn_readfirstlane(tid >> 6), lane = tid & 63, wr = wid >> 2, wc = wid & 3, fr = lane & 15, fq = lane >> 4;
    unsigned cvg[2][2], nvg[2][2], cvb[2][2], nvb[2][2];
#define PG8_RC(i_) int R_, C_; stage_rc(tid * 16 + (i_) * 8192, R_, C_); const int sR_ = R_; const unsigned sC_ = (unsigned)C_ * 2u; const int sRb_ = PERM ? ((R_ & ~31) + perm32(R_ & 31)) : R_; (void)sR_; (void)sRb_; (void)sC_
    const size_t kstep = 128;
    const unsigned ldsw = (unsigned)wid * 1024u;
    const int aoff = lds_byte(wr * 64 + fr, fq * 8), boff = lds_byte(wc * 32 + fr, fq * 8);
#define PG8_SA(b, h) (((b) * 2 + (h)) * HTB)
#define PG8_SB(b, h) ((4 + (b) * 2 + (h)) * HTB)
#define PG8_STAGE(bufoff, gbase, voff) do { _Pragma("unroll") for (int _i = 0; _i < 2; ++_i) \
        __builtin_amdgcn_global_load_lds((const unsigned*)((const char*)(gbase) + (voff)[_i]), (LAS unsigned*)(lds + (bufoff) + ldsw + _i * 8192), 16, 0, 0); } while (0)
#define PG8_LDA(dst, b, h) do { if constexpr (FP8) { _Pragma("unroll") for (int m = 0; m < 4; ++m) dst##8[m] = cat8(*(const LAS bf16x8*)(lds + PG8_SA(b, h) + aoff + m * 2048), *(const LAS bf16x8*)(lds + PG8_SA(b, h) + aoff + m * 2048 + 1024)); } \
        else { _Pragma("unroll") for (int m = 0; m < 4; ++m) _Pragma("unroll") for (int k = 0; k < 2; ++k) dst[m][k] = *(const LAS bf16x8*)(lds + PG8_SA(b, h) + aoff + m * 2048 + k * 1024); } } while (0)
#define PG8_LDB(dst, b, h) do { if constexpr (FP8) { _Pragma("unroll") for (int n = 0; n < 2; ++n) dst##8[n] = cat8(*(const LAS bf16x8*)(lds + PG8_SB(b, h) + boff + n * 2048), *(const LAS bf16x8*)(lds + PG8_SB(b, h) + boff + n * 2048 + 1024)); } \
        else { _Pragma("unroll") for (int n = 0; n < 2; ++n) _Pragma("unroll") for (int k = 0; k < 2; ++k) dst[n][k] = *(const LAS bf16x8*)(lds + PG8_SB(b, h) + boff + n * 2048 + k * 1024); } } while (0)
#define PG8_MMA(ai, bj, At, Bt) do { __builtin_amdgcn_s_setprio(1); \
        if constexpr (FP8) { _Pragma("unroll") for (int m = 0; m < 4; ++m) _Pragma("unroll") for (int n = 0; n < 2; ++n)   \
            asm volatile("v_mfma_scale_f32_16x16x128_f8f6f4 %0, %1, %2, %0, %3, %3 op_sel_hi:[0,0,0]" : "+v"(acc[ai][bj][m][n]) : "v"(Bt##8[n]), "v"(At##8[m]), "v"(one_scale)); } \
        else { _Pragma("unroll") for (int m = 0; m < 4; ++m) _Pragma("unroll") for (int n = 0; n < 2; ++n) _Pragma("unroll") for (int k = 0; k < 2; ++k) \
            acc[ai][bj][m][n] = __builtin_amdgcn_mfma_f32_16x16x32_bf16(Bt[n][k], At[m][k], acc[ai][bj][m][n], 0, 0, 0); } \
        __builtin_amdgcn_s_setprio(0); } while (0)
#define PG8_WAIT_V(n) asm volatile("s_waitcnt vmcnt(" #n ")" ::: "memory")
#define PG8_WAIT_L(n) asm volatile("s_waitcnt lgkmcnt(" #n ")" ::: "memory")
#define PG8_BAR __builtin_amdgcn_s_barrier()
#define PG8_SCHED __builtin_amdgcn_sched_barrier(0)
#define PG8_GIDX(dst, op_) do { _Pragma("unroll") for (int i_ = 0; i_ < 2; ++i_) { PG8_RC(i_); _Pragma("unroll") for (int h_ = 0; h_ < 2; ++h_) dst[h_][i_] = (unsigned)grows[(op_).slot0 + h_ * 128 + sR_] * (unsigned)((op_).lda * 2) + sC_; } } while (0)
#define PG8_AOFF(dst, op_) do { _Pragma("unroll") for (int i_ = 0; i_ < 2; ++i_) { PG8_RC(i_); _Pragma("unroll") for (int h_ = 0; h_ < 2; ++h_) dst[h_][i_] = (unsigned)((sR_ + 128 * h_) * (op_).lda) * 2u + sC_; } } while (0)
#define PG8_BOFF(dst, op_) do { _Pragma("unroll") for (int i_ = 0; i_ < 2; ++i_) { PG8_RC(i_); _Pragma("unroll") for (int h_ = 0; h_ < 2; ++h_) { const int c_ = sRb_ + 128 * h_; \
        dst[h_][i_] = (unsigned)(((op_).bmap ? (64 * (c_ & 7) + (c_ >> 3)) : c_) * (op_).ldb) * 2u + sC_; } } } while (0)
#define PG8_COPY(dst, src) do { _Pragma("unroll") for (int h_ = 0; h_ < 2; ++h_) _Pragma("unroll") for (int i_ = 0; i_ < 2; ++i_) dst[h_][i_] = src[h_][i_]; } while (0)
    Unit cur, nxt; int ui = 0;
    if (!S.next(0, cur)) return;
    f32x4 acc[2][2][4][2];
#pragma unroll
    for (int a = 0; a < 2; ++a)
#pragma unroll
        for (int b = 0; b < 2; ++b)
#pragma unroll
            for (int m = 0; m < 4; ++m)
#pragma unroll
                for (int n = 0; n < 2; ++n) acc[a][b][m][n] = (f32x4){0.f, 0.f, 0.f, 0.f};
    bf16x8 At[4][2], B0[2][2], B1[2][2]; i32x8 At8[4], B08[2], B18[2];
    const int one_scale = 0x7F7F7F7F;
    const char* cA; const char* cB; int nt;
    bool has_next; const char* nA; const char* nB; int nnt;
    { const Operands op = AD(cur); cA = (const char*)op.A; cB = (const char*)op.Bt; nt = op.K / 64; PG8_BOFF(cvb, op);
      has_next = S.next(1, nxt); const Operands o1 = has_next ? AD(nxt) : op; PG8_BOFF(nvb, o1); nA = (const char*)o1.A; nB = (const char*)o1.Bt; nnt = o1.K / 64;
      if constexpr (GATHER) { PG8_GIDX(cvg, op); PG8_GIDX(nvg, o1); PG8_WAIT_V(0); } else { PG8_AOFF(cvg, op); PG8_AOFF(nvg, o1); } }
    PG8_STAGE(PG8_SB(0, 0), cB, cvb[0]); PG8_STAGE(PG8_SB(0, 1), cB, cvb[1]); PG8_STAGE(PG8_SA(0, 0), cA, cvg[0]); PG8_STAGE(PG8_SA(0, 1), cA, cvg[1]);
    if (wr == 1) PG8_BAR;
    PG8_WAIT_V(2); PG8_BAR;
    PG8_STAGE(PG8_SB(1, 0), cB + kstep, cvb[0]); PG8_STAGE(PG8_SA(1, 0), cA + kstep, cvg[0]); PG8_STAGE(PG8_SB(1, 1), cB + kstep, cvb[1]);
    PG8_WAIT_V(6); PG8_BAR;
    for (;;) {
#pragma unroll 1
        for (int t = 0; t < nt; t += 2) {
            const bool last = (t == nt - 2);
            const char* a1 = cA + (size_t)(t + 1) * kstep;
            const char* a2 = last ? nA : cA + (size_t)(t + 2) * kstep; const char* b2 = last ? nB : cB + (size_t)(t + 2) * kstep;
            const char* a3 = a2 + kstep; const char* b3 = b2 + kstep;
            unsigned v2[2][2], w2[2][2];
#pragma unroll
            for (int h_ = 0; h_ < 2; ++h_)
#pragma unroll
                for (int i_ = 0; i_ < 2; ++i_) { v2[h_][i_] = last ? nvg[h_][i_] : cvg[h_][i_]; w2[h_][i_] = last ? nvb[h_][i_] : cvb[h_][i_]; }
            PG8_LDB(B0, 0, 0); PG8_LDB(B1, 0, 1); PG8_SCHED; PG8_LDA(At, 0, 0); PG8_STAGE(PG8_SA(1, 1), a1, cvg[1]);
            PG8_WAIT_V(8); PG8_WAIT_L(0); PG8_BAR; PG8_MMA(0, 0, At, B0); PG8_MMA(0, 1, At, B1); PG8_BAR; PG8_SCHED;
            PG8_LDA(At, 0, 1); PG8_STAGE(PG8_SB(0, 0), b2, w2[0]); PG8_STAGE(PG8_SB(0, 1), b2, w2[1]); PG8_STAGE(PG8_SA(0, 0), a2, v2[0]);
            PG8_WAIT_V(8); PG8_WAIT_L(0); PG8_BAR; PG8_MMA(1, 0, At, B0); PG8_MMA(1, 1, At, B1); PG8_BAR; PG8_SCHED;
            PG8_LDB(B0, 1, 0); PG8_LDB(B1, 1, 1); PG8_SCHED; PG8_LDA(At, 1, 0); PG8_STAGE(PG8_SA(0, 1), a2, v2[1]);
            PG8_WAIT_V(8); PG8_WAIT_L(0); PG8_BAR; PG8_MMA(0, 0, At, B0); PG8_MMA(0, 1, At, B1); PG8_BAR; PG8_SCHED;
            PG8_LDA(At, 1, 1); PG8_STAGE(PG8_SB(1, 0), b3, w2[0]); PG8_STAGE(PG8_SB(1, 1), b3, w2[1]); PG8_STAGE(PG8_SA(1, 0), a3, v2[0]);
            PG8_WAIT_V(8); PG8_WAIT_L(0); PG8_BAR; PG8_MMA(1, 0, At, B0); PG8_MMA(1, 1, At, B1); PG8_BAR; PG8_SCHED;
        }
        if constexpr (FP8) asm volatile("s_nop 15\n\ts_nop 15" ::: "memory");
        if (wr == 0) PG8_BAR;
        unsigned fvg[2][2], fvb[2][2];
        Unit u2; const bool h2 = S.next(ui + 2, u2); const char* fA = nA; const char* fB = nB; int fnt = nnt;
        if (h2) { const Operands o2 = AD(u2); fA = (const char*)o2.A; fB = (const char*)o2.Bt; fnt = o2.K / 64; PG8_BOFF(fvb, o2); if constexpr (GATHER) PG8_GIDX(fvg, o2); else PG8_AOFF(fvg, o2); }
        else { PG8_COPY(fvb, nvb); PG8_COPY(fvg, nvg); }
        { int fr2 = fr, fq2 = fq; asm volatile("" : "+v"(fr2), "+v"(fq2));
          E(acc, cur, wr, wc, fr2, fq2); }
        if (!has_next) break;
        if constexpr (GATHER) PG8_WAIT_V(0);
        PG8_COPY(cvg, nvg); PG8_COPY(nvg, fvg); PG8_COPY(cvb, nvb); PG8_COPY(nvb, fvb);
        if (E.reset(cur)) {
#pragma unroll
        for (int a = 0; a < 2; ++a)
#pragma unroll
            for (int b = 0; b < 2; ++b)
#pragma unroll
                for (int m = 0; m < 4; ++m)
#pragma unroll
                    for (int n = 0; n < 2; ++n) acc[a][b][m][n] = (f32x4){0.f, 0.f, 0.f, 0.f};
        }
        cur = nxt; cA = nA; cB = nB; nt = nnt; ++ui;
        nxt = u2; has_next = h2; nA = fA; nB = fB; nnt = fnt;
        if (wr == 1) PG8_BAR;
    }
    PG8_WAIT_V(0);
    PG8_BAR;
#undef PG8_SA
#undef PG8_SB
#undef PG8_STAGE
#undef PG8_LDA
#undef PG8_LDB
#undef PG8_MMA
#undef PG8_WAIT_V
#undef PG8_WAIT_L
#undef PG8_BAR
#undef PG8_SCHED
#undef PG8_GIDX
#undef PG8_AOFF
#undef PG8_BOFF
#undef PG8_COPY
#undef PG8_RC
}
template <class F> struct EpiFn { F f; __device__ __forceinline__ void operator()(f32x4 (&acc)[2][2][4][2], const Unit& u, int wr, int wc, int fr, int fq) const { f(acc, u, wr, wc, fr, fq); } __device__ __forceinline__ bool reset(const Unit&) const { return true; } };
template <class F> __device__ __forceinline__ EpiFn<F> mk_epi(F f) { return EpiFn<F>{f}; }
template <class F> struct EpiSeg { F f; int last; __device__ __forceinline__ void operator()(f32x4 (&acc)[2][2][4][2], const Unit& u, int wr, int wc, int fr, int fq) const { f(acc, u, wr, wc, fr, fq); } __device__ __forceinline__ bool reset(const Unit& u) const { return u.seg == last; } };
template <class F> __device__ __forceinline__ EpiSeg<F> mk_epi_seg(F f, int last) { return EpiSeg<F>{f, last}; }
template <int NSEG> struct SegSched { GroupSched base; __device__ __forceinline__ bool next(int j, Unit& u) const { if (!base.next(j / NSEG, u)) return false; u.seg = j % NSEG; return true; } };
#ifndef DUP_PH
#define DUP_PH -1
#endif
#define REP_BEGIN(k) _Pragma("unroll 1") for (int rep_ = 0; rep_ < ((DUP_PH == (k)) ? 2 : 1); ++rep_) { if (rep_) { if constexpr (PH < 0) xcd_barrier(bar); }
#define REP_END }
#define GEMM(S, AD, E, K, lda, ldb) gemm_fast<false, false, false>(F.lds, F.tid, S, AD, mk_epi(E), nullptr)
#define GEMM_P(S, AD, E) gemm_fast<false, true, false>(F.lds, F.tid, S, AD, mk_epi(E), nullptr)
#define GEMM_P8(S, AD, E) gemm_fast<false, true, true>(F.lds, F.tid, S, AD, mk_epi(E), nullptr)
#define GEMM_GATHER8(S, AD, E, rows) gemm_fast<true, true, true>(F.lds, F.tid, S, AD, mk_epi(E), rows)
#define EPI_ARGS f32x4 (&acc)[2][2][4][2], const Unit& u, int wr, int wc, int fr, int fq
#define EPI_FOR(...) _Pragma("unroll") for (int ai = 0; ai < 2; ++ai) _Pragma("unroll") for (int m = 0; m < 4; ++m) { const int r = ai * 128 + wr * 64 + m * 16 + fr; \
    _Pragma("unroll") for (int bj = 0; bj < 2; ++bj) _Pragma("unroll") for (int n = 0; n < 2; ++n) { const int c = bj * 128 + wc * 32 + n * 16 + 4 * fq; const f32x4 v = acc[ai][bj][m][n]; __VA_ARGS__ } }
#define EPI_FOR8(...) _Pragma("unroll") for (int ai = 0; ai < 2; ++ai) _Pragma("unroll") for (int m = 0; m < 4; ++m) { const int r = ai * 128 + wr * 64 + m * 16 + fr; \
    _Pragma("unroll") for (int bj = 0; bj < 2; ++bj) { const int c = bj * 128 + wc * 32 + 8 * fq; const f32x4 v0 = acc[ai][bj][m][0], v1 = acc[ai][bj][m][1]; __VA_ARGS__ } }
__device__ __forceinline__ void st_bf8(bf16* p, f32x4 a, f32x4 b) { u32x4 w; w.x = pk2(a[0], a[1]); w.y = pk2(a[2], a[3]); w.z = pk2(b[0], b[1]); w.w = pk2(b[2], b[3]); *(u32x4*)p = w; }
__device__ __forceinline__ void st_bf4(bf16* p, f32x4 v) { u32x2 w; w.x = pk2(v[0], v[1]); w.y = pk2(v[2], v[3]); *(u32x2*)p = w; }

__device__ __forceinline__ void p_mod(const Params& P, Frame& F) {
    LAS float* sc = (LAS float*)F.lds;
    LAS float* red = (LAS float*)(F.lds + 9 * 1024 * 4);
    float* MOD = WSP(float, WS_MOD);
    bool have = false;
    for (int it = F.bid; it < 2 * 96; it += F.G) {
        if (!have) {
            for (int i = F.tid; i < 9 * 1024; i += NTHREADS) { const int r = i >> 10, k = i & 1023; const float v = r < 8 ? P.c[r * 1024 + k] : P.c_ctx[k]; sc[i] = v * sigmoidf_(v); }
            have = true;
        }
        __syncthreads();
        const int l = it / 96, j0 = (it % 96) * 64, jj = F.tid & 63, kc = F.tid >> 6;
        const float* W = P.ada_w + (size_t)l * 1024 * 6144 + j0 + jj;
        float a[9];
#pragma unroll
        for (int r = 0; r < 9; ++r) a[r] = 0.f;
#pragma unroll 8
        for (int k = kc * 128; k < kc * 128 + 128; ++k) { const float w = W[(size_t)k * 6144];
#pragma unroll
            for (int r = 0; r < 9; ++r) a[r] += sc[r * 1024 + k] * w; }
#pragma unroll
        for (int r = 0; r < 9; ++r) red[(kc * 9 + r) * 64 + jj] = a[r];
        __syncthreads();
        for (int o = F.tid; o < 9 * 64; o += NTHREADS) { const int r = o >> 6, j = o & 63; float s = 0.f;
#pragma unroll
            for (int q = 0; q < 8; ++q) s += red[(q * 9 + r) * 64 + j];
            MOD[((size_t)l * 9 + r) * 6144 + j0 + j] = s + P.ada_b[l * 6144 + j0 + j]; }
    }
    __syncthreads();
}
__device__ __forceinline__ void p_dftgen(Frame& F) {
    LAS float* tab = (LAS float*)F.lds;
    for (int j = F.tid; j < 4096; j += NTHREADS) tab[j] = cospif((float)j * (1.0f / 2048.0f));
    __syncthreads();
    bf16* DC_ = WSP(bf16, WS_DFTC); bf16* M1 = WSP(bf16, WS_M1T); bf16* M2 = WSP(bf16, WS_M2T);
    const int nchunk = 256 * 64 + 256 * 32 + 256 * 64;
    for (int ch = F.bid * NTHREADS + F.tid; ch < nchunk; ch += F.G * NTHREADS) {
        float v[8]; bf16* dst;
        if (ch < 256 * 64) { const int kf = ch >> 6, col0 = (ch & 63) * 8, cs = col0 >> 8, l0 = col0 & 255;
#pragma unroll
            for (int i = 0; i < 8; ++i) { const int j = ((kf * (l0 + i)) & 255) * 16; v[i] = cs ? -tab[(j + 3072) & 4095] : tab[j]; }
            dst = DC_ + (size_t)kf * 512 + col0; }
        else if (ch < 256 * 64 + 256 * 32) { const int c2 = ch - 256 * 64, row = c2 >> 5, col0 = (c2 & 31) * 8, ri = row >> 7, h = (row >> 6) & 1, k1 = row & 63, h2 = col0 >> 7, cs = (col0 >> 6) & 1, l10 = col0 & 63;
#pragma unroll
            for (int i = 0; i < 8; ++i) { const int j = ((k1 * (l10 + i)) & 63) * 64; const float c = tab[j], sn = tab[(j + 3072) & 4095];
                v[i] = (h != h2) ? 0.f : (ri == 0 ? (cs == 0 ? c : -sn) : (cs == 0 ? sn : c)); }
            dst = M1 + (size_t)row * 256 + col0; }
        else { const int c2 = ch - 256 * 64 - 256 * 32, row = c2 >> 6, col0 = (c2 & 63) * 8, q = row >> 6, k2 = row & 63, q2 = col0 >> 7, ri = (col0 >> 6) & 1, l20 = col0 & 63;
#pragma unroll
            for (int i = 0; i < 8; ++i) { const int j = ((k2 * (l20 + i)) & 63) * 64; const float c = tab[j], sn = tab[(j + 3072) & 4095];
                v[i] = (q != q2) ? 0.f : (ri == 0 ? c : -sn); }
            dst = M2 + (size_t)row * 512 + col0; }
        u32x4 o; o.x = pk2(v[0], v[1]); o.y = pk2(v[2], v[3]); o.z = pk2(v[4], v[5]); o.w = pk2(v[6], v[7]);
        *(u32x4*)dst = o;
    }
    __syncthreads();
}
__device__ __forceinline__ void transpose_item(const float* W, int ldw, int k0, int n0, bf16* WT, int ldt, int drow0, LAS float* scr, int lane) {
    f32x4 ld[8];
#pragma unroll
    for (int i = 0; i < 8; ++i) ld[i] = *(const f32x4*)(W + (size_t)(k0 + 8 * i + (lane >> 3)) * ldw + n0 + 4 * (lane & 7));
#pragma unroll
    for (int i = 0; i < 8; ++i) { LAS float* d = scr + (8 * i + (lane >> 3)) * 33 + 4 * (lane & 7); d[0] = ld[i][0]; d[1] = ld[i][1]; d[2] = ld[i][2]; d[3] = ld[i][3]; }
    LDS_WAIT(); asm volatile("" ::: "memory");
    const int c = lane & 7;
#pragma unroll
    for (int j = 0; j < 4; ++j) { const int n = (lane >> 3) + 8 * j; const LAS float* s = scr + (8 * c) * 33 + n;
        u32x4 o; o.x = pk2(s[0 * 33], s[1 * 33]); o.y = pk2(s[2 * 33], s[3 * 33]); o.z = pk2(s[4 * 33], s[5 * 33]); o.w = pk2(s[6 * 33], s[7 * 33]);
        *(u32x4*)(WT + (size_t)(drow0 + n) * ldt + k0 + 8 * c) = o; }
    LDS_WAIT(); asm volatile("" ::: "memory");
}
__device__ __forceinline__ void transpose_item8(const float* W, int ldw, int k0, int n0, unsigned char* WT, int ldt, int drow0, LAS float* scr, int lane) {
    f32x4 ld[8];
#pragma unroll
    for (int i = 0; i < 8; ++i) ld[i] = *(const f32x4*)(W + (size_t)(k0 + 8 * i + (lane >> 3)) * ldw + n0 + 4 * (lane & 7));
#pragma unroll
    for (int i = 0; i < 8; ++i) { LAS float* d = scr + (8 * i + (lane >> 3)) * 33 + 4 * (lane & 7); d[0] = ld[i][0]; d[1] = ld[i][1]; d[2] = ld[i][2]; d[3] = ld[i][3]; }
    LDS_WAIT(); asm volatile("" ::: "memory");
    const int c = lane & 7;
#pragma unroll
    for (int j = 0; j < 4; ++j) { const int n = (lane >> 3) + 8 * j; const LAS float* s = scr + (8 * c) * 33 + n;
        u32x2 o; o.x = pk4_fp8(s[0 * 33] * W8S, s[1 * 33] * W8S, s[2 * 33] * W8S, s[3 * 33] * W8S); o.y = pk4_fp8(s[4 * 33] * W8S, s[5 * 33] * W8S, s[6 * 33] * W8S, s[7 * 33] * W8S);
        *(u32x2*)(WT + (size_t)(drow0 + n) * ldt + k0 + 8 * c) = o; }
    LDS_WAIT(); asm volatile("" ::: "memory");
}
__device__ __forceinline__ void transpose_item8w(const float* W, int ldw, int k0, int n0, unsigned char* WT, int ldt, int drow0, LAS float* scr, int lane) {
    f32x4 ld[16];
#pragma unroll
    for (int i = 0; i < 16; ++i) ld[i] = *(const f32x4*)(W + (size_t)(k0 + 4 * i + (lane >> 4)) * ldw + n0 + 4 * (lane & 15));
#pragma unroll
    for (int i = 0; i < 16; ++i) { LAS float* d = scr + (4 * i + (lane >> 4)) * 65 + 4 * (lane & 15); d[0] = ld[i][0]; d[1] = ld[i][1]; d[2] = ld[i][2]; d[3] = ld[i][3]; }
    LDS_WAIT(); asm volatile("" ::: "memory");
    const int c = lane & 3;
#pragma unroll
    for (int p = 0; p < 4; ++p) { const int n = (lane >> 2) + 16 * p; const LAS float* s = scr + (16 * c) * 65 + n; u32x4 o;
#pragma unroll
        for (int q = 0; q < 4; ++q) o[q] = pk4_fp8(s[(4 * q) * 65] * W8S, s[(4 * q + 1) * 65] * W8S, s[(4 * q + 2) * 65] * W8S, s[(4 * q + 3) * 65] * W8S);
        *(u32x4*)(WT + (size_t)(drow0 + n) * ldt + k0 + 16 * c) = o; }
    LDS_WAIT(); asm volatile("" ::: "memory");
}
__device__ __forceinline__ void cv_load(const float* W, int ldw, int lane, f32x4 (&ld)[16]) {
#pragma unroll
    for (int i = 0; i < 16; ++i) ld[i] = *(const f32x4*)(W + (size_t)(4 * i + (lane >> 4)) * ldw + 4 * (lane & 15));
}
__device__ __forceinline__ void cv_store(const f32x4 (&ld)[16], unsigned char* WT, int ldt, LAS float* scr, int lane) {
#pragma unroll
    for (int i = 0; i < 16; ++i) { LAS float* d = scr + (4 * i + (lane >> 4)) * 65 + 4 * (lane & 15); d[0] = ld[i][0]; d[1] = ld[i][1]; d[2] = ld[i][2]; d[3] = ld[i][3]; }
    LDS_WAIT(); asm volatile("" ::: "memory");
    const int c = lane & 3;
#pragma unroll
    for (int p = 0; p < 4; ++p) { const int n = (lane >> 2) + 16 * p; const LAS float* s = scr + (16 * c) * 65 + n; u32x4 o;
#pragma unroll
        for (int q = 0; q < 4; ++q) o[q] = pk4_fp8(s[(4 * q) * 65] * W8S, s[(4 * q + 1) * 65] * W8S, s[(4 * q + 2) * 65] * W8S, s[(4 * q + 3) * 65] * W8S);
        *(u32x4*)(WT + (size_t)n * ldt + 16 * c) = o; }
    LDS_WAIT(); asm volatile("" ::: "memory");
}
__device__ __forceinline__ void cv_item(const Params& P, unsigned char* ws, int l, int it, const float*& W, int& ldw, unsigned char*& WT, int& ldt) {
    constexpr int I_E = 16 * 44;
    const int which = it / (16 * I_E), r0 = it % (16 * I_E), e = r0 / I_E, r = r0 % I_E;
    if (which < 2) { const int kb = r / 44, nb = r % 44, n0 = nb * 64;
        W = (which == 0 ? P.w_eg : P.w_eu) + ((size_t)l * 16 + e) * 1024 * FF + (size_t)(kb * 64) * FF + n0; ldw = FF;
        WT = ws + WS_WGU + (size_t)e * 5632 * 1024 + (size_t)((n0 >> 7) * 256 + (which ? 128 : 0) + (n0 & 127)) * 1024 + kb * 64; ldt = 1024; }
    else { const int kb = r / 16, nb = r % 16;
        W = P.w_ed + ((size_t)l * 16 + e) * FF * 1024 + (size_t)(kb * 64) * 1024 + nb * 64; ldw = 1024;
        WT = ws + WS_WD + (size_t)e * 1024 * FF + (size_t)(nb * 64) * FF + kb * 64; ldt = FF; }
}
__device__ __forceinline__ void wconv_experts(const Params& P, Frame& F, int l, int rank, int nblk) {
    LAS float* scr = (LAS float*)(F.lds + (F.wave < 7 ? F.wave * 17408 : 131584));
    const int gw = rank * NWAVES + F.wave, NGW = nblk * NWAVES, NIT = 3 * 16 * 16 * 44;
    f32x4 la[16], lb[16]; const float* W; int ldw; unsigned char* T0; int ldt0;
    int it = gw;
    if (it < NIT) { cv_item(P, F.ws, l, it, W, ldw, T0, ldt0); cv_load(W, ldw, F.lane, la); }
#pragma unroll 1
    for (; it < NIT; it += NGW) {
        unsigned char* T1 = T0; int ldt1 = ldt0; const int nit = it + NGW;
        if (nit < NIT) { cv_item(P, F.ws, l, nit, W, ldw, T1, ldt1); cv_load(W, ldw, F.lane, lb); }
        cv_store(la, T0, ldt0, scr, F.lane);
#pragma unroll
        for (int i = 0; i < 16; ++i) la[i] = lb[i];
        T0 = T1; ldt0 = ldt1;
    }
    __syncthreads();
}
constexpr int WC_IN = 1, WC_FO = 2, WC_OUT = 4, WC_ALL = 7;
__device__ __forceinline__ void p_wconv(const Params& P, Frame& F, int l, int rank, int nblk, int parts) {
    LAS float* scr = (LAS float*)(F.lds + F.wave * 16384);
    const int gw = rank * NWAVES + F.wave, NGW = nblk * NWAVES;
    const float* w_in = P.w_in + (size_t)l * 1024 * INW;
    bf16* WA = WSP(bf16, WS_WA); bf16* WFV = WSP(bf16, WS_WFV);
    constexpr int I_K = 16 * 32, I_Q = 16 * 32, I_P = 16 * 16, I_G = 16 * 96, I_V = 16 * 32, I_AO = 16 * 32, I_FO = 8 * 32, I_OUT = 16 * 32;
    constexpr int NSM = I_K + I_Q + I_P + I_G + I_V + I_AO + I_FO + I_OUT;
    for (int it = gw; it < NSM; it += NGW) {
        int r = it;
        if (r < I_K + I_Q + I_P + I_G + I_V + I_AO) { if (!(parts & WC_IN)) continue; }
        else if (r < I_K + I_Q + I_P + I_G + I_V + I_AO + I_FO) { if (!(parts & WC_FO)) continue; }
        else if (!(parts & WC_OUT)) continue;
        if (r < I_K) { transpose_item8(w_in, INW, (r / 32) * 64, 0 + (r % 32) * 32, WSP(unsigned char, WS_WA8), 1024, 0 + (r % 32) * 32, scr, F.lane); continue; } r -= I_K;
        if (r < I_Q) { transpose_item8(w_in, INW, (r / 32) * 64, 2048 + (r % 32) * 32, WSP(unsigned char, WS_WA8), 1024, 1024 + (r % 32) * 32, scr, F.lane); continue; } r -= I_Q;
        if (r < I_P) { transpose_item(w_in, INW, (r / 16) * 64, 3584 + (r % 16) * 32, WA, 1024, 2048 + (r % 16) * 32, scr, F.lane); continue; } r -= I_P;
        if (r < I_G) { transpose_item8(w_in, INW, (r / 96) * 64, 4096 + (r % 96) * 32, WSP(unsigned char, WS_WA8), 1024, 3072 + (r % 96) * 32, scr, F.lane); continue; } r -= I_G;
        if (r < I_V) { transpose_item8(w_in, INW, (r / 32) * 64, 1024 + (r % 32) * 32, WSP(unsigned char, WS_WA8), 1024, 2048 + (r % 32) * 32, scr, F.lane); continue; } r -= I_V;
        if (r < I_AO) { transpose_item8(P.w_att_o + (size_t)l * 1024 * 1024, 1024, (r / 32) * 64, (r % 32) * 32, WSP(unsigned char, WS_WAO), 1024, (r % 32) * 32, scr, F.lane); continue; } r -= I_AO;
        if (r < I_FO) { transpose_item(P.w_fourier + (size_t)l * 512 * 1024, 1024, (r / 32) * 64, (r % 32) * 32, WSP(bf16, WS_WFO), 512, (r % 32) * 32, scr, F.lane); continue; } r -= I_FO;
        transpose_item(P.w_out + (size_t)l * 1024 * 1024, 1024, (r / 32) * 64, (r % 32) * 32, WSP(bf16, WS_WOUT), 1024, (r % 32) * 32, scr, F.lane);
    }
    if (parts & WC_FO) { bf16* WPO = WSP(bf16, WS_WPO); const float* wp = P.w_pool + (size_t)l * 4 * 128 * 256;
      for (int i = rank * NTHREADS + F.tid; i < 1024 * 256; i += nblk * NTHREADS) { const int n = i >> 8, kk = i & 255, g = n >> 8, f = n & 255;
          WPO[i] = (bf16)(((kk >> 7) == (g & 1)) ? f2bf(wp[((size_t)g * 128 + (kk & 127)) * 256 + f]) : 0u); } }
    if (!(parts & WC_IN)) { __syncthreads(); return; }
    { LAS float* t128 = (LAS float*)F.lds; LAS float* srcs = t128 + 128;
      int tid = F.tid; asm volatile("" : "+v"(tid));
      __syncthreads();
      for (int j = tid; j < 128; j += NTHREADS) t128[j] = cospif((float)j * (1.0f / 64.0f));
      for (int tile = rank; tile < 256; tile += nblk) { const int g = tile >> 6, kb = tile & 63;
          __syncthreads();
          { const int kk = tid >> 5, c4 = (tid & 31) * 4; const f32x4 v = *(const f32x4*)(w_in + (size_t)(kb * 16 + kk) * INW + 3072 + g * 128 + c4); LAS float* d = srcs + kk * 129 + c4; d[0] = v[0]; d[1] = v[1]; d[2] = v[2]; d[3] = v[3]; }
          __syncthreads();
          const int m = tid >> 2, kq = tid & 3; float sc_[4] = {0.f, 0.f, 0.f, 0.f}, ss_[4] = {0.f, 0.f, 0.f, 0.f}; const LAS float* sp = srcs + (4 * kq) * 129;
#pragma unroll 4
          for (int c = 0; c < 128; ++c) { const float tc = t128[(m * c) & 127], ts = t128[(m * c + 96) & 127];
#pragma unroll
              for (int j = 0; j < 4; ++j) { const float v = sp[j * 129 + c]; sc_[j] += v * tc; ss_[j] += v * ts; } }
          bf16* o = WFV + (size_t)((g * 128 + m) * 2) * 1024 + kb * 16 + 4 * kq;
          st_bf4(o, (f32x4){sc_[0], sc_[1], sc_[2], sc_[3]}); st_bf4(o + 1024, (f32x4){ss_[0], ss_[1], ss_[2], ss_[3]}); }
      __syncthreads(); }
}

struct RowMod { const float* g; const float* sh; const float* sc; };
__device__ __forceinline__ void row_load(const float* row, int lane, f32x4 (&v)[4]) {
#pragma unroll
    for (int j = 0; j < 4; ++j) v[j] = *(const f32x4*)(row + 4 * lane + 256 * j);
}
__device__ __forceinline__ void row_load_bf(const bf16* row, int lane, f32x4 (&v)[4]) {
#pragma unroll
    for (int j = 0; j < 4; ++j) { const u32x2 w = *(const u32x2*)(row + 4 * lane + 256 * j); v[j] = (f32x4){bflo(w.x), bfhi(w.x), bflo(w.y), bfhi(w.y)}; }
}
__device__ __forceinline__ float row_rstd(const f32x4 (&v)[4]) {
    float s = 0.f;
#pragma unroll
    for (int j = 0; j < 4; ++j) s += (v[j][0] * v[j][0] + v[j][1] * v[j][1]) + (v[j][2] * v[j][2] + v[j][3] * v[j][3]);
    return rsqrtf(wave_sum(s) * (1.0f / 1024.0f) + RMS_EPS);
}
__device__ __forceinline__ void row_modulate(const f32x4 (&v)[4], float rstd, const RowMod& M, int lane, f32x4 (&y)[4]) {
#pragma unroll
    for (int j = 0; j < 4; ++j) { const int k = 4 * lane + 256 * j; const f32x4 g = *(const f32x4*)(M.g + k), sh = *(const f32x4*)(M.sh + k), sc = *(const f32x4*)(M.sc + k);
        y[j] = v[j] * rstd * g * (sc + 1.0f) + sh; }
}
__device__ __forceinline__ void row_store_bf(bf16* row, int lane, const f32x4 (&y)[4]) {
#pragma unroll
    for (int j = 0; j < 4; ++j) st_bf4(row + 4 * lane + 256 * j, y[j]);
}
__device__ __forceinline__ void row_store_f8(unsigned char* row, int lane, const f32x4 (&y)[4]) {
#pragma unroll
    for (int j = 0; j < 4; ++j) *(unsigned*)(row + 4 * lane + 256 * j) = pk4_fp8(y[j][0] * A8S, y[j][1] * A8S, y[j][2] * A8S, y[j][3] * A8S);
}
__device__ __forceinline__ const float* mod_ptr(Frame& F, int l, int row, int which) { const int mr = row < RL ? (row >> 12) : 8; return WSP(float, WS_MOD) + ((size_t)l * 9 + mr) * 6144 + which * 1024; }

__device__ __forceinline__ void row_modulate2(const f32x4 (&v0)[4], const f32x4 (&v1)[4], float rs0, float rs1, const RowMod& M, int lane, f32x4 (&y0)[4], f32x4 (&y1)[4]) {
#pragma unroll
    for (int j = 0; j < 4; ++j) { const int k = 4 * lane + 256 * j; const f32x4 g = *(const f32x4*)(M.g + k), sh = *(const f32x4*)(M.sh + k), sc = *(const f32x4*)(M.sc + k); const f32x4 m = g * (sc + 1.0f);
        y0[j] = v0[j] * rs0 * m + sh; y1[j] = v1[j] * rs1 * m + sh; }
}
__device__ __forceinline__ void p_rowpass_a0(const Params& P, Frame& F) {
    const int gw = F.bid * NWAVES + F.wave, NGW = F.G * NWAVES; bf16* H = WSP(bf16, WS_H); unsigned char* H8 = WSP(unsigned char, WS_H8);
    f32x4 vn[2][4]; int p = gw;
    if (p < RT / 2) { const int row = 2 * p; const float* src = row < RL ? P.x + (size_t)row * DM : P.ctx + (size_t)(row - RL) * DM; row_load(src, F.lane, vn[0]); row_load(src + DM, F.lane, vn[1]); }
    for (; p < RT / 2; p += NGW) { const int row = 2 * p;
        f32x4 v0[4], v1[4], y0[4], y1[4];
#pragma unroll
        for (int j = 0; j < 4; ++j) { v0[j] = vn[0][j]; v1[j] = vn[1][j]; }
        { const int nr = 2 * (p + NGW); if (nr < RT) { const float* src = nr < RL ? P.x + (size_t)nr * DM : P.ctx + (size_t)(nr - RL) * DM; row_load(src, F.lane, vn[0]); row_load(src + DM, F.lane, vn[1]); } }
        const float rs0 = row_rstd(v0), rs1 = row_rstd(v1);
        RowMod M{P.norm1_g, mod_ptr(F, 0, row, 0), mod_ptr(F, 0, row, 1)};
        row_modulate2(v0, v1, rs0, rs1, M, F.lane, y0, y1);
        row_store_bf(H + (size_t)row * DM, F.lane, y0); row_store_f8(H8 + (size_t)row * DM, F.lane, y0);
        row_store_bf(H + (size_t)(row + 1) * DM, F.lane, y1); row_store_f8(H8 + (size_t)(row + 1) * DM, F.lane, y1);
    }
}
constexpr int DPP_MIRROR = 0x140, DPP_HMIRROR = 0x141;
__device__ __forceinline__ void p_rowpass_k(const Params& P, Frame& F, int l, int nrows) {
    const int gw = F.bid * NWAVES + F.wave, NGW = F.G * NWAVES; bf16* H = WSP(bf16, WS_H);
    const int* SEL = WSP(int, WS_SEL); const bf16* Y = WSP(bf16, WS_Y);
    f32x4 vn[2][4]; int seln = -1; int p = gw; const int NP = nrows >> 1;
    bf16* XB = WSP(bf16, WS_XB);
    if (p < NP) { const int row = 2 * p; const bf16* src = XB + (size_t)row * DM; row_load_bf(src, F.lane, vn[0]); row_load_bf(src + DM, F.lane, vn[1]);
        seln = F.lane < 32 ? SEL[(size_t)row * 16 + F.lane] : -1; }
    for (; p < NP; p += NGW) { const int row = 2 * p;
        f32x4 v0[4], v1[4], a0[4], a1[4]; const int sel = seln;
#pragma unroll
        for (int j = 0; j < 4; ++j) { v0[j] = vn[0][j]; v1[j] = vn[1][j]; a0[j] = (f32x4){0.f, 0.f, 0.f, 0.f}; a1[j] = (f32x4){0.f, 0.f, 0.f, 0.f}; }
        { const int nr = 2 * (p + NGW); if (nr < nrows) { const bf16* src = XB + (size_t)nr * DM; row_load_bf(src, F.lane, vn[0]); row_load_bf(src + DM, F.lane, vn[1]);
            seln = F.lane < 32 ? SEL[(size_t)nr * 16 + F.lane] : -1; } }
        const unsigned emall = (unsigned)__ballot(sel >= 0);
        unsigned em0 = emall & 0xffffu, em1 = (emall >> 16) & 0xffffu; int s0[4], s1[4];
#pragma unroll
        for (int q = 0; q < 4; ++q) { s0[q] = -1; if (em0) { const int e = __builtin_ctz(em0); em0 &= em0 - 1; s0[q] = __builtin_amdgcn_readlane(sel, e); }
                                      s1[q] = -1; if (em1) { const int e = __builtin_ctz(em1); em1 &= em1 - 1; s1[q] = __builtin_amdgcn_readlane(sel, 16 + e); } }
        u32x2 w0[4][4], w1[4][4];
#pragma unroll
        for (int q = 0; q < 4; ++q) {
            if (s0[q] >= 0) { const bf16* yr = Y + (size_t)s0[q] * DM + 4 * F.lane;
#pragma unroll
                for (int j = 0; j < 4; ++j) w0[q][j] = *(const u32x2*)(yr + 256 * j); }
            if (s1[q] >= 0) { const bf16* yr = Y + (size_t)s1[q] * DM + 4 * F.lane;
#pragma unroll
                for (int j = 0; j < 4; ++j) w1[q][j] = *(const u32x2*)(yr + 256 * j); } }
#pragma unroll
        for (int q = 0; q < 4; ++q) {
            if (s0[q] >= 0) {
#pragma unroll
                for (int j = 0; j < 4; ++j) { const u32x2 w = w0[q][j]; a0[j][0] += bflo(w.x); a0[j][1] += bfhi(w.x); a0[j][2] += bflo(w.y); a0[j][3] += bfhi(w.y); } }
            if (s1[q] >= 0) {
#pragma unroll
                for (int j = 0; j < 4; ++j) { const u32x2 w = w1[q][j]; a1[j][0] += bflo(w.x); a1[j][1] += bfhi(w.x); a1[j][2] += bflo(w.y); a1[j][3] += bfhi(w.y); } } }
        while (em0) { const int e = __builtin_ctz(em0); em0 &= em0 - 1; const int sl = __builtin_amdgcn_readlane(sel, e); const bf16* yr = Y + (size_t)sl * DM;
#pragma unroll
            for (int j = 0; j < 4; ++j) { const u32x2 w = *(const u32x2*)(yr + 4 * F.lane + 256 * j); a0[j][0] += bflo(w.x); a0[j][1] += bfhi(w.x); a0[j][2] += bflo(w.y); a0[j][3] += bfhi(w.y); } }
        while (em1) { const int e = __builtin_ctz(em1); em1 &= em1 - 1; const int sl = __builtin_amdgcn_readlane(sel, 16 + e); const bf16* yr = Y + (size_t)sl * DM;
#pragma unroll
            for (int j = 0; j < 4; ++j) { const u32x2 w = *(const u32x2*)(yr + 4 * F.lane + 256 * j); a1[j][0] += bflo(w.x); a1[j][1] += bfhi(w.x); a1[j][2] += bflo(w.y); a1[j][3] += bfhi(w.y); } }
        const float* g2 = mod_ptr(F, l, row, 5);
#pragma unroll
        for (int j = 0; j < 4; ++j) { const f32x4 g = *(const f32x4*)(g2 + 4 * F.lane + 256 * j); v0[j] = v0[j] + g * a0[j]; v1[j] = v1[j] + g * a1[j]; }
        const float rs0 = row_rstd(v0), rs1 = row_rstd(v1);
        if (l == 0) {
#pragma unroll
            for (int j = 0; j < 4; ++j) { st_bf4(XB + (size_t)row * DM + 4 * F.lane + 256 * j, v0[j]); st_bf4(XB + (size_t)(row + 1) * DM + 4 * F.lane + 256 * j, v1[j]); }
            f32x4 y0[4], y1[4]; RowMod M{P.norm1_g + 1024, mod_ptr(F, 1, row, 0), mod_ptr(F, 1, row, 1)};
            row_modulate2(v0, v1, rs0, rs1, M, F.lane, y0, y1);
            row_store_bf(H + (size_t)row * DM, F.lane, y0); row_store_f8(WSP(unsigned char, WS_H8) + (size_t)row * DM, F.lane, y0);
            row_store_bf(H + (size_t)(row + 1) * DM, F.lane, y1); row_store_f8(WSP(unsigned char, WS_H8) + (size_t)(row + 1) * DM, F.lane, y1);
        } else {
#pragma unroll
            for (int j = 0; j < 4; ++j) { const f32x4 g = *(const f32x4*)(P.final_g + 4 * F.lane + 256 * j); float* xr = P.out + (size_t)row * DM + 4 * F.lane + 256 * j; *(f32x4*)xr = v0[j] * rs0 * g; *(f32x4*)(xr + DM) = v1[j] * rs1 * g; }
        }
    }
}

constexpr int RF_WH = 0, RF_WL = 16 * RF_PITCH * 2, RF_M8 = 2 * RF_WL, RF_S8 = RF_M8 + 4096, RF_BIAS = RF_S8 + 4096, RF_RS = RF_BIAS + 64;
__device__ __forceinline__ void p_rftables(const Params& P, Frame& F) {
    LAS float* red = (LAS float*)F.lds;
    for (int job = F.bid; job < 2 * 9 * 16; job += F.G) { const int e = job & 15, lm = job >> 4, l = lm / 9;
        int tid = F.tid; asm volatile("" : "+v"(tid));
        const float* wr = P.w_router + (size_t)l * 1024 * 16; const float* g2n = P.norm2_g + l * 1024;
        const float* sh = WSP(float, WS_MOD) + (size_t)lm * 6144 + 3 * 1024; const float* sc = sh + 1024;
        unsigned char* T = WSP(unsigned char, WS_RFT) + (size_t)lm * RF_TBL;
        float bs = 0.f;
#pragma unroll
        for (int q = 0; q < 2; ++q) { const int k = tid + 512 * q; const float m = g2n[k] * (1.0f + sc[k]), r = wr[k * 16 + e], w = m * r;
            const unsigned hi = f2bf(w); const float lo = w - bf2f(hi);
            ((bf16*)(T + RF_WH))[e * RF_PITCH + k] = (bf16)hi; ((bf16*)(T + RF_WL))[e * RF_PITCH + k] = (bf16)f2bf(lo);
            bs += sh[k] * r;
            if (e == 0) { ((float*)(T + RF_M8))[k] = m * A8S; ((float*)(T + RF_S8))[k] = sh[k] * A8S; } }
        bs = wave_sum(bs);
        __syncthreads();
        if (F.lane == 0) red[F.wave] = bs;
        __syncthreads();
        if (tid == 0) { float a = 0.f;
#pragma unroll
            for (int w = 0; w < NWAVES; ++w) a += red[w];
            ((float*)(T + RF_BIAS))[e] = a; }
    }
    __syncthreads();
}
__device__ __forceinline__ void rf_copy(Frame& F, const unsigned char* T) {
    int tid = F.tid; asm volatile("" : "+v"(tid));
    __syncthreads();
    u32x4 v[10];
#pragma unroll
    for (int q = 0; q < 10; ++q) { const int c = tid + 512 * q; if (c < RF_TBL / 16) v[q] = *(const u32x4*)(T + (size_t)c * 16); }
#pragma unroll
    for (int q = 0; q < 10; ++q) { const int c = tid + 512 * q; if (c < RF_TBL / 16) *(LAS u32x4*)(F.lds + c * 16) = v[q]; }
    __syncthreads();
}
__device__ __forceinline__ void rf_compute(Frame& F, const u32x4 (&xw)[32], unsigned char* H8, float* AFF, int row0) {
    const int i = F.lane & 15, g = F.lane >> 4;
    int og = 8 * g; asm volatile("" : "+v"(og));
    f32x2 s2 = {0.f, 0.f};
#pragma unroll
    for (int t = 0; t < 32; ++t)
#pragma unroll
        for (int q = 0; q < 4; ++q) { const f32x2 v = {bflo(xw[t][q]), bfhi(xw[t][q])}; s2 += v * v; }
    float ss = s2[0] + s2[1];
    { auto a = __builtin_amdgcn_permlane16_swap(__float_as_uint(ss), __float_as_uint(ss), false, false); ss = __uint_as_float(a[0]) + __uint_as_float(a[1]);
      auto b = __builtin_amdgcn_permlane32_swap(__float_as_uint(ss), __float_as_uint(ss), false, false); ss = __uint_as_float(b[0]) + __uint_as_float(b[1]); }
    const float rstd = rsqrtf(ss * (1.0f / 1024.0f) + RMS_EPS);
    LAS float* RS = (LAS float*)(F.lds + RF_RS) + F.wave * 16;
    if (F.lane < 16) RS[F.lane] = rstd;
    f32x4 acc = {0.f, 0.f, 0.f, 0.f};
    const LAS unsigned char* wb = F.lds + (i * RF_PITCH + og) * 2;
#pragma unroll
    for (int t = 0; t < 32; ++t) { const bf16x8 bh = *(const LAS bf16x8*)(wb + RF_WH + 64 * t), bl = *(const LAS bf16x8*)(wb + RF_WL + 64 * t); const bf16x8 a = __builtin_bit_cast(bf16x8, xw[t]);
        acc = __builtin_amdgcn_mfma_f32_16x16x32_bf16(a, bh, acc, 0, 0, 0); acc = __builtin_amdgcn_mfma_f32_16x16x32_bf16(a, bl, acc, 0, 0, 0);
        if ((t & 3) == 3) asm volatile("" ::: "memory"); }
    { const LAS float* M8 = (const LAS float*)(F.lds + RF_M8) + og; const LAS float* S8 = (const LAS float*)(F.lds + RF_S8) + og; unsigned char* hr = H8 + (size_t)(row0 + i) * DM + 8 * g;
#pragma unroll
      for (int t = 0; t < 32; ++t) { const f32x4 m0 = *(const LAS f32x4*)(M8 + 32 * t), m1 = *(const LAS f32x4*)(M8 + 32 * t + 4), h0 = *(const LAS f32x4*)(S8 + 32 * t), h1 = *(const LAS f32x4*)(S8 + 32 * t + 4);
          u32x4 x = xw[t]; asm volatile("" : "+v"(x));
          const f32x4 xa = {bflo(x[0]), bfhi(x[0]), bflo(x[1]), bfhi(x[1])}, xb = {bflo(x[2]), bfhi(x[2]), bflo(x[3]), bfhi(x[3])};
          const f32x4 ya = xa * rstd * m0 + h0, yb = xb * rstd * m1 + h1;
          u32x2 w; w.x = pk4_fp8(ya[0], ya[1], ya[2], ya[3]); w.y = pk4_fp8(yb[0], yb[1], yb[2], yb[3]); *(u32x2*)(hr + 32 * t) = w;
          if (t & 1) asm volatile("" ::: "memory"); } }
    LDS_WAIT(); asm volatile("" ::: "memory");
    const f32x4 rs4 = *(const LAS f32x4*)(RS + 4 * g); const float bias = ((const LAS float*)(F.lds + RF_BIAS))[i];
#pragma unroll
    for (int r = 0; r < 4; ++r) { const float lg = acc[r] * rs4[r] + bias; float mx = lg;
        mx = fmaxf(mx, dppf<DPP_XOR1>(mx)); mx = fmaxf(mx, dppf<DPP_XOR2>(mx)); mx = fmaxf(mx, dppf<DPP_HMIRROR>(mx)); mx = fmaxf(mx, dppf<DPP_MIRROR>(mx));
        const float ex = __expf(lg - mx); float den = ex;
        den += dppf<DPP_XOR1>(den); den += dppf<DPP_XOR2>(den); den += dppf<DPP_HMIRROR>(den); den += dppf<DPP_MIRROR>(den);
        AFF[(size_t)(row0 + 4 * g + r) * 16 + i] = ex / den; }
}
__device__ __forceinline__ void p_rowpass_f(const Params& P, Frame& F, int l, int nrows) {
    const bf16* XB = WSP(bf16, WS_XB); unsigned char* H8 = WSP(unsigned char, WS_H8); float* AFF = WSP(float, WS_AFF);
    int cur = -1;
    for (int it = F.bid; it < nrows / 128; it += F.G) { const int row0 = it * 128 + 16 * F.wave, mr = row0 < RL ? (row0 >> 12) : 8;
        const bf16* xr = XB + (size_t)(row0 + (F.lane & 15)) * DM + 8 * (F.lane >> 4);
        u32x4 xw[32];
#pragma unroll
        for (int t = 0; t < 32; ++t) xw[t] = *(const u32x4*)(xr + 32 * t);
        if (mr != cur) { rf_copy(F, WSP(unsigned char, WS_RFT) + (size_t)(l * 9 + mr) * RF_TBL); cur = mr; }
        rf_compute(F, xw, H8, AFF, row0); }
    __syncthreads();
}
constexpr int ACK_STRIDE = 72, ACV_STRIDE = 264;
constexpr int ALDS_CK = 0, ALDS_CV = 256 * ACK_STRIDE * 2, ALDS_RP = ALDS_CV + 64 * ACV_STRIDE * 2;
struct AttnState { float m, sum; f32x4 o[4]; };
__device__ __forceinline__ float xrow16_max(float x) {
    auto s = __builtin_amdgcn_permlane16_swap(__float_as_uint(x), __float_as_uint(x), false, false);
    x = fmaxf(__uint_as_float(s[0]), __uint_as_float(s[1]));
    auto t = __builtin_amdgcn_permlane32_swap(__float_as_uint(x), __float_as_uint(x), false, false);
    return fmaxf(__uint_as_float(t[0]), __uint_as_float(t[1]));
}
__device__ __forceinline__ float xrow16_sum(float x) {
    auto s = __builtin_amdgcn_permlane16_swap(__float_as_uint(x), __float_as_uint(x), false, false);
    x = __uint_as_float(s[0]) + __uint_as_float(s[1]);
    auto t = __builtin_amdgcn_permlane32_swap(__float_as_uint(x), __float_as_uint(x), false, false);
    return __uint_as_float(t[0]) + __uint_as_float(t[1]);
}
#define MFMA16(a, b, c) __builtin_amdgcn_mfma_f32_16x16x32_bf16((a), (b), (c), 0, 0, 0)
template <int NT>
__device__ __forceinline__ void attn_tail(AttnState& S, f32x4 (&sc)[NT], const u32x4 (&vw)[NT / 2][4]) {
    float cm = -__builtin_inff();
#pragma unroll
    for (int t = 0; t < NT; ++t)
#pragma unroll
        for (int j = 0; j < 4; ++j) cm = fmaxf(cm, sc[t][j]);
    cm = xrow16_max(cm);
    const bool need = (fabsf(cm) > 12.0f) && (cm > -1e30f);
    if (__builtin_amdgcn_ballot_w64(need) != 0ull) {
        const float d = need ? cm : 0.f, scl = __builtin_amdgcn_exp2f(-d);
        S.m += d; S.sum *= scl;
#pragma unroll
        for (int dt = 0; dt < 4; ++dt) S.o[dt] = S.o[dt] * scl;
#pragma unroll
        for (int t = 0; t < NT; ++t)
#pragma unroll
            for (int j = 0; j < 4; ++j) sc[t][j] -= d;
    }
    float ps = 0.f;
#pragma unroll
    for (int t = 0; t < NT; ++t)
#pragma unroll
        for (int j = 0; j < 4; ++j) { const float p = __builtin_amdgcn_exp2f(sc[t][j]); sc[t][j] = p; ps += p; }
    S.sum += ps;
#pragma unroll
    for (int ks = 0; ks < NT / 2; ++ks) { u32x4 pw; pw.x = pk2(sc[2 * ks][0], sc[2 * ks][1]); pw.y = pk2(sc[2 * ks][2], sc[2 * ks][3]); pw.z = pk2(sc[2 * ks + 1][0], sc[2 * ks + 1][1]); pw.w = pk2(sc[2 * ks + 1][2], sc[2 * ks + 1][3]);
        const bf16x8 pf = __builtin_bit_cast(bf16x8, pw);
#pragma unroll
        for (int dt = 0; dt < 4; ++dt) S.o[dt] = MFMA16(__builtin_bit_cast(bf16x8, vw[ks][dt]), pf, S.o[dt]); }
}
__device__ __forceinline__ void attn_unit2(const bf16* __restrict__ KQ, const bf16* __restrict__ VT, unsigned char* __restrict__ ATT, LAS unsigned char* lds,
                                           const int b, const int h, const int rowqA, const int rowqB, const bool win, const int r, const int qt, const int lane) {
    const int l15 = lane & 15, g = lane >> 4;
    const f32x4 z = {0.f, 0.f, 0.f, 0.f};
    bf16x8 qA[2], qB[2];
    { const bf16* qp = KQ + (size_t)(rowqA + l15) * 2048 + 1024 + h * 64 + 8 * g; qA[0] = *(const bf16x8*)qp; qA[1] = *(const bf16x8*)(qp + 32); }
    { const bf16* qp = KQ + (size_t)(rowqB + l15) * 2048 + 1024 + h * 64 + 8 * g; qB[0] = *(const bf16x8*)qp; qB[1] = *(const bf16x8*)(qp + 32); }
    AttnState SA, SB; SA.m = 0.f; SA.sum = 0.f; SB.m = 0.f; SB.sum = 0.f;
#pragma unroll
    for (int dt = 0; dt < 4; ++dt) { SA.o[dt] = z; SB.o[dt] = z; }
    if (win) {
        const int rsA = min(max(r - 4, 0), 56), dB = min(max(r - 3, 0), 56) - rsA, kc0 = min(max(16 * qt - 8, 0), 32);
        const int q = 16 * qt + l15, csq = min(max(q - 8, 0), 48);
        const int krow0 = 8 * (l15 >> 2) + (l15 & 3);
        const bf16* kb = KQ + (size_t)(b * SEQ + kc0 + krow0) * 2048 + h * 64 + 8 * g;
        const bf16* vb = VT + (size_t)(b * 1024 + h * 64 + l15) * 4096 + kc0 + 8 * g;
        const LAS float* rp = (const LAS float*)(lds + ALDS_RP);
        const int jb = kc0 + 8 * g;
        const int okb = jb - csq;
        const LAS float* rpl = rp + 16 + (jb - q + 15);
        float madd[2][4];
#pragma unroll
        for (int t = 0; t < 2; ++t)
#pragma unroll
            for (int j = 0; j < 4; ++j) madd[t][j] = ((unsigned)(okb + 4 * t + j) < 16u) ? 0.f : -__builtin_inff();
        bf16x8 K0[2][2], K1[2][2]; u32x4 V0[1][4], V1[1][4];
#define ATT_LOADW(KB, VB, i) do { const int gr_ = min(rsA + (i), 63); const bf16* kp_ = kb + (size_t)(gr_ * 64) * 2048; const bf16* vp_ = vb + gr_ * 64; \
        _Pragma("unroll") for (int t = 0; t < 2; ++t) { KB[t][0] = *(const bf16x8*)(kp_ + (size_t)(4 * t) * 2048); KB[t][1] = *(const bf16x8*)(kp_ + (size_t)(4 * t) * 2048 + 32); } \
        _Pragma("unroll") for (int dt = 0; dt < 4; ++dt) VB[0][dt] = *(const u32x4*)(vp_ + (size_t)(16 * dt) * 4096); } while (0)
#define ATT_ONE(ST, QF, KB, VB, roff, rowok) do { f32x4 sc[2]; \
        const LAS float* bp_ = rpl + ((rowok) ? (roff) : 15) * 64; \
        _Pragma("unroll") for (int t = 0; t < 2; ++t) _Pragma("unroll") for (int j = 0; j < 4; ++j) sc[t][j] = (bp_[4 * t + j] + madd[t][j]) - ST.m;     \
        _Pragma("unroll") for (int t = 0; t < 2; ++t) { sc[t] = MFMA16(KB[t][0], QF[0], sc[t]); sc[t] = MFMA16(KB[t][1], QF[1], sc[t]); } \
        attn_tail<2>(ST, sc, VB); } while (0)
#define ATT_COMPUTE(KB, VB, i) do { const int roffA_ = min(rsA + (i) - r + 7, 14); \
        ATT_ONE(SA, qA, KB, VB, roffA_, (i) <= 7); \
        ATT_ONE(SB, qB, KB, VB, max(roffA_ - 1, 0), (i) >= dB && (i) <= 7 + dB); } while (0)
        ATT_LOADW(K0, V0, 0);
#pragma unroll 1
        for (int i = 0; i < 8; i += 2) { ATT_LOADW(K1, V1, i + 1); ATT_COMPUTE(K0, V0, i); ATT_LOADW(K0, V0, i + 2); ATT_COMPUTE(K1, V1, i + 1); }
        ATT_COMPUTE(K0, V0, 8);
#undef ATT_LOADW
#undef ATT_ONE
#undef ATT_COMPUTE
    }
    { const LAS bf16* ck = (const LAS bf16*)(lds + ALDS_CK) + l15 * ACK_STRIDE + 8 * g;
      const LAS bf16* cv = (const LAS bf16*)(lds + ALDS_CV) + l15 * ACV_STRIDE + 8 * g;
#pragma unroll 1
      for (int c = 0; c < 4; ++c) {
          bf16x8 kf[4][2]; u32x4 vw[2][4];
#pragma unroll
          for (int t = 0; t < 4; ++t) { const LAS bf16* kp = ck + (64 * c + 16 * t) * ACK_STRIDE; kf[t][0] = *(const LAS bf16x8*)kp; kf[t][1] = *(const LAS bf16x8*)(kp + 32); }
#pragma unroll
          for (int ks = 0; ks < 2; ++ks)
#pragma unroll
              for (int dt = 0; dt < 4; ++dt) vw[ks][dt] = *(const LAS u32x4*)(cv + (16 * dt) * ACV_STRIDE + 64 * c + 32 * ks);
          { f32x4 sc[4]; const float nm = -SA.m; const f32x4 c0 = {nm, nm, nm, nm};
#pragma unroll
            for (int t = 0; t < 4; ++t) { sc[t] = MFMA16(kf[t][0], qA[0], c0); sc[t] = MFMA16(kf[t][1], qA[1], sc[t]); }
            attn_tail<4>(SA, sc, vw); }
          { f32x4 sc[4]; const float nm = -SB.m; const f32x4 c0 = {nm, nm, nm, nm};
#pragma unroll
            for (int t = 0; t < 4; ++t) { sc[t] = MFMA16(kf[t][0], qB[0], c0); sc[t] = MFMA16(kf[t][1], qB[1], sc[t]); }
            attn_tail<4>(SB, sc, vw); }
      } }
    { const float inv = 1.0f / xrow16_sum(SA.sum);
#pragma unroll
      for (int dt = 0; dt < 4; ++dt) { const f32x4 o = SA.o[dt] * (inv * ATS); *(unsigned*)(ATT + (size_t)(rowqA + l15) * 1024 + h * 64 + 16 * dt + 4 * g) = pk4_fp8(o[0], o[1], o[2], o[3]); } }
    { const float inv = 1.0f / xrow16_sum(SB.sum);
#pragma unroll
      for (int dt = 0; dt < 4; ++dt) { const f32x4 o = SB.o[dt] * (inv * ATS); *(unsigned*)(ATT + (size_t)(rowqB + l15) * 1024 + h * 64 + 16 * dt + 4 * g) = pk4_fp8(o[0], o[1], o[2], o[3]); } }
}
__device__ __forceinline__ void p_attn_mfma(const Params& P, Frame& F, int l, bool with_ctx_queries, int nblk, int rank) {
    const bf16* KQ = WSP(bf16, WS_KQ); const bf16* VT = WSP(bf16, WS_VT); unsigned char* ATT = WSP(unsigned char, WS_ATT);
    const float* rpb = P.rpb + (size_t)l * 16 * 465;
    const int it0 = (int)(((long)rank * 2048) / nblk), it1 = (int)(((long)(rank + 1) * 2048) / nblk);
    int pcur = -1;
    for (int hp = it0; hp < it1; ++hp) {
        const int p = hp >> 4, eighth = (hp >> 1) & 7, st = hp & 1, b = p >> 4, h = p & 15;
        if (p != pcur) { pcur = p;
        __syncthreads();
        { LAS bf16* ck = (LAS bf16*)(F.lds + ALDS_CK); LAS bf16* cv = (LAS bf16*)(F.lds + ALDS_CV); LAS float* rp = (LAS float*)(F.lds + ALDS_RP);
          { const int key = F.tid >> 1, hf = F.tid & 1; const int k32 = key & 31, pos = (key & ~31) + ((k32 >> 2) & 1) * 16 + 4 * (k32 >> 3) + (k32 & 3);
            const u32x4* src = (const u32x4*)(KQ + (size_t)(RL + b * CTXL + key) * 2048 + h * 64 + hf * 32); LAS u32x4* dst = (LAS u32x4*)(ck + pos * ACK_STRIDE + hf * 32);
#pragma unroll
            for (int i = 0; i < 4; ++i) dst[i] = src[i]; }
          { const int d = F.tid >> 3, sg = F.tid & 7; const u32x4* src = (const u32x4*)(VT + YT_CTX_OFF + (size_t)(b * 1024 + h * 64 + d) * 256 + sg * 32); LAS u32x4* dst = (LAS u32x4*)(cv + d * ACV_STRIDE + sg * 32);
#pragma unroll
            for (int i = 0; i < 4; ++i) dst[i] = src[i]; }
          for (int i = F.tid; i < 16 * 64; i += NTHREADS) { const int rr = i >> 6, cc = (i & 63) - 16; rp[i] = rr == 15 ? -__builtin_inff() : ((cc >= 0 && cc < 31) ? rpb[h * 465 + rr * 31 + cc] * LOG2E : 0.f); } }
        __syncthreads(); }
        const int qt = F.wave & 3, rpi = F.wave >> 2;
        { const int r = eighth * 8 + st * 4 + rpi * 2; const int rowqA = b * SEQ + r * 64 + 16 * qt;
            attn_unit2(KQ, VT, ATT, F.lds, b, h, rowqA, rowqA + 64, true, r, qt, F.lane); }
        if (with_ctx_queries && eighth == 0 && st == 0) { const int rowqA = RL + b * CTXL + 32 * F.wave; attn_unit2(KQ, VT, ATT, F.lds, b, h, rowqA, rowqA + 16, false, 0, 0, F.lane); }
    }
    __syncthreads();
}

__device__ __forceinline__ void ld8(const bf16* p, float (&x)[8]) { const u32x4 w = *(const u32x4*)p;
#pragma unroll
    for (int q = 0; q < 4; ++q) { x[2 * q] = bflo(w[q]); x[2 * q + 1] = bfhi(w[q]); } }
__device__ __forceinline__ void add8(float (&S)[8], u32x4 w, float sg) {
    asm volatile("" : "+v"(w));
#pragma unroll
    for (int q = 0; q < 4; ++q) { S[2 * q] += sg * bflo(w[q]); S[2 * q + 1] += sg * bfhi(w[q]); }
}
template <int HW> __device__ __forceinline__ void pool_item(const bf16* src, bf16* dst, int t0, int Lb) {
    constexpr int NR = 16 + 2 * HW;
    u32x4 x[NR];
#pragma unroll
    for (int r = 0; r < NR; ++r) { const int tt = t0 - HW + r; x[r] = (tt >= 0 && tt < Lb) ? *(const u32x4*)(src + (size_t)tt * 512) : (u32x4){0u, 0u, 0u, 0u}; }
    float S[8];
#pragma unroll
    for (int q = 0; q < 8; ++q) S[q] = 0.f;
#pragma unroll
    for (int r = 0; r < 2 * HW; ++r) add8(S, x[r], 1.f);
#pragma unroll
    for (int j = 0; j < 16; ++j) { const int t = t0 + j; const int lo = max(t - HW, 0), hi = min(t + HW, Lb); const float inv = 1.0f / (float)(hi - lo);
        u32x4 me = x[HW + j]; asm volatile("" : "+v"(me)); u32x4 o;
#pragma unroll
        for (int q = 0; q < 4; ++q) o[q] = pk2(S[2 * q] * inv - bflo(me[q]), S[2 * q + 1] * inv - bfhi(me[q]));
        *(u32x4*)(dst + (size_t)t * 512) = o;
        add8(S, x[2 * HW + j], 1.f); add8(S, x[j], -1.f); }
}
__device__ __forceinline__ void p_pool(Frame& F, int nrows) {
    const bf16* PB = WSP(bf16, WS_PB); bf16* POOL = WSP(bf16, WS_POOL);
    for (int i = F.bid * NTHREADS + F.tid; i < (nrows >> 4) * 64; i += F.G * NTHREADS) {
        const int c16 = i & 15, g = (i >> 6) & 3, row0 = (((i >> 8) << 2) + ((i >> 4) & 3)) << 4, ch = g * 16 + c16;
        int base, t0, Lb; if (row0 < RL) { base = row0 & ~4095; t0 = row0 & 4095; Lb = SEQ; } else { const int rr = row0 - RL; base = RL + (rr & ~255); t0 = rr & 255; Lb = CTXL; }
        const bf16* src = PB + (size_t)base * 512 + ch * 8; bf16* dst = POOL + (size_t)base * 512 + ch * 8;
        if (g == 0) pool_item<1>(src, dst, t0, Lb); else if (g == 1) pool_item<2>(src, dst, t0, Lb); else if (g == 2) pool_item<4>(src, dst, t0, Lb); else pool_item<8>(src, dst, t0, Lb);
    }
}

__device__ __forceinline__ int block_sum_i(int v, LAS int* sm, int tid) {
    v = wave_sum_i(v);
    __syncthreads();
    if ((tid & 63) == 0) sm[tid >> 6] = v;
    __syncthreads();
    int s = 0;
#pragma unroll
    for (int i = 0; i < 8; ++i) s += sm[i];
    return s;
}
__device__ __forceinline__ int block_excl_scan(int v, LAS int* sm, int tid, int& total) {
    const int lane = tid & 63, w = tid >> 6; int inc = v;
#pragma unroll
    for (int o = 1; o < 64; o <<= 1) { const int t = __builtin_amdgcn_ds_bpermute(((lane - o) & 63) << 2, inc); if (lane >= o) inc += t; }
    __syncthreads();
    if (lane == 63) sm[w] = inc;
    __syncthreads();
    int base = 0; total = 0;
#pragma unroll
    for (int i = 0; i < 8; ++i) { const int s = sm[i]; if (i < w) base += s; total += s; }
    return base + inc - v;
}
template <int NPT>
__device__ __forceinline__ void topk_pair(Frame& F, int row0, int n, int cap, int e, int slot0) {
    LAS int* sm = (LAS int*)F.lds;
    const float* AFF = WSP(float, WS_AFF); int* SROW = WSP(int, WS_SROW); float* SG = WSP(float, WS_SGATE); int* SEL = WSP(int, WS_SEL);
    unsigned key[NPT];
#pragma unroll
    for (int j = 0; j < NPT; ++j) { const int i = F.tid * NPT + j; key[j] = (i < n) ? __float_as_uint(AFF[(size_t)(row0 + i) * 16 + e]) : 0u; }
    unsigned T = 0u;
    for (int bit = 30; bit >= 0; --bit) { const unsigned cand = T | (1u << bit); int cnt = 0;
#pragma unroll
        for (int j = 0; j < NPT; ++j) cnt += (key[j] >= cand) ? 1 : 0;
        cnt = block_sum_i(cnt, sm, F.tid);
        if (cnt >= cap) T = cand; }
    int ngt = 0, neq = 0;
#pragma unroll
    for (int j = 0; j < NPT; ++j) { ngt += (key[j] > T) ? 1 : 0; neq += (key[j] == T) ? 1 : 0; }
    int tot_gt, tot_eq;
    (void)block_excl_scan(ngt, sm, F.tid, tot_gt);
    int eqr = block_excl_scan(neq, sm, F.tid, tot_eq);
    const int need_eq = cap - tot_gt;
    int nsel = 0; bool selj[NPT];
#pragma unroll
    for (int j = 0; j < NPT; ++j) { bool s = key[j] > T; if (key[j] == T && T != 0u) { s = eqr < need_eq; ++eqr; } selj[j] = s; nsel += s ? 1 : 0; }
    int tot_sel; int pos = block_excl_scan(nsel, sm, F.tid, tot_sel);
#pragma unroll
    for (int j = 0; j < NPT; ++j) { const int i = F.tid * NPT + j;
        if (i < n) { const int row = row0 + i;
            if (selj[j]) { const int slot = slot0 + pos; ++pos; SROW[slot] = row; SG[slot] = __uint_as_float(key[j]); SEL[(size_t)row * 16 + e] = slot; }
            else SEL[(size_t)row * 16 + e] = -1; } }
    __syncthreads();
}
__device__ __forceinline__ void p_topk(Frame& F, bool with_ctx) {
    const int npairs = 128 + (with_ctx ? 128 : 0);
    for (int pi = F.bid; pi < npairs; pi += F.G) {
        if (pi < 128) { const int b = pi >> 4, e = pi & 15; topk_pair<8>(F, b * SEQ, SEQ, CAPL, e, e * SLOT_E + b * CAPL); }
        else { const int p2 = pi - 128, b = p2 >> 4, e = p2 & 15; topk_pair<1>(F, RL + b * CTXL, CTXL, CAPC, e, e * SLOT_E + 4096 + b * CAPC); }
    }
}
template <int PH> __global__ void __launch_bounds__(NTHREADS, 2) fwd_kernel(Params P) {
    extern __shared__ __attribute__((aligned(16))) unsigned char lds_raw[];
    Frame F; F.lds = (LAS unsigned char*)lds_raw; F.tid = threadIdx.x; F.lane = F.tid & 63; F.wave = __builtin_amdgcn_readfirstlane(F.tid >> 6); F.G = gridDim.x; F.bid = blockIdx.x; F.ws = P.ws;
    const int wave0 = __builtin_amdgcn_readfirstlane((int)threadIdx.x >> 6);
    volatile LAS unsigned* MISC = (volatile LAS unsigned*)(F.lds + LDS_MISC);
    if (F.tid < 64) MISC[F.tid] = 0u;
    __syncthreads();
    XcdBarrier bar; bar.bar = WSP(unsigned, WS_CTL) + CW_BAR; bar.x = 0; bar.st = MISC + 8;
    if constexpr (PH < 0) bar = xcd_barrier_post(WSP(unsigned, WS_CTL) + CW_BAR, MISC + 8);
#define IN(k) (PH < 0 || PH == (k))
#define REFRESH() do { unsigned on_ = ~0u; asm volatile("" : "+s"(on_)); int t_ = wave0 * 64 + (int)__builtin_amdgcn_mbcnt_hi(on_, __builtin_amdgcn_mbcnt_lo(on_, 0u)); asm volatile("" : "+v"(t_)); F.tid = t_; F.lane = t_ & 63; F.wave = __builtin_amdgcn_readfirstlane(t_ >> 6); } while (0)
#define SEAM(k) do { if constexpr (PH < 0) xcd_barrier(bar); } while (0)

    if (IN(0)) { REP_BEGIN(100) p_mod(P, F); p_dftgen(F); REP_END REP_BEGIN(101) p_wconv(P, F, 0, F.bid, F.G, WC_ALL); REP_END }
    SEAM(0);
    if (IN(1)) { p_rftables(P, F); p_rowpass_a0(P, F); }
    SEAM(1);
    for (int l = P.l_lo; l < P.l_hi; ++l) {
        constexpr int pb = 2; const bool L0 = (l == 0);
        bf16* H = WSP(bf16, WS_H);
        if (IN(pb + 0)) { REFRESH(); REP_BEGIN(2)
            const int u1 = 128 * 8 + 8 * (L0 ? 8 : 4), u2a = 128 * 2 + (L0 ? 8 * 2 : 0), u2 = u2a + 128 * 12 + (L0 ? 8 * 12 : 0), u3 = 4 * 128 + (L0 ? 4 * 8 : 0);
            const bf16* H8 = WSP(bf16, WS_H8); const bf16* WA8 = WSP(bf16, WS_WA8);
            { GroupSched S; S.init(1, 128, 8, F.G, F.bid, 8, L0 ? 8 : 4, 128, 0);
              auto AD = [=](const Unit& u) { return Operands{H8 + (size_t)u.pm * 256 * 512, WA8 + (size_t)u.pn * 256 * 512, 512, 512, 0, 512}; };
              bf16* KQ = WSP(bf16, WS_KQ);
              auto E = [=](EPI_ARGS) { const int row0 = u.pm * 256; const float qs = (u.pn >= 4) ? QSCALE * INV8 : INV8;
                  EPI_FOR8( st_bf8(KQ + (size_t)(row0 + r) * 2048 + u.pn * 256 + c, v0 * qs, v1 * qs); ) };
              GEMM_P8(S, AD, E); }
            REFRESH();
            { GroupSched S; S.init(1, 128, 2, F.G, (F.bid + F.G - ((u1 % F.G) & ~7)) % F.G, L0 ? 8 : 0, 2, 128, 0);
              const bf16* WA = WSP(bf16, WS_WA);
              auto AD = [=](const Unit& u) { return Operands{H + (size_t)u.pm * 256 * DM, WA + (size_t)(u.pn + 8) * 256 * DM, DM, DM, 0, DM}; };
              bf16* PBp = WSP(bf16, WS_PB);
              auto E = [=](EPI_ARGS) { const int row0 = u.pm * 256; EPI_FOR8( st_bf8(PBp + (size_t)(row0 + r) * 512 + u.pn * 256 + c, v0, v1); ) };
              GEMM_P(S, AD, E); }
            REFRESH();
            { GroupSched S; S.init(1, 128, 12, F.G, (F.bid + F.G - (((u1 + u2a) % F.G) & ~7)) % F.G, L0 ? 8 : 0, 12, 128, 0);
              bf16* GB = WSP(bf16, WS_GB);
              auto AD = [=](const Unit& u) { return Operands{H8 + (size_t)u.pm * 256 * 512, WA8 + (size_t)(3072 + u.pn * 256) * 512, 512, 512, 0, 512}; };
              auto E = [=](EPI_ARGS) { const int row0 = u.pm * 256;
                  EPI_FOR8( f32x4 s0; f32x4 s1; _Pragma("unroll") for (int j = 0; j < 4; ++j) { s0[j] = sigmoidf_(v0[j] * INV8); s1[j] = sigmoidf_(v1[j] * INV8); } st_bf8(GB + (size_t)(row0 + r) * 3072 + u.pn * 256 + c, s0, s1); ) };
              GEMM_P8(S, AD, E); }
            REFRESH();
            { GroupSched S; S.init(1, 4, 128, F.G, (F.bid + F.G - (((u1 + u2) % F.G) & ~7)) % F.G, L0 ? 4 : 0, 8, 0, 128);
              const bf16* WFV = WSP(bf16, WS_WFV);
              auto AD = [=](const Unit& u) { const bool fmap = (u.pn < 128); const int t16 = u.pn & 15;
                  const size_t tok0 = fmap ? (size_t)(u.pn >> 4) * SEQ + 64 * ((t16 >> 1) * 8) + (t16 & 1) * 32 : (size_t)u.pn * 256;
                  return Operands{WFV + (size_t)u.pm * 256 * DM, H + tok0 * DM, DM, DM, 0, DM, fmap ? 1 : 0}; };
              bf16* YT = WSP(bf16, WS_YT);
              auto E = [=](EPI_ARGS) { const int rr0 = u.pm * 256;
                  if (u.pn < 128) { const int b = u.pn >> 4; const int t16 = u.pn & 15, l10 = (t16 >> 1) * 8, l20 = (t16 & 1) * 32;
                      EPI_FOR8( const int fc = rr0 + r; st_bf8(YT + (((((size_t)b * 512 + (fc >> 1)) * 32 + (c >> 3)) * 2 + (l20 >> 5)) * 2 + (fc & 1)) * 64 + l10, v0, v1); ) }
                  else { const int b = u.pn - 128; EPI_FOR8( st_bf8(YT + YT_CTX_OFF + ((size_t)b * 1024 + rr0 + r) * 256 + c, v0, v1); ) } };
              GEMM_P(S, AD, E); }
            REFRESH();
            { GroupSched S; S.init(1, 4, 128, F.G, (F.bid + F.G - (((u1 + u2 + u3) % F.G) & ~7)) % F.G, 4, 8, 0, 128);
              auto AD = [=](const Unit& u) { return Operands{WA8 + (size_t)(2048 + u.pm * 256) * 512, H8 + (size_t)u.pn * 256 * 512, 512, 512, 0, 512}; };
              bf16* VT = WSP(bf16, WS_VT);
              auto E = [=](EPI_ARGS) { const int rr0 = u.pm * 256;
                  if (u.pn < 128) { const int b = u.pn >> 4, l0 = (u.pn & 15) * 256; EPI_FOR8( st_bf8(VT + ((size_t)b * 1024 + rr0 + r) * 4096 + l0 + c, v0 * INV8, v1 * INV8); ) }
                  else { const int b = u.pn - 128; EPI_FOR8( st_bf8(VT + YT_CTX_OFF + ((size_t)b * 1024 + rr0 + r) * 256 + c, v0 * INV8, v1 * INV8); ) } };
              GEMM_P8(S, AD, E); }
        REP_END }
        SEAM(pb + 0);
        if (IN(pb + 1)) { REFRESH();
            { const int nc0 = F.G * 69 / 256, nconv = nc0 > 0 ? nc0 : 1, na = F.G - nconv;
              if (F.bid < na) p_attn_mfma(P, F, l, L0, na, F.bid);
              else wconv_experts(P, F, l, F.bid - na, nconv); }
            REFRESH();
            REP_BEGIN(32)
            { LAS float* tw = (LAS float*)(F.lds + LDS_TW);
              for (int j = F.tid; j < 4096; j += NTHREADS) tw[j] = cospif((float)j * (1.0f / 2048.0f));
              __syncthreads();
              GroupSched S; S.init(1, 1, 512, F.G, F.bid);
              const bf16* M1 = WSP(bf16, WS_M1T); const bf16* YF = WSP(bf16, WS_YT); bf16* ZP = WSP(bf16, WS_ZP);
              auto AD = [=](const Unit& u) { return Operands{M1, YF + (size_t)u.pn * 256 * 256, 256, 256, 0, 256}; };
              auto E = [=](EPI_ARGS) {
                  const int b = u.pn >> 6, gm0 = (u.pn & 63) * 8 + wc, l20 = 32 * wr + 8 * fq;
#pragma unroll
                  for (int m = 0; m < 4; ++m) { const int k1 = 16 * m + fr;
#pragma unroll
                      for (int bj = 0; bj < 2; ++bj) { const int gm = gm0 + 4 * bj;
                          f32x4 zr[2], zi[2];
#pragma unroll
                          for (int n = 0; n < 2; ++n)
#pragma unroll
                              for (int j = 0; j < 4; ++j) { const int ix = k1 * (l20 + 4 * n + j); const float tc = tw[ix], ts = tw[(ix + 3072) & 4095];
                                  const float ur = acc[0][bj][m][n][j], ui = acc[1][bj][m][n][j]; zr[n][j] = ur * tc - ui * ts; zi[n][j] = ur * ts + ui * tc; }
                          bf16* dst = ZP + (((((size_t)b * 64 + k1) * 128 + (gm & 127)) * 4 + (gm >> 7)) * 2) * 64 + l20;
                          st_bf8(dst, zr[0], zr[1]); st_bf8(dst + 64, zi[0], zi[1]); } } };
              GEMM_P(S, AD, E); }
            REP_END
        }
        SEAM(pb + 1);
        if (IN(pb + 10)) { REFRESH();
            { GroupSched S; S.init(1, L0 ? 136 : 128, 4, F.G, F.bid);
              const bf16* A8 = WSP(bf16, WS_ATT); const bf16* W8 = WSP(bf16, WS_WAO); const bf16* GB = WSP(bf16, WS_GB); bf16* YA = WSP(bf16, WS_KQ);
              auto AD = [=](const Unit& u) { return Operands{A8 + (size_t)u.pm * 256 * 512, W8 + (size_t)u.pn * 256 * 512, 512, 512, 0, 512}; };
              auto E = [=](EPI_ARGS) { const int colb = u.pn * 256 + wc * 32 + 8 * fq;
#pragma unroll
                  for (int ai = 0; ai < 2; ++ai) { u32x4 g0[4][2];
#pragma unroll
                      for (int m = 0; m < 4; ++m)
#pragma unroll
                          for (int bj = 0; bj < 2; ++bj) g0[m][bj] = *(const u32x4*)(GB + ((size_t)u.pm * 256 + ai * 128 + wr * 64 + m * 16 + fr) * 3072 + colb + bj * 128);
#pragma unroll
                      for (int m = 0; m < 4; ++m)
#pragma unroll
                          for (int bj = 0; bj < 2; ++bj) { const u32x4 g = g0[m][bj]; const f32x4 ga = {bflo(g[0]), bfhi(g[0]), bflo(g[1]), bfhi(g[1])}, gb = {bflo(g[2]), bfhi(g[2]), bflo(g[3]), bfhi(g[3])};
                              st_bf8(YA + ((size_t)u.pm * 256 + ai * 128 + wr * 64 + m * 16 + fr) * 1024 + colb + bj * 128, acc[ai][bj][m][0] * ga * INVAT, acc[ai][bj][m][1] * gb * INVAT); } } };
              GEMM_P8(S, AD, E); }
            REFRESH();
            { GroupSched S; S.init(1, 1, 256, F.G, F.bid);
              const bf16* M2 = WSP(bf16, WS_M2T); const bf16* ZP = WSP(bf16, WS_ZP); bf16* FOUR = WSP(bf16, WS_FOUR);
              auto AD = [=](const Unit& u) { return Operands{M2, ZP + (size_t)u.pn * 256 * 512, 512, 512, 0, 512}; };
              auto E = [=](EPI_ARGS) { const float sc = 0.0013810679320049757f;
#pragma unroll
                  for (int ai = 0; ai < 2; ++ai)
#pragma unroll
                      for (int m = 0; m < 4; ++m) { const int q = 2 * ai + wr, k2 = 16 * m + fr;
#pragma unroll
                          for (int bj = 0; bj < 2; ++bj) { const int bk = u.pn * 2 + bj, b = bk >> 6, k1 = bk & 63;
                              st_bf8(FOUR + ((size_t)b * SEQ + k1 + 64 * k2) * 512 + q * 128 + wc * 32 + 8 * fq, acc[ai][bj][m][0] * sc, acc[ai][bj][m][1] * sc); } } };
              GEMM_P(S, AD, E); }
            REFRESH();
            if (L0) { GroupSched S; S.init(1, 1, 16, F.G, (F.bid + F.G - 128 % F.G) % F.G);
              const bf16* DFTC = WSP(bf16, WS_DFTC); const bf16* YTC = WSP(bf16, WS_YT) + YT_CTX_OFF; bf16* FOUR = WSP(bf16, WS_FOUR);
              auto AD = [=](const Unit& u) { return Operands{DFTC, YTC + (size_t)u.pn * 256 * 512, 512, 512, 0, 512}; };
              auto E = [=](EPI_ARGS) { const int b = u.pn >> 1, c0 = (u.pn & 1) * 256; const float sc = 0.005524271728019903f;
                  EPI_FOR8( st_bf8(FOUR + ((size_t)RL + b * CTXL + r) * 512 + c0 + c, v0 * sc, v1 * sc); ) };
              GEMM_P(S, AD, E); }
            REFRESH();
            REP_BEGIN(33) p_pool(F, L0 ? RT : RL); REP_END
        }
        SEAM(pb + 10);
        if (IN(pb + 2)) { REFRESH();
            SegSched<2> S; S.base.init(1, L0 ? 136 : 128, 4, F.G, F.bid);
            const bf16* FOUR = WSP(bf16, WS_FOUR); const bf16* POOL = WSP(bf16, WS_POOL); const bf16* WFO = WSP(bf16, WS_WFO); const bf16* WPO = WSP(bf16, WS_WPO);
            const bf16* GB = WSP(bf16, WS_GB); const bf16* YA = WSP(bf16, WS_KQ); bf16* MRGB = WSP(bf16, WS_MRGB); const float* ps = P.pool_scale + l * 1024;
            auto AD = [=](const Unit& u) {
                if (u.seg == 0) return Operands{FOUR + (size_t)u.pm * 256 * 512, WFO + (size_t)u.pn * 256 * 512, 512, 512, 0, 512};
                return Operands{POOL + (size_t)u.pm * 256 * 512 + (u.pn >> 1) * 256, WPO + (size_t)u.pn * 256 * 256, 512, 256, 0, 256}; };
            auto E = [=](EPI_ARGS) {
                const bool fin = (u.seg == 1); const int colb = u.pn * 256 + wc * 32 + 8 * fq;
                f32x4 psv[2][2];
#pragma unroll
                for (int bj = 0; bj < 2; ++bj)
#pragma unroll
                    for (int n = 0; n < 2; ++n) { f32x4 p = *(const f32x4*)(ps + colb + bj * 128 + 4 * n);
#pragma unroll
                        for (int j = 0; j < 4; ++j) p[j] = (fabsf(p[j]) < 1e-18f) ? copysignf(1e-18f, p[j]) : p[j];
                        psv[bj][n] = p; }
#pragma unroll
                for (int ai = 0; ai < 2; ++ai)
#pragma unroll
                    for (int m = 0; m < 4; ++m) { const size_t row = (size_t)u.pm * 256 + ai * 128 + wr * 64 + m * 16 + fr; const bf16* gr = GB + row * 3072 + colb;
                        u32x4 g1r[2], g2r[2], yar[2];
#pragma unroll
                        for (int bj = 0; bj < 2; ++bj) { g2r[bj] = *(const u32x4*)(gr + 2048 + bj * 128); if (fin) yar[bj] = *(const u32x4*)(YA + row * 1024 + colb + bj * 128); else g1r[bj] = *(const u32x4*)(gr + 1024 + bj * 128); }
#pragma unroll
                        for (int bj = 0; bj < 2; ++bj) { f32x4 o[2];
#pragma unroll
                            for (int n = 0; n < 2; ++n) { const u32x4 xr = fin ? yar[bj] : g1r[bj];
                                const f32x4 g2 = (f32x4){fmaxf(bflo(g2r[bj][2 * n]), 1e-18f), fmaxf(bfhi(g2r[bj][2 * n]), 1e-18f), fmaxf(bflo(g2r[bj][2 * n + 1]), 1e-18f), fmaxf(bfhi(g2r[bj][2 * n + 1]), 1e-18f)} * psv[bj][n];
                                const f32x4 x = {bflo(xr[2 * n]), bfhi(xr[2 * n]), bflo(xr[2 * n + 1]), bfhi(xr[2 * n + 1])};
#pragma unroll
                                for (int j = 0; j < 4; ++j) o[n][j] = fin ? (x[j] + acc[ai][bj][m][n][j] * g2[j]) : (acc[ai][bj][m][n][j] * x[j] * __builtin_amdgcn_rcpf(g2[j]));
                                acc[ai][bj][m][n] = o[n]; }
                            if (fin) st_bf8(MRGB + row * 1024 + colb + bj * 128, o[0], o[1]); } } };
            gemm_fast<false, true, false>(F.lds, F.tid, S, AD, mk_epi_seg(E, 1), nullptr);
            if (L0) { const int nun = 136 * 4, busy = nun - ((nun - 1) / F.G) * F.G;
                if (busy < F.G && F.bid >= busy) p_wconv(P, F, 1, F.bid - busy, F.G - busy, WC_IN); }
        }
        SEAM(pb + 2);
        if (IN(pb + 3)) { REFRESH();
            GroupSched S; S.init(1, L0 ? 136 : 128, 4, F.G, F.bid); const bf16* A = WSP(bf16, WS_MRGB); const bf16* W = WSP(bf16, WS_WOUT);
            bf16* XB = WSP(bf16, WS_XB); const float* MOD = WSP(float, WS_MOD) + (size_t)l * 9 * 6144;
            auto AD = [=](const Unit& u) { return Operands{A + (size_t)u.pm * 256 * 1024, W + (size_t)u.pn * 256 * 1024, 1024, 1024, 0, 1024}; };
            auto E = [=](EPI_ARGS) {
                const int row0 = u.pm * 256, mr = row0 < RL ? (row0 >> 12) : 8, colb = u.pn * 256 + wc * 32 + 8 * fq;
                bf16* dst0 = XB + (size_t)row0 * DM;
                f32x4 gv[2][2];
#pragma unroll
                for (int bj = 0; bj < 2; ++bj)
#pragma unroll
                    for (int n = 0; n < 2; ++n) gv[bj][n] = *(const f32x4*)(MOD + (size_t)mr * 6144 + 2048 + colb + bj * 128 + 4 * n);
                if (L0) { const float* src0 = row0 < RL ? P.x + (size_t)row0 * DM : P.ctx + (size_t)(row0 - RL) * DM;
#pragma unroll
                    for (int am = 0; am < 4; ++am) { const int ai = am >> 1, mh = (am & 1) * 2; f32x4 xv[2][2][2];
#pragma unroll
                        for (int m = 0; m < 2; ++m) { const size_t ro = (size_t)(ai * 128 + wr * 64 + (mh + m) * 16 + fr) * DM + colb;
#pragma unroll
                            for (int bj = 0; bj < 2; ++bj)
#pragma unroll
                                for (int n = 0; n < 2; ++n) xv[m][bj][n] = *(const f32x4*)(src0 + ro + bj * 128 + 4 * n); }
#pragma unroll
                        for (int m = 0; m < 2; ++m) { const size_t ro = (size_t)(ai * 128 + wr * 64 + (mh + m) * 16 + fr) * DM + colb;
#pragma unroll
                            for (int bj = 0; bj < 2; ++bj) st_bf8(dst0 + ro + bj * 128, xv[m][bj][0] + gv[bj][0] * acc[ai][bj][mh + m][0], xv[m][bj][1] + gv[bj][1] * acc[ai][bj][mh + m][1]); } }
                } else {
#pragma unroll
                    for (int ai = 0; ai < 2; ++ai) { u32x4 xr[4][2];
#pragma unroll
                        for (int m = 0; m < 4; ++m) { const size_t ro = (size_t)(ai * 128 + wr * 64 + m * 16 + fr) * DM + colb;
#pragma unroll
                            for (int bj = 0; bj < 2; ++bj) xr[m][bj] = *(const u32x4*)(dst0 + ro + bj * 128); }
#pragma unroll
                        for (int m = 0; m < 4; ++m) { const size_t ro = (size_t)(ai * 128 + wr * 64 + m * 16 + fr) * DM + colb;
#pragma unroll
                            for (int bj = 0; bj < 2; ++bj) { const u32x4 x = xr[m][bj]; const f32x4 xa = {bflo(x[0]), bfhi(x[0]), bflo(x[1]), bfhi(x[1])}, xb = {bflo(x[2]), bfhi(x[2]), bflo(x[3]), bfhi(x[3])};
                                st_bf8(dst0 + ro + bj * 128, xa + gv[bj][0] * acc[ai][bj][m][0], xb + gv[bj][1] * acc[ai][bj][m][1]); } } } } };
            GEMM_P(S, AD, E);
            if (L0) { const int nun = 136 * 4, busy = nun - ((nun - 1) / F.G) * F.G;
                if (busy < F.G && F.bid >= busy) p_wconv(P, F, 1, F.bid - busy, F.G - busy, WC_FO); }
        }
        SEAM(pb + 3);
        if (IN(pb + 4)) { REFRESH(); REP_BEGIN(6) p_rowpass_f(P, F, l, L0 ? RT : RL); REP_END }
        SEAM(pb + 4);
        if (IN(pb + 5)) { REFRESH(); REP_BEGIN(7) p_topk(F, L0); REP_END }
        SEAM(pb + 5);
        if (IN(pb + 7)) { REFRESH(); REP_BEGIN(9)
            GroupSched S; S.init(16, L0 ? 17 : 16, 22, F.G, F.bid); const bf16* H8 = WSP(bf16, WS_H8); const bf16* W = WSP(bf16, WS_WGU); unsigned char* HID = WSP(unsigned char, WS_HID); const int* SROW = WSP(int, WS_SROW);
            auto AD = [=](const Unit& u) { return Operands{H8, W + ((size_t)u.grp * 5632 + u.pn * 256) * 512, 512, 512, u.grp * SLOT_E + u.pm * 256, 512}; };
            auto E = [=](EPI_ARGS) {
#pragma unroll
                for (int ai = 0; ai < 2; ++ai)
#pragma unroll
                    for (int m = 0; m < 4; ++m) { const size_t slot = (size_t)u.grp * SLOT_E + u.pm * 256 + ai * 128 + wr * 64 + m * 16 + fr; f32x4 o[2];
#pragma unroll
                        for (int n = 0; n < 2; ++n) { const f32x4 a = acc[ai][0][m][n] * INV8, up = acc[ai][1][m][n] * (INV8 * A8S);
#pragma unroll
                            for (int j = 0; j < 4; ++j) o[n][j] = a[j] * sigmoidf_(a[j]) * up[j]; }
                        u32x2 w; w.x = pk4_fp8(o[0][0], o[0][1], o[0][2], o[0][3]); w.y = pk4_fp8(o[1][0], o[1][1], o[1][2], o[1][3]);
                        *(u32x2*)(HID + slot * FF + u.pn * 128 + wc * 32 + 8 * fq) = w; } };
            GEMM_GATHER8(S, AD, E, SROW);
        REP_END }
        SEAM(pb + 7);
        if (IN(pb + 8)) { REFRESH(); REP_BEGIN(10)
            const int tpe = L0 ? 17 : 16;
            GroupSched S; S.init(1, 16 * tpe, 4, F.G, F.bid); const bf16* HID = WSP(bf16, WS_HID); const bf16* W = WSP(bf16, WS_WD); bf16* Y = WSP(bf16, WS_Y); const float* SG = WSP(float, WS_SGATE);
            auto AD = [=](const Unit& u) { const int e = u.pm / tpe, st = e * 17 + (u.pm - e * tpe); return Operands{HID + (size_t)st * 256 * (FF / 2), W + ((size_t)e * 1024 + u.pn * 256) * (FF / 2), FF / 2, FF / 2, 0, FF / 2}; };
            auto E = [=](EPI_ARGS) { const int e = u.pm / tpe; const size_t slot0 = (size_t)(e * 17 + (u.pm - e * tpe)) * 256 + wr * 64 + fr; float gt[2][4];
#pragma unroll
                for (int ai = 0; ai < 2; ++ai)
#pragma unroll
                    for (int m = 0; m < 4; ++m) gt[ai][m] = SG[slot0 + ai * 128 + m * 16] * INV8;
#pragma unroll
                for (int ai = 0; ai < 2; ++ai)
#pragma unroll
                    for (int m = 0; m < 4; ++m)
#pragma unroll
                        for (int bj = 0; bj < 2; ++bj) st_bf8(Y + (slot0 + ai * 128 + m * 16) * DM + u.pn * 256 + bj * 128 + wc * 32 + 8 * fq, acc[ai][bj][m][0] * gt[ai][m], acc[ai][bj][m][1] * gt[ai][m]); };
            GEMM_P8(S, AD, E);
        REP_END }
        SEAM(pb + 8);
        if (IN(pb + 9)) { REFRESH(); p_rowpass_k(P, F, l, L0 ? RT : RL); if (L0) p_wconv(P, F, 1, F.bid, F.G, WC_OUT); }
        if (L0) SEAM(pb + 9);
    }
#undef IN
#undef SEAM
}
template <int PH> static void launch_ph(int grid, const Params& p, hipStream_t stream) { hipLaunchKernelGGL(fwd_kernel<PH>, dim3(grid), dim3(NTHREADS), LDS_BYTES, stream, p); }
template <int PH> static bool set_attr() { return hipFuncSetAttribute((const void*)fwd_kernel<PH>, hipFuncAttributeMaxDynamicSharedMemorySize, LDS_BYTES) == hipSuccess; }

#ifndef DUP_LAUNCH
#define DUP_LAUNCH -1
#endif
extern "C" void kernel_launch(void* const* d_in, const int* in_sizes, int n_in, void* d_out, int out_size, void* d_ws, size_t ws_size, hipStream_t stream) {
    static int grid = 0;
    if (grid == 0) {
        if (n_in != 20 || out_size != RL * DM || ws_size < WS_END) { fprintf(stderr, "kernel_launch: unexpected shapes (n_in %d out %d ws %zu need %zu)\n", n_in, out_size, ws_size, (size_t)WS_END); grid = -1; return; }
        int dev = 0, cus = 0, per_cu = 0;
        if (hipGetDevice(&dev) != hipSuccess || hipDeviceGetAttribute(&cus, hipDeviceAttributeMultiprocessorCount, dev) != hipSuccess) { grid = -1; return; }
#if N_LAUNCH_MODE == 1
        if (!set_attr<-1>()) { fprintf(stderr, "kernel_launch: hipFuncSetAttribute failed\n"); grid = -1; return; }
        if (hipOccupancyMaxActiveBlocksPerMultiprocessor(&per_cu, (const void*)fwd_kernel<-1>, NTHREADS, LDS_BYTES) != hipSuccess || per_cu < 1) fprintf(stderr, "kernel_launch: occupancy query reports %d\n", per_cu);
#else
        if (!(set_attr<0>() && set_attr<1>() && set_attr<2>() && set_attr<3>() && set_attr<12>() && set_attr<4>() && set_attr<5>() && set_attr<6>() && set_attr<7>() && set_attr<9>() && set_attr<10>() && set_attr<11>())) { fprintf(stderr, "kernel_launch: hipFuncSetAttribute failed\n"); grid = -1; return; }
        (void)per_cu;
#endif
        (void)hipGetLastError();
        grid = cus;
    }
    if (grid < 0) return;
    if (hipMemsetAsync((char*)d_ws + WS_CTL, 0, CTL_BYTES, stream) != hipSuccess) return;
    Params p{};
    const float** pp = (const float**)&p;
    for (int i = 0; i < 20; ++i) pp[i] = (const float*)d_in[i];
    p.out = (float*)d_out; p.ws = (unsigned char*)d_ws;
#if N_LAUNCH_MODE == 1
    p.l_lo = 0; p.l_hi = 2;
    launch_ph<-1>(grid, p, stream);
#else
    p.l_lo = 0; p.l_hi = 0; launch_ph<0>(grid, p, stream); if (DUP_LAUNCH == 0) launch_ph<0>(grid, p, stream); launch_ph<1>(grid, p, stream); if (DUP_LAUNCH == 1) launch_ph<1>(grid, p, stream);
#define LP(k) do { launch_ph<k>(grid, p, stream); if (DUP_LAUNCH == (k) && l == 0) launch_ph<k>(grid, p, stream); } while (0)
    for (int l = 0; l < 2; ++l) { p.l_lo = l; p.l_hi = l + 1;
        LP(2); LP(3); LP(12); LP(4); LP(5); LP(6); LP(7); LP(9); LP(10); LP(11); }
#endif
}
```

```cpp
#include <hip/hip_runtime.h>
#include <cstdio>
#include <cstdint>

#ifndef N_LAUNCH_MODE
#define N_LAUNCH_MODE 1
#endif

#define GAS __attribute__((address_space(1)))
#define LAS __attribute__((address_space(3)))
typedef unsigned short bf16;
typedef short bf16x8 __attribute__((ext_vector_type(8)));
typedef float f32x4 __attribute__((ext_vector_type(4)));
typedef unsigned u32x4 __attribute__((ext_vector_type(4)));
typedef unsigned u32x2 __attribute__((ext_vector_type(2)));

constexpr int NB = 8, SEQ = 4096, DM = 1024, CTXL = 256, NH = 16, HD = 64, GRIDW = 64;
constexpr int RL = NB * SEQ, RC = NB * CTXL, RT = RL + RC;
constexpr int INW = 7168, NE = 16, FF = 2816, CAPL = 512, CAPC = 32;
constexpr int SLOT_E = 4352, NSLOT = NE * SLOT_E;
constexpr float RMS_EPS = 1e-6f;
constexpr float LOG2E = 1.4426950408889634f, QSCALE = 0.125f * LOG2E;
constexpr float A8S = 8.0f, W8S = 64.0f, INV8 = 1.0f / (A8S * W8S);
constexpr float ATS = 32.0f, INVAT = 1.0f / (ATS * W8S);
constexpr int NWAVES = 8, NTHREADS = 512;

constexpr size_t al256(size_t x) { return (x + 255) & ~(size_t)255; }
constexpr size_t WS_CTL = 0, CTL_BYTES = 1u << 20;
constexpr size_t WS_MOD = WS_CTL + CTL_BYTES;
constexpr size_t WS_XC = al256(WS_MOD + (size_t)2 * 9 * 6144 * 4);
constexpr size_t WS_AFF = al256(WS_XC + (size_t)RC * DM * 4);
constexpr size_t WS_SROW = al256(WS_AFF + (size_t)RT * 16 * 4);
constexpr size_t WS_SGATE = al256(WS_SROW + (size_t)NSLOT * 4);
constexpr size_t WS_SEL = al256(WS_SGATE + (size_t)NSLOT * 4);
constexpr size_t WS_DFTM = al256(WS_SEL + (size_t)RT * 16 * 4);
constexpr size_t WS_DFTC = al256(WS_DFTM + (size_t)4096 * 8192 * 2);
constexpr size_t WS_WA = al256(WS_DFTC + (size_t)256 * 512 * 2);
constexpr size_t WS_WFV = al256(WS_WA + (size_t)5632 * 1024 * 2);
constexpr size_t WS_WAO = al256(WS_WFV + (size_t)2048 * 1024 * 2);
constexpr size_t WS_WFO = al256(WS_WAO + (size_t)1024 * 1024 * 2);
constexpr size_t WS_WPO = al256(WS_WFO + (size_t)1024 * 512 * 2);
constexpr size_t WS_WOUT = al256(WS_WPO + (size_t)1024 * 256 * 2);
constexpr size_t WS_WGU = al256(WS_WOUT + (size_t)1024 * 1024 * 2);
constexpr size_t WS_WD = al256(WS_WGU + (size_t)16 * 5632 * 1024);
constexpr size_t WS_WA8 = al256(WS_WD + (size_t)16 * 1024 * 2816);
constexpr size_t WS_H = al256(WS_WA8 + (size_t)6144 * 1024);
constexpr size_t WS_H8 = al256(WS_H + (size_t)RT * DM * 2);
constexpr size_t WS_R = al256(WS_H8 + (size_t)RT * DM);
constexpr size_t WS_KQ = WS_R;
constexpr size_t WS_MRG = WS_KQ;
constexpr size_t WS_PB = al256(WS_KQ + (size_t)RT * 2048 * 2);
constexpr size_t WS_GB = al256(WS_PB + (size_t)RT * 512 * 2);
constexpr size_t WS_YT = al256(WS_GB + (size_t)RT * 3072 * 2);
constexpr size_t WS_MRGB = WS_YT;
constexpr size_t WS_VT = al256(WS_YT + (size_t)RT * 1024 * 2);
constexpr size_t WS_FOUR = al256(WS_VT + (size_t)RT * 1024 * 2);
constexpr size_t WS_ATT = al256(WS_FOUR + (size_t)RT * 512 * 2);
constexpr size_t WS_POOL = al256(WS_ATT + (size_t)RT * 1024 * 2);
constexpr size_t WS_MIX_END = al256(WS_POOL + (size_t)RT * 512 * 2);
constexpr size_t WS_XG = WS_R;
constexpr size_t WS_HID = al256(WS_XG + (size_t)NSLOT * 1024 * 2);
constexpr size_t WS_Y = al256(WS_HID + (size_t)NSLOT * 2816);
constexpr size_t WS_MOE_END = al256(WS_Y + (size_t)NSLOT * 1024 * 2);
constexpr size_t WS_END0 = WS_MIX_END > WS_MOE_END ? WS_MIX_END : WS_MOE_END;
constexpr size_t WS_ZP = WS_END0;
constexpr size_t WS_M1T = al256(WS_ZP + ((size_t)8 * 64 * 512 * 128 + 1024) * 2);
constexpr size_t WS_M2T = al256(WS_M1T + (size_t)256 * 256 * 2);
constexpr size_t WS_XB = al256(WS_M2T + (size_t)256 * 512 * 2);
constexpr int RF_PITCH = 1032, RF_TBL = 2 * 16 * RF_PITCH * 2 + 4096 + 4096 + 64;
constexpr size_t WS_RFT = al256(WS_XB + (size_t)RT * DM * 2);
constexpr size_t WS_WGU1 = al256(WS_RFT + (size_t)18 * RF_TBL);
constexpr size_t WS_WD1 = al256(WS_WGU1 + (size_t)16 * 5632 * 1024);
constexpr size_t WS_END = al256(WS_WD1 + (size_t)16 * 1024 * 2816);
static_assert(WS_END <= (size_t)1400 * 1024 * 1024, "workspace map exceeds the guaranteed scratch size (>= sum of the inputs)");
constexpr size_t YT_CTX_OFF = (size_t)8 * 1024 * 4096;

constexpr int CW_BAR = 4096;

constexpr int LDS_BYTES = 155648;
constexpr int LDS_TW = 132096;
constexpr int LDS_MISC = 131072;

__device__ __forceinline__ unsigned f2bf(float f) { unsigned u = __float_as_uint(f); return (u + 0x7fffu + ((u >> 16) & 1u)) >> 16; }
typedef __bf16 hbf16x2 __attribute__((ext_vector_type(2)));
typedef float f32x2 __attribute__((ext_vector_type(2)));
__device__ __forceinline__ unsigned pk2(float lo, float hi) { const f32x2 v = {lo, hi}; return __builtin_bit_cast(unsigned, __builtin_convertvector(v, hbf16x2)); }
__device__ __forceinline__ unsigned pk4_fp8(float a, float b, float c, float d) {
    a = __builtin_amdgcn_fmed3f(a, -448.f, 448.f); b = __builtin_amdgcn_fmed3f(b, -448.f, 448.f); c = __builtin_amdgcn_fmed3f(c, -448.f, 448.f); d = __builtin_amdgcn_fmed3f(d, -448.f, 448.f);
    int w = 0; w = __builtin_amdgcn_cvt_pk_fp8_f32(a, b, w, false); w = __builtin_amdgcn_cvt_pk_fp8_f32(c, d, w, true); return (unsigned)w; }
__device__ __forceinline__ float bf2f(unsigned b) { return __uint_as_float(b << 16); }
__device__ __forceinline__ float bflo(unsigned w) { return __uint_as_float(w << 16); }
__device__ __forceinline__ float bfhi(unsigned w) { return __uint_as_float(w & 0xffff0000u); }
template <int CTRL> __device__ __forceinline__ float dppf(float x) { return __builtin_bit_cast(float, __builtin_amdgcn_mov_dpp(__builtin_bit_cast(int, x), CTRL, 0xf, 0xf, true)); }
template <int CTRL> __device__ __forceinline__ int dppi(int x) { return __builtin_amdgcn_mov_dpp(x, CTRL, 0xf, 0xf, true); }
constexpr int DPP_XOR1 = 0xB1, DPP_XOR2 = 0x4E, DPP_ROR4 = 0x124, DPP_ROR8 = 0x128;
__device__ __forceinline__ float wave_sum(float v) {
    v += dppf<DPP_XOR1>(v); v += dppf<DPP_XOR2>(v); v += dppf<DPP_ROR4>(v); v += dppf<DPP_ROR8>(v);
    auto s = __builtin_amdgcn_permlane16_swap(__float_as_uint(v), __float_as_uint(v), false, false); v = __uint_as_float(s[0]) + __uint_as_float(s[1]);
    auto t = __builtin_amdgcn_permlane32_swap(__float_as_uint(v), __float_as_uint(v), false, false); return __uint_as_float(t[0]) + __uint_as_float(t[1]);
}
__device__ __forceinline__ float wave_max(float v) {
    v = fmaxf(v, dppf<DPP_XOR1>(v)); v = fmaxf(v, dppf<DPP_XOR2>(v)); v = fmaxf(v, dppf<DPP_ROR4>(v)); v = fmaxf(v, dppf<DPP_ROR8>(v));
    auto s = __builtin_amdgcn_permlane16_swap(__float_as_uint(v), __float_as_uint(v), false, false); v = fmaxf(__uint_as_float(s[0]), __uint_as_float(s[1]));
    auto t = __builtin_amdgcn_permlane32_swap(__float_as_uint(v), __float_as_uint(v), false, false); return fmaxf(__uint_as_float(t[0]), __uint_as_float(t[1]));
}
__device__ __forceinline__ int wave_sum_i(int v) {
    v += dppi<DPP_XOR1>(v); v += dppi<DPP_XOR2>(v); v += dppi<DPP_ROR4>(v); v += dppi<DPP_ROR8>(v);
    auto s = __builtin_amdgcn_permlane16_swap((unsigned)v, (unsigned)v, false, false); v = (int)(s[0] + s[1]);
    auto t = __builtin_amdgcn_permlane32_swap((unsigned)v, (unsigned)v, false, false); return (int)(t[0] + t[1]);
}
__device__ __forceinline__ float sigmoidf_(float x) { return __builtin_amdgcn_rcpf(1.f + __builtin_amdgcn_exp2f(x * -1.4426950408889634f)); }
#define LDS_WAIT() asm volatile("s_waitcnt lgkmcnt(0)" ::: "memory")

#define XB_TMO      128
#define XB_XCNT(j)  (256  + 64 * (j))
#define XB_XSUB(j)  (1280 + 64 * (j))
#define XB_XGEN(j)  (2304 + 64 * (j))
#define XB_TOP      3328
#define XB_TOPGEN   3392
#define XCD_BAR_WORDS 3456
#define XB_SPIN_CAP (1u << 22)

__device__ __forceinline__ unsigned xb_ld(unsigned* p)              { return __hip_atomic_load(p, __ATOMIC_RELAXED, __HIP_MEMORY_SCOPE_AGENT); }
__device__ __forceinline__ unsigned xb_add(unsigned* p, unsigned v) { return __hip_atomic_fetch_add(p, v, __ATOMIC_RELAXED, __HIP_MEMORY_SCOPE_AGENT); }
__device__ __forceinline__ unsigned xb_xcc_id() { return (unsigned)__builtin_amdgcn_s_getreg((3 << 11) | 20) & 0xFu; }
#define XB_SPIN(cond, bar) do { unsigned _sp = 0; while (cond) { __builtin_amdgcn_s_sleep(1); \
    if ((++_sp & 255u) == 0u) { if (xb_ld(&(bar)[XB_TMO])) break; if (_sp > XB_SPIN_CAP) { atomicAdd(&(bar)[XB_TMO], 1u); break; } } } } while (0)

struct XcdBarrier { unsigned* bar; unsigned x; volatile LAS unsigned* st; };

__device__ __forceinline__ XcdBarrier xcd_barrier_post(unsigned* bar, volatile LAS unsigned* st) {
    XcdBarrier b; b.bar = bar; b.x = xb_xcc_id(); b.st = st;
    if (threadIdx.x == 0) (void)xb_add(&bar[XB_XCNT(b.x)], 1u);
    return b;
}
__device__ __forceinline__ void xcd_barrier_complete(unsigned* bar, unsigned x, unsigned& nloc, unsigned& nx) {
    const unsigned G = gridDim.x * gridDim.y * gridDim.z;
    unsigned sum, cnt, mine, sp = 0u;
    for (;;) {
        sum = 0u; cnt = 0u; mine = 0u;
#pragma unroll
        for (unsigned j = 0; j < 16; ++j) { const unsigned c = xb_ld(&bar[XB_XCNT(j)]); sum += c; cnt += (c > 0u) ? 1u : 0u; mine = (j == x) ? c : mine; }
        if (sum == G) break;
        __builtin_amdgcn_s_sleep(1);
        if ((++sp & 255u) == 0u) { if (xb_ld(&bar[XB_TMO])) break; if (sp > XB_SPIN_CAP) { atomicAdd(&bar[XB_TMO], 1u); break; } }
    }
    nloc = mine > 0u ? mine : 1u; nx = cnt > 0u ? cnt : 1u;
}
__device__ __forceinline__ void xcd_barrier(const XcdBarrier& b) {
    asm volatile("s_waitcnt vmcnt(0)" ::: "memory");
    __syncthreads();
    if (threadIdx.x == 0) {
        unsigned* bar = b.bar;
        __builtin_amdgcn_s_waitcnt(0);
        unsigned nloc = b.st[0], nx = b.st[1];
        if (nloc == 0u) { xcd_barrier_complete(bar, b.x, nloc, nx); b.st[0] = nloc; b.st[1] = nx; }
        const unsigned old = xb_add(&bar[XB_XSUB(b.x)], 1u);
        const unsigned gen = old / nloc;
        if (old + 1u == (gen + 1u) * nloc) {
            __builtin_amdgcn_fence(__ATOMIC_RELEASE, "agent");
            asm volatile("s_waitcnt vmcnt(0)" ::: "memory");
            const unsigned og = xb_add(&bar[XB_TOP], 1u);
            const unsigned tg = og / nx;
            if (og + 1u == (tg + 1u) * nx) xb_add(&bar[XB_TOPGEN], 1u);
            else XB_SPIN(xb_ld(&bar[XB_TOPGEN]) == tg, bar);
            __builtin_amdgcn_fence(__ATOMIC_ACQUIRE, "agent");
            xb_add(&bar[XB_XGEN(b.x)], 1u);
            asm volatile("s_waitcnt vmcnt(0)" ::: "memory");
        } else {
            XB_SPIN(xb_ld(&bar[XB_XGEN(b.x)]) == gen, bar);
            __builtin_amdgcn_fence(__ATOMIC_ACQUIRE, "agent");
            asm volatile("s_waitcnt vmcnt(0)" ::: "memory");
        }
    }
    __syncthreads();
}

struct Params {
    const float *x, *c, *ctx, *c_ctx, *ada_w, *ada_b, *norm1_g, *norm2_g, *w_in, *rpb, *w_att_o, *w_fourier, *w_pool, *pool_scale, *w_out, *w_router, *w_eg, *w_eu, *w_ed, *final_g;
    float* out; unsigned char* ws; int l_lo, l_hi;
};
struct Frame {
    LAS unsigned char* lds;
    int tid, lane, wave, G, bid;
    unsigned char* ws;
};
#define WSP(T, off) ((T*)(F.ws + (off)))

struct Unit { int grp, pm, pn, seg; };
struct GroupSched {
    int ng, nM, nN, G, c; int tM, tN, tpm0, tpn0;
    __device__ __forceinline__ void init(int ng_, int nM_, int nN_, int G_, int c_, int tM_ = 0, int tN_ = 0, int tpm0_ = 0, int tpn0_ = 0) { ng = ng_; nM = nM_; nN = nN_; G = G_; c = c_; tM = tM_; tN = tN_; tpm0 = tpm0_; tpn0 = tpn0_; }
    __device__ __forceinline__ bool next(int i, Unit& u) const {
        const int per = nM * nN; const int L = i * G + c;
        if (L < ng * per) {
            u.grp = L / per; int wgid = L - u.grp * per;
            { const int q = per / 8, r = per % 8, xcd = wgid % 8, off = wgid / 8; wgid = (xcd < r ? xcd * (q + 1) : r * (q + 1) + (xcd - r) * q) + off; }
            const int nig = 8 * nN, gid = wgid / nig, fm = gid * 8, gsz = (nM - fm) < 8 ? (nM - fm) : 8;
            u.pm = fm + ((wgid % nig) % gsz); u.pn = (wgid % nig) / gsz; u.seg = 0; return true;
        }
        const int w = L - ng * per;
        if (w < tM * tN) { u.grp = ng; u.pm = tpm0 + (w % tM); u.pn = tpn0 + (w / tM); u.seg = 0; return true; }
        return false;
    }
};
struct Operands { const bf16* A; const bf16* Bt; int lda, ldb, slot0, K; int bmap; };

constexpr int HTB = 128 * 64 * 2;
__device__ __forceinline__ int lds_byte(int r, int c) { const int st = (r >> 4) * 2 + (c >> 5), rr = r & 15, cc = c & 31, ob = rr * 64 + cc * 2; return st * 1024 + (ob ^ (((ob >> 9) & 1) << 5)); }
__device__ __forceinline__ int perm32(int rho) { const int n = rho >> 4, i = rho & 15; return 8 * (i >> 2) + 4 * n + (i & 3); }
__device__ __forceinline__ void stage_rc(int b, int& R, int& C) { const int st = b / 1024, sb = b % 1024, swz = sb ^ (((sb >> 9) & 1) << 5); R = (st >> 1) * 16 + swz / 64; C = (st & 1) * 32 + (swz % 64) / 2; }
typedef int i32x8 __attribute__((ext_vector_type(8)));
typedef int i32x4 __attribute__((ext_vector_type(4)));
__device__ __forceinline__ i32x8 cat8(bf16x8 lo, bf16x8 hi) { const i32x4 a = __builtin_bit_cast(i32x4, lo), b = __builtin_bit_cast(i32x4, hi); return (i32x8){a[0], a[1], a[2], a[3], b[0], b[1], b[2], b[3]}; }
template <bool GATHER, bool PERM, bool FP8, class Sched, class Addr, class Epi>
__device__ __forceinline__ void gemm_fast(LAS unsigned char* lds, const int tid, const Sched& S, const Addr& AD, const Epi& E, const int* __restrict__ grows) {
    const int wid = __builtin_amdgcn_readfirstlane(tid >> 6), lane = tid & 63, wr = wid >> 2, wc = wid & 3, fr = lane & 15, fq = lane >> 4;
    unsigned cvg[2][2], nvg[2][2], cvb[2][2], nvb[2][2];
#define PG8_RC(i_) int R_, C_; stage_rc(tid * 16 + (i_) * 8192, R_, C_); const int sR_ = R_; const unsigned sC_ = (unsigned)C_ * 2u; const int sRb_ = PERM ? ((R_ & ~31) + perm32(R_ & 31)) : R_; (void)sR_; (void)sRb_; (void)sC_
    const size_t kstep = 128;
    const unsigned ldsw = (unsigned)wid * 1024u;
    const int aoff = lds_byte(wr * 64 + fr, fq * 8), boff = lds_byte(wc * 32 + fr, fq * 8);
#define PG8_SA(b, h) (((b) * 2 + (h)) * HTB)
#define PG8_SB(b, h) ((4 + (b) * 2 + (h)) * HTB)
#define PG8_STAGE(bufoff, gbase, voff) do { _Pragma("unroll") for (int _i = 0; _i < 2; ++_i) \
        __builtin_amdgcn_global_load_lds((const unsigned*)((const char*)(gbase) + (voff)[_i]), (LAS unsigned*)(lds + (bufoff) + ldsw + _i * 8192), 16, 0, 0); } while (0)
#define PG8_LDA(dst, b, h) do { if constexpr (FP8) { _Pragma("unroll") for (int m = 0; m < 4; ++m) dst##8[m] = cat8(*(const LAS bf16x8*)(lds + PG8_SA(b, h) + aoff + m * 2048), *(const LAS bf16x8*)(lds + PG8_SA(b, h) + aoff + m * 2048 + 1024)); } \
        else { _Pragma("unroll") for (int m = 0; m < 4; ++m) _Pragma("unroll") for (int k = 0; k < 2; ++k) dst[m][k] = *(const LAS bf16x8*)(lds + PG8_SA(b, h) + aoff + m * 2048 + k * 1024); } } while (0)
#define PG8_LDB(dst, b, h) do { if constexpr (FP8) { _Pragma("unroll") for (int n = 0; n < 2; ++n) dst##8[n] = cat8(*(const LAS bf16x8*)(lds + PG8_SB(b, h) + boff + n * 2048), *(const LAS bf16x8*)(lds + PG8_SB(b, h) + boff + n * 2048 + 1024)); } \
        else { _Pragma("unroll") for (int n = 0; n < 2; ++n) _Pragma("unroll") for (int k = 0; k < 2; ++k) dst[n][k] = *(const LAS bf16x8*)(lds + PG8_SB(b, h) + boff + n * 2048 + k * 1024); } } while (0)
#define PG8_MMA(ai, bj, At, Bt) do { __builtin_amdgcn_s_setprio(1); \
        if constexpr (FP8) { _Pragma("unroll") for (int m = 0; m < 4; ++m) _Pragma("unroll") for (int n = 0; n < 2; ++n)   \
            asm volatile("v_mfma_scale_f32_16x16x128_f8f6f4 %0, %1, %2, %0, %3, %3 op_sel_hi:[0,0,0]" : "+v"(acc[ai][bj][m][n]) : "v"(Bt##8[n]), "v"(At##8[m]), "v"(one_scale)); } \
        else { _Pragma("unroll") for (int m = 0; m < 4; ++m) _Pragma("unroll") for (int n = 0; n < 2; ++n) _Pragma("unroll") for (int k = 0; k < 2; ++k) \
            acc[ai][bj][m][n] = __builtin_amdgcn_mfma_f32_16x16x32_bf16(Bt[n][k], At[m][k], acc[ai][bj][m][n], 0, 0, 0); } \
        __builtin_amdgcn_s_setprio(0); } while (0)
#define PG8_WAIT_V(n) asm volatile("s_waitcnt vmcnt(" #n ")" ::: "memory")
#define PG8_WAIT_L(n) asm volatile("s_waitcnt lgkmcnt(" #n ")" ::: "memory")
#define PG8_BAR __builtin_amdgcn_s_barrier()
#define PG8_SCHED __builtin_amdgcn_sched_barrier(0)
#define PG8_GIDX(dst, op_) do { _Pragma("unroll") for (int i_ = 0; i_ < 2; ++i_) { PG8_RC(i_); _Pragma("unroll") for (int h_ = 0; h_ < 2; ++h_) dst[h_][i_] = (unsigned)grows[(op_).slot0 + h_ * 128 + sR_] * (unsigned)((op_).lda * 2) + sC_; } } while (0)
#define PG8_AOFF(dst, op_) do { _Pragma("unroll") for (int i_ = 0; i_ < 2; ++i_) { PG8_RC(i_); _Pragma("unroll") for (int h_ = 0; h_ < 2; ++h_) dst[h_][i_] = (unsigned)((sR_ + 128 * h_) * (op_).lda) * 2u + sC_; } } while (0)
#define PG8_BOFF(dst, op_) do { _Pragma("unroll") for (int i_ = 0; i_ < 2; ++i_) { PG8_RC(i_); _Pragma("unroll") for (int h_ = 0; h_ < 2; ++h_) { const int c_ = sRb_ + 128 * h_; \
        dst[h_][i_] = (unsigned)(((op_).bmap ? (64 * (c_ & 7) + (c_ >> 3)) : c_) * (op_).ldb) * 2u + sC_; } } } while (0)
#define PG8_COPY(dst, src) do { _Pragma("unroll") for (int h_ = 0; h_ < 2; ++h_) _Pragma("unroll") for (int i_ = 0; i_ < 2; ++i_) dst[h_][i_] = src[h_][i_]; } while (0)
    Unit cur, nxt; int ui = 0;
    if (!S.next(0, cur)) return;
    f32x4 acc[2][2][4][2];
#pragma unroll
    for (int a = 0; a < 2; ++a)
#pragma unroll
        for (int b = 0; b < 2; ++b)
#pragma unroll
            for (int m = 0; m < 4; ++m)
#pragma unroll
                for (int n = 0; n < 2; ++n) acc[a][b][m][n] = (f32x4){0.f, 0.f, 0.f, 0.f};
    bf16x8 At[4][2], B0[2][2], B1[2][2]; i32x8 At8[4], B08[2], B18[2];
    const int one_scale = 0x7F7F7F7F;
    const char* cA; const char* cB; int nt;
    bool has_next; const char* nA; const char* nB; int nnt;
    { const Operands op = AD(cur); cA = (const char*)op.A; cB = (const char*)op.Bt; nt = op.K / 64; PG8_BOFF(cvb, op);
      has_next = S.next(1, nxt); const Operands o1 = has_next ? AD(nxt) : op; PG8_BOFF(nvb, o1); nA = (const char*)o1.A; nB = (const char*)o1.Bt; nnt = o1.K / 64;
      if constexpr (GATHER) { PG8_GIDX(cvg, op); PG8_GIDX(nvg, o1); PG8_WAIT_V(0); } else { PG8_AOFF(cvg, op); PG8_AOFF(nvg, o1); } }
    PG8_STAGE(PG8_SB(0, 0), cB, cvb[0]); PG8_STAGE(PG8_SB(0, 1), cB, cvb[1]); PG8_STAGE(PG8_SA(0, 0), cA, cvg[0]); PG8_STAGE(PG8_SA(0, 1), cA, cvg[1]);
    if (wr == 1) PG8_BAR;
    PG8_WAIT_V(2); PG8_BAR;
    PG8_STAGE(PG8_SB(1, 0), cB + kstep, cvb[0]); PG8_STAGE(PG8_SA(1, 0), cA + kstep, cvg[0]); PG8_STAGE(PG8_SB(1, 1), cB + kstep, cvb[1]);
    PG8_WAIT_V(6); PG8_BAR;
    for (;;) {
#pragma unroll 1
        for (int t = 0; t < nt; t += 2) {
            const bool last = (t == nt - 2);
            const char* a1 = cA + (size_t)(t + 1) * kstep;
            const char* a2 = last ? nA : cA + (size_t)(t + 2) * kstep; const char* b2 = last ? nB : cB + (size_t)(t + 2) * kstep;
            const char* a3 = a2 + kstep; const char* b3 = b2 + kstep;
            unsigned v2[2][2], w2[2][2];
#pragma unroll
            for (int h_ = 0; h_ < 2; ++h_)
#pragma unroll
                for (int i_ = 0; i_ < 2; ++i_) { v2[h_][i_] = last ? nvg[h_][i_] : cvg[h_][i_]; w2[h_][i_] = last ? nvb[h_][i_] : cvb[h_][i_]; }
            PG8_LDB(B0, 0, 0); PG8_LDB(B1, 0, 1); PG8_SCHED; PG8_LDA(At, 0, 0); PG8_STAGE(PG8_SA(1, 1), a1, cvg[1]);
            PG8_WAIT_V(8); PG8_WAIT_L(0); PG8_BAR; PG8_MMA(0, 0, At, B0); PG8_MMA(0, 1, At, B1); PG8_BAR; PG8_SCHED;
            PG8_LDA(At, 0, 1); PG8_STAGE(PG8_SB(0, 0), b2, w2[0]); PG8_STAGE(PG8_SB(0, 1), b2, w2[1]); PG8_STAGE(PG8_SA(0, 0), a2, v2[0]);
            PG8_WAIT_V(8); PG8_WAIT_L(0); PG8_BAR; PG8_MMA(1, 0, At, B0); PG8_MMA(1, 1, At, B1); PG8_BAR; PG8_SCHED;
            PG8_LDB(B0, 1, 0); PG8_LDB(B1, 1, 1); PG8_SCHED; PG8_LDA(At, 1, 0); PG8_STAGE(PG8_SA(0, 1), a2, v2[1]);
            PG8_WAIT_V(8); PG8_WAIT_L(0); PG8_BAR; PG8_MMA(0, 0, At, B0); PG8_MMA(0, 1, At, B1); PG8_BAR; PG8_SCHED;
            PG8_LDA(At, 1, 1); PG8_STAGE(PG8_SB(1, 0), b3, w2[0]); PG8_STAGE(PG8_SB(1, 1), b3, w2[1]); PG8_STAGE(PG8_SA(1, 0), a3, v2[0]);
            PG8_WAIT_V(8); PG8_WAIT_L(0); PG8_BAR; PG8_MMA(1, 0, At, B0); PG8_MMA(1, 1, At, B1); PG8_BAR; PG8_SCHED;
        }
        if constexpr (FP8) asm volatile("s_nop 15\n\ts_nop 15" ::: "memory");
        if (wr == 0) PG8_BAR;
        unsigned fvg[2][2], fvb[2][2];
        Unit u2; const bool h2 = S.next(ui + 2, u2); const char* fA = nA; const char* fB = nB; int fnt = nnt;
        if (h2) { const Operands o2 = AD(u2); fA = (const char*)o2.A; fB = (const char*)o2.Bt; fnt = o2.K / 64; PG8_BOFF(fvb, o2); if constexpr (GATHER) PG8_GIDX(fvg, o2); else PG8_AOFF(fvg, o2); }
        else { PG8_COPY(fvb, nvb); PG8_COPY(fvg, nvg); }
        { int fr2 = fr, fq2 = fq; asm volatile("" : "+v"(fr2), "+v"(fq2));
          E(acc, cur, wr, wc, fr2, fq2); }
        if (!has_next) break;
        if constexpr (GATHER) PG8_WAIT_V(0);
        PG8_COPY(cvg, nvg); PG8_COPY(nvg, fvg); PG8_COPY(cvb, nvb); PG8_COPY(nvb, fvb);
        if (E.reset(cur)) {
#pragma unroll
        for (int a = 0; a < 2; ++a)
#pragma unroll
            for (int b = 0; b < 2; ++b)
#pragma unroll
                for (int m = 0; m < 4; ++m)
#pragma unroll
                    for (int n = 0; n < 2; ++n) acc[a][b][m][n] = (f32x4){0.f, 0.f, 0.f, 0.f};
        }
        cur = nxt; cA = nA; cB = nB; nt = nnt; ++ui;
        nxt = u2; has_next = h2; nA = fA; nB = fB; nnt = fnt;
        if (wr == 1) PG8_BAR;
    }
    PG8_WAIT_V(0);
    PG8_BAR;
#undef PG8_SA
#undef PG8_SB
#undef PG8_STAGE
#undef PG8_LDA
#undef PG8_LDB
#undef PG8_MMA
#undef PG8_WAIT_V
#undef PG8_WAIT_L
#undef PG8_BAR
#undef PG8_SCHED
#undef PG8_GIDX
#undef PG8_AOFF
#undef PG8_BOFF
#undef PG8_COPY
#undef PG8_RC
}
template <class F> struct EpiFn { F f; __device__ __forceinline__ void operator()(f32x4 (&acc)[2][2][4][2], const Unit& u, int wr, int wc, int fr, int fq) const { f(acc, u, wr, wc, fr, fq); } __device__ __forceinline__ bool reset(const Unit&) const { return true; } };
template <class F> __device__ __forceinline__ EpiFn<F> mk_epi(F f) { return EpiFn<F>{f}; }
template <class F> struct EpiSeg { F f; int last; __device__ __forceinline__ void operator()(f32x4 (&acc)[2][2][4][2], const Unit& u, int wr, int wc, int fr, int fq) const { f(acc, u, wr, wc, fr, fq); } __device__ __forceinline__ bool reset(const Unit& u) const { return u.seg == last; } };
template <class F> __device__ __forceinline__ EpiSeg<F> mk_epi_seg(F f, int last) { return EpiSeg<F>{f, last}; }
template <int NSEG> struct SegSched { GroupSched base; __device__ __forceinline__ bool next(int j, Unit& u) const { if (!base.next(j / NSEG, u)) return false; u.seg = j % NSEG; return true; } };
#ifndef DUP_PH
#define DUP_PH -1
#endif
#define REP_BEGIN(k) _Pragma("unroll 1") for (int rep_ = 0; rep_ < ((DUP_PH == (k)) ? 2 : 1); ++rep_) { if (rep_) { if constexpr (PH < 0) xcd_barrier(bar); }
#define REP_END }
#define GEMM(S, AD, E, K, lda, ldb) gemm_fast<false, false, false>(F.lds, F.tid, S, AD, mk_epi(E), nullptr)
#define GEMM_P(S, AD, E) gemm_fast<false, true, false>(F.lds, F.tid, S, AD, mk_epi(E), nullptr)
#define GEMM_P8(S, AD, E) gemm_fast<false, true, true>(F.lds, F.tid, S, AD, mk_epi(E), nullptr)
#define GEMM_GATHER8(S, AD, E, rows) gemm_fast<true, true, true>(F.lds, F.tid, S, AD, mk_epi(E), rows)
#define EPI_ARGS f32x4 (&acc)[2][2][4][2], const Unit& u, int wr, int wc, int fr, int fq
#define EPI_FOR(...) _Pragma("unroll") for (int ai = 0; ai < 2; ++ai) _Pragma("unroll") for (int m = 0; m < 4; ++m) { const int r = ai * 128 + wr * 64 + m * 16 + fr; \
    _Pragma("unroll") for (int bj = 0; bj < 2; ++bj) _Pragma("unroll") for (int n = 0; n < 2; ++n) { const int c = bj * 128 + wc * 32 + n * 16 + 4 * fq; const f32x4 v = acc[ai][bj][m][n]; __VA_ARGS__ } }
#define EPI_FOR8(...) _Pragma("unroll") for (int ai = 0; ai < 2; ++ai) _Pragma("unroll") for (int m = 0; m < 4; ++m) { const int r = ai * 128 + wr * 64 + m * 16 + fr; \
    _Pragma("unroll") for (int bj = 0; bj < 2; ++bj) { const int c = bj * 128 + wc * 32 + 8 * fq; const f32x4 v0 = acc[ai][bj][m][0], v1 = acc[ai][bj][m][1]; __VA_ARGS__ } }
__device__ __forceinline__ void st_bf8(bf16* p, f32x4 a, f32x4 b) { u32x4 w; w.x = pk2(a[0], a[1]); w.y = pk2(a[2], a[3]); w.z = pk2(b[0], b[1]); w.w = pk2(b[2], b[3]); *(u32x4*)p = w; }
__device__ __forceinline__ void st_bf4(bf16* p, f32x4 v) { u32x2 w; w.x = pk2(v[0], v[1]); w.y = pk2(v[2], v[3]); *(u32x2*)p = w; }

__device__ __forceinline__ void p_mod(const Params& P, Frame& F) {
    LAS float* sc = (LAS float*)F.lds;
    LAS float* red = (LAS float*)(F.lds + 9 * 1024 * 4);
    float* MOD = WSP(float, WS_MOD);
    bool have = false;
    for (int it = F.bid; it < 2 * 96; it += F.G) {
        if (!have) {
            for (int i = F.tid; i < 9 * 1024; i += NTHREADS) { const int r = i >> 10, k = i & 1023; const float v = r < 8 ? P.c[r * 1024 + k] : P.c_ctx[k]; sc[i] = v * sigmoidf_(v); }
            have = true;
        }
        __syncthreads();
        const int l = it / 96, j0 = (it % 96) * 64, jj = F.tid & 63, kc = F.tid >> 6;
        const float* W = P.ada_w + (size_t)l * 1024 * 6144 + j0 + jj;
        float a[9];
#pragma unroll
        for (int r = 0; r < 9; ++r) a[r] = 0.f;
#pragma unroll 8
        for (int k = kc * 128; k < kc * 128 + 128; ++k) { const float w = W[(size_t)k * 6144];
#pragma unroll
            for (int r = 0; r < 9; ++r) a[r] += sc[r * 1024 + k] * w; }
#pragma unroll
        for (int r = 0; r < 9; ++r) red[(kc * 9 + r) * 64 + jj] = a[r];
        __syncthreads();
        for (int o = F.tid; o < 9 * 64; o += NTHREADS) { const int r = o >> 6, j = o & 63; float s = 0.f;
#pragma unroll
            for (int q = 0; q < 8; ++q) s += red[(q * 9 + r) * 64 + j];
            MOD[((size_t)l * 9 + r) * 6144 + j0 + j] = s + P.ada_b[l * 6144 + j0 + j]; }
    }
    __syncthreads();
}
__device__ __forceinline__ void p_dftgen(Frame& F) {
    LAS float* tab = (LAS float*)F.lds;
    for (int j = F.tid; j < 4096; j += NTHREADS) tab[j] = cospif((float)j * (1.0f / 2048.0f));
    __syncthreads();
    bf16* DC_ = WSP(bf16, WS_DFTC); bf16* M1 = WSP(bf16, WS_M1T); bf16* M2 = WSP(bf16, WS_M2T);
    const int nchunk = 256 * 64 + 256 * 32 + 256 * 64;
    for (int ch = F.bid * NTHREADS + F.tid; ch < nchunk; ch += F.G * NTHREADS) {
        float v[8]; bf16* dst;
        if (ch < 256 * 64) { const int kf = ch >> 6, col0 = (ch & 63) * 8, cs = col0 >> 8, l0 = col0 & 255;
#pragma unroll
            for (int i = 0; i < 8; ++i) { const int j = ((kf * (l0 + i)) & 255) * 16; v[i] = cs ? -tab[(j + 3072) & 4095] : tab[j]; }
            dst = DC_ + (size_t)kf * 512 + col0; }
        else if (ch < 256 * 64 + 256 * 32) { const int c2 = ch - 256 * 64, row = c2 >> 5, col0 = (c2 & 31) * 8, ri = row >> 7, h = (row >> 6) & 1, k1 = row & 63, h2 = col0 >> 7, cs = (col0 >> 6) & 1, l10 = col0 & 63;
#pragma unroll
            for (int i = 0; i < 8; ++i) { const int j = ((k1 * (l10 + i)) & 63) * 64; const float c = tab[j], sn = tab[(j + 3072) & 4095];
                v[i] = (h != h2) ? 0.f : (ri == 0 ? (cs == 0 ? c : -sn) : (cs == 0 ? sn : c)); }
            dst = M1 + (size_t)row * 256 + col0; }
        else { const int c2 = ch - 256 * 64 - 256 * 32, row = c2 >> 6, col0 = (c2 & 63) * 8, q = row >> 6, k2 = row & 63, q2 = col0 >> 7, ri = (col0 >> 6) & 1, l20 = col0 & 63;
#pragma unroll
            for (int i = 0; i < 8; ++i) { const int j = ((k2 * (l20 + i)) & 63) * 64; const float c = tab[j], sn = tab[(j + 3072) & 4095];
                v[i] = (q != q2) ? 0.f : (ri == 0 ? c : -sn); }
            dst = M2 + (size_t)row * 512 + col0; }
        u32x4 o; o.x = pk2(v[0], v[1]); o.y = pk2(v[2], v[3]); o.z = pk2(v[4], v[5]); o.w = pk2(v[6], v[7]);
        *(u32x4*)dst = o;
    }
    __syncthreads();
}
__device__ __forceinline__ void transpose_item(const float* W, int ldw, int k0, int n0, bf16* WT, int ldt, int drow0, LAS float* scr, int lane) {
    f32x4 ld[8];
#pragma unroll
    for (int i = 0; i < 8; ++i) ld[i] = *(const f32x4*)(W + (size_t)(k0 + 8 * i + (lane >> 3)) * ldw + n0 + 4 * (lane & 7));
#pragma unroll
    for (int i = 0; i < 8; ++i) { LAS float* d = scr + (8 * i + (lane >> 3)) * 33 + 4 * (lane & 7); d[0] = ld[i][0]; d[1] = ld[i][1]; d[2] = ld[i][2]; d[3] = ld[i][3]; }
    LDS_WAIT(); asm volatile("" ::: "memory");
    const int c = lane & 7;
#pragma unroll
    for (int j = 0; j < 4; ++j) { const int n = (lane >> 3) + 8 * j; const LAS float* s = scr + (8 * c) * 33 + n;
        u32x4 o; o.x = pk2(s[0 * 33], s[1 * 33]); o.y = pk2(s[2 * 33], s[3 * 33]); o.z = pk2(s[4 * 33], s[5 * 33]); o.w = pk2(s[6 * 33], s[7 * 33]);
        *(u32x4*)(WT + (size_t)(drow0 + n) * ldt + k0 + 8 * c) = o; }
    LDS_WAIT(); asm volatile("" ::: "memory");
}
__device__ __forceinline__ void transpose_item8(const float* W, int ldw, int k0, int n0, unsigned char* WT, int ldt, int drow0, LAS float* scr, int lane) {
    f32x4 ld[8];
#pragma unroll
    for (int i = 0; i < 8; ++i) ld[i] = *(const f32x4*)(W + (size_t)(k0 + 8 * i + (lane >> 3)) * ldw + n0 + 4 * (lane & 7));
#pragma unroll
    for (int i = 0; i < 8; ++i) { LAS float* d = scr + (8 * i + (lane >> 3)) * 33 + 4 * (lane & 7); d[0] = ld[i][0]; d[1] = ld[i][1]; d[2] = ld[i][2]; d[3] = ld[i][3]; }
    LDS_WAIT(); asm volatile("" ::: "memory");
    const int c = lane & 7;
#pragma unroll
    for (int j = 0; j < 4; ++j) { const int n = (lane >> 3) + 8 * j; const LAS float* s = scr + (8 * c) * 33 + n;
        u32x2 o; o.x = pk4_fp8(s[0 * 33] * W8S, s[1 * 33] * W8S, s[2 * 33] * W8S, s[3 * 33] * W8S); o.y = pk4_fp8(s[4 * 33] * W8S, s[5 * 33] * W8S, s[6 * 33] * W8S, s[7 * 33] * W8S);
        *(u32x2*)(WT + (size_t)(drow0 + n) * ldt + k0 + 8 * c) = o; }
    LDS_WAIT(); asm volatile("" ::: "memory");
}
__device__ __forceinline__ void transpose_item8w(const float* W, int ldw, int k0, int n0, unsigned char* WT, int ldt, int drow0, LAS float* scr, int lane) {
    f32x4 ld[16];
#pragma unroll
    for (int i = 0; i < 16; ++i) ld[i] = *(const f32x4*)(W + (size_t)(k0 + 4 * i + (lane >> 4)) * ldw + n0 + 4 * (lane & 15));
#pragma unroll
    for (int i = 0; i < 16; ++i) { LAS float* d = scr + (4 * i + (lane >> 4)) * 65 + 4 * (lane & 15); d[0] = ld[i][0]; d[1] = ld[i][1]; d[2] = ld[i][2]; d[3] = ld[i][3]; }
    LDS_WAIT(); asm volatile("" ::: "memory");
    const int c = lane & 3;
#pragma unroll
    for (int p = 0; p < 4; ++p) { const int n = (lane >> 2) + 16 * p; const LAS float* s = scr + (16 * c) * 65 + n; u32x4 o;
#pragma unroll
        for (int q = 0; q < 4; ++q) o[q] = pk4_fp8(s[(4 * q) * 65] * W8S, s[(4 * q + 1) * 65] * W8S, s[(4 * q + 2) * 65] * W8S, s[(4 * q + 3) * 65] * W8S);
        *(u32x4*)(WT + (size_t)(drow0 + n) * ldt + k0 + 16 * c) = o; }
    LDS_WAIT(); asm volatile("" ::: "memory");
}
__device__ __forceinline__ void cv_load(const float* W, int ldw, int lane, f32x4 (&ld)[16]) {
#pragma unroll
    for (int i = 0; i < 16; ++i) ld[i] = *(const f32x4*)(W + (size_t)(4 * i + (lane >> 4)) * ldw + 4 * (lane & 15));
}
__device__ __forceinline__ void cv_store(const f32x4 (&ld)[16], unsigned char* WT, int ldt, LAS float* scr, int lane) {
#pragma unroll
    for (int i = 0; i < 16; ++i) { LAS float* d = scr + (4 * i + (lane >> 4)) * 65 + 4 * (lane & 15); d[0] = ld[i][0]; d[1] = ld[i][1]; d[2] = ld[i][2]; d[3] = ld[i][3]; }
    LDS_WAIT(); asm volatile("" ::: "memory");
    const int c = lane & 3;
#pragma unroll
    for (int p = 0; p < 4; ++p) { const int n = (lane >> 2) + 16 * p; const LAS float* s = scr + (16 * c) * 65 + n; u32x4 o;
#pragma unroll
        for (int q = 0; q < 4; ++q) o[q] = pk4_fp8(s[(4 * q) * 65] * W8S, s[(4 * q + 1) * 65] * W8S, s[(4 * q + 2) * 65] * W8S, s[(4 * q + 3) * 65] * W8S);
        *(u32x4*)(WT + (size_t)n * ldt + 16 * c) = o; }
    LDS_WAIT(); asm volatile("" ::: "memory");
}
__device__ __forceinline__ void cv_item(const Params& P, unsigned char* ws, int l, int it, const float*& W, int& ldw, unsigned char*& WT, int& ldt) {
    constexpr int I_E = 16 * 44;
    const int which = it / (16 * I_E), r0 = it % (16 * I_E), e = r0 / I_E, r = r0 % I_E;
    if (which < 2) { const int kb = r / 44, nb = r % 44, n0 = nb * 64;
        W = (which == 0 ? P.w_eg : P.w_eu) + ((size_t)l * 16 + e) * 1024 * FF + (size_t)(kb * 64) * FF + n0; ldw = FF;
        WT = ws + (l ? WS_WGU1 : WS_WGU) + (size_t)e * 5632 * 1024 + (size_t)((n0 >> 7) * 256 + (which ? 128 : 0) + (n0 & 127)) * 1024 + kb * 64; ldt = 1024; }
    else { const int kb = r / 16, nb = r % 16;
        W = P.w_ed + ((size_t)l * 16 + e) * FF * 1024 + (size_t)(kb * 64) * 1024 + nb * 64; ldw = 1024;
        WT = ws + (l ? WS_WD1 : WS_WD) + (size_t)e * 1024 * FF + (size_t)(nb * 64) * FF + kb * 64; ldt = FF; }
}
constexpr int CV_NIT = 3 * 16 * 16 * 44;
constexpr int CV_A = CV_NIT * 18 / 100, CV_B = CV_A + CV_NIT * 23 / 100, CV_C = CV_B + CV_NIT * 28 / 100;
__device__ __forceinline__ void wconv_experts(const Params& P, Frame& F, int l, int rank, int nblk, int it_lo, int it_hi) {
    LAS float* scr = (LAS float*)(F.lds + (F.wave < 7 ? F.wave * 17408 : 131584));
    const int gw = rank * NWAVES + F.wave, NGW = nblk * NWAVES, NIT = it_hi;
    f32x4 la[16], lb[16]; const float* W; int ldw; unsigned char* T0; int ldt0;
    int it = it_lo + gw;
    if (it < NIT) { cv_item(P, F.ws, l, it, W, ldw, T0, ldt0); cv_load(W, ldw, F.lane, la); }
#pragma unroll 1
    for (; it < NIT; it += NGW) {
        unsigned char* T1 = T0; int ldt1 = ldt0; const int nit = it + NGW;
        if (nit < NIT) { cv_item(P, F.ws, l, nit, W, ldw, T1, ldt1); cv_load(W, ldw, F.lane, lb); }
        cv_store(la, T0, ldt0, scr, F.lane);
#pragma unroll
        for (int i = 0; i < 16; ++i) la[i] = lb[i];
        T0 = T1; ldt0 = ldt1;
    }
    __syncthreads();
}
__device__ __forceinline__ void p_wconv(const Params& P, Frame& F, int l) {
    LAS float* scr = (LAS float*)(F.lds + F.wave * 16384);
    const int gw = F.bid * NWAVES + F.wave, NGW = F.G * NWAVES;
    const float* w_in = P.w_in + (size_t)l * 1024 * INW;
    bf16* WA = WSP(bf16, WS_WA); bf16* WFV = WSP(bf16, WS_WFV);
    constexpr int I_K = 16 * 32, I_Q = 16 * 32, I_P = 16 * 16, I_G = 16 * 96, I_V = 16 * 32, I_AO = 16 * 32, I_FO = 8 * 32, I_OUT = 16 * 32;
    constexpr int NSM = I_K + I_Q + I_P + I_G + I_V + I_AO + I_FO + I_OUT;
    for (int it = gw; it < NSM; it += NGW) {
        int r = it;
        if (r < I_K) { transpose_item8(w_in, INW, (r / 32) * 64, 0 + (r % 32) * 32, WSP(unsigned char, WS_WA8), 1024, 0 + (r % 32) * 32, scr, F.lane); continue; } r -= I_K;
        if (r < I_Q) { transpose_item8(w_in, INW, (r / 32) * 64, 2048 + (r % 32) * 32, WSP(unsigned char, WS_WA8), 1024, 1024 + (r % 32) * 32, scr, F.lane); continue; } r -= I_Q;
        if (r < I_P) { transpose_item(w_in, INW, (r / 16) * 64, 3584 + (r % 16) * 32, WA, 1024, 2048 + (r % 16) * 32, scr, F.lane); continue; } r -= I_P;
        if (r < I_G) { transpose_item8(w_in, INW, (r / 96) * 64, 4096 + (r % 96) * 32, WSP(unsigned char, WS_WA8), 1024, 3072 + (r % 96) * 32, scr, F.lane); continue; } r -= I_G;
        if (r < I_V) { transpose_item8(w_in, INW, (r / 32) * 64, 1024 + (r % 32) * 32, WSP(unsigned char, WS_WA8), 1024, 2048 + (r % 32) * 32, scr, F.lane); continue; } r -= I_V;
        if (r < I_AO) { transpose_item8(P.w_att_o + (size_t)l * 1024 * 1024, 1024, (r / 32) * 64, (r % 32) * 32, WSP(unsigned char, WS_WAO), 1024, (r % 32) * 32, scr, F.lane); continue; } r -= I_AO;
        if (r < I_FO) { transpose_item(P.w_fourier + (size_t)l * 512 * 1024, 1024, (r / 32) * 64, (r % 32) * 32, WSP(bf16, WS_WFO), 512, (r % 32) * 32, scr, F.lane); continue; } r -= I_FO;
        transpose_item(P.w_out + (size_t)l * 1024 * 1024, 1024, (r / 32) * 64, (r % 32) * 32, WSP(bf16, WS_WOUT), 1024, (r % 32) * 32, scr, F.lane);
    }
    { bf16* WPO = WSP(bf16, WS_WPO); const float* wp = P.w_pool + (size_t)l * 4 * 128 * 256;
#pragma unroll 1
      for (int i = F.bid * NTHREADS + F.tid; i < 1024 * 128; i += F.G * NTHREADS) { const int n = i >> 7, kk = i & 127, g = n >> 8, f = n & 255;
          WPO[i] = (bf16)f2bf(wp[((size_t)g * 128 + kk) * 256 + f]);
          asm volatile("" : "+v"(i)); } }
    { LAS float* t128 = (LAS float*)F.lds; LAS float* srcs = t128 + 128;
      int tid = F.tid; asm volatile("" : "+v"(tid));
      __syncthreads();
      for (int j = tid; j < 128; j += NTHREADS) t128[j] = cospif((float)j * (1.0f / 64.0f));
      for (int tile = F.bid; tile < 256; tile += F.G) { const int g = tile >> 6, kb = tile & 63;
          __syncthreads();
          { const int kk = tid >> 5, c4 = (tid & 31) * 4; const f32x4 v = *(const f32x4*)(w_in + (size_t)(kb * 16 + kk) * INW + 3072 + g * 128 + c4); LAS float* d = srcs + kk * 129 + c4; d[0] = v[0]; d[1] = v[1]; d[2] = v[2]; d[3] = v[3]; }
          __syncthreads();
          const int m = tid >> 2, kq = tid & 3; float sc_[4] = {0.f, 0.f, 0.f, 0.f}, ss_[4] = {0.f, 0.f, 0.f, 0.f}; const LAS float* sp = srcs + (4 * kq) * 129;
#pragma unroll 4
          for (int c = 0; c < 128; ++c) { const float tc = t128[(m * c) & 127], ts = t128[(m * c + 96) & 127];
#pragma unroll
              for (int j = 0; j < 4; ++j) { const float v = sp[j * 129 + c]; sc_[j] += v * tc; ss_[j] += v * ts; } }
          bf16* o = WFV + (size_t)((g * 128 + m) * 2) * 1024 + kb * 16 + 4 * kq;
          st_bf4(o, (f32x4){sc_[0], sc_[1], sc_[2], sc_[3]}); st_bf4(o + 1024, (f32x4){ss_[0], ss_[1], ss_[2], ss_[3]}); }
      __syncthreads(); }
}

struct RowMod { const float* g; const float* sh; const float* sc; };
__device__ __forceinline__ void row_load(const float* row, int lane, f32x4 (&v)[4]) {
#pragma unroll
    for (int j = 0; j < 4; ++j) v[j] = *(const f32x4*)(row + 4 * lane + 256 * j);
}
__device__ __forceinline__ void row_load_bf(const bf16* row, int lane, f32x4 (&v)[4]) {
#pragma unroll
    for (int j = 0; j < 4; ++j) { const u32x2 w = *(const u32x2*)(row + 4 * lane + 256 * j); v[j] = (f32x4){bflo(w.x), bfhi(w.x), bflo(w.y), bfhi(w.y)}; }
}
__device__ __forceinline__ float row_rstd(const f32x4 (&v)[4]) {
    float s = 0.f;
#pragma unroll
    for (int j = 0; j < 4; ++j) s += (v[j][0] * v[j][0] + v[j][1] * v[j][1]) + (v[j][2] * v[j][2] + v[j][3] * v[j][3]);
    return rsqrtf(wave_sum(s) * (1.0f / 1024.0f) + RMS_EPS);
}
__device__ __forceinline__ void row_modulate(const f32x4 (&v)[4], float rstd, const RowMod& M, int lane, f32x4 (&y)[4]) {
#pragma unroll
    for (int j = 0; j < 4; ++j) { const int k = 4 * lane + 256 * j; const f32x4 g = *(const f32x4*)(M.g + k), sh = *(const f32x4*)(M.sh + k), sc = *(const f32x4*)(M.sc + k);
        y[j] = v[j] * rstd * g * (sc + 1.0f) + sh; }
}
__device__ __forceinline__ void row_store_bf(bf16* row, int lane, const f32x4 (&y)[4]) {
#pragma unroll
    for (int j = 0; j < 4; ++j) st_bf4(row + 4 * lane + 256 * j, y[j]);
}
__device__ __forceinline__ void row_store_f8(unsigned char* row, int lane, const f32x4 (&y)[4]) {
#pragma unroll
    for (int j = 0; j < 4; ++j) *(unsigned*)(row + 4 * lane + 256 * j) = pk4_fp8(y[j][0] * A8S, y[j][1] * A8S, y[j][2] * A8S, y[j][3] * A8S);
}
__device__ __forceinline__ const float* mod_ptr(Frame& F, int l, int row, int which) { const int mr = row < RL ? (row >> 12) : 8; return WSP(float, WS_MOD) + ((size_t)l * 9 + mr) * 6144 + which * 1024; }

__device__ __forceinline__ void row_modulate2(const f32x4 (&v0)[4], const f32x4 (&v1)[4], float rs0, float rs1, const RowMod& M, int lane, f32x4 (&y0)[4], f32x4 (&y1)[4]) {
#pragma unroll
    for (int j = 0; j < 4; ++j) { const int k = 4 * lane + 256 * j; const f32x4 g = *(const f32x4*)(M.g + k), sh = *(const f32x4*)(M.sh + k), sc = *(const f32x4*)(M.sc + k); const f32x4 m = g * (sc + 1.0f);
        y0[j] = v0[j] * rs0 * m + sh; y1[j] = v1[j] * rs1 * m + sh; }
}
__device__ __forceinline__ void p_rowpass_a0(const Params& P, Frame& F) {
    const int gw = F.bid * NWAVES + F.wave, NGW = F.G * NWAVES; bf16* H = WSP(bf16, WS_H); unsigned char* H8 = WSP(unsigned char, WS_H8);
    f32x4 vn[2][4]; int p = gw;
    if (p < RT / 2) { const int row = 2 * p; const float* src = row < RL ? P.x + (size_t)row * DM : P.ctx + (size_t)(row - RL) * DM; row_load(src, F.lane, vn[0]); row_load(src + DM, F.lane, vn[1]); }
    for (; p < RT / 2; p += NGW) { const int row = 2 * p;
        f32x4 v0[4], v1[4], y0[4], y1[4];
#pragma unroll
        for (int j = 0; j < 4; ++j) { v0[j] = vn[0][j]; v1[j] = vn[1][j]; }
        { const int nr = 2 * (p + NGW); if (nr < RT) { const float* src = nr < RL ? P.x + (size_t)nr * DM : P.ctx + (size_t)(nr - RL) * DM; row_load(src, F.lane, vn[0]); row_load(src + DM, F.lane, vn[1]); } }
        const float rs0 = row_rstd(v0), rs1 = row_rstd(v1);
        RowMod M{P.norm1_g, mod_ptr(F, 0, row, 0), mod_ptr(F, 0, row, 1)};
        row_modulate2(v0, v1, rs0, rs1, M, F.lane, y0, y1);
        row_store_bf(H + (size_t)row * DM, F.lane, y0); row_store_f8(H8 + (size_t)row * DM, F.lane, y0);
        row_store_bf(H + (size_t)(row + 1) * DM, F.lane, y1); row_store_f8(H8 + (size_t)(row + 1) * DM, F.lane, y1);
    }
}
constexpr int DPP_MIRROR = 0x140, DPP_HMIRROR = 0x141;
__device__ __forceinline__ void p_rowpass_k(const Params& P, Frame& F, int l, int nrows) {
    const int gw = F.bid * NWAVES + F.wave, NGW = F.G * NWAVES; bf16* H = WSP(bf16, WS_H);
    const int* SEL = WSP(int, WS_SEL); const bf16* Y = WSP(bf16, WS_Y);
    f32x4 vn[2][4]; int seln = -1; int p = gw; const int NP = nrows >> 1;
    bf16* XB = WSP(bf16, WS_XB);
    if (p < NP) { const int row = 2 * p; const bf16* src = XB + (size_t)row * DM; row_load_bf(src, F.lane, vn[0]); row_load_bf(src + DM, F.lane, vn[1]);
        seln = F.lane < 32 ? SEL[(size_t)row * 16 + F.lane] : -1; }
    for (; p < NP; p += NGW) { const int row = 2 * p;
        f32x4 v0[4], v1[4], a0[4], a1[4]; const int sel = seln;
#pragma unroll
        for (int j = 0; j < 4; ++j) { v0[j] = vn[0][j]; v1[j] = vn[1][j]; a0[j] = (f32x4){0.f, 0.f, 0.f, 0.f}; a1[j] = (f32x4){0.f, 0.f, 0.f, 0.f}; }
        { const int nr = 2 * (p + NGW); if (nr < nrows) { const bf16* src = XB + (size_t)nr * DM; row_load_bf(src, F.lane, vn[0]); row_load_bf(src + DM, F.lane, vn[1]);
            seln = F.lane < 32 ? SEL[(size_t)nr * 16 + F.lane] : -1; } }
        const unsigned emall = (unsigned)__ballot(sel >= 0);
        unsigned em0 = emall & 0xffffu, em1 = (emall >> 16) & 0xffffu; int s0[4], s1[4];
#pragma unroll
        for (int q = 0; q < 4; ++q) { s0[q] = -1; if (em0) { const int e = __builtin_ctz(em0); em0 &= em0 - 1; s0[q] = __builtin_amdgcn_readlane(sel, e); }
                                      s1[q] = -1; if (em1) { const int e = __builtin_ctz(em1); em1 &= em1 - 1; s1[q] = __builtin_amdgcn_readlane(sel, 16 + e); } }
        u32x2 w0[4][4], w1[4][4];
#pragma unroll
        for (int q = 0; q < 4; ++q) {
            if (s0[q] >= 0) { const bf16* yr = Y + (size_t)s0[q] * DM + 4 * F.lane;
#pragma unroll
                for (int j = 0; j < 4; ++j) w0[q][j] = *(const u32x2*)(yr + 256 * j); }
            if (s1[q] >= 0) { const bf16* yr = Y + (size_t)s1[q] * DM + 4 * F.lane;
#pragma unroll
                for (int j = 0; j < 4; ++j) w1[q][j] = *(const u32x2*)(yr + 256 * j); } }
#pragma unroll
        for (int q = 0; q < 4; ++q) {
            if (s0[q] >= 0) {
#pragma unroll
                for (int j = 0; j < 4; ++j) { const u32x2 w = w0[q][j]; a0[j][0] += bflo(w.x); a0[j][1] += bfhi(w.x); a0[j][2] += bflo(w.y); a0[j][3] += bfhi(w.y); } }
            if (s1[q] >= 0) {
#pragma unroll
                for (int j = 0; j < 4; ++j) { const u32x2 w = w1[q][j]; a1[j][0] += bflo(w.x); a1[j][1] += bfhi(w.x); a1[j][2] += bflo(w.y); a1[j][3] += bfhi(w.y); } } }
        while (em0) { const int e = __builtin_ctz(em0); em0 &= em0 - 1; const int sl = __builtin_amdgcn_readlane(sel, e); const bf16* yr = Y + (size_t)sl * DM;
#pragma unroll
            for (int j = 0; j < 4; ++j) { const u32x2 w = *(const u32x2*)(yr + 4 * F.lane + 256 * j); a0[j][0] += bflo(w.x); a0[j][1] += bfhi(w.x); a0[j][2] += bflo(w.y); a0[j][3] += bfhi(w.y); } }
        while (em1) { const int e = __builtin_ctz(em1); em1 &= em1 - 1; const int sl = __builtin_amdgcn_readlane(sel, 16 + e); const bf16* yr = Y + (size_t)sl * DM;
#pragma unroll
            for (int j = 0; j < 4; ++j) { const u32x2 w = *(const u32x2*)(yr + 4 * F.lane + 256 * j); a1[j][0] += bflo(w.x); a1[j][1] += bfhi(w.x); a1[j][2] += bflo(w.y); a1[j][3] += bfhi(w.y); } }
        const float* g2 = mod_ptr(F, l, row, 5);
#pragma unroll
        for (int j = 0; j < 4; ++j) { const f32x4 g = *(const f32x4*)(g2 + 4 * F.lane + 256 * j); v0[j] = v0[j] + g * a0[j]; v1[j] = v1[j] + g * a1[j]; }
        const float rs0 = row_rstd(v0), rs1 = row_rstd(v1);
        if (l == 0) {
#pragma unroll
            for (int j = 0; j < 4; ++j) { st_bf4(XB + (size_t)row * DM + 4 * F.lane + 256 * j, v0[j]); st_bf4(XB + (size_t)(row + 1) * DM + 4 * F.lane + 256 * j, v1[j]); }
            f32x4 y0[4], y1[4]; RowMod M{P.norm1_g + 1024, mod_ptr(F, 1, row, 0), mod_ptr(F, 1, row, 1)};
            row_modulate2(v0, v1, rs0, rs1, M, F.lane, y0, y1);
            row_store_bf(H + (size_t)row * DM, F.lane, y0); row_store_f8(WSP(unsigned char, WS_H8) + (size_t)row * DM, F.lane, y0);
            row_store_bf(H + (size_t)(row + 1) * DM, F.lane, y1); row_store_f8(WSP(unsigned char, WS_H8) + (size_t)(row + 1) * DM, F.lane, y1);
        } else {
#pragma unroll
            for (int j = 0; j < 4; ++j) { const f32x4 g = *(const f32x4*)(P.final_g + 4 * F.lane + 256 * j); float* xr = P.out + (size_t)row * DM + 4 * F.lane + 256 * j; *(f32x4*)xr = v0[j] * rs0 * g; *(f32x4*)(xr + DM) = v1[j] * rs1 * g; }
        }
    }
}

constexpr int RF_WH = 0, RF_WL = 16 * RF_PITCH * 2, RF_M8 = 2 * RF_WL, RF_S8 = RF_M8 + 4096, RF_BIAS = RF_S8 + 4096, RF_RS = RF_BIAS + 64;
__device__ __forceinline__ void p_rftables(const Params& P, Frame& F) {
    LAS float* red = (LAS float*)F.lds;
    for (int job = F.bid; job < 2 * 9 * 16; job += F.G) { const int e = job & 15, lm = job >> 4, l = lm / 9;
        int tid = F.tid; asm volatile("" : "+v"(tid));
        const float* wr = P.w_router + (size_t)l * 1024 * 16; const float* g2n = P.norm2_g + l * 1024;
        const float* sh = WSP(float, WS_MOD) + (size_t)lm * 6144 + 3 * 1024; const float* sc = sh + 1024;
        unsigned char* T = WSP(unsigned char, WS_RFT) + (size_t)lm * RF_TBL;
        float bs = 0.f;
#pragma unroll
        for (int q = 0; q < 2; ++q) { const int k = tid + 512 * q; const float m = g2n[k] * (1.0f + sc[k]), r = wr[k * 16 + e], w = m * r;
            const unsigned hi = f2bf(w); const float lo = w - bf2f(hi);
            ((bf16*)(T + RF_WH))[e * RF_PITCH + k] = (bf16)hi; ((bf16*)(T + RF_WL))[e * RF_PITCH + k] = (bf16)f2bf(lo);
            bs += sh[k] * r;
            if (e == 0) { ((float*)(T + RF_M8))[k] = m * A8S; ((float*)(T + RF_S8))[k] = sh[k] * A8S; } }
        bs = wave_sum(bs);
        __syncthreads();
        if (F.lane == 0) red[F.wave] = bs;
        __syncthreads();
        if (tid == 0) { float a = 0.f;
#pragma unroll
            for (int w = 0; w < NWAVES; ++w) a += red[w];
            ((float*)(T + RF_BIAS))[e] = a; }
    }
    __syncthreads();
}
__device__ __forceinline__ void rf_copy(Frame& F, const unsigned char* T) {
    int tid = F.tid; asm volatile("" : "+v"(tid));
    __syncthreads();
    u32x4 v[10];
#pragma unroll
    for (int q = 0; q < 10; ++q) { const int c = tid + 512 * q; if (c < RF_TBL / 16) v[q] = *(const u32x4*)(T + (size_t)c * 16); }
#pragma unroll
    for (int q = 0; q < 10; ++q) { const int c = tid + 512 * q; if (c < RF_TBL / 16) *(LAS u32x4*)(F.lds + c * 16) = v[q]; }
    __syncthreads();
}
__device__ __forceinline__ void rf_compute(Frame& F, const u32x4 (&xw)[32], unsigned char* H8, float* AFF, int row0) {
    const int i = F.lane & 15, g = F.lane >> 4;
    int og = 8 * g; asm volatile("" : "+v"(og));
    f32x2 s2 = {0.f, 0.f};
#pragma unroll
    for (int t = 0; t < 32; ++t)
#pragma unroll
        for (int q = 0; q < 4; ++q) { const f32x2 v = {bflo(xw[t][q]), bfhi(xw[t][q])}; s2 += v * v; }
    float ss = s2[0] + s2[1];
    { auto a = __builtin_amdgcn_permlane16_swap(__float_as_uint(ss), __float_as_uint(ss), false, false); ss = __uint_as_float(a[0]) + __uint_as_float(a[1]);
      auto b = __builtin_amdgcn_permlane32_swap(__float_as_uint(ss), __float_as_uint(ss), false, false); ss = __uint_as_float(b[0]) + __uint_as_float(b[1]); }
    const float rstd = rsqrtf(ss * (1.0f / 1024.0f) + RMS_EPS);
    LAS float* RS = (LAS float*)(F.lds + RF_RS) + F.wave * 16;
    if (F.lane < 16) RS[F.lane] = rstd;
    f32x4 acc = {0.f, 0.f, 0.f, 0.f};
    const LAS unsigned char* wb = F.lds + (i * RF_PITCH + og) * 2;
#pragma unroll
    for (int t = 0; t < 32; ++t) { const bf16x8 bh = *(const LAS bf16x8*)(wb + RF_WH + 64 * t), bl = *(const LAS bf16x8*)(wb + RF_WL + 64 * t); const bf16x8 a = __builtin_bit_cast(bf16x8, xw[t]);
        acc = __builtin_amdgcn_mfma_f32_16x16x32_bf16(a, bh, acc, 0, 0, 0); acc = __builtin_amdgcn_mfma_f32_16x16x32_bf16(a, bl, acc, 0, 0, 0);
        if ((t & 3) == 3) asm volatile("" ::: "memory"); }
    { const LAS float* M8 = (const LAS float*)(F.lds + RF_M8) + og; const LAS float* S8 = (const LAS float*)(F.lds + RF_S8) + og; unsigned char* hr = H8 + (size_t)(row0 + i) * DM + 8 * g;
#pragma unroll
      for (int t = 0; t < 32; ++t) { const f32x4 m0 = *(const LAS f32x4*)(M8 + 32 * t), m1 = *(const LAS f32x4*)(M8 + 32 * t + 4), h0 = *(const LAS f32x4*)(S8 + 32 * t), h1 = *(const LAS f32x4*)(S8 + 32 * t + 4);
          u32x4 x = xw[t]; asm volatile("" : "+v"(x));
          const f32x4 xa = {bflo(x[0]), bfhi(x[0]), bflo(x[1]), bfhi(x[1])}, xb = {bflo(x[2]), bfhi(x[2]), bflo(x[3]), bfhi(x[3])};
          const f32x4 ya = xa * rstd * m0 + h0, yb = xb * rstd * m1 + h1;
          u32x2 w; w.x = pk4_fp8(ya[0], ya[1], ya[2], ya[3]); w.y = pk4_fp8(yb[0], yb[1], yb[2], yb[3]); *(u32x2*)(hr + 32 * t) = w;
          if (t & 1) asm volatile("" ::: "memory"); } }
    LDS_WAIT(); asm volatile("" ::: "memory");
    const f32x4 rs4 = *(const LAS f32x4*)(RS + 4 * g); const float bias = ((const LAS float*)(F.lds + RF_BIAS))[i];
#pragma unroll
    for (int r = 0; r < 4; ++r) { const float lg = acc[r] * rs4[r] + bias; float mx = lg;
        mx = fmaxf(mx, dppf<DPP_XOR1>(mx)); mx = fmaxf(mx, dppf<DPP_XOR2>(mx)); mx = fmaxf(mx, dppf<DPP_HMIRROR>(mx)); mx = fmaxf(mx, dppf<DPP_MIRROR>(mx));
        const float ex = __expf(lg - mx); float den = ex;
        den += dppf<DPP_XOR1>(den); den += dppf<DPP_XOR2>(den); den += dppf<DPP_HMIRROR>(den); den += dppf<DPP_MIRROR>(den);
        AFF[(size_t)(row0 + 4 * g + r) * 16 + i] = ex / den; }
}
__device__ __forceinline__ void p_rowpass_f(const Params& P, Frame& F, int l, int nrows) {
    const bf16* XB = WSP(bf16, WS_XB); unsigned char* H8 = WSP(unsigned char, WS_H8); float* AFF = WSP(float, WS_AFF);
    int cur = -1;
    for (int it = F.bid; it < nrows / 128; it += F.G) { const int row0 = it * 128 + 16 * F.wave, mr = row0 < RL ? (row0 >> 12) : 8;
        const bf16* xr = XB + (size_t)(row0 + (F.lane & 15)) * DM + 8 * (F.lane >> 4);
        u32x4 xw[32];
#pragma unroll
        for (int t = 0; t < 32; ++t) xw[t] = *(const u32x4*)(xr + 32 * t);
        if (mr != cur) { rf_copy(F, WSP(unsigned char, WS_RFT) + (size_t)(l * 9 + mr) * RF_TBL); cur = mr; }
        rf_compute(F, xw, H8, AFF, row0); }
    __syncthreads();
}
constexpr int ACK_STRIDE = 72, ACV_STRIDE = 264;
constexpr int ALDS_CK = 0, ALDS_CV = 256 * ACK_STRIDE * 2, ALDS_RP = ALDS_CV + 64 * ACV_STRIDE * 2;
struct AttnState { float m, sum; f32x4 o[4]; };
__device__ __forceinline__ float xrow16_max(float x) {
    auto s = __builtin_amdgcn_permlane16_swap(__float_as_uint(x), __float_as_uint(x), false, false);
    x = fmaxf(__uint_as_float(s[0]), __uint_as_float(s[1]));
    auto t = __builtin_amdgcn_permlane32_swap(__float_as_uint(x), __float_as_uint(x), false, false);
    return fmaxf(__uint_as_float(t[0]), __uint_as_float(t[1]));
}
__device__ __forceinline__ float xrow16_sum(float x) {
    auto s = __builtin_amdgcn_permlane16_swap(__float_as_uint(x), __float_as_uint(x), false, false);
    x = __uint_as_float(s[0]) + __uint_as_float(s[1]);
    auto t = __builtin_amdgcn_permlane32_swap(__float_as_uint(x), __float_as_uint(x), false, false);
    return __uint_as_float(t[0]) + __uint_as_float(t[1]);
}
#define MFMA16(a, b, c) __builtin_amdgcn_mfma_f32_16x16x32_bf16((a), (b), (c), 0, 0, 0)
template <int NT>
__device__ __forceinline__ void attn_tail(AttnState& S, f32x4 (&sc)[NT], const u32x4 (&vw)[NT / 2][4]) {
    float cm = -__builtin_inff();
#pragma unroll
    for (int t = 0; t < NT; ++t)
#pragma unroll
        for (int j = 0; j < 4; ++j) cm = fmaxf(cm, sc[t][j]);
    cm = xrow16_max(cm);
    const bool need = (fabsf(cm) > 12.0f) && (cm > -1e30f);
    if (__builtin_amdgcn_ballot_w64(need) != 0ull) {
        const float d = need ? cm : 0.f, scl = __builtin_amdgcn_exp2f(-d);
        S.m += d; S.sum *= scl;
#pragma unroll
        for (int dt = 0; dt < 4; ++dt) S.o[dt] = S.o[dt] * scl;
#pragma unroll
        for (int t = 0; t < NT; ++t)
#pragma unroll
            for (int j = 0; j < 4; ++j) sc[t][j] -= d;
    }
    float ps = 0.f;
#pragma unroll
    for (int t = 0; t < NT; ++t)
#pragma unroll
        for (int j = 0; j < 4; ++j) { const float p = __builtin_amdgcn_exp2f(sc[t][j]); sc[t][j] = p; ps += p; }
    S.sum += ps;
#pragma unroll
    for (int ks = 0; ks < NT / 2; ++ks) { u32x4 pw; pw.x = pk2(sc[2 * ks][0], sc[2 * ks][1]); pw.y = pk2(sc[2 * ks][2], sc[2 * ks][3]); pw.z = pk2(sc[2 * ks + 1][0], sc[2 * ks + 1][1]); pw.w = pk2(sc[2 * ks + 1][2], sc[2 * ks + 1][3]);
        const bf16x8 pf = __builtin_bit_cast(bf16x8, pw);
#pragma unroll
        for (int dt = 0; dt < 4; ++dt) S.o[dt] = MFMA16(__builtin_bit_cast(bf16x8, vw[ks][dt]), pf, S.o[dt]); }
}
__device__ __forceinline__ void attn_unit2(const bf16* __restrict__ KQ, const bf16* __restrict__ VT, unsigned char* __restrict__ ATT, LAS unsigned char* lds,
                                           const int b, const int h, const int rowqA, const int rowqB, const bool win, const int r, const int qt, const int lane) {
    const int l15 = lane & 15, g = lane >> 4;
    const f32x4 z = {0.f, 0.f, 0.f, 0.f};
    bf16x8 qA[2], qB[2];
    { const bf16* qp = KQ + (size_t)(rowqA + l15) * 2048 + 1024 + h * 64 + 8 * g; qA[0] = *(const bf16x8*)qp; qA[1] = *(const bf16x8*)(qp + 32); }
    { const bf16* qp = KQ + (size_t)(rowqB + l15) * 2048 + 1024 + h * 64 + 8 * g; qB[0] = *(const bf16x8*)qp; qB[1] = *(const bf16x8*)(qp + 32); }
    AttnState SA, SB; SA.m = 0.f; SA.sum = 0.f; SB.m = 0.f; SB.sum = 0.f;
#pragma unroll
    for (int dt = 0; dt < 4; ++dt) { SA.o[dt] = z; SB.o[dt] = z; }
    if (win) {
        const int rsA = min(max(r - 4, 0), 56), dB = min(max(r - 3, 0), 56) - rsA, kc0 = min(max(16 * qt - 8, 0), 32);
        const int q = 16 * qt + l15, csq = min(max(q - 8, 0), 48);
        const int krow0 = 8 * (l15 >> 2) + (l15 & 3);
        const bf16* kb = KQ + (size_t)(b * SEQ + kc0 + krow0) * 2048 + h * 64 + 8 * g;
        const bf16* vb = VT + (size_t)(b * 1024 + h * 64 + l15) * 4096 + kc0 + 8 * g;
        const LAS float* rp = (const LAS float*)(lds + ALDS_RP);
        const int jb = kc0 + 8 * g;
        const int okb = jb - csq;
        const LAS float* rpl = rp + 16 + (jb - q + 15);
        float madd[2][4];
#pragma unroll
        for (int t = 0; t < 2; ++t)
#pragma unroll
            for (int j = 0; j < 4; ++j) madd[t][j] = ((unsigned)(okb + 4 * t + j) < 16u) ? 0.f : -__builtin_inff();
        bf16x8 K0[2][2], K1[2][2]; u32x4 V0[1][4], V1[1][4];
#define ATT_LOADW(KB, VB, i) do { const int gr_ = min(rsA + (i), 63); const bf16* kp_ = kb + (size_t)(gr_ * 64) * 2048; const bf16* vp_ = vb + gr_ * 64; \
        _Pragma("unroll") for (int t = 0; t < 2; ++t) { KB[t][0] = *(const bf16x8*)(kp_ + (size_t)(4 * t) * 2048); KB[t][1] = *(const bf16x8*)(kp_ + (size_t)(4 * t) * 2048 + 32); } \
        _Pragma("unroll") for (int dt = 0; dt < 4; ++dt) VB[0][dt] = *(const u32x4*)(vp_ + (size_t)(16 * dt) * 4096); } while (0)
#define ATT_ONE(ST, QF, KB, VB, roff, rowok) do { f32x4 sc[2]; \
        const LAS float* bp_ = rpl + ((rowok) ? (roff) : 15) * 64; \
        _Pragma("unroll") for (int t = 0; t < 2; ++t) _Pragma("unroll") for (int j = 0; j < 4; ++j) sc[t][j] = (bp_[4 * t + j] + madd[t][j]) - ST.m;     \
        _Pragma("unroll") for (int t = 0; t < 2; ++t) { sc[t] = MFMA16(KB[t][0], QF[0], sc[t]); sc[t] = MFMA16(KB[t][1], QF[1], sc[t]); } \
        attn_tail<2>(ST, sc, VB); } while (0)
#define ATT_COMPUTE(KB, VB, i) do { const int roffA_ = min(rsA + (i) - r + 7, 14); \
        ATT_ONE(SA, qA, KB, VB, roffA_, (i) <= 7); \
        ATT_ONE(SB, qB, KB, VB, max(roffA_ - 1, 0), (i) >= dB && (i) <= 7 + dB); } while (0)
        ATT_LOADW(K0, V0, 0);
#pragma unroll 1
        for (int i = 0; i < 8; i += 2) { ATT_LOADW(K1, V1, i + 1); ATT_COMPUTE(K0, V0, i); ATT_LOADW(K0, V0, i + 2); ATT_COMPUTE(K1, V1, i + 1); }
        ATT_COMPUTE(K0, V0, 8);
#undef ATT_LOADW
#undef ATT_ONE
#undef ATT_COMPUTE
    }
    { const LAS bf16* ck = (const LAS bf16*)(lds + ALDS_CK) + l15 * ACK_STRIDE + 8 * g;
      const LAS bf16* cv = (const LAS bf16*)(lds + ALDS_CV) + l15 * ACV_STRIDE + 8 * g;
#pragma unroll 1
      for (int c = 0; c < 4; ++c) {
          bf16x8 kf[4][2]; u32x4 vw[2][4];
#pragma unroll
          for (int t = 0; t < 4; ++t) { const LAS bf16* kp = ck + (64 * c + 16 * t) * ACK_STRIDE; kf[t][0] = *(const LAS bf16x8*)kp; kf[t][1] = *(const LAS bf16x8*)(kp + 32); }
#pragma unroll
          for (int ks = 0; ks < 2; ++ks)
#pragma unroll
              for (int dt = 0; dt < 4; ++dt) vw[ks][dt] = *(const LAS u32x4*)(cv + (16 * dt) * ACV_STRIDE + 64 * c + 32 * ks);
          { f32x4 sc[4]; const float nm = -SA.m; const f32x4 c0 = {nm, nm, nm, nm};
#pragma unroll
            for (int t = 0; t < 4; ++t) { sc[t] = MFMA16(kf[t][0], qA[0], c0); sc[t] = MFMA16(kf[t][1], qA[1], sc[t]); }
            attn_tail<4>(SA, sc, vw); }
          { f32x4 sc[4]; const float nm = -SB.m; const f32x4 c0 = {nm, nm, nm, nm};
#pragma unroll
            for (int t = 0; t < 4; ++t) { sc[t] = MFMA16(kf[t][0], qB[0], c0); sc[t] = MFMA16(kf[t][1], qB[1], sc[t]); }
            attn_tail<4>(SB, sc, vw); }
      } }
    { const float inv = 1.0f / xrow16_sum(SA.sum);
#pragma unroll
      for (int dt = 0; dt < 4; ++dt) { const f32x4 o = SA.o[dt] * (inv * ATS); *(unsigned*)(ATT + (size_t)(rowqA + l15) * 1024 + h * 64 + 16 * dt + 4 * g) = pk4_fp8(o[0], o[1], o[2], o[3]); } }
    { const float inv = 1.0f / xrow16_sum(SB.sum);
#pragma unroll
      for (int dt = 0; dt < 4; ++dt) { const f32x4 o = SB.o[dt] * (inv * ATS); *(unsigned*)(ATT + (size_t)(rowqB + l15) * 1024 + h * 64 + 16 * dt + 4 * g) = pk4_fp8(o[0], o[1], o[2], o[3]); } }
}
__device__ __forceinline__ void p_attn_mfma(const Params& P, Frame& F, int l, bool with_ctx_queries, int nblk, int rank) {
    const bf16* KQ = WSP(bf16, WS_KQ); const bf16* VT = WSP(bf16, WS_VT); unsigned char* ATT = WSP(unsigned char, WS_ATT);
    const float* rpb = P.rpb + (size_t)l * 16 * 465;
    const int it0 = (int)(((long)rank * 2048) / nblk), it1 = (int)(((long)(rank + 1) * 2048) / nblk);
    int pcur = -1;
    for (int hp = it0; hp < it1; ++hp) {
        const int p = hp >> 4, eighth = (hp >> 1) & 7, st = hp & 1, b = p >> 4, h = p & 15;
        if (p != pcur) { pcur = p;
        __syncthreads();
        { LAS bf16* ck = (LAS bf16*)(F.lds + ALDS_CK); LAS bf16* cv = (LAS bf16*)(F.lds + ALDS_CV); LAS float* rp = (LAS float*)(F.lds + ALDS_RP);
          { const int key = F.tid >> 1, hf = F.tid & 1; const int k32 = key & 31, pos = (key & ~31) + ((k32 >> 2) & 1) * 16 + 4 * (k32 >> 3) + (k32 & 3);
            const u32x4* src = (const u32x4*)(KQ + (size_t)(RL + b * CTXL + key) * 2048 + h * 64 + hf * 32); LAS u32x4* dst = (LAS u32x4*)(ck + pos * ACK_STRIDE + hf * 32);
#pragma unroll
            for (int i = 0; i < 4; ++i) dst[i] = src[i]; }
          { const int d = F.tid >> 3, sg = F.tid & 7; const u32x4* src = (const u32x4*)(VT + YT_CTX_OFF + (size_t)(b * 1024 + h * 64 + d) * 256 + sg * 32); LAS u32x4* dst = (LAS u32x4*)(cv + d * ACV_STRIDE + sg * 32);
#pragma unroll
            for (int i = 0; i < 4; ++i) dst[i] = src[i]; }
          for (int i = F.tid; i < 16 * 64; i += NTHREADS) { const int rr = i >> 6, cc = (i & 63) - 16; rp[i] = rr == 15 ? -__builtin_inff() : ((cc >= 0 && cc < 31) ? rpb[h * 465 + rr * 31 + cc] * LOG2E : 0.f); } }
        __syncthreads(); }
        const int qt = F.wave & 3, rpi = F.wave >> 2;
        { const int r = eighth * 8 + st * 4 + rpi * 2; const int rowqA = b * SEQ + r * 64 + 16 * qt;
            attn_unit2(KQ, VT, ATT, F.lds, b, h, rowqA, rowqA + 64, true, r, qt, F.lane); }
        if (with_ctx_queries && eighth == 0 && st == 0) { const int rowqA = RL + b * CTXL + 32 * F.wave; attn_unit2(KQ, VT, ATT, F.lds, b, h, rowqA, rowqA + 16, false, 0, 0, F.lane); }
    }
    __syncthreads();
}

__device__ __forceinline__ void ld8(const bf16* p, float (&x)[8]) { const u32x4 w = *(const u32x4*)p;
#pragma unroll
    for (int q = 0; q < 4; ++q) { x[2 * q] = bflo(w[q]); x[2 * q + 1] = bfhi(w[q]); } }
__device__ __forceinline__ void add8(float (&S)[8], u32x4 w, float sg) {
    asm volatile("" : "+v"(w));
#pragma unroll
    for (int q = 0; q < 4; ++q) { S[2 * q] += sg * bflo(w[q]); S[2 * q + 1] += sg * bfhi(w[q]); }
}
template <int HW> __device__ __forceinline__ void pool_item(const bf16* src, bf16* dst, int t0, int Lb) {
    constexpr int NR = 16 + 2 * HW;
    u32x4 x[NR];
#pragma unroll
    for (int r = 0; r < NR; ++r) { const int tt = t0 - HW + r; x[r] = (tt >= 0 && tt < Lb) ? *(const u32x4*)(src + (size_t)tt * 512) : (u32x4){0u, 0u, 0u, 0u}; }
    float S[8];
#pragma unroll
    for (int q = 0; q < 8; ++q) S[q] = 0.f;
#pragma unroll
    for (int r = 0; r < 2 * HW; ++r) add8(S, x[r], 1.f);
#pragma unroll
    for (int j = 0; j < 16; ++j) { const int t = t0 + j; const int lo = max(t - HW, 0), hi = min(t + HW, Lb); const float inv = 1.0f / (float)(hi - lo);
        u32x4 me = x[HW + j]; asm volatile("" : "+v"(me)); u32x4 o;
#pragma unroll
        for (int q = 0; q < 4; ++q) o[q] = pk2(S[2 * q] * inv - bflo(me[q]), S[2 * q + 1] * inv - bfhi(me[q]));
        *(u32x4*)(dst + (size_t)t * 512) = o;
        add8(S, x[2 * HW + j], 1.f); add8(S, x[j], -1.f); }
}
__device__ __forceinline__ void p_pool(Frame& F, int nrows) {
    const bf16* PB = WSP(bf16, WS_PB); bf16* POOL = WSP(bf16, WS_POOL);
    for (int i = F.bid * NTHREADS + F.tid; i < (nrows >> 4) * 64; i += F.G * NTHREADS) {
        const int c16 = i & 15, g = (i >> 6) & 3, row0 = (((i >> 8) << 2) + ((i >> 4) & 3)) << 4, ch = g * 16 + c16;
        int base, t0, Lb; if (row0 < RL) { base = row0 & ~4095; t0 = row0 & 4095; Lb = SEQ; } else { const int rr = row0 - RL; base = RL + (rr & ~255); t0 = rr & 255; Lb = CTXL; }
        const bf16* src = PB + (size_t)base * 512 + ch * 8; bf16* dst = POOL + (size_t)base * 512 + ch * 8;
        if (g == 0) pool_item<1>(src, dst, t0, Lb); else if (g == 1) pool_item<2>(src, dst, t0, Lb); else if (g == 2) pool_item<4>(src, dst, t0, Lb); else pool_item<8>(src, dst, t0, Lb);
    }
}

__device__ __forceinline__ int block_sum_i(int v, LAS int* sm, int tid) {
    v = wave_sum_i(v);
    __syncthreads();
    if ((tid & 63) == 0) sm[tid >> 6] = v;
    __syncthreads();
    int s = 0;
#pragma unroll
    for (int i = 0; i < 8; ++i) s += sm[i];
    return s;
}
__device__ __forceinline__ int block_excl_scan(int v, LAS int* sm, int tid, int& total) {
    const int lane = tid & 63, w = tid >> 6; int inc = v;
#pragma unroll
    for (int o = 1; o < 64; o <<= 1) { const int t = __builtin_amdgcn_ds_bpermute(((lane - o) & 63) << 2, inc); if (lane >= o) inc += t; }
    __syncthreads();
    if (lane == 63) sm[w] = inc;
    __syncthreads();
    int base = 0; total = 0;
#pragma unroll
    for (int i = 0; i < 8; ++i) { const int s = sm[i]; if (i < w) base += s; total += s; }
    return base + inc - v;
}
template <int NPT>
__device__ __forceinline__ void topk_pair(Frame& F, int row0, int n, int cap, int e, int slot0) {
    LAS int* sm = (LAS int*)F.lds;
    const float* AFF = WSP(float, WS_AFF); int* SROW = WSP(int, WS_SROW); float* SG = WSP(float, WS_SGATE); int* SEL = WSP(int, WS_SEL);
    unsigned key[NPT];
#pragma unroll
    for (int j = 0; j < NPT; ++j) { const int i = F.tid * NPT + j; key[j] = (i < n) ? __float_as_uint(AFF[(size_t)(row0 + i) * 16 + e]) : 0u; }
    unsigned T = 0u;
    for (int bit = 30; bit >= 0; --bit) { const unsigned cand = T | (1u << bit); int cnt = 0;
#pragma unroll
        for (int j = 0; j < NPT; ++j) cnt += (key[j] >= cand) ? 1 : 0;
        cnt = block_sum_i(cnt, sm, F.tid);
        if (cnt >= cap) T = cand; }
    int ngt = 0, neq = 0;
#pragma unroll
    for (int j = 0; j < NPT; ++j) { ngt += (key[j] > T) ? 1 : 0; neq += (key[j] == T) ? 1 : 0; }
    int tot_gt, tot_eq;
    (void)block_excl_scan(ngt, sm, F.tid, tot_gt);
    int eqr = block_excl_scan(neq, sm, F.tid, tot_eq);
    const int need_eq = cap - tot_gt;
    int nsel = 0; bool selj[NPT];
#pragma unroll
    for (int j = 0; j < NPT; ++j) { bool s = key[j] > T; if (key[j] == T && T != 0u) { s = eqr < need_eq; ++eqr; } selj[j] = s; nsel += s ? 1 : 0; }
    int tot_sel; int pos = block_excl_scan(nsel, sm, F.tid, tot_sel);
#pragma unroll
    for (int j = 0; j < NPT; ++j) { const int i = F.tid * NPT + j;
        if (i < n) { const int row = row0 + i;
            if (selj[j]) { const int slot = slot0 + pos; ++pos; SROW[slot] = row; SG[slot] = __uint_as_float(key[j]); SEL[(size_t)row * 16 + e] = slot; }
            else SEL[(size_t)row * 16 + e] = -1; } }
    __syncthreads();
}
__device__ __forceinline__ void p_topk(Frame& F, bool with_ctx) {
    const int npairs = 128 + (with_ctx ? 128 : 0);
    for (int pi = F.bid; pi < npairs; pi += F.G) {
        if (pi < 128) { const int b = pi >> 4, e = pi & 15; topk_pair<8>(F, b * SEQ, SEQ, CAPL, e, e * SLOT_E + b * CAPL); }
        else { const int p2 = pi - 128, b = p2 >> 4, e = p2 & 15; topk_pair<1>(F, RL + b * CTXL, CTXL, CAPC, e, e * SLOT_E + 4096 + b * CAPC); }
    }
}
template <int PH> __global__ void __launch_bounds__(NTHREADS, 2) fwd_kernel(Params P) {
    extern __shared__ __attribute__((aligned(16))) unsigned char lds_raw[];
    Frame F; F.lds = (LAS unsigned char*)lds_raw; F.tid = threadIdx.x; F.lane = F.tid & 63; F.wave = __builtin_amdgcn_readfirstlane(F.tid >> 6); F.G = gridDim.x; F.bid = blockIdx.x; F.ws = P.ws;
    const int wave0 = __builtin_amdgcn_readfirstlane((int)threadIdx.x >> 6);
    volatile LAS unsigned* MISC = (volatile LAS unsigned*)(F.lds + LDS_MISC);
    if (F.tid < 64) MISC[F.tid] = 0u;
    __syncthreads();
    XcdBarrier bar; bar.bar = WSP(unsigned, WS_CTL) + CW_BAR; bar.x = 0; bar.st = MISC + 8;
    if constexpr (PH < 0) bar = xcd_barrier_post(WSP(unsigned, WS_CTL) + CW_BAR, MISC + 8);
#define IN(k) (PH < 0 || PH == (k))
#define REFRESH() do { unsigned on_ = ~0u; asm volatile("" : "+s"(on_)); int t_ = wave0 * 64 + (int)__builtin_amdgcn_mbcnt_hi(on_, __builtin_amdgcn_mbcnt_lo(on_, 0u)); asm volatile("" : "+v"(t_)); F.tid = t_; F.lane = t_ & 63; F.wave = __builtin_amdgcn_readfirstlane(t_ >> 6); } while (0)
#define SEAM(k) do { if constexpr (PH < 0) xcd_barrier(bar); } while (0)

    if (IN(0)) { REP_BEGIN(100) p_mod(P, F); p_dftgen(F); REP_END REP_BEGIN(101) p_wconv(P, F, 0); REP_END }
    SEAM(0);
    if (IN(1)) { p_rftables(P, F); p_rowpass_a0(P, F); }
    SEAM(1);
    for (int l = P.l_lo; l < P.l_hi; ++l) {
        constexpr int pb = 2; const bool L0 = (l == 0);
        bf16* H = WSP(bf16, WS_H);
        if (IN(pb + 0)) { REFRESH(); REP_BEGIN(2)
            const int u1 = 128 * 8 + 8 * (L0 ? 8 : 4), u2a = 128 * 2 + (L0 ? 8 * 2 : 0), u2 = u2a + 128 * 12 + (L0 ? 8 * 12 : 0), u3 = 4 * 128 + (L0 ? 4 * 8 : 0);
            const bf16* H8 = WSP(bf16, WS_H8); const bf16* WA8 = WSP(bf16, WS_WA8);
            { GroupSched S; S.init(1, 128, 8, F.G, F.bid, 8, L0 ? 8 : 4, 128, 0);
              auto AD = [=](const Unit& u) { return Operands{H8 + (size_t)u.pm * 256 * 512, WA8 + (size_t)u.pn * 256 * 512, 512, 512, 0, 512}; };
              bf16* KQ = WSP(bf16, WS_KQ);
              auto E = [=](EPI_ARGS) { const int row0 = u.pm * 256; const float qs = (u.pn >= 4) ? QSCALE * INV8 : INV8;
                  EPI_FOR8( st_bf8(KQ + (size_t)(row0 + r) * 2048 + u.pn * 256 + c, v0 * qs, v1 * qs); ) };
              GEMM_P8(S, AD, E); }
            REFRESH();
            { GroupSched S; S.init(1, 128, 2, F.G, (F.bid + F.G - ((u1 % F.G) & ~7)) % F.G, L0 ? 8 : 0, 2, 128, 0);
              const bf16* WA = WSP(bf16, WS_WA);
              auto AD = [=](const Unit& u) { return Operands{H + (size_t)u.pm * 256 * DM, WA + (size_t)(u.pn + 8) * 256 * DM, DM, DM, 0, DM}; };
              bf16* PBp = WSP(bf16, WS_PB);
              auto E = [=](EPI_ARGS) { const int row0 = u.pm * 256; EPI_FOR8( st_bf8(PBp + (size_t)(row0 + r) * 512 + u.pn * 256 + c, v0, v1); ) };
              GEMM_P(S, AD, E); }
            REFRESH();
            { GroupSched S; S.init(1, 128, 12, F.G, (F.bid + F.G - (((u1 + u2a) % F.G) & ~7)) % F.G, L0 ? 8 : 0, 12, 128, 0);
              bf16* GB = WSP(bf16, WS_GB);
              auto AD = [=](const Unit& u) { return Operands{H8 + (size_t)u.pm * 256 * 512, WA8 + (size_t)(3072 + u.pn * 256) * 512, 512, 512, 0, 512}; };
              auto E = [=](EPI_ARGS) { const int row0 = u.pm * 256;
                  EPI_FOR8( f32x4 s0; f32x4 s1; _Pragma("unroll") for (int j = 0; j < 4; ++j) { s0[j] = sigmoidf_(v0[j] * INV8); s1[j] = sigmoidf_(v1[j] * INV8); } st_bf8(GB + (size_t)(row0 + r) * 3072 + u.pn * 256 + c, s0, s1); ) };
              GEMM_P8(S, AD, E); }
            REFRESH();
            { GroupSched S; S.init(1, 4, 128, F.G, (F.bid + F.G - (((u1 + u2) % F.G) & ~7)) % F.G, L0 ? 4 : 0, 8, 0, 128);
              const bf16* WFV = WSP(bf16, WS_WFV);
              auto AD = [=](const Unit& u) { const bool fmap = (u.pn < 128); const int t16 = u.pn & 15;
                  const size_t tok0 = fmap ? (size_t)(u.pn >> 4) * SEQ + 64 * ((t16 >> 1) * 8) + (t16 & 1) * 32 : (size_t)u.pn * 256;
                  return Operands{WFV + (size_t)u.pm * 256 * DM, H + tok0 * DM, DM, DM, 0, DM, fmap ? 1 : 0}; };
              bf16* YT = WSP(bf16, WS_YT);
              auto E = [=](EPI_ARGS) { const int rr0 = u.pm * 256;
                  if (u.pn < 128) { const int b = u.pn >> 4; const int t16 = u.pn & 15, l10 = (t16 >> 1) * 8, l20 = (t16 & 1) * 32;
                      EPI_FOR8( const int fc = rr0 + r; st_bf8(YT + (((((size_t)b * 512 + (fc >> 1)) * 32 + (c >> 3)) * 2 + (l20 >> 5)) * 2 + (fc & 1)) * 64 + l10, v0, v1); ) }
                  else { const int b = u.pn - 128; EPI_FOR8( st_bf8(YT + YT_CTX_OFF + ((size_t)b * 1024 + rr0 + r) * 256 + c, v0, v1); ) } };
              GEMM_P(S, AD, E); }
            REFRESH();
            { GroupSched S; S.init(1, 4, 128, F.G, (F.bid + F.G - (((u1 + u2 + u3) % F.G) & ~7)) % F.G, 4, 8, 0, 128);
              auto AD = [=](const Unit& u) { return Operands{WA8 + (size_t)(2048 + u.pm * 256) * 512, H8 + (size_t)u.pn * 256 * 512, 512, 512, 0, 512}; };
              bf16* VT = WSP(bf16, WS_VT);
              auto E = [=](EPI_ARGS) { const int rr0 = u.pm * 256;
                  if (u.pn < 128) { const int b = u.pn >> 4, l0 = (u.pn & 15) * 256; EPI_FOR8( st_bf8(VT + ((size_t)b * 1024 + rr0 + r) * 4096 + l0 + c, v0 * INV8, v1 * INV8); ) }
                  else { const int b = u.pn - 128; EPI_FOR8( st_bf8(VT + YT_CTX_OFF + ((size_t)b * 1024 + rr0 + r) * 256 + c, v0 * INV8, v1 * INV8); ) } };
              GEMM_P8(S, AD, E); }
        REP_END }
        SEAM(pb + 0);
        if (IN(pb + 1)) { REFRESH();
            { const int nc0 = F.G * (L0 ? 69 : 27) / 256, nconv = nc0 > 0 ? nc0 : 1, na = F.G - nconv;
              if (F.bid < na) p_attn_mfma(P, F, l, L0, na, F.bid);
              else wconv_experts(P, F, l, F.bid - na, nconv, L0 ? 0 : CV_C, CV_NIT); }
            REFRESH();
            REP_BEGIN(32)
            { LAS float* tw = (LAS float*)(F.lds + LDS_TW);
              for (int j = F.tid; j < 4096; j += NTHREADS) tw[j] = cospif((float)j * (1.0f / 2048.0f));
              __syncthreads();
              GroupSched S; S.init(1, 1, 512, F.G, F.bid);
              const bf16* M1 = WSP(bf16, WS_M1T); const bf16* YF = WSP(bf16, WS_YT); bf16* ZP = WSP(bf16, WS_ZP);
              auto AD = [=](const Unit& u) { return Operands{M1, YF + (size_t)u.pn * 256 * 256, 256, 256, 0, 256}; };
              auto E = [=](EPI_ARGS) {
                  const int b = u.pn >> 6, gm0 = (u.pn & 63) * 8 + wc, l20 = 32 * wr + 8 * fq;
#pragma unroll
                  for (int m = 0; m < 4; ++m) { const int k1 = 16 * m + fr;
#pragma unroll
                      for (int bj = 0; bj < 2; ++bj) { const int gm = gm0 + 4 * bj;
                          f32x4 zr[2], zi[2];
#pragma unroll
                          for (int n = 0; n < 2; ++n)
#pragma unroll
                              for (int j = 0; j < 4; ++j) { const int ix = k1 * (l20 + 4 * n + j); const float tc = tw[ix], ts = tw[(ix + 3072) & 4095];
                                  const float ur = acc[0][bj][m][n][j], ui = acc[1][bj][m][n][j]; zr[n][j] = ur * tc - ui * ts; zi[n][j] = ur * ts + ui * tc; }
                          bf16* dst = ZP + (((((size_t)b * 64 + k1) * 128 + (gm & 127)) * 4 + (gm >> 7)) * 2) * 64 + l20;
                          st_bf8(dst, zr[0], zr[1]); st_bf8(dst + 64, zi[0], zi[1]); } } };
              GEMM_P(S, AD, E); }
            REP_END
        }
        SEAM(pb + 1);
        if (IN(pb + 10)) { REFRESH();
            { GroupSched S; S.init(1, L0 ? 136 : 128, 4, F.G, F.bid);
              const bf16* A8 = WSP(bf16, WS_ATT); const bf16* W8 = WSP(bf16, WS_WAO); const bf16* GB = WSP(bf16, WS_GB); bf16* YA = WSP(bf16, WS_KQ);
              auto AD = [=](const Unit& u) { return Operands{A8 + (size_t)u.pm * 256 * 512, W8 + (size_t)u.pn * 256 * 512, 512, 512, 0, 512}; };
              auto E = [=](EPI_ARGS) { const int colb = u.pn * 256 + wc * 32 + 8 * fq;
#pragma unroll
                  for (int ai = 0; ai < 2; ++ai) { u32x4 g0[4][2];
#pragma unroll
                      for (int m = 0; m < 4; ++m)
#pragma unroll
                          for (int bj = 0; bj < 2; ++bj) g0[m][bj] = *(const u32x4*)(GB + ((size_t)u.pm * 256 + ai * 128 + wr * 64 + m * 16 + fr) * 3072 + colb + bj * 128);
#pragma unroll
                      for (int m = 0; m < 4; ++m)
#pragma unroll
                          for (int bj = 0; bj < 2; ++bj) { const u32x4 g = g0[m][bj]; const f32x4 ga = {bflo(g[0]), bfhi(g[0]), bflo(g[1]), bfhi(g[1])}, gb = {bflo(g[2]), bfhi(g[2]), bflo(g[3]), bfhi(g[3])};
                              st_bf8(YA + ((size_t)u.pm * 256 + ai * 128 + wr * 64 + m * 16 + fr) * 1024 + colb + bj * 128, acc[ai][bj][m][0] * ga * INVAT, acc[ai][bj][m][1] * gb * INVAT); } } };
              GEMM_P8(S, AD, E); }
            REFRESH();
            { GroupSched S; S.init(1, 1, 256, F.G, F.bid);
              const bf16* M2 = WSP(bf16, WS_M2T); const bf16* ZP = WSP(bf16, WS_ZP); bf16* FOUR = WSP(bf16, WS_FOUR);
              auto AD = [=](const Unit& u) { return Operands{M2, ZP + (size_t)u.pn * 256 * 512, 512, 512, 0, 512}; };
              auto E = [=](EPI_ARGS) { const float sc = 0.0013810679320049757f;
#pragma unroll
                  for (int ai = 0; ai < 2; ++ai)
#pragma unroll
                      for (int m = 0; m < 4; ++m) { const int q = 2 * ai + wr, k2 = 16 * m + fr;
#pragma unroll
                          for (int bj = 0; bj < 2; ++bj) { const int bk = u.pn * 2 + bj, b = bk >> 6, k1 = bk & 63;
                              st_bf8(FOUR + ((size_t)b * SEQ + k1 + 64 * k2) * 512 + q * 128 + wc * 32 + 8 * fq, acc[ai][bj][m][0] * sc, acc[ai][bj][m][1] * sc); } } };
              GEMM_P(S, AD, E); }
            REFRESH();
            if (L0) { GroupSched S; S.init(1, 1, 16, F.G, (F.bid + F.G - 128 % F.G) % F.G);
              const bf16* DFTC = WSP(bf16, WS_DFTC); const bf16* YTC = WSP(bf16, WS_YT) + YT_CTX_OFF; bf16* FOUR = WSP(bf16, WS_FOUR);
              auto AD = [=](const Unit& u) { return Operands{DFTC, YTC + (size_t)u.pn * 256 * 512, 512, 512, 0, 512}; };
              auto E = [=](EPI_ARGS) { const int b = u.pn >> 1, c0 = (u.pn & 1) * 256; const float sc = 0.005524271728019903f;
                  EPI_FOR8( st_bf8(FOUR + ((size_t)RL + b * CTXL + r) * 512 + c0 + c, v0 * sc, v1 * sc); ) };
              GEMM_P(S, AD, E); }
            REFRESH();
            REP_BEGIN(33) p_pool(F, L0 ? RT : RL); REP_END
        }
        SEAM(pb + 10);
        if (IN(pb + 2)) { REFRESH();
            SegSched<2> S; S.base.init(1, L0 ? 136 : 128, 4, F.G, F.bid);
            const bf16* FOUR = WSP(bf16, WS_FOUR); const bf16* POOL = WSP(bf16, WS_POOL); const bf16* WFO = WSP(bf16, WS_WFO); const bf16* WPO = WSP(bf16, WS_WPO);
            const bf16* GB = WSP(bf16, WS_GB); const bf16* YA = WSP(bf16, WS_KQ); bf16* MRGB = WSP(bf16, WS_MRGB); const float* ps = P.pool_scale + l * 1024;
            auto AD = [=](const Unit& u) {
                if (u.seg == 0) return Operands{FOUR + (size_t)u.pm * 256 * 512, WFO + (size_t)u.pn * 256 * 512, 512, 512, 0, 512};
                return Operands{POOL + (size_t)u.pm * 256 * 512 + u.pn * 128, WPO + (size_t)u.pn * 256 * 128, 512, 128, 0, 128}; };
            auto E = [=](EPI_ARGS) {
                const bool fin = (u.seg == 1); const int colb = u.pn * 256 + wc * 32 + 8 * fq;
                f32x4 psv[2][2];
#pragma unroll
                for (int bj = 0; bj < 2; ++bj)
#pragma unroll
                    for (int n = 0; n < 2; ++n) { f32x4 p = *(const f32x4*)(ps + colb + bj * 128 + 4 * n);
#pragma unroll
                        for (int j = 0; j < 4; ++j) p[j] = (fabsf(p[j]) < 1e-18f) ? copysignf(1e-18f, p[j]) : p[j];
                        psv[bj][n] = p; }
#pragma unroll
                for (int ai = 0; ai < 2; ++ai)
#pragma unroll
                    for (int m = 0; m < 4; ++m) { const size_t row = (size_t)u.pm * 256 + ai * 128 + wr * 64 + m * 16 + fr; const bf16* gr = GB + row * 3072 + colb;
                        u32x4 g1r[2], g2r[2], yar[2];
#pragma unroll
                        for (int bj = 0; bj < 2; ++bj) { g2r[bj] = *(const u32x4*)(gr + 2048 + bj * 128); if (fin) yar[bj] = *(const u32x4*)(YA + row * 1024 + colb + bj * 128); else g1r[bj] = *(const u32x4*)(gr + 1024 + bj * 128); }
#pragma unroll
                        for (int bj = 0; bj < 2; ++bj) { f32x4 o[2];
#pragma unroll
                            for (int n = 0; n < 2; ++n) { const u32x4 xr = fin ? yar[bj] : g1r[bj];
                                const f32x4 g2 = (f32x4){fmaxf(bflo(g2r[bj][2 * n]), 1e-18f), fmaxf(bfhi(g2r[bj][2 * n]), 1e-18f), fmaxf(bflo(g2r[bj][2 * n + 1]), 1e-18f), fmaxf(bfhi(g2r[bj][2 * n + 1]), 1e-18f)} * psv[bj][n];
                                const f32x4 x = {bflo(xr[2 * n]), bfhi(xr[2 * n]), bflo(xr[2 * n + 1]), bfhi(xr[2 * n + 1])};
#pragma unroll
                                for (int j = 0; j < 4; ++j) o[n][j] = fin ? (x[j] + acc[ai][bj][m][n][j] * g2[j]) : (acc[ai][bj][m][n][j] * x[j] * __builtin_amdgcn_rcpf(g2[j]));
                                acc[ai][bj][m][n] = o[n]; }
                            if (fin) st_bf8(MRGB + row * 1024 + colb + bj * 128, o[0], o[1]); } } };
            gemm_fast<false, true, false>(F.lds, F.tid, S, AD, mk_epi_seg(E, 1), nullptr);
            if (L0) { const int nun = 136 * 4, busy = nun - ((nun - 1) / F.G) * F.G;
                if (busy < F.G && F.bid >= busy) wconv_experts(P, F, 1, F.bid - busy, F.G - busy, 0, CV_A); }
        }
        SEAM(pb + 2);
        if (IN(pb + 3)) { REFRESH();
            GroupSched S; S.init(1, L0 ? 136 : 128, 4, F.G, F.bid); const bf16* A = WSP(bf16, WS_MRGB); const bf16* W = WSP(bf16, WS_WOUT);
            bf16* XB = WSP(bf16, WS_XB); const float* MOD = WSP(float, WS_MOD) + (size_t)l * 9 * 6144;
            auto AD = [=](const Unit& u) { return Operands{A + (size_t)u.pm * 256 * 1024, W + (size_t)u.pn * 256 * 1024, 1024, 1024, 0, 1024}; };
            auto E = [=](EPI_ARGS) {
                const int row0 = u.pm * 256, mr = row0 < RL ? (row0 >> 12) : 8, colb = u.pn * 256 + wc * 32 + 8 * fq;
                bf16* dst0 = XB + (size_t)row0 * DM;
                f32x4 gv[2][2];
#pragma unroll
                for (int bj = 0; bj < 2; ++bj)
#pragma unroll
                    for (int n = 0; n < 2; ++n) gv[bj][n] = *(const f32x4*)(MOD + (size_t)mr * 6144 + 2048 + colb + bj * 128 + 4 * n);
                if (L0) { const float* src0 = row0 < RL ? P.x + (size_t)row0 * DM : P.ctx + (size_t)(row0 - RL) * DM;
#pragma unroll
                    for (int am = 0; am < 4; ++am) { const int ai = am >> 1, mh = (am & 1) * 2; f32x4 xv[2][2][2];
#pragma unroll
                        for (int m = 0; m < 2; ++m) { const size_t ro = (size_t)(ai * 128 + wr * 64 + (mh + m) * 16 + fr) * DM + colb;
#pragma unroll
                            for (int bj = 0; bj < 2; ++bj)
#pragma unroll
                                for (int n = 0; n < 2; ++n) xv[m][bj][n] = *(const f32x4*)(src0 + ro + bj * 128 + 4 * n); }
#pragma unroll
                        for (int m = 0; m < 2; ++m) { const size_t ro = (size_t)(ai * 128 + wr * 64 + (mh + m) * 16 + fr) * DM + colb;
#pragma unroll
                            for (int bj = 0; bj < 2; ++bj) st_bf8(dst0 + ro + bj * 128, xv[m][bj][0] + gv[bj][0] * acc[ai][bj][mh + m][0], xv[m][bj][1] + gv[bj][1] * acc[ai][bj][mh + m][1]); } }
                } else {
#pragma unroll
                    for (int ai = 0; ai < 2; ++ai) { u32x4 xr[4][2];
#pragma unroll
                        for (int m = 0; m < 4; ++m) { const size_t ro = (size_t)(ai * 128 + wr * 64 + m * 16 + fr) * DM + colb;
#pragma unroll
                            for (int bj = 0; bj < 2; ++bj) xr[m][bj] = *(const u32x4*)(dst0 + ro + bj * 128); }
#pragma unroll
                        for (int m = 0; m < 4; ++m) { const size_t ro = (size_t)(ai * 128 + wr * 64 + m * 16 + fr) * DM + colb;
#pragma unroll
                            for (int bj = 0; bj < 2; ++bj) { const u32x4 x = xr[m][bj]; const f32x4 xa = {bflo(x[0]), bfhi(x[0]), bflo(x[1]), bfhi(x[1])}, xb = {bflo(x[2]), bfhi(x[2]), bflo(x[3]), bfhi(x[3])};
                                st_bf8(dst0 + ro + bj * 128, xa + gv[bj][0] * acc[ai][bj][m][0], xb + gv[bj][1] * acc[ai][bj][m][1]); } } } } };
            GEMM_P(S, AD, E);
            if (L0) { const int nun = 136 * 4, busy = nun - ((nun - 1) / F.G) * F.G;
                if (busy < F.G && F.bid >= busy) wconv_experts(P, F, 1, F.bid - busy, F.G - busy, CV_A, CV_B); }
        }
        SEAM(pb + 3);
        if (IN(pb + 4)) { REFRESH(); REP_BEGIN(6) p_rowpass_f(P, F, l, L0 ? RT : RL); REP_END }
        SEAM(pb + 4);
        if (IN(pb + 5)) { REFRESH(); REP_BEGIN(7) p_topk(F, L0); REP_END }
        SEAM(pb + 5);
        if (IN(pb + 7)) { REFRESH(); REP_BEGIN(9)
            GroupSched S; S.init(16, L0 ? 17 : 16, 22, F.G, F.bid); const bf16* H8 = WSP(bf16, WS_H8); const bf16* W = WSP(bf16, l ? WS_WGU1 : WS_WGU); unsigned char* HID = WSP(unsigned char, WS_HID); const int* SROW = WSP(int, WS_SROW);
            auto AD = [=](const Unit& u) { return Operands{H8, W + ((size_t)u.grp * 5632 + u.pn * 256) * 512, 512, 512, u.grp * SLOT_E + u.pm * 256, 512}; };
            auto E = [=](EPI_ARGS) {
#pragma unroll
                for (int ai = 0; ai < 2; ++ai)
#pragma unroll
                    for (int m = 0; m < 4; ++m) { const size_t slot = (size_t)u.grp * SLOT_E + u.pm * 256 + ai * 128 + wr * 64 + m * 16 + fr; f32x4 o[2];
#pragma unroll
                        for (int n = 0; n < 2; ++n) { const f32x4 a = acc[ai][0][m][n] * INV8, up = acc[ai][1][m][n] * (INV8 * A8S);
#pragma unroll
                            for (int j = 0; j < 4; ++j) o[n][j] = a[j] * sigmoidf_(a[j]) * up[j]; }
                        u32x2 w; w.x = pk4_fp8(o[0][0], o[0][1], o[0][2], o[0][3]); w.y = pk4_fp8(o[1][0], o[1][1], o[1][2], o[1][3]);
                        *(u32x2*)(HID + slot * FF + u.pn * 128 + wc * 32 + 8 * fq) = w; } };
            GEMM_GATHER8(S, AD, E, SROW);
        REP_END }
        SEAM(pb + 7);
        if (IN(pb + 8)) { REFRESH(); REP_BEGIN(10)
            const int tpe = L0 ? 17 : 16;
            GroupSched S; S.init(1, 16 * tpe, 4, F.G, F.bid); const bf16* HID = WSP(bf16, WS_HID); const bf16* W = WSP(bf16, l ? WS_WD1 : WS_WD); bf16* Y = WSP(bf16, WS_Y); const float* SG = WSP(float, WS_SGATE);
            auto AD = [=](const Unit& u) { const int e = u.pm / tpe, st = e * 17 + (u.pm - e * tpe); return Operands{HID + (size_t)st * 256 * (FF / 2), W + ((size_t)e * 1024 + u.pn * 256) * (FF / 2), FF / 2, FF / 2, 0, FF / 2}; };
            auto E = [=](EPI_ARGS) { const int e = u.pm / tpe; const size_t slot0 = (size_t)(e * 17 + (u.pm - e * tpe)) * 256 + wr * 64 + fr; float gt[2][4];
#pragma unroll
                for (int ai = 0; ai < 2; ++ai)
#pragma unroll
                    for (int m = 0; m < 4; ++m) gt[ai][m] = SG[slot0 + ai * 128 + m * 16] * INV8;
#pragma unroll
                for (int ai = 0; ai < 2; ++ai)
#pragma unroll
                    for (int m = 0; m < 4; ++m)
#pragma unroll
                        for (int bj = 0; bj < 2; ++bj) st_bf8(Y + (slot0 + ai * 128 + m * 16) * DM + u.pn * 256 + bj * 128 + wc * 32 + 8 * fq, acc[ai][bj][m][0] * gt[ai][m], acc[ai][bj][m][1] * gt[ai][m]); };
            GEMM_P8(S, AD, E);
            if (L0) { const int nun = 16 * 17 * 4, busy = nun - ((nun - 1) / F.G) * F.G;
                if (busy < F.G && F.bid >= busy) wconv_experts(P, F, 1, F.bid - busy, F.G - busy, CV_B, CV_C); }
        REP_END }
        SEAM(pb + 8);
        if (IN(pb + 9)) { REFRESH(); p_rowpass_k(P, F, l, L0 ? RT : RL); if (L0) p_wconv(P, F, 1); }
        if (L0) SEAM(pb + 9);
    }
#undef IN
#undef SEAM
}
template <int PH> static void launch_ph(int grid, const Params& p, hipStream_t stream) { hipLaunchKernelGGL(fwd_kernel<PH>, dim3(grid), dim3(NTHREADS), LDS_BYTES, stream, p); }
template <int PH> static bool set_attr() { return hipFuncSetAttribute((const void*)fwd_kernel<PH>, hipFuncAttributeMaxDynamicSharedMemorySize, LDS_BYTES) == hipSuccess; }

#ifndef DUP_LAUNCH
#define DUP_LAUNCH -1
#endif
extern "C" void kernel_launch(void* const* d_in, const int* in_sizes, int n_in, void* d_out, int out_size, void* d_ws, size_t ws_size, hipStream_t stream) {
    static int grid = 0;
    if (grid == 0) {
        if (n_in != 20 || out_size != RL * DM || ws_size < WS_END) { fprintf(stderr, "kernel_launch: unexpected shapes (n_in %d out %d ws %zu need %zu)\n", n_in, out_size, ws_size, (size_t)WS_END); grid = -1; return; }
        int dev = 0, cus = 0, per_cu = 0;
        if (hipGetDevice(&dev) != hipSuccess || hipDeviceGetAttribute(&cus, hipDeviceAttributeMultiprocessorCount, dev) != hipSuccess) { grid = -1; return; }
#if N_LAUNCH_MODE == 1
        if (!set_attr<-1>()) { fprintf(stderr, "kernel_launch: hipFuncSetAttribute failed\n"); grid = -1; return; }
        if (hipOccupancyMaxActiveBlocksPerMultiprocessor(&per_cu, (const void*)fwd_kernel<-1>, NTHREADS, LDS_BYTES) != hipSuccess || per_cu < 1) fprintf(stderr, "kernel_launch: occupancy query reports %d\n", per_cu);
#else
        if (!(set_attr<0>() && set_attr<1>() && set_attr<2>() && set_attr<3>() && set_attr<12>() && set_attr<4>() && set_attr<5>() && set_attr<6>() && set_attr<7>() && set_attr<9>() && set_attr<10>() && set_attr<11>())) { fprintf(stderr, "kernel_launch: hipFuncSetAttribute failed\n"); grid = -1; return; }
        (void)per_cu;
#endif
        (void)hipGetLastError();
        grid = cus;
    }
    if (grid < 0) return;
    if (hipMemsetAsync((char*)d_ws + WS_CTL, 0, CTL_BYTES, stream) != hipSuccess) return;
    Params p{};
    const float** pp = (const float**)&p;
    for (int i = 0; i < 20; ++i) pp[i] = (const float*)d_in[i];
    p.out = (float*)d_out; p.ws = (unsigned char*)d_ws;
#if N_LAUNCH_MODE == 1
    p.l_lo = 0; p.l_hi = 2;
    launch_ph<-1>(grid, p, stream);
#else
    p.l_lo = 0; p.l_hi = 0; launch_ph<0>(grid, p, stream); if (DUP_LAUNCH == 0) launch_ph<0>(grid, p, stream); launch_ph<1>(grid, p, stream); if (DUP_LAUNCH == 1) launch_ph<1>(grid, p, stream);
#define LP(k) do { launch_ph<k>(grid, p, stream); if (DUP_LAUNCH == (k) && l == 0) launch_ph<k>(grid, p, stream); } while (0)
    for (int l = 0; l < 2; ++l) { p.l_lo = l; p.l_hi = l + 1;
        LP(2); LP(3); LP(12); LP(4); LP(5); LP(6); LP(7); LP(9); LP(10); LP(11); }
#endif
}
```

```cpp
#include <hip/hip_runtime.h>
#include <cstdio>
#include <cstdint>

#ifndef N_LAUNCH_MODE
#define N_LAUNCH_MODE 1
#endif

#define GAS __attribute__((address_space(1)))
#define LAS __attribute__((address_space(3)))
typedef unsigned short bf16;
typedef short bf16x8 __attribute__((ext_vector_type(8)));
typedef float f32x4 __attribute__((ext_vector_type(4)));
typedef unsigned u32x4 __attribute__((ext_vector_type(4)));
typedef unsigned u32x2 __attribute__((ext_vector_type(2)));

constexpr int NB = 8, SEQ = 4096, DM = 1024, CTXL = 256, NH = 16, HD = 64, GRIDW = 64;
constexpr int RL = NB * SEQ, RC = NB * CTXL, RT = RL + RC;
constexpr int INW = 7168, NE = 16, FF = 2816, CAPL = 512, CAPC = 32;
constexpr int SLOT_E = 4352, NSLOT = NE * SLOT_E;
constexpr float RMS_EPS = 1e-6f;
constexpr float LOG2E = 1.4426950408889634f, QSCALE = 0.125f * LOG2E;
constexpr float A8S = 8.0f, W8S = 64.0f, INV8 = 1.0f / (A8S * W8S);
constexpr float ATS = 32.0f, INVAT = 1.0f / (ATS * W8S);
constexpr int NWAVES = 8, NTHREADS = 512;

constexpr size_t al256(size_t x) { return (x + 255) & ~(size_t)255; }
constexpr size_t WS_CTL = 0, CTL_BYTES = 1u << 20;
constexpr size_t WS_MOD = WS_CTL + CTL_BYTES;
constexpr size_t WS_XC = al256(WS_MOD + (size_t)2 * 9 * 6144 * 4);
constexpr size_t WS_AFF = al256(WS_XC + (size_t)RC * DM * 4);
constexpr size_t WS_SROW = al256(WS_AFF + (size_t)RT * 16 * 4);
constexpr size_t WS_SGATE = al256(WS_SROW + (size_t)NSLOT * 4);
constexpr size_t WS_SEL = al256(WS_SGATE + (size_t)NSLOT * 4);
constexpr size_t WS_DFTM = al256(WS_SEL + (size_t)RT * 16 * 4);
constexpr size_t WS_DFTC = al256(WS_DFTM + (size_t)4096 * 8192 * 2);
constexpr size_t WS_WA = al256(WS_DFTC + (size_t)256 * 512 * 2);
constexpr size_t WS_WFV = al256(WS_WA + (size_t)5632 * 1024 * 2);
constexpr size_t WS_WAO = al256(WS_WFV + (size_t)2048 * 1024 * 2);
constexpr size_t WS_WFO = al256(WS_WAO + (size_t)1024 * 1024 * 2);
constexpr size_t WS_WPO = al256(WS_WFO + (size_t)1024 * 512 * 2);
constexpr size_t WS_WOUT = al256(WS_WPO + (size_t)1024 * 256 * 2);
constexpr size_t WS_WGU = al256(WS_WOUT + (size_t)1024 * 1024 * 2);
constexpr size_t WS_WD = al256(WS_WGU + (size_t)16 * 5632 * 1024);
constexpr size_t WS_WA8 = al256(WS_WD + (size_t)16 * 1024 * 2816);
constexpr size_t WS_H = al256(WS_WA8 + (size_t)6144 * 1024);
constexpr size_t WS_H8 = al256(WS_H + (size_t)RT * DM * 2);
constexpr size_t WS_R = al256(WS_H8 + (size_t)RT * DM);
constexpr size_t WS_KQ = WS_R;
constexpr size_t WS_MRG = WS_KQ;
constexpr size_t WS_PB = al256(WS_KQ + (size_t)RT * 2048 * 2);
constexpr size_t WS_GB = al256(WS_PB + (size_t)RT * 512 * 2);
constexpr size_t WS_YT = al256(WS_GB + (size_t)RT * 3072 * 2);
constexpr size_t WS_MRGB = WS_YT;
constexpr size_t WS_VT = al256(WS_YT + (size_t)RT * 1024 * 2);
constexpr size_t WS_FOUR = al256(WS_VT + (size_t)RT * 1024 * 2);
constexpr size_t WS_ATT = al256(WS_FOUR + (size_t)RT * 512 * 2);
constexpr size_t WS_POOL = al256(WS_ATT + (size_t)RT * 1024 * 2);
constexpr size_t WS_MIX_END = al256(WS_POOL + (size_t)RT * 512 * 2);
constexpr size_t WS_XG = WS_R;
constexpr size_t WS_HID = al256(WS_XG + (size_t)NSLOT * 1024 * 2);
constexpr size_t WS_Y = al256(WS_HID + (size_t)NSLOT * 2816);
constexpr size_t WS_MOE_END = al256(WS_Y + (size_t)NSLOT * 1024 * 2);
constexpr size_t WS_END0 = WS_MIX_END > WS_MOE_END ? WS_MIX_END : WS_MOE_END;
constexpr size_t WS_ZP = WS_END0;
constexpr size_t WS_M1T = al256(WS_ZP + ((size_t)8 * 64 * 512 * 128 + 1024) * 2);
constexpr size_t WS_M2T = al256(WS_M1T + (size_t)256 * 256 * 2);
constexpr size_t WS_XB = al256(WS_M2T + (size_t)256 * 512 * 2);
constexpr int RF_PITCH = 1032, RF_TBL = 2 * 16 * RF_PITCH * 2 + 4096 + 4096 + 64;
constexpr size_t WS_RFT = al256(WS_XB + (size_t)RT * DM * 2);
constexpr size_t WS_WGU1 = al256(WS_RFT + (size_t)18 * RF_TBL);
constexpr size_t WS_WD1 = al256(WS_WGU1 + (size_t)16 * 5632 * 1024);
constexpr size_t WS_END = al256(WS_WD1 + (size_t)16 * 1024 * 2816);
static_assert(WS_END <= (size_t)1400 * 1024 * 1024, "workspace map exceeds the guaranteed scratch size (>= sum of the inputs)");
constexpr size_t YT_CTX_OFF = (size_t)8 * 1024 * 4096;

constexpr int CW_BAR = 4096;

constexpr int LDS_BYTES = 155648;
constexpr int LDS_TW = 132096;
constexpr int LDS_MISC = 131072;

__device__ __forceinline__ unsigned f2bf(float f) { unsigned u = __float_as_uint(f); return (u + 0x7fffu + ((u >> 16) & 1u)) >> 16; }
typedef __bf16 hbf16x2 __attribute__((ext_vector_type(2)));
typedef float f32x2 __attribute__((ext_vector_type(2)));
__device__ __forceinline__ unsigned pk2(float lo, float hi) { const f32x2 v = {lo, hi}; return __builtin_bit_cast(unsigned, __builtin_convertvector(v, hbf16x2)); }
__device__ __forceinline__ unsigned pk4_fp8(float a, float b, float c, float d) {
    a = __builtin_amdgcn_fmed3f(a, -448.f, 448.f); b = __builtin_amdgcn_fmed3f(b, -448.f, 448.f); c = __builtin_amdgcn_fmed3f(c, -448.f, 448.f); d = __builtin_amdgcn_fmed3f(d, -448.f, 448.f);
    int w = 0; w = __builtin_amdgcn_cvt_pk_fp8_f32(a, b, w, false); w = __builtin_amdgcn_cvt_pk_fp8_f32(c, d, w, true); return (unsigned)w; }
__device__ __forceinline__ unsigned pk4_u8(float a, float b, float c, float d) { unsigned w = 0; w = __builtin_amdgcn_cvt_pk_u8_f32(a, 0, w); w = __builtin_amdgcn_cvt_pk_u8_f32(b, 1, w); w = __builtin_amdgcn_cvt_pk_u8_f32(c, 2, w); return __builtin_amdgcn_cvt_pk_u8_f32(d, 3, w); }
__device__ __forceinline__ f32x4 u8x4_f(unsigned w) { return (f32x4){(float)(w & 0xffu), (float)((w >> 8) & 0xffu), (float)((w >> 16) & 0xffu), (float)(w >> 24)}; }
constexpr float G8S = 255.0f, G8I = 1.0f / 255.0f;
constexpr float YS = 16.0f, YSI = 1.0f / 16.0f;
__device__ __forceinline__ void acc_fp8x4(f32x4& a, unsigned w) { const f32x2 lo = __builtin_amdgcn_cvt_pk_f32_fp8((int)w, false), hi = __builtin_amdgcn_cvt_pk_f32_fp8((int)w, true); a[0] += lo[0]; a[1] += lo[1]; a[2] += hi[0]; a[3] += hi[1]; }
__device__ __forceinline__ bf16x8 fp8x8_bf16(u32x2 w) {
    const f32x2 a = __builtin_amdgcn_cvt_pk_f32_fp8((int)w.x, false) * YSI, b = __builtin_amdgcn_cvt_pk_f32_fp8((int)w.x, true) * YSI, c = __builtin_amdgcn_cvt_pk_f32_fp8((int)w.y, false) * YSI, d = __builtin_amdgcn_cvt_pk_f32_fp8((int)w.y, true) * YSI;
    u32x4 o; o.x = pk2(a[0], a[1]); o.y = pk2(b[0], b[1]); o.z = pk2(c[0], c[1]); o.w = pk2(d[0], d[1]); return __builtin_bit_cast(bf16x8, o); }
__device__ __forceinline__ float bf2f(unsigned b) { return __uint_as_float(b << 16); }
__device__ __forceinline__ float bflo(unsigned w) { return __uint_as_float(w << 16); }
__device__ __forceinline__ float bfhi(unsigned w) { return __uint_as_float(w & 0xffff0000u); }
template <int CTRL> __device__ __forceinline__ float dppf(float x) { return __builtin_bit_cast(float, __builtin_amdgcn_mov_dpp(__builtin_bit_cast(int, x), CTRL, 0xf, 0xf, true)); }
template <int CTRL> __device__ __forceinline__ int dppi(int x) { return __builtin_amdgcn_mov_dpp(x, CTRL, 0xf, 0xf, true); }
constexpr int DPP_XOR1 = 0xB1, DPP_XOR2 = 0x4E, DPP_ROR4 = 0x124, DPP_ROR8 = 0x128;
__device__ __forceinline__ float wave_sum(float v) {
    v += dppf<DPP_XOR1>(v); v += dppf<DPP_XOR2>(v); v += dppf<DPP_ROR4>(v); v += dppf<DPP_ROR8>(v);
    auto s = __builtin_amdgcn_permlane16_swap(__float_as_uint(v), __float_as_uint(v), false, false); v = __uint_as_float(s[0]) + __uint_as_float(s[1]);
    auto t = __builtin_amdgcn_permlane32_swap(__float_as_uint(v), __float_as_uint(v), false, false); return __uint_as_float(t[0]) + __uint_as_float(t[1]);
}
__device__ __forceinline__ float wave_max(float v) {
    v = fmaxf(v, dppf<DPP_XOR1>(v)); v = fmaxf(v, dppf<DPP_XOR2>(v)); v = fmaxf(v, dppf<DPP_ROR4>(v)); v = fmaxf(v, dppf<DPP_ROR8>(v));
    auto s = __builtin_amdgcn_permlane16_swap(__float_as_uint(v), __float_as_uint(v), false, false); v = fmaxf(__uint_as_float(s[0]), __uint_as_float(s[1]));
    auto t = __builtin_amdgcn_permlane32_swap(__float_as_uint(v), __float_as_uint(v), false, false); return fmaxf(__uint_as_float(t[0]), __uint_as_float(t[1]));
}
__device__ __forceinline__ int wave_sum_i(int v) {
    v += dppi<DPP_XOR1>(v); v += dppi<DPP_XOR2>(v); v += dppi<DPP_ROR4>(v); v += dppi<DPP_ROR8>(v);
    auto s = __builtin_amdgcn_permlane16_swap((unsigned)v, (unsigned)v, false, false); v = (int)(s[0] + s[1]);
    auto t = __builtin_amdgcn_permlane32_swap((unsigned)v, (unsigned)v, false, false); return (int)(t[0] + t[1]);
}
__device__ __forceinline__ float sigmoidf_(float x) { return __builtin_amdgcn_rcpf(1.f + __builtin_amdgcn_exp2f(x * -1.4426950408889634f)); }
#define LDS_WAIT() asm volatile("s_waitcnt lgkmcnt(0)" ::: "memory")

#define XB_TMO      128
#define XB_XCNT(j)  (256  + 64 * (j))
#define XB_XSUB(j)  (1280 + 64 * (j))
#define XB_XGEN(j)  (2304 + 64 * (j))
#define XB_TOP      3328
#define XB_TOPGEN   3392
#define XCD_BAR_WORDS 3456
#define XB_SPIN_CAP (1u << 22)

__device__ __forceinline__ unsigned xb_ld(unsigned* p)              { return __hip_atomic_load(p, __ATOMIC_RELAXED, __HIP_MEMORY_SCOPE_AGENT); }
__device__ __forceinline__ unsigned xb_add(unsigned* p, unsigned v) { return __hip_atomic_fetch_add(p, v, __ATOMIC_RELAXED, __HIP_MEMORY_SCOPE_AGENT); }
__device__ __forceinline__ unsigned xb_xcc_id() { return (unsigned)__builtin_amdgcn_s_getreg((3 << 11) | 20) & 0xFu; }
#define XB_SPIN(cond, bar) do { unsigned _sp = 0; while (cond) { __builtin_amdgcn_s_sleep(1); \
    if ((++_sp & 255u) == 0u) { if (xb_ld(&(bar)[XB_TMO])) break; if (_sp > XB_SPIN_CAP) { atomicAdd(&(bar)[XB_TMO], 1u); break; } } } } while (0)

struct XcdBarrier { unsigned* bar; unsigned x; volatile LAS unsigned* st; };

__device__ __forceinline__ XcdBarrier xcd_barrier_post(unsigned* bar, volatile LAS unsigned* st) {
    XcdBarrier b; b.bar = bar; b.x = xb_xcc_id(); b.st = st;
    if (threadIdx.x == 0) (void)xb_add(&bar[XB_XCNT(b.x)], 1u);
    return b;
}
__device__ __forceinline__ void xcd_barrier_complete(unsigned* bar, unsigned x, unsigned& nloc, unsigned& nx) {
    const unsigned G = gridDim.x * gridDim.y * gridDim.z;
    unsigned sum, cnt, mine, sp = 0u;
    for (;;) {
        sum = 0u; cnt = 0u; mine = 0u;
#pragma unroll
        for (unsigned j = 0; j < 16; ++j) { const unsigned c = xb_ld(&bar[XB_XCNT(j)]); sum += c; cnt += (c > 0u) ? 1u : 0u; mine = (j == x) ? c : mine; }
        if (sum == G) break;
        __builtin_amdgcn_s_sleep(1);
        if ((++sp & 255u) == 0u) { if (xb_ld(&bar[XB_TMO])) break; if (sp > XB_SPIN_CAP) { atomicAdd(&bar[XB_TMO], 1u); break; } }
    }
    nloc = mine > 0u ? mine : 1u; nx = cnt > 0u ? cnt : 1u;
}
__device__ __forceinline__ void xcd_barrier(const XcdBarrier& b) {
    asm volatile("s_waitcnt vmcnt(0)" ::: "memory");
    __syncthreads();
    if (threadIdx.x == 0) {
        unsigned* bar = b.bar;
        __builtin_amdgcn_s_waitcnt(0);
        unsigned nloc = b.st[0], nx = b.st[1];
        if (nloc == 0u) { xcd_barrier_complete(bar, b.x, nloc, nx); b.st[0] = nloc; b.st[1] = nx; }
        const unsigned old = xb_add(&bar[XB_XSUB(b.x)], 1u);
        const unsigned gen = old / nloc;
        if (old + 1u == (gen + 1u) * nloc) {
            __builtin_amdgcn_fence(__ATOMIC_RELEASE, "agent");
            asm volatile("s_waitcnt vmcnt(0)" ::: "memory");
            const unsigned og = xb_add(&bar[XB_TOP], 1u);
            const unsigned tg = og / nx;
            if (og + 1u == (tg + 1u) * nx) xb_add(&bar[XB_TOPGEN], 1u);
            else XB_SPIN(xb_ld(&bar[XB_TOPGEN]) == tg, bar);
            __builtin_amdgcn_fence(__ATOMIC_ACQUIRE, "agent");
            xb_add(&bar[XB_XGEN(b.x)], 1u);
            asm volatile("s_waitcnt vmcnt(0)" ::: "memory");
        } else {
            XB_SPIN(xb_ld(&bar[XB_XGEN(b.x)]) == gen, bar);
            __builtin_amdgcn_fence(__ATOMIC_ACQUIRE, "agent");
            asm volatile("s_waitcnt vmcnt(0)" ::: "memory");
        }
    }
    __syncthreads();
}

struct Params {
    const float *x, *c, *ctx, *c_ctx, *ada_w, *ada_b, *norm1_g, *norm2_g, *w_in, *rpb, *w_att_o, *w_fourier, *w_pool, *pool_scale, *w_out, *w_router, *w_eg, *w_eu, *w_ed, *final_g;
    float* out; unsigned char* ws; int l_lo, l_hi;
};
struct Frame {
    LAS unsigned char* lds;
    int tid, lane, wave, G, bid;
    unsigned char* ws;
};
#define WSP(T, off) ((T*)(F.ws + (off)))

struct Unit { int grp, pm, pn, seg; };
struct GroupSched {
    int ng, nM, nN, G, c; int tM, tN, tpm0, tpn0;
    __device__ __forceinline__ void init(int ng_, int nM_, int nN_, int G_, int c_, int tM_ = 0, int tN_ = 0, int tpm0_ = 0, int tpn0_ = 0) { ng = ng_; nM = nM_; nN = nN_; G = G_; c = c_; tM = tM_; tN = tN_; tpm0 = tpm0_; tpn0 = tpn0_; }
    __device__ __forceinline__ bool next(int i, Unit& u) const {
        const int per = nM * nN; const int L = i * G + c;
        if (L < ng * per) {
            u.grp = L / per; int wgid = L - u.grp * per;
            { const int q = per / 8, r = per % 8, xcd = wgid % 8, off = wgid / 8; wgid = (xcd < r ? xcd * (q + 1) : r * (q + 1) + (xcd - r) * q) + off; }
            const int nig = 8 * nN, gid = wgid / nig, fm = gid * 8, gsz = (nM - fm) < 8 ? (nM - fm) : 8;
            u.pm = fm + ((wgid % nig) % gsz); u.pn = (wgid % nig) / gsz; u.seg = 0; return true;
        }
        const int w = L - ng * per;
        if (w < tM * tN) { u.grp = ng; u.pm = tpm0 + (w % tM); u.pn = tpn0 + (w / tM); u.seg = 0; return true; }
        return false;
    }
};
struct Operands { const bf16* A; const bf16* Bt; int lda, ldb, slot0, K; int bmap; };

constexpr int HTB = 128 * 64 * 2;
__device__ __forceinline__ int lds_byte(int r, int c) { const int st = (r >> 4) * 2 + (c >> 5), rr = r & 15, cc = c & 31, ob = rr * 64 + cc * 2; return st * 1024 + (ob ^ (((ob >> 9) & 1) << 5)); }
__device__ __forceinline__ int perm32(int rho) { const int n = rho >> 4, i = rho & 15; return 8 * (i >> 2) + 4 * n + (i & 3); }
__device__ __forceinline__ void stage_rc(int b, int& R, int& C) { const int st = b / 1024, sb = b % 1024, swz = sb ^ (((sb >> 9) & 1) << 5); R = (st >> 1) * 16 + swz / 64; C = (st & 1) * 32 + (swz % 64) / 2; }
typedef int i32x8 __attribute__((ext_vector_type(8)));
typedef int i32x4 __attribute__((ext_vector_type(4)));
__device__ __forceinline__ i32x8 cat8(bf16x8 lo, bf16x8 hi) { const i32x4 a = __builtin_bit_cast(i32x4, lo), b = __builtin_bit_cast(i32x4, hi); return (i32x8){a[0], a[1], a[2], a[3], b[0], b[1], b[2], b[3]}; }
template <bool GATHER, bool PERM, bool FP8, int BAUX = 0, class Sched, class Addr, class Epi>
__device__ __forceinline__ void gemm_fast(LAS unsigned char* lds, const int tid, const Sched& S, const Addr& AD, const Epi& E, const int* __restrict__ grows) {
    const int wid = __builtin_amdgcn_readfirstlane(tid >> 6), lane = tid & 63, wr = wid >> 2, wc = wid & 3, fr = lane & 15, fq = lane >> 4;
    unsigned cvg[2][2], nvg[2][2], cvb[2][2], nvb[2][2];
#define PG8_RC(i_) int R_, C_; stage_rc(tid * 16 + (i_) * 8192, R_, C_); const int sR_ = R_; const unsigned sC_ = (unsigned)C_ * 2u; const int sRb_ = PERM ? ((R_ & ~31) + perm32(R_ & 31)) : R_; (void)sR_; (void)sRb_; (void)sC_
    const size_t kstep = 128;
    const unsigned ldsw = (unsigned)wid * 1024u;
    const int aoff = lds_byte(wr * 64 + fr, fq * 8), boff = lds_byte(wc * 32 + fr, fq * 8);
#define PG8_SA(b, h) (((b) * 2 + (h)) * HTB)
#define PG8_SB(b, h) ((4 + (b) * 2 + (h)) * HTB)
#define PG8_STAGE(bufoff, gbase, voff) do { _Pragma("unroll") for (int _i = 0; _i < 2; ++_i) \
        __builtin_amdgcn_global_load_lds((const unsigned*)((const char*)(gbase) + (voff)[_i]), (LAS unsigned*)(lds + (bufoff) + ldsw + _i * 8192), 16, 0, 0); } while (0)
#define PG8_STAGEB(bufoff, gbase, voff) do { _Pragma("unroll") for (int _i = 0; _i < 2; ++_i) \
        __builtin_amdgcn_global_load_lds((const unsigned*)((const char*)(gbase) + (voff)[_i]), (LAS unsigned*)(lds + (bufoff) + ldsw + _i * 8192), 16, 0, BAUX); } while (0)
#define PG8_LDA(dst, b, h) do { if constexpr (FP8) { _Pragma("unroll") for (int m = 0; m < 4; ++m) dst##8[m] = cat8(*(const LAS bf16x8*)(lds + PG8_SA(b, h) + aoff + m * 2048), *(const LAS bf16x8*)(lds + PG8_SA(b, h) + aoff + m * 2048 + 1024)); } \
        else { _Pragma("unroll") for (int m = 0; m < 4; ++m) _Pragma("unroll") for (int k = 0; k < 2; ++k) dst[m][k] = *(const LAS bf16x8*)(lds + PG8_SA(b, h) + aoff + m * 2048 + k * 1024); } } while (0)
#define PG8_LDB(dst, b, h) do { if constexpr (FP8) { _Pragma("unroll") for (int n = 0; n < 2; ++n) dst##8[n] = cat8(*(const LAS bf16x8*)(lds + PG8_SB(b, h) + boff + n * 2048), *(const LAS bf16x8*)(lds + PG8_SB(b, h) + boff + n * 2048 + 1024)); } \
        else { _Pragma("unroll") for (int n = 0; n < 2; ++n) _Pragma("unroll") for (int k = 0; k < 2; ++k) dst[n][k] = *(const LAS bf16x8*)(lds + PG8_SB(b, h) + boff + n * 2048 + k * 1024); } } while (0)
#define PG8_MMA(ai, bj, At, Bt) do { __builtin_amdgcn_s_setprio(1); \
        if constexpr (FP8) { _Pragma("unroll") for (int m = 0; m < 4; ++m) _Pragma("unroll") for (int n = 0; n < 2; ++n)   \
            asm volatile("v_mfma_scale_f32_16x16x128_f8f6f4 %0, %1, %2, %0, %3, %3 op_sel_hi:[0,0,0]" : "+v"(acc[ai][bj][m][n]) : "v"(Bt##8[n]), "v"(At##8[m]), "v"(one_scale)); } \
        else { _Pragma("unroll") for (int m = 0; m < 4; ++m) _Pragma("unroll") for (int n = 0; n < 2; ++n) _Pragma("unroll") for (int k = 0; k < 2; ++k) \
            acc[ai][bj][m][n] = __builtin_amdgcn_mfma_f32_16x16x32_bf16(Bt[n][k], At[m][k], acc[ai][bj][m][n], 0, 0, 0); } \
        __builtin_amdgcn_s_setprio(0); } while (0)
#define PG8_WAIT_V(n) asm volatile("s_waitcnt vmcnt(" #n ")" ::: "memory")
#define PG8_WAIT_L(n) asm volatile("s_waitcnt lgkmcnt(" #n ")" ::: "memory")
#define PG8_BAR __builtin_amdgcn_s_barrier()
#define PG8_SCHED __builtin_amdgcn_sched_barrier(0)
#define PG8_GIDX(dst, op_) do { _Pragma("unroll") for (int i_ = 0; i_ < 2; ++i_) { PG8_RC(i_); _Pragma("unroll") for (int h_ = 0; h_ < 2; ++h_) dst[h_][i_] = (unsigned)grows[(op_).slot0 + h_ * 128 + sR_] * (unsigned)((op_).lda * 2) + sC_; } } while (0)
#define PG8_AOFF(dst, op_) do { _Pragma("unroll") for (int i_ = 0; i_ < 2; ++i_) { PG8_RC(i_); _Pragma("unroll") for (int h_ = 0; h_ < 2; ++h_) dst[h_][i_] = (unsigned)((sR_ + 128 * h_) * (op_).lda) * 2u + sC_; } } while (0)
#define PG8_BOFF(dst, op_) do { _Pragma("unroll") for (int i_ = 0; i_ < 2; ++i_) { PG8_RC(i_); _Pragma("unroll") for (int h_ = 0; h_ < 2; ++h_) { const int c_ = sRb_ + 128 * h_; \
        dst[h_][i_] = (unsigned)(((op_).bmap ? (64 * (c_ & 7) + (c_ >> 3)) : c_) * (op_).ldb) * 2u + sC_; } } } while (0)
#define PG8_COPY(dst, src) do { _Pragma("unroll") for (int h_ = 0; h_ < 2; ++h_) _Pragma("unroll") for (int i_ = 0; i_ < 2; ++i_) dst[h_][i_] = src[h_][i_]; } while (0)
    Unit cur, nxt; int ui = 0;
    if (!S.next(0, cur)) return;
    f32x4 acc[2][2][4][2];
#pragma unroll
    for (int a = 0; a < 2; ++a)
#pragma unroll
        for (int b = 0; b < 2; ++b)
#pragma unroll
            for (int m = 0; m < 4; ++m)
#pragma unroll
                for (int n = 0; n < 2; ++n) acc[a][b][m][n] = (f32x4){0.f, 0.f, 0.f, 0.f};
    bf16x8 At[4][2], B0[2][2], B1[2][2]; i32x8 At8[4], B08[2], B18[2];
    const int one_scale = 0x7F7F7F7F;
    const char* cA; const char* cB; int nt;
    bool has_next; const char* nA; const char* nB; int nnt;
    { const Operands op = AD(cur); cA = (const char*)op.A; cB = (const char*)op.Bt; nt = op.K / 64; PG8_BOFF(cvb, op);
      has_next = S.next(1, nxt); const Operands o1 = has_next ? AD(nxt) : op; PG8_BOFF(nvb, o1); nA = (const char*)o1.A; nB = (const char*)o1.Bt; nnt = o1.K / 64;
      if constexpr (GATHER) { PG8_GIDX(cvg, op); PG8_GIDX(nvg, o1); PG8_WAIT_V(0); } else { PG8_AOFF(cvg, op); PG8_AOFF(nvg, o1); } }
    PG8_STAGEB(PG8_SB(0, 0), cB, cvb[0]); PG8_STAGEB(PG8_SB(0, 1), cB, cvb[1]); PG8_STAGE(PG8_SA(0, 0), cA, cvg[0]); PG8_STAGE(PG8_SA(0, 1), cA, cvg[1]);
    if (wr == 1) PG8_BAR;
    PG8_WAIT_V(2); PG8_BAR;
    PG8_STAGEB(PG8_SB(1, 0), cB + kstep, cvb[0]); PG8_STAGE(PG8_SA(1, 0), cA + kstep, cvg[0]); PG8_STAGEB(PG8_SB(1, 1), cB + kstep, cvb[1]);
    PG8_WAIT_V(6); PG8_BAR;
    for (;;) {
#pragma unroll 1
        for (int t = 0; t < nt; t += 2) {
            const bool last = (t == nt - 2);
            const char* a1 = cA + (size_t)(t + 1) * kstep;
            const char* a2 = last ? nA : cA + (size_t)(t + 2) * kstep; const char* b2 = last ? nB : cB + (size_t)(t + 2) * kstep;
            const char* a3 = a2 + kstep; const char* b3 = b2 + kstep;
            unsigned v2[2][2], w2[2][2];
#pragma unroll
            for (int h_ = 0; h_ < 2; ++h_)
#pragma unroll
                for (int i_ = 0; i_ < 2; ++i_) { v2[h_][i_] = last ? nvg[h_][i_] : cvg[h_][i_]; w2[h_][i_] = last ? nvb[h_][i_] : cvb[h_][i_]; }
            PG8_LDB(B0, 0, 0); PG8_LDB(B1, 0, 1); PG8_SCHED; PG8_LDA(At, 0, 0); PG8_STAGE(PG8_SA(1, 1), a1, cvg[1]);
            PG8_WAIT_V(8); PG8_WAIT_L(0); PG8_BAR; PG8_MMA(0, 0, At, B0); PG8_MMA(0, 1, At, B1); PG8_BAR; PG8_SCHED;
            PG8_LDA(At, 0, 1); PG8_STAGEB(PG8_SB(0, 0), b2, w2[0]); PG8_STAGEB(PG8_SB(0, 1), b2, w2[1]); PG8_STAGE(PG8_SA(0, 0), a2, v2[0]);
            PG8_WAIT_V(8); PG8_WAIT_L(0); PG8_BAR; PG8_MMA(1, 0, At, B0); PG8_MMA(1, 1, At, B1); PG8_BAR; PG8_SCHED;
            PG8_LDB(B0, 1, 0); PG8_LDB(B1, 1, 1); PG8_SCHED; PG8_LDA(At, 1, 0); PG8_STAGE(PG8_SA(0, 1), a2, v2[1]);
            PG8_WAIT_V(8); PG8_WAIT_L(0); PG8_BAR; PG8_MMA(0, 0, At, B0); PG8_MMA(0, 1, At, B1); PG8_BAR; PG8_SCHED;
            PG8_LDA(At, 1, 1); PG8_STAGEB(PG8_SB(1, 0), b3, w2[0]); PG8_STAGEB(PG8_SB(1, 1), b3, w2[1]); PG8_STAGE(PG8_SA(1, 0), a3, v2[0]);
            PG8_WAIT_V(8); PG8_WAIT_L(0); PG8_BAR; PG8_MMA(1, 0, At, B0); PG8_MMA(1, 1, At, B1); PG8_BAR; PG8_SCHED;
        }
        if constexpr (FP8) asm volatile("s_nop 15\n\ts_nop 15" ::: "memory");
        if (wr == 0) PG8_BAR;
        unsigned fvg[2][2], fvb[2][2];
        Unit u2; const bool h2 = S.next(ui + 2, u2); const char* fA = nA; const char* fB = nB; int fnt = nnt;
        if (h2) { const Operands o2 = AD(u2); fA = (const char*)o2.A; fB = (const char*)o2.Bt; fnt = o2.K / 64; PG8_BOFF(fvb, o2); if constexpr (GATHER) PG8_GIDX(fvg, o2); else PG8_AOFF(fvg, o2); }
        else { PG8_COPY(fvb, nvb); PG8_COPY(fvg, nvg); }
        { int fr2 = fr, fq2 = fq; asm volatile("" : "+v"(fr2), "+v"(fq2));
          E(acc, cur, wr, wc, fr2, fq2); }
        if (!has_next) break;
        if constexpr (GATHER) PG8_WAIT_V(0);
        PG8_COPY(cvg, nvg); PG8_COPY(nvg, fvg); PG8_COPY(cvb, nvb); PG8_COPY(nvb, fvb);
        if (E.reset(cur)) {
#pragma unroll
        for (int a = 0; a < 2; ++a)
#pragma unroll
            for (int b = 0; b < 2; ++b)
#pragma unroll
                for (int m = 0; m < 4; ++m)
#pragma unroll
                    for (int n = 0; n < 2; ++n) acc[a][b][m][n] = (f32x4){0.f, 0.f, 0.f, 0.f};
        }
        cur = nxt; cA = nA; cB = nB; nt = nnt; ++ui;
        nxt = u2; has_next = h2; nA = fA; nB = fB; nnt = fnt;
        if (wr == 1) PG8_BAR;
    }
    PG8_WAIT_V(0);
    PG8_BAR;
#undef PG8_SA
#undef PG8_SB
#undef PG8_STAGE
#undef PG8_STAGEB
#undef PG8_LDA
#undef PG8_LDB
#undef PG8_MMA
#undef PG8_WAIT_V
#undef PG8_WAIT_L
#undef PG8_BAR
#undef PG8_SCHED
#undef PG8_GIDX
#undef PG8_AOFF
#undef PG8_BOFF
#undef PG8_COPY
#undef PG8_RC
}
template <class F> struct EpiFn { F f; __device__ __forceinline__ void operator()(f32x4 (&acc)[2][2][4][2], const Unit& u, int wr, int wc, int fr, int fq) const { f(acc, u, wr, wc, fr, fq); } __device__ __forceinline__ bool reset(const Unit&) const { return true; } };
template <class F> __device__ __forceinline__ EpiFn<F> mk_epi(F f) { return EpiFn<F>{f}; }
template <class F> struct EpiSeg { F f; int last; __device__ __forceinline__ void operator()(f32x4 (&acc)[2][2][4][2], const Unit& u, int wr, int wc, int fr, int fq) const { f(acc, u, wr, wc, fr, fq); } __device__ __forceinline__ bool reset(const Unit& u) const { return u.seg == last; } };
template <class F> __device__ __forceinline__ EpiSeg<F> mk_epi_seg(F f, int last) { return EpiSeg<F>{f, last}; }
template <int NSEG> struct SegSched { GroupSched base; __device__ __forceinline__ bool next(int j, Unit& u) const { if (!base.next(j / NSEG, u)) return false; u.seg = j % NSEG; return true; } };
#ifndef DUP_PH
#define DUP_PH -1
#endif
#define REP_BEGIN(k) _Pragma("unroll 1") for (int rep_ = 0; rep_ < ((DUP_PH == (k)) ? 2 : 1); ++rep_) { if (rep_) { if constexpr (PH < 0) xcd_barrier(bar); }
#define REP_END }
#define GEMM(S, AD, E, K, lda, ldb) gemm_fast<false, false, false>(F.lds, F.tid, S, AD, mk_epi(E), nullptr)
#define GEMM_P(S, AD, E) gemm_fast<false, true, false>(F.lds, F.tid, S, AD, mk_epi(E), nullptr)
#define GEMM_P_BNT(S, AD, E) gemm_fast<false, true, false, 2>(F.lds, F.tid, S, AD, mk_epi(E), nullptr)
#define GEMM_P8(S, AD, E) gemm_fast<false, true, true>(F.lds, F.tid, S, AD, mk_epi(E), nullptr)
#define GEMM_GATHER8(S, AD, E, rows) gemm_fast<true, true, true>(F.lds, F.tid, S, AD, mk_epi(E), rows)
#define EPI_ARGS f32x4 (&acc)[2][2][4][2], const Unit& u, int wr, int wc, int fr, int fq
#define EPI_FOR(...) _Pragma("unroll") for (int ai = 0; ai < 2; ++ai) _Pragma("unroll") for (int m = 0; m < 4; ++m) { const int r = ai * 128 + wr * 64 + m * 16 + fr; \
    _Pragma("unroll") for (int bj = 0; bj < 2; ++bj) _Pragma("unroll") for (int n = 0; n < 2; ++n) { const int c = bj * 128 + wc * 32 + n * 16 + 4 * fq; const f32x4 v = acc[ai][bj][m][n]; __VA_ARGS__ } }
#define EPI_FOR8(...) _Pragma("unroll") for (int ai = 0; ai < 2; ++ai) _Pragma("unroll") for (int m = 0; m < 4; ++m) { const int r = ai * 128 + wr * 64 + m * 16 + fr; \
    _Pragma("unroll") for (int bj = 0; bj < 2; ++bj) { const int c = bj * 128 + wc * 32 + 8 * fq; const f32x4 v0 = acc[ai][bj][m][0], v1 = acc[ai][bj][m][1]; __VA_ARGS__ } }
__device__ __forceinline__ void st_bf8(bf16* p, f32x4 a, f32x4 b) { u32x4 w; w.x = pk2(a[0], a[1]); w.y = pk2(a[2], a[3]); w.z = pk2(b[0], b[1]); w.w = pk2(b[2], b[3]); *(u32x4*)p = w; }
__device__ __forceinline__ void st_bf4(bf16* p, f32x4 v) { u32x2 w; w.x = pk2(v[0], v[1]); w.y = pk2(v[2], v[3]); *(u32x2*)p = w; }

__device__ __forceinline__ void p_mod(const Params& P, Frame& F) {
    LAS float* sc = (LAS float*)F.lds;
    LAS float* red = (LAS float*)(F.lds + 9 * 1024 * 4);
    float* MOD = WSP(float, WS_MOD);
    bool have = false;
    for (int it = F.bid; it < 2 * 96; it += F.G) {
        if (!have) {
            for (int i = F.tid; i < 9 * 1024; i += NTHREADS) { const int r = i >> 10, k = i & 1023; const float v = r < 8 ? P.c[r * 1024 + k] : P.c_ctx[k]; sc[i] = v * sigmoidf_(v); }
            have = true;
        }
        __syncthreads();
        const int l = it / 96, j0 = (it % 96) * 64, jj = F.tid & 63, kc = F.tid >> 6;
        const float* W = P.ada_w + (size_t)l * 1024 * 6144 + j0 + jj;
        float a[9];
#pragma unroll
        for (int r = 0; r < 9; ++r) a[r] = 0.f;
#pragma unroll 8
        for (int k = kc * 128; k < kc * 128 + 128; ++k) { const float w = __builtin_nontemporal_load(W + (size_t)k * 6144);
#pragma unroll
            for (int r = 0; r < 9; ++r) a[r] += sc[r * 1024 + k] * w; }
#pragma unroll
        for (int r = 0; r < 9; ++r) red[(kc * 9 + r) * 64 + jj] = a[r];
        __syncthreads();
        for (int o = F.tid; o < 9 * 64; o += NTHREADS) { const int r = o >> 6, j = o & 63; float s = 0.f;
#pragma unroll
            for (int q = 0; q < 8; ++q) s += red[(q * 9 + r) * 64 + j];
            MOD[((size_t)l * 9 + r) * 6144 + j0 + j] = s + P.ada_b[l * 6144 + j0 + j]; }
    }
    __syncthreads();
}
__device__ __forceinline__ void p_dftgen(Frame& F) {
    LAS float* tab = (LAS float*)F.lds;
    for (int j = F.tid; j < 4096; j += NTHREADS) tab[j] = cospif((float)j * (1.0f / 2048.0f));
    __syncthreads();
    bf16* DC_ = WSP(bf16, WS_DFTC); bf16* M1 = WSP(bf16, WS_M1T); bf16* M2 = WSP(bf16, WS_M2T);
    const int nchunk = 256 * 64 + 256 * 32 + 256 * 64;
    for (int ch = F.bid * NTHREADS + F.tid; ch < nchunk; ch += F.G * NTHREADS) {
        float v[8]; bf16* dst;
        if (ch < 256 * 64) { const int kf = ch >> 6, col0 = (ch & 63) * 8, cs = col0 >> 8, l0 = col0 & 255;
#pragma unroll
            for (int i = 0; i < 8; ++i) { const int j = ((kf * (l0 + i)) & 255) * 16; v[i] = cs ? -tab[(j + 3072) & 4095] : tab[j]; }
            dst = DC_ + (size_t)kf * 512 + col0; }
        else if (ch < 256 * 64 + 256 * 32) { const int c2 = ch - 256 * 64, row = c2 >> 5, col0 = (c2 & 31) * 8, ri = row >> 7, h = (row >> 6) & 1, k1 = row & 63, h2 = col0 >> 7, cs = (col0 >> 6) & 1, l10 = col0 & 63;
#pragma unroll
            for (int i = 0; i < 8; ++i) { const int j = ((k1 * (l10 + i)) & 63) * 64; const float c = tab[j], sn = tab[(j + 3072) & 4095];
                v[i] = (h != h2) ? 0.f : (ri == 0 ? (cs == 0 ? c : -sn) : (cs == 0 ? sn : c)); }
            dst = M1 + (size_t)row * 256 + col0; }
        else { const int c2 = ch - 256 * 64 - 256 * 32, row = c2 >> 6, col0 = (c2 & 63) * 8, q = row >> 6, k2 = row & 63, q2 = col0 >> 7, ri = (col0 >> 6) & 1, l20 = col0 & 63;
#pragma unroll
            for (int i = 0; i < 8; ++i) { const int j = ((k2 * (l20 + i)) & 63) * 64; const float c = tab[j], sn = tab[(j + 3072) & 4095];
                v[i] = (q != q2) ? 0.f : (ri == 0 ? c : -sn); }
            dst = M2 + (size_t)row * 512 + col0; }
        u32x4 o; o.x = pk2(v[0], v[1]); o.y = pk2(v[2], v[3]); o.z = pk2(v[4], v[5]); o.w = pk2(v[6], v[7]);
        *(u32x4*)dst = o;
    }
    __syncthreads();
}
__device__ __forceinline__ void transpose_item(const float* W, int ldw, int k0, int n0, bf16* WT, int ldt, int drow0, LAS float* scr, int lane) {
    f32x4 ld[8];
#pragma unroll
    for (int i = 0; i < 8; ++i) ld[i] = __builtin_nontemporal_load((const f32x4*)(W + (size_t)(k0 + 8 * i + (lane >> 3)) * ldw + n0 + 4 * (lane & 7)));
#pragma unroll
    for (int i = 0; i < 8; ++i) { LAS float* d = scr + (8 * i + (lane >> 3)) * 33 + 4 * (lane & 7); d[0] = ld[i][0]; d[1] = ld[i][1]; d[2] = ld[i][2]; d[3] = ld[i][3]; }
    LDS_WAIT(); asm volatile("" ::: "memory");
    const int c = lane & 7;
#pragma unroll
    for (int j = 0; j < 4; ++j) { const int n = (lane >> 3) + 8 * j; const LAS float* s = scr + (8 * c) * 33 + n;
        u32x4 o; o.x = pk2(s[0 * 33], s[1 * 33]); o.y = pk2(s[2 * 33], s[3 * 33]); o.z = pk2(s[4 * 33], s[5 * 33]); o.w = pk2(s[6 * 33], s[7 * 33]);
        *(u32x4*)(WT + (size_t)(drow0 + n) * ldt + k0 + 8 * c) = o; }
    LDS_WAIT(); asm volatile("" ::: "memory");
}
__device__ __forceinline__ void transpose_item8(const float* W, int ldw, int k0, int n0, unsigned char* WT, int ldt, int drow0, LAS float* scr, int lane) {
    f32x4 ld[8];
#pragma unroll
    for (int i = 0; i < 8; ++i) ld[i] = __builtin_nontemporal_load((const f32x4*)(W + (size_t)(k0 + 8 * i + (lane >> 3)) * ldw + n0 + 4 * (lane & 7)));
#pragma unroll
    for (int i = 0; i < 8; ++i) { LAS float* d = scr + (8 * i + (lane >> 3)) * 33 + 4 * (lane & 7); d[0] = ld[i][0]; d[1] = ld[i][1]; d[2] = ld[i][2]; d[3] = ld[i][3]; }
    LDS_WAIT(); asm volatile("" ::: "memory");
    const int c = lane & 7;
#pragma unroll
    for (int j = 0; j < 4; ++j) { const int n = (lane >> 3) + 8 * j; const LAS float* s = scr + (8 * c) * 33 + n;
        u32x2 o; o.x = pk4_fp8(s[0 * 33] * W8S, s[1 * 33] * W8S, s[2 * 33] * W8S, s[3 * 33] * W8S); o.y = pk4_fp8(s[4 * 33] * W8S, s[5 * 33] * W8S, s[6 * 33] * W8S, s[7 * 33] * W8S);
        *(u32x2*)(WT + (size_t)(drow0 + n) * ldt + k0 + 8 * c) = o; }
    LDS_WAIT(); asm volatile("" ::: "memory");
}
__device__ __forceinline__ void transpose_item8w(const float* W, int ldw, int k0, int n0, unsigned char* WT, int ldt, int drow0, LAS float* scr, int lane) {
    f32x4 ld[16];
#pragma unroll
    for (int i = 0; i < 16; ++i) ld[i] = *(const f32x4*)(W + (size_t)(k0 + 4 * i + (lane >> 4)) * ldw + n0 + 4 * (lane & 15));
#pragma unroll
    for (int i = 0; i < 16; ++i) { LAS float* d = scr + (4 * i + (lane >> 4)) * 65 + 4 * (lane & 15); d[0] = ld[i][0]; d[1] = ld[i][1]; d[2] = ld[i][2]; d[3] = ld[i][3]; }
    LDS_WAIT(); asm volatile("" ::: "memory");
    const int c = lane & 3;
#pragma unroll
    for (int p = 0; p < 4; ++p) { const int n = (lane >> 2) + 16 * p; const LAS float* s = scr + (16 * c) * 65 + n; u32x4 o;
#pragma unroll
        for (int q = 0; q < 4; ++q) o[q] = pk4_fp8(s[(4 * q) * 65] * W8S, s[(4 * q + 1) * 65] * W8S, s[(4 * q + 2) * 65] * W8S, s[(4 * q + 3) * 65] * W8S);
        *(u32x4*)(WT + (size_t)(drow0 + n) * ldt + k0 + 16 * c) = o; }
    LDS_WAIT(); asm volatile("" ::: "memory");
}
__device__ __forceinline__ void cv_load(const float* W, int ldw, int lane, f32x4 (&ld)[16]) {
#pragma unroll
    for (int i = 0; i < 16; ++i) ld[i] = __builtin_nontemporal_load((const f32x4*)(W + (size_t)(4 * i + (lane >> 4)) * ldw + 4 * (lane & 15)));
}
__device__ __forceinline__ void cv_store(const f32x4 (&ld)[16], unsigned char* WT, int ldt, LAS float* scr, int lane) {
#pragma unroll
    for (int i = 0; i < 16; ++i) { LAS float* d = scr + (4 * i + (lane >> 4)) * 65 + 4 * (lane & 15); d[0] = ld[i][0]; d[1] = ld[i][1]; d[2] = ld[i][2]; d[3] = ld[i][3]; }
    LDS_WAIT(); asm volatile("" ::: "memory");
    const int c = lane & 3;
#pragma unroll
    for (int p = 0; p < 4; ++p) { const int n = (lane >> 2) + 16 * p; const LAS float* s = scr + (16 * c) * 65 + n; u32x4 o;
#pragma unroll
        for (int q = 0; q < 4; ++q) o[q] = pk4_fp8(s[(4 * q) * 65] * W8S, s[(4 * q + 1) * 65] * W8S, s[(4 * q + 2) * 65] * W8S, s[(4 * q + 3) * 65] * W8S);
        __builtin_nontemporal_store(o, (u32x4*)(WT + (size_t)n * ldt + 16 * c)); }
    LDS_WAIT(); asm volatile("" ::: "memory");
}
__device__ __forceinline__ void cv_item(const Params& P, unsigned char* ws, int l, int it, const float*& W, int& ldw, unsigned char*& WT, int& ldt) {
    constexpr int I_E = 16 * 44;
    const int which = it / (16 * I_E), r0 = it % (16 * I_E), e = r0 / I_E, r = r0 % I_E;
    if (which < 2) { const int kb = r / 44, nb = r % 44, n0 = nb * 64;
        W = (which == 0 ? P.w_eg : P.w_eu) + ((size_t)l * 16 + e) * 1024 * FF + (size_t)(kb * 64) * FF + n0; ldw = FF;
        WT = ws + (l ? WS_WGU1 : WS_WGU) + (size_t)e * 5632 * 1024 + (size_t)((n0 >> 7) * 256 + (which ? 128 : 0) + (n0 & 127)) * 1024 + kb * 64; ldt = 1024; }
    else { const int kb = r / 16, nb = r % 16;
        W = P.w_ed + ((size_t)l * 16 + e) * FF * 1024 + (size_t)(kb * 64) * 1024 + nb * 64; ldw = 1024;
        WT = ws + (l ? WS_WD1 : WS_WD) + (size_t)e * 1024 * FF + (size_t)(nb * 64) * FF + kb * 64; ldt = FF; }
}
constexpr int CV_NIT = 3 * 16 * 16 * 44;
constexpr int CV_A = CV_NIT * 18 / 100, CV_B = CV_A + CV_NIT * 23 / 100, CV_C = CV_B + CV_NIT * 28 / 100;
__device__ __forceinline__ void wconv_experts(const Params& P, Frame& F, int l, int rank, int nblk, int it_lo, int it_hi) {
    LAS float* scr = (LAS float*)(F.lds + (F.wave < 7 ? F.wave * 17408 : 131584));
    const int gw = rank * NWAVES + F.wave, NGW = nblk * NWAVES, NIT = it_hi;
    f32x4 la[16], lb[16]; const float* W; int ldw; unsigned char* T0; int ldt0;
    int it = it_lo + gw;
    if (it < NIT) { cv_item(P, F.ws, l, it, W, ldw, T0, ldt0); cv_load(W, ldw, F.lane, la); }
#pragma unroll 1
    for (; it < NIT; it += NGW) {
        unsigned char* T1 = T0; int ldt1 = ldt0; const int nit = it + NGW;
        if (nit < NIT) { cv_item(P, F.ws, l, nit, W, ldw, T1, ldt1); cv_load(W, ldw, F.lane, lb); }
        cv_store(la, T0, ldt0, scr, F.lane);
#pragma unroll
        for (int i = 0; i < 16; ++i) la[i] = lb[i];
        T0 = T1; ldt0 = ldt1;
    }
    __syncthreads();
}
__device__ __forceinline__ void p_wconv(const Params& P, Frame& F, int l) {
    LAS float* scr = (LAS float*)(F.lds + F.wave * 16384);
    const int gw = F.bid * NWAVES + F.wave, NGW = F.G * NWAVES;
    const float* w_in = P.w_in + (size_t)l * 1024 * INW;
    bf16* WA = WSP(bf16, WS_WA); bf16* WFV = WSP(bf16, WS_WFV);
    constexpr int I_K = 16 * 32, I_Q = 16 * 32, I_P = 16 * 16, I_G = 16 * 96, I_V = 16 * 32, I_AO = 16 * 32, I_FO = 8 * 32, I_OUT = 16 * 32;
    constexpr int NSM = I_K + I_Q + I_P + I_G + I_V + I_AO + I_FO + I_OUT;
    for (int it = gw; it < NSM; it += NGW) {
        int r = it;
        if (r < I_K) { transpose_item8(w_in, INW, (r / 32) * 64, 0 + (r % 32) * 32, WSP(unsigned char, WS_WA8), 1024, 0 + (r % 32) * 32, scr, F.lane); continue; } r -= I_K;
        if (r < I_Q) { transpose_item8(w_in, INW, (r / 32) * 64, 2048 + (r % 32) * 32, WSP(unsigned char, WS_WA8), 1024, 1024 + (r % 32) * 32, scr, F.lane); continue; } r -= I_Q;
        if (r < I_P) { transpose_item(w_in, INW, (r / 16) * 64, 3584 + (r % 16) * 32, WA, 1024, 2048 + (r % 16) * 32, scr, F.lane); continue; } r -= I_P;
        if (r < I_G) { transpose_item8(w_in, INW, (r / 96) * 64, 4096 + (r % 96) * 32, WSP(unsigned char, WS_WA8), 1024, 3072 + (r % 96) * 32, scr, F.lane); continue; } r -= I_G;
        if (r < I_V) { transpose_item8(w_in, INW, (r / 32) * 64, 1024 + (r % 32) * 32, WSP(unsigned char, WS_WA8), 1024, 2048 + (r % 32) * 32, scr, F.lane); continue; } r -= I_V;
        if (r < I_AO) { transpose_item8(P.w_att_o + (size_t)l * 1024 * 1024, 1024, (r / 32) * 64, (r % 32) * 32, WSP(unsigned char, WS_WAO), 1024, (r % 32) * 32, scr, F.lane); continue; } r -= I_AO;
        if (r < I_FO) { transpose_item(P.w_fourier + (size_t)l * 512 * 1024, 1024, (r / 32) * 64, (r % 32) * 32, WSP(bf16, WS_WFO), 512, (r % 32) * 32, scr, F.lane); continue; } r -= I_FO;
        transpose_item(P.w_out + (size_t)l * 1024 * 1024, 1024, (r / 32) * 64, (r % 32) * 32, WSP(bf16, WS_WOUT), 1024, (r % 32) * 32, scr, F.lane);
    }
    { bf16* WPO = WSP(bf16, WS_WPO); const float* wp = P.w_pool + (size_t)l * 4 * 128 * 256;
#pragma unroll 1
      for (int i = F.bid * NTHREADS + F.tid; i < 1024 * 128; i += F.G * NTHREADS) { const int n = i >> 7, kk = i & 127, g = n >> 8, f = n & 255;
          WPO[i] = (bf16)f2bf(wp[((size_t)g * 128 + kk) * 256 + f]);
          asm volatile("" : "+v"(i)); } }
    { LAS float* t128 = (LAS float*)F.lds; LAS float* srcs = t128 + 128;
      int tid = F.tid; asm volatile("" : "+v"(tid));
      __syncthreads();
      for (int j = tid; j < 128; j += NTHREADS) t128[j] = cospif((float)j * (1.0f / 64.0f));
      for (int tile = F.bid; tile < 256; tile += F.G) { const int g = tile >> 6, kb = tile & 63;
          __syncthreads();
          { const int kk = tid >> 5, c4 = (tid & 31) * 4; const f32x4 v = *(const f32x4*)(w_in + (size_t)(kb * 16 + kk) * INW + 3072 + g * 128 + c4); LAS float* d = srcs + kk * 129 + c4; d[0] = v[0]; d[1] = v[1]; d[2] = v[2]; d[3] = v[3]; }
          __syncthreads();
          const int m = tid >> 2, kq = tid & 3; float sc_[4] = {0.f, 0.f, 0.f, 0.f}, ss_[4] = {0.f, 0.f, 0.f, 0.f}; const LAS float* sp = srcs + (4 * kq) * 129;
#pragma unroll 4
          for (int c = 0; c < 128; ++c) { const float tc = t128[(m * c) & 127], ts = t128[(m * c + 96) & 127];
#pragma unroll
              for (int j = 0; j < 4; ++j) { const float v = sp[j * 129 + c]; sc_[j] += v * tc; ss_[j] += v * ts; } }
          bf16* o = WFV + (size_t)((g * 128 + m) * 2) * 1024 + kb * 16 + 4 * kq;
          st_bf4(o, (f32x4){sc_[0], sc_[1], sc_[2], sc_[3]}); st_bf4(o + 1024, (f32x4){ss_[0], ss_[1], ss_[2], ss_[3]}); }
      __syncthreads(); }
}

struct RowMod { const float* g; const float* sh; const float* sc; };
__device__ __forceinline__ void row_load(const float* row, int lane, f32x4 (&v)[4]) {
#pragma unroll
    for (int j = 0; j < 4; ++j) v[j] = *(const f32x4*)(row + 4 * lane + 256 * j);
}
__device__ __forceinline__ void row_load_bf(const bf16* row, int lane, f32x4 (&v)[4]) {
#pragma unroll
    for (int j = 0; j < 4; ++j) { const u32x2 w = *(const u32x2*)(row + 4 * lane + 256 * j); v[j] = (f32x4){bflo(w.x), bfhi(w.x), bflo(w.y), bfhi(w.y)}; }
}
__device__ __forceinline__ void row_load_nt(const float* row, int lane, f32x4 (&v)[4]) {
#pragma unroll
    for (int j = 0; j < 4; ++j) v[j] = __builtin_nontemporal_load((const f32x4*)(row + 4 * lane + 256 * j));
}
__device__ __forceinline__ float row_rstd(const f32x4 (&v)[4]) {
    float s = 0.f;
#pragma unroll
    for (int j = 0; j < 4; ++j) s += (v[j][0] * v[j][0] + v[j][1] * v[j][1]) + (v[j][2] * v[j][2] + v[j][3] * v[j][3]);
    return rsqrtf(wave_sum(s) * (1.0f / 1024.0f) + RMS_EPS);
}
__device__ __forceinline__ void row_modulate(const f32x4 (&v)[4], float rstd, const RowMod& M, int lane, f32x4 (&y)[4]) {
#pragma unroll
    for (int j = 0; j < 4; ++j) { const int k = 4 * lane + 256 * j; const f32x4 g = *(const f32x4*)(M.g + k), sh = *(const f32x4*)(M.sh + k), sc = *(const f32x4*)(M.sc + k);
        y[j] = v[j] * rstd * g * (sc + 1.0f) + sh; }
}
__device__ __forceinline__ void row_store_bf(bf16* row, int lane, const f32x4 (&y)[4]) {
#pragma unroll
    for (int j = 0; j < 4; ++j) st_bf4(row + 4 * lane + 256 * j, y[j]);
}
__device__ __forceinline__ void row_store_f8(unsigned char* row, int lane, const f32x4 (&y)[4]) {
#pragma unroll
    for (int j = 0; j < 4; ++j) *(unsigned*)(row + 4 * lane + 256 * j) = pk4_fp8(y[j][0] * A8S, y[j][1] * A8S, y[j][2] * A8S, y[j][3] * A8S);
}
__device__ __forceinline__ const float* mod_ptr(Frame& F, int l, int row, int which) { const int mr = row < RL ? (row >> 12) : 8; return WSP(float, WS_MOD) + ((size_t)l * 9 + mr) * 6144 + which * 1024; }

__device__ __forceinline__ void row_modulate2(const f32x4 (&v0)[4], const f32x4 (&v1)[4], float rs0, float rs1, const RowMod& M, int lane, f32x4 (&y0)[4], f32x4 (&y1)[4]) {
#pragma unroll
    for (int j = 0; j < 4; ++j) { const int k = 4 * lane + 256 * j; const f32x4 g = *(const f32x4*)(M.g + k), sh = *(const f32x4*)(M.sh + k), sc = *(const f32x4*)(M.sc + k); const f32x4 m = g * (sc + 1.0f);
        y0[j] = v0[j] * rs0 * m + sh; y1[j] = v1[j] * rs1 * m + sh; }
}
__device__ __forceinline__ void p_rowpass_a0(const Params& P, Frame& F) {
    const int gw = F.bid * NWAVES + F.wave, NGW = F.G * NWAVES; bf16* H = WSP(bf16, WS_H); unsigned char* H8 = WSP(unsigned char, WS_H8);
    f32x4 vn[2][4]; int p = gw;
    if (p < RT / 2) { const int row = 2 * p; const float* src = row < RL ? P.x + (size_t)row * DM : P.ctx + (size_t)(row - RL) * DM; row_load_nt(src, F.lane, vn[0]); row_load_nt(src + DM, F.lane, vn[1]); }
    for (; p < RT / 2; p += NGW) { const int row = 2 * p;
        f32x4 v0[4], v1[4], y0[4], y1[4];
#pragma unroll
        for (int j = 0; j < 4; ++j) { v0[j] = vn[0][j]; v1[j] = vn[1][j]; }
        { const int nr = 2 * (p + NGW); if (nr < RT) { const float* src = nr < RL ? P.x + (size_t)nr * DM : P.ctx + (size_t)(nr - RL) * DM; row_load_nt(src, F.lane, vn[0]); row_load_nt(src + DM, F.lane, vn[1]); } }
        const float rs0 = row_rstd(v0), rs1 = row_rstd(v1);
        RowMod M{P.norm1_g, mod_ptr(F, 0, row, 0), mod_ptr(F, 0, row, 1)};
        row_modulate2(v0, v1, rs0, rs1, M, F.lane, y0, y1);
        row_store_bf(H + (size_t)row * DM, F.lane, y0); row_store_f8(H8 + (size_t)row * DM, F.lane, y0);
        row_store_bf(H + (size_t)(row + 1) * DM, F.lane, y1); row_store_f8(H8 + (size_t)(row + 1) * DM, F.lane, y1);
    }
}
constexpr int DPP_MIRROR = 0x140, DPP_HMIRROR = 0x141;
__device__ __forceinline__ void p_rowpass_k(const Params& P, Frame& F, int l, int nrows) {
    const int gw = F.bid * NWAVES + F.wave, NGW = F.G * NWAVES; bf16* H = WSP(bf16, WS_H);
    const int* SEL = WSP(int, WS_SEL); const unsigned char* Y = WSP(unsigned char, WS_Y);
    f32x4 vn[2][4]; int seln = -1; int p = gw; const int NP = nrows >> 1;
    bf16* XB = WSP(bf16, WS_XB);
    if (p < NP) { const int row = 2 * p; const bf16* src = XB + (size_t)row * DM; row_load_bf(src, F.lane, vn[0]); row_load_bf(src + DM, F.lane, vn[1]);
        seln = F.lane < 32 ? SEL[(size_t)row * 16 + F.lane] : -1; }
    for (; p < NP; p += NGW) { const int row = 2 * p;
        f32x4 v0[4], v1[4], a0[4], a1[4]; const int sel = seln;
#pragma unroll
        for (int j = 0; j < 4; ++j) { v0[j] = vn[0][j]; v1[j] = vn[1][j]; a0[j] = (f32x4){0.f, 0.f, 0.f, 0.f}; a1[j] = (f32x4){0.f, 0.f, 0.f, 0.f}; }
        { const int nr = 2 * (p + NGW); if (nr < nrows) { const bf16* src = XB + (size_t)nr * DM; row_load_bf(src, F.lane, vn[0]); row_load_bf(src + DM, F.lane, vn[1]);
            seln = F.lane < 32 ? SEL[(size_t)nr * 16 + F.lane] : -1; } }
        const unsigned emall = (unsigned)__ballot(sel >= 0);
        unsigned em0 = emall & 0xffffu, em1 = (emall >> 16) & 0xffffu; int s0[4], s1[4];
#pragma unroll
        for (int q = 0; q < 4; ++q) { s0[q] = -1; if (em0) { const int e = __builtin_ctz(em0); em0 &= em0 - 1; s0[q] = __builtin_amdgcn_readlane(sel, e); }
                                      s1[q] = -1; if (em1) { const int e = __builtin_ctz(em1); em1 &= em1 - 1; s1[q] = __builtin_amdgcn_readlane(sel, 16 + e); } }
        unsigned w0[4][4], w1[4][4];
#pragma unroll
        for (int q = 0; q < 4; ++q) {
            if (s0[q] >= 0) { const unsigned char* yr = Y + (size_t)s0[q] * DM + 4 * F.lane;
#pragma unroll
                for (int j = 0; j < 4; ++j) w0[q][j] = __builtin_nontemporal_load((const unsigned*)(yr + 256 * j)); }
            if (s1[q] >= 0) { const unsigned char* yr = Y + (size_t)s1[q] * DM + 4 * F.lane;
#pragma unroll
                for (int j = 0; j < 4; ++j) w1[q][j] = __builtin_nontemporal_load((const unsigned*)(yr + 256 * j)); } }
#pragma unroll
        for (int q = 0; q < 4; ++q) {
            if (s0[q] >= 0) {
#pragma unroll
                for (int j = 0; j < 4; ++j) acc_fp8x4(a0[j], w0[q][j]); }
            if (s1[q] >= 0) {
#pragma unroll
                for (int j = 0; j < 4; ++j) acc_fp8x4(a1[j], w1[q][j]); } }
        while (em0) { const int e = __builtin_ctz(em0); em0 &= em0 - 1; const int sl = __builtin_amdgcn_readlane(sel, e); const unsigned char* yr = Y + (size_t)sl * DM;
#pragma unroll
            for (int j = 0; j < 4; ++j) acc_fp8x4(a0[j], *(const unsigned*)(yr + 4 * F.lane + 256 * j)); }
        while (em1) { const int e = __builtin_ctz(em1); em1 &= em1 - 1; const int sl = __builtin_amdgcn_readlane(sel, 16 + e); const unsigned char* yr = Y + (size_t)sl * DM;
#pragma unroll
            for (int j = 0; j < 4; ++j) acc_fp8x4(a1[j], *(const unsigned*)(yr + 4 * F.lane + 256 * j)); }
        const float* g2 = mod_ptr(F, l, row, 5);
#pragma unroll
        for (int j = 0; j < 4; ++j) { const f32x4 g = *(const f32x4*)(g2 + 4 * F.lane + 256 * j) * YSI; v0[j] = v0[j] + g * a0[j]; v1[j] = v1[j] + g * a1[j]; }
        const float rs0 = row_rstd(v0), rs1 = row_rstd(v1);
        if (l == 0) {
#pragma unroll
            for (int j = 0; j < 4; ++j) { st_bf4(XB + (size_t)row * DM + 4 * F.lane + 256 * j, v0[j]); st_bf4(XB + (size_t)(row + 1) * DM + 4 * F.lane + 256 * j, v1[j]); }
            f32x4 y0[4], y1[4]; RowMod M{P.norm1_g + 1024, mod_ptr(F, 1, row, 0), mod_ptr(F, 1, row, 1)};
            row_modulate2(v0, v1, rs0, rs1, M, F.lane, y0, y1);
            row_store_bf(H + (size_t)row * DM, F.lane, y0); row_store_f8(WSP(unsigned char, WS_H8) + (size_t)row * DM, F.lane, y0);
            row_store_bf(H + (size_t)(row + 1) * DM, F.lane, y1); row_store_f8(WSP(unsigned char, WS_H8) + (size_t)(row + 1) * DM, F.lane, y1);
        } else {
#pragma unroll
            for (int j = 0; j < 4; ++j) { const f32x4 g = *(const f32x4*)(P.final_g + 4 * F.lane + 256 * j); float* xr = P.out + (size_t)row * DM + 4 * F.lane + 256 * j; __builtin_nontemporal_store(v0[j] * rs0 * g, (f32x4*)xr); __builtin_nontemporal_store(v1[j] * rs1 * g, (f32x4*)(xr + DM)); }
        }
    }
}

constexpr int RF_WH = 0, RF_WL = 16 * RF_PITCH * 2, RF_M8 = 2 * RF_WL, RF_S8 = RF_M8 + 4096, RF_BIAS = RF_S8 + 4096, RF_RS = RF_BIAS + 64;
__device__ __forceinline__ void p_rftables(const Params& P, Frame& F) {
    LAS float* red = (LAS float*)F.lds;
    for (int job = F.bid; job < 2 * 9 * 16; job += F.G) { const int e = job & 15, lm = job >> 4, l = lm / 9;
        int tid = F.tid; asm volatile("" : "+v"(tid));
        const float* wr = P.w_router + (size_t)l * 1024 * 16; const float* g2n = P.norm2_g + l * 1024;
        const float* sh = WSP(float, WS_MOD) + (size_t)lm * 6144 + 3 * 1024; const float* sc = sh + 1024;
        unsigned char* T = WSP(unsigned char, WS_RFT) + (size_t)lm * RF_TBL;
        float bs = 0.f;
#pragma unroll
        for (int q = 0; q < 2; ++q) { const int k = tid + 512 * q; const float m = g2n[k] * (1.0f + sc[k]), r = wr[k * 16 + e], w = m * r;
            const unsigned hi = f2bf(w); const float lo = w - bf2f(hi);
            ((bf16*)(T + RF_WH))[e * RF_PITCH + k] = (bf16)hi; ((bf16*)(T + RF_WL))[e * RF_PITCH + k] = (bf16)f2bf(lo);
            bs += sh[k] * r;
            if (e == 0) { ((float*)(T + RF_M8))[k] = m * A8S; ((float*)(T + RF_S8))[k] = sh[k] * A8S; } }
        bs = wave_sum(bs);
        __syncthreads();
        if (F.lane == 0) red[F.wave] = bs;
        __syncthreads();
        if (tid == 0) { float a = 0.f;
#pragma unroll
            for (int w = 0; w < NWAVES; ++w) a += red[w];
            ((float*)(T + RF_BIAS))[e] = a; }
    }
    __syncthreads();
}
__device__ __forceinline__ void rf_copy(Frame& F, const unsigned char* T) {
    int tid = F.tid; asm volatile("" : "+v"(tid));
    __syncthreads();
    u32x4 v[10];
#pragma unroll
    for (int q = 0; q < 10; ++q) { const int c = tid + 512 * q; if (c < RF_TBL / 16) v[q] = *(const u32x4*)(T + (size_t)c * 16); }
#pragma unroll
    for (int q = 0; q < 10; ++q) { const int c = tid + 512 * q; if (c < RF_TBL / 16) *(LAS u32x4*)(F.lds + c * 16) = v[q]; }
    __syncthreads();
}
__device__ __forceinline__ void rf_compute(Frame& F, const u32x4 (&xw)[32], unsigned char* H8, float* AFF, int row0) {
    const int i = F.lane & 15, g = F.lane >> 4;
    int og = 8 * g; asm volatile("" : "+v"(og));
    f32x2 s2 = {0.f, 0.f};
#pragma unroll
    for (int t = 0; t < 32; ++t)
#pragma unroll
        for (int q = 0; q < 4; ++q) { const f32x2 v = {bflo(xw[t][q]), bfhi(xw[t][q])}; s2 += v * v; }
    float ss = s2[0] + s2[1];
    { auto a = __builtin_amdgcn_permlane16_swap(__float_as_uint(ss), __float_as_uint(ss), false, false); ss = __uint_as_float(a[0]) + __uint_as_float(a[1]);
      auto b = __builtin_amdgcn_permlane32_swap(__float_as_uint(ss), __float_as_uint(ss), false, false); ss = __uint_as_float(b[0]) + __uint_as_float(b[1]); }
    const float rstd = rsqrtf(ss * (1.0f / 1024.0f) + RMS_EPS);
    LAS float* RS = (LAS float*)(F.lds + RF_RS) + F.wave * 16;
    if (F.lane < 16) RS[F.lane] = rstd;
    f32x4 acc = {0.f, 0.f, 0.f, 0.f};
    const LAS unsigned char* wb = F.lds + (i * RF_PITCH + og) * 2;
#pragma unroll
    for (int t = 0; t < 32; ++t) { const bf16x8 bh = *(const LAS bf16x8*)(wb + RF_WH + 64 * t), bl = *(const LAS bf16x8*)(wb + RF_WL + 64 * t); const bf16x8 a = __builtin_bit_cast(bf16x8, xw[t]);
        acc = __builtin_amdgcn_mfma_f32_16x16x32_bf16(a, bh, acc, 0, 0, 0); acc = __builtin_amdgcn_mfma_f32_16x16x32_bf16(a, bl, acc, 0, 0, 0);
        if ((t & 3) == 3) asm volatile("" ::: "memory"); }
    { const LAS float* M8 = (const LAS float*)(F.lds + RF_M8) + og; const LAS float* S8 = (const LAS float*)(F.lds + RF_S8) + og; unsigned char* hr = H8 + (size_t)(row0 + i) * DM + 8 * g;
#pragma unroll
      for (int t = 0; t < 32; ++t) { const f32x4 m0 = *(const LAS f32x4*)(M8 + 32 * t), m1 = *(const LAS f32x4*)(M8 + 32 * t + 4), h0 = *(const LAS f32x4*)(S8 + 32 * t), h1 = *(const LAS f32x4*)(S8 + 32 * t + 4);
          u32x4 x = xw[t]; asm volatile("" : "+v"(x));
          const f32x4 xa = {bflo(x[0]), bfhi(x[0]), bflo(x[1]), bfhi(x[1])}, xb = {bflo(x[2]), bfhi(x[2]), bflo(x[3]), bfhi(x[3])};
          const f32x4 ya = xa * rstd * m0 + h0, yb = xb * rstd * m1 + h1;
          u32x2 w; w.x = pk4_fp8(ya[0], ya[1], ya[2], ya[3]); w.y = pk4_fp8(yb[0], yb[1], yb[2], yb[3]); *(u32x2*)(hr + 32 * t) = w;
          if (t & 1) asm volatile("" ::: "memory"); } }
    LDS_WAIT(); asm volatile("" ::: "memory");
    const f32x4 rs4 = *(const LAS f32x4*)(RS + 4 * g); const float bias = ((const LAS float*)(F.lds + RF_BIAS))[i];
#pragma unroll
    for (int r = 0; r < 4; ++r) { const float lg = acc[r] * rs4[r] + bias; float mx = lg;
        mx = fmaxf(mx, dppf<DPP_XOR1>(mx)); mx = fmaxf(mx, dppf<DPP_XOR2>(mx)); mx = fmaxf(mx, dppf<DPP_HMIRROR>(mx)); mx = fmaxf(mx, dppf<DPP_MIRROR>(mx));
        const float ex = __expf(lg - mx); float den = ex;
        den += dppf<DPP_XOR1>(den); den += dppf<DPP_XOR2>(den); den += dppf<DPP_HMIRROR>(den); den += dppf<DPP_MIRROR>(den);
        AFF[(size_t)(row0 + 4 * g + r) * 16 + i] = ex / den; }
}
__device__ __forceinline__ void p_rowpass_f(const Params& P, Frame& F, int l, int nrows) {
    const bf16* XB = WSP(bf16, WS_XB); unsigned char* H8 = WSP(unsigned char, WS_H8); float* AFF = WSP(float, WS_AFF);
    int cur = -1;
    for (int it = F.bid; it < nrows / 128; it += F.G) { const int row0 = it * 128 + 16 * F.wave, mr = row0 < RL ? (row0 >> 12) : 8;
        const bf16* xr = XB + (size_t)(row0 + (F.lane & 15)) * DM + 8 * (F.lane >> 4);
        u32x4 xw[32];
#pragma unroll
        for (int t = 0; t < 32; ++t) xw[t] = *(const u32x4*)(xr + 32 * t);
        if (mr != cur) { rf_copy(F, WSP(unsigned char, WS_RFT) + (size_t)(l * 9 + mr) * RF_TBL); cur = mr; }
        rf_compute(F, xw, H8, AFF, row0); }
    __syncthreads();
}
constexpr int ACK_STRIDE = 72, ACV_STRIDE = 264;
constexpr int ALDS_CK = 0, ALDS_CV = 256 * ACK_STRIDE * 2, ALDS_RP = ALDS_CV + 64 * ACV_STRIDE * 2;
struct AttnState { float m, sum; f32x4 o[4]; };
__device__ __forceinline__ float xrow16_max(float x) {
    auto s = __builtin_amdgcn_permlane16_swap(__float_as_uint(x), __float_as_uint(x), false, false);
    x = fmaxf(__uint_as_float(s[0]), __uint_as_float(s[1]));
    auto t = __builtin_amdgcn_permlane32_swap(__float_as_uint(x), __float_as_uint(x), false, false);
    return fmaxf(__uint_as_float(t[0]), __uint_as_float(t[1]));
}
__device__ __forceinline__ float xrow16_sum(float x) {
    auto s = __builtin_amdgcn_permlane16_swap(__float_as_uint(x), __float_as_uint(x), false, false);
    x = __uint_as_float(s[0]) + __uint_as_float(s[1]);
    auto t = __builtin_amdgcn_permlane32_swap(__float_as_uint(x), __float_as_uint(x), false, false);
    return __uint_as_float(t[0]) + __uint_as_float(t[1]);
}
#define MFMA16(a, b, c) __builtin_amdgcn_mfma_f32_16x16x32_bf16((a), (b), (c), 0, 0, 0)
#define MFMA8(a, b, c) __builtin_amdgcn_mfma_f32_16x16x32_fp8_fp8(__builtin_bit_cast(long, (a)), __builtin_bit_cast(long, (b)), (c), 0, 0, 0)
constexpr float KS8 = 0.5f, QS8 = 2.0f;
constexpr int ACK8 = 80;
template <int NT>
__device__ __forceinline__ void attn_tail(AttnState& S, f32x4 (&sc)[NT], const u32x4 (&vw)[NT / 2][4]) {
    float cm = -__builtin_inff();
#pragma unroll
    for (int t = 0; t < NT; ++t)
#pragma unroll
        for (int j = 0; j < 4; ++j) cm = fmaxf(cm, sc[t][j]);
    cm = xrow16_max(cm);
    const bool need = (fabsf(cm) > 12.0f) && (cm > -1e30f);
    if (__builtin_amdgcn_ballot_w64(need) != 0ull) {
        const float d = need ? cm : 0.f, scl = __builtin_amdgcn_exp2f(-d);
        S.m += d; S.sum *= scl;
#pragma unroll
        for (int dt = 0; dt < 4; ++dt) S.o[dt] = S.o[dt] * scl;
#pragma unroll
        for (int t = 0; t < NT; ++t)
#pragma unroll
            for (int j = 0; j < 4; ++j) sc[t][j] -= d;
    }
    float ps = 0.f;
#pragma unroll
    for (int t = 0; t < NT; ++t)
#pragma unroll
        for (int j = 0; j < 4; ++j) { const float p = __builtin_amdgcn_exp2f(sc[t][j]); sc[t][j] = p; ps += p; }
    S.sum += ps;
#pragma unroll
    for (int ks = 0; ks < NT / 2; ++ks) { u32x4 pw; pw.x = pk2(sc[2 * ks][0], sc[2 * ks][1]); pw.y = pk2(sc[2 * ks][2], sc[2 * ks][3]); pw.z = pk2(sc[2 * ks + 1][0], sc[2 * ks + 1][1]); pw.w = pk2(sc[2 * ks + 1][2], sc[2 * ks + 1][3]);
        const bf16x8 pf = __builtin_bit_cast(bf16x8, pw);
#pragma unroll
        for (int dt = 0; dt < 4; ++dt) S.o[dt] = MFMA16(__builtin_bit_cast(bf16x8, vw[ks][dt]), pf, S.o[dt]); }
}
__device__ __forceinline__ void attn_unit2(const bf16* __restrict__ KQ, const bf16* __restrict__ VT, unsigned char* __restrict__ ATT, LAS unsigned char* lds,
                                           const int b, const int h, const int rowqA, const int rowqB, const bool win, const int r, const int qt, const int lane) {
    const int l15 = lane & 15, g = lane >> 4;
    const f32x4 z = {0.f, 0.f, 0.f, 0.f};
    u32x2 qA[2], qB[2];
    { const unsigned char* qp = (const unsigned char*)(KQ + (size_t)RT * 1024) + (size_t)(rowqA + l15) * 1024 + h * 64 + 8 * g; qA[0] = *(const u32x2*)qp; qA[1] = *(const u32x2*)(qp + 32); }
    { const unsigned char* qp = (const unsigned char*)(KQ + (size_t)RT * 1024) + (size_t)(rowqB + l15) * 1024 + h * 64 + 8 * g; qB[0] = *(const u32x2*)qp; qB[1] = *(const u32x2*)(qp + 32); }
    AttnState SA, SB; SA.m = 0.f; SA.sum = 0.f; SB.m = 0.f; SB.sum = 0.f;
#pragma unroll
    for (int dt = 0; dt < 4; ++dt) { SA.o[dt] = z; SB.o[dt] = z; }
    if (win) {
        const int rsA = min(max(r - 4, 0), 56), dB = min(max(r - 3, 0), 56) - rsA, kc0 = min(max(16 * qt - 8, 0), 32);
        const int q = 16 * qt + l15, csq = min(max(q - 8, 0), 48);
        const int krow0 = 8 * (l15 >> 2) + (l15 & 3);
        const unsigned char* kb = (const unsigned char*)KQ + ((size_t)(b * 16 + h) * SEQ + kc0 + krow0) * 64 + 8 * g;
        const bf16* vb = VT + ((((size_t)(b * 16 + h) * 512 + (kc0 >> 3) + g) * 64 + l15) << 3);
        const LAS float* rp = (const LAS float*)(lds + ALDS_RP);
        const int jb = kc0 + 8 * g;
        const int okb = jb - csq;
        const LAS float* rpl = rp + 16 + (jb - q + 15);
        float madd[2][4];
#pragma unroll
        for (int t = 0; t < 2; ++t)
#pragma unroll
            for (int j = 0; j < 4; ++j) madd[t][j] = ((unsigned)(okb + 4 * t + j) < 16u) ? 0.f : -__builtin_inff();
        u32x2 K0[2][2], K1[2][2]; u32x4 V0[1][4], V1[1][4];
#define ATT_LOADW(KB, VB, i) do { const int gr_ = min(rsA + (i), 63); const unsigned char* kp_ = kb + (size_t)(gr_ * 64) * 64; const bf16* vp_ = vb + (size_t)gr_ * (8 * 512); \
        _Pragma("unroll") for (int t = 0; t < 2; ++t) { KB[t][0] = *(const u32x2*)(kp_ + (size_t)(4 * t) * 64); KB[t][1] = *(const u32x2*)(kp_ + (size_t)(4 * t) * 64 + 32); } \
        _Pragma("unroll") for (int dt = 0; dt < 4; ++dt) VB[0][dt] = *(const u32x4*)(vp_ + 16 * dt * 8); } while (0)
#define ATT_ONE(ST, QF, KB, VB, roff, rowok) do { f32x4 sc[2]; \
        const LAS float* bp_ = rpl + ((rowok) ? (roff) : 15) * 64; \
        _Pragma("unroll") for (int t = 0; t < 2; ++t) _Pragma("unroll") for (int j = 0; j < 4; ++j) sc[t][j] = (bp_[4 * t + j] + madd[t][j]) - ST.m;     \
        _Pragma("unroll") for (int t = 0; t < 2; ++t) { sc[t] = MFMA8(KB[t][0], QF[0], sc[t]); sc[t] = MFMA8(KB[t][1], QF[1], sc[t]); } \
        attn_tail<2>(ST, sc, VB); } while (0)
#define ATT_COMPUTE(KB, VB, i) do { const int roffA_ = min(rsA + (i) - r + 7, 14); \
        ATT_ONE(SA, qA, KB, VB, roffA_, (i) <= 7); \
        ATT_ONE(SB, qB, KB, VB, max(roffA_ - 1, 0), (i) >= dB && (i) <= 7 + dB); } while (0)
        ATT_LOADW(K0, V0, 0);
#pragma unroll 1
        for (int i = 0; i < 8; i += 2) { ATT_LOADW(K1, V1, i + 1); ATT_COMPUTE(K0, V0, i); ATT_LOADW(K0, V0, i + 2); ATT_COMPUTE(K1, V1, i + 1); }
        ATT_COMPUTE(K0, V0, 8);
#undef ATT_LOADW
#undef ATT_ONE
#undef ATT_COMPUTE
    }
    { const LAS unsigned char* ck = lds + ALDS_CK + l15 * ACK8 + 8 * g;
      const LAS bf16* cv = (const LAS bf16*)(lds + ALDS_CV) + l15 * ACV_STRIDE + 8 * g;
#pragma unroll 1
      for (int c = 0; c < 4; ++c) {
          u32x2 kf[4][2]; u32x4 vw[2][4];
#pragma unroll
          for (int t = 0; t < 4; ++t) { const LAS unsigned char* kp = ck + (64 * c + 16 * t) * ACK8; kf[t][0] = *(const LAS u32x2*)kp; kf[t][1] = *(const LAS u32x2*)(kp + 32); }
#pragma unroll
          for (int ks = 0; ks < 2; ++ks)
#pragma unroll
              for (int dt = 0; dt < 4; ++dt) vw[ks][dt] = *(const LAS u32x4*)(cv + (16 * dt) * ACV_STRIDE + 64 * c + 32 * ks);
          { f32x4 sc[4]; const float nm = -SA.m; const f32x4 c0 = {nm, nm, nm, nm};
#pragma unroll
            for (int t = 0; t < 4; ++t) { sc[t] = MFMA8(kf[t][0], qA[0], c0); sc[t] = MFMA8(kf[t][1], qA[1], sc[t]); }
            attn_tail<4>(SA, sc, vw); }
          { f32x4 sc[4]; const float nm = -SB.m; const f32x4 c0 = {nm, nm, nm, nm};
#pragma unroll
            for (int t = 0; t < 4; ++t) { sc[t] = MFMA8(kf[t][0], qB[0], c0); sc[t] = MFMA8(kf[t][1], qB[1], sc[t]); }
            attn_tail<4>(SB, sc, vw); }
      } }
    { const float inv = 1.0f / xrow16_sum(SA.sum);
#pragma unroll
      for (int dt = 0; dt < 4; ++dt) { const f32x4 o = SA.o[dt] * (inv * ATS); *(unsigned*)(ATT + (size_t)(rowqA + l15) * 1024 + h * 64 + 16 * dt + 4 * g) = pk4_fp8(o[0], o[1], o[2], o[3]); } }
    { const float inv = 1.0f / xrow16_sum(SB.sum);
#pragma unroll
      for (int dt = 0; dt < 4; ++dt) { const f32x4 o = SB.o[dt] * (inv * ATS); *(unsigned*)(ATT + (size_t)(rowqB + l15) * 1024 + h * 64 + 16 * dt + 4 * g) = pk4_fp8(o[0], o[1], o[2], o[3]); } }
}
__device__ __forceinline__ void p_attn_mfma(const Params& P, Frame& F, int l, bool with_ctx_queries, int nblk, int rank) {
    const bf16* KQ = WSP(bf16, WS_KQ); const bf16* VT = WSP(bf16, WS_VT); unsigned char* ATT = WSP(unsigned char, WS_ATT);
    const float* rpb = P.rpb + (size_t)l * 16 * 465;
    int r2 = rank >> 3;
    for (int y = 0; y < (rank & 7); ++y) r2 += (nblk - y + 7) >> 3;
    const int it0 = (int)(((long)r2 * 2048) / nblk), it1 = (int)(((long)(r2 + 1) * 2048) / nblk);
    int pcur = -1;
    for (int hp = it0; hp < it1; ++hp) {
        const int p = hp >> 4, eighth = (hp >> 1) & 7, st = hp & 1, b = p >> 4, h = p & 15;
        if (p != pcur) { pcur = p;
        __syncthreads();
        { LAS bf16* ck = (LAS bf16*)(F.lds + ALDS_CK); LAS bf16* cv = (LAS bf16*)(F.lds + ALDS_CV); LAS float* rp = (LAS float*)(F.lds + ALDS_RP);
          { const int key = F.tid >> 1, hf = F.tid & 1; const int k32 = key & 31, pos = (key & ~31) + ((k32 >> 2) & 1) * 16 + 4 * (k32 >> 3) + (k32 & 3);
            const u32x4* src = (const u32x4*)((const unsigned char*)KQ + (size_t)RL * 1024 + ((size_t)(b * 16 + h) * CTXL + key) * 64 + hf * 32); LAS u32x4* dst = (LAS u32x4*)((LAS unsigned char*)ck + pos * ACK8 + hf * 32);
#pragma unroll
            for (int i = 0; i < 2; ++i) dst[i] = src[i]; }
          { const int d = F.tid >> 3, sg = F.tid & 7; const u32x4* src = (const u32x4*)(VT + YT_CTX_OFF + (size_t)(b * 1024 + h * 64 + d) * 256 + sg * 32); LAS u32x4* dst = (LAS u32x4*)(cv + d * ACV_STRIDE + sg * 32);
#pragma unroll
            for (int i = 0; i < 4; ++i) dst[i] = src[i]; }
          for (int i = F.tid; i < 16 * 64; i += NTHREADS) { const int rr = i >> 6, cc = (i & 63) - 16; rp[i] = rr == 15 ? -__builtin_inff() : ((cc >= 0 && cc < 31) ? rpb[h * 465 + rr * 31 + cc] * LOG2E : 0.f); } }
        __syncthreads(); }
        const int qt = F.wave & 3, rpi = F.wave >> 2;
        { const int r = eighth * 8 + st * 4 + rpi * 2; const int rowqA = b * SEQ + r * 64 + 16 * qt;
            attn_unit2(KQ, VT, ATT, F.lds, b, h, rowqA, rowqA + 64, true, r, qt, F.lane); }
        if (with_ctx_queries && eighth == 0 && st == 0) { const int rowqA = RL + b * CTXL + 32 * F.wave; attn_unit2(KQ, VT, ATT, F.lds, b, h, rowqA, rowqA + 16, false, 0, 0, F.lane); }
    }
    __syncthreads();
}

__device__ __forceinline__ void ld8(const bf16* p, float (&x)[8]) { const u32x4 w = *(const u32x4*)p;
#pragma unroll
    for (int q = 0; q < 4; ++q) { x[2 * q] = bflo(w[q]); x[2 * q + 1] = bfhi(w[q]); } }
__device__ __forceinline__ void add8(float (&S)[8], u32x4 w, float sg) {
    asm volatile("" : "+v"(w));
#pragma unroll
    for (int q = 0; q < 4; ++q) { S[2 * q] += sg * bflo(w[q]); S[2 * q + 1] += sg * bfhi(w[q]); }
}
template <int HW> __device__ __forceinline__ void pool_item(const bf16* src, bf16* dst, int t0, int Lb) {
    constexpr int NR = 16 + 2 * HW;
    u32x4 x[NR];
#pragma unroll
    for (int r = 0; r < NR; ++r) { const int tt = t0 - HW + r; x[r] = (tt >= 0 && tt < Lb) ? *(const u32x4*)(src + (size_t)tt * 512) : (u32x4){0u, 0u, 0u, 0u}; }
    float S[8];
#pragma unroll
    for (int q = 0; q < 8; ++q) S[q] = 0.f;
#pragma unroll
    for (int r = 0; r < 2 * HW; ++r) add8(S, x[r], 1.f);
#pragma unroll
    for (int j = 0; j < 16; ++j) { const int t = t0 + j; const int lo = max(t - HW, 0), hi = min(t + HW, Lb); const float inv = 1.0f / (float)(hi - lo);
        u32x4 me = x[HW + j]; asm volatile("" : "+v"(me)); u32x4 o;
#pragma unroll
        for (int q = 0; q < 4; ++q) o[q] = pk2(S[2 * q] * inv - bflo(me[q]), S[2 * q + 1] * inv - bfhi(me[q]));
        *(u32x4*)(dst + (size_t)t * 512) = o;
        add8(S, x[2 * HW + j], 1.f); add8(S, x[j], -1.f); }
}
__device__ __forceinline__ void p_pool(Frame& F, int nrows) {
    const bf16* PB = WSP(bf16, WS_PB); bf16* POOL = WSP(bf16, WS_POOL);
    for (int i = F.bid * NTHREADS + F.tid; i < (nrows >> 4) * 64; i += F.G * NTHREADS) {
        const int c16 = i & 15, g = (i >> 6) & 3, row0 = (((i >> 8) << 2) + ((i >> 4) & 3)) << 4, ch = g * 16 + c16;
        int base, t0, Lb; if (row0 < RL) { base = row0 & ~4095; t0 = row0 & 4095; Lb = SEQ; } else { const int rr = row0 - RL; base = RL + (rr & ~255); t0 = rr & 255; Lb = CTXL; }
        const bf16* src = PB + (size_t)base * 512 + ch * 8; bf16* dst = POOL + (size_t)base * 512 + ch * 8;
        if (g == 0) pool_item<1>(src, dst, t0, Lb); else if (g == 1) pool_item<2>(src, dst, t0, Lb); else if (g == 2) pool_item<4>(src, dst, t0, Lb); else pool_item<8>(src, dst, t0, Lb);
    }
}

__device__ __forceinline__ int block_sum_i(int v, LAS int* sm, int tid) {
    v = wave_sum_i(v);
    __syncthreads();
    if ((tid & 63) == 0) sm[tid >> 6] = v;
    __syncthreads();
    int s = 0;
#pragma unroll
    for (int i = 0; i < 8; ++i) s += sm[i];
    return s;
}
__device__ __forceinline__ int block_excl_scan(int v, LAS int* sm, int tid, int& total) {
    const int lane = tid & 63, w = tid >> 6; int inc = v;
#pragma unroll
    for (int o = 1; o < 64; o <<= 1) { const int t = __builtin_amdgcn_ds_bpermute(((lane - o) & 63) << 2, inc); if (lane >= o) inc += t; }
    __syncthreads();
    if (lane == 63) sm[w] = inc;
    __syncthreads();
    int base = 0; total = 0;
#pragma unroll
    for (int i = 0; i < 8; ++i) { const int s = sm[i]; if (i < w) base += s; total += s; }
    return base + inc - v;
}
template <int NPT>
__device__ __forceinline__ void topk_pair(Frame& F, int row0, int n, int cap, int e, int slot0) {
    LAS int* sm = (LAS int*)F.lds;
    const float* AFF = WSP(float, WS_AFF); int* SROW = WSP(int, WS_SROW); float* SG = WSP(float, WS_SGATE); int* SEL = WSP(int, WS_SEL);
    unsigned key[NPT];
#pragma unroll
    for (int j = 0; j < NPT; ++j) { const int i = F.tid * NPT + j; key[j] = (i < n) ? __float_as_uint(AFF[(size_t)(row0 + i) * 16 + e]) : 0u; }
    unsigned T = 0u;
    for (int bit = 30; bit >= 0; --bit) { const unsigned cand = T | (1u << bit); int cnt = 0;
#pragma unroll
        for (int j = 0; j < NPT; ++j) cnt += (key[j] >= cand) ? 1 : 0;
        cnt = block_sum_i(cnt, sm, F.tid);
        if (cnt >= cap) T = cand; }
    int ngt = 0, neq = 0;
#pragma unroll
    for (int j = 0; j < NPT; ++j) { ngt += (key[j] > T) ? 1 : 0; neq += (key[j] == T) ? 1 : 0; }
    int tot_gt, tot_eq;
    (void)block_excl_scan(ngt, sm, F.tid, tot_gt);
    int eqr = block_excl_scan(neq, sm, F.tid, tot_eq);
    const int need_eq = cap - tot_gt;
    int nsel = 0; bool selj[NPT];
#pragma unroll
    for (int j = 0; j < NPT; ++j) { bool s = key[j] > T; if (key[j] == T && T != 0u) { s = eqr < need_eq; ++eqr; } selj[j] = s; nsel += s ? 1 : 0; }
    int tot_sel; int pos = block_excl_scan(nsel, sm, F.tid, tot_sel);
#pragma unroll
    for (int j = 0; j < NPT; ++j) { const int i = F.tid * NPT + j;
        if (i < n) { const int row = row0 + i;
            if (selj[j]) { const int slot = slot0 + pos; ++pos; SROW[slot] = row; SG[slot] = __uint_as_float(key[j]); SEL[(size_t)row * 16 + e] = slot; }
            else SEL[(size_t)row * 16 + e] = -1; } }
    __syncthreads();
}
__device__ __forceinline__ void p_topk(Frame& F, bool with_ctx) {
    const int npairs = 128 + (with_ctx ? 128 : 0);
    for (int pi = F.bid; pi < npairs; pi += F.G) {
        if (pi < 128) { const int b = pi >> 4, e = pi & 15; topk_pair<8>(F, b * SEQ, SEQ, CAPL, e, e * SLOT_E + b * CAPL); }
        else { const int p2 = pi - 128, b = p2 >> 4, e = p2 & 15; topk_pair<1>(F, RL + b * CTXL, CTXL, CAPC, e, e * SLOT_E + 4096 + b * CAPC); }
    }
}
template <int PH> __global__ void __launch_bounds__(NTHREADS, 2) fwd_kernel(Params P) {
    extern __shared__ __attribute__((aligned(16))) unsigned char lds_raw[];
    Frame F; F.lds = (LAS unsigned char*)lds_raw; F.tid = threadIdx.x; F.lane = F.tid & 63; F.wave = __builtin_amdgcn_readfirstlane(F.tid >> 6); F.G = gridDim.x; F.bid = blockIdx.x; F.ws = P.ws;
    const int wave0 = __builtin_amdgcn_readfirstlane((int)threadIdx.x >> 6);
    volatile LAS unsigned* MISC = (volatile LAS unsigned*)(F.lds + LDS_MISC);
    if (F.tid < 64) MISC[F.tid] = 0u;
    __syncthreads();
    XcdBarrier bar; bar.bar = WSP(unsigned, WS_CTL) + CW_BAR; bar.x = 0; bar.st = MISC + 8;
    if constexpr (PH < 0) bar = xcd_barrier_post(WSP(unsigned, WS_CTL) + CW_BAR, MISC + 8);
#define IN(k) (PH < 0 || PH == (k))
#define REFRESH() do { unsigned on_ = ~0u; asm volatile("" : "+s"(on_)); int t_ = wave0 * 64 + (int)__builtin_amdgcn_mbcnt_hi(on_, __builtin_amdgcn_mbcnt_lo(on_, 0u)); asm volatile("" : "+v"(t_)); F.tid = t_; F.lane = t_ & 63; F.wave = __builtin_amdgcn_readfirstlane(t_ >> 6); } while (0)
#define SEAM(k) do { if constexpr (PH < 0) xcd_barrier(bar); } while (0)

    if (IN(0)) { REP_BEGIN(100) p_mod(P, F); p_dftgen(F); REP_END REP_BEGIN(101) p_wconv(P, F, 0); REP_END }
    SEAM(0);
    if (IN(1)) { p_rftables(P, F); p_rowpass_a0(P, F); }
    SEAM(1);
    for (int l = P.l_lo; l < P.l_hi; ++l) {
        constexpr int pb = 2; const bool L0 = (l == 0);
        bf16* H = WSP(bf16, WS_H);
        if (IN(pb + 0)) { REFRESH(); REP_BEGIN(2)
            const int u1 = 128 * 8 + 8 * (L0 ? 8 : 4), u2a = 128 * 2 + (L0 ? 8 * 2 : 0), u2 = u2a + 128 * 12 + (L0 ? 8 * 12 : 0), u3 = 4 * 128 + (L0 ? 4 * 8 : 0);
            const bf16* H8 = WSP(bf16, WS_H8); const bf16* WA8 = WSP(bf16, WS_WA8);
            { GroupSched S; S.init(1, 128, 8, F.G, F.bid, 8, L0 ? 8 : 4, 128, 0);
              auto AD = [=](const Unit& u) { return Operands{H8 + (size_t)u.pm * 256 * 512, WA8 + (size_t)u.pn * 256 * 512, 512, 512, 0, 512}; };
              bf16* KQ = WSP(bf16, WS_KQ);
              auto E = [=](EPI_ARGS) { const int row0 = u.pm * 256;
                  if (u.pn >= 4) { const float qs = QSCALE * INV8 * QS8;
                      EPI_FOR8( const f32x4 q0 = v0 * qs; const f32x4 q1 = v1 * qs; u32x2 w; w.x = pk4_fp8(q0[0], q0[1], q0[2], q0[3]); w.y = pk4_fp8(q1[0], q1[1], q1[2], q1[3]);
                                *(u32x2*)((unsigned char*)(KQ + (size_t)RT * 1024) + (size_t)(row0 + r) * 1024 + (u.pn - 4) * 256 + c) = w; ) }
                  else if (row0 < RL) { const int b = row0 >> 12, t0 = row0 & 4095;
                      EPI_FOR8( const int col = u.pn * 256 + c; const f32x4 k0 = v0 * (INV8 * KS8); const f32x4 k1 = v1 * (INV8 * KS8); u32x2 w; w.x = pk4_fp8(k0[0], k0[1], k0[2], k0[3]); w.y = pk4_fp8(k1[0], k1[1], k1[2], k1[3]);
                                *(u32x2*)((unsigned char*)KQ + ((size_t)(b * 16 + (col >> 6)) * SEQ + t0 + r) * 64 + (col & 63)) = w; ) }
                  else { const int rr0 = row0 - RL, b = rr0 >> 8, t0 = rr0 & 255;
                      EPI_FOR8( const int col = u.pn * 256 + c; const f32x4 k0 = v0 * (INV8 * KS8); const f32x4 k1 = v1 * (INV8 * KS8); u32x2 w; w.x = pk4_fp8(k0[0], k0[1], k0[2], k0[3]); w.y = pk4_fp8(k1[0], k1[1], k1[2], k1[3]);
                                *(u32x2*)((unsigned char*)KQ + (size_t)RL * 1024 + ((size_t)(b * 16 + (col >> 6)) * CTXL + t0 + r) * 64 + (col & 63)) = w; ) } };
              GEMM_P8(S, AD, E); }
            REFRESH();
            { GroupSched S; S.init(1, 128, 2, F.G, (F.bid + F.G - ((u1 % F.G) & ~7)) % F.G, L0 ? 8 : 0, 2, 128, 0);
              const bf16* WA = WSP(bf16, WS_WA);
              auto AD = [=](const Unit& u) { return Operands{H + (size_t)u.pm * 256 * DM, WA + (size_t)(u.pn + 8) * 256 * DM, DM, DM, 0, DM}; };
              bf16* PBp = WSP(bf16, WS_PB);
              auto E = [=](EPI_ARGS) { const int row0 = u.pm * 256; EPI_FOR8( st_bf8(PBp + (size_t)(row0 + r) * 512 + u.pn * 256 + c, v0, v1); ) };
              GEMM_P(S, AD, E); }
            REFRESH();
            { GroupSched S; S.init(1, 128, 12, F.G, (F.bid + F.G - (((u1 + u2a) % F.G) & ~7)) % F.G, L0 ? 8 : 0, 12, 128, 0);
              unsigned char* GB = WSP(unsigned char, WS_GB);
              auto AD = [=](const Unit& u) { return Operands{H8 + (size_t)u.pm * 256 * 512, WA8 + (size_t)(3072 + u.pn * 256) * 512, 512, 512, 0, 512}; };
              auto E = [=](EPI_ARGS) { const int row0 = u.pm * 256;
                  EPI_FOR8( f32x4 s0; f32x4 s1; _Pragma("unroll") for (int j = 0; j < 4; ++j) { s0[j] = sigmoidf_(v0[j] * INV8) * G8S; s1[j] = sigmoidf_(v1[j] * INV8) * G8S; }
                            u32x2 w; w.x = pk4_u8(s0[0], s0[1], s0[2], s0[3]); w.y = pk4_u8(s1[0], s1[1], s1[2], s1[3]); *(u32x2*)(GB + (size_t)(row0 + r) * 3072 + u.pn * 256 + c) = w; ) };
              GEMM_P8(S, AD, E); }
            REFRESH();
            { GroupSched S; S.init(1, 4, 128, F.G, (F.bid + F.G - (((u1 + u2) % F.G) & ~7)) % F.G, L0 ? 4 : 0, 8, 0, 128);
              const bf16* WFV = WSP(bf16, WS_WFV);
              auto AD = [=](const Unit& u) { const bool fmap = (u.pn < 128); const int t16 = u.pn & 15;
                  const size_t tok0 = fmap ? (size_t)(u.pn >> 4) * SEQ + 64 * ((t16 >> 1) * 8) + (t16 & 1) * 32 : (size_t)u.pn * 256;
                  return Operands{WFV + (size_t)u.pm * 256 * DM, H + tok0 * DM, DM, DM, 0, DM, fmap ? 1 : 0}; };
              bf16* YT = WSP(bf16, WS_YT);
              auto E = [=](EPI_ARGS) { const int rr0 = u.pm * 256;
                  if (u.pn < 128) { const int b = u.pn >> 4; const int t16 = u.pn & 15, l10 = (t16 >> 1) * 8, l20 = (t16 & 1) * 32;
                      EPI_FOR8( const int fc = rr0 + r; st_bf8(YT + (((((size_t)b * 512 + (fc >> 1)) * 32 + (c >> 3)) * 2 + (l20 >> 5)) * 2 + (fc & 1)) * 64 + l10, v0, v1); ) }
                  else { const int b = u.pn - 128; EPI_FOR8( st_bf8(YT + YT_CTX_OFF + ((size_t)b * 1024 + rr0 + r) * 256 + c, v0, v1); ) } };
              GEMM_P(S, AD, E); }
            REFRESH();
            { GroupSched S; S.init(1, 4, 128, F.G, (F.bid + F.G - (((u1 + u2 + u3) % F.G) & ~7)) % F.G, 4, 8, 0, 128);
              auto AD = [=](const Unit& u) { return Operands{WA8 + (size_t)(2048 + u.pm * 256) * 512, H8 + (size_t)u.pn * 256 * 512, 512, 512, 0, 512}; };
              bf16* VT = WSP(bf16, WS_VT);
              auto E = [=](EPI_ARGS) { const int rr0 = u.pm * 256;
                  if (u.pn < 128) { const int b = u.pn >> 4, l0 = (u.pn & 15) * 256; EPI_FOR8( const int ch = rr0 + r; st_bf8(VT + ((((size_t)(b * 16 + (ch >> 6)) * 512 + ((l0 + c) >> 3)) * 64 + (ch & 63)) << 3), v0 * INV8, v1 * INV8); ) }
                  else { const int b = u.pn - 128; EPI_FOR8( st_bf8(VT + YT_CTX_OFF + ((size_t)b * 1024 + rr0 + r) * 256 + c, v0 * INV8, v1 * INV8); ) } };
              GEMM_P8(S, AD, E); }
        REP_END }
        SEAM(pb + 0);
        if (IN(pb + 1)) { REFRESH();
            { const int nc0 = F.G * (L0 ? 69 : 27) / 256, nconv = nc0 > 0 ? nc0 : 1, na = F.G - nconv;
              if (F.bid < na) p_attn_mfma(P, F, l, L0, na, F.bid);
              else wconv_experts(P, F, l, F.bid - na, nconv, L0 ? 0 : CV_C, CV_NIT); }
            REFRESH();
            REP_BEGIN(32)
            { LAS float* tw = (LAS float*)(F.lds + LDS_TW);
              for (int j = F.tid; j < 4096; j += NTHREADS) tw[j] = cospif((float)j * (1.0f / 2048.0f));
              __syncthreads();
              GroupSched S; S.init(1, 1, 512, F.G, F.bid);
              const bf16* M1 = WSP(bf16, WS_M1T); const bf16* YF = WSP(bf16, WS_YT); bf16* ZP = WSP(bf16, WS_ZP);
              auto AD = [=](const Unit& u) { return Operands{M1, YF + (size_t)u.pn * 256 * 256, 256, 256, 0, 256}; };
              auto E = [=](EPI_ARGS) {
                  const int b = u.pn >> 6, gm0 = (u.pn & 63) * 8 + wc, l20 = 32 * wr + 8 * fq;
#pragma unroll
                  for (int m = 0; m < 4; ++m) { const int k1 = 16 * m + fr;
#pragma unroll
                      for (int bj = 0; bj < 2; ++bj) { const int gm = gm0 + 4 * bj;
                          f32x4 zr[2], zi[2];
#pragma unroll
                          for (int n = 0; n < 2; ++n)
#pragma unroll
                              for (int j = 0; j < 4; ++j) { const int ix = k1 * (l20 + 4 * n + j); const float tc = tw[ix], ts = tw[(ix + 3072) & 4095];
                                  const float ur = acc[0][bj][m][n][j], ui = acc[1][bj][m][n][j]; zr[n][j] = ur * tc - ui * ts; zi[n][j] = ur * ts + ui * tc; }
                          bf16* dst = ZP + (((((size_t)b * 64 + k1) * 128 + (gm & 127)) * 4 + (gm >> 7)) * 2) * 64 + l20;
                          st_bf8(dst, zr[0], zr[1]); st_bf8(dst + 64, zi[0], zi[1]); } } };
              GEMM_P_BNT(S, AD, E); }
            REP_END
        }
        SEAM(pb + 1);
        if (IN(pb + 10)) { REFRESH();
            { GroupSched S; S.init(1, L0 ? 136 : 128, 4, F.G, F.bid);
              const bf16* A8 = WSP(bf16, WS_ATT); const bf16* W8 = WSP(bf16, WS_WAO); const unsigned char* GB = WSP(unsigned char, WS_GB); unsigned char* YA = WSP(unsigned char, WS_KQ);
              auto AD = [=](const Unit& u) { return Operands{A8 + (size_t)u.pm * 256 * 512, W8 + (size_t)u.pn * 256 * 512, 512, 512, 0, 512}; };
              auto E = [=](EPI_ARGS) { const int colb = u.pn * 256 + wc * 32 + 8 * fq;
#pragma unroll
                  for (int ai = 0; ai < 2; ++ai) { u32x2 g0[4][2];
#pragma unroll
                      for (int m = 0; m < 4; ++m)
#pragma unroll
                          for (int bj = 0; bj < 2; ++bj) g0[m][bj] = *(const u32x2*)(GB + ((size_t)u.pm * 256 + ai * 128 + wr * 64 + m * 16 + fr) * 3072 + colb + bj * 128);
#pragma unroll
                      for (int m = 0; m < 4; ++m)
#pragma unroll
                          for (int bj = 0; bj < 2; ++bj) { const u32x2 g = g0[m][bj]; const f32x4 ga = u8x4_f(g.x), gb = u8x4_f(g.y);
                              const f32x4 o0 = acc[ai][bj][m][0] * ga * (INVAT * G8I * YS), o1 = acc[ai][bj][m][1] * gb * (INVAT * G8I * YS); u32x2 w; w.x = pk4_fp8(o0[0], o0[1], o0[2], o0[3]); w.y = pk4_fp8(o1[0], o1[1], o1[2], o1[3]);
                              *(u32x2*)(YA + ((size_t)u.pm * 256 + ai * 128 + wr * 64 + m * 16 + fr) * 1024 + colb + bj * 128) = w; } } };
              GEMM_P8(S, AD, E); }
            REFRESH();
            { GroupSched S; S.init(1, 1, 256, F.G, F.bid);
              const bf16* M2 = WSP(bf16, WS_M2T); const bf16* ZP = WSP(bf16, WS_ZP); bf16* FOUR = WSP(bf16, WS_FOUR);
              auto AD = [=](const Unit& u) { return Operands{M2, ZP + (size_t)u.pn * 256 * 512, 512, 512, 0, 512}; };
              auto E = [=](EPI_ARGS) { const float sc = 0.0013810679320049757f;
#pragma unroll
                  for (int ai = 0; ai < 2; ++ai)
#pragma unroll
                      for (int m = 0; m < 4; ++m) { const int q = 2 * ai + wr, k2 = 16 * m + fr;
#pragma unroll
                          for (int bj = 0; bj < 2; ++bj) { const int bk = u.pn * 2 + bj, b = bk >> 6, k1 = bk & 63;
                              st_bf8(FOUR + ((size_t)b * SEQ + k1 + 64 * k2) * 512 + q * 128 + wc * 32 + 8 * fq, acc[ai][bj][m][0] * sc, acc[ai][bj][m][1] * sc); } } };
              GEMM_P_BNT(S, AD, E); }
            REFRESH();
            if (L0) { GroupSched S; S.init(1, 1, 16, F.G, (F.bid + F.G - 128 % F.G) % F.G);
              const bf16* DFTC = WSP(bf16, WS_DFTC); const bf16* YTC = WSP(bf16, WS_YT) + YT_CTX_OFF; bf16* FOUR = WSP(bf16, WS_FOUR);
              auto AD = [=](const Unit& u) { return Operands{DFTC, YTC + (size_t)u.pn * 256 * 512, 512, 512, 0, 512}; };
              auto E = [=](EPI_ARGS) { const int b = u.pn >> 1, c0 = (u.pn & 1) * 256; const float sc = 0.005524271728019903f;
                  EPI_FOR8( st_bf8(FOUR + ((size_t)RL + b * CTXL + r) * 512 + c0 + c, v0 * sc, v1 * sc); ) };
              GEMM_P(S, AD, E); }
            REFRESH();
            REP_BEGIN(33) p_pool(F, L0 ? RT : RL); REP_END
        }
        SEAM(pb + 10);
        if (IN(pb + 2)) { REFRESH();
            SegSched<2> S; S.base.init(1, L0 ? 136 : 128, 4, F.G, F.bid);
            const bf16* FOUR = WSP(bf16, WS_FOUR); const bf16* POOL = WSP(bf16, WS_POOL); const bf16* WFO = WSP(bf16, WS_WFO); const bf16* WPO = WSP(bf16, WS_WPO);
            const unsigned char* GB = WSP(unsigned char, WS_GB); const unsigned char* YA = WSP(unsigned char, WS_KQ); bf16* MRGB = WSP(bf16, WS_MRGB); const float* ps = P.pool_scale + l * 1024;
            auto AD = [=](const Unit& u) {
                if (u.seg == 0) return Operands{FOUR + (size_t)u.pm * 256 * 512, WFO + (size_t)u.pn * 256 * 512, 512, 512, 0, 512};
                return Operands{POOL + (size_t)u.pm * 256 * 512 + u.pn * 128, WPO + (size_t)u.pn * 256 * 128, 512, 128, 0, 128}; };
            auto E = [=](EPI_ARGS) {
                const bool fin = (u.seg == 1); const int colb = u.pn * 256 + wc * 32 + 8 * fq;
                f32x4 psv[2][2];
#pragma unroll
                for (int bj = 0; bj < 2; ++bj)
#pragma unroll
                    for (int n = 0; n < 2; ++n) { f32x4 p = *(const f32x4*)(ps + colb + bj * 128 + 4 * n);
#pragma unroll
                        for (int j = 0; j < 4; ++j) p[j] = (fabsf(p[j]) < 1e-18f) ? copysignf(1e-18f, p[j]) : p[j];
                        psv[bj][n] = p * G8I; }
#pragma unroll
                for (int ai = 0; ai < 2; ++ai)
#pragma unroll
                    for (int m = 0; m < 4; ++m) { const size_t row = (size_t)u.pm * 256 + ai * 128 + wr * 64 + m * 16 + fr; const unsigned char* gr = GB + row * 3072 + colb;
                        u32x2 g2r[2], xr[2];
#pragma unroll
                        for (int bj = 0; bj < 2; ++bj) { g2r[bj] = *(const u32x2*)(gr + 2048 + bj * 128);
                            const unsigned char* px = fin ? (YA + row * 1024 + colb + bj * 128) : (gr + 1024 + bj * 128); xr[bj] = *(const u32x2*)px; }
#pragma unroll
                        for (int bj = 0; bj < 2; ++bj) { f32x4 o[2];
#pragma unroll
                            for (int n = 0; n < 2; ++n) {
                                f32x4 g2 = u8x4_f(g2r[bj][n]);
#pragma unroll
                                for (int j = 0; j < 4; ++j) g2[j] = fmaxf(g2[j], 1e-16f);
                                g2 = g2 * psv[bj][n];
                                const f32x2 ylo = __builtin_amdgcn_cvt_pk_f32_fp8((int)xr[bj][n], false), yhi = __builtin_amdgcn_cvt_pk_f32_fp8((int)xr[bj][n], true);
                                const f32x4 xa = (f32x4){ylo[0], ylo[1], yhi[0], yhi[1]} * YSI, xb = u8x4_f(xr[bj][n]) * G8I;
#pragma unroll
                                for (int j = 0; j < 4; ++j) o[n][j] = fin ? (xa[j] + acc[ai][bj][m][n][j] * g2[j]) : (acc[ai][bj][m][n][j] * xb[j] * __builtin_amdgcn_rcpf(g2[j]));
                                acc[ai][bj][m][n] = o[n]; }
                            if (fin) st_bf8(MRGB + row * 1024 + colb + bj * 128, o[0], o[1]); } } };
            gemm_fast<false, true, false>(F.lds, F.tid, S, AD, mk_epi_seg(E, 1), nullptr);
            REFRESH();
            if (L0) { const int nun = 136 * 4, busy = nun - ((nun - 1) / F.G) * F.G;
                if (busy < F.G && F.bid >= busy) wconv_experts(P, F, 1, F.bid - busy, F.G - busy, 0, CV_A); }
        }
        SEAM(pb + 2);
        if (IN(pb + 3)) { REFRESH();
            GroupSched S; S.init(1, L0 ? 136 : 128, 4, F.G, F.bid); const bf16* A = WSP(bf16, WS_MRGB); const bf16* W = WSP(bf16, WS_WOUT);
            bf16* XB = WSP(bf16, WS_XB); const float* MOD = WSP(float, WS_MOD) + (size_t)l * 9 * 6144;
            auto AD = [=](const Unit& u) { return Operands{A + (size_t)u.pm * 256 * 1024, W + (size_t)u.pn * 256 * 1024, 1024, 1024, 0, 1024}; };
            auto E = [=](EPI_ARGS) {
                const int row0 = u.pm * 256, mr = row0 < RL ? (row0 >> 12) : 8, colb = u.pn * 256 + wc * 32 + 8 * fq;
                bf16* dst0 = XB + (size_t)row0 * DM;
                f32x4 gv[2][2];
#pragma unroll
                for (int bj = 0; bj < 2; ++bj)
#pragma unroll
                    for (int n = 0; n < 2; ++n) gv[bj][n] = *(const f32x4*)(MOD + (size_t)mr * 6144 + 2048 + colb + bj * 128 + 4 * n);
                if (L0) { const float* src0 = row0 < RL ? P.x + (size_t)row0 * DM : P.ctx + (size_t)(row0 - RL) * DM;
#pragma unroll
                    for (int am = 0; am < 4; ++am) { const int ai = am >> 1, mh = (am & 1) * 2; f32x4 xv[2][2][2];
#pragma unroll
                        for (int m = 0; m < 2; ++m) { const size_t ro = (size_t)(ai * 128 + wr * 64 + (mh + m) * 16 + fr) * DM + colb;
#pragma unroll
                            for (int bj = 0; bj < 2; ++bj)
#pragma unroll
                                for (int n = 0; n < 2; ++n) xv[m][bj][n] = __builtin_nontemporal_load((const f32x4*)(src0 + ro + bj * 128 + 4 * n)); }
#pragma unroll
                        for (int m = 0; m < 2; ++m) { const size_t ro = (size_t)(ai * 128 + wr * 64 + (mh + m) * 16 + fr) * DM + colb;
#pragma unroll
                            for (int bj = 0; bj < 2; ++bj) st_bf8(dst0 + ro + bj * 128, xv[m][bj][0] + gv[bj][0] * acc[ai][bj][mh + m][0], xv[m][bj][1] + gv[bj][1] * acc[ai][bj][mh + m][1]); } }
                } else {
#pragma unroll
                    for (int ai = 0; ai < 2; ++ai) { u32x4 xr[4][2];
#pragma unroll
                        for (int m = 0; m < 4; ++m) { const size_t ro = (size_t)(ai * 128 + wr * 64 + m * 16 + fr) * DM + colb;
#pragma unroll
                            for (int bj = 0; bj < 2; ++bj) xr[m][bj] = *(const u32x4*)(dst0 + ro + bj * 128); }
#pragma unroll
                        for (int m = 0; m < 4; ++m) { const size_t ro = (size_t)(ai * 128 + wr * 64 + m * 16 + fr) * DM + colb;
#pragma unroll
                            for (int bj = 0; bj < 2; ++bj) { const u32x4 x = xr[m][bj]; const f32x4 xa = {bflo(x[0]), bfhi(x[0]), bflo(x[1]), bfhi(x[1])}, xb = {bflo(x[2]), bfhi(x[2]), bflo(x[3]), bfhi(x[3])};
                                st_bf8(dst0 + ro + bj * 128, xa + gv[bj][0] * acc[ai][bj][m][0], xb + gv[bj][1] * acc[ai][bj][m][1]); } } } } };
            GEMM_P(S, AD, E);
            REFRESH();
            if (L0) { const int nun = 136 * 4, busy = nun - ((nun - 1) / F.G) * F.G;
                if (busy < F.G && F.bid >= busy) wconv_experts(P, F, 1, F.bid - busy, F.G - busy, CV_A, CV_B); }
        }
        SEAM(pb + 3);
        if (IN(pb + 4)) { REFRESH(); REP_BEGIN(6) p_rowpass_f(P, F, l, L0 ? RT : RL); REP_END }
        SEAM(pb + 4);
        if (IN(pb + 5)) { REFRESH(); REP_BEGIN(7) p_topk(F, L0); REP_END }
        SEAM(pb + 5);
        if (IN(pb + 7)) { REFRESH(); REP_BEGIN(9)
            GroupSched S; S.init(16, L0 ? 17 : 16, 22, F.G, F.bid); const bf16* H8 = WSP(bf16, WS_H8); const bf16* W = WSP(bf16, l ? WS_WGU1 : WS_WGU); unsigned char* HID = WSP(unsigned char, WS_HID); const int* SROW = WSP(int, WS_SROW);
            auto AD = [=](const Unit& u) { return Operands{H8, W + ((size_t)u.grp * 5632 + u.pn * 256) * 512, 512, 512, u.grp * SLOT_E + u.pm * 256, 512}; };
            auto E = [=](EPI_ARGS) {
#pragma unroll
                for (int ai = 0; ai < 2; ++ai)
#pragma unroll
                    for (int m = 0; m < 4; ++m) { const size_t slot = (size_t)u.grp * SLOT_E + u.pm * 256 + ai * 128 + wr * 64 + m * 16 + fr; f32x4 o[2];
#pragma unroll
                        for (int n = 0; n < 2; ++n) { const f32x4 a = acc[ai][0][m][n] * INV8, up = acc[ai][1][m][n] * (INV8 * A8S);
#pragma unroll
                            for (int j = 0; j < 4; ++j) o[n][j] = a[j] * sigmoidf_(a[j]) * up[j]; }
                        u32x2 w; w.x = pk4_fp8(o[0][0], o[0][1], o[0][2], o[0][3]); w.y = pk4_fp8(o[1][0], o[1][1], o[1][2], o[1][3]);
                        *(u32x2*)(HID + slot * FF + u.pn * 128 + wc * 32 + 8 * fq) = w; } };
            GEMM_GATHER8(S, AD, E, SROW);
        REP_END }
        SEAM(pb + 7);
        if (IN(pb + 8)) { REFRESH(); REP_BEGIN(10)
            const int tpe = L0 ? 17 : 16;
            GroupSched S; S.init(1, 16 * tpe, 4, F.G, F.bid); const bf16* HID = WSP(bf16, WS_HID); const bf16* W = WSP(bf16, l ? WS_WD1 : WS_WD); unsigned char* Y = WSP(unsigned char, WS_Y); const float* SG = WSP(float, WS_SGATE);
            auto AD = [=](const Unit& u) { const int e = u.pm / tpe, st = e * 17 + (u.pm - e * tpe); return Operands{HID + (size_t)st * 256 * (FF / 2), W + ((size_t)e * 1024 + u.pn * 256) * (FF / 2), FF / 2, FF / 2, 0, FF / 2}; };
            auto E = [=](EPI_ARGS) { const int e = u.pm / tpe; const size_t slot0 = (size_t)(e * 17 + (u.pm - e * tpe)) * 256 + wr * 64 + fr; float gt[2][4];
#pragma unroll
                for (int ai = 0; ai < 2; ++ai)
#pragma unroll
                    for (int m = 0; m < 4; ++m) gt[ai][m] = SG[slot0 + ai * 128 + m * 16] * (INV8 * YS);
#pragma unroll
                for (int ai = 0; ai < 2; ++ai)
#pragma unroll
                    for (int m = 0; m < 4; ++m)
#pragma unroll
                        for (int bj = 0; bj < 2; ++bj) { const f32x4 o0 = acc[ai][bj][m][0] * gt[ai][m], o1 = acc[ai][bj][m][1] * gt[ai][m]; u32x2 w; w.x = pk4_fp8(o0[0], o0[1], o0[2], o0[3]); w.y = pk4_fp8(o1[0], o1[1], o1[2], o1[3]);
                            *(u32x2*)(Y + (slot0 + ai * 128 + m * 16) * DM + u.pn * 256 + bj * 128 + wc * 32 + 8 * fq) = w; } };
            GEMM_P8(S, AD, E);
            REFRESH();
            if (L0) { const int nun = 16 * 17 * 4, busy = nun - ((nun - 1) / F.G) * F.G;
                if (busy < F.G && F.bid >= busy) wconv_experts(P, F, 1, F.bid - busy, F.G - busy, CV_B, CV_C); }
        REP_END }
        SEAM(pb + 8);
        if (IN(pb + 9)) { REFRESH(); p_rowpass_k(P, F, l, L0 ? RT : RL); if (L0) p_wconv(P, F, 1); }
        if (L0) SEAM(pb + 9);
    }
#undef IN
#undef SEAM
}
template <int PH> static void launch_ph(int grid, const Params& p, hipStream_t stream) { hipLaunchKernelGGL(fwd_kernel<PH>, dim3(grid), dim3(NTHREADS), LDS_BYTES, stream, p); }
template <int PH> static bool set_attr() { return hipFuncSetAttribute((const void*)fwd_kernel<PH>, hipFuncAttributeMaxDynamicSharedMemorySize, LDS_BYTES) == hipSuccess; }

#ifndef DUP_LAUNCH
#define DUP_LAUNCH -1
#endif
extern "C" void kernel_launch(void* const* d_in, const int* in_sizes, int n_in, void* d_out, int out_size, void* d_ws, size_t ws_size, hipStream_t stream) {
    static int grid = 0;
    if (grid == 0) {
        if (n_in != 20 || out_size != RL * DM || ws_size < WS_END) { fprintf(stderr, "kernel_launch: unexpected shapes (n_in %d out %d ws %zu need %zu)\n", n_in, out_size, ws_size, (size_t)WS_END); grid = -1; return; }
        int dev = 0, cus = 0, per_cu = 0;
        if (hipGetDevice(&dev) != hipSuccess || hipDeviceGetAttribute(&cus, hipDeviceAttributeMultiprocessorCount, dev) != hipSuccess) { grid = -1; return; }
#if N_LAUNCH_MODE == 1
        if (!set_attr<-1>()) { fprintf(stderr, "kernel_launch: hipFuncSetAttribute failed\n"); grid = -1; return; }
        if (hipOccupancyMaxActiveBlocksPerMultiprocessor(&per_cu, (const void*)fwd_kernel<-1>, NTHREADS, LDS_BYTES) != hipSuccess || per_cu < 1) fprintf(stderr, "kernel_launch: occupancy query reports %d\n", per_cu);
#else
        if (!(set_attr<0>() && set_attr<1>() && set_attr<2>() && set_attr<3>() && set_attr<12>() && set_attr<4>() && set_attr<5>() && set_attr<6>() && set_attr<7>() && set_attr<9>() && set_attr<10>() && set_attr<11>())) { fprintf(stderr, "kernel_launch: hipFuncSetAttribute failed\n"); grid = -1; return; }
        (void)per_cu;
#endif
        (void)hipGetLastError();
        grid = cus;
    }
    if (grid < 0) return;
    if (hipMemsetAsync((char*)d_ws + WS_CTL, 0, CTL_BYTES, stream) != hipSuccess) return;
    Params p{};
    const float** pp = (const float**)&p;
    for (int i = 0; i < 20; ++i) pp[i] = (const float*)d_in[i];
    p.out = (float*)d_out; p.ws = (unsigned char*)d_ws;
#if N_LAUNCH_MODE == 1
    p.l_lo = 0; p.l_hi = 2;
    launch_ph<-1>(grid, p, stream);
#else
    p.l_lo = 0; p.l_hi = 0; launch_ph<0>(grid, p, stream); if (DUP_LAUNCH == 0) launch_ph<0>(grid, p, stream); launch_ph<1>(grid, p, stream); if (DUP_LAUNCH == 1) launch_ph<1>(grid, p, stream);
#define LP(k) do { launch_ph<k>(grid, p, stream); if (DUP_LAUNCH == (k) && l == 0) launch_ph<k>(grid, p, stream); } while (0)
    for (int l = 0; l < 2; ++l) { p.l_lo = l; p.l_hi = l + 1;
        LP(2); LP(3); LP(12); LP(4); LP(5); LP(6); LP(7); LP(9); LP(10); LP(11); }
#endif
}
```
